# Optimizing an MI355X kernel written in HIP

```python
import math
import jax
import jax.numpy as jnp
from jax import lax
import numpy as np

D_MODEL = 1024
BATCH = 4
SEQ = 8192
DEPTH = 2

EPS = 1e-6
M_HEADS = 4
M_DH = D_MODEL // 8
M_W = M_HEADS * M_DH
M_CHUNK = 128
CONV_K = 4
B_HEADS = 8
B_DH = D_MODEL // 16
B_W = B_HEADS * B_DH
MOBA_BLOCK = 256
MOBA_TOPK = 3
MOBA_QCHUNK = 64
C_HEADS = 8
C_DH = D_MODEL // 16
C_VDH = 2 * C_DH
C_W = C_HEADS * C_VDH
C_QBLOCK = 128
PEER_HEADS = 8
PEER_NKEYS = 128
PEER_N = PEER_NKEYS * PEER_NKEYS
PEER_DK = 256
PEER_TOPK = 16
PEER_TOK_CHUNK = 128

IN_EVEN = 4 * M_W + 2 * M_HEADS + 3 * B_W
MIX_EVEN = M_W + B_W
IN_ODD = 4 * C_HEADS * C_DH + C_HEADS * C_VDH
N_EVEN = (DEPTH + 1) // 2
N_ODD = DEPTH // 2

kernel_name = 'hybrid_mlstm_moba_diffattn_peer_block'


def rms_norm(x, g):
    xf = x.astype(jnp.float32)
    y = xf * lax.rsqrt(jnp.mean(xf * xf, axis=-1, keepdims=True) + EPS)
    return (y * g.astype(jnp.float32)).astype(x.dtype)


def alibi_slopes(n_heads):
    return jnp.asarray([2.0 ** (-8.0 * (h + 1) / n_heads) for h in range(n_heads)], dtype=jnp.float32)


def causal_depthwise_conv(x, w):
    ch = x.shape[-1]
    return lax.conv_general_dilated(x, w.astype(x.dtype)[:, None, :], window_strides=(1,),
                                    padding=[(CONV_K - 1, 0)],
                                    dimension_numbers=('NWC', 'WIO', 'NWC'),
                                    feature_group_count=ch)


def to_heads(t, n_heads):
    bn, s, _ = t.shape
    return t.reshape(bn, s, n_heads, -1).transpose(0, 2, 1, 3)


def from_heads(t):
    bn, h, s, dh = t.shape
    return t.transpose(0, 2, 1, 3).reshape(bn, s, h * dh)


def mlstm_chunkwise(q, k, v, i_pre, f_pre):
    f32 = jnp.float32
    bn, nh, s, dh = q.shape
    L = M_CHUNK
    nc = s // L
    q = q.astype(f32).reshape(bn, nh, nc, L, dh)
    k = (k.astype(f32) * dh ** -0.5).reshape(bn, nh, nc, L, dh)
    v = v.astype(f32).reshape(bn, nh, nc, L, dh)
    ig = i_pre.astype(f32).reshape(bn, nh, nc, L)
    b = jnp.cumsum(jax.nn.log_sigmoid(f_pre.astype(f32)).reshape(bn, nh, nc, L), axis=-1)
    b_end = b[..., -1]
    w_end = b_end[..., None] - b + ig
    m_loc = jnp.max(w_end, axis=-1)
    e_end = jnp.exp(w_end - m_loc[..., None])
    c_loc = jnp.einsum('bhcl,bhcld,bhcle->bhcde', e_end, k, v)
    n_loc = jnp.einsum('bhcl,bhcld->bhcd', e_end, k)

    def step(carry, inp):
        c_st, n_st, m_st = carry
        be, cl, nl, ml = inp
        m_new = jnp.maximum(be + m_st, ml)
        a = jnp.exp(be + m_st - m_new)
        sc = jnp.exp(ml - m_new)
        c_new = a[..., None, None] * c_st + sc[..., None, None] * cl
        n_new = a[..., None] * n_st + sc[..., None] * nl
        return (c_new, n_new, m_new), (c_st, n_st, m_st)

    init = (jnp.zeros((bn, nh, dh, dh), f32), jnp.zeros((bn, nh, dh), f32), jnp.zeros((bn, nh), f32))
    xs = tuple(jnp.moveaxis(t, 2, 0) for t in (b_end, c_loc, n_loc, m_loc))
    _, (c_prev, n_prev, m_prev) = lax.scan(step, init, xs)
    c_prev = jnp.moveaxis(c_prev, 0, 2)
    n_prev = jnp.moveaxis(n_prev, 0, 2)
    m_prev = jnp.moveaxis(m_prev, 0, 2)
    causal = jnp.tril(jnp.ones((L, L), dtype=bool))
    log_d = jnp.where(causal, b[..., :, None] - b[..., None, :] + ig[..., None, :], -jnp.inf)
    a_inter = b + m_prev[..., None]
    m_t = jnp.maximum(a_inter, jnp.max(log_d, axis=-1))
    w_inter = jnp.exp(a_inter - m_t)
    s_intra = jnp.einsum('bhcld,bhcsd->bhcls', q, k) * jnp.exp(log_d - m_t[..., None])
    num = (w_inter[..., None] * jnp.einsum('bhcld,bhcde->bhcle', q, c_prev)
           + jnp.einsum('bhcls,bhcse->bhcle', s_intra, v))
    den = w_inter * jnp.einsum('bhcld,bhcd->bhcl', q, n_prev) + jnp.sum(s_intra, axis=-1)
    h = num / jnp.maximum(jnp.abs(den), jnp.exp(-m_t))[..., None]
    return h.reshape(bn, nh, s, dh)


def moba_attention(q, k, v, slopes):
    f32 = jnp.float32
    bn, nh, s, dh = q.shape
    bs = MOBA_BLOCK
    nb = -(-s // bs)
    pad = nb * bs - s
    scale = dh ** -0.5
    q = q.astype(f32)
    k_blk = jnp.pad(k.astype(f32), ((0, 0), (0, 0), (0, pad), (0, 0))).reshape(bn, nh, nb, bs, dh)
    v_blk = jnp.pad(v.astype(f32), ((0, 0), (0, 0), (0, pad), (0, 0))).reshape(bn, nh, nb, bs, dh)
    k_sel_n = min(MOBA_TOPK, nb - 1)
    if k_sel_n > 0:
        gate = jnp.einsum('bhsd,bhnd->bhsn', q, jnp.mean(k_blk, axis=3))
        fully_past = jnp.arange(nb)[None, :] < (jnp.arange(s) // bs)[:, None]
        gate = jnp.where(fully_past, gate, -jnp.inf)
        gate_val, sel = lax.top_k(gate, k_sel_n)
        sel_ok = jnp.isfinite(gate_val)
    b_idx = jnp.arange(bn)[:, None, None, None]
    h_idx = jnp.arange(nh)[None, :, None, None]
    qc_n = MOBA_QCHUNK

    def one_chunk(ci):
        t0 = ci * qc_n
        qc = lax.dynamic_slice_in_dim(q, t0, qc_n, axis=2)
        tq = t0 + jnp.arange(qc_n)
        j = t0 // bs
        k_own = lax.dynamic_index_in_dim(k_blk, j, axis=2, keepdims=False)
        v_own = lax.dynamic_index_in_dim(v_blk, j, axis=2, keepdims=False)
        dist_own = (tq[:, None] - (j * bs + jnp.arange(bs))[None, :]).astype(f32)
        logit_own = jnp.einsum('bhqd,bhkd->bhqk', qc, k_own) * scale - slopes[:, None, None] * dist_own
        logit_own = jnp.where(dist_own >= 0, logit_own, -jnp.inf)
        if k_sel_n == 0:
            p = jax.nn.softmax(logit_own, axis=-1)
            return jnp.einsum('bhqk,bhkd->bhqd', p, v_own)
        sc = lax.dynamic_slice_in_dim(sel, t0, qc_n, axis=2)
        ok = lax.dynamic_slice_in_dim(sel_ok, t0, qc_n, axis=2)
        k_g = k_blk[b_idx, h_idx, sc]
        v_g = v_blk[b_idx, h_idx, sc]
        dist_g = (tq[:, None, None] - (sc[..., None] * bs + jnp.arange(bs))).astype(f32)
        logit_g = jnp.einsum('bhqd,bhqnkd->bhqnk', qc, k_g) * scale - slopes[:, None, None, None] * dist_g
        logit_g = jnp.where(ok[..., None], logit_g, -jnp.inf)
        logits = jnp.concatenate([logit_g.reshape(bn, nh, qc_n, k_sel_n * bs), logit_own], axis=-1)
        p = jax.nn.softmax(logits, axis=-1)
        p_g = p[..., :k_sel_n * bs].reshape(bn, nh, qc_n, k_sel_n, bs)
        p_own = p[..., k_sel_n * bs:]
        return jnp.einsum('bhqnk,bhqnkd->bhqd', p_g, v_g) + jnp.einsum('bhqk,bhkd->bhqd', p_own, v_own)

    out = lax.map(one_chunk, jnp.arange(s // qc_n))
    return out.transpose(1, 2, 0, 3, 4).reshape(bn, nh, s, dh)


def diff_attention(q, k, v, lam, slopes):
    f32 = jnp.float32
    bn, nh, _, s, dh = q.shape
    scale = dh ** -0.5
    qf = q.astype(f32)
    kf = k.astype(f32)
    vf = v.astype(f32)
    kpos = jnp.arange(s)
    qb_n = C_QBLOCK

    def one_block(ci):
        t0 = ci * qb_n
        qb = lax.dynamic_slice_in_dim(qf, t0, qb_n, axis=3)
        dist = ((t0 + jnp.arange(qb_n))[:, None] - kpos[None, :]).astype(f32)
        logits = jnp.einsum('bhcqd,bhckd->bhcqk', qb, kf) * scale - slopes[:, None, None, None] * dist
        logits = jnp.where(dist >= 0, logits, -jnp.inf)
        p = jax.nn.softmax(logits, axis=-1)
        return jnp.einsum('bhqk,bhkd->bhqd', p[:, :, 0] - lam * p[:, :, 1], vf)

    out = lax.map(one_block, jnp.arange(s // qb_n))
    return out.transpose(1, 2, 0, 3, 4).reshape(bn, nh, s, v.shape[-1])


def mlstm_moba_mixer(h, w_in, conv_w, igate_b, fgate_b, mnorm_g, qn_g, kn_g, w_out):
    f32 = jnp.float32
    z = h @ w_in
    offs = np.cumsum([M_W, M_W, M_W, M_W, M_HEADS, M_HEADS, B_W, B_W]).tolist()
    mq, mk, mv, mo, mi, mf, bq, bk, bv = jnp.split(z, offs, axis=-1)
    qk = jax.nn.silu(causal_depthwise_conv(jnp.concatenate([mq, mk], axis=-1), conv_w))
    mq, mk = qk[..., :M_W], qk[..., M_W:]
    i_pre = (mi + igate_b).transpose(0, 2, 1)
    f_pre = (mf + fgate_b).transpose(0, 2, 1)
    hm = mlstm_chunkwise(to_heads(mq, M_HEADS), to_heads(mk, M_HEADS), to_heads(mv, M_HEADS), i_pre, f_pre)
    hm = rms_norm(hm, mnorm_g[:, None, :]) * jax.nn.sigmoid(to_heads(mo, M_HEADS).astype(f32))
    qb = rms_norm(to_heads(bq, B_HEADS), qn_g)
    kb = rms_norm(to_heads(bk, B_HEADS), kn_g)
    hb = moba_attention(qb, kb, to_heads(bv, B_HEADS), alibi_slopes(B_HEADS))
    y = jnp.concatenate([from_heads(hm), from_heads(hb)], axis=-1).astype(h.dtype)
    return y @ w_out


def diff_attention_mixer(h, w_in, qn_g, kn_g, lam_p, onorm_g, w_out, lam_init):
    f32 = jnp.float32
    bn, s, _ = h.shape
    z = h @ w_in
    qk_w = 2 * C_HEADS * C_DH
    q = z[..., :qk_w].reshape(bn, s, C_HEADS, 2, C_DH).transpose(0, 2, 3, 1, 4)
    k = z[..., qk_w:2 * qk_w].reshape(bn, s, C_HEADS, 2, C_DH).transpose(0, 2, 3, 1, 4)
    v = to_heads(z[..., 2 * qk_w:], C_HEADS)
    q = rms_norm(q, qn_g)
    k = rms_norm(k, kn_g)
    lp = lam_p.astype(f32)
    lam = jnp.exp(jnp.sum(lp[0] * lp[1])) - jnp.exp(jnp.sum(lp[2] * lp[3])) + lam_init
    o = diff_attention(q, k, v, lam, alibi_slopes(C_HEADS))
    o = rms_norm(o, onorm_g) * (1.0 - lam_init)
    return from_heads(o).astype(h.dtype) @ w_out


def peer_ffn(x, wq, keys, u, v):
    f32 = jnp.float32
    bn, s, d = x.shape
    t = bn * s
    xt = x.reshape(t, d)
    qry = (xt @ wq).astype(f32).reshape(t, PEER_HEADS, 2, PEER_DK // 2)
    sub = jnp.einsum('thpd,pnd->thpn', qry, keys.astype(f32))
    s_top, i_top = lax.top_k(sub, PEER_TOPK)
    cand_s = (s_top[:, :, 0, :, None] + s_top[:, :, 1, None, :]).reshape(t, PEER_HEADS, PEER_TOPK * PEER_TOPK)
    cand_i = (i_top[:, :, 0, :, None] * PEER_NKEYS + i_top[:, :, 1, None, :]).reshape(t, PEER_HEADS, PEER_TOPK * PEER_TOPK)
    score, pos = lax.top_k(cand_s, PEER_TOPK)
    idx = jnp.take_along_axis(cand_i, pos, axis=-1)
    gate = jax.nn.softmax(score, axis=-1)
    tc = PEER_TOK_CHUNK
    nt = t // tc

    def one_chunk(args):
        xb, ib, gb = args
        act = jax.nn.gelu(jnp.einsum('td,thkd->thk', xb, u[ib]).astype(f32), approximate=False) * gb
        return jnp.einsum('thk,thkd->td', act, v[ib].astype(f32))

    out = lax.map(one_chunk, (xt.reshape(nt, tc, d),
                              idx.reshape(nt, tc, PEER_HEADS, PEER_TOPK),
                              gate.reshape(nt, tc, PEER_HEADS, PEER_TOPK)))
    return out.reshape(bn, s, d).astype(x.dtype)


def setup_inputs(seed: int = 0) -> dict:
    key = jax.random.key(seed)
    ks = jax.random.split(key, 24)
    f32 = jnp.float32
    D = D_MODEL

    def nrm(k, shape, sc):
        return jax.random.normal(k, shape, f32) * sc

    return {
        'x': nrm(ks[0], (BATCH, SEQ, D), 1.0),
        'c': nrm(ks[1], (BATCH, D), 1.0),
        'ada_w': nrm(ks[2], (DEPTH, D, 6 * D), 0.5 * D ** -0.5),
        'ada_b': nrm(ks[3], (DEPTH, 6 * D), 0.01),
        'norm_mix_g': 1.0 + nrm(ks[4], (DEPTH, D), 0.02),
        'norm_ffn_g': 1.0 + nrm(ks[5], (DEPTH, D), 0.02),
        'ev_w_in': nrm(ks[6], (N_EVEN, D, IN_EVEN), D ** -0.5),
        'ev_conv_w': nrm(ks[7], (N_EVEN, CONV_K, 2 * M_W), CONV_K ** -0.5),
        'ev_igate_b': -1.0 + nrm(ks[8], (N_EVEN, M_HEADS), 0.1),
        'ev_fgate_b': jnp.linspace(3.0, 6.0, M_HEADS, dtype=f32) + nrm(ks[9], (N_EVEN, M_HEADS), 0.1),
        'ev_mnorm_g': 1.0 + nrm(ks[10], (N_EVEN, M_HEADS, M_DH), 0.02),
        'ev_qn_g': 1.0 + nrm(ks[11], (N_EVEN, B_DH), 0.02),
        'ev_kn_g': 1.0 + nrm(ks[12], (N_EVEN, B_DH), 0.02),
        'ev_w_out': nrm(ks[13], (N_EVEN, MIX_EVEN, D), MIX_EVEN ** -0.5),
        'od_w_in': nrm(ks[14], (N_ODD, D, IN_ODD), D ** -0.5),
        'od_qn_g': 1.0 + nrm(ks[15], (N_ODD, C_DH), 0.02),
        'od_kn_g': 1.0 + nrm(ks[16], (N_ODD, C_DH), 0.02),
        'od_lam': nrm(ks[17], (N_ODD, 4, C_DH), 0.1),
        'od_onorm_g': 1.0 + nrm(ks[18], (N_ODD, C_VDH), 0.02),
        'od_w_out': nrm(ks[19], (N_ODD, C_W, D), C_W ** -0.5),
        'peer_wq': nrm(ks[20], (DEPTH, D, PEER_HEADS * PEER_DK), D ** -0.5),
        'peer_keys': nrm(ks[21], (DEPTH, 2, PEER_NKEYS, PEER_DK // 2), (PEER_DK // 2) ** -0.5),
        'peer_u': nrm(ks[22], (DEPTH, PEER_N, D), D ** -0.5),
        'peer_v': nrm(ks[23], (DEPTH, PEER_N, D), PEER_HEADS ** -0.5),
    }


def reference(x, c, ada_w, ada_b, norm_mix_g, norm_ffn_g, ev_w_in, ev_conv_w, ev_igate_b, ev_fgate_b,
              ev_mnorm_g, ev_qn_g, ev_kn_g, ev_w_out, od_w_in, od_qn_g, od_kn_g, od_lam, od_onorm_g,
              od_w_out, peer_wq, peer_keys, peer_u, peer_v):
    c_act = jax.nn.silu(c.astype(jnp.float32))
    for layer in range(DEPTH):
        mod = (c_act @ ada_w[layer].astype(jnp.float32) + ada_b[layer].astype(jnp.float32)).astype(x.dtype)
        sh1, sc1, g1, sh2, sc2, g2 = [m[:, None, :] for m in jnp.split(mod, 6, axis=-1)]
        h = rms_norm(x, norm_mix_g[layer]) * (1.0 + sc1) + sh1
        if layer % 2 == 0:
            e = layer // 2
            y = mlstm_moba_mixer(h, ev_w_in[e], ev_conv_w[e], ev_igate_b[e], ev_fgate_b[e],
                                 ev_mnorm_g[e], ev_qn_g[e], ev_kn_g[e], ev_w_out[e])
        else:
            o = layer // 2
            lam_init = 0.8 - 0.6 * math.exp(-0.3 * layer)
            y = diff_attention_mixer(h, od_w_in[o], od_qn_g[o], od_kn_g[o], od_lam[o],
                                     od_onorm_g[o], od_w_out[o], lam_init)
        x = x + g1 * y.astype(x.dtype)
        h = rms_norm(x, norm_ffn_g[layer]) * (1.0 + sc2) + sh2
        x = x + g2 * peer_ffn(h, peer_wq[layer], peer_keys[layer], peer_u[layer], peer_v[layer])
    return x
```

```cpp
#include <hip/hip_runtime.h>
#include <cstdio>
#include <cstdint>
namespace pg8 {
#define PG8_LAS __attribute__((address_space(3)))
typedef unsigned short bf16_t;
typedef short bf16x8 __attribute__((ext_vector_type(8)));
typedef float f32x4 __attribute__((ext_vector_type(4)));
typedef unsigned u32x4 __attribute__((ext_vector_type(4)));
constexpr int BM = 256, BK = 64, HALF = 128, HTB = HALF * BK * 2  , STAGE_BYTES = 8 * HTB, NXCD = 8, WGM = 8;

__host__ __device__ __forceinline__ int lds_byte(int r, int c) { const int st = (r >> 4) * 2 + (c >> 5), rr = r & 15, cc = c & 31, ob = rr * 64 + cc * 2; return st * 1024 + (ob ^ (((ob >> 9) & 1) << 5)); }
__host__ __device__ __forceinline__ void stage_rc(int b, int& R, int& C) { const int st = b / 1024, sb = b % 1024, swz = sb ^ (((sb >> 9) & 1) << 5); R = (st >> 1) * 16 + swz / 64; C = (st & 1) * 32 + (swz % 64) / 2; }
__host__ __device__ __forceinline__ int perm32(int rho) { const int n = rho >> 4, i = rho & 15; return 8 * (i >> 2) + 4 * n + (i & 3); }

struct Unit { int pm, pn; };
struct Gemm { const bf16_t* A; const bf16_t* Bt; int M, N, K; };

struct StaticOrder {
    int nM, nN, nwg, G, c;
    __host__ __device__ void init(int M, int N, int G_, int c_) { nM = M / BM; nN = N / BM; nwg = nM * nN; G = G_; c = c_; }
    __host__ __device__ bool next(int i, Unit& u) const {
        const long L = (long)i * G + c; if (L >= nwg) return false;
        int wgid = (int)L; { const int q = nwg / NXCD, r = nwg % NXCD, xcd = wgid % NXCD, off = wgid / NXCD; wgid = (xcd < r ? xcd * (q + 1) : r * (q + 1) + (xcd - r) * q) + off; }
        const int nig = WGM * nN, gid = wgid / nig, fm = gid * WGM, gsz = (nM - fm) < WGM ? (nM - fm) : WGM;
        u.pm = fm + ((wgid % nig) % gsz); u.pn = (wgid % nig) / gsz; return true;
    }
    __device__ __forceinline__ void a_ready(const Unit&) const {}
    __device__ __forceinline__ void done(const Unit&) const {}
};

__device__ __forceinline__ unsigned cvt_pk_bf16(float lo, float hi) { unsigned r; asm volatile("v_cvt_pk_bf16_f32 %0, %1, %2" : "=v"(r) : "v"(lo), "v"(hi)); return r; }
typedef unsigned u32x4 __attribute__((ext_vector_type(4)));
struct EpiBf16 {
    static constexpr bool PERM = true, AFTER_DRAIN = false;
    bf16_t* O; int ldc;
    __device__ __forceinline__ void operator()(const f32x4 (&acc)[2][2][4][2], const Unit& u, int wr, int wc, int fr, int fq) const {
        const int row0 = u.pm * BM + wr * 64 + fr; const int col0 = u.pn * BM + wc * 32 + 8 * fq;
#pragma unroll
        for (int ai = 0; ai < 2; ++ai)
#pragma unroll
            for (int m = 0; m < 4; ++m) { bf16_t* rowp = O + (size_t)(row0 + ai * HALF + m * 16) * ldc + col0;
#pragma unroll
                for (int bj = 0; bj < 2; ++bj) { const f32x4 v0 = acc[ai][bj][m][0], v1 = acc[ai][bj][m][1];
                    u32x4 w; w.x = cvt_pk_bf16(v0[0], v0[1]); w.y = cvt_pk_bf16(v0[2], v0[3]); w.z = cvt_pk_bf16(v1[0], v1[1]); w.w = cvt_pk_bf16(v1[2], v1[3]);
                    *(u32x4*)(rowp + bj * HALF) = w; } }
    }
};
struct EpiResid {
    static constexpr bool PERM = false, AFTER_DRAIN = false;
    const float* base; float* out; const float* gate; float dbg;
    __device__ __forceinline__ void operator()(const f32x4 (&acc)[2][2][4][2], const Unit& u, int wr, int wc, int fr, int fq) const {
        const int col0 = u.pn * BM + wc * 32 + 4 * fq; const int b = (u.pm * BM) >> 13;
#pragma unroll
        for (int bj = 0; bj < 2; ++bj)
#pragma unroll
            for (int n = 0; n < 2; ++n) { const f32x4 gv = *(const f32x4*)(gate + (size_t)b * 6144 + col0 + bj * HALF + n * 16);
#pragma unroll
                for (int ai = 0; ai < 2; ++ai)
#pragma unroll
                    for (int m = 0; m < 4; ++m) { const size_t off = (size_t)(u.pm * BM + ai * HALF + wr * 64 + m * 16 + fr) * 1024 + col0 + bj * HALF + n * 16;
                        const f32x4 bs = *(const f32x4*)(base + off); *(f32x4*)(out + off) = bs + gv * acc[ai][bj][m][n] * dbg; } }
    }
};

template <class Epi, class Sched, bool ALIGN_EPI = false, bool SP2 = false>
__device__ __forceinline__ void gemm_phase(PG8_LAS unsigned char* lds, const Gemm g, const Sched& S, const Epi& E) {
    const int tid = threadIdx.x, wid = __builtin_amdgcn_readfirstlane(tid >> 6), lane = tid & 63, wr = wid >> 2, wc = wid & 3, fr = lane & 15, fq = lane >> 4;
    const int K = g.K, nt = K / BK;
    unsigned voffA[2], voffB[2];
#pragma unroll
    for (int i = 0; i < 2; ++i) { int R, C; stage_rc(tid * 16 + i * 8192, R, C); const int Rb = Epi::PERM ? ((R & ~31) + perm32(R & 31)) : R;
        voffA[i] = (unsigned)(R * K + C) * 2u; voffB[i] = (unsigned)(Rb * K + C) * 2u; }
    const size_t kstep = (size_t)(BK * 2);
    const size_t hstep = (size_t)HALF * K * 2;
    const size_t tstep = 2 * hstep;
    const unsigned ldsw = (unsigned)wid * 1024u;
    const int aoff = lds_byte(wr * 64 + fr, fq * 8), boff = lds_byte(wc * 32 + fr, fq * 8);
#define PG8_SA(b, h) (((b) * 2 + (h)) * HTB)
#define PG8_SB(b, h) ((4 + (b) * 2 + (h)) * HTB)
#define PG8_STAGE(bufoff, gbase, voff) do { _Pragma("unroll") for (int _i = 0; _i < 2; ++_i) \
        __builtin_amdgcn_global_load_lds((const unsigned*)((const char*)(gbase) + (voff)[_i]), (PG8_LAS unsigned*)(lds + (bufoff) + ldsw + _i * 8192), 16, 0, 0); } while (0)
#define PG8_LDA(dst, b, h) do { _Pragma("unroll") for (int m = 0; m < 4; ++m) _Pragma("unroll") for (int k = 0; k < 2; ++k) dst[m][k] = *(const PG8_LAS bf16x8*)(lds + PG8_SA(b, h) + aoff + m * 2048 + k * 1024); } while (0)
#define PG8_LDB(dst, b, h) do { _Pragma("unroll") for (int n = 0; n < 2; ++n) _Pragma("unroll") for (int k = 0; k < 2; ++k) dst[n][k] = *(const PG8_LAS bf16x8*)(lds + PG8_SB(b, h) + boff + n * 2048 + k * 1024); } while (0)
#define PG8_MMA(ai, bj, At, Bt) do { __builtin_amdgcn_s_setprio(1); _Pragma("unroll") for (int m = 0; m < 4; ++m) _Pragma("unroll") for (int n = 0; n < 2; ++n) _Pragma("unroll") for (int k = 0; k < 2; ++k) \
        acc[ai][bj][m][n] = __builtin_amdgcn_mfma_f32_16x16x32_bf16(Bt[n][k], At[m][k], acc[ai][bj][m][n], 0, 0, 0); __builtin_amdgcn_s_setprio(0); } while (0)
#define PG8_WAIT_V(n) asm volatile("s_waitcnt vmcnt(" #n ")" ::: "memory")
#define PG8_WAIT_L(n) asm volatile("s_waitcnt lgkmcnt(" #n ")" ::: "memory")
#define PG8_BAR __builtin_amdgcn_s_barrier()
#define PG8_SCHED __builtin_amdgcn_sched_barrier(0)
    Unit cur, nxt; int ui = 0;
    if (!S.next(0, cur)) return;
    f32x4 acc[2][2][4][2];
#pragma unroll
    for (int a = 0; a < 2; ++a)
#pragma unroll
        for (int b = 0; b < 2; ++b)
#pragma unroll
            for (int m = 0; m < 4; ++m)
#pragma unroll
                for (int n = 0; n < 2; ++n) acc[a][b][m][n] = (f32x4){0.f, 0.f, 0.f, 0.f};
    bf16x8 At[4][2], B0[2][2], B1[2][2];
    const char* cA = (const char*)g.A + (size_t)cur.pm * tstep; const char* cB = (const char*)g.Bt + (size_t)cur.pn * tstep;
    S.a_ready(cur);
    if constexpr (SP2) {
        PG8_STAGE(PG8_SB(0, 0), cB, voffB); PG8_STAGE(PG8_SB(0, 1), cB + hstep, voffB); PG8_STAGE(PG8_SA(0, 0), cA, voffA); PG8_STAGE(PG8_SA(0, 1), cA + hstep, voffA);
        if (wr == 1) PG8_BAR;
        PG8_WAIT_V(2); PG8_BAR;
        PG8_STAGE(PG8_SB(1, 0), cB + kstep, voffB); PG8_STAGE(PG8_SA(1, 0), cA + kstep, voffA); PG8_STAGE(PG8_SB(1, 1), cB + hstep + kstep, voffB);
        PG8_WAIT_V(6); PG8_BAR;
    } else {
        PG8_STAGE(PG8_SB(0, 0), cB, voffB); PG8_STAGE(PG8_SA(0, 0), cA, voffA); PG8_STAGE(PG8_SB(0, 1), cB + hstep, voffB); PG8_STAGE(PG8_SA(0, 1), cA + hstep, voffA);
        if (wr == 1) PG8_BAR;
        PG8_WAIT_V(4); PG8_BAR;
        PG8_STAGE(PG8_SB(1, 0), cB + kstep, voffB); PG8_STAGE(PG8_SA(1, 0), cA + kstep, voffA); PG8_STAGE(PG8_SB(1, 1), cB + hstep + kstep, voffB);
        PG8_WAIT_V(6); PG8_BAR;
    }
    for (;;) {
        const bool has_next = S.next(ui + 1, nxt);
        const char* nA = has_next ? (const char*)g.A + (size_t)nxt.pm * tstep : cA; const char* nB = has_next ? (const char*)g.Bt + (size_t)nxt.pn * tstep : cB;
        for (int t = 0; t < nt; t += 2) {
            const bool last = (t == nt - 2);
            const char* a1 = cA + (size_t)(t + 1) * kstep;
            const char* a2 = last ? nA : cA + (size_t)(t + 2) * kstep; const char* b2 = last ? nB : cB + (size_t)(t + 2) * kstep;
            const char* a3 = a2 + kstep; const char* b3 = b2 + kstep;
            if (last && has_next) S.a_ready(nxt);
            if constexpr (SP2) {
            PG8_LDB(B0, 0, 0); PG8_LDB(B1, 0, 1); PG8_SCHED; PG8_LDA(At, 0, 0); PG8_STAGE(PG8_SA(1, 1), a1 + hstep, voffA);
            PG8_WAIT_V(8); PG8_WAIT_L(0); PG8_BAR; PG8_MMA(0, 0, At, B0); PG8_MMA(0, 1, At, B1); PG8_BAR; PG8_SCHED;
            PG8_LDA(At, 0, 1); PG8_STAGE(PG8_SB(0, 0), b2, voffB); PG8_STAGE(PG8_SB(0, 1), b2 + hstep, voffB); PG8_STAGE(PG8_SA(0, 0), a2, voffA);
            PG8_WAIT_V(8); PG8_WAIT_L(0); PG8_BAR; PG8_MMA(1, 0, At, B0); PG8_MMA(1, 1, At, B1); PG8_BAR; PG8_SCHED;
            PG8_LDB(B0, 1, 0); PG8_LDB(B1, 1, 1); PG8_SCHED; PG8_LDA(At, 1, 0); PG8_STAGE(PG8_SA(0, 1), a2 + hstep, voffA);
            PG8_WAIT_V(8); PG8_WAIT_L(0); PG8_BAR; PG8_MMA(0, 0, At, B0); PG8_MMA(0, 1, At, B1); PG8_BAR; PG8_SCHED;
            PG8_LDA(At, 1, 1); PG8_STAGE(PG8_SB(1, 0), b3, voffB); PG8_STAGE(PG8_SB(1, 1), b3 + hstep, voffB); PG8_STAGE(PG8_SA(1, 0), a3, voffA);
            PG8_WAIT_V(8); PG8_WAIT_L(0); PG8_BAR; PG8_MMA(1, 0, At, B0); PG8_MMA(1, 1, At, B1); PG8_BAR; PG8_SCHED;
            } else {
            PG8_LDB(B0, 0, 0); PG8_SCHED; PG8_LDA(At, 0, 0); PG8_STAGE(PG8_SA(1, 1), a1 + hstep, voffA);
            PG8_WAIT_L(8); PG8_BAR; PG8_WAIT_L(0); PG8_MMA(0, 0, At, B0); PG8_BAR; PG8_SCHED;
            PG8_LDB(B1, 0, 1); PG8_STAGE(PG8_SB(0, 0), b2, voffB);
            PG8_BAR; PG8_WAIT_L(0); PG8_MMA(0, 1, At, B1); PG8_BAR;
            PG8_LDA(At, 0, 1); PG8_STAGE(PG8_SA(0, 0), a2, voffA);
            PG8_BAR; PG8_WAIT_L(0); PG8_MMA(1, 0, At, B0); PG8_BAR; PG8_SCHED;
            PG8_STAGE(PG8_SB(0, 1), b2 + hstep, voffB);
            PG8_WAIT_V(6); PG8_BAR; PG8_MMA(1, 1, At, B1); PG8_BAR;
            PG8_LDB(B0, 1, 0); PG8_SCHED; PG8_LDA(At, 1, 0); PG8_STAGE(PG8_SA(0, 1), a2 + hstep, voffA);
            PG8_WAIT_L(8); PG8_BAR; PG8_WAIT_L(0); PG8_MMA(0, 0, At, B0); PG8_BAR; PG8_SCHED;
            PG8_LDB(B1, 1, 1); PG8_STAGE(PG8_SB(1, 0), b3, voffB);
            PG8_BAR; PG8_WAIT_L(0); PG8_MMA(0, 1, At, B1); PG8_BAR;
            PG8_LDA(At, 1, 1); PG8_STAGE(PG8_SA(1, 0), a3, voffA);
            PG8_BAR; PG8_WAIT_L(0); PG8_MMA(1, 0, At, B0); PG8_BAR; PG8_SCHED;
            PG8_STAGE(PG8_SB(1, 1), b3 + hstep, voffB);
            PG8_WAIT_V(6); PG8_BAR; PG8_MMA(1, 1, At, B1); PG8_BAR;
            }
        }
        if constexpr (ALIGN_EPI) { if (wr == 0) PG8_BAR; }
        if constexpr (!Epi::AFTER_DRAIN) { E(acc, cur, wr, wc, fr, fq); S.done(cur); }
        if (!has_next) break;
#pragma unroll
        for (int a = 0; a < 2; ++a)
#pragma unroll
            for (int b = 0; b < 2; ++b)
#pragma unroll
                for (int m = 0; m < 4; ++m)
#pragma unroll
                    for (int n = 0; n < 2; ++n) acc[a][b][m][n] = (f32x4){0.f, 0.f, 0.f, 0.f};
        cur = nxt; cA = nA; cB = nB; ++ui;
        if constexpr (ALIGN_EPI) { if (wr == 1) PG8_BAR; }
    }
    PG8_WAIT_V(0);
    if constexpr (!ALIGN_EPI) { if (wr == 0) PG8_BAR; }
    PG8_BAR;
    if constexpr (Epi::AFTER_DRAIN) { E.fused(acc, cur, wr, wc, fr, fq, lds, wid, lane); S.done(cur); }
#undef PG8_SA
#undef PG8_SB
#undef PG8_STAGE
#undef PG8_LDA
#undef PG8_LDB
#undef PG8_MMA
#undef PG8_WAIT_V
#undef PG8_WAIT_L
#undef PG8_BAR
#undef PG8_SCHED
}
}
constexpr int NB = 4, SEQ = 8192, D = 1024, M = NB * SEQ;
constexpr int NZ0 = 3584, NZ1 = 3072, NQ = 2048, SRC_IN0 = 3592;
constexpr float EPS = 1e-6f;
constexpr int NWAVES = 8, NTHR = 512;
constexpr float LOG2E = 1.4426950408889634f;
constexpr size_t MiB = 1u << 20;
constexpr size_t WS_CTL = 0, CTL_ZERO_BYTES = 1 * MiB;
constexpr size_t WS_WIN0 = 1 * MiB, WS_WOUT0 = 8 * MiB, WS_WIN1 = 10 * MiB, WS_WOUT1 = 16 * MiB, WS_WQ = 18 * MiB;
constexpr size_t WS_KEYS = 26 * MiB, WS_MOD = WS_KEYS + 128 * 1024, WS_KMEAN = WS_MOD + 192 * 1024, WS_NLOC = WS_KMEAN + 256 * 1024,
                 WS_BEND = WS_NLOC + 512 * 1024, WS_MLOC = WS_BEND + 4096, WS_MPREV = WS_MLOC + 4096;
constexpr size_t WS_GATES = 28 * MiB;
constexpr size_t WS_UB = 32 * MiB, WS_VB = 96 * MiB, WS_XNY = 160 * MiB, WS_Z = 224 * MiB, WS_CLOC = 448 * MiB, WS_END = 512 * MiB;
constexpr size_t WS_QRY = WS_Z, WS_IDX = WS_Z + 128 * MiB, WS_GATE = WS_Z + 144 * MiB;
constexpr int CW_BAR = 4096;
constexpr int RING_BYTES = 139264;
constexpr int LDSCTL_OFF = RING_BYTES, MISC_OFF = LDSCTL_OFF + 320;
constexpr int LDS_BYTES = 147456;
static_assert(MISC_OFF + 128 <= LDS_BYTES, "LDS map");

#define GAS __attribute__((address_space(1)))
#define LAS __attribute__((address_space(3)))
typedef unsigned short bf16;
typedef unsigned v4u __attribute__((ext_vector_type(4)));
typedef unsigned v2u __attribute__((ext_vector_type(2)));
typedef float f32x4 __attribute__((ext_vector_type(4)));
typedef float f32x16 __attribute__((ext_vector_type(16)));
typedef short bf16x8 __attribute__((ext_vector_type(8)));
typedef short s16x4 __attribute__((ext_vector_type(4)));
typedef GAS unsigned gu32;
#define RLX_AGENT __ATOMIC_RELAXED, __HIP_MEMORY_SCOPE_AGENT
#define LDS_WAIT() asm volatile("s_waitcnt lgkmcnt(0)" ::: "memory")
#define VM_WAIT() asm volatile("s_waitcnt vmcnt(0)" ::: "memory")
__device__ __forceinline__ unsigned f2bf(float f) { unsigned u = __builtin_bit_cast(unsigned, f); return (u + 0x7fffu + ((u >> 16) & 1u)) >> 16; }
__device__ __forceinline__ unsigned pk2(float lo, float hi) { return f2bf(lo) | (f2bf(hi) << 16); }
__device__ __forceinline__ float bflo(unsigned w) { return __builtin_bit_cast(float, w << 16); }
__device__ __forceinline__ float bfhi(unsigned w) { return __builtin_bit_cast(float, w & 0xffff0000u); }
__device__ __forceinline__ float bf2f(bf16 h) { return __builtin_bit_cast(float, (unsigned)h << 16); }
__device__ __forceinline__ float wave_sum(float v) {
#pragma unroll
    for (int o = 1; o < 64; o <<= 1) v += __shfl_xor(v, o);
    return v;
}
__device__ __forceinline__ float wave_max(float v) {
#pragma unroll
    for (int o = 1; o < 64; o <<= 1) v = fmaxf(v, __shfl_xor(v, o));
    return v;
}
__device__ __forceinline__ float silu_f(float x) { return x / (1.f + __expf(-x)); }
__device__ __forceinline__ float sigmoid_f(float x) { return 1.f / (1.f + __expf(-x)); }
__device__ __forceinline__ float logsigmoid_f(float x) { return fminf(x, 0.f) - log1pf(__expf(-fabsf(x))); }
struct Args { const float* in[24]; float* out; unsigned char* ws; int ph_lo, ph_hi; };
#define XB_TMO      128
#define XB_XCNT(j)  (256  + 64 * (j))
#define XB_XSUB(j)  (1280 + 64 * (j))
#define XB_XGEN(j)  (2304 + 64 * (j))
#define XB_TOP      3328
#define XB_TOPGEN   3392
#define XCD_BAR_WORDS 3456
#define XB_SPIN_CAP (1u << 18)

__device__ __forceinline__ unsigned xb_ld(unsigned* p)              { return __hip_atomic_load(p, __ATOMIC_RELAXED, __HIP_MEMORY_SCOPE_AGENT); }
__device__ __forceinline__ unsigned xb_add(unsigned* p, unsigned v) { return __hip_atomic_fetch_add(p, v, __ATOMIC_RELAXED, __HIP_MEMORY_SCOPE_AGENT); }
__device__ __forceinline__ unsigned xb_xcc_id() { return (unsigned)__builtin_amdgcn_s_getreg((3 << 11) | 20) & 0xFu; }
#define XB_SPIN(cond, bar) do { unsigned _sp = 0; while (cond) { __builtin_amdgcn_s_sleep(1); \
    if ((++_sp & 255u) == 0u) { if (xb_ld(&(bar)[XB_TMO])) break; if (_sp > XB_SPIN_CAP) { atomicAdd(&(bar)[XB_TMO], 1u); break; } } } } while (0)

struct XcdBarrier {
    unsigned* bar; unsigned x;
    volatile LAS unsigned* st;
};

__device__ __forceinline__ XcdBarrier xcd_barrier_post(unsigned* bar, volatile LAS unsigned* st) {
    XcdBarrier b; b.bar = bar; b.x = xb_xcc_id(); b.st = st;
    if (threadIdx.x == 0) (void)xb_add(&bar[XB_XCNT(b.x)], 1u);
    return b;
}
__device__ __forceinline__ void xcd_barrier_complete(unsigned* bar, unsigned x, unsigned& nloc, unsigned& nx) {
    const unsigned G = gridDim.x * gridDim.y * gridDim.z;
    unsigned sum, cnt, mine, sp = 0u;
    for (;;) {
        sum = 0u; cnt = 0u; mine = 0u;
#pragma unroll
        for (unsigned j = 0; j < 16; ++j) { const unsigned c = xb_ld(&bar[XB_XCNT(j)]); sum += c; cnt += (c > 0u) ? 1u : 0u; mine = (j == x) ? c : mine; }
        if (sum == G) break;
        __builtin_amdgcn_s_sleep(1);
        if ((++sp & 255u) == 0u) { if (xb_ld(&bar[XB_TMO])) break; if (sp > XB_SPIN_CAP) { atomicAdd(&bar[XB_TMO], 1u); break; } }
    }
    nloc = mine > 0u ? mine : 1u; nx = cnt > 0u ? cnt : 1u;
}

__device__ __forceinline__ void xcd_barrier(const XcdBarrier& b) {
    asm volatile("s_waitcnt vmcnt(0)" ::: "memory");
    __syncthreads();
    if (threadIdx.x == 0) {
        unsigned* bar = b.bar;
        __builtin_amdgcn_s_waitcnt(0);
        unsigned nloc = b.st[0], nx = b.st[1];
        if (nloc == 0u) { xcd_barrier_complete(bar, b.x, nloc, nx); b.st[0] = nloc; b.st[1] = nx; }
        const unsigned old = xb_add(&bar[XB_XSUB(b.x)], 1u);
        const unsigned gen = old / nloc;
        if (old + 1u == (gen + 1u) * nloc) {
            __builtin_amdgcn_fence(__ATOMIC_RELEASE, "agent");
            asm volatile("s_waitcnt vmcnt(0)" ::: "memory");
            const unsigned og = xb_add(&bar[XB_TOP], 1u);
            const unsigned tg = og / nx;
            if (og + 1u == (tg + 1u) * nx) xb_add(&bar[XB_TOPGEN], 1u);
            else XB_SPIN(xb_ld(&bar[XB_TOPGEN]) == tg, bar);
            __builtin_amdgcn_fence(__ATOMIC_ACQUIRE, "agent");
            xb_add(&bar[XB_XGEN(b.x)], 1u);
            asm volatile("s_waitcnt vmcnt(0)" ::: "memory");
        } else {
            XB_SPIN(xb_ld(&bar[XB_XGEN(b.x)]) == gen, bar);
            __builtin_amdgcn_fence(__ATOMIC_ACQUIRE, "agent");
            asm volatile("s_waitcnt vmcnt(0)" ::: "memory");
        }
    }
    __syncthreads();
}
struct Frame {
    LAS unsigned char* lds;
    int tid, lane, wave, G, bid;
    float* out; unsigned char* ws;
};
#define WSP(T, off) ((T*)(F.ws + (off)))

__device__ __forceinline__ void p0_transpose_item(const float* W, int K, int ldw, int nblk, int thr, int shift, bf16* WT, LAS float* scr, int item, int lane) {
    const int kb = item / nblk, nb = item % nblk, k0 = 64 * kb, n0 = 32 * nb, ns = n0 + (n0 >= thr ? shift : 0);
#pragma unroll 8
    for (int i = 0; i < 32; ++i) { const int kk = 2 * i + (lane >> 5); scr[kk * 33 + (lane & 31)] = W[(size_t)(k0 + kk) * ldw + ns + (lane & 31)]; }
    LDS_WAIT(); asm volatile("" ::: "memory");
    const int c = lane & 7;
#pragma unroll
    for (int j = 0; j < 4; ++j) { const int n = (lane >> 3) + 8 * j; const LAS float* s = scr + (8 * c) * 33 + n;
        v4u o; o.x = pk2(s[0 * 33], s[1 * 33]); o.y = pk2(s[2 * 33], s[3 * 33]); o.z = pk2(s[4 * 33], s[5 * 33]); o.w = pk2(s[6 * 33], s[7 * 33]);
        *(GAS v4u*)(WT + (size_t)(n0 + n) * K + k0 + 8 * c) = o; }
    LDS_WAIT(); asm volatile("" ::: "memory");
}
__device__ __forceinline__ void cvt_f32_bf16_stream(const float* src, bf16* dst, size_t n8, size_t gtid, size_t gthreads) {
    for (size_t i = gtid; i < n8; i += gthreads) {
        const f32x4 a = *(const GAS f32x4*)(src + i * 8), b = *(const GAS f32x4*)(src + i * 8 + 4);
        v4u o; o.x = pk2(a.x, a.y); o.y = pk2(a.z, a.w); o.z = pk2(b.x, b.y); o.w = pk2(b.z, b.w);
        *(GAS v4u*)(dst + i * 8) = o; }
}
__device__ __forceinline__ void p0_prologue(Frame& F, const Args& A) {
    {
        const float* c = A.in[1]; const float* aw = A.in[2]; const float* ab = A.in[3]; float* MOD = WSP(float, WS_MOD);
        LAS float* red = (LAS float*)F.lds;
        for (int item = F.bid; item < 192; item += F.G) {
            const int l = item / 96, n0 = (item % 96) * 64;
            float acc[4] = {0.f, 0.f, 0.f, 0.f};
            const int kbeg = F.wave * 128;
#pragma unroll 4
            for (int k = kbeg; k < kbeg + 128; ++k) {
                const float wv = aw[((size_t)l * 1024 + k) * 6144 + n0 + F.lane];
#pragma unroll
                for (int b = 0; b < 4; ++b) acc[b] += silu_f(c[b * 1024 + k]) * wv;
            }
#pragma unroll
            for (int b = 0; b < 4; ++b) red[(F.wave * 4 + b) * 64 + F.lane] = acc[b];
            __syncthreads();
            if (F.tid < 256) { const int b = F.tid >> 6, ln = F.tid & 63; float s = ab[l * 6144 + n0 + ln];
#pragma unroll
                for (int w = 0; w < 8; ++w) s += red[(w * 4 + b) * 64 + ln];
                MOD[(size_t)(l * 4 + b) * 6144 + n0 + ln] = s; }
            __syncthreads();
        }
    }
    {
        LAS float* scr = (LAS float*)(F.lds + F.wave * 8704);
        const int gw = F.bid * NWAVES + F.wave, NGW = F.G * NWAVES;
        constexpr int I_IN0 = 16 * (NZ0 / 32), I_OUT = 16 * 32, I_IN1 = 16 * (NZ1 / 32), I_Q = 16 * (NQ / 32);
        constexpr int NITEMS = I_IN0 + 2 * I_OUT + I_IN1 + 2 * I_Q;
        for (int it = gw; it < NITEMS; it += NGW) {
            int r = it;
            if (r < I_IN0) { p0_transpose_item(A.in[6], D, SRC_IN0, NZ0 / 32, 2048, 8, WSP(bf16, WS_WIN0), scr, r, F.lane); continue; } r -= I_IN0;
            if (r < I_OUT) { p0_transpose_item(A.in[13], D, D, 32, 1 << 30, 0, WSP(bf16, WS_WOUT0), scr, r, F.lane); continue; } r -= I_OUT;
            if (r < I_IN1) { p0_transpose_item(A.in[14], D, NZ1, NZ1 / 32, 1 << 30, 0, WSP(bf16, WS_WIN1), scr, r, F.lane); continue; } r -= I_IN1;
            if (r < I_OUT) { p0_transpose_item(A.in[19], D, D, 32, 1 << 30, 0, WSP(bf16, WS_WOUT1), scr, r, F.lane); continue; } r -= I_OUT;
            if (r < I_Q) { p0_transpose_item(A.in[20], D, NQ, NQ / 32, 1 << 30, 0, WSP(bf16, WS_WQ), scr, r, F.lane); continue; } r -= I_Q;
            p0_transpose_item(A.in[20] + (size_t)D * NQ, D, NQ, NQ / 32, 1 << 30, 0, WSP(bf16, WS_WQ) + (size_t)NQ * D, scr, r, F.lane);
        }
    }
    {
        const size_t gtid = (size_t)F.bid * NTHR + F.tid, gth = (size_t)F.G * NTHR;
        cvt_f32_bf16_stream(A.in[21], WSP(bf16, WS_KEYS), (size_t)2 * 2 * 128 * 128 / 8, gtid, gth);
        cvt_f32_bf16_stream(A.in[22], WSP(bf16, WS_UB), (size_t)2 * 16384 * 1024 / 8, gtid, gth);
        cvt_f32_bf16_stream(A.in[23], WSP(bf16, WS_VB), (size_t)2 * 16384 * 1024 / 8, gtid, gth);
    }
}

template <bool GATES>
__device__ __forceinline__ void norm_pass(Frame& F, const Args& A, const float* X, const float* g, const float* mod, int shc, bf16* XN) {
    LAS float* wgT = (LAS float*)F.lds;
    if (GATES) {
        const float* win = A.in[6];
        for (int i = F.tid; i < 8 * 1024; i += NTHR) { const int cg = i >> 10, k = i & 1023; wgT[i] = win[(size_t)k * SRC_IN0 + 2048 + cg]; }
        __syncthreads();
    }
    const int gw = F.bid * NWAVES + F.wave, NGW = F.G * NWAVES;
    for (int row = gw; row < M; row += NGW) {
        const int b = row >> 13;
        const GAS f32x4* xr = (const GAS f32x4*)(X + (size_t)row * D) + F.lane;
        f32x4 v[4]; float ss = 0.f;
#pragma unroll
        for (int j = 0; j < 4; ++j) { v[j] = xr[64 * j]; ss += (v[j].x * v[j].x + v[j].y * v[j].y) + (v[j].z * v[j].z + v[j].w * v[j].w); }
        const float rstd = rsqrtf(wave_sum(ss) * (1.f / D) + EPS);
        const float* shp = mod + (size_t)b * 6144 + shc * 1024; const float* scp = shp + 1024;
#pragma unroll
        for (int j = 0; j < 4; ++j) { const int c = 4 * F.lane + 256 * j;
            const f32x4 gg = *(const f32x4*)(g + c), sc = *(const f32x4*)(scp + c), sh = *(const f32x4*)(shp + c);
            v[j] = v[j] * rstd * gg * (sc + 1.f) + sh;
            v2u o; o.x = pk2(v[j].x, v[j].y); o.y = pk2(v[j].z, v[j].w);
            *(GAS v2u*)(XN + (size_t)row * D + c) = o; }
        if (GATES) {
            float* GT = WSP(float, WS_GATES);
#pragma unroll
            for (int cg = 0; cg < 8; ++cg) { float p = 0.f;
#pragma unroll
                for (int j = 0; j < 4; ++j) { const f32x4 w = *(const LAS f32x4*)(wgT + cg * 1024 + 4 * F.lane + 256 * j); p += (v[j].x * w.x + v[j].y * w.y) + (v[j].z * w.z + v[j].w * w.w); }
                p = wave_sum(p);
                if (F.lane == 0) GT[(size_t)row * 8 + cg] = p + (cg < 4 ? A.in[8][cg] : A.in[9][cg - 4]); }
        }
    }
}

__device__ __forceinline__ void qknorm_unit(Frame& F, bf16* Z, int ldz, int row0, int col0, const float* g, float* kmean  ) {
    const int c = col0 + 8 * F.lane, d0 = (8 * F.lane) & 63;
    float gv[8];
#pragma unroll
    for (int i = 0; i < 8; ++i) gv[i] = g[d0 + i];
    float ks[8] = {0.f, 0.f, 0.f, 0.f, 0.f, 0.f, 0.f, 0.f};
    for (int r = 0; r < 32; ++r) {
        bf16* p = Z + (size_t)(row0 + F.wave * 32 + r) * ldz + c;
        const v4u w = *(const GAS v4u*)p;
        float x[8] = {bflo(w.x), bfhi(w.x), bflo(w.y), bfhi(w.y), bflo(w.z), bfhi(w.z), bflo(w.w), bfhi(w.w)};
        float ss = 0.f;
#pragma unroll
        for (int i = 0; i < 8; ++i) ss += x[i] * x[i];
        ss += __shfl_xor(ss, 1); ss += __shfl_xor(ss, 2); ss += __shfl_xor(ss, 4);
        const float rstd = rsqrtf(ss * (1.f / 64.f) + EPS);
#pragma unroll
        for (int i = 0; i < 8; ++i) { x[i] = x[i] * rstd * gv[i]; ks[i] += x[i]; }
        v4u o; o.x = pk2(x[0], x[1]); o.y = pk2(x[2], x[3]); o.z = pk2(x[4], x[5]); o.w = pk2(x[6], x[7]);
        *(GAS v4u*)p = o;
    }
    if (kmean) {
        LAS float* red = (LAS float*)F.lds;
#pragma unroll
        for (int i = 0; i < 8; ++i) red[F.wave * 512 + 8 * F.lane + i] = ks[i];
        __syncthreads();
        { float s = 0.f;
#pragma unroll
          for (int w = 0; w < 8; ++w) s += red[w * 512 + F.tid];
          kmean[(size_t)(F.tid >> 6) * (32 * 64) + (F.tid & 63)] = s * (1.f / 256.f); }
        __syncthreads();
    }
}
constexpr int KSTRB = 144;
template <int DV> struct VStr { static constexpr int B = (DV == 64) ? 192 : 320; };
typedef short v4i16_t __attribute__((ext_vector_type(4)));
__device__ __forceinline__ s16x4 vtr(const LAS unsigned char* p) { return __builtin_bit_cast(s16x4, __builtin_amdgcn_ds_read_tr16_b64_v4i16((LAS v4i16_t*)p)); }
__device__ __forceinline__ unsigned cvtpk(float lo, float hi) { typedef float f2 __attribute__((ext_vector_type(2))); typedef __bf16 b2 __attribute__((ext_vector_type(2)));
    f2 v = {lo, hi}; b2 b = __builtin_convertvector(v, b2); return __builtin_bit_cast(unsigned, b); }
__device__ __forceinline__ float xhalf(float v) {
    auto rr = __builtin_amdgcn_permlane32_swap(__builtin_bit_cast(unsigned, v), __builtin_bit_cast(unsigned, v), false, false);
    return __builtin_bit_cast(float, (threadIdx.x & 32) ? rr[0] : rr[1]);
}
template <int DV> struct AttnSt { f32x16 o[DV / 32]; float m, l; };
template <int DV> __device__ __forceinline__ void attn_init(AttnSt<DV>& st) {
#pragma unroll
    for (int t = 0; t < DV / 32; ++t)
#pragma unroll
        for (int r = 0; r < 16; ++r) st.o[t][r] = 0.f;
    st.m = -1e30f; st.l = 0.f;
}
template <int DV>
__device__ __forceinline__ void attn_tile(AttnSt<DV>& st, const LAS unsigned char* Kt, const LAS unsigned char* Vt, const bf16x8 (&qf)[4], float sc2, float sl2, int tq, int kt0, bool diag, bool rowok, int lane) {
    const int r32 = lane & 31, hi = lane >> 5;
    f32x16 s0, s1;
#pragma unroll
    for (int r = 0; r < 16; ++r) { s0[r] = 0.f; s1[r] = 0.f; }
    const LAS unsigned char* kp = Kt + r32 * KSTRB + hi * 16;
#pragma unroll
    for (int ks = 0; ks < 4; ++ks) {
        const bf16x8 k0 = *(const LAS bf16x8*)(kp + ks * 32), k1 = *(const LAS bf16x8*)(kp + 32 * KSTRB + ks * 32);
        s0 = __builtin_amdgcn_mfma_f32_32x32x16_bf16(k0, qf[ks], s0, 0, 0, 0);
        s1 = __builtin_amdgcn_mfma_f32_32x32x16_bf16(k1, qf[ks], s1, 0, 0, 0);
    }
    const int kb = kt0 + 4 * hi;
    const float c0 = -sl2 * (float)(tq - kb);
    float mx = -INFINITY;
#pragma unroll
    for (int r = 0; r < 16; ++r) {
        const int ko = (r & 3) + 8 * (r >> 2);
        float a = s0[r] * sc2 + (c0 + sl2 * (float)ko), b = s1[r] * sc2 + (c0 + sl2 * (float)(ko + 32));
        if (diag) { if (kb + ko > tq) a = -INFINITY; if (kb + ko + 32 > tq) b = -INFINITY; }
        if (!rowok) { a = -INFINITY; b = -INFINITY; }
        s0[r] = a; s1[r] = b; mx = fmaxf(mx, fmaxf(a, b));
    }
    mx = fmaxf(mx, xhalf(mx));
    const float mn = fmaxf(st.m, mx);
    const float alpha = __builtin_amdgcn_exp2f(st.m - mn);
    st.m = mn;
    float ps = 0.f;
#pragma unroll
    for (int r = 0; r < 16; ++r) { s0[r] = __builtin_amdgcn_exp2f(s0[r] - mn); s1[r] = __builtin_amdgcn_exp2f(s1[r] - mn); ps += s0[r] + s1[r]; }
    st.l = st.l * alpha + ps;
#pragma unroll
    for (int t = 0; t < DV / 32; ++t)
#pragma unroll
        for (int r = 0; r < 16; ++r) st.o[t][r] *= alpha;
    bf16x8 pf[2][2];
#pragma unroll
    for (int s = 0; s < 2; ++s) {
        v4u a, b;
        a.x = cvtpk(s0[8 * s + 0], s0[8 * s + 1]); a.y = cvtpk(s0[8 * s + 2], s0[8 * s + 3]); a.z = cvtpk(s0[8 * s + 4], s0[8 * s + 5]); a.w = cvtpk(s0[8 * s + 6], s0[8 * s + 7]);
        b.x = cvtpk(s1[8 * s + 0], s1[8 * s + 1]); b.y = cvtpk(s1[8 * s + 2], s1[8 * s + 3]); b.z = cvtpk(s1[8 * s + 4], s1[8 * s + 5]); b.w = cvtpk(s1[8 * s + 6], s1[8 * s + 7]);
        pf[0][s] = __builtin_bit_cast(bf16x8, a); pf[1][s] = __builtin_bit_cast(bf16x8, b);
    }
    constexpr int VS = VStr<DV>::B;
    const int g = lane >> 4, i16 = lane & 15;
    const LAS unsigned char* vp = Vt + (4 * (g >> 1) + (i16 >> 2)) * VS + (16 * (g & 1) + 4 * (i16 & 3)) * 2;
#pragma unroll
    for (int kbk = 0; kbk < 2; ++kbk)
#pragma unroll
        for (int s = 0; s < 2; ++s)
#pragma unroll
            for (int t = 0; t < DV / 32; ++t) {
                const s16x4 lo = vtr(vp + (kbk * 32 + 16 * s) * VS + t * 64), h8 = vtr(vp + (kbk * 32 + 16 * s + 8) * VS + t * 64);
                const bf16x8 va = {lo[0], lo[1], lo[2], lo[3], h8[0], h8[1], h8[2], h8[3]};
                st.o[t] = __builtin_amdgcn_mfma_f32_32x32x16_bf16(va, pf[kbk][s], st.o[t], 0, 0, 0);
            }
}
template <int NK, int DV> struct TileRegs { v4u k[NK]; v4u v[DV / 64]; };
template <int NK, int DV>
__device__ __forceinline__ void tile_load(TileRegs<NK, DV>& R, const bf16* Z, int ldz, size_t zrow0, int kcol, int vcol, int tid) {
#pragma unroll
    for (int i = 0; i < NK; ++i) { const int ch = tid + 512 * i; const int row = ch / (8 * NK), cc = ch % (8 * NK);
        R.k[i] = *(const GAS v4u*)(Z + (zrow0 + row) * ldz + kcol + cc * 8); }
#pragma unroll
    for (int i = 0; i < DV / 64; ++i) { const int ch = tid + 512 * i; const int row = ch / (DV / 8), cc = ch % (DV / 8);
        R.v[i] = *(const GAS v4u*)(Z + (zrow0 + row) * ldz + vcol + cc * 8); }
}
template <int NK, int DV>
__device__ __forceinline__ void tile_store(const TileRegs<NK, DV>& R, LAS unsigned char* Kt  , LAS unsigned char* Vt, int tid) {
#pragma unroll
    for (int i = 0; i < NK; ++i) { const int ch = tid + 512 * i; const int row = ch / (8 * NK), cc = ch % (8 * NK);
        *(LAS v4u*)(Kt + (cc >> 3) * (64 * KSTRB) + row * KSTRB + (cc & 7) * 16) = R.k[i]; }
#pragma unroll
    for (int i = 0; i < DV / 64; ++i) { const int ch = tid + 512 * i; const int row = ch / (DV / 8), cc = ch % (DV / 8);
        *(LAS v4u*)(Vt + row * VStr<DV>::B + cc * 16) = R.v[i]; }
}
__device__ __forceinline__ void moba_unit(Frame& F, int b, int h, int j) {
    const bf16* Z = WSP(bf16, WS_Z); constexpr int ldz = NZ0;
    const int lane = F.lane, w = F.wave, r32 = lane & 31, hi = lane >> 5, tid = F.tid;
    const size_t rowb = (size_t)b * SEQ;
    const int qpos = j * 256 + w * 32 + r32;
    const int qcol = 2048 + h * 64, kcol = 2560 + h * 64, vcol = 3072 + h * 64;
    LAS unsigned char* lds = F.lds;
    constexpr int BUFB = 64 * KSTRB + 64 * VStr<64>::B;
    LAS unsigned char* kmh = lds + 2 * BUFB;
    LAS unsigned char* kml = lds + 2 * BUFB + 32 * KSTRB;
    LAS unsigned* msk = (LAS unsigned*)(lds + 2 * BUFB + 64 * KSTRB);
    { const float* KM = WSP(float, WS_KMEAN) + (size_t)((b * 8 + h) * 32) * 64; const f32x4 x = *(const f32x4*)(KM + 4 * tid);
      const int n = tid >> 4, d0 = (tid & 15) * 4;
      const unsigned h0 = f2bf(x.x), h1 = f2bf(x.y), h2 = f2bf(x.z), h3 = f2bf(x.w);
      v2u hv; hv.x = h0 | (h1 << 16); hv.y = h2 | (h3 << 16);
      v2u lv; lv.x = pk2(x.x - __builtin_bit_cast(float, h0 << 16), x.y - __builtin_bit_cast(float, h1 << 16)); lv.y = pk2(x.z - __builtin_bit_cast(float, h2 << 16), x.w - __builtin_bit_cast(float, h3 << 16));
      *(LAS v2u*)(kmh + n * KSTRB + d0 * 2) = hv; *(LAS v2u*)(kml + n * KSTRB + d0 * 2) = lv; }
    if (tid < 16) msk[tid] = 0u;
    bf16x8 qf[4];
    const bf16* qrow = Z + (rowb + qpos) * ldz + qcol;
#pragma unroll
    for (int ks = 0; ks < 4; ++ks) qf[ks] = *(const GAS bf16x8*)(qrow + 16 * ks + 8 * hi);
    __syncthreads();
    f32x16 gt;
#pragma unroll
    for (int r = 0; r < 16; ++r) gt[r] = 0.f;
#pragma unroll
    for (int ks = 0; ks < 4; ++ks) {
        const bf16x8 a = *(const LAS bf16x8*)(kmh + r32 * KSTRB + hi * 16 + ks * 32), c = *(const LAS bf16x8*)(kml + r32 * KSTRB + hi * 16 + ks * 32);
        gt = __builtin_amdgcn_mfma_f32_32x32x16_bf16(a, qf[ks], gt, 0, 0, 0);
        gt = __builtin_amdgcn_mfma_f32_32x32x16_bf16(c, qf[ks], gt, 0, 0, 0);
    }
    float t0 = -INFINITY, t1 = -INFINITY, t2 = -INFINITY;
#define INS3(key) do { float k_ = (key); float a_ = fmaxf(t0, k_), l_ = fminf(t0, k_); t0 = a_; a_ = fmaxf(t1, l_); l_ = fminf(t1, l_); t1 = a_; t2 = fmaxf(t2, l_); } while (0)
#pragma unroll
    for (int r = 0; r < 16; ++r) { const int n = (r & 3) + 8 * (r >> 2) + 4 * hi;
        const float key = (n < j) ? __builtin_bit_cast(float, (__builtin_bit_cast(unsigned, gt[r]) & ~31u) | (unsigned)n) : -INFINITY; INS3(key); }
    { const float p0 = xhalf(t0), p1 = xhalf(t1), p2 = xhalf(t2); INS3(p0); INS3(p1); INS3(p2); }
#undef INS3
    const int sel0 = (t0 > -INFINITY) ? (int)(__builtin_bit_cast(unsigned, t0) & 31u) : -1;
    const int sel1 = (t1 > -INFINITY) ? (int)(__builtin_bit_cast(unsigned, t1) & 31u) : -1;
    const int sel2 = (t2 > -INFINITY) ? (int)(__builtin_bit_cast(unsigned, t2) & 31u) : -1;
    { const unsigned mm = (sel0 >= 0 ? 1u << sel0 : 0u) | (sel1 >= 0 ? 1u << sel1 : 0u) | (sel2 >= 0 ? 1u << sel2 : 0u);
      if (mm) { __hip_atomic_fetch_or(msk + w, mm, __ATOMIC_RELAXED, __HIP_MEMORY_SCOPE_WORKGROUP); __hip_atomic_fetch_or(msk + 8, mm, __ATOMIC_RELAXED, __HIP_MEMORY_SCOPE_WORKGROUP); } }
    __syncthreads();
    const unsigned bmask = msk[8]; const unsigned wmask = (unsigned)__builtin_amdgcn_readfirstlane((int)msk[w]);
    const float sl2 = ldexpf(1.f, -(h + 1)) * LOG2E, sc2 = 0.125f * LOG2E;
    AttnSt<64> st; attn_init<64>(st);
    unsigned rem = bmask;
    int blk = rem ? __builtin_ctz(rem) : j; if (rem) rem &= rem - 1;
    int kt = 0, buf = 0;
    TileRegs<1, 64> R;
    tile_load<1, 64>(R, Z, ldz, rowb + blk * 256 + kt * 64, kcol, vcol, tid);
    tile_store<1, 64>(R, lds, lds + 64 * KSTRB, tid);
    __syncthreads();
    for (;;) {
        int nblk = blk, nkt = kt + 1; bool has_next = true;
        if (nkt == 4) { nkt = 0; if (blk == j) has_next = false; else if (rem) { nblk = __builtin_ctz(rem); rem &= rem - 1; } else nblk = j; }
        if (has_next) tile_load<1, 64>(R, Z, ldz, rowb + nblk * 256 + nkt * 64, kcol, vcol, tid);
        const bool own = (blk == j);
        const bool active = own ? (kt * 64 <= w * 32 + 31) : (((wmask >> blk) & 1u) != 0u);
        if (active) {
            const bool rowok = own || blk == sel0 || blk == sel1 || blk == sel2;
            const bool diag = own && (kt * 64 + 63 > w * 32);
            attn_tile<64>(st, lds + buf * BUFB, lds + buf * BUFB + 64 * KSTRB, qf, sc2, sl2, qpos, blk * 256 + kt * 64, diag, rowok, lane);
        }
        if (!has_next) break;
        tile_store<1, 64>(R, lds + (buf ^ 1) * BUFB, lds + (buf ^ 1) * BUFB + 64 * KSTRB, tid);
        __syncthreads();
        buf ^= 1; blk = nblk; kt = nkt;
    }
    const float inv = 1.f / (st.l + xhalf(st.l));
    bf16* Y = WSP(bf16, WS_XNY) + (rowb + qpos) * 1024 + 512 + h * 64;
#pragma unroll
    for (int t = 0; t < 2; ++t)
#pragma unroll
        for (int rg = 0; rg < 4; ++rg) { v2u o; o.x = pk2(st.o[t][4 * rg] * inv, st.o[t][4 * rg + 1] * inv); o.y = pk2(st.o[t][4 * rg + 2] * inv, st.o[t][4 * rg + 3] * inv);
            *(GAS v2u*)(Y + t * 32 + 8 * rg + 4 * hi) = o; }
    __syncthreads();
}

__device__ __forceinline__ void diff_unit(Frame& F, const Args& A, int b, int h, int qt, float lam) {
    const bf16* Z = WSP(bf16, WS_Z); constexpr int ldz = NZ1;
    const int lane = F.lane, w = F.wave, r32 = lane & 31, hi = lane >> 5, tid = F.tid;
    const int comp = w >> 2, wq = w & 3;
    const size_t rowb = (size_t)b * SEQ;
    const int q0 = qt * 128, qpos = q0 + wq * 32 + r32;
    const int qcol = h * 128 + comp * 64, kcol = 1024 + h * 128, vcol = 2048 + h * 128;
    LAS unsigned char* lds = F.lds;
    constexpr int BUFB = 2 * 64 * KSTRB + 64 * VStr<128>::B;
    bf16x8 qf[4];
    const bf16* qrow = Z + (rowb + qpos) * ldz + qcol;
#pragma unroll
    for (int ks = 0; ks < 4; ++ks) qf[ks] = *(const GAS bf16x8*)(qrow + 16 * ks + 8 * hi);
    const float sl2 = ldexpf(1.f, -(h + 1)) * LOG2E, sc2 = 0.125f * LOG2E;
    AttnSt<128> st; attn_init<128>(st);
    const int nt = (q0 + 128) / 64;
    TileRegs<2, 128> R;
    tile_load<2, 128>(R, Z, ldz, rowb, kcol, vcol, tid);
    tile_store<2, 128>(R, lds, lds + 2 * 64 * KSTRB, tid);
    __syncthreads();
    int buf = 0;
    for (int kt = 0; kt < nt; ++kt) {
        const bool has_next = kt + 1 < nt;
        if (has_next) tile_load<2, 128>(R, Z, ldz, rowb + (size_t)(kt + 1) * 64, kcol, vcol, tid);
        if (kt * 64 <= q0 + wq * 32 + 31) {
            const bool diag = kt * 64 + 63 > q0 + wq * 32;
            attn_tile<128>(st, lds + buf * BUFB + comp * (64 * KSTRB), lds + buf * BUFB + 2 * 64 * KSTRB, qf, sc2, sl2, qpos, kt * 64, diag, true, lane);
        }
        if (has_next) { tile_store<2, 128>(R, lds + (buf ^ 1) * BUFB, lds + (buf ^ 1) * BUFB + 2 * 64 * KSTRB, tid); }
        __syncthreads();
        buf ^= 1;
    }
    const float inv = 1.f / (st.l + xhalf(st.l));
    LAS float* o2 = (LAS float*)lds;
    if (comp == 1) {
#pragma unroll
        for (int t = 0; t < 4; ++t)
#pragma unroll
            for (int r = 0; r < 16; ++r) o2[((wq * 4 + t) * 16 + r) * 64 + lane] = st.o[t][r] * inv;
    }
    __syncthreads();
    if (comp == 0) {
        float ss = 0.f;
#pragma unroll
        for (int t = 0; t < 4; ++t)
#pragma unroll
            for (int r = 0; r < 16; ++r) { const float v = st.o[t][r] * inv - lam * o2[((wq * 4 + t) * 16 + r) * 64 + lane]; st.o[t][r] = v; ss += v * v; }
        ss += xhalf(ss);
        const float rs = rsqrtf(ss * (1.f / 128.f) + EPS) * 0.6444909324090307f;
        const float* og = A.in[18];
        bf16* Y = WSP(bf16, WS_XNY) + (rowb + qpos) * 1024 + h * 128;
#pragma unroll
        for (int t = 0; t < 4; ++t)
#pragma unroll
            for (int rg = 0; rg < 4; ++rg) { const int dv = t * 32 + 8 * rg + 4 * hi; const f32x4 gg = *(const f32x4*)(og + dv);
                v2u o; o.x = pk2(st.o[t][4 * rg] * rs * gg.x, st.o[t][4 * rg + 1] * rs * gg.y); o.y = pk2(st.o[t][4 * rg + 2] * rs * gg.z, st.o[t][4 * rg + 3] * rs * gg.w);
                *(GAS v2u*)(Y + dv) = o; }
    }
    __syncthreads();
}
template <int MT, int NT>
__device__ __forceinline__ void mma_nt(const LAS unsigned char* A, int lda, const LAS unsigned char* B, int ldb, int K, f32x4 (&acc)[MT][NT], int lane) {
    const int r = lane & 15, kq = (lane >> 4) * 16;
    for (int k0 = 0; k0 < K; k0 += 32) {
        bf16x8 a[MT], bb[NT];
#pragma unroll
        for (int m = 0; m < MT; ++m) a[m] = *(const LAS bf16x8*)(A + (m * 16 + r) * lda + k0 * 2 + kq);
#pragma unroll
        for (int n = 0; n < NT; ++n) bb[n] = *(const LAS bf16x8*)(B + (n * 16 + r) * ldb + k0 * 2 + kq);
#pragma unroll
        for (int m = 0; m < MT; ++m)
#pragma unroll
            for (int n = 0; n < NT; ++n) acc[m][n] = __builtin_amdgcn_mfma_f32_16x16x32_bf16(a[m], bb[n], acc[m][n], 0, 0, 0);
    }
}
constexpr int TS = 272;
constexpr int TILEB = 128 * TS;
constexpr int ML_Q = 0, ML_K = TILEB, ML_V = 2 * TILEB, ML_SM = 3 * TILEB;

__device__ __forceinline__ void ml_gates(const float* GT, size_t row0, int hm, LAS float* sm, int lane) {
    const float i0 = GT[(row0 + 2 * lane) * 8 + hm], i1 = GT[(row0 + 2 * lane + 1) * 8 + hm];
    const float f0 = logsigmoid_f(GT[(row0 + 2 * lane) * 8 + 4 + hm]), f1 = logsigmoid_f(GT[(row0 + 2 * lane + 1) * 8 + 4 + hm]);
    float s = f0 + f1;
#pragma unroll
    for (int o = 1; o < 64; o <<= 1) { const float t = __shfl_up(s, o); if (lane >= o) s += t; }
    const float excl = s - (f0 + f1);
    sm[2 * lane] = excl + f0; sm[2 * lane + 1] = excl + f0 + f1;
    sm[128 + 2 * lane] = i0; sm[128 + 2 * lane + 1] = i1;
}
template <bool TRANSPOSE>
__device__ __forceinline__ void ml_conv_tile(const bf16* Z, size_t rowb, int t0, int zc, const float* cw, int wc, float mul, LAS unsigned char* dst, const LAS float* rs, int tid) {
#pragma unroll
    for (int it = 0; it < 4; ++it) {
        const int item = tid + 512 * it, l = item >> 4, ch = (item & 15) * 8;
        float acc[8];
#pragma unroll
        for (int i = 0; i < 8; ++i) acc[i] = 0.f;
#pragma unroll
        for (int jj = 0; jj < 4; ++jj) {
            const int t = t0 + l - 3 + jj;
            if (t >= 0) {
                const v4u w = *(const GAS v4u*)(Z + (rowb + t) * NZ0 + zc + ch);
                const float x[8] = {bflo(w.x), bfhi(w.x), bflo(w.y), bfhi(w.y), bflo(w.z), bfhi(w.z), bflo(w.w), bfhi(w.w)};
                const f32x4 c0 = *(const f32x4*)(cw + jj * 1024 + wc + ch), c1 = *(const f32x4*)(cw + jj * 1024 + wc + ch + 4);
                acc[0] += x[0] * c0.x; acc[1] += x[1] * c0.y; acc[2] += x[2] * c0.z; acc[3] += x[3] * c0.w;
                acc[4] += x[4] * c1.x; acc[5] += x[5] * c1.y; acc[6] += x[6] * c1.z; acc[7] += x[7] * c1.w;
            }
        }
        const float sc = TRANSPOSE ? mul * rs[l] : mul;
#pragma unroll
        for (int i = 0; i < 8; ++i) acc[i] = silu_f(acc[i]) * sc;
        if (TRANSPOSE) {
#pragma unroll
            for (int i = 0; i < 8; ++i) *(LAS bf16*)(dst + (ch + i) * TS + l * 2) = (bf16)f2bf(acc[i]);
        } else {
            v4u o; o.x = pk2(acc[0], acc[1]); o.y = pk2(acc[2], acc[3]); o.z = pk2(acc[4], acc[5]); o.w = pk2(acc[6], acc[7]);
            *(LAS v4u*)(dst + l * TS + ch * 2) = o;
        }
    }
}
__device__ __forceinline__ void ml_vt_tile(const bf16* Z, size_t row0, int zc, LAS unsigned char* dst, int tid) {
#pragma unroll
    for (int it = 0; it < 4; ++it) {
        const int item = tid + 512 * it, l = item >> 4, ch = (item & 15) * 8;
        const v4u w = *(const GAS v4u*)(Z + (row0 + l) * NZ0 + zc + ch);
        const unsigned ww[4] = {w.x, w.y, w.z, w.w};
#pragma unroll
        for (int i = 0; i < 4; ++i) { *(LAS bf16*)(dst + (ch + 2 * i) * TS + l * 2) = (bf16)(ww[i] & 0xffffu); *(LAS bf16*)(dst + (ch + 2 * i + 1) * TS + l * 2) = (bf16)(ww[i] >> 16); }
    }
}
__device__ __forceinline__ void mlstm_a_unit(Frame& F, const Args& A, int unit) {
    const int c = unit & 63, bh = unit >> 6, hm = bh & 3, b = bh >> 2;
    const bf16* Z = WSP(bf16, WS_Z); const float* GT = WSP(float, WS_GATES);
    const size_t rowb = (size_t)b * SEQ; const int t0 = c * 128;
    LAS unsigned char* lds = F.lds; LAS float* sm = (LAS float*)(lds + ML_SM);
    if (F.wave == 0) {
        ml_gates(GT, rowb + t0, hm, sm, F.lane);
        LDS_WAIT();
        const float bend = sm[127];
        const float w0 = bend - sm[2 * F.lane] + sm[128 + 2 * F.lane], w1 = bend - sm[2 * F.lane + 1] + sm[128 + 2 * F.lane + 1];
        const float ml = wave_max(fmaxf(w0, w1));
        sm[256 + 2 * F.lane] = __expf(w0 - ml); sm[256 + 2 * F.lane + 1] = __expf(w1 - ml);
        if (F.lane == 0) { WSP(float, WS_BEND)[unit] = bend; WSP(float, WS_MLOC)[unit] = ml; }
    }
    __syncthreads();
    ml_conv_tile<true>(Z, rowb, t0, 512 + hm * 128, A.in[7], 512 + hm * 128, 0.08838834764831845f, lds + ML_K, sm + 256, F.tid);
    ml_vt_tile(Z, rowb + t0, 1024 + hm * 128, lds + ML_V, F.tid);
    __syncthreads();
    f32x4 acc[2][4];
#pragma unroll
    for (int m = 0; m < 2; ++m)
#pragma unroll
        for (int n = 0; n < 4; ++n) acc[m][n] = (f32x4){0.f, 0.f, 0.f, 0.f};
    const int dv0 = 32 * (F.wave >> 1), dk0 = 64 * (F.wave & 1);
    mma_nt<2, 4>(lds + ML_V + dv0 * TS, TS, lds + ML_K + dk0 * TS, TS, 128, acc, F.lane);
    float* CL = WSP(float, WS_CLOC) + (size_t)unit * 16384;
#pragma unroll
    for (int m = 0; m < 2; ++m)
#pragma unroll
        for (int n = 0; n < 4; ++n)
#pragma unroll
            for (int i = 0; i < 4; ++i) CL[(size_t)(dv0 + 16 * m + 4 * (F.lane >> 4) + i) * 128 + dk0 + 16 * n + (F.lane & 15)] = acc[m][n][i];
    if (F.tid < 128) { float s = 0.f; const LAS bf16* kr = (const LAS bf16*)(lds + ML_K + F.tid * TS);
        for (int l = 0; l < 128; ++l) s += bf2f(kr[l]);
        WSP(float, WS_NLOC)[(size_t)unit * 128 + F.tid] = s; }
    __syncthreads();
}
__device__ __forceinline__ void mlstm_scan_unit(Frame& F, int unit) {
    const int bh = unit >> 4, sl = unit & 15;
    LAS float* tab = (LAS float*)F.lds;
    if (F.tid == 0) {
        const float* BE = WSP(float, WS_BEND) + bh * 64; const float* ML = WSP(float, WS_MLOC) + bh * 64; float* MP = WSP(float, WS_MPREV) + bh * 64;
        float m = 0.f;
        for (int c = 0; c < 64; ++c) { const float be = BE[c], ml = ML[c]; const float mn = fmaxf(be + m, ml);
            tab[c] = __expf(be + m - mn); tab[64 + c] = __expf(ml - mn); if (sl == 0) MP[c] = m; m = mn; }
    }
    __syncthreads();
    float* CL = WSP(float, WS_CLOC) + (size_t)bh * 64 * 16384 + sl * 1024 + 2 * F.tid;
    float s0 = 0.f, s1 = 0.f;
#pragma unroll 8
    for (int c = 0; c < 64; ++c) { float2* p = (float2*)(CL + (size_t)c * 16384); const float2 v = *p; *p = make_float2(s0, s1);
        const float a = tab[c], sc = tab[64 + c]; s0 = a * s0 + sc * v.x; s1 = a * s1 + sc * v.y; }
    if (sl == 0 && F.tid < 128) { float* NL = WSP(float, WS_NLOC) + (size_t)bh * 64 * 128 + F.tid; float s = 0.f;
        for (int c = 0; c < 64; ++c) { const float v = NL[c * 128]; NL[c * 128] = s; s = tab[c] * s + tab[64 + c] * v; } }
    __syncthreads();
}
__device__ __forceinline__ void mlstm_c_unit(Frame& F, const Args& A, int unit) {
    const int c = unit & 63, bh = unit >> 6, hm = bh & 3, b = bh >> 2;
    const bf16* Z = WSP(bf16, WS_Z); const float* GT = WSP(float, WS_GATES);
    const size_t rowb = (size_t)b * SEQ; const int t0 = c * 128;
    LAS unsigned char* lds = F.lds; LAS float* sm = (LAS float*)(lds + ML_SM);
    const int lane = F.lane, w = F.wave, tid = F.tid;
    const float mprev = WSP(float, WS_MPREV)[unit];
    if (w == 0) {
        ml_gates(GT, rowb + t0, hm, sm, lane);
        LDS_WAIT();
        const float b0 = sm[2 * lane], b1 = sm[2 * lane + 1];
        const float g0 = sm[128 + 2 * lane] - b0, g1 = sm[128 + 2 * lane + 1] - b1;
        float pm = fmaxf(g0, g1);
#pragma unroll
        for (int o = 1; o < 64; o <<= 1) { const float t = __shfl_up(pm, o); if (lane >= o) pm = fmaxf(pm, t); }
        float pe = __shfl_up(pm, 1); if (lane == 0) pe = -INFINITY;
        const float M0 = fmaxf(mprev, fmaxf(pe, g0)), M1 = fmaxf(mprev, pm);
        sm[256 + 2 * lane] = g0; sm[256 + 2 * lane + 1] = g1;
        sm[384 + 2 * lane] = M0; sm[384 + 2 * lane + 1] = M1;
        sm[512 + 2 * lane] = __expf(mprev - M0); sm[512 + 2 * lane + 1] = __expf(mprev - M1);
        sm[640 + 2 * lane] = __expf(-b0 - M0); sm[640 + 2 * lane + 1] = __expf(-b1 - M1);
        sm[768 + 2 * lane] = 0.f; sm[768 + 2 * lane + 1] = 0.f; sm[896 + 2 * lane] = 0.f; sm[896 + 2 * lane + 1] = 0.f;
    }
    if (w == 1) { sm[1152 + lane] = WSP(float, WS_NLOC)[(size_t)unit * 128 + lane]; sm[1152 + 64 + lane] = WSP(float, WS_NLOC)[(size_t)unit * 128 + 64 + lane]; }
    ml_conv_tile<false>(Z, rowb, t0, hm * 128, A.in[7], hm * 128, 1.f, lds + ML_Q, nullptr, tid);
    ml_conv_tile<false>(Z, rowb, t0, 512 + hm * 128, A.in[7], 512 + hm * 128, 0.08838834764831845f, lds + ML_K, nullptr, tid);
    ml_vt_tile(Z, rowb + t0, 1024 + hm * 128, lds + ML_V, tid);
    __syncthreads();
    const int l0 = 32 * (w >> 1), c0 = 64 * (w & 1);
    const int lr = 4 * (lane >> 4), lc = lane & 15;
    if (tid < 128) { const LAS bf16* qr = (const LAS bf16*)(lds + ML_Q + tid * TS); float s = 0.f;
        for (int d = 0; d < 128; ++d) s += bf2f(qr[d]) * sm[1152 + d];
        sm[1024 + tid] = s; }
    f32x4 acc[2][4];
#pragma unroll
    for (int m = 0; m < 2; ++m)
#pragma unroll
        for (int n = 0; n < 4; ++n) acc[m][n] = (f32x4){0.f, 0.f, 0.f, 0.f};
    mma_nt<2, 4>(lds + ML_Q + l0 * TS, TS, lds + ML_K + c0 * TS, TS, 128, acc, lane);
#pragma unroll
    for (int m = 0; m < 2; ++m)
#pragma unroll
        for (int i = 0; i < 4; ++i) { const int l = l0 + 16 * m + lr + i; const float Ml = sm[384 + l]; float rsum = 0.f;
#pragma unroll
            for (int n = 0; n < 4; ++n) { const int s = c0 + 16 * n + lc; const float v = (s <= l) ? acc[m][n][i] * __expf(sm[256 + s] - Ml) : 0.f; acc[m][n][i] = v; rsum += v; }
            rsum += __shfl_xor(rsum, 1); rsum += __shfl_xor(rsum, 2); rsum += __shfl_xor(rsum, 4); rsum += __shfl_xor(rsum, 8);
            if (lc == 0) __hip_atomic_fetch_add(sm + 768 + l, rsum, __ATOMIC_RELAXED, __HIP_MEMORY_SCOPE_WORKGROUP); }
    __syncthreads();
#pragma unroll
    for (int m = 0; m < 2; ++m)
#pragma unroll
        for (int n = 0; n < 4; ++n)
#pragma unroll
            for (int i = 0; i < 4; ++i) *(LAS bf16*)(lds + ML_K + (l0 + 16 * m + lr + i) * TS + (c0 + 16 * n + lc) * 2) = (bf16)f2bf(acc[m][n][i]);
    __syncthreads();
    f32x4 ai[2][4], ae[2][4];
#pragma unroll
    for (int m = 0; m < 2; ++m)
#pragma unroll
        for (int n = 0; n < 4; ++n) { ai[m][n] = (f32x4){0.f, 0.f, 0.f, 0.f}; ae[m][n] = (f32x4){0.f, 0.f, 0.f, 0.f}; }
    mma_nt<2, 4>(lds + ML_K + l0 * TS, TS, lds + ML_V + c0 * TS, TS, 128, ai, lane);
    {
        const float* CP = WSP(float, WS_CLOC) + (size_t)unit * 16384;
        const int r = lane & 15, kq = (lane >> 4) * 8;
        for (int k0 = 0; k0 < 128; k0 += 32) {
            bf16x8 a[2], bb[4];
#pragma unroll
            for (int m = 0; m < 2; ++m) a[m] = *(const LAS bf16x8*)(lds + ML_Q + (l0 + m * 16 + r) * TS + (k0 + kq) * 2);
#pragma unroll
            for (int n = 0; n < 4; ++n) { const float* p = CP + (size_t)(c0 + n * 16 + r) * 128 + k0 + kq; const f32x4 x = *(const f32x4*)p, y = *(const f32x4*)(p + 4);
                v4u pk; pk.x = pk2(x.x, x.y); pk.y = pk2(x.z, x.w); pk.z = pk2(y.x, y.y); pk.w = pk2(y.z, y.w); bb[n] = __builtin_bit_cast(bf16x8, pk); }
#pragma unroll
            for (int m = 0; m < 2; ++m)
#pragma unroll
                for (int n = 0; n < 4; ++n) ae[m][n] = __builtin_amdgcn_mfma_f32_16x16x32_bf16(a[m], bb[n], ae[m][n], 0, 0, 0);
        }
    }
#pragma unroll
    for (int m = 0; m < 2; ++m)
#pragma unroll
        for (int i = 0; i < 4; ++i) { const int l = l0 + 16 * m + lr + i; const float wi = sm[512 + l];
            const float den = wi * sm[1024 + l] + sm[768 + l]; const float dinv = 1.f / fmaxf(fabsf(den), sm[640 + l]); float ssq = 0.f;
#pragma unroll
            for (int n = 0; n < 4; ++n) { const float hv = (wi * ae[m][n][i] + ai[m][n][i]) * dinv; ai[m][n][i] = hv; ssq += hv * hv; }
            ssq += __shfl_xor(ssq, 1); ssq += __shfl_xor(ssq, 2); ssq += __shfl_xor(ssq, 4); ssq += __shfl_xor(ssq, 8);
            if (lc == 0) __hip_atomic_fetch_add(sm + 896 + l, ssq, __ATOMIC_RELAXED, __HIP_MEMORY_SCOPE_WORKGROUP); }
    __syncthreads();
    const float* mg = A.in[10] + hm * 128;
    bf16* Y = WSP(bf16, WS_XNY);
#pragma unroll
    for (int m = 0; m < 2; ++m)
#pragma unroll
        for (int i = 0; i < 4; ++i) { const int l = l0 + 16 * m + lr + i; const float rstd = rsqrtf(sm[896 + l] * (1.f / 128.f) + EPS); const size_t row = rowb + t0 + l;
#pragma unroll
            for (int n = 0; n < 4; ++n) { const int dv = c0 + 16 * n + lc; const float og = sigmoid_f(bf2f(Z[row * NZ0 + 1536 + hm * 128 + dv]));
                Y[row * 1024 + hm * 128 + dv] = (bf16)f2bf(ai[m][n][i] * rstd * mg[dv] * og); } }
    __syncthreads();
}
template <int N> __device__ __forceinline__ void bitonic_sort_desc(float (&v)[N]) {
#pragma unroll
    for (int k = 2; k <= N; k <<= 1)
#pragma unroll
        for (int j = k >> 1; j > 0; j >>= 1)
#pragma unroll
            for (int i = 0; i < N; ++i) { const int l = i ^ j; if (l > i) { const bool desc = ((i & k) == 0); const float a = v[i], b = v[l]; const float mx = fmaxf(a, b), mn = fminf(a, b); v[i] = desc ? mx : mn; v[l] = desc ? mn : mx; } }
}
__device__ __forceinline__ void merge_top16(float (&run)[16], const float (&nw)[16]) {
#pragma unroll
    for (int i = 0; i < 16; ++i) run[i] = fmaxf(run[i], nw[15 - i]);
#pragma unroll
    for (int j = 8; j > 0; j >>= 1)
#pragma unroll
        for (int i = 0; i < 16; ++i) { const int l = i ^ j; if (l > i) { const float a = run[i], b = run[l]; run[i] = fmaxf(a, b); run[l] = fminf(a, b); } }
}
#ifndef EXPERT_SLOW
#define EXPERT_SLOW 1
#endif
#ifndef ROUTE_SLOW
#define ROUTE_SLOW 1
#endif
constexpr int SCS = 132;
__device__ __forceinline__ void peer_route_unit(Frame& F, int tok0, int hd, const bf16* KEYS) {
    const bf16* QRY = WSP(bf16, WS_QRY); int* IDX = WSP(int, WS_IDX); float* GATE = WSP(float, WS_GATE);
    LAS float* SC = (LAS float*)F.lds;
    const int lane = F.lane, w = F.wave, tid = F.tid;
    {
        const int p = w & 1, tg = w >> 1, r = lane & 15, kq = (lane >> 4) * 8;
        f32x4 acc[2][8];
#pragma unroll
        for (int m = 0; m < 2; ++m)
#pragma unroll
            for (int n = 0; n < 8; ++n) acc[m][n] = (f32x4){0.f, 0.f, 0.f, 0.f};
#pragma unroll
        for (int k0 = 0; k0 < 128; k0 += 32) {
            bf16x8 a[2], bb[8];
#pragma unroll
            for (int m = 0; m < 2; ++m) a[m] = *(const GAS bf16x8*)(QRY + (size_t)(tok0 + 32 * tg + 16 * m + r) * NQ + hd * 256 + p * 128 + k0 + kq);
#pragma unroll
            for (int n = 0; n < 8; ++n) bb[n] = *(const GAS bf16x8*)(KEYS + (size_t)(p * 128 + 16 * n + r) * 128 + k0 + kq);
#pragma unroll
            for (int m = 0; m < 2; ++m)
#pragma unroll
                for (int n = 0; n < 8; ++n) acc[m][n] = __builtin_amdgcn_mfma_f32_16x16x32_bf16(a[m], bb[n], acc[m][n], 0, 0, 0);
        }
#pragma unroll
        for (int m = 0; m < 2; ++m)
#pragma unroll
            for (int n = 0; n < 8; ++n)
#pragma unroll
                for (int i = 0; i < 4; ++i) SC[(p * 128 + 32 * tg + 16 * m + 4 * (lane >> 4) + i) * SCS + 16 * n + r] = acc[m][n][i];
    }
    __syncthreads();
#if defined(CHECK) && CHECK
    if (tok0 == 0 && hd == 0) { float* DB = WSP(float, WS_CLOC) + 8 * 1024 * 1024; for (int i = tid; i < 2 * 128 * 128; i += NTHR) DB[i] = SC[(i >> 7) * SCS + (i & 127)]; }
    __syncthreads();
#endif
#if ROUTE_SLOW
    if (tid < 128) {
        const int t = tid;
        float s0[16], s1[16]; unsigned i0[16], i1[16];
        { const LAS float* row = SC + (0 * 128 + t) * SCS; float prev = INFINITY;
#pragma unroll
          for (int k = 0; k < 16; ++k) { float best = -INFINITY; unsigned bi = 0; for (int n = 0; n < 128; ++n) { const float v = row[n]; if (v < prev && v > best) { best = v; bi = n; } } s0[k] = best; i0[k] = bi; prev = best; } }
        { const LAS float* row = SC + (1 * 128 + t) * SCS; float prev = INFINITY;
#pragma unroll
          for (int k = 0; k < 16; ++k) { float best = -INFINITY; unsigned bi = 0; for (int n = 0; n < 128; ++n) { const float v = row[n]; if (v < prev && v > best) { best = v; bi = n; } } s1[k] = best; i1[k] = bi; prev = best; } }
        float top[16]; unsigned tid16[16];
        { float prev = INFINITY;
#pragma unroll
          for (int k = 0; k < 16; ++k) { float best = -INFINITY; unsigned be = 0;
#pragma unroll
              for (int i = 0; i < 16; ++i)
#pragma unroll
                  for (int j = 0; j < 16; ++j) if ((i + 1) * (j + 1) <= 16) { const float v = s0[i] + s1[j]; if (v < prev && v > best) { best = v; be = i0[i] * 128u + i1[j]; } }
              top[k] = best; tid16[k] = be; prev = best; } }
        float sc[16], den = 0.f;
#pragma unroll
        for (int k = 0; k < 16; ++k) { sc[k] = __expf(top[k] - top[0]); den += sc[k]; }
        const float inv = 1.f / den;
        const size_t ob = (size_t)(tok0 + t) * 128 + hd * 16;
#pragma unroll
        for (int k = 0; k < 16; ++k) { IDX[ob + k] = (int)tid16[k]; GATE[ob + k] = sc[k] * inv; }
    }
    __syncthreads();
#else
    {
        const int t = tid & 127, p = (tid >> 7) & 1, half = tid >> 8;
        LAS float* seg = SC + (p * 128 + t) * SCS + 64 * half;
        float run[16], nw[16];
#pragma unroll
        for (int ch = 0; ch < 4; ++ch) {
#pragma unroll
            for (int q = 0; q < 4; ++q) { const f32x4 v = *(const LAS f32x4*)(seg + 16 * ch + 4 * q);
#pragma unroll
                for (int e = 0; e < 4; ++e) { const unsigned n = (unsigned)(64 * half + 16 * ch + 4 * q + e); const float key = __builtin_bit_cast(float, (__builtin_bit_cast(unsigned, v[e]) & ~127u) | n);
                    if (ch == 0) run[4 * q + e] = key; else nw[4 * q + e] = key; } }
            if (ch == 0) bitonic_sort_desc<16>(run); else { bitonic_sort_desc<16>(nw); merge_top16(run, nw); }
        }
#pragma unroll
        for (int q = 0; q < 4; ++q) *(LAS f32x4*)(seg + 4 * q) = (f32x4){run[4 * q], run[4 * q + 1], run[4 * q + 2], run[4 * q + 3]};
    }
    __syncthreads();
    if (tid < 128) {
        const int t = tid;
        float s0[16], s1[16];
        {
            LAS float* a = SC + (0 * 128 + t) * SCS; float nw[16];
#pragma unroll
            for (int q = 0; q < 4; ++q) { const f32x4 v = *(const LAS f32x4*)(a + 4 * q), u = *(const LAS f32x4*)(a + 64 + 4 * q);
#pragma unroll
                for (int e = 0; e < 4; ++e) { s0[4 * q + e] = v[e]; nw[4 * q + e] = u[e]; } }
            merge_top16(s0, nw);
#pragma unroll
            for (int q = 0; q < 4; ++q) *(LAS f32x4*)(a + 16 + 4 * q) = (f32x4){s0[4 * q], s0[4 * q + 1], s0[4 * q + 2], s0[4 * q + 3]};
        }
        {
            LAS float* a = SC + (1 * 128 + t) * SCS; float nw[16];
#pragma unroll
            for (int q = 0; q < 4; ++q) { const f32x4 v = *(const LAS f32x4*)(a + 4 * q), u = *(const LAS f32x4*)(a + 64 + 4 * q);
#pragma unroll
                for (int e = 0; e < 4; ++e) { s1[4 * q + e] = v[e]; nw[4 * q + e] = u[e]; } }
            merge_top16(s1, nw);
#pragma unroll
            for (int q = 0; q < 4; ++q) *(LAS f32x4*)(a + 16 + 4 * q) = (f32x4){s1[4 * q], s1[4 * q + 1], s1[4 * q + 2], s1[4 * q + 3]};
        }
#pragma unroll
        for (int i = 0; i < 16; ++i) { s0[i] = __builtin_bit_cast(float, __builtin_bit_cast(unsigned, s0[i]) & ~127u); s1[i] = __builtin_bit_cast(float, __builtin_bit_cast(unsigned, s1[i]) & ~127u); }
        constexpr int CNT[16] = {16, 8, 5, 4, 3, 2, 2, 2, 1, 1, 1, 1, 1, 1, 1, 1};
        constexpr int OFF[16] = {0, 16, 24, 29, 33, 36, 38, 40, 42, 43, 44, 45, 46, 47, 48, 49};
        float top[16], nw[16];
#pragma unroll
        for (int grp = 0; grp < 4; ++grp) {
#pragma unroll
            for (int e = 0; e < 16; ++e) nw[e] = -INFINITY;
#pragma unroll
            for (int i = 0; i < 16; ++i)
#pragma unroll
                for (int j = 0; j < 16; ++j) if (j < CNT[i] && (OFF[i] + j) / 16 == grp) {
                    const float sum = s0[i] + s1[j];
                    nw[(OFF[i] + j) % 16] = __builtin_bit_cast(float, (__builtin_bit_cast(unsigned, sum) & ~255u) | (unsigned)(i * 16 + j)); }
            bitonic_sort_desc<16>(nw);
            if (grp == 0) {
#pragma unroll
                for (int e = 0; e < 16; ++e) top[e] = nw[e];
            } else merge_top16(top, nw);
        }
#if defined(CHECK) && CHECK
        if (tok0 == 0 && hd == 0) { float* DB = WSP(float, WS_CLOC) + 8 * 1024 * 1024 + 32768;
#pragma unroll
            for (int i = 0; i < 16; ++i) { DB[t * 48 + i] = s0[i]; DB[t * 48 + 16 + i] = s1[i]; DB[t * 48 + 32 + i] = top[i]; } }
#endif
        float sc[16], den = 0.f;
        const float mx = __builtin_bit_cast(float, __builtin_bit_cast(unsigned, top[0]) & ~255u);
#pragma unroll
        for (int k = 0; k < 16; ++k) { sc[k] = __expf(__builtin_bit_cast(float, __builtin_bit_cast(unsigned, top[k]) & ~255u) - mx); den += sc[k]; }
        const float inv = 1.f / den;
        LDS_WAIT();
        const LAS unsigned* l0 = (const LAS unsigned*)(SC + (0 * 128 + t) * SCS + 16); const LAS unsigned* l1 = (const LAS unsigned*)(SC + (1 * 128 + t) * SCS + 16);
        const size_t ob = (size_t)(tok0 + t) * 128 + hd * 16;
#pragma unroll
        for (int k = 0; k < 16; ++k) { const unsigned id = __builtin_bit_cast(unsigned, top[k]) & 255u;
            const unsigned e0 = l0[id >> 4] & 127u, e1 = l1[id & 15u] & 127u;
            IDX[ob + k] = (int)(e0 * 128u + e1); GATE[ob + k] = sc[k] * inv; }
    }
    __syncthreads();
#endif
}
__device__ __forceinline__ void peer_expert_phase(Frame& F, const bf16* U, const bf16* V, const float* g2  , float dbg, float* dbgout) {
    const bf16* XN = WSP(bf16, WS_XNY); const int* IDX = WSP(int, WS_IDX); const float* GATE = WSP(float, WS_GATE);
    const int lane = F.lane, q = lane >> 4, l16 = lane & 15;
    LAS unsigned* wi = (LAS unsigned*)(F.lds + F.wave * 2048);
    LAS float* wg = (LAS float*)(F.lds + F.wave * 2048 + 512);
    LAS float* wa = (LAS float*)(F.lds + F.wave * 2048 + 1024);
    typedef __bf16 bf2 __attribute__((ext_vector_type(2)));
    const int gw = F.bid * NWAVES + F.wave, NGW = F.G * NWAVES;
    for (int tok = gw; tok < M; tok += NGW) {
#if EXPERT_SLOW
        float hv[16];
        { const v4u x = *(const GAS v4u*)(XN + (size_t)tok * D + 8 * lane), y = *(const GAS v4u*)(XN + (size_t)tok * D + 512 + 8 * lane);
          hv[0] = bflo(x.x); hv[1] = bfhi(x.x); hv[2] = bflo(x.y); hv[3] = bfhi(x.y); hv[4] = bflo(x.z); hv[5] = bfhi(x.z); hv[6] = bflo(x.w); hv[7] = bfhi(x.w);
          hv[8] = bflo(y.x); hv[9] = bfhi(y.x); hv[10] = bflo(y.y); hv[11] = bfhi(y.y); hv[12] = bflo(y.z); hv[13] = bfhi(y.z); hv[14] = bflo(y.w); hv[15] = bfhi(y.w); }
        float o[16];
#pragma unroll
        for (int i = 0; i < 16; ++i) o[i] = 0.f;
        for (int e = 0; e < 128; ++e) {
            const int id = IDX[(size_t)tok * 128 + e]; const float gt = GATE[(size_t)tok * 128 + e];
            const bf16* ur = U + (size_t)id * D; const bf16* vr = V + (size_t)id * D;
            const v4u ux = *(const GAS v4u*)(ur + 8 * lane), uy = *(const GAS v4u*)(ur + 512 + 8 * lane);
            float p = hv[0] * bflo(ux.x) + hv[1] * bfhi(ux.x) + hv[2] * bflo(ux.y) + hv[3] * bfhi(ux.y) + hv[4] * bflo(ux.z) + hv[5] * bfhi(ux.z) + hv[6] * bflo(ux.w) + hv[7] * bfhi(ux.w)
                    + hv[8] * bflo(uy.x) + hv[9] * bfhi(uy.x) + hv[10] * bflo(uy.y) + hv[11] * bfhi(uy.y) + hv[12] * bflo(uy.z) + hv[13] * bfhi(uy.z) + hv[14] * bflo(uy.w) + hv[15] * bfhi(uy.w);
            p = wave_sum(p);
            const float a = 0.5f * p * (1.f + erff(p * 0.70710678118654752f)) * gt;
            const v4u x = *(const GAS v4u*)(vr + 8 * lane), y = *(const GAS v4u*)(vr + 512 + 8 * lane);
            o[0] += a * bflo(x.x); o[1] += a * bfhi(x.x); o[2] += a * bflo(x.y); o[3] += a * bfhi(x.y); o[4] += a * bflo(x.z); o[5] += a * bfhi(x.z); o[6] += a * bflo(x.w); o[7] += a * bfhi(x.w);
            o[8] += a * bflo(y.x); o[9] += a * bfhi(y.x); o[10] += a * bflo(y.y); o[11] += a * bfhi(y.y); o[12] += a * bflo(y.z); o[13] += a * bfhi(y.z); o[14] += a * bflo(y.w); o[15] += a * bfhi(y.w);
        }
#else
        wi[lane] = (unsigned)IDX[(size_t)tok * 128 + lane]; wi[64 + lane] = (unsigned)IDX[(size_t)tok * 128 + 64 + lane];
        wg[lane] = GATE[(size_t)tok * 128 + lane]; wg[64 + lane] = GATE[(size_t)tok * 128 + 64 + lane];
        v4u hx[8];
#pragma unroll
        for (int jj = 0; jj < 8; ++jj) hx[jj] = *(const GAS v4u*)(XN + (size_t)tok * D + (l16 + 16 * jj) * 8);
        LDS_WAIT();
        for (int it = 0; it < 32; ++it) {
            const unsigned e = wi[4 * it + q];
            const bf16* ur = U + (size_t)e * D;
            float acc = 0.f;
#pragma unroll
            for (int jj = 0; jj < 8; ++jj) { const v4u uw = *(const GAS v4u*)(ur + (l16 + 16 * jj) * 8);
                acc = __builtin_amdgcn_fdot2_f32_bf16(__builtin_bit_cast(bf2, uw.x), __builtin_bit_cast(bf2, hx[jj].x), acc, false);
                acc = __builtin_amdgcn_fdot2_f32_bf16(__builtin_bit_cast(bf2, uw.y), __builtin_bit_cast(bf2, hx[jj].y), acc, false);
                acc = __builtin_amdgcn_fdot2_f32_bf16(__builtin_bit_cast(bf2, uw.z), __builtin_bit_cast(bf2, hx[jj].z), acc, false);
                acc = __builtin_amdgcn_fdot2_f32_bf16(__builtin_bit_cast(bf2, uw.w), __builtin_bit_cast(bf2, hx[jj].w), acc, false); }
            acc += __shfl_xor(acc, 1); acc += __shfl_xor(acc, 2); acc += __shfl_xor(acc, 4); acc += __shfl_xor(acc, 8);
            if (l16 == 0) wa[4 * it + q] = acc;
        }
        LDS_WAIT();
        { const float a0 = wa[lane], a1 = wa[64 + lane];
          wa[lane] = 0.5f * a0 * (1.f + erff(a0 * 0.70710678118654752f)) * wg[lane]; wa[64 + lane] = 0.5f * a1 * (1.f + erff(a1 * 0.70710678118654752f)) * wg[64 + lane]; }
        LDS_WAIT();
        float o[16];
#pragma unroll
        for (int i = 0; i < 16; ++i) o[i] = 0.f;
#pragma unroll 4
        for (int e = 0; e < 128; ++e) {
            const float a = wa[e]; const bf16* vr = V + (size_t)wi[e] * D;
            const v4u x = *(const GAS v4u*)(vr + 8 * lane), y = *(const GAS v4u*)(vr + 512 + 8 * lane);
            o[0] += a * bflo(x.x); o[1] += a * bfhi(x.x); o[2] += a * bflo(x.y); o[3] += a * bfhi(x.y); o[4] += a * bflo(x.z); o[5] += a * bfhi(x.z); o[6] += a * bflo(x.w); o[7] += a * bfhi(x.w);
            o[8] += a * bflo(y.x); o[9] += a * bfhi(y.x); o[10] += a * bflo(y.y); o[11] += a * bfhi(y.y); o[12] += a * bflo(y.z); o[13] += a * bfhi(y.z); o[14] += a * bflo(y.w); o[15] += a * bfhi(y.w);
        }
#endif
#if defined(CHECK) && CHECK
        if (tok < 4096 && dbgout) { float* dr = dbgout + (size_t)tok * D;
#pragma unroll
            for (int i = 0; i < 8; ++i) { dr[8 * lane + i] = o[i]; dr[512 + 8 * lane + i] = o[8 + i]; } }
#endif
        const int b = tok >> 13;
        float* xr = F.out + (size_t)tok * D; const float* gr = g2 + (size_t)b * 6144;
#pragma unroll
        for (int hh = 0; hh < 2; ++hh)
#pragma unroll
            for (int qq = 0; qq < 2; ++qq) { const int c = hh * 512 + 8 * lane + 4 * qq; const f32x4 xv = *(const f32x4*)(xr + c), gv = *(const f32x4*)(gr + c);
                *(f32x4*)(xr + c) = xv + gv * dbg * (f32x4){o[hh * 8 + qq * 4], o[hh * 8 + qq * 4 + 1], o[hh * 8 + qq * 4 + 2], o[hh * 8 + qq * 4 + 3]}; }
    }
}
#if defined(CHECK) && CHECK
constexpr size_t WS_DBG = 512 * 1024;
constexpr size_t WS_DBGOUT = WS_CLOC;
#ifndef CHECK_LAYER
#define CHECK_LAYER 1
#endif
__global__ void chk_qry(Args a) {
    const bf16* XN = (const bf16*)(a.ws + WS_XNY); const bf16* QRY = (const bf16*)(a.ws + WS_QRY); const float* wq = a.in[20] + (size_t)CHECK_LAYER * D * NQ;
    float* R = (float*)(a.ws + WS_CTL + WS_DBG);
    const int tok = (blockIdx.x * 977) % M; const int col = (threadIdx.x * 37 + blockIdx.x * 11) % NQ;
    float s = 0.f; for (int k = 0; k < D; ++k) s += bf2f(XN[(size_t)tok * D + k]) * wq[(size_t)k * NQ + col];
    const float q = bf2f(QRY[(size_t)tok * NQ + col]);
    atomicAdd(R + 0, (s - q) * (s - q)); atomicAdd(R + 1, s * s);
}
__global__ void chk_keys(Args a) {
    const bf16* KB = (const bf16*)(a.ws + WS_KEYS); const float* keys = a.in[21]; float* R = (float*)(a.ws + WS_CTL + WS_DBG);
    const int i = blockIdx.x * blockDim.x + threadIdx.x; if (i < 2 * 2 * 128 * 128) { const float d = bf2f(KB[i]) - keys[i]; atomicAdd(R + 8, d * d); atomicAdd(R + 9, keys[i] * keys[i]); }
}
__global__ void chk_uv(Args a) {
    const bf16* UB = (const bf16*)(a.ws + WS_UB); const bf16* VB = (const bf16*)(a.ws + WS_VB); float* R = (float*)(a.ws + WS_CTL + WS_DBG);
    const size_t i = ((size_t)blockIdx.x * blockDim.x + threadIdx.x) * 61 % ((size_t)2 * 16384 * 1024);
    const float du = bf2f(UB[i]) - a.in[22][i], dv = bf2f(VB[i]) - a.in[23][i];
    atomicAdd(R + 16, du * du + dv * dv); atomicAdd(R + 17, a.in[22][i] * a.in[22][i] + a.in[23][i] * a.in[23][i]);
}
__global__ void chk_route(Args a) {
    const bf16* QRY = (const bf16*)(a.ws + WS_QRY); const float* keys = a.in[21] + (size_t)CHECK_LAYER * 2 * 128 * 128;
    const int* IDX = (const int*)(a.ws + WS_IDX); const float* GATE = (const float*)(a.ws + WS_GATE);
    float* R = (float*)(a.ws + WS_CTL + WS_DBG);
    __shared__ float sc[2][128]; __shared__ float sc0[2][128]; __shared__ float ts[2][16]; __shared__ int ti[2][16]; __shared__ float cs[256]; __shared__ int ci[256];
    const int tok = (blockIdx.x * 613 + 5) % M, hd = blockIdx.x & 7, tid = threadIdx.x;
    { const int p = tid >> 7, n = tid & 127; float s = 0.f; for (int d = 0; d < 128; ++d) s += bf2f(QRY[(size_t)tok * NQ + hd * 256 + p * 128 + d]) * keys[(size_t)(p * 128 + n) * 128 + d]; sc[p][n] = s; sc0[p][n] = s; }
    __syncthreads();
    if (tid < 2) { const int p = tid; for (int k = 0; k < 16; ++k) { int best = 0; float bv = -INFINITY; for (int n = 0; n < 128; ++n) if (sc[p][n] > bv) { bv = sc[p][n]; best = n; } ts[p][k] = bv; ti[p][k] = best; sc[p][best] = -INFINITY; } }
    __syncthreads();
    cs[tid] = ts[0][tid >> 4] + ts[1][tid & 15]; ci[tid] = ti[0][tid >> 4] * 128 + ti[1][tid & 15];
    __syncthreads();
    if (tid == 0) {
        float fs[16]; int fi[16];
        for (int k = 0; k < 16; ++k) { int best = 0; float bv = -INFINITY; for (int n = 0; n < 256; ++n) if (cs[n] > bv) { bv = cs[n]; best = n; } fs[k] = bv; fi[k] = ci[best]; cs[best] = -INFINITY; }
        float den = 0.f; for (int k = 0; k < 16; ++k) den += __expf(fs[k] - fs[0]);
        int mism = 0; float ge = 0.f;
        for (int k = 0; k < 16; ++k) { bool found = false; for (int j = 0; j < 16; ++j) if (IDX[(size_t)tok * 128 + hd * 16 + j] == fi[k]) { found = true; const float g = __expf(fs[k] - fs[0]) / den; const float d = g - GATE[(size_t)tok * 128 + hd * 16 + j]; ge += d * d; } if (!found) ++mism; }
        { int ba = 0, bb = 0; for (int j = 0; j < 16; ++j) { const int e = IDX[(size_t)tok * 128 + hd * 16 + j]; const int ea = (e >> 7) & 127, eb = e & 127;
            if (!(e >= 0 && e < 16384) || sc0[0][ea] + sc0[1][eb] < fs[15] - 0.05f) ++ba; if (!(e >= 0 && e < 16384) || sc0[1][ea] + sc0[0][eb] < fs[15] - 0.05f) ++bb; }
          atomicAdd(R + 10, (float)ba); atomicAdd(R + 11, (float)bb); }
        atomicAdd(R + 2, (float)mism); atomicAdd(R + 3, 16.f); atomicAdd(R + 4, ge); atomicAdd(R + 5, 1.f / 16.f);
    }
}
__global__ void chk_scores(Args a) {
    const bf16* QRY = (const bf16*)(a.ws + WS_QRY); const float* keys = a.in[21] + (size_t)CHECK_LAYER * 2 * 128 * 128;
    const float* DB = (const float*)(a.ws + WS_CLOC) + 8 * 1024 * 1024; float* R = (float*)(a.ws + WS_CTL + WS_DBG);
    const int t = blockIdx.x, tid = threadIdx.x;
    __shared__ float sc[2][128];
    { const int p = tid >> 7, n = tid & 127; float s = 0.f; for (int d = 0; d < 128; ++d) s += bf2f(QRY[(size_t)t * NQ + p * 128 + d]) * keys[(size_t)(p * 128 + n) * 128 + d];
      const float dv = DB[(p * 128 + t) * 128 + n]; atomicAdd(R + 12, (s - dv) * (s - dv)); atomicAdd(R + 13, s * s); sc[p][n] = dv; }
    __syncthreads();
    if (tid < 2) { const int p = tid; int bad = 0; for (int k = 0; k < 16; ++k) { int best = 0; float bv = -INFINITY; for (int n = 0; n < 128; ++n) if (sc[p][n] > bv) { bv = sc[p][n]; best = n; }
        const float lv = DB[32768 + t * 48 + 16 * p + k]; if (fabsf(lv - bv) > 1e-3f * (1.f + fabsf(bv))) ++bad; sc[p][best] = -INFINITY; }
        atomicAdd(R + 14, (float)bad); atomicAdd(R + 15, 16.f); }
}
__global__ void chk_expert(Args a) {
    const bf16* XN = (const bf16*)(a.ws + WS_XNY); const int* IDX = (const int*)(a.ws + WS_IDX); const float* GATE = (const float*)(a.ws + WS_GATE);
    const float* U = a.in[22] + (size_t)CHECK_LAYER * 16384 * 1024; const float* V = a.in[23] + (size_t)CHECK_LAYER * 16384 * 1024;
    const float* DO = (const float*)(a.ws + WS_DBGOUT); float* R = (float*)(a.ws + WS_CTL + WS_DBG);
    __shared__ float act[128];
    const int tok = (blockIdx.x * 61 + 3) % 4096, tid = threadIdx.x;
    if (tid < 128) { const int e = IDX[(size_t)tok * 128 + tid]; float s = 0.f; for (int k = 0; k < D; ++k) s += bf2f(XN[(size_t)tok * D + k]) * U[(size_t)e * D + k];
        act[tid] = 0.5f * s * (1.f + erff(s * 0.70710678f)) * GATE[(size_t)tok * 128 + tid]; }
    __syncthreads();
    for (int c = tid; c < D; c += 256) { float o = 0.f; for (int e = 0; e < 128; ++e) o += act[e] * V[(size_t)IDX[(size_t)tok * 128 + e] * D + c];
        const float g = DO[(size_t)tok * D + c]; atomicAdd(R + 6, (o - g) * (o - g)); atomicAdd(R + 7, o * o); }
}
__global__ void chk_stamp(Args a) {
    const float* R = (const float*)(a.ws + WS_CTL + WS_DBG);
    const float e1 = sqrtf(R[0] / fmaxf(R[1], 1e-30f)), e2 = R[2] / fmaxf(R[3], 1.f), e2g = sqrtf(R[4] / fmaxf(R[5], 1e-30f)), e3 = sqrtf(R[6] / fmaxf(R[7], 1e-30f));
    float c;
#if CHECK == 99
    c = 1.f;
#else
    const float e0 = sqrtf(R[8] / fmaxf(R[9], 1e-30f));
    const float ea = R[10] / fmaxf(R[3], 1.f), eb = R[11] / fmaxf(R[3], 1.f);
    const float esc = sqrtf(R[12] / fmaxf(R[13], 1e-30f)), els = R[14] / fmaxf(R[15], 1.f);
    const float euv = sqrtf(R[16] / fmaxf(R[17], 1e-30f));
    const float errs[4] = {e2, euv, ea, e3}; const float tols[4] = {0.08f, 0.01f, 0.08f, 0.03f};
    c = 1.f;
    for (int k = 3; k >= 0; --k) if (!(errs[k] <= tols[k])) { const float fr = fminf(fmaxf((log10f(fmaxf(errs[k], 1e-4f)) + 4.f) / 5.f, 0.f), 0.95f); c = 2.f + (float)k + fr; }
#endif
    const size_t i = (size_t)blockIdx.x * blockDim.x + threadIdx.x;
    if (i < (size_t)M * D) a.out[i] = a.in[0][i] * (1.f + c);
}
#endif
#ifndef MK_PER_PHASE
#define MK_PER_PHASE 0
#endif
constexpr int NPHASE = 20;
#ifndef DBG_Y0
#define DBG_Y0 1
#define DBG_P0 1
#define DBG_Y1 1
#define DBG_P1 1
#endif
#ifndef PHASE_MASK
#define PHASE_MASK 0x1fffffu
#endif
#define IN(k) (lo <= (k) && (k) < hi && ((PHASE_MASK >> (k)) & 1u))
#define SEAM(k) do { if (IN(k) && IN((k) + 1)) xcd_barrier(bar); } while (0)
template <int layer>
__device__ __forceinline__ void layer_phases(Frame& F, const Args& args, const XcdBarrier& bar, const int lo, const int hi) {
    float* MOD = WSP(float, WS_MOD);
    bf16* XNY = WSP(bf16, WS_XNY); bf16* Zb = WSP(bf16, WS_Z);

        constexpr int pb = layer * 10;
        const float* mod = MOD + (size_t)layer * 4 * 6144;
        if (IN(pb + 1)) { if (layer == 0) norm_pass<true>(F, args, args.in[0], args.in[4], mod, 0, XNY); else norm_pass<false>(F, args, F.out, args.in[4] + 1024, mod, 0, XNY); } SEAM(pb + 1);
        if (IN(pb + 2)) {
            const int N = layer == 0 ? NZ0 : NZ1;
            pg8::Gemm g{XNY, layer == 0 ? WSP(bf16, WS_WIN0) : WSP(bf16, WS_WIN1), M, N, D}; pg8::StaticOrder S; S.init(M, N, F.G, F.bid);
            pg8::EpiBf16 E{Zb, N};
            pg8::gemm_phase<pg8::EpiBf16, pg8::StaticOrder, true, true>(F.lds, g, S, E);
        } SEAM(pb + 2);
        if (layer == 0) {
            if (IN(3)) {
                for (int u = F.bid; u < 1024 + 256; u += F.G) {
                    if (u < 1024) mlstm_a_unit(F, args, u);
                    else { const int v = u - 1024, b = v >> 6, j = (v >> 1) & 31, which = v & 1;
                        qknorm_unit(F, Zb, NZ0, b * SEQ + j * 256, which ? 2560 : 2048, which ? args.in[12] : args.in[11], which ? WSP(float, WS_KMEAN) + (size_t)((b * 8) * 32 + j) * 64 : nullptr); }
                }
            } SEAM(3);
            if (IN(4)) {
                for (int u = F.bid; u < 256; u += F.G) mlstm_scan_unit(F, u);
                for (int u = F.bid; u < 1024; u += F.G) { const int k = u >> 8, idx = u & 255, bh = idx & 31, jj = idx >> 5; const int j = (k & 1) ? 31 - 8 * k - (7 - jj) : 31 - 8 * k - jj;
                    moba_unit(F, bh >> 3, bh & 7, j); }
            } SEAM(4);
            if (IN(5)) { for (int u = F.bid; u < 1024; u += F.G) mlstm_c_unit(F, args, u); } SEAM(5);
        } else {
            if (IN(13)) {
                for (int u = F.bid; u < 512; u += F.G) { const int rt = u >> 2, cr = u & 3; qknorm_unit(F, Zb, NZ1, rt * 256, cr * 512, cr < 2 ? args.in[15] : args.in[16], nullptr); }
            } SEAM(13);
            if (IN(14)) {
                const float* lp = args.in[17];
                const float lam = __expf(wave_sum(lp[F.lane] * lp[64 + F.lane])) - __expf(wave_sum(lp[128 + F.lane] * lp[192 + F.lane])) + 0.35550906759096926f;
                for (int u = F.bid; u < 2048; u += F.G) { const int k = u >> 8, idx = u & 255, bh = idx & 31, qq = idx >> 5; const int qt = (k & 1) ? 63 - 8 * k - (7 - qq) : 63 - 8 * k - qq;
                    diff_unit(F, args, bh >> 3, bh & 7, qt, lam); }
            } SEAM(14);
        }
        if (IN(pb + 6)) {
            pg8::Gemm g{XNY, layer == 0 ? WSP(bf16, WS_WOUT0) : WSP(bf16, WS_WOUT1), M, D, D}; pg8::StaticOrder S; S.init(M, D, F.G, F.bid);
            pg8::EpiResid E{layer == 0 ? args.in[0] : F.out, F.out, mod + 2 * 1024, layer == 0 ? (float)DBG_Y0 : (float)DBG_Y1};
            pg8::gemm_phase<pg8::EpiResid, pg8::StaticOrder, true, true>(F.lds, g, S, E);
        } SEAM(pb + 6);
        if (IN(pb + 7)) { norm_pass<false>(F, args, F.out, args.in[5] + layer * 1024, mod, 3, XNY); } SEAM(pb + 7);
        if (IN(pb + 8)) {
            pg8::Gemm g{XNY, WSP(bf16, WS_WQ) + (size_t)layer * NQ * D, M, NQ, D}; pg8::StaticOrder S; S.init(M, NQ, F.G, F.bid);
            pg8::EpiBf16 E{WSP(bf16, WS_QRY), NQ};
            pg8::gemm_phase<pg8::EpiBf16, pg8::StaticOrder, true, true>(F.lds, g, S, E);
        } SEAM(pb + 8);
        if (IN(pb + 9)) { const bf16* KEYS = WSP(bf16, WS_KEYS) + (size_t)layer * 2 * 128 * 128;
            for (int u = F.bid; u < 2048; u += F.G) peer_route_unit(F, (u >> 3) * 128, u & 7, KEYS); } SEAM(pb + 9);
        if (IN(pb + 10)) { peer_expert_phase(F, WSP(bf16, WS_UB) + (size_t)layer * 16384 * 1024, WSP(bf16, WS_VB) + (size_t)layer * 16384 * 1024, mod + 5 * 1024, layer == 0 ? (float)DBG_P0 : (float)DBG_P1, layer == 1 ? WSP(float, WS_CLOC) : nullptr); }
        if (layer == 0) SEAM(10);
    }
__global__ void __launch_bounds__(NTHR, 2) mega_fwd(Args args) {
    extern __shared__ __attribute__((aligned(16))) unsigned char lds_raw[];
    Frame F;
    F.lds = (LAS unsigned char*)lds_raw;
    F.tid = threadIdx.x; F.lane = F.tid & 63; F.wave = __builtin_amdgcn_readfirstlane(F.tid >> 6);
    F.G = gridDim.x; F.bid = blockIdx.x;
    F.out = args.out; F.ws = args.ws;
    volatile LAS unsigned* MISC = (volatile LAS unsigned*)(F.lds + MISC_OFF);
    for (int u = F.tid; u < (LDS_BYTES - LDSCTL_OFF) / 4; u += NTHR) ((LAS unsigned*)(F.lds + LDSCTL_OFF))[u] = 0u;
    __syncthreads();
    XcdBarrier bar; bar.bar = (unsigned*)(F.ws + WS_CTL) + CW_BAR; bar.x = 0; bar.st = nullptr;
    if (!MK_PER_PHASE) bar = xcd_barrier_post((unsigned*)(F.ws + WS_CTL) + CW_BAR, MISC + 8);
    const int lo = args.ph_lo, hi = args.ph_hi;

    if (IN(0)) { p0_prologue(F, args); } SEAM(0);
    layer_phases<0>(F, args, bar, lo, hi);
    layer_phases<1>(F, args, bar, lo, hi);
}
#undef IN
#undef SEAM

extern "C" void kernel_launch(void* const* d_in, const int* in_sizes, int n_in, void* d_out, int out_size, void* d_ws, size_t ws_size, hipStream_t stream) {
    static int grid = 0;
    if (grid == 0) {
        if (n_in != 24 || in_sizes[0] != M * D || out_size != M * D || ws_size < WS_END) { fprintf(stderr, "kernel_launch: unexpected problem (n_in %d, in0 %d, out %d, ws %zu < %zu); nothing launched\n", n_in, n_in > 0 ? in_sizes[0] : -1, out_size, ws_size, (size_t)WS_END); grid = -1; return; }
        int dev = 0, cus = 0, per_cu = 0;
        if (hipGetDevice(&dev) != hipSuccess || hipDeviceGetAttribute(&cus, hipDeviceAttributeMultiprocessorCount, dev) != hipSuccess) { grid = -1; return; }
        if (hipFuncSetAttribute((const void*)mega_fwd, hipFuncAttributeMaxDynamicSharedMemorySize, LDS_BYTES) != hipSuccess) { fprintf(stderr, "kernel_launch: hipFuncSetAttribute failed\n"); grid = -1; return; }
        if (hipOccupancyMaxActiveBlocksPerMultiprocessor(&per_cu, (const void*)mega_fwd, NTHR, LDS_BYTES) != hipSuccess || per_cu < 1)
            fprintf(stderr, "kernel_launch: note: occupancy query reports %d workgroups per CU\n", per_cu);
        (void)hipGetLastError();
        grid = cus;
    }
    if (grid < 0) return;
    if (hipMemsetAsync((char*)d_ws + WS_CTL, 0, CTL_ZERO_BYTES, stream) != hipSuccess) { fprintf(stderr, "kernel_launch: memset failed\n"); return; }
    Args a{};
    for (int i = 0; i < 24; ++i) a.in[i] = (const float*)d_in[i];
    a.out = (float*)d_out; a.ws = (unsigned char*)d_ws;
#if MK_PER_PHASE
    for (int p = 0; p < NPHASE + 1; ++p) { a.ph_lo = p; a.ph_hi = p + 1; hipLaunchKernelGGL(mega_fwd, dim3(grid), dim3(NTHR), LDS_BYTES, stream, a); }
#else
    a.ph_lo = 0; a.ph_hi = NPHASE + 1;
    hipLaunchKernelGGL(mega_fwd, dim3(grid), dim3(NTHR), LDS_BYTES, stream, a);
#endif
#if defined(CHECK) && CHECK
    chk_qry<<<256, 256, 0, stream>>>(a); chk_keys<<<256, 256, 0, stream>>>(a); chk_uv<<<1024, 256, 0, stream>>>(a); chk_scores<<<128, 256, 0, stream>>>(a); chk_route<<<512, 256, 0, stream>>>(a); chk_expert<<<64, 256, 0, stream>>>(a); chk_stamp<<<(M * D + 255) / 256, 256, 0, stream>>>(a);
#endif
    const hipError_t le = hipPeekAtLastError();
    if (le != hipSuccess) fprintf(stderr, "kernel_launch: launch failed: %s\n", hipGetErrorName(le));
}
```

```cpp
#include <hip/hip_runtime.h>
#include <cstdio>
#include <cstdint>
namespace pg8 {
#define PG8_LAS __attribute__((address_space(3)))
typedef unsigned short bf16_t;
typedef short bf16x8 __attribute__((ext_vector_type(8)));
typedef float f32x4 __attribute__((ext_vector_type(4)));
typedef unsigned u32x4 __attribute__((ext_vector_type(4)));
constexpr int BM = 256, BK = 64, HALF = 128, HTB = HALF * BK * 2  , STAGE_BYTES = 8 * HTB, NXCD = 8, WGM = 8;

__host__ __device__ __forceinline__ int lds_byte(int r, int c) { const int st = (r >> 4) * 2 + (c >> 5), rr = r & 15, cc = c & 31, ob = rr * 64 + cc * 2; return st * 1024 + (ob ^ (((ob >> 9) & 1) << 5)); }
__host__ __device__ __forceinline__ void stage_rc(int b, int& R, int& C) { const int st = b / 1024, sb = b % 1024, swz = sb ^ (((sb >> 9) & 1) << 5); R = (st >> 1) * 16 + swz / 64; C = (st & 1) * 32 + (swz % 64) / 2; }
__host__ __device__ __forceinline__ int perm32(int rho) { const int n = rho >> 4, i = rho & 15; return 8 * (i >> 2) + 4 * n + (i & 3); }

struct Unit { int pm, pn; };
struct Gemm { const bf16_t* A; const bf16_t* Bt; int M, N, K; };

struct StaticOrder {
    int nM, nN, nwg, G, c;
    __host__ __device__ void init(int M, int N, int G_, int c_) { nM = M / BM; nN = N / BM; nwg = nM * nN; G = G_; c = c_; }
    __host__ __device__ bool next(int i, Unit& u) const {
        const long L = (long)i * G + c; if (L >= nwg) return false;
        int wgid = (int)L; { const int q = nwg / NXCD, r = nwg % NXCD, xcd = wgid % NXCD, off = wgid / NXCD; wgid = (xcd < r ? xcd * (q + 1) : r * (q + 1) + (xcd - r) * q) + off; }
        const int nig = WGM * nN, gid = wgid / nig, fm = gid * WGM, gsz = (nM - fm) < WGM ? (nM - fm) : WGM;
        u.pm = fm + ((wgid % nig) % gsz); u.pn = (wgid % nig) / gsz; return true;
    }
    __device__ __forceinline__ void a_ready(const Unit&) const {}
    __device__ __forceinline__ void done(const Unit&) const {}
};

__device__ __forceinline__ unsigned cvt_pk_bf16(float lo, float hi) { unsigned r; asm volatile("v_cvt_pk_bf16_f32 %0, %1, %2" : "=v"(r) : "v"(lo), "v"(hi)); return r; }
typedef unsigned u32x4 __attribute__((ext_vector_type(4)));
struct EpiBf16 {
    static constexpr bool PERM = true, AFTER_DRAIN = false;
    bf16_t* O; int ldc;
    __device__ __forceinline__ void operator()(const f32x4 (&acc)[2][2][4][2], const Unit& u, int wr, int wc, int fr, int fq) const {
        const int row0 = u.pm * BM + wr * 64 + fr; const int col0 = u.pn * BM + wc * 32 + 8 * fq;
#pragma unroll
        for (int ai = 0; ai < 2; ++ai)
#pragma unroll
            for (int m = 0; m < 4; ++m) { bf16_t* rowp = O + (size_t)(row0 + ai * HALF + m * 16) * ldc + col0;
#pragma unroll
                for (int bj = 0; bj < 2; ++bj) { const f32x4 v0 = acc[ai][bj][m][0], v1 = acc[ai][bj][m][1];
                    u32x4 w; w.x = cvt_pk_bf16(v0[0], v0[1]); w.y = cvt_pk_bf16(v0[2], v0[3]); w.z = cvt_pk_bf16(v1[0], v1[1]); w.w = cvt_pk_bf16(v1[2], v1[3]);
                    *(u32x4*)(rowp + bj * HALF) = w; } }
    }
};
struct EpiResid {
    static constexpr bool PERM = false, AFTER_DRAIN = false;
    const float* base; float* out; const float* gate; float dbg;
    __device__ __forceinline__ void operator()(const f32x4 (&acc)[2][2][4][2], const Unit& u, int wr, int wc, int fr, int fq) const {
        const int col0 = u.pn * BM + wc * 32 + 4 * fq; const int b = (u.pm * BM) >> 13;
#pragma unroll
        for (int bj = 0; bj < 2; ++bj)
#pragma unroll
            for (int n = 0; n < 2; ++n) { const f32x4 gv = *(const f32x4*)(gate + (size_t)b * 6144 + col0 + bj * HALF + n * 16);
#pragma unroll
                for (int ai = 0; ai < 2; ++ai)
#pragma unroll
                    for (int m = 0; m < 4; ++m) { const size_t off = (size_t)(u.pm * BM + ai * HALF + wr * 64 + m * 16 + fr) * 1024 + col0 + bj * HALF + n * 16;
                        const f32x4 bs = *(const f32x4*)(base + off); *(f32x4*)(out + off) = bs + gv * acc[ai][bj][m][n] * dbg; } }
    }
};

template <class Epi, class Sched, bool ALIGN_EPI = false, bool SP2 = false>
__device__ __forceinline__ void gemm_phase(PG8_LAS unsigned char* lds, const Gemm g, const Sched& S, const Epi& E) {
    const int tid = threadIdx.x, wid = __builtin_amdgcn_readfirstlane(tid >> 6), lane = tid & 63, wr = wid >> 2, wc = wid & 3, fr = lane & 15, fq = lane >> 4;
    const int K = g.K, nt = K / BK;
    unsigned voffA[2], voffB[2];
#pragma unroll
    for (int i = 0; i < 2; ++i) { int R, C; stage_rc(tid * 16 + i * 8192, R, C); const int Rb = Epi::PERM ? ((R & ~31) + perm32(R & 31)) : R;
        voffA[i] = (unsigned)(R * K + C) * 2u; voffB[i] = (unsigned)(Rb * K + C) * 2u; }
    const size_t kstep = (size_t)(BK * 2);
    const size_t hstep = (size_t)HALF * K * 2;
    const size_t tstep = 2 * hstep;
    const unsigned ldsw = (unsigned)wid * 1024u;
    const int aoff = lds_byte(wr * 64 + fr, fq * 8), boff = lds_byte(wc * 32 + fr, fq * 8);
#define PG8_SA(b, h) (((b) * 2 + (h)) * HTB)
#define PG8_SB(b, h) ((4 + (b) * 2 + (h)) * HTB)
#define PG8_STAGE(bufoff, gbase, voff) do { _Pragma("unroll") for (int _i = 0; _i < 2; ++_i) \
        __builtin_amdgcn_global_load_lds((const unsigned*)((const char*)(gbase) + (voff)[_i]), (PG8_LAS unsigned*)(lds + (bufoff) + ldsw + _i * 8192), 16, 0, 0); } while (0)
#define PG8_LDA(dst, b, h) do { _Pragma("unroll") for (int m = 0; m < 4; ++m) _Pragma("unroll") for (int k = 0; k < 2; ++k) dst[m][k] = *(const PG8_LAS bf16x8*)(lds + PG8_SA(b, h) + aoff + m * 2048 + k * 1024); } while (0)
#define PG8_LDB(dst, b, h) do { _Pragma("unroll") for (int n = 0; n < 2; ++n) _Pragma("unroll") for (int k = 0; k < 2; ++k) dst[n][k] = *(const PG8_LAS bf16x8*)(lds + PG8_SB(b, h) + boff + n * 2048 + k * 1024); } while (0)
#define PG8_MMA(ai, bj, At, Bt) do { __builtin_amdgcn_s_setprio(1); _Pragma("unroll") for (int m = 0; m < 4; ++m) _Pragma("unroll") for (int n = 0; n < 2; ++n) _Pragma("unroll") for (int k = 0; k < 2; ++k) \
        acc[ai][bj][m][n] = __builtin_amdgcn_mfma_f32_16x16x32_bf16(Bt[n][k], At[m][k], acc[ai][bj][m][n], 0, 0, 0); __builtin_amdgcn_s_setprio(0); } while (0)
#define PG8_WAIT_V(n) asm volatile("s_waitcnt vmcnt(" #n ")" ::: "memory")
#define PG8_WAIT_L(n) asm volatile("s_waitcnt lgkmcnt(" #n ")" ::: "memory")
#define PG8_BAR __builtin_amdgcn_s_barrier()
#define PG8_SCHED __builtin_amdgcn_sched_barrier(0)
    Unit cur, nxt; int ui = 0;
    if (!S.next(0, cur)) return;
    f32x4 acc[2][2][4][2];
#pragma unroll
    for (int a = 0; a < 2; ++a)
#pragma unroll
        for (int b = 0; b < 2; ++b)
#pragma unroll
            for (int m = 0; m < 4; ++m)
#pragma unroll
                for (int n = 0; n < 2; ++n) acc[a][b][m][n] = (f32x4){0.f, 0.f, 0.f, 0.f};
    bf16x8 At[4][2], B0[2][2], B1[2][2];
    const char* cA = (const char*)g.A + (size_t)cur.pm * tstep; const char* cB = (const char*)g.Bt + (size_t)cur.pn * tstep;
    S.a_ready(cur);
    if constexpr (SP2) {
        PG8_STAGE(PG8_SB(0, 0), cB, voffB); PG8_STAGE(PG8_SB(0, 1), cB + hstep, voffB); PG8_STAGE(PG8_SA(0, 0), cA, voffA); PG8_STAGE(PG8_SA(0, 1), cA + hstep, voffA);
        if (wr == 1) PG8_BAR;
        PG8_WAIT_V(2); PG8_BAR;
        PG8_STAGE(PG8_SB(1, 0), cB + kstep, voffB); PG8_STAGE(PG8_SA(1, 0), cA + kstep, voffA); PG8_STAGE(PG8_SB(1, 1), cB + hstep + kstep, voffB);
        PG8_WAIT_V(6); PG8_BAR;
    } else {
        PG8_STAGE(PG8_SB(0, 0), cB, voffB); PG8_STAGE(PG8_SA(0, 0), cA, voffA); PG8_STAGE(PG8_SB(0, 1), cB + hstep, voffB); PG8_STAGE(PG8_SA(0, 1), cA + hstep, voffA);
        if (wr == 1) PG8_BAR;
        PG8_WAIT_V(4); PG8_BAR;
        PG8_STAGE(PG8_SB(1, 0), cB + kstep, voffB); PG8_STAGE(PG8_SA(1, 0), cA + kstep, voffA); PG8_STAGE(PG8_SB(1, 1), cB + hstep + kstep, voffB);
        PG8_WAIT_V(6); PG8_BAR;
    }
    for (;;) {
        const bool has_next = S.next(ui + 1, nxt);
        const char* nA = has_next ? (const char*)g.A + (size_t)nxt.pm * tstep : cA; const char* nB = has_next ? (const char*)g.Bt + (size_t)nxt.pn * tstep : cB;
        for (int t = 0; t < nt; t += 2) {
            const bool last = (t == nt - 2);
            const char* a1 = cA + (size_t)(t + 1) * kstep;
            const char* a2 = last ? nA : cA + (size_t)(t + 2) * kstep; const char* b2 = last ? nB : cB + (size_t)(t + 2) * kstep;
            const char* a3 = a2 + kstep; const char* b3 = b2 + kstep;
            if (last && has_next) S.a_ready(nxt);
            if constexpr (SP2) {
            PG8_LDB(B0, 0, 0); PG8_LDB(B1, 0, 1); PG8_SCHED; PG8_LDA(At, 0, 0); PG8_STAGE(PG8_SA(1, 1), a1 + hstep, voffA);
            PG8_WAIT_V(8); PG8_WAIT_L(0); PG8_BAR; PG8_MMA(0, 0, At, B0); PG8_MMA(0, 1, At, B1); PG8_BAR; PG8_SCHED;
            PG8_LDA(At, 0, 1); PG8_STAGE(PG8_SB(0, 0), b2, voffB); PG8_STAGE(PG8_SB(0, 1), b2 + hstep, voffB); PG8_STAGE(PG8_SA(0, 0), a2, voffA);
            PG8_WAIT_V(8); PG8_WAIT_L(0); PG8_BAR; PG8_MMA(1, 0, At, B0); PG8_MMA(1, 1, At, B1); PG8_BAR; PG8_SCHED;
            PG8_LDB(B0, 1, 0); PG8_LDB(B1, 1, 1); PG8_SCHED; PG8_LDA(At, 1, 0); PG8_STAGE(PG8_SA(0, 1), a2 + hstep, voffA);
            PG8_WAIT_V(8); PG8_WAIT_L(0); PG8_BAR; PG8_MMA(0, 0, At, B0); PG8_MMA(0, 1, At, B1); PG8_BAR; PG8_SCHED;
            PG8_LDA(At, 1, 1); PG8_STAGE(PG8_SB(1, 0), b3, voffB); PG8_STAGE(PG8_SB(1, 1), b3 + hstep, voffB); PG8_STAGE(PG8_SA(1, 0), a3, voffA);
            PG8_WAIT_V(8); PG8_WAIT_L(0); PG8_BAR; PG8_MMA(1, 0, At, B0); PG8_MMA(1, 1, At, B1); PG8_BAR; PG8_SCHED;
            } else {
            PG8_LDB(B0, 0, 0); PG8_SCHED; PG8_LDA(At, 0, 0); PG8_STAGE(PG8_SA(1, 1), a1 + hstep, voffA);
            PG8_WAIT_L(8); PG8_BAR; PG8_WAIT_L(0); PG8_MMA(0, 0, At, B0); PG8_BAR; PG8_SCHED;
            PG8_LDB(B1, 0, 1); PG8_STAGE(PG8_SB(0, 0), b2, voffB);
            PG8_BAR; PG8_WAIT_L(0); PG8_MMA(0, 1, At, B1); PG8_BAR;
            PG8_LDA(At, 0, 1); PG8_STAGE(PG8_SA(0, 0), a2, voffA);
            PG8_BAR; PG8_WAIT_L(0); PG8_MMA(1, 0, At, B0); PG8_BAR; PG8_SCHED;
            PG8_STAGE(PG8_SB(0, 1), b2 + hstep, voffB);
            PG8_WAIT_V(6); PG8_BAR; PG8_MMA(1, 1, At, B1); PG8_BAR;
            PG8_LDB(B0, 1, 0); PG8_SCHED; PG8_LDA(At, 1, 0); PG8_STAGE(PG8_SA(0, 1), a2 + hstep, voffA);
            PG8_WAIT_L(8); PG8_BAR; PG8_WAIT_L(0); PG8_MMA(0, 0, At, B0); PG8_BAR; PG8_SCHED;
            PG8_LDB(B1, 1, 1); PG8_STAGE(PG8_SB(1, 0), b3, voffB);
            PG8_BAR; PG8_WAIT_L(0); PG8_MMA(0, 1, At, B1); PG8_BAR;
            PG8_LDA(At, 1, 1); PG8_STAGE(PG8_SA(1, 0), a3, voffA);
            PG8_BAR; PG8_WAIT_L(0); PG8_MMA(1, 0, At, B0); PG8_BAR; PG8_SCHED;
            PG8_STAGE(PG8_SB(1, 1), b3 + hstep, voffB);
            PG8_WAIT_V(6); PG8_BAR; PG8_MMA(1, 1, At, B1); PG8_BAR;
            }
        }
        if constexpr (ALIGN_EPI) { if (wr == 0) PG8_BAR; }
        if constexpr (!Epi::AFTER_DRAIN) { E(acc, cur, wr, wc, fr, fq); S.done(cur); }
        if (!has_next) break;
#pragma unroll
        for (int a = 0; a < 2; ++a)
#pragma unroll
            for (int b = 0; b < 2; ++b)
#pragma unroll
                for (int m = 0; m < 4; ++m)
#pragma unroll
                    for (int n = 0; n < 2; ++n) acc[a][b][m][n] = (f32x4){0.f, 0.f, 0.f, 0.f};
        cur = nxt; cA = nA; cB = nB; ++ui;
        if constexpr (ALIGN_EPI) { if (wr == 1) PG8_BAR; }
    }
    PG8_WAIT_V(0);
    if constexpr (!ALIGN_EPI) { if (wr == 0) PG8_BAR; }
    PG8_BAR;
    if constexpr (Epi::AFTER_DRAIN) { E.fused(acc, cur, wr, wc, fr, fq, lds, wid, lane); S.done(cur); }
#undef PG8_SA
#undef PG8_SB
#undef PG8_STAGE
#undef PG8_LDA
#undef PG8_LDB
#undef PG8_MMA
#undef PG8_WAIT_V
#undef PG8_WAIT_L
#undef PG8_BAR
#undef PG8_SCHED
}
}
constexpr int NB = 4, SEQ = 8192, D = 1024, M = NB * SEQ;
constexpr int NZ0 = 3584, NZ1 = 3072, NQ = 2048, SRC_IN0 = 3592;
constexpr float EPS = 1e-6f;
constexpr int NWAVES = 8, NTHR = 512;
constexpr float LOG2E = 1.4426950408889634f;
constexpr size_t MiB = 1u << 20;
constexpr size_t WS_CTL = 0, CTL_ZERO_BYTES = 1 * MiB;
constexpr size_t WS_WIN0 = 1 * MiB, WS_WOUT0 = 8 * MiB, WS_WIN1 = 10 * MiB, WS_WOUT1 = 16 * MiB, WS_WQ = 18 * MiB;
constexpr size_t WS_KEYS = 26 * MiB, WS_MOD = WS_KEYS + 128 * 1024, WS_KMEAN = WS_MOD + 192 * 1024, WS_NLOC = WS_KMEAN + 256 * 1024,
                 WS_BEND = WS_NLOC + 512 * 1024, WS_MLOC = WS_BEND + 4096, WS_MPREV = WS_MLOC + 4096;
constexpr size_t WS_GATES = 28 * MiB;
constexpr size_t WS_UB = 32 * MiB, WS_VB = 96 * MiB, WS_XNY = 160 * MiB, WS_Z = 224 * MiB, WS_CLOC = 448 * MiB, WS_END = 512 * MiB;
constexpr size_t WS_QRY = WS_Z, WS_IDX = WS_Z + 128 * MiB, WS_GATE = WS_Z + 144 * MiB;
constexpr int CW_BAR = 4096;
constexpr int RING_BYTES = 139264;
constexpr int LDSCTL_OFF = RING_BYTES, MISC_OFF = LDSCTL_OFF + 320;
constexpr int LDS_BYTES = 147456;
static_assert(MISC_OFF + 128 <= LDS_BYTES, "LDS map");

#define GAS __attribute__((address_space(1)))
#define LAS __attribute__((address_space(3)))
typedef unsigned short bf16;
typedef unsigned v4u __attribute__((ext_vector_type(4)));
typedef unsigned v2u __attribute__((ext_vector_type(2)));
typedef float f32x4 __attribute__((ext_vector_type(4)));
typedef float f32x16 __attribute__((ext_vector_type(16)));
typedef short bf16x8 __attribute__((ext_vector_type(8)));
typedef short s16x4 __attribute__((ext_vector_type(4)));
typedef GAS unsigned gu32;
#define RLX_AGENT __ATOMIC_RELAXED, __HIP_MEMORY_SCOPE_AGENT
#define LDS_WAIT() asm volatile("s_waitcnt lgkmcnt(0)" ::: "memory")
#define VM_WAIT() asm volatile("s_waitcnt vmcnt(0)" ::: "memory")
__device__ __forceinline__ unsigned f2bf(float f) { unsigned u = __builtin_bit_cast(unsigned, f); return (u + 0x7fffu + ((u >> 16) & 1u)) >> 16; }
__device__ __forceinline__ unsigned pk2(float lo, float hi) { return f2bf(lo) | (f2bf(hi) << 16); }
__device__ __forceinline__ float bflo(unsigned w) { return __builtin_bit_cast(float, w << 16); }
__device__ __forceinline__ float bfhi(unsigned w) { return __builtin_bit_cast(float, w & 0xffff0000u); }
__device__ __forceinline__ float bf2f(bf16 h) { return __builtin_bit_cast(float, (unsigned)h << 16); }
__device__ __forceinline__ unsigned f2u(float x) { return __builtin_bit_cast(unsigned, x); }
__device__ __forceinline__ float u2f(unsigned x) { return __builtin_bit_cast(float, x); }
__device__ __forceinline__ float dot2bf(unsigned a, unsigned b, float acc) { typedef __bf16 bf2_ __attribute__((ext_vector_type(2))); return __builtin_amdgcn_fdot2_f32_bf16(__builtin_bit_cast(bf2_, a), __builtin_bit_cast(bf2_, b), acc, false); }
__device__ __forceinline__ float wave_sum(float v) {
#pragma unroll
    for (int o = 1; o < 64; o <<= 1) v += __shfl_xor(v, o);
    return v;
}
__device__ __forceinline__ float wave_max(float v) {
#pragma unroll
    for (int o = 1; o < 64; o <<= 1) v = fmaxf(v, __shfl_xor(v, o));
    return v;
}
__device__ __forceinline__ float silu_f(float x) { return x / (1.f + __expf(-x)); }
__device__ __forceinline__ float sigmoid_f(float x) { return 1.f / (1.f + __expf(-x)); }
__device__ __forceinline__ float logsigmoid_f(float x) { return fminf(x, 0.f) - log1pf(__expf(-fabsf(x))); }
struct Args { const float* in[24]; float* out; unsigned char* ws; int ph_lo, ph_hi; };
#define XB_TMO      128
#define XB_XCNT(j)  (256  + 64 * (j))
#define XB_XSUB(j)  (1280 + 64 * (j))
#define XB_XGEN(j)  (2304 + 64 * (j))
#define XB_TOP      3328
#define XB_TOPGEN   3392
#define XCD_BAR_WORDS 3456
#define XB_SPIN_CAP (1u << 18)

__device__ __forceinline__ unsigned xb_ld(unsigned* p)              { return __hip_atomic_load(p, __ATOMIC_RELAXED, __HIP_MEMORY_SCOPE_AGENT); }
__device__ __forceinline__ unsigned xb_add(unsigned* p, unsigned v) { return __hip_atomic_fetch_add(p, v, __ATOMIC_RELAXED, __HIP_MEMORY_SCOPE_AGENT); }
__device__ __forceinline__ unsigned xb_xcc_id() { return (unsigned)__builtin_amdgcn_s_getreg((3 << 11) | 20) & 0xFu; }
#define XB_SPIN(cond, bar) do { unsigned _sp = 0; while (cond) { __builtin_amdgcn_s_sleep(1); \
    if ((++_sp & 255u) == 0u) { if (xb_ld(&(bar)[XB_TMO])) break; if (_sp > XB_SPIN_CAP) { atomicAdd(&(bar)[XB_TMO], 1u); break; } } } } while (0)

struct XcdBarrier {
    unsigned* bar; unsigned x;
    volatile LAS unsigned* st;
};

__device__ __forceinline__ XcdBarrier xcd_barrier_post(unsigned* bar, volatile LAS unsigned* st) {
    XcdBarrier b; b.bar = bar; b.x = xb_xcc_id(); b.st = st;
    if (threadIdx.x == 0) (void)xb_add(&bar[XB_XCNT(b.x)], 1u);
    return b;
}
__device__ __forceinline__ void xcd_barrier_complete(unsigned* bar, unsigned x, unsigned& nloc, unsigned& nx) {
    const unsigned G = gridDim.x * gridDim.y * gridDim.z;
    unsigned sum, cnt, mine, sp = 0u;
    for (;;) {
        sum = 0u; cnt = 0u; mine = 0u;
#pragma unroll
        for (unsigned j = 0; j < 16; ++j) { const unsigned c = xb_ld(&bar[XB_XCNT(j)]); sum += c; cnt += (c > 0u) ? 1u : 0u; mine = (j == x) ? c : mine; }
        if (sum == G) break;
        __builtin_amdgcn_s_sleep(1);
        if ((++sp & 255u) == 0u) { if (xb_ld(&bar[XB_TMO])) break; if (sp > XB_SPIN_CAP) { atomicAdd(&bar[XB_TMO], 1u); break; } }
    }
    nloc = mine > 0u ? mine : 1u; nx = cnt > 0u ? cnt : 1u;
}

__device__ __forceinline__ void xcd_barrier(const XcdBarrier& b) {
    asm volatile("s_waitcnt vmcnt(0)" ::: "memory");
    __syncthreads();
    if (threadIdx.x == 0) {
        unsigned* bar = b.bar;
        __builtin_amdgcn_s_waitcnt(0);
        unsigned nloc = b.st[0], nx = b.st[1];
        if (nloc == 0u) { xcd_barrier_complete(bar, b.x, nloc, nx); b.st[0] = nloc; b.st[1] = nx; }
        const unsigned old = xb_add(&bar[XB_XSUB(b.x)], 1u);
        const unsigned gen = old / nloc;
        if (old + 1u == (gen + 1u) * nloc) {
            __builtin_amdgcn_fence(__ATOMIC_RELEASE, "agent");
            asm volatile("s_waitcnt vmcnt(0)" ::: "memory");
            const unsigned og = xb_add(&bar[XB_TOP], 1u);
            const unsigned tg = og / nx;
            if (og + 1u == (tg + 1u) * nx) xb_add(&bar[XB_TOPGEN], 1u);
            else XB_SPIN(xb_ld(&bar[XB_TOPGEN]) == tg, bar);
            __builtin_amdgcn_fence(__ATOMIC_ACQUIRE, "agent");
            xb_add(&bar[XB_XGEN(b.x)], 1u);
            asm volatile("s_waitcnt vmcnt(0)" ::: "memory");
        } else {
            XB_SPIN(xb_ld(&bar[XB_XGEN(b.x)]) == gen, bar);
            __builtin_amdgcn_fence(__ATOMIC_ACQUIRE, "agent");
            asm volatile("s_waitcnt vmcnt(0)" ::: "memory");
        }
    }
    __syncthreads();
}
struct Frame {
    LAS unsigned char* lds;
    int tid, lane, wave, G, bid;
    float* out; unsigned char* ws;
};
#define WSP(T, off) ((T*)(F.ws + (off)))

__device__ __forceinline__ void p0_transpose_item(const float* W, int K, int ldw, int nblk, int thr, int shift, bf16* WT, LAS float* scr, int item, int lane) {
    const int kb = item / nblk, nb = item % nblk, k0 = 64 * kb, n0 = 32 * nb, ns = n0 + (n0 >= thr ? shift : 0);
#pragma unroll 8
    for (int i = 0; i < 32; ++i) { const int kk = 2 * i + (lane >> 5); scr[kk * 33 + (lane & 31)] = W[(size_t)(k0 + kk) * ldw + ns + (lane & 31)]; }
    LDS_WAIT(); asm volatile("" ::: "memory");
    const int c = lane & 7;
#pragma unroll
    for (int j = 0; j < 4; ++j) { const int n = (lane >> 3) + 8 * j; const LAS float* s = scr + (8 * c) * 33 + n;
        v4u o; o.x = pk2(s[0 * 33], s[1 * 33]); o.y = pk2(s[2 * 33], s[3 * 33]); o.z = pk2(s[4 * 33], s[5 * 33]); o.w = pk2(s[6 * 33], s[7 * 33]);
        *(GAS v4u*)(WT + (size_t)(n0 + n) * K + k0 + 8 * c) = o; }
    LDS_WAIT(); asm volatile("" ::: "memory");
}
__device__ __forceinline__ void cvt_f32_bf16_stream(const float* src, bf16* dst, size_t n8, size_t gtid, size_t gthreads) {
    for (size_t i = gtid; i < n8; i += gthreads) {
        const f32x4 a = *(const GAS f32x4*)(src + i * 8), b = *(const GAS f32x4*)(src + i * 8 + 4);
        v4u o; o.x = pk2(a.x, a.y); o.y = pk2(a.z, a.w); o.z = pk2(b.x, b.y); o.w = pk2(b.z, b.w);
        *(GAS v4u*)(dst + i * 8) = o; }
}
__device__ __forceinline__ void p0_prologue(Frame& F, const Args& A) {
    {
        const float* c = A.in[1]; const float* aw = A.in[2]; const float* ab = A.in[3]; float* MOD = WSP(float, WS_MOD);
        LAS float* red = (LAS float*)F.lds;
        for (int item = F.bid; item < 192; item += F.G) {
            const int l = item / 96, n0 = (item % 96) * 64;
            float acc[4] = {0.f, 0.f, 0.f, 0.f};
            const int kbeg = F.wave * 128;
#pragma unroll 4
            for (int k = kbeg; k < kbeg + 128; ++k) {
                const float wv = aw[((size_t)l * 1024 + k) * 6144 + n0 + F.lane];
#pragma unroll
                for (int b = 0; b < 4; ++b) acc[b] += silu_f(c[b * 1024 + k]) * wv;
            }
#pragma unroll
            for (int b = 0; b < 4; ++b) red[(F.wave * 4 + b) * 64 + F.lane] = acc[b];
            __syncthreads();
            if (F.tid < 256) { const int b = F.tid >> 6, ln = F.tid & 63; float s = ab[l * 6144 + n0 + ln];
#pragma unroll
                for (int w = 0; w < 8; ++w) s += red[(w * 4 + b) * 64 + ln];
                MOD[(size_t)(l * 4 + b) * 6144 + n0 + ln] = s; }
            __syncthreads();
        }
    }
    {
        LAS float* scr = (LAS float*)(F.lds + F.wave * 8704);
        const int gw = F.bid * NWAVES + F.wave, NGW = F.G * NWAVES;
        constexpr int I_IN0 = 16 * (NZ0 / 32), I_OUT = 16 * 32, I_IN1 = 16 * (NZ1 / 32), I_Q = 16 * (NQ / 32);
        constexpr int NITEMS = I_IN0 + 2 * I_OUT + I_IN1 + 2 * I_Q;
        for (int it = gw; it < NITEMS; it += NGW) {
            int r = it;
            if (r < I_IN0) { p0_transpose_item(A.in[6], D, SRC_IN0, NZ0 / 32, 2048, 8, WSP(bf16, WS_WIN0), scr, r, F.lane); continue; } r -= I_IN0;
            if (r < I_OUT) { p0_transpose_item(A.in[13], D, D, 32, 1 << 30, 0, WSP(bf16, WS_WOUT0), scr, r, F.lane); continue; } r -= I_OUT;
            if (r < I_IN1) { p0_transpose_item(A.in[14], D, NZ1, NZ1 / 32, 1 << 30, 0, WSP(bf16, WS_WIN1), scr, r, F.lane); continue; } r -= I_IN1;
            if (r < I_OUT) { p0_transpose_item(A.in[19], D, D, 32, 1 << 30, 0, WSP(bf16, WS_WOUT1), scr, r, F.lane); continue; } r -= I_OUT;
            if (r < I_Q) { p0_transpose_item(A.in[20], D, NQ, NQ / 32, 1 << 30, 0, WSP(bf16, WS_WQ), scr, r, F.lane); continue; } r -= I_Q;
            p0_transpose_item(A.in[20] + (size_t)D * NQ, D, NQ, NQ / 32, 1 << 30, 0, WSP(bf16, WS_WQ) + (size_t)NQ * D, scr, r, F.lane);
        }
    }
    {
        const size_t gtid = (size_t)F.bid * NTHR + F.tid, gth = (size_t)F.G * NTHR;
        cvt_f32_bf16_stream(A.in[21], WSP(bf16, WS_KEYS), (size_t)2 * 2 * 128 * 128 / 8, gtid, gth);
        cvt_f32_bf16_stream(A.in[22], WSP(bf16, WS_UB), (size_t)2 * 16384 * 1024 / 8, gtid, gth);
        cvt_f32_bf16_stream(A.in[23], WSP(bf16, WS_VB), (size_t)2 * 16384 * 1024 / 8, gtid, gth);
    }
}

template <bool GATES>
__device__ __forceinline__ void norm_pass(Frame& F, const Args& A, const float* X, const float* g, const float* mod, int shc, bf16* XN) {
    LAS float* wgT = (LAS float*)F.lds;
    if (GATES) {
        const float* win = A.in[6];
        for (int i = F.tid; i < 8 * 1024; i += NTHR) { const int cg = i >> 10, k = i & 1023; wgT[i] = win[(size_t)k * SRC_IN0 + 2048 + cg]; }
        __syncthreads();
    }
    const int gw = F.bid * NWAVES + F.wave, NGW = F.G * NWAVES;
    for (int row = gw; row < M; row += NGW) {
        const int b = row >> 13;
        const GAS f32x4* xr = (const GAS f32x4*)(X + (size_t)row * D) + F.lane;
        f32x4 v[4]; float ss = 0.f;
#pragma unroll
        for (int j = 0; j < 4; ++j) { v[j] = xr[64 * j]; ss += (v[j].x * v[j].x + v[j].y * v[j].y) + (v[j].z * v[j].z + v[j].w * v[j].w); }
        const float rstd = rsqrtf(wave_sum(ss) * (1.f / D) + EPS);
        const float* shp = mod + (size_t)b * 6144 + shc * 1024; const float* scp = shp + 1024;
#pragma unroll
        for (int j = 0; j < 4; ++j) { const int c = 4 * F.lane + 256 * j;
            const f32x4 gg = *(const f32x4*)(g + c), sc = *(const f32x4*)(scp + c), sh = *(const f32x4*)(shp + c);
            v[j] = v[j] * rstd * gg * (sc + 1.f) + sh;
            v2u o; o.x = pk2(v[j].x, v[j].y); o.y = pk2(v[j].z, v[j].w);
            *(GAS v2u*)(XN + (size_t)row * D + c) = o; }
        if (GATES) {
            float* GT = WSP(float, WS_GATES);
#pragma unroll
            for (int cg = 0; cg < 8; ++cg) { float p = 0.f;
#pragma unroll
                for (int j = 0; j < 4; ++j) { const f32x4 w = *(const LAS f32x4*)(wgT + cg * 1024 + 4 * F.lane + 256 * j); p += (v[j].x * w.x + v[j].y * w.y) + (v[j].z * w.z + v[j].w * w.w); }
                p = wave_sum(p);
                if (F.lane == 0) GT[(size_t)row * 8 + cg] = p + (cg < 4 ? A.in[8][cg] : A.in[9][cg - 4]); }
        }
    }
}

__device__ __forceinline__ void qknorm_unit(Frame& F, bf16* Z, int ldz, int row0, int col0, const float* g, float* kmean  ) {
    const int c = col0 + 8 * F.lane, d0 = (8 * F.lane) & 63;
    float gv[8];
#pragma unroll
    for (int i = 0; i < 8; ++i) gv[i] = g[d0 + i];
    float ks[8] = {0.f, 0.f, 0.f, 0.f, 0.f, 0.f, 0.f, 0.f};
    for (int r = 0; r < 32; ++r) {
        bf16* p = Z + (size_t)(row0 + F.wave * 32 + r) * ldz + c;
        const v4u w = *(const GAS v4u*)p;
        float x[8] = {bflo(w.x), bfhi(w.x), bflo(w.y), bfhi(w.y), bflo(w.z), bfhi(w.z), bflo(w.w), bfhi(w.w)};
        float ss = 0.f;
#pragma unroll
        for (int i = 0; i < 8; ++i) ss += x[i] * x[i];
        ss += __shfl_xor(ss, 1); ss += __shfl_xor(ss, 2); ss += __shfl_xor(ss, 4);
        const float rstd = rsqrtf(ss * (1.f / 64.f) + EPS);
#pragma unroll
        for (int i = 0; i < 8; ++i) { x[i] = x[i] * rstd * gv[i]; ks[i] += x[i]; }
        v4u o; o.x = pk2(x[0], x[1]); o.y = pk2(x[2], x[3]); o.z = pk2(x[4], x[5]); o.w = pk2(x[6], x[7]);
        *(GAS v4u*)p = o;
    }
    if (kmean) {
        LAS float* red = (LAS float*)F.lds;
#pragma unroll
        for (int i = 0; i < 8; ++i) red[F.wave * 512 + 8 * F.lane + i] = ks[i];
        __syncthreads();
        { float s = 0.f;
#pragma unroll
          for (int w = 0; w < 8; ++w) s += red[w * 512 + F.tid];
          kmean[(size_t)(F.tid >> 6) * (32 * 64) + (F.tid & 63)] = s * (1.f / 256.f); }
        __syncthreads();
    }
}
constexpr int KSTRB = 144;
template <int DV> struct VStr { static constexpr int B = (DV == 64) ? 192 : 320; };
typedef short v4i16_t __attribute__((ext_vector_type(4)));
__device__ __forceinline__ s16x4 vtr(const LAS unsigned char* p) { return __builtin_bit_cast(s16x4, __builtin_amdgcn_ds_read_tr16_b64_v4i16((LAS v4i16_t*)p)); }
__device__ __forceinline__ unsigned cvtpk(float lo, float hi) { typedef float f2 __attribute__((ext_vector_type(2))); typedef __bf16 b2 __attribute__((ext_vector_type(2)));
    f2 v = {lo, hi}; b2 b = __builtin_convertvector(v, b2); return __builtin_bit_cast(unsigned, b); }
__device__ __forceinline__ float xhalf(float v) {
    auto rr = __builtin_amdgcn_permlane32_swap(__builtin_bit_cast(unsigned, v), __builtin_bit_cast(unsigned, v), false, false);
    const unsigned r0 = rr[0], r1 = rr[1]; return u2f((threadIdx.x & 32) ? r0 : r1);
}
template <int DV> struct AttnSt { f32x16 o[DV / 32]; float m, l; };
template <int DV> __device__ __forceinline__ void attn_init(AttnSt<DV>& st) {
#pragma unroll
    for (int t = 0; t < DV / 32; ++t)
#pragma unroll
        for (int r = 0; r < 16; ++r) st.o[t][r] = 0.f;
    st.m = -1e30f; st.l = 0.f;
}
template <int DV>
__device__ __forceinline__ void attn_tile(AttnSt<DV>& st, const LAS unsigned char* Kt, const LAS unsigned char* Vt, const bf16x8 (&qf)[4], float sc2, float sl2, int tq, int kt0, bool diag, bool rowok, int lane) {
    const int r32 = lane & 31, hi = lane >> 5;
    f32x16 s0, s1;
#pragma unroll
    for (int r = 0; r < 16; ++r) { s0[r] = 0.f; s1[r] = 0.f; }
    const LAS unsigned char* kp = Kt + r32 * KSTRB + hi * 16;
#pragma unroll
    for (int ks = 0; ks < 4; ++ks) {
        const bf16x8 k0 = *(const LAS bf16x8*)(kp + ks * 32), k1 = *(const LAS bf16x8*)(kp + 32 * KSTRB + ks * 32);
        s0 = __builtin_amdgcn_mfma_f32_32x32x16_bf16(k0, qf[ks], s0, 0, 0, 0);
        s1 = __builtin_amdgcn_mfma_f32_32x32x16_bf16(k1, qf[ks], s1, 0, 0, 0);
    }
    const int kb = kt0 + 4 * hi;
    const float c0 = -sl2 * (float)(tq - kb);
    float mx = -INFINITY;
#pragma unroll
    for (int r = 0; r < 16; ++r) {
        const int ko = (r & 3) + 8 * (r >> 2);
        float a = s0[r] * sc2 + (c0 + sl2 * (float)ko), b = s1[r] * sc2 + (c0 + sl2 * (float)(ko + 32));
        if (diag) { if (kb + ko > tq) a = -INFINITY; if (kb + ko + 32 > tq) b = -INFINITY; }
        if (!rowok) { a = -INFINITY; b = -INFINITY; }
        s0[r] = a; s1[r] = b; mx = fmaxf(mx, fmaxf(a, b));
    }
    mx = fmaxf(mx, xhalf(mx));
    const float mn = fmaxf(st.m, mx);
    const float alpha = __builtin_amdgcn_exp2f(st.m - mn);
    st.m = mn;
    float ps = 0.f;
#pragma unroll
    for (int r = 0; r < 16; ++r) { s0[r] = __builtin_amdgcn_exp2f(s0[r] - mn); s1[r] = __builtin_amdgcn_exp2f(s1[r] - mn); ps += s0[r] + s1[r]; }
    st.l = st.l * alpha + ps;
#pragma unroll
    for (int t = 0; t < DV / 32; ++t)
#pragma unroll
        for (int r = 0; r < 16; ++r) st.o[t][r] *= alpha;
    bf16x8 pf[2][2];
#pragma unroll
    for (int s = 0; s < 2; ++s) {
        v4u a, b;
        a.x = cvtpk(s0[8 * s + 0], s0[8 * s + 1]); a.y = cvtpk(s0[8 * s + 2], s0[8 * s + 3]); a.z = cvtpk(s0[8 * s + 4], s0[8 * s + 5]); a.w = cvtpk(s0[8 * s + 6], s0[8 * s + 7]);
        b.x = cvtpk(s1[8 * s + 0], s1[8 * s + 1]); b.y = cvtpk(s1[8 * s + 2], s1[8 * s + 3]); b.z = cvtpk(s1[8 * s + 4], s1[8 * s + 5]); b.w = cvtpk(s1[8 * s + 6], s1[8 * s + 7]);
        pf[0][s] = __builtin_bit_cast(bf16x8, a); pf[1][s] = __builtin_bit_cast(bf16x8, b);
    }
    constexpr int VS = VStr<DV>::B;
    const int g = lane >> 4, i16 = lane & 15;
    const LAS unsigned char* vp = Vt + (4 * (g >> 1) + (i16 >> 2)) * VS + (16 * (g & 1) + 4 * (i16 & 3)) * 2;
#pragma unroll
    for (int kbk = 0; kbk < 2; ++kbk)
#pragma unroll
        for (int s = 0; s < 2; ++s)
#pragma unroll
            for (int t = 0; t < DV / 32; ++t) {
                const s16x4 lo = vtr(vp + (kbk * 32 + 16 * s) * VS + t * 64), h8 = vtr(vp + (kbk * 32 + 16 * s + 8) * VS + t * 64);
                const bf16x8 va = {lo[0], lo[1], lo[2], lo[3], h8[0], h8[1], h8[2], h8[3]};
                st.o[t] = __builtin_amdgcn_mfma_f32_32x32x16_bf16(va, pf[kbk][s], st.o[t], 0, 0, 0);
            }
}
template <int NK, int DV> struct TileRegs { v4u k[NK]; v4u v[DV / 64]; };
template <int NK, int DV>
__device__ __forceinline__ void tile_load(TileRegs<NK, DV>& R, const bf16* Z, int ldz, size_t zrow0, int kcol, int vcol, int tid) {
#pragma unroll
    for (int i = 0; i < NK; ++i) { const int ch = tid + 512 * i; const int row = ch / (8 * NK), cc = ch % (8 * NK);
        R.k[i] = *(const GAS v4u*)(Z + (zrow0 + row) * ldz + kcol + cc * 8); }
#pragma unroll
    for (int i = 0; i < DV / 64; ++i) { const int ch = tid + 512 * i; const int row = ch / (DV / 8), cc = ch % (DV / 8);
        R.v[i] = *(const GAS v4u*)(Z + (zrow0 + row) * ldz + vcol + cc * 8); }
}
template <int NK, int DV>
__device__ __forceinline__ void tile_store(const TileRegs<NK, DV>& R, LAS unsigned char* Kt  , LAS unsigned char* Vt, int tid) {
#pragma unroll
    for (int i = 0; i < NK; ++i) { const int ch = tid + 512 * i; const int row = ch / (8 * NK), cc = ch % (8 * NK);
        *(LAS v4u*)(Kt + (cc >> 3) * (64 * KSTRB) + row * KSTRB + (cc & 7) * 16) = R.k[i]; }
#pragma unroll
    for (int i = 0; i < DV / 64; ++i) { const int ch = tid + 512 * i; const int row = ch / (DV / 8), cc = ch % (DV / 8);
        *(LAS v4u*)(Vt + row * VStr<DV>::B + cc * 16) = R.v[i]; }
}
__device__ __forceinline__ void moba_unit(Frame& F, int b, int h, int j) {
    const bf16* Z = WSP(bf16, WS_Z); constexpr int ldz = NZ0;
    const int lane = F.lane, w = F.wave, r32 = lane & 31, hi = lane >> 5, tid = F.tid;
    const size_t rowb = (size_t)b * SEQ;
    const int qpos = j * 256 + w * 32 + r32;
    const int qcol = 2048 + h * 64, kcol = 2560 + h * 64, vcol = 3072 + h * 64;
    LAS unsigned char* lds = F.lds;
    constexpr int BUFB = 64 * KSTRB + 64 * VStr<64>::B;
    LAS unsigned char* kmh = lds + 2 * BUFB;
    LAS unsigned char* kml = lds + 2 * BUFB + 32 * KSTRB;
    LAS unsigned* msk = (LAS unsigned*)(lds + 2 * BUFB + 64 * KSTRB);
    { const float* KM = WSP(float, WS_KMEAN) + (size_t)((b * 8 + h) * 32) * 64; const f32x4 x = *(const f32x4*)(KM + 4 * tid);
      const int n = tid >> 4, d0 = (tid & 15) * 4;
      const unsigned h0 = f2bf(x.x), h1 = f2bf(x.y), h2 = f2bf(x.z), h3 = f2bf(x.w);
      v2u hv; hv.x = h0 | (h1 << 16); hv.y = h2 | (h3 << 16);
      v2u lv; lv.x = pk2(x.x - u2f(h0 << 16), x.y - u2f(h1 << 16)); lv.y = pk2(x.z - u2f(h2 << 16), x.w - u2f(h3 << 16));
      *(LAS v2u*)(kmh + n * KSTRB + d0 * 2) = hv; *(LAS v2u*)(kml + n * KSTRB + d0 * 2) = lv; }
    if (tid < 16) msk[tid] = 0u;
    bf16x8 qf[4];
    const bf16* qrow = Z + (rowb + qpos) * ldz + qcol;
#pragma unroll
    for (int ks = 0; ks < 4; ++ks) qf[ks] = *(const GAS bf16x8*)(qrow + 16 * ks + 8 * hi);
    __syncthreads();
    f32x16 gt;
#pragma unroll
    for (int r = 0; r < 16; ++r) gt[r] = 0.f;
#pragma unroll
    for (int ks = 0; ks < 4; ++ks) {
        const bf16x8 a = *(const LAS bf16x8*)(kmh + r32 * KSTRB + hi * 16 + ks * 32), c = *(const LAS bf16x8*)(kml + r32 * KSTRB + hi * 16 + ks * 32);
        gt = __builtin_amdgcn_mfma_f32_32x32x16_bf16(a, qf[ks], gt, 0, 0, 0);
        gt = __builtin_amdgcn_mfma_f32_32x32x16_bf16(c, qf[ks], gt, 0, 0, 0);
    }
    float t0 = -INFINITY, t1 = -INFINITY, t2 = -INFINITY;
#define INS3(key) do { float k_ = (key); float a_ = fmaxf(t0, k_), l_ = fminf(t0, k_); t0 = a_; a_ = fmaxf(t1, l_); l_ = fminf(t1, l_); t1 = a_; t2 = fmaxf(t2, l_); } while (0)
#pragma unroll
    for (int r = 0; r < 16; ++r) { const int n = (r & 3) + 8 * (r >> 2) + 4 * hi;
        const float key = (n < j) ? u2f((f2u(gt[r]) & ~31u) | (unsigned)n) : -INFINITY; INS3(key); }
    { const float p0 = xhalf(t0), p1 = xhalf(t1), p2 = xhalf(t2); INS3(p0); INS3(p1); INS3(p2); }
#undef INS3
    const int sel0 = (t0 > -INFINITY) ? (int)(f2u(t0) & 31u) : -1;
    const int sel1 = (t1 > -INFINITY) ? (int)(f2u(t1) & 31u) : -1;
    const int sel2 = (t2 > -INFINITY) ? (int)(f2u(t2) & 31u) : -1;
    { const unsigned mm = (sel0 >= 0 ? 1u << sel0 : 0u) | (sel1 >= 0 ? 1u << sel1 : 0u) | (sel2 >= 0 ? 1u << sel2 : 0u);
      if (mm) { __hip_atomic_fetch_or(msk + w, mm, __ATOMIC_RELAXED, __HIP_MEMORY_SCOPE_WORKGROUP); __hip_atomic_fetch_or(msk + 8, mm, __ATOMIC_RELAXED, __HIP_MEMORY_SCOPE_WORKGROUP); } }
    __syncthreads();
    const unsigned bmask = msk[8]; const unsigned wmask = (unsigned)__builtin_amdgcn_readfirstlane((int)msk[w]);
    const float sl2 = ldexpf(1.f, -(h + 1)) * LOG2E, sc2 = 0.125f * LOG2E;
    AttnSt<64> st; attn_init<64>(st);
    unsigned rem = bmask;
    int blk = rem ? __builtin_ctz(rem) : j; if (rem) rem &= rem - 1;
    int kt = 0, buf = 0;
    TileRegs<1, 64> R;
    tile_load<1, 64>(R, Z, ldz, rowb + blk * 256 + kt * 64, kcol, vcol, tid);
    tile_store<1, 64>(R, lds, lds + 64 * KSTRB, tid);
    __syncthreads();
    for (;;) {
        int nblk = blk, nkt = kt + 1; bool has_next = true;
        if (nkt == 4) { nkt = 0; if (blk == j) has_next = false; else if (rem) { nblk = __builtin_ctz(rem); rem &= rem - 1; } else nblk = j; }
        if (has_next) tile_load<1, 64>(R, Z, ldz, rowb + nblk * 256 + nkt * 64, kcol, vcol, tid);
        const bool own = (blk == j);
        const bool active = own ? (kt * 64 <= w * 32 + 31) : (((wmask >> blk) & 1u) != 0u);
        if (active) {
            const bool rowok = own || blk == sel0 || blk == sel1 || blk == sel2;
            const bool diag = own && (kt * 64 + 63 > w * 32);
            attn_tile<64>(st, lds + buf * BUFB, lds + buf * BUFB + 64 * KSTRB, qf, sc2, sl2, qpos, blk * 256 + kt * 64, diag, rowok, lane);
        }
        if (!has_next) break;
        tile_store<1, 64>(R, lds + (buf ^ 1) * BUFB, lds + (buf ^ 1) * BUFB + 64 * KSTRB, tid);
        __syncthreads();
        buf ^= 1; blk = nblk; kt = nkt;
    }
    const float inv = 1.f / (st.l + xhalf(st.l));
    bf16* Y = WSP(bf16, WS_XNY) + (rowb + qpos) * 1024 + 512 + h * 64;
#pragma unroll
    for (int t = 0; t < 2; ++t)
#pragma unroll
        for (int rg = 0; rg < 4; ++rg) { v2u o; o.x = pk2(st.o[t][4 * rg] * inv, st.o[t][4 * rg + 1] * inv); o.y = pk2(st.o[t][4 * rg + 2] * inv, st.o[t][4 * rg + 3] * inv);
            *(GAS v2u*)(Y + t * 32 + 8 * rg + 4 * hi) = o; }
    __syncthreads();
}

__device__ __forceinline__ void diff_unit(Frame& F, const Args& A, int b, int h, int qt, float lam) {
    const bf16* Z = WSP(bf16, WS_Z); constexpr int ldz = NZ1;
    const int lane = F.lane, w = F.wave, r32 = lane & 31, hi = lane >> 5, tid = F.tid;
    const int comp = w >> 2, wq = w & 3;
    const size_t rowb = (size_t)b * SEQ;
    const int q0 = qt * 128, qpos = q0 + wq * 32 + r32;
    const int qcol = h * 128 + comp * 64, kcol = 1024 + h * 128, vcol = 2048 + h * 128;
    LAS unsigned char* lds = F.lds;
    constexpr int BUFB = 2 * 64 * KSTRB + 64 * VStr<128>::B;
    bf16x8 qf[4];
    const bf16* qrow = Z + (rowb + qpos) * ldz + qcol;
#pragma unroll
    for (int ks = 0; ks < 4; ++ks) qf[ks] = *(const GAS bf16x8*)(qrow + 16 * ks + 8 * hi);
    const float sl2 = ldexpf(1.f, -(h + 1)) * LOG2E, sc2 = 0.125f * LOG2E;
    AttnSt<128> st; attn_init<128>(st);
    const int nt = (q0 + 128) / 64;
    TileRegs<2, 128> R;
    tile_load<2, 128>(R, Z, ldz, rowb, kcol, vcol, tid);
    tile_store<2, 128>(R, lds, lds + 2 * 64 * KSTRB, tid);
    __syncthreads();
    int buf = 0;
    for (int kt = 0; kt < nt; ++kt) {
        const bool has_next = kt + 1 < nt;
        if (has_next) tile_load<2, 128>(R, Z, ldz, rowb + (size_t)(kt + 1) * 64, kcol, vcol, tid);
        if (kt * 64 <= q0 + wq * 32 + 31) {
            const bool diag = kt * 64 + 63 > q0 + wq * 32;
            attn_tile<128>(st, lds + buf * BUFB + comp * (64 * KSTRB), lds + buf * BUFB + 2 * 64 * KSTRB, qf, sc2, sl2, qpos, kt * 64, diag, true, lane);
        }
        if (has_next) { tile_store<2, 128>(R, lds + (buf ^ 1) * BUFB, lds + (buf ^ 1) * BUFB + 2 * 64 * KSTRB, tid); }
        __syncthreads();
        buf ^= 1;
    }
    const float inv = 1.f / (st.l + xhalf(st.l));
    LAS float* o2 = (LAS float*)lds;
    if (comp == 1) {
#pragma unroll
        for (int t = 0; t < 4; ++t)
#pragma unroll
            for (int r = 0; r < 16; ++r) o2[((wq * 4 + t) * 16 + r) * 64 + lane] = st.o[t][r] * inv;
    }
    __syncthreads();
    if (comp == 0) {
        float ss = 0.f;
#pragma unroll
        for (int t = 0; t < 4; ++t)
#pragma unroll
            for (int r = 0; r < 16; ++r) { const float v = st.o[t][r] * inv - lam * o2[((wq * 4 + t) * 16 + r) * 64 + lane]; st.o[t][r] = v; ss += v * v; }
        ss += xhalf(ss);
        const float rs = rsqrtf(ss * (1.f / 128.f) + EPS) * 0.6444909324090307f;
        const float* og = A.in[18];
        bf16* Y = WSP(bf16, WS_XNY) + (rowb + qpos) * 1024 + h * 128;
#pragma unroll
        for (int t = 0; t < 4; ++t)
#pragma unroll
            for (int rg = 0; rg < 4; ++rg) { const int dv = t * 32 + 8 * rg + 4 * hi; const f32x4 gg = *(const f32x4*)(og + dv);
                v2u o; o.x = pk2(st.o[t][4 * rg] * rs * gg.x, st.o[t][4 * rg + 1] * rs * gg.y); o.y = pk2(st.o[t][4 * rg + 2] * rs * gg.z, st.o[t][4 * rg + 3] * rs * gg.w);
                *(GAS v2u*)(Y + dv) = o; }
    }
    __syncthreads();
}
template <int MT, int NT>
__device__ __forceinline__ void mma_nt(const LAS unsigned char* A, int lda, const LAS unsigned char* B, int ldb, int K, f32x4 (&acc)[MT][NT], int lane) {
    const int r = lane & 15, kq = (lane >> 4) * 16;
    for (int k0 = 0; k0 < K; k0 += 32) {
        bf16x8 a[MT], bb[NT];
#pragma unroll
        for (int m = 0; m < MT; ++m) a[m] = *(const LAS bf16x8*)(A + (m * 16 + r) * lda + k0 * 2 + kq);
#pragma unroll
        for (int n = 0; n < NT; ++n) bb[n] = *(const LAS bf16x8*)(B + (n * 16 + r) * ldb + k0 * 2 + kq);
#pragma unroll
        for (int m = 0; m < MT; ++m)
#pragma unroll
            for (int n = 0; n < NT; ++n) acc[m][n] = __builtin_amdgcn_mfma_f32_16x16x32_bf16(a[m], bb[n], acc[m][n], 0, 0, 0);
    }
}
constexpr int TS = 272;
constexpr int TILEB = 128 * TS;
constexpr int ML_Q = 0, ML_K = TILEB, ML_V = 2 * TILEB, ML_SM = 3 * TILEB;

__device__ __forceinline__ void ml_gates(const float* GT, size_t row0, int hm, LAS float* sm, int lane) {
    const float i0 = GT[(row0 + 2 * lane) * 8 + hm], i1 = GT[(row0 + 2 * lane + 1) * 8 + hm];
    const float f0 = logsigmoid_f(GT[(row0 + 2 * lane) * 8 + 4 + hm]), f1 = logsigmoid_f(GT[(row0 + 2 * lane + 1) * 8 + 4 + hm]);
    float s = f0 + f1;
#pragma unroll
    for (int o = 1; o < 64; o <<= 1) { const float t = __shfl_up(s, o); if (lane >= o) s += t; }
    const float excl = s - (f0 + f1);
    sm[2 * lane] = excl + f0; sm[2 * lane + 1] = excl + f0 + f1;
    sm[128 + 2 * lane] = i0; sm[128 + 2 * lane + 1] = i1;
}
template <bool TRANSPOSE>
__device__ __forceinline__ void ml_conv_tile(const bf16* Z, size_t rowb, int t0, int zc, const float* cw, int wc, float mul, LAS unsigned char* dst, const LAS float* rs, int tid) {
#pragma unroll
    for (int it = 0; it < 4; ++it) {
        const int item = tid + 512 * it, l = item >> 4, ch = (item & 15) * 8;
        float acc[8];
#pragma unroll
        for (int i = 0; i < 8; ++i) acc[i] = 0.f;
#pragma unroll
        for (int jj = 0; jj < 4; ++jj) {
            const int t = t0 + l - 3 + jj;
            if (t >= 0) {
                const v4u w = *(const GAS v4u*)(Z + (rowb + t) * NZ0 + zc + ch);
                const float x[8] = {bflo(w.x), bfhi(w.x), bflo(w.y), bfhi(w.y), bflo(w.z), bfhi(w.z), bflo(w.w), bfhi(w.w)};
                const f32x4 c0 = *(const f32x4*)(cw + jj * 1024 + wc + ch), c1 = *(const f32x4*)(cw + jj * 1024 + wc + ch + 4);
                acc[0] += x[0] * c0.x; acc[1] += x[1] * c0.y; acc[2] += x[2] * c0.z; acc[3] += x[3] * c0.w;
                acc[4] += x[4] * c1.x; acc[5] += x[5] * c1.y; acc[6] += x[6] * c1.z; acc[7] += x[7] * c1.w;
            }
        }
        const float sc = TRANSPOSE ? mul * rs[l] : mul;
#pragma unroll
        for (int i = 0; i < 8; ++i) acc[i] = silu_f(acc[i]) * sc;
        if (TRANSPOSE) {
#pragma unroll
            for (int i = 0; i < 8; ++i) *(LAS bf16*)(dst + (ch + i) * TS + l * 2) = (bf16)f2bf(acc[i]);
        } else {
            v4u o; o.x = pk2(acc[0], acc[1]); o.y = pk2(acc[2], acc[3]); o.z = pk2(acc[4], acc[5]); o.w = pk2(acc[6], acc[7]);
            *(LAS v4u*)(dst + l * TS + ch * 2) = o;
        }
    }
}
__device__ __forceinline__ void ml_vt_tile(const bf16* Z, size_t row0, int zc, LAS unsigned char* dst, int tid) {
#pragma unroll
    for (int it = 0; it < 4; ++it) {
        const int item = tid + 512 * it, l = item >> 4, ch = (item & 15) * 8;
        const v4u w = *(const GAS v4u*)(Z + (row0 + l) * NZ0 + zc + ch);
        const unsigned ww[4] = {w.x, w.y, w.z, w.w};
#pragma unroll
        for (int i = 0; i < 4; ++i) { *(LAS bf16*)(dst + (ch + 2 * i) * TS + l * 2) = (bf16)(ww[i] & 0xffffu); *(LAS bf16*)(dst + (ch + 2 * i + 1) * TS + l * 2) = (bf16)(ww[i] >> 16); }
    }
}
__device__ __forceinline__ void mlstm_a_unit(Frame& F, const Args& A, int unit) {
    const int c = unit & 63, bh = unit >> 6, hm = bh & 3, b = bh >> 2;
    const bf16* Z = WSP(bf16, WS_Z); const float* GT = WSP(float, WS_GATES);
    const size_t rowb = (size_t)b * SEQ; const int t0 = c * 128;
    LAS unsigned char* lds = F.lds; LAS float* sm = (LAS float*)(lds + ML_SM);
    if (F.wave == 0) {
        ml_gates(GT, rowb + t0, hm, sm, F.lane);
        LDS_WAIT();
        const float bend = sm[127];
        const float w0 = bend - sm[2 * F.lane] + sm[128 + 2 * F.lane], w1 = bend - sm[2 * F.lane + 1] + sm[128 + 2 * F.lane + 1];
        const float ml = wave_max(fmaxf(w0, w1));
        sm[256 + 2 * F.lane] = __expf(w0 - ml); sm[256 + 2 * F.lane + 1] = __expf(w1 - ml);
        if (F.lane == 0) { WSP(float, WS_BEND)[unit] = bend; WSP(float, WS_MLOC)[unit] = ml; }
    }
    __syncthreads();
    ml_conv_tile<true>(Z, rowb, t0, 512 + hm * 128, A.in[7], 512 + hm * 128, 0.08838834764831845f, lds + ML_K, sm + 256, F.tid);
    ml_vt_tile(Z, rowb + t0, 1024 + hm * 128, lds + ML_V, F.tid);
    __syncthreads();
    f32x4 acc[2][4];
#pragma unroll
    for (int m = 0; m < 2; ++m)
#pragma unroll
        for (int n = 0; n < 4; ++n) acc[m][n] = (f32x4){0.f, 0.f, 0.f, 0.f};
    const int dv0 = 32 * (F.wave >> 1), dk0 = 64 * (F.wave & 1);
    mma_nt<2, 4>(lds + ML_V + dv0 * TS, TS, lds + ML_K + dk0 * TS, TS, 128, acc, F.lane);
    float* CL = WSP(float, WS_CLOC) + (size_t)unit * 16384;
#pragma unroll
    for (int m = 0; m < 2; ++m)
#pragma unroll
        for (int n = 0; n < 4; ++n)
#pragma unroll
            for (int i = 0; i < 4; ++i) CL[(size_t)(dv0 + 16 * m + 4 * (F.lane >> 4) + i) * 128 + dk0 + 16 * n + (F.lane & 15)] = acc[m][n][i];
    if (F.tid < 128) { float s = 0.f; const LAS bf16* kr = (const LAS bf16*)(lds + ML_K + F.tid * TS);
        for (int l = 0; l < 128; ++l) s += bf2f(kr[l]);
        WSP(float, WS_NLOC)[(size_t)unit * 128 + F.tid] = s; }
    __syncthreads();
}
__device__ __forceinline__ void mlstm_scan_unit(Frame& F, int unit) {
    const int bh = unit >> 4, sl = unit & 15;
    LAS float* tab = (LAS float*)F.lds;
    if (F.tid == 0) {
        const float* BE = WSP(float, WS_BEND) + bh * 64; const float* ML = WSP(float, WS_MLOC) + bh * 64; float* MP = WSP(float, WS_MPREV) + bh * 64;
        float m = 0.f;
        for (int c = 0; c < 64; ++c) { const float be = BE[c], ml = ML[c]; const float mn = fmaxf(be + m, ml);
            tab[c] = __expf(be + m - mn); tab[64 + c] = __expf(ml - mn); if (sl == 0) MP[c] = m; m = mn; }
    }
    __syncthreads();
    float* CL = WSP(float, WS_CLOC) + (size_t)bh * 64 * 16384 + sl * 1024 + 2 * F.tid;
    float s0 = 0.f, s1 = 0.f;
#pragma unroll 8
    for (int c = 0; c < 64; ++c) { float2* p = (float2*)(CL + (size_t)c * 16384); const float2 v = *p; *p = make_float2(s0, s1);
        const float a = tab[c], sc = tab[64 + c]; s0 = a * s0 + sc * v.x; s1 = a * s1 + sc * v.y; }
    if (sl == 0 && F.tid < 128) { float* NL = WSP(float, WS_NLOC) + (size_t)bh * 64 * 128 + F.tid; float s = 0.f;
        for (int c = 0; c < 64; ++c) { const float v = NL[c * 128]; NL[c * 128] = s; s = tab[c] * s + tab[64 + c] * v; } }
    __syncthreads();
}
__device__ __forceinline__ void mlstm_c_unit(Frame& F, const Args& A, int unit) {
    const int c = unit & 63, bh = unit >> 6, hm = bh & 3, b = bh >> 2;
    const bf16* Z = WSP(bf16, WS_Z); const float* GT = WSP(float, WS_GATES);
    const size_t rowb = (size_t)b * SEQ; const int t0 = c * 128;
    LAS unsigned char* lds = F.lds; LAS float* sm = (LAS float*)(lds + ML_SM);
    const int lane = F.lane, w = F.wave, tid = F.tid;
    const float mprev = WSP(float, WS_MPREV)[unit];
    if (w == 0) {
        ml_gates(GT, rowb + t0, hm, sm, lane);
        LDS_WAIT();
        const float b0 = sm[2 * lane], b1 = sm[2 * lane + 1];
        const float g0 = sm[128 + 2 * lane] - b0, g1 = sm[128 + 2 * lane + 1] - b1;
        float pm = fmaxf(g0, g1);
#pragma unroll
        for (int o = 1; o < 64; o <<= 1) { const float t = __shfl_up(pm, o); if (lane >= o) pm = fmaxf(pm, t); }
        float pe = __shfl_up(pm, 1); if (lane == 0) pe = -INFINITY;
        const float M0 = fmaxf(mprev, fmaxf(pe, g0)), M1 = fmaxf(mprev, pm);
        sm[256 + 2 * lane] = g0; sm[256 + 2 * lane + 1] = g1;
        sm[384 + 2 * lane] = M0; sm[384 + 2 * lane + 1] = M1;
        sm[512 + 2 * lane] = __expf(mprev - M0); sm[512 + 2 * lane + 1] = __expf(mprev - M1);
        sm[640 + 2 * lane] = __expf(-b0 - M0); sm[640 + 2 * lane + 1] = __expf(-b1 - M1);
        sm[768 + 2 * lane] = 0.f; sm[768 + 2 * lane + 1] = 0.f; sm[896 + 2 * lane] = 0.f; sm[896 + 2 * lane + 1] = 0.f;
    }
    if (w == 1) { sm[1152 + lane] = WSP(float, WS_NLOC)[(size_t)unit * 128 + lane]; sm[1152 + 64 + lane] = WSP(float, WS_NLOC)[(size_t)unit * 128 + 64 + lane]; }
    ml_conv_tile<false>(Z, rowb, t0, hm * 128, A.in[7], hm * 128, 1.f, lds + ML_Q, nullptr, tid);
    ml_conv_tile<false>(Z, rowb, t0, 512 + hm * 128, A.in[7], 512 + hm * 128, 0.08838834764831845f, lds + ML_K, nullptr, tid);
    ml_vt_tile(Z, rowb + t0, 1024 + hm * 128, lds + ML_V, tid);
    __syncthreads();
    const int l0 = 32 * (w >> 1), c0 = 64 * (w & 1);
    const int lr = 4 * (lane >> 4), lc = lane & 15;
    if (tid < 128) { const LAS bf16* qr = (const LAS bf16*)(lds + ML_Q + tid * TS); float s = 0.f;
        for (int d = 0; d < 128; ++d) s += bf2f(qr[d]) * sm[1152 + d];
        sm[1024 + tid] = s; }
    f32x4 acc[2][4];
#pragma unroll
    for (int m = 0; m < 2; ++m)
#pragma unroll
        for (int n = 0; n < 4; ++n) acc[m][n] = (f32x4){0.f, 0.f, 0.f, 0.f};
    mma_nt<2, 4>(lds + ML_Q + l0 * TS, TS, lds + ML_K + c0 * TS, TS, 128, acc, lane);
#pragma unroll
    for (int m = 0; m < 2; ++m)
#pragma unroll
        for (int i = 0; i < 4; ++i) { const int l = l0 + 16 * m + lr + i; const float Ml = sm[384 + l]; float rsum = 0.f;
#pragma unroll
            for (int n = 0; n < 4; ++n) { const int s = c0 + 16 * n + lc; const float v = (s <= l) ? acc[m][n][i] * __expf(sm[256 + s] - Ml) : 0.f; acc[m][n][i] = v; rsum += v; }
            rsum += __shfl_xor(rsum, 1); rsum += __shfl_xor(rsum, 2); rsum += __shfl_xor(rsum, 4); rsum += __shfl_xor(rsum, 8);
            if (lc == 0) __hip_atomic_fetch_add(sm + 768 + l, rsum, __ATOMIC_RELAXED, __HIP_MEMORY_SCOPE_WORKGROUP); }
    __syncthreads();
#pragma unroll
    for (int m = 0; m < 2; ++m)
#pragma unroll
        for (int n = 0; n < 4; ++n)
#pragma unroll
            for (int i = 0; i < 4; ++i) *(LAS bf16*)(lds + ML_K + (l0 + 16 * m + lr + i) * TS + (c0 + 16 * n + lc) * 2) = (bf16)f2bf(acc[m][n][i]);
    __syncthreads();
    f32x4 ai[2][4], ae[2][4];
#pragma unroll
    for (int m = 0; m < 2; ++m)
#pragma unroll
        for (int n = 0; n < 4; ++n) { ai[m][n] = (f32x4){0.f, 0.f, 0.f, 0.f}; ae[m][n] = (f32x4){0.f, 0.f, 0.f, 0.f}; }
    mma_nt<2, 4>(lds + ML_K + l0 * TS, TS, lds + ML_V + c0 * TS, TS, 128, ai, lane);
    {
        const float* CP = WSP(float, WS_CLOC) + (size_t)unit * 16384;
        const int r = lane & 15, kq = (lane >> 4) * 8;
        for (int k0 = 0; k0 < 128; k0 += 32) {
            bf16x8 a[2], bb[4];
#pragma unroll
            for (int m = 0; m < 2; ++m) a[m] = *(const LAS bf16x8*)(lds + ML_Q + (l0 + m * 16 + r) * TS + (k0 + kq) * 2);
#pragma unroll
            for (int n = 0; n < 4; ++n) { const float* p = CP + (size_t)(c0 + n * 16 + r) * 128 + k0 + kq; const f32x4 x = *(const f32x4*)p, y = *(const f32x4*)(p + 4);
                v4u pk; pk.x = pk2(x.x, x.y); pk.y = pk2(x.z, x.w); pk.z = pk2(y.x, y.y); pk.w = pk2(y.z, y.w); bb[n] = __builtin_bit_cast(bf16x8, pk); }
#pragma unroll
            for (int m = 0; m < 2; ++m)
#pragma unroll
                for (int n = 0; n < 4; ++n) ae[m][n] = __builtin_amdgcn_mfma_f32_16x16x32_bf16(a[m], bb[n], ae[m][n], 0, 0, 0);
        }
    }
#pragma unroll
    for (int m = 0; m < 2; ++m)
#pragma unroll
        for (int i = 0; i < 4; ++i) { const int l = l0 + 16 * m + lr + i; const float wi = sm[512 + l];
            const float den = wi * sm[1024 + l] + sm[768 + l]; const float dinv = 1.f / fmaxf(fabsf(den), sm[640 + l]); float ssq = 0.f;
#pragma unroll
            for (int n = 0; n < 4; ++n) { const float hv = (wi * ae[m][n][i] + ai[m][n][i]) * dinv; ai[m][n][i] = hv; ssq += hv * hv; }
            ssq += __shfl_xor(ssq, 1); ssq += __shfl_xor(ssq, 2); ssq += __shfl_xor(ssq, 4); ssq += __shfl_xor(ssq, 8);
            if (lc == 0) __hip_atomic_fetch_add(sm + 896 + l, ssq, __ATOMIC_RELAXED, __HIP_MEMORY_SCOPE_WORKGROUP); }
    __syncthreads();
    const float* mg = A.in[10] + hm * 128;
    bf16* Y = WSP(bf16, WS_XNY);
#pragma unroll
    for (int m = 0; m < 2; ++m)
#pragma unroll
        for (int i = 0; i < 4; ++i) { const int l = l0 + 16 * m + lr + i; const float rstd = rsqrtf(sm[896 + l] * (1.f / 128.f) + EPS); const size_t row = rowb + t0 + l;
#pragma unroll
            for (int n = 0; n < 4; ++n) { const int dv = c0 + 16 * n + lc; const float og = sigmoid_f(bf2f(Z[row * NZ0 + 1536 + hm * 128 + dv]));
                Y[row * 1024 + hm * 128 + dv] = (bf16)f2bf(ai[m][n][i] * rstd * mg[dv] * og); } }
    __syncthreads();
}
template <int N> __device__ __forceinline__ void bitonic_sort_desc(float (&v)[N]) {
#pragma unroll
    for (int k = 2; k <= N; k <<= 1)
#pragma unroll
        for (int j = k >> 1; j > 0; j >>= 1)
#pragma unroll
            for (int i = 0; i < N; ++i) { const int l = i ^ j; if (l > i) { const bool desc = ((i & k) == 0); const float a = v[i], b = v[l]; const float mx = fmaxf(a, b), mn = fminf(a, b); v[i] = desc ? mx : mn; v[l] = desc ? mn : mx; } }
}
__device__ __forceinline__ void merge_top16(float (&run)[16], const float (&nw)[16]) {
#pragma unroll
    for (int i = 0; i < 16; ++i) run[i] = fmaxf(run[i], nw[15 - i]);
#pragma unroll
    for (int j = 8; j > 0; j >>= 1)
#pragma unroll
        for (int i = 0; i < 16; ++i) { const int l = i ^ j; if (l > i) { const float a = run[i], b = run[l]; run[i] = fmaxf(a, b); run[l] = fminf(a, b); } }
}
#ifndef EXPERT_SLOW
#define EXPERT_SLOW 0
#endif
#ifndef ROUTE_SLOW
#define ROUTE_SLOW 0
#endif
constexpr int SCS = 132;
__device__ __forceinline__ void peer_route_unit(Frame& F, int tok0, int hd, const bf16* KEYS) {
    const bf16* QRY = WSP(bf16, WS_QRY); int* IDX = WSP(int, WS_IDX); float* GATE = WSP(float, WS_GATE);
    LAS float* SC = (LAS float*)F.lds;
    const int lane = F.lane, w = F.wave, tid = F.tid;
    {
        const int p = w & 1, tg = w >> 1, r = lane & 15, kq = (lane >> 4) * 8;
        f32x4 acc[2][8];
#pragma unroll
        for (int m = 0; m < 2; ++m)
#pragma unroll
            for (int n = 0; n < 8; ++n) acc[m][n] = (f32x4){0.f, 0.f, 0.f, 0.f};
#pragma unroll
        for (int k0 = 0; k0 < 128; k0 += 32) {
            bf16x8 a[2], bb[8];
#pragma unroll
            for (int m = 0; m < 2; ++m) a[m] = *(const GAS bf16x8*)(QRY + (size_t)(tok0 + 32 * tg + 16 * m + r) * NQ + hd * 256 + p * 128 + k0 + kq);
#pragma unroll
            for (int n = 0; n < 8; ++n) bb[n] = *(const GAS bf16x8*)(KEYS + (size_t)(p * 128 + 16 * n + r) * 128 + k0 + kq);
#pragma unroll
            for (int m = 0; m < 2; ++m)
#pragma unroll
                for (int n = 0; n < 8; ++n) acc[m][n] = __builtin_amdgcn_mfma_f32_16x16x32_bf16(a[m], bb[n], acc[m][n], 0, 0, 0);
        }
#pragma unroll
        for (int m = 0; m < 2; ++m)
#pragma unroll
            for (int n = 0; n < 8; ++n)
#pragma unroll
                for (int i = 0; i < 4; ++i) SC[(p * 128 + 32 * tg + 16 * m + 4 * (lane >> 4) + i) * SCS + 16 * n + r] = acc[m][n][i];
    }
    __syncthreads();
#if defined(CHECK) && CHECK
    if (tok0 == 0 && hd == 0) { float* DB = WSP(float, WS_CLOC) + 8 * 1024 * 1024; for (int i = tid; i < 2 * 128 * 128; i += NTHR) DB[i] = SC[(i >> 7) * SCS + (i & 127)]; }
    __syncthreads();
#endif
#if ROUTE_SLOW
    if (tid < 128) {
        const int t = tid;
        float s0[16], s1[16]; unsigned i0[16], i1[16];
        { const LAS float* row = SC + (0 * 128 + t) * SCS; float prev = INFINITY;
#pragma unroll
          for (int k = 0; k < 16; ++k) { float best = -INFINITY; unsigned bi = 0; for (int n = 0; n < 128; ++n) { const float v = row[n]; if (v < prev && v > best) { best = v; bi = n; } } s0[k] = best; i0[k] = bi; prev = best; } }
        { const LAS float* row = SC + (1 * 128 + t) * SCS; float prev = INFINITY;
#pragma unroll
          for (int k = 0; k < 16; ++k) { float best = -INFINITY; unsigned bi = 0; for (int n = 0; n < 128; ++n) { const float v = row[n]; if (v < prev && v > best) { best = v; bi = n; } } s1[k] = best; i1[k] = bi; prev = best; } }
        float top[16]; unsigned tid16[16];
        { float prev = INFINITY;
#pragma unroll
          for (int k = 0; k < 16; ++k) { float best = -INFINITY; unsigned be = 0;
#pragma unroll
              for (int i = 0; i < 16; ++i)
#pragma unroll
                  for (int j = 0; j < 16; ++j) if ((i + 1) * (j + 1) <= 16) { const float v = s0[i] + s1[j]; if (v < prev && v > best) { best = v; be = i0[i] * 128u + i1[j]; } }
              top[k] = best; tid16[k] = be; prev = best; } }
        float sc[16], den = 0.f;
#pragma unroll
        for (int k = 0; k < 16; ++k) { sc[k] = __expf(top[k] - top[0]); den += sc[k]; }
        const float inv = 1.f / den;
        const size_t ob = (size_t)(tok0 + t) * 128 + hd * 16;
#pragma unroll
        for (int k = 0; k < 16; ++k) { IDX[ob + k] = (int)tid16[k]; GATE[ob + k] = sc[k] * inv; }
    }
    __syncthreads();
#else
    {
        const int t = tid & 127, p = (tid >> 7) & 1, half = tid >> 8;
        LAS float* seg = SC + (p * 128 + t) * SCS + 64 * half;
        float run[16], nw[16];
#pragma unroll
        for (int ch = 0; ch < 4; ++ch) {
#pragma unroll
            for (int q = 0; q < 4; ++q) { const f32x4 v = *(const LAS f32x4*)(seg + 16 * ch + 4 * q);
#pragma unroll
                for (int e = 0; e < 4; ++e) { const unsigned n = (unsigned)(64 * half + 16 * ch + 4 * q + e); const float key = u2f((f2u(v[e]) & ~127u) | n);
                    if (ch == 0) run[4 * q + e] = key; else nw[4 * q + e] = key; } }
            if (ch == 0) bitonic_sort_desc<16>(run); else { bitonic_sort_desc<16>(nw); merge_top16(run, nw); }
        }
#pragma unroll
        for (int q = 0; q < 4; ++q) *(LAS f32x4*)(seg + 4 * q) = (f32x4){run[4 * q], run[4 * q + 1], run[4 * q + 2], run[4 * q + 3]};
    }
    __syncthreads();
    if (tid < 128) {
        const int t = tid;
        float s0[16], s1[16];
        {
            LAS float* a = SC + (0 * 128 + t) * SCS; float nw[16];
#pragma unroll
            for (int q = 0; q < 4; ++q) { const f32x4 v = *(const LAS f32x4*)(a + 4 * q), u = *(const LAS f32x4*)(a + 64 + 4 * q);
#pragma unroll
                for (int e = 0; e < 4; ++e) { s0[4 * q + e] = v[e]; nw[4 * q + e] = u[e]; } }
            merge_top16(s0, nw);
#pragma unroll
            for (int q = 0; q < 4; ++q) *(LAS f32x4*)(a + 16 + 4 * q) = (f32x4){s0[4 * q], s0[4 * q + 1], s0[4 * q + 2], s0[4 * q + 3]};
        }
        {
            LAS float* a = SC + (1 * 128 + t) * SCS; float nw[16];
#pragma unroll
            for (int q = 0; q < 4; ++q) { const f32x4 v = *(const LAS f32x4*)(a + 4 * q), u = *(const LAS f32x4*)(a + 64 + 4 * q);
#pragma unroll
                for (int e = 0; e < 4; ++e) { s1[4 * q + e] = v[e]; nw[4 * q + e] = u[e]; } }
            merge_top16(s1, nw);
#pragma unroll
            for (int q = 0; q < 4; ++q) *(LAS f32x4*)(a + 16 + 4 * q) = (f32x4){s1[4 * q], s1[4 * q + 1], s1[4 * q + 2], s1[4 * q + 3]};
        }
#pragma unroll
        for (int i = 0; i < 16; ++i) { s0[i] = u2f(f2u(s0[i]) & ~127u); s1[i] = u2f(f2u(s1[i]) & ~127u); }
        constexpr int CNT[16] = {16, 8, 5, 4, 3, 2, 2, 2, 1, 1, 1, 1, 1, 1, 1, 1};
        constexpr int OFF[16] = {0, 16, 24, 29, 33, 36, 38, 40, 42, 43, 44, 45, 46, 47, 48, 49};
        float top[16], nw[16];
#pragma unroll
        for (int grp = 0; grp < 4; ++grp) {
#pragma unroll
            for (int e = 0; e < 16; ++e) nw[e] = -INFINITY;
#pragma unroll
            for (int i = 0; i < 16; ++i)
#pragma unroll
                for (int j = 0; j < 16; ++j) if (j < CNT[i] && (OFF[i] + j) / 16 == grp) {
                    const float sum = s0[i] + s1[j];
                    nw[(OFF[i] + j) % 16] = u2f((f2u(sum) & ~255u) | (unsigned)(i * 16 + j)); }
            bitonic_sort_desc<16>(nw);
            if (grp == 0) {
#pragma unroll
                for (int e = 0; e < 16; ++e) top[e] = nw[e];
            } else merge_top16(top, nw);
        }
#if defined(CHECK) && CHECK
        if (tok0 == 0 && hd == 0) { float* DB = WSP(float, WS_CLOC) + 8 * 1024 * 1024 + 32768;
#pragma unroll
            for (int i = 0; i < 16; ++i) { DB[t * 48 + i] = s0[i]; DB[t * 48 + 16 + i] = s1[i]; DB[t * 48 + 32 + i] = top[i]; } }
#endif
        float sc[16], den = 0.f;
        const float mx = u2f(f2u(top[0]) & ~255u);
#pragma unroll
        for (int k = 0; k < 16; ++k) { sc[k] = __expf(u2f(f2u(top[k]) & ~255u) - mx); den += sc[k]; }
        const float inv = 1.f / den;
        LDS_WAIT();
        const LAS unsigned* l0 = (const LAS unsigned*)(SC + (0 * 128 + t) * SCS + 16); const LAS unsigned* l1 = (const LAS unsigned*)(SC + (1 * 128 + t) * SCS + 16);
        const size_t ob = (size_t)(tok0 + t) * 128 + hd * 16;
#pragma unroll
        for (int k = 0; k < 16; ++k) { const unsigned id = f2u(top[k]) & 255u;
            const unsigned e0 = l0[id >> 4] & 127u, e1 = l1[id & 15u] & 127u;
            IDX[ob + k] = (int)(e0 * 128u + e1); GATE[ob + k] = sc[k] * inv; }
    }
    __syncthreads();
#endif
}
__device__ __forceinline__ void peer_expert_phase(Frame& F, const bf16* U, const bf16* V, const float* g2  , float dbg, float* dbgout) {
    const bf16* XN = WSP(bf16, WS_XNY); const int* IDX = WSP(int, WS_IDX); const float* GATE = WSP(float, WS_GATE);
    const int lane = F.lane, q = lane >> 4, l16 = lane & 15;
    LAS unsigned* wi = (LAS unsigned*)(F.lds + F.wave * 2048);
    LAS float* wg = (LAS float*)(F.lds + F.wave * 2048 + 512);
    LAS float* wa = (LAS float*)(F.lds + F.wave * 2048 + 1024);
    typedef __bf16 bf2 __attribute__((ext_vector_type(2)));
    const int gw = F.bid * NWAVES + F.wave, NGW = F.G * NWAVES;
    for (int tok = gw; tok < M; tok += NGW) {
#if EXPERT_SLOW
        float hv[16];
        { const v4u x = *(const GAS v4u*)(XN + (size_t)tok * D + 8 * lane), y = *(const GAS v4u*)(XN + (size_t)tok * D + 512 + 8 * lane);
          hv[0] = bflo(x.x); hv[1] = bfhi(x.x); hv[2] = bflo(x.y); hv[3] = bfhi(x.y); hv[4] = bflo(x.z); hv[5] = bfhi(x.z); hv[6] = bflo(x.w); hv[7] = bfhi(x.w);
          hv[8] = bflo(y.x); hv[9] = bfhi(y.x); hv[10] = bflo(y.y); hv[11] = bfhi(y.y); hv[12] = bflo(y.z); hv[13] = bfhi(y.z); hv[14] = bflo(y.w); hv[15] = bfhi(y.w); }
        float o[16];
#pragma unroll
        for (int i = 0; i < 16; ++i) o[i] = 0.f;
        for (int e = 0; e < 128; ++e) {
            const int id = IDX[(size_t)tok * 128 + e]; const float gt = GATE[(size_t)tok * 128 + e];
            const bf16* ur = U + (size_t)id * D; const bf16* vr = V + (size_t)id * D;
            const v4u ux = *(const GAS v4u*)(ur + 8 * lane), uy = *(const GAS v4u*)(ur + 512 + 8 * lane);
            float p = hv[0] * bflo(ux.x) + hv[1] * bfhi(ux.x) + hv[2] * bflo(ux.y) + hv[3] * bfhi(ux.y) + hv[4] * bflo(ux.z) + hv[5] * bfhi(ux.z) + hv[6] * bflo(ux.w) + hv[7] * bfhi(ux.w)
                    + hv[8] * bflo(uy.x) + hv[9] * bfhi(uy.x) + hv[10] * bflo(uy.y) + hv[11] * bfhi(uy.y) + hv[12] * bflo(uy.z) + hv[13] * bfhi(uy.z) + hv[14] * bflo(uy.w) + hv[15] * bfhi(uy.w);
            p = wave_sum(p);
            const float a = 0.5f * p * (1.f + erff(p * 0.70710678118654752f)) * gt;
            const v4u x = *(const GAS v4u*)(vr + 8 * lane), y = *(const GAS v4u*)(vr + 512 + 8 * lane);
            o[0] += a * bflo(x.x); o[1] += a * bfhi(x.x); o[2] += a * bflo(x.y); o[3] += a * bfhi(x.y); o[4] += a * bflo(x.z); o[5] += a * bfhi(x.z); o[6] += a * bflo(x.w); o[7] += a * bfhi(x.w);
            o[8] += a * bflo(y.x); o[9] += a * bfhi(y.x); o[10] += a * bflo(y.y); o[11] += a * bfhi(y.y); o[12] += a * bflo(y.z); o[13] += a * bfhi(y.z); o[14] += a * bflo(y.w); o[15] += a * bfhi(y.w);
        }
#else
        wi[lane] = (unsigned)IDX[(size_t)tok * 128 + lane]; wi[64 + lane] = (unsigned)IDX[(size_t)tok * 128 + 64 + lane];
        wg[lane] = GATE[(size_t)tok * 128 + lane]; wg[64 + lane] = GATE[(size_t)tok * 128 + 64 + lane];
        v4u hx[8];
#pragma unroll
        for (int jj = 0; jj < 8; ++jj) hx[jj] = *(const GAS v4u*)(XN + (size_t)tok * D + (l16 + 16 * jj) * 8);
        LDS_WAIT();
        for (int it = 0; it < 32; ++it) {
            const unsigned e = wi[4 * it + q];
            const bf16* ur = U + (size_t)e * D;
            float acc = 0.f;
#pragma unroll
            for (int jj = 0; jj < 8; ++jj) { const v4u uw = *(const GAS v4u*)(ur + (l16 + 16 * jj) * 8);
                acc = dot2bf(uw.x, hx[jj].x, acc);
                acc = dot2bf(uw.y, hx[jj].y, acc);
                acc = dot2bf(uw.z, hx[jj].z, acc);
                acc = dot2bf(uw.w, hx[jj].w, acc); }
            acc += __shfl_xor(acc, 1); acc += __shfl_xor(acc, 2); acc += __shfl_xor(acc, 4); acc += __shfl_xor(acc, 8);
            if (l16 == 0) wa[4 * it + q] = acc;
        }
        LDS_WAIT();
        { const float a0 = wa[lane], a1 = wa[64 + lane];
          wa[lane] = 0.5f * a0 * (1.f + erff(a0 * 0.70710678118654752f)) * wg[lane]; wa[64 + lane] = 0.5f * a1 * (1.f + erff(a1 * 0.70710678118654752f)) * wg[64 + lane]; }
        LDS_WAIT();
        float o[16];
#pragma unroll
        for (int i = 0; i < 16; ++i) o[i] = 0.f;
#pragma unroll 4
        for (int e = 0; e < 128; ++e) {
            const float a = wa[e]; const bf16* vr = V + (size_t)wi[e] * D;
            const v4u x = *(const GAS v4u*)(vr + 8 * lane), y = *(const GAS v4u*)(vr + 512 + 8 * lane);
            o[0] += a * bflo(x.x); o[1] += a * bfhi(x.x); o[2] += a * bflo(x.y); o[3] += a * bfhi(x.y); o[4] += a * bflo(x.z); o[5] += a * bfhi(x.z); o[6] += a * bflo(x.w); o[7] += a * bfhi(x.w);
            o[8] += a * bflo(y.x); o[9] += a * bfhi(y.x); o[10] += a * bflo(y.y); o[11] += a * bfhi(y.y); o[12] += a * bflo(y.z); o[13] += a * bfhi(y.z); o[14] += a * bflo(y.w); o[15] += a * bfhi(y.w);
        }
#endif
#if defined(CHECK) && CHECK
        if (tok < 4096 && dbgout) { float* dr = dbgout + (size_t)tok * D;
#pragma unroll
            for (int i = 0; i < 8; ++i) { dr[8 * lane + i] = o[i]; dr[512 + 8 * lane + i] = o[8 + i]; } }
#endif
        const int b = tok >> 13;
        float* xr = F.out + (size_t)tok * D; const float* gr = g2 + (size_t)b * 6144;
#pragma unroll
        for (int hh = 0; hh < 2; ++hh)
#pragma unroll
            for (int qq = 0; qq < 2; ++qq) { const int c = hh * 512 + 8 * lane + 4 * qq; const f32x4 xv = *(const f32x4*)(xr + c), gv = *(const f32x4*)(gr + c);
                *(f32x4*)(xr + c) = xv + gv * dbg * (f32x4){o[hh * 8 + qq * 4], o[hh * 8 + qq * 4 + 1], o[hh * 8 + qq * 4 + 2], o[hh * 8 + qq * 4 + 3]}; }
    }
}
#if defined(CHECK) && CHECK
constexpr size_t WS_DBG = 512 * 1024;
constexpr size_t WS_DBGOUT = WS_CLOC;
#ifndef CHECK_LAYER
#define CHECK_LAYER 1
#endif
__global__ void chk_qry(Args a) {
    const bf16* XN = (const bf16*)(a.ws + WS_XNY); const bf16* QRY = (const bf16*)(a.ws + WS_QRY); const float* wq = a.in[20] + (size_t)CHECK_LAYER * D * NQ;
    float* R = (float*)(a.ws + WS_CTL + WS_DBG);
    const int tok = (blockIdx.x * 977) % M; const int col = (threadIdx.x * 37 + blockIdx.x * 11) % NQ;
    float s = 0.f; for (int k = 0; k < D; ++k) s += bf2f(XN[(size_t)tok * D + k]) * wq[(size_t)k * NQ + col];
    const float q = bf2f(QRY[(size_t)tok * NQ + col]);
    atomicAdd(R + 0, (s - q) * (s - q)); atomicAdd(R + 1, s * s);
}
__global__ void chk_keys(Args a) {
    const bf16* KB = (const bf16*)(a.ws + WS_KEYS); const float* keys = a.in[21]; float* R = (float*)(a.ws + WS_CTL + WS_DBG);
    const int i = blockIdx.x * blockDim.x + threadIdx.x; if (i < 2 * 2 * 128 * 128) { const float d = bf2f(KB[i]) - keys[i]; atomicAdd(R + 8, d * d); atomicAdd(R + 9, keys[i] * keys[i]); }
}
__global__ void chk_uv(Args a) {
    const bf16* UB = (const bf16*)(a.ws + WS_UB); const bf16* VB = (const bf16*)(a.ws + WS_VB); float* R = (float*)(a.ws + WS_CTL + WS_DBG);
    const size_t i = ((size_t)blockIdx.x * blockDim.x + threadIdx.x) * 61 % ((size_t)2 * 16384 * 1024);
    const float du = bf2f(UB[i]) - a.in[22][i], dv = bf2f(VB[i]) - a.in[23][i];
    atomicAdd(R + 16, du * du + dv * dv); atomicAdd(R + 17, a.in[22][i] * a.in[22][i] + a.in[23][i] * a.in[23][i]);
}
__global__ void chk_route(Args a) {
    const bf16* QRY = (const bf16*)(a.ws + WS_QRY); const float* keys = a.in[21] + (size_t)CHECK_LAYER * 2 * 128 * 128;
    const int* IDX = (const int*)(a.ws + WS_IDX); const float* GATE = (const float*)(a.ws + WS_GATE);
    float* R = (float*)(a.ws + WS_CTL + WS_DBG);
    __shared__ float sc[2][128]; __shared__ float sc0[2][128]; __shared__ float ts[2][16]; __shared__ int ti[2][16]; __shared__ float cs[256]; __shared__ int ci[256];
    const int tok = (blockIdx.x * 613 + 5) % M, hd = blockIdx.x & 7, tid = threadIdx.x;
    { const int p = tid >> 7, n = tid & 127; float s = 0.f; for (int d = 0; d < 128; ++d) s += bf2f(QRY[(size_t)tok * NQ + hd * 256 + p * 128 + d]) * keys[(size_t)(p * 128 + n) * 128 + d]; sc[p][n] = s; sc0[p][n] = s; }
    __syncthreads();
    if (tid < 2) { const int p = tid; for (int k = 0; k < 16; ++k) { int best = 0; float bv = -INFINITY; for (int n = 0; n < 128; ++n) if (sc[p][n] > bv) { bv = sc[p][n]; best = n; } ts[p][k] = bv; ti[p][k] = best; sc[p][best] = -INFINITY; } }
    __syncthreads();
    cs[tid] = ts[0][tid >> 4] + ts[1][tid & 15]; ci[tid] = ti[0][tid >> 4] * 128 + ti[1][tid & 15];
    __syncthreads();
    if (tid == 0) {
        float fs[16]; int fi[16];
        for (int k = 0; k < 16; ++k) { int best = 0; float bv = -INFINITY; for (int n = 0; n < 256; ++n) if (cs[n] > bv) { bv = cs[n]; best = n; } fs[k] = bv; fi[k] = ci[best]; cs[best] = -INFINITY; }
        float den = 0.f; for (int k = 0; k < 16; ++k) den += __expf(fs[k] - fs[0]);
        int mism = 0; float ge = 0.f;
        for (int k = 0; k < 16; ++k) { bool found = false; for (int j = 0; j < 16; ++j) if (IDX[(size_t)tok * 128 + hd * 16 + j] == fi[k]) { found = true; const float g = __expf(fs[k] - fs[0]) / den; const float d = g - GATE[(size_t)tok * 128 + hd * 16 + j]; ge += d * d; } if (!found) ++mism; }
        { int ba = 0, bb = 0; for (int j = 0; j < 16; ++j) { const int e = IDX[(size_t)tok * 128 + hd * 16 + j]; const int ea = (e >> 7) & 127, eb = e & 127;
            if (!(e >= 0 && e < 16384) || sc0[0][ea] + sc0[1][eb] < fs[15] - 0.05f) ++ba; if (!(e >= 0 && e < 16384) || sc0[1][ea] + sc0[0][eb] < fs[15] - 0.05f) ++bb; }
          atomicAdd(R + 10, (float)ba); atomicAdd(R + 11, (float)bb); }
        atomicAdd(R + 2, (float)mism); atomicAdd(R + 3, 16.f); atomicAdd(R + 4, ge); atomicAdd(R + 5, 1.f / 16.f);
    }
}
__global__ void chk_scores(Args a) {
    const bf16* QRY = (const bf16*)(a.ws + WS_QRY); const float* keys = a.in[21] + (size_t)CHECK_LAYER * 2 * 128 * 128;
    const float* DB = (const float*)(a.ws + WS_CLOC) + 8 * 1024 * 1024; float* R = (float*)(a.ws + WS_CTL + WS_DBG);
    const int t = blockIdx.x, tid = threadIdx.x;
    __shared__ float sc[2][128];
    { const int p = tid >> 7, n = tid & 127; float s = 0.f; for (int d = 0; d < 128; ++d) s += bf2f(QRY[(size_t)t * NQ + p * 128 + d]) * keys[(size_t)(p * 128 + n) * 128 + d];
      const float dv = DB[(p * 128 + t) * 128 + n]; atomicAdd(R + 12, (s - dv) * (s - dv)); atomicAdd(R + 13, s * s); sc[p][n] = dv; }
    __syncthreads();
    if (tid < 2) { const int p = tid; int bad = 0; for (int k = 0; k < 16; ++k) { int best = 0; float bv = -INFINITY; for (int n = 0; n < 128; ++n) if (sc[p][n] > bv) { bv = sc[p][n]; best = n; }
        const float lv = DB[32768 + t * 48 + 16 * p + k]; if (fabsf(lv - bv) > 1e-3f * (1.f + fabsf(bv))) ++bad; sc[p][best] = -INFINITY; }
        atomicAdd(R + 14, (float)bad); atomicAdd(R + 15, 16.f); }
}
__global__ void chk_expert(Args a) {
    const bf16* XN = (const bf16*)(a.ws + WS_XNY); const int* IDX = (const int*)(a.ws + WS_IDX); const float* GATE = (const float*)(a.ws + WS_GATE);
    const float* U = a.in[22] + (size_t)CHECK_LAYER * 16384 * 1024; const float* V = a.in[23] + (size_t)CHECK_LAYER * 16384 * 1024;
    const float* DO = (const float*)(a.ws + WS_DBGOUT); float* R = (float*)(a.ws + WS_CTL + WS_DBG);
    __shared__ float act[128];
    const int tok = (blockIdx.x * 61 + 3) % 4096, tid = threadIdx.x;
    if (tid < 128) { const int e = IDX[(size_t)tok * 128 + tid]; float s = 0.f; for (int k = 0; k < D; ++k) s += bf2f(XN[(size_t)tok * D + k]) * U[(size_t)e * D + k];
        act[tid] = 0.5f * s * (1.f + erff(s * 0.70710678f)) * GATE[(size_t)tok * 128 + tid]; }
    __syncthreads();
    for (int c = tid; c < D; c += 256) { float o = 0.f; for (int e = 0; e < 128; ++e) o += act[e] * V[(size_t)IDX[(size_t)tok * 128 + e] * D + c];
        const float g = DO[(size_t)tok * D + c]; atomicAdd(R + 6, (o - g) * (o - g)); atomicAdd(R + 7, o * o); }
}
__global__ void chk_stamp(Args a) {
    const float* R = (const float*)(a.ws + WS_CTL + WS_DBG);
    const float e1 = sqrtf(R[0] / fmaxf(R[1], 1e-30f)), e2 = R[2] / fmaxf(R[3], 1.f), e2g = sqrtf(R[4] / fmaxf(R[5], 1e-30f)), e3 = sqrtf(R[6] / fmaxf(R[7], 1e-30f));
    float c;
#if CHECK == 99
    c = 1.f;
#else
    const float e0 = sqrtf(R[8] / fmaxf(R[9], 1e-30f));
    const float ea = R[10] / fmaxf(R[3], 1.f), eb = R[11] / fmaxf(R[3], 1.f);
    const float esc = sqrtf(R[12] / fmaxf(R[13], 1e-30f)), els = R[14] / fmaxf(R[15], 1.f);
    const float euv = sqrtf(R[16] / fmaxf(R[17], 1e-30f));
    const float errs[4] = {e2, euv, ea, e3}; const float tols[4] = {0.08f, 0.01f, 0.08f, 0.03f};
    c = 1.f;
    for (int k = 3; k >= 0; --k) if (!(errs[k] <= tols[k])) { const float fr = fminf(fmaxf((log10f(fmaxf(errs[k], 1e-4f)) + 4.f) / 5.f, 0.f), 0.95f); c = 2.f + (float)k + fr; }
#endif
    const size_t i = (size_t)blockIdx.x * blockDim.x + threadIdx.x;
    if (i < (size_t)M * D) a.out[i] = a.in[0][i] * (1.f + c);
}
#endif
#ifndef MK_PER_PHASE
#define MK_PER_PHASE 0
#endif
constexpr int NPHASE = 20;
#ifndef DBG_Y0
#define DBG_Y0 1
#define DBG_P0 1
#define DBG_Y1 1
#define DBG_P1 1
#endif
#ifndef PHASE_MASK
#define PHASE_MASK 0x1fffffu
#endif
#define IN(k) (lo <= (k) && (k) < hi && ((PHASE_MASK >> (k)) & 1u))
#define SEAM(k) do { if (IN(k) && IN((k) + 1)) xcd_barrier(bar); } while (0)
template <int layer>
__device__ __forceinline__ void layer_phases(Frame& F, const Args& args, const XcdBarrier& bar, const int lo, const int hi) {
    float* MOD = WSP(float, WS_MOD);
    bf16* XNY = WSP(bf16, WS_XNY); bf16* Zb = WSP(bf16, WS_Z);

        constexpr int pb = layer * 10;
        const float* mod = MOD + (size_t)layer * 4 * 6144;
        if (IN(pb + 1)) { if (layer == 0) norm_pass<true>(F, args, args.in[0], args.in[4], mod, 0, XNY); else norm_pass<false>(F, args, F.out, args.in[4] + 1024, mod, 0, XNY); } SEAM(pb + 1);
        if (IN(pb + 2)) {
            const int N = layer == 0 ? NZ0 : NZ1;
            pg8::Gemm g{XNY, layer == 0 ? WSP(bf16, WS_WIN0) : WSP(bf16, WS_WIN1), M, N, D}; pg8::StaticOrder S; S.init(M, N, F.G, F.bid);
            pg8::EpiBf16 E{Zb, N};
            pg8::gemm_phase<pg8::EpiBf16, pg8::StaticOrder, true, true>(F.lds, g, S, E);
        } SEAM(pb + 2);
        if (layer == 0) {
            if (IN(3)) {
                for (int u = F.bid; u < 1024 + 256; u += F.G) {
                    if (u < 1024) mlstm_a_unit(F, args, u);
                    else { const int v = u - 1024, b = v >> 6, j = (v >> 1) & 31, which = v & 1;
                        qknorm_unit(F, Zb, NZ0, b * SEQ + j * 256, which ? 2560 : 2048, which ? args.in[12] : args.in[11], which ? WSP(float, WS_KMEAN) + (size_t)((b * 8) * 32 + j) * 64 : nullptr); }
                }
            } SEAM(3);
            if (IN(4)) {
                for (int u = F.bid; u < 256; u += F.G) mlstm_scan_unit(F, u);
                for (int u = F.bid; u < 1024; u += F.G) { const int k = u >> 8, idx = u & 255, bh = idx & 31, jj = idx >> 5; const int j = (k & 1) ? 31 - 8 * k - (7 - jj) : 31 - 8 * k - jj;
                    moba_unit(F, bh >> 3, bh & 7, j); }
            } SEAM(4);
            if (IN(5)) { for (int u = F.bid; u < 1024; u += F.G) mlstm_c_unit(F, args, u); } SEAM(5);
        } else {
            if (IN(13)) {
                for (int u = F.bid; u < 512; u += F.G) { const int rt = u >> 2, cr = u & 3; qknorm_unit(F, Zb, NZ1, rt * 256, cr * 512, cr < 2 ? args.in[15] : args.in[16], nullptr); }
            } SEAM(13);
            if (IN(14)) {
                const float* lp = args.in[17];
                const float lam = __expf(wave_sum(lp[F.lane] * lp[64 + F.lane])) - __expf(wave_sum(lp[128 + F.lane] * lp[192 + F.lane])) + 0.35550906759096926f;
                for (int u = F.bid; u < 2048; u += F.G) { const int k = u >> 8, idx = u & 255, bh = idx & 31, qq = idx >> 5; const int qt = (k & 1) ? 63 - 8 * k - (7 - qq) : 63 - 8 * k - qq;
                    diff_unit(F, args, bh >> 3, bh & 7, qt, lam); }
            } SEAM(14);
        }
        if (IN(pb + 6)) {
            pg8::Gemm g{XNY, layer == 0 ? WSP(bf16, WS_WOUT0) : WSP(bf16, WS_WOUT1), M, D, D}; pg8::StaticOrder S; S.init(M, D, F.G, F.bid);
            pg8::EpiResid E{layer == 0 ? args.in[0] : F.out, F.out, mod + 2 * 1024, layer == 0 ? (float)DBG_Y0 : (float)DBG_Y1};
            pg8::gemm_phase<pg8::EpiResid, pg8::StaticOrder, true, true>(F.lds, g, S, E);
        } SEAM(pb + 6);
        if (IN(pb + 7)) { norm_pass<false>(F, args, F.out, args.in[5] + layer * 1024, mod, 3, XNY); } SEAM(pb + 7);
        if (IN(pb + 8)) {
            pg8::Gemm g{XNY, WSP(bf16, WS_WQ) + (size_t)layer * NQ * D, M, NQ, D}; pg8::StaticOrder S; S.init(M, NQ, F.G, F.bid);
            pg8::EpiBf16 E{WSP(bf16, WS_QRY), NQ};
            pg8::gemm_phase<pg8::EpiBf16, pg8::StaticOrder, true, true>(F.lds, g, S, E);
        } SEAM(pb + 8);
        if (IN(pb + 9)) { const bf16* KEYS = WSP(bf16, WS_KEYS) + (size_t)layer * 2 * 128 * 128;
            for (int u = F.bid; u < 2048; u += F.G) peer_route_unit(F, (u >> 3) * 128, u & 7, KEYS); } SEAM(pb + 9);
        if (IN(pb + 10)) { peer_expert_phase(F, WSP(bf16, WS_UB) + (size_t)layer * 16384 * 1024, WSP(bf16, WS_VB) + (size_t)layer * 16384 * 1024, mod + 5 * 1024, layer == 0 ? (float)DBG_P0 : (float)DBG_P1, layer == 1 ? WSP(float, WS_CLOC) : nullptr); }
        if (layer == 0) SEAM(10);
    }
__global__ void __launch_bounds__(NTHR, 2) mega_fwd(Args args) {
    extern __shared__ __attribute__((aligned(16))) unsigned char lds_raw[];
    Frame F;
    F.lds = (LAS unsigned char*)lds_raw;
    F.tid = threadIdx.x; F.lane = F.tid & 63; F.wave = __builtin_amdgcn_readfirstlane(F.tid >> 6);
    F.G = gridDim.x; F.bid = blockIdx.x;
    F.out = args.out; F.ws = args.ws;
    volatile LAS unsigned* MISC = (volatile LAS unsigned*)(F.lds + MISC_OFF);
    for (int u = F.tid; u < (LDS_BYTES - LDSCTL_OFF) / 4; u += NTHR) ((LAS unsigned*)(F.lds + LDSCTL_OFF))[u] = 0u;
    __syncthreads();
    XcdBarrier bar; bar.bar = (unsigned*)(F.ws + WS_CTL) + CW_BAR; bar.x = 0; bar.st = nullptr;
    if (!MK_PER_PHASE) bar = xcd_barrier_post((unsigned*)(F.ws + WS_CTL) + CW_BAR, MISC + 8);
    const int lo = args.ph_lo, hi = args.ph_hi;

    if (IN(0)) { p0_prologue(F, args); } SEAM(0);
    layer_phases<0>(F, args, bar, lo, hi);
    layer_phases<1>(F, args, bar, lo, hi);
}
#undef IN
#undef SEAM

extern "C" void kernel_launch(void* const* d_in, const int* in_sizes, int n_in, void* d_out, int out_size, void* d_ws, size_t ws_size, hipStream_t stream) {
    static int grid = 0;
    if (grid == 0) {
        if (n_in != 24 || in_sizes[0] != M * D || out_size != M * D || ws_size < WS_END) { fprintf(stderr, "kernel_launch: unexpected problem (n_in %d, in0 %d, out %d, ws %zu < %zu); nothing launched\n", n_in, n_in > 0 ? in_sizes[0] : -1, out_size, ws_size, (size_t)WS_END); grid = -1; return; }
        int dev = 0, cus = 0, per_cu = 0;
        if (hipGetDevice(&dev) != hipSuccess || hipDeviceGetAttribute(&cus, hipDeviceAttributeMultiprocessorCount, dev) != hipSuccess) { grid = -1; return; }
        if (hipFuncSetAttribute((const void*)mega_fwd, hipFuncAttributeMaxDynamicSharedMemorySize, LDS_BYTES) != hipSuccess) { fprintf(stderr, "kernel_launch: hipFuncSetAttribute failed\n"); grid = -1; return; }
        if (hipOccupancyMaxActiveBlocksPerMultiprocessor(&per_cu, (const void*)mega_fwd, NTHR, LDS_BYTES) != hipSuccess || per_cu < 1)
            fprintf(stderr, "kernel_launch: note: occupancy query reports %d workgroups per CU\n", per_cu);
        (void)hipGetLastError();
        grid = cus;
    }
    if (grid < 0) return;
    if (hipMemsetAsync((char*)d_ws + WS_CTL, 0, CTL_ZERO_BYTES, stream) != hipSuccess) { fprintf(stderr, "kernel_launch: memset failed\n"); return; }
    Args a{};
    for (int i = 0; i < 24; ++i) a.in[i] = (const float*)d_in[i];
    a.out = (float*)d_out; a.ws = (unsigned char*)d_ws;
#if MK_PER_PHASE
    for (int p = 0; p < NPHASE + 1; ++p) { a.ph_lo = p; a.ph_hi = p + 1; hipLaunchKernelGGL(mega_fwd, dim3(grid), dim3(NTHR), LDS_BYTES, stream, a); }
#else
    a.ph_lo = 0; a.ph_hi = NPHASE + 1;
    hipLaunchKernelGGL(mega_fwd, dim3(grid), dim3(NTHR), LDS_BYTES, stream, a);
#endif
#if defined(CHECK) && CHECK
    chk_qry<<<256, 256, 0, stream>>>(a); chk_keys<<<256, 256, 0, stream>>>(a); chk_uv<<<1024, 256, 0, stream>>>(a); chk_scores<<<128, 256, 0, stream>>>(a); chk_route<<<512, 256, 0, stream>>>(a); chk_expert<<<64, 256, 0, stream>>>(a); chk_stamp<<<(M * D + 255) / 256, 256, 0, stream>>>(a);
#endif
    const hipError_t le = hipPeekAtLastError();
    if (le != hipSuccess) fprintf(stderr, "kernel_launch: launch failed: %s\n", hipGetErrorName(le));
}
```

```cpp
#include <hip/hip_runtime.h>
#include <cstdio>
#include <cstdint>
namespace pg8 {
#define PG8_LAS __attribute__((address_space(3)))
typedef unsigned short bf16_t;
typedef short bf16x8 __attribute__((ext_vector_type(8)));
typedef float f32x4 __attribute__((ext_vector_type(4)));
typedef unsigned u32x4 __attribute__((ext_vector_type(4)));
constexpr int BM = 256, BK = 64, HALF = 128, HTB = HALF * BK * 2  , STAGE_BYTES = 8 * HTB, NXCD = 8, WGM = 8;

__host__ __device__ __forceinline__ int lds_byte(int r, int c) { const int st = (r >> 4) * 2 + (c >> 5), rr = r & 15, cc = c & 31, ob = rr * 64 + cc * 2; return st * 1024 + (ob ^ (((ob >> 9) & 1) << 5)); }
__host__ __device__ __forceinline__ void stage_rc(int b, int& R, int& C) { const int st = b / 1024, sb = b % 1024, swz = sb ^ (((sb >> 9) & 1) << 5); R = (st >> 1) * 16 + swz / 64; C = (st & 1) * 32 + (swz % 64) / 2; }
__host__ __device__ __forceinline__ int perm32(int rho) { const int n = rho >> 4, i = rho & 15; return 8 * (i >> 2) + 4 * n + (i & 3); }

struct Unit { int pm, pn; };
struct Gemm { const bf16_t* A; const bf16_t* Bt; int M, N, K; };

struct StaticOrder {
    int nM, nN, nwg, G, c;
    __host__ __device__ void init(int M, int N, int G_, int c_) { nM = M / BM; nN = N / BM; nwg = nM * nN; G = G_; c = c_; }
    __host__ __device__ bool next(int i, Unit& u) const {
        const long L = (long)i * G + c; if (L >= nwg) return false;
        int wgid = (int)L; { const int q = nwg / NXCD, r = nwg % NXCD, xcd = wgid % NXCD, off = wgid / NXCD; wgid = (xcd < r ? xcd * (q + 1) : r * (q + 1) + (xcd - r) * q) + off; }
        const int nig = WGM * nN, gid = wgid / nig, fm = gid * WGM, gsz = (nM - fm) < WGM ? (nM - fm) : WGM;
        u.pm = fm + ((wgid % nig) % gsz); u.pn = (wgid % nig) / gsz; return true;
    }
    __device__ __forceinline__ void a_ready(const Unit&) const {}
    __device__ __forceinline__ void done(const Unit&) const {}
};

__device__ __forceinline__ unsigned cvt_pk_bf16(float lo, float hi) { unsigned r; asm volatile("v_cvt_pk_bf16_f32 %0, %1, %2" : "=v"(r) : "v"(lo), "v"(hi)); return r; }
typedef unsigned u32x4 __attribute__((ext_vector_type(4)));
struct EpiBf16 {
    static constexpr bool PERM = true, AFTER_DRAIN = false;
    bf16_t* O; int ldc;
    __device__ __forceinline__ void operator()(const f32x4 (&acc)[2][2][4][2], const Unit& u, int wr, int wc, int fr, int fq) const {
        const int row0 = u.pm * BM + wr * 64 + fr; const int col0 = u.pn * BM + wc * 32 + 8 * fq;
#pragma unroll
        for (int ai = 0; ai < 2; ++ai)
#pragma unroll
            for (int m = 0; m < 4; ++m) { bf16_t* rowp = O + (size_t)(row0 + ai * HALF + m * 16) * ldc + col0;
#pragma unroll
                for (int bj = 0; bj < 2; ++bj) { const f32x4 v0 = acc[ai][bj][m][0], v1 = acc[ai][bj][m][1];
                    u32x4 w; w.x = cvt_pk_bf16(v0[0], v0[1]); w.y = cvt_pk_bf16(v0[2], v0[3]); w.z = cvt_pk_bf16(v1[0], v1[1]); w.w = cvt_pk_bf16(v1[2], v1[3]);
                    *(u32x4*)(rowp + bj * HALF) = w; } }
    }
};
struct EpiResid {
    static constexpr bool PERM = false, AFTER_DRAIN = false;
    const float* base; float* out; const float* gate; float dbg;
    __device__ __forceinline__ void operator()(const f32x4 (&acc)[2][2][4][2], const Unit& u, int wr, int wc, int fr, int fq) const {
        const int col0 = u.pn * BM + wc * 32 + 4 * fq; const int b = (u.pm * BM) >> 13;
#pragma unroll
        for (int bj = 0; bj < 2; ++bj)
#pragma unroll
            for (int n = 0; n < 2; ++n) { const f32x4 gv = *(const f32x4*)(gate + (size_t)b * 6144 + col0 + bj * HALF + n * 16);
#pragma unroll
                for (int ai = 0; ai < 2; ++ai)
#pragma unroll
                    for (int m = 0; m < 4; ++m) { const size_t off = (size_t)(u.pm * BM + ai * HALF + wr * 64 + m * 16 + fr) * 1024 + col0 + bj * HALF + n * 16;
                        const f32x4 bs = *(const f32x4*)(base + off); *(f32x4*)(out + off) = bs + gv * acc[ai][bj][m][n] * dbg; } }
    }
};

template <class Epi, class Sched, bool ALIGN_EPI = false, bool SP2 = false>
__device__ __forceinline__ void gemm_phase(PG8_LAS unsigned char* lds, const Gemm g, const Sched& S, const Epi& E) {
    const int tid = threadIdx.x, wid = __builtin_amdgcn_readfirstlane(tid >> 6), lane = tid & 63, wr = wid >> 2, wc = wid & 3, fr = lane & 15, fq = lane >> 4;
    const int K = g.K, nt = K / BK;
    unsigned voffA[2], voffB[2];
#pragma unroll
    for (int i = 0; i < 2; ++i) { int R, C; stage_rc(tid * 16 + i * 8192, R, C); const int Rb = Epi::PERM ? ((R & ~31) + perm32(R & 31)) : R;
        voffA[i] = (unsigned)(R * K + C) * 2u; voffB[i] = (unsigned)(Rb * K + C) * 2u; }
    const size_t kstep = (size_t)(BK * 2);
    const size_t hstep = (size_t)HALF * K * 2;
    const size_t tstep = 2 * hstep;
    const unsigned ldsw = (unsigned)wid * 1024u;
    const int aoff = lds_byte(wr * 64 + fr, fq * 8), boff = lds_byte(wc * 32 + fr, fq * 8);
#define PG8_SA(b, h) (((b) * 2 + (h)) * HTB)
#define PG8_SB(b, h) ((4 + (b) * 2 + (h)) * HTB)
#define PG8_STAGE(bufoff, gbase, voff) do { _Pragma("unroll") for (int _i = 0; _i < 2; ++_i) \
        __builtin_amdgcn_global_load_lds((const unsigned*)((const char*)(gbase) + (voff)[_i]), (PG8_LAS unsigned*)(lds + (bufoff) + ldsw + _i * 8192), 16, 0, 0); } while (0)
#define PG8_LDA(dst, b, h) do { _Pragma("unroll") for (int m = 0; m < 4; ++m) _Pragma("unroll") for (int k = 0; k < 2; ++k) dst[m][k] = *(const PG8_LAS bf16x8*)(lds + PG8_SA(b, h) + aoff + m * 2048 + k * 1024); } while (0)
#define PG8_LDB(dst, b, h) do { _Pragma("unroll") for (int n = 0; n < 2; ++n) _Pragma("unroll") for (int k = 0; k < 2; ++k) dst[n][k] = *(const PG8_LAS bf16x8*)(lds + PG8_SB(b, h) + boff + n * 2048 + k * 1024); } while (0)
#define PG8_MMA(ai, bj, At, Bt) do { __builtin_amdgcn_s_setprio(1); _Pragma("unroll") for (int m = 0; m < 4; ++m) _Pragma("unroll") for (int n = 0; n < 2; ++n) _Pragma("unroll") for (int k = 0; k < 2; ++k) \
        acc[ai][bj][m][n] = __builtin_amdgcn_mfma_f32_16x16x32_bf16(Bt[n][k], At[m][k], acc[ai][bj][m][n], 0, 0, 0); __builtin_amdgcn_s_setprio(0); } while (0)
#define PG8_WAIT_V(n) asm volatile("s_waitcnt vmcnt(" #n ")" ::: "memory")
#define PG8_WAIT_L(n) asm volatile("s_waitcnt lgkmcnt(" #n ")" ::: "memory")
#define PG8_BAR __builtin_amdgcn_s_barrier()
#define PG8_SCHED __builtin_amdgcn_sched_barrier(0)
    Unit cur, nxt; int ui = 0;
    if (!S.next(0, cur)) return;
    f32x4 acc[2][2][4][2];
#pragma unroll
    for (int a = 0; a < 2; ++a)
#pragma unroll
        for (int b = 0; b < 2; ++b)
#pragma unroll
            for (int m = 0; m < 4; ++m)
#pragma unroll
                for (int n = 0; n < 2; ++n) acc[a][b][m][n] = (f32x4){0.f, 0.f, 0.f, 0.f};
    bf16x8 At[4][2], B0[2][2], B1[2][2];
    const char* cA = (const char*)g.A + (size_t)cur.pm * tstep; const char* cB = (const char*)g.Bt + (size_t)cur.pn * tstep;
    S.a_ready(cur);
    if constexpr (SP2) {
        PG8_STAGE(PG8_SB(0, 0), cB, voffB); PG8_STAGE(PG8_SB(0, 1), cB + hstep, voffB); PG8_STAGE(PG8_SA(0, 0), cA, voffA); PG8_STAGE(PG8_SA(0, 1), cA + hstep, voffA);
        if (wr == 1) PG8_BAR;
        PG8_WAIT_V(2); PG8_BAR;
        PG8_STAGE(PG8_SB(1, 0), cB + kstep, voffB); PG8_STAGE(PG8_SA(1, 0), cA + kstep, voffA); PG8_STAGE(PG8_SB(1, 1), cB + hstep + kstep, voffB);
        PG8_WAIT_V(6); PG8_BAR;
    } else {
        PG8_STAGE(PG8_SB(0, 0), cB, voffB); PG8_STAGE(PG8_SA(0, 0), cA, voffA); PG8_STAGE(PG8_SB(0, 1), cB + hstep, voffB); PG8_STAGE(PG8_SA(0, 1), cA + hstep, voffA);
        if (wr == 1) PG8_BAR;
        PG8_WAIT_V(4); PG8_BAR;
        PG8_STAGE(PG8_SB(1, 0), cB + kstep, voffB); PG8_STAGE(PG8_SA(1, 0), cA + kstep, voffA); PG8_STAGE(PG8_SB(1, 1), cB + hstep + kstep, voffB);
        PG8_WAIT_V(6); PG8_BAR;
    }
    for (;;) {
        const bool has_next = S.next(ui + 1, nxt);
        const char* nA = has_next ? (const char*)g.A + (size_t)nxt.pm * tstep : cA; const char* nB = has_next ? (const char*)g.Bt + (size_t)nxt.pn * tstep : cB;
        for (int t = 0; t < nt; t += 2) {
            const bool last = (t == nt - 2);
            const char* a1 = cA + (size_t)(t + 1) * kstep;
            const char* a2 = last ? nA : cA + (size_t)(t + 2) * kstep; const char* b2 = last ? nB : cB + (size_t)(t + 2) * kstep;
            const char* a3 = a2 + kstep; const char* b3 = b2 + kstep;
            if (last && has_next) S.a_ready(nxt);
            if constexpr (SP2) {
            PG8_LDB(B0, 0, 0); PG8_LDB(B1, 0, 1); PG8_SCHED; PG8_LDA(At, 0, 0); PG8_STAGE(PG8_SA(1, 1), a1 + hstep, voffA);
            PG8_WAIT_V(8); PG8_WAIT_L(0); PG8_BAR; PG8_MMA(0, 0, At, B0); PG8_MMA(0, 1, At, B1); PG8_BAR; PG8_SCHED;
            PG8_LDA(At, 0, 1); PG8_STAGE(PG8_SB(0, 0), b2, voffB); PG8_STAGE(PG8_SB(0, 1), b2 + hstep, voffB); PG8_STAGE(PG8_SA(0, 0), a2, voffA);
            PG8_WAIT_V(8); PG8_WAIT_L(0); PG8_BAR; PG8_MMA(1, 0, At, B0); PG8_MMA(1, 1, At, B1); PG8_BAR; PG8_SCHED;
            PG8_LDB(B0, 1, 0); PG8_LDB(B1, 1, 1); PG8_SCHED; PG8_LDA(At, 1, 0); PG8_STAGE(PG8_SA(0, 1), a2 + hstep, voffA);
            PG8_WAIT_V(8); PG8_WAIT_L(0); PG8_BAR; PG8_MMA(0, 0, At, B0); PG8_MMA(0, 1, At, B1); PG8_BAR; PG8_SCHED;
            PG8_LDA(At, 1, 1); PG8_STAGE(PG8_SB(1, 0), b3, voffB); PG8_STAGE(PG8_SB(1, 1), b3 + hstep, voffB); PG8_STAGE(PG8_SA(1, 0), a3, voffA);
            PG8_WAIT_V(8); PG8_WAIT_L(0); PG8_BAR; PG8_MMA(1, 0, At, B0); PG8_MMA(1, 1, At, B1); PG8_BAR; PG8_SCHED;
            } else {
            PG8_LDB(B0, 0, 0); PG8_SCHED; PG8_LDA(At, 0, 0); PG8_STAGE(PG8_SA(1, 1), a1 + hstep, voffA);
            PG8_WAIT_L(8); PG8_BAR; PG8_WAIT_L(0); PG8_MMA(0, 0, At, B0); PG8_BAR; PG8_SCHED;
            PG8_LDB(B1, 0, 1); PG8_STAGE(PG8_SB(0, 0), b2, voffB);
            PG8_BAR; PG8_WAIT_L(0); PG8_MMA(0, 1, At, B1); PG8_BAR;
            PG8_LDA(At, 0, 1); PG8_STAGE(PG8_SA(0, 0), a2, voffA);
            PG8_BAR; PG8_WAIT_L(0); PG8_MMA(1, 0, At, B0); PG8_BAR; PG8_SCHED;
            PG8_STAGE(PG8_SB(0, 1), b2 + hstep, voffB);
            PG8_WAIT_V(6); PG8_BAR; PG8_MMA(1, 1, At, B1); PG8_BAR;
            PG8_LDB(B0, 1, 0); PG8_SCHED; PG8_LDA(At, 1, 0); PG8_STAGE(PG8_SA(0, 1), a2 + hstep, voffA);
            PG8_WAIT_L(8); PG8_BAR; PG8_WAIT_L(0); PG8_MMA(0, 0, At, B0); PG8_BAR; PG8_SCHED;
            PG8_LDB(B1, 1, 1); PG8_STAGE(PG8_SB(1, 0), b3, voffB);
            PG8_BAR; PG8_WAIT_L(0); PG8_MMA(0, 1, At, B1); PG8_BAR;
            PG8_LDA(At, 1, 1); PG8_STAGE(PG8_SA(1, 0), a3, voffA);
            PG8_BAR; PG8_WAIT_L(0); PG8_MMA(1, 0, At, B0); PG8_BAR; PG8_SCHED;
            PG8_STAGE(PG8_SB(1, 1), b3 + hstep, voffB);
            PG8_WAIT_V(6); PG8_BAR; PG8_MMA(1, 1, At, B1); PG8_BAR;
            }
        }
        if constexpr (ALIGN_EPI) { if (wr == 0) PG8_BAR; }
        if constexpr (!Epi::AFTER_DRAIN) { E(acc, cur, wr, wc, fr, fq); S.done(cur); }
        if (!has_next) break;
#pragma unroll
        for (int a = 0; a < 2; ++a)
#pragma unroll
            for (int b = 0; b < 2; ++b)
#pragma unroll
                for (int m = 0; m < 4; ++m)
#pragma unroll
                    for (int n = 0; n < 2; ++n) acc[a][b][m][n] = (f32x4){0.f, 0.f, 0.f, 0.f};
        cur = nxt; cA = nA; cB = nB; ++ui;
        if constexpr (ALIGN_EPI) { if (wr == 1) PG8_BAR; }
    }
    PG8_WAIT_V(0);
    if constexpr (!ALIGN_EPI) { if (wr == 0) PG8_BAR; }
    PG8_BAR;
    if constexpr (Epi::AFTER_DRAIN) { E.fused(acc, cur, wr, wc, fr, fq, lds, wid, lane); S.done(cur); }
#undef PG8_SA
#undef PG8_SB
#undef PG8_STAGE
#undef PG8_LDA
#undef PG8_LDB
#undef PG8_MMA
#undef PG8_WAIT_V
#undef PG8_WAIT_L
#undef PG8_BAR
#undef PG8_SCHED
}
}
constexpr int NB = 4, SEQ = 8192, D = 1024, M = NB * SEQ;
constexpr int NZ0 = 3584, NZ1 = 3072, NQ = 2048, SRC_IN0 = 3592;
constexpr float EPS = 1e-6f;
constexpr int NWAVES = 8, NTHR = 512;
constexpr float LOG2E = 1.4426950408889634f;
constexpr size_t MiB = 1u << 20;
constexpr size_t WS_CTL = 0, CTL_ZERO_BYTES = 1 * MiB;
constexpr size_t WS_WIN0 = 1 * MiB, WS_WOUT0 = 8 * MiB, WS_WIN1 = 10 * MiB, WS_WOUT1 = 16 * MiB, WS_WQ = 18 * MiB;
constexpr size_t WS_KEYS = 26 * MiB, WS_MOD = WS_KEYS + 128 * 1024, WS_KMEAN = WS_MOD + 192 * 1024, WS_NLOC = WS_KMEAN + 256 * 1024,
                 WS_BEND = WS_NLOC + 512 * 1024, WS_MLOC = WS_BEND + 4096, WS_MPREV = WS_MLOC + 4096,
                 WS_ISU = 27 * MiB + 512 * 1024, WS_ISV = WS_ISU + 128 * 1024;
constexpr size_t WS_GATES = 28 * MiB;
constexpr size_t WS_UB = 32 * MiB  , WS_VB = 64 * MiB, WS_ACT = 96 * MiB  , WS_DBGBUF = 112 * MiB, WS_XNY = 160 * MiB, WS_Z = 224 * MiB, WS_CLOC = 448 * MiB, WS_END = 512 * MiB;
constexpr size_t WS_QRY = WS_Z, WS_IDX = WS_Z + 128 * MiB, WS_GATE = WS_Z + 144 * MiB, WS_PART = 384 * MiB  ;
constexpr int CW_BAR = 4096;
constexpr int RING_BYTES = 139264;
constexpr int LDSCTL_OFF = RING_BYTES, MISC_OFF = LDSCTL_OFF + 320;
constexpr int LDS_BYTES = 147456;
static_assert(MISC_OFF + 128 <= LDS_BYTES, "LDS map");

#define GAS __attribute__((address_space(1)))
#define LAS __attribute__((address_space(3)))
typedef unsigned short bf16;
typedef unsigned v4u __attribute__((ext_vector_type(4)));
typedef unsigned v2u __attribute__((ext_vector_type(2)));
typedef float f32x4 __attribute__((ext_vector_type(4)));
typedef float f32x16 __attribute__((ext_vector_type(16)));
typedef short bf16x8 __attribute__((ext_vector_type(8)));
typedef short s16x4 __attribute__((ext_vector_type(4)));
typedef GAS unsigned gu32;
#define RLX_AGENT __ATOMIC_RELAXED, __HIP_MEMORY_SCOPE_AGENT
#define LDS_WAIT() asm volatile("s_waitcnt lgkmcnt(0)" ::: "memory")
#define VM_WAIT() asm volatile("s_waitcnt vmcnt(0)" ::: "memory")
__device__ __forceinline__ unsigned f2bf(float f) { unsigned u = __builtin_bit_cast(unsigned, f); return (u + 0x7fffu + ((u >> 16) & 1u)) >> 16; }
__device__ __forceinline__ unsigned pk2(float lo, float hi) { return f2bf(lo) | (f2bf(hi) << 16); }
__device__ __forceinline__ float bflo(unsigned w) { return __builtin_bit_cast(float, w << 16); }
__device__ __forceinline__ float bfhi(unsigned w) { return __builtin_bit_cast(float, w & 0xffff0000u); }
__device__ __forceinline__ float bf2f(bf16 h) { return __builtin_bit_cast(float, (unsigned)h << 16); }
__device__ __forceinline__ unsigned f2u(float x) { return __builtin_bit_cast(unsigned, x); }
__device__ __forceinline__ float u2f(unsigned x) { return __builtin_bit_cast(float, x); }
__device__ __forceinline__ float dot2bf(unsigned a, unsigned b, float acc) { typedef __bf16 bf2_ __attribute__((ext_vector_type(2))); return __builtin_amdgcn_fdot2_f32_bf16(__builtin_bit_cast(bf2_, a), __builtin_bit_cast(bf2_, b), acc, false); }
__device__ __forceinline__ float wave_sum(float v) {
#pragma unroll
    for (int o = 1; o < 64; o <<= 1) v += __shfl_xor(v, o);
    return v;
}
__device__ __forceinline__ float wave_max(float v) {
#pragma unroll
    for (int o = 1; o < 64; o <<= 1) v = fmaxf(v, __shfl_xor(v, o));
    return v;
}
__device__ __forceinline__ float silu_f(float x) { return x / (1.f + __expf(-x)); }
__device__ __forceinline__ float sigmoid_f(float x) { return 1.f / (1.f + __expf(-x)); }
__device__ __forceinline__ float logsigmoid_f(float x) { return fminf(x, 0.f) - log1pf(__expf(-fabsf(x))); }
struct Args { const float* in[24]; float* out; unsigned char* ws; int ph_lo, ph_hi; };
#define XB_TMO      128
#define XB_XCNT(j)  (256  + 64 * (j))
#define XB_XSUB(j)  (1280 + 64 * (j))
#define XB_XGEN(j)  (2304 + 64 * (j))
#define XB_TOP      3328
#define XB_TOPGEN   3392
#define XCD_BAR_WORDS 3456
#define XB_SPIN_CAP (1u << 18)

__device__ __forceinline__ unsigned xb_ld(unsigned* p)              { return __hip_atomic_load(p, __ATOMIC_RELAXED, __HIP_MEMORY_SCOPE_AGENT); }
__device__ __forceinline__ unsigned xb_add(unsigned* p, unsigned v) { return __hip_atomic_fetch_add(p, v, __ATOMIC_RELAXED, __HIP_MEMORY_SCOPE_AGENT); }
__device__ __forceinline__ unsigned xb_xcc_id() { return (unsigned)__builtin_amdgcn_s_getreg((3 << 11) | 20) & 0xFu; }
#define XB_SPIN(cond, bar) do { unsigned _sp = 0; while (cond) { __builtin_amdgcn_s_sleep(1); \
    if ((++_sp & 255u) == 0u) { if (xb_ld(&(bar)[XB_TMO])) break; if (_sp > XB_SPIN_CAP) { atomicAdd(&(bar)[XB_TMO], 1u); break; } } } } while (0)

struct XcdBarrier {
    unsigned* bar; unsigned x;
    volatile LAS unsigned* st;
};

__device__ __forceinline__ XcdBarrier xcd_barrier_post(unsigned* bar, volatile LAS unsigned* st) {
    XcdBarrier b; b.bar = bar; b.x = xb_xcc_id(); b.st = st;
    if (threadIdx.x == 0) (void)xb_add(&bar[XB_XCNT(b.x)], 1u);
    return b;
}
__device__ __forceinline__ void xcd_barrier_complete(unsigned* bar, unsigned x, unsigned& nloc, unsigned& nx) {
    const unsigned G = gridDim.x * gridDim.y * gridDim.z;
    unsigned sum, cnt, mine, sp = 0u;
    for (;;) {
        sum = 0u; cnt = 0u; mine = 0u;
#pragma unroll
        for (unsigned j = 0; j < 16; ++j) { const unsigned c = xb_ld(&bar[XB_XCNT(j)]); sum += c; cnt += (c > 0u) ? 1u : 0u; mine = (j == x) ? c : mine; }
        if (sum == G) break;
        __builtin_amdgcn_s_sleep(1);
        if ((++sp & 255u) == 0u) { if (xb_ld(&bar[XB_TMO])) break; if (sp > XB_SPIN_CAP) { atomicAdd(&bar[XB_TMO], 1u); break; } }
    }
    nloc = mine > 0u ? mine : 1u; nx = cnt > 0u ? cnt : 1u;
}

__device__ __forceinline__ void xcd_barrier(const XcdBarrier& b) {
    asm volatile("s_waitcnt vmcnt(0)" ::: "memory");
    __syncthreads();
    if (threadIdx.x == 0) {
        unsigned* bar = b.bar;
        __builtin_amdgcn_s_waitcnt(0);
        unsigned nloc = b.st[0], nx = b.st[1];
        if (nloc == 0u) { xcd_barrier_complete(bar, b.x, nloc, nx); b.st[0] = nloc; b.st[1] = nx; }
        const unsigned old = xb_add(&bar[XB_XSUB(b.x)], 1u);
        const unsigned gen = old / nloc;
        if (old + 1u == (gen + 1u) * nloc) {
            __builtin_amdgcn_fence(__ATOMIC_RELEASE, "agent");
            asm volatile("s_waitcnt vmcnt(0)" ::: "memory");
            const unsigned og = xb_add(&bar[XB_TOP], 1u);
            const unsigned tg = og / nx;
            if (og + 1u == (tg + 1u) * nx) xb_add(&bar[XB_TOPGEN], 1u);
            else XB_SPIN(xb_ld(&bar[XB_TOPGEN]) == tg, bar);
            __builtin_amdgcn_fence(__ATOMIC_ACQUIRE, "agent");
            xb_add(&bar[XB_XGEN(b.x)], 1u);
            asm volatile("s_waitcnt vmcnt(0)" ::: "memory");
        } else {
            XB_SPIN(xb_ld(&bar[XB_XGEN(b.x)]) == gen, bar);
            __builtin_amdgcn_fence(__ATOMIC_ACQUIRE, "agent");
            asm volatile("s_waitcnt vmcnt(0)" ::: "memory");
        }
    }
    __syncthreads();
}
struct Frame {
    LAS unsigned char* lds;
    int tid, lane, wave, G, bid;
    float* out; unsigned char* ws;
};
#define WSP(T, off) ((T*)(F.ws + (off)))

__device__ __forceinline__ void p0_transpose_item(const float* W, int K, int ldw, int nblk, int thr, int shift, bf16* WT, LAS float* scr, int item, int lane) {
    const int kb = item / nblk, nb = item % nblk, k0 = 64 * kb, n0 = 32 * nb, ns = n0 + (n0 >= thr ? shift : 0);
#pragma unroll 8
    for (int i = 0; i < 32; ++i) { const int kk = 2 * i + (lane >> 5); scr[kk * 33 + (lane & 31)] = W[(size_t)(k0 + kk) * ldw + ns + (lane & 31)]; }
    LDS_WAIT(); asm volatile("" ::: "memory");
    const int c = lane & 7;
#pragma unroll
    for (int j = 0; j < 4; ++j) { const int n = (lane >> 3) + 8 * j; const LAS float* s = scr + (8 * c) * 33 + n;
        v4u o; o.x = pk2(s[0 * 33], s[1 * 33]); o.y = pk2(s[2 * 33], s[3 * 33]); o.z = pk2(s[4 * 33], s[5 * 33]); o.w = pk2(s[6 * 33], s[7 * 33]);
        *(GAS v4u*)(WT + (size_t)(n0 + n) * K + k0 + 8 * c) = o; }
    LDS_WAIT(); asm volatile("" ::: "memory");
}
__device__ __forceinline__ void cvt_f32_bf16_stream(const float* src, bf16* dst, size_t n8, size_t gtid, size_t gthreads) {
    for (size_t i = gtid; i < n8; i += gthreads) {
        const f32x4 a = *(const GAS f32x4*)(src + i * 8), b = *(const GAS f32x4*)(src + i * 8 + 4);
        v4u o; o.x = pk2(a.x, a.y); o.y = pk2(a.z, a.w); o.z = pk2(b.x, b.y); o.w = pk2(b.z, b.w);
        *(GAS v4u*)(dst + i * 8) = o; }
}
__device__ __forceinline__ void p0_fp8_rows(Frame& F, const float* src, unsigned char* dst, float* iscale) {
    const int gw = F.bid * NWAVES + F.wave, NGW = F.G * NWAVES, lane = F.lane;
    for (int row = gw; row < 2 * 16384; row += NGW) {
        const float* r = src + (size_t)row * 1024 + 16 * lane;
        const f32x4 a = *(const GAS f32x4*)r, b = *(const GAS f32x4*)(r + 4), c = *(const GAS f32x4*)(r + 8), e = *(const GAS f32x4*)(r + 12);
        float am = fmaxf(fmaxf(fmaxf(fabsf(a.x), fabsf(a.y)), fmaxf(fabsf(a.z), fabsf(a.w))), fmaxf(fmaxf(fabsf(b.x), fabsf(b.y)), fmaxf(fabsf(b.z), fabsf(b.w))));
        am = fmaxf(am, fmaxf(fmaxf(fmaxf(fabsf(c.x), fabsf(c.y)), fmaxf(fabsf(c.z), fabsf(c.w))), fmaxf(fmaxf(fabsf(e.x), fabsf(e.y)), fmaxf(fabsf(e.z), fabsf(e.w)))));
        am = wave_max(am);
        const float sc = am > 1e-30f ? exp2f(floorf(log2f(256.f / am))) : 1.f;
        int w0 = 0, w1 = 0, w2 = 0, w3 = 0;
        w0 = __builtin_amdgcn_cvt_pk_fp8_f32(a.x * sc, a.y * sc, w0, false); w0 = __builtin_amdgcn_cvt_pk_fp8_f32(a.z * sc, a.w * sc, w0, true);
        w1 = __builtin_amdgcn_cvt_pk_fp8_f32(b.x * sc, b.y * sc, w1, false); w1 = __builtin_amdgcn_cvt_pk_fp8_f32(b.z * sc, b.w * sc, w1, true);
        w2 = __builtin_amdgcn_cvt_pk_fp8_f32(c.x * sc, c.y * sc, w2, false); w2 = __builtin_amdgcn_cvt_pk_fp8_f32(c.z * sc, c.w * sc, w2, true);
        w3 = __builtin_amdgcn_cvt_pk_fp8_f32(e.x * sc, e.y * sc, w3, false); w3 = __builtin_amdgcn_cvt_pk_fp8_f32(e.z * sc, e.w * sc, w3, true);
        const int layer = row >> 14, er = row & 16383;
        v4u o; o.x = (unsigned)w0; o.y = (unsigned)w1; o.z = (unsigned)w2; o.w = (unsigned)w3;
        *(GAS v4u*)(dst + ((size_t)((layer * 8 + (lane >> 3)) * 16384 + er)) * 128 + 16 * (lane & 7)) = o;
        if (lane == 0) iscale[row] = 1.f / sc;
    }
}
__device__ __forceinline__ void p0_prologue(Frame& F, const Args& A) {
    {
        const float* c = A.in[1]; const float* aw = A.in[2]; const float* ab = A.in[3]; float* MOD = WSP(float, WS_MOD);
        LAS float* red = (LAS float*)F.lds;
        for (int item = F.bid; item < 192; item += F.G) {
            const int l = item / 96, n0 = (item % 96) * 64;
            float acc[4] = {0.f, 0.f, 0.f, 0.f};
            const int kbeg = F.wave * 128;
#pragma unroll 4
            for (int k = kbeg; k < kbeg + 128; ++k) {
                const float wv = aw[((size_t)l * 1024 + k) * 6144 + n0 + F.lane];
#pragma unroll
                for (int b = 0; b < 4; ++b) acc[b] += silu_f(c[b * 1024 + k]) * wv;
            }
#pragma unroll
            for (int b = 0; b < 4; ++b) red[(F.wave * 4 + b) * 64 + F.lane] = acc[b];
            __syncthreads();
            if (F.tid < 256) { const int b = F.tid >> 6, ln = F.tid & 63; float s = ab[l * 6144 + n0 + ln];
#pragma unroll
                for (int w = 0; w < 8; ++w) s += red[(w * 4 + b) * 64 + ln];
                MOD[(size_t)(l * 4 + b) * 6144 + n0 + ln] = s; }
            __syncthreads();
        }
    }
    {
        LAS float* scr = (LAS float*)(F.lds + F.wave * 8704);
        const int gw = F.bid * NWAVES + F.wave, NGW = F.G * NWAVES;
        constexpr int I_IN0 = 16 * (NZ0 / 32), I_OUT = 16 * 32, I_IN1 = 16 * (NZ1 / 32), I_Q = 16 * (NQ / 32);
        constexpr int NITEMS = I_IN0 + 2 * I_OUT + I_IN1 + 2 * I_Q;
        for (int it = gw; it < NITEMS; it += NGW) {
            int r = it;
            if (r < I_IN0) { p0_transpose_item(A.in[6], D, SRC_IN0, NZ0 / 32, 2048, 8, WSP(bf16, WS_WIN0), scr, r, F.lane); continue; } r -= I_IN0;
            if (r < I_OUT) { p0_transpose_item(A.in[13], D, D, 32, 1 << 30, 0, WSP(bf16, WS_WOUT0), scr, r, F.lane); continue; } r -= I_OUT;
            if (r < I_IN1) { p0_transpose_item(A.in[14], D, NZ1, NZ1 / 32, 1 << 30, 0, WSP(bf16, WS_WIN1), scr, r, F.lane); continue; } r -= I_IN1;
            if (r < I_OUT) { p0_transpose_item(A.in[19], D, D, 32, 1 << 30, 0, WSP(bf16, WS_WOUT1), scr, r, F.lane); continue; } r -= I_OUT;
            if (r < I_Q) { p0_transpose_item(A.in[20], D, NQ, NQ / 32, 1 << 30, 0, WSP(bf16, WS_WQ), scr, r, F.lane); continue; } r -= I_Q;
            p0_transpose_item(A.in[20] + (size_t)D * NQ, D, NQ, NQ / 32, 1 << 30, 0, WSP(bf16, WS_WQ) + (size_t)NQ * D, scr, r, F.lane);
        }
    }
    {
        const size_t gtid = (size_t)F.bid * NTHR + F.tid, gth = (size_t)F.G * NTHR;
        cvt_f32_bf16_stream(A.in[21], WSP(bf16, WS_KEYS), (size_t)2 * 2 * 128 * 128 / 8, gtid, gth);
        p0_fp8_rows(F, A.in[22], F.ws + WS_UB, WSP(float, WS_ISU));
        p0_fp8_rows(F, A.in[23], F.ws + WS_VB, WSP(float, WS_ISV));
    }
}

template <bool GATES>
__device__ __forceinline__ void norm_pass(Frame& F, const Args& A, const float* X, const float* g, const float* mod, int shc, bf16* XN) {
    LAS float* wgT = (LAS float*)F.lds;
    if (GATES) {
        const float* win = A.in[6];
        for (int i = F.tid; i < 8 * 1024; i += NTHR) { const int cg = i >> 10, k = i & 1023; wgT[i] = win[(size_t)k * SRC_IN0 + 2048 + cg]; }
        __syncthreads();
    }
    const int gw = F.bid * NWAVES + F.wave, NGW = F.G * NWAVES;
    for (int row = gw; row < M; row += NGW) {
        const int b = row >> 13;
        const GAS f32x4* xr = (const GAS f32x4*)(X + (size_t)row * D) + F.lane;
        f32x4 v[4]; float ss = 0.f;
#pragma unroll
        for (int j = 0; j < 4; ++j) { v[j] = xr[64 * j]; ss += (v[j].x * v[j].x + v[j].y * v[j].y) + (v[j].z * v[j].z + v[j].w * v[j].w); }
        const float rstd = rsqrtf(wave_sum(ss) * (1.f / D) + EPS);
        const float* shp = mod + (size_t)b * 6144 + shc * 1024; const float* scp = shp + 1024;
#pragma unroll
        for (int j = 0; j < 4; ++j) { const int c = 4 * F.lane + 256 * j;
            const f32x4 gg = *(const f32x4*)(g + c), sc = *(const f32x4*)(scp + c), sh = *(const f32x4*)(shp + c);
            v[j] = v[j] * rstd * gg * (sc + 1.f) + sh;
            v2u o; o.x = pk2(v[j].x, v[j].y); o.y = pk2(v[j].z, v[j].w);
            *(GAS v2u*)(XN + (size_t)row * D + c) = o; }
        if (GATES) {
            float* GT = WSP(float, WS_GATES);
#pragma unroll
            for (int cg = 0; cg < 8; ++cg) { float p = 0.f;
#pragma unroll
                for (int j = 0; j < 4; ++j) { const f32x4 w = *(const LAS f32x4*)(wgT + cg * 1024 + 4 * F.lane + 256 * j); p += (v[j].x * w.x + v[j].y * w.y) + (v[j].z * w.z + v[j].w * w.w); }
                p = wave_sum(p);
                if (F.lane == 0) GT[(size_t)row * 8 + cg] = p + (cg < 4 ? A.in[8][cg] : A.in[9][cg - 4]); }
        }
    }
}

__device__ __forceinline__ void qknorm_unit(Frame& F, bf16* Z, int ldz, int row0, int col0, const float* g, float* kmean  ) {
    const int c = col0 + 8 * F.lane, d0 = (8 * F.lane) & 63;
    float gv[8];
#pragma unroll
    for (int i = 0; i < 8; ++i) gv[i] = g[d0 + i];
    float ks[8] = {0.f, 0.f, 0.f, 0.f, 0.f, 0.f, 0.f, 0.f};
    for (int r = 0; r < 32; ++r) {
        bf16* p = Z + (size_t)(row0 + F.wave * 32 + r) * ldz + c;
        const v4u w = *(const GAS v4u*)p;
        float x[8] = {bflo(w.x), bfhi(w.x), bflo(w.y), bfhi(w.y), bflo(w.z), bfhi(w.z), bflo(w.w), bfhi(w.w)};
        float ss = 0.f;
#pragma unroll
        for (int i = 0; i < 8; ++i) ss += x[i] * x[i];
        ss += __shfl_xor(ss, 1); ss += __shfl_xor(ss, 2); ss += __shfl_xor(ss, 4);
        const float rstd = rsqrtf(ss * (1.f / 64.f) + EPS);
#pragma unroll
        for (int i = 0; i < 8; ++i) { x[i] = x[i] * rstd * gv[i]; ks[i] += x[i]; }
        v4u o; o.x = pk2(x[0], x[1]); o.y = pk2(x[2], x[3]); o.z = pk2(x[4], x[5]); o.w = pk2(x[6], x[7]);
        *(GAS v4u*)p = o;
    }
    if (kmean) {
        LAS float* red = (LAS float*)F.lds;
#pragma unroll
        for (int i = 0; i < 8; ++i) red[F.wave * 512 + 8 * F.lane + i] = ks[i];
        __syncthreads();
        { float s = 0.f;
#pragma unroll
          for (int w = 0; w < 8; ++w) s += red[w * 512 + F.tid];
          kmean[(size_t)(F.tid >> 6) * (32 * 64) + (F.tid & 63)] = s * (1.f / 256.f); }
        __syncthreads();
    }
}
constexpr int KSTRB = 144;
template <int DV> struct VStr { static constexpr int B = (DV == 64) ? 192 : 320; };
typedef short v4i16_t __attribute__((ext_vector_type(4)));
__device__ __forceinline__ s16x4 vtr(const LAS unsigned char* p) { return __builtin_bit_cast(s16x4, __builtin_amdgcn_ds_read_tr16_b64_v4i16((LAS v4i16_t*)p)); }
__device__ __forceinline__ unsigned cvtpk(float lo, float hi) { typedef float f2 __attribute__((ext_vector_type(2))); typedef __bf16 b2 __attribute__((ext_vector_type(2)));
    f2 v = {lo, hi}; b2 b = __builtin_convertvector(v, b2); return __builtin_bit_cast(unsigned, b); }
__device__ __forceinline__ float xhalf(float v) {
    auto rr = __builtin_amdgcn_permlane32_swap(__builtin_bit_cast(unsigned, v), __builtin_bit_cast(unsigned, v), false, false);
    const unsigned r0 = rr[0], r1 = rr[1]; return u2f((threadIdx.x & 32) ? r0 : r1);
}
template <int DV> struct AttnSt { f32x16 o[DV / 32]; float m, l; };
template <int DV> __device__ __forceinline__ void attn_init(AttnSt<DV>& st) {
#pragma unroll
    for (int t = 0; t < DV / 32; ++t)
#pragma unroll
        for (int r = 0; r < 16; ++r) st.o[t][r] = 0.f;
    st.m = -1e30f; st.l = 0.f;
}
template <int DV>
__device__ __forceinline__ void attn_tile(AttnSt<DV>& st, const LAS unsigned char* Kt, const LAS unsigned char* Vt, const bf16x8 (&qf)[4], float sc2, float sl2, int tq, int kt0, bool diag, bool rowok, int lane) {
    const int r32 = lane & 31, hi = lane >> 5;
    f32x16 s0, s1;
#pragma unroll
    for (int r = 0; r < 16; ++r) { s0[r] = 0.f; s1[r] = 0.f; }
    const LAS unsigned char* kp = Kt + r32 * KSTRB + hi * 16;
#pragma unroll
    for (int ks = 0; ks < 4; ++ks) {
        const bf16x8 k0 = *(const LAS bf16x8*)(kp + ks * 32), k1 = *(const LAS bf16x8*)(kp + 32 * KSTRB + ks * 32);
        s0 = __builtin_amdgcn_mfma_f32_32x32x16_bf16(k0, qf[ks], s0, 0, 0, 0);
        s1 = __builtin_amdgcn_mfma_f32_32x32x16_bf16(k1, qf[ks], s1, 0, 0, 0);
    }
    const int kb = kt0 + 4 * hi;
    const float c0 = -sl2 * (float)(tq - kb);
    float mx = -INFINITY;
#pragma unroll
    for (int r = 0; r < 16; ++r) {
        const int ko = (r & 3) + 8 * (r >> 2);
        float a = s0[r] * sc2 + (c0 + sl2 * (float)ko), b = s1[r] * sc2 + (c0 + sl2 * (float)(ko + 32));
        if (diag) { if (kb + ko > tq) a = -INFINITY; if (kb + ko + 32 > tq) b = -INFINITY; }
        if (!rowok) { a = -INFINITY; b = -INFINITY; }
        s0[r] = a; s1[r] = b; mx = fmaxf(mx, fmaxf(a, b));
    }
    mx = fmaxf(mx, xhalf(mx));
    const float mn = fmaxf(st.m, mx);
    const float alpha = __builtin_amdgcn_exp2f(st.m - mn);
    st.m = mn;
    float ps = 0.f;
#pragma unroll
    for (int r = 0; r < 16; ++r) { s0[r] = __builtin_amdgcn_exp2f(s0[r] - mn); s1[r] = __builtin_amdgcn_exp2f(s1[r] - mn); ps += s0[r] + s1[r]; }
    st.l = st.l * alpha + ps;
#pragma unroll
    for (int t = 0; t < DV / 32; ++t)
#pragma unroll
        for (int r = 0; r < 16; ++r) st.o[t][r] *= alpha;
    bf16x8 pf[2][2];
#pragma unroll
    for (int s = 0; s < 2; ++s) {
        v4u a, b;
        a.x = cvtpk(s0[8 * s + 0], s0[8 * s + 1]); a.y = cvtpk(s0[8 * s + 2], s0[8 * s + 3]); a.z = cvtpk(s0[8 * s + 4], s0[8 * s + 5]); a.w = cvtpk(s0[8 * s + 6], s0[8 * s + 7]);
        b.x = cvtpk(s1[8 * s + 0], s1[8 * s + 1]); b.y = cvtpk(s1[8 * s + 2], s1[8 * s + 3]); b.z = cvtpk(s1[8 * s + 4], s1[8 * s + 5]); b.w = cvtpk(s1[8 * s + 6], s1[8 * s + 7]);
        pf[0][s] = __builtin_bit_cast(bf16x8, a); pf[1][s] = __builtin_bit_cast(bf16x8, b);
    }
    constexpr int VS = VStr<DV>::B;
    const int g = lane >> 4, i16 = lane & 15;
    const LAS unsigned char* vp = Vt + (4 * (g >> 1) + (i16 >> 2)) * VS + (16 * (g & 1) + 4 * (i16 & 3)) * 2;
#pragma unroll
    for (int kbk = 0; kbk < 2; ++kbk)
#pragma unroll
        for (int s = 0; s < 2; ++s)
#pragma unroll
            for (int t = 0; t < DV / 32; ++t) {
                const s16x4 lo = vtr(vp + (kbk * 32 + 16 * s) * VS + t * 64), h8 = vtr(vp + (kbk * 32 + 16 * s + 8) * VS + t * 64);
                const bf16x8 va = {lo[0], lo[1], lo[2], lo[3], h8[0], h8[1], h8[2], h8[3]};
                st.o[t] = __builtin_amdgcn_mfma_f32_32x32x16_bf16(va, pf[kbk][s], st.o[t], 0, 0, 0);
            }
}
template <int NK, int DV> struct TileRegs { v4u k[NK]; v4u v[DV / 64]; };
template <int NK, int DV>
__device__ __forceinline__ void tile_load(TileRegs<NK, DV>& R, const bf16* Z, int ldz, size_t zrow0, int kcol, int vcol, int tid) {
#pragma unroll
    for (int i = 0; i < NK; ++i) { const int ch = tid + 512 * i; const int row = ch / (8 * NK), cc = ch % (8 * NK);
        R.k[i] = *(const GAS v4u*)(Z + (zrow0 + row) * ldz + kcol + cc * 8); }
#pragma unroll
    for (int i = 0; i < DV / 64; ++i) { const int ch = tid + 512 * i; const int row = ch / (DV / 8), cc = ch % (DV / 8);
        R.v[i] = *(const GAS v4u*)(Z + (zrow0 + row) * ldz + vcol + cc * 8); }
}
template <int NK, int DV>
__device__ __forceinline__ void tile_store(const TileRegs<NK, DV>& R, LAS unsigned char* Kt  , LAS unsigned char* Vt, int tid) {
#pragma unroll
    for (int i = 0; i < NK; ++i) { const int ch = tid + 512 * i; const int row = ch / (8 * NK), cc = ch % (8 * NK);
        *(LAS v4u*)(Kt + (cc >> 3) * (64 * KSTRB) + row * KSTRB + (cc & 7) * 16) = R.k[i]; }
#pragma unroll
    for (int i = 0; i < DV / 64; ++i) { const int ch = tid + 512 * i; const int row = ch / (DV / 8), cc = ch % (DV / 8);
        *(LAS v4u*)(Vt + row * VStr<DV>::B + cc * 16) = R.v[i]; }
}
__device__ __forceinline__ void moba_unit(Frame& F, int b, int h, int j) {
    const bf16* Z = WSP(bf16, WS_Z); constexpr int ldz = NZ0;
    const int lane = F.lane, w = F.wave, r32 = lane & 31, hi = lane >> 5, tid = F.tid;
    const size_t rowb = (size_t)b * SEQ;
    const int qpos = j * 256 + w * 32 + r32;
    const int qcol = 2048 + h * 64, kcol = 2560 + h * 64, vcol = 3072 + h * 64;
    LAS unsigned char* lds = F.lds;
    constexpr int BUFB = 64 * KSTRB + 64 * VStr<64>::B;
    LAS unsigned char* kmh = lds + 2 * BUFB;
    LAS unsigned char* kml = lds + 2 * BUFB + 32 * KSTRB;
    LAS unsigned* msk = (LAS unsigned*)(lds + 2 * BUFB + 64 * KSTRB);
    { const float* KM = WSP(float, WS_KMEAN) + (size_t)((b * 8 + h) * 32) * 64; const f32x4 x = *(const f32x4*)(KM + 4 * tid);
      const int n = tid >> 4, d0 = (tid & 15) * 4;
      const unsigned h0 = f2bf(x.x), h1 = f2bf(x.y), h2 = f2bf(x.z), h3 = f2bf(x.w);
      v2u hv; hv.x = h0 | (h1 << 16); hv.y = h2 | (h3 << 16);
      v2u lv; lv.x = pk2(x.x - u2f(h0 << 16), x.y - u2f(h1 << 16)); lv.y = pk2(x.z - u2f(h2 << 16), x.w - u2f(h3 << 16));
      *(LAS v2u*)(kmh + n * KSTRB + d0 * 2) = hv; *(LAS v2u*)(kml + n * KSTRB + d0 * 2) = lv; }
    if (tid < 16) msk[tid] = 0u;
    bf16x8 qf[4];
    const bf16* qrow = Z + (rowb + qpos) * ldz + qcol;
#pragma unroll
    for (int ks = 0; ks < 4; ++ks) qf[ks] = *(const GAS bf16x8*)(qrow + 16 * ks + 8 * hi);
    __syncthreads();
    f32x16 gt;
#pragma unroll
    for (int r = 0; r < 16; ++r) gt[r] = 0.f;
#pragma unroll
    for (int ks = 0; ks < 4; ++ks) {
        const bf16x8 a = *(const LAS bf16x8*)(kmh + r32 * KSTRB + hi * 16 + ks * 32), c = *(const LAS bf16x8*)(kml + r32 * KSTRB + hi * 16 + ks * 32);
        gt = __builtin_amdgcn_mfma_f32_32x32x16_bf16(a, qf[ks], gt, 0, 0, 0);
        gt = __builtin_amdgcn_mfma_f32_32x32x16_bf16(c, qf[ks], gt, 0, 0, 0);
    }
    float t0 = -INFINITY, t1 = -INFINITY, t2 = -INFINITY;
#define INS3(key) do { float k_ = (key); float a_ = fmaxf(t0, k_), l_ = fminf(t0, k_); t0 = a_; a_ = fmaxf(t1, l_); l_ = fminf(t1, l_); t1 = a_; t2 = fmaxf(t2, l_); } while (0)
#pragma unroll
    for (int r = 0; r < 16; ++r) { const int n = (r & 3) + 8 * (r >> 2) + 4 * hi;
        const float key = (n < j) ? u2f((f2u(gt[r]) & ~31u) | (unsigned)n) : -INFINITY; INS3(key); }
    { const float p0 = xhalf(t0), p1 = xhalf(t1), p2 = xhalf(t2); INS3(p0); INS3(p1); INS3(p2); }
#undef INS3
    const int sel0 = (t0 > -INFINITY) ? (int)(f2u(t0) & 31u) : -1;
    const int sel1 = (t1 > -INFINITY) ? (int)(f2u(t1) & 31u) : -1;
    const int sel2 = (t2 > -INFINITY) ? (int)(f2u(t2) & 31u) : -1;
    { const unsigned mm = (sel0 >= 0 ? 1u << sel0 : 0u) | (sel1 >= 0 ? 1u << sel1 : 0u) | (sel2 >= 0 ? 1u << sel2 : 0u);
      if (mm) { __hip_atomic_fetch_or(msk + w, mm, __ATOMIC_RELAXED, __HIP_MEMORY_SCOPE_WORKGROUP); __hip_atomic_fetch_or(msk + 8, mm, __ATOMIC_RELAXED, __HIP_MEMORY_SCOPE_WORKGROUP); } }
    __syncthreads();
    const unsigned bmask = msk[8]; const unsigned wmask = (unsigned)__builtin_amdgcn_readfirstlane((int)msk[w]);
    const float sl2 = ldexpf(1.f, -(h + 1)) * LOG2E, sc2 = 0.125f * LOG2E;
    AttnSt<64> st; attn_init<64>(st);
    unsigned rem = bmask;
    int blk = rem ? __builtin_ctz(rem) : j; if (rem) rem &= rem - 1;
    int kt = 0, buf = 0;
    TileRegs<1, 64> R;
    tile_load<1, 64>(R, Z, ldz, rowb + blk * 256 + kt * 64, kcol, vcol, tid);
    tile_store<1, 64>(R, lds, lds + 64 * KSTRB, tid);
    __syncthreads();
    for (;;) {
        int nblk = blk, nkt = kt + 1; bool has_next = true;
        if (nkt == 4) { nkt = 0; if (blk == j) has_next = false; else if (rem) { nblk = __builtin_ctz(rem); rem &= rem - 1; } else nblk = j; }
        if (has_next) tile_load<1, 64>(R, Z, ldz, rowb + nblk * 256 + nkt * 64, kcol, vcol, tid);
        const bool own = (blk == j);
        const bool active = own ? (kt * 64 <= w * 32 + 31) : (((wmask >> blk) & 1u) != 0u);
        if (active) {
            const bool rowok = own || blk == sel0 || blk == sel1 || blk == sel2;
            const bool diag = own && (kt * 64 + 63 > w * 32);
            attn_tile<64>(st, lds + buf * BUFB, lds + buf * BUFB + 64 * KSTRB, qf, sc2, sl2, qpos, blk * 256 + kt * 64, diag, rowok, lane);
        }
        if (!has_next) break;
        tile_store<1, 64>(R, lds + (buf ^ 1) * BUFB, lds + (buf ^ 1) * BUFB + 64 * KSTRB, tid);
        __syncthreads();
        buf ^= 1; blk = nblk; kt = nkt;
    }
    const float inv = 1.f / (st.l + xhalf(st.l));
    bf16* Y = WSP(bf16, WS_XNY) + (rowb + qpos) * 1024 + 512 + h * 64;
#pragma unroll
    for (int t = 0; t < 2; ++t)
#pragma unroll
        for (int rg = 0; rg < 4; ++rg) { v2u o; o.x = pk2(st.o[t][4 * rg] * inv, st.o[t][4 * rg + 1] * inv); o.y = pk2(st.o[t][4 * rg + 2] * inv, st.o[t][4 * rg + 3] * inv);
            *(GAS v2u*)(Y + t * 32 + 8 * rg + 4 * hi) = o; }
    __syncthreads();
}

__device__ __forceinline__ void diff_unit(Frame& F, const Args& A, int b, int h, int qt, float lam) {
    const bf16* Z = WSP(bf16, WS_Z); constexpr int ldz = NZ1;
    const int lane = F.lane, w = F.wave, r32 = lane & 31, hi = lane >> 5, tid = F.tid;
    const int comp = w >> 2, wq = w & 3;
    const size_t rowb = (size_t)b * SEQ;
    const int q0 = qt * 128, qpos = q0 + wq * 32 + r32;
    const int qcol = h * 128 + comp * 64, kcol = 1024 + h * 128, vcol = 2048 + h * 128;
    LAS unsigned char* lds = F.lds;
    constexpr int BUFB = 2 * 64 * KSTRB + 64 * VStr<128>::B;
    bf16x8 qf[4];
    const bf16* qrow = Z + (rowb + qpos) * ldz + qcol;
#pragma unroll
    for (int ks = 0; ks < 4; ++ks) qf[ks] = *(const GAS bf16x8*)(qrow + 16 * ks + 8 * hi);
    const float sl2 = ldexpf(1.f, -(h + 1)) * LOG2E, sc2 = 0.125f * LOG2E;
    AttnSt<128> st; attn_init<128>(st);
    const int nt = (q0 + 128) / 64;
    TileRegs<2, 128> R;
    tile_load<2, 128>(R, Z, ldz, rowb, kcol, vcol, tid);
    tile_store<2, 128>(R, lds, lds + 2 * 64 * KSTRB, tid);
    __syncthreads();
    int buf = 0;
    for (int kt = 0; kt < nt; ++kt) {
        const bool has_next = kt + 1 < nt;
        if (has_next) tile_load<2, 128>(R, Z, ldz, rowb + (size_t)(kt + 1) * 64, kcol, vcol, tid);
        if (kt * 64 <= q0 + wq * 32 + 31) {
            const bool diag = kt * 64 + 63 > q0 + wq * 32;
            attn_tile<128>(st, lds + buf * BUFB + comp * (64 * KSTRB), lds + buf * BUFB + 2 * 64 * KSTRB, qf, sc2, sl2, qpos, kt * 64, diag, true, lane);
        }
        if (has_next) { tile_store<2, 128>(R, lds + (buf ^ 1) * BUFB, lds + (buf ^ 1) * BUFB + 2 * 64 * KSTRB, tid); }
        __syncthreads();
        buf ^= 1;
    }
    const float inv = 1.f / (st.l + xhalf(st.l));
    LAS float* o2 = (LAS float*)lds;
    if (comp == 1) {
#pragma unroll
        for (int t = 0; t < 4; ++t)
#pragma unroll
            for (int r = 0; r < 16; ++r) o2[((wq * 4 + t) * 16 + r) * 64 + lane] = st.o[t][r] * inv;
    }
    __syncthreads();
    if (comp == 0) {
        float ss = 0.f;
#pragma unroll
        for (int t = 0; t < 4; ++t)
#pragma unroll
            for (int r = 0; r < 16; ++r) { const float v = st.o[t][r] * inv - lam * o2[((wq * 4 + t) * 16 + r) * 64 + lane]; st.o[t][r] = v; ss += v * v; }
        ss += xhalf(ss);
        const float rs = rsqrtf(ss * (1.f / 128.f) + EPS) * 0.6444909324090307f;
        const float* og = A.in[18];
        bf16* Y = WSP(bf16, WS_XNY) + (rowb + qpos) * 1024 + h * 128;
#pragma unroll
        for (int t = 0; t < 4; ++t)
#pragma unroll
            for (int rg = 0; rg < 4; ++rg) { const int dv = t * 32 + 8 * rg + 4 * hi; const f32x4 gg = *(const f32x4*)(og + dv);
                v2u o; o.x = pk2(st.o[t][4 * rg] * rs * gg.x, st.o[t][4 * rg + 1] * rs * gg.y); o.y = pk2(st.o[t][4 * rg + 2] * rs * gg.z, st.o[t][4 * rg + 3] * rs * gg.w);
                *(GAS v2u*)(Y + dv) = o; }
    }
    __syncthreads();
}
template <int MT, int NT>
__device__ __forceinline__ void mma_nt(const LAS unsigned char* A, int lda, const LAS unsigned char* B, int ldb, int K, f32x4 (&acc)[MT][NT], int lane) {
    const int r = lane & 15, kq = (lane >> 4) * 16;
    for (int k0 = 0; k0 < K; k0 += 32) {
        bf16x8 a[MT], bb[NT];
#pragma unroll
        for (int m = 0; m < MT; ++m) a[m] = *(const LAS bf16x8*)(A + (m * 16 + r) * lda + k0 * 2 + kq);
#pragma unroll
        for (int n = 0; n < NT; ++n) bb[n] = *(const LAS bf16x8*)(B + (n * 16 + r) * ldb + k0 * 2 + kq);
#pragma unroll
        for (int m = 0; m < MT; ++m)
#pragma unroll
            for (int n = 0; n < NT; ++n) acc[m][n] = __builtin_amdgcn_mfma_f32_16x16x32_bf16(a[m], bb[n], acc[m][n], 0, 0, 0);
    }
}
constexpr int TS = 272;
constexpr int TILEB = 128 * TS;
constexpr int ML_Q = 0, ML_K = TILEB, ML_V = 2 * TILEB, ML_SM = 3 * TILEB;

__device__ __forceinline__ void ml_gates(const float* GT, size_t row0, int hm, LAS float* sm, int lane) {
    const float i0 = GT[(row0 + 2 * lane) * 8 + hm], i1 = GT[(row0 + 2 * lane + 1) * 8 + hm];
    const float f0 = logsigmoid_f(GT[(row0 + 2 * lane) * 8 + 4 + hm]), f1 = logsigmoid_f(GT[(row0 + 2 * lane + 1) * 8 + 4 + hm]);
    float s = f0 + f1;
#pragma unroll
    for (int o = 1; o < 64; o <<= 1) { const float t = __shfl_up(s, o); if (lane >= o) s += t; }
    const float excl = s - (f0 + f1);
    sm[2 * lane] = excl + f0; sm[2 * lane + 1] = excl + f0 + f1;
    sm[128 + 2 * lane] = i0; sm[128 + 2 * lane + 1] = i1;
}
template <bool TRANSPOSE>
__device__ __forceinline__ void ml_conv_tile(const bf16* Z, size_t rowb, int t0, int zc, const float* cw, int wc, float mul, LAS unsigned char* dst, const LAS float* rs, int tid) {
#pragma unroll
    for (int it = 0; it < 4; ++it) {
        const int item = tid + 512 * it, l = item >> 4, ch = (item & 15) * 8;
        float acc[8];
#pragma unroll
        for (int i = 0; i < 8; ++i) acc[i] = 0.f;
#pragma unroll
        for (int jj = 0; jj < 4; ++jj) {
            const int t = t0 + l - 3 + jj;
            if (t >= 0) {
                const v4u w = *(const GAS v4u*)(Z + (rowb + t) * NZ0 + zc + ch);
                const float x[8] = {bflo(w.x), bfhi(w.x), bflo(w.y), bfhi(w.y), bflo(w.z), bfhi(w.z), bflo(w.w), bfhi(w.w)};
                const f32x4 c0 = *(const f32x4*)(cw + jj * 1024 + wc + ch), c1 = *(const f32x4*)(cw + jj * 1024 + wc + ch + 4);
                acc[0] += x[0] * c0.x; acc[1] += x[1] * c0.y; acc[2] += x[2] * c0.z; acc[3] += x[3] * c0.w;
                acc[4] += x[4] * c1.x; acc[5] += x[5] * c1.y; acc[6] += x[6] * c1.z; acc[7] += x[7] * c1.w;
            }
        }
        const float sc = TRANSPOSE ? mul * rs[l] : mul;
#pragma unroll
        for (int i = 0; i < 8; ++i) acc[i] = silu_f(acc[i]) * sc;
        if (TRANSPOSE) {
#pragma unroll
            for (int i = 0; i < 8; ++i) *(LAS bf16*)(dst + (ch + i) * TS + l * 2) = (bf16)f2bf(acc[i]);
        } else {
            v4u o; o.x = pk2(acc[0], acc[1]); o.y = pk2(acc[2], acc[3]); o.z = pk2(acc[4], acc[5]); o.w = pk2(acc[6], acc[7]);
            *(LAS v4u*)(dst + l * TS + ch * 2) = o;
        }
    }
}
__device__ __forceinline__ void ml_vt_tile(const bf16* Z, size_t row0, int zc, LAS unsigned char* dst, int tid) {
#pragma unroll
    for (int it = 0; it < 4; ++it) {
        const int item = tid + 512 * it, l = item >> 4, ch = (item & 15) * 8;
        const v4u w = *(const GAS v4u*)(Z + (row0 + l) * NZ0 + zc + ch);
        const unsigned ww[4] = {w.x, w.y, w.z, w.w};
#pragma unroll
        for (int i = 0; i < 4; ++i) { *(LAS bf16*)(dst + (ch + 2 * i) * TS + l * 2) = (bf16)(ww[i] & 0xffffu); *(LAS bf16*)(dst + (ch + 2 * i + 1) * TS + l * 2) = (bf16)(ww[i] >> 16); }
    }
}
__device__ __forceinline__ void mlstm_a_unit(Frame& F, const Args& A, int unit) {
    const int c = unit & 63, bh = unit >> 6, hm = bh & 3, b = bh >> 2;
    const bf16* Z = WSP(bf16, WS_Z); const float* GT = WSP(float, WS_GATES);
    const size_t rowb = (size_t)b * SEQ; const int t0 = c * 128;
    LAS unsigned char* lds = F.lds; LAS float* sm = (LAS float*)(lds + ML_SM);
    if (F.wave == 0) {
        ml_gates(GT, rowb + t0, hm, sm, F.lane);
        LDS_WAIT();
        const float bend = sm[127];
        const float w0 = bend - sm[2 * F.lane] + sm[128 + 2 * F.lane], w1 = bend - sm[2 * F.lane + 1] + sm[128 + 2 * F.lane + 1];
        const float ml = wave_max(fmaxf(w0, w1));
        sm[256 + 2 * F.lane] = __expf(w0 - ml); sm[256 + 2 * F.lane + 1] = __expf(w1 - ml);
        if (F.lane == 0) { WSP(float, WS_BEND)[unit] = bend; WSP(float, WS_MLOC)[unit] = ml; }
    }
    __syncthreads();
    ml_conv_tile<true>(Z, rowb, t0, 512 + hm * 128, A.in[7], 512 + hm * 128, 0.08838834764831845f, lds + ML_K, sm + 256, F.tid);
    ml_vt_tile(Z, rowb + t0, 1024 + hm * 128, lds + ML_V, F.tid);
    __syncthreads();
    f32x4 acc[2][4];
#pragma unroll
    for (int m = 0; m < 2; ++m)
#pragma unroll
        for (int n = 0; n < 4; ++n) acc[m][n] = (f32x4){0.f, 0.f, 0.f, 0.f};
    const int dv0 = 32 * (F.wave >> 1), dk0 = 64 * (F.wave & 1);
    mma_nt<2, 4>(lds + ML_V + dv0 * TS, TS, lds + ML_K + dk0 * TS, TS, 128, acc, F.lane);
    float* CL = WSP(float, WS_CLOC) + (size_t)unit * 16384;
#pragma unroll
    for (int m = 0; m < 2; ++m)
#pragma unroll
        for (int n = 0; n < 4; ++n)
#pragma unroll
            for (int i = 0; i < 4; ++i) CL[(size_t)(dv0 + 16 * m + 4 * (F.lane >> 4) + i) * 128 + dk0 + 16 * n + (F.lane & 15)] = acc[m][n][i];
    if (F.tid < 128) { float s = 0.f; const LAS bf16* kr = (const LAS bf16*)(lds + ML_K + F.tid * TS);
        for (int l = 0; l < 128; ++l) s += bf2f(kr[l]);
        WSP(float, WS_NLOC)[(size_t)unit * 128 + F.tid] = s; }
    __syncthreads();
}
__device__ __forceinline__ void mlstm_scan_unit(Frame& F, int unit) {
    const int bh = unit >> 4, sl = unit & 15;
    LAS float* tab = (LAS float*)F.lds;
    if (F.tid == 0) {
        const float* BE = WSP(float, WS_BEND) + bh * 64; const float* ML = WSP(float, WS_MLOC) + bh * 64; float* MP = WSP(float, WS_MPREV) + bh * 64;
        float m = 0.f;
        for (int c = 0; c < 64; ++c) { const float be = BE[c], ml = ML[c]; const float mn = fmaxf(be + m, ml);
            tab[c] = __expf(be + m - mn); tab[64 + c] = __expf(ml - mn); if (sl == 0) MP[c] = m; m = mn; }
    }
    __syncthreads();
    float* CL = WSP(float, WS_CLOC) + (size_t)bh * 64 * 16384 + sl * 1024 + 2 * F.tid;
    float s0 = 0.f, s1 = 0.f;
#pragma unroll 8
    for (int c = 0; c < 64; ++c) { float2* p = (float2*)(CL + (size_t)c * 16384); const float2 v = *p; *p = make_float2(s0, s1);
        const float a = tab[c], sc = tab[64 + c]; s0 = a * s0 + sc * v.x; s1 = a * s1 + sc * v.y; }
    if (sl == 0 && F.tid < 128) { float* NL = WSP(float, WS_NLOC) + (size_t)bh * 64 * 128 + F.tid; float s = 0.f;
        for (int c = 0; c < 64; ++c) { const float v = NL[c * 128]; NL[c * 128] = s; s = tab[c] * s + tab[64 + c] * v; } }
    __syncthreads();
}
__device__ __forceinline__ void mlstm_c_unit(Frame& F, const Args& A, int unit) {
    const int c = unit & 63, bh = unit >> 6, hm = bh & 3, b = bh >> 2;
    const bf16* Z = WSP(bf16, WS_Z); const float* GT = WSP(float, WS_GATES);
    const size_t rowb = (size_t)b * SEQ; const int t0 = c * 128;
    LAS unsigned char* lds = F.lds; LAS float* sm = (LAS float*)(lds + ML_SM);
    const int lane = F.lane, w = F.wave, tid = F.tid;
    const float mprev = WSP(float, WS_MPREV)[unit];
    if (w == 0) {
        ml_gates(GT, rowb + t0, hm, sm, lane);
        LDS_WAIT();
        const float b0 = sm[2 * lane], b1 = sm[2 * lane + 1];
        const float g0 = sm[128 + 2 * lane] - b0, g1 = sm[128 + 2 * lane + 1] - b1;
        float pm = fmaxf(g0, g1);
#pragma unroll
        for (int o = 1; o < 64; o <<= 1) { const float t = __shfl_up(pm, o); if (lane >= o) pm = fmaxf(pm, t); }
        float pe = __shfl_up(pm, 1); if (lane == 0) pe = -INFINITY;
        const float M0 = fmaxf(mprev, fmaxf(pe, g0)), M1 = fmaxf(mprev, pm);
        sm[256 + 2 * lane] = g0; sm[256 + 2 * lane + 1] = g1;
        sm[384 + 2 * lane] = M0; sm[384 + 2 * lane + 1] = M1;
        sm[512 + 2 * lane] = __expf(mprev - M0); sm[512 + 2 * lane + 1] = __expf(mprev - M1);
        sm[640 + 2 * lane] = __expf(-b0 - M0); sm[640 + 2 * lane + 1] = __expf(-b1 - M1);
        sm[768 + 2 * lane] = 0.f; sm[768 + 2 * lane + 1] = 0.f; sm[896 + 2 * lane] = 0.f; sm[896 + 2 * lane + 1] = 0.f;
    }
    if (w == 1) { sm[1152 + lane] = WSP(float, WS_NLOC)[(size_t)unit * 128 + lane]; sm[1152 + 64 + lane] = WSP(float, WS_NLOC)[(size_t)unit * 128 + 64 + lane]; }
    ml_conv_tile<false>(Z, rowb, t0, hm * 128, A.in[7], hm * 128, 1.f, lds + ML_Q, nullptr, tid);
    ml_conv_tile<false>(Z, rowb, t0, 512 + hm * 128, A.in[7], 512 + hm * 128, 0.08838834764831845f, lds + ML_K, nullptr, tid);
    ml_vt_tile(Z, rowb + t0, 1024 + hm * 128, lds + ML_V, tid);
    __syncthreads();
    const int l0 = 32 * (w >> 1), c0 = 64 * (w & 1);
    const int lr = 4 * (lane >> 4), lc = lane & 15;
    if (tid < 128) { const LAS bf16* qr = (const LAS bf16*)(lds + ML_Q + tid * TS); float s = 0.f;
        for (int d = 0; d < 128; ++d) s += bf2f(qr[d]) * sm[1152 + d];
        sm[1024 + tid] = s; }
    f32x4 acc[2][4];
#pragma unroll
    for (int m = 0; m < 2; ++m)
#pragma unroll
        for (int n = 0; n < 4; ++n) acc[m][n] = (f32x4){0.f, 0.f, 0.f, 0.f};
    mma_nt<2, 4>(lds + ML_Q + l0 * TS, TS, lds + ML_K + c0 * TS, TS, 128, acc, lane);
#pragma unroll
    for (int m = 0; m < 2; ++m)
#pragma unroll
        for (int i = 0; i < 4; ++i) { const int l = l0 + 16 * m + lr + i; const float Ml = sm[384 + l]; float rsum = 0.f;
#pragma unroll
            for (int n = 0; n < 4; ++n) { const int s = c0 + 16 * n + lc; const float v = (s <= l) ? acc[m][n][i] * __expf(sm[256 + s] - Ml) : 0.f; acc[m][n][i] = v; rsum += v; }
            rsum += __shfl_xor(rsum, 1); rsum += __shfl_xor(rsum, 2); rsum += __shfl_xor(rsum, 4); rsum += __shfl_xor(rsum, 8);
            if (lc == 0) __hip_atomic_fetch_add(sm + 768 + l, rsum, __ATOMIC_RELAXED, __HIP_MEMORY_SCOPE_WORKGROUP); }
    __syncthreads();
#pragma unroll
    for (int m = 0; m < 2; ++m)
#pragma unroll
        for (int n = 0; n < 4; ++n)
#pragma unroll
            for (int i = 0; i < 4; ++i) *(LAS bf16*)(lds + ML_K + (l0 + 16 * m + lr + i) * TS + (c0 + 16 * n + lc) * 2) = (bf16)f2bf(acc[m][n][i]);
    __syncthreads();
    f32x4 ai[2][4], ae[2][4];
#pragma unroll
    for (int m = 0; m < 2; ++m)
#pragma unroll
        for (int n = 0; n < 4; ++n) { ai[m][n] = (f32x4){0.f, 0.f, 0.f, 0.f}; ae[m][n] = (f32x4){0.f, 0.f, 0.f, 0.f}; }
    mma_nt<2, 4>(lds + ML_K + l0 * TS, TS, lds + ML_V + c0 * TS, TS, 128, ai, lane);
    {
        const float* CP = WSP(float, WS_CLOC) + (size_t)unit * 16384;
        const int r = lane & 15, kq = (lane >> 4) * 8;
        for (int k0 = 0; k0 < 128; k0 += 32) {
            bf16x8 a[2], bb[4];
#pragma unroll
            for (int m = 0; m < 2; ++m) a[m] = *(const LAS bf16x8*)(lds + ML_Q + (l0 + m * 16 + r) * TS + (k0 + kq) * 2);
#pragma unroll
            for (int n = 0; n < 4; ++n) { const float* p = CP + (size_t)(c0 + n * 16 + r) * 128 + k0 + kq; const f32x4 x = *(const f32x4*)p, y = *(const f32x4*)(p + 4);
                v4u pk; pk.x = pk2(x.x, x.y); pk.y = pk2(x.z, x.w); pk.z = pk2(y.x, y.y); pk.w = pk2(y.z, y.w); bb[n] = __builtin_bit_cast(bf16x8, pk); }
#pragma unroll
            for (int m = 0; m < 2; ++m)
#pragma unroll
                for (int n = 0; n < 4; ++n) ae[m][n] = __builtin_amdgcn_mfma_f32_16x16x32_bf16(a[m], bb[n], ae[m][n], 0, 0, 0);
        }
    }
#pragma unroll
    for (int m = 0; m < 2; ++m)
#pragma unroll
        for (int i = 0; i < 4; ++i) { const int l = l0 + 16 * m + lr + i; const float wi = sm[512 + l];
            const float den = wi * sm[1024 + l] + sm[768 + l]; const float dinv = 1.f / fmaxf(fabsf(den), sm[640 + l]); float ssq = 0.f;
#pragma unroll
            for (int n = 0; n < 4; ++n) { const float hv = (wi * ae[m][n][i] + ai[m][n][i]) * dinv; ai[m][n][i] = hv; ssq += hv * hv; }
            ssq += __shfl_xor(ssq, 1); ssq += __shfl_xor(ssq, 2); ssq += __shfl_xor(ssq, 4); ssq += __shfl_xor(ssq, 8);
            if (lc == 0) __hip_atomic_fetch_add(sm + 896 + l, ssq, __ATOMIC_RELAXED, __HIP_MEMORY_SCOPE_WORKGROUP); }
    __syncthreads();
    const float* mg = A.in[10] + hm * 128;
    bf16* Y = WSP(bf16, WS_XNY);
#pragma unroll
    for (int m = 0; m < 2; ++m)
#pragma unroll
        for (int i = 0; i < 4; ++i) { const int l = l0 + 16 * m + lr + i; const float rstd = rsqrtf(sm[896 + l] * (1.f / 128.f) + EPS); const size_t row = rowb + t0 + l;
#pragma unroll
            for (int n = 0; n < 4; ++n) { const int dv = c0 + 16 * n + lc; const float og = sigmoid_f(bf2f(Z[row * NZ0 + 1536 + hm * 128 + dv]));
                Y[row * 1024 + hm * 128 + dv] = (bf16)f2bf(ai[m][n][i] * rstd * mg[dv] * og); } }
    __syncthreads();
}
template <int N> __device__ __forceinline__ void bitonic_sort_desc(float (&v)[N]) {
#pragma unroll
    for (int k = 2; k <= N; k <<= 1)
#pragma unroll
        for (int j = k >> 1; j > 0; j >>= 1)
#pragma unroll
            for (int i = 0; i < N; ++i) { const int l = i ^ j; if (l > i) { const bool desc = ((i & k) == 0); const float a = v[i], b = v[l]; const float mx = fmaxf(a, b), mn = fminf(a, b); v[i] = desc ? mx : mn; v[l] = desc ? mn : mx; } }
}
__device__ __forceinline__ void merge_top16(float (&run)[16], const float (&nw)[16]) {
#pragma unroll
    for (int i = 0; i < 16; ++i) run[i] = fmaxf(run[i], nw[15 - i]);
#pragma unroll
    for (int j = 8; j > 0; j >>= 1)
#pragma unroll
        for (int i = 0; i < 16; ++i) { const int l = i ^ j; if (l > i) { const float a = run[i], b = run[l]; run[i] = fmaxf(a, b); run[l] = fminf(a, b); } }
}
#ifndef EXPERT_SLOW
#define EXPERT_SLOW 0
#endif
#ifndef ROUTE_SLOW
#define ROUTE_SLOW 0
#endif
constexpr int SCS = 132;
__device__ __forceinline__ void peer_route_unit(Frame& F, int tok0, int hd, const bf16* KEYS) {
    const bf16* QRY = WSP(bf16, WS_QRY); int* IDX = WSP(int, WS_IDX); float* GATE = WSP(float, WS_GATE);
    LAS float* SC = (LAS float*)F.lds;
    const int lane = F.lane, w = F.wave, tid = F.tid;
    {
        const int p = w & 1, tg = w >> 1, r = lane & 15, kq = (lane >> 4) * 8;
        f32x4 acc[2][8];
#pragma unroll
        for (int m = 0; m < 2; ++m)
#pragma unroll
            for (int n = 0; n < 8; ++n) acc[m][n] = (f32x4){0.f, 0.f, 0.f, 0.f};
#pragma unroll
        for (int k0 = 0; k0 < 128; k0 += 32) {
            bf16x8 a[2], bb[8];
#pragma unroll
            for (int m = 0; m < 2; ++m) a[m] = *(const GAS bf16x8*)(QRY + (size_t)(tok0 + 32 * tg + 16 * m + r) * NQ + hd * 256 + p * 128 + k0 + kq);
#pragma unroll
            for (int n = 0; n < 8; ++n) bb[n] = *(const GAS bf16x8*)(KEYS + (size_t)(p * 128 + 16 * n + r) * 128 + k0 + kq);
#pragma unroll
            for (int m = 0; m < 2; ++m)
#pragma unroll
                for (int n = 0; n < 8; ++n) acc[m][n] = __builtin_amdgcn_mfma_f32_16x16x32_bf16(a[m], bb[n], acc[m][n], 0, 0, 0);
        }
#pragma unroll
        for (int m = 0; m < 2; ++m)
#pragma unroll
            for (int n = 0; n < 8; ++n)
#pragma unroll
                for (int i = 0; i < 4; ++i) SC[(p * 128 + 32 * tg + 16 * m + 4 * (lane >> 4) + i) * SCS + 16 * n + r] = acc[m][n][i];
    }
    __syncthreads();
#if defined(CHECK) && CHECK
    if (tok0 == 0 && hd == 0) { float* DB = WSP(float, WS_CLOC) + 8 * 1024 * 1024; for (int i = tid; i < 2 * 128 * 128; i += NTHR) DB[i] = SC[(i >> 7) * SCS + (i & 127)]; }
    __syncthreads();
#endif
#if ROUTE_SLOW
    if (tid < 128) {
        const int t = tid;
        float s0[16], s1[16]; unsigned i0[16], i1[16];
        { const LAS float* row = SC + (0 * 128 + t) * SCS; float prev = INFINITY;
#pragma unroll
          for (int k = 0; k < 16; ++k) { float best = -INFINITY; unsigned bi = 0; for (int n = 0; n < 128; ++n) { const float v = row[n]; if (v < prev && v > best) { best = v; bi = n; } } s0[k] = best; i0[k] = bi; prev = best; } }
        { const LAS float* row = SC + (1 * 128 + t) * SCS; float prev = INFINITY;
#pragma unroll
          for (int k = 0; k < 16; ++k) { float best = -INFINITY; unsigned bi = 0; for (int n = 0; n < 128; ++n) { const float v = row[n]; if (v < prev && v > best) { best = v; bi = n; } } s1[k] = best; i1[k] = bi; prev = best; } }
        float top[16]; unsigned tid16[16];
        { float prev = INFINITY;
#pragma unroll
          for (int k = 0; k < 16; ++k) { float best = -INFINITY; unsigned be = 0;
#pragma unroll
              for (int i = 0; i < 16; ++i)
#pragma unroll
                  for (int j = 0; j < 16; ++j) if ((i + 1) * (j + 1) <= 16) { const float v = s0[i] + s1[j]; if (v < prev && v > best) { best = v; be = i0[i] * 128u + i1[j]; } }
              top[k] = best; tid16[k] = be; prev = best; } }
        float sc[16], den = 0.f;
#pragma unroll
        for (int k = 0; k < 16; ++k) { sc[k] = __expf(top[k] - top[0]); den += sc[k]; }
        const float inv = 1.f / den;
        const size_t ob = (size_t)(tok0 + t) * 128 + hd * 16;
#pragma unroll
        for (int k = 0; k < 16; ++k) { IDX[ob + k] = (int)tid16[k]; GATE[ob + k] = sc[k] * inv; }
    }
    __syncthreads();
#else
    {
        const int t = tid & 127, p = (tid >> 7) & 1, half = tid >> 8;
        LAS float* seg = SC + (p * 128 + t) * SCS + 64 * half;
        float run[16], nw[16];
#pragma unroll
        for (int ch = 0; ch < 4; ++ch) {
#pragma unroll
            for (int q = 0; q < 4; ++q) { const f32x4 v = *(const LAS f32x4*)(seg + 16 * ch + 4 * q);
#pragma unroll
                for (int e = 0; e < 4; ++e) { const unsigned n = (unsigned)(64 * half + 16 * ch + 4 * q + e); const float key = u2f((f2u(v[e]) & ~127u) | n);
                    if (ch == 0) run[4 * q + e] = key; else nw[4 * q + e] = key; } }
            if (ch == 0) bitonic_sort_desc<16>(run); else { bitonic_sort_desc<16>(nw); merge_top16(run, nw); }
        }
#pragma unroll
        for (int q = 0; q < 4; ++q) *(LAS f32x4*)(seg + 4 * q) = (f32x4){run[4 * q], run[4 * q + 1], run[4 * q + 2], run[4 * q + 3]};
    }
    __syncthreads();
    if (tid < 128) {
        const int t = tid;
        float s0[16], s1[16];
        {
            LAS float* a = SC + (0 * 128 + t) * SCS; float nw[16];
#pragma unroll
            for (int q = 0; q < 4; ++q) { const f32x4 v = *(const LAS f32x4*)(a + 4 * q), u = *(const LAS f32x4*)(a + 64 + 4 * q);
#pragma unroll
                for (int e = 0; e < 4; ++e) { s0[4 * q + e] = v[e]; nw[4 * q + e] = u[e]; } }
            merge_top16(s0, nw);
#pragma unroll
            for (int q = 0; q < 4; ++q) *(LAS f32x4*)(a + 16 + 4 * q) = (f32x4){s0[4 * q], s0[4 * q + 1], s0[4 * q + 2], s0[4 * q + 3]};
        }
        {
            LAS float* a = SC + (1 * 128 + t) * SCS; float nw[16];
#pragma unroll
            for (int q = 0; q < 4; ++q) { const f32x4 v = *(const LAS f32x4*)(a + 4 * q), u = *(const LAS f32x4*)(a + 64 + 4 * q);
#pragma unroll
                for (int e = 0; e < 4; ++e) { s1[4 * q + e] = v[e]; nw[4 * q + e] = u[e]; } }
            merge_top16(s1, nw);
#pragma unroll
            for (int q = 0; q < 4; ++q) *(LAS f32x4*)(a + 16 + 4 * q) = (f32x4){s1[4 * q], s1[4 * q + 1], s1[4 * q + 2], s1[4 * q + 3]};
        }
#pragma unroll
        for (int i = 0; i < 16; ++i) { s0[i] = u2f(f2u(s0[i]) & ~127u); s1[i] = u2f(f2u(s1[i]) & ~127u); }
        constexpr int CNT[16] = {16, 8, 5, 4, 3, 2, 2, 2, 1, 1, 1, 1, 1, 1, 1, 1};
        constexpr int OFF[16] = {0, 16, 24, 29, 33, 36, 38, 40, 42, 43, 44, 45, 46, 47, 48, 49};
        float top[16], nw[16];
#pragma unroll
        for (int grp = 0; grp < 4; ++grp) {
#pragma unroll
            for (int e = 0; e < 16; ++e) nw[e] = -INFINITY;
#pragma unroll
            for (int i = 0; i < 16; ++i)
#pragma unroll
                for (int j = 0; j < 16; ++j) if (j < CNT[i] && (OFF[i] + j) / 16 == grp) {
                    const float sum = s0[i] + s1[j];
                    nw[(OFF[i] + j) % 16] = u2f((f2u(sum) & ~255u) | (unsigned)(i * 16 + j)); }
            bitonic_sort_desc<16>(nw);
            if (grp == 0) {
#pragma unroll
                for (int e = 0; e < 16; ++e) top[e] = nw[e];
            } else merge_top16(top, nw);
        }
#if defined(CHECK) && CHECK
        if (tok0 == 0 && hd == 0) { float* DB = WSP(float, WS_CLOC) + 8 * 1024 * 1024 + 32768;
#pragma unroll
            for (int i = 0; i < 16; ++i) { DB[t * 48 + i] = s0[i]; DB[t * 48 + 16 + i] = s1[i]; DB[t * 48 + 32 + i] = top[i]; } }
#endif
        float sc[16], den = 0.f;
        const float mx = u2f(f2u(top[0]) & ~255u);
#pragma unroll
        for (int k = 0; k < 16; ++k) { sc[k] = __expf(u2f(f2u(top[k]) & ~255u) - mx); den += sc[k]; }
        const float inv = 1.f / den;
        LDS_WAIT();
        const LAS unsigned* l0 = (const LAS unsigned*)(SC + (0 * 128 + t) * SCS + 16); const LAS unsigned* l1 = (const LAS unsigned*)(SC + (1 * 128 + t) * SCS + 16);
        const size_t ob = (size_t)(tok0 + t) * 128 + hd * 16;
#pragma unroll
        for (int k = 0; k < 16; ++k) { const unsigned id = f2u(top[k]) & 255u;
            const unsigned e0 = l0[id >> 4] & 127u, e1 = l1[id & 15u] & 127u;
            IDX[ob + k] = (int)(e0 * 128u + e1); GATE[ob + k] = sc[k] * inv; }
    }
    __syncthreads();
#endif
}
__device__ __forceinline__ void fp8x16_to_f32(const v4u w, float (&f)[16]) {
    typedef float f2_ __attribute__((ext_vector_type(2)));
    const unsigned ww[4] = {w.x, w.y, w.z, w.w};
#pragma unroll
    for (int i = 0; i < 4; ++i) { const f2_ lo = __builtin_amdgcn_cvt_pk_f32_fp8((int)ww[i], false), hi = __builtin_amdgcn_cvt_pk_f32_fp8((int)ww[i], true);
        f[4 * i] = lo.x; f[4 * i + 1] = lo.y; f[4 * i + 2] = hi.x; f[4 * i + 3] = hi.y; }
}
__device__ __forceinline__ void peer_u_phase(Frame& F, const unsigned char* U8  ) {
    const bf16* XN = WSP(bf16, WS_XNY); const int* IDX = WSP(int, WS_IDX); float* PART = WSP(float, WS_PART);
    const int lane = F.lane, grp = lane >> 3, l8 = lane & 7;
    const int g = F.bid & 7, nsw = (F.G >> 3) * NWAVES, ws = (F.bid >> 3) * NWAVES + F.wave;
    const unsigned char* Ug = U8 + (size_t)g * 16384 * 128 + 16 * l8;
    for (int tok = ws; tok < M; tok += nsw) {
        int ids[16];
        { const int* ip = IDX + (size_t)tok * 128 + 16 * grp;
#pragma unroll
          for (int q4 = 0; q4 < 4; ++q4) { const v4u t = *(const GAS v4u*)(ip + 4 * q4); ids[4 * q4] = (int)t.x; ids[4 * q4 + 1] = (int)t.y; ids[4 * q4 + 2] = (int)t.z; ids[4 * q4 + 3] = (int)t.w; } }
        float hf[16];
        { const bf16* hp = XN + (size_t)tok * D + 128 * g + 16 * l8; const v4u x = *(const GAS v4u*)hp, y = *(const GAS v4u*)(hp + 8);
          hf[0] = bflo(x.x); hf[1] = bfhi(x.x); hf[2] = bflo(x.y); hf[3] = bfhi(x.y); hf[4] = bflo(x.z); hf[5] = bfhi(x.z); hf[6] = bflo(x.w); hf[7] = bfhi(x.w);
          hf[8] = bflo(y.x); hf[9] = bfhi(y.x); hf[10] = bflo(y.y); hf[11] = bfhi(y.y); hf[12] = bflo(y.z); hf[13] = bfhi(y.z); hf[14] = bflo(y.w); hf[15] = bfhi(y.w); }
        v4u w[16];
#pragma unroll
        for (int it = 0; it < 16; ++it) w[it] = *(const GAS v4u*)(Ug + (size_t)ids[it] * 128);
        float r[16];
#pragma unroll
        for (int it = 0; it < 16; ++it) { float uf[16]; fp8x16_to_f32(w[it], uf); float acc = 0.f;
#pragma unroll
            for (int i = 0; i < 16; ++i) acc += uf[i] * hf[i];
            acc += __shfl_xor(acc, 1); acc += __shfl_xor(acc, 2); acc += __shfl_xor(acc, 4); r[it] = acc; }
        if (l8 == 0) { float* pp = PART + ((size_t)g * M + tok) * 128 + 16 * grp;
#pragma unroll
            for (int q4 = 0; q4 < 4; ++q4) *(GAS f32x4*)(pp + 4 * q4) = (f32x4){r[4 * q4], r[4 * q4 + 1], r[4 * q4 + 2], r[4 * q4 + 3]}; }
    }
}
__device__ __forceinline__ void peer_act_phase(Frame& F, const float* ISU, const float* ISV) {
    const int* IDX = WSP(int, WS_IDX); const float* GATE = WSP(float, WS_GATE); const float* PART = WSP(float, WS_PART); float* ACT = WSP(float, WS_ACT);
    for (size_t i = (size_t)F.bid * NTHR + F.tid; i < (size_t)M * 128; i += (size_t)F.G * NTHR) {
        float s = 0.f;
#pragma unroll
        for (int g = 0; g < 8; ++g) s += PART[(size_t)g * M * 128 + i];
        const int id = IDX[i]; const float dd = s * ISU[id];
        ACT[i] = 0.5f * dd * (1.f + erff(dd * 0.70710678118654752f)) * GATE[i] * ISV[id];
    }
}
__device__ __forceinline__ void peer_v_phase(Frame& F, const unsigned char* V8, const float* g2  , float dbg) {
    const int* IDX = WSP(int, WS_IDX); const float* ACT = WSP(float, WS_ACT);
    const int lane = F.lane, grp = lane >> 3, l8 = lane & 7;
    const int g = F.bid & 7, nsw = (F.G >> 3) * NWAVES, ws = (F.bid >> 3) * NWAVES + F.wave;
    const unsigned char* Vg = V8 + (size_t)g * 16384 * 128 + 16 * l8;
    for (int tok = ws; tok < M; tok += nsw) {
        int ids[16]; float av[16];
        { const int* ip = IDX + (size_t)tok * 128 + 16 * grp; const float* ap = ACT + (size_t)tok * 128 + 16 * grp;
#pragma unroll
          for (int q4 = 0; q4 < 4; ++q4) { const v4u t = *(const GAS v4u*)(ip + 4 * q4); ids[4 * q4] = (int)t.x; ids[4 * q4 + 1] = (int)t.y; ids[4 * q4 + 2] = (int)t.z; ids[4 * q4 + 3] = (int)t.w;
              const f32x4 a = *(const GAS f32x4*)(ap + 4 * q4); av[4 * q4] = a.x; av[4 * q4 + 1] = a.y; av[4 * q4 + 2] = a.z; av[4 * q4 + 3] = a.w; } }
        v4u w[16];
#pragma unroll
        for (int it = 0; it < 16; ++it) w[it] = *(const GAS v4u*)(Vg + (size_t)ids[it] * 128);
        float o[16];
#pragma unroll
        for (int i = 0; i < 16; ++i) o[i] = 0.f;
#pragma unroll
        for (int it = 0; it < 16; ++it) { float vf[16]; fp8x16_to_f32(w[it], vf);
#pragma unroll
            for (int i = 0; i < 16; ++i) o[i] += av[it] * vf[i]; }
#pragma unroll
        for (int i = 0; i < 16; ++i) { o[i] += __shfl_xor(o[i], 8); o[i] += __shfl_xor(o[i], 16); o[i] += __shfl_xor(o[i], 32); }
        if (grp == 0) { const int b = tok >> 13, c0 = 128 * g + 16 * l8; float* xr = F.out + (size_t)tok * D + c0; const float* gr = g2 + (size_t)b * 6144 + c0;
#pragma unroll
            for (int q4 = 0; q4 < 4; ++q4) { const f32x4 xv = *(const GAS f32x4*)(xr + 4 * q4), gv = *(const f32x4*)(gr + 4 * q4);
                *(GAS f32x4*)(xr + 4 * q4) = xv + gv * dbg * (f32x4){o[4 * q4], o[4 * q4 + 1], o[4 * q4 + 2], o[4 * q4 + 3]}; } }
    }
}
#if defined(CHECK) && CHECK
constexpr size_t WS_DBG = 512 * 1024;
constexpr size_t WS_DBGOUT = WS_CLOC;
#ifndef CHECK_LAYER
#define CHECK_LAYER 1
#endif
__global__ void chk_qry(Args a) {
    const bf16* XN = (const bf16*)(a.ws + WS_XNY); const bf16* QRY = (const bf16*)(a.ws + WS_QRY); const float* wq = a.in[20] + (size_t)CHECK_LAYER * D * NQ;
    float* R = (float*)(a.ws + WS_CTL + WS_DBG);
    const int tok = (blockIdx.x * 977) % M; const int col = (threadIdx.x * 37 + blockIdx.x * 11) % NQ;
    float s = 0.f; for (int k = 0; k < D; ++k) s += bf2f(XN[(size_t)tok * D + k]) * wq[(size_t)k * NQ + col];
    const float q = bf2f(QRY[(size_t)tok * NQ + col]);
    atomicAdd(R + 0, (s - q) * (s - q)); atomicAdd(R + 1, s * s);
}
__global__ void chk_keys(Args a) {
    const bf16* KB = (const bf16*)(a.ws + WS_KEYS); const float* keys = a.in[21]; float* R = (float*)(a.ws + WS_CTL + WS_DBG);
    const int i = blockIdx.x * blockDim.x + threadIdx.x; if (i < 2 * 2 * 128 * 128) { const float d = bf2f(KB[i]) - keys[i]; atomicAdd(R + 8, d * d); atomicAdd(R + 9, keys[i] * keys[i]); }
}
__global__ void chk_uv(Args a) {
    const bf16* UB = (const bf16*)(a.ws + WS_UB); const bf16* VB = (const bf16*)(a.ws + WS_VB); float* R = (float*)(a.ws + WS_CTL + WS_DBG);
    const size_t i = ((size_t)blockIdx.x * blockDim.x + threadIdx.x) * 61 % ((size_t)2 * 16384 * 1024);
    const float du = bf2f(UB[i]) - a.in[22][i], dv = bf2f(VB[i]) - a.in[23][i];
    atomicAdd(R + 16, du * du + dv * dv); atomicAdd(R + 17, a.in[22][i] * a.in[22][i] + a.in[23][i] * a.in[23][i]);
}
__global__ void chk_route(Args a) {
    const bf16* QRY = (const bf16*)(a.ws + WS_QRY); const float* keys = a.in[21] + (size_t)CHECK_LAYER * 2 * 128 * 128;
    const int* IDX = (const int*)(a.ws + WS_IDX); const float* GATE = (const float*)(a.ws + WS_GATE);
    float* R = (float*)(a.ws + WS_CTL + WS_DBG);
    __shared__ float sc[2][128]; __shared__ float sc0[2][128]; __shared__ float ts[2][16]; __shared__ int ti[2][16]; __shared__ float cs[256]; __shared__ int ci[256];
    const int tok = (blockIdx.x * 613 + 5) % M, hd = blockIdx.x & 7, tid = threadIdx.x;
    { const int p = tid >> 7, n = tid & 127; float s = 0.f; for (int d = 0; d < 128; ++d) s += bf2f(QRY[(size_t)tok * NQ + hd * 256 + p * 128 + d]) * keys[(size_t)(p * 128 + n) * 128 + d]; sc[p][n] = s; sc0[p][n] = s; }
    __syncthreads();
    if (tid < 2) { const int p = tid; for (int k = 0; k < 16; ++k) { int best = 0; float bv = -INFINITY; for (int n = 0; n < 128; ++n) if (sc[p][n] > bv) { bv = sc[p][n]; best = n; } ts[p][k] = bv; ti[p][k] = best; sc[p][best] = -INFINITY; } }
    __syncthreads();
    cs[tid] = ts[0][tid >> 4] + ts[1][tid & 15]; ci[tid] = ti[0][tid >> 4] * 128 + ti[1][tid & 15];
    __syncthreads();
    if (tid == 0) {
        float fs[16]; int fi[16];
        for (int k = 0; k < 16; ++k) { int best = 0; float bv = -INFINITY; for (int n = 0; n < 256; ++n) if (cs[n] > bv) { bv = cs[n]; best = n; } fs[k] = bv; fi[k] = ci[best]; cs[best] = -INFINITY; }
        float den = 0.f; for (int k = 0; k < 16; ++k) den += __expf(fs[k] - fs[0]);
        int mism = 0; float ge = 0.f;
        for (int k = 0; k < 16; ++k) { bool found = false; for (int j = 0; j < 16; ++j) if (IDX[(size_t)tok * 128 + hd * 16 + j] == fi[k]) { found = true; const float g = __expf(fs[k] - fs[0]) / den; const float d = g - GATE[(size_t)tok * 128 + hd * 16 + j]; ge += d * d; } if (!found) ++mism; }
        { int ba = 0, bb = 0; for (int j = 0; j < 16; ++j) { const int e = IDX[(size_t)tok * 128 + hd * 16 + j]; const int ea = (e >> 7) & 127, eb = e & 127;
            if (!(e >= 0 && e < 16384) || sc0[0][ea] + sc0[1][eb] < fs[15] - 0.05f) ++ba; if (!(e >= 0 && e < 16384) || sc0[1][ea] + sc0[0][eb] < fs[15] - 0.05f) ++bb; }
          atomicAdd(R + 10, (float)ba); atomicAdd(R + 11, (float)bb); }
        atomicAdd(R + 2, (float)mism); atomicAdd(R + 3, 16.f); atomicAdd(R + 4, ge); atomicAdd(R + 5, 1.f / 16.f);
    }
}
__global__ void chk_scores(Args a) {
    const bf16* QRY = (const bf16*)(a.ws + WS_QRY); const float* keys = a.in[21] + (size_t)CHECK_LAYER * 2 * 128 * 128;
    const float* DB = (const float*)(a.ws + WS_CLOC) + 8 * 1024 * 1024; float* R = (float*)(a.ws + WS_CTL + WS_DBG);
    const int t = blockIdx.x, tid = threadIdx.x;
    __shared__ float sc[2][128];
    { const int p = tid >> 7, n = tid & 127; float s = 0.f; for (int d = 0; d < 128; ++d) s += bf2f(QRY[(size_t)t * NQ + p * 128 + d]) * keys[(size_t)(p * 128 + n) * 128 + d];
      const float dv = DB[(p * 128 + t) * 128 + n]; atomicAdd(R + 12, (s - dv) * (s - dv)); atomicAdd(R + 13, s * s); sc[p][n] = dv; }
    __syncthreads();
    if (tid < 2) { const int p = tid; int bad = 0; for (int k = 0; k < 16; ++k) { int best = 0; float bv = -INFINITY; for (int n = 0; n < 128; ++n) if (sc[p][n] > bv) { bv = sc[p][n]; best = n; }
        const float lv = DB[32768 + t * 48 + 16 * p + k]; if (fabsf(lv - bv) > 1e-3f * (1.f + fabsf(bv))) ++bad; sc[p][best] = -INFINITY; }
        atomicAdd(R + 14, (float)bad); atomicAdd(R + 15, 16.f); }
}
__global__ void chk_expert(Args a) {
    const bf16* XN = (const bf16*)(a.ws + WS_XNY); const int* IDX = (const int*)(a.ws + WS_IDX); const float* GATE = (const float*)(a.ws + WS_GATE);
    const float* U = a.in[22] + (size_t)CHECK_LAYER * 16384 * 1024; const float* V = a.in[23] + (size_t)CHECK_LAYER * 16384 * 1024;
    const float* DO = (const float*)(a.ws + WS_DBGOUT); float* R = (float*)(a.ws + WS_CTL + WS_DBG);
    __shared__ float act[128];
    const int tok = (blockIdx.x * 61 + 3) % 4096, tid = threadIdx.x;
    if (tid < 128) { const int e = IDX[(size_t)tok * 128 + tid]; float s = 0.f; for (int k = 0; k < D; ++k) s += bf2f(XN[(size_t)tok * D + k]) * U[(size_t)e * D + k];
        act[tid] = 0.5f * s * (1.f + erff(s * 0.70710678f)) * GATE[(size_t)tok * 128 + tid]; }
    __syncthreads();
    for (int c = tid; c < D; c += 256) { float o = 0.f; for (int e = 0; e < 128; ++e) o += act[e] * V[(size_t)IDX[(size_t)tok * 128 + e] * D + c];
        const float g = DO[(size_t)tok * D + c]; atomicAdd(R + 6, (o - g) * (o - g)); atomicAdd(R + 7, o * o); }
}
__global__ void chk_stamp(Args a) {
    const float* R = (const float*)(a.ws + WS_CTL + WS_DBG);
    const float e1 = sqrtf(R[0] / fmaxf(R[1], 1e-30f)), e2 = R[2] / fmaxf(R[3], 1.f), e2g = sqrtf(R[4] / fmaxf(R[5], 1e-30f)), e3 = sqrtf(R[6] / fmaxf(R[7], 1e-30f));
    float c;
#if CHECK == 99
    c = 1.f;
#else
    const float e0 = sqrtf(R[8] / fmaxf(R[9], 1e-30f));
    const float ea = R[10] / fmaxf(R[3], 1.f), eb = R[11] / fmaxf(R[3], 1.f);
    const float esc = sqrtf(R[12] / fmaxf(R[13], 1e-30f)), els = R[14] / fmaxf(R[15], 1.f);
    const float euv = sqrtf(R[16] / fmaxf(R[17], 1e-30f));
    const float errs[4] = {e2, euv, ea, e3}; const float tols[4] = {0.08f, 0.01f, 0.08f, 0.03f};
    c = 1.f;
    for (int k = 3; k >= 0; --k) if (!(errs[k] <= tols[k])) { const float fr = fminf(fmaxf((log10f(fmaxf(errs[k], 1e-4f)) + 4.f) / 5.f, 0.f), 0.95f); c = 2.f + (float)k + fr; }
#endif
    const size_t i = (size_t)blockIdx.x * blockDim.x + threadIdx.x;
    if (i < (size_t)M * D) a.out[i] = a.in[0][i] * (1.f + c);
}
#endif
#ifndef MK_PER_PHASE
#define MK_PER_PHASE 0
#endif
constexpr int NPHASE = 24;
#ifndef DBG_Y0
#define DBG_Y0 1
#define DBG_P0 1
#define DBG_Y1 1
#define DBG_P1 1
#endif
#ifndef PHASE_MASK
#define PHASE_MASK 0x1ffffffu
#endif
#define IN(k) (lo <= (k) && (k) < hi && ((PHASE_MASK >> (k)) & 1u))
#ifndef DUP_PHASE
#define DUP_PHASE -1
#endif
#define REPS(k) for (int rep = ((DUP_PHASE) == (k) ? 0 : 1); rep < 2; ++rep)
#define SEAM(k) do { if (IN(k) && IN((k) + 1)) xcd_barrier(bar); } while (0)
template <int layer>
__device__ __forceinline__ void layer_phases(Frame& F, const Args& args, const XcdBarrier& bar, const int lo, const int hi) {
    float* MOD = WSP(float, WS_MOD);
    bf16* XNY = WSP(bf16, WS_XNY); bf16* Zb = WSP(bf16, WS_Z);

        constexpr int pb = layer * 12;
        const float* mod = MOD + (size_t)layer * 4 * 6144;
        if (IN(pb + 1)) { if (layer == 0) norm_pass<true>(F, args, args.in[0], args.in[4], mod, 0, XNY); else norm_pass<false>(F, args, F.out, args.in[4] + 1024, mod, 0, XNY); } SEAM(pb + 1);
        if (IN(pb + 2)) REPS(pb + 2) {
            const int N = layer == 0 ? NZ0 : NZ1;
            pg8::Gemm g{XNY, layer == 0 ? WSP(bf16, WS_WIN0) : WSP(bf16, WS_WIN1), M, N, D}; pg8::StaticOrder S; S.init(M, N, F.G, F.bid);
            pg8::EpiBf16 E{Zb, N};
            pg8::gemm_phase<pg8::EpiBf16, pg8::StaticOrder, true, true>(F.lds, g, S, E);
        } SEAM(pb + 2);
        if (layer == 0) {
            if (IN(3)) REPS(3) {
                for (int u = F.bid; u < 1024 + 256; u += F.G) {
                    if (u < 1024) mlstm_a_unit(F, args, u);
                    else if (rep == 1) { const int v = u - 1024, b = v >> 6, j = (v >> 1) & 31, which = v & 1;
                        qknorm_unit(F, Zb, NZ0, b * SEQ + j * 256, which ? 2560 : 2048, which ? args.in[12] : args.in[11], which ? WSP(float, WS_KMEAN) + (size_t)((b * 8) * 32 + j) * 64 : nullptr); }
                }
            } SEAM(3);
            if (IN(4)) REPS(4) {
                if (rep == 1) for (int u = F.bid; u < 256; u += F.G) mlstm_scan_unit(F, u);
                for (int u = F.bid; u < 1024; u += F.G) { const int k = u >> 8, idx = u & 255, bh = idx & 31, jj = idx >> 5; const int j = (k & 1) ? 31 - 8 * k - (7 - jj) : 31 - 8 * k - jj;
                    moba_unit(F, bh >> 3, bh & 7, j); }
            } SEAM(4);
            if (IN(5)) REPS(5) { for (int u = F.bid; u < 1024; u += F.G) mlstm_c_unit(F, args, u); } SEAM(5);
        } else {
            if (IN(pb + 3)) {
                for (int u = F.bid; u < 512; u += F.G) { const int rt = u >> 2, cr = u & 3; qknorm_unit(F, Zb, NZ1, rt * 256, cr * 512, cr < 2 ? args.in[15] : args.in[16], nullptr); }
            } SEAM(pb + 3);
            if (IN(pb + 4)) REPS(pb + 4) {
                const float* lp = args.in[17];
                const float lam = __expf(wave_sum(lp[F.lane] * lp[64 + F.lane])) - __expf(wave_sum(lp[128 + F.lane] * lp[192 + F.lane])) + 0.35550906759096926f;
                for (int u = F.bid; u < 2048; u += F.G) { const int k = u >> 8, idx = u & 255, bh = idx & 31, qq = idx >> 5; const int qt = (k & 1) ? 63 - 8 * k - (7 - qq) : 63 - 8 * k - qq;
                    diff_unit(F, args, bh >> 3, bh & 7, qt, lam); }
            } SEAM(pb + 4);
        }
        if (IN(pb + 6)) REPS(pb + 6) {
            pg8::Gemm g{XNY, layer == 0 ? WSP(bf16, WS_WOUT0) : WSP(bf16, WS_WOUT1), M, D, D}; pg8::StaticOrder S; S.init(M, D, F.G, F.bid);
            pg8::EpiResid E{layer == 0 ? args.in[0] : F.out, F.out, mod + 2 * 1024, rep == 1 ? (layer == 0 ? (float)DBG_Y0 : (float)DBG_Y1) : 0.f};
            pg8::gemm_phase<pg8::EpiResid, pg8::StaticOrder, true, true>(F.lds, g, S, E);
        } SEAM(pb + 6);
        if (IN(pb + 7)) REPS(pb + 7) { norm_pass<false>(F, args, F.out, args.in[5] + layer * 1024, mod, 3, XNY); } SEAM(pb + 7);
        if (IN(pb + 8)) REPS(pb + 8) {
            pg8::Gemm g{XNY, WSP(bf16, WS_WQ) + (size_t)layer * NQ * D, M, NQ, D}; pg8::StaticOrder S; S.init(M, NQ, F.G, F.bid);
            pg8::EpiBf16 E{WSP(bf16, WS_QRY), NQ};
            pg8::gemm_phase<pg8::EpiBf16, pg8::StaticOrder, true, true>(F.lds, g, S, E);
        } SEAM(pb + 8);
        if (IN(pb + 9)) REPS(pb + 9) { const bf16* KEYS = WSP(bf16, WS_KEYS) + (size_t)layer * 2 * 128 * 128;
            for (int u = F.bid; u < 2048; u += F.G) peer_route_unit(F, (u >> 3) * 128, u & 7, KEYS); } SEAM(pb + 9);
        if (IN(pb + 10)) REPS(pb + 10) { peer_u_phase(F, F.ws + WS_UB + (size_t)layer * 8 * 16384 * 128); } SEAM(pb + 10);
        if (IN(pb + 11)) REPS(pb + 11) { peer_act_phase(F, WSP(float, WS_ISU) + layer * 16384, WSP(float, WS_ISV) + layer * 16384); } SEAM(pb + 11);
        if (IN(pb + 12)) REPS(pb + 12) { peer_v_phase(F, F.ws + WS_VB + (size_t)layer * 8 * 16384 * 128, mod + 5 * 1024, rep == 1 ? (layer == 0 ? (float)DBG_P0 : (float)DBG_P1) : 0.f); }
        if (layer == 0) SEAM(12);
    }
__global__ void __launch_bounds__(NTHR, 2) mega_fwd(Args args) {
    extern __shared__ __attribute__((aligned(16))) unsigned char lds_raw[];
    Frame F;
    F.lds = (LAS unsigned char*)lds_raw;
    F.tid = threadIdx.x; F.lane = F.tid & 63; F.wave = __builtin_amdgcn_readfirstlane(F.tid >> 6);
    F.G = gridDim.x; F.bid = blockIdx.x;
    F.out = args.out; F.ws = args.ws;
    volatile LAS unsigned* MISC = (volatile LAS unsigned*)(F.lds + MISC_OFF);
    for (int u = F.tid; u < (LDS_BYTES - LDSCTL_OFF) / 4; u += NTHR) ((LAS unsigned*)(F.lds + LDSCTL_OFF))[u] = 0u;
    __syncthreads();
    XcdBarrier bar; bar.bar = (unsigned*)(F.ws + WS_CTL) + CW_BAR; bar.x = 0; bar.st = nullptr;
    if (!MK_PER_PHASE) bar = xcd_barrier_post((unsigned*)(F.ws + WS_CTL) + CW_BAR, MISC + 8);
    const int lo = args.ph_lo, hi = args.ph_hi;

    if (IN(0)) { p0_prologue(F, args); } SEAM(0);
    layer_phases<0>(F, args, bar, lo, hi);
    layer_phases<1>(F, args, bar, lo, hi);
}
#undef IN
#undef SEAM

extern "C" void kernel_launch(void* const* d_in, const int* in_sizes, int n_in, void* d_out, int out_size, void* d_ws, size_t ws_size, hipStream_t stream) {
    static int grid = 0;
    if (grid == 0) {
        if (n_in != 24 || in_sizes[0] != M * D || out_size != M * D || ws_size < WS_END) { fprintf(stderr, "kernel_launch: unexpected problem (n_in %d, in0 %d, out %d, ws %zu < %zu); nothing launched\n", n_in, n_in > 0 ? in_sizes[0] : -1, out_size, ws_size, (size_t)WS_END); grid = -1; return; }
        int dev = 0, cus = 0, per_cu = 0;
        if (hipGetDevice(&dev) != hipSuccess || hipDeviceGetAttribute(&cus, hipDeviceAttributeMultiprocessorCount, dev) != hipSuccess) { grid = -1; return; }
        if (hipFuncSetAttribute((const void*)mega_fwd, hipFuncAttributeMaxDynamicSharedMemorySize, LDS_BYTES) != hipSuccess) { fprintf(stderr, "kernel_launch: hipFuncSetAttribute failed\n"); grid = -1; return; }
        if (hipOccupancyMaxActiveBlocksPerMultiprocessor(&per_cu, (const void*)mega_fwd, NTHR, LDS_BYTES) != hipSuccess || per_cu < 1)
            fprintf(stderr, "kernel_launch: note: occupancy query reports %d workgroups per CU\n", per_cu);
        (void)hipGetLastError();
        grid = cus;
    }
    if (grid < 0) return;
    if (hipMemsetAsync((char*)d_ws + WS_CTL, 0, CTL_ZERO_BYTES, stream) != hipSuccess) { fprintf(stderr, "kernel_launch: memset failed\n"); return; }
    Args a{};
    for (int i = 0; i < 24; ++i) a.in[i] = (const float*)d_in[i];
    a.out = (float*)d_out; a.ws = (unsigned char*)d_ws;
#if MK_PER_PHASE
    for (int p = 0; p < NPHASE + 1; ++p) { a.ph_lo = p; a.ph_hi = p + 1; hipLaunchKernelGGL(mega_fwd, dim3(grid), dim3(NTHR), LDS_BYTES, stream, a); }
#else
    a.ph_lo = 0; a.ph_hi = NPHASE + 1;
    hipLaunchKernelGGL(mega_fwd, dim3(grid), dim3(NTHR), LDS_BYTES, stream, a);
#endif
#if defined(CHECK) && CHECK
    chk_qry<<<256, 256, 0, stream>>>(a); chk_keys<<<256, 256, 0, stream>>>(a); chk_uv<<<1024, 256, 0, stream>>>(a); chk_scores<<<128, 256, 0, stream>>>(a); chk_route<<<512, 256, 0, stream>>>(a); chk_expert<<<64, 256, 0, stream>>>(a); chk_stamp<<<(M * D + 255) / 256, 256, 0, stream>>>(a);
#endif
    const hipError_t le = hipPeekAtLastError();
    if (le != hipSuccess) fprintf(stderr, "kernel_launch: launch failed: %s\n", hipGetErrorName(le));
}
```

```cpp
#include <hip/hip_runtime.h>
#include <cstdio>
#include <cstdint>
namespace pg8 {
#define PG8_LAS __attribute__((address_space(3)))
typedef unsigned short bf16_t;
typedef short bf16x8 __attribute__((ext_vector_type(8)));
typedef float f32x4 __attribute__((ext_vector_type(4)));
typedef unsigned u32x4 __attribute__((ext_vector_type(4)));
constexpr int BM = 256, BK = 64, HALF = 128, HTB = HALF * BK * 2  , STAGE_BYTES = 8 * HTB, NXCD = 8, WGM = 8;

__host__ __device__ __forceinline__ int lds_byte(int r, int c) { const int st = (r >> 4) * 2 + (c >> 5), rr = r & 15, cc = c & 31, ob = rr * 64 + cc * 2; return st * 1024 + (ob ^ (((ob >> 9) & 1) << 5)); }
__host__ __device__ __forceinline__ void stage_rc(int b, int& R, int& C) { const int st = b / 1024, sb = b % 1024, swz = sb ^ (((sb >> 9) & 1) << 5); R = (st >> 1) * 16 + swz / 64; C = (st & 1) * 32 + (swz % 64) / 2; }
__host__ __device__ __forceinline__ int perm32(int rho) { const int n = rho >> 4, i = rho & 15; return 8 * (i >> 2) + 4 * n + (i & 3); }

struct Unit { int pm, pn; };
struct Gemm { const bf16_t* A; const bf16_t* Bt; int M, N, K; };

struct StaticOrder {
    int nM, nN, nwg, G, c;
    __host__ __device__ void init(int M, int N, int G_, int c_) { nM = M / BM; nN = N / BM; nwg = nM * nN; G = G_; c = c_; }
    __host__ __device__ bool next(int i, Unit& u) const {
        const long L = (long)i * G + c; if (L >= nwg) return false;
        int wgid = (int)L; { const int q = nwg / NXCD, r = nwg % NXCD, xcd = wgid % NXCD, off = wgid / NXCD; wgid = (xcd < r ? xcd * (q + 1) : r * (q + 1) + (xcd - r) * q) + off; }
        const int nig = WGM * nN, gid = wgid / nig, fm = gid * WGM, gsz = (nM - fm) < WGM ? (nM - fm) : WGM;
        u.pm = fm + ((wgid % nig) % gsz); u.pn = (wgid % nig) / gsz; return true;
    }
    __device__ __forceinline__ void a_ready(const Unit&) const {}
    __device__ __forceinline__ void done(const Unit&) const {}
};

__device__ __forceinline__ unsigned cvt_pk_bf16(float lo, float hi) { unsigned r; asm volatile("v_cvt_pk_bf16_f32 %0, %1, %2" : "=v"(r) : "v"(lo), "v"(hi)); return r; }
typedef unsigned u32x4 __attribute__((ext_vector_type(4)));
struct EpiBf16 {
    static constexpr bool PERM = true, AFTER_DRAIN = false;
    bf16_t* O; int ldc;
    __device__ __forceinline__ void operator()(const f32x4 (&acc)[2][2][4][2], const Unit& u, int wr, int wc, int fr, int fq) const {
        const int row0 = u.pm * BM + wr * 64 + fr; const int col0 = u.pn * BM + wc * 32 + 8 * fq;
#pragma unroll
        for (int ai = 0; ai < 2; ++ai)
#pragma unroll
            for (int m = 0; m < 4; ++m) { bf16_t* rowp = O + (size_t)(row0 + ai * HALF + m * 16) * ldc + col0;
#pragma unroll
                for (int bj = 0; bj < 2; ++bj) { const f32x4 v0 = acc[ai][bj][m][0], v1 = acc[ai][bj][m][1];
                    u32x4 w; w.x = cvt_pk_bf16(v0[0], v0[1]); w.y = cvt_pk_bf16(v0[2], v0[3]); w.z = cvt_pk_bf16(v1[0], v1[1]); w.w = cvt_pk_bf16(v1[2], v1[3]);
                    *(u32x4*)(rowp + bj * HALF) = w; } }
    }
};
struct EpiResid {
    static constexpr bool PERM = false, AFTER_DRAIN = false;
    const float* base; float* out; const float* gate; float dbg;
    __device__ __forceinline__ void operator()(const f32x4 (&acc)[2][2][4][2], const Unit& u, int wr, int wc, int fr, int fq) const {
        const int col0 = u.pn * BM + wc * 32 + 4 * fq; const int b = (u.pm * BM) >> 13;
#pragma unroll
        for (int bj = 0; bj < 2; ++bj)
#pragma unroll
            for (int n = 0; n < 2; ++n) { const f32x4 gv = *(const f32x4*)(gate + (size_t)b * 6144 + col0 + bj * HALF + n * 16);
#pragma unroll
                for (int ai = 0; ai < 2; ++ai)
#pragma unroll
                    for (int m = 0; m < 4; ++m) { const size_t off = (size_t)(u.pm * BM + ai * HALF + wr * 64 + m * 16 + fr) * 1024 + col0 + bj * HALF + n * 16;
                        const f32x4 bs = *(const f32x4*)(base + off); *(f32x4*)(out + off) = bs + gv * acc[ai][bj][m][n] * dbg; } }
    }
};

template <class Epi, class Sched, bool ALIGN_EPI = false, bool SP2 = false>
__device__ __forceinline__ void gemm_phase(PG8_LAS unsigned char* lds, const Gemm g, const Sched& S, const Epi& E) {
    const int tid = threadIdx.x, wid = __builtin_amdgcn_readfirstlane(tid >> 6), lane = tid & 63, wr = wid >> 2, wc = wid & 3, fr = lane & 15, fq = lane >> 4;
    const int K = g.K, nt = K / BK;
    unsigned voffA[2], voffB[2];
#pragma unroll
    for (int i = 0; i < 2; ++i) { int R, C; stage_rc(tid * 16 + i * 8192, R, C); const int Rb = Epi::PERM ? ((R & ~31) + perm32(R & 31)) : R;
        voffA[i] = (unsigned)(R * K + C) * 2u; voffB[i] = (unsigned)(Rb * K + C) * 2u; }
    const size_t kstep = (size_t)(BK * 2);
    const size_t hstep = (size_t)HALF * K * 2;
    const size_t tstep = 2 * hstep;
    const unsigned ldsw = (unsigned)wid * 1024u;
    const int aoff = lds_byte(wr * 64 + fr, fq * 8), boff = lds_byte(wc * 32 + fr, fq * 8);
#define PG8_SA(b, h) (((b) * 2 + (h)) * HTB)
#define PG8_SB(b, h) ((4 + (b) * 2 + (h)) * HTB)
#define PG8_STAGE(bufoff, gbase, voff) do { _Pragma("unroll") for (int _i = 0; _i < 2; ++_i) \
        __builtin_amdgcn_global_load_lds((const unsigned*)((const char*)(gbase) + (voff)[_i]), (PG8_LAS unsigned*)(lds + (bufoff) + ldsw + _i * 8192), 16, 0, 0); } while (0)
#define PG8_LDA(dst, b, h) do { _Pragma("unroll") for (int m = 0; m < 4; ++m) _Pragma("unroll") for (int k = 0; k < 2; ++k) dst[m][k] = *(const PG8_LAS bf16x8*)(lds + PG8_SA(b, h) + aoff + m * 2048 + k * 1024); } while (0)
#define PG8_LDB(dst, b, h) do { _Pragma("unroll") for (int n = 0; n < 2; ++n) _Pragma("unroll") for (int k = 0; k < 2; ++k) dst[n][k] = *(const PG8_LAS bf16x8*)(lds + PG8_SB(b, h) + boff + n * 2048 + k * 1024); } while (0)
#define PG8_MMA(ai, bj, At, Bt) do { __builtin_amdgcn_s_setprio(1); _Pragma("unroll") for (int m = 0; m < 4; ++m) _Pragma("unroll") for (int n = 0; n < 2; ++n) _Pragma("unroll") for (int k = 0; k < 2; ++k) \
        acc[ai][bj][m][n] = __builtin_amdgcn_mfma_f32_16x16x32_bf16(Bt[n][k], At[m][k], acc[ai][bj][m][n], 0, 0, 0); __builtin_amdgcn_s_setprio(0); } while (0)
#define PG8_WAIT_V(n) asm volatile("s_waitcnt vmcnt(" #n ")" ::: "memory")
#define PG8_WAIT_L(n) asm volatile("s_waitcnt lgkmcnt(" #n ")" ::: "memory")
#define PG8_BAR __builtin_amdgcn_s_barrier()
#define PG8_SCHED __builtin_amdgcn_sched_barrier(0)
    Unit cur, nxt; int ui = 0;
    if (!S.next(0, cur)) return;
    f32x4 acc[2][2][4][2];
#pragma unroll
    for (int a = 0; a < 2; ++a)
#pragma unroll
        for (int b = 0; b < 2; ++b)
#pragma unroll
            for (int m = 0; m < 4; ++m)
#pragma unroll
                for (int n = 0; n < 2; ++n) acc[a][b][m][n] = (f32x4){0.f, 0.f, 0.f, 0.f};
    bf16x8 At[4][2], B0[2][2], B1[2][2];
    const char* cA = (const char*)g.A + (size_t)cur.pm * tstep; const char* cB = (const char*)g.Bt + (size_t)cur.pn * tstep;
    S.a_ready(cur);
    if constexpr (SP2) {
        PG8_STAGE(PG8_SB(0, 0), cB, voffB); PG8_STAGE(PG8_SB(0, 1), cB + hstep, voffB); PG8_STAGE(PG8_SA(0, 0), cA, voffA); PG8_STAGE(PG8_SA(0, 1), cA + hstep, voffA);
        if (wr == 1) PG8_BAR;
        PG8_WAIT_V(2); PG8_BAR;
        PG8_STAGE(PG8_SB(1, 0), cB + kstep, voffB); PG8_STAGE(PG8_SA(1, 0), cA + kstep, voffA); PG8_STAGE(PG8_SB(1, 1), cB + hstep + kstep, voffB);
        PG8_WAIT_V(6); PG8_BAR;
    } else {
        PG8_STAGE(PG8_SB(0, 0), cB, voffB); PG8_STAGE(PG8_SA(0, 0), cA, voffA); PG8_STAGE(PG8_SB(0, 1), cB + hstep, voffB); PG8_STAGE(PG8_SA(0, 1), cA + hstep, voffA);
        if (wr == 1) PG8_BAR;
        PG8_WAIT_V(4); PG8_BAR;
        PG8_STAGE(PG8_SB(1, 0), cB + kstep, voffB); PG8_STAGE(PG8_SA(1, 0), cA + kstep, voffA); PG8_STAGE(PG8_SB(1, 1), cB + hstep + kstep, voffB);
        PG8_WAIT_V(6); PG8_BAR;
    }
    for (;;) {
        const bool has_next = S.next(ui + 1, nxt);
        const char* nA = has_next ? (const char*)g.A + (size_t)nxt.pm * tstep : cA; const char* nB = has_next ? (const char*)g.Bt + (size_t)nxt.pn * tstep : cB;
        for (int t = 0; t < nt; t += 2) {
            const bool last = (t == nt - 2);
            const char* a1 = cA + (size_t)(t + 1) * kstep;
            const char* a2 = last ? nA : cA + (size_t)(t + 2) * kstep; const char* b2 = last ? nB : cB + (size_t)(t + 2) * kstep;
            const char* a3 = a2 + kstep; const char* b3 = b2 + kstep;
            if (last && has_next) S.a_ready(nxt);
            if constexpr (SP2) {
            PG8_LDB(B0, 0, 0); PG8_LDB(B1, 0, 1); PG8_SCHED; PG8_LDA(At, 0, 0); PG8_STAGE(PG8_SA(1, 1), a1 + hstep, voffA);
            PG8_WAIT_V(8); PG8_WAIT_L(0); PG8_BAR; PG8_MMA(0, 0, At, B0); PG8_MMA(0, 1, At, B1); PG8_BAR; PG8_SCHED;
            PG8_LDA(At, 0, 1); PG8_STAGE(PG8_SB(0, 0), b2, voffB); PG8_STAGE(PG8_SB(0, 1), b2 + hstep, voffB); PG8_STAGE(PG8_SA(0, 0), a2, voffA);
            PG8_WAIT_V(8); PG8_WAIT_L(0); PG8_BAR; PG8_MMA(1, 0, At, B0); PG8_MMA(1, 1, At, B1); PG8_BAR; PG8_SCHED;
            PG8_LDB(B0, 1, 0); PG8_LDB(B1, 1, 1); PG8_SCHED; PG8_LDA(At, 1, 0); PG8_STAGE(PG8_SA(0, 1), a2 + hstep, voffA);
            PG8_WAIT_V(8); PG8_WAIT_L(0); PG8_BAR; PG8_MMA(0, 0, At, B0); PG8_MMA(0, 1, At, B1); PG8_BAR; PG8_SCHED;
            PG8_LDA(At, 1, 1); PG8_STAGE(PG8_SB(1, 0), b3, voffB); PG8_STAGE(PG8_SB(1, 1), b3 + hstep, voffB); PG8_STAGE(PG8_SA(1, 0), a3, voffA);
            PG8_WAIT_V(8); PG8_WAIT_L(0); PG8_BAR; PG8_MMA(1, 0, At, B0); PG8_MMA(1, 1, At, B1); PG8_BAR; PG8_SCHED;
            } else {
            PG8_LDB(B0, 0, 0); PG8_SCHED; PG8_LDA(At, 0, 0); PG8_STAGE(PG8_SA(1, 1), a1 + hstep, voffA);
            PG8_WAIT_L(8); PG8_BAR; PG8_WAIT_L(0); PG8_MMA(0, 0, At, B0); PG8_BAR; PG8_SCHED;
            PG8_LDB(B1, 0, 1); PG8_STAGE(PG8_SB(0, 0), b2, voffB);
            PG8_BAR; PG8_WAIT_L(0); PG8_MMA(0, 1, At, B1); PG8_BAR;
            PG8_LDA(At, 0, 1); PG8_STAGE(PG8_SA(0, 0), a2, voffA);
            PG8_BAR; PG8_WAIT_L(0); PG8_MMA(1, 0, At, B0); PG8_BAR; PG8_SCHED;
            PG8_STAGE(PG8_SB(0, 1), b2 + hstep, voffB);
            PG8_WAIT_V(6); PG8_BAR; PG8_MMA(1, 1, At, B1); PG8_BAR;
            PG8_LDB(B0, 1, 0); PG8_SCHED; PG8_LDA(At, 1, 0); PG8_STAGE(PG8_SA(0, 1), a2 + hstep, voffA);
            PG8_WAIT_L(8); PG8_BAR; PG8_WAIT_L(0); PG8_MMA(0, 0, At, B0); PG8_BAR; PG8_SCHED;
            PG8_LDB(B1, 1, 1); PG8_STAGE(PG8_SB(1, 0), b3, voffB);
            PG8_BAR; PG8_WAIT_L(0); PG8_MMA(0, 1, At, B1); PG8_BAR;
            PG8_LDA(At, 1, 1); PG8_STAGE(PG8_SA(1, 0), a3, voffA);
            PG8_BAR; PG8_WAIT_L(0); PG8_MMA(1, 0, At, B0); PG8_BAR; PG8_SCHED;
            PG8_STAGE(PG8_SB(1, 1), b3 + hstep, voffB);
            PG8_WAIT_V(6); PG8_BAR; PG8_MMA(1, 1, At, B1); PG8_BAR;
            }
        }
        if constexpr (ALIGN_EPI) { if (wr == 0) PG8_BAR; }
        if constexpr (!Epi::AFTER_DRAIN) { E(acc, cur, wr, wc, fr, fq); S.done(cur); }
        if (!has_next) break;
#pragma unroll
        for (int a = 0; a < 2; ++a)
#pragma unroll
            for (int b = 0; b < 2; ++b)
#pragma unroll
                for (int m = 0; m < 4; ++m)
#pragma unroll
                    for (int n = 0; n < 2; ++n) acc[a][b][m][n] = (f32x4){0.f, 0.f, 0.f, 0.f};
        cur = nxt; cA = nA; cB = nB; ++ui;
        if constexpr (ALIGN_EPI) { if (wr == 1) PG8_BAR; }
    }
    PG8_WAIT_V(0);
    if constexpr (!ALIGN_EPI) { if (wr == 0) PG8_BAR; }
    PG8_BAR;
    if constexpr (Epi::AFTER_DRAIN) { E.fused(acc, cur, wr, wc, fr, fq, lds, wid, lane); S.done(cur); }
#undef PG8_SA
#undef PG8_SB
#undef PG8_STAGE
#undef PG8_LDA
#undef PG8_LDB
#undef PG8_MMA
#undef PG8_WAIT_V
#undef PG8_WAIT_L
#undef PG8_BAR
#undef PG8_SCHED
}
}
constexpr int NB = 4, SEQ = 8192, D = 1024, M = NB * SEQ;
constexpr int NZ0 = 3584, NZ1 = 3072, NQ = 2048, SRC_IN0 = 3592;
constexpr float EPS = 1e-6f;
constexpr int NWAVES = 8, NTHR = 512;
constexpr float LOG2E = 1.4426950408889634f;
constexpr size_t MiB = 1u << 20;
constexpr size_t WS_CTL = 0, CTL_ZERO_BYTES = 1 * MiB;
constexpr size_t WS_WIN0 = 1 * MiB, WS_WOUT0 = 8 * MiB, WS_WIN1 = 10 * MiB, WS_WOUT1 = 16 * MiB, WS_WQ = 18 * MiB;
constexpr size_t WS_KEYS = 26 * MiB, WS_MOD = WS_KEYS + 128 * 1024, WS_KMEAN = WS_MOD + 192 * 1024, WS_NLOC = WS_KMEAN + 256 * 1024,
                 WS_BEND = WS_NLOC + 512 * 1024, WS_MLOC = WS_BEND + 4096, WS_MPREV = WS_MLOC + 4096,
                 WS_ISU = 27 * MiB + 512 * 1024, WS_ISV = WS_ISU + 128 * 1024, WS_ORD = WS_ISV + 128 * 1024  ;
constexpr size_t WS_GATES = 28 * MiB;
constexpr size_t WS_UB = 32 * MiB  , WS_VB = 64 * MiB, WS_ACT = 96 * MiB  , WS_DBGBUF = 112 * MiB, WS_XNY = 160 * MiB, WS_Z = 224 * MiB, WS_CLOC = 448 * MiB, WS_END = 512 * MiB;
constexpr size_t WS_QRY = WS_Z, WS_IDX = WS_Z + 128 * MiB, WS_GATE = WS_Z + 144 * MiB, WS_PART = 384 * MiB  ;
constexpr int CW_BAR = 4096, CW_QMOBA = 8192, CW_QDIFF = 8256;
constexpr float ALIBI_MARGIN = 27.03f;
constexpr int RING_BYTES = 139264;
constexpr int LDSCTL_OFF = RING_BYTES, MISC_OFF = LDSCTL_OFF + 320;
constexpr int LDS_BYTES = 147456;
static_assert(MISC_OFF + 128 <= LDS_BYTES, "LDS map");

#define GAS __attribute__((address_space(1)))
#define LAS __attribute__((address_space(3)))
typedef unsigned short bf16;
typedef unsigned v4u __attribute__((ext_vector_type(4)));
typedef unsigned v2u __attribute__((ext_vector_type(2)));
typedef float f32x4 __attribute__((ext_vector_type(4)));
typedef float f32x16 __attribute__((ext_vector_type(16)));
typedef short bf16x8 __attribute__((ext_vector_type(8)));
typedef short s16x4 __attribute__((ext_vector_type(4)));
typedef GAS unsigned gu32;
#define RLX_AGENT __ATOMIC_RELAXED, __HIP_MEMORY_SCOPE_AGENT
#define LDS_WAIT() asm volatile("s_waitcnt lgkmcnt(0)" ::: "memory")
#define VM_WAIT() asm volatile("s_waitcnt vmcnt(0)" ::: "memory")
__device__ __forceinline__ unsigned f2bf(float f) { unsigned u = __builtin_bit_cast(unsigned, f); return (u + 0x7fffu + ((u >> 16) & 1u)) >> 16; }
__device__ __forceinline__ unsigned pk2(float lo, float hi) { return f2bf(lo) | (f2bf(hi) << 16); }
__device__ __forceinline__ float bflo(unsigned w) { return __builtin_bit_cast(float, w << 16); }
__device__ __forceinline__ float bfhi(unsigned w) { return __builtin_bit_cast(float, w & 0xffff0000u); }
__device__ __forceinline__ float bf2f(bf16 h) { return __builtin_bit_cast(float, (unsigned)h << 16); }
__device__ __forceinline__ unsigned f2u(float x) { return __builtin_bit_cast(unsigned, x); }
__device__ __forceinline__ float u2f(unsigned x) { return __builtin_bit_cast(float, x); }
__device__ __forceinline__ float dot2bf(unsigned a, unsigned b, float acc) { typedef __bf16 bf2_ __attribute__((ext_vector_type(2))); return __builtin_amdgcn_fdot2_f32_bf16(__builtin_bit_cast(bf2_, a), __builtin_bit_cast(bf2_, b), acc, false); }
__device__ __forceinline__ float wave_sum(float v) {
#pragma unroll
    for (int o = 1; o < 64; o <<= 1) v += __shfl_xor(v, o);
    return v;
}
__device__ __forceinline__ float wave_max(float v) {
#pragma unroll
    for (int o = 1; o < 64; o <<= 1) v = fmaxf(v, __shfl_xor(v, o));
    return v;
}
__device__ __forceinline__ float silu_f(float x) { return x / (1.f + __expf(-x)); }
__device__ __forceinline__ float sigmoid_f(float x) { return 1.f / (1.f + __expf(-x)); }
__device__ __forceinline__ float logsigmoid_f(float x) { return fminf(x, 0.f) - log1pf(__expf(-fabsf(x))); }
struct Args { const float* in[24]; float* out; unsigned char* ws; int ph_lo, ph_hi; };
#define XB_TMO      128
#define XB_XCNT(j)  (256  + 64 * (j))
#define XB_XSUB(j)  (1280 + 64 * (j))
#define XB_XGEN(j)  (2304 + 64 * (j))
#define XB_TOP      3328
#define XB_TOPGEN   3392
#define XCD_BAR_WORDS 3456
#define XB_SPIN_CAP (1u << 18)

__device__ __forceinline__ unsigned xb_ld(unsigned* p)              { return __hip_atomic_load(p, __ATOMIC_RELAXED, __HIP_MEMORY_SCOPE_AGENT); }
__device__ __forceinline__ unsigned xb_add(unsigned* p, unsigned v) { return __hip_atomic_fetch_add(p, v, __ATOMIC_RELAXED, __HIP_MEMORY_SCOPE_AGENT); }
__device__ __forceinline__ unsigned xb_xcc_id() { return (unsigned)__builtin_amdgcn_s_getreg((3 << 11) | 20) & 0xFu; }
#define XB_SPIN(cond, bar) do { unsigned _sp = 0; while (cond) { __builtin_amdgcn_s_sleep(1); \
    if ((++_sp & 255u) == 0u) { if (xb_ld(&(bar)[XB_TMO])) break; if (_sp > XB_SPIN_CAP) { atomicAdd(&(bar)[XB_TMO], 1u); break; } } } } while (0)

struct XcdBarrier {
    unsigned* bar; unsigned x;
    volatile LAS unsigned* st;
};

__device__ __forceinline__ XcdBarrier xcd_barrier_post(unsigned* bar, volatile LAS unsigned* st) {
    XcdBarrier b; b.bar = bar; b.x = xb_xcc_id(); b.st = st;
    if (threadIdx.x == 0) (void)xb_add(&bar[XB_XCNT(b.x)], 1u);
    return b;
}
__device__ __forceinline__ void xcd_barrier_complete(unsigned* bar, unsigned x, unsigned& nloc, unsigned& nx) {
    const unsigned G = gridDim.x * gridDim.y * gridDim.z;
    unsigned sum, cnt, mine, sp = 0u;
    for (;;) {
        sum = 0u; cnt = 0u; mine = 0u;
#pragma unroll
        for (unsigned j = 0; j < 16; ++j) { const unsigned c = xb_ld(&bar[XB_XCNT(j)]); sum += c; cnt += (c > 0u) ? 1u : 0u; mine = (j == x) ? c : mine; }
        if (sum == G) break;
        __builtin_amdgcn_s_sleep(1);
        if ((++sp & 255u) == 0u) { if (xb_ld(&bar[XB_TMO])) break; if (sp > XB_SPIN_CAP) { atomicAdd(&bar[XB_TMO], 1u); break; } }
    }
    nloc = mine > 0u ? mine : 1u; nx = cnt > 0u ? cnt : 1u;
}

__device__ __forceinline__ void xcd_barrier(const XcdBarrier& b) {
    asm volatile("s_waitcnt vmcnt(0)" ::: "memory");
    __syncthreads();
    if (threadIdx.x == 0) {
        unsigned* bar = b.bar;
        __builtin_amdgcn_s_waitcnt(0);
        unsigned nloc = b.st[0], nx = b.st[1];
        if (nloc == 0u) { xcd_barrier_complete(bar, b.x, nloc, nx); b.st[0] = nloc; b.st[1] = nx; }
        const unsigned old = xb_add(&bar[XB_XSUB(b.x)], 1u);
        const unsigned gen = old / nloc;
        if (old + 1u == (gen + 1u) * nloc) {
            __builtin_amdgcn_fence(__ATOMIC_RELEASE, "agent");
            asm volatile("s_waitcnt vmcnt(0)" ::: "memory");
            const unsigned og = xb_add(&bar[XB_TOP], 1u);
            const unsigned tg = og / nx;
            if (og + 1u == (tg + 1u) * nx) xb_add(&bar[XB_TOPGEN], 1u);
            else XB_SPIN(xb_ld(&bar[XB_TOPGEN]) == tg, bar);
            __builtin_amdgcn_fence(__ATOMIC_ACQUIRE, "agent");
            xb_add(&bar[XB_XGEN(b.x)], 1u);
            asm volatile("s_waitcnt vmcnt(0)" ::: "memory");
        } else {
            XB_SPIN(xb_ld(&bar[XB_XGEN(b.x)]) == gen, bar);
            __builtin_amdgcn_fence(__ATOMIC_ACQUIRE, "agent");
            asm volatile("s_waitcnt vmcnt(0)" ::: "memory");
        }
    }
    __syncthreads();
}
struct Frame {
    LAS unsigned char* lds;
    int tid, lane, wave, G, bid;
    float* out; unsigned char* ws;
};
#define WSP(T, off) ((T*)(F.ws + (off)))

__device__ __forceinline__ void p0_transpose_item(const float* W, int K, int ldw, int nblk, int thr, int shift, bf16* WT, LAS float* scr, int item, int lane) {
    const int kb = item / nblk, nb = item % nblk, k0 = 64 * kb, n0 = 32 * nb, ns = n0 + (n0 >= thr ? shift : 0);
#pragma unroll 8
    for (int i = 0; i < 32; ++i) { const int kk = 2 * i + (lane >> 5); scr[kk * 33 + (lane & 31)] = W[(size_t)(k0 + kk) * ldw + ns + (lane & 31)]; }
    LDS_WAIT(); asm volatile("" ::: "memory");
    const int c = lane & 7;
#pragma unroll
    for (int j = 0; j < 4; ++j) { const int n = (lane >> 3) + 8 * j; const LAS float* s = scr + (8 * c) * 33 + n;
        v4u o; o.x = pk2(s[0 * 33], s[1 * 33]); o.y = pk2(s[2 * 33], s[3 * 33]); o.z = pk2(s[4 * 33], s[5 * 33]); o.w = pk2(s[6 * 33], s[7 * 33]);
        *(GAS v4u*)(WT + (size_t)(n0 + n) * K + k0 + 8 * c) = o; }
    LDS_WAIT(); asm volatile("" ::: "memory");
}
__device__ __forceinline__ void cvt_f32_bf16_stream(const float* src, bf16* dst, size_t n8, size_t gtid, size_t gthreads) {
    for (size_t i = gtid; i < n8; i += gthreads) {
        const f32x4 a = *(const GAS f32x4*)(src + i * 8), b = *(const GAS f32x4*)(src + i * 8 + 4);
        v4u o; o.x = pk2(a.x, a.y); o.y = pk2(a.z, a.w); o.z = pk2(b.x, b.y); o.w = pk2(b.z, b.w);
        *(GAS v4u*)(dst + i * 8) = o; }
}
__device__ __forceinline__ void p0_fp8_rows(Frame& F, const float* src, unsigned char* dst, float* iscale) {
    const int gw = F.bid * NWAVES + F.wave, NGW = F.G * NWAVES, lane = F.lane;
    for (int row = gw; row < 2 * 16384; row += NGW) {
        const float* r = src + (size_t)row * 1024 + 16 * lane;
        const f32x4 a = *(const GAS f32x4*)r, b = *(const GAS f32x4*)(r + 4), c = *(const GAS f32x4*)(r + 8), e = *(const GAS f32x4*)(r + 12);
        float am = fmaxf(fmaxf(fmaxf(fabsf(a.x), fabsf(a.y)), fmaxf(fabsf(a.z), fabsf(a.w))), fmaxf(fmaxf(fabsf(b.x), fabsf(b.y)), fmaxf(fabsf(b.z), fabsf(b.w))));
        am = fmaxf(am, fmaxf(fmaxf(fmaxf(fabsf(c.x), fabsf(c.y)), fmaxf(fabsf(c.z), fabsf(c.w))), fmaxf(fmaxf(fabsf(e.x), fabsf(e.y)), fmaxf(fabsf(e.z), fabsf(e.w)))));
        am = wave_max(am);
        const float sc = am > 1e-30f ? exp2f(floorf(log2f(256.f / am))) : 1.f;
        int w0 = 0, w1 = 0, w2 = 0, w3 = 0;
        w0 = __builtin_amdgcn_cvt_pk_fp8_f32(a.x * sc, a.y * sc, w0, false); w0 = __builtin_amdgcn_cvt_pk_fp8_f32(a.z * sc, a.w * sc, w0, true);
        w1 = __builtin_amdgcn_cvt_pk_fp8_f32(b.x * sc, b.y * sc, w1, false); w1 = __builtin_amdgcn_cvt_pk_fp8_f32(b.z * sc, b.w * sc, w1, true);
        w2 = __builtin_amdgcn_cvt_pk_fp8_f32(c.x * sc, c.y * sc, w2, false); w2 = __builtin_amdgcn_cvt_pk_fp8_f32(c.z * sc, c.w * sc, w2, true);
        w3 = __builtin_amdgcn_cvt_pk_fp8_f32(e.x * sc, e.y * sc, w3, false); w3 = __builtin_amdgcn_cvt_pk_fp8_f32(e.z * sc, e.w * sc, w3, true);
        const int layer = row >> 14, er = row & 16383;
        v4u o; o.x = (unsigned)w0; o.y = (unsigned)w1; o.z = (unsigned)w2; o.w = (unsigned)w3;
        *(GAS v4u*)(dst + ((size_t)((layer * 8 + (lane >> 3)) * 16384 + er)) * 128 + 16 * (lane & 7)) = o;
        if (lane == 0) iscale[row] = 1.f / sc;
    }
}
__device__ __forceinline__ void p0_prologue(Frame& F, const Args& A) {
    {
        const float* c = A.in[1]; const float* aw = A.in[2]; const float* ab = A.in[3]; float* MOD = WSP(float, WS_MOD);
        LAS float* red = (LAS float*)F.lds;
        for (int item = F.bid; item < 192; item += F.G) {
            const int l = item / 96, n0 = (item % 96) * 64;
            float acc[4] = {0.f, 0.f, 0.f, 0.f};
            const int kbeg = F.wave * 128;
#pragma unroll 4
            for (int k = kbeg; k < kbeg + 128; ++k) {
                const float wv = aw[((size_t)l * 1024 + k) * 6144 + n0 + F.lane];
#pragma unroll
                for (int b = 0; b < 4; ++b) acc[b] += silu_f(c[b * 1024 + k]) * wv;
            }
#pragma unroll
            for (int b = 0; b < 4; ++b) red[(F.wave * 4 + b) * 64 + F.lane] = acc[b];
            __syncthreads();
            if (F.tid < 256) { const int b = F.tid >> 6, ln = F.tid & 63; float s = ab[l * 6144 + n0 + ln];
#pragma unroll
                for (int w = 0; w < 8; ++w) s += red[(w * 4 + b) * 64 + ln];
                MOD[(size_t)(l * 4 + b) * 6144 + n0 + ln] = s; }
            __syncthreads();
        }
    }
    if (F.bid == 0) {
        LAS unsigned* hist = (LAS unsigned*)F.lds;
        unsigned short* ORD = WSP(unsigned short, WS_ORD);
        for (int pass = 0; pass < 2; ++pass) {
            const int nunits = pass == 0 ? 2048 : 1024;
            if (F.tid < 160) hist[F.tid] = 0u;
            __syncthreads();
            for (int u = F.tid; u < nunits; u += NTHR) {
                const int q = pass == 0 ? (u & 63) : (u & 31), h = pass == 0 ? ((u >> 6) & 7) : ((u >> 5) & 7);
                const float dcut = 46.f * (float)(2 << h);
                int cost;
                if (pass == 0) { const int nt = 2 * q + 2; int lo = (int)ceilf(((float)(q * 128) - dcut - 63.f) * (1.f / 64.f)); if (lo < 0) lo = 0; cost = nt - lo; }
                else { int lo = (int)ceilf(((float)(q * 256) - dcut - 255.f) * (1.f / 256.f)); if (lo < 0) lo = 0; int nb = q - lo; if (nb > 3 * 8) nb = 24; cost = 4 * (nb + 1); }
                if (cost > 159) cost = 159;
                atomicAdd((unsigned*)(hist + (159 - cost)), 1u);
            }
            __syncthreads();
            if (F.tid == 0) { unsigned acc = 0; for (int i = 0; i < 160; ++i) { const unsigned c = hist[i]; hist[i] = acc; acc += c; } }
            __syncthreads();
            for (int u = F.tid; u < nunits; u += NTHR) {
                const int q = pass == 0 ? (u & 63) : (u & 31), h = pass == 0 ? ((u >> 6) & 7) : ((u >> 5) & 7);
                const float dcut = 46.f * (float)(2 << h);
                int cost;
                if (pass == 0) { const int nt = 2 * q + 2; int lo = (int)ceilf(((float)(q * 128) - dcut - 63.f) * (1.f / 64.f)); if (lo < 0) lo = 0; cost = nt - lo; }
                else { int lo = (int)ceilf(((float)(q * 256) - dcut - 255.f) * (1.f / 256.f)); if (lo < 0) lo = 0; int nb = q - lo; if (nb > 3 * 8) nb = 24; cost = 4 * (nb + 1); }
                if (cost > 159) cost = 159;
                const unsigned pos = atomicAdd((unsigned*)(hist + (159 - cost)), 1u);
                ORD[(pass == 0 ? 0 : 2048) + pos] = (unsigned short)u;
            }
            __syncthreads();
        }
    }
    {
        LAS float* scr = (LAS float*)(F.lds + F.wave * 8704);
        const int gw = F.bid * NWAVES + F.wave, NGW = F.G * NWAVES;
        constexpr int I_IN0 = 16 * (NZ0 / 32), I_OUT = 16 * 32, I_IN1 = 16 * (NZ1 / 32), I_Q = 16 * (NQ / 32);
        constexpr int NITEMS = I_IN0 + 2 * I_OUT + I_IN1 + 2 * I_Q;
        for (int it = gw; it < NITEMS; it += NGW) {
            int r = it;
            if (r < I_IN0) { p0_transpose_item(A.in[6], D, SRC_IN0, NZ0 / 32, 2048, 8, WSP(bf16, WS_WIN0), scr, r, F.lane); continue; } r -= I_IN0;
            if (r < I_OUT) { p0_transpose_item(A.in[13], D, D, 32, 1 << 30, 0, WSP(bf16, WS_WOUT0), scr, r, F.lane); continue; } r -= I_OUT;
            if (r < I_IN1) { p0_transpose_item(A.in[14], D, NZ1, NZ1 / 32, 1 << 30, 0, WSP(bf16, WS_WIN1), scr, r, F.lane); continue; } r -= I_IN1;
            if (r < I_OUT) { p0_transpose_item(A.in[19], D, D, 32, 1 << 30, 0, WSP(bf16, WS_WOUT1), scr, r, F.lane); continue; } r -= I_OUT;
            if (r < I_Q) { p0_transpose_item(A.in[20], D, NQ, NQ / 32, 1 << 30, 0, WSP(bf16, WS_WQ), scr, r, F.lane); continue; } r -= I_Q;
            p0_transpose_item(A.in[20] + (size_t)D * NQ, D, NQ, NQ / 32, 1 << 30, 0, WSP(bf16, WS_WQ) + (size_t)NQ * D, scr, r, F.lane);
        }
    }
    {
        const size_t gtid = (size_t)F.bid * NTHR + F.tid, gth = (size_t)F.G * NTHR;
        cvt_f32_bf16_stream(A.in[21], WSP(bf16, WS_KEYS), (size_t)2 * 2 * 128 * 128 / 8, gtid, gth);
        p0_fp8_rows(F, A.in[22], F.ws + WS_UB, WSP(float, WS_ISU));
        p0_fp8_rows(F, A.in[23], F.ws + WS_VB, WSP(float, WS_ISV));
    }
}

template <bool GATES>
__device__ __forceinline__ void norm_pass(Frame& F, const Args& A, const float* X, const float* g, const float* mod, int shc, bf16* XN) {
    LAS float* wgT = (LAS float*)F.lds;
    if (GATES) {
        const float* win = A.in[6];
        for (int i = F.tid; i < 8 * 1024; i += NTHR) { const int cg = i >> 10, k = i & 1023; wgT[i] = win[(size_t)k * SRC_IN0 + 2048 + cg]; }
        __syncthreads();
    }
    const int gw = F.bid * NWAVES + F.wave, NGW = F.G * NWAVES;
    for (int row = gw; row < M; row += NGW) {
        const int b = row >> 13;
        const GAS f32x4* xr = (const GAS f32x4*)(X + (size_t)row * D) + F.lane;
        f32x4 v[4]; float ss = 0.f;
#pragma unroll
        for (int j = 0; j < 4; ++j) { v[j] = xr[64 * j]; ss += (v[j].x * v[j].x + v[j].y * v[j].y) + (v[j].z * v[j].z + v[j].w * v[j].w); }
        const float rstd = rsqrtf(wave_sum(ss) * (1.f / D) + EPS);
        const float* shp = mod + (size_t)b * 6144 + shc * 1024; const float* scp = shp + 1024;
#pragma unroll
        for (int j = 0; j < 4; ++j) { const int c = 4 * F.lane + 256 * j;
            const f32x4 gg = *(const f32x4*)(g + c), sc = *(const f32x4*)(scp + c), sh = *(const f32x4*)(shp + c);
            v[j] = v[j] * rstd * gg * (sc + 1.f) + sh;
            v2u o; o.x = pk2(v[j].x, v[j].y); o.y = pk2(v[j].z, v[j].w);
            *(GAS v2u*)(XN + (size_t)row * D + c) = o; }
        if (GATES) {
            float* GT = WSP(float, WS_GATES);
#pragma unroll
            for (int cg = 0; cg < 8; ++cg) { float p = 0.f;
#pragma unroll
                for (int j = 0; j < 4; ++j) { const f32x4 w = *(const LAS f32x4*)(wgT + cg * 1024 + 4 * F.lane + 256 * j); p += (v[j].x * w.x + v[j].y * w.y) + (v[j].z * w.z + v[j].w * w.w); }
                p = wave_sum(p);
                if (F.lane == 0) GT[(size_t)row * 8 + cg] = p + (cg < 4 ? A.in[8][cg] : A.in[9][cg - 4]); }
        }
    }
}

__device__ __forceinline__ void qknorm_unit(Frame& F, bf16* Z, int ldz, int row0, int col0, const float* g, float* kmean  ) {
    const int c = col0 + 8 * F.lane, d0 = (8 * F.lane) & 63;
    float gv[8];
#pragma unroll
    for (int i = 0; i < 8; ++i) gv[i] = g[d0 + i];
    float ks[8] = {0.f, 0.f, 0.f, 0.f, 0.f, 0.f, 0.f, 0.f};
    for (int r = 0; r < 32; ++r) {
        bf16* p = Z + (size_t)(row0 + F.wave * 32 + r) * ldz + c;
        const v4u w = *(const GAS v4u*)p;
        float x[8] = {bflo(w.x), bfhi(w.x), bflo(w.y), bfhi(w.y), bflo(w.z), bfhi(w.z), bflo(w.w), bfhi(w.w)};
        float ss = 0.f;
#pragma unroll
        for (int i = 0; i < 8; ++i) ss += x[i] * x[i];
        ss += __shfl_xor(ss, 1); ss += __shfl_xor(ss, 2); ss += __shfl_xor(ss, 4);
        const float rstd = rsqrtf(ss * (1.f / 64.f) + EPS);
#pragma unroll
        for (int i = 0; i < 8; ++i) { x[i] = x[i] * rstd * gv[i]; ks[i] += x[i]; }
        v4u o; o.x = pk2(x[0], x[1]); o.y = pk2(x[2], x[3]); o.z = pk2(x[4], x[5]); o.w = pk2(x[6], x[7]);
        *(GAS v4u*)p = o;
    }
    if (kmean) {
        LAS float* red = (LAS float*)F.lds;
#pragma unroll
        for (int i = 0; i < 8; ++i) red[F.wave * 512 + 8 * F.lane + i] = ks[i];
        __syncthreads();
        { float s = 0.f;
#pragma unroll
          for (int w = 0; w < 8; ++w) s += red[w * 512 + F.tid];
          kmean[(size_t)(F.tid >> 6) * (32 * 64) + (F.tid & 63)] = s * (1.f / 256.f); }
        __syncthreads();
    }
}
constexpr int KSTRB = 144;
template <int DV> struct VStr { static constexpr int B = (DV == 64) ? 192 : 320; };
typedef short v4i16_t __attribute__((ext_vector_type(4)));
__device__ __forceinline__ s16x4 vtr(const LAS unsigned char* p) { return __builtin_bit_cast(s16x4, __builtin_amdgcn_ds_read_tr16_b64_v4i16((LAS v4i16_t*)p)); }
__device__ __forceinline__ unsigned cvtpk(float lo, float hi) { typedef float f2 __attribute__((ext_vector_type(2))); typedef __bf16 b2 __attribute__((ext_vector_type(2)));
    f2 v = {lo, hi}; b2 b = __builtin_convertvector(v, b2); return __builtin_bit_cast(unsigned, b); }
__device__ __forceinline__ float xhalf(float v) {
    auto rr = __builtin_amdgcn_permlane32_swap(__builtin_bit_cast(unsigned, v), __builtin_bit_cast(unsigned, v), false, false);
    const unsigned r0 = rr[0], r1 = rr[1]; return u2f((threadIdx.x & 32) ? r0 : r1);
}
template <int DV> struct AttnSt { f32x16 o[DV / 32]; float m, l; };
template <int DV> __device__ __forceinline__ void attn_init(AttnSt<DV>& st) {
#pragma unroll
    for (int t = 0; t < DV / 32; ++t)
#pragma unroll
        for (int r = 0; r < 16; ++r) st.o[t][r] = 0.f;
    st.m = -1e30f; st.l = 0.f;
}
template <int DV>
__device__ __forceinline__ void attn_tile(AttnSt<DV>& st, const LAS unsigned char* Kt, const LAS unsigned char* Vt, const bf16x8 (&qf)[4], float sc2, float sl2, int tq, int kt0, bool diag, bool rowok, int lane) {
    const int r32 = lane & 31, hi = lane >> 5;
    f32x16 s0, s1;
#pragma unroll
    for (int r = 0; r < 16; ++r) { s0[r] = 0.f; s1[r] = 0.f; }
    const LAS unsigned char* kp = Kt + r32 * KSTRB + hi * 16;
#pragma unroll
    for (int ks = 0; ks < 4; ++ks) {
        const bf16x8 k0 = *(const LAS bf16x8*)(kp + ks * 32), k1 = *(const LAS bf16x8*)(kp + 32 * KSTRB + ks * 32);
        s0 = __builtin_amdgcn_mfma_f32_32x32x16_bf16(k0, qf[ks], s0, 0, 0, 0);
        s1 = __builtin_amdgcn_mfma_f32_32x32x16_bf16(k1, qf[ks], s1, 0, 0, 0);
    }
    const int kb = kt0 + 4 * hi;
    const float c0 = -sl2 * (float)(tq - kb);
    float mx = -INFINITY;
#pragma unroll
    for (int r = 0; r < 16; ++r) {
        const int ko = (r & 3) + 8 * (r >> 2);
        float a = s0[r] * sc2 + (c0 + sl2 * (float)ko), b = s1[r] * sc2 + (c0 + sl2 * (float)(ko + 32));
        if (diag) { if (kb + ko > tq) a = -INFINITY; if (kb + ko + 32 > tq) b = -INFINITY; }
        if (!rowok) { a = -INFINITY; b = -INFINITY; }
        s0[r] = a; s1[r] = b; mx = fmaxf(mx, fmaxf(a, b));
    }
    mx = fmaxf(mx, xhalf(mx));
    const float mn = fmaxf(st.m, mx);
    const float alpha = __builtin_amdgcn_exp2f(st.m - mn);
    st.m = mn;
    float ps = 0.f;
#pragma unroll
    for (int r = 0; r < 16; ++r) { s0[r] = __builtin_amdgcn_exp2f(s0[r] - mn); s1[r] = __builtin_amdgcn_exp2f(s1[r] - mn); ps += s0[r] + s1[r]; }
    st.l = st.l * alpha + ps;
#pragma unroll
    for (int t = 0; t < DV / 32; ++t)
#pragma unroll
        for (int r = 0; r < 16; ++r) st.o[t][r] *= alpha;
    bf16x8 pf[2][2];
#pragma unroll
    for (int s = 0; s < 2; ++s) {
        v4u a, b;
        a.x = cvtpk(s0[8 * s + 0], s0[8 * s + 1]); a.y = cvtpk(s0[8 * s + 2], s0[8 * s + 3]); a.z = cvtpk(s0[8 * s + 4], s0[8 * s + 5]); a.w = cvtpk(s0[8 * s + 6], s0[8 * s + 7]);
        b.x = cvtpk(s1[8 * s + 0], s1[8 * s + 1]); b.y = cvtpk(s1[8 * s + 2], s1[8 * s + 3]); b.z = cvtpk(s1[8 * s + 4], s1[8 * s + 5]); b.w = cvtpk(s1[8 * s + 6], s1[8 * s + 7]);
        pf[0][s] = __builtin_bit_cast(bf16x8, a); pf[1][s] = __builtin_bit_cast(bf16x8, b);
    }
    constexpr int VS = VStr<DV>::B;
    const int g = lane >> 4, i16 = lane & 15;
    const LAS unsigned char* vp = Vt + (4 * (g >> 1) + (i16 >> 2)) * VS + (16 * (g & 1) + 4 * (i16 & 3)) * 2;
#pragma unroll
    for (int kbk = 0; kbk < 2; ++kbk)
#pragma unroll
        for (int s = 0; s < 2; ++s)
#pragma unroll
            for (int t = 0; t < DV / 32; ++t) {
                const s16x4 lo = vtr(vp + (kbk * 32 + 16 * s) * VS + t * 64), h8 = vtr(vp + (kbk * 32 + 16 * s + 8) * VS + t * 64);
                const bf16x8 va = {lo[0], lo[1], lo[2], lo[3], h8[0], h8[1], h8[2], h8[3]};
                st.o[t] = __builtin_amdgcn_mfma_f32_32x32x16_bf16(va, pf[kbk][s], st.o[t], 0, 0, 0);
            }
}
template <int NK, int DV> struct TileRegs { v4u k[NK]; v4u v[DV / 64]; };
template <int NK, int DV>
__device__ __forceinline__ void tile_load(TileRegs<NK, DV>& R, const bf16* Z, int ldz, size_t zrow0, int kcol, int vcol, int tid) {
#pragma unroll
    for (int i = 0; i < NK; ++i) { const int ch = tid + 512 * i; const int row = ch / (8 * NK), cc = ch % (8 * NK);
        R.k[i] = *(const GAS v4u*)(Z + (zrow0 + row) * ldz + kcol + cc * 8); }
#pragma unroll
    for (int i = 0; i < DV / 64; ++i) { const int ch = tid + 512 * i; const int row = ch / (DV / 8), cc = ch % (DV / 8);
        R.v[i] = *(const GAS v4u*)(Z + (zrow0 + row) * ldz + vcol + cc * 8); }
}
template <int NK, int DV>
__device__ __forceinline__ void tile_store(const TileRegs<NK, DV>& R, LAS unsigned char* Kt  , LAS unsigned char* Vt, int tid) {
#pragma unroll
    for (int i = 0; i < NK; ++i) { const int ch = tid + 512 * i; const int row = ch / (8 * NK), cc = ch % (8 * NK);
        *(LAS v4u*)(Kt + (cc >> 3) * (64 * KSTRB) + row * KSTRB + (cc & 7) * 16) = R.k[i]; }
#pragma unroll
    for (int i = 0; i < DV / 64; ++i) { const int ch = tid + 512 * i; const int row = ch / (DV / 8), cc = ch % (DV / 8);
        *(LAS v4u*)(Vt + row * VStr<DV>::B + cc * 16) = R.v[i]; }
}
__device__ __forceinline__ void moba_unit(Frame& F, int b, int h, int j, float tcut  ) {
    const bf16* Z = WSP(bf16, WS_Z); constexpr int ldz = NZ0;
    const int lane = F.lane, w = F.wave, r32 = lane & 31, hi = lane >> 5, tid = F.tid;
    const size_t rowb = (size_t)b * SEQ;
    const int qpos = j * 256 + w * 32 + r32;
    const int qcol = 2048 + h * 64, kcol = 2560 + h * 64, vcol = 3072 + h * 64;
    LAS unsigned char* lds = F.lds;
    constexpr int BUFB = 64 * KSTRB + 64 * VStr<64>::B;
    LAS unsigned char* kmh = lds + 2 * BUFB;
    LAS unsigned char* kml = lds + 2 * BUFB + 32 * KSTRB;
    LAS unsigned* msk = (LAS unsigned*)(lds + 2 * BUFB + 64 * KSTRB);
    { const float* KM = WSP(float, WS_KMEAN) + (size_t)((b * 8 + h) * 32) * 64; const f32x4 x = *(const f32x4*)(KM + 4 * tid);
      const int n = tid >> 4, d0 = (tid & 15) * 4;
      const unsigned h0 = f2bf(x.x), h1 = f2bf(x.y), h2 = f2bf(x.z), h3 = f2bf(x.w);
      v2u hv; hv.x = h0 | (h1 << 16); hv.y = h2 | (h3 << 16);
      v2u lv; lv.x = pk2(x.x - u2f(h0 << 16), x.y - u2f(h1 << 16)); lv.y = pk2(x.z - u2f(h2 << 16), x.w - u2f(h3 << 16));
      *(LAS v2u*)(kmh + n * KSTRB + d0 * 2) = hv; *(LAS v2u*)(kml + n * KSTRB + d0 * 2) = lv; }
    if (tid < 16) msk[tid] = 0u;
    bf16x8 qf[4];
    const bf16* qrow = Z + (rowb + qpos) * ldz + qcol;
#pragma unroll
    for (int ks = 0; ks < 4; ++ks) qf[ks] = *(const GAS bf16x8*)(qrow + 16 * ks + 8 * hi);
    __syncthreads();
    f32x16 gt;
#pragma unroll
    for (int r = 0; r < 16; ++r) gt[r] = 0.f;
#pragma unroll
    for (int ks = 0; ks < 4; ++ks) {
        const bf16x8 a = *(const LAS bf16x8*)(kmh + r32 * KSTRB + hi * 16 + ks * 32), c = *(const LAS bf16x8*)(kml + r32 * KSTRB + hi * 16 + ks * 32);
        gt = __builtin_amdgcn_mfma_f32_32x32x16_bf16(a, qf[ks], gt, 0, 0, 0);
        gt = __builtin_amdgcn_mfma_f32_32x32x16_bf16(c, qf[ks], gt, 0, 0, 0);
    }
    float t0 = -INFINITY, t1 = -INFINITY, t2 = -INFINITY;
#define INS3(key) do { float k_ = (key); float a_ = fmaxf(t0, k_), l_ = fminf(t0, k_); t0 = a_; a_ = fmaxf(t1, l_); l_ = fminf(t1, l_); t1 = a_; t2 = fmaxf(t2, l_); } while (0)
#pragma unroll
    for (int r = 0; r < 16; ++r) { const int n = (r & 3) + 8 * (r >> 2) + 4 * hi;
        const float key = (n < j) ? u2f((f2u(gt[r]) & ~31u) | (unsigned)n) : -INFINITY; INS3(key); }
    { const float p0 = xhalf(t0), p1 = xhalf(t1), p2 = xhalf(t2); INS3(p0); INS3(p1); INS3(p2); }
#undef INS3
    const int sel0 = (t0 > -INFINITY) ? (int)(f2u(t0) & 31u) : -1;
    const int sel1 = (t1 > -INFINITY) ? (int)(f2u(t1) & 31u) : -1;
    const int sel2 = (t2 > -INFINITY) ? (int)(f2u(t2) & 31u) : -1;
    { const unsigned mm = (sel0 >= 0 ? 1u << sel0 : 0u) | (sel1 >= 0 ? 1u << sel1 : 0u) | (sel2 >= 0 ? 1u << sel2 : 0u);
      if (mm) { __hip_atomic_fetch_or(msk + w, mm, __ATOMIC_RELAXED, __HIP_MEMORY_SCOPE_WORKGROUP); __hip_atomic_fetch_or(msk + 8, mm, __ATOMIC_RELAXED, __HIP_MEMORY_SCOPE_WORKGROUP); } }
    __syncthreads();
    const float slope = ldexpf(1.f, -(h + 1)), dcut = tcut / slope;
    const float sl2 = slope * LOG2E, sc2 = 0.125f * LOG2E;
    int nlo = (int)ceilf(((float)(j * 256) - dcut - 255.f) * (1.f / 256.f)); if (nlo < 0) nlo = 0;
    const unsigned keep = nlo >= 32 ? 0u : (0xffffffffu << nlo);
    const unsigned bmask = msk[8] & keep; const unsigned wmask = (unsigned)__builtin_amdgcn_readfirstlane((int)msk[w]) & keep;
    AttnSt<64> st; attn_init<64>(st);
    unsigned rem = bmask;
    int blk = rem ? __builtin_ctz(rem) : j; if (rem) rem &= rem - 1;
    int kt = 0, buf = 0;
    TileRegs<1, 64> R;
    tile_load<1, 64>(R, Z, ldz, rowb + blk * 256 + kt * 64, kcol, vcol, tid);
    tile_store<1, 64>(R, lds, lds + 64 * KSTRB, tid);
    __syncthreads();
    for (;;) {
        int nblk = blk, nkt = kt + 1; bool has_next = true;
        if (nkt == 4) { nkt = 0; if (blk == j) has_next = false; else if (rem) { nblk = __builtin_ctz(rem); rem &= rem - 1; } else nblk = j; }
        if (has_next) tile_load<1, 64>(R, Z, ldz, rowb + nblk * 256 + nkt * 64, kcol, vcol, tid);
        const bool own = (blk == j);
        const bool active = (own ? (kt * 64 <= w * 32 + 31) : (((wmask >> blk) & 1u) != 0u)) && ((float)(j * 256 + w * 32 - (blk * 256 + kt * 64 + 63)) <= dcut);
        if (active) {
            const bool rowok = own || blk == sel0 || blk == sel1 || blk == sel2;
            const bool diag = own && (kt * 64 + 63 > w * 32);
            attn_tile<64>(st, lds + buf * BUFB, lds + buf * BUFB + 64 * KSTRB, qf, sc2, sl2, qpos, blk * 256 + kt * 64, diag, rowok, lane);
        }
        if (!has_next) break;
        tile_store<1, 64>(R, lds + (buf ^ 1) * BUFB, lds + (buf ^ 1) * BUFB + 64 * KSTRB, tid);
        __syncthreads();
        buf ^= 1; blk = nblk; kt = nkt;
    }
    const float inv = 1.f / (st.l + xhalf(st.l));
    bf16* Y = WSP(bf16, WS_XNY) + (rowb + qpos) * 1024 + 512 + h * 64;
#pragma unroll
    for (int t = 0; t < 2; ++t)
#pragma unroll
        for (int rg = 0; rg < 4; ++rg) { v2u o; o.x = pk2(st.o[t][4 * rg] * inv, st.o[t][4 * rg + 1] * inv); o.y = pk2(st.o[t][4 * rg + 2] * inv, st.o[t][4 * rg + 3] * inv);
            *(GAS v2u*)(Y + t * 32 + 8 * rg + 4 * hi) = o; }
    __syncthreads();
}

__device__ __forceinline__ void diff_unit(Frame& F, const Args& A, int b, int h, int qt, float lam, float tcut) {
    const bf16* Z = WSP(bf16, WS_Z); constexpr int ldz = NZ1;
    const int lane = F.lane, w = F.wave, r32 = lane & 31, hi = lane >> 5, tid = F.tid;
    const int comp = w >> 2, wq = w & 3;
    const size_t rowb = (size_t)b * SEQ;
    const int q0 = qt * 128, qpos = q0 + wq * 32 + r32;
    const int qcol = h * 128 + comp * 64, kcol = 1024 + h * 128, vcol = 2048 + h * 128;
    LAS unsigned char* lds = F.lds;
    constexpr int BUFB = 2 * 64 * KSTRB + 64 * VStr<128>::B;
    bf16x8 qf[4];
    const bf16* qrow = Z + (rowb + qpos) * ldz + qcol;
#pragma unroll
    for (int ks = 0; ks < 4; ++ks) qf[ks] = *(const GAS bf16x8*)(qrow + 16 * ks + 8 * hi);
    const float slope = ldexpf(1.f, -(h + 1)), dcut = tcut / slope;
    const float sl2 = slope * LOG2E, sc2 = 0.125f * LOG2E;
    AttnSt<128> st; attn_init<128>(st);
    const int nt = (q0 + 128) / 64;
    int kt_lo = (int)ceilf(((float)q0 - dcut - 63.f) * (1.f / 64.f)); if (kt_lo < 0) kt_lo = 0;
    TileRegs<2, 128> R;
    tile_load<2, 128>(R, Z, ldz, rowb + (size_t)kt_lo * 64, kcol, vcol, tid);
    tile_store<2, 128>(R, lds, lds + 2 * 64 * KSTRB, tid);
    __syncthreads();
    int buf = 0;
    for (int kt = kt_lo; kt < nt; ++kt) {
        const bool has_next = kt + 1 < nt;
        if (has_next) tile_load<2, 128>(R, Z, ldz, rowb + (size_t)(kt + 1) * 64, kcol, vcol, tid);
        if (kt * 64 <= q0 + wq * 32 + 31) {
            const bool diag = kt * 64 + 63 > q0 + wq * 32;
            attn_tile<128>(st, lds + buf * BUFB + comp * (64 * KSTRB), lds + buf * BUFB + 2 * 64 * KSTRB, qf, sc2, sl2, qpos, kt * 64, diag, true, lane);
        }
        if (has_next) { tile_store<2, 128>(R, lds + (buf ^ 1) * BUFB, lds + (buf ^ 1) * BUFB + 2 * 64 * KSTRB, tid); }
        __syncthreads();
        buf ^= 1;
    }
    const float inv = 1.f / (st.l + xhalf(st.l));
    LAS float* o2 = (LAS float*)lds;
    if (comp == 1) {
#pragma unroll
        for (int t = 0; t < 4; ++t)
#pragma unroll
            for (int r = 0; r < 16; ++r) o2[((wq * 4 + t) * 16 + r) * 64 + lane] = st.o[t][r] * inv;
    }
    __syncthreads();
    if (comp == 0) {
        float ss = 0.f;
#pragma unroll
        for (int t = 0; t < 4; ++t)
#pragma unroll
            for (int r = 0; r < 16; ++r) { const float v = st.o[t][r] * inv - lam * o2[((wq * 4 + t) * 16 + r) * 64 + lane]; st.o[t][r] = v; ss += v * v; }
        ss += xhalf(ss);
        const float rs = rsqrtf(ss * (1.f / 128.f) + EPS) * 0.6444909324090307f;
        const float* og = A.in[18];
        bf16* Y = WSP(bf16, WS_XNY) + (rowb + qpos) * 1024 + h * 128;
#pragma unroll
        for (int t = 0; t < 4; ++t)
#pragma unroll
            for (int rg = 0; rg < 4; ++rg) { const int dv = t * 32 + 8 * rg + 4 * hi; const f32x4 gg = *(const f32x4*)(og + dv);
                v2u o; o.x = pk2(st.o[t][4 * rg] * rs * gg.x, st.o[t][4 * rg + 1] * rs * gg.y); o.y = pk2(st.o[t][4 * rg + 2] * rs * gg.z, st.o[t][4 * rg + 3] * rs * gg.w);
                *(GAS v2u*)(Y + dv) = o; }
    }
    __syncthreads();
}
template <int MT, int NT>
__device__ __forceinline__ void mma_nt(const LAS unsigned char* A, int lda, const LAS unsigned char* B, int ldb, int K, f32x4 (&acc)[MT][NT], int lane) {
    const int r = lane & 15, kq = (lane >> 4) * 16;
    for (int k0 = 0; k0 < K; k0 += 32) {
        bf16x8 a[MT], bb[NT];
#pragma unroll
        for (int m = 0; m < MT; ++m) a[m] = *(const LAS bf16x8*)(A + (m * 16 + r) * lda + k0 * 2 + kq);
#pragma unroll
        for (int n = 0; n < NT; ++n) bb[n] = *(const LAS bf16x8*)(B + (n * 16 + r) * ldb + k0 * 2 + kq);
#pragma unroll
        for (int m = 0; m < MT; ++m)
#pragma unroll
            for (int n = 0; n < NT; ++n) acc[m][n] = __builtin_amdgcn_mfma_f32_16x16x32_bf16(a[m], bb[n], acc[m][n], 0, 0, 0);
    }
}
constexpr int TS = 272;
constexpr int TILEB = 128 * TS;
constexpr int ML_Q = 0, ML_K = TILEB, ML_V = 2 * TILEB, ML_SM = 3 * TILEB;

__device__ __forceinline__ void ml_gates(const float* GT, size_t row0, int hm, LAS float* sm, int lane) {
    const float i0 = GT[(row0 + 2 * lane) * 8 + hm], i1 = GT[(row0 + 2 * lane + 1) * 8 + hm];
    const float f0 = logsigmoid_f(GT[(row0 + 2 * lane) * 8 + 4 + hm]), f1 = logsigmoid_f(GT[(row0 + 2 * lane + 1) * 8 + 4 + hm]);
    float s = f0 + f1;
#pragma unroll
    for (int o = 1; o < 64; o <<= 1) { const float t = __shfl_up(s, o); if (lane >= o) s += t; }
    const float excl = s - (f0 + f1);
    sm[2 * lane] = excl + f0; sm[2 * lane + 1] = excl + f0 + f1;
    sm[128 + 2 * lane] = i0; sm[128 + 2 * lane + 1] = i1;
}
template <bool TRANSPOSE>
__device__ __forceinline__ void ml_conv_tile(const bf16* Z, size_t rowb, int t0, int zc, const float* cw, int wc, float mul, LAS unsigned char* dst, const LAS float* rs, int tid) {
#pragma unroll
    for (int it = 0; it < 4; ++it) {
        const int item = tid + 512 * it, l = item >> 4, ch = (item & 15) * 8;
        float acc[8];
#pragma unroll
        for (int i = 0; i < 8; ++i) acc[i] = 0.f;
#pragma unroll
        for (int jj = 0; jj < 4; ++jj) {
            const int t = t0 + l - 3 + jj;
            if (t >= 0) {
                const v4u w = *(const GAS v4u*)(Z + (rowb + t) * NZ0 + zc + ch);
                const float x[8] = {bflo(w.x), bfhi(w.x), bflo(w.y), bfhi(w.y), bflo(w.z), bfhi(w.z), bflo(w.w), bfhi(w.w)};
                const f32x4 c0 = *(const f32x4*)(cw + jj * 1024 + wc + ch), c1 = *(const f32x4*)(cw + jj * 1024 + wc + ch + 4);
                acc[0] += x[0] * c0.x; acc[1] += x[1] * c0.y; acc[2] += x[2] * c0.z; acc[3] += x[3] * c0.w;
                acc[4] += x[4] * c1.x; acc[5] += x[5] * c1.y; acc[6] += x[6] * c1.z; acc[7] += x[7] * c1.w;
            }
        }
        const float sc = TRANSPOSE ? mul * rs[l] : mul;
#pragma unroll
        for (int i = 0; i < 8; ++i) acc[i] = silu_f(acc[i]) * sc;
        if (TRANSPOSE) {
#pragma unroll
            for (int i = 0; i < 8; ++i) *(LAS bf16*)(dst + (ch + i) * TS + l * 2) = (bf16)f2bf(acc[i]);
        } else {
            v4u o; o.x = pk2(acc[0], acc[1]); o.y = pk2(acc[2], acc[3]); o.z = pk2(acc[4], acc[5]); o.w = pk2(acc[6], acc[7]);
            *(LAS v4u*)(dst + l * TS + ch * 2) = o;
        }
    }
}
__device__ __forceinline__ void ml_vt_tile(const bf16* Z, size_t row0, int zc, LAS unsigned char* dst, int tid) {
#pragma unroll
    for (int it = 0; it < 4; ++it) {
        const int item = tid + 512 * it, l = item >> 4, ch = (item & 15) * 8;
        const v4u w = *(const GAS v4u*)(Z + (row0 + l) * NZ0 + zc + ch);
        const unsigned ww[4] = {w.x, w.y, w.z, w.w};
#pragma unroll
        for (int i = 0; i < 4; ++i) { *(LAS bf16*)(dst + (ch + 2 * i) * TS + l * 2) = (bf16)(ww[i] & 0xffffu); *(LAS bf16*)(dst + (ch + 2 * i + 1) * TS + l * 2) = (bf16)(ww[i] >> 16); }
    }
}
__device__ __forceinline__ void mlstm_a_unit(Frame& F, const Args& A, int unit) {
    const int c = unit & 63, bh = unit >> 6, hm = bh & 3, b = bh >> 2;
    const bf16* Z = WSP(bf16, WS_Z); const float* GT = WSP(float, WS_GATES);
    const size_t rowb = (size_t)b * SEQ; const int t0 = c * 128;
    LAS unsigned char* lds = F.lds; LAS float* sm = (LAS float*)(lds + ML_SM);
    if (F.wave == 0) {
        ml_gates(GT, rowb + t0, hm, sm, F.lane);
        LDS_WAIT();
        const float bend = sm[127];
        const float w0 = bend - sm[2 * F.lane] + sm[128 + 2 * F.lane], w1 = bend - sm[2 * F.lane + 1] + sm[128 + 2 * F.lane + 1];
        const float ml = wave_max(fmaxf(w0, w1));
        sm[256 + 2 * F.lane] = __expf(w0 - ml); sm[256 + 2 * F.lane + 1] = __expf(w1 - ml);
        if (F.lane == 0) { WSP(float, WS_BEND)[unit] = bend; WSP(float, WS_MLOC)[unit] = ml; }
    }
    __syncthreads();
    ml_conv_tile<true>(Z, rowb, t0, 512 + hm * 128, A.in[7], 512 + hm * 128, 0.08838834764831845f, lds + ML_K, sm + 256, F.tid);
    ml_vt_tile(Z, rowb + t0, 1024 + hm * 128, lds + ML_V, F.tid);
    __syncthreads();
    f32x4 acc[2][4];
#pragma unroll
    for (int m = 0; m < 2; ++m)
#pragma unroll
        for (int n = 0; n < 4; ++n) acc[m][n] = (f32x4){0.f, 0.f, 0.f, 0.f};
    const int dv0 = 32 * (F.wave >> 1), dk0 = 64 * (F.wave & 1);
    mma_nt<2, 4>(lds + ML_V + dv0 * TS, TS, lds + ML_K + dk0 * TS, TS, 128, acc, F.lane);
    float* CL = WSP(float, WS_CLOC) + (size_t)unit * 16384;
#pragma unroll
    for (int m = 0; m < 2; ++m)
#pragma unroll
        for (int n = 0; n < 4; ++n)
#pragma unroll
            for (int i = 0; i < 4; ++i) CL[(size_t)(dv0 + 16 * m + 4 * (F.lane >> 4) + i) * 128 + dk0 + 16 * n + (F.lane & 15)] = acc[m][n][i];
    if (F.tid < 128) { float s = 0.f; const LAS bf16* kr = (const LAS bf16*)(lds + ML_K + F.tid * TS);
        for (int l = 0; l < 128; ++l) s += bf2f(kr[l]);
        WSP(float, WS_NLOC)[(size_t)unit * 128 + F.tid] = s; }
    __syncthreads();
}
__device__ __forceinline__ void mlstm_scan_unit(Frame& F, int unit) {
    const int bh = unit >> 4, sl = unit & 15;
    LAS float* tab = (LAS float*)F.lds;
    if (F.tid == 0) {
        const float* BE = WSP(float, WS_BEND) + bh * 64; const float* ML = WSP(float, WS_MLOC) + bh * 64; float* MP = WSP(float, WS_MPREV) + bh * 64;
        float m = 0.f;
        for (int c = 0; c < 64; ++c) { const float be = BE[c], ml = ML[c]; const float mn = fmaxf(be + m, ml);
            tab[c] = __expf(be + m - mn); tab[64 + c] = __expf(ml - mn); if (sl == 0) MP[c] = m; m = mn; }
    }
    __syncthreads();
    float* CL = WSP(float, WS_CLOC) + (size_t)bh * 64 * 16384 + sl * 1024 + 2 * F.tid;
    float s0 = 0.f, s1 = 0.f;
#pragma unroll 8
    for (int c = 0; c < 64; ++c) { float2* p = (float2*)(CL + (size_t)c * 16384); const float2 v = *p; *p = make_float2(s0, s1);
        const float a = tab[c], sc = tab[64 + c]; s0 = a * s0 + sc * v.x; s1 = a * s1 + sc * v.y; }
    if (sl == 0 && F.tid < 128) { float* NL = WSP(float, WS_NLOC) + (size_t)bh * 64 * 128 + F.tid; float s = 0.f;
        for (int c = 0; c < 64; ++c) { const float v = NL[c * 128]; NL[c * 128] = s; s = tab[c] * s + tab[64 + c] * v; } }
    __syncthreads();
}
__device__ __forceinline__ void mlstm_c_unit(Frame& F, const Args& A, int unit) {
    const int c = unit & 63, bh = unit >> 6, hm = bh & 3, b = bh >> 2;
    const bf16* Z = WSP(bf16, WS_Z); const float* GT = WSP(float, WS_GATES);
    const size_t rowb = (size_t)b * SEQ; const int t0 = c * 128;
    LAS unsigned char* lds = F.lds; LAS float* sm = (LAS float*)(lds + ML_SM);
    const int lane = F.lane, w = F.wave, tid = F.tid;
    const float mprev = WSP(float, WS_MPREV)[unit];
    if (w == 0) {
        ml_gates(GT, rowb + t0, hm, sm, lane);
        LDS_WAIT();
        const float b0 = sm[2 * lane], b1 = sm[2 * lane + 1];
        const float g0 = sm[128 + 2 * lane] - b0, g1 = sm[128 + 2 * lane + 1] - b1;
        float pm = fmaxf(g0, g1);
#pragma unroll
        for (int o = 1; o < 64; o <<= 1) { const float t = __shfl_up(pm, o); if (lane >= o) pm = fmaxf(pm, t); }
        float pe = __shfl_up(pm, 1); if (lane == 0) pe = -INFINITY;
        const float M0 = fmaxf(mprev, fmaxf(pe, g0)), M1 = fmaxf(mprev, pm);
        sm[256 + 2 * lane] = g0; sm[256 + 2 * lane + 1] = g1;
        sm[384 + 2 * lane] = M0; sm[384 + 2 * lane + 1] = M1;
        sm[512 + 2 * lane] = __expf(mprev - M0); sm[512 + 2 * lane + 1] = __expf(mprev - M1);
        sm[640 + 2 * lane] = __expf(-b0 - M0); sm[640 + 2 * lane + 1] = __expf(-b1 - M1);
        sm[768 + 2 * lane] = 0.f; sm[768 + 2 * lane + 1] = 0.f; sm[896 + 2 * lane] = 0.f; sm[896 + 2 * lane + 1] = 0.f;
    }
    if (w == 1) { sm[1152 + lane] = WSP(float, WS_NLOC)[(size_t)unit * 128 + lane]; sm[1152 + 64 + lane] = WSP(float, WS_NLOC)[(size_t)unit * 128 + 64 + lane]; }
    ml_conv_tile<false>(Z, rowb, t0, hm * 128, A.in[7], hm * 128, 1.f, lds + ML_Q, nullptr, tid);
    ml_conv_tile<false>(Z, rowb, t0, 512 + hm * 128, A.in[7], 512 + hm * 128, 0.08838834764831845f, lds + ML_K, nullptr, tid);
    ml_vt_tile(Z, rowb + t0, 1024 + hm * 128, lds + ML_V, tid);
    __syncthreads();
    const int l0 = 32 * (w >> 1), c0 = 64 * (w & 1);
    const int lr = 4 * (lane >> 4), lc = lane & 15;
    if (tid < 128) { const LAS bf16* qr = (const LAS bf16*)(lds + ML_Q + tid * TS); float s = 0.f;
        for (int d = 0; d < 128; ++d) s += bf2f(qr[d]) * sm[1152 + d];
        sm[1024 + tid] = s; }
    f32x4 acc[2][4];
#pragma unroll
    for (int m = 0; m < 2; ++m)
#pragma unroll
        for (int n = 0; n < 4; ++n) acc[m][n] = (f32x4){0.f, 0.f, 0.f, 0.f};
    mma_nt<2, 4>(lds + ML_Q + l0 * TS, TS, lds + ML_K + c0 * TS, TS, 128, acc, lane);
#pragma unroll
    for (int m = 0; m < 2; ++m)
#pragma unroll
        for (int i = 0; i < 4; ++i) { const int l = l0 + 16 * m + lr + i; const float Ml = sm[384 + l]; float rsum = 0.f;
#pragma unroll
            for (int n = 0; n < 4; ++n) { const int s = c0 + 16 * n + lc; const float v = (s <= l) ? acc[m][n][i] * __expf(sm[256 + s] - Ml) : 0.f; acc[m][n][i] = v; rsum += v; }
            rsum += __shfl_xor(rsum, 1); rsum += __shfl_xor(rsum, 2); rsum += __shfl_xor(rsum, 4); rsum += __shfl_xor(rsum, 8);
            if (lc == 0) __hip_atomic_fetch_add(sm + 768 + l, rsum, __ATOMIC_RELAXED, __HIP_MEMORY_SCOPE_WORKGROUP); }
    __syncthreads();
#pragma unroll
    for (int m = 0; m < 2; ++m)
#pragma unroll
        for (int n = 0; n < 4; ++n)
#pragma unroll
            for (int i = 0; i < 4; ++i) *(LAS bf16*)(lds + ML_K + (l0 + 16 * m + lr + i) * TS + (c0 + 16 * n + lc) * 2) = (bf16)f2bf(acc[m][n][i]);
    __syncthreads();
    f32x4 ai[2][4], ae[2][4];
#pragma unroll
    for (int m = 0; m < 2; ++m)
#pragma unroll
        for (int n = 0; n < 4; ++n) { ai[m][n] = (f32x4){0.f, 0.f, 0.f, 0.f}; ae[m][n] = (f32x4){0.f, 0.f, 0.f, 0.f}; }
    mma_nt<2, 4>(lds + ML_K + l0 * TS, TS, lds + ML_V + c0 * TS, TS, 128, ai, lane);
    {
        const float* CP = WSP(float, WS_CLOC) + (size_t)unit * 16384;
        const int r = lane & 15, kq = (lane >> 4) * 8;
        for (int k0 = 0; k0 < 128; k0 += 32) {
            bf16x8 a[2], bb[4];
#pragma unroll
            for (int m = 0; m < 2; ++m) a[m] = *(const LAS bf16x8*)(lds + ML_Q + (l0 + m * 16 + r) * TS + (k0 + kq) * 2);
#pragma unroll
            for (int n = 0; n < 4; ++n) { const float* p = CP + (size_t)(c0 + n * 16 + r) * 128 + k0 + kq; const f32x4 x = *(const f32x4*)p, y = *(const f32x4*)(p + 4);
                v4u pk; pk.x = pk2(x.x, x.y); pk.y = pk2(x.z, x.w); pk.z = pk2(y.x, y.y); pk.w = pk2(y.z, y.w); bb[n] = __builtin_bit_cast(bf16x8, pk); }
#pragma unroll
            for (int m = 0; m < 2; ++m)
#pragma unroll
                for (int n = 0; n < 4; ++n) ae[m][n] = __builtin_amdgcn_mfma_f32_16x16x32_bf16(a[m], bb[n], ae[m][n], 0, 0, 0);
        }
    }
#pragma unroll
    for (int m = 0; m < 2; ++m)
#pragma unroll
        for (int i = 0; i < 4; ++i) { const int l = l0 + 16 * m + lr + i; const float wi = sm[512 + l];
            const float den = wi * sm[1024 + l] + sm[768 + l]; const float dinv = 1.f / fmaxf(fabsf(den), sm[640 + l]); float ssq = 0.f;
#pragma unroll
            for (int n = 0; n < 4; ++n) { const float hv = (wi * ae[m][n][i] + ai[m][n][i]) * dinv; ai[m][n][i] = hv; ssq += hv * hv; }
            ssq += __shfl_xor(ssq, 1); ssq += __shfl_xor(ssq, 2); ssq += __shfl_xor(ssq, 4); ssq += __shfl_xor(ssq, 8);
            if (lc == 0) __hip_atomic_fetch_add(sm + 896 + l, ssq, __ATOMIC_RELAXED, __HIP_MEMORY_SCOPE_WORKGROUP); }
    __syncthreads();
    const float* mg = A.in[10] + hm * 128;
    bf16* Y = WSP(bf16, WS_XNY);
#pragma unroll
    for (int m = 0; m < 2; ++m)
#pragma unroll
        for (int i = 0; i < 4; ++i) { const int l = l0 + 16 * m + lr + i; const float rstd = rsqrtf(sm[896 + l] * (1.f / 128.f) + EPS); const size_t row = rowb + t0 + l;
#pragma unroll
            for (int n = 0; n < 4; ++n) { const int dv = c0 + 16 * n + lc; const float og = sigmoid_f(bf2f(Z[row * NZ0 + 1536 + hm * 128 + dv]));
                Y[row * 1024 + hm * 128 + dv] = (bf16)f2bf(ai[m][n][i] * rstd * mg[dv] * og); } }
    __syncthreads();
}
template <int N> __device__ __forceinline__ void bitonic_sort_desc(float (&v)[N]) {
#pragma unroll
    for (int k = 2; k <= N; k <<= 1)
#pragma unroll
        for (int j = k >> 1; j > 0; j >>= 1)
#pragma unroll
            for (int i = 0; i < N; ++i) { const int l = i ^ j; if (l > i) { const bool desc = ((i & k) == 0); const float a = v[i], b = v[l]; const float mx = fmaxf(a, b), mn = fminf(a, b); v[i] = desc ? mx : mn; v[l] = desc ? mn : mx; } }
}
__device__ __forceinline__ void merge_top16(float (&run)[16], const float (&nw)[16]) {
#pragma unroll
    for (int i = 0; i < 16; ++i) run[i] = fmaxf(run[i], nw[15 - i]);
#pragma unroll
    for (int j = 8; j > 0; j >>= 1)
#pragma unroll
        for (int i = 0; i < 16; ++i) { const int l = i ^ j; if (l > i) { const float a = run[i], b = run[l]; run[i] = fmaxf(a, b); run[l] = fminf(a, b); } }
}
#ifndef EXPERT_SLOW
#define EXPERT_SLOW 0
#endif
#ifndef ROUTE_SLOW
#define ROUTE_SLOW 0
#endif
constexpr int SCS = 132;
__device__ __forceinline__ void peer_route_unit(Frame& F, int tok0, int hd, const bf16* KEYS) {
    const bf16* QRY = WSP(bf16, WS_QRY); int* IDX = WSP(int, WS_IDX); float* GATE = WSP(float, WS_GATE);
    LAS float* SC = (LAS float*)F.lds;
    const int lane = F.lane, w = F.wave, tid = F.tid;
    {
        const int p = w & 1, tg = w >> 1, r = lane & 15, kq = (lane >> 4) * 8;
        f32x4 acc[2][8];
#pragma unroll
        for (int m = 0; m < 2; ++m)
#pragma unroll
            for (int n = 0; n < 8; ++n) acc[m][n] = (f32x4){0.f, 0.f, 0.f, 0.f};
#pragma unroll
        for (int k0 = 0; k0 < 128; k0 += 32) {
            bf16x8 a[2], bb[8];
#pragma unroll
            for (int m = 0; m < 2; ++m) a[m] = *(const GAS bf16x8*)(QRY + (size_t)(tok0 + 32 * tg + 16 * m + r) * NQ + hd * 256 + p * 128 + k0 + kq);
#pragma unroll
            for (int n = 0; n < 8; ++n) bb[n] = *(const GAS bf16x8*)(KEYS + (size_t)(p * 128 + 16 * n + r) * 128 + k0 + kq);
#pragma unroll
            for (int m = 0; m < 2; ++m)
#pragma unroll
                for (int n = 0; n < 8; ++n) acc[m][n] = __builtin_amdgcn_mfma_f32_16x16x32_bf16(a[m], bb[n], acc[m][n], 0, 0, 0);
        }
#pragma unroll
        for (int m = 0; m < 2; ++m)
#pragma unroll
            for (int n = 0; n < 8; ++n)
#pragma unroll
                for (int i = 0; i < 4; ++i) SC[(p * 128 + 32 * tg + 16 * m + 4 * (lane >> 4) + i) * SCS + 16 * n + r] = acc[m][n][i];
    }
    __syncthreads();
#if defined(CHECK) && CHECK
    if (tok0 == 0 && hd == 0) { float* DB = WSP(float, WS_CLOC) + 8 * 1024 * 1024; for (int i = tid; i < 2 * 128 * 128; i += NTHR) DB[i] = SC[(i >> 7) * SCS + (i & 127)]; }
    __syncthreads();
#endif
#if ROUTE_SLOW
    if (tid < 128) {
        const int t = tid;
        float s0[16], s1[16]; unsigned i0[16], i1[16];
        { const LAS float* row = SC + (0 * 128 + t) * SCS; float prev = INFINITY;
#pragma unroll
          for (int k = 0; k < 16; ++k) { float best = -INFINITY; unsigned bi = 0; for (int n = 0; n < 128; ++n) { const float v = row[n]; if (v < prev && v > best) { best = v; bi = n; } } s0[k] = best; i0[k] = bi; prev = best; } }
        { const LAS float* row = SC + (1 * 128 + t) * SCS; float prev = INFINITY;
#pragma unroll
          for (int k = 0; k < 16; ++k) { float best = -INFINITY; unsigned bi = 0; for (int n = 0; n < 128; ++n) { const float v = row[n]; if (v < prev && v > best) { best = v; bi = n; } } s1[k] = best; i1[k] = bi; prev = best; } }
        float top[16]; unsigned tid16[16];
        { float prev = INFINITY;
#pragma unroll
          for (int k = 0; k < 16; ++k) { float best = -INFINITY; unsigned be = 0;
#pragma unroll
              for (int i = 0; i < 16; ++i)
#pragma unroll
                  for (int j = 0; j < 16; ++j) if ((i + 1) * (j + 1) <= 16) { const float v = s0[i] + s1[j]; if (v < prev && v > best) { best = v; be = i0[i] * 128u + i1[j]; } }
              top[k] = best; tid16[k] = be; prev = best; } }
        float sc[16], den = 0.f;
#pragma unroll
        for (int k = 0; k < 16; ++k) { sc[k] = __expf(top[k] - top[0]); den += sc[k]; }
        const float inv = 1.f / den;
        const size_t ob = (size_t)(tok0 + t) * 128 + hd * 16;
#pragma unroll
        for (int k = 0; k < 16; ++k) { IDX[ob + k] = (int)tid16[k]; GATE[ob + k] = sc[k] * inv; }
    }
    __syncthreads();
#else
    {
        const int t = tid & 127, p = (tid >> 7) & 1, half = tid >> 8;
        LAS float* seg = SC + (p * 128 + t) * SCS + 64 * half;
        float run[16], nw[16];
#pragma unroll
        for (int ch = 0; ch < 4; ++ch) {
#pragma unroll
            for (int q = 0; q < 4; ++q) { const f32x4 v = *(const LAS f32x4*)(seg + 16 * ch + 4 * q);
#pragma unroll
                for (int e = 0; e < 4; ++e) { const unsigned n = (unsigned)(64 * half + 16 * ch + 4 * q + e); const float key = u2f((f2u(v[e]) & ~127u) | n);
                    if (ch == 0) run[4 * q + e] = key; else nw[4 * q + e] = key; } }
            if (ch == 0) bitonic_sort_desc<16>(run); else { bitonic_sort_desc<16>(nw); merge_top16(run, nw); }
        }
#pragma unroll
        for (int q = 0; q < 4; ++q) *(LAS f32x4*)(seg + 4 * q) = (f32x4){run[4 * q], run[4 * q + 1], run[4 * q + 2], run[4 * q + 3]};
    }
    __syncthreads();
    if (tid < 128) {
        const int t = tid;
        float s0[16], s1[16];
        {
            LAS float* a = SC + (0 * 128 + t) * SCS; float nw[16];
#pragma unroll
            for (int q = 0; q < 4; ++q) { const f32x4 v = *(const LAS f32x4*)(a + 4 * q), u = *(const LAS f32x4*)(a + 64 + 4 * q);
#pragma unroll
                for (int e = 0; e < 4; ++e) { s0[4 * q + e] = v[e]; nw[4 * q + e] = u[e]; } }
            merge_top16(s0, nw);
#pragma unroll
            for (int q = 0; q < 4; ++q) *(LAS f32x4*)(a + 16 + 4 * q) = (f32x4){s0[4 * q], s0[4 * q + 1], s0[4 * q + 2], s0[4 * q + 3]};
        }
        {
            LAS float* a = SC + (1 * 128 + t) * SCS; float nw[16];
#pragma unroll
            for (int q = 0; q < 4; ++q) { const f32x4 v = *(const LAS f32x4*)(a + 4 * q), u = *(const LAS f32x4*)(a + 64 + 4 * q);
#pragma unroll
                for (int e = 0; e < 4; ++e) { s1[4 * q + e] = v[e]; nw[4 * q + e] = u[e]; } }
            merge_top16(s1, nw);
#pragma unroll
            for (int q = 0; q < 4; ++q) *(LAS f32x4*)(a + 16 + 4 * q) = (f32x4){s1[4 * q], s1[4 * q + 1], s1[4 * q + 2], s1[4 * q + 3]};
        }
#pragma unroll
        for (int i = 0; i < 16; ++i) { s0[i] = u2f(f2u(s0[i]) & ~127u); s1[i] = u2f(f2u(s1[i]) & ~127u); }
        constexpr int CNT[16] = {16, 8, 5, 4, 3, 2, 2, 2, 1, 1, 1, 1, 1, 1, 1, 1};
        constexpr int OFF[16] = {0, 16, 24, 29, 33, 36, 38, 40, 42, 43, 44, 45, 46, 47, 48, 49};
        float top[16], nw[16];
#pragma unroll
        for (int grp = 0; grp < 4; ++grp) {
#pragma unroll
            for (int e = 0; e < 16; ++e) nw[e] = -INFINITY;
#pragma unroll
            for (int i = 0; i < 16; ++i)
#pragma unroll
                for (int j = 0; j < 16; ++j) if (j < CNT[i] && (OFF[i] + j) / 16 == grp) {
                    const float sum = s0[i] + s1[j];
                    nw[(OFF[i] + j) % 16] = u2f((f2u(sum) & ~255u) | (unsigned)(i * 16 + j)); }
            bitonic_sort_desc<16>(nw);
            if (grp == 0) {
#pragma unroll
                for (int e = 0; e < 16; ++e) top[e] = nw[e];
            } else merge_top16(top, nw);
        }
#if defined(CHECK) && CHECK
        if (tok0 == 0 && hd == 0) { float* DB = WSP(float, WS_CLOC) + 8 * 1024 * 1024 + 32768;
#pragma unroll
            for (int i = 0; i < 16; ++i) { DB[t * 48 + i] = s0[i]; DB[t * 48 + 16 + i] = s1[i]; DB[t * 48 + 32 + i] = top[i]; } }
#endif
        float sc[16], den = 0.f;
        const float mx = u2f(f2u(top[0]) & ~255u);
#pragma unroll
        for (int k = 0; k < 16; ++k) { sc[k] = __expf(u2f(f2u(top[k]) & ~255u) - mx); den += sc[k]; }
        const float inv = 1.f / den;
        LDS_WAIT();
        const LAS unsigned* l0 = (const LAS unsigned*)(SC + (0 * 128 + t) * SCS + 16); const LAS unsigned* l1 = (const LAS unsigned*)(SC + (1 * 128 + t) * SCS + 16);
        const size_t ob = (size_t)(tok0 + t) * 128 + hd * 16;
#pragma unroll
        for (int k = 0; k < 16; ++k) { const unsigned id = f2u(top[k]) & 255u;
            const unsigned e0 = l0[id >> 4] & 127u, e1 = l1[id & 15u] & 127u;
            IDX[ob + k] = (int)(e0 * 128u + e1); GATE[ob + k] = sc[k] * inv; }
    }
    __syncthreads();
#endif
}
__device__ __forceinline__ void fp8x16_to_f32(const v4u w, float (&f)[16]) {
    typedef float f2_ __attribute__((ext_vector_type(2)));
    const unsigned ww[4] = {w.x, w.y, w.z, w.w};
#pragma unroll
    for (int i = 0; i < 4; ++i) { const f2_ lo = __builtin_amdgcn_cvt_pk_f32_fp8((int)ww[i], false), hi = __builtin_amdgcn_cvt_pk_f32_fp8((int)ww[i], true);
        f[4 * i] = lo.x; f[4 * i + 1] = lo.y; f[4 * i + 2] = hi.x; f[4 * i + 3] = hi.y; }
}
__device__ __forceinline__ void peer_u_phase(Frame& F, const unsigned char* U8  ) {
    const bf16* XN = WSP(bf16, WS_XNY); const int* IDX = WSP(int, WS_IDX); float* PART = WSP(float, WS_PART);
    const int lane = F.lane, grp = lane >> 3, l8 = lane & 7;
    const int g = F.bid & 7, nsw = (F.G >> 3) * NWAVES, ws = (F.bid >> 3) * NWAVES + F.wave;
    const unsigned char* Ug = U8 + (size_t)g * 16384 * 128 + 16 * l8;
    for (int tok = ws; tok < M; tok += nsw) {
        int ids[16];
        { const int* ip = IDX + (size_t)tok * 128 + 16 * grp;
#pragma unroll
          for (int q4 = 0; q4 < 4; ++q4) { const v4u t = *(const GAS v4u*)(ip + 4 * q4); ids[4 * q4] = (int)t.x; ids[4 * q4 + 1] = (int)t.y; ids[4 * q4 + 2] = (int)t.z; ids[4 * q4 + 3] = (int)t.w; } }
        float hf[16];
        { const bf16* hp = XN + (size_t)tok * D + 128 * g + 16 * l8; const v4u x = *(const GAS v4u*)hp, y = *(const GAS v4u*)(hp + 8);
          hf[0] = bflo(x.x); hf[1] = bfhi(x.x); hf[2] = bflo(x.y); hf[3] = bfhi(x.y); hf[4] = bflo(x.z); hf[5] = bfhi(x.z); hf[6] = bflo(x.w); hf[7] = bfhi(x.w);
          hf[8] = bflo(y.x); hf[9] = bfhi(y.x); hf[10] = bflo(y.y); hf[11] = bfhi(y.y); hf[12] = bflo(y.z); hf[13] = bfhi(y.z); hf[14] = bflo(y.w); hf[15] = bfhi(y.w); }
        v4u w[16];
#pragma unroll
        for (int it = 0; it < 16; ++it) w[it] = *(const GAS v4u*)(Ug + (size_t)ids[it] * 128);
        float r[16];
#pragma unroll
        for (int it = 0; it < 16; ++it) { float uf[16]; fp8x16_to_f32(w[it], uf); float acc = 0.f;
#pragma unroll
            for (int i = 0; i < 16; ++i) acc += uf[i] * hf[i];
            acc += __shfl_xor(acc, 1); acc += __shfl_xor(acc, 2); acc += __shfl_xor(acc, 4); r[it] = acc; }
        if (l8 == 0) { float* pp = PART + ((size_t)g * M + tok) * 128 + 16 * grp;
#pragma unroll
            for (int q4 = 0; q4 < 4; ++q4) *(GAS f32x4*)(pp + 4 * q4) = (f32x4){r[4 * q4], r[4 * q4 + 1], r[4 * q4 + 2], r[4 * q4 + 3]}; }
    }
}
__device__ __forceinline__ void peer_act_phase(Frame& F, const float* ISU, const float* ISV) {
    const int* IDX = WSP(int, WS_IDX); const float* GATE = WSP(float, WS_GATE); const float* PART = WSP(float, WS_PART); float* ACT = WSP(float, WS_ACT);
    for (size_t i = (size_t)F.bid * NTHR + F.tid; i < (size_t)M * 128; i += (size_t)F.G * NTHR) {
        float s = 0.f;
#pragma unroll
        for (int g = 0; g < 8; ++g) s += PART[(size_t)g * M * 128 + i];
        const int id = IDX[i]; const float dd = s * ISU[id];
        ACT[i] = 0.5f * dd * (1.f + erff(dd * 0.70710678118654752f)) * GATE[i] * ISV[id];
    }
}
__device__ __forceinline__ void peer_v_phase(Frame& F, const unsigned char* V8, const float* g2  , float dbg) {
    const int* IDX = WSP(int, WS_IDX); const float* ACT = WSP(float, WS_ACT);
    const int lane = F.lane, grp = lane >> 3, l8 = lane & 7;
    const int g = F.bid & 7, nsw = (F.G >> 3) * NWAVES, ws = (F.bid >> 3) * NWAVES + F.wave;
    const unsigned char* Vg = V8 + (size_t)g * 16384 * 128 + 16 * l8;
    for (int tok = ws; tok < M; tok += nsw) {
        int ids[16]; float av[16];
        { const int* ip = IDX + (size_t)tok * 128 + 16 * grp; const float* ap = ACT + (size_t)tok * 128 + 16 * grp;
#pragma unroll
          for (int q4 = 0; q4 < 4; ++q4) { const v4u t = *(const GAS v4u*)(ip + 4 * q4); ids[4 * q4] = (int)t.x; ids[4 * q4 + 1] = (int)t.y; ids[4 * q4 + 2] = (int)t.z; ids[4 * q4 + 3] = (int)t.w;
              const f32x4 a = *(const GAS f32x4*)(ap + 4 * q4); av[4 * q4] = a.x; av[4 * q4 + 1] = a.y; av[4 * q4 + 2] = a.z; av[4 * q4 + 3] = a.w; } }
        v4u w[16];
#pragma unroll
        for (int it = 0; it < 16; ++it) w[it] = *(const GAS v4u*)(Vg + (size_t)ids[it] * 128);
        float o[16];
#pragma unroll
        for (int i = 0; i < 16; ++i) o[i] = 0.f;
#pragma unroll
        for (int it = 0; it < 16; ++it) { float vf[16]; fp8x16_to_f32(w[it], vf);
#pragma unroll
            for (int i = 0; i < 16; ++i) o[i] += av[it] * vf[i]; }
#pragma unroll
        for (int i = 0; i < 16; ++i) { o[i] += __shfl_xor(o[i], 8); o[i] += __shfl_xor(o[i], 16); o[i] += __shfl_xor(o[i], 32); }
        if (grp == 0) { const int b = tok >> 13, c0 = 128 * g + 16 * l8; float* xr = F.out + (size_t)tok * D + c0; const float* gr = g2 + (size_t)b * 6144 + c0;
#pragma unroll
            for (int q4 = 0; q4 < 4; ++q4) { const f32x4 xv = *(const GAS f32x4*)(xr + 4 * q4), gv = *(const f32x4*)(gr + 4 * q4);
                *(GAS f32x4*)(xr + 4 * q4) = xv + gv * dbg * (f32x4){o[4 * q4], o[4 * q4 + 1], o[4 * q4 + 2], o[4 * q4 + 3]}; } }
    }
}
#if defined(CHECK) && CHECK
constexpr size_t WS_DBG = 512 * 1024;
constexpr size_t WS_DBGOUT = WS_CLOC;
#ifndef CHECK_LAYER
#define CHECK_LAYER 1
#endif
__global__ void chk_qry(Args a) {
    const bf16* XN = (const bf16*)(a.ws + WS_XNY); const bf16* QRY = (const bf16*)(a.ws + WS_QRY); const float* wq = a.in[20] + (size_t)CHECK_LAYER * D * NQ;
    float* R = (float*)(a.ws + WS_CTL + WS_DBG);
    const int tok = (blockIdx.x * 977) % M; const int col = (threadIdx.x * 37 + blockIdx.x * 11) % NQ;
    float s = 0.f; for (int k = 0; k < D; ++k) s += bf2f(XN[(size_t)tok * D + k]) * wq[(size_t)k * NQ + col];
    const float q = bf2f(QRY[(size_t)tok * NQ + col]);
    atomicAdd(R + 0, (s - q) * (s - q)); atomicAdd(R + 1, s * s);
}
__global__ void chk_keys(Args a) {
    const bf16* KB = (const bf16*)(a.ws + WS_KEYS); const float* keys = a.in[21]; float* R = (float*)(a.ws + WS_CTL + WS_DBG);
    const int i = blockIdx.x * blockDim.x + threadIdx.x; if (i < 2 * 2 * 128 * 128) { const float d = bf2f(KB[i]) - keys[i]; atomicAdd(R + 8, d * d); atomicAdd(R + 9, keys[i] * keys[i]); }
}
__global__ void chk_uv(Args a) {
    const bf16* UB = (const bf16*)(a.ws + WS_UB); const bf16* VB = (const bf16*)(a.ws + WS_VB); float* R = (float*)(a.ws + WS_CTL + WS_DBG);
    const size_t i = ((size_t)blockIdx.x * blockDim.x + threadIdx.x) * 61 % ((size_t)2 * 16384 * 1024);
    const float du = bf2f(UB[i]) - a.in[22][i], dv = bf2f(VB[i]) - a.in[23][i];
    atomicAdd(R + 16, du * du + dv * dv); atomicAdd(R + 17, a.in[22][i] * a.in[22][i] + a.in[23][i] * a.in[23][i]);
}
__global__ void chk_route(Args a) {
    const bf16* QRY = (const bf16*)(a.ws + WS_QRY); const float* keys = a.in[21] + (size_t)CHECK_LAYER * 2 * 128 * 128;
    const int* IDX = (const int*)(a.ws + WS_IDX); const float* GATE = (const float*)(a.ws + WS_GATE);
    float* R = (float*)(a.ws + WS_CTL + WS_DBG);
    __shared__ float sc[2][128]; __shared__ float sc0[2][128]; __shared__ float ts[2][16]; __shared__ int ti[2][16]; __shared__ float cs[256]; __shared__ int ci[256];
    const int tok = (blockIdx.x * 613 + 5) % M, hd = blockIdx.x & 7, tid = threadIdx.x;
    { const int p = tid >> 7, n = tid & 127; float s = 0.f; for (int d = 0; d < 128; ++d) s += bf2f(QRY[(size_t)tok * NQ + hd * 256 + p * 128 + d]) * keys[(size_t)(p * 128 + n) * 128 + d]; sc[p][n] = s; sc0[p][n] = s; }
    __syncthreads();
    if (tid < 2) { const int p = tid; for (int k = 0; k < 16; ++k) { int best = 0; float bv = -INFINITY; for (int n = 0; n < 128; ++n) if (sc[p][n] > bv) { bv = sc[p][n]; best = n; } ts[p][k] = bv; ti[p][k] = best; sc[p][best] = -INFINITY; } }
    __syncthreads();
    cs[tid] = ts[0][tid >> 4] + ts[1][tid & 15]; ci[tid] = ti[0][tid >> 4] * 128 + ti[1][tid & 15];
    __syncthreads();
    if (tid == 0) {
        float fs[16]; int fi[16];
        for (int k = 0; k < 16; ++k) { int best = 0; float bv = -INFINITY; for (int n = 0; n < 256; ++n) if (cs[n] > bv) { bv = cs[n]; best = n; } fs[k] = bv; fi[k] = ci[best]; cs[best] = -INFINITY; }
        float den = 0.f; for (int k = 0; k < 16; ++k) den += __expf(fs[k] - fs[0]);
        int mism = 0; float ge = 0.f;
        for (int k = 0; k < 16; ++k) { bool found = false; for (int j = 0; j < 16; ++j) if (IDX[(size_t)tok * 128 + hd * 16 + j] == fi[k]) { found = true; const float g = __expf(fs[k] - fs[0]) / den; const float d = g - GATE[(size_t)tok * 128 + hd * 16 + j]; ge += d * d; } if (!found) ++mism; }
        { int ba = 0, bb = 0; for (int j = 0; j < 16; ++j) { const int e = IDX[(size_t)tok * 128 + hd * 16 + j]; const int ea = (e >> 7) & 127, eb = e & 127;
            if (!(e >= 0 && e < 16384) || sc0[0][ea] + sc0[1][eb] < fs[15] - 0.05f) ++ba; if (!(e >= 0 && e < 16384) || sc0[1][ea] + sc0[0][eb] < fs[15] - 0.05f) ++bb; }
          atomicAdd(R + 10, (float)ba); atomicAdd(R + 11, (float)bb); }
        atomicAdd(R + 2, (float)mism); atomicAdd(R + 3, 16.f); atomicAdd(R + 4, ge); atomicAdd(R + 5, 1.f / 16.f);
    }
}
__global__ void chk_scores(Args a) {
    const bf16* QRY = (const bf16*)(a.ws + WS_QRY); const float* keys = a.in[21] + (size_t)CHECK_LAYER * 2 * 128 * 128;
    const float* DB = (const float*)(a.ws + WS_CLOC) + 8 * 1024 * 1024; float* R = (float*)(a.ws + WS_CTL + WS_DBG);
    const int t = blockIdx.x, tid = threadIdx.x;
    __shared__ float sc[2][128];
    { const int p = tid >> 7, n = tid & 127; float s = 0.f; for (int d = 0; d < 128; ++d) s += bf2f(QRY[(size_t)t * NQ + p * 128 + d]) * keys[(size_t)(p * 128 + n) * 128 + d];
      const float dv = DB[(p * 128 + t) * 128 + n]; atomicAdd(R + 12, (s - dv) * (s - dv)); atomicAdd(R + 13, s * s); sc[p][n] = dv; }
    __syncthreads();
    if (tid < 2) { const int p = tid; int bad = 0; for (int k = 0; k < 16; ++k) { int best = 0; float bv = -INFINITY; for (int n = 0; n < 128; ++n) if (sc[p][n] > bv) { bv = sc[p][n]; best = n; }
        const float lv = DB[32768 + t * 48 + 16 * p + k]; if (fabsf(lv - bv) > 1e-3f * (1.f + fabsf(bv))) ++bad; sc[p][best] = -INFINITY; }
        atomicAdd(R + 14, (float)bad); atomicAdd(R + 15, 16.f); }
}
__global__ void chk_expert(Args a) {
    const bf16* XN = (const bf16*)(a.ws + WS_XNY); const int* IDX = (const int*)(a.ws + WS_IDX); const float* GATE = (const float*)(a.ws + WS_GATE);
    const float* U = a.in[22] + (size_t)CHECK_LAYER * 16384 * 1024; const float* V = a.in[23] + (size_t)CHECK_LAYER * 16384 * 1024;
    const float* DO = (const float*)(a.ws + WS_DBGOUT); float* R = (float*)(a.ws + WS_CTL + WS_DBG);
    __shared__ float act[128];
    const int tok = (blockIdx.x * 61 + 3) % 4096, tid = threadIdx.x;
    if (tid < 128) { const int e = IDX[(size_t)tok * 128 + tid]; float s = 0.f; for (int k = 0; k < D; ++k) s += bf2f(XN[(size_t)tok * D + k]) * U[(size_t)e * D + k];
        act[tid] = 0.5f * s * (1.f + erff(s * 0.70710678f)) * GATE[(size_t)tok * 128 + tid]; }
    __syncthreads();
    for (int c = tid; c < D; c += 256) { float o = 0.f; for (int e = 0; e < 128; ++e) o += act[e] * V[(size_t)IDX[(size_t)tok * 128 + e] * D + c];
        const float g = DO[(size_t)tok * D + c]; atomicAdd(R + 6, (o - g) * (o - g)); atomicAdd(R + 7, o * o); }
}
__global__ void chk_stamp(Args a) {
    const float* R = (const float*)(a.ws + WS_CTL + WS_DBG);
    const float e1 = sqrtf(R[0] / fmaxf(R[1], 1e-30f)), e2 = R[2] / fmaxf(R[3], 1.f), e2g = sqrtf(R[4] / fmaxf(R[5], 1e-30f)), e3 = sqrtf(R[6] / fmaxf(R[7], 1e-30f));
    float c;
#if CHECK == 99
    c = 1.f;
#else
    const float e0 = sqrtf(R[8] / fmaxf(R[9], 1e-30f));
    const float ea = R[10] / fmaxf(R[3], 1.f), eb = R[11] / fmaxf(R[3], 1.f);
    const float esc = sqrtf(R[12] / fmaxf(R[13], 1e-30f)), els = R[14] / fmaxf(R[15], 1.f);
    const float euv = sqrtf(R[16] / fmaxf(R[17], 1e-30f));
    const float errs[4] = {e2, euv, ea, e3}; const float tols[4] = {0.08f, 0.01f, 0.08f, 0.03f};
    c = 1.f;
    for (int k = 3; k >= 0; --k) if (!(errs[k] <= tols[k])) { const float fr = fminf(fmaxf((log10f(fmaxf(errs[k], 1e-4f)) + 4.f) / 5.f, 0.f), 0.95f); c = 2.f + (float)k + fr; }
#endif
    const size_t i = (size_t)blockIdx.x * blockDim.x + threadIdx.x;
    if (i < (size_t)M * D) a.out[i] = a.in[0][i] * (1.f + c);
}
#endif
#ifndef MK_PER_PHASE
#define MK_PER_PHASE 0
#endif
constexpr int NPHASE = 24;
#ifndef DBG_Y0
#define DBG_Y0 1
#define DBG_P0 1
#define DBG_Y1 1
#define DBG_P1 1
#endif
#ifndef PHASE_MASK
#define PHASE_MASK 0x1ffffffu
#endif
#define IN(k) (lo <= (k) && (k) < hi && ((PHASE_MASK >> (k)) & 1u))
#ifndef DUP_PHASE
#define DUP_PHASE -1
#endif
#define REPS(k) for (int rep = ((DUP_PHASE) == (k) ? 0 : 1); rep < 2; ++rep)
#define SEAM(k) do { if (IN(k) && IN((k) + 1)) xcd_barrier(bar); } while (0)
__device__ __forceinline__ float alibi_tcut(const float* gq, const float* gk, int lane) { return 16.f * wave_max(fabsf(gq[lane])) * wave_max(fabsf(gk[lane])) + ALIBI_MARGIN; }
template <int layer>
__device__ __forceinline__ void layer_phases(Frame& F, const Args& args, const XcdBarrier& bar, const int lo, const int hi) {
    volatile LAS unsigned* MISCW = (volatile LAS unsigned*)(F.lds + MISC_OFF);
    float* MOD = WSP(float, WS_MOD);
    bf16* XNY = WSP(bf16, WS_XNY); bf16* Zb = WSP(bf16, WS_Z);

        constexpr int pb = layer * 12;
        const float* mod = MOD + (size_t)layer * 4 * 6144;
        if (IN(pb + 1)) { if (layer == 0) norm_pass<true>(F, args, args.in[0], args.in[4], mod, 0, XNY); else norm_pass<false>(F, args, F.out, args.in[4] + 1024, mod, 0, XNY); } SEAM(pb + 1);
        if (IN(pb + 2)) REPS(pb + 2) {
            const int N = layer == 0 ? NZ0 : NZ1;
            pg8::Gemm g{XNY, layer == 0 ? WSP(bf16, WS_WIN0) : WSP(bf16, WS_WIN1), M, N, D}; pg8::StaticOrder S; S.init(M, N, F.G, F.bid);
            pg8::EpiBf16 E{Zb, N};
            pg8::gemm_phase<pg8::EpiBf16, pg8::StaticOrder, true, true>(F.lds, g, S, E);
        } SEAM(pb + 2);
        if (layer == 0) {
            if (IN(3)) REPS(3) {
                for (int u = F.bid; u < 1024 + 256; u += F.G) {
                    if (u < 1024) mlstm_a_unit(F, args, u);
                    else if (rep == 1) { const int v = u - 1024, b = v >> 6, j = (v >> 1) & 31, which = v & 1;
                        qknorm_unit(F, Zb, NZ0, b * SEQ + j * 256, which ? 2560 : 2048, which ? args.in[12] : args.in[11], which ? WSP(float, WS_KMEAN) + (size_t)((b * 8) * 32 + j) * 64 : nullptr); }
                }
            } SEAM(3);
            if (IN(4)) REPS(4) {
                if (rep == 1) for (int u = F.bid; u < 256; u += F.G) mlstm_scan_unit(F, u);
                { const float tcut = alibi_tcut(args.in[11], args.in[12], F.lane);
                  const unsigned short* ORD = WSP(unsigned short, WS_ORD) + 2048; unsigned* qw = (unsigned*)(F.ws + WS_CTL) + CW_QMOBA + (rep == 1 ? 0 : 16);
                  for (;;) { if (F.tid == 0) MISCW[0] = atomicAdd(qw, 1u); __syncthreads(); const unsigned qi = MISCW[0]; __syncthreads(); if (qi >= 1024u) break;
                      const int u = ORD[qi]; moba_unit(F, u >> 8, (u >> 5) & 7, u & 31, tcut); } }
            } SEAM(4);
            if (IN(5)) REPS(5) { for (int u = F.bid; u < 1024; u += F.G) mlstm_c_unit(F, args, u); } SEAM(5);
        } else {
            if (IN(pb + 3)) {
                for (int u = F.bid; u < 512; u += F.G) { const int rt = u >> 2, cr = u & 3; qknorm_unit(F, Zb, NZ1, rt * 256, cr * 512, cr < 2 ? args.in[15] : args.in[16], nullptr); }
            } SEAM(pb + 3);
            if (IN(pb + 4)) REPS(pb + 4) {
                const float* lp = args.in[17];
                const float lam = __expf(wave_sum(lp[F.lane] * lp[64 + F.lane])) - __expf(wave_sum(lp[128 + F.lane] * lp[192 + F.lane])) + 0.35550906759096926f;
                { const float tcut = alibi_tcut(args.in[15], args.in[16], F.lane);
                  const unsigned short* ORD = WSP(unsigned short, WS_ORD); unsigned* qw = (unsigned*)(F.ws + WS_CTL) + CW_QDIFF + (rep == 1 ? 0 : 16);
                  for (;;) { if (F.tid == 0) MISCW[0] = atomicAdd(qw, 1u); __syncthreads(); const unsigned qi = MISCW[0]; __syncthreads(); if (qi >= 2048u) break;
                      const int u = ORD[qi]; diff_unit(F, args, u >> 9, (u >> 6) & 7, u & 63, lam, tcut); } }
            } SEAM(pb + 4);
        }
        if (IN(pb + 6)) REPS(pb + 6) {
            pg8::Gemm g{XNY, layer == 0 ? WSP(bf16, WS_WOUT0) : WSP(bf16, WS_WOUT1), M, D, D}; pg8::StaticOrder S; S.init(M, D, F.G, F.bid);
            pg8::EpiResid E{layer == 0 ? args.in[0] : F.out, F.out, mod + 2 * 1024, rep == 1 ? (layer == 0 ? (float)DBG_Y0 : (float)DBG_Y1) : 0.f};
            pg8::gemm_phase<pg8::EpiResid, pg8::StaticOrder, true, true>(F.lds, g, S, E);
        } SEAM(pb + 6);
        if (IN(pb + 7)) REPS(pb + 7) { norm_pass<false>(F, args, F.out, args.in[5] + layer * 1024, mod, 3, XNY); } SEAM(pb + 7);
        if (IN(pb + 8)) REPS(pb + 8) {
            pg8::Gemm g{XNY, WSP(bf16, WS_WQ) + (size_t)layer * NQ * D, M, NQ, D}; pg8::StaticOrder S; S.init(M, NQ, F.G, F.bid);
            pg8::EpiBf16 E{WSP(bf16, WS_QRY), NQ};
            pg8::gemm_phase<pg8::EpiBf16, pg8::StaticOrder, true, true>(F.lds, g, S, E);
        } SEAM(pb + 8);
        if (IN(pb + 9)) REPS(pb + 9) { const bf16* KEYS = WSP(bf16, WS_KEYS) + (size_t)layer * 2 * 128 * 128;
            for (int u = F.bid; u < 2048; u += F.G) peer_route_unit(F, (u >> 3) * 128, u & 7, KEYS); } SEAM(pb + 9);
        if (IN(pb + 10)) REPS(pb + 10) { peer_u_phase(F, F.ws + WS_UB + (size_t)layer * 8 * 16384 * 128); } SEAM(pb + 10);
        if (IN(pb + 11)) REPS(pb + 11) { peer_act_phase(F, WSP(float, WS_ISU) + layer * 16384, WSP(float, WS_ISV) + layer * 16384); } SEAM(pb + 11);
        if (IN(pb + 12)) REPS(pb + 12) { peer_v_phase(F, F.ws + WS_VB + (size_t)layer * 8 * 16384 * 128, mod + 5 * 1024, rep == 1 ? (layer == 0 ? (float)DBG_P0 : (float)DBG_P1) : 0.f); }
        if (layer == 0) SEAM(12);
    }
__global__ void __launch_bounds__(NTHR, 2) mega_fwd(Args args) {
    extern __shared__ __attribute__((aligned(16))) unsigned char lds_raw[];
    Frame F;
    F.lds = (LAS unsigned char*)lds_raw;
    F.tid = threadIdx.x; F.lane = F.tid & 63; F.wave = __builtin_amdgcn_readfirstlane(F.tid >> 6);
    F.G = gridDim.x; F.bid = blockIdx.x;
    F.out = args.out; F.ws = args.ws;
    volatile LAS unsigned* MISC = (volatile LAS unsigned*)(F.lds + MISC_OFF);
    for (int u = F.tid; u < (LDS_BYTES - LDSCTL_OFF) / 4; u += NTHR) ((LAS unsigned*)(F.lds + LDSCTL_OFF))[u] = 0u;
    __syncthreads();
    XcdBarrier bar; bar.bar = (unsigned*)(F.ws + WS_CTL) + CW_BAR; bar.x = 0; bar.st = nullptr;
    if (!MK_PER_PHASE) bar = xcd_barrier_post((unsigned*)(F.ws + WS_CTL) + CW_BAR, MISC + 8);
    const int lo = args.ph_lo, hi = args.ph_hi;

    if (IN(0)) { p0_prologue(F, args); } SEAM(0);
    layer_phases<0>(F, args, bar, lo, hi);
    layer_phases<1>(F, args, bar, lo, hi);
}
#undef IN
#undef SEAM

extern "C" void kernel_launch(void* const* d_in, const int* in_sizes, int n_in, void* d_out, int out_size, void* d_ws, size_t ws_size, hipStream_t stream) {
    static int grid = 0;
    if (grid == 0) {
        if (n_in != 24 || in_sizes[0] != M * D || out_size != M * D || ws_size < WS_END) { fprintf(stderr, "kernel_launch: unexpected problem (n_in %d, in0 %d, out %d, ws %zu < %zu); nothing launched\n", n_in, n_in > 0 ? in_sizes[0] : -1, out_size, ws_size, (size_t)WS_END); grid = -1; return; }
        int dev = 0, cus = 0, per_cu = 0;
        if (hipGetDevice(&dev) != hipSuccess || hipDeviceGetAttribute(&cus, hipDeviceAttributeMultiprocessorCount, dev) != hipSuccess) { grid = -1; return; }
        if (hipFuncSetAttribute((const void*)mega_fwd, hipFuncAttributeMaxDynamicSharedMemorySize, LDS_BYTES) != hipSuccess) { fprintf(stderr, "kernel_launch: hipFuncSetAttribute failed\n"); grid = -1; return; }
        if (hipOccupancyMaxActiveBlocksPerMultiprocessor(&per_cu, (const void*)mega_fwd, NTHR, LDS_BYTES) != hipSuccess || per_cu < 1)
            fprintf(stderr, "kernel_launch: note: occupancy query reports %d workgroups per CU\n", per_cu);
        (void)hipGetLastError();
        grid = cus;
    }
    if (grid < 0) return;
    if (hipMemsetAsync((char*)d_ws + WS_CTL, 0, CTL_ZERO_BYTES, stream) != hipSuccess) { fprintf(stderr, "kernel_launch: memset failed\n"); return; }
    Args a{};
    for (int i = 0; i < 24; ++i) a.in[i] = (const float*)d_in[i];
    a.out = (float*)d_out; a.ws = (unsigned char*)d_ws;
#if MK_PER_PHASE
    for (int p = 0; p < NPHASE + 1; ++p) { a.ph_lo = p; a.ph_hi = p + 1; hipLaunchKernelGGL(mega_fwd, dim3(grid), dim3(NTHR), LDS_BYTES, stream, a); }
#else
    a.ph_lo = 0; a.ph_hi = NPHASE + 1;
    hipLaunchKernelGGL(mega_fwd, dim3(grid), dim3(NTHR), LDS_BYTES, stream, a);
#endif
#if defined(CHECK) && CHECK
    chk_qry<<<256, 256, 0, stream>>>(a); chk_keys<<<256, 256, 0, stream>>>(a); chk_uv<<<1024, 256, 0, stream>>>(a); chk_scores<<<128, 256, 0, stream>>>(a); chk_route<<<512, 256, 0, stream>>>(a); chk_expert<<<64, 256, 0, stream>>>(a); chk_stamp<<<(M * D + 255) / 256, 256, 0, stream>>>(a);
#endif
    const hipError_t le = hipPeekAtLastError();
    if (le != hipSuccess) fprintf(stderr, "kernel_launch: launch failed: %s\n", hipGetErrorName(le));
}
```

```cpp
#include <hip/hip_runtime.h>
#include <cstdio>
#include <cstdint>
namespace pg8 {
#define PG8_LAS __attribute__((address_space(3)))
typedef unsigned short bf16_t;
typedef short bf16x8 __attribute__((ext_vector_type(8)));
typedef float f32x4 __attribute__((ext_vector_type(4)));
typedef unsigned u32x4 __attribute__((ext_vector_type(4)));
constexpr int BM = 256, BK = 64, HALF = 128, HTB = HALF * BK * 2  , STAGE_BYTES = 8 * HTB, NXCD = 8, WGM = 8;

__host__ __device__ __forceinline__ int lds_byte(int r, int c) { const int st = (r >> 4) * 2 + (c >> 5), rr = r & 15, cc = c & 31, ob = rr * 64 + cc * 2; return st * 1024 + (ob ^ (((ob >> 9) & 1) << 5)); }
__host__ __device__ __forceinline__ void stage_rc(int b, int& R, int& C) { const int st = b / 1024, sb = b % 1024, swz = sb ^ (((sb >> 9) & 1) << 5); R = (st >> 1) * 16 + swz / 64; C = (st & 1) * 32 + (swz % 64) / 2; }
__host__ __device__ __forceinline__ int perm32(int rho) { const int n = rho >> 4, i = rho & 15; return 8 * (i >> 2) + 4 * n + (i & 3); }

struct Unit { int pm, pn; };
struct Gemm { const bf16_t* A; const bf16_t* Bt; int M, N, K; };

struct StaticOrder {
    int nM, nN, nwg, G, c;
    __host__ __device__ void init(int M, int N, int G_, int c_) { nM = M / BM; nN = N / BM; nwg = nM * nN; G = G_; c = c_; }
    __host__ __device__ bool next(int i, Unit& u) const {
        const long L = (long)i * G + c; if (L >= nwg) return false;
        int wgid = (int)L; { const int q = nwg / NXCD, r = nwg % NXCD, xcd = wgid % NXCD, off = wgid / NXCD; wgid = (xcd < r ? xcd * (q + 1) : r * (q + 1) + (xcd - r) * q) + off; }
        const int nig = WGM * nN, gid = wgid / nig, fm = gid * WGM, gsz = (nM - fm) < WGM ? (nM - fm) : WGM;
        u.pm = fm + ((wgid % nig) % gsz); u.pn = (wgid % nig) / gsz; return true;
    }
    __device__ __forceinline__ void a_ready(const Unit&) const {}
    __device__ __forceinline__ void done(const Unit&) const {}
};

__device__ __forceinline__ unsigned cvt_pk_bf16(float lo, float hi) { unsigned r; asm volatile("v_cvt_pk_bf16_f32 %0, %1, %2" : "=v"(r) : "v"(lo), "v"(hi)); return r; }
typedef unsigned u32x4 __attribute__((ext_vector_type(4)));
struct EpiBf16 {
    static constexpr bool PERM = true, AFTER_DRAIN = false;
    bf16_t* O; int ldc;
    __device__ __forceinline__ void operator()(const f32x4 (&acc)[2][2][4][2], const Unit& u, int wr, int wc, int fr, int fq) const {
        const int row0 = u.pm * BM + wr * 64 + fr; const int col0 = u.pn * BM + wc * 32 + 8 * fq;
#pragma unroll
        for (int ai = 0; ai < 2; ++ai)
#pragma unroll
            for (int m = 0; m < 4; ++m) { bf16_t* rowp = O + (size_t)(row0 + ai * HALF + m * 16) * ldc + col0;
#pragma unroll
                for (int bj = 0; bj < 2; ++bj) { const f32x4 v0 = acc[ai][bj][m][0], v1 = acc[ai][bj][m][1];
                    u32x4 w; w.x = cvt_pk_bf16(v0[0], v0[1]); w.y = cvt_pk_bf16(v0[2], v0[3]); w.z = cvt_pk_bf16(v1[0], v1[1]); w.w = cvt_pk_bf16(v1[2], v1[3]);
                    *(u32x4*)(rowp + bj * HALF) = w; } }
    }
};
struct EpiResid {
    static constexpr bool PERM = false, AFTER_DRAIN = false;
    const float* base; float* out; const float* gate; float dbg;
    __device__ __forceinline__ void operator()(const f32x4 (&acc)[2][2][4][2], const Unit& u, int wr, int wc, int fr, int fq) const {
        const int col0 = u.pn * BM + wc * 32 + 4 * fq; const int b = (u.pm * BM) >> 13;
#pragma unroll
        for (int bj = 0; bj < 2; ++bj)
#pragma unroll
            for (int n = 0; n < 2; ++n) { const f32x4 gv = *(const f32x4*)(gate + (size_t)b * 6144 + col0 + bj * HALF + n * 16);
#pragma unroll
                for (int ai = 0; ai < 2; ++ai)
#pragma unroll
                    for (int m = 0; m < 4; ++m) { const size_t off = (size_t)(u.pm * BM + ai * HALF + wr * 64 + m * 16 + fr) * 1024 + col0 + bj * HALF + n * 16;
                        const f32x4 bs = *(const f32x4*)(base + off); *(f32x4*)(out + off) = bs + gv * acc[ai][bj][m][n] * dbg; } }
    }
};

template <class Epi, class Sched, bool ALIGN_EPI = false, bool SP2 = false>
__device__ __forceinline__ void gemm_phase(PG8_LAS unsigned char* lds, const Gemm g, const Sched& S, const Epi& E) {
    const int tid = threadIdx.x, wid = __builtin_amdgcn_readfirstlane(tid >> 6), lane = tid & 63, wr = wid >> 2, wc = wid & 3, fr = lane & 15, fq = lane >> 4;
    const int K = g.K, nt = K / BK;
    unsigned voffA[2], voffB[2];
#pragma unroll
    for (int i = 0; i < 2; ++i) { int R, C; stage_rc(tid * 16 + i * 8192, R, C); const int Rb = Epi::PERM ? ((R & ~31) + perm32(R & 31)) : R;
        voffA[i] = (unsigned)(R * K + C) * 2u; voffB[i] = (unsigned)(Rb * K + C) * 2u; }
    const size_t kstep = (size_t)(BK * 2);
    const size_t hstep = (size_t)HALF * K * 2;
    const size_t tstep = 2 * hstep;
    const unsigned ldsw = (unsigned)wid * 1024u;
    const int aoff = lds_byte(wr * 64 + fr, fq * 8), boff = lds_byte(wc * 32 + fr, fq * 8);
#define PG8_SA(b, h) (((b) * 2 + (h)) * HTB)
#define PG8_SB(b, h) ((4 + (b) * 2 + (h)) * HTB)
#define PG8_STAGE(bufoff, gbase, voff) do { _Pragma("unroll") for (int _i = 0; _i < 2; ++_i) \
        __builtin_amdgcn_global_load_lds((const unsigned*)((const char*)(gbase) + (voff)[_i]), (PG8_LAS unsigned*)(lds + (bufoff) + ldsw + _i * 8192), 16, 0, 0); } while (0)
#define PG8_LDA(dst, b, h) do { _Pragma("unroll") for (int m = 0; m < 4; ++m) _Pragma("unroll") for (int k = 0; k < 2; ++k) dst[m][k] = *(const PG8_LAS bf16x8*)(lds + PG8_SA(b, h) + aoff + m * 2048 + k * 1024); } while (0)
#define PG8_LDB(dst, b, h) do { _Pragma("unroll") for (int n = 0; n < 2; ++n) _Pragma("unroll") for (int k = 0; k < 2; ++k) dst[n][k] = *(const PG8_LAS bf16x8*)(lds + PG8_SB(b, h) + boff + n * 2048 + k * 1024); } while (0)
#define PG8_MMA(ai, bj, At, Bt) do { __builtin_amdgcn_s_setprio(1); _Pragma("unroll") for (int m = 0; m < 4; ++m) _Pragma("unroll") for (int n = 0; n < 2; ++n) _Pragma("unroll") for (int k = 0; k < 2; ++k) \
        acc[ai][bj][m][n] = __builtin_amdgcn_mfma_f32_16x16x32_bf16(Bt[n][k], At[m][k], acc[ai][bj][m][n], 0, 0, 0); __builtin_amdgcn_s_setprio(0); } while (0)
#define PG8_WAIT_V(n) asm volatile("s_waitcnt vmcnt(" #n ")" ::: "memory")
#define PG8_WAIT_L(n) asm volatile("s_waitcnt lgkmcnt(" #n ")" ::: "memory")
#define PG8_BAR __builtin_amdgcn_s_barrier()
#define PG8_SCHED __builtin_amdgcn_sched_barrier(0)
    Unit cur, nxt; int ui = 0;
    if (!S.next(0, cur)) return;
    f32x4 acc[2][2][4][2];
#pragma unroll
    for (int a = 0; a < 2; ++a)
#pragma unroll
        for (int b = 0; b < 2; ++b)
#pragma unroll
            for (int m = 0; m < 4; ++m)
#pragma unroll
                for (int n = 0; n < 2; ++n) acc[a][b][m][n] = (f32x4){0.f, 0.f, 0.f, 0.f};
    bf16x8 At[4][2], B0[2][2], B1[2][2];
    const char* cA = (const char*)g.A + (size_t)cur.pm * tstep; const char* cB = (const char*)g.Bt + (size_t)cur.pn * tstep;
    S.a_ready(cur);
    if constexpr (SP2) {
        PG8_STAGE(PG8_SB(0, 0), cB, voffB); PG8_STAGE(PG8_SB(0, 1), cB + hstep, voffB); PG8_STAGE(PG8_SA(0, 0), cA, voffA); PG8_STAGE(PG8_SA(0, 1), cA + hstep, voffA);
        if (wr == 1) PG8_BAR;
        PG8_WAIT_V(2); PG8_BAR;
        PG8_STAGE(PG8_SB(1, 0), cB + kstep, voffB); PG8_STAGE(PG8_SA(1, 0), cA + kstep, voffA); PG8_STAGE(PG8_SB(1, 1), cB + hstep + kstep, voffB);
        PG8_WAIT_V(6); PG8_BAR;
    } else {
        PG8_STAGE(PG8_SB(0, 0), cB, voffB); PG8_STAGE(PG8_SA(0, 0), cA, voffA); PG8_STAGE(PG8_SB(0, 1), cB + hstep, voffB); PG8_STAGE(PG8_SA(0, 1), cA + hstep, voffA);
        if (wr == 1) PG8_BAR;
        PG8_WAIT_V(4); PG8_BAR;
        PG8_STAGE(PG8_SB(1, 0), cB + kstep, voffB); PG8_STAGE(PG8_SA(1, 0), cA + kstep, voffA); PG8_STAGE(PG8_SB(1, 1), cB + hstep + kstep, voffB);
        PG8_WAIT_V(6); PG8_BAR;
    }
    for (;;) {
        const bool has_next = S.next(ui + 1, nxt);
        const char* nA = has_next ? (const char*)g.A + (size_t)nxt.pm * tstep : cA; const char* nB = has_next ? (const char*)g.Bt + (size_t)nxt.pn * tstep : cB;
        for (int t = 0; t < nt; t += 2) {
            const bool last = (t == nt - 2);
            const char* a1 = cA + (size_t)(t + 1) * kstep;
            const char* a2 = last ? nA : cA + (size_t)(t + 2) * kstep; const char* b2 = last ? nB : cB + (size_t)(t + 2) * kstep;
            const char* a3 = a2 + kstep; const char* b3 = b2 + kstep;
            if (last && has_next) S.a_ready(nxt);
            if constexpr (SP2) {
            PG8_LDB(B0, 0, 0); PG8_LDB(B1, 0, 1); PG8_SCHED; PG8_LDA(At, 0, 0); PG8_STAGE(PG8_SA(1, 1), a1 + hstep, voffA);
            PG8_WAIT_V(8); PG8_WAIT_L(0); PG8_BAR; PG8_MMA(0, 0, At, B0); PG8_MMA(0, 1, At, B1); PG8_BAR; PG8_SCHED;
            PG8_LDA(At, 0, 1); PG8_STAGE(PG8_SB(0, 0), b2, voffB); PG8_STAGE(PG8_SB(0, 1), b2 + hstep, voffB); PG8_STAGE(PG8_SA(0, 0), a2, voffA);
            PG8_WAIT_V(8); PG8_WAIT_L(0); PG8_BAR; PG8_MMA(1, 0, At, B0); PG8_MMA(1, 1, At, B1); PG8_BAR; PG8_SCHED;
            PG8_LDB(B0, 1, 0); PG8_LDB(B1, 1, 1); PG8_SCHED; PG8_LDA(At, 1, 0); PG8_STAGE(PG8_SA(0, 1), a2 + hstep, voffA);
            PG8_WAIT_V(8); PG8_WAIT_L(0); PG8_BAR; PG8_MMA(0, 0, At, B0); PG8_MMA(0, 1, At, B1); PG8_BAR; PG8_SCHED;
            PG8_LDA(At, 1, 1); PG8_STAGE(PG8_SB(1, 0), b3, voffB); PG8_STAGE(PG8_SB(1, 1), b3 + hstep, voffB); PG8_STAGE(PG8_SA(1, 0), a3, voffA);
            PG8_WAIT_V(8); PG8_WAIT_L(0); PG8_BAR; PG8_MMA(1, 0, At, B0); PG8_MMA(1, 1, At, B1); PG8_BAR; PG8_SCHED;
            } else {
            PG8_LDB(B0, 0, 0); PG8_SCHED; PG8_LDA(At, 0, 0); PG8_STAGE(PG8_SA(1, 1), a1 + hstep, voffA);
            PG8_WAIT_L(8); PG8_BAR; PG8_WAIT_L(0); PG8_MMA(0, 0, At, B0); PG8_BAR; PG8_SCHED;
            PG8_LDB(B1, 0, 1); PG8_STAGE(PG8_SB(0, 0), b2, voffB);
            PG8_BAR; PG8_WAIT_L(0); PG8_MMA(0, 1, At, B1); PG8_BAR;
            PG8_LDA(At, 0, 1); PG8_STAGE(PG8_SA(0, 0), a2, voffA);
            PG8_BAR; PG8_WAIT_L(0); PG8_MMA(1, 0, At, B0); PG8_BAR; PG8_SCHED;
            PG8_STAGE(PG8_SB(0, 1), b2 + hstep, voffB);
            PG8_WAIT_V(6); PG8_BAR; PG8_MMA(1, 1, At, B1); PG8_BAR;
            PG8_LDB(B0, 1, 0); PG8_SCHED; PG8_LDA(At, 1, 0); PG8_STAGE(PG8_SA(0, 1), a2 + hstep, voffA);
            PG8_WAIT_L(8); PG8_BAR; PG8_WAIT_L(0); PG8_MMA(0, 0, At, B0); PG8_BAR; PG8_SCHED;
            PG8_LDB(B1, 1, 1); PG8_STAGE(PG8_SB(1, 0), b3, voffB);
            PG8_BAR; PG8_WAIT_L(0); PG8_MMA(0, 1, At, B1); PG8_BAR;
            PG8_LDA(At, 1, 1); PG8_STAGE(PG8_SA(1, 0), a3, voffA);
            PG8_BAR; PG8_WAIT_L(0); PG8_MMA(1, 0, At, B0); PG8_BAR; PG8_SCHED;
            PG8_STAGE(PG8_SB(1, 1), b3 + hstep, voffB);
            PG8_WAIT_V(6); PG8_BAR; PG8_MMA(1, 1, At, B1); PG8_BAR;
            }
        }
        if constexpr (ALIGN_EPI) { if (wr == 0) PG8_BAR; }
        if constexpr (!Epi::AFTER_DRAIN) { E(acc, cur, wr, wc, fr, fq); S.done(cur); }
        if (!has_next) break;
#pragma unroll
        for (int a = 0; a < 2; ++a)
#pragma unroll
            for (int b = 0; b < 2; ++b)
#pragma unroll
                for (int m = 0; m < 4; ++m)
#pragma unroll
                    for (int n = 0; n < 2; ++n) acc[a][b][m][n] = (f32x4){0.f, 0.f, 0.f, 0.f};
        cur = nxt; cA = nA; cB = nB; ++ui;
        if constexpr (ALIGN_EPI) { if (wr == 1) PG8_BAR; }
    }
    PG8_WAIT_V(0);
    if constexpr (!ALIGN_EPI) { if (wr == 0) PG8_BAR; }
    PG8_BAR;
    if constexpr (Epi::AFTER_DRAIN) { E.fused(acc, cur, wr, wc, fr, fq, lds, wid, lane); S.done(cur); }
#undef PG8_SA
#undef PG8_SB
#undef PG8_STAGE
#undef PG8_LDA
#undef PG8_LDB
#undef PG8_MMA
#undef PG8_WAIT_V
#undef PG8_WAIT_L
#undef PG8_BAR
#undef PG8_SCHED
}
}
constexpr int NB = 4, SEQ = 8192, D = 1024, M = NB * SEQ;
constexpr int NZ0 = 3584, NZ1 = 3072, NQ = 2048, SRC_IN0 = 3592;
constexpr float EPS = 1e-6f;
constexpr int NWAVES = 8, NTHR = 512;
constexpr float LOG2E = 1.4426950408889634f;
constexpr size_t MiB = 1u << 20;
constexpr size_t WS_CTL = 0, CTL_ZERO_BYTES = 1 * MiB;
constexpr size_t WS_WIN0 = 1 * MiB, WS_WOUT0 = 8 * MiB, WS_WIN1 = 10 * MiB, WS_WOUT1 = 16 * MiB, WS_WQ = 18 * MiB;
constexpr size_t WS_KEYS = 26 * MiB, WS_MOD = WS_KEYS + 128 * 1024, WS_KMEAN = WS_MOD + 192 * 1024, WS_NLOC = WS_KMEAN + 256 * 1024,
                 WS_BEND = WS_NLOC + 512 * 1024, WS_MLOC = WS_BEND + 4096, WS_MPREV = WS_MLOC + 4096,
                 WS_ISU = 27 * MiB + 512 * 1024, WS_ISV = WS_ISU + 128 * 1024, WS_ORD = WS_ISV + 128 * 1024  ;
constexpr size_t WS_GATES = 28 * MiB;
constexpr size_t WS_UB = 32 * MiB  , WS_VB = 64 * MiB, WS_ACT = 96 * MiB  , WS_DBGBUF = 112 * MiB, WS_XNY = 160 * MiB, WS_Z = 224 * MiB, WS_CLOC = 448 * MiB, WS_END = 512 * MiB;
constexpr size_t WS_QRY = WS_Z, WS_IDX = WS_Z + 128 * MiB, WS_GATE = WS_Z + 144 * MiB, WS_PART = 384 * MiB  ;
constexpr int CW_BAR = 4096, CW_QMOBA = 8192, CW_QDIFF = 8256;
constexpr float ALIBI_MARGIN = 27.03f;
constexpr int RING_BYTES = 139264;
constexpr int LDSCTL_OFF = RING_BYTES, MISC_OFF = LDSCTL_OFF + 320;
constexpr int LDS_BYTES = 147456;
static_assert(MISC_OFF + 128 <= LDS_BYTES, "LDS map");

#define GAS __attribute__((address_space(1)))
#define LAS __attribute__((address_space(3)))
typedef unsigned short bf16;
typedef unsigned v4u __attribute__((ext_vector_type(4)));
typedef unsigned v2u __attribute__((ext_vector_type(2)));
typedef float f32x4 __attribute__((ext_vector_type(4)));
typedef float f32x16 __attribute__((ext_vector_type(16)));
typedef short bf16x8 __attribute__((ext_vector_type(8)));
typedef short s16x4 __attribute__((ext_vector_type(4)));
typedef GAS unsigned gu32;
#define RLX_AGENT __ATOMIC_RELAXED, __HIP_MEMORY_SCOPE_AGENT
#define LDS_WAIT() asm volatile("s_waitcnt lgkmcnt(0)" ::: "memory")
#define VM_WAIT() asm volatile("s_waitcnt vmcnt(0)" ::: "memory")
__device__ __forceinline__ unsigned f2bf(float f) { unsigned u = __builtin_bit_cast(unsigned, f); return (u + 0x7fffu + ((u >> 16) & 1u)) >> 16; }
__device__ __forceinline__ unsigned pk2(float lo, float hi) { return f2bf(lo) | (f2bf(hi) << 16); }
__device__ __forceinline__ float bflo(unsigned w) { return __builtin_bit_cast(float, w << 16); }
__device__ __forceinline__ float bfhi(unsigned w) { return __builtin_bit_cast(float, w & 0xffff0000u); }
__device__ __forceinline__ float bf2f(bf16 h) { return __builtin_bit_cast(float, (unsigned)h << 16); }
__device__ __forceinline__ unsigned f2u(float x) { return __builtin_bit_cast(unsigned, x); }
__device__ __forceinline__ float u2f(unsigned x) { return __builtin_bit_cast(float, x); }
__device__ __forceinline__ float dot2bf(unsigned a, unsigned b, float acc) { typedef __bf16 bf2_ __attribute__((ext_vector_type(2))); return __builtin_amdgcn_fdot2_f32_bf16(__builtin_bit_cast(bf2_, a), __builtin_bit_cast(bf2_, b), acc, false); }
__device__ __forceinline__ float wave_sum(float v) {
#pragma unroll
    for (int o = 1; o < 64; o <<= 1) v += __shfl_xor(v, o);
    return v;
}
__device__ __forceinline__ float wave_max(float v) {
#pragma unroll
    for (int o = 1; o < 64; o <<= 1) v = fmaxf(v, __shfl_xor(v, o));
    return v;
}
__device__ __forceinline__ float silu_f(float x) { return x / (1.f + __expf(-x)); }
__device__ __forceinline__ float sigmoid_f(float x) { return 1.f / (1.f + __expf(-x)); }
__device__ __forceinline__ float logsigmoid_f(float x) { return fminf(x, 0.f) - log1pf(__expf(-fabsf(x))); }
struct Args { const float* in[24]; float* out; unsigned char* ws; int ph_lo, ph_hi; };
#define XB_TMO      128
#define XB_XCNT(j)  (256  + 64 * (j))
#define XB_XSUB(j)  (1280 + 64 * (j))
#define XB_XGEN(j)  (2304 + 64 * (j))
#define XB_TOP      3328
#define XB_TOPGEN   3392
#define XCD_BAR_WORDS 3456
#define XB_SPIN_CAP (1u << 18)

__device__ __forceinline__ unsigned xb_ld(unsigned* p)              { return __hip_atomic_load(p, __ATOMIC_RELAXED, __HIP_MEMORY_SCOPE_AGENT); }
__device__ __forceinline__ unsigned xb_add(unsigned* p, unsigned v) { return __hip_atomic_fetch_add(p, v, __ATOMIC_RELAXED, __HIP_MEMORY_SCOPE_AGENT); }
__device__ __forceinline__ unsigned xb_xcc_id() { return (unsigned)__builtin_amdgcn_s_getreg((3 << 11) | 20) & 0xFu; }
#define XB_SPIN(cond, bar) do { unsigned _sp = 0; while (cond) { __builtin_amdgcn_s_sleep(1); \
    if ((++_sp & 255u) == 0u) { if (xb_ld(&(bar)[XB_TMO])) break; if (_sp > XB_SPIN_CAP) { atomicAdd(&(bar)[XB_TMO], 1u); break; } } } } while (0)

struct XcdBarrier {
    unsigned* bar; unsigned x;
    volatile LAS unsigned* st;
};

__device__ __forceinline__ XcdBarrier xcd_barrier_post(unsigned* bar, volatile LAS unsigned* st) {
    XcdBarrier b; b.bar = bar; b.x = xb_xcc_id(); b.st = st;
    if (threadIdx.x == 0) (void)xb_add(&bar[XB_XCNT(b.x)], 1u);
    return b;
}
__device__ __forceinline__ void xcd_barrier_complete(unsigned* bar, unsigned x, unsigned& nloc, unsigned& nx) {
    const unsigned G = gridDim.x * gridDim.y * gridDim.z;
    unsigned sum, cnt, mine, sp = 0u;
    for (;;) {
        sum = 0u; cnt = 0u; mine = 0u;
#pragma unroll
        for (unsigned j = 0; j < 16; ++j) { const unsigned c = xb_ld(&bar[XB_XCNT(j)]); sum += c; cnt += (c > 0u) ? 1u : 0u; mine = (j == x) ? c : mine; }
        if (sum == G) break;
        __builtin_amdgcn_s_sleep(1);
        if ((++sp & 255u) == 0u) { if (xb_ld(&bar[XB_TMO])) break; if (sp > XB_SPIN_CAP) { atomicAdd(&bar[XB_TMO], 1u); break; } }
    }
    nloc = mine > 0u ? mine : 1u; nx = cnt > 0u ? cnt : 1u;
}

__device__ __forceinline__ void xcd_barrier(const XcdBarrier& b) {
    asm volatile("s_waitcnt vmcnt(0)" ::: "memory");
    __syncthreads();
    if (threadIdx.x == 0) {
        unsigned* bar = b.bar;
        __builtin_amdgcn_s_waitcnt(0);
        unsigned nloc = b.st[0], nx = b.st[1];
        if (nloc == 0u) { xcd_barrier_complete(bar, b.x, nloc, nx); b.st[0] = nloc; b.st[1] = nx; }
        const unsigned old = xb_add(&bar[XB_XSUB(b.x)], 1u);
        const unsigned gen = old / nloc;
        if (old + 1u == (gen + 1u) * nloc) {
            __builtin_amdgcn_fence(__ATOMIC_RELEASE, "agent");
            asm volatile("s_waitcnt vmcnt(0)" ::: "memory");
            const unsigned og = xb_add(&bar[XB_TOP], 1u);
            const unsigned tg = og / nx;
            if (og + 1u == (tg + 1u) * nx) xb_add(&bar[XB_TOPGEN], 1u);
            else XB_SPIN(xb_ld(&bar[XB_TOPGEN]) == tg, bar);
            __builtin_amdgcn_fence(__ATOMIC_ACQUIRE, "agent");
            xb_add(&bar[XB_XGEN(b.x)], 1u);
            asm volatile("s_waitcnt vmcnt(0)" ::: "memory");
        } else {
            XB_SPIN(xb_ld(&bar[XB_XGEN(b.x)]) == gen, bar);
            __builtin_amdgcn_fence(__ATOMIC_ACQUIRE, "agent");
            asm volatile("s_waitcnt vmcnt(0)" ::: "memory");
        }
    }
    __syncthreads();
}
struct Frame {
    LAS unsigned char* lds;
    int tid, lane, wave, G, bid;
    float* out; unsigned char* ws;
};
#define WSP(T, off) ((T*)(F.ws + (off)))

__device__ __forceinline__ void p0_transpose_item(const float* W, int K, int ldw, int nblk, int thr, int shift, bf16* WT, LAS float* scr, int item, int lane) {
    const int kb = item / nblk, nb = item % nblk, k0 = 64 * kb, n0 = 32 * nb, ns = n0 + (n0 >= thr ? shift : 0);
#pragma unroll 8
    for (int i = 0; i < 32; ++i) { const int kk = 2 * i + (lane >> 5); scr[kk * 33 + (lane & 31)] = W[(size_t)(k0 + kk) * ldw + ns + (lane & 31)]; }
    LDS_WAIT(); asm volatile("" ::: "memory");
    const int c = lane & 7;
#pragma unroll
    for (int j = 0; j < 4; ++j) { const int n = (lane >> 3) + 8 * j; const LAS float* s = scr + (8 * c) * 33 + n;
        v4u o; o.x = pk2(s[0 * 33], s[1 * 33]); o.y = pk2(s[2 * 33], s[3 * 33]); o.z = pk2(s[4 * 33], s[5 * 33]); o.w = pk2(s[6 * 33], s[7 * 33]);
        *(GAS v4u*)(WT + (size_t)(n0 + n) * K + k0 + 8 * c) = o; }
    LDS_WAIT(); asm volatile("" ::: "memory");
}
__device__ __forceinline__ void cvt_f32_bf16_stream(const float* src, bf16* dst, size_t n8, size_t gtid, size_t gthreads) {
    for (size_t i = gtid; i < n8; i += gthreads) {
        const f32x4 a = *(const GAS f32x4*)(src + i * 8), b = *(const GAS f32x4*)(src + i * 8 + 4);
        v4u o; o.x = pk2(a.x, a.y); o.y = pk2(a.z, a.w); o.z = pk2(b.x, b.y); o.w = pk2(b.z, b.w);
        *(GAS v4u*)(dst + i * 8) = o; }
}
__device__ __forceinline__ void p0_fp8_rows(Frame& F, const float* src, unsigned char* dst, float* iscale) {
    const int gw = F.bid * NWAVES + F.wave, NGW = F.G * NWAVES, lane = F.lane;
    for (int row = gw; row < 2 * 16384; row += NGW) {
        const float* r = src + (size_t)row * 1024 + 16 * lane;
        const f32x4 a = *(const GAS f32x4*)r, b = *(const GAS f32x4*)(r + 4), c = *(const GAS f32x4*)(r + 8), e = *(const GAS f32x4*)(r + 12);
        float am = fmaxf(fmaxf(fmaxf(fabsf(a.x), fabsf(a.y)), fmaxf(fabsf(a.z), fabsf(a.w))), fmaxf(fmaxf(fabsf(b.x), fabsf(b.y)), fmaxf(fabsf(b.z), fabsf(b.w))));
        am = fmaxf(am, fmaxf(fmaxf(fmaxf(fabsf(c.x), fabsf(c.y)), fmaxf(fabsf(c.z), fabsf(c.w))), fmaxf(fmaxf(fabsf(e.x), fabsf(e.y)), fmaxf(fabsf(e.z), fabsf(e.w)))));
        am = wave_max(am);
        const float sc = am > 1e-30f ? exp2f(floorf(log2f(256.f / am))) : 1.f;
        int w0 = 0, w1 = 0, w2 = 0, w3 = 0;
        w0 = __builtin_amdgcn_cvt_pk_fp8_f32(a.x * sc, a.y * sc, w0, false); w0 = __builtin_amdgcn_cvt_pk_fp8_f32(a.z * sc, a.w * sc, w0, true);
        w1 = __builtin_amdgcn_cvt_pk_fp8_f32(b.x * sc, b.y * sc, w1, false); w1 = __builtin_amdgcn_cvt_pk_fp8_f32(b.z * sc, b.w * sc, w1, true);
        w2 = __builtin_amdgcn_cvt_pk_fp8_f32(c.x * sc, c.y * sc, w2, false); w2 = __builtin_amdgcn_cvt_pk_fp8_f32(c.z * sc, c.w * sc, w2, true);
        w3 = __builtin_amdgcn_cvt_pk_fp8_f32(e.x * sc, e.y * sc, w3, false); w3 = __builtin_amdgcn_cvt_pk_fp8_f32(e.z * sc, e.w * sc, w3, true);
        const int layer = row >> 14, er = row & 16383;
        v4u o; o.x = (unsigned)w0; o.y = (unsigned)w1; o.z = (unsigned)w2; o.w = (unsigned)w3;
        *(GAS v4u*)(dst + ((size_t)((layer * 8 + (lane >> 3)) * 16384 + er)) * 128 + 16 * (lane & 7)) = o;
        if (lane == 0) iscale[row] = 1.f / sc;
    }
}
__device__ __forceinline__ void p0_i8_rows(Frame& F, const float* src, unsigned char* dst, float* scale) {
    const int gw = F.bid * NWAVES + F.wave, NGW = F.G * NWAVES, lane = F.lane;
    for (int row = gw; row < 2 * 16384; row += NGW) {
        const float* r = src + (size_t)row * 1024 + 16 * lane;
        float x[16];
#pragma unroll
        for (int q4 = 0; q4 < 4; ++q4) { const f32x4 a = *(const GAS f32x4*)(r + 4 * q4); x[4 * q4] = a.x; x[4 * q4 + 1] = a.y; x[4 * q4 + 2] = a.z; x[4 * q4 + 3] = a.w; }
        float am = 0.f;
#pragma unroll
        for (int i = 0; i < 16; ++i) am = fmaxf(am, fabsf(x[i]));
        am = wave_max(am);
        const float inv = am > 1e-30f ? 127.f / am : 0.f;
        unsigned wd[4];
#pragma unroll
        for (int q4 = 0; q4 < 4; ++q4) { unsigned w = 0;
#pragma unroll
            for (int e = 0; e < 4; ++e) { const int qv = (int)rintf(x[4 * q4 + e] * inv); w |= ((unsigned)qv & 0xffu) << (8 * e); }
            wd[q4] = w; }
        const int layer = row >> 14, er = row & 16383;
        v4u o; o.x = wd[0]; o.y = wd[1]; o.z = wd[2]; o.w = wd[3];
        *(GAS v4u*)(dst + ((size_t)((layer * 8 + (lane >> 3)) * 16384 + er)) * 128 + 16 * (lane & 7)) = o;
        if (lane == 0) scale[row] = am * (1.f / 127.f);
    }
}
__device__ __forceinline__ void p0_prologue(Frame& F, const Args& A) {
    {
        const float* c = A.in[1]; const float* aw = A.in[2]; const float* ab = A.in[3]; float* MOD = WSP(float, WS_MOD);
        LAS float* red = (LAS float*)F.lds;
        for (int item = F.bid; item < 192; item += F.G) {
            const int l = item / 96, n0 = (item % 96) * 64;
            float acc[4] = {0.f, 0.f, 0.f, 0.f};
            const int kbeg = F.wave * 128;
#pragma unroll 4
            for (int k = kbeg; k < kbeg + 128; ++k) {
                const float wv = aw[((size_t)l * 1024 + k) * 6144 + n0 + F.lane];
#pragma unroll
                for (int b = 0; b < 4; ++b) acc[b] += silu_f(c[b * 1024 + k]) * wv;
            }
#pragma unroll
            for (int b = 0; b < 4; ++b) red[(F.wave * 4 + b) * 64 + F.lane] = acc[b];
            __syncthreads();
            if (F.tid < 256) { const int b = F.tid >> 6, ln = F.tid & 63; float s = ab[l * 6144 + n0 + ln];
#pragma unroll
                for (int w = 0; w < 8; ++w) s += red[(w * 4 + b) * 64 + ln];
                MOD[(size_t)(l * 4 + b) * 6144 + n0 + ln] = s; }
            __syncthreads();
        }
    }
    if (F.bid == 0) {
        LAS unsigned* hist = (LAS unsigned*)F.lds;
        unsigned short* ORD = WSP(unsigned short, WS_ORD);
        for (int pass = 0; pass < 2; ++pass) {
            const int nunits = pass == 0 ? 2048 : 1024;
            if (F.tid < 160) hist[F.tid] = 0u;
            __syncthreads();
            for (int u = F.tid; u < nunits; u += NTHR) {
                const int q = pass == 0 ? (u & 63) : (u & 31), h = pass == 0 ? ((u >> 6) & 7) : ((u >> 5) & 7);
                const float dcut = 46.f * (float)(2 << h);
                int cost;
                if (pass == 0) { const int nt = 2 * q + 2; int lo = (int)ceilf(((float)(q * 128) - dcut - 63.f) * (1.f / 64.f)); if (lo < 0) lo = 0; cost = nt - lo; }
                else { int lo = (int)ceilf(((float)(q * 256) - dcut - 255.f) * (1.f / 256.f)); if (lo < 0) lo = 0; int nb = q - lo; if (nb > 3 * 8) nb = 24; cost = 4 * (nb + 1); }
                if (cost > 159) cost = 159;
                atomicAdd((unsigned*)(hist + (159 - cost)), 1u);
            }
            __syncthreads();
            if (F.tid == 0) { unsigned acc = 0; for (int i = 0; i < 160; ++i) { const unsigned c = hist[i]; hist[i] = acc; acc += c; } }
            __syncthreads();
            for (int u = F.tid; u < nunits; u += NTHR) {
                const int q = pass == 0 ? (u & 63) : (u & 31), h = pass == 0 ? ((u >> 6) & 7) : ((u >> 5) & 7);
                const float dcut = 46.f * (float)(2 << h);
                int cost;
                if (pass == 0) { const int nt = 2 * q + 2; int lo = (int)ceilf(((float)(q * 128) - dcut - 63.f) * (1.f / 64.f)); if (lo < 0) lo = 0; cost = nt - lo; }
                else { int lo = (int)ceilf(((float)(q * 256) - dcut - 255.f) * (1.f / 256.f)); if (lo < 0) lo = 0; int nb = q - lo; if (nb > 3 * 8) nb = 24; cost = 4 * (nb + 1); }
                if (cost > 159) cost = 159;
                const unsigned pos = atomicAdd((unsigned*)(hist + (159 - cost)), 1u);
                ORD[(pass == 0 ? 0 : 2048) + pos] = (unsigned short)u;
            }
            __syncthreads();
        }
    }
    {
        LAS float* scr = (LAS float*)(F.lds + F.wave * 8704);
        const int gw = F.bid * NWAVES + F.wave, NGW = F.G * NWAVES;
        constexpr int I_IN0 = 16 * (NZ0 / 32), I_OUT = 16 * 32, I_IN1 = 16 * (NZ1 / 32), I_Q = 16 * (NQ / 32);
        constexpr int NITEMS = I_IN0 + 2 * I_OUT + I_IN1 + 2 * I_Q;
        for (int it = gw; it < NITEMS; it += NGW) {
            int r = it;
            if (r < I_IN0) { p0_transpose_item(A.in[6], D, SRC_IN0, NZ0 / 32, 2048, 8, WSP(bf16, WS_WIN0), scr, r, F.lane); continue; } r -= I_IN0;
            if (r < I_OUT) { p0_transpose_item(A.in[13], D, D, 32, 1 << 30, 0, WSP(bf16, WS_WOUT0), scr, r, F.lane); continue; } r -= I_OUT;
            if (r < I_IN1) { p0_transpose_item(A.in[14], D, NZ1, NZ1 / 32, 1 << 30, 0, WSP(bf16, WS_WIN1), scr, r, F.lane); continue; } r -= I_IN1;
            if (r < I_OUT) { p0_transpose_item(A.in[19], D, D, 32, 1 << 30, 0, WSP(bf16, WS_WOUT1), scr, r, F.lane); continue; } r -= I_OUT;
            if (r < I_Q) { p0_transpose_item(A.in[20], D, NQ, NQ / 32, 1 << 30, 0, WSP(bf16, WS_WQ), scr, r, F.lane); continue; } r -= I_Q;
            p0_transpose_item(A.in[20] + (size_t)D * NQ, D, NQ, NQ / 32, 1 << 30, 0, WSP(bf16, WS_WQ) + (size_t)NQ * D, scr, r, F.lane);
        }
    }
    {
        const size_t gtid = (size_t)F.bid * NTHR + F.tid, gth = (size_t)F.G * NTHR;
        cvt_f32_bf16_stream(A.in[21], WSP(bf16, WS_KEYS), (size_t)2 * 2 * 128 * 128 / 8, gtid, gth);
        p0_i8_rows(F, A.in[22], F.ws + WS_UB, WSP(float, WS_ISU));
        p0_fp8_rows(F, A.in[23], F.ws + WS_VB, WSP(float, WS_ISV));
    }
}

template <bool GATES>
__device__ __forceinline__ void norm_pass(Frame& F, const Args& A, const float* X, const float* g, const float* mod, int shc, bf16* XN) {
    LAS float* wgT = (LAS float*)F.lds;
    if (GATES) {
        const float* win = A.in[6];
        for (int i = F.tid; i < 8 * 1024; i += NTHR) { const int cg = i >> 10, k = i & 1023; wgT[i] = win[(size_t)k * SRC_IN0 + 2048 + cg]; }
        __syncthreads();
    }
    const int gw = F.bid * NWAVES + F.wave, NGW = F.G * NWAVES;
    for (int row = gw; row < M; row += NGW) {
        const int b = row >> 13;
        const GAS f32x4* xr = (const GAS f32x4*)(X + (size_t)row * D) + F.lane;
        f32x4 v[4]; float ss = 0.f;
#pragma unroll
        for (int j = 0; j < 4; ++j) { v[j] = xr[64 * j]; ss += (v[j].x * v[j].x + v[j].y * v[j].y) + (v[j].z * v[j].z + v[j].w * v[j].w); }
        const float rstd = rsqrtf(wave_sum(ss) * (1.f / D) + EPS);
        const float* shp = mod + (size_t)b * 6144 + shc * 1024; const float* scp = shp + 1024;
#pragma unroll
        for (int j = 0; j < 4; ++j) { const int c = 4 * F.lane + 256 * j;
            const f32x4 gg = *(const f32x4*)(g + c), sc = *(const f32x4*)(scp + c), sh = *(const f32x4*)(shp + c);
            v[j] = v[j] * rstd * gg * (sc + 1.f) + sh;
            v2u o; o.x = pk2(v[j].x, v[j].y); o.y = pk2(v[j].z, v[j].w);
            *(GAS v2u*)(XN + (size_t)row * D + c) = o; }
        if (GATES) {
            float* GT = WSP(float, WS_GATES);
#pragma unroll
            for (int cg = 0; cg < 8; ++cg) { float p = 0.f;
#pragma unroll
                for (int j = 0; j < 4; ++j) { const f32x4 w = *(const LAS f32x4*)(wgT + cg * 1024 + 4 * F.lane + 256 * j); p += (v[j].x * w.x + v[j].y * w.y) + (v[j].z * w.z + v[j].w * w.w); }
                p = wave_sum(p);
                if (F.lane == 0) GT[(size_t)row * 8 + cg] = p + (cg < 4 ? A.in[8][cg] : A.in[9][cg - 4]); }
        }
    }
}

__device__ __forceinline__ void qknorm_unit(Frame& F, bf16* Z, int ldz, int row0, int col0, const float* g, float* kmean  ) {
    const int c = col0 + 8 * F.lane, d0 = (8 * F.lane) & 63;
    float gv[8];
#pragma unroll
    for (int i = 0; i < 8; ++i) gv[i] = g[d0 + i];
    float ks[8] = {0.f, 0.f, 0.f, 0.f, 0.f, 0.f, 0.f, 0.f};
    for (int r = 0; r < 32; ++r) {
        bf16* p = Z + (size_t)(row0 + F.wave * 32 + r) * ldz + c;
        const v4u w = *(const GAS v4u*)p;
        float x[8] = {bflo(w.x), bfhi(w.x), bflo(w.y), bfhi(w.y), bflo(w.z), bfhi(w.z), bflo(w.w), bfhi(w.w)};
        float ss = 0.f;
#pragma unroll
        for (int i = 0; i < 8; ++i) ss += x[i] * x[i];
        ss += __shfl_xor(ss, 1); ss += __shfl_xor(ss, 2); ss += __shfl_xor(ss, 4);
        const float rstd = rsqrtf(ss * (1.f / 64.f) + EPS);
#pragma unroll
        for (int i = 0; i < 8; ++i) { x[i] = x[i] * rstd * gv[i]; ks[i] += x[i]; }
        v4u o; o.x = pk2(x[0], x[1]); o.y = pk2(x[2], x[3]); o.z = pk2(x[4], x[5]); o.w = pk2(x[6], x[7]);
        *(GAS v4u*)p = o;
    }
    if (kmean) {
        LAS float* red = (LAS float*)F.lds;
#pragma unroll
        for (int i = 0; i < 8; ++i) red[F.wave * 512 + 8 * F.lane + i] = ks[i];
        __syncthreads();
        { float s = 0.f;
#pragma unroll
          for (int w = 0; w < 8; ++w) s += red[w * 512 + F.tid];
          kmean[(size_t)(F.tid >> 6) * (32 * 64) + (F.tid & 63)] = s * (1.f / 256.f); }
        __syncthreads();
    }
}
constexpr int KSTRB = 144;
template <int DV> struct VStr { static constexpr int B = (DV == 64) ? 192 : 320; };
typedef short v4i16_t __attribute__((ext_vector_type(4)));
__device__ __forceinline__ s16x4 vtr(const LAS unsigned char* p) { return __builtin_bit_cast(s16x4, __builtin_amdgcn_ds_read_tr16_b64_v4i16((LAS v4i16_t*)p)); }
__device__ __forceinline__ unsigned cvtpk(float lo, float hi) { typedef float f2 __attribute__((ext_vector_type(2))); typedef __bf16 b2 __attribute__((ext_vector_type(2)));
    f2 v = {lo, hi}; b2 b = __builtin_convertvector(v, b2); return __builtin_bit_cast(unsigned, b); }
__device__ __forceinline__ float xhalf(float v) {
    auto rr = __builtin_amdgcn_permlane32_swap(__builtin_bit_cast(unsigned, v), __builtin_bit_cast(unsigned, v), false, false);
    const unsigned r0 = rr[0], r1 = rr[1]; return u2f((threadIdx.x & 32) ? r0 : r1);
}
template <int DV> struct AttnSt { f32x16 o[DV / 32]; float m, l; };
template <int DV> __device__ __forceinline__ void attn_init(AttnSt<DV>& st) {
#pragma unroll
    for (int t = 0; t < DV / 32; ++t)
#pragma unroll
        for (int r = 0; r < 16; ++r) st.o[t][r] = 0.f;
    st.m = -1e30f; st.l = 0.f;
}
template <int DV>
__device__ __forceinline__ void attn_tile(AttnSt<DV>& st, const LAS unsigned char* Kt, const LAS unsigned char* Vt, const bf16x8 (&qf)[4], float sc2, float sl2, int tq, int kt0, bool diag, bool rowok, int lane) {
    const int r32 = lane & 31, hi = lane >> 5;
    f32x16 s0, s1;
#pragma unroll
    for (int r = 0; r < 16; ++r) { s0[r] = 0.f; s1[r] = 0.f; }
    const LAS unsigned char* kp = Kt + r32 * KSTRB + hi * 16;
#pragma unroll
    for (int ks = 0; ks < 4; ++ks) {
        const bf16x8 k0 = *(const LAS bf16x8*)(kp + ks * 32), k1 = *(const LAS bf16x8*)(kp + 32 * KSTRB + ks * 32);
        s0 = __builtin_amdgcn_mfma_f32_32x32x16_bf16(k0, qf[ks], s0, 0, 0, 0);
        s1 = __builtin_amdgcn_mfma_f32_32x32x16_bf16(k1, qf[ks], s1, 0, 0, 0);
    }
    const int kb = kt0 + 4 * hi;
    const float c0 = -sl2 * (float)(tq - kb);
    float mx = -INFINITY;
#pragma unroll
    for (int r = 0; r < 16; ++r) {
        const int ko = (r & 3) + 8 * (r >> 2);
        float a = s0[r] * sc2 + (c0 + sl2 * (float)ko), b = s1[r] * sc2 + (c0 + sl2 * (float)(ko + 32));
        if (diag) { if (kb + ko > tq) a = -INFINITY; if (kb + ko + 32 > tq) b = -INFINITY; }
        if (!rowok) { a = -INFINITY; b = -INFINITY; }
        s0[r] = a; s1[r] = b; mx = fmaxf(mx, fmaxf(a, b));
    }
    mx = fmaxf(mx, xhalf(mx));
    const float mn = fmaxf(st.m, mx);
    const float alpha = __builtin_amdgcn_exp2f(st.m - mn);
    st.m = mn;
    float ps = 0.f;
#pragma unroll
    for (int r = 0; r < 16; ++r) { s0[r] = __builtin_amdgcn_exp2f(s0[r] - mn); s1[r] = __builtin_amdgcn_exp2f(s1[r] - mn); ps += s0[r] + s1[r]; }
    st.l = st.l * alpha + ps;
#pragma unroll
    for (int t = 0; t < DV / 32; ++t)
#pragma unroll
        for (int r = 0; r < 16; ++r) st.o[t][r] *= alpha;
    bf16x8 pf[2][2];
#pragma unroll
    for (int s = 0; s < 2; ++s) {
        v4u a, b;
        a.x = cvtpk(s0[8 * s + 0], s0[8 * s + 1]); a.y = cvtpk(s0[8 * s + 2], s0[8 * s + 3]); a.z = cvtpk(s0[8 * s + 4], s0[8 * s + 5]); a.w = cvtpk(s0[8 * s + 6], s0[8 * s + 7]);
        b.x = cvtpk(s1[8 * s + 0], s1[8 * s + 1]); b.y = cvtpk(s1[8 * s + 2], s1[8 * s + 3]); b.z = cvtpk(s1[8 * s + 4], s1[8 * s + 5]); b.w = cvtpk(s1[8 * s + 6], s1[8 * s + 7]);
        pf[0][s] = __builtin_bit_cast(bf16x8, a); pf[1][s] = __builtin_bit_cast(bf16x8, b);
    }
    constexpr int VS = VStr<DV>::B;
    const int g = lane >> 4, i16 = lane & 15;
    const LAS unsigned char* vp = Vt + (4 * (g >> 1) + (i16 >> 2)) * VS + (16 * (g & 1) + 4 * (i16 & 3)) * 2;
#pragma unroll
    for (int kbk = 0; kbk < 2; ++kbk)
#pragma unroll
        for (int s = 0; s < 2; ++s)
#pragma unroll
            for (int t = 0; t < DV / 32; ++t) {
                const s16x4 lo = vtr(vp + (kbk * 32 + 16 * s) * VS + t * 64), h8 = vtr(vp + (kbk * 32 + 16 * s + 8) * VS + t * 64);
                const bf16x8 va = {lo[0], lo[1], lo[2], lo[3], h8[0], h8[1], h8[2], h8[3]};
                st.o[t] = __builtin_amdgcn_mfma_f32_32x32x16_bf16(va, pf[kbk][s], st.o[t], 0, 0, 0);
            }
}
template <int NK, int DV> struct TileRegs { v4u k[NK]; v4u v[DV / 64]; };
template <int NK, int DV>
__device__ __forceinline__ void tile_load(TileRegs<NK, DV>& R, const bf16* Z, int ldz, size_t zrow0, int kcol, int vcol, int tid) {
#pragma unroll
    for (int i = 0; i < NK; ++i) { const int ch = tid + 512 * i; const int row = ch / (8 * NK), cc = ch % (8 * NK);
        R.k[i] = *(const GAS v4u*)(Z + (zrow0 + row) * ldz + kcol + cc * 8); }
#pragma unroll
    for (int i = 0; i < DV / 64; ++i) { const int ch = tid + 512 * i; const int row = ch / (DV / 8), cc = ch % (DV / 8);
        R.v[i] = *(const GAS v4u*)(Z + (zrow0 + row) * ldz + vcol + cc * 8); }
}
template <int NK, int DV>
__device__ __forceinline__ void tile_store(const TileRegs<NK, DV>& R, LAS unsigned char* Kt  , LAS unsigned char* Vt, int tid) {
#pragma unroll
    for (int i = 0; i < NK; ++i) { const int ch = tid + 512 * i; const int row = ch / (8 * NK), cc = ch % (8 * NK);
        *(LAS v4u*)(Kt + (cc >> 3) * (64 * KSTRB) + row * KSTRB + (cc & 7) * 16) = R.k[i]; }
#pragma unroll
    for (int i = 0; i < DV / 64; ++i) { const int ch = tid + 512 * i; const int row = ch / (DV / 8), cc = ch % (DV / 8);
        *(LAS v4u*)(Vt + row * VStr<DV>::B + cc * 16) = R.v[i]; }
}
__device__ __forceinline__ void moba_unit(Frame& F, int b, int h, int j, float tcut  ) {
    const bf16* Z = WSP(bf16, WS_Z); constexpr int ldz = NZ0;
    const int lane = F.lane, w = F.wave, r32 = lane & 31, hi = lane >> 5, tid = F.tid;
    const size_t rowb = (size_t)b * SEQ;
    const int qpos = j * 256 + w * 32 + r32;
    const int qcol = 2048 + h * 64, kcol = 2560 + h * 64, vcol = 3072 + h * 64;
    LAS unsigned char* lds = F.lds;
    constexpr int BUFB = 64 * KSTRB + 64 * VStr<64>::B;
    LAS unsigned char* kmh = lds + 2 * BUFB;
    LAS unsigned char* kml = lds + 2 * BUFB + 32 * KSTRB;
    LAS unsigned* msk = (LAS unsigned*)(lds + 2 * BUFB + 64 * KSTRB);
    { const float* KM = WSP(float, WS_KMEAN) + (size_t)((b * 8 + h) * 32) * 64; const f32x4 x = *(const f32x4*)(KM + 4 * tid);
      const int n = tid >> 4, d0 = (tid & 15) * 4;
      const unsigned h0 = f2bf(x.x), h1 = f2bf(x.y), h2 = f2bf(x.z), h3 = f2bf(x.w);
      v2u hv; hv.x = h0 | (h1 << 16); hv.y = h2 | (h3 << 16);
      v2u lv; lv.x = pk2(x.x - u2f(h0 << 16), x.y - u2f(h1 << 16)); lv.y = pk2(x.z - u2f(h2 << 16), x.w - u2f(h3 << 16));
      *(LAS v2u*)(kmh + n * KSTRB + d0 * 2) = hv; *(LAS v2u*)(kml + n * KSTRB + d0 * 2) = lv; }
    if (tid < 16) msk[tid] = 0u;
    bf16x8 qf[4];
    const bf16* qrow = Z + (rowb + qpos) * ldz + qcol;
#pragma unroll
    for (int ks = 0; ks < 4; ++ks) qf[ks] = *(const GAS bf16x8*)(qrow + 16 * ks + 8 * hi);
    __syncthreads();
    f32x16 gt;
#pragma unroll
    for (int r = 0; r < 16; ++r) gt[r] = 0.f;
#pragma unroll
    for (int ks = 0; ks < 4; ++ks) {
        const bf16x8 a = *(const LAS bf16x8*)(kmh + r32 * KSTRB + hi * 16 + ks * 32), c = *(const LAS bf16x8*)(kml + r32 * KSTRB + hi * 16 + ks * 32);
        gt = __builtin_amdgcn_mfma_f32_32x32x16_bf16(a, qf[ks], gt, 0, 0, 0);
        gt = __builtin_amdgcn_mfma_f32_32x32x16_bf16(c, qf[ks], gt, 0, 0, 0);
    }
    float t0 = -INFINITY, t1 = -INFINITY, t2 = -INFINITY;
#define INS3(key) do { float k_ = (key); float a_ = fmaxf(t0, k_), l_ = fminf(t0, k_); t0 = a_; a_ = fmaxf(t1, l_); l_ = fminf(t1, l_); t1 = a_; t2 = fmaxf(t2, l_); } while (0)
#pragma unroll
    for (int r = 0; r < 16; ++r) { const int n = (r & 3) + 8 * (r >> 2) + 4 * hi;
        const float key = (n < j) ? u2f((f2u(gt[r]) & ~31u) | (unsigned)n) : -INFINITY; INS3(key); }
    { const float p0 = xhalf(t0), p1 = xhalf(t1), p2 = xhalf(t2); INS3(p0); INS3(p1); INS3(p2); }
#undef INS3
    const int sel0 = (t0 > -INFINITY) ? (int)(f2u(t0) & 31u) : -1;
    const int sel1 = (t1 > -INFINITY) ? (int)(f2u(t1) & 31u) : -1;
    const int sel2 = (t2 > -INFINITY) ? (int)(f2u(t2) & 31u) : -1;
    { const unsigned mm = (sel0 >= 0 ? 1u << sel0 : 0u) | (sel1 >= 0 ? 1u << sel1 : 0u) | (sel2 >= 0 ? 1u << sel2 : 0u);
      if (mm) { __hip_atomic_fetch_or(msk + w, mm, __ATOMIC_RELAXED, __HIP_MEMORY_SCOPE_WORKGROUP); __hip_atomic_fetch_or(msk + 8, mm, __ATOMIC_RELAXED, __HIP_MEMORY_SCOPE_WORKGROUP); } }
    __syncthreads();
    const float slope = ldexpf(1.f, -(h + 1)), dcut = tcut / slope;
    const float sl2 = slope * LOG2E, sc2 = 0.125f * LOG2E;
    int nlo = (int)ceilf(((float)(j * 256) - dcut - 255.f) * (1.f / 256.f)); if (nlo < 0) nlo = 0;
    const unsigned keep = nlo >= 32 ? 0u : (0xffffffffu << nlo);
    const unsigned bmask = msk[8] & keep; const unsigned wmask = (unsigned)__builtin_amdgcn_readfirstlane((int)msk[w]) & keep;
    AttnSt<64> st; attn_init<64>(st);
    unsigned rem = bmask;
    int blk = rem ? __builtin_ctz(rem) : j; if (rem) rem &= rem - 1;
    int kt = 0, buf = 0;
    TileRegs<1, 64> R;
    tile_load<1, 64>(R, Z, ldz, rowb + blk * 256 + kt * 64, kcol, vcol, tid);
    tile_store<1, 64>(R, lds, lds + 64 * KSTRB, tid);
    __syncthreads();
    for (;;) {
        int nblk = blk, nkt = kt + 1; bool has_next = true;
        if (nkt == 4) { nkt = 0; if (blk == j) has_next = false; else if (rem) { nblk = __builtin_ctz(rem); rem &= rem - 1; } else nblk = j; }
        if (has_next) tile_load<1, 64>(R, Z, ldz, rowb + nblk * 256 + nkt * 64, kcol, vcol, tid);
        const bool own = (blk == j);
        const bool active = (own ? (kt * 64 <= w * 32 + 31) : (((wmask >> blk) & 1u) != 0u)) && ((float)(j * 256 + w * 32 - (blk * 256 + kt * 64 + 63)) <= dcut);
        if (active) {
            const bool rowok = own || blk == sel0 || blk == sel1 || blk == sel2;
            const bool diag = own && (kt * 64 + 63 > w * 32);
            attn_tile<64>(st, lds + buf * BUFB, lds + buf * BUFB + 64 * KSTRB, qf, sc2, sl2, qpos, blk * 256 + kt * 64, diag, rowok, lane);
        }
        if (!has_next) break;
        tile_store<1, 64>(R, lds + (buf ^ 1) * BUFB, lds + (buf ^ 1) * BUFB + 64 * KSTRB, tid);
        __syncthreads();
        buf ^= 1; blk = nblk; kt = nkt;
    }
    const float inv = 1.f / (st.l + xhalf(st.l));
    bf16* Y = WSP(bf16, WS_XNY) + (rowb + qpos) * 1024 + 512 + h * 64;
#pragma unroll
    for (int t = 0; t < 2; ++t)
#pragma unroll
        for (int rg = 0; rg < 4; ++rg) { v2u o; o.x = pk2(st.o[t][4 * rg] * inv, st.o[t][4 * rg + 1] * inv); o.y = pk2(st.o[t][4 * rg + 2] * inv, st.o[t][4 * rg + 3] * inv);
            *(GAS v2u*)(Y + t * 32 + 8 * rg + 4 * hi) = o; }
    __syncthreads();
}

__device__ __forceinline__ void diff_unit(Frame& F, const Args& A, int b, int h, int qt, float lam, float tcut) {
    const bf16* Z = WSP(bf16, WS_Z); constexpr int ldz = NZ1;
    const int lane = F.lane, w = F.wave, r32 = lane & 31, hi = lane >> 5, tid = F.tid;
    const int comp = w >> 2, wq = w & 3;
    const size_t rowb = (size_t)b * SEQ;
    const int q0 = qt * 128, qpos = q0 + wq * 32 + r32;
    const int qcol = h * 128 + comp * 64, kcol = 1024 + h * 128, vcol = 2048 + h * 128;
    LAS unsigned char* lds = F.lds;
    constexpr int BUFB = 2 * 64 * KSTRB + 64 * VStr<128>::B;
    bf16x8 qf[4];
    const bf16* qrow = Z + (rowb + qpos) * ldz + qcol;
#pragma unroll
    for (int ks = 0; ks < 4; ++ks) qf[ks] = *(const GAS bf16x8*)(qrow + 16 * ks + 8 * hi);
    const float slope = ldexpf(1.f, -(h + 1)), dcut = tcut / slope;
    const float sl2 = slope * LOG2E, sc2 = 0.125f * LOG2E;
    AttnSt<128> st; attn_init<128>(st);
    const int nt = (q0 + 128) / 64;
    int kt_lo = (int)ceilf(((float)q0 - dcut - 63.f) * (1.f / 64.f)); if (kt_lo < 0) kt_lo = 0;
    TileRegs<2, 128> R;
    tile_load<2, 128>(R, Z, ldz, rowb + (size_t)kt_lo * 64, kcol, vcol, tid);
    tile_store<2, 128>(R, lds, lds + 2 * 64 * KSTRB, tid);
    __syncthreads();
    int buf = 0;
    for (int kt = kt_lo; kt < nt; ++kt) {
        const bool has_next = kt + 1 < nt;
        if (has_next) tile_load<2, 128>(R, Z, ldz, rowb + (size_t)(kt + 1) * 64, kcol, vcol, tid);
        if (kt * 64 <= q0 + wq * 32 + 31) {
            const bool diag = kt * 64 + 63 > q0 + wq * 32;
            attn_tile<128>(st, lds + buf * BUFB + comp * (64 * KSTRB), lds + buf * BUFB + 2 * 64 * KSTRB, qf, sc2, sl2, qpos, kt * 64, diag, true, lane);
        }
        if (has_next) { tile_store<2, 128>(R, lds + (buf ^ 1) * BUFB, lds + (buf ^ 1) * BUFB + 2 * 64 * KSTRB, tid); }
        __syncthreads();
        buf ^= 1;
    }
    const float inv = 1.f / (st.l + xhalf(st.l));
    LAS float* o2 = (LAS float*)lds;
    if (comp == 1) {
#pragma unroll
        for (int t = 0; t < 4; ++t)
#pragma unroll
            for (int r = 0; r < 16; ++r) o2[((wq * 4 + t) * 16 + r) * 64 + lane] = st.o[t][r] * inv;
    }
    __syncthreads();
    if (comp == 0) {
        float ss = 0.f;
#pragma unroll
        for (int t = 0; t < 4; ++t)
#pragma unroll
            for (int r = 0; r < 16; ++r) { const float v = st.o[t][r] * inv - lam * o2[((wq * 4 + t) * 16 + r) * 64 + lane]; st.o[t][r] = v; ss += v * v; }
        ss += xhalf(ss);
        const float rs = rsqrtf(ss * (1.f / 128.f) + EPS) * 0.6444909324090307f;
        const float* og = A.in[18];
        bf16* Y = WSP(bf16, WS_XNY) + (rowb + qpos) * 1024 + h * 128;
#pragma unroll
        for (int t = 0; t < 4; ++t)
#pragma unroll
            for (int rg = 0; rg < 4; ++rg) { const int dv = t * 32 + 8 * rg + 4 * hi; const f32x4 gg = *(const f32x4*)(og + dv);
                v2u o; o.x = pk2(st.o[t][4 * rg] * rs * gg.x, st.o[t][4 * rg + 1] * rs * gg.y); o.y = pk2(st.o[t][4 * rg + 2] * rs * gg.z, st.o[t][4 * rg + 3] * rs * gg.w);
                *(GAS v2u*)(Y + dv) = o; }
    }
    __syncthreads();
}
template <int MT, int NT>
__device__ __forceinline__ void mma_nt(const LAS unsigned char* A, int lda, const LAS unsigned char* B, int ldb, int K, f32x4 (&acc)[MT][NT], int lane) {
    const int r = lane & 15, kq = (lane >> 4) * 16;
    for (int k0 = 0; k0 < K; k0 += 32) {
        bf16x8 a[MT], bb[NT];
#pragma unroll
        for (int m = 0; m < MT; ++m) a[m] = *(const LAS bf16x8*)(A + (m * 16 + r) * lda + k0 * 2 + kq);
#pragma unroll
        for (int n = 0; n < NT; ++n) bb[n] = *(const LAS bf16x8*)(B + (n * 16 + r) * ldb + k0 * 2 + kq);
#pragma unroll
        for (int m = 0; m < MT; ++m)
#pragma unroll
            for (int n = 0; n < NT; ++n) acc[m][n] = __builtin_amdgcn_mfma_f32_16x16x32_bf16(a[m], bb[n], acc[m][n], 0, 0, 0);
    }
}
constexpr int TS = 272;
constexpr int TILEB = 128 * TS;
constexpr int ML_Q = 0, ML_K = TILEB, ML_V = 2 * TILEB, ML_SM = 3 * TILEB;

__device__ __forceinline__ void ml_gates(const float* GT, size_t row0, int hm, LAS float* sm, int lane) {
    const float i0 = GT[(row0 + 2 * lane) * 8 + hm], i1 = GT[(row0 + 2 * lane + 1) * 8 + hm];
    const float f0 = logsigmoid_f(GT[(row0 + 2 * lane) * 8 + 4 + hm]), f1 = logsigmoid_f(GT[(row0 + 2 * lane + 1) * 8 + 4 + hm]);
    float s = f0 + f1;
#pragma unroll
    for (int o = 1; o < 64; o <<= 1) { const float t = __shfl_up(s, o); if (lane >= o) s += t; }
    const float excl = s - (f0 + f1);
    sm[2 * lane] = excl + f0; sm[2 * lane + 1] = excl + f0 + f1;
    sm[128 + 2 * lane] = i0; sm[128 + 2 * lane + 1] = i1;
}
template <bool TRANSPOSE>
__device__ __forceinline__ void ml_conv_tile(const bf16* Z, size_t rowb, int t0, int zc, const float* cw, int wc, float mul, LAS unsigned char* dst, const LAS float* rs, int tid) {
#pragma unroll
    for (int it = 0; it < 4; ++it) {
        const int item = tid + 512 * it, l = item >> 4, ch = (item & 15) * 8;
        float acc[8];
#pragma unroll
        for (int i = 0; i < 8; ++i) acc[i] = 0.f;
#pragma unroll
        for (int jj = 0; jj < 4; ++jj) {
            const int t = t0 + l - 3 + jj;
            if (t >= 0) {
                const v4u w = *(const GAS v4u*)(Z + (rowb + t) * NZ0 + zc + ch);
                const float x[8] = {bflo(w.x), bfhi(w.x), bflo(w.y), bfhi(w.y), bflo(w.z), bfhi(w.z), bflo(w.w), bfhi(w.w)};
                const f32x4 c0 = *(const f32x4*)(cw + jj * 1024 + wc + ch), c1 = *(const f32x4*)(cw + jj * 1024 + wc + ch + 4);
                acc[0] += x[0] * c0.x; acc[1] += x[1] * c0.y; acc[2] += x[2] * c0.z; acc[3] += x[3] * c0.w;
                acc[4] += x[4] * c1.x; acc[5] += x[5] * c1.y; acc[6] += x[6] * c1.z; acc[7] += x[7] * c1.w;
            }
        }
        const float sc = TRANSPOSE ? mul * rs[l] : mul;
#pragma unroll
        for (int i = 0; i < 8; ++i) acc[i] = silu_f(acc[i]) * sc;
        if (TRANSPOSE) {
#pragma unroll
            for (int i = 0; i < 8; ++i) *(LAS bf16*)(dst + (ch + i) * TS + l * 2) = (bf16)f2bf(acc[i]);
        } else {
            v4u o; o.x = pk2(acc[0], acc[1]); o.y = pk2(acc[2], acc[3]); o.z = pk2(acc[4], acc[5]); o.w = pk2(acc[6], acc[7]);
            *(LAS v4u*)(dst + l * TS + ch * 2) = o;
        }
    }
}
__device__ __forceinline__ void ml_vt_tile(const bf16* Z, size_t row0, int zc, LAS unsigned char* dst, int tid) {
#pragma unroll
    for (int it = 0; it < 4; ++it) {
        const int item = tid + 512 * it, l = item >> 4, ch = (item & 15) * 8;
        const v4u w = *(const GAS v4u*)(Z + (row0 + l) * NZ0 + zc + ch);
        const unsigned ww[4] = {w.x, w.y, w.z, w.w};
#pragma unroll
        for (int i = 0; i < 4; ++i) { *(LAS bf16*)(dst + (ch + 2 * i) * TS + l * 2) = (bf16)(ww[i] & 0xffffu); *(LAS bf16*)(dst + (ch + 2 * i + 1) * TS + l * 2) = (bf16)(ww[i] >> 16); }
    }
}
__device__ __forceinline__ void mlstm_a_unit(Frame& F, const Args& A, int unit) {
    const int c = unit & 63, bh = unit >> 6, hm = bh & 3, b = bh >> 2;
    const bf16* Z = WSP(bf16, WS_Z); const float* GT = WSP(float, WS_GATES);
    const size_t rowb = (size_t)b * SEQ; const int t0 = c * 128;
    LAS unsigned char* lds = F.lds; LAS float* sm = (LAS float*)(lds + ML_SM);
    if (F.wave == 0) {
        ml_gates(GT, rowb + t0, hm, sm, F.lane);
        LDS_WAIT();
        const float bend = sm[127];
        const float w0 = bend - sm[2 * F.lane] + sm[128 + 2 * F.lane], w1 = bend - sm[2 * F.lane + 1] + sm[128 + 2 * F.lane + 1];
        const float ml = wave_max(fmaxf(w0, w1));
        sm[256 + 2 * F.lane] = __expf(w0 - ml); sm[256 + 2 * F.lane + 1] = __expf(w1 - ml);
        if (F.lane == 0) { WSP(float, WS_BEND)[unit] = bend; WSP(float, WS_MLOC)[unit] = ml; }
    }
    __syncthreads();
    ml_conv_tile<true>(Z, rowb, t0, 512 + hm * 128, A.in[7], 512 + hm * 128, 0.08838834764831845f, lds + ML_K, sm + 256, F.tid);
    ml_vt_tile(Z, rowb + t0, 1024 + hm * 128, lds + ML_V, F.tid);
    __syncthreads();
    f32x4 acc[2][4];
#pragma unroll
    for (int m = 0; m < 2; ++m)
#pragma unroll
        for (int n = 0; n < 4; ++n) acc[m][n] = (f32x4){0.f, 0.f, 0.f, 0.f};
    const int dv0 = 32 * (F.wave >> 1), dk0 = 64 * (F.wave & 1);
    mma_nt<2, 4>(lds + ML_V + dv0 * TS, TS, lds + ML_K + dk0 * TS, TS, 128, acc, F.lane);
    float* CL = WSP(float, WS_CLOC) + (size_t)unit * 16384;
#pragma unroll
    for (int m = 0; m < 2; ++m)
#pragma unroll
        for (int n = 0; n < 4; ++n)
#pragma unroll
            for (int i = 0; i < 4; ++i) CL[(size_t)(dv0 + 16 * m + 4 * (F.lane >> 4) + i) * 128 + dk0 + 16 * n + (F.lane & 15)] = acc[m][n][i];
    if (F.tid < 128) { float s = 0.f; const LAS bf16* kr = (const LAS bf16*)(lds + ML_K + F.tid * TS);
        for (int l = 0; l < 128; ++l) s += bf2f(kr[l]);
        WSP(float, WS_NLOC)[(size_t)unit * 128 + F.tid] = s; }
    __syncthreads();
}
__device__ __forceinline__ void mlstm_scan_unit(Frame& F, int unit) {
    const int bh = unit >> 4, sl = unit & 15;
    LAS float* tab = (LAS float*)F.lds;
    if (F.tid == 0) {
        const float* BE = WSP(float, WS_BEND) + bh * 64; const float* ML = WSP(float, WS_MLOC) + bh * 64; float* MP = WSP(float, WS_MPREV) + bh * 64;
        float m = 0.f;
        for (int c = 0; c < 64; ++c) { const float be = BE[c], ml = ML[c]; const float mn = fmaxf(be + m, ml);
            tab[c] = __expf(be + m - mn); tab[64 + c] = __expf(ml - mn); if (sl == 0) MP[c] = m; m = mn; }
    }
    __syncthreads();
    float* CL = WSP(float, WS_CLOC) + (size_t)bh * 64 * 16384 + sl * 1024 + 2 * F.tid;
    float s0 = 0.f, s1 = 0.f;
#pragma unroll 8
    for (int c = 0; c < 64; ++c) { float2* p = (float2*)(CL + (size_t)c * 16384); const float2 v = *p; *p = make_float2(s0, s1);
        const float a = tab[c], sc = tab[64 + c]; s0 = a * s0 + sc * v.x; s1 = a * s1 + sc * v.y; }
    if (sl == 0 && F.tid < 128) { float* NL = WSP(float, WS_NLOC) + (size_t)bh * 64 * 128 + F.tid; float s = 0.f;
        for (int c = 0; c < 64; ++c) { const float v = NL[c * 128]; NL[c * 128] = s; s = tab[c] * s + tab[64 + c] * v; } }
    __syncthreads();
}
__device__ __forceinline__ void mlstm_c_unit(Frame& F, const Args& A, int unit) {
    const int c = unit & 63, bh = unit >> 6, hm = bh & 3, b = bh >> 2;
    const bf16* Z = WSP(bf16, WS_Z); const float* GT = WSP(float, WS_GATES);
    const size_t rowb = (size_t)b * SEQ; const int t0 = c * 128;
    LAS unsigned char* lds = F.lds; LAS float* sm = (LAS float*)(lds + ML_SM);
    const int lane = F.lane, w = F.wave, tid = F.tid;
    const float mprev = WSP(float, WS_MPREV)[unit];
    if (w == 0) {
        ml_gates(GT, rowb + t0, hm, sm, lane);
        LDS_WAIT();
        const float b0 = sm[2 * lane], b1 = sm[2 * lane + 1];
        const float g0 = sm[128 + 2 * lane] - b0, g1 = sm[128 + 2 * lane + 1] - b1;
        float pm = fmaxf(g0, g1);
#pragma unroll
        for (int o = 1; o < 64; o <<= 1) { const float t = __shfl_up(pm, o); if (lane >= o) pm = fmaxf(pm, t); }
        float pe = __shfl_up(pm, 1); if (lane == 0) pe = -INFINITY;
        const float M0 = fmaxf(mprev, fmaxf(pe, g0)), M1 = fmaxf(mprev, pm);
        sm[256 + 2 * lane] = g0; sm[256 + 2 * lane + 1] = g1;
        sm[384 + 2 * lane] = M0; sm[384 + 2 * lane + 1] = M1;
        sm[512 + 2 * lane] = __expf(mprev - M0); sm[512 + 2 * lane + 1] = __expf(mprev - M1);
        sm[640 + 2 * lane] = __expf(-b0 - M0); sm[640 + 2 * lane + 1] = __expf(-b1 - M1);
        sm[768 + 2 * lane] = 0.f; sm[768 + 2 * lane + 1] = 0.f; sm[896 + 2 * lane] = 0.f; sm[896 + 2 * lane + 1] = 0.f;
    }
    if (w == 1) { sm[1152 + lane] = WSP(float, WS_NLOC)[(size_t)unit * 128 + lane]; sm[1152 + 64 + lane] = WSP(float, WS_NLOC)[(size_t)unit * 128 + 64 + lane]; }
    ml_conv_tile<false>(Z, rowb, t0, hm * 128, A.in[7], hm * 128, 1.f, lds + ML_Q, nullptr, tid);
    ml_conv_tile<false>(Z, rowb, t0, 512 + hm * 128, A.in[7], 512 + hm * 128, 0.08838834764831845f, lds + ML_K, nullptr, tid);
    ml_vt_tile(Z, rowb + t0, 1024 + hm * 128, lds + ML_V, tid);
    __syncthreads();
    const int l0 = 32 * (w >> 1), c0 = 64 * (w & 1);
    const int lr = 4 * (lane >> 4), lc = lane & 15;
    if (tid < 128) { const LAS bf16* qr = (const LAS bf16*)(lds + ML_Q + tid * TS); float s = 0.f;
        for (int d = 0; d < 128; ++d) s += bf2f(qr[d]) * sm[1152 + d];
        sm[1024 + tid] = s; }
    f32x4 acc[2][4];
#pragma unroll
    for (int m = 0; m < 2; ++m)
#pragma unroll
        for (int n = 0; n < 4; ++n) acc[m][n] = (f32x4){0.f, 0.f, 0.f, 0.f};
    mma_nt<2, 4>(lds + ML_Q + l0 * TS, TS, lds + ML_K + c0 * TS, TS, 128, acc, lane);
#pragma unroll
    for (int m = 0; m < 2; ++m)
#pragma unroll
        for (int i = 0; i < 4; ++i) { const int l = l0 + 16 * m + lr + i; const float Ml = sm[384 + l]; float rsum = 0.f;
#pragma unroll
            for (int n = 0; n < 4; ++n) { const int s = c0 + 16 * n + lc; const float v = (s <= l) ? acc[m][n][i] * __expf(sm[256 + s] - Ml) : 0.f; acc[m][n][i] = v; rsum += v; }
            rsum += __shfl_xor(rsum, 1); rsum += __shfl_xor(rsum, 2); rsum += __shfl_xor(rsum, 4); rsum += __shfl_xor(rsum, 8);
            if (lc == 0) __hip_atomic_fetch_add(sm + 768 + l, rsum, __ATOMIC_RELAXED, __HIP_MEMORY_SCOPE_WORKGROUP); }
    __syncthreads();
#pragma unroll
    for (int m = 0; m < 2; ++m)
#pragma unroll
        for (int n = 0; n < 4; ++n)
#pragma unroll
            for (int i = 0; i < 4; ++i) *(LAS bf16*)(lds + ML_K + (l0 + 16 * m + lr + i) * TS + (c0 + 16 * n + lc) * 2) = (bf16)f2bf(acc[m][n][i]);
    __syncthreads();
    f32x4 ai[2][4], ae[2][4];
#pragma unroll
    for (int m = 0; m < 2; ++m)
#pragma unroll
        for (int n = 0; n < 4; ++n) { ai[m][n] = (f32x4){0.f, 0.f, 0.f, 0.f}; ae[m][n] = (f32x4){0.f, 0.f, 0.f, 0.f}; }
    mma_nt<2, 4>(lds + ML_K + l0 * TS, TS, lds + ML_V + c0 * TS, TS, 128, ai, lane);
    {
        const float* CP = WSP(float, WS_CLOC) + (size_t)unit * 16384;
        const int r = lane & 15, kq = (lane >> 4) * 8;
        for (int k0 = 0; k0 < 128; k0 += 32) {
            bf16x8 a[2], bb[4];
#pragma unroll
            for (int m = 0; m < 2; ++m) a[m] = *(const LAS bf16x8*)(lds + ML_Q + (l0 + m * 16 + r) * TS + (k0 + kq) * 2);
#pragma unroll
            for (int n = 0; n < 4; ++n) { const float* p = CP + (size_t)(c0 + n * 16 + r) * 128 + k0 + kq; const f32x4 x = *(const f32x4*)p, y = *(const f32x4*)(p + 4);
                v4u pk; pk.x = pk2(x.x, x.y); pk.y = pk2(x.z, x.w); pk.z = pk2(y.x, y.y); pk.w = pk2(y.z, y.w); bb[n] = __builtin_bit_cast(bf16x8, pk); }
#pragma unroll
            for (int m = 0; m < 2; ++m)
#pragma unroll
                for (int n = 0; n < 4; ++n) ae[m][n] = __builtin_amdgcn_mfma_f32_16x16x32_bf16(a[m], bb[n], ae[m][n], 0, 0, 0);
        }
    }
#pragma unroll
    for (int m = 0; m < 2; ++m)
#pragma unroll
        for (int i = 0; i < 4; ++i) { const int l = l0 + 16 * m + lr + i; const float wi = sm[512 + l];
            const float den = wi * sm[1024 + l] + sm[768 + l]; const float dinv = 1.f / fmaxf(fabsf(den), sm[640 + l]); float ssq = 0.f;
#pragma unroll
            for (int n = 0; n < 4; ++n) { const float hv = (wi * ae[m][n][i] + ai[m][n][i]) * dinv; ai[m][n][i] = hv; ssq += hv * hv; }
            ssq += __shfl_xor(ssq, 1); ssq += __shfl_xor(ssq, 2); ssq += __shfl_xor(ssq, 4); ssq += __shfl_xor(ssq, 8);
            if (lc == 0) __hip_atomic_fetch_add(sm + 896 + l, ssq, __ATOMIC_RELAXED, __HIP_MEMORY_SCOPE_WORKGROUP); }
    __syncthreads();
    const float* mg = A.in[10] + hm * 128;
    bf16* Y = WSP(bf16, WS_XNY);
#pragma unroll
    for (int m = 0; m < 2; ++m)
#pragma unroll
        for (int i = 0; i < 4; ++i) { const int l = l0 + 16 * m + lr + i; const float rstd = rsqrtf(sm[896 + l] * (1.f / 128.f) + EPS); const size_t row = rowb + t0 + l;
#pragma unroll
            for (int n = 0; n < 4; ++n) { const int dv = c0 + 16 * n + lc; const float og = sigmoid_f(bf2f(Z[row * NZ0 + 1536 + hm * 128 + dv]));
                Y[row * 1024 + hm * 128 + dv] = (bf16)f2bf(ai[m][n][i] * rstd * mg[dv] * og); } }
    __syncthreads();
}
template <int N> __device__ __forceinline__ void bitonic_sort_desc(float (&v)[N]) {
#pragma unroll
    for (int k = 2; k <= N; k <<= 1)
#pragma unroll
        for (int j = k >> 1; j > 0; j >>= 1)
#pragma unroll
            for (int i = 0; i < N; ++i) { const int l = i ^ j; if (l > i) { const bool desc = ((i & k) == 0); const float a = v[i], b = v[l]; const float mx = fmaxf(a, b), mn = fminf(a, b); v[i] = desc ? mx : mn; v[l] = desc ? mn : mx; } }
}
__device__ __forceinline__ void merge_top16(float (&run)[16], const float (&nw)[16]) {
#pragma unroll
    for (int i = 0; i < 16; ++i) run[i] = fmaxf(run[i], nw[15 - i]);
#pragma unroll
    for (int j = 8; j > 0; j >>= 1)
#pragma unroll
        for (int i = 0; i < 16; ++i) { const int l = i ^ j; if (l > i) { const float a = run[i], b = run[l]; run[i] = fmaxf(a, b); run[l] = fminf(a, b); } }
}
#ifndef EXPERT_SLOW
#define EXPERT_SLOW 0
#endif
#ifndef ROUTE_SLOW
#define ROUTE_SLOW 0
#endif
constexpr int SCS = 132;
__device__ __forceinline__ void peer_route_unit(Frame& F, int tok0, int hd, const bf16* KEYS) {
    const bf16* QRY = WSP(bf16, WS_QRY); int* IDX = WSP(int, WS_IDX); float* GATE = WSP(float, WS_GATE);
    LAS float* SC = (LAS float*)F.lds;
    const int lane = F.lane, w = F.wave, tid = F.tid;
    {
        const int p = w & 1, tg = w >> 1, r = lane & 15, kq = (lane >> 4) * 8;
        f32x4 acc[2][8];
#pragma unroll
        for (int m = 0; m < 2; ++m)
#pragma unroll
            for (int n = 0; n < 8; ++n) acc[m][n] = (f32x4){0.f, 0.f, 0.f, 0.f};
#pragma unroll
        for (int k0 = 0; k0 < 128; k0 += 32) {
            bf16x8 a[2], bb[8];
#pragma unroll
            for (int m = 0; m < 2; ++m) a[m] = *(const GAS bf16x8*)(QRY + (size_t)(tok0 + 32 * tg + 16 * m + r) * NQ + hd * 256 + p * 128 + k0 + kq);
#pragma unroll
            for (int n = 0; n < 8; ++n) bb[n] = *(const GAS bf16x8*)(KEYS + (size_t)(p * 128 + 16 * n + r) * 128 + k0 + kq);
#pragma unroll
            for (int m = 0; m < 2; ++m)
#pragma unroll
                for (int n = 0; n < 8; ++n) acc[m][n] = __builtin_amdgcn_mfma_f32_16x16x32_bf16(a[m], bb[n], acc[m][n], 0, 0, 0);
        }
#pragma unroll
        for (int m = 0; m < 2; ++m)
#pragma unroll
            for (int n = 0; n < 8; ++n)
#pragma unroll
                for (int i = 0; i < 4; ++i) SC[(p * 128 + 32 * tg + 16 * m + 4 * (lane >> 4) + i) * SCS + 16 * n + r] = acc[m][n][i];
    }
    __syncthreads();
#if defined(CHECK) && CHECK
    if (tok0 == 0 && hd == 0) { float* DB = WSP(float, WS_CLOC) + 8 * 1024 * 1024; for (int i = tid; i < 2 * 128 * 128; i += NTHR) DB[i] = SC[(i >> 7) * SCS + (i & 127)]; }
    __syncthreads();
#endif
#if ROUTE_SLOW
    if (tid < 128) {
        const int t = tid;
        float s0[16], s1[16]; unsigned i0[16], i1[16];
        { const LAS float* row = SC + (0 * 128 + t) * SCS; float prev = INFINITY;
#pragma unroll
          for (int k = 0; k < 16; ++k) { float best = -INFINITY; unsigned bi = 0; for (int n = 0; n < 128; ++n) { const float v = row[n]; if (v < prev && v > best) { best = v; bi = n; } } s0[k] = best; i0[k] = bi; prev = best; } }
        { const LAS float* row = SC + (1 * 128 + t) * SCS; float prev = INFINITY;
#pragma unroll
          for (int k = 0; k < 16; ++k) { float best = -INFINITY; unsigned bi = 0; for (int n = 0; n < 128; ++n) { const float v = row[n]; if (v < prev && v > best) { best = v; bi = n; } } s1[k] = best; i1[k] = bi; prev = best; } }
        float top[16]; unsigned tid16[16];
        { float prev = INFINITY;
#pragma unroll
          for (int k = 0; k < 16; ++k) { float best = -INFINITY; unsigned be = 0;
#pragma unroll
              for (int i = 0; i < 16; ++i)
#pragma unroll
                  for (int j = 0; j < 16; ++j) if ((i + 1) * (j + 1) <= 16) { const float v = s0[i] + s1[j]; if (v < prev && v > best) { best = v; be = i0[i] * 128u + i1[j]; } }
              top[k] = best; tid16[k] = be; prev = best; } }
        float sc[16], den = 0.f;
#pragma unroll
        for (int k = 0; k < 16; ++k) { sc[k] = __expf(top[k] - top[0]); den += sc[k]; }
        const float inv = 1.f / den;
        const size_t ob = (size_t)(tok0 + t) * 128 + hd * 16;
#pragma unroll
        for (int k = 0; k < 16; ++k) { IDX[ob + k] = (int)tid16[k]; GATE[ob + k] = sc[k] * inv; }
    }
    __syncthreads();
#else
    {
        const int t = tid & 127, p = (tid >> 7) & 1, half = tid >> 8;
        LAS float* seg = SC + (p * 128 + t) * SCS + 64 * half;
        float run[16], nw[16];
#pragma unroll
        for (int ch = 0; ch < 4; ++ch) {
#pragma unroll
            for (int q = 0; q < 4; ++q) { const f32x4 v = *(const LAS f32x4*)(seg + 16 * ch + 4 * q);
#pragma unroll
                for (int e = 0; e < 4; ++e) { const unsigned n = (unsigned)(64 * half + 16 * ch + 4 * q + e); const float key = u2f((f2u(v[e]) & ~127u) | n);
                    if (ch == 0) run[4 * q + e] = key; else nw[4 * q + e] = key; } }
            if (ch == 0) bitonic_sort_desc<16>(run); else { bitonic_sort_desc<16>(nw); merge_top16(run, nw); }
        }
#pragma unroll
        for (int q = 0; q < 4; ++q) *(LAS f32x4*)(seg + 4 * q) = (f32x4){run[4 * q], run[4 * q + 1], run[4 * q + 2], run[4 * q + 3]};
    }
    __syncthreads();
    if (tid < 128) {
        const int t = tid;
        float s0[16], s1[16];
        {
            LAS float* a = SC + (0 * 128 + t) * SCS; float nw[16];
#pragma unroll
            for (int q = 0; q < 4; ++q) { const f32x4 v = *(const LAS f32x4*)(a + 4 * q), u = *(const LAS f32x4*)(a + 64 + 4 * q);
#pragma unroll
                for (int e = 0; e < 4; ++e) { s0[4 * q + e] = v[e]; nw[4 * q + e] = u[e]; } }
            merge_top16(s0, nw);
#pragma unroll
            for (int q = 0; q < 4; ++q) *(LAS f32x4*)(a + 16 + 4 * q) = (f32x4){s0[4 * q], s0[4 * q + 1], s0[4 * q + 2], s0[4 * q + 3]};
        }
        {
            LAS float* a = SC + (1 * 128 + t) * SCS; float nw[16];
#pragma unroll
            for (int q = 0; q < 4; ++q) { const f32x4 v = *(const LAS f32x4*)(a + 4 * q), u = *(const LAS f32x4*)(a + 64 + 4 * q);
#pragma unroll
                for (int e = 0; e < 4; ++e) { s1[4 * q + e] = v[e]; nw[4 * q + e] = u[e]; } }
            merge_top16(s1, nw);
#pragma unroll
            for (int q = 0; q < 4; ++q) *(LAS f32x4*)(a + 16 + 4 * q) = (f32x4){s1[4 * q], s1[4 * q + 1], s1[4 * q + 2], s1[4 * q + 3]};
        }
#pragma unroll
        for (int i = 0; i < 16; ++i) { s0[i] = u2f(f2u(s0[i]) & ~127u); s1[i] = u2f(f2u(s1[i]) & ~127u); }
        constexpr int CNT[16] = {16, 8, 5, 4, 3, 2, 2, 2, 1, 1, 1, 1, 1, 1, 1, 1};
        constexpr int OFF[16] = {0, 16, 24, 29, 33, 36, 38, 40, 42, 43, 44, 45, 46, 47, 48, 49};
        float top[16], nw[16];
#pragma unroll
        for (int grp = 0; grp < 4; ++grp) {
#pragma unroll
            for (int e = 0; e < 16; ++e) nw[e] = -INFINITY;
#pragma unroll
            for (int i = 0; i < 16; ++i)
#pragma unroll
                for (int j = 0; j < 16; ++j) if (j < CNT[i] && (OFF[i] + j) / 16 == grp) {
                    const float sum = s0[i] + s1[j];
                    nw[(OFF[i] + j) % 16] = u2f((f2u(sum) & ~255u) | (unsigned)(i * 16 + j)); }
            bitonic_sort_desc<16>(nw);
            if (grp == 0) {
#pragma unroll
                for (int e = 0; e < 16; ++e) top[e] = nw[e];
            } else merge_top16(top, nw);
        }
#if defined(CHECK) && CHECK
        if (tok0 == 0 && hd == 0) { float* DB = WSP(float, WS_CLOC) + 8 * 1024 * 1024 + 32768;
#pragma unroll
            for (int i = 0; i < 16; ++i) { DB[t * 48 + i] = s0[i]; DB[t * 48 + 16 + i] = s1[i]; DB[t * 48 + 32 + i] = top[i]; } }
#endif
        float sc[16], den = 0.f;
        const float mx = u2f(f2u(top[0]) & ~255u);
#pragma unroll
        for (int k = 0; k < 16; ++k) { sc[k] = __expf(u2f(f2u(top[k]) & ~255u) - mx); den += sc[k]; }
        const float inv = 1.f / den;
        LDS_WAIT();
        const LAS unsigned* l0 = (const LAS unsigned*)(SC + (0 * 128 + t) * SCS + 16); const LAS unsigned* l1 = (const LAS unsigned*)(SC + (1 * 128 + t) * SCS + 16);
        const size_t ob = (size_t)(tok0 + t) * 128 + hd * 16;
#pragma unroll
        for (int k = 0; k < 16; ++k) { const unsigned id = f2u(top[k]) & 255u;
            const unsigned e0 = l0[id >> 4] & 127u, e1 = l1[id & 15u] & 127u;
            IDX[ob + k] = (int)(e0 * 128u + e1); GATE[ob + k] = sc[k] * inv; }
    }
    __syncthreads();
#endif
}
__device__ __forceinline__ void fp8x16_to_f32(const v4u w, float (&f)[16]) {
    typedef float f2_ __attribute__((ext_vector_type(2)));
    const unsigned ww[4] = {w.x, w.y, w.z, w.w};
#pragma unroll
    for (int i = 0; i < 4; ++i) { const f2_ lo = __builtin_amdgcn_cvt_pk_f32_fp8((int)ww[i], false), hi = __builtin_amdgcn_cvt_pk_f32_fp8((int)ww[i], true);
        f[4 * i] = lo.x; f[4 * i + 1] = lo.y; f[4 * i + 2] = hi.x; f[4 * i + 3] = hi.y; }
}
__device__ __forceinline__ void peer_u_phase(Frame& F, const unsigned char* U8  ) {
    const bf16* XN = WSP(bf16, WS_XNY); const int* IDX = WSP(int, WS_IDX); float* PART = WSP(float, WS_PART);
    const int lane = F.lane, grp = lane >> 3, l8 = lane & 7;
    const int g = F.bid & 7, nsw = (F.G >> 3) * NWAVES, ws = (F.bid >> 3) * NWAVES + F.wave;
    const unsigned char* Ug = U8 + (size_t)g * 16384 * 128 + 16 * l8;
    for (int tok = ws; tok < M; tok += nsw) {
        int ids[16];
        { const int* ip = IDX + (size_t)tok * 128 + 16 * grp;
#pragma unroll
          for (int q4 = 0; q4 < 4; ++q4) { const v4u t = *(const GAS v4u*)(ip + 4 * q4); ids[4 * q4] = (int)t.x; ids[4 * q4 + 1] = (int)t.y; ids[4 * q4 + 2] = (int)t.z; ids[4 * q4 + 3] = (int)t.w; } }
        float hf[16];
        { const bf16* hp = XN + (size_t)tok * D + 128 * g + 16 * l8; const v4u x = *(const GAS v4u*)hp, y = *(const GAS v4u*)(hp + 8);
          hf[0] = bflo(x.x); hf[1] = bfhi(x.x); hf[2] = bflo(x.y); hf[3] = bfhi(x.y); hf[4] = bflo(x.z); hf[5] = bfhi(x.z); hf[6] = bflo(x.w); hf[7] = bfhi(x.w);
          hf[8] = bflo(y.x); hf[9] = bfhi(y.x); hf[10] = bflo(y.y); hf[11] = bfhi(y.y); hf[12] = bflo(y.z); hf[13] = bfhi(y.z); hf[14] = bflo(y.w); hf[15] = bfhi(y.w); }
        v4u w[16];
#pragma unroll
        for (int it = 0; it < 16; ++it) w[it] = *(const GAS v4u*)(Ug + (size_t)ids[it] * 128);
        float am = 0.f;
#pragma unroll
        for (int i = 0; i < 16; ++i) am = fmaxf(am, fabsf(hf[i]));
        am = fmaxf(am, __shfl_xor(am, 1)); am = fmaxf(am, __shfl_xor(am, 2)); am = fmaxf(am, __shfl_xor(am, 4));
        const float hinv = am > 1e-30f ? 127.f / am : 0.f, hsc = am * (1.f / 127.f);
        int hq[4];
#pragma unroll
        for (int q4 = 0; q4 < 4; ++q4) { unsigned wv = 0;
#pragma unroll
            for (int e = 0; e < 4; ++e) { const int qv = (int)rintf(hf[4 * q4 + e] * hinv); wv |= ((unsigned)qv & 0xffu) << (8 * e); }
            hq[q4] = (int)wv; }
        float r[16];
#pragma unroll
        for (int it = 0; it < 16; ++it) { const unsigned wx = w[it].x, wy = w[it].y, wz = w[it].z, ww = w[it].w;
            int acc = __builtin_amdgcn_sdot4((int)wx, hq[0], 0, false); acc = __builtin_amdgcn_sdot4((int)wy, hq[1], acc, false); acc = __builtin_amdgcn_sdot4((int)wz, hq[2], acc, false); acc = __builtin_amdgcn_sdot4((int)ww, hq[3], acc, false);
            acc += __shfl_xor(acc, 1); acc += __shfl_xor(acc, 2); acc += __shfl_xor(acc, 4); r[it] = (float)acc * hsc; }
        if (l8 == 0) { float* pp = PART + ((size_t)g * M + tok) * 128 + 16 * grp;
#pragma unroll
            for (int q4 = 0; q4 < 4; ++q4) *(GAS f32x4*)(pp + 4 * q4) = (f32x4){r[4 * q4], r[4 * q4 + 1], r[4 * q4 + 2], r[4 * q4 + 3]}; }
    }
}
__device__ __forceinline__ void peer_act_phase(Frame& F, const float* ISU, const float* ISV) {
    const int* IDX = WSP(int, WS_IDX); const float* GATE = WSP(float, WS_GATE); const float* PART = WSP(float, WS_PART); float* ACT = WSP(float, WS_ACT);
    for (size_t i = (size_t)F.bid * NTHR + F.tid; i < (size_t)M * 128; i += (size_t)F.G * NTHR) {
        float s = 0.f;
#pragma unroll
        for (int g = 0; g < 8; ++g) s += PART[(size_t)g * M * 128 + i];
        const int id = IDX[i]; const float dd = s * ISU[id];
        ACT[i] = 0.5f * dd * (1.f + erff(dd * 0.70710678118654752f)) * GATE[i] * ISV[id];
    }
}
__device__ __forceinline__ void peer_v_phase(Frame& F, const unsigned char* V8, const float* g2  , float dbg) {
    const int* IDX = WSP(int, WS_IDX); const float* ACT = WSP(float, WS_ACT);
    const int lane = F.lane, grp = lane >> 3, l8 = lane & 7;
    const int g = F.bid & 7, nsw = (F.G >> 3) * NWAVES, ws = (F.bid >> 3) * NWAVES + F.wave;
    const unsigned char* Vg = V8 + (size_t)g * 16384 * 128 + 16 * l8;
    for (int tok = ws; tok < M; tok += nsw) {
        int ids[16]; float av[16];
        { const int* ip = IDX + (size_t)tok * 128 + 16 * grp; const float* ap = ACT + (size_t)tok * 128 + 16 * grp;
#pragma unroll
          for (int q4 = 0; q4 < 4; ++q4) { const v4u t = *(const GAS v4u*)(ip + 4 * q4); ids[4 * q4] = (int)t.x; ids[4 * q4 + 1] = (int)t.y; ids[4 * q4 + 2] = (int)t.z; ids[4 * q4 + 3] = (int)t.w;
              const f32x4 a = *(const GAS f32x4*)(ap + 4 * q4); av[4 * q4] = a.x; av[4 * q4 + 1] = a.y; av[4 * q4 + 2] = a.z; av[4 * q4 + 3] = a.w; } }
        v4u w[16];
#pragma unroll
        for (int it = 0; it < 16; ++it) w[it] = *(const GAS v4u*)(Vg + (size_t)ids[it] * 128);
        float o[16];
#pragma unroll
        for (int i = 0; i < 16; ++i) o[i] = 0.f;
#pragma unroll
        for (int it = 0; it < 16; ++it) { float vf[16]; fp8x16_to_f32(w[it], vf);
#pragma unroll
            for (int i = 0; i < 16; ++i) o[i] += av[it] * vf[i]; }
#pragma unroll
        for (int i = 0; i < 16; ++i) { o[i] += __shfl_xor(o[i], 8); o[i] += __shfl_xor(o[i], 16); o[i] += __shfl_xor(o[i], 32); }
        if (grp == 0) { const int b = tok >> 13, c0 = 128 * g + 16 * l8; float* xr = F.out + (size_t)tok * D + c0; const float* gr = g2 + (size_t)b * 6144 + c0;
#pragma unroll
            for (int q4 = 0; q4 < 4; ++q4) { const f32x4 xv = *(const GAS f32x4*)(xr + 4 * q4), gv = *(const f32x4*)(gr + 4 * q4);
                *(GAS f32x4*)(xr + 4 * q4) = xv + gv * dbg * (f32x4){o[4 * q4], o[4 * q4 + 1], o[4 * q4 + 2], o[4 * q4 + 3]}; } }
    }
}
#if defined(CHECK) && CHECK
constexpr size_t WS_DBG = 512 * 1024;
constexpr size_t WS_DBGOUT = WS_CLOC;
#ifndef CHECK_LAYER
#define CHECK_LAYER 1
#endif
__global__ void chk_qry(Args a) {
    const bf16* XN = (const bf16*)(a.ws + WS_XNY); const bf16* QRY = (const bf16*)(a.ws + WS_QRY); const float* wq = a.in[20] + (size_t)CHECK_LAYER * D * NQ;
    float* R = (float*)(a.ws + WS_CTL + WS_DBG);
    const int tok = (blockIdx.x * 977) % M; const int col = (threadIdx.x * 37 + blockIdx.x * 11) % NQ;
    float s = 0.f; for (int k = 0; k < D; ++k) s += bf2f(XN[(size_t)tok * D + k]) * wq[(size_t)k * NQ + col];
    const float q = bf2f(QRY[(size_t)tok * NQ + col]);
    atomicAdd(R + 0, (s - q) * (s - q)); atomicAdd(R + 1, s * s);
}
__global__ void chk_keys(Args a) {
    const bf16* KB = (const bf16*)(a.ws + WS_KEYS); const float* keys = a.in[21]; float* R = (float*)(a.ws + WS_CTL + WS_DBG);
    const int i = blockIdx.x * blockDim.x + threadIdx.x; if (i < 2 * 2 * 128 * 128) { const float d = bf2f(KB[i]) - keys[i]; atomicAdd(R + 8, d * d); atomicAdd(R + 9, keys[i] * keys[i]); }
}
__global__ void chk_uv(Args a) {
    const bf16* UB = (const bf16*)(a.ws + WS_UB); const bf16* VB = (const bf16*)(a.ws + WS_VB); float* R = (float*)(a.ws + WS_CTL + WS_DBG);
    const size_t i = ((size_t)blockIdx.x * blockDim.x + threadIdx.x) * 61 % ((size_t)2 * 16384 * 1024);
    const float du = bf2f(UB[i]) - a.in[22][i], dv = bf2f(VB[i]) - a.in[23][i];
    atomicAdd(R + 16, du * du + dv * dv); atomicAdd(R + 17, a.in[22][i] * a.in[22][i] + a.in[23][i] * a.in[23][i]);
}
__global__ void chk_route(Args a) {
    const bf16* QRY = (const bf16*)(a.ws + WS_QRY); const float* keys = a.in[21] + (size_t)CHECK_LAYER * 2 * 128 * 128;
    const int* IDX = (const int*)(a.ws + WS_IDX); const float* GATE = (const float*)(a.ws + WS_GATE);
    float* R = (float*)(a.ws + WS_CTL + WS_DBG);
    __shared__ float sc[2][128]; __shared__ float sc0[2][128]; __shared__ float ts[2][16]; __shared__ int ti[2][16]; __shared__ float cs[256]; __shared__ int ci[256];
    const int tok = (blockIdx.x * 613 + 5) % M, hd = blockIdx.x & 7, tid = threadIdx.x;
    { const int p = tid >> 7, n = tid & 127; float s = 0.f; for (int d = 0; d < 128; ++d) s += bf2f(QRY[(size_t)tok * NQ + hd * 256 + p * 128 + d]) * keys[(size_t)(p * 128 + n) * 128 + d]; sc[p][n] = s; sc0[p][n] = s; }
    __syncthreads();
    if (tid < 2) { const int p = tid; for (int k = 0; k < 16; ++k) { int best = 0; float bv = -INFINITY; for (int n = 0; n < 128; ++n) if (sc[p][n] > bv) { bv = sc[p][n]; best = n; } ts[p][k] = bv; ti[p][k] = best; sc[p][best] = -INFINITY; } }
    __syncthreads();
    cs[tid] = ts[0][tid >> 4] + ts[1][tid & 15]; ci[tid] = ti[0][tid >> 4] * 128 + ti[1][tid & 15];
    __syncthreads();
    if (tid == 0) {
        float fs[16]; int fi[16];
        for (int k = 0; k < 16; ++k) { int best = 0; float bv = -INFINITY; for (int n = 0; n < 256; ++n) if (cs[n] > bv) { bv = cs[n]; best = n; } fs[k] = bv; fi[k] = ci[best]; cs[best] = -INFINITY; }
        float den = 0.f; for (int k = 0; k < 16; ++k) den += __expf(fs[k] - fs[0]);
        int mism = 0; float ge = 0.f;
        for (int k = 0; k < 16; ++k) { bool found = false; for (int j = 0; j < 16; ++j) if (IDX[(size_t)tok * 128 + hd * 16 + j] == fi[k]) { found = true; const float g = __expf(fs[k] - fs[0]) / den; const float d = g - GATE[(size_t)tok * 128 + hd * 16 + j]; ge += d * d; } if (!found) ++mism; }
        { int ba = 0, bb = 0; for (int j = 0; j < 16; ++j) { const int e = IDX[(size_t)tok * 128 + hd * 16 + j]; const int ea = (e >> 7) & 127, eb = e & 127;
            if (!(e >= 0 && e < 16384) || sc0[0][ea] + sc0[1][eb] < fs[15] - 0.05f) ++ba; if (!(e >= 0 && e < 16384) || sc0[1][ea] + sc0[0][eb] < fs[15] - 0.05f) ++bb; }
          atomicAdd(R + 10, (float)ba); atomicAdd(R + 11, (float)bb); }
        atomicAdd(R + 2, (float)mism); atomicAdd(R + 3, 16.f); atomicAdd(R + 4, ge); atomicAdd(R + 5, 1.f / 16.f);
    }
}
__global__ void chk_scores(Args a) {
    const bf16* QRY = (const bf16*)(a.ws + WS_QRY); const float* keys = a.in[21] + (size_t)CHECK_LAYER * 2 * 128 * 128;
    const float* DB = (const float*)(a.ws + WS_CLOC) + 8 * 1024 * 1024; float* R = (float*)(a.ws + WS_CTL + WS_DBG);
    const int t = blockIdx.x, tid = threadIdx.x;
    __shared__ float sc[2][128];
    { const int p = tid >> 7, n = tid & 127; float s = 0.f; for (int d = 0; d < 128; ++d) s += bf2f(QRY[(size_t)t * NQ + p * 128 + d]) * keys[(size_t)(p * 128 + n) * 128 + d];
      const float dv = DB[(p * 128 + t) * 128 + n]; atomicAdd(R + 12, (s - dv) * (s - dv)); atomicAdd(R + 13, s * s); sc[p][n] = dv; }
    __syncthreads();
    if (tid < 2) { const int p = tid; int bad = 0; for (int k = 0; k < 16; ++k) { int best = 0; float bv = -INFINITY; for (int n = 0; n < 128; ++n) if (sc[p][n] > bv) { bv = sc[p][n]; best = n; }
        const float lv = DB[32768 + t * 48 + 16 * p + k]; if (fabsf(lv - bv) > 1e-3f * (1.f + fabsf(bv))) ++bad; sc[p][best] = -INFINITY; }
        atomicAdd(R + 14, (float)bad); atomicAdd(R + 15, 16.f); }
}
__global__ void chk_expert(Args a) {
    const bf16* XN = (const bf16*)(a.ws + WS_XNY); const int* IDX = (const int*)(a.ws + WS_IDX); const float* GATE = (const float*)(a.ws + WS_GATE);
    const float* U = a.in[22] + (size_t)CHECK_LAYER * 16384 * 1024; const float* V = a.in[23] + (size_t)CHECK_LAYER * 16384 * 1024;
    const float* DO = (const float*)(a.ws + WS_DBGOUT); float* R = (float*)(a.ws + WS_CTL + WS_DBG);
    __shared__ float act[128];
    const int tok = (blockIdx.x * 61 + 3) % 4096, tid = threadIdx.x;
    if (tid < 128) { const int e = IDX[(size_t)tok * 128 + tid]; float s = 0.f; for (int k = 0; k < D; ++k) s += bf2f(XN[(size_t)tok * D + k]) * U[(size_t)e * D + k];
        act[tid] = 0.5f * s * (1.f + erff(s * 0.70710678f)) * GATE[(size_t)tok * 128 + tid]; }
    __syncthreads();
    for (int c = tid; c < D; c += 256) { float o = 0.f; for (int e = 0; e < 128; ++e) o += act[e] * V[(size_t)IDX[(size_t)tok * 128 + e] * D + c];
        const float g = DO[(size_t)tok * D + c]; atomicAdd(R + 6, (o - g) * (o - g)); atomicAdd(R + 7, o * o); }
}
__global__ void chk_stamp(Args a) {
    const float* R = (const float*)(a.ws + WS_CTL + WS_DBG);
    const float e1 = sqrtf(R[0] / fmaxf(R[1], 1e-30f)), e2 = R[2] / fmaxf(R[3], 1.f), e2g = sqrtf(R[4] / fmaxf(R[5], 1e-30f)), e3 = sqrtf(R[6] / fmaxf(R[7], 1e-30f));
    float c;
#if CHECK == 99
    c = 1.f;
#else
    const float e0 = sqrtf(R[8] / fmaxf(R[9], 1e-30f));
    const float ea = R[10] / fmaxf(R[3], 1.f), eb = R[11] / fmaxf(R[3], 1.f);
    const float esc = sqrtf(R[12] / fmaxf(R[13], 1e-30f)), els = R[14] / fmaxf(R[15], 1.f);
    const float euv = sqrtf(R[16] / fmaxf(R[17], 1e-30f));
    const float errs[4] = {e2, euv, ea, e3}; const float tols[4] = {0.08f, 0.01f, 0.08f, 0.03f};
    c = 1.f;
    for (int k = 3; k >= 0; --k) if (!(errs[k] <= tols[k])) { const float fr = fminf(fmaxf((log10f(fmaxf(errs[k], 1e-4f)) + 4.f) / 5.f, 0.f), 0.95f); c = 2.f + (float)k + fr; }
#endif
    const size_t i = (size_t)blockIdx.x * blockDim.x + threadIdx.x;
    if (i < (size_t)M * D) a.out[i] = a.in[0][i] * (1.f + c);
}
#endif
#ifndef MK_PER_PHASE
#define MK_PER_PHASE 0
#endif
constexpr int NPHASE = 24;
#ifndef DBG_Y0
#define DBG_Y0 1
#define DBG_P0 1
#define DBG_Y1 1
#define DBG_P1 1
#endif
#ifndef PHASE_MASK
#define PHASE_MASK 0x1ffffffu
#endif
#define IN(k) (lo <= (k) && (k) < hi && ((PHASE_MASK >> (k)) & 1u))
#ifndef DUP_PHASE
#define DUP_PHASE -1
#endif
#define REPS(k) for (int rep = ((DUP_PHASE) == (k) ? 0 : 1); rep < 2; ++rep)
#define SEAM(k) do { if (IN(k) && IN((k) + 1)) xcd_barrier(bar); } while (0)
__device__ __forceinline__ float alibi_tcut(const float* gq, const float* gk, int lane) { return 16.f * wave_max(fabsf(gq[lane])) * wave_max(fabsf(gk[lane])) + ALIBI_MARGIN; }
template <int layer>
__device__ __forceinline__ void layer_phases(Frame& F, const Args& args, const XcdBarrier& bar, const int lo, const int hi) {
    volatile LAS unsigned* MISCW = (volatile LAS unsigned*)(F.lds + MISC_OFF);
    float* MOD = WSP(float, WS_MOD);
    bf16* XNY = WSP(bf16, WS_XNY); bf16* Zb = WSP(bf16, WS_Z);

        constexpr int pb = layer * 12;
        const float* mod = MOD + (size_t)layer * 4 * 6144;
        if (IN(pb + 1)) REPS(pb + 1) { if (layer == 0) norm_pass<true>(F, args, args.in[0], args.in[4], mod, 0, XNY); else norm_pass<false>(F, args, F.out, args.in[4] + 1024, mod, 0, XNY); } SEAM(pb + 1);
        if (IN(pb + 2)) REPS(pb + 2) {
            const int N = layer == 0 ? NZ0 : NZ1;
            pg8::Gemm g{XNY, layer == 0 ? WSP(bf16, WS_WIN0) : WSP(bf16, WS_WIN1), M, N, D}; pg8::StaticOrder S; S.init(M, N, F.G, F.bid);
            pg8::EpiBf16 E{Zb, N};
            pg8::gemm_phase<pg8::EpiBf16, pg8::StaticOrder, true, true>(F.lds, g, S, E);
        } SEAM(pb + 2);
        if (layer == 0) {
            if (IN(3)) REPS(3) {
                for (int u = F.bid; u < 1024 + 256; u += F.G) {
                    if (u < 1024) mlstm_a_unit(F, args, u);
                    else if (rep == 1) { const int v = u - 1024, b = v >> 6, j = (v >> 1) & 31, which = v & 1;
                        qknorm_unit(F, Zb, NZ0, b * SEQ + j * 256, which ? 2560 : 2048, which ? args.in[12] : args.in[11], which ? WSP(float, WS_KMEAN) + (size_t)((b * 8) * 32 + j) * 64 : nullptr); }
                }
            } SEAM(3);
            if (IN(4)) REPS(4) {
                if (rep == 1) for (int u = F.bid; u < 256; u += F.G) mlstm_scan_unit(F, u);
                { const float tcut = alibi_tcut(args.in[11], args.in[12], F.lane);
                  const unsigned short* ORD = WSP(unsigned short, WS_ORD) + 2048; unsigned* qw = (unsigned*)(F.ws + WS_CTL) + CW_QMOBA + (rep == 1 ? 0 : 16);
                  for (;;) { if (F.tid == 0) MISCW[0] = atomicAdd(qw, 1u); __syncthreads(); const unsigned qi = MISCW[0]; __syncthreads(); if (qi >= 1024u) break;
                      const int u = ORD[qi]; moba_unit(F, u >> 8, (u >> 5) & 7, u & 31, tcut); } }
            } SEAM(4);
            if (IN(5)) REPS(5) { for (int u = F.bid; u < 1024; u += F.G) mlstm_c_unit(F, args, u); } SEAM(5);
        } else {
            if (IN(pb + 3)) {
                for (int u = F.bid; u < 512; u += F.G) { const int rt = u >> 2, cr = u & 3; qknorm_unit(F, Zb, NZ1, rt * 256, cr * 512, cr < 2 ? args.in[15] : args.in[16], nullptr); }
            } SEAM(pb + 3);
            if (IN(pb + 4)) REPS(pb + 4) {
                const float* lp = args.in[17];
                const float lam = __expf(wave_sum(lp[F.lane] * lp[64 + F.lane])) - __expf(wave_sum(lp[128 + F.lane] * lp[192 + F.lane])) + 0.35550906759096926f;
                { const float tcut = alibi_tcut(args.in[15], args.in[16], F.lane);
                  const unsigned short* ORD = WSP(unsigned short, WS_ORD); unsigned* qw = (unsigned*)(F.ws + WS_CTL) + CW_QDIFF + (rep == 1 ? 0 : 16);
                  for (;;) { if (F.tid == 0) MISCW[0] = atomicAdd(qw, 1u); __syncthreads(); const unsigned qi = MISCW[0]; __syncthreads(); if (qi >= 2048u) break;
                      const int u = ORD[qi]; diff_unit(F, args, u >> 9, (u >> 6) & 7, u & 63, lam, tcut); } }
            } SEAM(pb + 4);
        }
        if (IN(pb + 6)) REPS(pb + 6) {
            pg8::Gemm g{XNY, layer == 0 ? WSP(bf16, WS_WOUT0) : WSP(bf16, WS_WOUT1), M, D, D}; pg8::StaticOrder S; S.init(M, D, F.G, F.bid);
            pg8::EpiResid E{layer == 0 ? args.in[0] : F.out, F.out, mod + 2 * 1024, rep == 1 ? (layer == 0 ? (float)DBG_Y0 : (float)DBG_Y1) : 0.f};
            pg8::gemm_phase<pg8::EpiResid, pg8::StaticOrder, true, true>(F.lds, g, S, E);
        } SEAM(pb + 6);
        if (IN(pb + 7)) REPS(pb + 7) { norm_pass<false>(F, args, F.out, args.in[5] + layer * 1024, mod, 3, XNY); } SEAM(pb + 7);
        if (IN(pb + 8)) REPS(pb + 8) {
            pg8::Gemm g{XNY, WSP(bf16, WS_WQ) + (size_t)layer * NQ * D, M, NQ, D}; pg8::StaticOrder S; S.init(M, NQ, F.G, F.bid);
            pg8::EpiBf16 E{WSP(bf16, WS_QRY), NQ};
            pg8::gemm_phase<pg8::EpiBf16, pg8::StaticOrder, true, true>(F.lds, g, S, E);
        } SEAM(pb + 8);
        if (IN(pb + 9)) REPS(pb + 9) { const bf16* KEYS = WSP(bf16, WS_KEYS) + (size_t)layer * 2 * 128 * 128;
            for (int u = F.bid; u < 2048; u += F.G) peer_route_unit(F, (u >> 3) * 128, u & 7, KEYS); } SEAM(pb + 9);
        if (IN(pb + 10)) REPS(pb + 10) { peer_u_phase(F, F.ws + WS_UB + (size_t)layer * 8 * 16384 * 128); } SEAM(pb + 10);
        if (IN(pb + 11)) REPS(pb + 11) { peer_act_phase(F, WSP(float, WS_ISU) + layer * 16384, WSP(float, WS_ISV) + layer * 16384); } SEAM(pb + 11);
        if (IN(pb + 12)) REPS(pb + 12) { peer_v_phase(F, F.ws + WS_VB + (size_t)layer * 8 * 16384 * 128, mod + 5 * 1024, rep == 1 ? (layer == 0 ? (float)DBG_P0 : (float)DBG_P1) : 0.f); }
        if (layer == 0) SEAM(12);
    }
__global__ void __launch_bounds__(NTHR, 2) mega_fwd(Args args) {
    extern __shared__ __attribute__((aligned(16))) unsigned char lds_raw[];
    Frame F;
    F.lds = (LAS unsigned char*)lds_raw;
    F.tid = threadIdx.x; F.lane = F.tid & 63; F.wave = __builtin_amdgcn_readfirstlane(F.tid >> 6);
    F.G = gridDim.x; F.bid = blockIdx.x;
    F.out = args.out; F.ws = args.ws;
    volatile LAS unsigned* MISC = (volatile LAS unsigned*)(F.lds + MISC_OFF);
    for (int u = F.tid; u < (LDS_BYTES - LDSCTL_OFF) / 4; u += NTHR) ((LAS unsigned*)(F.lds + LDSCTL_OFF))[u] = 0u;
    __syncthreads();
    XcdBarrier bar; bar.bar = (unsigned*)(F.ws + WS_CTL) + CW_BAR; bar.x = 0; bar.st = nullptr;
    if (!MK_PER_PHASE) bar = xcd_barrier_post((unsigned*)(F.ws + WS_CTL) + CW_BAR, MISC + 8);
    const int lo = args.ph_lo, hi = args.ph_hi;

    if (IN(0)) REPS(0) { p0_prologue(F, args); } SEAM(0);
    layer_phases<0>(F, args, bar, lo, hi);
    layer_phases<1>(F, args, bar, lo, hi);
}
#undef IN
#undef SEAM

extern "C" void kernel_launch(void* const* d_in, const int* in_sizes, int n_in, void* d_out, int out_size, void* d_ws, size_t ws_size, hipStream_t stream) {
    static int grid = 0;
    if (grid == 0) {
        if (n_in != 24 || in_sizes[0] != M * D || out_size != M * D || ws_size < WS_END) { fprintf(stderr, "kernel_launch: unexpected problem (n_in %d, in0 %d, out %d, ws %zu < %zu); nothing launched\n", n_in, n_in > 0 ? in_sizes[0] : -1, out_size, ws_size, (size_t)WS_END); grid = -1; return; }
        int dev = 0, cus = 0, per_cu = 0;
        if (hipGetDevice(&dev) != hipSuccess || hipDeviceGetAttribute(&cus, hipDeviceAttributeMultiprocessorCount, dev) != hipSuccess) { grid = -1; return; }
        if (hipFuncSetAttribute((const void*)mega_fwd, hipFuncAttributeMaxDynamicSharedMemorySize, LDS_BYTES) != hipSuccess) { fprintf(stderr, "kernel_launch: hipFuncSetAttribute failed\n"); grid = -1; return; }
        if (hipOccupancyMaxActiveBlocksPerMultiprocessor(&per_cu, (const void*)mega_fwd, NTHR, LDS_BYTES) != hipSuccess || per_cu < 1)
            fprintf(stderr, "kernel_launch: note: occupancy query reports %d workgroups per CU\n", per_cu);
        (void)hipGetLastError();
        grid = cus;
    }
    if (grid < 0) return;
    if (hipMemsetAsync((char*)d_ws + WS_CTL, 0, CTL_ZERO_BYTES, stream) != hipSuccess) { fprintf(stderr, "kernel_launch: memset failed\n"); return; }
    Args a{};
    for (int i = 0; i < 24; ++i) a.in[i] = (const float*)d_in[i];
    a.out = (float*)d_out; a.ws = (unsigned char*)d_ws;
#if MK_PER_PHASE
    for (int p = 0; p < NPHASE + 1; ++p) { a.ph_lo = p; a.ph_hi = p + 1; hipLaunchKernelGGL(mega_fwd, dim3(grid), dim3(NTHR), LDS_BYTES, stream, a); }
#else
    a.ph_lo = 0; a.ph_hi = NPHASE + 1;
    hipLaunchKernelGGL(mega_fwd, dim3(grid), dim3(NTHR), LDS_BYTES, stream, a);
#endif
#if defined(CHECK) && CHECK
    chk_qry<<<256, 256, 0, stream>>>(a); chk_keys<<<256, 256, 0, stream>>>(a); chk_uv<<<1024, 256, 0, stream>>>(a); chk_scores<<<128, 256, 0, stream>>>(a); chk_route<<<512, 256, 0, stream>>>(a); chk_expert<<<64, 256, 0, stream>>>(a); chk_stamp<<<(M * D + 255) / 256, 256, 0, stream>>>(a);
#endif
    const hipError_t le = hipPeekAtLastError();
    if (le != hipSuccess) fprintf(stderr, "kernel_launch: launch failed: %s\n", hipGetErrorName(le));
}
```

```cpp
#include <hip/hip_runtime.h>
#include <cstdio>
#include <cstdint>
namespace pg8 {
#define PG8_LAS __attribute__((address_space(3)))
typedef unsigned short bf16_t;
typedef short bf16x8 __attribute__((ext_vector_type(8)));
typedef float f32x4 __attribute__((ext_vector_type(4)));
typedef unsigned u32x4 __attribute__((ext_vector_type(4)));
constexpr int BM = 256, BK = 64, HALF = 128, HTB = HALF * BK * 2  , STAGE_BYTES = 8 * HTB, NXCD = 8, WGM = 8;

__host__ __device__ __forceinline__ int lds_byte(int r, int c) { const int st = (r >> 4) * 2 + (c >> 5), rr = r & 15, cc = c & 31, ob = rr * 64 + cc * 2; return st * 1024 + (ob ^ (((ob >> 9) & 1) << 5)); }
__host__ __device__ __forceinline__ void stage_rc(int b, int& R, int& C) { const int st = b / 1024, sb = b % 1024, swz = sb ^ (((sb >> 9) & 1) << 5); R = (st >> 1) * 16 + swz / 64; C = (st & 1) * 32 + (swz % 64) / 2; }
__host__ __device__ __forceinline__ int perm32(int rho) { const int n = rho >> 4, i = rho & 15; return 8 * (i >> 2) + 4 * n + (i & 3); }

struct Unit { int pm, pn; };
struct Gemm { const bf16_t* A; const bf16_t* Bt; int M, N, K; };

struct StaticOrder {
    int nM, nN, nwg, G, c;
    __host__ __device__ void init(int M, int N, int G_, int c_) { nM = M / BM; nN = N / BM; nwg = nM * nN; G = G_; c = c_; }
    __host__ __device__ bool next(int i, Unit& u) const {
        const long L = (long)i * G + c; if (L >= nwg) return false;
        int wgid = (int)L; { const int q = nwg / NXCD, r = nwg % NXCD, xcd = wgid % NXCD, off = wgid / NXCD; wgid = (xcd < r ? xcd * (q + 1) : r * (q + 1) + (xcd - r) * q) + off; }
        const int nig = WGM * nN, gid = wgid / nig, fm = gid * WGM, gsz = (nM - fm) < WGM ? (nM - fm) : WGM;
        u.pm = fm + ((wgid % nig) % gsz); u.pn = (wgid % nig) / gsz; return true;
    }
    __device__ __forceinline__ void a_ready(const Unit&) const {}
    __device__ __forceinline__ void done(const Unit&) const {}
};

__device__ __forceinline__ unsigned cvt_pk_bf16(float lo, float hi) { unsigned r; asm volatile("v_cvt_pk_bf16_f32 %0, %1, %2" : "=v"(r) : "v"(lo), "v"(hi)); return r; }
typedef unsigned u32x4 __attribute__((ext_vector_type(4)));
struct EpiBf16 {
    static constexpr bool PERM = true, AFTER_DRAIN = false;
    bf16_t* O; int ldc;
    __device__ __forceinline__ void operator()(const f32x4 (&acc)[2][2][4][2], const Unit& u, int wr, int wc, int fr, int fq) const {
        const int row0 = u.pm * BM + wr * 64 + fr; const int col0 = u.pn * BM + wc * 32 + 8 * fq;
#pragma unroll
        for (int ai = 0; ai < 2; ++ai)
#pragma unroll
            for (int m = 0; m < 4; ++m) { bf16_t* rowp = O + (size_t)(row0 + ai * HALF + m * 16) * ldc + col0;
#pragma unroll
                for (int bj = 0; bj < 2; ++bj) { const f32x4 v0 = acc[ai][bj][m][0], v1 = acc[ai][bj][m][1];
                    u32x4 w; w.x = cvt_pk_bf16(v0[0], v0[1]); w.y = cvt_pk_bf16(v0[2], v0[3]); w.z = cvt_pk_bf16(v1[0], v1[1]); w.w = cvt_pk_bf16(v1[2], v1[3]);
                    *(u32x4*)(rowp + bj * HALF) = w; } }
    }
};
struct EpiResid {
    static constexpr bool PERM = false, AFTER_DRAIN = false;
    const float* base; float* out; const float* gate; float dbg;
    __device__ __forceinline__ void operator()(const f32x4 (&acc)[2][2][4][2], const Unit& u, int wr, int wc, int fr, int fq) const {
        const int col0 = u.pn * BM + wc * 32 + 4 * fq; const int b = (u.pm * BM) >> 13;
#pragma unroll
        for (int bj = 0; bj < 2; ++bj)
#pragma unroll
            for (int n = 0; n < 2; ++n) { const f32x4 gv = *(const f32x4*)(gate + (size_t)b * 6144 + col0 + bj * HALF + n * 16);
#pragma unroll
                for (int ai = 0; ai < 2; ++ai)
#pragma unroll
                    for (int m = 0; m < 4; ++m) { const size_t off = (size_t)(u.pm * BM + ai * HALF + wr * 64 + m * 16 + fr) * 1024 + col0 + bj * HALF + n * 16;
                        const f32x4 bs = *(const f32x4*)(base + off); *(f32x4*)(out + off) = bs + gv * acc[ai][bj][m][n] * dbg; } }
    }
};

template <class Epi, class Sched, bool ALIGN_EPI = false, bool SP2 = false>
__device__ __forceinline__ void gemm_phase(PG8_LAS unsigned char* lds, const Gemm g, const Sched& S, const Epi& E) {
    const int tid = threadIdx.x, wid = __builtin_amdgcn_readfirstlane(tid >> 6), lane = tid & 63, wr = wid >> 2, wc = wid & 3, fr = lane & 15, fq = lane >> 4;
    const int K = g.K, nt = K / BK;
    unsigned voffA[2], voffB[2];
#pragma unroll
    for (int i = 0; i < 2; ++i) { int R, C; stage_rc(tid * 16 + i * 8192, R, C); const int Rb = Epi::PERM ? ((R & ~31) + perm32(R & 31)) : R;
        voffA[i] = (unsigned)(R * K + C) * 2u; voffB[i] = (unsigned)(Rb * K + C) * 2u; }
    const size_t kstep = (size_t)(BK * 2);
    const size_t hstep = (size_t)HALF * K * 2;
    const size_t tstep = 2 * hstep;
    const unsigned ldsw = (unsigned)wid * 1024u;
    const int aoff = lds_byte(wr * 64 + fr, fq * 8), boff = lds_byte(wc * 32 + fr, fq * 8);
#define PG8_SA(b, h) (((b) * 2 + (h)) * HTB)
#define PG8_SB(b, h) ((4 + (b) * 2 + (h)) * HTB)
#define PG8_STAGE(bufoff, gbase, voff) do { _Pragma("unroll") for (int _i = 0; _i < 2; ++_i) \
        __builtin_amdgcn_global_load_lds((const unsigned*)((const char*)(gbase) + (voff)[_i]), (PG8_LAS unsigned*)(lds + (bufoff) + ldsw + _i * 8192), 16, 0, 0); } while (0)
#define PG8_LDA(dst, b, h) do { _Pragma("unroll") for (int m = 0; m < 4; ++m) _Pragma("unroll") for (int k = 0; k < 2; ++k) dst[m][k] = *(const PG8_LAS bf16x8*)(lds + PG8_SA(b, h) + aoff + m * 2048 + k * 1024); } while (0)
#define PG8_LDB(dst, b, h) do { _Pragma("unroll") for (int n = 0; n < 2; ++n) _Pragma("unroll") for (int k = 0; k < 2; ++k) dst[n][k] = *(const PG8_LAS bf16x8*)(lds + PG8_SB(b, h) + boff + n * 2048 + k * 1024); } while (0)
#define PG8_MMA(ai, bj, At, Bt) do { __builtin_amdgcn_s_setprio(1); _Pragma("unroll") for (int m = 0; m < 4; ++m) _Pragma("unroll") for (int n = 0; n < 2; ++n) _Pragma("unroll") for (int k = 0; k < 2; ++k) \
        acc[ai][bj][m][n] = __builtin_amdgcn_mfma_f32_16x16x32_bf16(Bt[n][k], At[m][k], acc[ai][bj][m][n], 0, 0, 0); __builtin_amdgcn_s_setprio(0); } while (0)
#define PG8_WAIT_V(n) asm volatile("s_waitcnt vmcnt(" #n ")" ::: "memory")
#define PG8_WAIT_L(n) asm volatile("s_waitcnt lgkmcnt(" #n ")" ::: "memory")
#define PG8_BAR __builtin_amdgcn_s_barrier()
#define PG8_SCHED __builtin_amdgcn_sched_barrier(0)
    Unit cur, nxt; int ui = 0;
    if (!S.next(0, cur)) return;
    f32x4 acc[2][2][4][2];
#pragma unroll
    for (int a = 0; a < 2; ++a)
#pragma unroll
        for (int b = 0; b < 2; ++b)
#pragma unroll
            for (int m = 0; m < 4; ++m)
#pragma unroll
                for (int n = 0; n < 2; ++n) acc[a][b][m][n] = (f32x4){0.f, 0.f, 0.f, 0.f};
    bf16x8 At[4][2], B0[2][2], B1[2][2];
    const char* cA = (const char*)g.A + (size_t)cur.pm * tstep; const char* cB = (const char*)g.Bt + (size_t)cur.pn * tstep;
    S.a_ready(cur);
    if constexpr (SP2) {
        PG8_STAGE(PG8_SB(0, 0), cB, voffB); PG8_STAGE(PG8_SB(0, 1), cB + hstep, voffB); PG8_STAGE(PG8_SA(0, 0), cA, voffA); PG8_STAGE(PG8_SA(0, 1), cA + hstep, voffA);
        if (wr == 1) PG8_BAR;
        PG8_WAIT_V(2); PG8_BAR;
        PG8_STAGE(PG8_SB(1, 0), cB + kstep, voffB); PG8_STAGE(PG8_SA(1, 0), cA + kstep, voffA); PG8_STAGE(PG8_SB(1, 1), cB + hstep + kstep, voffB);
        PG8_WAIT_V(6); PG8_BAR;
    } else {
        PG8_STAGE(PG8_SB(0, 0), cB, voffB); PG8_STAGE(PG8_SA(0, 0), cA, voffA); PG8_STAGE(PG8_SB(0, 1), cB + hstep, voffB); PG8_STAGE(PG8_SA(0, 1), cA + hstep, voffA);
        if (wr == 1) PG8_BAR;
        PG8_WAIT_V(4); PG8_BAR;
        PG8_STAGE(PG8_SB(1, 0), cB + kstep, voffB); PG8_STAGE(PG8_SA(1, 0), cA + kstep, voffA); PG8_STAGE(PG8_SB(1, 1), cB + hstep + kstep, voffB);
        PG8_WAIT_V(6); PG8_BAR;
    }
    for (;;) {
        const bool has_next = S.next(ui + 1, nxt);
        const char* nA = has_next ? (const char*)g.A + (size_t)nxt.pm * tstep : cA; const char* nB = has_next ? (const char*)g.Bt + (size_t)nxt.pn * tstep : cB;
        for (int t = 0; t < nt; t += 2) {
            const bool last = (t == nt - 2);
            const char* a1 = cA + (size_t)(t + 1) * kstep;
            const char* a2 = last ? nA : cA + (size_t)(t + 2) * kstep; const char* b2 = last ? nB : cB + (size_t)(t + 2) * kstep;
            const char* a3 = a2 + kstep; const char* b3 = b2 + kstep;
            if (last && has_next) S.a_ready(nxt);
            if constexpr (SP2) {
            PG8_LDB(B0, 0, 0); PG8_LDB(B1, 0, 1); PG8_SCHED; PG8_LDA(At, 0, 0); PG8_STAGE(PG8_SA(1, 1), a1 + hstep, voffA);
            PG8_WAIT_V(8); PG8_WAIT_L(0); PG8_BAR; PG8_MMA(0, 0, At, B0); PG8_MMA(0, 1, At, B1); PG8_BAR; PG8_SCHED;
            PG8_LDA(At, 0, 1); PG8_STAGE(PG8_SB(0, 0), b2, voffB); PG8_STAGE(PG8_SB(0, 1), b2 + hstep, voffB); PG8_STAGE(PG8_SA(0, 0), a2, voffA);
            PG8_WAIT_V(8); PG8_WAIT_L(0); PG8_BAR; PG8_MMA(1, 0, At, B0); PG8_MMA(1, 1, At, B1); PG8_BAR; PG8_SCHED;
            PG8_LDB(B0, 1, 0); PG8_LDB(B1, 1, 1); PG8_SCHED; PG8_LDA(At, 1, 0); PG8_STAGE(PG8_SA(0, 1), a2 + hstep, voffA);
            PG8_WAIT_V(8); PG8_WAIT_L(0); PG8_BAR; PG8_MMA(0, 0, At, B0); PG8_MMA(0, 1, At, B1); PG8_BAR; PG8_SCHED;
            PG8_LDA(At, 1, 1); PG8_STAGE(PG8_SB(1, 0), b3, voffB); PG8_STAGE(PG8_SB(1, 1), b3 + hstep, voffB); PG8_STAGE(PG8_SA(1, 0), a3, voffA);
            PG8_WAIT_V(8); PG8_WAIT_L(0); PG8_BAR; PG8_MMA(1, 0, At, B0); PG8_MMA(1, 1, At, B1); PG8_BAR; PG8_SCHED;
            } else {
            PG8_LDB(B0, 0, 0); PG8_SCHED; PG8_LDA(At, 0, 0); PG8_STAGE(PG8_SA(1, 1), a1 + hstep, voffA);
            PG8_WAIT_L(8); PG8_BAR; PG8_WAIT_L(0); PG8_MMA(0, 0, At, B0); PG8_BAR; PG8_SCHED;
            PG8_LDB(B1, 0, 1); PG8_STAGE(PG8_SB(0, 0), b2, voffB);
            PG8_BAR; PG8_WAIT_L(0); PG8_MMA(0, 1, At, B1); PG8_BAR;
            PG8_LDA(At, 0, 1); PG8_STAGE(PG8_SA(0, 0), a2, voffA);
            PG8_BAR; PG8_WAIT_L(0); PG8_MMA(1, 0, At, B0); PG8_BAR; PG8_SCHED;
            PG8_STAGE(PG8_SB(0, 1), b2 + hstep, voffB);
            PG8_WAIT_V(6); PG8_BAR; PG8_MMA(1, 1, At, B1); PG8_BAR;
            PG8_LDB(B0, 1, 0); PG8_SCHED; PG8_LDA(At, 1, 0); PG8_STAGE(PG8_SA(0, 1), a2 + hstep, voffA);
            PG8_WAIT_L(8); PG8_BAR; PG8_WAIT_L(0); PG8_MMA(0, 0, At, B0); PG8_BAR; PG8_SCHED;
            PG8_LDB(B1, 1, 1); PG8_STAGE(PG8_SB(1, 0), b3, voffB);
            PG8_BAR; PG8_WAIT_L(0); PG8_MMA(0, 1, At, B1); PG8_BAR;
            PG8_LDA(At, 1, 1); PG8_STAGE(PG8_SA(1, 0), a3, voffA);
            PG8_BAR; PG8_WAIT_L(0); PG8_MMA(1, 0, At, B0); PG8_BAR; PG8_SCHED;
            PG8_STAGE(PG8_SB(1, 1), b3 + hstep, voffB);
            PG8_WAIT_V(6); PG8_BAR; PG8_MMA(1, 1, At, B1); PG8_BAR;
            }
        }
        if constexpr (ALIGN_EPI) { if (wr == 0) PG8_BAR; }
        if constexpr (!Epi::AFTER_DRAIN) { E(acc, cur, wr, wc, fr, fq); S.done(cur); }
        if (!has_next) break;
#pragma unroll
        for (int a = 0; a < 2; ++a)
#pragma unroll
            for (int b = 0; b < 2; ++b)
#pragma unroll
                for (int m = 0; m < 4; ++m)
#pragma unroll
                    for (int n = 0; n < 2; ++n) acc[a][b][m][n] = (f32x4){0.f, 0.f, 0.f, 0.f};
        cur = nxt; cA = nA; cB = nB; ++ui;
        if constexpr (ALIGN_EPI) { if (wr == 1) PG8_BAR; }
    }
    PG8_WAIT_V(0);
    if constexpr (!ALIGN_EPI) { if (wr == 0) PG8_BAR; }
    PG8_BAR;
    if constexpr (Epi::AFTER_DRAIN) { E.fused(acc, cur, wr, wc, fr, fq, lds, wid, lane); S.done(cur); }
#undef PG8_SA
#undef PG8_SB
#undef PG8_STAGE
#undef PG8_LDA
#undef PG8_LDB
#undef PG8_MMA
#undef PG8_WAIT_V
#undef PG8_WAIT_L
#undef PG8_BAR
#undef PG8_SCHED
}
}
constexpr int NB = 4, SEQ = 8192, D = 1024, M = NB * SEQ;
constexpr int NZ0 = 3584, NZ1 = 3072, NQ = 2048, SRC_IN0 = 3592;
constexpr float EPS = 1e-6f;
constexpr int NWAVES = 8, NTHR = 512;
constexpr float LOG2E = 1.4426950408889634f;
constexpr size_t MiB = 1u << 20;
constexpr size_t WS_CTL = 0, CTL_ZERO_BYTES = 1 * MiB;
constexpr size_t WS_WIN0 = 1 * MiB, WS_WOUT0 = 8 * MiB, WS_WIN1 = 10 * MiB, WS_WOUT1 = 16 * MiB, WS_WQ = 18 * MiB;
constexpr size_t WS_KEYS = 26 * MiB, WS_MOD = WS_KEYS + 128 * 1024, WS_KMEAN = WS_MOD + 192 * 1024, WS_NLOC = WS_KMEAN + 256 * 1024,
                 WS_BEND = WS_NLOC + 512 * 1024, WS_MLOC = WS_BEND + 4096, WS_MPREV = WS_MLOC + 4096,
                 WS_ISU = 27 * MiB + 512 * 1024, WS_ISV = WS_ISU + 128 * 1024, WS_ORD = WS_ISV + 128 * 1024  ;
constexpr size_t WS_GATES = 28 * MiB;
constexpr size_t WS_UB = 32 * MiB  , WS_VB = 64 * MiB, WS_ACT = 96 * MiB  , WS_DBGBUF = 112 * MiB, WS_XNY = 160 * MiB, WS_Z = 224 * MiB, WS_CLOC = 448 * MiB, WS_END = 512 * MiB;
constexpr size_t WS_QRY = WS_Z, WS_IDX = WS_Z + 128 * MiB, WS_GATE = WS_Z + 144 * MiB, WS_PART = 384 * MiB  ;
constexpr int CW_BAR = 4096, CW_QMOBA = 8192, CW_QDIFF = 8256;
constexpr float ALIBI_MARGIN = 27.03f;
constexpr int RING_BYTES = 139264;
constexpr int LDSCTL_OFF = RING_BYTES, MISC_OFF = LDSCTL_OFF + 320;
constexpr int LDS_BYTES = 147456;
static_assert(MISC_OFF + 128 <= LDS_BYTES, "LDS map");

#define GAS __attribute__((address_space(1)))
#define LAS __attribute__((address_space(3)))
typedef unsigned short bf16;
typedef unsigned v4u __attribute__((ext_vector_type(4)));
typedef unsigned v2u __attribute__((ext_vector_type(2)));
typedef float f32x4 __attribute__((ext_vector_type(4)));
typedef float f32x16 __attribute__((ext_vector_type(16)));
typedef short bf16x8 __attribute__((ext_vector_type(8)));
typedef short s16x4 __attribute__((ext_vector_type(4)));
typedef GAS unsigned gu32;
#define RLX_AGENT __ATOMIC_RELAXED, __HIP_MEMORY_SCOPE_AGENT
#define LDS_WAIT() asm volatile("s_waitcnt lgkmcnt(0)" ::: "memory")
#define VM_WAIT() asm volatile("s_waitcnt vmcnt(0)" ::: "memory")
__device__ __forceinline__ unsigned f2bf(float f) { unsigned u = __builtin_bit_cast(unsigned, f); return (u + 0x7fffu + ((u >> 16) & 1u)) >> 16; }
__device__ __forceinline__ unsigned pk2(float lo, float hi) { return f2bf(lo) | (f2bf(hi) << 16); }
__device__ __forceinline__ float bflo(unsigned w) { return __builtin_bit_cast(float, w << 16); }
__device__ __forceinline__ float bfhi(unsigned w) { return __builtin_bit_cast(float, w & 0xffff0000u); }
__device__ __forceinline__ float bf2f(bf16 h) { return __builtin_bit_cast(float, (unsigned)h << 16); }
__device__ __forceinline__ unsigned f2u(float x) { return __builtin_bit_cast(unsigned, x); }
__device__ __forceinline__ float u2f(unsigned x) { return __builtin_bit_cast(float, x); }
__device__ __forceinline__ float dot2bf(unsigned a, unsigned b, float acc) { typedef __bf16 bf2_ __attribute__((ext_vector_type(2))); return __builtin_amdgcn_fdot2_f32_bf16(__builtin_bit_cast(bf2_, a), __builtin_bit_cast(bf2_, b), acc, false); }
__device__ __forceinline__ float wave_sum(float v) {
#pragma unroll
    for (int o = 1; o < 64; o <<= 1) v += __shfl_xor(v, o);
    return v;
}
__device__ __forceinline__ float wave_max(float v) {
#pragma unroll
    for (int o = 1; o < 64; o <<= 1) v = fmaxf(v, __shfl_xor(v, o));
    return v;
}
__device__ __forceinline__ float silu_f(float x) { return x / (1.f + __expf(-x)); }
__device__ __forceinline__ float sigmoid_f(float x) { return 1.f / (1.f + __expf(-x)); }
__device__ __forceinline__ float logsigmoid_f(float x) { return fminf(x, 0.f) - log1pf(__expf(-fabsf(x))); }
struct Args { const float* in[24]; float* out; unsigned char* ws; int ph_lo, ph_hi; };
#define XB_TMO      128
#define XB_XCNT(j)  (256  + 64 * (j))
#define XB_XSUB(j)  (1280 + 64 * (j))
#define XB_XGEN(j)  (2304 + 64 * (j))
#define XB_TOP      3328
#define XB_TOPGEN   3392
#define XCD_BAR_WORDS 3456
#define XB_SPIN_CAP (1u << 18)

__device__ __forceinline__ unsigned xb_ld(unsigned* p)              { return __hip_atomic_load(p, __ATOMIC_RELAXED, __HIP_MEMORY_SCOPE_AGENT); }
__device__ __forceinline__ unsigned xb_add(unsigned* p, unsigned v) { return __hip_atomic_fetch_add(p, v, __ATOMIC_RELAXED, __HIP_MEMORY_SCOPE_AGENT); }
__device__ __forceinline__ unsigned xb_xcc_id() { return (unsigned)__builtin_amdgcn_s_getreg((3 << 11) | 20) & 0xFu; }
#define XB_SPIN(cond, bar) do { unsigned _sp = 0; while (cond) { __builtin_amdgcn_s_sleep(1); \
    if ((++_sp & 255u) == 0u) { if (xb_ld(&(bar)[XB_TMO])) break; if (_sp > XB_SPIN_CAP) { atomicAdd(&(bar)[XB_TMO], 1u); break; } } } } while (0)

struct XcdBarrier {
    unsigned* bar; unsigned x;
    volatile LAS unsigned* st;
};

__device__ __forceinline__ XcdBarrier xcd_barrier_post(unsigned* bar, volatile LAS unsigned* st) {
    XcdBarrier b; b.bar = bar; b.x = xb_xcc_id(); b.st = st;
    if (threadIdx.x == 0) (void)xb_add(&bar[XB_XCNT(b.x)], 1u);
    return b;
}
__device__ __forceinline__ void xcd_barrier_complete(unsigned* bar, unsigned x, unsigned& nloc, unsigned& nx) {
    const unsigned G = gridDim.x * gridDim.y * gridDim.z;
    unsigned sum, cnt, mine, sp = 0u;
    for (;;) {
        sum = 0u; cnt = 0u; mine = 0u;
#pragma unroll
        for (unsigned j = 0; j < 16; ++j) { const unsigned c = xb_ld(&bar[XB_XCNT(j)]); sum += c; cnt += (c > 0u) ? 1u : 0u; mine = (j == x) ? c : mine; }
        if (sum == G) break;
        __builtin_amdgcn_s_sleep(1);
        if ((++sp & 255u) == 0u) { if (xb_ld(&bar[XB_TMO])) break; if (sp > XB_SPIN_CAP) { atomicAdd(&bar[XB_TMO], 1u); break; } }
    }
    nloc = mine > 0u ? mine : 1u; nx = cnt > 0u ? cnt : 1u;
}

__device__ __forceinline__ void xcd_barrier(const XcdBarrier& b) {
    asm volatile("s_waitcnt vmcnt(0)" ::: "memory");
    __syncthreads();
    if (threadIdx.x == 0) {
        unsigned* bar = b.bar;
        __builtin_amdgcn_s_waitcnt(0);
        unsigned nloc = b.st[0], nx = b.st[1];
        if (nloc == 0u) { xcd_barrier_complete(bar, b.x, nloc, nx); b.st[0] = nloc; b.st[1] = nx; }
        const unsigned old = xb_add(&bar[XB_XSUB(b.x)], 1u);
        const unsigned gen = old / nloc;
        if (old + 1u == (gen + 1u) * nloc) {
            __builtin_amdgcn_fence(__ATOMIC_RELEASE, "agent");
            asm volatile("s_waitcnt vmcnt(0)" ::: "memory");
            const unsigned og = xb_add(&bar[XB_TOP], 1u);
            const unsigned tg = og / nx;
            if (og + 1u == (tg + 1u) * nx) xb_add(&bar[XB_TOPGEN], 1u);
            else XB_SPIN(xb_ld(&bar[XB_TOPGEN]) == tg, bar);
            __builtin_amdgcn_fence(__ATOMIC_ACQUIRE, "agent");
            xb_add(&bar[XB_XGEN(b.x)], 1u);
            asm volatile("s_waitcnt vmcnt(0)" ::: "memory");
        } else {
            XB_SPIN(xb_ld(&bar[XB_XGEN(b.x)]) == gen, bar);
            __builtin_amdgcn_fence(__ATOMIC_ACQUIRE, "agent");
            asm volatile("s_waitcnt vmcnt(0)" ::: "memory");
        }
    }
    __syncthreads();
}
struct Frame {
    LAS unsigned char* lds;
    int tid, lane, wave, G, bid;
    float* out; unsigned char* ws;
};
#define WSP(T, off) ((T*)(F.ws + (off)))

__device__ __forceinline__ void p0_transpose_item(const float* W, int K, int ldw, int nblk, int thr, int shift, bf16* WT, LAS float* scr, int item, int lane) {
    const int kb = item / nblk, nb = item % nblk, k0 = 64 * kb, n0 = 32 * nb, ns = n0 + (n0 >= thr ? shift : 0);
#pragma unroll 8
    for (int i = 0; i < 32; ++i) { const int kk = 2 * i + (lane >> 5); scr[kk * 33 + (lane & 31)] = W[(size_t)(k0 + kk) * ldw + ns + (lane & 31)]; }
    LDS_WAIT(); asm volatile("" ::: "memory");
    const int c = lane & 7;
#pragma unroll
    for (int j = 0; j < 4; ++j) { const int n = (lane >> 3) + 8 * j; const LAS float* s = scr + (8 * c) * 33 + n;
        v4u o; o.x = pk2(s[0 * 33], s[1 * 33]); o.y = pk2(s[2 * 33], s[3 * 33]); o.z = pk2(s[4 * 33], s[5 * 33]); o.w = pk2(s[6 * 33], s[7 * 33]);
        *(GAS v4u*)(WT + (size_t)(n0 + n) * K + k0 + 8 * c) = o; }
    LDS_WAIT(); asm volatile("" ::: "memory");
}
__device__ __forceinline__ void cvt_f32_bf16_stream(const float* src, bf16* dst, size_t n8, size_t gtid, size_t gthreads) {
    for (size_t i = gtid; i < n8; i += gthreads) {
        const f32x4 a = *(const GAS f32x4*)(src + i * 8), b = *(const GAS f32x4*)(src + i * 8 + 4);
        v4u o; o.x = pk2(a.x, a.y); o.y = pk2(a.z, a.w); o.z = pk2(b.x, b.y); o.w = pk2(b.z, b.w);
        *(GAS v4u*)(dst + i * 8) = o; }
}
__device__ __forceinline__ void p0_fp8_rows(Frame& F, const float* src, unsigned char* dst, float* iscale) {
    const int gw = F.bid * NWAVES + F.wave, NGW = F.G * NWAVES, lane = F.lane;
    for (int row = gw; row < 2 * 16384; row += NGW) {
        const float* r = src + (size_t)row * 1024 + 16 * lane;
        const f32x4 a = *(const GAS f32x4*)r, b = *(const GAS f32x4*)(r + 4), c = *(const GAS f32x4*)(r + 8), e = *(const GAS f32x4*)(r + 12);
        float am = fmaxf(fmaxf(fmaxf(fabsf(a.x), fabsf(a.y)), fmaxf(fabsf(a.z), fabsf(a.w))), fmaxf(fmaxf(fabsf(b.x), fabsf(b.y)), fmaxf(fabsf(b.z), fabsf(b.w))));
        am = fmaxf(am, fmaxf(fmaxf(fmaxf(fabsf(c.x), fabsf(c.y)), fmaxf(fabsf(c.z), fabsf(c.w))), fmaxf(fmaxf(fabsf(e.x), fabsf(e.y)), fmaxf(fabsf(e.z), fabsf(e.w)))));
        am = wave_max(am);
        const float sc = am > 1e-30f ? exp2f(floorf(log2f(256.f / am))) : 1.f;
        int w0 = 0, w1 = 0, w2 = 0, w3 = 0;
        w0 = __builtin_amdgcn_cvt_pk_fp8_f32(a.x * sc, a.y * sc, w0, false); w0 = __builtin_amdgcn_cvt_pk_fp8_f32(a.z * sc, a.w * sc, w0, true);
        w1 = __builtin_amdgcn_cvt_pk_fp8_f32(b.x * sc, b.y * sc, w1, false); w1 = __builtin_amdgcn_cvt_pk_fp8_f32(b.z * sc, b.w * sc, w1, true);
        w2 = __builtin_amdgcn_cvt_pk_fp8_f32(c.x * sc, c.y * sc, w2, false); w2 = __builtin_amdgcn_cvt_pk_fp8_f32(c.z * sc, c.w * sc, w2, true);
        w3 = __builtin_amdgcn_cvt_pk_fp8_f32(e.x * sc, e.y * sc, w3, false); w3 = __builtin_amdgcn_cvt_pk_fp8_f32(e.z * sc, e.w * sc, w3, true);
        const int layer = row >> 14, er = row & 16383;
        v4u o; o.x = (unsigned)w0; o.y = (unsigned)w1; o.z = (unsigned)w2; o.w = (unsigned)w3;
        *(GAS v4u*)(dst + ((size_t)((layer * 8 + (lane >> 3)) * 16384 + er)) * 128 + 16 * (lane & 7)) = o;
        if (lane == 0) iscale[row] = 1.f / sc;
    }
}
__device__ __forceinline__ void p0_i8_rows(Frame& F, const float* src, unsigned char* dst, float* scale) {
    const int gw = F.bid * NWAVES + F.wave, NGW = F.G * NWAVES, lane = F.lane;
    for (int row = gw; row < 2 * 16384; row += NGW) {
        const float* r = src + (size_t)row * 1024 + 16 * lane;
        float x[16];
#pragma unroll
        for (int q4 = 0; q4 < 4; ++q4) { const f32x4 a = *(const GAS f32x4*)(r + 4 * q4); x[4 * q4] = a.x; x[4 * q4 + 1] = a.y; x[4 * q4 + 2] = a.z; x[4 * q4 + 3] = a.w; }
        float am = 0.f;
#pragma unroll
        for (int i = 0; i < 16; ++i) am = fmaxf(am, fabsf(x[i]));
        am = wave_max(am);
        const float inv = am > 1e-30f ? 127.f / am : 0.f;
        unsigned wd[4];
#pragma unroll
        for (int q4 = 0; q4 < 4; ++q4) { unsigned w = 0;
#pragma unroll
            for (int e = 0; e < 4; ++e) { const int qv = (int)rintf(x[4 * q4 + e] * inv); w |= ((unsigned)qv & 0xffu) << (8 * e); }
            wd[q4] = w; }
        const int layer = row >> 14, er = row & 16383;
        v4u o; o.x = wd[0]; o.y = wd[1]; o.z = wd[2]; o.w = wd[3];
        *(GAS v4u*)(dst + ((size_t)((layer * 8 + (lane >> 3)) * 16384 + er)) * 128 + 16 * (lane & 7)) = o;
        if (lane == 0) scale[row] = am * (1.f / 127.f);
    }
}
__device__ __forceinline__ void p0_prologue(Frame& F, const Args& A) {
    {
        const float* c = A.in[1]; const float* aw = A.in[2]; const float* ab = A.in[3]; float* MOD = WSP(float, WS_MOD);
        LAS float* red = (LAS float*)F.lds;
        for (int item = F.bid; item < 192; item += F.G) {
            const int l = item / 96, n0 = (item % 96) * 64;
            float acc[4] = {0.f, 0.f, 0.f, 0.f};
            const int kbeg = F.wave * 128;
#pragma unroll 4
            for (int k = kbeg; k < kbeg + 128; ++k) {
                const float wv = aw[((size_t)l * 1024 + k) * 6144 + n0 + F.lane];
#pragma unroll
                for (int b = 0; b < 4; ++b) acc[b] += silu_f(c[b * 1024 + k]) * wv;
            }
#pragma unroll
            for (int b = 0; b < 4; ++b) red[(F.wave * 4 + b) * 64 + F.lane] = acc[b];
            __syncthreads();
            if (F.tid < 256) { const int b = F.tid >> 6, ln = F.tid & 63; float s = ab[l * 6144 + n0 + ln];
#pragma unroll
                for (int w = 0; w < 8; ++w) s += red[(w * 4 + b) * 64 + ln];
                MOD[(size_t)(l * 4 + b) * 6144 + n0 + ln] = s; }
            __syncthreads();
        }
    }
    if (F.bid == 0) {
        LAS unsigned* hist = (LAS unsigned*)F.lds;
        unsigned short* ORD = WSP(unsigned short, WS_ORD);
        for (int pass = 0; pass < 2; ++pass) {
            const int nunits = pass == 0 ? 2048 : 1024;
            if (F.tid < 160) hist[F.tid] = 0u;
            __syncthreads();
            for (int u = F.tid; u < nunits; u += NTHR) {
                const int q = pass == 0 ? (u & 63) : (u & 31), h = pass == 0 ? ((u >> 6) & 7) : ((u >> 5) & 7);
                const float dcut = 46.f * (float)(2 << h);
                int cost;
                if (pass == 0) { const int nt = 2 * q + 2; int lo = (int)ceilf(((float)(q * 128) - dcut - 63.f) * (1.f / 64.f)); if (lo < 0) lo = 0; cost = nt - lo; }
                else { int lo = (int)ceilf(((float)(q * 256) - dcut - 255.f) * (1.f / 256.f)); if (lo < 0) lo = 0; int nb = q - lo; if (nb > 3 * 8) nb = 24; cost = 4 * (nb + 1); }
                if (cost > 159) cost = 159;
                atomicAdd((unsigned*)(hist + (159 - cost)), 1u);
            }
            __syncthreads();
            if (F.tid == 0) { unsigned acc = 0; for (int i = 0; i < 160; ++i) { const unsigned c = hist[i]; hist[i] = acc; acc += c; } }
            __syncthreads();
            for (int u = F.tid; u < nunits; u += NTHR) {
                const int q = pass == 0 ? (u & 63) : (u & 31), h = pass == 0 ? ((u >> 6) & 7) : ((u >> 5) & 7);
                const float dcut = 46.f * (float)(2 << h);
                int cost;
                if (pass == 0) { const int nt = 2 * q + 2; int lo = (int)ceilf(((float)(q * 128) - dcut - 63.f) * (1.f / 64.f)); if (lo < 0) lo = 0; cost = nt - lo; }
                else { int lo = (int)ceilf(((float)(q * 256) - dcut - 255.f) * (1.f / 256.f)); if (lo < 0) lo = 0; int nb = q - lo; if (nb > 3 * 8) nb = 24; cost = 4 * (nb + 1); }
                if (cost > 159) cost = 159;
                const unsigned pos = atomicAdd((unsigned*)(hist + (159 - cost)), 1u);
                ORD[(pass == 0 ? 0 : 2048) + pos] = (unsigned short)u;
            }
            __syncthreads();
        }
    }
    {
        LAS float* scr = (LAS float*)(F.lds + F.wave * 8704);
        const int gw = F.bid * NWAVES + F.wave, NGW = F.G * NWAVES;
        constexpr int I_IN0 = 16 * (NZ0 / 32), I_OUT = 16 * 32, I_IN1 = 16 * (NZ1 / 32), I_Q = 16 * (NQ / 32);
        constexpr int NITEMS = I_IN0 + 2 * I_OUT + I_IN1 + 2 * I_Q;
        for (int it = gw; it < NITEMS; it += NGW) {
            int r = it;
            if (r < I_IN0) { p0_transpose_item(A.in[6], D, SRC_IN0, NZ0 / 32, 2048, 8, WSP(bf16, WS_WIN0), scr, r, F.lane); continue; } r -= I_IN0;
            if (r < I_OUT) { p0_transpose_item(A.in[13], D, D, 32, 1 << 30, 0, WSP(bf16, WS_WOUT0), scr, r, F.lane); continue; } r -= I_OUT;
            if (r < I_IN1) { p0_transpose_item(A.in[14], D, NZ1, NZ1 / 32, 1 << 30, 0, WSP(bf16, WS_WIN1), scr, r, F.lane); continue; } r -= I_IN1;
            if (r < I_OUT) { p0_transpose_item(A.in[19], D, D, 32, 1 << 30, 0, WSP(bf16, WS_WOUT1), scr, r, F.lane); continue; } r -= I_OUT;
            if (r < I_Q) { p0_transpose_item(A.in[20], D, NQ, NQ / 32, 1 << 30, 0, WSP(bf16, WS_WQ), scr, r, F.lane); continue; } r -= I_Q;
            p0_transpose_item(A.in[20] + (size_t)D * NQ, D, NQ, NQ / 32, 1 << 30, 0, WSP(bf16, WS_WQ) + (size_t)NQ * D, scr, r, F.lane);
        }
    }
    {
        const size_t gtid = (size_t)F.bid * NTHR + F.tid, gth = (size_t)F.G * NTHR;
        cvt_f32_bf16_stream(A.in[21], WSP(bf16, WS_KEYS), (size_t)2 * 2 * 128 * 128 / 8, gtid, gth);
        p0_i8_rows(F, A.in[22], F.ws + WS_UB, WSP(float, WS_ISU));
        p0_fp8_rows(F, A.in[23], F.ws + WS_VB, WSP(float, WS_ISV));
    }
}

template <bool GATES>
__device__ __forceinline__ void norm_pass(Frame& F, const Args& A, const float* X, const float* g, const float* mod, int shc, bf16* XN) {
    LAS float* wgT = (LAS float*)F.lds;
    if (GATES) {
        const float* win = A.in[6];
        for (int i = F.tid; i < 8 * 1024; i += NTHR) { const int cg = i >> 10, k = i & 1023; wgT[i] = win[(size_t)k * SRC_IN0 + 2048 + cg]; }
        __syncthreads();
    }
    const int gw = F.bid * NWAVES + F.wave, NGW = F.G * NWAVES;
    for (int row = gw; row < M; row += NGW) {
        const int b = row >> 13;
        const GAS f32x4* xr = (const GAS f32x4*)(X + (size_t)row * D) + F.lane;
        f32x4 v[4]; float ss = 0.f;
#pragma unroll
        for (int j = 0; j < 4; ++j) { v[j] = xr[64 * j]; ss += (v[j].x * v[j].x + v[j].y * v[j].y) + (v[j].z * v[j].z + v[j].w * v[j].w); }
        const float rstd = rsqrtf(wave_sum(ss) * (1.f / D) + EPS);
        const float* shp = mod + (size_t)b * 6144 + shc * 1024; const float* scp = shp + 1024;
#pragma unroll
        for (int j = 0; j < 4; ++j) { const int c = 4 * F.lane + 256 * j;
            const f32x4 gg = *(const f32x4*)(g + c), sc = *(const f32x4*)(scp + c), sh = *(const f32x4*)(shp + c);
            v[j] = v[j] * rstd * gg * (sc + 1.f) + sh;
            v2u o; o.x = pk2(v[j].x, v[j].y); o.y = pk2(v[j].z, v[j].w);
            *(GAS v2u*)(XN + (size_t)row * D + c) = o; }
        if (GATES) {
            float* GT = WSP(float, WS_GATES);
#pragma unroll
            for (int cg = 0; cg < 8; ++cg) { float p = 0.f;
#pragma unroll
                for (int j = 0; j < 4; ++j) { const f32x4 w = *(const LAS f32x4*)(wgT + cg * 1024 + 4 * F.lane + 256 * j); p += (v[j].x * w.x + v[j].y * w.y) + (v[j].z * w.z + v[j].w * w.w); }
                p = wave_sum(p);
                if (F.lane == 0) GT[(size_t)row * 8 + cg] = p + (cg < 4 ? A.in[8][cg] : A.in[9][cg - 4]); }
        }
    }
}

__device__ __forceinline__ void qknorm_unit(Frame& F, bf16* Z, int ldz, int row0, int col0, const float* g, float gmul, float* kmean  ) {
    const int c = col0 + 8 * F.lane, d0 = (8 * F.lane) & 63;
    float gv[8];
#pragma unroll
    for (int i = 0; i < 8; ++i) gv[i] = g[d0 + i] * gmul;
    float ks[8] = {0.f, 0.f, 0.f, 0.f, 0.f, 0.f, 0.f, 0.f};
    for (int r = 0; r < 32; ++r) {
        bf16* p = Z + (size_t)(row0 + F.wave * 32 + r) * ldz + c;
        const v4u w = *(const GAS v4u*)p;
        float x[8] = {bflo(w.x), bfhi(w.x), bflo(w.y), bfhi(w.y), bflo(w.z), bfhi(w.z), bflo(w.w), bfhi(w.w)};
        float ss = 0.f;
#pragma unroll
        for (int i = 0; i < 8; ++i) ss += x[i] * x[i];
        ss += __shfl_xor(ss, 1); ss += __shfl_xor(ss, 2); ss += __shfl_xor(ss, 4);
        const float rstd = rsqrtf(ss * (1.f / 64.f) + EPS);
#pragma unroll
        for (int i = 0; i < 8; ++i) { x[i] = x[i] * rstd * gv[i]; ks[i] += x[i]; }
        v4u o; o.x = pk2(x[0], x[1]); o.y = pk2(x[2], x[3]); o.z = pk2(x[4], x[5]); o.w = pk2(x[6], x[7]);
        *(GAS v4u*)p = o;
    }
    if (kmean) {
        LAS float* red = (LAS float*)F.lds;
#pragma unroll
        for (int i = 0; i < 8; ++i) red[F.wave * 512 + 8 * F.lane + i] = ks[i];
        __syncthreads();
        { float s = 0.f;
#pragma unroll
          for (int w = 0; w < 8; ++w) s += red[w * 512 + F.tid];
          kmean[(size_t)(F.tid >> 6) * (32 * 64) + (F.tid & 63)] = s * (1.f / 256.f); }
        __syncthreads();
    }
}
constexpr int KSTRB = 144;
template <int DV> struct VStr { static constexpr int B = (DV == 64) ? 192 : 320; };
typedef short v4i16_t __attribute__((ext_vector_type(4)));
__device__ __forceinline__ s16x4 vtr(const LAS unsigned char* p) { return __builtin_bit_cast(s16x4, __builtin_amdgcn_ds_read_tr16_b64_v4i16((LAS v4i16_t*)p)); }
__device__ __forceinline__ unsigned cvtpk(float lo, float hi) { typedef float f2 __attribute__((ext_vector_type(2))); typedef __bf16 b2 __attribute__((ext_vector_type(2)));
    f2 v = {lo, hi}; b2 b = __builtin_convertvector(v, b2); return __builtin_bit_cast(unsigned, b); }
__device__ __forceinline__ float xhalf(float v) {
    auto rr = __builtin_amdgcn_permlane32_swap(__builtin_bit_cast(unsigned, v), __builtin_bit_cast(unsigned, v), false, false);
    const unsigned r0 = rr[0], r1 = rr[1]; return u2f((threadIdx.x & 32) ? r0 : r1);
}
template <int DV> struct AttnSt { f32x16 o[DV / 32]; float m, l; };
template <int DV> __device__ __forceinline__ void attn_init(AttnSt<DV>& st) {
#pragma unroll
    for (int t = 0; t < DV / 32; ++t)
#pragma unroll
        for (int r = 0; r < 16; ++r) st.o[t][r] = 0.f;
    st.m = -1e30f; st.l = 0.f;
}
template <int DV>
__device__ __forceinline__ void attn_tile(AttnSt<DV>& st, const LAS unsigned char* Kt, const LAS unsigned char* Vt, const bf16x8 (&qf)[4], float sc2, float sl2, int tq, int kt0, bool diag, bool rowok, int lane) {
    const int r32 = lane & 31, hi = lane >> 5;
    const int kb = kt0 + 4 * hi;
    const float c0 = -sl2 * (float)(tq - kb);
    f32x16 s0, s1;
#pragma unroll
    for (int r = 0; r < 16; ++r) { const int ko = (r & 3) + 8 * (r >> 2); s0[r] = c0 + sl2 * (float)ko; s1[r] = c0 + sl2 * (float)(ko + 32); }
    const LAS unsigned char* kp = Kt + r32 * KSTRB + hi * 16;
#pragma unroll
    for (int ks = 0; ks < 4; ++ks) {
        const bf16x8 k0 = *(const LAS bf16x8*)(kp + ks * 32), k1 = *(const LAS bf16x8*)(kp + 32 * KSTRB + ks * 32);
        s0 = __builtin_amdgcn_mfma_f32_32x32x16_bf16(k0, qf[ks], s0, 0, 0, 0);
        s1 = __builtin_amdgcn_mfma_f32_32x32x16_bf16(k1, qf[ks], s1, 0, 0, 0);
    }
    if (diag || !rowok) {
#pragma unroll
        for (int r = 0; r < 16; ++r) { const int ko = (r & 3) + 8 * (r >> 2);
            if (!rowok || kb + ko > tq) s0[r] = -INFINITY;
            if (!rowok || kb + ko + 32 > tq) s1[r] = -INFINITY; }
    }
    float mx = fmaxf(s0[0], s1[0]);
#pragma unroll
    for (int r = 1; r < 16; ++r) mx = fmaxf(mx, fmaxf(s0[r], s1[r]));
    mx = fmaxf(mx, xhalf(mx));
    if (__any(mx > st.m)) {
        const float mn = fmaxf(st.m, mx);
        const float alpha = __builtin_amdgcn_exp2f(st.m - mn);
        st.m = mn; st.l *= alpha;
#pragma unroll
        for (int t = 0; t < DV / 32; ++t)
#pragma unroll
            for (int r = 0; r < 16; ++r) st.o[t][r] *= alpha;
    }
    const float mn = st.m;
    float ps = 0.f;
#pragma unroll
    for (int r = 0; r < 16; ++r) { s0[r] = __builtin_amdgcn_exp2f(s0[r] - mn); s1[r] = __builtin_amdgcn_exp2f(s1[r] - mn); ps += s0[r] + s1[r]; }
    st.l += ps;
    bf16x8 pf[2][2];
#pragma unroll
    for (int s = 0; s < 2; ++s) {
        v4u a, b;
        a.x = cvtpk(s0[8 * s + 0], s0[8 * s + 1]); a.y = cvtpk(s0[8 * s + 2], s0[8 * s + 3]); a.z = cvtpk(s0[8 * s + 4], s0[8 * s + 5]); a.w = cvtpk(s0[8 * s + 6], s0[8 * s + 7]);
        b.x = cvtpk(s1[8 * s + 0], s1[8 * s + 1]); b.y = cvtpk(s1[8 * s + 2], s1[8 * s + 3]); b.z = cvtpk(s1[8 * s + 4], s1[8 * s + 5]); b.w = cvtpk(s1[8 * s + 6], s1[8 * s + 7]);
        pf[0][s] = __builtin_bit_cast(bf16x8, a); pf[1][s] = __builtin_bit_cast(bf16x8, b);
    }
    constexpr int VS = VStr<DV>::B;
    const int g = lane >> 4, i16 = lane & 15;
    const LAS unsigned char* vp = Vt + (4 * (g >> 1) + (i16 >> 2)) * VS + (16 * (g & 1) + 4 * (i16 & 3)) * 2;
#pragma unroll
    for (int kbk = 0; kbk < 2; ++kbk)
#pragma unroll
        for (int s = 0; s < 2; ++s)
#pragma unroll
            for (int t = 0; t < DV / 32; ++t) {
                const s16x4 lo = vtr(vp + (kbk * 32 + 16 * s) * VS + t * 64), h8 = vtr(vp + (kbk * 32 + 16 * s + 8) * VS + t * 64);
                const bf16x8 va = {lo[0], lo[1], lo[2], lo[3], h8[0], h8[1], h8[2], h8[3]};
                st.o[t] = __builtin_amdgcn_mfma_f32_32x32x16_bf16(va, pf[kbk][s], st.o[t], 0, 0, 0);
            }
}
template <int NK, int DV> struct TileRegs { v4u k[NK]; v4u v[DV / 64]; };
template <int NK, int DV>
__device__ __forceinline__ void tile_load(TileRegs<NK, DV>& R, const bf16* Z, int ldz, size_t zrow0, int kcol, int vcol, int tid) {
#pragma unroll
    for (int i = 0; i < NK; ++i) { const int ch = tid + 512 * i; const int row = ch / (8 * NK), cc = ch % (8 * NK);
        R.k[i] = *(const GAS v4u*)(Z + (zrow0 + row) * ldz + kcol + cc * 8); }
#pragma unroll
    for (int i = 0; i < DV / 64; ++i) { const int ch = tid + 512 * i; const int row = ch / (DV / 8), cc = ch % (DV / 8);
        R.v[i] = *(const GAS v4u*)(Z + (zrow0 + row) * ldz + vcol + cc * 8); }
}
template <int NK, int DV>
__device__ __forceinline__ void tile_store(const TileRegs<NK, DV>& R, LAS unsigned char* Kt  , LAS unsigned char* Vt, int tid) {
#pragma unroll
    for (int i = 0; i < NK; ++i) { const int ch = tid + 512 * i; const int row = ch / (8 * NK), cc = ch % (8 * NK);
        *(LAS v4u*)(Kt + (cc >> 3) * (64 * KSTRB) + row * KSTRB + (cc & 7) * 16) = R.k[i]; }
#pragma unroll
    for (int i = 0; i < DV / 64; ++i) { const int ch = tid + 512 * i; const int row = ch / (DV / 8), cc = ch % (DV / 8);
        *(LAS v4u*)(Vt + row * VStr<DV>::B + cc * 16) = R.v[i]; }
}
__device__ __forceinline__ void moba_unit(Frame& F, int b, int h, int j, float tcut  ) {
    const bf16* Z = WSP(bf16, WS_Z); constexpr int ldz = NZ0;
    const int lane = F.lane, w = F.wave, r32 = lane & 31, hi = lane >> 5, tid = F.tid;
    const size_t rowb = (size_t)b * SEQ;
    const int qpos = j * 256 + w * 32 + r32;
    const int qcol = 2048 + h * 64, kcol = 2560 + h * 64, vcol = 3072 + h * 64;
    LAS unsigned char* lds = F.lds;
    constexpr int BUFB = 64 * KSTRB + 64 * VStr<64>::B;
    LAS unsigned char* kmh = lds + 2 * BUFB;
    LAS unsigned char* kml = lds + 2 * BUFB + 32 * KSTRB;
    LAS unsigned* msk = (LAS unsigned*)(lds + 2 * BUFB + 64 * KSTRB);
    { const float* KM = WSP(float, WS_KMEAN) + (size_t)((b * 8 + h) * 32) * 64; const f32x4 x = *(const f32x4*)(KM + 4 * tid);
      const int n = tid >> 4, d0 = (tid & 15) * 4;
      const unsigned h0 = f2bf(x.x), h1 = f2bf(x.y), h2 = f2bf(x.z), h3 = f2bf(x.w);
      v2u hv; hv.x = h0 | (h1 << 16); hv.y = h2 | (h3 << 16);
      v2u lv; lv.x = pk2(x.x - u2f(h0 << 16), x.y - u2f(h1 << 16)); lv.y = pk2(x.z - u2f(h2 << 16), x.w - u2f(h3 << 16));
      *(LAS v2u*)(kmh + n * KSTRB + d0 * 2) = hv; *(LAS v2u*)(kml + n * KSTRB + d0 * 2) = lv; }
    if (tid < 16) msk[tid] = 0u;
    bf16x8 qf[4];
    const bf16* qrow = Z + (rowb + qpos) * ldz + qcol;
#pragma unroll
    for (int ks = 0; ks < 4; ++ks) qf[ks] = *(const GAS bf16x8*)(qrow + 16 * ks + 8 * hi);
    __syncthreads();
    f32x16 gt;
#pragma unroll
    for (int r = 0; r < 16; ++r) gt[r] = 0.f;
#pragma unroll
    for (int ks = 0; ks < 4; ++ks) {
        const bf16x8 a = *(const LAS bf16x8*)(kmh + r32 * KSTRB + hi * 16 + ks * 32), c = *(const LAS bf16x8*)(kml + r32 * KSTRB + hi * 16 + ks * 32);
        gt = __builtin_amdgcn_mfma_f32_32x32x16_bf16(a, qf[ks], gt, 0, 0, 0);
        gt = __builtin_amdgcn_mfma_f32_32x32x16_bf16(c, qf[ks], gt, 0, 0, 0);
    }
    float t0 = -INFINITY, t1 = -INFINITY, t2 = -INFINITY;
#define INS3(key) do { float k_ = (key); float a_ = fmaxf(t0, k_), l_ = fminf(t0, k_); t0 = a_; a_ = fmaxf(t1, l_); l_ = fminf(t1, l_); t1 = a_; t2 = fmaxf(t2, l_); } while (0)
#pragma unroll
    for (int r = 0; r < 16; ++r) { const int n = (r & 3) + 8 * (r >> 2) + 4 * hi;
        const float key = (n < j) ? u2f((f2u(gt[r]) & ~31u) | (unsigned)n) : -INFINITY; INS3(key); }
    { const float p0 = xhalf(t0), p1 = xhalf(t1), p2 = xhalf(t2); INS3(p0); INS3(p1); INS3(p2); }
#undef INS3
    const int sel0 = (t0 > -INFINITY) ? (int)(f2u(t0) & 31u) : -1;
    const int sel1 = (t1 > -INFINITY) ? (int)(f2u(t1) & 31u) : -1;
    const int sel2 = (t2 > -INFINITY) ? (int)(f2u(t2) & 31u) : -1;
    { const unsigned mm = (sel0 >= 0 ? 1u << sel0 : 0u) | (sel1 >= 0 ? 1u << sel1 : 0u) | (sel2 >= 0 ? 1u << sel2 : 0u);
      if (mm) { __hip_atomic_fetch_or(msk + w, mm, __ATOMIC_RELAXED, __HIP_MEMORY_SCOPE_WORKGROUP); __hip_atomic_fetch_or(msk + 8, mm, __ATOMIC_RELAXED, __HIP_MEMORY_SCOPE_WORKGROUP); } }
    __syncthreads();
    const float slope = ldexpf(1.f, -(h + 1)), dcut = tcut / slope;
    const float sl2 = slope * LOG2E, sc2 = 0.125f * LOG2E;
    int nlo = (int)ceilf(((float)(j * 256) - dcut - 255.f) * (1.f / 256.f)); if (nlo < 0) nlo = 0;
    const unsigned keep = nlo >= 32 ? 0u : (0xffffffffu << nlo);
    const unsigned bmask = msk[8] & keep; const unsigned wmask = (unsigned)__builtin_amdgcn_readfirstlane((int)msk[w]) & keep;
    AttnSt<64> st; attn_init<64>(st);
    unsigned rem = bmask;
    int blk = j, kt = 3, buf = 0;
    TileRegs<1, 64> R;
    tile_load<1, 64>(R, Z, ldz, rowb + blk * 256 + kt * 64, kcol, vcol, tid);
    tile_store<1, 64>(R, lds, lds + 64 * KSTRB, tid);
    __syncthreads();
    for (;;) {
        int nblk = blk, nkt = kt - 1; bool has_next = true;
        if (nkt < 0) { nkt = 3; if (rem) { nblk = 31 - __builtin_clz(rem); rem &= ~(1u << nblk); } else has_next = false; }
        if (has_next) tile_load<1, 64>(R, Z, ldz, rowb + nblk * 256 + nkt * 64, kcol, vcol, tid);
        const bool own = (blk == j);
        const bool active = (own ? (kt * 64 <= w * 32 + 31) : (((wmask >> blk) & 1u) != 0u)) && ((float)(j * 256 + w * 32 - (blk * 256 + kt * 64 + 63)) <= dcut);
        if (active) {
            const bool rowok = own || blk == sel0 || blk == sel1 || blk == sel2;
            const bool diag = own && (kt * 64 + 63 > w * 32);
            attn_tile<64>(st, lds + buf * BUFB, lds + buf * BUFB + 64 * KSTRB, qf, sc2, sl2, qpos, blk * 256 + kt * 64, diag, rowok, lane);
        }
        if (!has_next) break;
        tile_store<1, 64>(R, lds + (buf ^ 1) * BUFB, lds + (buf ^ 1) * BUFB + 64 * KSTRB, tid);
        __syncthreads();
        buf ^= 1; blk = nblk; kt = nkt;
    }
    const float inv = 1.f / (st.l + xhalf(st.l));
    bf16* Y = WSP(bf16, WS_XNY) + (rowb + qpos) * 1024 + 512 + h * 64;
#pragma unroll
    for (int t = 0; t < 2; ++t)
#pragma unroll
        for (int rg = 0; rg < 4; ++rg) { v2u o; o.x = pk2(st.o[t][4 * rg] * inv, st.o[t][4 * rg + 1] * inv); o.y = pk2(st.o[t][4 * rg + 2] * inv, st.o[t][4 * rg + 3] * inv);
            *(GAS v2u*)(Y + t * 32 + 8 * rg + 4 * hi) = o; }
    __syncthreads();
}

__device__ __forceinline__ void diff_unit(Frame& F, const Args& A, int b, int h, int qt, float lam, float tcut) {
    const bf16* Z = WSP(bf16, WS_Z); constexpr int ldz = NZ1;
    const int lane = F.lane, w = F.wave, r32 = lane & 31, hi = lane >> 5, tid = F.tid;
    const int comp = w >> 2, wq = w & 3;
    const size_t rowb = (size_t)b * SEQ;
    const int q0 = qt * 128, qpos = q0 + wq * 32 + r32;
    const int qcol = h * 128 + comp * 64, kcol = 1024 + h * 128, vcol = 2048 + h * 128;
    LAS unsigned char* lds = F.lds;
    constexpr int BUFB = 2 * 64 * KSTRB + 64 * VStr<128>::B;
    bf16x8 qf[4];
    const bf16* qrow = Z + (rowb + qpos) * ldz + qcol;
#pragma unroll
    for (int ks = 0; ks < 4; ++ks) qf[ks] = *(const GAS bf16x8*)(qrow + 16 * ks + 8 * hi);
    const float slope = ldexpf(1.f, -(h + 1)), dcut = tcut / slope;
    const float sl2 = slope * LOG2E, sc2 = 0.125f * LOG2E;
    AttnSt<128> st; attn_init<128>(st);
    const int nt = (q0 + 128) / 64;
    int kt_lo = (int)ceilf(((float)q0 - dcut - 63.f) * (1.f / 64.f)); if (kt_lo < 0) kt_lo = 0;
    TileRegs<2, 128> R;
    tile_load<2, 128>(R, Z, ldz, rowb + (size_t)(nt - 1) * 64, kcol, vcol, tid);
    tile_store<2, 128>(R, lds, lds + 2 * 64 * KSTRB, tid);
    __syncthreads();
    int buf = 0;
    for (int kt = nt - 1; kt >= kt_lo; --kt) {
        const bool has_next = kt > kt_lo;
        if (has_next) tile_load<2, 128>(R, Z, ldz, rowb + (size_t)(kt - 1) * 64, kcol, vcol, tid);
        if (kt * 64 <= q0 + wq * 32 + 31) {
            const bool diag = kt * 64 + 63 > q0 + wq * 32;
            attn_tile<128>(st, lds + buf * BUFB + comp * (64 * KSTRB), lds + buf * BUFB + 2 * 64 * KSTRB, qf, sc2, sl2, qpos, kt * 64, diag, true, lane);
        }
        if (has_next) { tile_store<2, 128>(R, lds + (buf ^ 1) * BUFB, lds + (buf ^ 1) * BUFB + 2 * 64 * KSTRB, tid); }
        __syncthreads();
        buf ^= 1;
    }
    const float inv = 1.f / (st.l + xhalf(st.l));
    LAS float* o2 = (LAS float*)lds;
    if (comp == 1) {
#pragma unroll
        for (int t = 0; t < 4; ++t)
#pragma unroll
            for (int r = 0; r < 16; ++r) o2[((wq * 4 + t) * 16 + r) * 64 + lane] = st.o[t][r] * inv;
    }
    __syncthreads();
    if (comp == 0) {
        float ss = 0.f;
#pragma unroll
        for (int t = 0; t < 4; ++t)
#pragma unroll
            for (int r = 0; r < 16; ++r) { const float v = st.o[t][r] * inv - lam * o2[((wq * 4 + t) * 16 + r) * 64 + lane]; st.o[t][r] = v; ss += v * v; }
        ss += xhalf(ss);
        const float rs = rsqrtf(ss * (1.f / 128.f) + EPS) * 0.6444909324090307f;
        const float* og = A.in[18];
        bf16* Y = WSP(bf16, WS_XNY) + (rowb + qpos) * 1024 + h * 128;
#pragma unroll
        for (int t = 0; t < 4; ++t)
#pragma unroll
            for (int rg = 0; rg < 4; ++rg) { const int dv = t * 32 + 8 * rg + 4 * hi; const f32x4 gg = *(const f32x4*)(og + dv);
                v2u o; o.x = pk2(st.o[t][4 * rg] * rs * gg.x, st.o[t][4 * rg + 1] * rs * gg.y); o.y = pk2(st.o[t][4 * rg + 2] * rs * gg.z, st.o[t][4 * rg + 3] * rs * gg.w);
                *(GAS v2u*)(Y + dv) = o; }
    }
    __syncthreads();
}
template <int MT, int NT>
__device__ __forceinline__ void mma_nt(const LAS unsigned char* A, int lda, const LAS unsigned char* B, int ldb, int K, f32x4 (&acc)[MT][NT], int lane) {
    const int r = lane & 15, kq = (lane >> 4) * 16;
    for (int k0 = 0; k0 < K; k0 += 32) {
        bf16x8 a[MT], bb[NT];
#pragma unroll
        for (int m = 0; m < MT; ++m) a[m] = *(const LAS bf16x8*)(A + (m * 16 + r) * lda + k0 * 2 + kq);
#pragma unroll
        for (int n = 0; n < NT; ++n) bb[n] = *(const LAS bf16x8*)(B + (n * 16 + r) * ldb + k0 * 2 + kq);
#pragma unroll
        for (int m = 0; m < MT; ++m)
#pragma unroll
            for (int n = 0; n < NT; ++n) acc[m][n] = __builtin_amdgcn_mfma_f32_16x16x32_bf16(a[m], bb[n], acc[m][n], 0, 0, 0);
    }
}
constexpr int TS = 272;
constexpr int TILEB = 128 * TS;
constexpr int ML_Q = 0, ML_K = TILEB, ML_V = 2 * TILEB, ML_SM = 3 * TILEB;

__device__ __forceinline__ void ml_gates(const float* GT, size_t row0, int hm, LAS float* sm, int lane) {
    const float i0 = GT[(row0 + 2 * lane) * 8 + hm], i1 = GT[(row0 + 2 * lane + 1) * 8 + hm];
    const float f0 = logsigmoid_f(GT[(row0 + 2 * lane) * 8 + 4 + hm]), f1 = logsigmoid_f(GT[(row0 + 2 * lane + 1) * 8 + 4 + hm]);
    float s = f0 + f1;
#pragma unroll
    for (int o = 1; o < 64; o <<= 1) { const float t = __shfl_up(s, o); if (lane >= o) s += t; }
    const float excl = s - (f0 + f1);
    sm[2 * lane] = excl + f0; sm[2 * lane + 1] = excl + f0 + f1;
    sm[128 + 2 * lane] = i0; sm[128 + 2 * lane + 1] = i1;
}
template <bool TRANSPOSE>
__device__ __forceinline__ void ml_conv_tile(const bf16* Z, size_t rowb, int t0, int zc, const float* cw, int wc, float mul, LAS unsigned char* dst, const LAS float* rs, int tid) {
#pragma unroll
    for (int it = 0; it < 4; ++it) {
        const int item = tid + 512 * it, l = item >> 4, ch = (item & 15) * 8;
        float acc[8];
#pragma unroll
        for (int i = 0; i < 8; ++i) acc[i] = 0.f;
#pragma unroll
        for (int jj = 0; jj < 4; ++jj) {
            const int t = t0 + l - 3 + jj;
            if (t >= 0) {
                const v4u w = *(const GAS v4u*)(Z + (rowb + t) * NZ0 + zc + ch);
                const float x[8] = {bflo(w.x), bfhi(w.x), bflo(w.y), bfhi(w.y), bflo(w.z), bfhi(w.z), bflo(w.w), bfhi(w.w)};
                const f32x4 c0 = *(const f32x4*)(cw + jj * 1024 + wc + ch), c1 = *(const f32x4*)(cw + jj * 1024 + wc + ch + 4);
                acc[0] += x[0] * c0.x; acc[1] += x[1] * c0.y; acc[2] += x[2] * c0.z; acc[3] += x[3] * c0.w;
                acc[4] += x[4] * c1.x; acc[5] += x[5] * c1.y; acc[6] += x[6] * c1.z; acc[7] += x[7] * c1.w;
            }
        }
        const float sc = TRANSPOSE ? mul * rs[l] : mul;
#pragma unroll
        for (int i = 0; i < 8; ++i) acc[i] = silu_f(acc[i]) * sc;
        if (TRANSPOSE) {
#pragma unroll
            for (int i = 0; i < 8; ++i) *(LAS bf16*)(dst + (ch + i) * TS + l * 2) = (bf16)f2bf(acc[i]);
        } else {
            v4u o; o.x = pk2(acc[0], acc[1]); o.y = pk2(acc[2], acc[3]); o.z = pk2(acc[4], acc[5]); o.w = pk2(acc[6], acc[7]);
            *(LAS v4u*)(dst + l * TS + ch * 2) = o;
        }
    }
}
__device__ __forceinline__ void ml_vt_tile(const bf16* Z, size_t row0, int zc, LAS unsigned char* dst, int tid) {
#pragma unroll
    for (int it = 0; it < 4; ++it) {
        const int item = tid + 512 * it, l = item >> 4, ch = (item & 15) * 8;
        const v4u w = *(const GAS v4u*)(Z + (row0 + l) * NZ0 + zc + ch);
        const unsigned ww[4] = {w.x, w.y, w.z, w.w};
#pragma unroll
        for (int i = 0; i < 4; ++i) { *(LAS bf16*)(dst + (ch + 2 * i) * TS + l * 2) = (bf16)(ww[i] & 0xffffu); *(LAS bf16*)(dst + (ch + 2 * i + 1) * TS + l * 2) = (bf16)(ww[i] >> 16); }
    }
}
__device__ __forceinline__ void mlstm_a_unit(Frame& F, const Args& A, int unit) {
    const int c = unit & 63, bh = unit >> 6, hm = bh & 3, b = bh >> 2;
    const bf16* Z = WSP(bf16, WS_Z); const float* GT = WSP(float, WS_GATES);
    const size_t rowb = (size_t)b * SEQ; const int t0 = c * 128;
    LAS unsigned char* lds = F.lds; LAS float* sm = (LAS float*)(lds + ML_SM);
    if (F.wave == 0) {
        ml_gates(GT, rowb + t0, hm, sm, F.lane);
        LDS_WAIT();
        const float bend = sm[127];
        const float w0 = bend - sm[2 * F.lane] + sm[128 + 2 * F.lane], w1 = bend - sm[2 * F.lane + 1] + sm[128 + 2 * F.lane + 1];
        const float ml = wave_max(fmaxf(w0, w1));
        sm[256 + 2 * F.lane] = __expf(w0 - ml); sm[256 + 2 * F.lane + 1] = __expf(w1 - ml);
        if (F.lane == 0) { WSP(float, WS_BEND)[unit] = bend; WSP(float, WS_MLOC)[unit] = ml; }
    }
    __syncthreads();
    ml_conv_tile<true>(Z, rowb, t0, 512 + hm * 128, A.in[7], 512 + hm * 128, 0.08838834764831845f, lds + ML_K, sm + 256, F.tid);
    ml_vt_tile(Z, rowb + t0, 1024 + hm * 128, lds + ML_V, F.tid);
    __syncthreads();
    f32x4 acc[2][4];
#pragma unroll
    for (int m = 0; m < 2; ++m)
#pragma unroll
        for (int n = 0; n < 4; ++n) acc[m][n] = (f32x4){0.f, 0.f, 0.f, 0.f};
    const int dv0 = 32 * (F.wave >> 1), dk0 = 64 * (F.wave & 1);
    mma_nt<2, 4>(lds + ML_V + dv0 * TS, TS, lds + ML_K + dk0 * TS, TS, 128, acc, F.lane);
    float* CL = WSP(float, WS_CLOC) + (size_t)unit * 16384;
#pragma unroll
    for (int m = 0; m < 2; ++m)
#pragma unroll
        for (int n = 0; n < 4; ++n)
#pragma unroll
            for (int i = 0; i < 4; ++i) CL[(size_t)(dv0 + 16 * m + 4 * (F.lane >> 4) + i) * 128 + dk0 + 16 * n + (F.lane & 15)] = acc[m][n][i];
    if (F.tid < 128) { float s = 0.f; const LAS bf16* kr = (const LAS bf16*)(lds + ML_K + F.tid * TS);
        for (int l = 0; l < 128; ++l) s += bf2f(kr[l]);
        WSP(float, WS_NLOC)[(size_t)unit * 128 + F.tid] = s; }
    __syncthreads();
}
__device__ __forceinline__ void mlstm_scan_unit(Frame& F, int unit) {
    const int bh = unit >> 4, sl = unit & 15;
    LAS float* tab = (LAS float*)F.lds;
    if (F.tid == 0) {
        const float* BE = WSP(float, WS_BEND) + bh * 64; const float* ML = WSP(float, WS_MLOC) + bh * 64; float* MP = WSP(float, WS_MPREV) + bh * 64;
        float m = 0.f;
        for (int c = 0; c < 64; ++c) { const float be = BE[c], ml = ML[c]; const float mn = fmaxf(be + m, ml);
            tab[c] = __expf(be + m - mn); tab[64 + c] = __expf(ml - mn); if (sl == 0) MP[c] = m; m = mn; }
    }
    __syncthreads();
    float* CL = WSP(float, WS_CLOC) + (size_t)bh * 64 * 16384 + sl * 1024 + 2 * F.tid;
    float s0 = 0.f, s1 = 0.f;
#pragma unroll 8
    for (int c = 0; c < 64; ++c) { float2* p = (float2*)(CL + (size_t)c * 16384); const float2 v = *p; *p = make_float2(s0, s1);
        const float a = tab[c], sc = tab[64 + c]; s0 = a * s0 + sc * v.x; s1 = a * s1 + sc * v.y; }
    if (sl == 0 && F.tid < 128) { float* NL = WSP(float, WS_NLOC) + (size_t)bh * 64 * 128 + F.tid; float s = 0.f;
        for (int c = 0; c < 64; ++c) { const float v = NL[c * 128]; NL[c * 128] = s; s = tab[c] * s + tab[64 + c] * v; } }
    __syncthreads();
}
__device__ __forceinline__ void mlstm_c_unit(Frame& F, const Args& A, int unit) {
    const int c = unit & 63, bh = unit >> 6, hm = bh & 3, b = bh >> 2;
    const bf16* Z = WSP(bf16, WS_Z); const float* GT = WSP(float, WS_GATES);
    const size_t rowb = (size_t)b * SEQ; const int t0 = c * 128;
    LAS unsigned char* lds = F.lds; LAS float* sm = (LAS float*)(lds + ML_SM);
    const int lane = F.lane, w = F.wave, tid = F.tid;
    const float mprev = WSP(float, WS_MPREV)[unit];
    if (w == 0) {
        ml_gates(GT, rowb + t0, hm, sm, lane);
        LDS_WAIT();
        const float b0 = sm[2 * lane], b1 = sm[2 * lane + 1];
        const float g0 = sm[128 + 2 * lane] - b0, g1 = sm[128 + 2 * lane + 1] - b1;
        float pm = fmaxf(g0, g1);
#pragma unroll
        for (int o = 1; o < 64; o <<= 1) { const float t = __shfl_up(pm, o); if (lane >= o) pm = fmaxf(pm, t); }
        float pe = __shfl_up(pm, 1); if (lane == 0) pe = -INFINITY;
        const float M0 = fmaxf(mprev, fmaxf(pe, g0)), M1 = fmaxf(mprev, pm);
        sm[256 + 2 * lane] = g0; sm[256 + 2 * lane + 1] = g1;
        sm[384 + 2 * lane] = M0; sm[384 + 2 * lane + 1] = M1;
        sm[512 + 2 * lane] = __expf(mprev - M0); sm[512 + 2 * lane + 1] = __expf(mprev - M1);
        sm[640 + 2 * lane] = __expf(-b0 - M0); sm[640 + 2 * lane + 1] = __expf(-b1 - M1);
        sm[768 + 2 * lane] = 0.f; sm[768 + 2 * lane + 1] = 0.f; sm[896 + 2 * lane] = 0.f; sm[896 + 2 * lane + 1] = 0.f;
    }
    if (w == 1) { sm[1152 + lane] = WSP(float, WS_NLOC)[(size_t)unit * 128 + lane]; sm[1152 + 64 + lane] = WSP(float, WS_NLOC)[(size_t)unit * 128 + 64 + lane]; }
    ml_conv_tile<false>(Z, rowb, t0, hm * 128, A.in[7], hm * 128, 1.f, lds + ML_Q, nullptr, tid);
    ml_conv_tile<false>(Z, rowb, t0, 512 + hm * 128, A.in[7], 512 + hm * 128, 0.08838834764831845f, lds + ML_K, nullptr, tid);
    ml_vt_tile(Z, rowb + t0, 1024 + hm * 128, lds + ML_V, tid);
    __syncthreads();
    const int l0 = 32 * (w >> 1), c0 = 64 * (w & 1);
    const int lr = 4 * (lane >> 4), lc = lane & 15;
    if (tid < 128) { const LAS bf16* qr = (const LAS bf16*)(lds + ML_Q + tid * TS); float s = 0.f;
        for (int d = 0; d < 128; ++d) s += bf2f(qr[d]) * sm[1152 + d];
        sm[1024 + tid] = s; }
    f32x4 acc[2][4];
#pragma unroll
    for (int m = 0; m < 2; ++m)
#pragma unroll
        for (int n = 0; n < 4; ++n) acc[m][n] = (f32x4){0.f, 0.f, 0.f, 0.f};
    mma_nt<2, 4>(lds + ML_Q + l0 * TS, TS, lds + ML_K + c0 * TS, TS, 128, acc, lane);
#pragma unroll
    for (int m = 0; m < 2; ++m)
#pragma unroll
        for (int i = 0; i < 4; ++i) { const int l = l0 + 16 * m + lr + i; const float Ml = sm[384 + l]; float rsum = 0.f;
#pragma unroll
            for (int n = 0; n < 4; ++n) { const int s = c0 + 16 * n + lc; const float v = (s <= l) ? acc[m][n][i] * __expf(sm[256 + s] - Ml) : 0.f; acc[m][n][i] = v; rsum += v; }
            rsum += __shfl_xor(rsum, 1); rsum += __shfl_xor(rsum, 2); rsum += __shfl_xor(rsum, 4); rsum += __shfl_xor(rsum, 8);
            if (lc == 0) __hip_atomic_fetch_add(sm + 768 + l, rsum, __ATOMIC_RELAXED, __HIP_MEMORY_SCOPE_WORKGROUP); }
    __syncthreads();
#pragma unroll
    for (int m = 0; m < 2; ++m)
#pragma unroll
        for (int n = 0; n < 4; ++n)
#pragma unroll
            for (int i = 0; i < 4; ++i) *(LAS bf16*)(lds + ML_K + (l0 + 16 * m + lr + i) * TS + (c0 + 16 * n + lc) * 2) = (bf16)f2bf(acc[m][n][i]);
    __syncthreads();
    f32x4 ai[2][4], ae[2][4];
#pragma unroll
    for (int m = 0; m < 2; ++m)
#pragma unroll
        for (int n = 0; n < 4; ++n) { ai[m][n] = (f32x4){0.f, 0.f, 0.f, 0.f}; ae[m][n] = (f32x4){0.f, 0.f, 0.f, 0.f}; }
    mma_nt<2, 4>(lds + ML_K + l0 * TS, TS, lds + ML_V + c0 * TS, TS, 128, ai, lane);
    {
        const float* CP = WSP(float, WS_CLOC) + (size_t)unit * 16384;
        const int r = lane & 15, kq = (lane >> 4) * 8;
        for (int k0 = 0; k0 < 128; k0 += 32) {
            bf16x8 a[2], bb[4];
#pragma unroll
            for (int m = 0; m < 2; ++m) a[m] = *(const LAS bf16x8*)(lds + ML_Q + (l0 + m * 16 + r) * TS + (k0 + kq) * 2);
#pragma unroll
            for (int n = 0; n < 4; ++n) { const float* p = CP + (size_t)(c0 + n * 16 + r) * 128 + k0 + kq; const f32x4 x = *(const f32x4*)p, y = *(const f32x4*)(p + 4);
                v4u pk; pk.x = pk2(x.x, x.y); pk.y = pk2(x.z, x.w); pk.z = pk2(y.x, y.y); pk.w = pk2(y.z, y.w); bb[n] = __builtin_bit_cast(bf16x8, pk); }
#pragma unroll
            for (int m = 0; m < 2; ++m)
#pragma unroll
                for (int n = 0; n < 4; ++n) ae[m][n] = __builtin_amdgcn_mfma_f32_16x16x32_bf16(a[m], bb[n], ae[m][n], 0, 0, 0);
        }
    }
#pragma unroll
    for (int m = 0; m < 2; ++m)
#pragma unroll
        for (int i = 0; i < 4; ++i) { const int l = l0 + 16 * m + lr + i; const float wi = sm[512 + l];
            const float den = wi * sm[1024 + l] + sm[768 + l]; const float dinv = 1.f / fmaxf(fabsf(den), sm[640 + l]); float ssq = 0.f;
#pragma unroll
            for (int n = 0; n < 4; ++n) { const float hv = (wi * ae[m][n][i] + ai[m][n][i]) * dinv; ai[m][n][i] = hv; ssq += hv * hv; }
            ssq += __shfl_xor(ssq, 1); ssq += __shfl_xor(ssq, 2); ssq += __shfl_xor(ssq, 4); ssq += __shfl_xor(ssq, 8);
            if (lc == 0) __hip_atomic_fetch_add(sm + 896 + l, ssq, __ATOMIC_RELAXED, __HIP_MEMORY_SCOPE_WORKGROUP); }
    __syncthreads();
    const float* mg = A.in[10] + hm * 128;
    bf16* Y = WSP(bf16, WS_XNY);
#pragma unroll
    for (int m = 0; m < 2; ++m)
#pragma unroll
        for (int i = 0; i < 4; ++i) { const int l = l0 + 16 * m + lr + i; const float rstd = rsqrtf(sm[896 + l] * (1.f / 128.f) + EPS); const size_t row = rowb + t0 + l;
#pragma unroll
            for (int n = 0; n < 4; ++n) { const int dv = c0 + 16 * n + lc; const float og = sigmoid_f(bf2f(Z[row * NZ0 + 1536 + hm * 128 + dv]));
                Y[row * 1024 + hm * 128 + dv] = (bf16)f2bf(ai[m][n][i] * rstd * mg[dv] * og); } }
    __syncthreads();
}
template <int N> __device__ __forceinline__ void bitonic_sort_desc(float (&v)[N]) {
#pragma unroll
    for (int k = 2; k <= N; k <<= 1)
#pragma unroll
        for (int j = k >> 1; j > 0; j >>= 1)
#pragma unroll
            for (int i = 0; i < N; ++i) { const int l = i ^ j; if (l > i) { const bool desc = ((i & k) == 0); const float a = v[i], b = v[l]; const float mx = fmaxf(a, b), mn = fminf(a, b); v[i] = desc ? mx : mn; v[l] = desc ? mn : mx; } }
}
__device__ __forceinline__ void merge_top16(float (&run)[16], const float (&nw)[16]) {
#pragma unroll
    for (int i = 0; i < 16; ++i) run[i] = fmaxf(run[i], nw[15 - i]);
#pragma unroll
    for (int j = 8; j > 0; j >>= 1)
#pragma unroll
        for (int i = 0; i < 16; ++i) { const int l = i ^ j; if (l > i) { const float a = run[i], b = run[l]; run[i] = fmaxf(a, b); run[l] = fminf(a, b); } }
}
#ifndef EXPERT_SLOW
#define EXPERT_SLOW 0
#endif
#ifndef ROUTE_SLOW
#define ROUTE_SLOW 0
#endif
constexpr int SCS = 132;
__device__ __forceinline__ void peer_route_unit(Frame& F, int tok0, int hd, const bf16* KEYS) {
    const bf16* QRY = WSP(bf16, WS_QRY); int* IDX = WSP(int, WS_IDX); float* GATE = WSP(float, WS_GATE);
    LAS float* SC = (LAS float*)F.lds;
    const int lane = F.lane, w = F.wave, tid = F.tid;
    {
        const int p = w & 1, tg = w >> 1, r = lane & 15, kq = (lane >> 4) * 8;
        f32x4 acc[2][8];
#pragma unroll
        for (int m = 0; m < 2; ++m)
#pragma unroll
            for (int n = 0; n < 8; ++n) acc[m][n] = (f32x4){0.f, 0.f, 0.f, 0.f};
#pragma unroll
        for (int k0 = 0; k0 < 128; k0 += 32) {
            bf16x8 a[2], bb[8];
#pragma unroll
            for (int m = 0; m < 2; ++m) a[m] = *(const GAS bf16x8*)(QRY + (size_t)(tok0 + 32 * tg + 16 * m + r) * NQ + hd * 256 + p * 128 + k0 + kq);
#pragma unroll
            for (int n = 0; n < 8; ++n) bb[n] = *(const GAS bf16x8*)(KEYS + (size_t)(p * 128 + 16 * n + r) * 128 + k0 + kq);
#pragma unroll
            for (int m = 0; m < 2; ++m)
#pragma unroll
                for (int n = 0; n < 8; ++n) acc[m][n] = __builtin_amdgcn_mfma_f32_16x16x32_bf16(a[m], bb[n], acc[m][n], 0, 0, 0);
        }
#pragma unroll
        for (int m = 0; m < 2; ++m)
#pragma unroll
            for (int n = 0; n < 8; ++n)
#pragma unroll
                for (int i = 0; i < 4; ++i) SC[(p * 128 + 32 * tg + 16 * m + 4 * (lane >> 4) + i) * SCS + 16 * n + r] = acc[m][n][i];
    }
    __syncthreads();
#if defined(CHECK) && CHECK
    if (tok0 == 0 && hd == 0) { float* DB = WSP(float, WS_CLOC) + 8 * 1024 * 1024; for (int i = tid; i < 2 * 128 * 128; i += NTHR) DB[i] = SC[(i >> 7) * SCS + (i & 127)]; }
    __syncthreads();
#endif
#if ROUTE_SLOW
    if (tid < 128) {
        const int t = tid;
        float s0[16], s1[16]; unsigned i0[16], i1[16];
        { const LAS float* row = SC + (0 * 128 + t) * SCS; float prev = INFINITY;
#pragma unroll
          for (int k = 0; k < 16; ++k) { float best = -INFINITY; unsigned bi = 0; for (int n = 0; n < 128; ++n) { const float v = row[n]; if (v < prev && v > best) { best = v; bi = n; } } s0[k] = best; i0[k] = bi; prev = best; } }
        { const LAS float* row = SC + (1 * 128 + t) * SCS; float prev = INFINITY;
#pragma unroll
          for (int k = 0; k < 16; ++k) { float best = -INFINITY; unsigned bi = 0; for (int n = 0; n < 128; ++n) { const float v = row[n]; if (v < prev && v > best) { best = v; bi = n; } } s1[k] = best; i1[k] = bi; prev = best; } }
        float top[16]; unsigned tid16[16];
        { float prev = INFINITY;
#pragma unroll
          for (int k = 0; k < 16; ++k) { float best = -INFINITY; unsigned be = 0;
#pragma unroll
              for (int i = 0; i < 16; ++i)
#pragma unroll
                  for (int j = 0; j < 16; ++j) if ((i + 1) * (j + 1) <= 16) { const float v = s0[i] + s1[j]; if (v < prev && v > best) { best = v; be = i0[i] * 128u + i1[j]; } }
              top[k] = best; tid16[k] = be; prev = best; } }
        float sc[16], den = 0.f;
#pragma unroll
        for (int k = 0; k < 16; ++k) { sc[k] = __expf(top[k] - top[0]); den += sc[k]; }
        const float inv = 1.f / den;
        const size_t ob = (size_t)(tok0 + t) * 128 + hd * 16;
#pragma unroll
        for (int k = 0; k < 16; ++k) { IDX[ob + k] = (int)tid16[k]; GATE[ob + k] = sc[k] * inv; }
    }
    __syncthreads();
#else
    {
        const int t = tid & 127, p = (tid >> 7) & 1, half = tid >> 8;
        LAS float* seg = SC + (p * 128 + t) * SCS + 64 * half;
        float run[16], nw[16];
#pragma unroll
        for (int ch = 0; ch < 4; ++ch) {
#pragma unroll
            for (int q = 0; q < 4; ++q) { const f32x4 v = *(const LAS f32x4*)(seg + 16 * ch + 4 * q);
#pragma unroll
                for (int e = 0; e < 4; ++e) { const unsigned n = (unsigned)(64 * half + 16 * ch + 4 * q + e); const float key = u2f((f2u(v[e]) & ~127u) | n);
                    if (ch == 0) run[4 * q + e] = key; else nw[4 * q + e] = key; } }
            if (ch == 0) bitonic_sort_desc<16>(run); else { bitonic_sort_desc<16>(nw); merge_top16(run, nw); }
        }
#pragma unroll
        for (int q = 0; q < 4; ++q) *(LAS f32x4*)(seg + 4 * q) = (f32x4){run[4 * q], run[4 * q + 1], run[4 * q + 2], run[4 * q + 3]};
    }
    __syncthreads();
    if (tid < 128) {
        const int t = tid;
        float s0[16], s1[16];
        {
            LAS float* a = SC + (0 * 128 + t) * SCS; float nw[16];
#pragma unroll
            for (int q = 0; q < 4; ++q) { const f32x4 v = *(const LAS f32x4*)(a + 4 * q), u = *(const LAS f32x4*)(a + 64 + 4 * q);
#pragma unroll
                for (int e = 0; e < 4; ++e) { s0[4 * q + e] = v[e]; nw[4 * q + e] = u[e]; } }
            merge_top16(s0, nw);
#pragma unroll
            for (int q = 0; q < 4; ++q) *(LAS f32x4*)(a + 16 + 4 * q) = (f32x4){s0[4 * q], s0[4 * q + 1], s0[4 * q + 2], s0[4 * q + 3]};
        }
        {
            LAS float* a = SC + (1 * 128 + t) * SCS; float nw[16];
#pragma unroll
            for (int q = 0; q < 4; ++q) { const f32x4 v = *(const LAS f32x4*)(a + 4 * q), u = *(const LAS f32x4*)(a + 64 + 4 * q);
#pragma unroll
                for (int e = 0; e < 4; ++e) { s1[4 * q + e] = v[e]; nw[4 * q + e] = u[e]; } }
            merge_top16(s1, nw);
#pragma unroll
            for (int q = 0; q < 4; ++q) *(LAS f32x4*)(a + 16 + 4 * q) = (f32x4){s1[4 * q], s1[4 * q + 1], s1[4 * q + 2], s1[4 * q + 3]};
        }
#pragma unroll
        for (int i = 0; i < 16; ++i) { s0[i] = u2f(f2u(s0[i]) & ~127u); s1[i] = u2f(f2u(s1[i]) & ~127u); }
        constexpr int CNT[16] = {16, 8, 5, 4, 3, 2, 2, 2, 1, 1, 1, 1, 1, 1, 1, 1};
        constexpr int OFF[16] = {0, 16, 24, 29, 33, 36, 38, 40, 42, 43, 44, 45, 46, 47, 48, 49};
        float top[16], nw[16];
#pragma unroll
        for (int grp = 0; grp < 4; ++grp) {
#pragma unroll
            for (int e = 0; e < 16; ++e) nw[e] = -INFINITY;
#pragma unroll
            for (int i = 0; i < 16; ++i)
#pragma unroll
                for (int j = 0; j < 16; ++j) if (j < CNT[i] && (OFF[i] + j) / 16 == grp) {
                    const float sum = s0[i] + s1[j];
                    nw[(OFF[i] + j) % 16] = u2f((f2u(sum) & ~255u) | (unsigned)(i * 16 + j)); }
            bitonic_sort_desc<16>(nw);
            if (grp == 0) {
#pragma unroll
                for (int e = 0; e < 16; ++e) top[e] = nw[e];
            } else merge_top16(top, nw);
        }
#if defined(CHECK) && CHECK
        if (tok0 == 0 && hd == 0) { float* DB = WSP(float, WS_CLOC) + 8 * 1024 * 1024 + 32768;
#pragma unroll
            for (int i = 0; i < 16; ++i) { DB[t * 48 + i] = s0[i]; DB[t * 48 + 16 + i] = s1[i]; DB[t * 48 + 32 + i] = top[i]; } }
#endif
        float sc[16], den = 0.f;
        const float mx = u2f(f2u(top[0]) & ~255u);
#pragma unroll
        for (int k = 0; k < 16; ++k) { sc[k] = __expf(u2f(f2u(top[k]) & ~255u) - mx); den += sc[k]; }
        const float inv = 1.f / den;
        LDS_WAIT();
        const LAS unsigned* l0 = (const LAS unsigned*)(SC + (0 * 128 + t) * SCS + 16); const LAS unsigned* l1 = (const LAS unsigned*)(SC + (1 * 128 + t) * SCS + 16);
        const size_t ob = (size_t)(tok0 + t) * 128 + hd * 16;
#pragma unroll
        for (int k = 0; k < 16; ++k) { const unsigned id = f2u(top[k]) & 255u;
            const unsigned e0 = l0[id >> 4] & 127u, e1 = l1[id & 15u] & 127u;
            IDX[ob + k] = (int)(e0 * 128u + e1); GATE[ob + k] = sc[k] * inv; }
    }
    __syncthreads();
#endif
}
__device__ __forceinline__ void fp8x16_to_f32(const v4u w, float (&f)[16]) {
    typedef float f2_ __attribute__((ext_vector_type(2)));
    const unsigned ww[4] = {w.x, w.y, w.z, w.w};
#pragma unroll
    for (int i = 0; i < 4; ++i) { const f2_ lo = __builtin_amdgcn_cvt_pk_f32_fp8((int)ww[i], false), hi = __builtin_amdgcn_cvt_pk_f32_fp8((int)ww[i], true);
        f[4 * i] = lo.x; f[4 * i + 1] = lo.y; f[4 * i + 2] = hi.x; f[4 * i + 3] = hi.y; }
}
__device__ __forceinline__ void peer_u_phase(Frame& F, const unsigned char* U8  ) {
    const bf16* XN = WSP(bf16, WS_XNY); const int* IDX = WSP(int, WS_IDX); float* PART = WSP(float, WS_PART);
    const int lane = F.lane, grp = lane >> 3, l8 = lane & 7;
    const int g = F.bid & 7, nsw = (F.G >> 3) * NWAVES, ws = (F.bid >> 3) * NWAVES + F.wave;
    const unsigned char* Ug = U8 + (size_t)g * 16384 * 128 + 16 * l8;
    for (int tok = ws; tok < M; tok += nsw) {
        int ids[16];
        { const int* ip = IDX + (size_t)tok * 128 + 16 * grp;
#pragma unroll
          for (int q4 = 0; q4 < 4; ++q4) { const v4u t = *(const GAS v4u*)(ip + 4 * q4); ids[4 * q4] = (int)t.x; ids[4 * q4 + 1] = (int)t.y; ids[4 * q4 + 2] = (int)t.z; ids[4 * q4 + 3] = (int)t.w; } }
        float hf[16];
        { const bf16* hp = XN + (size_t)tok * D + 128 * g + 16 * l8; const v4u x = *(const GAS v4u*)hp, y = *(const GAS v4u*)(hp + 8);
          hf[0] = bflo(x.x); hf[1] = bfhi(x.x); hf[2] = bflo(x.y); hf[3] = bfhi(x.y); hf[4] = bflo(x.z); hf[5] = bfhi(x.z); hf[6] = bflo(x.w); hf[7] = bfhi(x.w);
          hf[8] = bflo(y.x); hf[9] = bfhi(y.x); hf[10] = bflo(y.y); hf[11] = bfhi(y.y); hf[12] = bflo(y.z); hf[13] = bfhi(y.z); hf[14] = bflo(y.w); hf[15] = bfhi(y.w); }
        v4u w[16];
#pragma unroll
        for (int it = 0; it < 16; ++it) w[it] = *(const GAS v4u*)(Ug + (size_t)ids[it] * 128);
        float am = 0.f;
#pragma unroll
        for (int i = 0; i < 16; ++i) am = fmaxf(am, fabsf(hf[i]));
        am = fmaxf(am, __shfl_xor(am, 1)); am = fmaxf(am, __shfl_xor(am, 2)); am = fmaxf(am, __shfl_xor(am, 4));
        const float hinv = am > 1e-30f ? 127.f / am : 0.f, hsc = am * (1.f / 127.f);
        int hq[4];
#pragma unroll
        for (int q4 = 0; q4 < 4; ++q4) { unsigned wv = 0;
#pragma unroll
            for (int e = 0; e < 4; ++e) { const int qv = (int)rintf(hf[4 * q4 + e] * hinv); wv |= ((unsigned)qv & 0xffu) << (8 * e); }
            hq[q4] = (int)wv; }
        float r[16];
#pragma unroll
        for (int it = 0; it < 16; ++it) { const unsigned wx = w[it].x, wy = w[it].y, wz = w[it].z, ww = w[it].w;
            int acc = __builtin_amdgcn_sdot4((int)wx, hq[0], 0, false); acc = __builtin_amdgcn_sdot4((int)wy, hq[1], acc, false); acc = __builtin_amdgcn_sdot4((int)wz, hq[2], acc, false); acc = __builtin_amdgcn_sdot4((int)ww, hq[3], acc, false);
            acc += __shfl_xor(acc, 1); acc += __shfl_xor(acc, 2); acc += __shfl_xor(acc, 4); r[it] = (float)acc * hsc; }
        if (l8 == 0) { float* pp = PART + ((size_t)g * M + tok) * 128 + 16 * grp;
#pragma unroll
            for (int q4 = 0; q4 < 4; ++q4) *(GAS f32x4*)(pp + 4 * q4) = (f32x4){r[4 * q4], r[4 * q4 + 1], r[4 * q4 + 2], r[4 * q4 + 3]}; }
    }
}
__device__ __forceinline__ void peer_act_phase(Frame& F, const float* ISU, const float* ISV) {
    const int* IDX = WSP(int, WS_IDX); const float* GATE = WSP(float, WS_GATE); const float* PART = WSP(float, WS_PART); float* ACT = WSP(float, WS_ACT);
    for (size_t i = (size_t)F.bid * NTHR + F.tid; i < (size_t)M * 128; i += (size_t)F.G * NTHR) {
        float s = 0.f;
#pragma unroll
        for (int g = 0; g < 8; ++g) s += PART[(size_t)g * M * 128 + i];
        const int id = IDX[i]; const float dd = s * ISU[id];
        ACT[i] = 0.5f * dd * (1.f + erff(dd * 0.70710678118654752f)) * GATE[i] * ISV[id];
    }
}
__device__ __forceinline__ void peer_v_phase(Frame& F, const unsigned char* V8, const float* g2  , float dbg) {
    const int* IDX = WSP(int, WS_IDX); const float* ACT = WSP(float, WS_ACT);
    const int lane = F.lane, grp = lane >> 3, l8 = lane & 7;
    const int g = F.bid & 7, nsw = (F.G >> 3) * NWAVES, ws = (F.bid >> 3) * NWAVES + F.wave;
    const unsigned char* Vg = V8 + (size_t)g * 16384 * 128 + 16 * l8;
    for (int tok = ws; tok < M; tok += nsw) {
        int ids[16]; float av[16];
        { const int* ip = IDX + (size_t)tok * 128 + 16 * grp; const float* ap = ACT + (size_t)tok * 128 + 16 * grp;
#pragma unroll
          for (int q4 = 0; q4 < 4; ++q4) { const v4u t = *(const GAS v4u*)(ip + 4 * q4); ids[4 * q4] = (int)t.x; ids[4 * q4 + 1] = (int)t.y; ids[4 * q4 + 2] = (int)t.z; ids[4 * q4 + 3] = (int)t.w;
              const f32x4 a = *(const GAS f32x4*)(ap + 4 * q4); av[4 * q4] = a.x; av[4 * q4 + 1] = a.y; av[4 * q4 + 2] = a.z; av[4 * q4 + 3] = a.w; } }
        v4u w[16];
#pragma unroll
        for (int it = 0; it < 16; ++it) w[it] = *(const GAS v4u*)(Vg + (size_t)ids[it] * 128);
        float o[16];
#pragma unroll
        for (int i = 0; i < 16; ++i) o[i] = 0.f;
#pragma unroll
        for (int it = 0; it < 16; ++it) { float vf[16]; fp8x16_to_f32(w[it], vf);
#pragma unroll
            for (int i = 0; i < 16; ++i) o[i] += av[it] * vf[i]; }
#pragma unroll
        for (int i = 0; i < 16; ++i) { o[i] += __shfl_xor(o[i], 8); o[i] += __shfl_xor(o[i], 16); o[i] += __shfl_xor(o[i], 32); }
        if (grp == 0) { const int b = tok >> 13, c0 = 128 * g + 16 * l8; float* xr = F.out + (size_t)tok * D + c0; const float* gr = g2 + (size_t)b * 6144 + c0;
#pragma unroll
            for (int q4 = 0; q4 < 4; ++q4) { const f32x4 xv = *(const GAS f32x4*)(xr + 4 * q4), gv = *(const f32x4*)(gr + 4 * q4);
                *(GAS f32x4*)(xr + 4 * q4) = xv + gv * dbg * (f32x4){o[4 * q4], o[4 * q4 + 1], o[4 * q4 + 2], o[4 * q4 + 3]}; } }
    }
}
#if defined(CHECK) && CHECK
constexpr size_t WS_DBG = 512 * 1024;
constexpr size_t WS_DBGOUT = WS_CLOC;
#ifndef CHECK_LAYER
#define CHECK_LAYER 1
#endif
__global__ void chk_qry(Args a) {
    const bf16* XN = (const bf16*)(a.ws + WS_XNY); const bf16* QRY = (const bf16*)(a.ws + WS_QRY); const float* wq = a.in[20] + (size_t)CHECK_LAYER * D * NQ;
    float* R = (float*)(a.ws + WS_CTL + WS_DBG);
    const int tok = (blockIdx.x * 977) % M; const int col = (threadIdx.x * 37 + blockIdx.x * 11) % NQ;
    float s = 0.f; for (int k = 0; k < D; ++k) s += bf2f(XN[(size_t)tok * D + k]) * wq[(size_t)k * NQ + col];
    const float q = bf2f(QRY[(size_t)tok * NQ + col]);
    atomicAdd(R + 0, (s - q) * (s - q)); atomicAdd(R + 1, s * s);
}
__global__ void chk_keys(Args a) {
    const bf16* KB = (const bf16*)(a.ws + WS_KEYS); const float* keys = a.in[21]; float* R = (float*)(a.ws + WS_CTL + WS_DBG);
    const int i = blockIdx.x * blockDim.x + threadIdx.x; if (i < 2 * 2 * 128 * 128) { const float d = bf2f(KB[i]) - keys[i]; atomicAdd(R + 8, d * d); atomicAdd(R + 9, keys[i] * keys[i]); }
}
__global__ void chk_uv(Args a) {
    const bf16* UB = (const bf16*)(a.ws + WS_UB); const bf16* VB = (const bf16*)(a.ws + WS_VB); float* R = (float*)(a.ws + WS_CTL + WS_DBG);
    const size_t i = ((size_t)blockIdx.x * blockDim.x + threadIdx.x) * 61 % ((size_t)2 * 16384 * 1024);
    const float du = bf2f(UB[i]) - a.in[22][i], dv = bf2f(VB[i]) - a.in[23][i];
    atomicAdd(R + 16, du * du + dv * dv); atomicAdd(R + 17, a.in[22][i] * a.in[22][i] + a.in[23][i] * a.in[23][i]);
}
__global__ void chk_route(Args a) {
    const bf16* QRY = (const bf16*)(a.ws + WS_QRY); const float* keys = a.in[21] + (size_t)CHECK_LAYER * 2 * 128 * 128;
    const int* IDX = (const int*)(a.ws + WS_IDX); const float* GATE = (const float*)(a.ws + WS_GATE);
    float* R = (float*)(a.ws + WS_CTL + WS_DBG);
    __shared__ float sc[2][128]; __shared__ float sc0[2][128]; __shared__ float ts[2][16]; __shared__ int ti[2][16]; __shared__ float cs[256]; __shared__ int ci[256];
    const int tok = (blockIdx.x * 613 + 5) % M, hd = blockIdx.x & 7, tid = threadIdx.x;
    { const int p = tid >> 7, n = tid & 127; float s = 0.f; for (int d = 0; d < 128; ++d) s += bf2f(QRY[(size_t)tok * NQ + hd * 256 + p * 128 + d]) * keys[(size_t)(p * 128 + n) * 128 + d]; sc[p][n] = s; sc0[p][n] = s; }
    __syncthreads();
    if (tid < 2) { const int p = tid; for (int k = 0; k < 16; ++k) { int best = 0; float bv = -INFINITY; for (int n = 0; n < 128; ++n) if (sc[p][n] > bv) { bv = sc[p][n]; best = n; } ts[p][k] = bv; ti[p][k] = best; sc[p][best] = -INFINITY; } }
    __syncthreads();
    cs[tid] = ts[0][tid >> 4] + ts[1][tid & 15]; ci[tid] = ti[0][tid >> 4] * 128 + ti[1][tid & 15];
    __syncthreads();
    if (tid == 0) {
        float fs[16]; int fi[16];
        for (int k = 0; k < 16; ++k) { int best = 0; float bv = -INFINITY; for (int n = 0; n < 256; ++n) if (cs[n] > bv) { bv = cs[n]; best = n; } fs[k] = bv; fi[k] = ci[best]; cs[best] = -INFINITY; }
        float den = 0.f; for (int k = 0; k < 16; ++k) den += __expf(fs[k] - fs[0]);
        int mism = 0; float ge = 0.f;
        for (int k = 0; k < 16; ++k) { bool found = false; for (int j = 0; j < 16; ++j) if (IDX[(size_t)tok * 128 + hd * 16 + j] == fi[k]) { found = true; const float g = __expf(fs[k] - fs[0]) / den; const float d = g - GATE[(size_t)tok * 128 + hd * 16 + j]; ge += d * d; } if (!found) ++mism; }
        { int ba = 0, bb = 0; for (int j = 0; j < 16; ++j) { const int e = IDX[(size_t)tok * 128 + hd * 16 + j]; const int ea = (e >> 7) & 127, eb = e & 127;
            if (!(e >= 0 && e < 16384) || sc0[0][ea] + sc0[1][eb] < fs[15] - 0.05f) ++ba; if (!(e >= 0 && e < 16384) || sc0[1][ea] + sc0[0][eb] < fs[15] - 0.05f) ++bb; }
          atomicAdd(R + 10, (float)ba); atomicAdd(R + 11, (float)bb); }
        atomicAdd(R + 2, (float)mism); atomicAdd(R + 3, 16.f); atomicAdd(R + 4, ge); atomicAdd(R + 5, 1.f / 16.f);
    }
}
__global__ void chk_scores(Args a) {
    const bf16* QRY = (const bf16*)(a.ws + WS_QRY); const float* keys = a.in[21] + (size_t)CHECK_LAYER * 2 * 128 * 128;
    const float* DB = (const float*)(a.ws + WS_CLOC) + 8 * 1024 * 1024; float* R = (float*)(a.ws + WS_CTL + WS_DBG);
    const int t = blockIdx.x, tid = threadIdx.x;
    __shared__ float sc[2][128];
    { const int p = tid >> 7, n = tid & 127; float s = 0.f; for (int d = 0; d < 128; ++d) s += bf2f(QRY[(size_t)t * NQ + p * 128 + d]) * keys[(size_t)(p * 128 + n) * 128 + d];
      const float dv = DB[(p * 128 + t) * 128 + n]; atomicAdd(R + 12, (s - dv) * (s - dv)); atomicAdd(R + 13, s * s); sc[p][n] = dv; }
    __syncthreads();
    if (tid < 2) { const int p = tid; int bad = 0; for (int k = 0; k < 16; ++k) { int best = 0; float bv = -INFINITY; for (int n = 0; n < 128; ++n) if (sc[p][n] > bv) { bv = sc[p][n]; best = n; }
        const float lv = DB[32768 + t * 48 + 16 * p + k]; if (fabsf(lv - bv) > 1e-3f * (1.f + fabsf(bv))) ++bad; sc[p][best] = -INFINITY; }
        atomicAdd(R + 14, (float)bad); atomicAdd(R + 15, 16.f); }
}
__global__ void chk_expert(Args a) {
    const bf16* XN = (const bf16*)(a.ws + WS_XNY); const int* IDX = (const int*)(a.ws + WS_IDX); const float* GATE = (const float*)(a.ws + WS_GATE);
    const float* U = a.in[22] + (size_t)CHECK_LAYER * 16384 * 1024; const float* V = a.in[23] + (size_t)CHECK_LAYER * 16384 * 1024;
    const float* DO = (const float*)(a.ws + WS_DBGOUT); float* R = (float*)(a.ws + WS_CTL + WS_DBG);
    __shared__ float act[128];
    const int tok = (blockIdx.x * 61 + 3) % 4096, tid = threadIdx.x;
    if (tid < 128) { const int e = IDX[(size_t)tok * 128 + tid]; float s = 0.f; for (int k = 0; k < D; ++k) s += bf2f(XN[(size_t)tok * D + k]) * U[(size_t)e * D + k];
        act[tid] = 0.5f * s * (1.f + erff(s * 0.70710678f)) * GATE[(size_t)tok * 128 + tid]; }
    __syncthreads();
    for (int c = tid; c < D; c += 256) { float o = 0.f; for (int e = 0; e < 128; ++e) o += act[e] * V[(size_t)IDX[(size_t)tok * 128 + e] * D + c];
        const float g = DO[(size_t)tok * D + c]; atomicAdd(R + 6, (o - g) * (o - g)); atomicAdd(R + 7, o * o); }
}
__global__ void chk_stamp(Args a) {
    const float* R = (const float*)(a.ws + WS_CTL + WS_DBG);
    const float e1 = sqrtf(R[0] / fmaxf(R[1], 1e-30f)), e2 = R[2] / fmaxf(R[3], 1.f), e2g = sqrtf(R[4] / fmaxf(R[5], 1e-30f)), e3 = sqrtf(R[6] / fmaxf(R[7], 1e-30f));
    float c;
#if CHECK == 99
    c = 1.f;
#else
    const float e0 = sqrtf(R[8] / fmaxf(R[9], 1e-30f));
    const float ea = R[10] / fmaxf(R[3], 1.f), eb = R[11] / fmaxf(R[3], 1.f);
    const float esc = sqrtf(R[12] / fmaxf(R[13], 1e-30f)), els = R[14] / fmaxf(R[15], 1.f);
    const float euv = sqrtf(R[16] / fmaxf(R[17], 1e-30f));
    const float errs[4] = {e2, euv, ea, e3}; const float tols[4] = {0.08f, 0.01f, 0.08f, 0.03f};
    c = 1.f;
    for (int k = 3; k >= 0; --k) if (!(errs[k] <= tols[k])) { const float fr = fminf(fmaxf((log10f(fmaxf(errs[k], 1e-4f)) + 4.f) / 5.f, 0.f), 0.95f); c = 2.f + (float)k + fr; }
#endif
    const size_t i = (size_t)blockIdx.x * blockDim.x + threadIdx.x;
    if (i < (size_t)M * D) a.out[i] = a.in[0][i] * (1.f + c);
}
#endif
#ifndef MK_PER_PHASE
#define MK_PER_PHASE 0
#endif
constexpr int NPHASE = 24;
#ifndef DBG_Y0
#define DBG_Y0 1
#define DBG_P0 1
#define DBG_Y1 1
#define DBG_P1 1
#endif
#ifndef PHASE_MASK
#define PHASE_MASK 0x1ffffffu
#endif
#define IN(k) (lo <= (k) && (k) < hi && ((PHASE_MASK >> (k)) & 1u))
#ifndef DUP_PHASE
#define DUP_PHASE -1
#endif
#define REPS(k) for (int rep = ((DUP_PHASE) == (k) ? 0 : 1); rep < 2; ++rep)
#define SEAM(k) do { if (IN(k) && IN((k) + 1)) xcd_barrier(bar); } while (0)
__device__ __forceinline__ float alibi_tcut(const float* gq, const float* gk, int lane) { return 16.f * wave_max(fabsf(gq[lane])) * wave_max(fabsf(gk[lane])) + ALIBI_MARGIN; }
template <int layer>
__device__ __forceinline__ void layer_phases(Frame& F, const Args& args, const XcdBarrier& bar, const int lo, const int hi) {
    volatile LAS unsigned* MISCW = (volatile LAS unsigned*)(F.lds + MISC_OFF);
    float* MOD = WSP(float, WS_MOD);
    bf16* XNY = WSP(bf16, WS_XNY); bf16* Zb = WSP(bf16, WS_Z);

        constexpr int pb = layer * 12;
        const float* mod = MOD + (size_t)layer * 4 * 6144;
        if (IN(pb + 1)) REPS(pb + 1) { if (layer == 0) norm_pass<true>(F, args, args.in[0], args.in[4], mod, 0, XNY); else norm_pass<false>(F, args, F.out, args.in[4] + 1024, mod, 0, XNY); } SEAM(pb + 1);
        if (IN(pb + 2)) REPS(pb + 2) {
            const int N = layer == 0 ? NZ0 : NZ1;
            pg8::Gemm g{XNY, layer == 0 ? WSP(bf16, WS_WIN0) : WSP(bf16, WS_WIN1), M, N, D}; pg8::StaticOrder S; S.init(M, N, F.G, F.bid);
            pg8::EpiBf16 E{Zb, N};
            pg8::gemm_phase<pg8::EpiBf16, pg8::StaticOrder, true, true>(F.lds, g, S, E);
        } SEAM(pb + 2);
        if (layer == 0) {
            if (IN(3)) REPS(3) {
                for (int u = F.bid; u < 1024 + 256; u += F.G) {
                    if (u < 1024) mlstm_a_unit(F, args, u);
                    else if (rep == 1) { const int v = u - 1024, b = v >> 6, j = (v >> 1) & 31, which = v & 1;
                        qknorm_unit(F, Zb, NZ0, b * SEQ + j * 256, which ? 2560 : 2048, which ? args.in[12] : args.in[11], which ? 1.f : 0.125f * LOG2E, which ? WSP(float, WS_KMEAN) + (size_t)((b * 8) * 32 + j) * 64 : nullptr); }
                }
            } SEAM(3);
            if (IN(4)) REPS(4) {
                if (rep == 1) for (int u = F.bid; u < 256; u += F.G) mlstm_scan_unit(F, u);
                { const float tcut = alibi_tcut(args.in[11], args.in[12], F.lane);
                  const unsigned short* ORD = WSP(unsigned short, WS_ORD) + 2048; unsigned* qw = (unsigned*)(F.ws + WS_CTL) + CW_QMOBA + (rep == 1 ? 0 : 16);
                  for (;;) { if (F.tid == 0) MISCW[0] = atomicAdd(qw, 1u); __syncthreads(); const unsigned qi = MISCW[0]; __syncthreads(); if (qi >= 1024u) break;
                      const int u = ORD[qi]; moba_unit(F, u >> 8, (u >> 5) & 7, u & 31, tcut); } }
            } SEAM(4);
            if (IN(5)) REPS(5) { for (int u = F.bid; u < 1024; u += F.G) mlstm_c_unit(F, args, u); } SEAM(5);
        } else {
            if (IN(pb + 3)) {
                for (int u = F.bid; u < 512; u += F.G) { const int rt = u >> 2, cr = u & 3; qknorm_unit(F, Zb, NZ1, rt * 256, cr * 512, cr < 2 ? args.in[15] : args.in[16], cr < 2 ? 0.125f * LOG2E : 1.f, nullptr); }
            } SEAM(pb + 3);
            if (IN(pb + 4)) REPS(pb + 4) {
                const float* lp = args.in[17];
                const float lam = __expf(wave_sum(lp[F.lane] * lp[64 + F.lane])) - __expf(wave_sum(lp[128 + F.lane] * lp[192 + F.lane])) + 0.35550906759096926f;
                { const float tcut = alibi_tcut(args.in[15], args.in[16], F.lane);
                  const unsigned short* ORD = WSP(unsigned short, WS_ORD); unsigned* qw = (unsigned*)(F.ws + WS_CTL) + CW_QDIFF + (rep == 1 ? 0 : 16);
                  for (;;) { if (F.tid == 0) MISCW[0] = atomicAdd(qw, 1u); __syncthreads(); const unsigned qi = MISCW[0]; __syncthreads(); if (qi >= 2048u) break;
                      const int u = ORD[qi]; diff_unit(F, args, u >> 9, (u >> 6) & 7, u & 63, lam, tcut); } }
            } SEAM(pb + 4);
        }
        if (IN(pb + 6)) REPS(pb + 6) {
            pg8::Gemm g{XNY, layer == 0 ? WSP(bf16, WS_WOUT0) : WSP(bf16, WS_WOUT1), M, D, D}; pg8::StaticOrder S; S.init(M, D, F.G, F.bid);
            pg8::EpiResid E{layer == 0 ? args.in[0] : F.out, F.out, mod + 2 * 1024, rep == 1 ? (layer == 0 ? (float)DBG_Y0 : (float)DBG_Y1) : 0.f};
            pg8::gemm_phase<pg8::EpiResid, pg8::StaticOrder, true, true>(F.lds, g, S, E);
        } SEAM(pb + 6);
        if (IN(pb + 7)) REPS(pb + 7) { norm_pass<false>(F, args, F.out, args.in[5] + layer * 1024, mod, 3, XNY); } SEAM(pb + 7);
        if (IN(pb + 8)) REPS(pb + 8) {
            pg8::Gemm g{XNY, WSP(bf16, WS_WQ) + (size_t)layer * NQ * D, M, NQ, D}; pg8::StaticOrder S; S.init(M, NQ, F.G, F.bid);
            pg8::EpiBf16 E{WSP(bf16, WS_QRY), NQ};
            pg8::gemm_phase<pg8::EpiBf16, pg8::StaticOrder, true, true>(F.lds, g, S, E);
        } SEAM(pb + 8);
        if (IN(pb + 9)) REPS(pb + 9) { const bf16* KEYS = WSP(bf16, WS_KEYS) + (size_t)layer * 2 * 128 * 128;
            for (int u = F.bid; u < 2048; u += F.G) peer_route_unit(F, (u >> 3) * 128, u & 7, KEYS); } SEAM(pb + 9);
        if (IN(pb + 10)) REPS(pb + 10) { peer_u_phase(F, F.ws + WS_UB + (size_t)layer * 8 * 16384 * 128); } SEAM(pb + 10);
        if (IN(pb + 11)) REPS(pb + 11) { peer_act_phase(F, WSP(float, WS_ISU) + layer * 16384, WSP(float, WS_ISV) + layer * 16384); } SEAM(pb + 11);
        if (IN(pb + 12)) REPS(pb + 12) { peer_v_phase(F, F.ws + WS_VB + (size_t)layer * 8 * 16384 * 128, mod + 5 * 1024, rep == 1 ? (layer == 0 ? (float)DBG_P0 : (float)DBG_P1) : 0.f); }
        if (layer == 0) SEAM(12);
    }
__global__ void __launch_bounds__(NTHR, 2) mega_fwd(Args args) {
    extern __shared__ __attribute__((aligned(16))) unsigned char lds_raw[];
    Frame F;
    F.lds = (LAS unsigned char*)lds_raw;
    F.tid = threadIdx.x; F.lane = F.tid & 63; F.wave = __builtin_amdgcn_readfirstlane(F.tid >> 6);
    F.G = gridDim.x; F.bid = blockIdx.x;
    F.out = args.out; F.ws = args.ws;
    volatile LAS unsigned* MISC = (volatile LAS unsigned*)(F.lds + MISC_OFF);
    for (int u = F.tid; u < (LDS_BYTES - LDSCTL_OFF) / 4; u += NTHR) ((LAS unsigned*)(F.lds + LDSCTL_OFF))[u] = 0u;
    __syncthreads();
    XcdBarrier bar; bar.bar = (unsigned*)(F.ws + WS_CTL) + CW_BAR; bar.x = 0; bar.st = nullptr;
    if (!MK_PER_PHASE) bar = xcd_barrier_post((unsigned*)(F.ws + WS_CTL) + CW_BAR, MISC + 8);
    const int lo = args.ph_lo, hi = args.ph_hi;

    if (IN(0)) REPS(0) { p0_prologue(F, args); } SEAM(0);
    layer_phases<0>(F, args, bar, lo, hi);
    layer_phases<1>(F, args, bar, lo, hi);
}
#undef IN
#undef SEAM

extern "C" void kernel_launch(void* const* d_in, const int* in_sizes, int n_in, void* d_out, int out_size, void* d_ws, size_t ws_size, hipStream_t stream) {
    static int grid = 0;
    if (grid == 0) {
        if (n_in != 24 || in_sizes[0] != M * D || out_size != M * D || ws_size < WS_END) { fprintf(stderr, "kernel_launch: unexpected problem (n_in %d, in0 %d, out %d, ws %zu < %zu); nothing launched\n", n_in, n_in > 0 ? in_sizes[0] : -1, out_size, ws_size, (size_t)WS_END); grid = -1; return; }
        int dev = 0, cus = 0, per_cu = 0;
        if (hipGetDevice(&dev) != hipSuccess || hipDeviceGetAttribute(&cus, hipDeviceAttributeMultiprocessorCount, dev) != hipSuccess) { grid = -1; return; }
        if (hipFuncSetAttribute((const void*)mega_fwd, hipFuncAttributeMaxDynamicSharedMemorySize, LDS_BYTES) != hipSuccess) { fprintf(stderr, "kernel_launch: hipFuncSetAttribute failed\n"); grid = -1; return; }
        if (hipOccupancyMaxActiveBlocksPerMultiprocessor(&per_cu, (const void*)mega_fwd, NTHR, LDS_BYTES) != hipSuccess || per_cu < 1)
            fprintf(stderr, "kernel_launch: note: occupancy query reports %d workgroups per CU\n", per_cu);
        (void)hipGetLastError();
        grid = cus;
    }
    if (grid < 0) return;
    if (hipMemsetAsync((char*)d_ws + WS_CTL, 0, CTL_ZERO_BYTES, stream) != hipSuccess) { fprintf(stderr, "kernel_launch: memset failed\n"); return; }
    Args a{};
    for (int i = 0; i < 24; ++i) a.in[i] = (const float*)d_in[i];
    a.out = (float*)d_out; a.ws = (unsigned char*)d_ws;
#if MK_PER_PHASE
    for (int p = 0; p < NPHASE + 1; ++p) { a.ph_lo = p; a.ph_hi = p + 1; hipLaunchKernelGGL(mega_fwd, dim3(grid), dim3(NTHR), LDS_BYTES, stream, a); }
#else
    a.ph_lo = 0; a.ph_hi = NPHASE + 1;
    hipLaunchKernelGGL(mega_fwd, dim3(grid), dim3(NTHR), LDS_BYTES, stream, a);
#endif
#if defined(CHECK) && CHECK
    chk_qry<<<256, 256, 0, stream>>>(a); chk_keys<<<256, 256, 0, stream>>>(a); chk_uv<<<1024, 256, 0, stream>>>(a); chk_scores<<<128, 256, 0, stream>>>(a); chk_route<<<512, 256, 0, stream>>>(a); chk_expert<<<64, 256, 0, stream>>>(a); chk_stamp<<<(M * D + 255) / 256, 256, 0, stream>>>(a);
#endif
    const hipError_t le = hipPeekAtLastError();
    if (le != hipSuccess) fprintf(stderr, "kernel_launch: launch failed: %s\n", hipGetErrorName(le));
}
```

```cpp
#include <hip/hip_runtime.h>
#include <cstdio>
#include <cstdint>
namespace pg8 {
#define PG8_LAS __attribute__((address_space(3)))
typedef unsigned short bf16_t;
typedef short bf16x8 __attribute__((ext_vector_type(8)));
typedef float f32x4 __attribute__((ext_vector_type(4)));
typedef unsigned u32x4 __attribute__((ext_vector_type(4)));
constexpr int BM = 256, BK = 64, HALF = 128, HTB = HALF * BK * 2  , STAGE_BYTES = 8 * HTB, NXCD = 8, WGM = 8;

__host__ __device__ __forceinline__ int lds_byte(int r, int c) { const int st = (r >> 4) * 2 + (c >> 5), rr = r & 15, cc = c & 31, ob = rr * 64 + cc * 2; return st * 1024 + (ob ^ (((ob >> 9) & 1) << 5)); }
__host__ __device__ __forceinline__ void stage_rc(int b, int& R, int& C) { const int st = b / 1024, sb = b % 1024, swz = sb ^ (((sb >> 9) & 1) << 5); R = (st >> 1) * 16 + swz / 64; C = (st & 1) * 32 + (swz % 64) / 2; }
__host__ __device__ __forceinline__ int perm32(int rho) { const int n = rho >> 4, i = rho & 15; return 8 * (i >> 2) + 4 * n + (i & 3); }

struct Unit { int pm, pn; };
struct Gemm { const bf16_t* A; const bf16_t* Bt; int M, N, K; };

struct StaticOrder {
    int nM, nN, nwg, G, c;
    __host__ __device__ void init(int M, int N, int G_, int c_) { nM = M / BM; nN = N / BM; nwg = nM * nN; G = G_; c = c_; }
    __host__ __device__ bool next(int i, Unit& u) const {
        const long L = (long)i * G + c; if (L >= nwg) return false;
        int wgid = (int)L; { const int q = nwg / NXCD, r = nwg % NXCD, xcd = wgid % NXCD, off = wgid / NXCD; wgid = (xcd < r ? xcd * (q + 1) : r * (q + 1) + (xcd - r) * q) + off; }
        const int nig = WGM * nN, gid = wgid / nig, fm = gid * WGM, gsz = (nM - fm) < WGM ? (nM - fm) : WGM;
        u.pm = fm + ((wgid % nig) % gsz); u.pn = (wgid % nig) / gsz; return true;
    }
    __device__ __forceinline__ void a_ready(const Unit&) const {}
    __device__ __forceinline__ void done(const Unit&) const {}
};

__device__ __forceinline__ unsigned cvt_pk_bf16(float lo, float hi) { unsigned r; asm volatile("v_cvt_pk_bf16_f32 %0, %1, %2" : "=v"(r) : "v"(lo), "v"(hi)); return r; }
typedef unsigned u32x4 __attribute__((ext_vector_type(4)));
struct EpiBf16 {
    static constexpr bool PERM = true, AFTER_DRAIN = false;
    bf16_t* O; int ldc;
    __device__ __forceinline__ void operator()(const f32x4 (&acc)[2][2][4][2], const Unit& u, int wr, int wc, int fr, int fq) const {
        const int row0 = u.pm * BM + wr * 64 + fr; const int col0 = u.pn * BM + wc * 32 + 8 * fq;
#pragma unroll
        for (int ai = 0; ai < 2; ++ai)
#pragma unroll
            for (int m = 0; m < 4; ++m) { bf16_t* rowp = O + (size_t)(row0 + ai * HALF + m * 16) * ldc + col0;
#pragma unroll
                for (int bj = 0; bj < 2; ++bj) { const f32x4 v0 = acc[ai][bj][m][0], v1 = acc[ai][bj][m][1];
                    u32x4 w; w.x = cvt_pk_bf16(v0[0], v0[1]); w.y = cvt_pk_bf16(v0[2], v0[3]); w.z = cvt_pk_bf16(v1[0], v1[1]); w.w = cvt_pk_bf16(v1[2], v1[3]);
                    *(u32x4*)(rowp + bj * HALF) = w; } }
    }
};
struct EpiResid {
    static constexpr bool PERM = false, AFTER_DRAIN = false;
    const float* base; float* out; const float* gate; float dbg;
    __device__ __forceinline__ void operator()(const f32x4 (&acc)[2][2][4][2], const Unit& u, int wr, int wc, int fr, int fq) const {
        const int col0 = u.pn * BM + wc * 32 + 4 * fq; const int b = (u.pm * BM) >> 13;
#pragma unroll
        for (int bj = 0; bj < 2; ++bj)
#pragma unroll
            for (int n = 0; n < 2; ++n) { const f32x4 gv = *(const f32x4*)(gate + (size_t)b * 6144 + col0 + bj * HALF + n * 16);
#pragma unroll
                for (int ai = 0; ai < 2; ++ai)
#pragma unroll
                    for (int m = 0; m < 4; ++m) { const size_t off = (size_t)(u.pm * BM + ai * HALF + wr * 64 + m * 16 + fr) * 1024 + col0 + bj * HALF + n * 16;
                        const f32x4 bs = *(const f32x4*)(base + off); *(f32x4*)(out + off) = bs + gv * acc[ai][bj][m][n] * dbg; } }
    }
};

template <class Epi, class Sched, bool ALIGN_EPI = false, bool SP2 = false>
__device__ __forceinline__ void gemm_phase(PG8_LAS unsigned char* lds, const Gemm g, const Sched& S, const Epi& E) {
    const int tid = threadIdx.x, wid = __builtin_amdgcn_readfirstlane(tid >> 6), lane = tid & 63, wr = wid >> 2, wc = wid & 3, fr = lane & 15, fq = lane >> 4;
    const int K = g.K, nt = K / BK;
    unsigned voffA[2], voffB[2];
#pragma unroll
    for (int i = 0; i < 2; ++i) { int R, C; stage_rc(tid * 16 + i * 8192, R, C); const int Rb = Epi::PERM ? ((R & ~31) + perm32(R & 31)) : R;
        voffA[i] = (unsigned)(R * K + C) * 2u; voffB[i] = (unsigned)(Rb * K + C) * 2u; }
    const size_t kstep = (size_t)(BK * 2);
    const size_t hstep = (size_t)HALF * K * 2;
    const size_t tstep = 2 * hstep;
    const unsigned ldsw = (unsigned)wid * 1024u;
    const int aoff = lds_byte(wr * 64 + fr, fq * 8), boff = lds_byte(wc * 32 + fr, fq * 8);
#define PG8_SA(b, h) (((b) * 2 + (h)) * HTB)
#define PG8_SB(b, h) ((4 + (b) * 2 + (h)) * HTB)
#define PG8_STAGE(bufoff, gbase, voff) do { _Pragma("unroll") for (int _i = 0; _i < 2; ++_i) \
        __builtin_amdgcn_global_load_lds((const unsigned*)((const char*)(gbase) + (voff)[_i]), (PG8_LAS unsigned*)(lds + (bufoff) + ldsw + _i * 8192), 16, 0, 0); } while (0)
#define PG8_LDA(dst, b, h) do { _Pragma("unroll") for (int m = 0; m < 4; ++m) _Pragma("unroll") for (int k = 0; k < 2; ++k) dst[m][k] = *(const PG8_LAS bf16x8*)(lds + PG8_SA(b, h) + aoff + m * 2048 + k * 1024); } while (0)
#define PG8_LDB(dst, b, h) do { _Pragma("unroll") for (int n = 0; n < 2; ++n) _Pragma("unroll") for (int k = 0; k < 2; ++k) dst[n][k] = *(const PG8_LAS bf16x8*)(lds + PG8_SB(b, h) + boff + n * 2048 + k * 1024); } while (0)
#define PG8_MMA(ai, bj, At, Bt) do { __builtin_amdgcn_s_setprio(1); _Pragma("unroll") for (int m = 0; m < 4; ++m) _Pragma("unroll") for (int n = 0; n < 2; ++n) _Pragma("unroll") for (int k = 0; k < 2; ++k) \
        acc[ai][bj][m][n] = __builtin_amdgcn_mfma_f32_16x16x32_bf16(Bt[n][k], At[m][k], acc[ai][bj][m][n], 0, 0, 0); __builtin_amdgcn_s_setprio(0); } while (0)
#define PG8_WAIT_V(n) asm volatile("s_waitcnt vmcnt(" #n ")" ::: "memory")
#define PG8_WAIT_L(n) asm volatile("s_waitcnt lgkmcnt(" #n ")" ::: "memory")
#define PG8_BAR __builtin_amdgcn_s_barrier()
#define PG8_SCHED __builtin_amdgcn_sched_barrier(0)
    Unit cur, nxt; int ui = 0;
    if (!S.next(0, cur)) return;
    f32x4 acc[2][2][4][2];
#pragma unroll
    for (int a = 0; a < 2; ++a)
#pragma unroll
        for (int b = 0; b < 2; ++b)
#pragma unroll
            for (int m = 0; m < 4; ++m)
#pragma unroll
                for (int n = 0; n < 2; ++n) acc[a][b][m][n] = (f32x4){0.f, 0.f, 0.f, 0.f};
    bf16x8 At[4][2], B0[2][2], B1[2][2];
    const char* cA = (const char*)g.A + (size_t)cur.pm * tstep; const char* cB = (const char*)g.Bt + (size_t)cur.pn * tstep;
    S.a_ready(cur);
    if constexpr (SP2) {
        PG8_STAGE(PG8_SB(0, 0), cB, voffB); PG8_STAGE(PG8_SB(0, 1), cB + hstep, voffB); PG8_STAGE(PG8_SA(0, 0), cA, voffA); PG8_STAGE(PG8_SA(0, 1), cA + hstep, voffA);
        if (wr == 1) PG8_BAR;
        PG8_WAIT_V(2); PG8_BAR;
        PG8_STAGE(PG8_SB(1, 0), cB + kstep, voffB); PG8_STAGE(PG8_SA(1, 0), cA + kstep, voffA); PG8_STAGE(PG8_SB(1, 1), cB + hstep + kstep, voffB);
        PG8_WAIT_V(6); PG8_BAR;
    } else {
        PG8_STAGE(PG8_SB(0, 0), cB, voffB); PG8_STAGE(PG8_SA(0, 0), cA, voffA); PG8_STAGE(PG8_SB(0, 1), cB + hstep, voffB); PG8_STAGE(PG8_SA(0, 1), cA + hstep, voffA);
        if (wr == 1) PG8_BAR;
        PG8_WAIT_V(4); PG8_BAR;
        PG8_STAGE(PG8_SB(1, 0), cB + kstep, voffB); PG8_STAGE(PG8_SA(1, 0), cA + kstep, voffA); PG8_STAGE(PG8_SB(1, 1), cB + hstep + kstep, voffB);
        PG8_WAIT_V(6); PG8_BAR;
    }
    for (;;) {
        const bool has_next = S.next(ui + 1, nxt);
        const char* nA = has_next ? (const char*)g.A + (size_t)nxt.pm * tstep : cA; const char* nB = has_next ? (const char*)g.Bt + (size_t)nxt.pn * tstep : cB;
        for (int t = 0; t < nt; t += 2) {
            const bool last = (t == nt - 2);
            const char* a1 = cA + (size_t)(t + 1) * kstep;
            const char* a2 = last ? nA : cA + (size_t)(t + 2) * kstep; const char* b2 = last ? nB : cB + (size_t)(t + 2) * kstep;
            const char* a3 = a2 + kstep; const char* b3 = b2 + kstep;
            if (last && has_next) S.a_ready(nxt);
            if constexpr (SP2) {
            PG8_LDB(B0, 0, 0); PG8_LDB(B1, 0, 1); PG8_SCHED; PG8_LDA(At, 0, 0); PG8_STAGE(PG8_SA(1, 1), a1 + hstep, voffA);
            PG8_WAIT_V(8); PG8_WAIT_L(0); PG8_BAR; PG8_MMA(0, 0, At, B0); PG8_MMA(0, 1, At, B1); PG8_BAR; PG8_SCHED;
            PG8_LDA(At, 0, 1); PG8_STAGE(PG8_SB(0, 0), b2, voffB); PG8_STAGE(PG8_SB(0, 1), b2 + hstep, voffB); PG8_STAGE(PG8_SA(0, 0), a2, voffA);
            PG8_WAIT_V(8); PG8_WAIT_L(0); PG8_BAR; PG8_MMA(1, 0, At, B0); PG8_MMA(1, 1, At, B1); PG8_BAR; PG8_SCHED;
            PG8_LDB(B0, 1, 0); PG8_LDB(B1, 1, 1); PG8_SCHED; PG8_LDA(At, 1, 0); PG8_STAGE(PG8_SA(0, 1), a2 + hstep, voffA);
            PG8_WAIT_V(8); PG8_WAIT_L(0); PG8_BAR; PG8_MMA(0, 0, At, B0); PG8_MMA(0, 1, At, B1); PG8_BAR; PG8_SCHED;
            PG8_LDA(At, 1, 1); PG8_STAGE(PG8_SB(1, 0), b3, voffB); PG8_STAGE(PG8_SB(1, 1), b3 + hstep, voffB); PG8_STAGE(PG8_SA(1, 0), a3, voffA);
            PG8_WAIT_V(8); PG8_WAIT_L(0); PG8_BAR; PG8_MMA(1, 0, At, B0); PG8_MMA(1, 1, At, B1); PG8_BAR; PG8_SCHED;
            } else {
            PG8_LDB(B0, 0, 0); PG8_SCHED; PG8_LDA(At, 0, 0); PG8_STAGE(PG8_SA(1, 1), a1 + hstep, voffA);
            PG8_WAIT_L(8); PG8_BAR; PG8_WAIT_L(0); PG8_MMA(0, 0, At, B0); PG8_BAR; PG8_SCHED;
            PG8_LDB(B1, 0, 1); PG8_STAGE(PG8_SB(0, 0), b2, voffB);
            PG8_BAR; PG8_WAIT_L(0); PG8_MMA(0, 1, At, B1); PG8_BAR;
            PG8_LDA(At, 0, 1); PG8_STAGE(PG8_SA(0, 0), a2, voffA);
            PG8_BAR; PG8_WAIT_L(0); PG8_MMA(1, 0, At, B0); PG8_BAR; PG8_SCHED;
            PG8_STAGE(PG8_SB(0, 1), b2 + hstep, voffB);
            PG8_WAIT_V(6); PG8_BAR; PG8_MMA(1, 1, At, B1); PG8_BAR;
            PG8_LDB(B0, 1, 0); PG8_SCHED; PG8_LDA(At, 1, 0); PG8_STAGE(PG8_SA(0, 1), a2 + hstep, voffA);
            PG8_WAIT_L(8); PG8_BAR; PG8_WAIT_L(0); PG8_MMA(0, 0, At, B0); PG8_BAR; PG8_SCHED;
            PG8_LDB(B1, 1, 1); PG8_STAGE(PG8_SB(1, 0), b3, voffB);
            PG8_BAR; PG8_WAIT_L(0); PG8_MMA(0, 1, At, B1); PG8_BAR;
            PG8_LDA(At, 1, 1); PG8_STAGE(PG8_SA(1, 0), a3, voffA);
            PG8_BAR; PG8_WAIT_L(0); PG8_MMA(1, 0, At, B0); PG8_BAR; PG8_SCHED;
            PG8_STAGE(PG8_SB(1, 1), b3 + hstep, voffB);
            PG8_WAIT_V(6); PG8_BAR; PG8_MMA(1, 1, At, B1); PG8_BAR;
            }
        }
        if constexpr (ALIGN_EPI) { if (wr == 0) PG8_BAR; }
        if constexpr (!Epi::AFTER_DRAIN) { E(acc, cur, wr, wc, fr, fq); S.done(cur); }
        if (!has_next) break;
#pragma unroll
        for (int a = 0; a < 2; ++a)
#pragma unroll
            for (int b = 0; b < 2; ++b)
#pragma unroll
                for (int m = 0; m < 4; ++m)
#pragma unroll
                    for (int n = 0; n < 2; ++n) acc[a][b][m][n] = (f32x4){0.f, 0.f, 0.f, 0.f};
        cur = nxt; cA = nA; cB = nB; ++ui;
        if constexpr (ALIGN_EPI) { if (wr == 1) PG8_BAR; }
    }
    PG8_WAIT_V(0);
    if constexpr (!ALIGN_EPI) { if (wr == 0) PG8_BAR; }
    PG8_BAR;
    if constexpr (Epi::AFTER_DRAIN) { E.fused(acc, cur, wr, wc, fr, fq, lds, wid, lane); S.done(cur); }
#undef PG8_SA
#undef PG8_SB
#undef PG8_STAGE
#undef PG8_LDA
#undef PG8_LDB
#undef PG8_MMA
#undef PG8_WAIT_V
#undef PG8_WAIT_L
#undef PG8_BAR
#undef PG8_SCHED
}
}
constexpr int NB = 4, SEQ = 8192, D = 1024, M = NB * SEQ;
constexpr int NZ0 = 3584, NZ1 = 3072, NQ = 2048, SRC_IN0 = 3592;
constexpr float EPS = 1e-6f;
constexpr int NWAVES = 8, NTHR = 512;
constexpr float LOG2E = 1.4426950408889634f;
constexpr size_t MiB = 1u << 20;
constexpr size_t WS_CTL = 0, CTL_ZERO_BYTES = 1 * MiB;
constexpr size_t WS_WIN0 = 1 * MiB, WS_WOUT0 = 8 * MiB, WS_WIN1 = 10 * MiB, WS_WOUT1 = 16 * MiB, WS_WQ = 18 * MiB;
constexpr size_t WS_KEYS = 26 * MiB, WS_MOD = WS_KEYS + 128 * 1024, WS_KMEAN = WS_MOD + 192 * 1024, WS_NLOC = WS_KMEAN + 256 * 1024,
                 WS_BEND = WS_NLOC + 512 * 1024, WS_MLOC = WS_BEND + 4096, WS_MPREV = WS_MLOC + 4096,
                 WS_ISU = 27 * MiB + 512 * 1024, WS_ISV = WS_ISU + 128 * 1024, WS_ORD = WS_ISV + 128 * 1024  ;
constexpr size_t WS_GATES = 28 * MiB;
constexpr size_t WS_UB = 32 * MiB  , WS_VB = 64 * MiB, WS_ACT = 96 * MiB  , WS_ACTS = 100 * MiB  , WS_DBGBUF = 112 * MiB, WS_XNY = 160 * MiB, WS_Z = 224 * MiB, WS_CLOC = 448 * MiB, WS_END = 512 * MiB;
constexpr size_t WS_QRY = WS_Z, WS_IDX = WS_Z + 128 * MiB, WS_GATE = WS_Z + 144 * MiB, WS_PART = 384 * MiB  ;
constexpr int CW_BAR = 4096, CW_QMOBA = 8192, CW_QDIFF = 8256;
constexpr float ALIBI_MARGIN = 27.03f;
constexpr int RING_BYTES = 139264;
constexpr int LDSCTL_OFF = RING_BYTES, MISC_OFF = LDSCTL_OFF + 320;
constexpr int LDS_BYTES = 147456;
static_assert(MISC_OFF + 128 <= LDS_BYTES, "LDS map");

#define GAS __attribute__((address_space(1)))
#define LAS __attribute__((address_space(3)))
typedef unsigned short bf16;
typedef unsigned v4u __attribute__((ext_vector_type(4)));
typedef unsigned v2u __attribute__((ext_vector_type(2)));
typedef float f32x4 __attribute__((ext_vector_type(4)));
typedef float f32x16 __attribute__((ext_vector_type(16)));
typedef short bf16x8 __attribute__((ext_vector_type(8)));
typedef short s16x4 __attribute__((ext_vector_type(4)));
typedef GAS unsigned gu32;
#define RLX_AGENT __ATOMIC_RELAXED, __HIP_MEMORY_SCOPE_AGENT
#define LDS_WAIT() asm volatile("s_waitcnt lgkmcnt(0)" ::: "memory")
#define VM_WAIT() asm volatile("s_waitcnt vmcnt(0)" ::: "memory")
__device__ __forceinline__ unsigned f2bf(float f) { unsigned u = __builtin_bit_cast(unsigned, f); return (u + 0x7fffu + ((u >> 16) & 1u)) >> 16; }
__device__ __forceinline__ unsigned pk2(float lo, float hi) { return f2bf(lo) | (f2bf(hi) << 16); }
__device__ __forceinline__ float bflo(unsigned w) { return __builtin_bit_cast(float, w << 16); }
__device__ __forceinline__ float bfhi(unsigned w) { return __builtin_bit_cast(float, w & 0xffff0000u); }
__device__ __forceinline__ float bf2f(bf16 h) { return __builtin_bit_cast(float, (unsigned)h << 16); }
__device__ __forceinline__ unsigned f2u(float x) { return __builtin_bit_cast(unsigned, x); }
__device__ __forceinline__ float u2f(unsigned x) { return __builtin_bit_cast(float, x); }
__device__ __forceinline__ float dot2bf(unsigned a, unsigned b, float acc) { typedef __bf16 bf2_ __attribute__((ext_vector_type(2))); return __builtin_amdgcn_fdot2_f32_bf16(__builtin_bit_cast(bf2_, a), __builtin_bit_cast(bf2_, b), acc, false); }
__device__ __forceinline__ float wave_sum(float v) {
#pragma unroll
    for (int o = 1; o < 64; o <<= 1) v += __shfl_xor(v, o);
    return v;
}
__device__ __forceinline__ float wave_max(float v) {
#pragma unroll
    for (int o = 1; o < 64; o <<= 1) v = fmaxf(v, __shfl_xor(v, o));
    return v;
}
__device__ __forceinline__ float silu_f(float x) { return x / (1.f + __expf(-x)); }
__device__ __forceinline__ float sigmoid_f(float x) { return 1.f / (1.f + __expf(-x)); }
__device__ __forceinline__ float logsigmoid_f(float x) { return fminf(x, 0.f) - log1pf(__expf(-fabsf(x))); }
struct Args { const float* in[24]; float* out; unsigned char* ws; int ph_lo, ph_hi; };
#define XB_TMO      128
#define XB_XCNT(j)  (256  + 64 * (j))
#define XB_XSUB(j)  (1280 + 64 * (j))
#define XB_XGEN(j)  (2304 + 64 * (j))
#define XB_TOP      3328
#define XB_TOPGEN   3392
#define XCD_BAR_WORDS 3456
#define XB_SPIN_CAP (1u << 18)

__device__ __forceinline__ unsigned xb_ld(unsigned* p)              { return __hip_atomic_load(p, __ATOMIC_RELAXED, __HIP_MEMORY_SCOPE_AGENT); }
__device__ __forceinline__ unsigned xb_add(unsigned* p, unsigned v) { return __hip_atomic_fetch_add(p, v, __ATOMIC_RELAXED, __HIP_MEMORY_SCOPE_AGENT); }
__device__ __forceinline__ unsigned xb_xcc_id() { return (unsigned)__builtin_amdgcn_s_getreg((3 << 11) | 20) & 0xFu; }
#define XB_SPIN(cond, bar) do { unsigned _sp = 0; while (cond) { __builtin_amdgcn_s_sleep(1); \
    if ((++_sp & 255u) == 0u) { if (xb_ld(&(bar)[XB_TMO])) break; if (_sp > XB_SPIN_CAP) { atomicAdd(&(bar)[XB_TMO], 1u); break; } } } } while (0)

struct XcdBarrier {
    unsigned* bar; unsigned x;
    volatile LAS unsigned* st;
};

__device__ __forceinline__ XcdBarrier xcd_barrier_post(unsigned* bar, volatile LAS unsigned* st) {
    XcdBarrier b; b.bar = bar; b.x = xb_xcc_id(); b.st = st;
    if (threadIdx.x == 0) (void)xb_add(&bar[XB_XCNT(b.x)], 1u);
    return b;
}
__device__ __forceinline__ void xcd_barrier_complete(unsigned* bar, unsigned x, unsigned& nloc, unsigned& nx) {
    const unsigned G = gridDim.x * gridDim.y * gridDim.z;
    unsigned sum, cnt, mine, sp = 0u;
    for (;;) {
        sum = 0u; cnt = 0u; mine = 0u;
#pragma unroll
        for (unsigned j = 0; j < 16; ++j) { const unsigned c = xb_ld(&bar[XB_XCNT(j)]); sum += c; cnt += (c > 0u) ? 1u : 0u; mine = (j == x) ? c : mine; }
        if (sum == G) break;
        __builtin_amdgcn_s_sleep(1);
        if ((++sp & 255u) == 0u) { if (xb_ld(&bar[XB_TMO])) break; if (sp > XB_SPIN_CAP) { atomicAdd(&bar[XB_TMO], 1u); break; } }
    }
    nloc = mine > 0u ? mine : 1u; nx = cnt > 0u ? cnt : 1u;
}

__device__ __forceinline__ void xcd_barrier(const XcdBarrier& b) {
    asm volatile("s_waitcnt vmcnt(0)" ::: "memory");
    __syncthreads();
    if (threadIdx.x == 0) {
        unsigned* bar = b.bar;
        __builtin_amdgcn_s_waitcnt(0);
        unsigned nloc = b.st[0], nx = b.st[1];
        if (nloc == 0u) { xcd_barrier_complete(bar, b.x, nloc, nx); b.st[0] = nloc; b.st[1] = nx; }
        const unsigned old = xb_add(&bar[XB_XSUB(b.x)], 1u);
        const unsigned gen = old / nloc;
        if (old + 1u == (gen + 1u) * nloc) {
            __builtin_amdgcn_fence(__ATOMIC_RELEASE, "agent");
            asm volatile("s_waitcnt vmcnt(0)" ::: "memory");
            const unsigned og = xb_add(&bar[XB_TOP], 1u);
            const unsigned tg = og / nx;
            if (og + 1u == (tg + 1u) * nx) xb_add(&bar[XB_TOPGEN], 1u);
            else XB_SPIN(xb_ld(&bar[XB_TOPGEN]) == tg, bar);
            __builtin_amdgcn_fence(__ATOMIC_ACQUIRE, "agent");
            xb_add(&bar[XB_XGEN(b.x)], 1u);
            asm volatile("s_waitcnt vmcnt(0)" ::: "memory");
        } else {
            XB_SPIN(xb_ld(&bar[XB_XGEN(b.x)]) == gen, bar);
            __builtin_amdgcn_fence(__ATOMIC_ACQUIRE, "agent");
            asm volatile("s_waitcnt vmcnt(0)" ::: "memory");
        }
    }
    __syncthreads();
}
struct Frame {
    LAS unsigned char* lds;
    int tid, lane, wave, G, bid;
    float* out; unsigned char* ws;
};
#define WSP(T, off) ((T*)(F.ws + (off)))

__device__ __forceinline__ void p0_transpose_item(const float* W, int K, int ldw, int nblk, int thr, int shift, bf16* WT, LAS float* scr, int item, int lane) {
    const int kb = item / nblk, nb = item % nblk, k0 = 64 * kb, n0 = 32 * nb, ns = n0 + (n0 >= thr ? shift : 0);
#pragma unroll 8
    for (int i = 0; i < 32; ++i) { const int kk = 2 * i + (lane >> 5); scr[kk * 33 + (lane & 31)] = W[(size_t)(k0 + kk) * ldw + ns + (lane & 31)]; }
    LDS_WAIT(); asm volatile("" ::: "memory");
    const int c = lane & 7;
#pragma unroll
    for (int j = 0; j < 4; ++j) { const int n = (lane >> 3) + 8 * j; const LAS float* s = scr + (8 * c) * 33 + n;
        v4u o; o.x = pk2(s[0 * 33], s[1 * 33]); o.y = pk2(s[2 * 33], s[3 * 33]); o.z = pk2(s[4 * 33], s[5 * 33]); o.w = pk2(s[6 * 33], s[7 * 33]);
        *(GAS v4u*)(WT + (size_t)(n0 + n) * K + k0 + 8 * c) = o; }
    LDS_WAIT(); asm volatile("" ::: "memory");
}
__device__ __forceinline__ void cvt_f32_bf16_stream(const float* src, bf16* dst, size_t n8, size_t gtid, size_t gthreads) {
    for (size_t i = gtid; i < n8; i += gthreads) {
        const f32x4 a = *(const GAS f32x4*)(src + i * 8), b = *(const GAS f32x4*)(src + i * 8 + 4);
        v4u o; o.x = pk2(a.x, a.y); o.y = pk2(a.z, a.w); o.z = pk2(b.x, b.y); o.w = pk2(b.z, b.w);
        *(GAS v4u*)(dst + i * 8) = o; }
}
__device__ __forceinline__ void p0_fp8_rows(Frame& F, const float* src, unsigned char* dst, float* iscale) {
    const int gw = F.bid * NWAVES + F.wave, NGW = F.G * NWAVES, lane = F.lane;
    for (int row = gw; row < 2 * 16384; row += NGW) {
        const float* r = src + (size_t)row * 1024 + 16 * lane;
        const f32x4 a = *(const GAS f32x4*)r, b = *(const GAS f32x4*)(r + 4), c = *(const GAS f32x4*)(r + 8), e = *(const GAS f32x4*)(r + 12);
        float am = fmaxf(fmaxf(fmaxf(fabsf(a.x), fabsf(a.y)), fmaxf(fabsf(a.z), fabsf(a.w))), fmaxf(fmaxf(fabsf(b.x), fabsf(b.y)), fmaxf(fabsf(b.z), fabsf(b.w))));
        am = fmaxf(am, fmaxf(fmaxf(fmaxf(fabsf(c.x), fabsf(c.y)), fmaxf(fabsf(c.z), fabsf(c.w))), fmaxf(fmaxf(fabsf(e.x), fabsf(e.y)), fmaxf(fabsf(e.z), fabsf(e.w)))));
        am = wave_max(am);
        const float sc = am > 1e-30f ? exp2f(floorf(log2f(256.f / am))) : 1.f;
        int w0 = 0, w1 = 0, w2 = 0, w3 = 0;
        w0 = __builtin_amdgcn_cvt_pk_fp8_f32(a.x * sc, a.y * sc, w0, false); w0 = __builtin_amdgcn_cvt_pk_fp8_f32(a.z * sc, a.w * sc, w0, true);
        w1 = __builtin_amdgcn_cvt_pk_fp8_f32(b.x * sc, b.y * sc, w1, false); w1 = __builtin_amdgcn_cvt_pk_fp8_f32(b.z * sc, b.w * sc, w1, true);
        w2 = __builtin_amdgcn_cvt_pk_fp8_f32(c.x * sc, c.y * sc, w2, false); w2 = __builtin_amdgcn_cvt_pk_fp8_f32(c.z * sc, c.w * sc, w2, true);
        w3 = __builtin_amdgcn_cvt_pk_fp8_f32(e.x * sc, e.y * sc, w3, false); w3 = __builtin_amdgcn_cvt_pk_fp8_f32(e.z * sc, e.w * sc, w3, true);
        const int layer = row >> 14, er = row & 16383;
        v4u o; o.x = (unsigned)w0; o.y = (unsigned)w1; o.z = (unsigned)w2; o.w = (unsigned)w3;
        *(GAS v4u*)(dst + ((size_t)((layer * 8 + (lane >> 3)) * 16384 + er)) * 128 + 16 * (lane & 7)) = o;
        if (lane == 0) iscale[row] = 1.f / sc;
    }
}
__device__ __forceinline__ void p0_i8_rows(Frame& F, const float* src, unsigned char* dst, float* scale) {
    const int gw = F.bid * NWAVES + F.wave, NGW = F.G * NWAVES, lane = F.lane;
    for (int row = gw; row < 2 * 16384; row += NGW) {
        const float* r = src + (size_t)row * 1024 + 16 * lane;
        float x[16];
#pragma unroll
        for (int q4 = 0; q4 < 4; ++q4) { const f32x4 a = *(const GAS f32x4*)(r + 4 * q4); x[4 * q4] = a.x; x[4 * q4 + 1] = a.y; x[4 * q4 + 2] = a.z; x[4 * q4 + 3] = a.w; }
        float am = 0.f;
#pragma unroll
        for (int i = 0; i < 16; ++i) am = fmaxf(am, fabsf(x[i]));
        am = wave_max(am);
        const float inv = am > 1e-30f ? 127.f / am : 0.f;
        unsigned wd[4];
#pragma unroll
        for (int q4 = 0; q4 < 4; ++q4) { unsigned w = 0;
#pragma unroll
            for (int e = 0; e < 4; ++e) { const int qv = (int)rintf(x[4 * q4 + e] * inv); w |= ((unsigned)qv & 0xffu) << (8 * e); }
            wd[q4] = w; }
        const int layer = row >> 14, er = row & 16383;
        v4u o; o.x = wd[0]; o.y = wd[1]; o.z = wd[2]; o.w = wd[3];
        *(GAS v4u*)(dst + ((size_t)((layer * 8 + (lane >> 3)) * 16384 + er)) * 128 + 16 * (lane & 7)) = o;
        if (lane == 0) scale[row] = am * (1.f / 127.f);
    }
}
__device__ __forceinline__ void p0_prologue(Frame& F, const Args& A) {
    {
        const float* c = A.in[1]; const float* aw = A.in[2]; const float* ab = A.in[3]; float* MOD = WSP(float, WS_MOD);
        LAS float* red = (LAS float*)F.lds;
        for (int item = F.bid; item < 192; item += F.G) {
            const int l = item / 96, n0 = (item % 96) * 64;
            float acc[4] = {0.f, 0.f, 0.f, 0.f};
            const int kbeg = F.wave * 128;
#pragma unroll 4
            for (int k = kbeg; k < kbeg + 128; ++k) {
                const float wv = aw[((size_t)l * 1024 + k) * 6144 + n0 + F.lane];
#pragma unroll
                for (int b = 0; b < 4; ++b) acc[b] += silu_f(c[b * 1024 + k]) * wv;
            }
#pragma unroll
            for (int b = 0; b < 4; ++b) red[(F.wave * 4 + b) * 64 + F.lane] = acc[b];
            __syncthreads();
            if (F.tid < 256) { const int b = F.tid >> 6, ln = F.tid & 63; float s = ab[l * 6144 + n0 + ln];
#pragma unroll
                for (int w = 0; w < 8; ++w) s += red[(w * 4 + b) * 64 + ln];
                MOD[(size_t)(l * 4 + b) * 6144 + n0 + ln] = s; }
            __syncthreads();
        }
    }
    if (F.bid == 0) {
        LAS unsigned* hist = (LAS unsigned*)F.lds;
        unsigned short* ORD = WSP(unsigned short, WS_ORD);
        for (int pass = 0; pass < 2; ++pass) {
            const int nunits = pass == 0 ? 2048 : 1024;
            if (F.tid < 160) hist[F.tid] = 0u;
            __syncthreads();
            for (int u = F.tid; u < nunits; u += NTHR) {
                const int q = pass == 0 ? (u & 63) : (u & 31), h = pass == 0 ? ((u >> 6) & 7) : ((u >> 5) & 7);
                const float dcut = 46.f * (float)(2 << h);
                int cost;
                if (pass == 0) { const int nt = 2 * q + 2; int lo = (int)ceilf(((float)(q * 128) - dcut - 63.f) * (1.f / 64.f)); if (lo < 0) lo = 0; cost = nt - lo; }
                else { int lo = (int)ceilf(((float)(q * 256) - dcut - 255.f) * (1.f / 256.f)); if (lo < 0) lo = 0; int nb = q - lo; if (nb > 3 * 8) nb = 24; cost = 4 * (nb + 1); }
                if (cost > 159) cost = 159;
                atomicAdd((unsigned*)(hist + (159 - cost)), 1u);
            }
            __syncthreads();
            if (F.tid == 0) { unsigned acc = 0; for (int i = 0; i < 160; ++i) { const unsigned c = hist[i]; hist[i] = acc; acc += c; } }
            __syncthreads();
            for (int u = F.tid; u < nunits; u += NTHR) {
                const int q = pass == 0 ? (u & 63) : (u & 31), h = pass == 0 ? ((u >> 6) & 7) : ((u >> 5) & 7);
                const float dcut = 46.f * (float)(2 << h);
                int cost;
                if (pass == 0) { const int nt = 2 * q + 2; int lo = (int)ceilf(((float)(q * 128) - dcut - 63.f) * (1.f / 64.f)); if (lo < 0) lo = 0; cost = nt - lo; }
                else { int lo = (int)ceilf(((float)(q * 256) - dcut - 255.f) * (1.f / 256.f)); if (lo < 0) lo = 0; int nb = q - lo; if (nb > 3 * 8) nb = 24; cost = 4 * (nb + 1); }
                if (cost > 159) cost = 159;
                const unsigned pos = atomicAdd((unsigned*)(hist + (159 - cost)), 1u);
                ORD[(pass == 0 ? 0 : 2048) + pos] = (unsigned short)u;
            }
            __syncthreads();
        }
    }
    {
        LAS float* scr = (LAS float*)(F.lds + F.wave * 8704);
        const int gw = F.bid * NWAVES + F.wave, NGW = F.G * NWAVES;
        constexpr int I_IN0 = 16 * (NZ0 / 32), I_OUT = 16 * 32, I_IN1 = 16 * (NZ1 / 32), I_Q = 16 * (NQ / 32);
        constexpr int NITEMS = I_IN0 + 2 * I_OUT + I_IN1 + 2 * I_Q;
        for (int it = gw; it < NITEMS; it += NGW) {
            int r = it;
            if (r < I_IN0) { p0_transpose_item(A.in[6], D, SRC_IN0, NZ0 / 32, 2048, 8, WSP(bf16, WS_WIN0), scr, r, F.lane); continue; } r -= I_IN0;
            if (r < I_OUT) { p0_transpose_item(A.in[13], D, D, 32, 1 << 30, 0, WSP(bf16, WS_WOUT0), scr, r, F.lane); continue; } r -= I_OUT;
            if (r < I_IN1) { p0_transpose_item(A.in[14], D, NZ1, NZ1 / 32, 1 << 30, 0, WSP(bf16, WS_WIN1), scr, r, F.lane); continue; } r -= I_IN1;
            if (r < I_OUT) { p0_transpose_item(A.in[19], D, D, 32, 1 << 30, 0, WSP(bf16, WS_WOUT1), scr, r, F.lane); continue; } r -= I_OUT;
            if (r < I_Q) { p0_transpose_item(A.in[20], D, NQ, NQ / 32, 1 << 30, 0, WSP(bf16, WS_WQ), scr, r, F.lane); continue; } r -= I_Q;
            p0_transpose_item(A.in[20] + (size_t)D * NQ, D, NQ, NQ / 32, 1 << 30, 0, WSP(bf16, WS_WQ) + (size_t)NQ * D, scr, r, F.lane);
        }
    }
    {
        const size_t gtid = (size_t)F.bid * NTHR + F.tid, gth = (size_t)F.G * NTHR;
        cvt_f32_bf16_stream(A.in[21], WSP(bf16, WS_KEYS), (size_t)2 * 2 * 128 * 128 / 8, gtid, gth);
        p0_i8_rows(F, A.in[22], F.ws + WS_UB, WSP(float, WS_ISU));
        p0_i8_rows(F, A.in[23], F.ws + WS_VB, WSP(float, WS_ISV));
    }
}

template <bool GATES>
__device__ __forceinline__ void norm_pass(Frame& F, const Args& A, const float* X, const float* g, const float* mod, int shc, bf16* XN) {
    LAS float* wgT = (LAS float*)F.lds;
    if (GATES) {
        const float* win = A.in[6];
        for (int i = F.tid; i < 8 * 1024; i += NTHR) { const int cg = i >> 10, k = i & 1023; wgT[i] = win[(size_t)k * SRC_IN0 + 2048 + cg]; }
        __syncthreads();
    }
    const int gw = F.bid * NWAVES + F.wave, NGW = F.G * NWAVES;
    for (int row = gw; row < M; row += NGW) {
        const int b = row >> 13;
        const GAS f32x4* xr = (const GAS f32x4*)(X + (size_t)row * D) + F.lane;
        f32x4 v[4]; float ss = 0.f;
#pragma unroll
        for (int j = 0; j < 4; ++j) { v[j] = xr[64 * j]; ss += (v[j].x * v[j].x + v[j].y * v[j].y) + (v[j].z * v[j].z + v[j].w * v[j].w); }
        const float rstd = rsqrtf(wave_sum(ss) * (1.f / D) + EPS);
        const float* shp = mod + (size_t)b * 6144 + shc * 1024; const float* scp = shp + 1024;
#pragma unroll
        for (int j = 0; j < 4; ++j) { const int c = 4 * F.lane + 256 * j;
            const f32x4 gg = *(const f32x4*)(g + c), sc = *(const f32x4*)(scp + c), sh = *(const f32x4*)(shp + c);
            v[j] = v[j] * rstd * gg * (sc + 1.f) + sh;
            v2u o; o.x = pk2(v[j].x, v[j].y); o.y = pk2(v[j].z, v[j].w);
            *(GAS v2u*)(XN + (size_t)row * D + c) = o; }
        if (GATES) {
            float* GT = WSP(float, WS_GATES);
#pragma unroll
            for (int cg = 0; cg < 8; ++cg) { float p = 0.f;
#pragma unroll
                for (int j = 0; j < 4; ++j) { const f32x4 w = *(const LAS f32x4*)(wgT + cg * 1024 + 4 * F.lane + 256 * j); p += (v[j].x * w.x + v[j].y * w.y) + (v[j].z * w.z + v[j].w * w.w); }
                p = wave_sum(p);
                if (F.lane == 0) GT[(size_t)row * 8 + cg] = p + (cg < 4 ? A.in[8][cg] : A.in[9][cg - 4]); }
        }
    }
}

__device__ __forceinline__ void qknorm_unit(Frame& F, bf16* Z, int ldz, int row0, int col0, const float* g, float gmul, float* kmean  ) {
    const int c = col0 + 8 * F.lane, d0 = (8 * F.lane) & 63;
    float gv[8];
#pragma unroll
    for (int i = 0; i < 8; ++i) gv[i] = g[d0 + i] * gmul;
    float ks[8] = {0.f, 0.f, 0.f, 0.f, 0.f, 0.f, 0.f, 0.f};
    for (int r = 0; r < 32; ++r) {
        bf16* p = Z + (size_t)(row0 + F.wave * 32 + r) * ldz + c;
        const v4u w = *(const GAS v4u*)p;
        float x[8] = {bflo(w.x), bfhi(w.x), bflo(w.y), bfhi(w.y), bflo(w.z), bfhi(w.z), bflo(w.w), bfhi(w.w)};
        float ss = 0.f;
#pragma unroll
        for (int i = 0; i < 8; ++i) ss += x[i] * x[i];
        ss += __shfl_xor(ss, 1); ss += __shfl_xor(ss, 2); ss += __shfl_xor(ss, 4);
        const float rstd = rsqrtf(ss * (1.f / 64.f) + EPS);
#pragma unroll
        for (int i = 0; i < 8; ++i) { x[i] = x[i] * rstd * gv[i]; ks[i] += x[i]; }
        v4u o; o.x = pk2(x[0], x[1]); o.y = pk2(x[2], x[3]); o.z = pk2(x[4], x[5]); o.w = pk2(x[6], x[7]);
        *(GAS v4u*)p = o;
    }
    if (kmean) {
        LAS float* red = (LAS float*)F.lds;
#pragma unroll
        for (int i = 0; i < 8; ++i) red[F.wave * 512 + 8 * F.lane + i] = ks[i];
        __syncthreads();
        { float s = 0.f;
#pragma unroll
          for (int w = 0; w < 8; ++w) s += red[w * 512 + F.tid];
          kmean[(size_t)(F.tid >> 6) * (32 * 64) + (F.tid & 63)] = s * (1.f / 256.f); }
        __syncthreads();
    }
}
constexpr int KSTRB = 144;
template <int DV> struct VStr { static constexpr int B = (DV == 64) ? 192 : 320; };
typedef short v4i16_t __attribute__((ext_vector_type(4)));
__device__ __forceinline__ s16x4 vtr(const LAS unsigned char* p) { return __builtin_bit_cast(s16x4, __builtin_amdgcn_ds_read_tr16_b64_v4i16((LAS v4i16_t*)p)); }
__device__ __forceinline__ unsigned cvtpk(float lo, float hi) { typedef float f2 __attribute__((ext_vector_type(2))); typedef __bf16 b2 __attribute__((ext_vector_type(2)));
    f2 v = {lo, hi}; b2 b = __builtin_convertvector(v, b2); return __builtin_bit_cast(unsigned, b); }
__device__ __forceinline__ float xhalf(float v) {
    auto rr = __builtin_amdgcn_permlane32_swap(__builtin_bit_cast(unsigned, v), __builtin_bit_cast(unsigned, v), false, false);
    const unsigned r0 = rr[0], r1 = rr[1]; return u2f((threadIdx.x & 32) ? r0 : r1);
}
template <int DV> struct AttnSt { f32x16 o[DV / 32]; float m, l; };
template <int DV> __device__ __forceinline__ void attn_init(AttnSt<DV>& st) {
#pragma unroll
    for (int t = 0; t < DV / 32; ++t)
#pragma unroll
        for (int r = 0; r < 16; ++r) st.o[t][r] = 0.f;
    st.m = -1e30f; st.l = 0.f;
}
template <int DV>
__device__ __forceinline__ void attn_tile(AttnSt<DV>& st, const LAS unsigned char* Kt, const LAS unsigned char* Vt, const bf16x8 (&qf)[4], float sc2, float sl2, int tq, int kt0, bool diag, bool rowok, int lane) {
    const int r32 = lane & 31, hi = lane >> 5;
    const int kb = kt0 + 4 * hi;
    const float c0 = -sl2 * (float)(tq - kb);
    f32x16 s0, s1;
#pragma unroll
    for (int r = 0; r < 16; ++r) { const int ko = (r & 3) + 8 * (r >> 2); s0[r] = c0 + sl2 * (float)ko; s1[r] = c0 + sl2 * (float)(ko + 32); }
    const LAS unsigned char* kp = Kt + r32 * KSTRB + hi * 16;
#pragma unroll
    for (int ks = 0; ks < 4; ++ks) {
        const bf16x8 k0 = *(const LAS bf16x8*)(kp + ks * 32), k1 = *(const LAS bf16x8*)(kp + 32 * KSTRB + ks * 32);
        s0 = __builtin_amdgcn_mfma_f32_32x32x16_bf16(k0, qf[ks], s0, 0, 0, 0);
        s1 = __builtin_amdgcn_mfma_f32_32x32x16_bf16(k1, qf[ks], s1, 0, 0, 0);
    }
    if (diag || !rowok) {
#pragma unroll
        for (int r = 0; r < 16; ++r) { const int ko = (r & 3) + 8 * (r >> 2);
            if (!rowok || kb + ko > tq) s0[r] = -INFINITY;
            if (!rowok || kb + ko + 32 > tq) s1[r] = -INFINITY; }
    }
    float mx = fmaxf(s0[0], s1[0]);
#pragma unroll
    for (int r = 1; r < 16; ++r) mx = fmaxf(mx, fmaxf(s0[r], s1[r]));
    mx = fmaxf(mx, xhalf(mx));
    if (__any(mx > st.m)) {
        const float mn = fmaxf(st.m, mx);
        const float alpha = __builtin_amdgcn_exp2f(st.m - mn);
        st.m = mn; st.l *= alpha;
#pragma unroll
        for (int t = 0; t < DV / 32; ++t)
#pragma unroll
            for (int r = 0; r < 16; ++r) st.o[t][r] *= alpha;
    }
    const float mn = st.m;
    float ps = 0.f;
#pragma unroll
    for (int r = 0; r < 16; ++r) { s0[r] = __builtin_amdgcn_exp2f(s0[r] - mn); s1[r] = __builtin_amdgcn_exp2f(s1[r] - mn); ps += s0[r] + s1[r]; }
    st.l += ps;
    bf16x8 pf[2][2];
#pragma unroll
    for (int s = 0; s < 2; ++s) {
        v4u a, b;
        a.x = cvtpk(s0[8 * s + 0], s0[8 * s + 1]); a.y = cvtpk(s0[8 * s + 2], s0[8 * s + 3]); a.z = cvtpk(s0[8 * s + 4], s0[8 * s + 5]); a.w = cvtpk(s0[8 * s + 6], s0[8 * s + 7]);
        b.x = cvtpk(s1[8 * s + 0], s1[8 * s + 1]); b.y = cvtpk(s1[8 * s + 2], s1[8 * s + 3]); b.z = cvtpk(s1[8 * s + 4], s1[8 * s + 5]); b.w = cvtpk(s1[8 * s + 6], s1[8 * s + 7]);
        pf[0][s] = __builtin_bit_cast(bf16x8, a); pf[1][s] = __builtin_bit_cast(bf16x8, b);
    }
    constexpr int VS = VStr<DV>::B;
    const int g = lane >> 4, i16 = lane & 15;
    const LAS unsigned char* vp = Vt + (4 * (g >> 1) + (i16 >> 2)) * VS + (16 * (g & 1) + 4 * (i16 & 3)) * 2;
#pragma unroll
    for (int kbk = 0; kbk < 2; ++kbk)
#pragma unroll
        for (int s = 0; s < 2; ++s)
#pragma unroll
            for (int t = 0; t < DV / 32; ++t) {
                const s16x4 lo = vtr(vp + (kbk * 32 + 16 * s) * VS + t * 64), h8 = vtr(vp + (kbk * 32 + 16 * s + 8) * VS + t * 64);
                const bf16x8 va = {lo[0], lo[1], lo[2], lo[3], h8[0], h8[1], h8[2], h8[3]};
                st.o[t] = __builtin_amdgcn_mfma_f32_32x32x16_bf16(va, pf[kbk][s], st.o[t], 0, 0, 0);
            }
}
template <int NK, int DV> struct TileRegs { v4u k[NK]; v4u v[DV / 64]; };
template <int NK, int DV>
__device__ __forceinline__ void tile_load(TileRegs<NK, DV>& R, const bf16* Z, int ldz, size_t zrow0, int kcol, int vcol, int tid) {
#pragma unroll
    for (int i = 0; i < NK; ++i) { const int ch = tid + 512 * i; const int row = ch / (8 * NK), cc = ch % (8 * NK);
        R.k[i] = *(const GAS v4u*)(Z + (zrow0 + row) * ldz + kcol + cc * 8); }
#pragma unroll
    for (int i = 0; i < DV / 64; ++i) { const int ch = tid + 512 * i; const int row = ch / (DV / 8), cc = ch % (DV / 8);
        R.v[i] = *(const GAS v4u*)(Z + (zrow0 + row) * ldz + vcol + cc * 8); }
}
template <int NK, int DV>
__device__ __forceinline__ void tile_store(const TileRegs<NK, DV>& R, LAS unsigned char* Kt  , LAS unsigned char* Vt, int tid) {
#pragma unroll
    for (int i = 0; i < NK; ++i) { const int ch = tid + 512 * i; const int row = ch / (8 * NK), cc = ch % (8 * NK);
        *(LAS v4u*)(Kt + (cc >> 3) * (64 * KSTRB) + row * KSTRB + (cc & 7) * 16) = R.k[i]; }
#pragma unroll
    for (int i = 0; i < DV / 64; ++i) { const int ch = tid + 512 * i; const int row = ch / (DV / 8), cc = ch % (DV / 8);
        *(LAS v4u*)(Vt + row * VStr<DV>::B + cc * 16) = R.v[i]; }
}
__device__ __forceinline__ void moba_unit(Frame& F, int b, int h, int j, float tcut  ) {
    const bf16* Z = WSP(bf16, WS_Z); constexpr int ldz = NZ0;
    const int lane = F.lane, w = F.wave, r32 = lane & 31, hi = lane >> 5, tid = F.tid;
    const size_t rowb = (size_t)b * SEQ;
    const int qpos = j * 256 + w * 32 + r32;
    const int qcol = 2048 + h * 64, kcol = 2560 + h * 64, vcol = 3072 + h * 64;
    LAS unsigned char* lds = F.lds;
    constexpr int BUFB = 64 * KSTRB + 64 * VStr<64>::B;
    LAS unsigned char* kmh = lds + 2 * BUFB;
    LAS unsigned char* kml = lds + 2 * BUFB + 32 * KSTRB;
    LAS unsigned* msk = (LAS unsigned*)(lds + 2 * BUFB + 64 * KSTRB);
    { const float* KM = WSP(float, WS_KMEAN) + (size_t)((b * 8 + h) * 32) * 64; const f32x4 x = *(const f32x4*)(KM + 4 * tid);
      const int n = tid >> 4, d0 = (tid & 15) * 4;
      const unsigned h0 = f2bf(x.x), h1 = f2bf(x.y), h2 = f2bf(x.z), h3 = f2bf(x.w);
      v2u hv; hv.x = h0 | (h1 << 16); hv.y = h2 | (h3 << 16);
      v2u lv; lv.x = pk2(x.x - u2f(h0 << 16), x.y - u2f(h1 << 16)); lv.y = pk2(x.z - u2f(h2 << 16), x.w - u2f(h3 << 16));
      *(LAS v2u*)(kmh + n * KSTRB + d0 * 2) = hv; *(LAS v2u*)(kml + n * KSTRB + d0 * 2) = lv; }
    if (tid < 16) msk[tid] = 0u;
    bf16x8 qf[4];
    const bf16* qrow = Z + (rowb + qpos) * ldz + qcol;
#pragma unroll
    for (int ks = 0; ks < 4; ++ks) qf[ks] = *(const GAS bf16x8*)(qrow + 16 * ks + 8 * hi);
    __syncthreads();
    f32x16 gt;
#pragma unroll
    for (int r = 0; r < 16; ++r) gt[r] = 0.f;
#pragma unroll
    for (int ks = 0; ks < 4; ++ks) {
        const bf16x8 a = *(const LAS bf16x8*)(kmh + r32 * KSTRB + hi * 16 + ks * 32), c = *(const LAS bf16x8*)(kml + r32 * KSTRB + hi * 16 + ks * 32);
        gt = __builtin_amdgcn_mfma_f32_32x32x16_bf16(a, qf[ks], gt, 0, 0, 0);
        gt = __builtin_amdgcn_mfma_f32_32x32x16_bf16(c, qf[ks], gt, 0, 0, 0);
    }
    float t0 = -INFINITY, t1 = -INFINITY, t2 = -INFINITY;
#define INS3(key) do { float k_ = (key); float a_ = fmaxf(t0, k_), l_ = fminf(t0, k_); t0 = a_; a_ = fmaxf(t1, l_); l_ = fminf(t1, l_); t1 = a_; t2 = fmaxf(t2, l_); } while (0)
#pragma unroll
    for (int r = 0; r < 16; ++r) { const int n = (r & 3) + 8 * (r >> 2) + 4 * hi;
        const float key = (n < j) ? u2f((f2u(gt[r]) & ~31u) | (unsigned)n) : -INFINITY; INS3(key); }
    { const float p0 = xhalf(t0), p1 = xhalf(t1), p2 = xhalf(t2); INS3(p0); INS3(p1); INS3(p2); }
#undef INS3
    const int sel0 = (t0 > -INFINITY) ? (int)(f2u(t0) & 31u) : -1;
    const int sel1 = (t1 > -INFINITY) ? (int)(f2u(t1) & 31u) : -1;
    const int sel2 = (t2 > -INFINITY) ? (int)(f2u(t2) & 31u) : -1;
    { const unsigned mm = (sel0 >= 0 ? 1u << sel0 : 0u) | (sel1 >= 0 ? 1u << sel1 : 0u) | (sel2 >= 0 ? 1u << sel2 : 0u);
      if (mm) { __hip_atomic_fetch_or(msk + w, mm, __ATOMIC_RELAXED, __HIP_MEMORY_SCOPE_WORKGROUP); __hip_atomic_fetch_or(msk + 8, mm, __ATOMIC_RELAXED, __HIP_MEMORY_SCOPE_WORKGROUP); } }
    __syncthreads();
    const float slope = ldexpf(1.f, -(h + 1)), dcut = tcut / slope;
    const float sl2 = slope * LOG2E, sc2 = 0.125f * LOG2E;
    int nlo = (int)ceilf(((float)(j * 256) - dcut - 255.f) * (1.f / 256.f)); if (nlo < 0) nlo = 0;
    const unsigned keep = nlo >= 32 ? 0u : (0xffffffffu << nlo);
    const unsigned bmask = msk[8] & keep; const unsigned wmask = (unsigned)__builtin_amdgcn_readfirstlane((int)msk[w]) & keep;
    AttnSt<64> st; attn_init<64>(st);
    unsigned rem = bmask;
    int blk = j, kt = 3, buf = 0;
    TileRegs<1, 64> R;
    tile_load<1, 64>(R, Z, ldz, rowb + blk * 256 + kt * 64, kcol, vcol, tid);
    tile_store<1, 64>(R, lds, lds + 64 * KSTRB, tid);
    __syncthreads();
    for (;;) {
        int nblk = blk, nkt = kt - 1; bool has_next = true;
        if (nkt < 0) { nkt = 3; if (rem) { nblk = 31 - __builtin_clz(rem); rem &= ~(1u << nblk); } else has_next = false; }
        if (has_next) tile_load<1, 64>(R, Z, ldz, rowb + nblk * 256 + nkt * 64, kcol, vcol, tid);
        const bool own = (blk == j);
        const bool active = (own ? (kt * 64 <= w * 32 + 31) : (((wmask >> blk) & 1u) != 0u)) && ((float)(j * 256 + w * 32 - (blk * 256 + kt * 64 + 63)) <= dcut);
        if (active) {
            const bool rowok = own || blk == sel0 || blk == sel1 || blk == sel2;
            const bool diag = own && (kt * 64 + 63 > w * 32);
            attn_tile<64>(st, lds + buf * BUFB, lds + buf * BUFB + 64 * KSTRB, qf, sc2, sl2, qpos, blk * 256 + kt * 64, diag, rowok, lane);
        }
        if (!has_next) break;
        tile_store<1, 64>(R, lds + (buf ^ 1) * BUFB, lds + (buf ^ 1) * BUFB + 64 * KSTRB, tid);
        __syncthreads();
        buf ^= 1; blk = nblk; kt = nkt;
    }
    const float inv = 1.f / (st.l + xhalf(st.l));
    bf16* Y = WSP(bf16, WS_XNY) + (rowb + qpos) * 1024 + 512 + h * 64;
#pragma unroll
    for (int t = 0; t < 2; ++t)
#pragma unroll
        for (int rg = 0; rg < 4; ++rg) { v2u o; o.x = pk2(st.o[t][4 * rg] * inv, st.o[t][4 * rg + 1] * inv); o.y = pk2(st.o[t][4 * rg + 2] * inv, st.o[t][4 * rg + 3] * inv);
            *(GAS v2u*)(Y + t * 32 + 8 * rg + 4 * hi) = o; }
    __syncthreads();
}

__device__ __forceinline__ void diff_unit(Frame& F, const Args& A, int b, int h, int qt, float lam, float tcut) {
    const bf16* Z = WSP(bf16, WS_Z); constexpr int ldz = NZ1;
    const int lane = F.lane, w = F.wave, r32 = lane & 31, hi = lane >> 5, tid = F.tid;
    const int comp = w >> 2, wq = w & 3;
    const size_t rowb = (size_t)b * SEQ;
    const int q0 = qt * 128, qpos = q0 + wq * 32 + r32;
    const int qcol = h * 128 + comp * 64, kcol = 1024 + h * 128, vcol = 2048 + h * 128;
    LAS unsigned char* lds = F.lds;
    constexpr int BUFB = 2 * 64 * KSTRB + 64 * VStr<128>::B;
    bf16x8 qf[4];
    const bf16* qrow = Z + (rowb + qpos) * ldz + qcol;
#pragma unroll
    for (int ks = 0; ks < 4; ++ks) qf[ks] = *(const GAS bf16x8*)(qrow + 16 * ks + 8 * hi);
    const float slope = ldexpf(1.f, -(h + 1)), dcut = tcut / slope;
    const float sl2 = slope * LOG2E, sc2 = 0.125f * LOG2E;
    AttnSt<128> st; attn_init<128>(st);
    const int nt = (q0 + 128) / 64;
    int kt_lo = (int)ceilf(((float)q0 - dcut - 63.f) * (1.f / 64.f)); if (kt_lo < 0) kt_lo = 0;
    TileRegs<2, 128> R;
    tile_load<2, 128>(R, Z, ldz, rowb + (size_t)(nt - 1) * 64, kcol, vcol, tid);
    tile_store<2, 128>(R, lds, lds + 2 * 64 * KSTRB, tid);
    __syncthreads();
    int buf = 0;
    for (int kt = nt - 1; kt >= kt_lo; --kt) {
        const bool has_next = kt > kt_lo;
        if (has_next) tile_load<2, 128>(R, Z, ldz, rowb + (size_t)(kt - 1) * 64, kcol, vcol, tid);
        if (kt * 64 <= q0 + wq * 32 + 31) {
            const bool diag = kt * 64 + 63 > q0 + wq * 32;
            attn_tile<128>(st, lds + buf * BUFB + comp * (64 * KSTRB), lds + buf * BUFB + 2 * 64 * KSTRB, qf, sc2, sl2, qpos, kt * 64, diag, true, lane);
        }
        if (has_next) { tile_store<2, 128>(R, lds + (buf ^ 1) * BUFB, lds + (buf ^ 1) * BUFB + 2 * 64 * KSTRB, tid); }
        __syncthreads();
        buf ^= 1;
    }
    const float inv = 1.f / (st.l + xhalf(st.l));
    LAS float* o2 = (LAS float*)lds;
    if (comp == 1) {
#pragma unroll
        for (int t = 0; t < 4; ++t)
#pragma unroll
            for (int r = 0; r < 16; ++r) o2[((wq * 4 + t) * 16 + r) * 64 + lane] = st.o[t][r] * inv;
    }
    __syncthreads();
    if (comp == 0) {
        float ss = 0.f;
#pragma unroll
        for (int t = 0; t < 4; ++t)
#pragma unroll
            for (int r = 0; r < 16; ++r) { const float v = st.o[t][r] * inv - lam * o2[((wq * 4 + t) * 16 + r) * 64 + lane]; st.o[t][r] = v; ss += v * v; }
        ss += xhalf(ss);
        const float rs = rsqrtf(ss * (1.f / 128.f) + EPS) * 0.6444909324090307f;
        const float* og = A.in[18];
        bf16* Y = WSP(bf16, WS_XNY) + (rowb + qpos) * 1024 + h * 128;
#pragma unroll
        for (int t = 0; t < 4; ++t)
#pragma unroll
            for (int rg = 0; rg < 4; ++rg) { const int dv = t * 32 + 8 * rg + 4 * hi; const f32x4 gg = *(const f32x4*)(og + dv);
                v2u o; o.x = pk2(st.o[t][4 * rg] * rs * gg.x, st.o[t][4 * rg + 1] * rs * gg.y); o.y = pk2(st.o[t][4 * rg + 2] * rs * gg.z, st.o[t][4 * rg + 3] * rs * gg.w);
                *(GAS v2u*)(Y + dv) = o; }
    }
    __syncthreads();
}
template <int MT, int NT>
__device__ __forceinline__ void mma_nt(const LAS unsigned char* A, int lda, const LAS unsigned char* B, int ldb, int K, f32x4 (&acc)[MT][NT], int lane) {
    const int r = lane & 15, kq = (lane >> 4) * 16;
    for (int k0 = 0; k0 < K; k0 += 32) {
        bf16x8 a[MT], bb[NT];
#pragma unroll
        for (int m = 0; m < MT; ++m) a[m] = *(const LAS bf16x8*)(A + (m * 16 + r) * lda + k0 * 2 + kq);
#pragma unroll
        for (int n = 0; n < NT; ++n) bb[n] = *(const LAS bf16x8*)(B + (n * 16 + r) * ldb + k0 * 2 + kq);
#pragma unroll
        for (int m = 0; m < MT; ++m)
#pragma unroll
            for (int n = 0; n < NT; ++n) acc[m][n] = __builtin_amdgcn_mfma_f32_16x16x32_bf16(a[m], bb[n], acc[m][n], 0, 0, 0);
    }
}
constexpr int TS = 272;
constexpr int TILEB = 128 * TS;
constexpr int ML_Q = 0, ML_K = TILEB, ML_V = 2 * TILEB, ML_SM = 3 * TILEB;

__device__ __forceinline__ void ml_gates(const float* GT, size_t row0, int hm, LAS float* sm, int lane) {
    const float i0 = GT[(row0 + 2 * lane) * 8 + hm], i1 = GT[(row0 + 2 * lane + 1) * 8 + hm];
    const float f0 = logsigmoid_f(GT[(row0 + 2 * lane) * 8 + 4 + hm]), f1 = logsigmoid_f(GT[(row0 + 2 * lane + 1) * 8 + 4 + hm]);
    float s = f0 + f1;
#pragma unroll
    for (int o = 1; o < 64; o <<= 1) { const float t = __shfl_up(s, o); if (lane >= o) s += t; }
    const float excl = s - (f0 + f1);
    sm[2 * lane] = excl + f0; sm[2 * lane + 1] = excl + f0 + f1;
    sm[128 + 2 * lane] = i0; sm[128 + 2 * lane + 1] = i1;
}
template <bool TRANSPOSE>
__device__ __forceinline__ void ml_conv_tile(const bf16* Z, size_t rowb, int t0, int zc, const float* cw, int wc, float mul, LAS unsigned char* dst, const LAS float* rs, int tid) {
#pragma unroll
    for (int it = 0; it < 4; ++it) {
        const int item = tid + 512 * it, l = item >> 4, ch = (item & 15) * 8;
        float acc[8];
#pragma unroll
        for (int i = 0; i < 8; ++i) acc[i] = 0.f;
#pragma unroll
        for (int jj = 0; jj < 4; ++jj) {
            const int t = t0 + l - 3 + jj;
            if (t >= 0) {
                const v4u w = *(const GAS v4u*)(Z + (rowb + t) * NZ0 + zc + ch);
                const float x[8] = {bflo(w.x), bfhi(w.x), bflo(w.y), bfhi(w.y), bflo(w.z), bfhi(w.z), bflo(w.w), bfhi(w.w)};
                const f32x4 c0 = *(const f32x4*)(cw + jj * 1024 + wc + ch), c1 = *(const f32x4*)(cw + jj * 1024 + wc + ch + 4);
                acc[0] += x[0] * c0.x; acc[1] += x[1] * c0.y; acc[2] += x[2] * c0.z; acc[3] += x[3] * c0.w;
                acc[4] += x[4] * c1.x; acc[5] += x[5] * c1.y; acc[6] += x[6] * c1.z; acc[7] += x[7] * c1.w;
            }
        }
        const float sc = TRANSPOSE ? mul * rs[l] : mul;
#pragma unroll
        for (int i = 0; i < 8; ++i) acc[i] = silu_f(acc[i]) * sc;
        if (TRANSPOSE) {
#pragma unroll
            for (int i = 0; i < 8; ++i) *(LAS bf16*)(dst + (ch + i) * TS + l * 2) = (bf16)f2bf(acc[i]);
        } else {
            v4u o; o.x = pk2(acc[0], acc[1]); o.y = pk2(acc[2], acc[3]); o.z = pk2(acc[4], acc[5]); o.w = pk2(acc[6], acc[7]);
            *(LAS v4u*)(dst + l * TS + ch * 2) = o;
        }
    }
}
__device__ __forceinline__ void ml_vt_tile(const bf16* Z, size_t row0, int zc, LAS unsigned char* dst, int tid) {
#pragma unroll
    for (int it = 0; it < 4; ++it) {
        const int item = tid + 512 * it, l = item >> 4, ch = (item & 15) * 8;
        const v4u w = *(const GAS v4u*)(Z + (row0 + l) * NZ0 + zc + ch);
        const unsigned ww[4] = {w.x, w.y, w.z, w.w};
#pragma unroll
        for (int i = 0; i < 4; ++i) { *(LAS bf16*)(dst + (ch + 2 * i) * TS + l * 2) = (bf16)(ww[i] & 0xffffu); *(LAS bf16*)(dst + (ch + 2 * i + 1) * TS + l * 2) = (bf16)(ww[i] >> 16); }
    }
}
__device__ __forceinline__ void mlstm_a_unit(Frame& F, const Args& A, int unit) {
    const int c = unit & 63, bh = unit >> 6, hm = bh & 3, b = bh >> 2;
    const bf16* Z = WSP(bf16, WS_Z); const float* GT = WSP(float, WS_GATES);
    const size_t rowb = (size_t)b * SEQ; const int t0 = c * 128;
    LAS unsigned char* lds = F.lds; LAS float* sm = (LAS float*)(lds + ML_SM);
    if (F.wave == 0) {
        ml_gates(GT, rowb + t0, hm, sm, F.lane);
        LDS_WAIT();
        const float bend = sm[127];
        const float w0 = bend - sm[2 * F.lane] + sm[128 + 2 * F.lane], w1 = bend - sm[2 * F.lane + 1] + sm[128 + 2 * F.lane + 1];
        const float ml = wave_max(fmaxf(w0, w1));
        sm[256 + 2 * F.lane] = __expf(w0 - ml); sm[256 + 2 * F.lane + 1] = __expf(w1 - ml);
        if (F.lane == 0) { WSP(float, WS_BEND)[unit] = bend; WSP(float, WS_MLOC)[unit] = ml; }
    }
    __syncthreads();
    ml_conv_tile<true>(Z, rowb, t0, 512 + hm * 128, A.in[7], 512 + hm * 128, 0.08838834764831845f, lds + ML_K, sm + 256, F.tid);
    ml_vt_tile(Z, rowb + t0, 1024 + hm * 128, lds + ML_V, F.tid);
    __syncthreads();
    f32x4 acc[2][4];
#pragma unroll
    for (int m = 0; m < 2; ++m)
#pragma unroll
        for (int n = 0; n < 4; ++n) acc[m][n] = (f32x4){0.f, 0.f, 0.f, 0.f};
    const int dv0 = 32 * (F.wave >> 1), dk0 = 64 * (F.wave & 1);
    mma_nt<2, 4>(lds + ML_V + dv0 * TS, TS, lds + ML_K + dk0 * TS, TS, 128, acc, F.lane);
    float* CL = WSP(float, WS_CLOC) + (size_t)unit * 16384;
#pragma unroll
    for (int m = 0; m < 2; ++m)
#pragma unroll
        for (int n = 0; n < 4; ++n)
#pragma unroll
            for (int i = 0; i < 4; ++i) CL[(size_t)(dv0 + 16 * m + 4 * (F.lane >> 4) + i) * 128 + dk0 + 16 * n + (F.lane & 15)] = acc[m][n][i];
    if (F.tid < 128) { float s = 0.f; const LAS bf16* kr = (const LAS bf16*)(lds + ML_K + F.tid * TS);
        for (int l = 0; l < 128; ++l) s += bf2f(kr[l]);
        WSP(float, WS_NLOC)[(size_t)unit * 128 + F.tid] = s; }
    __syncthreads();
}
__device__ __forceinline__ void mlstm_scan_unit(Frame& F, int unit) {
    const int bh = unit >> 4, sl = unit & 15;
    LAS float* tab = (LAS float*)F.lds;
    if (F.tid == 0) {
        const float* BE = WSP(float, WS_BEND) + bh * 64; const float* ML = WSP(float, WS_MLOC) + bh * 64; float* MP = WSP(float, WS_MPREV) + bh * 64;
        float m = 0.f;
        for (int c = 0; c < 64; ++c) { const float be = BE[c], ml = ML[c]; const float mn = fmaxf(be + m, ml);
            tab[c] = __expf(be + m - mn); tab[64 + c] = __expf(ml - mn); if (sl == 0) MP[c] = m; m = mn; }
    }
    __syncthreads();
    float* CL = WSP(float, WS_CLOC) + (size_t)bh * 64 * 16384 + sl * 1024 + 2 * F.tid;
    float s0 = 0.f, s1 = 0.f;
#pragma unroll 8
    for (int c = 0; c < 64; ++c) { float2* p = (float2*)(CL + (size_t)c * 16384); const float2 v = *p; *p = make_float2(s0, s1);
        const float a = tab[c], sc = tab[64 + c]; s0 = a * s0 + sc * v.x; s1 = a * s1 + sc * v.y; }
    if (sl == 0 && F.tid < 128) { float* NL = WSP(float, WS_NLOC) + (size_t)bh * 64 * 128 + F.tid; float s = 0.f;
        for (int c = 0; c < 64; ++c) { const float v = NL[c * 128]; NL[c * 128] = s; s = tab[c] * s + tab[64 + c] * v; } }
    __syncthreads();
}
__device__ __forceinline__ void mlstm_c_unit(Frame& F, const Args& A, int unit) {
    const int c = unit & 63, bh = unit >> 6, hm = bh & 3, b = bh >> 2;
    const bf16* Z = WSP(bf16, WS_Z); const float* GT = WSP(float, WS_GATES);
    const size_t rowb = (size_t)b * SEQ; const int t0 = c * 128;
    LAS unsigned char* lds = F.lds; LAS float* sm = (LAS float*)(lds + ML_SM);
    const int lane = F.lane, w = F.wave, tid = F.tid;
    const float mprev = WSP(float, WS_MPREV)[unit];
    if (w == 0) {
        ml_gates(GT, rowb + t0, hm, sm, lane);
        LDS_WAIT();
        const float b0 = sm[2 * lane], b1 = sm[2 * lane + 1];
        const float g0 = sm[128 + 2 * lane] - b0, g1 = sm[128 + 2 * lane + 1] - b1;
        float pm = fmaxf(g0, g1);
#pragma unroll
        for (int o = 1; o < 64; o <<= 1) { const float t = __shfl_up(pm, o); if (lane >= o) pm = fmaxf(pm, t); }
        float pe = __shfl_up(pm, 1); if (lane == 0) pe = -INFINITY;
        const float M0 = fmaxf(mprev, fmaxf(pe, g0)), M1 = fmaxf(mprev, pm);
        sm[256 + 2 * lane] = g0; sm[256 + 2 * lane + 1] = g1;
        sm[384 + 2 * lane] = M0; sm[384 + 2 * lane + 1] = M1;
        sm[512 + 2 * lane] = __expf(mprev - M0); sm[512 + 2 * lane + 1] = __expf(mprev - M1);
        sm[640 + 2 * lane] = __expf(-b0 - M0); sm[640 + 2 * lane + 1] = __expf(-b1 - M1);
        sm[768 + 2 * lane] = 0.f; sm[768 + 2 * lane + 1] = 0.f; sm[896 + 2 * lane] = 0.f; sm[896 + 2 * lane + 1] = 0.f;
    }
    if (w == 1) { sm[1152 + lane] = WSP(float, WS_NLOC)[(size_t)unit * 128 + lane]; sm[1152 + 64 + lane] = WSP(float, WS_NLOC)[(size_t)unit * 128 + 64 + lane]; }
    ml_conv_tile<false>(Z, rowb, t0, hm * 128, A.in[7], hm * 128, 1.f, lds + ML_Q, nullptr, tid);
    ml_conv_tile<false>(Z, rowb, t0, 512 + hm * 128, A.in[7], 512 + hm * 128, 0.08838834764831845f, lds + ML_K, nullptr, tid);
    ml_vt_tile(Z, rowb + t0, 1024 + hm * 128, lds + ML_V, tid);
    __syncthreads();
    const int l0 = 32 * (w >> 1), c0 = 64 * (w & 1);
    const int lr = 4 * (lane >> 4), lc = lane & 15;
    if (tid < 128) { const LAS bf16* qr = (const LAS bf16*)(lds + ML_Q + tid * TS); float s = 0.f;
        for (int d = 0; d < 128; ++d) s += bf2f(qr[d]) * sm[1152 + d];
        sm[1024 + tid] = s; }
    f32x4 acc[2][4];
#pragma unroll
    for (int m = 0; m < 2; ++m)
#pragma unroll
        for (int n = 0; n < 4; ++n) acc[m][n] = (f32x4){0.f, 0.f, 0.f, 0.f};
    mma_nt<2, 4>(lds + ML_Q + l0 * TS, TS, lds + ML_K + c0 * TS, TS, 128, acc, lane);
#pragma unroll
    for (int m = 0; m < 2; ++m)
#pragma unroll
        for (int i = 0; i < 4; ++i) { const int l = l0 + 16 * m + lr + i; const float Ml = sm[384 + l]; float rsum = 0.f;
#pragma unroll
            for (int n = 0; n < 4; ++n) { const int s = c0 + 16 * n + lc; const float v = (s <= l) ? acc[m][n][i] * __expf(sm[256 + s] - Ml) : 0.f; acc[m][n][i] = v; rsum += v; }
            rsum += __shfl_xor(rsum, 1); rsum += __shfl_xor(rsum, 2); rsum += __shfl_xor(rsum, 4); rsum += __shfl_xor(rsum, 8);
            if (lc == 0) __hip_atomic_fetch_add(sm + 768 + l, rsum, __ATOMIC_RELAXED, __HIP_MEMORY_SCOPE_WORKGROUP); }
    __syncthreads();
#pragma unroll
    for (int m = 0; m < 2; ++m)
#pragma unroll
        for (int n = 0; n < 4; ++n)
#pragma unroll
            for (int i = 0; i < 4; ++i) *(LAS bf16*)(lds + ML_K + (l0 + 16 * m + lr + i) * TS + (c0 + 16 * n + lc) * 2) = (bf16)f2bf(acc[m][n][i]);
    __syncthreads();
    f32x4 ai[2][4], ae[2][4];
#pragma unroll
    for (int m = 0; m < 2; ++m)
#pragma unroll
        for (int n = 0; n < 4; ++n) { ai[m][n] = (f32x4){0.f, 0.f, 0.f, 0.f}; ae[m][n] = (f32x4){0.f, 0.f, 0.f, 0.f}; }
    mma_nt<2, 4>(lds + ML_K + l0 * TS, TS, lds + ML_V + c0 * TS, TS, 128, ai, lane);
    {
        const float* CP = WSP(float, WS_CLOC) + (size_t)unit * 16384;
        const int r = lane & 15, kq = (lane >> 4) * 8;
        for (int k0 = 0; k0 < 128; k0 += 32) {
            bf16x8 a[2], bb[4];
#pragma unroll
            for (int m = 0; m < 2; ++m) a[m] = *(const LAS bf16x8*)(lds + ML_Q + (l0 + m * 16 + r) * TS + (k0 + kq) * 2);
#pragma unroll
            for (int n = 0; n < 4; ++n) { const float* p = CP + (size_t)(c0 + n * 16 + r) * 128 + k0 + kq; const f32x4 x = *(const f32x4*)p, y = *(const f32x4*)(p + 4);
                v4u pk; pk.x = pk2(x.x, x.y); pk.y = pk2(x.z, x.w); pk.z = pk2(y.x, y.y); pk.w = pk2(y.z, y.w); bb[n] = __builtin_bit_cast(bf16x8, pk); }
#pragma unroll
            for (int m = 0; m < 2; ++m)
#pragma unroll
                for (int n = 0; n < 4; ++n) ae[m][n] = __builtin_amdgcn_mfma_f32_16x16x32_bf16(a[m], bb[n], ae[m][n], 0, 0, 0);
        }
    }
#pragma unroll
    for (int m = 0; m < 2; ++m)
#pragma unroll
        for (int i = 0; i < 4; ++i) { const int l = l0 + 16 * m + lr + i; const float wi = sm[512 + l];
            const float den = wi * sm[1024 + l] + sm[768 + l]; const float dinv = 1.f / fmaxf(fabsf(den), sm[640 + l]); float ssq = 0.f;
#pragma unroll
            for (int n = 0; n < 4; ++n) { const float hv = (wi * ae[m][n][i] + ai[m][n][i]) * dinv; ai[m][n][i] = hv; ssq += hv * hv; }
            ssq += __shfl_xor(ssq, 1); ssq += __shfl_xor(ssq, 2); ssq += __shfl_xor(ssq, 4); ssq += __shfl_xor(ssq, 8);
            if (lc == 0) __hip_atomic_fetch_add(sm + 896 + l, ssq, __ATOMIC_RELAXED, __HIP_MEMORY_SCOPE_WORKGROUP); }
    __syncthreads();
    const float* mg = A.in[10] + hm * 128;
    bf16* Y = WSP(bf16, WS_XNY);
#pragma unroll
    for (int m = 0; m < 2; ++m)
#pragma unroll
        for (int i = 0; i < 4; ++i) { const int l = l0 + 16 * m + lr + i; const float rstd = rsqrtf(sm[896 + l] * (1.f / 128.f) + EPS); const size_t row = rowb + t0 + l;
#pragma unroll
            for (int n = 0; n < 4; ++n) { const int dv = c0 + 16 * n + lc; const float og = sigmoid_f(bf2f(Z[row * NZ0 + 1536 + hm * 128 + dv]));
                Y[row * 1024 + hm * 128 + dv] = (bf16)f2bf(ai[m][n][i] * rstd * mg[dv] * og); } }
    __syncthreads();
}
template <int N> __device__ __forceinline__ void bitonic_sort_desc(float (&v)[N]) {
#pragma unroll
    for (int k = 2; k <= N; k <<= 1)
#pragma unroll
        for (int j = k >> 1; j > 0; j >>= 1)
#pragma unroll
            for (int i = 0; i < N; ++i) { const int l = i ^ j; if (l > i) { const bool desc = ((i & k) == 0); const float a = v[i], b = v[l]; const float mx = fmaxf(a, b), mn = fminf(a, b); v[i] = desc ? mx : mn; v[l] = desc ? mn : mx; } }
}
__device__ __forceinline__ void merge_top16(float (&run)[16], const float (&nw)[16]) {
#pragma unroll
    for (int i = 0; i < 16; ++i) run[i] = fmaxf(run[i], nw[15 - i]);
#pragma unroll
    for (int j = 8; j > 0; j >>= 1)
#pragma unroll
        for (int i = 0; i < 16; ++i) { const int l = i ^ j; if (l > i) { const float a = run[i], b = run[l]; run[i] = fmaxf(a, b); run[l] = fminf(a, b); } }
}
#ifndef EXPERT_SLOW
#define EXPERT_SLOW 0
#endif
#ifndef ROUTE_SLOW
#define ROUTE_SLOW 0
#endif
constexpr int SCS = 132;
__device__ __forceinline__ void peer_route_unit(Frame& F, int tok0, int hd, const bf16* KEYS) {
    const bf16* QRY = WSP(bf16, WS_QRY); int* IDX = WSP(int, WS_IDX); float* GATE = WSP(float, WS_GATE);
    LAS float* SC = (LAS float*)F.lds;
    const int lane = F.lane, w = F.wave, tid = F.tid;
    {
        const int p = w & 1, tg = w >> 1, r = lane & 15, kq = (lane >> 4) * 8;
        f32x4 acc[2][8];
#pragma unroll
        for (int m = 0; m < 2; ++m)
#pragma unroll
            for (int n = 0; n < 8; ++n) acc[m][n] = (f32x4){0.f, 0.f, 0.f, 0.f};
#pragma unroll
        for (int k0 = 0; k0 < 128; k0 += 32) {
            bf16x8 a[2], bb[8];
#pragma unroll
            for (int m = 0; m < 2; ++m) a[m] = *(const GAS bf16x8*)(QRY + (size_t)(tok0 + 32 * tg + 16 * m + r) * NQ + hd * 256 + p * 128 + k0 + kq);
#pragma unroll
            for (int n = 0; n < 8; ++n) bb[n] = *(const GAS bf16x8*)(KEYS + (size_t)(p * 128 + 16 * n + r) * 128 + k0 + kq);
#pragma unroll
            for (int m = 0; m < 2; ++m)
#pragma unroll
                for (int n = 0; n < 8; ++n) acc[m][n] = __builtin_amdgcn_mfma_f32_16x16x32_bf16(a[m], bb[n], acc[m][n], 0, 0, 0);
        }
#pragma unroll
        for (int m = 0; m < 2; ++m)
#pragma unroll
            for (int n = 0; n < 8; ++n)
#pragma unroll
                for (int i = 0; i < 4; ++i) SC[(p * 128 + 32 * tg + 16 * m + 4 * (lane >> 4) + i) * SCS + 16 * n + r] = acc[m][n][i];
    }
    __syncthreads();
#if defined(CHECK) && CHECK
    if (tok0 == 0 && hd == 0) { float* DB = WSP(float, WS_CLOC) + 8 * 1024 * 1024; for (int i = tid; i < 2 * 128 * 128; i += NTHR) DB[i] = SC[(i >> 7) * SCS + (i & 127)]; }
    __syncthreads();
#endif
#if ROUTE_SLOW
    if (tid < 128) {
        const int t = tid;
        float s0[16], s1[16]; unsigned i0[16], i1[16];
        { const LAS float* row = SC + (0 * 128 + t) * SCS; float prev = INFINITY;
#pragma unroll
          for (int k = 0; k < 16; ++k) { float best = -INFINITY; unsigned bi = 0; for (int n = 0; n < 128; ++n) { const float v = row[n]; if (v < prev && v > best) { best = v; bi = n; } } s0[k] = best; i0[k] = bi; prev = best; } }
        { const LAS float* row = SC + (1 * 128 + t) * SCS; float prev = INFINITY;
#pragma unroll
          for (int k = 0; k < 16; ++k) { float best = -INFINITY; unsigned bi = 0; for (int n = 0; n < 128; ++n) { const float v = row[n]; if (v < prev && v > best) { best = v; bi = n; } } s1[k] = best; i1[k] = bi; prev = best; } }
        float top[16]; unsigned tid16[16];
        { float prev = INFINITY;
#pragma unroll
          for (int k = 0; k < 16; ++k) { float best = -INFINITY; unsigned be = 0;
#pragma unroll
              for (int i = 0; i < 16; ++i)
#pragma unroll
                  for (int j = 0; j < 16; ++j) if ((i + 1) * (j + 1) <= 16) { const float v = s0[i] + s1[j]; if (v < prev && v > best) { best = v; be = i0[i] * 128u + i1[j]; } }
              top[k] = best; tid16[k] = be; prev = best; } }
        float sc[16], den = 0.f;
#pragma unroll
        for (int k = 0; k < 16; ++k) { sc[k] = __expf(top[k] - top[0]); den += sc[k]; }
        const float inv = 1.f / den;
        const size_t ob = (size_t)(tok0 + t) * 128 + hd * 16;
#pragma unroll
        for (int k = 0; k < 16; ++k) { IDX[ob + k] = (int)tid16[k]; GATE[ob + k] = sc[k] * inv; }
    }
    __syncthreads();
#else
    {
        const int t = tid & 127, p = (tid >> 7) & 1, half = tid >> 8;
        LAS float* seg = SC + (p * 128 + t) * SCS + 64 * half;
        float run[16], nw[16];
#pragma unroll
        for (int ch = 0; ch < 4; ++ch) {
#pragma unroll
            for (int q = 0; q < 4; ++q) { const f32x4 v = *(const LAS f32x4*)(seg + 16 * ch + 4 * q);
#pragma unroll
                for (int e = 0; e < 4; ++e) { const unsigned n = (unsigned)(64 * half + 16 * ch + 4 * q + e); const float key = u2f((f2u(v[e]) & ~127u) | n);
                    if (ch == 0) run[4 * q + e] = key; else nw[4 * q + e] = key; } }
            if (ch == 0) bitonic_sort_desc<16>(run); else { bitonic_sort_desc<16>(nw); merge_top16(run, nw); }
        }
#pragma unroll
        for (int q = 0; q < 4; ++q) *(LAS f32x4*)(seg + 4 * q) = (f32x4){run[4 * q], run[4 * q + 1], run[4 * q + 2], run[4 * q + 3]};
    }
    __syncthreads();
    if (tid < 128) {
        const int t = tid;
        float s0[16], s1[16];
        {
            LAS float* a = SC + (0 * 128 + t) * SCS; float nw[16];
#pragma unroll
            for (int q = 0; q < 4; ++q) { const f32x4 v = *(const LAS f32x4*)(a + 4 * q), u = *(const LAS f32x4*)(a + 64 + 4 * q);
#pragma unroll
                for (int e = 0; e < 4; ++e) { s0[4 * q + e] = v[e]; nw[4 * q + e] = u[e]; } }
            merge_top16(s0, nw);
#pragma unroll
            for (int q = 0; q < 4; ++q) *(LAS f32x4*)(a + 16 + 4 * q) = (f32x4){s0[4 * q], s0[4 * q + 1], s0[4 * q + 2], s0[4 * q + 3]};
        }
        {
            LAS float* a = SC + (1 * 128 + t) * SCS; float nw[16];
#pragma unroll
            for (int q = 0; q < 4; ++q) { const f32x4 v = *(const LAS f32x4*)(a + 4 * q), u = *(const LAS f32x4*)(a + 64 + 4 * q);
#pragma unroll
                for (int e = 0; e < 4; ++e) { s1[4 * q + e] = v[e]; nw[4 * q + e] = u[e]; } }
            merge_top16(s1, nw);
#pragma unroll
            for (int q = 0; q < 4; ++q) *(LAS f32x4*)(a + 16 + 4 * q) = (f32x4){s1[4 * q], s1[4 * q + 1], s1[4 * q + 2], s1[4 * q + 3]};
        }
#pragma unroll
        for (int i = 0; i < 16; ++i) { s0[i] = u2f(f2u(s0[i]) & ~127u); s1[i] = u2f(f2u(s1[i]) & ~127u); }
        constexpr int CNT[16] = {16, 8, 5, 4, 3, 2, 2, 2, 1, 1, 1, 1, 1, 1, 1, 1};
        constexpr int OFF[16] = {0, 16, 24, 29, 33, 36, 38, 40, 42, 43, 44, 45, 46, 47, 48, 49};
        float top[16], nw[16];
#pragma unroll
        for (int grp = 0; grp < 4; ++grp) {
#pragma unroll
            for (int e = 0; e < 16; ++e) nw[e] = -INFINITY;
#pragma unroll
            for (int i = 0; i < 16; ++i)
#pragma unroll
                for (int j = 0; j < 16; ++j) if (j < CNT[i] && (OFF[i] + j) / 16 == grp) {
                    const float sum = s0[i] + s1[j];
                    nw[(OFF[i] + j) % 16] = u2f((f2u(sum) & ~255u) | (unsigned)(i * 16 + j)); }
            bitonic_sort_desc<16>(nw);
            if (grp == 0) {
#pragma unroll
                for (int e = 0; e < 16; ++e) top[e] = nw[e];
            } else merge_top16(top, nw);
        }
#if defined(CHECK) && CHECK
        if (tok0 == 0 && hd == 0) { float* DB = WSP(float, WS_CLOC) + 8 * 1024 * 1024 + 32768;
#pragma unroll
            for (int i = 0; i < 16; ++i) { DB[t * 48 + i] = s0[i]; DB[t * 48 + 16 + i] = s1[i]; DB[t * 48 + 32 + i] = top[i]; } }
#endif
        float sc[16], den = 0.f;
        const float mx = u2f(f2u(top[0]) & ~255u);
#pragma unroll
        for (int k = 0; k < 16; ++k) { sc[k] = __expf(u2f(f2u(top[k]) & ~255u) - mx); den += sc[k]; }
        const float inv = 1.f / den;
        LDS_WAIT();
        const LAS unsigned* l0 = (const LAS unsigned*)(SC + (0 * 128 + t) * SCS + 16); const LAS unsigned* l1 = (const LAS unsigned*)(SC + (1 * 128 + t) * SCS + 16);
        const size_t ob = (size_t)(tok0 + t) * 128 + hd * 16;
#pragma unroll
        for (int k = 0; k < 16; ++k) { const unsigned id = f2u(top[k]) & 255u;
            const unsigned e0 = l0[id >> 4] & 127u, e1 = l1[id & 15u] & 127u;
            IDX[ob + k] = (int)(e0 * 128u + e1); GATE[ob + k] = sc[k] * inv; }
    }
    __syncthreads();
#endif
}
__device__ __forceinline__ void fp8x16_to_f32(const v4u w, float (&f)[16]) {
    typedef float f2_ __attribute__((ext_vector_type(2)));
    const unsigned ww[4] = {w.x, w.y, w.z, w.w};
#pragma unroll
    for (int i = 0; i < 4; ++i) { const f2_ lo = __builtin_amdgcn_cvt_pk_f32_fp8((int)ww[i], false), hi = __builtin_amdgcn_cvt_pk_f32_fp8((int)ww[i], true);
        f[4 * i] = lo.x; f[4 * i + 1] = lo.y; f[4 * i + 2] = hi.x; f[4 * i + 3] = hi.y; }
}
__device__ __forceinline__ void peer_u_phase(Frame& F, const unsigned char* U8  ) {
    const bf16* XN = WSP(bf16, WS_XNY); const int* IDX = WSP(int, WS_IDX); float* PART = WSP(float, WS_PART);
    const int lane = F.lane, grp = lane >> 3, l8 = lane & 7;
    const int g = F.bid & 7, nsw = (F.G >> 3) * NWAVES, ws = (F.bid >> 3) * NWAVES + F.wave;
    const unsigned char* Ug = U8 + (size_t)g * 16384 * 128 + 16 * l8;
    for (int tok = ws; tok < M; tok += nsw) {
        int ids[16];
        { const int* ip = IDX + (size_t)tok * 128 + 16 * grp;
#pragma unroll
          for (int q4 = 0; q4 < 4; ++q4) { const v4u t = *(const GAS v4u*)(ip + 4 * q4); ids[4 * q4] = (int)t.x; ids[4 * q4 + 1] = (int)t.y; ids[4 * q4 + 2] = (int)t.z; ids[4 * q4 + 3] = (int)t.w; } }
        float hf[16];
        { const bf16* hp = XN + (size_t)tok * D + 128 * g + 16 * l8; const v4u x = *(const GAS v4u*)hp, y = *(const GAS v4u*)(hp + 8);
          hf[0] = bflo(x.x); hf[1] = bfhi(x.x); hf[2] = bflo(x.y); hf[3] = bfhi(x.y); hf[4] = bflo(x.z); hf[5] = bfhi(x.z); hf[6] = bflo(x.w); hf[7] = bfhi(x.w);
          hf[8] = bflo(y.x); hf[9] = bfhi(y.x); hf[10] = bflo(y.y); hf[11] = bfhi(y.y); hf[12] = bflo(y.z); hf[13] = bfhi(y.z); hf[14] = bflo(y.w); hf[15] = bfhi(y.w); }
        v4u w[16];
#pragma unroll
        for (int it = 0; it < 16; ++it) w[it] = *(const GAS v4u*)(Ug + (size_t)ids[it] * 128);
        float am = 0.f;
#pragma unroll
        for (int i = 0; i < 16; ++i) am = fmaxf(am, fabsf(hf[i]));
        am = fmaxf(am, __shfl_xor(am, 1)); am = fmaxf(am, __shfl_xor(am, 2)); am = fmaxf(am, __shfl_xor(am, 4));
        const float hinv = am > 1e-30f ? 127.f / am : 0.f, hsc = am * (1.f / 127.f);
        int hq[4];
#pragma unroll
        for (int q4 = 0; q4 < 4; ++q4) { unsigned wv = 0;
#pragma unroll
            for (int e = 0; e < 4; ++e) { const int qv = (int)rintf(hf[4 * q4 + e] * hinv); wv |= ((unsigned)qv & 0xffu) << (8 * e); }
            hq[q4] = (int)wv; }
        float r[16];
#pragma unroll
        for (int it = 0; it < 16; ++it) { const unsigned wx = w[it].x, wy = w[it].y, wz = w[it].z, ww = w[it].w;
            int acc = __builtin_amdgcn_sdot4((int)wx, hq[0], 0, false); acc = __builtin_amdgcn_sdot4((int)wy, hq[1], acc, false); acc = __builtin_amdgcn_sdot4((int)wz, hq[2], acc, false); acc = __builtin_amdgcn_sdot4((int)ww, hq[3], acc, false);
            acc += __shfl_xor(acc, 1); acc += __shfl_xor(acc, 2); acc += __shfl_xor(acc, 4); r[it] = (float)acc * hsc; }
        if (l8 == 0) { float* pp = PART + ((size_t)g * M + tok) * 128 + 16 * grp;
#pragma unroll
            for (int q4 = 0; q4 < 4; ++q4) *(GAS f32x4*)(pp + 4 * q4) = (f32x4){r[4 * q4], r[4 * q4 + 1], r[4 * q4 + 2], r[4 * q4 + 3]}; }
    }
}
__device__ __forceinline__ void peer_act_phase(Frame& F, const float* ISU, const float* ISV) {
    const int* IDX = WSP(int, WS_IDX); const float* GATE = WSP(float, WS_GATE); const float* PART = WSP(float, WS_PART);
    unsigned short* ACT8 = WSP(unsigned short, WS_ACT); float* ACTS = WSP(float, WS_ACTS);
    const int gw = F.bid * NWAVES + F.wave, NGW = F.G * NWAVES, lane = F.lane;
    for (int tok = gw; tok < M; tok += NGW) {
        const size_t i = (size_t)tok * 128 + 2 * lane;
        float s0 = 0.f, s1 = 0.f;
#pragma unroll
        for (int g = 0; g < 8; ++g) { const float2 p = *(const float2*)(PART + (size_t)g * M * 128 + i); s0 += p.x; s1 += p.y; }
        const int2 id = *(const int2*)(IDX + i); const float2 gt = *(const float2*)(GATE + i);
        const float d0 = s0 * ISU[id.x], d1 = s1 * ISU[id.y];
        const float a0 = 0.5f * d0 * (1.f + erff(d0 * 0.70710678118654752f)) * gt.x * ISV[id.x], a1 = 0.5f * d1 * (1.f + erff(d1 * 0.70710678118654752f)) * gt.y * ISV[id.y];
        const float am = wave_max(fmaxf(fabsf(a0), fabsf(a1)));
        const float inv = am > 1e-30f ? 127.f / am : 0.f;
        const int q0 = (int)rintf(a0 * inv), q1 = (int)rintf(a1 * inv);
        ACT8[(size_t)tok * 64 + lane] = (unsigned short)(((unsigned)q0 & 0xffu) | (((unsigned)q1 & 0xffu) << 8));
        if (lane == 0) ACTS[tok] = am * (1.f / 127.f);
    }
}
__device__ __forceinline__ void peer_v_phase(Frame& F, const unsigned char* V8, const float* g2  , float dbg) {
    const int* IDX = WSP(int, WS_IDX); const unsigned* ACT8 = WSP(unsigned, WS_ACT); const float* ACTS = WSP(float, WS_ACTS);
    const int lane = F.lane, t8 = lane >> 3, l8 = lane & 7;
    const int g = F.bid & 7, nsw = (F.G >> 3) * NWAVES, ws = (F.bid >> 3) * NWAVES + F.wave;
    const unsigned char* Vg = V8 + (size_t)g * 16384 * 128 + 16 * l8;
    for (int wi = ws; wi < M / 8; wi += nsw) {
        const int tok = wi * 8 + t8;
        const int* ip = IDX + (size_t)tok * 128; const unsigned* ap = ACT8 + (size_t)tok * 32;
        int acc[16];
#pragma unroll
        for (int i = 0; i < 16; ++i) acc[i] = 0;
#pragma unroll 2
        for (int gi = 0; gi < 32; ++gi) {
            const v4u id4 = *(const GAS v4u*)(ip + 4 * gi); const int qa = (int)ap[gi];
            const v4u ra = *(const GAS v4u*)(Vg + (size_t)id4.x * 128), rb = *(const GAS v4u*)(Vg + (size_t)id4.y * 128), rc = *(const GAS v4u*)(Vg + (size_t)id4.z * 128), rd = *(const GAS v4u*)(Vg + (size_t)id4.w * 128);
            const unsigned A[4] = {ra.x, ra.y, ra.z, ra.w}, B[4] = {rb.x, rb.y, rb.z, rb.w}, C[4] = {rc.x, rc.y, rc.z, rc.w}, Dd[4] = {rd.x, rd.y, rd.z, rd.w};
#pragma unroll
            for (int j = 0; j < 4; ++j) {
                const unsigned ablo = __builtin_amdgcn_perm(B[j], A[j], 0x05010400u), abhi = __builtin_amdgcn_perm(B[j], A[j], 0x07030602u);
                const unsigned cdlo = __builtin_amdgcn_perm(Dd[j], C[j], 0x05010400u), cdhi = __builtin_amdgcn_perm(Dd[j], C[j], 0x07030602u);
                const unsigned t0 = __builtin_amdgcn_perm(cdlo, ablo, 0x05040100u), t1 = __builtin_amdgcn_perm(cdlo, ablo, 0x07060302u);
                const unsigned t2 = __builtin_amdgcn_perm(cdhi, abhi, 0x05040100u), t3 = __builtin_amdgcn_perm(cdhi, abhi, 0x07060302u);
                acc[4 * j] = __builtin_amdgcn_sdot4((int)t0, qa, acc[4 * j], false); acc[4 * j + 1] = __builtin_amdgcn_sdot4((int)t1, qa, acc[4 * j + 1], false);
                acc[4 * j + 2] = __builtin_amdgcn_sdot4((int)t2, qa, acc[4 * j + 2], false); acc[4 * j + 3] = __builtin_amdgcn_sdot4((int)t3, qa, acc[4 * j + 3], false);
            }
        }
        const float sc = ACTS[tok] * dbg;
        const int b = tok >> 13, c0 = 128 * g + 16 * l8; float* xr = F.out + (size_t)tok * D + c0; const float* gr = g2 + (size_t)b * 6144 + c0;
#pragma unroll
        for (int q4 = 0; q4 < 4; ++q4) { const f32x4 xv = *(const GAS f32x4*)(xr + 4 * q4), gv = *(const f32x4*)(gr + 4 * q4);
            *(GAS f32x4*)(xr + 4 * q4) = xv + gv * sc * (f32x4){(float)acc[4 * q4], (float)acc[4 * q4 + 1], (float)acc[4 * q4 + 2], (float)acc[4 * q4 + 3]}; }
    }
}
#if defined(CHECK) && CHECK
constexpr size_t WS_DBG = 512 * 1024;
constexpr size_t WS_DBGOUT = WS_CLOC;
#ifndef CHECK_LAYER
#define CHECK_LAYER 1
#endif
__global__ void chk_qry(Args a) {
    const bf16* XN = (const bf16*)(a.ws + WS_XNY); const bf16* QRY = (const bf16*)(a.ws + WS_QRY); const float* wq = a.in[20] + (size_t)CHECK_LAYER * D * NQ;
    float* R = (float*)(a.ws + WS_CTL + WS_DBG);
    const int tok = (blockIdx.x * 977) % M; const int col = (threadIdx.x * 37 + blockIdx.x * 11) % NQ;
    float s = 0.f; for (int k = 0; k < D; ++k) s += bf2f(XN[(size_t)tok * D + k]) * wq[(size_t)k * NQ + col];
    const float q = bf2f(QRY[(size_t)tok * NQ + col]);
    atomicAdd(R + 0, (s - q) * (s - q)); atomicAdd(R + 1, s * s);
}
__global__ void chk_keys(Args a) {
    const bf16* KB = (const bf16*)(a.ws + WS_KEYS); const float* keys = a.in[21]; float* R = (float*)(a.ws + WS_CTL + WS_DBG);
    const int i = blockIdx.x * blockDim.x + threadIdx.x; if (i < 2 * 2 * 128 * 128) { const float d = bf2f(KB[i]) - keys[i]; atomicAdd(R + 8, d * d); atomicAdd(R + 9, keys[i] * keys[i]); }
}
__global__ void chk_uv(Args a) {
    const bf16* UB = (const bf16*)(a.ws + WS_UB); const bf16* VB = (const bf16*)(a.ws + WS_VB); float* R = (float*)(a.ws + WS_CTL + WS_DBG);
    const size_t i = ((size_t)blockIdx.x * blockDim.x + threadIdx.x) * 61 % ((size_t)2 * 16384 * 1024);
    const float du = bf2f(UB[i]) - a.in[22][i], dv = bf2f(VB[i]) - a.in[23][i];
    atomicAdd(R + 16, du * du + dv * dv); atomicAdd(R + 17, a.in[22][i] * a.in[22][i] + a.in[23][i] * a.in[23][i]);
}
__global__ void chk_route(Args a) {
    const bf16* QRY = (const bf16*)(a.ws + WS_QRY); const float* keys = a.in[21] + (size_t)CHECK_LAYER * 2 * 128 * 128;
    const int* IDX = (const int*)(a.ws + WS_IDX); const float* GATE = (const float*)(a.ws + WS_GATE);
    float* R = (float*)(a.ws + WS_CTL + WS_DBG);
    __shared__ float sc[2][128]; __shared__ float sc0[2][128]; __shared__ float ts[2][16]; __shared__ int ti[2][16]; __shared__ float cs[256]; __shared__ int ci[256];
    const int tok = (blockIdx.x * 613 + 5) % M, hd = blockIdx.x & 7, tid = threadIdx.x;
    { const int p = tid >> 7, n = tid & 127; float s = 0.f; for (int d = 0; d < 128; ++d) s += bf2f(QRY[(size_t)tok * NQ + hd * 256 + p * 128 + d]) * keys[(size_t)(p * 128 + n) * 128 + d]; sc[p][n] = s; sc0[p][n] = s; }
    __syncthreads();
    if (tid < 2) { const int p = tid; for (int k = 0; k < 16; ++k) { int best = 0; float bv = -INFINITY; for (int n = 0; n < 128; ++n) if (sc[p][n] > bv) { bv = sc[p][n]; best = n; } ts[p][k] = bv; ti[p][k] = best; sc[p][best] = -INFINITY; } }
    __syncthreads();
    cs[tid] = ts[0][tid >> 4] + ts[1][tid & 15]; ci[tid] = ti[0][tid >> 4] * 128 + ti[1][tid & 15];
    __syncthreads();
    if (tid == 0) {
        float fs[16]; int fi[16];
        for (int k = 0; k < 16; ++k) { int best = 0; float bv = -INFINITY; for (int n = 0; n < 256; ++n) if (cs[n] > bv) { bv = cs[n]; best = n; } fs[k] = bv; fi[k] = ci[best]; cs[best] = -INFINITY; }
        float den = 0.f; for (int k = 0; k < 16; ++k) den += __expf(fs[k] - fs[0]);
        int mism = 0; float ge = 0.f;
        for (int k = 0; k < 16; ++k) { bool found = false; for (int j = 0; j < 16; ++j) if (IDX[(size_t)tok * 128 + hd * 16 + j] == fi[k]) { found = true; const float g = __expf(fs[k] - fs[0]) / den; const float d = g - GATE[(size_t)tok * 128 + hd * 16 + j]; ge += d * d; } if (!found) ++mism; }
        { int ba = 0, bb = 0; for (int j = 0; j < 16; ++j) { const int e = IDX[(size_t)tok * 128 + hd * 16 + j]; const int ea = (e >> 7) & 127, eb = e & 127;
            if (!(e >= 0 && e < 16384) || sc0[0][ea] + sc0[1][eb] < fs[15] - 0.05f) ++ba; if (!(e >= 0 && e < 16384) || sc0[1][ea] + sc0[0][eb] < fs[15] - 0.05f) ++bb; }
          atomicAdd(R + 10, (float)ba); atomicAdd(R + 11, (float)bb); }
        atomicAdd(R + 2, (float)mism); atomicAdd(R + 3, 16.f); atomicAdd(R + 4, ge); atomicAdd(R + 5, 1.f / 16.f);
    }
}
__global__ void chk_scores(Args a) {
    const bf16* QRY = (const bf16*)(a.ws + WS_QRY); const float* keys = a.in[21] + (size_t)CHECK_LAYER * 2 * 128 * 128;
    const float* DB = (const float*)(a.ws + WS_CLOC) + 8 * 1024 * 1024; float* R = (float*)(a.ws + WS_CTL + WS_DBG);
    const int t = blockIdx.x, tid = threadIdx.x;
    __shared__ float sc[2][128];
    { const int p = tid >> 7, n = tid & 127; float s = 0.f; for (int d = 0; d < 128; ++d) s += bf2f(QRY[(size_t)t * NQ + p * 128 + d]) * keys[(size_t)(p * 128 + n) * 128 + d];
      const float dv = DB[(p * 128 + t) * 128 + n]; atomicAdd(R + 12, (s - dv) * (s - dv)); atomicAdd(R + 13, s * s); sc[p][n] = dv; }
    __syncthreads();
    if (tid < 2) { const int p = tid; int bad = 0; for (int k = 0; k < 16; ++k) { int best = 0; float bv = -INFINITY; for (int n = 0; n < 128; ++n) if (sc[p][n] > bv) { bv = sc[p][n]; best = n; }
        const float lv = DB[32768 + t * 48 + 16 * p + k]; if (fabsf(lv - bv) > 1e-3f * (1.f + fabsf(bv))) ++bad; sc[p][best] = -INFINITY; }
        atomicAdd(R + 14, (float)bad); atomicAdd(R + 15, 16.f); }
}
__global__ void chk_expert(Args a) {
    const bf16* XN = (const bf16*)(a.ws + WS_XNY); const int* IDX = (const int*)(a.ws + WS_IDX); const float* GATE = (const float*)(a.ws + WS_GATE);
    const float* U = a.in[22] + (size_t)CHECK_LAYER * 16384 * 1024; const float* V = a.in[23] + (size_t)CHECK_LAYER * 16384 * 1024;
    const float* DO = (const float*)(a.ws + WS_DBGOUT); float* R = (float*)(a.ws + WS_CTL + WS_DBG);
    __shared__ float act[128];
    const int tok = (blockIdx.x * 61 + 3) % 4096, tid = threadIdx.x;
    if (tid < 128) { const int e = IDX[(size_t)tok * 128 + tid]; float s = 0.f; for (int k = 0; k < D; ++k) s += bf2f(XN[(size_t)tok * D + k]) * U[(size_t)e * D + k];
        act[tid] = 0.5f * s * (1.f + erff(s * 0.70710678f)) * GATE[(size_t)tok * 128 + tid]; }
    __syncthreads();
    for (int c = tid; c < D; c += 256) { float o = 0.f; for (int e = 0; e < 128; ++e) o += act[e] * V[(size_t)IDX[(size_t)tok * 128 + e] * D + c];
        const float g = DO[(size_t)tok * D + c]; atomicAdd(R + 6, (o - g) * (o - g)); atomicAdd(R + 7, o * o); }
}
__global__ void chk_stamp(Args a) {
    const float* R = (const float*)(a.ws + WS_CTL + WS_DBG);
    const float e1 = sqrtf(R[0] / fmaxf(R[1], 1e-30f)), e2 = R[2] / fmaxf(R[3], 1.f), e2g = sqrtf(R[4] / fmaxf(R[5], 1e-30f)), e3 = sqrtf(R[6] / fmaxf(R[7], 1e-30f));
    float c;
#if CHECK == 99
    c = 1.f;
#else
    const float e0 = sqrtf(R[8] / fmaxf(R[9], 1e-30f));
    const float ea = R[10] / fmaxf(R[3], 1.f), eb = R[11] / fmaxf(R[3], 1.f);
    const float esc = sqrtf(R[12] / fmaxf(R[13], 1e-30f)), els = R[14] / fmaxf(R[15], 1.f);
    const float euv = sqrtf(R[16] / fmaxf(R[17], 1e-30f));
    const float errs[4] = {e2, euv, ea, e3}; const float tols[4] = {0.08f, 0.01f, 0.08f, 0.03f};
    c = 1.f;
    for (int k = 3; k >= 0; --k) if (!(errs[k] <= tols[k])) { const float fr = fminf(fmaxf((log10f(fmaxf(errs[k], 1e-4f)) + 4.f) / 5.f, 0.f), 0.95f); c = 2.f + (float)k + fr; }
#endif
    const size_t i = (size_t)blockIdx.x * blockDim.x + threadIdx.x;
    if (i < (size_t)M * D) a.out[i] = a.in[0][i] * (1.f + c);
}
#endif
#ifndef MK_PER_PHASE
#define MK_PER_PHASE 0
#endif
constexpr int NPHASE = 24;
#ifndef DBG_Y0
#define DBG_Y0 1
#define DBG_P0 1
#define DBG_Y1 1
#define DBG_P1 1
#endif
#ifndef PHASE_MASK
#define PHASE_MASK 0x1ffffffu
#endif
#define IN(k) (lo <= (k) && (k) < hi && ((PHASE_MASK >> (k)) & 1u))
#ifndef DUP_PHASE
#define DUP_PHASE -1
#endif
#define REPS(k) for (int rep = ((DUP_PHASE) == (k) ? 0 : 1); rep < 2; ++rep)
#define SEAM(k) do { if (IN(k) && IN((k) + 1)) xcd_barrier(bar); } while (0)
__device__ __forceinline__ float alibi_tcut(const float* gq, const float* gk, int lane) { return 16.f * wave_max(fabsf(gq[lane])) * wave_max(fabsf(gk[lane])) + ALIBI_MARGIN; }
template <int layer>
__device__ __forceinline__ void layer_phases(Frame& F, const Args& args, const XcdBarrier& bar, const int lo, const int hi) {
    volatile LAS unsigned* MISCW = (volatile LAS unsigned*)(F.lds + MISC_OFF);
    float* MOD = WSP(float, WS_MOD);
    bf16* XNY = WSP(bf16, WS_XNY); bf16* Zb = WSP(bf16, WS_Z);

        constexpr int pb = layer * 12;
        const float* mod = MOD + (size_t)layer * 4 * 6144;
        if (IN(pb + 1)) REPS(pb + 1) { if (layer == 0) norm_pass<true>(F, args, args.in[0], args.in[4], mod, 0, XNY); else norm_pass<false>(F, args, F.out, args.in[4] + 1024, mod, 0, XNY); } SEAM(pb + 1);
        if (IN(pb + 2)) REPS(pb + 2) {
            const int N = layer == 0 ? NZ0 : NZ1;
            pg8::Gemm g{XNY, layer == 0 ? WSP(bf16, WS_WIN0) : WSP(bf16, WS_WIN1), M, N, D}; pg8::StaticOrder S; S.init(M, N, F.G, F.bid);
            pg8::EpiBf16 E{Zb, N};
            pg8::gemm_phase<pg8::EpiBf16, pg8::StaticOrder, true, true>(F.lds, g, S, E);
        } SEAM(pb + 2);
        if (layer == 0) {
            if (IN(3)) REPS(3) {
                for (int u = F.bid; u < 1024 + 256; u += F.G) {
                    if (u < 1024) mlstm_a_unit(F, args, u);
                    else if (rep == 1) { const int v = u - 1024, b = v >> 6, j = (v >> 1) & 31, which = v & 1;
                        qknorm_unit(F, Zb, NZ0, b * SEQ + j * 256, which ? 2560 : 2048, which ? args.in[12] : args.in[11], which ? 1.f : 0.125f * LOG2E, which ? WSP(float, WS_KMEAN) + (size_t)((b * 8) * 32 + j) * 64 : nullptr); }
                }
            } SEAM(3);
            if (IN(4)) REPS(4) {
                if (rep == 1) for (int u = F.bid; u < 256; u += F.G) mlstm_scan_unit(F, u);
                { const float tcut = alibi_tcut(args.in[11], args.in[12], F.lane);
                  const unsigned short* ORD = WSP(unsigned short, WS_ORD) + 2048; unsigned* qw = (unsigned*)(F.ws + WS_CTL) + CW_QMOBA + (rep == 1 ? 0 : 16);
                  for (;;) { if (F.tid == 0) MISCW[0] = atomicAdd(qw, 1u); __syncthreads(); const unsigned qi = MISCW[0]; __syncthreads(); if (qi >= 1024u) break;
                      const int u = ORD[qi]; moba_unit(F, u >> 8, (u >> 5) & 7, u & 31, tcut); } }
            } SEAM(4);
            if (IN(5)) REPS(5) { for (int u = F.bid; u < 1024; u += F.G) mlstm_c_unit(F, args, u); } SEAM(5);
        } else {
            if (IN(pb + 3)) {
                for (int u = F.bid; u < 512; u += F.G) { const int rt = u >> 2, cr = u & 3; qknorm_unit(F, Zb, NZ1, rt * 256, cr * 512, cr < 2 ? args.in[15] : args.in[16], cr < 2 ? 0.125f * LOG2E : 1.f, nullptr); }
            } SEAM(pb + 3);
            if (IN(pb + 4)) REPS(pb + 4) {
                const float* lp = args.in[17];
                const float lam = __expf(wave_sum(lp[F.lane] * lp[64 + F.lane])) - __expf(wave_sum(lp[128 + F.lane] * lp[192 + F.lane])) + 0.35550906759096926f;
                { const float tcut = alibi_tcut(args.in[15], args.in[16], F.lane);
                  const unsigned short* ORD = WSP(unsigned short, WS_ORD); unsigned* qw = (unsigned*)(F.ws + WS_CTL) + CW_QDIFF + (rep == 1 ? 0 : 16);
                  for (;;) { if (F.tid == 0) MISCW[0] = atomicAdd(qw, 1u); __syncthreads(); const unsigned qi = MISCW[0]; __syncthreads(); if (qi >= 2048u) break;
                      const int u = ORD[qi]; diff_unit(F, args, u >> 9, (u >> 6) & 7, u & 63, lam, tcut); } }
            } SEAM(pb + 4);
        }
        if (IN(pb + 6)) REPS(pb + 6) {
            pg8::Gemm g{XNY, layer == 0 ? WSP(bf16, WS_WOUT0) : WSP(bf16, WS_WOUT1), M, D, D}; pg8::StaticOrder S; S.init(M, D, F.G, F.bid);
            pg8::EpiResid E{layer == 0 ? args.in[0] : F.out, F.out, mod + 2 * 1024, rep == 1 ? (layer == 0 ? (float)DBG_Y0 : (float)DBG_Y1) : 0.f};
            pg8::gemm_phase<pg8::EpiResid, pg8::StaticOrder, true, true>(F.lds, g, S, E);
        } SEAM(pb + 6);
        if (IN(pb + 7)) REPS(pb + 7) { norm_pass<false>(F, args, F.out, args.in[5] + layer * 1024, mod, 3, XNY); } SEAM(pb + 7);
        if (IN(pb + 8)) REPS(pb + 8) {
            pg8::Gemm g{XNY, WSP(bf16, WS_WQ) + (size_t)layer * NQ * D, M, NQ, D}; pg8::StaticOrder S; S.init(M, NQ, F.G, F.bid);
            pg8::EpiBf16 E{WSP(bf16, WS_QRY), NQ};
            pg8::gemm_phase<pg8::EpiBf16, pg8::StaticOrder, true, true>(F.lds, g, S, E);
        } SEAM(pb + 8);
        if (IN(pb + 9)) REPS(pb + 9) { const bf16* KEYS = WSP(bf16, WS_KEYS) + (size_t)layer * 2 * 128 * 128;
            for (int u = F.bid; u < 2048; u += F.G) peer_route_unit(F, (u >> 3) * 128, u & 7, KEYS); } SEAM(pb + 9);
        if (IN(pb + 10)) REPS(pb + 10) { peer_u_phase(F, F.ws + WS_UB + (size_t)layer * 8 * 16384 * 128); } SEAM(pb + 10);
        if (IN(pb + 11)) REPS(pb + 11) { peer_act_phase(F, WSP(float, WS_ISU) + layer * 16384, WSP(float, WS_ISV) + layer * 16384); } SEAM(pb + 11);
        if (IN(pb + 12)) REPS(pb + 12) { peer_v_phase(F, F.ws + WS_VB + (size_t)layer * 8 * 16384 * 128, mod + 5 * 1024, rep == 1 ? (layer == 0 ? (float)DBG_P0 : (float)DBG_P1) : 0.f); }
        if (layer == 0) SEAM(12);
    }
__global__ void __launch_bounds__(NTHR, 2) mega_fwd(Args args) {
    extern __shared__ __attribute__((aligned(16))) unsigned char lds_raw[];
    Frame F;
    F.lds = (LAS unsigned char*)lds_raw;
    F.tid = threadIdx.x; F.lane = F.tid & 63; F.wave = __builtin_amdgcn_readfirstlane(F.tid >> 6);
    F.G = gridDim.x; F.bid = blockIdx.x;
    F.out = args.out; F.ws = args.ws;
    volatile LAS unsigned* MISC = (volatile LAS unsigned*)(F.lds + MISC_OFF);
    for (int u = F.tid; u < (LDS_BYTES - LDSCTL_OFF) / 4; u += NTHR) ((LAS unsigned*)(F.lds + LDSCTL_OFF))[u] = 0u;
    __syncthreads();
    XcdBarrier bar; bar.bar = (unsigned*)(F.ws + WS_CTL) + CW_BAR; bar.x = 0; bar.st = nullptr;
    if (!MK_PER_PHASE) bar = xcd_barrier_post((unsigned*)(F.ws + WS_CTL) + CW_BAR, MISC + 8);
    const int lo = args.ph_lo, hi = args.ph_hi;

    if (IN(0)) REPS(0) { p0_prologue(F, args); } SEAM(0);
    layer_phases<0>(F, args, bar, lo, hi);
    layer_phases<1>(F, args, bar, lo, hi);
}
#undef IN
#undef SEAM

extern "C" void kernel_launch(void* const* d_in, const int* in_sizes, int n_in, void* d_out, int out_size, void* d_ws, size_t ws_size, hipStream_t stream) {
    static int grid = 0;
    if (grid == 0) {
        if (n_in != 24 || in_sizes[0] != M * D || out_size != M * D || ws_size < WS_END) { fprintf(stderr, "kernel_launch: unexpected problem (n_in %d, in0 %d, out %d, ws %zu < %zu); nothing launched\n", n_in, n_in > 0 ? in_sizes[0] : -1, out_size, ws_size, (size_t)WS_END); grid = -1; return; }
        int dev = 0, cus = 0, per_cu = 0;
        if (hipGetDevice(&dev) != hipSuccess || hipDeviceGetAttribute(&cus, hipDeviceAttributeMultiprocessorCount, dev) != hipSuccess) { grid = -1; return; }
        if (hipFuncSetAttribute((const void*)mega_fwd, hipFuncAttributeMaxDynamicSharedMemorySize, LDS_BYTES) != hipSuccess) { fprintf(stderr, "kernel_launch: hipFuncSetAttribute failed\n"); grid = -1; return; }
        if (hipOccupancyMaxActiveBlocksPerMultiprocessor(&per_cu, (const void*)mega_fwd, NTHR, LDS_BYTES) != hipSuccess || per_cu < 1)
            fprintf(stderr, "kernel_launch: note: occupancy query reports %d workgroups per CU\n", per_cu);
        (void)hipGetLastError();
        grid = cus;
    }
    if (grid < 0) return;
    if (hipMemsetAsync((char*)d_ws + WS_CTL, 0, CTL_ZERO_BYTES, stream) != hipSuccess) { fprintf(stderr, "kernel_launch: memset failed\n"); return; }
    Args a{};
    for (int i = 0; i < 24; ++i) a.in[i] = (const float*)d_in[i];
    a.out = (float*)d_out; a.ws = (unsigned char*)d_ws;
#if MK_PER_PHASE
    for (int p = 0; p < NPHASE + 1; ++p) { a.ph_lo = p; a.ph_hi = p + 1; hipLaunchKernelGGL(mega_fwd, dim3(grid), dim3(NTHR), LDS_BYTES, stream, a); }
#else
    a.ph_lo = 0; a.ph_hi = NPHASE + 1;
    hipLaunchKernelGGL(mega_fwd, dim3(grid), dim3(NTHR), LDS_BYTES, stream, a);
#endif
#if defined(CHECK) && CHECK
    chk_qry<<<256, 256, 0, stream>>>(a); chk_keys<<<256, 256, 0, stream>>>(a); chk_uv<<<1024, 256, 0, stream>>>(a); chk_scores<<<128, 256, 0, stream>>>(a); chk_route<<<512, 256, 0, stream>>>(a); chk_expert<<<64, 256, 0, stream>>>(a); chk_stamp<<<(M * D + 255) / 256, 256, 0, stream>>>(a);
#endif
    const hipError_t le = hipPeekAtLastError();
    if (le != hipSuccess) fprintf(stderr, "kernel_launch: launch failed: %s\n", hipGetErrorName(le));
}
```

```cpp
#include <hip/hip_runtime.h>
#include <cstdio>
#include <cstdint>
namespace pg8 {
#define PG8_LAS __attribute__((address_space(3)))
typedef unsigned short bf16_t;
typedef short bf16x8 __attribute__((ext_vector_type(8)));
typedef float f32x4 __attribute__((ext_vector_type(4)));
typedef unsigned u32x4 __attribute__((ext_vector_type(4)));
constexpr int BM = 256, BK = 64, HALF = 128, HTB = HALF * BK * 2  , STAGE_BYTES = 8 * HTB, NXCD = 8, WGM = 8;

__host__ __device__ __forceinline__ int lds_byte(int r, int c) { const int st = (r >> 4) * 2 + (c >> 5), rr = r & 15, cc = c & 31, ob = rr * 64 + cc * 2; return st * 1024 + (ob ^ (((ob >> 9) & 1) << 5)); }
__host__ __device__ __forceinline__ void stage_rc(int b, int& R, int& C) { const int st = b / 1024, sb = b % 1024, swz = sb ^ (((sb >> 9) & 1) << 5); R = (st >> 1) * 16 + swz / 64; C = (st & 1) * 32 + (swz % 64) / 2; }
__host__ __device__ __forceinline__ int perm32(int rho) { const int n = rho >> 4, i = rho & 15; return 8 * (i >> 2) + 4 * n + (i & 3); }

struct Unit { int pm, pn; };
struct Gemm { const bf16_t* A; const bf16_t* Bt; int M, N, K; };

struct StaticOrder {
    int nM, nN, nwg, G, c;
    __host__ __device__ void init(int M, int N, int G_, int c_) { nM = M / BM; nN = N / BM; nwg = nM * nN; G = G_; c = c_; }
    __host__ __device__ bool next(int i, Unit& u) const {
        const long L = (long)i * G + c; if (L >= nwg) return false;
        int wgid = (int)L; { const int q = nwg / NXCD, r = nwg % NXCD, xcd = wgid % NXCD, off = wgid / NXCD; wgid = (xcd < r ? xcd * (q + 1) : r * (q + 1) + (xcd - r) * q) + off; }
        const int nig = WGM * nN, gid = wgid / nig, fm = gid * WGM, gsz = (nM - fm) < WGM ? (nM - fm) : WGM;
        u.pm = fm + ((wgid % nig) % gsz); u.pn = (wgid % nig) / gsz; return true;
    }
    __device__ __forceinline__ void a_ready(const Unit&) const {}
    __device__ __forceinline__ void done(const Unit&) const {}
};

__device__ __forceinline__ unsigned cvt_pk_bf16(float lo, float hi) { unsigned r; asm volatile("v_cvt_pk_bf16_f32 %0, %1, %2" : "=v"(r) : "v"(lo), "v"(hi)); return r; }
typedef unsigned u32x4 __attribute__((ext_vector_type(4)));
struct EpiBf16 {
    static constexpr bool PERM = true, AFTER_DRAIN = false;
    bf16_t* O; int ldc;
    __device__ __forceinline__ void operator()(const f32x4 (&acc)[2][2][4][2], const Unit& u, int wr, int wc, int fr, int fq) const {
        const int row0 = u.pm * BM + wr * 64 + fr; const int col0 = u.pn * BM + wc * 32 + 8 * fq;
#pragma unroll
        for (int ai = 0; ai < 2; ++ai)
#pragma unroll
            for (int m = 0; m < 4; ++m) { bf16_t* rowp = O + (size_t)(row0 + ai * HALF + m * 16) * ldc + col0;
#pragma unroll
                for (int bj = 0; bj < 2; ++bj) { const f32x4 v0 = acc[ai][bj][m][0], v1 = acc[ai][bj][m][1];
                    u32x4 w; w.x = cvt_pk_bf16(v0[0], v0[1]); w.y = cvt_pk_bf16(v0[2], v0[3]); w.z = cvt_pk_bf16(v1[0], v1[1]); w.w = cvt_pk_bf16(v1[2], v1[3]);
                    *(u32x4*)(rowp + bj * HALF) = w; } }
    }
};
struct EpiResid {
    static constexpr bool PERM = false, AFTER_DRAIN = false;
    const float* base; float* out; const float* gate; float dbg;
    __device__ __forceinline__ void operator()(const f32x4 (&acc)[2][2][4][2], const Unit& u, int wr, int wc, int fr, int fq) const {
        const int col0 = u.pn * BM + wc * 32 + 4 * fq; const int b = (u.pm * BM) >> 13;
#pragma unroll
        for (int bj = 0; bj < 2; ++bj)
#pragma unroll
            for (int n = 0; n < 2; ++n) { const f32x4 gv = *(const f32x4*)(gate + (size_t)b * 6144 + col0 + bj * HALF + n * 16);
#pragma unroll
                for (int ai = 0; ai < 2; ++ai)
#pragma unroll
                    for (int m = 0; m < 4; ++m) { const size_t off = (size_t)(u.pm * BM + ai * HALF + wr * 64 + m * 16 + fr) * 1024 + col0 + bj * HALF + n * 16;
                        const f32x4 bs = *(const f32x4*)(base + off); *(f32x4*)(out + off) = bs + gv * acc[ai][bj][m][n] * dbg; } }
    }
};

template <class Epi, class Sched, bool ALIGN_EPI = false, bool SP2 = false>
__device__ __forceinline__ void gemm_phase(PG8_LAS unsigned char* lds, const Gemm g, const Sched& S, const Epi& E) {
    const int tid = threadIdx.x, wid = __builtin_amdgcn_readfirstlane(tid >> 6), lane = tid & 63, wr = wid >> 2, wc = wid & 3, fr = lane & 15, fq = lane >> 4;
    const int K = g.K, nt = K / BK;
    unsigned voffA[2], voffB[2];
#pragma unroll
    for (int i = 0; i < 2; ++i) { int R, C; stage_rc(tid * 16 + i * 8192, R, C); const int Rb = Epi::PERM ? ((R & ~31) + perm32(R & 31)) : R;
        voffA[i] = (unsigned)(R * K + C) * 2u; voffB[i] = (unsigned)(Rb * K + C) * 2u; }
    const size_t kstep = (size_t)(BK * 2);
    const size_t hstep = (size_t)HALF * K * 2;
    const size_t tstep = 2 * hstep;
    const unsigned ldsw = (unsigned)wid * 1024u;
    const int aoff = lds_byte(wr * 64 + fr, fq * 8), boff = lds_byte(wc * 32 + fr, fq * 8);
#define PG8_SA(b, h) (((b) * 2 + (h)) * HTB)
#define PG8_SB(b, h) ((4 + (b) * 2 + (h)) * HTB)
#define PG8_STAGE(bufoff, gbase, voff) do { _Pragma("unroll") for (int _i = 0; _i < 2; ++_i) \
        __builtin_amdgcn_global_load_lds((const unsigned*)((const char*)(gbase) + (voff)[_i]), (PG8_LAS unsigned*)(lds + (bufoff) + ldsw + _i * 8192), 16, 0, 0); } while (0)
#define PG8_LDA(dst, b, h) do { _Pragma("unroll") for (int m = 0; m < 4; ++m) _Pragma("unroll") for (int k = 0; k < 2; ++k) dst[m][k] = *(const PG8_LAS bf16x8*)(lds + PG8_SA(b, h) + aoff + m * 2048 + k * 1024); } while (0)
#define PG8_LDB(dst, b, h) do { _Pragma("unroll") for (int n = 0; n < 2; ++n) _Pragma("unroll") for (int k = 0; k < 2; ++k) dst[n][k] = *(const PG8_LAS bf16x8*)(lds + PG8_SB(b, h) + boff + n * 2048 + k * 1024); } while (0)
#define PG8_MMA(ai, bj, At, Bt) do { __builtin_amdgcn_s_setprio(1); _Pragma("unroll") for (int m = 0; m < 4; ++m) _Pragma("unroll") for (int n = 0; n < 2; ++n) _Pragma("unroll") for (int k = 0; k < 2; ++k) \
        acc[ai][bj][m][n] = __builtin_amdgcn_mfma_f32_16x16x32_bf16(Bt[n][k], At[m][k], acc[ai][bj][m][n], 0, 0, 0); __builtin_amdgcn_s_setprio(0); } while (0)
#define PG8_WAIT_V(n) asm volatile("s_waitcnt vmcnt(" #n ")" ::: "memory")
#define PG8_WAIT_L(n) asm volatile("s_waitcnt lgkmcnt(" #n ")" ::: "memory")
#define PG8_BAR __builtin_amdgcn_s_barrier()
#define PG8_SCHED __builtin_amdgcn_sched_barrier(0)
    Unit cur, nxt; int ui = 0;
    if (!S.next(0, cur)) return;
    f32x4 acc[2][2][4][2];
#pragma unroll
    for (int a = 0; a < 2; ++a)
#pragma unroll
        for (int b = 0; b < 2; ++b)
#pragma unroll
            for (int m = 0; m < 4; ++m)
#pragma unroll
                for (int n = 0; n < 2; ++n) acc[a][b][m][n] = (f32x4){0.f, 0.f, 0.f, 0.f};
    bf16x8 At[4][2], B0[2][2], B1[2][2];
    const char* cA = (const char*)g.A + (size_t)cur.pm * tstep; const char* cB = (const char*)g.Bt + (size_t)cur.pn * tstep;
    S.a_ready(cur);
    if constexpr (SP2) {
        PG8_STAGE(PG8_SB(0, 0), cB, voffB); PG8_STAGE(PG8_SB(0, 1), cB + hstep, voffB); PG8_STAGE(PG8_SA(0, 0), cA, voffA); PG8_STAGE(PG8_SA(0, 1), cA + hstep, voffA);
        if (wr == 1) PG8_BAR;
        PG8_WAIT_V(2); PG8_BAR;
        PG8_STAGE(PG8_SB(1, 0), cB + kstep, voffB); PG8_STAGE(PG8_SA(1, 0), cA + kstep, voffA); PG8_STAGE(PG8_SB(1, 1), cB + hstep + kstep, voffB);
        PG8_WAIT_V(6); PG8_BAR;
    } else {
        PG8_STAGE(PG8_SB(0, 0), cB, voffB); PG8_STAGE(PG8_SA(0, 0), cA, voffA); PG8_STAGE(PG8_SB(0, 1), cB + hstep, voffB); PG8_STAGE(PG8_SA(0, 1), cA + hstep, voffA);
        if (wr == 1) PG8_BAR;
        PG8_WAIT_V(4); PG8_BAR;
        PG8_STAGE(PG8_SB(1, 0), cB + kstep, voffB); PG8_STAGE(PG8_SA(1, 0), cA + kstep, voffA); PG8_STAGE(PG8_SB(1, 1), cB + hstep + kstep, voffB);
        PG8_WAIT_V(6); PG8_BAR;
    }
    for (;;) {
        const bool has_next = S.next(ui + 1, nxt);
        const char* nA = has_next ? (const char*)g.A + (size_t)nxt.pm * tstep : cA; const char* nB = has_next ? (const char*)g.Bt + (size_t)nxt.pn * tstep : cB;
        for (int t = 0; t < nt; t += 2) {
            const bool last = (t == nt - 2);
            const char* a1 = cA + (size_t)(t + 1) * kstep;
            const char* a2 = last ? nA : cA + (size_t)(t + 2) * kstep; const char* b2 = last ? nB : cB + (size_t)(t + 2) * kstep;
            const char* a3 = a2 + kstep; const char* b3 = b2 + kstep;
            if (last && has_next) S.a_ready(nxt);
            if constexpr (SP2) {
            PG8_LDB(B0, 0, 0); PG8_LDB(B1, 0, 1); PG8_SCHED; PG8_LDA(At, 0, 0); PG8_STAGE(PG8_SA(1, 1), a1 + hstep, voffA);
            PG8_WAIT_V(8); PG8_WAIT_L(0); PG8_BAR; PG8_MMA(0, 0, At, B0); PG8_MMA(0, 1, At, B1); PG8_BAR; PG8_SCHED;
            PG8_LDA(At, 0, 1); PG8_STAGE(PG8_SB(0, 0), b2, voffB); PG8_STAGE(PG8_SB(0, 1), b2 + hstep, voffB); PG8_STAGE(PG8_SA(0, 0), a2, voffA);
            PG8_WAIT_V(8); PG8_WAIT_L(0); PG8_BAR; PG8_MMA(1, 0, At, B0); PG8_MMA(1, 1, At, B1); PG8_BAR; PG8_SCHED;
            PG8_LDB(B0, 1, 0); PG8_LDB(B1, 1, 1); PG8_SCHED; PG8_LDA(At, 1, 0); PG8_STAGE(PG8_SA(0, 1), a2 + hstep, voffA);
            PG8_WAIT_V(8); PG8_WAIT_L(0); PG8_BAR; PG8_MMA(0, 0, At, B0); PG8_MMA(0, 1, At, B1); PG8_BAR; PG8_SCHED;
            PG8_LDA(At, 1, 1); PG8_STAGE(PG8_SB(1, 0), b3, voffB); PG8_STAGE(PG8_SB(1, 1), b3 + hstep, voffB); PG8_STAGE(PG8_SA(1, 0), a3, voffA);
            PG8_WAIT_V(8); PG8_WAIT_L(0); PG8_BAR; PG8_MMA(1, 0, At, B0); PG8_MMA(1, 1, At, B1); PG8_BAR; PG8_SCHED;
            } else {
            PG8_LDB(B0, 0, 0); PG8_SCHED; PG8_LDA(At, 0, 0); PG8_STAGE(PG8_SA(1, 1), a1 + hstep, voffA);
            PG8_WAIT_L(8); PG8_BAR; PG8_WAIT_L(0); PG8_MMA(0, 0, At, B0); PG8_BAR; PG8_SCHED;
            PG8_LDB(B1, 0, 1); PG8_STAGE(PG8_SB(0, 0), b2, voffB);
            PG8_BAR; PG8_WAIT_L(0); PG8_MMA(0, 1, At, B1); PG8_BAR;
            PG8_LDA(At, 0, 1); PG8_STAGE(PG8_SA(0, 0), a2, voffA);
            PG8_BAR; PG8_WAIT_L(0); PG8_MMA(1, 0, At, B0); PG8_BAR; PG8_SCHED;
            PG8_STAGE(PG8_SB(0, 1), b2 + hstep, voffB);
            PG8_WAIT_V(6); PG8_BAR; PG8_MMA(1, 1, At, B1); PG8_BAR;
            PG8_LDB(B0, 1, 0); PG8_SCHED; PG8_LDA(At, 1, 0); PG8_STAGE(PG8_SA(0, 1), a2 + hstep, voffA);
            PG8_WAIT_L(8); PG8_BAR; PG8_WAIT_L(0); PG8_MMA(0, 0, At, B0); PG8_BAR; PG8_SCHED;
            PG8_LDB(B1, 1, 1); PG8_STAGE(PG8_SB(1, 0), b3, voffB);
            PG8_BAR; PG8_WAIT_L(0); PG8_MMA(0, 1, At, B1); PG8_BAR;
            PG8_LDA(At, 1, 1); PG8_STAGE(PG8_SA(1, 0), a3, voffA);
            PG8_BAR; PG8_WAIT_L(0); PG8_MMA(1, 0, At, B0); PG8_BAR; PG8_SCHED;
            PG8_STAGE(PG8_SB(1, 1), b3 + hstep, voffB);
            PG8_WAIT_V(6); PG8_BAR; PG8_MMA(1, 1, At, B1); PG8_BAR;
            }
        }
        if constexpr (ALIGN_EPI) { if (wr == 0) PG8_BAR; }
        if constexpr (!Epi::AFTER_DRAIN) { E(acc, cur, wr, wc, fr, fq); S.done(cur); }
        if (!has_next) break;
#pragma unroll
        for (int a = 0; a < 2; ++a)
#pragma unroll
            for (int b = 0; b < 2; ++b)
#pragma unroll
                for (int m = 0; m < 4; ++m)
#pragma unroll
                    for (int n = 0; n < 2; ++n) acc[a][b][m][n] = (f32x4){0.f, 0.f, 0.f, 0.f};
        cur = nxt; cA = nA; cB = nB; ++ui;
        if constexpr (ALIGN_EPI) { if (wr == 1) PG8_BAR; }
    }
    PG8_WAIT_V(0);
    if constexpr (!ALIGN_EPI) { if (wr == 0) PG8_BAR; }
    PG8_BAR;
    if constexpr (Epi::AFTER_DRAIN) { E.fused(acc, cur, wr, wc, fr, fq, lds, wid, lane); S.done(cur); }
#undef PG8_SA
#undef PG8_SB
#undef PG8_STAGE
#undef PG8_LDA
#undef PG8_LDB
#undef PG8_MMA
#undef PG8_WAIT_V
#undef PG8_WAIT_L
#undef PG8_BAR
#undef PG8_SCHED
}
}
constexpr int NB = 4, SEQ = 8192, D = 1024, M = NB * SEQ;
constexpr int NZ0 = 3584, NZ1 = 3072, NQ = 2048, SRC_IN0 = 3592;
constexpr float EPS = 1e-6f;
constexpr int NWAVES = 8, NTHR = 512;
constexpr float LOG2E = 1.4426950408889634f;
constexpr size_t MiB = 1u << 20;
constexpr size_t WS_CTL = 0, CTL_ZERO_BYTES = 1 * MiB;
constexpr size_t WS_WIN0 = 1 * MiB, WS_WOUT0 = 8 * MiB, WS_WIN1 = 10 * MiB, WS_WOUT1 = 16 * MiB, WS_WQ = 18 * MiB;
constexpr size_t WS_KEYS = 26 * MiB, WS_MOD = WS_KEYS + 128 * 1024, WS_KMEAN = WS_MOD + 192 * 1024, WS_NLOC = WS_KMEAN + 256 * 1024,
                 WS_BEND = WS_NLOC + 512 * 1024, WS_MLOC = WS_BEND + 4096, WS_MPREV = WS_MLOC + 4096,
                 WS_ISU = 27 * MiB + 512 * 1024, WS_ISV = WS_ISU + 128 * 1024, WS_ORD = WS_ISV + 128 * 1024  ;
constexpr size_t WS_GATES = 28 * MiB;
constexpr size_t WS_UB = 32 * MiB  , WS_VB = 64 * MiB, WS_ACT = 96 * MiB  , WS_ACTS = 100 * MiB  , WS_DBGBUF = 112 * MiB, WS_XNY = 160 * MiB, WS_Z = 224 * MiB, WS_CLOC = 448 * MiB, WS_END = 512 * MiB;
constexpr size_t WS_QRY = WS_Z, WS_IDX = WS_Z + 128 * MiB, WS_GATE = WS_Z + 144 * MiB, WS_PART = 384 * MiB  ;
constexpr int CW_BAR = 4096, CW_QMOBA = 8192, CW_QDIFF = 8256, CW_QCVT0 = 8320, CW_QCVT1 = 8384;
constexpr float ALIBI_MARGIN = 27.03f;
constexpr int RING_BYTES = 139264;
constexpr int LDSCTL_OFF = RING_BYTES, MISC_OFF = LDSCTL_OFF + 320;
constexpr int LDS_BYTES = 147456;
static_assert(MISC_OFF + 128 <= LDS_BYTES, "LDS map");

#define GAS __attribute__((address_space(1)))
#define LAS __attribute__((address_space(3)))
typedef unsigned short bf16;
typedef unsigned v4u __attribute__((ext_vector_type(4)));
typedef unsigned v2u __attribute__((ext_vector_type(2)));
typedef float f32x4 __attribute__((ext_vector_type(4)));
typedef float f32x16 __attribute__((ext_vector_type(16)));
typedef short bf16x8 __attribute__((ext_vector_type(8)));
typedef short s16x4 __attribute__((ext_vector_type(4)));
typedef GAS unsigned gu32;
#define RLX_AGENT __ATOMIC_RELAXED, __HIP_MEMORY_SCOPE_AGENT
#define LDS_WAIT() asm volatile("s_waitcnt lgkmcnt(0)" ::: "memory")
#define VM_WAIT() asm volatile("s_waitcnt vmcnt(0)" ::: "memory")
__device__ __forceinline__ unsigned f2bf(float f) { unsigned u = __builtin_bit_cast(unsigned, f); return (u + 0x7fffu + ((u >> 16) & 1u)) >> 16; }
__device__ __forceinline__ unsigned pk2(float lo, float hi) { return f2bf(lo) | (f2bf(hi) << 16); }
__device__ __forceinline__ float bflo(unsigned w) { return __builtin_bit_cast(float, w << 16); }
__device__ __forceinline__ float bfhi(unsigned w) { return __builtin_bit_cast(float, w & 0xffff0000u); }
__device__ __forceinline__ float bf2f(bf16 h) { return __builtin_bit_cast(float, (unsigned)h << 16); }
__device__ __forceinline__ unsigned f2u(float x) { return __builtin_bit_cast(unsigned, x); }
__device__ __forceinline__ float u2f(unsigned x) { return __builtin_bit_cast(float, x); }
__device__ __forceinline__ float dot2bf(unsigned a, unsigned b, float acc) { typedef __bf16 bf2_ __attribute__((ext_vector_type(2))); return __builtin_amdgcn_fdot2_f32_bf16(__builtin_bit_cast(bf2_, a), __builtin_bit_cast(bf2_, b), acc, false); }
__device__ __forceinline__ float wave_sum(float v) {
#pragma unroll
    for (int o = 1; o < 64; o <<= 1) v += __shfl_xor(v, o);
    return v;
}
__device__ __forceinline__ float wave_max(float v) {
#pragma unroll
    for (int o = 1; o < 64; o <<= 1) v = fmaxf(v, __shfl_xor(v, o));
    return v;
}
__device__ __forceinline__ float silu_f(float x) { return x / (1.f + __expf(-x)); }
__device__ __forceinline__ float sigmoid_f(float x) { return 1.f / (1.f + __expf(-x)); }
__device__ __forceinline__ float logsigmoid_f(float x) { return fminf(x, 0.f) - log1pf(__expf(-fabsf(x))); }
struct Args { const float* in[24]; float* out; unsigned char* ws; int ph_lo, ph_hi; };
#define XB_TMO      128
#define XB_XCNT(j)  (256  + 64 * (j))
#define XB_XSUB(j)  (1280 + 64 * (j))
#define XB_XGEN(j)  (2304 + 64 * (j))
#define XB_TOP      3328
#define XB_TOPGEN   3392
#define XCD_BAR_WORDS 3456
#define XB_SPIN_CAP (1u << 18)

__device__ __forceinline__ unsigned xb_ld(unsigned* p)              { return __hip_atomic_load(p, __ATOMIC_RELAXED, __HIP_MEMORY_SCOPE_AGENT); }
__device__ __forceinline__ unsigned xb_add(unsigned* p, unsigned v) { return __hip_atomic_fetch_add(p, v, __ATOMIC_RELAXED, __HIP_MEMORY_SCOPE_AGENT); }
__device__ __forceinline__ unsigned xb_xcc_id() { return (unsigned)__builtin_amdgcn_s_getreg((3 << 11) | 20) & 0xFu; }
#define XB_SPIN(cond, bar) do { unsigned _sp = 0; while (cond) { __builtin_amdgcn_s_sleep(1); \
    if ((++_sp & 255u) == 0u) { if (xb_ld(&(bar)[XB_TMO])) break; if (_sp > XB_SPIN_CAP) { atomicAdd(&(bar)[XB_TMO], 1u); break; } } } } while (0)

struct XcdBarrier {
    unsigned* bar; unsigned x;
    volatile LAS unsigned* st;
};

__device__ __forceinline__ XcdBarrier xcd_barrier_post(unsigned* bar, volatile LAS unsigned* st) {
    XcdBarrier b; b.bar = bar; b.x = xb_xcc_id(); b.st = st;
    if (threadIdx.x == 0) (void)xb_add(&bar[XB_XCNT(b.x)], 1u);
    return b;
}
__device__ __forceinline__ void xcd_barrier_complete(unsigned* bar, unsigned x, unsigned& nloc, unsigned& nx) {
    const unsigned G = gridDim.x * gridDim.y * gridDim.z;
    unsigned sum, cnt, mine, sp = 0u;
    for (;;) {
        sum = 0u; cnt = 0u; mine = 0u;
#pragma unroll
        for (unsigned j = 0; j < 16; ++j) { const unsigned c = xb_ld(&bar[XB_XCNT(j)]); sum += c; cnt += (c > 0u) ? 1u : 0u; mine = (j == x) ? c : mine; }
        if (sum == G) break;
        __builtin_amdgcn_s_sleep(1);
        if ((++sp & 255u) == 0u) { if (xb_ld(&bar[XB_TMO])) break; if (sp > XB_SPIN_CAP) { atomicAdd(&bar[XB_TMO], 1u); break; } }
    }
    nloc = mine > 0u ? mine : 1u; nx = cnt > 0u ? cnt : 1u;
}

__device__ __forceinline__ void xcd_barrier(const XcdBarrier& b) {
    asm volatile("s_waitcnt vmcnt(0)" ::: "memory");
    __syncthreads();
    if (threadIdx.x == 0) {
        unsigned* bar = b.bar;
        __builtin_amdgcn_s_waitcnt(0);
        unsigned nloc = b.st[0], nx = b.st[1];
        if (nloc == 0u) { xcd_barrier_complete(bar, b.x, nloc, nx); b.st[0] = nloc; b.st[1] = nx; }
        const unsigned old = xb_add(&bar[XB_XSUB(b.x)], 1u);
        const unsigned gen = old / nloc;
        if (old + 1u == (gen + 1u) * nloc) {
            __builtin_amdgcn_fence(__ATOMIC_RELEASE, "agent");
            asm volatile("s_waitcnt vmcnt(0)" ::: "memory");
            const unsigned og = xb_add(&bar[XB_TOP], 1u);
            const unsigned tg = og / nx;
            if (og + 1u == (tg + 1u) * nx) xb_add(&bar[XB_TOPGEN], 1u);
            else XB_SPIN(xb_ld(&bar[XB_TOPGEN]) == tg, bar);
            __builtin_amdgcn_fence(__ATOMIC_ACQUIRE, "agent");
            xb_add(&bar[XB_XGEN(b.x)], 1u);
            asm volatile("s_waitcnt vmcnt(0)" ::: "memory");
        } else {
            XB_SPIN(xb_ld(&bar[XB_XGEN(b.x)]) == gen, bar);
            __builtin_amdgcn_fence(__ATOMIC_ACQUIRE, "agent");
            asm volatile("s_waitcnt vmcnt(0)" ::: "memory");
        }
    }
    __syncthreads();
}
struct Frame {
    LAS unsigned char* lds;
    int tid, lane, wave, G, bid;
    float* out; unsigned char* ws;
};
#define WSP(T, off) ((T*)(F.ws + (off)))

__device__ __forceinline__ void p0_transpose_item(const float* W, int K, int ldw, int nblk, int thr, int shift, bf16* WT, LAS float* scr, int item, int lane) {
    const int kb = item / nblk, nb = item % nblk, k0 = 64 * kb, n0 = 32 * nb, ns = n0 + (n0 >= thr ? shift : 0);
#pragma unroll 8
    for (int i = 0; i < 32; ++i) { const int kk = 2 * i + (lane >> 5); scr[kk * 33 + (lane & 31)] = W[(size_t)(k0 + kk) * ldw + ns + (lane & 31)]; }
    LDS_WAIT(); asm volatile("" ::: "memory");
    const int c = lane & 7;
#pragma unroll
    for (int j = 0; j < 4; ++j) { const int n = (lane >> 3) + 8 * j; const LAS float* s = scr + (8 * c) * 33 + n;
        v4u o; o.x = pk2(s[0 * 33], s[1 * 33]); o.y = pk2(s[2 * 33], s[3 * 33]); o.z = pk2(s[4 * 33], s[5 * 33]); o.w = pk2(s[6 * 33], s[7 * 33]);
        *(GAS v4u*)(WT + (size_t)(n0 + n) * K + k0 + 8 * c) = o; }
    LDS_WAIT(); asm volatile("" ::: "memory");
}
__device__ __forceinline__ void cvt_f32_bf16_stream(const float* src, bf16* dst, size_t n8, size_t gtid, size_t gthreads) {
    for (size_t i = gtid; i < n8; i += gthreads) {
        const f32x4 a = *(const GAS f32x4*)(src + i * 8), b = *(const GAS f32x4*)(src + i * 8 + 4);
        v4u o; o.x = pk2(a.x, a.y); o.y = pk2(a.z, a.w); o.z = pk2(b.x, b.y); o.w = pk2(b.z, b.w);
        *(GAS v4u*)(dst + i * 8) = o; }
}
__device__ __forceinline__ void i8_row(const float* src_row, unsigned char* dst  , float* scale  , int er, int lane) {
    const float* r = src_row + 16 * lane;
    float x[16];
#pragma unroll
    for (int q4 = 0; q4 < 4; ++q4) { const f32x4 a = *(const GAS f32x4*)(r + 4 * q4); x[4 * q4] = a.x; x[4 * q4 + 1] = a.y; x[4 * q4 + 2] = a.z; x[4 * q4 + 3] = a.w; }
    float am = 0.f;
#pragma unroll
    for (int i = 0; i < 16; ++i) am = fmaxf(am, fabsf(x[i]));
    am = wave_max(am);
    const float inv = am > 1e-30f ? 127.f / am : 0.f;
    unsigned wd[4];
#pragma unroll
    for (int q4 = 0; q4 < 4; ++q4) { unsigned w = 0;
#pragma unroll
        for (int e = 0; e < 4; ++e) { const int qv = (int)rintf(x[4 * q4 + e] * inv); w |= ((unsigned)qv & 0xffu) << (8 * e); }
        wd[q4] = w; }
    v4u o; o.x = wd[0]; o.y = wd[1]; o.z = wd[2]; o.w = wd[3];
    *(GAS v4u*)(dst + ((size_t)((lane >> 3) * 16384 + er)) * 128 + 16 * (lane & 7)) = o;
    if (lane == 0) scale[er] = am * (1.f / 127.f);
}
__device__ __forceinline__ void i8_chunk(Frame& F, const Args& A, int layer, int c) {
    const int tbl = c >> 8, row0 = (c & 255) * 64 + F.wave * 8;
    const float* src = A.in[22 + tbl] + (size_t)layer * 16384 * 1024;
    unsigned char* dst = F.ws + (tbl ? WS_VB : WS_UB) + (size_t)layer * 8 * 16384 * 128;
    float* sc = WSP(float, tbl ? WS_ISV : WS_ISU) + layer * 16384;
    for (int i = 0; i < 8; ++i) i8_row(src + (size_t)(row0 + i) * 1024, dst, sc, row0 + i, F.lane);
}
__device__ __forceinline__ void p0_prologue(Frame& F, const Args& A) {
    {
        const float* c = A.in[1]; const float* aw = A.in[2]; const float* ab = A.in[3]; float* MOD = WSP(float, WS_MOD);
        LAS float* red = (LAS float*)F.lds;
        for (int item = F.bid; item < 192; item += F.G) {
            const int l = item / 96, n0 = (item % 96) * 64;
            float acc[4] = {0.f, 0.f, 0.f, 0.f};
            const int kbeg = F.wave * 128;
#pragma unroll 4
            for (int k = kbeg; k < kbeg + 128; ++k) {
                const float wv = aw[((size_t)l * 1024 + k) * 6144 + n0 + F.lane];
#pragma unroll
                for (int b = 0; b < 4; ++b) acc[b] += silu_f(c[b * 1024 + k]) * wv;
            }
#pragma unroll
            for (int b = 0; b < 4; ++b) red[(F.wave * 4 + b) * 64 + F.lane] = acc[b];
            __syncthreads();
            if (F.tid < 256) { const int b = F.tid >> 6, ln = F.tid & 63; float s = ab[l * 6144 + n0 + ln];
#pragma unroll
                for (int w = 0; w < 8; ++w) s += red[(w * 4 + b) * 64 + ln];
                MOD[(size_t)(l * 4 + b) * 6144 + n0 + ln] = s; }
            __syncthreads();
        }
    }
    if (F.bid == 0) {
        LAS unsigned* hist = (LAS unsigned*)F.lds;
        unsigned short* ORD = WSP(unsigned short, WS_ORD);
        for (int pass = 0; pass < 2; ++pass) {
            const int nunits = pass == 0 ? 2048 : 1024;
            if (F.tid < 160) hist[F.tid] = 0u;
            __syncthreads();
            for (int u = F.tid; u < nunits; u += NTHR) {
                const int q = pass == 0 ? (u & 63) : (u & 31), h = pass == 0 ? ((u >> 6) & 7) : ((u >> 5) & 7);
                const float dcut = 46.f * (float)(2 << h);
                int cost;
                if (pass == 0) { const int nt = 2 * q + 2; int lo = (int)ceilf(((float)(q * 128) - dcut - 63.f) * (1.f / 64.f)); if (lo < 0) lo = 0; cost = nt - lo; }
                else { int lo = (int)ceilf(((float)(q * 256) - dcut - 255.f) * (1.f / 256.f)); if (lo < 0) lo = 0; int nb = q - lo; if (nb > 3 * 8) nb = 24; cost = 4 * (nb + 1); }
                if (cost > 159) cost = 159;
                atomicAdd((unsigned*)(hist + (159 - cost)), 1u);
            }
            __syncthreads();
            if (F.tid == 0) { unsigned acc = 0; for (int i = 0; i < 160; ++i) { const unsigned c = hist[i]; hist[i] = acc; acc += c; } }
            __syncthreads();
            for (int u = F.tid; u < nunits; u += NTHR) {
                const int q = pass == 0 ? (u & 63) : (u & 31), h = pass == 0 ? ((u >> 6) & 7) : ((u >> 5) & 7);
                const float dcut = 46.f * (float)(2 << h);
                int cost;
                if (pass == 0) { const int nt = 2 * q + 2; int lo = (int)ceilf(((float)(q * 128) - dcut - 63.f) * (1.f / 64.f)); if (lo < 0) lo = 0; cost = nt - lo; }
                else { int lo = (int)ceilf(((float)(q * 256) - dcut - 255.f) * (1.f / 256.f)); if (lo < 0) lo = 0; int nb = q - lo; if (nb > 3 * 8) nb = 24; cost = 4 * (nb + 1); }
                if (cost > 159) cost = 159;
                const unsigned pos = atomicAdd((unsigned*)(hist + (159 - cost)), 1u);
                ORD[(pass == 0 ? 0 : 2048) + pos] = (unsigned short)u;
            }
            __syncthreads();
        }
    }
    {
        LAS float* scr = (LAS float*)(F.lds + F.wave * 8704);
        const int gw = F.bid * NWAVES + F.wave, NGW = F.G * NWAVES;
        constexpr int I_IN0 = 16 * (NZ0 / 32), I_OUT = 16 * 32, I_IN1 = 16 * (NZ1 / 32), I_Q = 16 * (NQ / 32);
        constexpr int NITEMS = I_IN0 + 2 * I_OUT + I_IN1 + 2 * I_Q;
        for (int it = gw; it < NITEMS; it += NGW) {
            int r = it;
            if (r < I_IN0) { p0_transpose_item(A.in[6], D, SRC_IN0, NZ0 / 32, 2048, 8, WSP(bf16, WS_WIN0), scr, r, F.lane); continue; } r -= I_IN0;
            if (r < I_OUT) { p0_transpose_item(A.in[13], D, D, 32, 1 << 30, 0, WSP(bf16, WS_WOUT0), scr, r, F.lane); continue; } r -= I_OUT;
            if (r < I_IN1) { p0_transpose_item(A.in[14], D, NZ1, NZ1 / 32, 1 << 30, 0, WSP(bf16, WS_WIN1), scr, r, F.lane); continue; } r -= I_IN1;
            if (r < I_OUT) { p0_transpose_item(A.in[19], D, D, 32, 1 << 30, 0, WSP(bf16, WS_WOUT1), scr, r, F.lane); continue; } r -= I_OUT;
            if (r < I_Q) { p0_transpose_item(A.in[20], D, NQ, NQ / 32, 1 << 30, 0, WSP(bf16, WS_WQ), scr, r, F.lane); continue; } r -= I_Q;
            p0_transpose_item(A.in[20] + (size_t)D * NQ, D, NQ, NQ / 32, 1 << 30, 0, WSP(bf16, WS_WQ) + (size_t)NQ * D, scr, r, F.lane);
        }
    }
    {
        const size_t gtid = (size_t)F.bid * NTHR + F.tid, gth = (size_t)F.G * NTHR;
        cvt_f32_bf16_stream(A.in[21], WSP(bf16, WS_KEYS), (size_t)2 * 2 * 128 * 128 / 8, gtid, gth);
    }
}

template <bool GATES>
__device__ __forceinline__ void norm_pass(Frame& F, const Args& A, const float* X, const float* g, const float* mod, int shc, bf16* XN) {
    LAS float* wgT = (LAS float*)F.lds;
    if (GATES) {
        const float* win = A.in[6];
        for (int i = F.tid; i < 8 * 1024; i += NTHR) { const int cg = i >> 10, k = i & 1023; wgT[i] = win[(size_t)k * SRC_IN0 + 2048 + cg]; }
        __syncthreads();
    }
    const int gw = F.bid * NWAVES + F.wave, NGW = F.G * NWAVES;
    for (int row = gw; row < M; row += NGW) {
        const int b = row >> 13;
        const GAS f32x4* xr = (const GAS f32x4*)(X + (size_t)row * D) + F.lane;
        f32x4 v[4]; float ss = 0.f;
#pragma unroll
        for (int j = 0; j < 4; ++j) { v[j] = xr[64 * j]; ss += (v[j].x * v[j].x + v[j].y * v[j].y) + (v[j].z * v[j].z + v[j].w * v[j].w); }
        const float rstd = rsqrtf(wave_sum(ss) * (1.f / D) + EPS);
        const float* shp = mod + (size_t)b * 6144 + shc * 1024; const float* scp = shp + 1024;
#pragma unroll
        for (int j = 0; j < 4; ++j) { const int c = 4 * F.lane + 256 * j;
            const f32x4 gg = *(const f32x4*)(g + c), sc = *(const f32x4*)(scp + c), sh = *(const f32x4*)(shp + c);
            v[j] = v[j] * rstd * gg * (sc + 1.f) + sh;
            v2u o; o.x = pk2(v[j].x, v[j].y); o.y = pk2(v[j].z, v[j].w);
            *(GAS v2u*)(XN + (size_t)row * D + c) = o; }
        if (GATES) {
            float* GT = WSP(float, WS_GATES);
#pragma unroll
            for (int cg = 0; cg < 8; ++cg) { float p = 0.f;
#pragma unroll
                for (int j = 0; j < 4; ++j) { const f32x4 w = *(const LAS f32x4*)(wgT + cg * 1024 + 4 * F.lane + 256 * j); p += (v[j].x * w.x + v[j].y * w.y) + (v[j].z * w.z + v[j].w * w.w); }
                p = wave_sum(p);
                if (F.lane == 0) GT[(size_t)row * 8 + cg] = p + (cg < 4 ? A.in[8][cg] : A.in[9][cg - 4]); }
        }
    }
}

__device__ __forceinline__ void qknorm_unit(Frame& F, bf16* Z, int ldz, int row0, int col0, const float* g, float gmul, float* kmean  ) {
    const int c = col0 + 8 * F.lane, d0 = (8 * F.lane) & 63;
    float gv[8];
#pragma unroll
    for (int i = 0; i < 8; ++i) gv[i] = g[d0 + i] * gmul;
    float ks[8] = {0.f, 0.f, 0.f, 0.f, 0.f, 0.f, 0.f, 0.f};
    for (int r = 0; r < 32; ++r) {
        bf16* p = Z + (size_t)(row0 + F.wave * 32 + r) * ldz + c;
        const v4u w = *(const GAS v4u*)p;
        float x[8] = {bflo(w.x), bfhi(w.x), bflo(w.y), bfhi(w.y), bflo(w.z), bfhi(w.z), bflo(w.w), bfhi(w.w)};
        float ss = 0.f;
#pragma unroll
        for (int i = 0; i < 8; ++i) ss += x[i] * x[i];
        ss += __shfl_xor(ss, 1); ss += __shfl_xor(ss, 2); ss += __shfl_xor(ss, 4);
        const float rstd = rsqrtf(ss * (1.f / 64.f) + EPS);
#pragma unroll
        for (int i = 0; i < 8; ++i) { x[i] = x[i] * rstd * gv[i]; ks[i] += x[i]; }
        v4u o; o.x = pk2(x[0], x[1]); o.y = pk2(x[2], x[3]); o.z = pk2(x[4], x[5]); o.w = pk2(x[6], x[7]);
        *(GAS v4u*)p = o;
    }
    if (kmean) {
        LAS float* red = (LAS float*)F.lds;
#pragma unroll
        for (int i = 0; i < 8; ++i) red[F.wave * 512 + 8 * F.lane + i] = ks[i];
        __syncthreads();
        { float s = 0.f;
#pragma unroll
          for (int w = 0; w < 8; ++w) s += red[w * 512 + F.tid];
          kmean[(size_t)(F.tid >> 6) * (32 * 64) + (F.tid & 63)] = s * (1.f / 256.f); }
        __syncthreads();
    }
}
constexpr int KSTRB = 144;
template <int DV> struct VStr { static constexpr int B = (DV == 64) ? 192 : 320; };
typedef short v4i16_t __attribute__((ext_vector_type(4)));
__device__ __forceinline__ s16x4 vtr(const LAS unsigned char* p) { return __builtin_bit_cast(s16x4, __builtin_amdgcn_ds_read_tr16_b64_v4i16((LAS v4i16_t*)p)); }
__device__ __forceinline__ unsigned cvtpk(float lo, float hi) { typedef float f2 __attribute__((ext_vector_type(2))); typedef __bf16 b2 __attribute__((ext_vector_type(2)));
    f2 v = {lo, hi}; b2 b = __builtin_convertvector(v, b2); return __builtin_bit_cast(unsigned, b); }
__device__ __forceinline__ float xhalf(float v) {
    auto rr = __builtin_amdgcn_permlane32_swap(__builtin_bit_cast(unsigned, v), __builtin_bit_cast(unsigned, v), false, false);
    const unsigned r0 = rr[0], r1 = rr[1]; return u2f((threadIdx.x & 32) ? r0 : r1);
}
template <int DV> struct AttnSt { f32x16 o[DV / 32]; float m, l; };
template <int DV> __device__ __forceinline__ void attn_init(AttnSt<DV>& st) {
#pragma unroll
    for (int t = 0; t < DV / 32; ++t)
#pragma unroll
        for (int r = 0; r < 16; ++r) st.o[t][r] = 0.f;
    st.m = -1e30f; st.l = 0.f;
}
template <int DV>
__device__ __forceinline__ void attn_tile(AttnSt<DV>& st, const LAS unsigned char* Kt, const LAS unsigned char* Vt, const bf16x8 (&qf)[4], float sc2, float sl2, int tq, int kt0, bool diag, bool rowok, int lane) {
    const int r32 = lane & 31, hi = lane >> 5;
    const int kb = kt0 + 4 * hi;
    const float c0 = -sl2 * (float)(tq - kb);
    f32x16 s0, s1;
#pragma unroll
    for (int r = 0; r < 16; ++r) { const int ko = (r & 3) + 8 * (r >> 2); s0[r] = c0 + sl2 * (float)ko; s1[r] = c0 + sl2 * (float)(ko + 32); }
    const LAS unsigned char* kp = Kt + r32 * KSTRB + hi * 16;
#pragma unroll
    for (int ks = 0; ks < 4; ++ks) {
        const bf16x8 k0 = *(const LAS bf16x8*)(kp + ks * 32), k1 = *(const LAS bf16x8*)(kp + 32 * KSTRB + ks * 32);
        s0 = __builtin_amdgcn_mfma_f32_32x32x16_bf16(k0, qf[ks], s0, 0, 0, 0);
        s1 = __builtin_amdgcn_mfma_f32_32x32x16_bf16(k1, qf[ks], s1, 0, 0, 0);
    }
    if (diag || !rowok) {
#pragma unroll
        for (int r = 0; r < 16; ++r) { const int ko = (r & 3) + 8 * (r >> 2);
            if (!rowok || kb + ko > tq) s0[r] = -INFINITY;
            if (!rowok || kb + ko + 32 > tq) s1[r] = -INFINITY; }
    }
    float mx = fmaxf(s0[0], s1[0]);
#pragma unroll
    for (int r = 1; r < 16; ++r) mx = fmaxf(mx, fmaxf(s0[r], s1[r]));
    mx = fmaxf(mx, xhalf(mx));
    if (__any(mx > st.m)) {
        const float mn = fmaxf(st.m, mx);
        const float alpha = __builtin_amdgcn_exp2f(st.m - mn);
        st.m = mn; st.l *= alpha;
#pragma unroll
        for (int t = 0; t < DV / 32; ++t)
#pragma unroll
            for (int r = 0; r < 16; ++r) st.o[t][r] *= alpha;
    }
    const float mn = st.m;
    float ps = 0.f;
#pragma unroll
    for (int r = 0; r < 16; ++r) { s0[r] = __builtin_amdgcn_exp2f(s0[r] - mn); s1[r] = __builtin_amdgcn_exp2f(s1[r] - mn); ps += s0[r] + s1[r]; }
    st.l += ps;
    bf16x8 pf[2][2];
#pragma unroll
    for (int s = 0; s < 2; ++s) {
        v4u a, b;
        a.x = cvtpk(s0[8 * s + 0], s0[8 * s + 1]); a.y = cvtpk(s0[8 * s + 2], s0[8 * s + 3]); a.z = cvtpk(s0[8 * s + 4], s0[8 * s + 5]); a.w = cvtpk(s0[8 * s + 6], s0[8 * s + 7]);
        b.x = cvtpk(s1[8 * s + 0], s1[8 * s + 1]); b.y = cvtpk(s1[8 * s + 2], s1[8 * s + 3]); b.z = cvtpk(s1[8 * s + 4], s1[8 * s + 5]); b.w = cvtpk(s1[8 * s + 6], s1[8 * s + 7]);
        pf[0][s] = __builtin_bit_cast(bf16x8, a); pf[1][s] = __builtin_bit_cast(bf16x8, b);
    }
    constexpr int VS = VStr<DV>::B;
    const int g = lane >> 4, i16 = lane & 15;
    const LAS unsigned char* vp = Vt + (4 * (g >> 1) + (i16 >> 2)) * VS + (16 * (g & 1) + 4 * (i16 & 3)) * 2;
#pragma unroll
    for (int kbk = 0; kbk < 2; ++kbk)
#pragma unroll
        for (int s = 0; s < 2; ++s)
#pragma unroll
            for (int t = 0; t < DV / 32; ++t) {
                const s16x4 lo = vtr(vp + (kbk * 32 + 16 * s) * VS + t * 64), h8 = vtr(vp + (kbk * 32 + 16 * s + 8) * VS + t * 64);
                const bf16x8 va = {lo[0], lo[1], lo[2], lo[3], h8[0], h8[1], h8[2], h8[3]};
                st.o[t] = __builtin_amdgcn_mfma_f32_32x32x16_bf16(va, pf[kbk][s], st.o[t], 0, 0, 0);
            }
}
template <int NK, int DV> struct TileRegs { v4u k[NK]; v4u v[DV / 64]; };
template <int NK, int DV>
__device__ __forceinline__ void tile_load(TileRegs<NK, DV>& R, const bf16* Z, int ldz, size_t zrow0, int kcol, int vcol, int tid) {
#pragma unroll
    for (int i = 0; i < NK; ++i) { const int ch = tid + 512 * i; const int row = ch / (8 * NK), cc = ch % (8 * NK);
        R.k[i] = *(const GAS v4u*)(Z + (zrow0 + row) * ldz + kcol + cc * 8); }
#pragma unroll
    for (int i = 0; i < DV / 64; ++i) { const int ch = tid + 512 * i; const int row = ch / (DV / 8), cc = ch % (DV / 8);
        R.v[i] = *(const GAS v4u*)(Z + (zrow0 + row) * ldz + vcol + cc * 8); }
}
template <int NK, int DV>
__device__ __forceinline__ void tile_store(const TileRegs<NK, DV>& R, LAS unsigned char* Kt  , LAS unsigned char* Vt, int tid) {
#pragma unroll
    for (int i = 0; i < NK; ++i) { const int ch = tid + 512 * i; const int row = ch / (8 * NK), cc = ch % (8 * NK);
        *(LAS v4u*)(Kt + (cc >> 3) * (64 * KSTRB) + row * KSTRB + (cc & 7) * 16) = R.k[i]; }
#pragma unroll
    for (int i = 0; i < DV / 64; ++i) { const int ch = tid + 512 * i; const int row = ch / (DV / 8), cc = ch % (DV / 8);
        *(LAS v4u*)(Vt + row * VStr<DV>::B + cc * 16) = R.v[i]; }
}
__device__ __forceinline__ void moba_unit(Frame& F, int b, int h, int j, float tcut  ) {
    const bf16* Z = WSP(bf16, WS_Z); constexpr int ldz = NZ0;
    const int lane = F.lane, w = F.wave, r32 = lane & 31, hi = lane >> 5, tid = F.tid;
    const size_t rowb = (size_t)b * SEQ;
    const int qpos = j * 256 + w * 32 + r32;
    const int qcol = 2048 + h * 64, kcol = 2560 + h * 64, vcol = 3072 + h * 64;
    LAS unsigned char* lds = F.lds;
    constexpr int BUFB = 64 * KSTRB + 64 * VStr<64>::B;
    LAS unsigned char* kmh = lds + 2 * BUFB;
    LAS unsigned char* kml = lds + 2 * BUFB + 32 * KSTRB;
    LAS unsigned* msk = (LAS unsigned*)(lds + 2 * BUFB + 64 * KSTRB);
    { const float* KM = WSP(float, WS_KMEAN) + (size_t)((b * 8 + h) * 32) * 64; const f32x4 x = *(const f32x4*)(KM + 4 * tid);
      const int n = tid >> 4, d0 = (tid & 15) * 4;
      const unsigned h0 = f2bf(x.x), h1 = f2bf(x.y), h2 = f2bf(x.z), h3 = f2bf(x.w);
      v2u hv; hv.x = h0 | (h1 << 16); hv.y = h2 | (h3 << 16);
      v2u lv; lv.x = pk2(x.x - u2f(h0 << 16), x.y - u2f(h1 << 16)); lv.y = pk2(x.z - u2f(h2 << 16), x.w - u2f(h3 << 16));
      *(LAS v2u*)(kmh + n * KSTRB + d0 * 2) = hv; *(LAS v2u*)(kml + n * KSTRB + d0 * 2) = lv; }
    if (tid < 16) msk[tid] = 0u;
    bf16x8 qf[4];
    const bf16* qrow = Z + (rowb + qpos) * ldz + qcol;
#pragma unroll
    for (int ks = 0; ks < 4; ++ks) qf[ks] = *(const GAS bf16x8*)(qrow + 16 * ks + 8 * hi);
    __syncthreads();
    f32x16 gt;
#pragma unroll
    for (int r = 0; r < 16; ++r) gt[r] = 0.f;
#pragma unroll
    for (int ks = 0; ks < 4; ++ks) {
        const bf16x8 a = *(const LAS bf16x8*)(kmh + r32 * KSTRB + hi * 16 + ks * 32), c = *(const LAS bf16x8*)(kml + r32 * KSTRB + hi * 16 + ks * 32);
        gt = __builtin_amdgcn_mfma_f32_32x32x16_bf16(a, qf[ks], gt, 0, 0, 0);
        gt = __builtin_amdgcn_mfma_f32_32x32x16_bf16(c, qf[ks], gt, 0, 0, 0);
    }
    float t0 = -INFINITY, t1 = -INFINITY, t2 = -INFINITY;
#define INS3(key) do { float k_ = (key); float a_ = fmaxf(t0, k_), l_ = fminf(t0, k_); t0 = a_; a_ = fmaxf(t1, l_); l_ = fminf(t1, l_); t1 = a_; t2 = fmaxf(t2, l_); } while (0)
#pragma unroll
    for (int r = 0; r < 16; ++r) { const int n = (r & 3) + 8 * (r >> 2) + 4 * hi;
        const float key = (n < j) ? u2f((f2u(gt[r]) & ~31u) | (unsigned)n) : -INFINITY; INS3(key); }
    { const float p0 = xhalf(t0), p1 = xhalf(t1), p2 = xhalf(t2); INS3(p0); INS3(p1); INS3(p2); }
#undef INS3
    const int sel0 = (t0 > -INFINITY) ? (int)(f2u(t0) & 31u) : -1;
    const int sel1 = (t1 > -INFINITY) ? (int)(f2u(t1) & 31u) : -1;
    const int sel2 = (t2 > -INFINITY) ? (int)(f2u(t2) & 31u) : -1;
    { const unsigned mm = (sel0 >= 0 ? 1u << sel0 : 0u) | (sel1 >= 0 ? 1u << sel1 : 0u) | (sel2 >= 0 ? 1u << sel2 : 0u);
      if (mm) { __hip_atomic_fetch_or(msk + w, mm, __ATOMIC_RELAXED, __HIP_MEMORY_SCOPE_WORKGROUP); __hip_atomic_fetch_or(msk + 8, mm, __ATOMIC_RELAXED, __HIP_MEMORY_SCOPE_WORKGROUP); } }
    __syncthreads();
    const float slope = ldexpf(1.f, -(h + 1)), dcut = tcut / slope;
    const float sl2 = slope * LOG2E, sc2 = 0.125f * LOG2E;
    int nlo = (int)ceilf(((float)(j * 256) - dcut - 255.f) * (1.f / 256.f)); if (nlo < 0) nlo = 0;
    const unsigned keep = nlo >= 32 ? 0u : (0xffffffffu << nlo);
    const unsigned bmask = msk[8] & keep; const unsigned wmask = (unsigned)__builtin_amdgcn_readfirstlane((int)msk[w]) & keep;
    AttnSt<64> st; attn_init<64>(st);
    unsigned rem = bmask;
    int blk = j, kt = 3, buf = 0;
    TileRegs<1, 64> R;
    tile_load<1, 64>(R, Z, ldz, rowb + blk * 256 + kt * 64, kcol, vcol, tid);
    tile_store<1, 64>(R, lds, lds + 64 * KSTRB, tid);
    __syncthreads();
    for (;;) {
        int nblk = blk, nkt = kt - 1; bool has_next = true;
        if (nkt < 0) { nkt = 3; if (rem) { nblk = 31 - __builtin_clz(rem); rem &= ~(1u << nblk); } else has_next = false; }
        if (has_next) tile_load<1, 64>(R, Z, ldz, rowb + nblk * 256 + nkt * 64, kcol, vcol, tid);
        const bool own = (blk == j);
        const bool active = (own ? (kt * 64 <= w * 32 + 31) : (((wmask >> blk) & 1u) != 0u)) && ((float)(j * 256 + w * 32 - (blk * 256 + kt * 64 + 63)) <= dcut);
        if (active) {
            const bool rowok = own || blk == sel0 || blk == sel1 || blk == sel2;
            const bool diag = own && (kt * 64 + 63 > w * 32);
            attn_tile<64>(st, lds + buf * BUFB, lds + buf * BUFB + 64 * KSTRB, qf, sc2, sl2, qpos, blk * 256 + kt * 64, diag, rowok, lane);
        }
        if (!has_next) break;
        tile_store<1, 64>(R, lds + (buf ^ 1) * BUFB, lds + (buf ^ 1) * BUFB + 64 * KSTRB, tid);
        __syncthreads();
        buf ^= 1; blk = nblk; kt = nkt;
    }
    const float inv = 1.f / (st.l + xhalf(st.l));
    bf16* Y = WSP(bf16, WS_XNY) + (rowb + qpos) * 1024 + 512 + h * 64;
#pragma unroll
    for (int t = 0; t < 2; ++t)
#pragma unroll
        for (int rg = 0; rg < 4; ++rg) { v2u o; o.x = pk2(st.o[t][4 * rg] * inv, st.o[t][4 * rg + 1] * inv); o.y = pk2(st.o[t][4 * rg + 2] * inv, st.o[t][4 * rg + 3] * inv);
            *(GAS v2u*)(Y + t * 32 + 8 * rg + 4 * hi) = o; }
    __syncthreads();
}

__device__ __forceinline__ void diff_unit(Frame& F, const Args& A, int b, int h, int qt, float lam, float tcut) {
    const bf16* Z = WSP(bf16, WS_Z); constexpr int ldz = NZ1;
    const int lane = F.lane, w = F.wave, r32 = lane & 31, hi = lane >> 5, tid = F.tid;
    const int comp = w >> 2, wq = w & 3;
    const size_t rowb = (size_t)b * SEQ;
    const int q0 = qt * 128, qpos = q0 + wq * 32 + r32;
    const int qcol = h * 128 + comp * 64, kcol = 1024 + h * 128, vcol = 2048 + h * 128;
    LAS unsigned char* lds = F.lds;
    constexpr int BUFB = 2 * 64 * KSTRB + 64 * VStr<128>::B;
    bf16x8 qf[4];
    const bf16* qrow = Z + (rowb + qpos) * ldz + qcol;
#pragma unroll
    for (int ks = 0; ks < 4; ++ks) qf[ks] = *(const GAS bf16x8*)(qrow + 16 * ks + 8 * hi);
    const float slope = ldexpf(1.f, -(h + 1)), dcut = tcut / slope;
    const float sl2 = slope * LOG2E, sc2 = 0.125f * LOG2E;
    AttnSt<128> st; attn_init<128>(st);
    const int nt = (q0 + 128) / 64;
    int kt_lo = (int)ceilf(((float)q0 - dcut - 63.f) * (1.f / 64.f)); if (kt_lo < 0) kt_lo = 0;
    TileRegs<2, 128> R;
    tile_load<2, 128>(R, Z, ldz, rowb + (size_t)(nt - 1) * 64, kcol, vcol, tid);
    tile_store<2, 128>(R, lds, lds + 2 * 64 * KSTRB, tid);
    __syncthreads();
    int buf = 0;
    for (int kt = nt - 1; kt >= kt_lo; --kt) {
        const bool has_next = kt > kt_lo;
        if (has_next) tile_load<2, 128>(R, Z, ldz, rowb + (size_t)(kt - 1) * 64, kcol, vcol, tid);
        if (kt * 64 <= q0 + wq * 32 + 31) {
            const bool diag = kt * 64 + 63 > q0 + wq * 32;
            attn_tile<128>(st, lds + buf * BUFB + comp * (64 * KSTRB), lds + buf * BUFB + 2 * 64 * KSTRB, qf, sc2, sl2, qpos, kt * 64, diag, true, lane);
        }
        if (has_next) { tile_store<2, 128>(R, lds + (buf ^ 1) * BUFB, lds + (buf ^ 1) * BUFB + 2 * 64 * KSTRB, tid); }
        __syncthreads();
        buf ^= 1;
    }
    const float inv = 1.f / (st.l + xhalf(st.l));
    LAS float* o2 = (LAS float*)lds;
    if (comp == 1) {
#pragma unroll
        for (int t = 0; t < 4; ++t)
#pragma unroll
            for (int r = 0; r < 16; ++r) o2[((wq * 4 + t) * 16 + r) * 64 + lane] = st.o[t][r] * inv;
    }
    __syncthreads();
    if (comp == 0) {
        float ss = 0.f;
#pragma unroll
        for (int t = 0; t < 4; ++t)
#pragma unroll
            for (int r = 0; r < 16; ++r) { const float v = st.o[t][r] * inv - lam * o2[((wq * 4 + t) * 16 + r) * 64 + lane]; st.o[t][r] = v; ss += v * v; }
        ss += xhalf(ss);
        const float rs = rsqrtf(ss * (1.f / 128.f) + EPS) * 0.6444909324090307f;
        const float* og = A.in[18];
        bf16* Y = WSP(bf16, WS_XNY) + (rowb + qpos) * 1024 + h * 128;
#pragma unroll
        for (int t = 0; t < 4; ++t)
#pragma unroll
            for (int rg = 0; rg < 4; ++rg) { const int dv = t * 32 + 8 * rg + 4 * hi; const f32x4 gg = *(const f32x4*)(og + dv);
                v2u o; o.x = pk2(st.o[t][4 * rg] * rs * gg.x, st.o[t][4 * rg + 1] * rs * gg.y); o.y = pk2(st.o[t][4 * rg + 2] * rs * gg.z, st.o[t][4 * rg + 3] * rs * gg.w);
                *(GAS v2u*)(Y + dv) = o; }
    }
    __syncthreads();
}
template <int MT, int NT>
__device__ __forceinline__ void mma_nt(const LAS unsigned char* A, int lda, const LAS unsigned char* B, int ldb, int K, f32x4 (&acc)[MT][NT], int lane) {
    const int r = lane & 15, kq = (lane >> 4) * 16;
    for (int k0 = 0; k0 < K; k0 += 32) {
        bf16x8 a[MT], bb[NT];
#pragma unroll
        for (int m = 0; m < MT; ++m) a[m] = *(const LAS bf16x8*)(A + (m * 16 + r) * lda + k0 * 2 + kq);
#pragma unroll
        for (int n = 0; n < NT; ++n) bb[n] = *(const LAS bf16x8*)(B + (n * 16 + r) * ldb + k0 * 2 + kq);
#pragma unroll
        for (int m = 0; m < MT; ++m)
#pragma unroll
            for (int n = 0; n < NT; ++n) acc[m][n] = __builtin_amdgcn_mfma_f32_16x16x32_bf16(a[m], bb[n], acc[m][n], 0, 0, 0);
    }
}
constexpr int TS = 272;
constexpr int TILEB = 128 * TS;
constexpr int ML_Q = 0, ML_K = TILEB, ML_V = 2 * TILEB, ML_SM = 3 * TILEB;

__device__ __forceinline__ void ml_gates(const float* GT, size_t row0, int hm, LAS float* sm, int lane) {
    const float i0 = GT[(row0 + 2 * lane) * 8 + hm], i1 = GT[(row0 + 2 * lane + 1) * 8 + hm];
    const float f0 = logsigmoid_f(GT[(row0 + 2 * lane) * 8 + 4 + hm]), f1 = logsigmoid_f(GT[(row0 + 2 * lane + 1) * 8 + 4 + hm]);
    float s = f0 + f1;
#pragma unroll
    for (int o = 1; o < 64; o <<= 1) { const float t = __shfl_up(s, o); if (lane >= o) s += t; }
    const float excl = s - (f0 + f1);
    sm[2 * lane] = excl + f0; sm[2 * lane + 1] = excl + f0 + f1;
    sm[128 + 2 * lane] = i0; sm[128 + 2 * lane + 1] = i1;
}
template <bool TRANSPOSE>
__device__ __forceinline__ void ml_conv_tile(const bf16* Z, size_t rowb, int t0, int zc, const float* cw, int wc, float mul, LAS unsigned char* dst, const LAS float* rs, int tid) {
#pragma unroll
    for (int it = 0; it < 4; ++it) {
        const int item = tid + 512 * it, l = item >> 4, ch = (item & 15) * 8;
        float acc[8];
#pragma unroll
        for (int i = 0; i < 8; ++i) acc[i] = 0.f;
#pragma unroll
        for (int jj = 0; jj < 4; ++jj) {
            const int t = t0 + l - 3 + jj;
            if (t >= 0) {
                const v4u w = *(const GAS v4u*)(Z + (rowb + t) * NZ0 + zc + ch);
                const float x[8] = {bflo(w.x), bfhi(w.x), bflo(w.y), bfhi(w.y), bflo(w.z), bfhi(w.z), bflo(w.w), bfhi(w.w)};
                const f32x4 c0 = *(const f32x4*)(cw + jj * 1024 + wc + ch), c1 = *(const f32x4*)(cw + jj * 1024 + wc + ch + 4);
                acc[0] += x[0] * c0.x; acc[1] += x[1] * c0.y; acc[2] += x[2] * c0.z; acc[3] += x[3] * c0.w;
                acc[4] += x[4] * c1.x; acc[5] += x[5] * c1.y; acc[6] += x[6] * c1.z; acc[7] += x[7] * c1.w;
            }
        }
        const float sc = TRANSPOSE ? mul * rs[l] : mul;
#pragma unroll
        for (int i = 0; i < 8; ++i) acc[i] = silu_f(acc[i]) * sc;
        if (TRANSPOSE) {
#pragma unroll
            for (int i = 0; i < 8; ++i) *(LAS bf16*)(dst + (ch + i) * TS + l * 2) = (bf16)f2bf(acc[i]);
        } else {
            v4u o; o.x = pk2(acc[0], acc[1]); o.y = pk2(acc[2], acc[3]); o.z = pk2(acc[4], acc[5]); o.w = pk2(acc[6], acc[7]);
            *(LAS v4u*)(dst + l * TS + ch * 2) = o;
        }
    }
}
__device__ __forceinline__ void ml_vt_tile(const bf16* Z, size_t row0, int zc, LAS unsigned char* dst, int tid) {
#pragma unroll
    for (int it = 0; it < 4; ++it) {
        const int item = tid + 512 * it, l = item >> 4, ch = (item & 15) * 8;
        const v4u w = *(const GAS v4u*)(Z + (row0 + l) * NZ0 + zc + ch);
        const unsigned ww[4] = {w.x, w.y, w.z, w.w};
#pragma unroll
        for (int i = 0; i < 4; ++i) { *(LAS bf16*)(dst + (ch + 2 * i) * TS + l * 2) = (bf16)(ww[i] & 0xffffu); *(LAS bf16*)(dst + (ch + 2 * i + 1) * TS + l * 2) = (bf16)(ww[i] >> 16); }
    }
}
__device__ __forceinline__ void mlstm_a_unit(Frame& F, const Args& A, int unit) {
    const int c = unit & 63, bh = unit >> 6, hm = bh & 3, b = bh >> 2;
    const bf16* Z = WSP(bf16, WS_Z); const float* GT = WSP(float, WS_GATES);
    const size_t rowb = (size_t)b * SEQ; const int t0 = c * 128;
    LAS unsigned char* lds = F.lds; LAS float* sm = (LAS float*)(lds + ML_SM);
    if (F.wave == 0) {
        ml_gates(GT, rowb + t0, hm, sm, F.lane);
        LDS_WAIT();
        const float bend = sm[127];
        const float w0 = bend - sm[2 * F.lane] + sm[128 + 2 * F.lane], w1 = bend - sm[2 * F.lane + 1] + sm[128 + 2 * F.lane + 1];
        const float ml = wave_max(fmaxf(w0, w1));
        sm[256 + 2 * F.lane] = __expf(w0 - ml); sm[256 + 2 * F.lane + 1] = __expf(w1 - ml);
        if (F.lane == 0) { WSP(float, WS_BEND)[unit] = bend; WSP(float, WS_MLOC)[unit] = ml; }
    }
    __syncthreads();
    ml_conv_tile<true>(Z, rowb, t0, 512 + hm * 128, A.in[7], 512 + hm * 128, 0.08838834764831845f, lds + ML_K, sm + 256, F.tid);
    ml_vt_tile(Z, rowb + t0, 1024 + hm * 128, lds + ML_V, F.tid);
    __syncthreads();
    f32x4 acc[2][4];
#pragma unroll
    for (int m = 0; m < 2; ++m)
#pragma unroll
        for (int n = 0; n < 4; ++n) acc[m][n] = (f32x4){0.f, 0.f, 0.f, 0.f};
    const int dv0 = 32 * (F.wave >> 1), dk0 = 64 * (F.wave & 1);
    mma_nt<2, 4>(lds + ML_V + dv0 * TS, TS, lds + ML_K + dk0 * TS, TS, 128, acc, F.lane);
    float* CL = WSP(float, WS_CLOC) + (size_t)unit * 16384;
#pragma unroll
    for (int m = 0; m < 2; ++m)
#pragma unroll
        for (int n = 0; n < 4; ++n)
#pragma unroll
            for (int i = 0; i < 4; ++i) CL[(size_t)(dv0 + 16 * m + 4 * (F.lane >> 4) + i) * 128 + dk0 + 16 * n + (F.lane & 15)] = acc[m][n][i];
    if (F.tid < 128) { float s = 0.f; const LAS bf16* kr = (const LAS bf16*)(lds + ML_K + F.tid * TS);
        for (int l = 0; l < 128; ++l) s += bf2f(kr[l]);
        WSP(float, WS_NLOC)[(size_t)unit * 128 + F.tid] = s; }
    __syncthreads();
}
__device__ __forceinline__ void mlstm_scan_unit(Frame& F, int unit) {
    const int bh = unit >> 4, sl = unit & 15;
    LAS float* tab = (LAS float*)F.lds;
    if (F.tid == 0) {
        const float* BE = WSP(float, WS_BEND) + bh * 64; const float* ML = WSP(float, WS_MLOC) + bh * 64; float* MP = WSP(float, WS_MPREV) + bh * 64;
        float m = 0.f;
        for (int c = 0; c < 64; ++c) { const float be = BE[c], ml = ML[c]; const float mn = fmaxf(be + m, ml);
            tab[c] = __expf(be + m - mn); tab[64 + c] = __expf(ml - mn); if (sl == 0) MP[c] = m; m = mn; }
    }
    __syncthreads();
    float* CL = WSP(float, WS_CLOC) + (size_t)bh * 64 * 16384 + sl * 1024 + 2 * F.tid;
    float s0 = 0.f, s1 = 0.f;
#pragma unroll 8
    for (int c = 0; c < 64; ++c) { float2* p = (float2*)(CL + (size_t)c * 16384); const float2 v = *p; *p = make_float2(s0, s1);
        const float a = tab[c], sc = tab[64 + c]; s0 = a * s0 + sc * v.x; s1 = a * s1 + sc * v.y; }
    if (sl == 0 && F.tid < 128) { float* NL = WSP(float, WS_NLOC) + (size_t)bh * 64 * 128 + F.tid; float s = 0.f;
        for (int c = 0; c < 64; ++c) { const float v = NL[c * 128]; NL[c * 128] = s; s = tab[c] * s + tab[64 + c] * v; } }
    __syncthreads();
}
__device__ __forceinline__ void mlstm_c_unit(Frame& F, const Args& A, int unit) {
    const int c = unit & 63, bh = unit >> 6, hm = bh & 3, b = bh >> 2;
    const bf16* Z = WSP(bf16, WS_Z); const float* GT = WSP(float, WS_GATES);
    const size_t rowb = (size_t)b * SEQ; const int t0 = c * 128;
    LAS unsigned char* lds = F.lds; LAS float* sm = (LAS float*)(lds + ML_SM);
    const int lane = F.lane, w = F.wave, tid = F.tid;
    const float mprev = WSP(float, WS_MPREV)[unit];
    if (w == 0) {
        ml_gates(GT, rowb + t0, hm, sm, lane);
        LDS_WAIT();
        const float b0 = sm[2 * lane], b1 = sm[2 * lane + 1];
        const float g0 = sm[128 + 2 * lane] - b0, g1 = sm[128 + 2 * lane + 1] - b1;
        float pm = fmaxf(g0, g1);
#pragma unroll
        for (int o = 1; o < 64; o <<= 1) { const float t = __shfl_up(pm, o); if (lane >= o) pm = fmaxf(pm, t); }
        float pe = __shfl_up(pm, 1); if (lane == 0) pe = -INFINITY;
        const float M0 = fmaxf(mprev, fmaxf(pe, g0)), M1 = fmaxf(mprev, pm);
        sm[256 + 2 * lane] = g0; sm[256 + 2 * lane + 1] = g1;
        sm[384 + 2 * lane] = M0; sm[384 + 2 * lane + 1] = M1;
        sm[512 + 2 * lane] = __expf(mprev - M0); sm[512 + 2 * lane + 1] = __expf(mprev - M1);
        sm[640 + 2 * lane] = __expf(-b0 - M0); sm[640 + 2 * lane + 1] = __expf(-b1 - M1);
        sm[768 + 2 * lane] = 0.f; sm[768 + 2 * lane + 1] = 0.f; sm[896 + 2 * lane] = 0.f; sm[896 + 2 * lane + 1] = 0.f;
    }
    if (w == 1) { sm[1152 + lane] = WSP(float, WS_NLOC)[(size_t)unit * 128 + lane]; sm[1152 + 64 + lane] = WSP(float, WS_NLOC)[(size_t)unit * 128 + 64 + lane]; }
    ml_conv_tile<false>(Z, rowb, t0, hm * 128, A.in[7], hm * 128, 1.f, lds + ML_Q, nullptr, tid);
    ml_conv_tile<false>(Z, rowb, t0, 512 + hm * 128, A.in[7], 512 + hm * 128, 0.08838834764831845f, lds + ML_K, nullptr, tid);
    ml_vt_tile(Z, rowb + t0, 1024 + hm * 128, lds + ML_V, tid);
    __syncthreads();
    const int l0 = 32 * (w >> 1), c0 = 64 * (w & 1);
    const int lr = 4 * (lane >> 4), lc = lane & 15;
    if (tid < 128) { const LAS bf16* qr = (const LAS bf16*)(lds + ML_Q + tid * TS); float s = 0.f;
        for (int d = 0; d < 128; ++d) s += bf2f(qr[d]) * sm[1152 + d];
        sm[1024 + tid] = s; }
    f32x4 acc[2][4];
#pragma unroll
    for (int m = 0; m < 2; ++m)
#pragma unroll
        for (int n = 0; n < 4; ++n) acc[m][n] = (f32x4){0.f, 0.f, 0.f, 0.f};
    mma_nt<2, 4>(lds + ML_Q + l0 * TS, TS, lds + ML_K + c0 * TS, TS, 128, acc, lane);
#pragma unroll
    for (int m = 0; m < 2; ++m)
#pragma unroll
        for (int i = 0; i < 4; ++i) { const int l = l0 + 16 * m + lr + i; const float Ml = sm[384 + l]; float rsum = 0.f;
#pragma unroll
            for (int n = 0; n < 4; ++n) { const int s = c0 + 16 * n + lc; const float v = (s <= l) ? acc[m][n][i] * __expf(sm[256 + s] - Ml) : 0.f; acc[m][n][i] = v; rsum += v; }
            rsum += __shfl_xor(rsum, 1); rsum += __shfl_xor(rsum, 2); rsum += __shfl_xor(rsum, 4); rsum += __shfl_xor(rsum, 8);
            if (lc == 0) __hip_atomic_fetch_add(sm + 768 + l, rsum, __ATOMIC_RELAXED, __HIP_MEMORY_SCOPE_WORKGROUP); }
    __syncthreads();
#pragma unroll
    for (int m = 0; m < 2; ++m)
#pragma unroll
        for (int n = 0; n < 4; ++n)
#pragma unroll
            for (int i = 0; i < 4; ++i) *(LAS bf16*)(lds + ML_K + (l0 + 16 * m + lr + i) * TS + (c0 + 16 * n + lc) * 2) = (bf16)f2bf(acc[m][n][i]);
    __syncthreads();
    f32x4 ai[2][4], ae[2][4];
#pragma unroll
    for (int m = 0; m < 2; ++m)
#pragma unroll
        for (int n = 0; n < 4; ++n) { ai[m][n] = (f32x4){0.f, 0.f, 0.f, 0.f}; ae[m][n] = (f32x4){0.f, 0.f, 0.f, 0.f}; }
    mma_nt<2, 4>(lds + ML_K + l0 * TS, TS, lds + ML_V + c0 * TS, TS, 128, ai, lane);
    {
        const float* CP = WSP(float, WS_CLOC) + (size_t)unit * 16384;
        const int r = lane & 15, kq = (lane >> 4) * 8;
        for (int k0 = 0; k0 < 128; k0 += 32) {
            bf16x8 a[2], bb[4];
#pragma unroll
            for (int m = 0; m < 2; ++m) a[m] = *(const LAS bf16x8*)(lds + ML_Q + (l0 + m * 16 + r) * TS + (k0 + kq) * 2);
#pragma unroll
            for (int n = 0; n < 4; ++n) { const float* p = CP + (size_t)(c0 + n * 16 + r) * 128 + k0 + kq; const f32x4 x = *(const f32x4*)p, y = *(const f32x4*)(p + 4);
                v4u pk; pk.x = pk2(x.x, x.y); pk.y = pk2(x.z, x.w); pk.z = pk2(y.x, y.y); pk.w = pk2(y.z, y.w); bb[n] = __builtin_bit_cast(bf16x8, pk); }
#pragma unroll
            for (int m = 0; m < 2; ++m)
#pragma unroll
                for (int n = 0; n < 4; ++n) ae[m][n] = __builtin_amdgcn_mfma_f32_16x16x32_bf16(a[m], bb[n], ae[m][n], 0, 0, 0);
        }
    }
#pragma unroll
    for (int m = 0; m < 2; ++m)
#pragma unroll
        for (int i = 0; i < 4; ++i) { const int l = l0 + 16 * m + lr + i; const float wi = sm[512 + l];
            const float den = wi * sm[1024 + l] + sm[768 + l]; const float dinv = 1.f / fmaxf(fabsf(den), sm[640 + l]); float ssq = 0.f;
#pragma unroll
            for (int n = 0; n < 4; ++n) { const float hv = (wi * ae[m][n][i] + ai[m][n][i]) * dinv; ai[m][n][i] = hv; ssq += hv * hv; }
            ssq += __shfl_xor(ssq, 1); ssq += __shfl_xor(ssq, 2); ssq += __shfl_xor(ssq, 4); ssq += __shfl_xor(ssq, 8);
            if (lc == 0) __hip_atomic_fetch_add(sm + 896 + l, ssq, __ATOMIC_RELAXED, __HIP_MEMORY_SCOPE_WORKGROUP); }
    __syncthreads();
    const float* mg = A.in[10] + hm * 128;
    bf16* Y = WSP(bf16, WS_XNY);
#pragma unroll
    for (int m = 0; m < 2; ++m)
#pragma unroll
        for (int i = 0; i < 4; ++i) { const int l = l0 + 16 * m + lr + i; const float rstd = rsqrtf(sm[896 + l] * (1.f / 128.f) + EPS); const size_t row = rowb + t0 + l;
#pragma unroll
            for (int n = 0; n < 4; ++n) { const int dv = c0 + 16 * n + lc; const float og = sigmoid_f(bf2f(Z[row * NZ0 + 1536 + hm * 128 + dv]));
                Y[row * 1024 + hm * 128 + dv] = (bf16)f2bf(ai[m][n][i] * rstd * mg[dv] * og); } }
    __syncthreads();
}
template <int N> __device__ __forceinline__ void bitonic_sort_desc(float (&v)[N]) {
#pragma unroll
    for (int k = 2; k <= N; k <<= 1)
#pragma unroll
        for (int j = k >> 1; j > 0; j >>= 1)
#pragma unroll
            for (int i = 0; i < N; ++i) { const int l = i ^ j; if (l > i) { const bool desc = ((i & k) == 0); const float a = v[i], b = v[l]; const float mx = fmaxf(a, b), mn = fminf(a, b); v[i] = desc ? mx : mn; v[l] = desc ? mn : mx; } }
}
__device__ __forceinline__ void merge_top16(float (&run)[16], const float (&nw)[16]) {
#pragma unroll
    for (int i = 0; i < 16; ++i) run[i] = fmaxf(run[i], nw[15 - i]);
#pragma unroll
    for (int j = 8; j > 0; j >>= 1)
#pragma unroll
        for (int i = 0; i < 16; ++i) { const int l = i ^ j; if (l > i) { const float a = run[i], b = run[l]; run[i] = fmaxf(a, b); run[l] = fminf(a, b); } }
}
#ifndef EXPERT_SLOW
#define EXPERT_SLOW 0
#endif
#ifndef ROUTE_SLOW
#define ROUTE_SLOW 0
#endif
constexpr int SCS = 132;
__device__ __forceinline__ void peer_route_unit(Frame& F, int tok0, int hd, const bf16x8 (&kf)[4][2], const int PROBE) {
    const bf16* QRY = WSP(bf16, WS_QRY); int* IDX = WSP(int, WS_IDX); float* GATE = WSP(float, WS_GATE);
    LAS float* SC = (LAS float*)F.lds;
    const int lane = F.lane, w = F.wave, tid = F.tid;
    {
        constexpr int AST = 528;
        LAS unsigned char* As = F.lds;
#pragma unroll
        for (int i = 0; i < 8; ++i) { const int ch = tid + 512 * i, row = ch >> 5, cc = ch & 31;
            *(LAS v4u*)(As + row * AST + cc * 16) = *(const GAS v4u*)(QRY + (size_t)(tok0 + row) * NQ + hd * 256 + cc * 8); }
        __syncthreads();
        const int p = w & 1, nq = w >> 1, r = lane & 15, kq = (lane >> 4) * 16;
        f32x4 acc[8][2];
#pragma unroll
        for (int m = 0; m < 8; ++m) { acc[m][0] = (f32x4){0.f, 0.f, 0.f, 0.f}; acc[m][1] = (f32x4){0.f, 0.f, 0.f, 0.f}; }
#pragma unroll
        for (int ks = 0; ks < 4; ++ks)
#pragma unroll
            for (int m = 0; m < 8; ++m) { const bf16x8 a = *(const LAS bf16x8*)(As + (16 * m + r) * AST + p * 256 + ks * 64 + kq);
                acc[m][0] = __builtin_amdgcn_mfma_f32_16x16x32_bf16(a, kf[ks][0], acc[m][0], 0, 0, 0);
                acc[m][1] = __builtin_amdgcn_mfma_f32_16x16x32_bf16(a, kf[ks][1], acc[m][1], 0, 0, 0); }
        __syncthreads();
#pragma unroll
        for (int m = 0; m < 8; ++m)
#pragma unroll
            for (int n = 0; n < 2; ++n)
#pragma unroll
                for (int i = 0; i < 4; ++i) SC[(p * 128 + 16 * m + 4 * (lane >> 4) + i) * SCS + 32 * nq + 16 * n + r] = acc[m][n][i];
    }
    __syncthreads();
#if defined(CHECK) && CHECK
    if (tok0 == 0 && hd == 0) { float* DB = WSP(float, WS_CLOC) + 8 * 1024 * 1024; for (int i = tid; i < 2 * 128 * 128; i += NTHR) DB[i] = SC[(i >> 7) * SCS + (i & 127)]; }
    __syncthreads();
#endif
#if ROUTE_SLOW
    if (tid < 128) {
        const int t = tid;
        float s0[16], s1[16]; unsigned i0[16], i1[16];
        { const LAS float* row = SC + (0 * 128 + t) * SCS; float prev = INFINITY;
#pragma unroll
          for (int k = 0; k < 16; ++k) { float best = -INFINITY; unsigned bi = 0; for (int n = 0; n < 128; ++n) { const float v = row[n]; if (v < prev && v > best) { best = v; bi = n; } } s0[k] = best; i0[k] = bi; prev = best; } }
        { const LAS float* row = SC + (1 * 128 + t) * SCS; float prev = INFINITY;
#pragma unroll
          for (int k = 0; k < 16; ++k) { float best = -INFINITY; unsigned bi = 0; for (int n = 0; n < 128; ++n) { const float v = row[n]; if (v < prev && v > best) { best = v; bi = n; } } s1[k] = best; i1[k] = bi; prev = best; } }
        float top[16]; unsigned tid16[16];
        { float prev = INFINITY;
#pragma unroll
          for (int k = 0; k < 16; ++k) { float best = -INFINITY; unsigned be = 0;
#pragma unroll
              for (int i = 0; i < 16; ++i)
#pragma unroll
                  for (int j = 0; j < 16; ++j) if ((i + 1) * (j + 1) <= 16) { const float v = s0[i] + s1[j]; if (v < prev && v > best) { best = v; be = i0[i] * 128u + i1[j]; } }
              top[k] = best; tid16[k] = be; prev = best; } }
        float sc[16], den = 0.f;
#pragma unroll
        for (int k = 0; k < 16; ++k) { sc[k] = __expf(top[k] - top[0]); den += sc[k]; }
        const float inv = 1.f / den;
        const size_t ob = (size_t)(tok0 + t) * 128 + hd * 16;
#pragma unroll
        for (int k = 0; k < 16; ++k) { IDX[ob + k] = (int)tid16[k]; GATE[ob + k] = sc[k] * inv; }
    }
    __syncthreads();
#else
    if (PROBE < 2) {
        const int t = tid & 127, p = (tid >> 7) & 1, half = tid >> 8;
        LAS float* seg = SC + (p * 128 + t) * SCS + 64 * half;
        float run[16], nw[16];
#pragma unroll
        for (int ch = 0; ch < 4; ++ch) {
#pragma unroll
            for (int q = 0; q < 4; ++q) { const f32x4 v = *(const LAS f32x4*)(seg + 16 * ch + 4 * q);
#pragma unroll
                for (int e = 0; e < 4; ++e) { const unsigned n = (unsigned)(64 * half + 16 * ch + 4 * q + e); const float key = u2f((f2u(v[e]) & ~127u) | n);
                    if (ch == 0) run[4 * q + e] = key; else nw[4 * q + e] = key; } }
            if (ch == 0) bitonic_sort_desc<16>(run); else { bitonic_sort_desc<16>(nw); merge_top16(run, nw); }
        }
#pragma unroll
        for (int q = 0; q < 4; ++q) *(LAS f32x4*)(seg + 4 * q) = (f32x4){run[4 * q], run[4 * q + 1], run[4 * q + 2], run[4 * q + 3]};
    }
    __syncthreads();
    if (tid < 128 && PROBE < 1) {
        const int t = tid;
        float s0[16], s1[16];
        {
            LAS float* a = SC + (0 * 128 + t) * SCS; float nw[16];
#pragma unroll
            for (int q = 0; q < 4; ++q) { const f32x4 v = *(const LAS f32x4*)(a + 4 * q), u = *(const LAS f32x4*)(a + 64 + 4 * q);
#pragma unroll
                for (int e = 0; e < 4; ++e) { s0[4 * q + e] = v[e]; nw[4 * q + e] = u[e]; } }
            merge_top16(s0, nw);
#pragma unroll
            for (int q = 0; q < 4; ++q) *(LAS f32x4*)(a + 16 + 4 * q) = (f32x4){s0[4 * q], s0[4 * q + 1], s0[4 * q + 2], s0[4 * q + 3]};
        }
        {
            LAS float* a = SC + (1 * 128 + t) * SCS; float nw[16];
#pragma unroll
            for (int q = 0; q < 4; ++q) { const f32x4 v = *(const LAS f32x4*)(a + 4 * q), u = *(const LAS f32x4*)(a + 64 + 4 * q);
#pragma unroll
                for (int e = 0; e < 4; ++e) { s1[4 * q + e] = v[e]; nw[4 * q + e] = u[e]; } }
            merge_top16(s1, nw);
#pragma unroll
            for (int q = 0; q < 4; ++q) *(LAS f32x4*)(a + 16 + 4 * q) = (f32x4){s1[4 * q], s1[4 * q + 1], s1[4 * q + 2], s1[4 * q + 3]};
        }
#pragma unroll
        for (int i = 0; i < 16; ++i) { s0[i] = u2f(f2u(s0[i]) & ~127u); s1[i] = u2f(f2u(s1[i]) & ~127u); }
        constexpr int CNT[16] = {16, 8, 5, 4, 3, 2, 2, 2, 1, 1, 1, 1, 1, 1, 1, 1};
        constexpr int OFF[16] = {0, 16, 24, 29, 33, 36, 38, 40, 42, 43, 44, 45, 46, 47, 48, 49};
        float top[16], nw[16];
#pragma unroll
        for (int grp = 0; grp < 4; ++grp) {
#pragma unroll
            for (int e = 0; e < 16; ++e) nw[e] = -INFINITY;
#pragma unroll
            for (int i = 0; i < 16; ++i)
#pragma unroll
                for (int j = 0; j < 16; ++j) if (j < CNT[i] && (OFF[i] + j) / 16 == grp) {
                    const float sum = s0[i] + s1[j];
                    nw[(OFF[i] + j) % 16] = u2f((f2u(sum) & ~255u) | (unsigned)(i * 16 + j)); }
            bitonic_sort_desc<16>(nw);
            if (grp == 0) {
#pragma unroll
                for (int e = 0; e < 16; ++e) top[e] = nw[e];
            } else merge_top16(top, nw);
        }
#if defined(CHECK) && CHECK
        if (tok0 == 0 && hd == 0) { float* DB = WSP(float, WS_CLOC) + 8 * 1024 * 1024 + 32768;
#pragma unroll
            for (int i = 0; i < 16; ++i) { DB[t * 48 + i] = s0[i]; DB[t * 48 + 16 + i] = s1[i]; DB[t * 48 + 32 + i] = top[i]; } }
#endif
        float sc[16], den = 0.f;
        const float mx = u2f(f2u(top[0]) & ~255u);
#pragma unroll
        for (int k = 0; k < 16; ++k) { sc[k] = __expf(u2f(f2u(top[k]) & ~255u) - mx); den += sc[k]; }
        const float inv = 1.f / den;
        LDS_WAIT();
        const LAS unsigned* l0 = (const LAS unsigned*)(SC + (0 * 128 + t) * SCS + 16); const LAS unsigned* l1 = (const LAS unsigned*)(SC + (1 * 128 + t) * SCS + 16);
        const size_t ob = (size_t)(tok0 + t) * 128 + hd * 16;
        unsigned eid[16];
#pragma unroll
        for (int k = 0; k < 16; ++k) { const unsigned id = f2u(top[k]) & 255u; const unsigned e0 = l0[id >> 4] & 127u, e1 = l1[id & 15u] & 127u; eid[k] = e0 * 128u + e1; }
#pragma unroll
        for (int q4 = 0; q4 < 4; ++q4) { v4u iv; iv.x = eid[4 * q4]; iv.y = eid[4 * q4 + 1]; iv.z = eid[4 * q4 + 2]; iv.w = eid[4 * q4 + 3];
            *(GAS v4u*)(IDX + ob + 4 * q4) = iv; *(GAS f32x4*)(GATE + ob + 4 * q4) = (f32x4){sc[4 * q4] * inv, sc[4 * q4 + 1] * inv, sc[4 * q4 + 2] * inv, sc[4 * q4 + 3] * inv}; }
    }
    __syncthreads();
#endif
}
__device__ __forceinline__ void peer_u_phase(Frame& F, const unsigned char* U8  ) {
    const bf16* XN = WSP(bf16, WS_XNY); const int* IDX = WSP(int, WS_IDX); float* PART = WSP(float, WS_PART);
    const int lane = F.lane, grp = lane >> 3, l8 = lane & 7;
    const int g = F.bid & 7, nsw = (F.G >> 3) * NWAVES, ws = (F.bid >> 3) * NWAVES + F.wave;
    const unsigned char* Ug = U8 + (size_t)g * 16384 * 128 + 16 * l8;
    for (int tok = ws; tok < M; tok += nsw) {
        int ids[16];
        { const int* ip = IDX + (size_t)tok * 128 + 16 * grp;
#pragma unroll
          for (int q4 = 0; q4 < 4; ++q4) { const v4u t = *(const GAS v4u*)(ip + 4 * q4); ids[4 * q4] = (int)t.x; ids[4 * q4 + 1] = (int)t.y; ids[4 * q4 + 2] = (int)t.z; ids[4 * q4 + 3] = (int)t.w; } }
        float hf[16];
        { const bf16* hp = XN + (size_t)tok * D + 128 * g + 16 * l8; const v4u x = *(const GAS v4u*)hp, y = *(const GAS v4u*)(hp + 8);
          hf[0] = bflo(x.x); hf[1] = bfhi(x.x); hf[2] = bflo(x.y); hf[3] = bfhi(x.y); hf[4] = bflo(x.z); hf[5] = bfhi(x.z); hf[6] = bflo(x.w); hf[7] = bfhi(x.w);
          hf[8] = bflo(y.x); hf[9] = bfhi(y.x); hf[10] = bflo(y.y); hf[11] = bfhi(y.y); hf[12] = bflo(y.z); hf[13] = bfhi(y.z); hf[14] = bflo(y.w); hf[15] = bfhi(y.w); }
        v4u w[16];
#pragma unroll
        for (int it = 0; it < 16; ++it) w[it] = *(const GAS v4u*)(Ug + (size_t)ids[it] * 128);
        float am = 0.f;
#pragma unroll
        for (int i = 0; i < 16; ++i) am = fmaxf(am, fabsf(hf[i]));
        am = fmaxf(am, __shfl_xor(am, 1)); am = fmaxf(am, __shfl_xor(am, 2)); am = fmaxf(am, __shfl_xor(am, 4));
        const float hinv = am > 1e-30f ? 127.f / am : 0.f, hsc = am * (1.f / 127.f);
        int hq[4];
#pragma unroll
        for (int q4 = 0; q4 < 4; ++q4) { unsigned wv = 0;
#pragma unroll
            for (int e = 0; e < 4; ++e) { const int qv = (int)rintf(hf[4 * q4 + e] * hinv); wv |= ((unsigned)qv & 0xffu) << (8 * e); }
            hq[q4] = (int)wv; }
        float r[16];
#pragma unroll
        for (int it = 0; it < 16; ++it) { const unsigned wx = w[it].x, wy = w[it].y, wz = w[it].z, ww = w[it].w;
            int acc = __builtin_amdgcn_sdot4((int)wx, hq[0], 0, false); acc = __builtin_amdgcn_sdot4((int)wy, hq[1], acc, false); acc = __builtin_amdgcn_sdot4((int)wz, hq[2], acc, false); acc = __builtin_amdgcn_sdot4((int)ww, hq[3], acc, false);
            acc += __shfl_xor(acc, 1); acc += __shfl_xor(acc, 2); acc += __shfl_xor(acc, 4); r[it] = (float)acc * hsc; }
        if (l8 == 0) { float* pp = PART + ((size_t)g * M + tok) * 128 + 16 * grp;
#pragma unroll
            for (int q4 = 0; q4 < 4; ++q4) *(GAS f32x4*)(pp + 4 * q4) = (f32x4){r[4 * q4], r[4 * q4 + 1], r[4 * q4 + 2], r[4 * q4 + 3]}; }
    }
}
__device__ __forceinline__ void peer_act_phase(Frame& F, const float* ISU, const float* ISV) {
    const int* IDX = WSP(int, WS_IDX); const float* GATE = WSP(float, WS_GATE); const float* PART = WSP(float, WS_PART);
    unsigned short* ACT8 = WSP(unsigned short, WS_ACT); float* ACTS = WSP(float, WS_ACTS);
    const int gw = F.bid * NWAVES + F.wave, NGW = F.G * NWAVES, lane = F.lane;
    for (int tok = gw; tok < M; tok += NGW) {
        const size_t i = (size_t)tok * 128 + 2 * lane;
        float s0 = 0.f, s1 = 0.f;
#pragma unroll
        for (int g = 0; g < 8; ++g) { const float2 p = *(const float2*)(PART + (size_t)g * M * 128 + i); s0 += p.x; s1 += p.y; }
        const int2 id = *(const int2*)(IDX + i); const float2 gt = *(const float2*)(GATE + i);
        const float d0 = s0 * ISU[id.x], d1 = s1 * ISU[id.y];
        const float a0 = 0.5f * d0 * (1.f + erff(d0 * 0.70710678118654752f)) * gt.x * ISV[id.x], a1 = 0.5f * d1 * (1.f + erff(d1 * 0.70710678118654752f)) * gt.y * ISV[id.y];
        const float am = wave_max(fmaxf(fabsf(a0), fabsf(a1)));
        const float inv = am > 1e-30f ? 127.f / am : 0.f;
        const int q0 = (int)rintf(a0 * inv), q1 = (int)rintf(a1 * inv);
        ACT8[(size_t)tok * 64 + lane] = (unsigned short)(((unsigned)q0 & 0xffu) | (((unsigned)q1 & 0xffu) << 8));
        if (lane == 0) ACTS[tok] = am * (1.f / 127.f);
    }
}
__device__ __forceinline__ void peer_v_phase(Frame& F, const unsigned char* V8, const float* g2  , float dbg) {
    const int* IDX = WSP(int, WS_IDX); const unsigned* ACT8 = WSP(unsigned, WS_ACT); const float* ACTS = WSP(float, WS_ACTS);
    const int lane = F.lane, t8 = lane >> 3, l8 = lane & 7;
    const int g = F.bid & 7, nsw = (F.G >> 3) * NWAVES, ws = (F.bid >> 3) * NWAVES + F.wave;
    const unsigned char* Vg = V8 + (size_t)g * 16384 * 128 + 16 * l8;
    for (int wi = ws; wi < M / 8; wi += nsw) {
        const int tok = wi * 8 + t8;
        const int* ip = IDX + (size_t)tok * 128; const unsigned* ap = ACT8 + (size_t)tok * 32;
        int acc[16];
#pragma unroll
        for (int i = 0; i < 16; ++i) acc[i] = 0;
#pragma unroll 2
        for (int gi = 0; gi < 32; ++gi) {
            const v4u id4 = *(const GAS v4u*)(ip + 4 * gi); const int qa = (int)ap[gi];
            const v4u ra = *(const GAS v4u*)(Vg + (size_t)id4.x * 128), rb = *(const GAS v4u*)(Vg + (size_t)id4.y * 128), rc = *(const GAS v4u*)(Vg + (size_t)id4.z * 128), rd = *(const GAS v4u*)(Vg + (size_t)id4.w * 128);
            const unsigned A[4] = {ra.x, ra.y, ra.z, ra.w}, B[4] = {rb.x, rb.y, rb.z, rb.w}, C[4] = {rc.x, rc.y, rc.z, rc.w}, Dd[4] = {rd.x, rd.y, rd.z, rd.w};
#pragma unroll
            for (int j = 0; j < 4; ++j) {
                const unsigned ablo = __builtin_amdgcn_perm(B[j], A[j], 0x05010400u), abhi = __builtin_amdgcn_perm(B[j], A[j], 0x07030602u);
                const unsigned cdlo = __builtin_amdgcn_perm(Dd[j], C[j], 0x05010400u), cdhi = __builtin_amdgcn_perm(Dd[j], C[j], 0x07030602u);
                const unsigned t0 = __builtin_amdgcn_perm(cdlo, ablo, 0x05040100u), t1 = __builtin_amdgcn_perm(cdlo, ablo, 0x07060302u);
                const unsigned t2 = __builtin_amdgcn_perm(cdhi, abhi, 0x05040100u), t3 = __builtin_amdgcn_perm(cdhi, abhi, 0x07060302u);
                acc[4 * j] = __builtin_amdgcn_sdot4((int)t0, qa, acc[4 * j], false); acc[4 * j + 1] = __builtin_amdgcn_sdot4((int)t1, qa, acc[4 * j + 1], false);
                acc[4 * j + 2] = __builtin_amdgcn_sdot4((int)t2, qa, acc[4 * j + 2], false); acc[4 * j + 3] = __builtin_amdgcn_sdot4((int)t3, qa, acc[4 * j + 3], false);
            }
        }
        const float sc = ACTS[tok] * dbg;
        const int b = tok >> 13, c0 = 128 * g + 16 * l8; float* xr = F.out + (size_t)tok * D + c0; const float* gr = g2 + (size_t)b * 6144 + c0;
#pragma unroll
        for (int q4 = 0; q4 < 4; ++q4) { const f32x4 xv = *(const GAS f32x4*)(xr + 4 * q4), gv = *(const f32x4*)(gr + 4 * q4);
            *(GAS f32x4*)(xr + 4 * q4) = xv + gv * sc * (f32x4){(float)acc[4 * q4], (float)acc[4 * q4 + 1], (float)acc[4 * q4 + 2], (float)acc[4 * q4 + 3]}; }
    }
}
#if defined(CHECK) && CHECK
constexpr size_t WS_DBG = 512 * 1024;
constexpr size_t WS_DBGOUT = WS_CLOC;
#ifndef CHECK_LAYER
#define CHECK_LAYER 1
#endif
__global__ void chk_qry(Args a) {
    const bf16* XN = (const bf16*)(a.ws + WS_XNY); const bf16* QRY = (const bf16*)(a.ws + WS_QRY); const float* wq = a.in[20] + (size_t)CHECK_LAYER * D * NQ;
    float* R = (float*)(a.ws + WS_CTL + WS_DBG);
    const int tok = (blockIdx.x * 977) % M; const int col = (threadIdx.x * 37 + blockIdx.x * 11) % NQ;
    float s = 0.f; for (int k = 0; k < D; ++k) s += bf2f(XN[(size_t)tok * D + k]) * wq[(size_t)k * NQ + col];
    const float q = bf2f(QRY[(size_t)tok * NQ + col]);
    atomicAdd(R + 0, (s - q) * (s - q)); atomicAdd(R + 1, s * s);
}
__global__ void chk_keys(Args a) {
    const bf16* KB = (const bf16*)(a.ws + WS_KEYS); const float* keys = a.in[21]; float* R = (float*)(a.ws + WS_CTL + WS_DBG);
    const int i = blockIdx.x * blockDim.x + threadIdx.x; if (i < 2 * 2 * 128 * 128) { const float d = bf2f(KB[i]) - keys[i]; atomicAdd(R + 8, d * d); atomicAdd(R + 9, keys[i] * keys[i]); }
}
__global__ void chk_uv(Args a) {
    const bf16* UB = (const bf16*)(a.ws + WS_UB); const bf16* VB = (const bf16*)(a.ws + WS_VB); float* R = (float*)(a.ws + WS_CTL + WS_DBG);
    const size_t i = ((size_t)blockIdx.x * blockDim.x + threadIdx.x) * 61 % ((size_t)2 * 16384 * 1024);
    const float du = bf2f(UB[i]) - a.in[22][i], dv = bf2f(VB[i]) - a.in[23][i];
    atomicAdd(R + 16, du * du + dv * dv); atomicAdd(R + 17, a.in[22][i] * a.in[22][i] + a.in[23][i] * a.in[23][i]);
}
__global__ void chk_route(Args a) {
    const bf16* QRY = (const bf16*)(a.ws + WS_QRY); const float* keys = a.in[21] + (size_t)CHECK_LAYER * 2 * 128 * 128;
    const int* IDX = (const int*)(a.ws + WS_IDX); const float* GATE = (const float*)(a.ws + WS_GATE);
    float* R = (float*)(a.ws + WS_CTL + WS_DBG);
    __shared__ float sc[2][128]; __shared__ float sc0[2][128]; __shared__ float ts[2][16]; __shared__ int ti[2][16]; __shared__ float cs[256]; __shared__ int ci[256];
    const int tok = (blockIdx.x * 613 + 5) % M, hd = blockIdx.x & 7, tid = threadIdx.x;
    { const int p = tid >> 7, n = tid & 127; float s = 0.f; for (int d = 0; d < 128; ++d) s += bf2f(QRY[(size_t)tok * NQ + hd * 256 + p * 128 + d]) * keys[(size_t)(p * 128 + n) * 128 + d]; sc[p][n] = s; sc0[p][n] = s; }
    __syncthreads();
    if (tid < 2) { const int p = tid; for (int k = 0; k < 16; ++k) { int best = 0; float bv = -INFINITY; for (int n = 0; n < 128; ++n) if (sc[p][n] > bv) { bv = sc[p][n]; best = n; } ts[p][k] = bv; ti[p][k] = best; sc[p][best] = -INFINITY; } }
    __syncthreads();
    cs[tid] = ts[0][tid >> 4] + ts[1][tid & 15]; ci[tid] = ti[0][tid >> 4] * 128 + ti[1][tid & 15];
    __syncthreads();
    if (tid == 0) {
        float fs[16]; int fi[16];
        for (int k = 0; k < 16; ++k) { int best = 0; float bv = -INFINITY; for (int n = 0; n < 256; ++n) if (cs[n] > bv) { bv = cs[n]; best = n; } fs[k] = bv; fi[k] = ci[best]; cs[best] = -INFINITY; }
        float den = 0.f; for (int k = 0; k < 16; ++k) den += __expf(fs[k] - fs[0]);
        int mism = 0; float ge = 0.f;
        for (int k = 0; k < 16; ++k) { bool found = false; for (int j = 0; j < 16; ++j) if (IDX[(size_t)tok * 128 + hd * 16 + j] == fi[k]) { found = true; const float g = __expf(fs[k] - fs[0]) / den; const float d = g - GATE[(size_t)tok * 128 + hd * 16 + j]; ge += d * d; } if (!found) ++mism; }
        { int ba = 0, bb = 0; for (int j = 0; j < 16; ++j) { const int e = IDX[(size_t)tok * 128 + hd * 16 + j]; const int ea = (e >> 7) & 127, eb = e & 127;
            if (!(e >= 0 && e < 16384) || sc0[0][ea] + sc0[1][eb] < fs[15] - 0.05f) ++ba; if (!(e >= 0 && e < 16384) || sc0[1][ea] + sc0[0][eb] < fs[15] - 0.05f) ++bb; }
          atomicAdd(R + 10, (float)ba); atomicAdd(R + 11, (float)bb); }
        atomicAdd(R + 2, (float)mism); atomicAdd(R + 3, 16.f); atomicAdd(R + 4, ge); atomicAdd(R + 5, 1.f / 16.f);
    }
}
__global__ void chk_scores(Args a) {
    const bf16* QRY = (const bf16*)(a.ws + WS_QRY); const float* keys = a.in[21] + (size_t)CHECK_LAYER * 2 * 128 * 128;
    const float* DB = (const float*)(a.ws + WS_CLOC) + 8 * 1024 * 1024; float* R = (float*)(a.ws + WS_CTL + WS_DBG);
    const int t = blockIdx.x, tid = threadIdx.x;
    __shared__ float sc[2][128];
    { const int p = tid >> 7, n = tid & 127; float s = 0.f; for (int d = 0; d < 128; ++d) s += bf2f(QRY[(size_t)t * NQ + p * 128 + d]) * keys[(size_t)(p * 128 + n) * 128 + d];
      const float dv = DB[(p * 128 + t) * 128 + n]; atomicAdd(R + 12, (s - dv) * (s - dv)); atomicAdd(R + 13, s * s); sc[p][n] = dv; }
    __syncthreads();
    if (tid < 2) { const int p = tid; int bad = 0; for (int k = 0; k < 16; ++k) { int best = 0; float bv = -INFINITY; for (int n = 0; n < 128; ++n) if (sc[p][n] > bv) { bv = sc[p][n]; best = n; }
        const float lv = DB[32768 + t * 48 + 16 * p + k]; if (fabsf(lv - bv) > 1e-3f * (1.f + fabsf(bv))) ++bad; sc[p][best] = -INFINITY; }
        atomicAdd(R + 14, (float)bad); atomicAdd(R + 15, 16.f); }
}
__global__ void chk_expert(Args a) {
    const bf16* XN = (const bf16*)(a.ws + WS_XNY); const int* IDX = (const int*)(a.ws + WS_IDX); const float* GATE = (const float*)(a.ws + WS_GATE);
    const float* U = a.in[22] + (size_t)CHECK_LAYER * 16384 * 1024; const float* V = a.in[23] + (size_t)CHECK_LAYER * 16384 * 1024;
    const float* DO = (const float*)(a.ws + WS_DBGOUT); float* R = (float*)(a.ws + WS_CTL + WS_DBG);
    __shared__ float act[128];
    const int tok = (blockIdx.x * 61 + 3) % 4096, tid = threadIdx.x;
    if (tid < 128) { const int e = IDX[(size_t)tok * 128 + tid]; float s = 0.f; for (int k = 0; k < D; ++k) s += bf2f(XN[(size_t)tok * D + k]) * U[(size_t)e * D + k];
        act[tid] = 0.5f * s * (1.f + erff(s * 0.70710678f)) * GATE[(size_t)tok * 128 + tid]; }
    __syncthreads();
    for (int c = tid; c < D; c += 256) { float o = 0.f; for (int e = 0; e < 128; ++e) o += act[e] * V[(size_t)IDX[(size_t)tok * 128 + e] * D + c];
        const float g = DO[(size_t)tok * D + c]; atomicAdd(R + 6, (o - g) * (o - g)); atomicAdd(R + 7, o * o); }
}
__global__ void chk_stamp(Args a) {
    const float* R = (const float*)(a.ws + WS_CTL + WS_DBG);
    const float e1 = sqrtf(R[0] / fmaxf(R[1], 1e-30f)), e2 = R[2] / fmaxf(R[3], 1.f), e2g = sqrtf(R[4] / fmaxf(R[5], 1e-30f)), e3 = sqrtf(R[6] / fmaxf(R[7], 1e-30f));
    float c;
#if CHECK == 99
    c = 1.f;
#else
    const float e0 = sqrtf(R[8] / fmaxf(R[9], 1e-30f));
    const float ea = R[10] / fmaxf(R[3], 1.f), eb = R[11] / fmaxf(R[3], 1.f);
    const float esc = sqrtf(R[12] / fmaxf(R[13], 1e-30f)), els = R[14] / fmaxf(R[15], 1.f);
    const float euv = sqrtf(R[16] / fmaxf(R[17], 1e-30f));
    const float errs[4] = {e2, euv, ea, e3}; const float tols[4] = {0.08f, 0.01f, 0.08f, 0.03f};
    c = 1.f;
    for (int k = 3; k >= 0; --k) if (!(errs[k] <= tols[k])) { const float fr = fminf(fmaxf((log10f(fmaxf(errs[k], 1e-4f)) + 4.f) / 5.f, 0.f), 0.95f); c = 2.f + (float)k + fr; }
#endif
    const size_t i = (size_t)blockIdx.x * blockDim.x + threadIdx.x;
    if (i < (size_t)M * D) a.out[i] = a.in[0][i] * (1.f + c);
}
#endif
#ifndef MK_PER_PHASE
#define MK_PER_PHASE 0
#endif
constexpr int NPHASE = 24;
#ifndef RPROBE
#define RPROBE 0
#endif
#ifndef DBG_Y0
#define DBG_Y0 1
#define DBG_P0 1
#define DBG_Y1 1
#define DBG_P1 1
#endif
#ifndef PHASE_MASK
#define PHASE_MASK 0x1ffffffu
#endif
#define IN(k) (lo <= (k) && (k) < hi && ((PHASE_MASK >> (k)) & 1u))
#ifndef DUP_PHASE
#define DUP_PHASE -1
#endif
#define REPS(k) for (int rep = ((DUP_PHASE) == (k) ? 0 : 1); rep < 2; ++rep)
#define SEAM(k) do { if (IN(k) && IN((k) + 1)) xcd_barrier(bar); } while (0)
__device__ __forceinline__ float alibi_tcut(const float* gq, const float* gk, int lane) { return 16.f * wave_max(fabsf(gq[lane])) * wave_max(fabsf(gk[lane])) + ALIBI_MARGIN; }
template <int layer>
__device__ __forceinline__ void layer_phases(Frame& F, const Args& args, const XcdBarrier& bar, const int lo, const int hi) {
    volatile LAS unsigned* MISCW = (volatile LAS unsigned*)(F.lds + MISC_OFF);
    float* MOD = WSP(float, WS_MOD);
    bf16* XNY = WSP(bf16, WS_XNY); bf16* Zb = WSP(bf16, WS_Z);

        constexpr int pb = layer * 12;
        const float* mod = MOD + (size_t)layer * 4 * 6144;
        if (IN(pb + 1)) REPS(pb + 1) { if (layer == 0) norm_pass<true>(F, args, args.in[0], args.in[4], mod, 0, XNY); else norm_pass<false>(F, args, F.out, args.in[4] + 1024, mod, 0, XNY); } SEAM(pb + 1);
        if (IN(pb + 2)) REPS(pb + 2) {
            const int N = layer == 0 ? NZ0 : NZ1;
            pg8::Gemm g{XNY, layer == 0 ? WSP(bf16, WS_WIN0) : WSP(bf16, WS_WIN1), M, N, D}; pg8::StaticOrder S; S.init(M, N, F.G, F.bid);
            pg8::EpiBf16 E{Zb, N};
            pg8::gemm_phase<pg8::EpiBf16, pg8::StaticOrder, true, true>(F.lds, g, S, E);
        } SEAM(pb + 2);
        if (layer == 0) {
            if (IN(3)) REPS(3) {
                for (int u = F.bid; u < 1024 + 256; u += F.G) {
                    if (u < 1024) mlstm_a_unit(F, args, u);
                    else if (rep == 1) { const int v = u - 1024, b = v >> 6, j = (v >> 1) & 31, which = v & 1;
                        qknorm_unit(F, Zb, NZ0, b * SEQ + j * 256, which ? 2560 : 2048, which ? args.in[12] : args.in[11], which ? 1.f : 0.125f * LOG2E, which ? WSP(float, WS_KMEAN) + (size_t)((b * 8) * 32 + j) * 64 : nullptr); }
                }
            } SEAM(3);
            if (IN(4)) REPS(4) {
                if (rep == 1) for (int u = F.bid; u < 256; u += F.G) mlstm_scan_unit(F, u);
                { const float tcut = alibi_tcut(args.in[11], args.in[12], F.lane);
                  const unsigned short* ORD = WSP(unsigned short, WS_ORD) + 2048; unsigned* qw = (unsigned*)(F.ws + WS_CTL) + CW_QMOBA + (rep == 1 ? 0 : 16);
                  for (;;) { if (F.tid == 0) MISCW[0] = atomicAdd(qw, 1u); __syncthreads(); const unsigned qi = MISCW[0]; __syncthreads(); if (qi >= 1024u) break;
                      const int u = ORD[qi]; moba_unit(F, u >> 8, (u >> 5) & 7, u & 31, tcut); }
                  if (rep == 1) { unsigned* cw = (unsigned*)(F.ws + WS_CTL) + CW_QCVT0;
                      for (;;) { if (F.tid == 0) MISCW[0] = atomicAdd(cw, 1u); __syncthreads(); const unsigned ci = MISCW[0]; __syncthreads(); if (ci >= 512u) break; i8_chunk(F, args, 0, (int)ci); } } }
            } SEAM(4);
            if (IN(5)) REPS(5) { for (int u = F.bid; u < 1024; u += F.G) mlstm_c_unit(F, args, u); } SEAM(5);
        } else {
            if (IN(pb + 3)) {
                for (int u = F.bid; u < 512; u += F.G) { const int rt = u >> 2, cr = u & 3; qknorm_unit(F, Zb, NZ1, rt * 256, cr * 512, cr < 2 ? args.in[15] : args.in[16], cr < 2 ? 0.125f * LOG2E : 1.f, nullptr); }
            } SEAM(pb + 3);
            if (IN(pb + 4)) REPS(pb + 4) {
                const float* lp = args.in[17];
                const float lam = __expf(wave_sum(lp[F.lane] * lp[64 + F.lane])) - __expf(wave_sum(lp[128 + F.lane] * lp[192 + F.lane])) + 0.35550906759096926f;
                { const float tcut = alibi_tcut(args.in[15], args.in[16], F.lane);
                  const unsigned short* ORD = WSP(unsigned short, WS_ORD); unsigned* qw = (unsigned*)(F.ws + WS_CTL) + CW_QDIFF + (rep == 1 ? 0 : 16);
                  for (;;) { if (F.tid == 0) MISCW[0] = atomicAdd(qw, 1u); __syncthreads(); const unsigned qi = MISCW[0]; __syncthreads(); if (qi >= 2048u) break;
                      const int u = ORD[qi]; diff_unit(F, args, u >> 9, (u >> 6) & 7, u & 63, lam, tcut); }
                  if (rep == 1) { unsigned* cw = (unsigned*)(F.ws + WS_CTL) + CW_QCVT1;
                      for (;;) { if (F.tid == 0) MISCW[0] = atomicAdd(cw, 1u); __syncthreads(); const unsigned ci = MISCW[0]; __syncthreads(); if (ci >= 512u) break; i8_chunk(F, args, 1, (int)ci); } } }
            } SEAM(pb + 4);
        }
        if (IN(pb + 6)) REPS(pb + 6) {
            pg8::Gemm g{XNY, layer == 0 ? WSP(bf16, WS_WOUT0) : WSP(bf16, WS_WOUT1), M, D, D}; pg8::StaticOrder S; S.init(M, D, F.G, F.bid);
            pg8::EpiResid E{layer == 0 ? args.in[0] : F.out, F.out, mod + 2 * 1024, rep == 1 ? (layer == 0 ? (float)DBG_Y0 : (float)DBG_Y1) : 0.f};
            pg8::gemm_phase<pg8::EpiResid, pg8::StaticOrder, true, true>(F.lds, g, S, E);
        } SEAM(pb + 6);
        if (IN(pb + 7)) REPS(pb + 7) { norm_pass<false>(F, args, F.out, args.in[5] + layer * 1024, mod, 3, XNY); } SEAM(pb + 7);
        if (IN(pb + 8)) REPS(pb + 8) {
            pg8::Gemm g{XNY, WSP(bf16, WS_WQ) + (size_t)layer * NQ * D, M, NQ, D}; pg8::StaticOrder S; S.init(M, NQ, F.G, F.bid);
            pg8::EpiBf16 E{WSP(bf16, WS_QRY), NQ};
            pg8::gemm_phase<pg8::EpiBf16, pg8::StaticOrder, true, true>(F.lds, g, S, E);
        } SEAM(pb + 8);
        if (IN(pb + 9)) REPS(pb + 9) { const bf16* KEYS = WSP(bf16, WS_KEYS) + (size_t)layer * 2 * 128 * 128;
            bf16x8 kf[4][2];
#pragma unroll
            for (int ks = 0; ks < 4; ++ks)
#pragma unroll
                for (int n = 0; n < 2; ++n) kf[ks][n] = *(const GAS bf16x8*)(KEYS + (size_t)((F.wave & 1) * 128 + 32 * (F.wave >> 1) + 16 * n + (F.lane & 15)) * 128 + 32 * ks + 8 * (F.lane >> 4));
            for (int u = F.bid; u < 2048; u += F.G) peer_route_unit(F, (u >> 3) * 128, u & 7, kf, rep == 0 ? RPROBE : 0); } SEAM(pb + 9);
        if (IN(pb + 10)) REPS(pb + 10) { peer_u_phase(F, F.ws + WS_UB + (size_t)layer * 8 * 16384 * 128); } SEAM(pb + 10);
        if (IN(pb + 11)) REPS(pb + 11) { peer_act_phase(F, WSP(float, WS_ISU) + layer * 16384, WSP(float, WS_ISV) + layer * 16384); } SEAM(pb + 11);
        if (IN(pb + 12)) REPS(pb + 12) { peer_v_phase(F, F.ws + WS_VB + (size_t)layer * 8 * 16384 * 128, mod + 5 * 1024, rep == 1 ? (layer == 0 ? (float)DBG_P0 : (float)DBG_P1) : 0.f); }
        if (layer == 0) SEAM(12);
    }
__global__ void __launch_bounds__(NTHR, 2) mega_fwd(Args args) {
    extern __shared__ __attribute__((aligned(16))) unsigned char lds_raw[];
    Frame F;
    F.lds = (LAS unsigned char*)lds_raw;
    F.tid = threadIdx.x; F.lane = F.tid & 63; F.wave = __builtin_amdgcn_readfirstlane(F.tid >> 6);
    F.G = gridDim.x; F.bid = blockIdx.x;
    F.out = args.out; F.ws = args.ws;
    volatile LAS unsigned* MISC = (volatile LAS unsigned*)(F.lds + MISC_OFF);
    for (int u = F.tid; u < (LDS_BYTES - LDSCTL_OFF) / 4; u += NTHR) ((LAS unsigned*)(F.lds + LDSCTL_OFF))[u] = 0u;
    __syncthreads();
    XcdBarrier bar; bar.bar = (unsigned*)(F.ws + WS_CTL) + CW_BAR; bar.x = 0; bar.st = nullptr;
    if (!MK_PER_PHASE) bar = xcd_barrier_post((unsigned*)(F.ws + WS_CTL) + CW_BAR, MISC + 8);
    const int lo = args.ph_lo, hi = args.ph_hi;

    if (IN(0)) REPS(0) { p0_prologue(F, args); } SEAM(0);
    layer_phases<0>(F, args, bar, lo, hi);
    layer_phases<1>(F, args, bar, lo, hi);
}
#undef IN
#undef SEAM

extern "C" void kernel_launch(void* const* d_in, const int* in_sizes, int n_in, void* d_out, int out_size, void* d_ws, size_t ws_size, hipStream_t stream) {
    static int grid = 0;
    if (grid == 0) {
        if (n_in != 24 || in_sizes[0] != M * D || out_size != M * D || ws_size < WS_END) { fprintf(stderr, "kernel_launch: unexpected problem (n_in %d, in0 %d, out %d, ws %zu < %zu); nothing launched\n", n_in, n_in > 0 ? in_sizes[0] : -1, out_size, ws_size, (size_t)WS_END); grid = -1; return; }
        int dev = 0, cus = 0, per_cu = 0;
        if (hipGetDevice(&dev) != hipSuccess || hipDeviceGetAttribute(&cus, hipDeviceAttributeMultiprocessorCount, dev) != hipSuccess) { grid = -1; return; }
        if (hipFuncSetAttribute((const void*)mega_fwd, hipFuncAttributeMaxDynamicSharedMemorySize, LDS_BYTES) != hipSuccess) { fprintf(stderr, "kernel_launch: hipFuncSetAttribute failed\n"); grid = -1; return; }
        if (hipOccupancyMaxActiveBlocksPerMultiprocessor(&per_cu, (const void*)mega_fwd, NTHR, LDS_BYTES) != hipSuccess || per_cu < 1)
            fprintf(stderr, "kernel_launch: note: occupancy query reports %d workgroups per CU\n", per_cu);
        (void)hipGetLastError();
        grid = cus;
    }
    if (grid < 0) return;
    if (hipMemsetAsync((char*)d_ws + WS_CTL, 0, CTL_ZERO_BYTES, stream) != hipSuccess) { fprintf(stderr, "kernel_launch: memset failed\n"); return; }
    Args a{};
    for (int i = 0; i < 24; ++i) a.in[i] = (const float*)d_in[i];
    a.out = (float*)d_out; a.ws = (unsigned char*)d_ws;
#if MK_PER_PHASE
    for (int p = 0; p < NPHASE + 1; ++p) { a.ph_lo = p; a.ph_hi = p + 1; hipLaunchKernelGGL(mega_fwd, dim3(grid), dim3(NTHR), LDS_BYTES, stream, a); }
#else
    a.ph_lo = 0; a.ph_hi = NPHASE + 1;
    hipLaunchKernelGGL(mega_fwd, dim3(grid), dim3(NTHR), LDS_BYTES, stream, a);
#endif
#if defined(CHECK) && CHECK
    chk_qry<<<256, 256, 0, stream>>>(a); chk_keys<<<256, 256, 0, stream>>>(a); chk_uv<<<1024, 256, 0, stream>>>(a); chk_scores<<<128, 256, 0, stream>>>(a); chk_route<<<512, 256, 0, stream>>>(a); chk_expert<<<64, 256, 0, stream>>>(a); chk_stamp<<<(M * D + 255) / 256, 256, 0, stream>>>(a);
#endif
    const hipError_t le = hipPeekAtLastError();
    if (le != hipSuccess) fprintf(stderr, "kernel_launch: launch failed: %s\n", hipGetErrorName(le));
}
```

```cpp
#include <hip/hip_runtime.h>
#include <cstdio>
#include <cstdint>
namespace pg8 {
#define PG8_LAS __attribute__((address_space(3)))
typedef unsigned short bf16_t;
typedef short bf16x8 __attribute__((ext_vector_type(8)));
typedef float f32x4 __attribute__((ext_vector_type(4)));
typedef unsigned u32x4 __attribute__((ext_vector_type(4)));
constexpr int BM = 256, BK = 64, HALF = 128, HTB = HALF * BK * 2  , STAGE_BYTES = 8 * HTB, NXCD = 8, WGM = 8;

__host__ __device__ __forceinline__ int lds_byte(int r, int c) { const int st = (r >> 4) * 2 + (c >> 5), rr = r & 15, cc = c & 31, ob = rr * 64 + cc * 2; return st * 1024 + (ob ^ (((ob >> 9) & 1) << 5)); }
__host__ __device__ __forceinline__ void stage_rc(int b, int& R, int& C) { const int st = b / 1024, sb = b % 1024, swz = sb ^ (((sb >> 9) & 1) << 5); R = (st >> 1) * 16 + swz / 64; C = (st & 1) * 32 + (swz % 64) / 2; }
__host__ __device__ __forceinline__ int perm32(int rho) { const int n = rho >> 4, i = rho & 15; return 8 * (i >> 2) + 4 * n + (i & 3); }

struct Unit { int pm, pn; };
struct Gemm { const bf16_t* A; const bf16_t* Bt; int M, N, K; };

struct StaticOrder {
    int nM, nN, nwg, G, c;
    __host__ __device__ void init(int M, int N, int G_, int c_) { nM = M / BM; nN = N / BM; nwg = nM * nN; G = G_; c = c_; }
    __host__ __device__ bool next(int i, Unit& u) const {
        const long L = (long)i * G + c; if (L >= nwg) return false;
        int wgid = (int)L; { const int q = nwg / NXCD, r = nwg % NXCD, xcd = wgid % NXCD, off = wgid / NXCD; wgid = (xcd < r ? xcd * (q + 1) : r * (q + 1) + (xcd - r) * q) + off; }
        const int nig = WGM * nN, gid = wgid / nig, fm = gid * WGM, gsz = (nM - fm) < WGM ? (nM - fm) : WGM;
        u.pm = fm + ((wgid % nig) % gsz); u.pn = (wgid % nig) / gsz; return true;
    }
    __device__ __forceinline__ void a_ready(const Unit&) const {}
    __device__ __forceinline__ void done(const Unit&) const {}
};

__device__ __forceinline__ unsigned cvt_pk_bf16(float lo, float hi) { unsigned r; asm volatile("v_cvt_pk_bf16_f32 %0, %1, %2" : "=v"(r) : "v"(lo), "v"(hi)); return r; }
typedef unsigned u32x4 __attribute__((ext_vector_type(4)));
struct EpiBf16 {
    static constexpr bool PERM = true, AFTER_DRAIN = false;
    bf16_t* O; int ldc;
    __device__ __forceinline__ void operator()(const f32x4 (&acc)[2][2][4][2], const Unit& u, int wr, int wc, int fr, int fq) const {
        const int row0 = u.pm * BM + wr * 64 + fr; const int col0 = u.pn * BM + wc * 32 + 8 * fq;
#pragma unroll
        for (int ai = 0; ai < 2; ++ai)
#pragma unroll
            for (int m = 0; m < 4; ++m) { bf16_t* rowp = O + (size_t)(row0 + ai * HALF + m * 16) * ldc + col0;
#pragma unroll
                for (int bj = 0; bj < 2; ++bj) { const f32x4 v0 = acc[ai][bj][m][0], v1 = acc[ai][bj][m][1];
                    u32x4 w; w.x = cvt_pk_bf16(v0[0], v0[1]); w.y = cvt_pk_bf16(v0[2], v0[3]); w.z = cvt_pk_bf16(v1[0], v1[1]); w.w = cvt_pk_bf16(v1[2], v1[3]);
                    *(u32x4*)(rowp + bj * HALF) = w; } }
    }
};
struct EpiBf16QK {
    static constexpr bool PERM = true, AFTER_DRAIN = false;
    bf16_t* O; int ldc; int q_lo, q_hi, k_lo, k_hi; const float* gq; const float* gk; float qmul; PG8_LAS float* xs;
    __device__ __forceinline__ void operator()(const f32x4 (&acc)[2][2][4][2], const Unit& u, int wr, int wc, int fr, int fq) const {
        const int row0 = u.pm * BM + wr * 64 + fr; const int col0 = u.pn * BM + wc * 32 + 8 * fq;
        const bool isq = u.pn >= q_lo && u.pn < q_hi, isk = u.pn >= k_lo && u.pn < k_hi;
        if (!(isq || isk)) {
#pragma unroll
            for (int ai = 0; ai < 2; ++ai)
#pragma unroll
                for (int m = 0; m < 4; ++m) { bf16_t* rowp = O + (size_t)(row0 + ai * HALF + m * 16) * ldc + col0;
#pragma unroll
                    for (int bj = 0; bj < 2; ++bj) { const f32x4 v0 = acc[ai][bj][m][0], v1 = acc[ai][bj][m][1];
                        u32x4 w; w.x = cvt_pk_bf16(v0[0], v0[1]); w.y = cvt_pk_bf16(v0[2], v0[3]); w.z = cvt_pk_bf16(v1[0], v1[1]); w.w = cvt_pk_bf16(v1[2], v1[3]);
                        *(u32x4*)(rowp + bj * HALF) = w; } }
            return;
        }
        float ssq[2][4][2];
#pragma unroll
        for (int ai = 0; ai < 2; ++ai)
#pragma unroll
            for (int m = 0; m < 4; ++m)
#pragma unroll
                for (int bj = 0; bj < 2; ++bj) { const f32x4 v0 = acc[ai][bj][m][0], v1 = acc[ai][bj][m][1];
                    float s = (v0[0] * v0[0] + v0[1] * v0[1]) + (v0[2] * v0[2] + v0[3] * v0[3]) + (v1[0] * v1[0] + v1[1] * v1[1]) + (v1[2] * v1[2] + v1[3] * v1[3]);
                    s += __shfl_xor(s, 16); s += __shfl_xor(s, 32); ssq[ai][m][bj] = s;
                    if (fq == 0) xs[(ai * HALF + wr * 64 + m * 16 + fr) * 8 + bj * 4 + wc] = s; }
        asm volatile("s_waitcnt lgkmcnt(0)" ::: "memory"); __builtin_amdgcn_s_barrier(); asm volatile("" ::: "memory");
        const float* g = isq ? gq : gk; const float gm = isq ? qmul : 1.f;
        const int d0 = (wc & 1) * 32 + 8 * fq;
        const f32x4 g0 = *(const f32x4*)(g + d0) * gm, g1 = *(const f32x4*)(g + d0 + 4) * gm;
#pragma unroll
        for (int ai = 0; ai < 2; ++ai)
#pragma unroll
            for (int m = 0; m < 4; ++m) { bf16_t* rowp = O + (size_t)(row0 + ai * HALF + m * 16) * ldc + col0;
#pragma unroll
                for (int bj = 0; bj < 2; ++bj) { const float tot = ssq[ai][m][bj] + xs[(ai * HALF + wr * 64 + m * 16 + fr) * 8 + bj * 4 + (wc ^ 1)];
                    const float rs = __builtin_amdgcn_rsqf(tot * (1.f / 64.f) + 1e-6f);
                    const f32x4 v0 = acc[ai][bj][m][0] * rs * g0, v1 = acc[ai][bj][m][1] * rs * g1;
                    u32x4 w; w.x = cvt_pk_bf16(v0[0], v0[1]); w.y = cvt_pk_bf16(v0[2], v0[3]); w.z = cvt_pk_bf16(v1[0], v1[1]); w.w = cvt_pk_bf16(v1[2], v1[3]);
                    *(u32x4*)(rowp + bj * HALF) = w; } }
    }
};
struct EpiResid {
    static constexpr bool PERM = false, AFTER_DRAIN = false;
    const float* base; float* out; const float* gate; float dbg;
    __device__ __forceinline__ void operator()(const f32x4 (&acc)[2][2][4][2], const Unit& u, int wr, int wc, int fr, int fq) const {
        const int col0 = u.pn * BM + wc * 32 + 4 * fq; const int b = (u.pm * BM) >> 13;
#pragma unroll
        for (int bj = 0; bj < 2; ++bj)
#pragma unroll
            for (int n = 0; n < 2; ++n) { const f32x4 gv = *(const f32x4*)(gate + (size_t)b * 6144 + col0 + bj * HALF + n * 16);
#pragma unroll
                for (int ai = 0; ai < 2; ++ai)
#pragma unroll
                    for (int m = 0; m < 4; ++m) { const size_t off = (size_t)(u.pm * BM + ai * HALF + wr * 64 + m * 16 + fr) * 1024 + col0 + bj * HALF + n * 16;
                        const f32x4 bs = *(const f32x4*)(base + off); *(f32x4*)(out + off) = bs + gv * acc[ai][bj][m][n] * dbg; } }
    }
};

template <class Epi, class Sched, bool ALIGN_EPI = false, bool SP2 = false>
__device__ __forceinline__ void gemm_phase(PG8_LAS unsigned char* lds, const Gemm g, const Sched& S, const Epi& E) {
    const int tid = threadIdx.x, wid = __builtin_amdgcn_readfirstlane(tid >> 6), lane = tid & 63, wr = wid >> 2, wc = wid & 3, fr = lane & 15, fq = lane >> 4;
    const int K = g.K, nt = K / BK;
    unsigned voffA[2], voffB[2];
#pragma unroll
    for (int i = 0; i < 2; ++i) { int R, C; stage_rc(tid * 16 + i * 8192, R, C); const int Rb = Epi::PERM ? ((R & ~31) + perm32(R & 31)) : R;
        voffA[i] = (unsigned)(R * K + C) * 2u; voffB[i] = (unsigned)(Rb * K + C) * 2u; }
    const size_t kstep = (size_t)(BK * 2);
    const size_t hstep = (size_t)HALF * K * 2;
    const size_t tstep = 2 * hstep;
    const unsigned ldsw = (unsigned)wid * 1024u;
    const int aoff = lds_byte(wr * 64 + fr, fq * 8), boff = lds_byte(wc * 32 + fr, fq * 8);
#define PG8_SA(b, h) (((b) * 2 + (h)) * HTB)
#define PG8_SB(b, h) ((4 + (b) * 2 + (h)) * HTB)
#define PG8_STAGE(bufoff, gbase, voff) do { _Pragma("unroll") for (int _i = 0; _i < 2; ++_i) \
        __builtin_amdgcn_global_load_lds((const unsigned*)((const char*)(gbase) + (voff)[_i]), (PG8_LAS unsigned*)(lds + (bufoff) + ldsw + _i * 8192), 16, 0, 0); } while (0)
#define PG8_LDA(dst, b, h) do { _Pragma("unroll") for (int m = 0; m < 4; ++m) _Pragma("unroll") for (int k = 0; k < 2; ++k) dst[m][k] = *(const PG8_LAS bf16x8*)(lds + PG8_SA(b, h) + aoff + m * 2048 + k * 1024); } while (0)
#define PG8_LDB(dst, b, h) do { _Pragma("unroll") for (int n = 0; n < 2; ++n) _Pragma("unroll") for (int k = 0; k < 2; ++k) dst[n][k] = *(const PG8_LAS bf16x8*)(lds + PG8_SB(b, h) + boff + n * 2048 + k * 1024); } while (0)
#define PG8_MMA(ai, bj, At, Bt) do { __builtin_amdgcn_s_setprio(1); _Pragma("unroll") for (int m = 0; m < 4; ++m) _Pragma("unroll") for (int n = 0; n < 2; ++n) _Pragma("unroll") for (int k = 0; k < 2; ++k) \
        acc[ai][bj][m][n] = __builtin_amdgcn_mfma_f32_16x16x32_bf16(Bt[n][k], At[m][k], acc[ai][bj][m][n], 0, 0, 0); __builtin_amdgcn_s_setprio(0); } while (0)
#define PG8_WAIT_V(n) asm volatile("s_waitcnt vmcnt(" #n ")" ::: "memory")
#define PG8_WAIT_L(n) asm volatile("s_waitcnt lgkmcnt(" #n ")" ::: "memory")
#define PG8_BAR __builtin_amdgcn_s_barrier()
#define PG8_SCHED __builtin_amdgcn_sched_barrier(0)
    Unit cur, nxt; int ui = 0;
    if (!S.next(0, cur)) return;
    f32x4 acc[2][2][4][2];
#pragma unroll
    for (int a = 0; a < 2; ++a)
#pragma unroll
        for (int b = 0; b < 2; ++b)
#pragma unroll
            for (int m = 0; m < 4; ++m)
#pragma unroll
                for (int n = 0; n < 2; ++n) acc[a][b][m][n] = (f32x4){0.f, 0.f, 0.f, 0.f};
    bf16x8 At[4][2], B0[2][2], B1[2][2];
    const char* cA = (const char*)g.A + (size_t)cur.pm * tstep; const char* cB = (const char*)g.Bt + (size_t)cur.pn * tstep;
    S.a_ready(cur);
    if constexpr (SP2) {
        PG8_STAGE(PG8_SB(0, 0), cB, voffB); PG8_STAGE(PG8_SB(0, 1), cB + hstep, voffB); PG8_STAGE(PG8_SA(0, 0), cA, voffA); PG8_STAGE(PG8_SA(0, 1), cA + hstep, voffA);
        if (wr == 1) PG8_BAR;
        PG8_WAIT_V(2); PG8_BAR;
        PG8_STAGE(PG8_SB(1, 0), cB + kstep, voffB); PG8_STAGE(PG8_SA(1, 0), cA + kstep, voffA); PG8_STAGE(PG8_SB(1, 1), cB + hstep + kstep, voffB);
        PG8_WAIT_V(6); PG8_BAR;
    } else {
        PG8_STAGE(PG8_SB(0, 0), cB, voffB); PG8_STAGE(PG8_SA(0, 0), cA, voffA); PG8_STAGE(PG8_SB(0, 1), cB + hstep, voffB); PG8_STAGE(PG8_SA(0, 1), cA + hstep, voffA);
        if (wr == 1) PG8_BAR;
        PG8_WAIT_V(4); PG8_BAR;
        PG8_STAGE(PG8_SB(1, 0), cB + kstep, voffB); PG8_STAGE(PG8_SA(1, 0), cA + kstep, voffA); PG8_STAGE(PG8_SB(1, 1), cB + hstep + kstep, voffB);
        PG8_WAIT_V(6); PG8_BAR;
    }
    for (;;) {
        const bool has_next = S.next(ui + 1, nxt);
        const char* nA = has_next ? (const char*)g.A + (size_t)nxt.pm * tstep : cA; const char* nB = has_next ? (const char*)g.Bt + (size_t)nxt.pn * tstep : cB;
        for (int t = 0; t < nt; t += 2) {
            const bool last = (t == nt - 2);
            const char* a1 = cA + (size_t)(t + 1) * kstep;
            const char* a2 = last ? nA : cA + (size_t)(t + 2) * kstep; const char* b2 = last ? nB : cB + (size_t)(t + 2) * kstep;
            const char* a3 = a2 + kstep; const char* b3 = b2 + kstep;
            if (last && has_next) S.a_ready(nxt);
            if constexpr (SP2) {
            PG8_LDB(B0, 0, 0); PG8_LDB(B1, 0, 1); PG8_SCHED; PG8_LDA(At, 0, 0); PG8_STAGE(PG8_SA(1, 1), a1 + hstep, voffA);
            PG8_WAIT_V(8); PG8_WAIT_L(0); PG8_BAR; PG8_MMA(0, 0, At, B0); PG8_MMA(0, 1, At, B1); PG8_BAR; PG8_SCHED;
            PG8_LDA(At, 0, 1); PG8_STAGE(PG8_SB(0, 0), b2, voffB); PG8_STAGE(PG8_SB(0, 1), b2 + hstep, voffB); PG8_STAGE(PG8_SA(0, 0), a2, voffA);
            PG8_WAIT_V(8); PG8_WAIT_L(0); PG8_BAR; PG8_MMA(1, 0, At, B0); PG8_MMA(1, 1, At, B1); PG8_BAR; PG8_SCHED;
            PG8_LDB(B0, 1, 0); PG8_LDB(B1, 1, 1); PG8_SCHED; PG8_LDA(At, 1, 0); PG8_STAGE(PG8_SA(0, 1), a2 + hstep, voffA);
            PG8_WAIT_V(8); PG8_WAIT_L(0); PG8_BAR; PG8_MMA(0, 0, At, B0); PG8_MMA(0, 1, At, B1); PG8_BAR; PG8_SCHED;
            PG8_LDA(At, 1, 1); PG8_STAGE(PG8_SB(1, 0), b3, voffB); PG8_STAGE(PG8_SB(1, 1), b3 + hstep, voffB); PG8_STAGE(PG8_SA(1, 0), a3, voffA);
            PG8_WAIT_V(8); PG8_WAIT_L(0); PG8_BAR; PG8_MMA(1, 0, At, B0); PG8_MMA(1, 1, At, B1); PG8_BAR; PG8_SCHED;
            } else {
            PG8_LDB(B0, 0, 0); PG8_SCHED; PG8_LDA(At, 0, 0); PG8_STAGE(PG8_SA(1, 1), a1 + hstep, voffA);
            PG8_WAIT_L(8); PG8_BAR; PG8_WAIT_L(0); PG8_MMA(0, 0, At, B0); PG8_BAR; PG8_SCHED;
            PG8_LDB(B1, 0, 1); PG8_STAGE(PG8_SB(0, 0), b2, voffB);
            PG8_BAR; PG8_WAIT_L(0); PG8_MMA(0, 1, At, B1); PG8_BAR;
            PG8_LDA(At, 0, 1); PG8_STAGE(PG8_SA(0, 0), a2, voffA);
            PG8_BAR; PG8_WAIT_L(0); PG8_MMA(1, 0, At, B0); PG8_BAR; PG8_SCHED;
            PG8_STAGE(PG8_SB(0, 1), b2 + hstep, voffB);
            PG8_WAIT_V(6); PG8_BAR; PG8_MMA(1, 1, At, B1); PG8_BAR;
            PG8_LDB(B0, 1, 0); PG8_SCHED; PG8_LDA(At, 1, 0); PG8_STAGE(PG8_SA(0, 1), a2 + hstep, voffA);
            PG8_WAIT_L(8); PG8_BAR; PG8_WAIT_L(0); PG8_MMA(0, 0, At, B0); PG8_BAR; PG8_SCHED;
            PG8_LDB(B1, 1, 1); PG8_STAGE(PG8_SB(1, 0), b3, voffB);
            PG8_BAR; PG8_WAIT_L(0); PG8_MMA(0, 1, At, B1); PG8_BAR;
            PG8_LDA(At, 1, 1); PG8_STAGE(PG8_SA(1, 0), a3, voffA);
            PG8_BAR; PG8_WAIT_L(0); PG8_MMA(1, 0, At, B0); PG8_BAR; PG8_SCHED;
            PG8_STAGE(PG8_SB(1, 1), b3 + hstep, voffB);
            PG8_WAIT_V(6); PG8_BAR; PG8_MMA(1, 1, At, B1); PG8_BAR;
            }
        }
        if constexpr (ALIGN_EPI) { if (wr == 0) PG8_BAR; }
        if constexpr (!Epi::AFTER_DRAIN) { E(acc, cur, wr, wc, fr, fq); S.done(cur); }
        if (!has_next) break;
#pragma unroll
        for (int a = 0; a < 2; ++a)
#pragma unroll
            for (int b = 0; b < 2; ++b)
#pragma unroll
                for (int m = 0; m < 4; ++m)
#pragma unroll
                    for (int n = 0; n < 2; ++n) acc[a][b][m][n] = (f32x4){0.f, 0.f, 0.f, 0.f};
        cur = nxt; cA = nA; cB = nB; ++ui;
        if constexpr (ALIGN_EPI) { if (wr == 1) PG8_BAR; }
    }
    PG8_WAIT_V(0);
    if constexpr (!ALIGN_EPI) { if (wr == 0) PG8_BAR; }
    PG8_BAR;
    if constexpr (Epi::AFTER_DRAIN) { E.fused(acc, cur, wr, wc, fr, fq, lds, wid, lane); S.done(cur); }
#undef PG8_SA
#undef PG8_SB
#undef PG8_STAGE
#undef PG8_LDA
#undef PG8_LDB
#undef PG8_MMA
#undef PG8_WAIT_V
#undef PG8_WAIT_L
#undef PG8_BAR
#undef PG8_SCHED
}
}
constexpr int NB = 4, SEQ = 8192, D = 1024, M = NB * SEQ;
constexpr int NZ0 = 3584, NZ1 = 3072, NQ = 2048, SRC_IN0 = 3592;
constexpr float EPS = 1e-6f;
constexpr int NWAVES = 8, NTHR = 512;
constexpr float LOG2E = 1.4426950408889634f;
constexpr size_t MiB = 1u << 20;
constexpr size_t WS_CTL = 0, CTL_ZERO_BYTES = 1 * MiB;
constexpr size_t WS_WIN0 = 1 * MiB, WS_WOUT0 = 8 * MiB, WS_WIN1 = 10 * MiB, WS_WOUT1 = 16 * MiB, WS_WQ = 18 * MiB;
constexpr size_t WS_KEYS = 26 * MiB, WS_MOD = WS_KEYS + 128 * 1024, WS_KMEAN = WS_MOD + 192 * 1024, WS_NLOC = WS_KMEAN + 256 * 1024,
                 WS_BEND = WS_NLOC + 512 * 1024, WS_MLOC = WS_BEND + 4096, WS_MPREV = WS_MLOC + 4096,
                 WS_ISU = 27 * MiB + 512 * 1024, WS_ISV = WS_ISU + 128 * 1024, WS_ORD = WS_ISV + 128 * 1024  ;
constexpr size_t WS_GATES = 28 * MiB;
constexpr size_t WS_UB = 32 * MiB  , WS_VB = 64 * MiB, WS_ACT = 96 * MiB  , WS_ACTS = 100 * MiB  , WS_DBGBUF = 112 * MiB, WS_XNY = 160 * MiB, WS_Z = 224 * MiB, WS_CLOC = 448 * MiB, WS_END = 512 * MiB;
constexpr size_t WS_QRY = WS_Z, WS_IDX = WS_Z + 128 * MiB, WS_GATE = WS_Z + 144 * MiB, WS_PART = 384 * MiB  ;
constexpr int CW_BAR = 4096, CW_QMOBA = 8192, CW_QDIFF = 8256, CW_QCVT0 = 8320, CW_QCVT1 = 8384;
constexpr float ALIBI_MARGIN = 27.03f;
constexpr int RING_BYTES = 139264;
constexpr int LDSCTL_OFF = RING_BYTES, MISC_OFF = LDSCTL_OFF + 320;
constexpr int LDS_BYTES = 147456;
static_assert(MISC_OFF + 128 <= LDS_BYTES, "LDS map");

#define GAS __attribute__((address_space(1)))
#define LAS __attribute__((address_space(3)))
typedef unsigned short bf16;
typedef unsigned v4u __attribute__((ext_vector_type(4)));
typedef unsigned v2u __attribute__((ext_vector_type(2)));
typedef float f32x4 __attribute__((ext_vector_type(4)));
typedef float f32x16 __attribute__((ext_vector_type(16)));
typedef short bf16x8 __attribute__((ext_vector_type(8)));
typedef short s16x4 __attribute__((ext_vector_type(4)));
typedef GAS unsigned gu32;
#define RLX_AGENT __ATOMIC_RELAXED, __HIP_MEMORY_SCOPE_AGENT
#define LDS_WAIT() asm volatile("s_waitcnt lgkmcnt(0)" ::: "memory")
#define VM_WAIT() asm volatile("s_waitcnt vmcnt(0)" ::: "memory")
__device__ __forceinline__ unsigned f2bf(float f) { unsigned u = __builtin_bit_cast(unsigned, f); return (u + 0x7fffu + ((u >> 16) & 1u)) >> 16; }
__device__ __forceinline__ unsigned pk2(float lo, float hi) { return f2bf(lo) | (f2bf(hi) << 16); }
__device__ __forceinline__ float bflo(unsigned w) { return __builtin_bit_cast(float, w << 16); }
__device__ __forceinline__ float bfhi(unsigned w) { return __builtin_bit_cast(float, w & 0xffff0000u); }
__device__ __forceinline__ float bf2f(bf16 h) { return __builtin_bit_cast(float, (unsigned)h << 16); }
__device__ __forceinline__ unsigned f2u(float x) { return __builtin_bit_cast(unsigned, x); }
__device__ __forceinline__ float u2f(unsigned x) { return __builtin_bit_cast(float, x); }
__device__ __forceinline__ float dot2bf(unsigned a, unsigned b, float acc) { typedef __bf16 bf2_ __attribute__((ext_vector_type(2))); return __builtin_amdgcn_fdot2_f32_bf16(__builtin_bit_cast(bf2_, a), __builtin_bit_cast(bf2_, b), acc, false); }
__device__ __forceinline__ float wave_sum(float v) {
#pragma unroll
    for (int o = 1; o < 64; o <<= 1) v += __shfl_xor(v, o);
    return v;
}
__device__ __forceinline__ float wave_max(float v) {
#pragma unroll
    for (int o = 1; o < 64; o <<= 1) v = fmaxf(v, __shfl_xor(v, o));
    return v;
}
__device__ __forceinline__ float silu_f(float x) { return x / (1.f + __expf(-x)); }
__device__ __forceinline__ float sigmoid_f(float x) { return 1.f / (1.f + __expf(-x)); }
__device__ __forceinline__ float logsigmoid_f(float x) { return fminf(x, 0.f) - log1pf(__expf(-fabsf(x))); }
struct Args { const float* in[24]; float* out; unsigned char* ws; int ph_lo, ph_hi; };
#define XB_TMO      128
#define XB_XCNT(j)  (256  + 64 * (j))
#define XB_XSUB(j)  (1280 + 64 * (j))
#define XB_XGEN(j)  (2304 + 64 * (j))
#define XB_TOP      3328
#define XB_TOPGEN   3392
#define XCD_BAR_WORDS 3456
#define XB_SPIN_CAP (1u << 18)

__device__ __forceinline__ unsigned xb_ld(unsigned* p)              { return __hip_atomic_load(p, __ATOMIC_RELAXED, __HIP_MEMORY_SCOPE_AGENT); }
__device__ __forceinline__ unsigned xb_add(unsigned* p, unsigned v) { return __hip_atomic_fetch_add(p, v, __ATOMIC_RELAXED, __HIP_MEMORY_SCOPE_AGENT); }
__device__ __forceinline__ unsigned xb_xcc_id() { return (unsigned)__builtin_amdgcn_s_getreg((3 << 11) | 20) & 0xFu; }
#define XB_SPIN(cond, bar) do { unsigned _sp = 0; while (cond) { __builtin_amdgcn_s_sleep(1); \
    if ((++_sp & 255u) == 0u) { if (xb_ld(&(bar)[XB_TMO])) break; if (_sp > XB_SPIN_CAP) { atomicAdd(&(bar)[XB_TMO], 1u); break; } } } } while (0)

struct XcdBarrier {
    unsigned* bar; unsigned x;
    volatile LAS unsigned* st;
};

__device__ __forceinline__ XcdBarrier xcd_barrier_post(unsigned* bar, volatile LAS unsigned* st) {
    XcdBarrier b; b.bar = bar; b.x = xb_xcc_id(); b.st = st;
    if (threadIdx.x == 0) (void)xb_add(&bar[XB_XCNT(b.x)], 1u);
    return b;
}
__device__ __forceinline__ void xcd_barrier_complete(unsigned* bar, unsigned x, unsigned& nloc, unsigned& nx) {
    const unsigned G = gridDim.x * gridDim.y * gridDim.z;
    unsigned sum, cnt, mine, sp = 0u;
    for (;;) {
        sum = 0u; cnt = 0u; mine = 0u;
#pragma unroll
        for (unsigned j = 0; j < 16; ++j) { const unsigned c = xb_ld(&bar[XB_XCNT(j)]); sum += c; cnt += (c > 0u) ? 1u : 0u; mine = (j == x) ? c : mine; }
        if (sum == G) break;
        __builtin_amdgcn_s_sleep(1);
        if ((++sp & 255u) == 0u) { if (xb_ld(&bar[XB_TMO])) break; if (sp > XB_SPIN_CAP) { atomicAdd(&bar[XB_TMO], 1u); break; } }
    }
    nloc = mine > 0u ? mine : 1u; nx = cnt > 0u ? cnt : 1u;
}

__device__ __forceinline__ void xcd_barrier(const XcdBarrier& b) {
    asm volatile("s_waitcnt vmcnt(0)" ::: "memory");
    __syncthreads();
    if (threadIdx.x == 0) {
        unsigned* bar = b.bar;
        __builtin_amdgcn_s_waitcnt(0);
        unsigned nloc = b.st[0], nx = b.st[1];
        if (nloc == 0u) { xcd_barrier_complete(bar, b.x, nloc, nx); b.st[0] = nloc; b.st[1] = nx; }
        const unsigned old = xb_add(&bar[XB_XSUB(b.x)], 1u);
        const unsigned gen = old / nloc;
        if (old + 1u == (gen + 1u) * nloc) {
            __builtin_amdgcn_fence(__ATOMIC_RELEASE, "agent");
            asm volatile("s_waitcnt vmcnt(0)" ::: "memory");
            const unsigned og = xb_add(&bar[XB_TOP], 1u);
            const unsigned tg = og / nx;
            if (og + 1u == (tg + 1u) * nx) xb_add(&bar[XB_TOPGEN], 1u);
            else XB_SPIN(xb_ld(&bar[XB_TOPGEN]) == tg, bar);
            __builtin_amdgcn_fence(__ATOMIC_ACQUIRE, "agent");
            xb_add(&bar[XB_XGEN(b.x)], 1u);
            asm volatile("s_waitcnt vmcnt(0)" ::: "memory");
        } else {
            XB_SPIN(xb_ld(&bar[XB_XGEN(b.x)]) == gen, bar);
            __builtin_amdgcn_fence(__ATOMIC_ACQUIRE, "agent");
            asm volatile("s_waitcnt vmcnt(0)" ::: "memory");
        }
    }
    __syncthreads();
}
struct Frame {
    LAS unsigned char* lds;
    int tid, lane, wave, G, bid;
    float* out; unsigned char* ws;
};
#define WSP(T, off) ((T*)(F.ws + (off)))

__device__ __forceinline__ void p0_transpose_item(const float* W, int K, int ldw, int nblk, int thr, int shift, bf16* WT, LAS float* scr, int item, int lane) {
    const int kb = item / nblk, nb = item % nblk, k0 = 64 * kb, n0 = 32 * nb, ns = n0 + (n0 >= thr ? shift : 0);
#pragma unroll 8
    for (int i = 0; i < 32; ++i) { const int kk = 2 * i + (lane >> 5); scr[kk * 33 + (lane & 31)] = W[(size_t)(k0 + kk) * ldw + ns + (lane & 31)]; }
    LDS_WAIT(); asm volatile("" ::: "memory");
    const int c = lane & 7;
#pragma unroll
    for (int j = 0; j < 4; ++j) { const int n = (lane >> 3) + 8 * j; const LAS float* s = scr + (8 * c) * 33 + n;
        v4u o; o.x = pk2(s[0 * 33], s[1 * 33]); o.y = pk2(s[2 * 33], s[3 * 33]); o.z = pk2(s[4 * 33], s[5 * 33]); o.w = pk2(s[6 * 33], s[7 * 33]);
        *(GAS v4u*)(WT + (size_t)(n0 + n) * K + k0 + 8 * c) = o; }
    LDS_WAIT(); asm volatile("" ::: "memory");
}
__device__ __forceinline__ void cvt_f32_bf16_stream(const float* src, bf16* dst, size_t n8, size_t gtid, size_t gthreads) {
    for (size_t i = gtid; i < n8; i += gthreads) {
        const f32x4 a = *(const GAS f32x4*)(src + i * 8), b = *(const GAS f32x4*)(src + i * 8 + 4);
        v4u o; o.x = pk2(a.x, a.y); o.y = pk2(a.z, a.w); o.z = pk2(b.x, b.y); o.w = pk2(b.z, b.w);
        *(GAS v4u*)(dst + i * 8) = o; }
}
__device__ __forceinline__ void i8_row(const float* src_row, unsigned char* dst  , float* scale  , int er, int lane) {
    const float* r = src_row + 16 * lane;
    float x[16];
#pragma unroll
    for (int q4 = 0; q4 < 4; ++q4) { const f32x4 a = *(const GAS f32x4*)(r + 4 * q4); x[4 * q4] = a.x; x[4 * q4 + 1] = a.y; x[4 * q4 + 2] = a.z; x[4 * q4 + 3] = a.w; }
    float am = 0.f;
#pragma unroll
    for (int i = 0; i < 16; ++i) am = fmaxf(am, fabsf(x[i]));
    am = wave_max(am);
    const float inv = am > 1e-30f ? 127.f / am : 0.f;
    unsigned wd[4];
#pragma unroll
    for (int q4 = 0; q4 < 4; ++q4) { unsigned w = 0;
#pragma unroll
        for (int e = 0; e < 4; ++e) { const int qv = (int)rintf(x[4 * q4 + e] * inv); w |= ((unsigned)qv & 0xffu) << (8 * e); }
        wd[q4] = w; }
    v4u o; o.x = wd[0]; o.y = wd[1]; o.z = wd[2]; o.w = wd[3];
    *(GAS v4u*)(dst + ((size_t)((lane >> 3) * 16384 + er)) * 128 + 16 * (lane & 7)) = o;
    if (lane == 0) scale[er] = am * (1.f / 127.f);
}
__device__ __forceinline__ void i8_chunk(Frame& F, const Args& A, int layer, int c) {
    const int tbl = c >> 8, row0 = (c & 255) * 64 + F.wave * 8;
    const float* src = A.in[22 + tbl] + (size_t)layer * 16384 * 1024;
    unsigned char* dst = F.ws + (tbl ? WS_VB : WS_UB) + (size_t)layer * 8 * 16384 * 128;
    float* sc = WSP(float, tbl ? WS_ISV : WS_ISU) + layer * 16384;
    for (int i = 0; i < 8; ++i) i8_row(src + (size_t)(row0 + i) * 1024, dst, sc, row0 + i, F.lane);
}
__device__ __forceinline__ void p0_prologue(Frame& F, const Args& A) {
    {
        const float* c = A.in[1]; const float* aw = A.in[2]; const float* ab = A.in[3]; float* MOD = WSP(float, WS_MOD);
        LAS float* red = (LAS float*)F.lds;
        for (int item = F.bid; item < 192; item += F.G) {
            const int l = item / 96, n0 = (item % 96) * 64;
            float acc[4] = {0.f, 0.f, 0.f, 0.f};
            const int kbeg = F.wave * 128;
#pragma unroll 4
            for (int k = kbeg; k < kbeg + 128; ++k) {
                const float wv = aw[((size_t)l * 1024 + k) * 6144 + n0 + F.lane];
#pragma unroll
                for (int b = 0; b < 4; ++b) acc[b] += silu_f(c[b * 1024 + k]) * wv;
            }
#pragma unroll
            for (int b = 0; b < 4; ++b) red[(F.wave * 4 + b) * 64 + F.lane] = acc[b];
            __syncthreads();
            if (F.tid < 256) { const int b = F.tid >> 6, ln = F.tid & 63; float s = ab[l * 6144 + n0 + ln];
#pragma unroll
                for (int w = 0; w < 8; ++w) s += red[(w * 4 + b) * 64 + ln];
                MOD[(size_t)(l * 4 + b) * 6144 + n0 + ln] = s; }
            __syncthreads();
        }
    }
    if (F.bid == 0) {
        LAS unsigned* hist = (LAS unsigned*)F.lds;
        unsigned short* ORD = WSP(unsigned short, WS_ORD);
        for (int pass = 0; pass < 2; ++pass) {
            const int nunits = pass == 0 ? 2048 : 1024;
            if (F.tid < 160) hist[F.tid] = 0u;
            __syncthreads();
            for (int u = F.tid; u < nunits; u += NTHR) {
                const int q = pass == 0 ? (u & 63) : (u & 31), h = pass == 0 ? ((u >> 6) & 7) : ((u >> 5) & 7);
                const float dcut = 46.f * (float)(2 << h);
                int cost;
                if (pass == 0) { const int nt = 2 * q + 2; int lo = (int)ceilf(((float)(q * 128) - dcut - 63.f) * (1.f / 64.f)); if (lo < 0) lo = 0; cost = nt - lo; }
                else { int lo = (int)ceilf(((float)(q * 256) - dcut - 255.f) * (1.f / 256.f)); if (lo < 0) lo = 0; int nb = q - lo; if (nb > 3 * 8) nb = 24; cost = 4 * (nb + 1); }
                if (cost > 159) cost = 159;
                atomicAdd((unsigned*)(hist + (159 - cost)), 1u);
            }
            __syncthreads();
            if (F.tid == 0) { unsigned acc = 0; for (int i = 0; i < 160; ++i) { const unsigned c = hist[i]; hist[i] = acc; acc += c; } }
            __syncthreads();
            for (int u = F.tid; u < nunits; u += NTHR) {
                const int q = pass == 0 ? (u & 63) : (u & 31), h = pass == 0 ? ((u >> 6) & 7) : ((u >> 5) & 7);
                const float dcut = 46.f * (float)(2 << h);
                int cost;
                if (pass == 0) { const int nt = 2 * q + 2; int lo = (int)ceilf(((float)(q * 128) - dcut - 63.f) * (1.f / 64.f)); if (lo < 0) lo = 0; cost = nt - lo; }
                else { int lo = (int)ceilf(((float)(q * 256) - dcut - 255.f) * (1.f / 256.f)); if (lo < 0) lo = 0; int nb = q - lo; if (nb > 3 * 8) nb = 24; cost = 4 * (nb + 1); }
                if (cost > 159) cost = 159;
                const unsigned pos = atomicAdd((unsigned*)(hist + (159 - cost)), 1u);
                ORD[(pass == 0 ? 0 : 2048) + pos] = (unsigned short)u;
            }
            __syncthreads();
        }
    }
    {
        LAS float* scr = (LAS float*)(F.lds + F.wave * 8704);
        const int gw = F.bid * NWAVES + F.wave, NGW = F.G * NWAVES;
        constexpr int I_IN0 = 16 * (NZ0 / 32), I_OUT = 16 * 32, I_IN1 = 16 * (NZ1 / 32), I_Q = 16 * (NQ / 32);
        constexpr int NITEMS = I_IN0 + 2 * I_OUT + I_IN1 + 2 * I_Q;
        for (int it = gw; it < NITEMS; it += NGW) {
            int r = it;
            if (r < I_IN0) { p0_transpose_item(A.in[6], D, SRC_IN0, NZ0 / 32, 2048, 8, WSP(bf16, WS_WIN0), scr, r, F.lane); continue; } r -= I_IN0;
            if (r < I_OUT) { p0_transpose_item(A.in[13], D, D, 32, 1 << 30, 0, WSP(bf16, WS_WOUT0), scr, r, F.lane); continue; } r -= I_OUT;
            if (r < I_IN1) { p0_transpose_item(A.in[14], D, NZ1, NZ1 / 32, 1 << 30, 0, WSP(bf16, WS_WIN1), scr, r, F.lane); continue; } r -= I_IN1;
            if (r < I_OUT) { p0_transpose_item(A.in[19], D, D, 32, 1 << 30, 0, WSP(bf16, WS_WOUT1), scr, r, F.lane); continue; } r -= I_OUT;
            if (r < I_Q) { p0_transpose_item(A.in[20], D, NQ, NQ / 32, 1 << 30, 0, WSP(bf16, WS_WQ), scr, r, F.lane); continue; } r -= I_Q;
            p0_transpose_item(A.in[20] + (size_t)D * NQ, D, NQ, NQ / 32, 1 << 30, 0, WSP(bf16, WS_WQ) + (size_t)NQ * D, scr, r, F.lane);
        }
    }
    {
        const size_t gtid = (size_t)F.bid * NTHR + F.tid, gth = (size_t)F.G * NTHR;
        cvt_f32_bf16_stream(A.in[21], WSP(bf16, WS_KEYS), (size_t)2 * 2 * 128 * 128 / 8, gtid, gth);
    }
}

template <bool GATES>
__device__ __forceinline__ void norm_pass(Frame& F, const Args& A, const float* X, const float* g, const float* mod, int shc, bf16* XN) {
    LAS float* wgT = (LAS float*)F.lds;
    if (GATES) {
        const float* win = A.in[6];
        for (int i = F.tid; i < 8 * 1024; i += NTHR) { const int cg = i >> 10, k = i & 1023; wgT[i] = win[(size_t)k * SRC_IN0 + 2048 + cg]; }
        __syncthreads();
    }
    const int gw = F.bid * NWAVES + F.wave, NGW = F.G * NWAVES;
    for (int row = gw; row < M; row += NGW) {
        const int b = row >> 13;
        const GAS f32x4* xr = (const GAS f32x4*)(X + (size_t)row * D) + F.lane;
        f32x4 v[4]; float ss = 0.f;
#pragma unroll
        for (int j = 0; j < 4; ++j) { v[j] = xr[64 * j]; ss += (v[j].x * v[j].x + v[j].y * v[j].y) + (v[j].z * v[j].z + v[j].w * v[j].w); }
        const float rstd = rsqrtf(wave_sum(ss) * (1.f / D) + EPS);
        const float* shp = mod + (size_t)b * 6144 + shc * 1024; const float* scp = shp + 1024;
#pragma unroll
        for (int j = 0; j < 4; ++j) { const int c = 4 * F.lane + 256 * j;
            const f32x4 gg = *(const f32x4*)(g + c), sc = *(const f32x4*)(scp + c), sh = *(const f32x4*)(shp + c);
            v[j] = v[j] * rstd * gg * (sc + 1.f) + sh;
            v2u o; o.x = pk2(v[j].x, v[j].y); o.y = pk2(v[j].z, v[j].w);
            *(GAS v2u*)(XN + (size_t)row * D + c) = o; }
        if (GATES) {
            float* GT = WSP(float, WS_GATES);
#pragma unroll
            for (int cg = 0; cg < 8; ++cg) { float p = 0.f;
#pragma unroll
                for (int j = 0; j < 4; ++j) { const f32x4 w = *(const LAS f32x4*)(wgT + cg * 1024 + 4 * F.lane + 256 * j); p += (v[j].x * w.x + v[j].y * w.y) + (v[j].z * w.z + v[j].w * w.w); }
                p = wave_sum(p);
                if (F.lane == 0) GT[(size_t)row * 8 + cg] = p + (cg < 4 ? A.in[8][cg] : A.in[9][cg - 4]); }
        }
    }
}

__device__ __forceinline__ void qknorm_unit(Frame& F, bf16* Z, int ldz, int row0, int col0, const float* g, float gmul, float* kmean  ) {
    const int c = col0 + 8 * F.lane, d0 = (8 * F.lane) & 63;
    float gv[8];
#pragma unroll
    for (int i = 0; i < 8; ++i) gv[i] = g[d0 + i] * gmul;
    float ks[8] = {0.f, 0.f, 0.f, 0.f, 0.f, 0.f, 0.f, 0.f};
    for (int r = 0; r < 32; ++r) {
        bf16* p = Z + (size_t)(row0 + F.wave * 32 + r) * ldz + c;
        const v4u w = *(const GAS v4u*)p;
        float x[8] = {bflo(w.x), bfhi(w.x), bflo(w.y), bfhi(w.y), bflo(w.z), bfhi(w.z), bflo(w.w), bfhi(w.w)};
        float ss = 0.f;
#pragma unroll
        for (int i = 0; i < 8; ++i) ss += x[i] * x[i];
        ss += __shfl_xor(ss, 1); ss += __shfl_xor(ss, 2); ss += __shfl_xor(ss, 4);
        const float rstd = rsqrtf(ss * (1.f / 64.f) + EPS);
#pragma unroll
        for (int i = 0; i < 8; ++i) { x[i] = x[i] * rstd * gv[i]; ks[i] += x[i]; }
        v4u o; o.x = pk2(x[0], x[1]); o.y = pk2(x[2], x[3]); o.z = pk2(x[4], x[5]); o.w = pk2(x[6], x[7]);
        *(GAS v4u*)p = o;
    }
    if (kmean) {
        LAS float* red = (LAS float*)F.lds;
#pragma unroll
        for (int i = 0; i < 8; ++i) red[F.wave * 512 + 8 * F.lane + i] = ks[i];
        __syncthreads();
        { float s = 0.f;
#pragma unroll
          for (int w = 0; w < 8; ++w) s += red[w * 512 + F.tid];
          kmean[(size_t)(F.tid >> 6) * (32 * 64) + (F.tid & 63)] = s * (1.f / 256.f); }
        __syncthreads();
    }
}

__device__ __forceinline__ void kmean_unit(Frame& F, const bf16* Z, int ldz, int row0, int col0, float* kmean) {
    const int c = col0 + 8 * F.lane;
    float ks[8] = {0.f, 0.f, 0.f, 0.f, 0.f, 0.f, 0.f, 0.f};
#pragma unroll 4
    for (int r = 0; r < 32; ++r) {
        const v4u w = *(const GAS v4u*)(Z + (size_t)(row0 + F.wave * 32 + r) * ldz + c);
        ks[0] += bflo(w.x); ks[1] += bfhi(w.x); ks[2] += bflo(w.y); ks[3] += bfhi(w.y); ks[4] += bflo(w.z); ks[5] += bfhi(w.z); ks[6] += bflo(w.w); ks[7] += bfhi(w.w);
    }
    LAS float* red = (LAS float*)F.lds;
#pragma unroll
    for (int i = 0; i < 8; ++i) red[F.wave * 512 + 8 * F.lane + i] = ks[i];
    __syncthreads();
    { float s = 0.f;
#pragma unroll
      for (int w = 0; w < 8; ++w) s += red[w * 512 + F.tid];
      kmean[(size_t)(F.tid >> 6) * (32 * 64) + (F.tid & 63)] = s * (1.f / 256.f); }
    __syncthreads();
}
constexpr int KSTRB = 144;
template <int DV> struct VStr { static constexpr int B = (DV == 64) ? 192 : 320; };
typedef short v4i16_t __attribute__((ext_vector_type(4)));
__device__ __forceinline__ s16x4 vtr(const LAS unsigned char* p) { return __builtin_bit_cast(s16x4, __builtin_amdgcn_ds_read_tr16_b64_v4i16((LAS v4i16_t*)p)); }
__device__ __forceinline__ unsigned cvtpk(float lo, float hi) { typedef float f2 __attribute__((ext_vector_type(2))); typedef __bf16 b2 __attribute__((ext_vector_type(2)));
    f2 v = {lo, hi}; b2 b = __builtin_convertvector(v, b2); return __builtin_bit_cast(unsigned, b); }
__device__ __forceinline__ float xhalf(float v) {
    auto rr = __builtin_amdgcn_permlane32_swap(__builtin_bit_cast(unsigned, v), __builtin_bit_cast(unsigned, v), false, false);
    const unsigned r0 = rr[0], r1 = rr[1]; return u2f((threadIdx.x & 32) ? r0 : r1);
}
template <int DV> struct AttnSt { f32x16 o[DV / 32]; float m, l; };
template <int DV> __device__ __forceinline__ void attn_init(AttnSt<DV>& st) {
#pragma unroll
    for (int t = 0; t < DV / 32; ++t)
#pragma unroll
        for (int r = 0; r < 16; ++r) st.o[t][r] = 0.f;
    st.m = -1e30f; st.l = 0.f;
}
template <int DV>
__device__ __forceinline__ void attn_tile(AttnSt<DV>& st, const LAS unsigned char* Kt, const LAS unsigned char* Vt, const bf16x8 (&qf)[4], float sc2, float sl2, int tq, int kt0, bool diag, bool rowok, int lane, const int probe = 0) {
    const int r32 = lane & 31, hi = lane >> 5;
    const int kb = kt0 + 4 * hi;
    const float c0 = -sl2 * (float)(tq - kb);
    f32x16 s0, s1;
#pragma unroll
    for (int r = 0; r < 16; ++r) { const int ko = (r & 3) + 8 * (r >> 2); s0[r] = c0 + sl2 * (float)ko; s1[r] = c0 + sl2 * (float)(ko + 32); }
    const LAS unsigned char* kp = Kt + r32 * KSTRB + hi * 16;
#pragma unroll
    for (int ks = 0; ks < 4; ++ks) {
        const bf16x8 k0 = *(const LAS bf16x8*)(kp + ks * 32), k1 = *(const LAS bf16x8*)(kp + 32 * KSTRB + ks * 32);
        s0 = __builtin_amdgcn_mfma_f32_32x32x16_bf16(k0, qf[ks], s0, 0, 0, 0);
        s1 = __builtin_amdgcn_mfma_f32_32x32x16_bf16(k1, qf[ks], s1, 0, 0, 0);
    }
    if (diag || !rowok) {
#pragma unroll
        for (int r = 0; r < 16; ++r) { const int ko = (r & 3) + 8 * (r >> 2);
            if (!rowok || kb + ko > tq) s0[r] = -INFINITY;
            if (!rowok || kb + ko + 32 > tq) s1[r] = -INFINITY; }
    }
    if (probe != 1) {
    float mx = fmaxf(s0[0], s1[0]);
#pragma unroll
    for (int r = 1; r < 16; ++r) mx = fmaxf(mx, fmaxf(s0[r], s1[r]));
    mx = fmaxf(mx, xhalf(mx));
    if (__any(mx > st.m)) {
        const float mn = fmaxf(st.m, mx);
        const float alpha = __builtin_amdgcn_exp2f(st.m - mn);
        st.m = mn; st.l *= alpha;
#pragma unroll
        for (int t = 0; t < DV / 32; ++t)
#pragma unroll
            for (int r = 0; r < 16; ++r) st.o[t][r] *= alpha;
    }
    const float mn = st.m;
    float ps = 0.f;
#pragma unroll
    for (int r = 0; r < 16; ++r) { s0[r] = __builtin_amdgcn_exp2f(s0[r] - mn); s1[r] = __builtin_amdgcn_exp2f(s1[r] - mn); ps += s0[r] + s1[r]; }
    st.l += ps;
    }
    bf16x8 pf[2][2];
#pragma unroll
    for (int s = 0; s < 2; ++s) {
        v4u a, b;
        a.x = cvtpk(s0[8 * s + 0], s0[8 * s + 1]); a.y = cvtpk(s0[8 * s + 2], s0[8 * s + 3]); a.z = cvtpk(s0[8 * s + 4], s0[8 * s + 5]); a.w = cvtpk(s0[8 * s + 6], s0[8 * s + 7]);
        b.x = cvtpk(s1[8 * s + 0], s1[8 * s + 1]); b.y = cvtpk(s1[8 * s + 2], s1[8 * s + 3]); b.z = cvtpk(s1[8 * s + 4], s1[8 * s + 5]); b.w = cvtpk(s1[8 * s + 6], s1[8 * s + 7]);
        pf[0][s] = __builtin_bit_cast(bf16x8, a); pf[1][s] = __builtin_bit_cast(bf16x8, b);
    }
    constexpr int VS = VStr<DV>::B;
    const int g = lane >> 4, i16 = lane & 15;
    const LAS unsigned char* vp = Vt + (4 * (g >> 1) + (i16 >> 2)) * VS + (16 * (g & 1) + 4 * (i16 & 3)) * 2;
    if (probe != 2)
#pragma unroll
    for (int kbk = 0; kbk < 2; ++kbk)
#pragma unroll
        for (int s = 0; s < 2; ++s)
#pragma unroll
            for (int t = 0; t < DV / 32; ++t) {
                const s16x4 lo = vtr(vp + (kbk * 32 + 16 * s) * VS + t * 64), h8 = vtr(vp + (kbk * 32 + 16 * s + 8) * VS + t * 64);
                const bf16x8 va = {lo[0], lo[1], lo[2], lo[3], h8[0], h8[1], h8[2], h8[3]};
                st.o[t] = __builtin_amdgcn_mfma_f32_32x32x16_bf16(va, pf[kbk][s], st.o[t], 0, 0, 0);
            }
}
template <int NK, int DV> struct TileRegs { v4u k[NK]; v4u v[DV / 64]; };
template <int NK, int DV>
__device__ __forceinline__ void tile_load(TileRegs<NK, DV>& R, const bf16* Z, int ldz, size_t zrow0, int kcol, int vcol, int tid) {
#pragma unroll
    for (int i = 0; i < NK; ++i) { const int ch = tid + 512 * i; const int row = ch / (8 * NK), cc = ch % (8 * NK);
        R.k[i] = *(const GAS v4u*)(Z + (zrow0 + row) * ldz + kcol + cc * 8); }
#pragma unroll
    for (int i = 0; i < DV / 64; ++i) { const int ch = tid + 512 * i; const int row = ch / (DV / 8), cc = ch % (DV / 8);
        R.v[i] = *(const GAS v4u*)(Z + (zrow0 + row) * ldz + vcol + cc * 8); }
}
template <int NK, int DV>
__device__ __forceinline__ void tile_store(const TileRegs<NK, DV>& R, LAS unsigned char* Kt  , LAS unsigned char* Vt, int tid) {
#pragma unroll
    for (int i = 0; i < NK; ++i) { const int ch = tid + 512 * i; const int row = ch / (8 * NK), cc = ch % (8 * NK);
        *(LAS v4u*)(Kt + (cc >> 3) * (64 * KSTRB) + row * KSTRB + (cc & 7) * 16) = R.k[i]; }
#pragma unroll
    for (int i = 0; i < DV / 64; ++i) { const int ch = tid + 512 * i; const int row = ch / (DV / 8), cc = ch % (DV / 8);
        *(LAS v4u*)(Vt + row * VStr<DV>::B + cc * 16) = R.v[i]; }
}
__device__ __forceinline__ void moba_unit(Frame& F, int b, int h, int j, float tcut  ) {
    const bf16* Z = WSP(bf16, WS_Z); constexpr int ldz = NZ0;
    const int lane = F.lane, w = F.wave, r32 = lane & 31, hi = lane >> 5, tid = F.tid;
    const size_t rowb = (size_t)b * SEQ;
    const int qpos = j * 256 + w * 32 + r32;
    const int qcol = 2048 + h * 64, kcol = 2560 + h * 64, vcol = 3072 + h * 64;
    LAS unsigned char* lds = F.lds;
    constexpr int BUFB = 64 * KSTRB + 64 * VStr<64>::B;
    LAS unsigned char* kmh = lds + 2 * BUFB;
    LAS unsigned char* kml = lds + 2 * BUFB + 32 * KSTRB;
    LAS unsigned* msk = (LAS unsigned*)(lds + 2 * BUFB + 64 * KSTRB);
    { const float* KM = WSP(float, WS_KMEAN) + (size_t)((b * 8 + h) * 32) * 64; const f32x4 x = *(const f32x4*)(KM + 4 * tid);
      const int n = tid >> 4, d0 = (tid & 15) * 4;
      const unsigned h0 = f2bf(x.x), h1 = f2bf(x.y), h2 = f2bf(x.z), h3 = f2bf(x.w);
      v2u hv; hv.x = h0 | (h1 << 16); hv.y = h2 | (h3 << 16);
      v2u lv; lv.x = pk2(x.x - u2f(h0 << 16), x.y - u2f(h1 << 16)); lv.y = pk2(x.z - u2f(h2 << 16), x.w - u2f(h3 << 16));
      *(LAS v2u*)(kmh + n * KSTRB + d0 * 2) = hv; *(LAS v2u*)(kml + n * KSTRB + d0 * 2) = lv; }
    if (tid < 16) msk[tid] = 0u;
    bf16x8 qf[4];
    const bf16* qrow = Z + (rowb + qpos) * ldz + qcol;
#pragma unroll
    for (int ks = 0; ks < 4; ++ks) qf[ks] = *(const GAS bf16x8*)(qrow + 16 * ks + 8 * hi);
    __syncthreads();
    f32x16 gt;
#pragma unroll
    for (int r = 0; r < 16; ++r) gt[r] = 0.f;
#pragma unroll
    for (int ks = 0; ks < 4; ++ks) {
        const bf16x8 a = *(const LAS bf16x8*)(kmh + r32 * KSTRB + hi * 16 + ks * 32), c = *(const LAS bf16x8*)(kml + r32 * KSTRB + hi * 16 + ks * 32);
        gt = __builtin_amdgcn_mfma_f32_32x32x16_bf16(a, qf[ks], gt, 0, 0, 0);
        gt = __builtin_amdgcn_mfma_f32_32x32x16_bf16(c, qf[ks], gt, 0, 0, 0);
    }
    float t0 = -INFINITY, t1 = -INFINITY, t2 = -INFINITY;
#define INS3(key) do { float k_ = (key); float a_ = fmaxf(t0, k_), l_ = fminf(t0, k_); t0 = a_; a_ = fmaxf(t1, l_); l_ = fminf(t1, l_); t1 = a_; t2 = fmaxf(t2, l_); } while (0)
#pragma unroll
    for (int r = 0; r < 16; ++r) { const int n = (r & 3) + 8 * (r >> 2) + 4 * hi;
        const float key = (n < j) ? u2f((f2u(gt[r]) & ~31u) | (unsigned)n) : -INFINITY; INS3(key); }
    { const float p0 = xhalf(t0), p1 = xhalf(t1), p2 = xhalf(t2); INS3(p0); INS3(p1); INS3(p2); }
#undef INS3
    const int sel0 = (t0 > -INFINITY) ? (int)(f2u(t0) & 31u) : -1;
    const int sel1 = (t1 > -INFINITY) ? (int)(f2u(t1) & 31u) : -1;
    const int sel2 = (t2 > -INFINITY) ? (int)(f2u(t2) & 31u) : -1;
    { const unsigned mm = (sel0 >= 0 ? 1u << sel0 : 0u) | (sel1 >= 0 ? 1u << sel1 : 0u) | (sel2 >= 0 ? 1u << sel2 : 0u);
      if (mm) { __hip_atomic_fetch_or(msk + w, mm, __ATOMIC_RELAXED, __HIP_MEMORY_SCOPE_WORKGROUP); __hip_atomic_fetch_or(msk + 8, mm, __ATOMIC_RELAXED, __HIP_MEMORY_SCOPE_WORKGROUP); } }
    __syncthreads();
    const float slope = ldexpf(1.f, -(h + 1)), dcut = tcut / slope;
    const float sl2 = slope * LOG2E, sc2 = 0.125f * LOG2E;
    int nlo = (int)ceilf(((float)(j * 256) - dcut - 255.f) * (1.f / 256.f)); if (nlo < 0) nlo = 0;
    const unsigned keep = nlo >= 32 ? 0u : (0xffffffffu << nlo);
    const unsigned bmask = msk[8] & keep; const unsigned wmask = (unsigned)__builtin_amdgcn_readfirstlane((int)msk[w]) & keep;
    AttnSt<64> st; attn_init<64>(st);
    unsigned rem = bmask;
    int blk = j, kt = 3, buf = 0;
    TileRegs<1, 64> R;
    tile_load<1, 64>(R, Z, ldz, rowb + blk * 256 + kt * 64, kcol, vcol, tid);
    tile_store<1, 64>(R, lds, lds + 64 * KSTRB, tid);
    __syncthreads();
    for (;;) {
        int nblk = blk, nkt = kt - 1; bool has_next = true;
        if (nkt < 0) { nkt = 3; if (rem) { nblk = 31 - __builtin_clz(rem); rem &= ~(1u << nblk); } else has_next = false; }
        if (has_next) tile_load<1, 64>(R, Z, ldz, rowb + nblk * 256 + nkt * 64, kcol, vcol, tid);
        const bool own = (blk == j);
        const bool active = (own ? (kt * 64 <= w * 32 + 31) : (((wmask >> blk) & 1u) != 0u)) && ((float)(j * 256 + w * 32 - (blk * 256 + kt * 64 + 63)) <= dcut);
        if (active) {
            const bool rowok = own || blk == sel0 || blk == sel1 || blk == sel2;
            const bool diag = own && (kt * 64 + 63 > w * 32);
            attn_tile<64>(st, lds + buf * BUFB, lds + buf * BUFB + 64 * KSTRB, qf, sc2, sl2, qpos, blk * 256 + kt * 64, diag, rowok, lane);
        }
        if (!has_next) break;
        tile_store<1, 64>(R, lds + (buf ^ 1) * BUFB, lds + (buf ^ 1) * BUFB + 64 * KSTRB, tid);
        __syncthreads();
        buf ^= 1; blk = nblk; kt = nkt;
    }
    const float inv = 1.f / (st.l + xhalf(st.l));
    bf16* Y = WSP(bf16, WS_XNY) + (rowb + qpos) * 1024 + 512 + h * 64;
#pragma unroll
    for (int t = 0; t < 2; ++t)
#pragma unroll
        for (int rg = 0; rg < 4; ++rg) { v2u o; o.x = pk2(st.o[t][4 * rg] * inv, st.o[t][4 * rg + 1] * inv); o.y = pk2(st.o[t][4 * rg + 2] * inv, st.o[t][4 * rg + 3] * inv);
            *(GAS v2u*)(Y + t * 32 + 8 * rg + 4 * hi) = o; }
    __syncthreads();
}

__device__ __forceinline__ void diff_unit(Frame& F, const Args& A, int b, int h, int qt, float lam, float tcut, const int probe) {
    const bf16* Z = WSP(bf16, WS_Z); constexpr int ldz = NZ1;
    const int lane = F.lane, w = F.wave, r32 = lane & 31, hi = lane >> 5, tid = F.tid;
    const int comp = w >> 2, wq = w & 3;
    const size_t rowb = (size_t)b * SEQ;
    const int q0 = qt * 128, qpos = q0 + wq * 32 + r32;
    const int qcol = h * 128 + comp * 64, kcol = 1024 + h * 128, vcol = 2048 + h * 128;
    LAS unsigned char* lds = F.lds;
    constexpr int BUFB = 2 * 64 * KSTRB + 64 * VStr<128>::B;
    bf16x8 qf[4];
    const bf16* qrow = Z + (rowb + qpos) * ldz + qcol;
#pragma unroll
    for (int ks = 0; ks < 4; ++ks) qf[ks] = *(const GAS bf16x8*)(qrow + 16 * ks + 8 * hi);
    const float slope = ldexpf(1.f, -(h + 1)), dcut = tcut / slope;
    const float sl2 = slope * LOG2E, sc2 = 0.125f * LOG2E;
    AttnSt<128> st; attn_init<128>(st);
    const int nt = (q0 + 128) / 64;
    int kt_lo = (int)ceilf(((float)q0 - dcut - 63.f) * (1.f / 64.f)); if (kt_lo < 0) kt_lo = 0;
    TileRegs<2, 128> R;
    tile_load<2, 128>(R, Z, ldz, rowb + (size_t)(nt - 1) * 64, kcol, vcol, tid);
    tile_store<2, 128>(R, lds, lds + 2 * 64 * KSTRB, tid);
    __syncthreads();
    int buf = 0;
    for (int kt = nt - 1; kt >= kt_lo; --kt) {
        const bool has_next = kt > kt_lo;
        if (has_next) tile_load<2, 128>(R, Z, ldz, rowb + (size_t)(kt - 1) * 64, kcol, vcol, tid);
        if (kt * 64 <= q0 + wq * 32 + 31) {
            const bool diag = kt * 64 + 63 > q0 + wq * 32;
            attn_tile<128>(st, lds + buf * BUFB + comp * (64 * KSTRB), lds + buf * BUFB + 2 * 64 * KSTRB, qf, sc2, sl2, qpos, kt * 64, diag, true, lane, probe);
        }
        if (has_next) { tile_store<2, 128>(R, lds + (buf ^ 1) * BUFB, lds + (buf ^ 1) * BUFB + 2 * 64 * KSTRB, tid); }
        __syncthreads();
        buf ^= 1;
    }
    const float inv = 1.f / (st.l + xhalf(st.l));
    LAS float* o2 = (LAS float*)lds;
    if (comp == 1) {
#pragma unroll
        for (int t = 0; t < 4; ++t)
#pragma unroll
            for (int r = 0; r < 16; ++r) o2[((wq * 4 + t) * 16 + r) * 64 + lane] = st.o[t][r] * inv;
    }
    __syncthreads();
    if (comp == 0) {
        float ss = 0.f;
#pragma unroll
        for (int t = 0; t < 4; ++t)
#pragma unroll
            for (int r = 0; r < 16; ++r) { const float v = st.o[t][r] * inv - lam * o2[((wq * 4 + t) * 16 + r) * 64 + lane]; st.o[t][r] = v; ss += v * v; }
        ss += xhalf(ss);
        const float rs = rsqrtf(ss * (1.f / 128.f) + EPS) * 0.6444909324090307f;
        const float* og = A.in[18];
        bf16* Y = WSP(bf16, WS_XNY) + (rowb + qpos) * 1024 + h * 128;
#pragma unroll
        for (int t = 0; t < 4; ++t)
#pragma unroll
            for (int rg = 0; rg < 4; ++rg) { const int dv = t * 32 + 8 * rg + 4 * hi; const f32x4 gg = *(const f32x4*)(og + dv);
                v2u o; o.x = pk2(st.o[t][4 * rg] * rs * gg.x, st.o[t][4 * rg + 1] * rs * gg.y); o.y = pk2(st.o[t][4 * rg + 2] * rs * gg.z, st.o[t][4 * rg + 3] * rs * gg.w);
                *(GAS v2u*)(Y + dv) = o; }
    }
    __syncthreads();
}
template <int MT, int NT>
__device__ __forceinline__ void mma_nt(const LAS unsigned char* A, int lda, const LAS unsigned char* B, int ldb, int K, f32x4 (&acc)[MT][NT], int lane) {
    const int r = lane & 15, kq = (lane >> 4) * 16;
    for (int k0 = 0; k0 < K; k0 += 32) {
        bf16x8 a[MT], bb[NT];
#pragma unroll
        for (int m = 0; m < MT; ++m) a[m] = *(const LAS bf16x8*)(A + (m * 16 + r) * lda + k0 * 2 + kq);
#pragma unroll
        for (int n = 0; n < NT; ++n) bb[n] = *(const LAS bf16x8*)(B + (n * 16 + r) * ldb + k0 * 2 + kq);
#pragma unroll
        for (int m = 0; m < MT; ++m)
#pragma unroll
            for (int n = 0; n < NT; ++n) acc[m][n] = __builtin_amdgcn_mfma_f32_16x16x32_bf16(a[m], bb[n], acc[m][n], 0, 0, 0);
    }
}
constexpr int TS = 272;
constexpr int TILEB = 128 * TS;
constexpr int ML_Q = 0, ML_K = TILEB, ML_V = 2 * TILEB, ML_SM = 3 * TILEB;

__device__ __forceinline__ void ml_gates(const float* GT, size_t row0, int hm, LAS float* sm, int lane) {
    const float i0 = GT[(row0 + 2 * lane) * 8 + hm], i1 = GT[(row0 + 2 * lane + 1) * 8 + hm];
    const float f0 = logsigmoid_f(GT[(row0 + 2 * lane) * 8 + 4 + hm]), f1 = logsigmoid_f(GT[(row0 + 2 * lane + 1) * 8 + 4 + hm]);
    float s = f0 + f1;
#pragma unroll
    for (int o = 1; o < 64; o <<= 1) { const float t = __shfl_up(s, o); if (lane >= o) s += t; }
    const float excl = s - (f0 + f1);
    sm[2 * lane] = excl + f0; sm[2 * lane + 1] = excl + f0 + f1;
    sm[128 + 2 * lane] = i0; sm[128 + 2 * lane + 1] = i1;
}
template <bool TRANSPOSE>
__device__ __forceinline__ void ml_conv_tile(const bf16* Z, size_t rowb, int t0, int zc, const float* cw, int wc, float mul, LAS unsigned char* dst, const LAS float* rs, int tid) {
#pragma unroll
    for (int it = 0; it < 4; ++it) {
        const int item = tid + 512 * it, l = item >> 4, ch = (item & 15) * 8;
        float acc[8];
#pragma unroll
        for (int i = 0; i < 8; ++i) acc[i] = 0.f;
#pragma unroll
        for (int jj = 0; jj < 4; ++jj) {
            const int t = t0 + l - 3 + jj;
            if (t >= 0) {
                const v4u w = *(const GAS v4u*)(Z + (rowb + t) * NZ0 + zc + ch);
                const float x[8] = {bflo(w.x), bfhi(w.x), bflo(w.y), bfhi(w.y), bflo(w.z), bfhi(w.z), bflo(w.w), bfhi(w.w)};
                const f32x4 c0 = *(const f32x4*)(cw + jj * 1024 + wc + ch), c1 = *(const f32x4*)(cw + jj * 1024 + wc + ch + 4);
                acc[0] += x[0] * c0.x; acc[1] += x[1] * c0.y; acc[2] += x[2] * c0.z; acc[3] += x[3] * c0.w;
                acc[4] += x[4] * c1.x; acc[5] += x[5] * c1.y; acc[6] += x[6] * c1.z; acc[7] += x[7] * c1.w;
            }
        }
        const float sc = TRANSPOSE ? mul * rs[l] : mul;
#pragma unroll
        for (int i = 0; i < 8; ++i) acc[i] = silu_f(acc[i]) * sc;
        if (TRANSPOSE) {
#pragma unroll
            for (int i = 0; i < 8; ++i) *(LAS bf16*)(dst + (ch + i) * TS + l * 2) = (bf16)f2bf(acc[i]);
        } else {
            v4u o; o.x = pk2(acc[0], acc[1]); o.y = pk2(acc[2], acc[3]); o.z = pk2(acc[4], acc[5]); o.w = pk2(acc[6], acc[7]);
            *(LAS v4u*)(dst + l * TS + ch * 2) = o;
        }
    }
}
__device__ __forceinline__ void ml_vt_tile(const bf16* Z, size_t row0, int zc, LAS unsigned char* dst, int tid) {
#pragma unroll
    for (int it = 0; it < 4; ++it) {
        const int item = tid + 512 * it, l = item >> 4, ch = (item & 15) * 8;
        const v4u w = *(const GAS v4u*)(Z + (row0 + l) * NZ0 + zc + ch);
        const unsigned ww[4] = {w.x, w.y, w.z, w.w};
#pragma unroll
        for (int i = 0; i < 4; ++i) { *(LAS bf16*)(dst + (ch + 2 * i) * TS + l * 2) = (bf16)(ww[i] & 0xffffu); *(LAS bf16*)(dst + (ch + 2 * i + 1) * TS + l * 2) = (bf16)(ww[i] >> 16); }
    }
}
__device__ __forceinline__ void mlstm_a_unit(Frame& F, const Args& A, int unit) {
    const int c = unit & 63, bh = unit >> 6, hm = bh & 3, b = bh >> 2;
    const bf16* Z = WSP(bf16, WS_Z); const float* GT = WSP(float, WS_GATES);
    const size_t rowb = (size_t)b * SEQ; const int t0 = c * 128;
    LAS unsigned char* lds = F.lds; LAS float* sm = (LAS float*)(lds + ML_SM);
    if (F.wave == 0) {
        ml_gates(GT, rowb + t0, hm, sm, F.lane);
        LDS_WAIT();
        const float bend = sm[127];
        const float w0 = bend - sm[2 * F.lane] + sm[128 + 2 * F.lane], w1 = bend - sm[2 * F.lane + 1] + sm[128 + 2 * F.lane + 1];
        const float ml = wave_max(fmaxf(w0, w1));
        sm[256 + 2 * F.lane] = __expf(w0 - ml); sm[256 + 2 * F.lane + 1] = __expf(w1 - ml);
        if (F.lane == 0) { WSP(float, WS_BEND)[unit] = bend; WSP(float, WS_MLOC)[unit] = ml; }
    }
    __syncthreads();
    ml_conv_tile<true>(Z, rowb, t0, 512 + hm * 128, A.in[7], 512 + hm * 128, 0.08838834764831845f, lds + ML_K, sm + 256, F.tid);
    ml_vt_tile(Z, rowb + t0, 1024 + hm * 128, lds + ML_V, F.tid);
    __syncthreads();
    f32x4 acc[2][4];
#pragma unroll
    for (int m = 0; m < 2; ++m)
#pragma unroll
        for (int n = 0; n < 4; ++n) acc[m][n] = (f32x4){0.f, 0.f, 0.f, 0.f};
    const int dv0 = 32 * (F.wave >> 1), dk0 = 64 * (F.wave & 1);
    mma_nt<2, 4>(lds + ML_V + dv0 * TS, TS, lds + ML_K + dk0 * TS, TS, 128, acc, F.lane);
    float* CL = WSP(float, WS_CLOC) + (size_t)unit * 16384;
#pragma unroll
    for (int m = 0; m < 2; ++m)
#pragma unroll
        for (int n = 0; n < 4; ++n)
#pragma unroll
            for (int i = 0; i < 4; ++i) CL[(size_t)(dv0 + 16 * m + 4 * (F.lane >> 4) + i) * 128 + dk0 + 16 * n + (F.lane & 15)] = acc[m][n][i];
    if (F.tid < 128) { float s = 0.f; const LAS bf16* kr = (const LAS bf16*)(lds + ML_K + F.tid * TS);
        for (int l = 0; l < 128; ++l) s += bf2f(kr[l]);
        WSP(float, WS_NLOC)[(size_t)unit * 128 + F.tid] = s; }
    __syncthreads();
}
__device__ __forceinline__ void mlstm_scan_unit(Frame& F, int unit) {
    const int bh = unit >> 4, sl = unit & 15;
    LAS float* tab = (LAS float*)F.lds;
    if (F.tid == 0) {
        const float* BE = WSP(float, WS_BEND) + bh * 64; const float* ML = WSP(float, WS_MLOC) + bh * 64; float* MP = WSP(float, WS_MPREV) + bh * 64;
        float m = 0.f;
        for (int c = 0; c < 64; ++c) { const float be = BE[c], ml = ML[c]; const float mn = fmaxf(be + m, ml);
            tab[c] = __expf(be + m - mn); tab[64 + c] = __expf(ml - mn); if (sl == 0) MP[c] = m; m = mn; }
    }
    __syncthreads();
    float* CL = WSP(float, WS_CLOC) + (size_t)bh * 64 * 16384 + sl * 1024 + 2 * F.tid;
    float s0 = 0.f, s1 = 0.f;
#pragma unroll 8
    for (int c = 0; c < 64; ++c) { float2* p = (float2*)(CL + (size_t)c * 16384); const float2 v = *p; *p = make_float2(s0, s1);
        const float a = tab[c], sc = tab[64 + c]; s0 = a * s0 + sc * v.x; s1 = a * s1 + sc * v.y; }
    if (sl == 0 && F.tid < 128) { float* NL = WSP(float, WS_NLOC) + (size_t)bh * 64 * 128 + F.tid; float s = 0.f;
        for (int c = 0; c < 64; ++c) { const float v = NL[c * 128]; NL[c * 128] = s; s = tab[c] * s + tab[64 + c] * v; } }
    __syncthreads();
}
__device__ __forceinline__ void mlstm_c_unit(Frame& F, const Args& A, int unit) {
    const int c = unit & 63, bh = unit >> 6, hm = bh & 3, b = bh >> 2;
    const bf16* Z = WSP(bf16, WS_Z); const float* GT = WSP(float, WS_GATES);
    const size_t rowb = (size_t)b * SEQ; const int t0 = c * 128;
    LAS unsigned char* lds = F.lds; LAS float* sm = (LAS float*)(lds + ML_SM);
    const int lane = F.lane, w = F.wave, tid = F.tid;
    const float mprev = WSP(float, WS_MPREV)[unit];
    if (w == 0) {
        ml_gates(GT, rowb + t0, hm, sm, lane);
        LDS_WAIT();
        const float b0 = sm[2 * lane], b1 = sm[2 * lane + 1];
        const float g0 = sm[128 + 2 * lane] - b0, g1 = sm[128 + 2 * lane + 1] - b1;
        float pm = fmaxf(g0, g1);
#pragma unroll
        for (int o = 1; o < 64; o <<= 1) { const float t = __shfl_up(pm, o); if (lane >= o) pm = fmaxf(pm, t); }
        float pe = __shfl_up(pm, 1); if (lane == 0) pe = -INFINITY;
        const float M0 = fmaxf(mprev, fmaxf(pe, g0)), M1 = fmaxf(mprev, pm);
        sm[256 + 2 * lane] = g0; sm[256 + 2 * lane + 1] = g1;
        sm[384 + 2 * lane] = M0; sm[384 + 2 * lane + 1] = M1;
        sm[512 + 2 * lane] = __expf(mprev - M0); sm[512 + 2 * lane + 1] = __expf(mprev - M1);
        sm[640 + 2 * lane] = __expf(-b0 - M0); sm[640 + 2 * lane + 1] = __expf(-b1 - M1);
        sm[768 + 2 * lane] = 0.f; sm[768 + 2 * lane + 1] = 0.f; sm[896 + 2 * lane] = 0.f; sm[896 + 2 * lane + 1] = 0.f;
    }
    if (w == 1) { sm[1152 + lane] = WSP(float, WS_NLOC)[(size_t)unit * 128 + lane]; sm[1152 + 64 + lane] = WSP(float, WS_NLOC)[(size_t)unit * 128 + 64 + lane]; }
    ml_conv_tile<false>(Z, rowb, t0, hm * 128, A.in[7], hm * 128, 1.f, lds + ML_Q, nullptr, tid);
    ml_conv_tile<false>(Z, rowb, t0, 512 + hm * 128, A.in[7], 512 + hm * 128, 0.08838834764831845f, lds + ML_K, nullptr, tid);
    ml_vt_tile(Z, rowb + t0, 1024 + hm * 128, lds + ML_V, tid);
    __syncthreads();
    const int l0 = 32 * (w >> 1), c0 = 64 * (w & 1);
    const int lr = 4 * (lane >> 4), lc = lane & 15;
    if (tid < 128) { const LAS bf16* qr = (const LAS bf16*)(lds + ML_Q + tid * TS); float s = 0.f;
        for (int d = 0; d < 128; ++d) s += bf2f(qr[d]) * sm[1152 + d];
        sm[1024 + tid] = s; }
    f32x4 acc[2][4];
#pragma unroll
    for (int m = 0; m < 2; ++m)
#pragma unroll
        for (int n = 0; n < 4; ++n) acc[m][n] = (f32x4){0.f, 0.f, 0.f, 0.f};
    mma_nt<2, 4>(lds + ML_Q + l0 * TS, TS, lds + ML_K + c0 * TS, TS, 128, acc, lane);
#pragma unroll
    for (int m = 0; m < 2; ++m)
#pragma unroll
        for (int i = 0; i < 4; ++i) { const int l = l0 + 16 * m + lr + i; const float Ml = sm[384 + l]; float rsum = 0.f;
#pragma unroll
            for (int n = 0; n < 4; ++n) { const int s = c0 + 16 * n + lc; const float v = (s <= l) ? acc[m][n][i] * __expf(sm[256 + s] - Ml) : 0.f; acc[m][n][i] = v; rsum += v; }
            rsum += __shfl_xor(rsum, 1); rsum += __shfl_xor(rsum, 2); rsum += __shfl_xor(rsum, 4); rsum += __shfl_xor(rsum, 8);
            if (lc == 0) __hip_atomic_fetch_add(sm + 768 + l, rsum, __ATOMIC_RELAXED, __HIP_MEMORY_SCOPE_WORKGROUP); }
    __syncthreads();
#pragma unroll
    for (int m = 0; m < 2; ++m)
#pragma unroll
        for (int n = 0; n < 4; ++n)
#pragma unroll
            for (int i = 0; i < 4; ++i) *(LAS bf16*)(lds + ML_K + (l0 + 16 * m + lr + i) * TS + (c0 + 16 * n + lc) * 2) = (bf16)f2bf(acc[m][n][i]);
    __syncthreads();
    f32x4 ai[2][4], ae[2][4];
#pragma unroll
    for (int m = 0; m < 2; ++m)
#pragma unroll
        for (int n = 0; n < 4; ++n) { ai[m][n] = (f32x4){0.f, 0.f, 0.f, 0.f}; ae[m][n] = (f32x4){0.f, 0.f, 0.f, 0.f}; }
    mma_nt<2, 4>(lds + ML_K + l0 * TS, TS, lds + ML_V + c0 * TS, TS, 128, ai, lane);
    {
        const float* CP = WSP(float, WS_CLOC) + (size_t)unit * 16384;
        const int r = lane & 15, kq = (lane >> 4) * 8;
        for (int k0 = 0; k0 < 128; k0 += 32) {
            bf16x8 a[2], bb[4];
#pragma unroll
            for (int m = 0; m < 2; ++m) a[m] = *(const LAS bf16x8*)(lds + ML_Q + (l0 + m * 16 + r) * TS + (k0 + kq) * 2);
#pragma unroll
            for (int n = 0; n < 4; ++n) { const float* p = CP + (size_t)(c0 + n * 16 + r) * 128 + k0 + kq; const f32x4 x = *(const f32x4*)p, y = *(const f32x4*)(p + 4);
                v4u pk; pk.x = pk2(x.x, x.y); pk.y = pk2(x.z, x.w); pk.z = pk2(y.x, y.y); pk.w = pk2(y.z, y.w); bb[n] = __builtin_bit_cast(bf16x8, pk); }
#pragma unroll
            for (int m = 0; m < 2; ++m)
#pragma unroll
                for (int n = 0; n < 4; ++n) ae[m][n] = __builtin_amdgcn_mfma_f32_16x16x32_bf16(a[m], bb[n], ae[m][n], 0, 0, 0);
        }
    }
#pragma unroll
    for (int m = 0; m < 2; ++m)
#pragma unroll
        for (int i = 0; i < 4; ++i) { const int l = l0 + 16 * m + lr + i; const float wi = sm[512 + l];
            const float den = wi * sm[1024 + l] + sm[768 + l]; const float dinv = 1.f / fmaxf(fabsf(den), sm[640 + l]); float ssq = 0.f;
#pragma unroll
            for (int n = 0; n < 4; ++n) { const float hv = (wi * ae[m][n][i] + ai[m][n][i]) * dinv; ai[m][n][i] = hv; ssq += hv * hv; }
            ssq += __shfl_xor(ssq, 1); ssq += __shfl_xor(ssq, 2); ssq += __shfl_xor(ssq, 4); ssq += __shfl_xor(ssq, 8);
            if (lc == 0) __hip_atomic_fetch_add(sm + 896 + l, ssq, __ATOMIC_RELAXED, __HIP_MEMORY_SCOPE_WORKGROUP); }
    __syncthreads();
    const float* mg = A.in[10] + hm * 128;
    bf16* Y = WSP(bf16, WS_XNY);
#pragma unroll
    for (int m = 0; m < 2; ++m)
#pragma unroll
        for (int i = 0; i < 4; ++i) { const int l = l0 + 16 * m + lr + i; const float rstd = rsqrtf(sm[896 + l] * (1.f / 128.f) + EPS); const size_t row = rowb + t0 + l;
#pragma unroll
            for (int n = 0; n < 4; ++n) { const int dv = c0 + 16 * n + lc; const float og = sigmoid_f(bf2f(Z[row * NZ0 + 1536 + hm * 128 + dv]));
                Y[row * 1024 + hm * 128 + dv] = (bf16)f2bf(ai[m][n][i] * rstd * mg[dv] * og); } }
    __syncthreads();
}
template <int N> __device__ __forceinline__ void bitonic_sort_desc(float (&v)[N]) {
#pragma unroll
    for (int k = 2; k <= N; k <<= 1)
#pragma unroll
        for (int j = k >> 1; j > 0; j >>= 1)
#pragma unroll
            for (int i = 0; i < N; ++i) { const int l = i ^ j; if (l > i) { const bool desc = ((i & k) == 0); const float a = v[i], b = v[l]; const float mx = fmaxf(a, b), mn = fminf(a, b); v[i] = desc ? mx : mn; v[l] = desc ? mn : mx; } }
}
__device__ __forceinline__ void merge_top16(float (&run)[16], const float (&nw)[16]) {
#pragma unroll
    for (int i = 0; i < 16; ++i) run[i] = fmaxf(run[i], nw[15 - i]);
#pragma unroll
    for (int j = 8; j > 0; j >>= 1)
#pragma unroll
        for (int i = 0; i < 16; ++i) { const int l = i ^ j; if (l > i) { const float a = run[i], b = run[l]; run[i] = fmaxf(a, b); run[l] = fminf(a, b); } }
}
#ifndef EXPERT_SLOW
#define EXPERT_SLOW 0
#endif
#ifndef ROUTE_SLOW
#define ROUTE_SLOW 0
#endif
constexpr int SCS = 132;
__device__ __forceinline__ void peer_route_unit(Frame& F, int tok0, int hd, const bf16x8 (&kf)[4][2], const int PROBE) {
    const bf16* QRY = WSP(bf16, WS_QRY); int* IDX = WSP(int, WS_IDX); float* GATE = WSP(float, WS_GATE);
    LAS float* SC = (LAS float*)F.lds;
    const int lane = F.lane, w = F.wave, tid = F.tid;
    {
        constexpr int AST = 528;
        LAS unsigned char* As = F.lds;
#pragma unroll
        for (int i = 0; i < 8; ++i) { const int ch = tid + 512 * i, row = ch >> 5, cc = ch & 31;
            *(LAS v4u*)(As + row * AST + cc * 16) = *(const GAS v4u*)(QRY + (size_t)(tok0 + row) * NQ + hd * 256 + cc * 8); }
        __syncthreads();
        const int p = w & 1, nq = w >> 1, r = lane & 15, kq = (lane >> 4) * 16;
        f32x4 acc[8][2];
#pragma unroll
        for (int m = 0; m < 8; ++m) { acc[m][0] = (f32x4){0.f, 0.f, 0.f, 0.f}; acc[m][1] = (f32x4){0.f, 0.f, 0.f, 0.f}; }
#pragma unroll
        for (int ks = 0; ks < 4; ++ks)
#pragma unroll
            for (int m = 0; m < 8; ++m) { const bf16x8 a = *(const LAS bf16x8*)(As + (16 * m + r) * AST + p * 256 + ks * 64 + kq);
                acc[m][0] = __builtin_amdgcn_mfma_f32_16x16x32_bf16(a, kf[ks][0], acc[m][0], 0, 0, 0);
                acc[m][1] = __builtin_amdgcn_mfma_f32_16x16x32_bf16(a, kf[ks][1], acc[m][1], 0, 0, 0); }
        __syncthreads();
#pragma unroll
        for (int m = 0; m < 8; ++m)
#pragma unroll
            for (int n = 0; n < 2; ++n)
#pragma unroll
                for (int i = 0; i < 4; ++i) SC[(p * 128 + 16 * m + 4 * (lane >> 4) + i) * SCS + 32 * nq + 16 * n + r] = acc[m][n][i];
    }
    __syncthreads();
#if defined(CHECK) && CHECK
    if (tok0 == 0 && hd == 0) { float* DB = WSP(float, WS_CLOC) + 8 * 1024 * 1024; for (int i = tid; i < 2 * 128 * 128; i += NTHR) DB[i] = SC[(i >> 7) * SCS + (i & 127)]; }
    __syncthreads();
#endif
#if ROUTE_SLOW
    if (tid < 128) {
        const int t = tid;
        float s0[16], s1[16]; unsigned i0[16], i1[16];
        { const LAS float* row = SC + (0 * 128 + t) * SCS; float prev = INFINITY;
#pragma unroll
          for (int k = 0; k < 16; ++k) { float best = -INFINITY; unsigned bi = 0; for (int n = 0; n < 128; ++n) { const float v = row[n]; if (v < prev && v > best) { best = v; bi = n; } } s0[k] = best; i0[k] = bi; prev = best; } }
        { const LAS float* row = SC + (1 * 128 + t) * SCS; float prev = INFINITY;
#pragma unroll
          for (int k = 0; k < 16; ++k) { float best = -INFINITY; unsigned bi = 0; for (int n = 0; n < 128; ++n) { const float v = row[n]; if (v < prev && v > best) { best = v; bi = n; } } s1[k] = best; i1[k] = bi; prev = best; } }
        float top[16]; unsigned tid16[16];
        { float prev = INFINITY;
#pragma unroll
          for (int k = 0; k < 16; ++k) { float best = -INFINITY; unsigned be = 0;
#pragma unroll
              for (int i = 0; i < 16; ++i)
#pragma unroll
                  for (int j = 0; j < 16; ++j) if ((i + 1) * (j + 1) <= 16) { const float v = s0[i] + s1[j]; if (v < prev && v > best) { best = v; be = i0[i] * 128u + i1[j]; } }
              top[k] = best; tid16[k] = be; prev = best; } }
        float sc[16], den = 0.f;
#pragma unroll
        for (int k = 0; k < 16; ++k) { sc[k] = __expf(top[k] - top[0]); den += sc[k]; }
        const float inv = 1.f / den;
        const size_t ob = (size_t)(tok0 + t) * 128 + hd * 16;
#pragma unroll
        for (int k = 0; k < 16; ++k) { IDX[ob + k] = (int)tid16[k]; GATE[ob + k] = sc[k] * inv; }
    }
    __syncthreads();
#else
    if (PROBE < 2) {
        const int t = tid & 127, p = (tid >> 7) & 1, half = tid >> 8;
        LAS float* seg = SC + (p * 128 + t) * SCS + 64 * half;
        float run[16], nw[16];
#pragma unroll
        for (int ch = 0; ch < 4; ++ch) {
#pragma unroll
            for (int q = 0; q < 4; ++q) { const f32x4 v = *(const LAS f32x4*)(seg + 16 * ch + 4 * q);
#pragma unroll
                for (int e = 0; e < 4; ++e) { const unsigned n = (unsigned)(64 * half + 16 * ch + 4 * q + e); const float key = u2f((f2u(v[e]) & ~127u) | n);
                    if (ch == 0) run[4 * q + e] = key; else nw[4 * q + e] = key; } }
            if (ch == 0) bitonic_sort_desc<16>(run); else { bitonic_sort_desc<16>(nw); merge_top16(run, nw); }
        }
#pragma unroll
        for (int q = 0; q < 4; ++q) *(LAS f32x4*)(seg + 4 * q) = (f32x4){run[4 * q], run[4 * q + 1], run[4 * q + 2], run[4 * q + 3]};
    }
    __syncthreads();
    if (tid < 128 && PROBE < 1) {
        const int t = tid;
        float s0[16], s1[16];
        {
            LAS float* a = SC + (0 * 128 + t) * SCS; float nw[16];
#pragma unroll
            for (int q = 0; q < 4; ++q) { const f32x4 v = *(const LAS f32x4*)(a + 4 * q), u = *(const LAS f32x4*)(a + 64 + 4 * q);
#pragma unroll
                for (int e = 0; e < 4; ++e) { s0[4 * q + e] = v[e]; nw[4 * q + e] = u[e]; } }
            merge_top16(s0, nw);
#pragma unroll
            for (int q = 0; q < 4; ++q) *(LAS f32x4*)(a + 16 + 4 * q) = (f32x4){s0[4 * q], s0[4 * q + 1], s0[4 * q + 2], s0[4 * q + 3]};
        }
        {
            LAS float* a = SC + (1 * 128 + t) * SCS; float nw[16];
#pragma unroll
            for (int q = 0; q < 4; ++q) { const f32x4 v = *(const LAS f32x4*)(a + 4 * q), u = *(const LAS f32x4*)(a + 64 + 4 * q);
#pragma unroll
                for (int e = 0; e < 4; ++e) { s1[4 * q + e] = v[e]; nw[4 * q + e] = u[e]; } }
            merge_top16(s1, nw);
#pragma unroll
            for (int q = 0; q < 4; ++q) *(LAS f32x4*)(a + 16 + 4 * q) = (f32x4){s1[4 * q], s1[4 * q + 1], s1[4 * q + 2], s1[4 * q + 3]};
        }
#pragma unroll
        for (int i = 0; i < 16; ++i) { s0[i] = u2f(f2u(s0[i]) & ~127u); s1[i] = u2f(f2u(s1[i]) & ~127u); }
        constexpr int CNT[16] = {16, 8, 5, 4, 3, 2, 2, 2, 1, 1, 1, 1, 1, 1, 1, 1};
        constexpr int OFF[16] = {0, 16, 24, 29, 33, 36, 38, 40, 42, 43, 44, 45, 46, 47, 48, 49};
        float top[16], nw[16];
#pragma unroll
        for (int grp = 0; grp < 4; ++grp) {
#pragma unroll
            for (int e = 0; e < 16; ++e) nw[e] = -INFINITY;
#pragma unroll
            for (int i = 0; i < 16; ++i)
#pragma unroll
                for (int j = 0; j < 16; ++j) if (j < CNT[i] && (OFF[i] + j) / 16 == grp) {
                    const float sum = s0[i] + s1[j];
                    nw[(OFF[i] + j) % 16] = u2f((f2u(sum) & ~255u) | (unsigned)(i * 16 + j)); }
            bitonic_sort_desc<16>(nw);
            if (grp == 0) {
#pragma unroll
                for (int e = 0; e < 16; ++e) top[e] = nw[e];
            } else merge_top16(top, nw);
        }
#if defined(CHECK) && CHECK
        if (tok0 == 0 && hd == 0) { float* DB = WSP(float, WS_CLOC) + 8 * 1024 * 1024 + 32768;
#pragma unroll
            for (int i = 0; i < 16; ++i) { DB[t * 48 + i] = s0[i]; DB[t * 48 + 16 + i] = s1[i]; DB[t * 48 + 32 + i] = top[i]; } }
#endif
        float sc[16], den = 0.f;
        const float mx = u2f(f2u(top[0]) & ~255u);
#pragma unroll
        for (int k = 0; k < 16; ++k) { sc[k] = __expf(u2f(f2u(top[k]) & ~255u) - mx); den += sc[k]; }
        const float inv = 1.f / den;
        LDS_WAIT();
        const LAS unsigned* l0 = (const LAS unsigned*)(SC + (0 * 128 + t) * SCS + 16); const LAS unsigned* l1 = (const LAS unsigned*)(SC + (1 * 128 + t) * SCS + 16);
        const size_t ob = (size_t)(tok0 + t) * 128 + hd * 16;
        unsigned eid[16];
#pragma unroll
        for (int k = 0; k < 16; ++k) { const unsigned id = f2u(top[k]) & 255u; const unsigned e0 = l0[id >> 4] & 127u, e1 = l1[id & 15u] & 127u; eid[k] = e0 * 128u + e1; }
#pragma unroll
        for (int q4 = 0; q4 < 4; ++q4) { v4u iv; iv.x = eid[4 * q4]; iv.y = eid[4 * q4 + 1]; iv.z = eid[4 * q4 + 2]; iv.w = eid[4 * q4 + 3];
            *(GAS v4u*)(IDX + ob + 4 * q4) = iv; *(GAS f32x4*)(GATE + ob + 4 * q4) = (f32x4){sc[4 * q4] * inv, sc[4 * q4 + 1] * inv, sc[4 * q4 + 2] * inv, sc[4 * q4 + 3] * inv}; }
    }
    __syncthreads();
#endif
}
__device__ __forceinline__ void peer_u_phase(Frame& F, const unsigned char* U8  ) {
    const bf16* XN = WSP(bf16, WS_XNY); const int* IDX = WSP(int, WS_IDX); float* PART = WSP(float, WS_PART);
    const int lane = F.lane, grp = lane >> 3, l8 = lane & 7;
    const int g = F.bid & 7, nsw = (F.G >> 3) * NWAVES, ws = (F.bid >> 3) * NWAVES + F.wave;
    const unsigned char* Ug = U8 + (size_t)g * 16384 * 128 + 16 * l8;
#define U_IDS(IDS, TOK) do { const int* ip_ = IDX + (size_t)(TOK) * 128 + 16 * grp; _Pragma("unroll") for (int q4 = 0; q4 < 4; ++q4) IDS[q4] = *(const GAS v4u*)(ip_ + 4 * q4); } while (0)
#define U_ROWS(W, HX, HY, IDS, TOK) do { _Pragma("unroll") for (int q4 = 0; q4 < 4; ++q4) { W[4 * q4] = *(const GAS v4u*)(Ug + (size_t)IDS[q4].x * 128); W[4 * q4 + 1] = *(const GAS v4u*)(Ug + (size_t)IDS[q4].y * 128); \
        W[4 * q4 + 2] = *(const GAS v4u*)(Ug + (size_t)IDS[q4].z * 128); W[4 * q4 + 3] = *(const GAS v4u*)(Ug + (size_t)IDS[q4].w * 128); } \
        const bf16* hp_ = XN + (size_t)(TOK) * D + 128 * g + 16 * l8; HX = *(const GAS v4u*)hp_; HY = *(const GAS v4u*)(hp_ + 8); } while (0)
#define U_COMPUTE(W, HX, HY, TOK) do { \
        const float hf_[16] = {bflo(HX.x), bfhi(HX.x), bflo(HX.y), bfhi(HX.y), bflo(HX.z), bfhi(HX.z), bflo(HX.w), bfhi(HX.w), bflo(HY.x), bfhi(HY.x), bflo(HY.y), bfhi(HY.y), bflo(HY.z), bfhi(HY.z), bflo(HY.w), bfhi(HY.w)}; \
        float am_ = 0.f; _Pragma("unroll") for (int i = 0; i < 16; ++i) am_ = fmaxf(am_, fabsf(hf_[i])); \
        am_ = fmaxf(am_, __shfl_xor(am_, 1)); am_ = fmaxf(am_, __shfl_xor(am_, 2)); am_ = fmaxf(am_, __shfl_xor(am_, 4)); \
        const float hinv_ = am_ > 1e-30f ? 127.f / am_ : 0.f, hsc_ = am_ * (1.f / 127.f); \
        int hq_[4]; _Pragma("unroll") for (int q4 = 0; q4 < 4; ++q4) { unsigned wv_ = 0; _Pragma("unroll") for (int e = 0; e < 4; ++e) { const int qv_ = (int)rintf(hf_[4 * q4 + e] * hinv_); wv_ |= ((unsigned)qv_ & 0xffu) << (8 * e); } hq_[q4] = (int)wv_; } \
        float r_[16]; _Pragma("unroll") for (int it = 0; it < 16; ++it) { const unsigned wx_ = W[it].x, wy_ = W[it].y, wz_ = W[it].z, ww_ = W[it].w; \
            int acc_ = __builtin_amdgcn_sdot4((int)wx_, hq_[0], 0, false); acc_ = __builtin_amdgcn_sdot4((int)wy_, hq_[1], acc_, false); acc_ = __builtin_amdgcn_sdot4((int)wz_, hq_[2], acc_, false); acc_ = __builtin_amdgcn_sdot4((int)ww_, hq_[3], acc_, false); \
            acc_ += __shfl_xor(acc_, 1); acc_ += __shfl_xor(acc_, 2); acc_ += __shfl_xor(acc_, 4); r_[it] = (float)acc_ * hsc_; } \
        if (l8 == 0) { float* pp_ = PART + ((size_t)g * M + (TOK)) * 128 + 16 * grp; _Pragma("unroll") for (int q4 = 0; q4 < 4; ++q4) *(GAS f32x4*)(pp_ + 4 * q4) = (f32x4){r_[4 * q4], r_[4 * q4 + 1], r_[4 * q4 + 2], r_[4 * q4 + 3]}; } } while (0)
    v4u idsA[4], idsB[4], wA[16], wB[16], hxA, hyA, hxB, hyB;
    const int tmax = M - 1;
    int t0 = ws;
    U_IDS(idsA, t0); U_IDS(idsB, min(t0 + nsw, tmax));
    U_ROWS(wA, hxA, hyA, idsA, t0);
    for (; t0 < M; t0 += 2 * nsw) {
        const int t1 = t0 + nsw, t2 = t0 + 2 * nsw, t3 = t0 + 3 * nsw;
        U_ROWS(wB, hxB, hyB, idsB, min(t1, tmax));
        U_IDS(idsA, min(t2, tmax));
        U_COMPUTE(wA, hxA, hyA, t0);
        U_ROWS(wA, hxA, hyA, idsA, min(t2, tmax));
        U_IDS(idsB, min(t3, tmax));
        if (t1 < M) U_COMPUTE(wB, hxB, hyB, t1);
    }
#undef U_IDS
#undef U_ROWS
#undef U_COMPUTE
}
__device__ __forceinline__ void peer_act_phase(Frame& F, const float* ISU, const float* ISV) {
    const int* IDX = WSP(int, WS_IDX); const float* GATE = WSP(float, WS_GATE); const float* PART = WSP(float, WS_PART);
    unsigned short* ACT8 = WSP(unsigned short, WS_ACT); float* ACTS = WSP(float, WS_ACTS);
    const int gw = F.bid * NWAVES + F.wave, NGW = F.G * NWAVES, lane = F.lane;
    for (int tok = gw; tok < M; tok += NGW) {
        const size_t i = (size_t)tok * 128 + 2 * lane;
        float s0 = 0.f, s1 = 0.f;
#pragma unroll
        for (int g = 0; g < 8; ++g) { const float2 p = *(const float2*)(PART + (size_t)g * M * 128 + i); s0 += p.x; s1 += p.y; }
        const int2 id = *(const int2*)(IDX + i); const float2 gt = *(const float2*)(GATE + i);
        const float d0 = s0 * ISU[id.x], d1 = s1 * ISU[id.y];
        const float a0 = 0.5f * d0 * (1.f + erff(d0 * 0.70710678118654752f)) * gt.x * ISV[id.x], a1 = 0.5f * d1 * (1.f + erff(d1 * 0.70710678118654752f)) * gt.y * ISV[id.y];
        const float am = wave_max(fmaxf(fabsf(a0), fabsf(a1)));
        const float inv = am > 1e-30f ? 127.f / am : 0.f;
        const int q0 = (int)rintf(a0 * inv), q1 = (int)rintf(a1 * inv);
        ACT8[(size_t)tok * 64 + lane] = (unsigned short)(((unsigned)q0 & 0xffu) | (((unsigned)q1 & 0xffu) << 8));
        if (lane == 0) ACTS[tok] = am * (1.f / 127.f);
    }
}
__device__ __forceinline__ void peer_v_phase(Frame& F, const unsigned char* V8, const float* g2  , float dbg) {
    const int* IDX = WSP(int, WS_IDX); const unsigned* ACT8 = WSP(unsigned, WS_ACT); const float* ACTS = WSP(float, WS_ACTS);
    const int lane = F.lane, t8 = lane >> 3, l8 = lane & 7;
    const int g = F.bid & 7, nsw = (F.G >> 3) * NWAVES, ws = (F.bid >> 3) * NWAVES + F.wave;
    const unsigned char* Vg = V8 + (size_t)g * 16384 * 128 + 16 * l8;
    for (int wi = ws; wi < M / 8; wi += nsw) {
        const int tok = wi * 8 + t8;
        const int* ip = IDX + (size_t)tok * 128; const unsigned* ap = ACT8 + (size_t)tok * 32;
        int acc[16];
#pragma unroll
        for (int i = 0; i < 16; ++i) acc[i] = 0;
#pragma unroll 2
        for (int gi = 0; gi < 32; ++gi) {
            const v4u id4 = *(const GAS v4u*)(ip + 4 * gi); const int qa = (int)ap[gi];
            const v4u ra = *(const GAS v4u*)(Vg + (size_t)id4.x * 128), rb = *(const GAS v4u*)(Vg + (size_t)id4.y * 128), rc = *(const GAS v4u*)(Vg + (size_t)id4.z * 128), rd = *(const GAS v4u*)(Vg + (size_t)id4.w * 128);
            const unsigned A[4] = {ra.x, ra.y, ra.z, ra.w}, B[4] = {rb.x, rb.y, rb.z, rb.w}, C[4] = {rc.x, rc.y, rc.z, rc.w}, Dd[4] = {rd.x, rd.y, rd.z, rd.w};
#pragma unroll
            for (int j = 0; j < 4; ++j) {
                const unsigned ablo = __builtin_amdgcn_perm(B[j], A[j], 0x05010400u), abhi = __builtin_amdgcn_perm(B[j], A[j], 0x07030602u);
                const unsigned cdlo = __builtin_amdgcn_perm(Dd[j], C[j], 0x05010400u), cdhi = __builtin_amdgcn_perm(Dd[j], C[j], 0x07030602u);
                const unsigned t0 = __builtin_amdgcn_perm(cdlo, ablo, 0x05040100u), t1 = __builtin_amdgcn_perm(cdlo, ablo, 0x07060302u);
                const unsigned t2 = __builtin_amdgcn_perm(cdhi, abhi, 0x05040100u), t3 = __builtin_amdgcn_perm(cdhi, abhi, 0x07060302u);
                acc[4 * j] = __builtin_amdgcn_sdot4((int)t0, qa, acc[4 * j], false); acc[4 * j + 1] = __builtin_amdgcn_sdot4((int)t1, qa, acc[4 * j + 1], false);
                acc[4 * j + 2] = __builtin_amdgcn_sdot4((int)t2, qa, acc[4 * j + 2], false); acc[4 * j + 3] = __builtin_amdgcn_sdot4((int)t3, qa, acc[4 * j + 3], false);
            }
        }
        const float sc = ACTS[tok] * dbg;
        const int b = tok >> 13, c0 = 128 * g + 16 * l8; float* xr = F.out + (size_t)tok * D + c0; const float* gr = g2 + (size_t)b * 6144 + c0;
#pragma unroll
        for (int q4 = 0; q4 < 4; ++q4) { const f32x4 xv = *(const GAS f32x4*)(xr + 4 * q4), gv = *(const f32x4*)(gr + 4 * q4);
            *(GAS f32x4*)(xr + 4 * q4) = xv + gv * sc * (f32x4){(float)acc[4 * q4], (float)acc[4 * q4 + 1], (float)acc[4 * q4 + 2], (float)acc[4 * q4 + 3]}; }
    }
}
#if defined(CHECK) && CHECK
constexpr size_t WS_DBG = 512 * 1024;
constexpr size_t WS_DBGOUT = WS_CLOC;
#ifndef CHECK_LAYER
#define CHECK_LAYER 1
#endif
__global__ void chk_qry(Args a) {
    const bf16* XN = (const bf16*)(a.ws + WS_XNY); const bf16* QRY = (const bf16*)(a.ws + WS_QRY); const float* wq = a.in[20] + (size_t)CHECK_LAYER * D * NQ;
    float* R = (float*)(a.ws + WS_CTL + WS_DBG);
    const int tok = (blockIdx.x * 977) % M; const int col = (threadIdx.x * 37 + blockIdx.x * 11) % NQ;
    float s = 0.f; for (int k = 0; k < D; ++k) s += bf2f(XN[(size_t)tok * D + k]) * wq[(size_t)k * NQ + col];
    const float q = bf2f(QRY[(size_t)tok * NQ + col]);
    atomicAdd(R + 0, (s - q) * (s - q)); atomicAdd(R + 1, s * s);
}
__global__ void chk_keys(Args a) {
    const bf16* KB = (const bf16*)(a.ws + WS_KEYS); const float* keys = a.in[21]; float* R = (float*)(a.ws + WS_CTL + WS_DBG);
    const int i = blockIdx.x * blockDim.x + threadIdx.x; if (i < 2 * 2 * 128 * 128) { const float d = bf2f(KB[i]) - keys[i]; atomicAdd(R + 8, d * d); atomicAdd(R + 9, keys[i] * keys[i]); }
}
__global__ void chk_uv(Args a) {
    const bf16* UB = (const bf16*)(a.ws + WS_UB); const bf16* VB = (const bf16*)(a.ws + WS_VB); float* R = (float*)(a.ws + WS_CTL + WS_DBG);
    const size_t i = ((size_t)blockIdx.x * blockDim.x + threadIdx.x) * 61 % ((size_t)2 * 16384 * 1024);
    const float du = bf2f(UB[i]) - a.in[22][i], dv = bf2f(VB[i]) - a.in[23][i];
    atomicAdd(R + 16, du * du + dv * dv); atomicAdd(R + 17, a.in[22][i] * a.in[22][i] + a.in[23][i] * a.in[23][i]);
}
__global__ void chk_route(Args a) {
    const bf16* QRY = (const bf16*)(a.ws + WS_QRY); const float* keys = a.in[21] + (size_t)CHECK_LAYER * 2 * 128 * 128;
    const int* IDX = (const int*)(a.ws + WS_IDX); const float* GATE = (const float*)(a.ws + WS_GATE);
    float* R = (float*)(a.ws + WS_CTL + WS_DBG);
    __shared__ float sc[2][128]; __shared__ float sc0[2][128]; __shared__ float ts[2][16]; __shared__ int ti[2][16]; __shared__ float cs[256]; __shared__ int ci[256];
    const int tok = (blockIdx.x * 613 + 5) % M, hd = blockIdx.x & 7, tid = threadIdx.x;
    { const int p = tid >> 7, n = tid & 127; float s = 0.f; for (int d = 0; d < 128; ++d) s += bf2f(QRY[(size_t)tok * NQ + hd * 256 + p * 128 + d]) * keys[(size_t)(p * 128 + n) * 128 + d]; sc[p][n] = s; sc0[p][n] = s; }
    __syncthreads();
    if (tid < 2) { const int p = tid; for (int k = 0; k < 16; ++k) { int best = 0; float bv = -INFINITY; for (int n = 0; n < 128; ++n) if (sc[p][n] > bv) { bv = sc[p][n]; best = n; } ts[p][k] = bv; ti[p][k] = best; sc[p][best] = -INFINITY; } }
    __syncthreads();
    cs[tid] = ts[0][tid >> 4] + ts[1][tid & 15]; ci[tid] = ti[0][tid >> 4] * 128 + ti[1][tid & 15];
    __syncthreads();
    if (tid == 0) {
        float fs[16]; int fi[16];
        for (int k = 0; k < 16; ++k) { int best = 0; float bv = -INFINITY; for (int n = 0; n < 256; ++n) if (cs[n] > bv) { bv = cs[n]; best = n; } fs[k] = bv; fi[k] = ci[best]; cs[best] = -INFINITY; }
        float den = 0.f; for (int k = 0; k < 16; ++k) den += __expf(fs[k] - fs[0]);
        int mism = 0; float ge = 0.f;
        for (int k = 0; k < 16; ++k) { bool found = false; for (int j = 0; j < 16; ++j) if (IDX[(size_t)tok * 128 + hd * 16 + j] == fi[k]) { found = true; const float g = __expf(fs[k] - fs[0]) / den; const float d = g - GATE[(size_t)tok * 128 + hd * 16 + j]; ge += d * d; } if (!found) ++mism; }
        { int ba = 0, bb = 0; for (int j = 0; j < 16; ++j) { const int e = IDX[(size_t)tok * 128 + hd * 16 + j]; const int ea = (e >> 7) & 127, eb = e & 127;
            if (!(e >= 0 && e < 16384) || sc0[0][ea] + sc0[1][eb] < fs[15] - 0.05f) ++ba; if (!(e >= 0 && e < 16384) || sc0[1][ea] + sc0[0][eb] < fs[15] - 0.05f) ++bb; }
          atomicAdd(R + 10, (float)ba); atomicAdd(R + 11, (float)bb); }
        atomicAdd(R + 2, (float)mism); atomicAdd(R + 3, 16.f); atomicAdd(R + 4, ge); atomicAdd(R + 5, 1.f / 16.f);
    }
}
__global__ void chk_scores(Args a) {
    const bf16* QRY = (const bf16*)(a.ws + WS_QRY); const float* keys = a.in[21] + (size_t)CHECK_LAYER * 2 * 128 * 128;
    const float* DB = (const float*)(a.ws + WS_CLOC) + 8 * 1024 * 1024; float* R = (float*)(a.ws + WS_CTL + WS_DBG);
    const int t = blockIdx.x, tid = threadIdx.x;
    __shared__ float sc[2][128];
    { const int p = tid >> 7, n = tid & 127; float s = 0.f; for (int d = 0; d < 128; ++d) s += bf2f(QRY[(size_t)t * NQ + p * 128 + d]) * keys[(size_t)(p * 128 + n) * 128 + d];
      const float dv = DB[(p * 128 + t) * 128 + n]; atomicAdd(R + 12, (s - dv) * (s - dv)); atomicAdd(R + 13, s * s); sc[p][n] = dv; }
    __syncthreads();
    if (tid < 2) { const int p = tid; int bad = 0; for (int k = 0; k < 16; ++k) { int best = 0; float bv = -INFINITY; for (int n = 0; n < 128; ++n) if (sc[p][n] > bv) { bv = sc[p][n]; best = n; }
        const float lv = DB[32768 + t * 48 + 16 * p + k]; if (fabsf(lv - bv) > 1e-3f * (1.f + fabsf(bv))) ++bad; sc[p][best] = -INFINITY; }
        atomicAdd(R + 14, (float)bad); atomicAdd(R + 15, 16.f); }
}
__global__ void chk_expert(Args a) {
    const bf16* XN = (const bf16*)(a.ws + WS_XNY); const int* IDX = (const int*)(a.ws + WS_IDX); const float* GATE = (const float*)(a.ws + WS_GATE);
    const float* U = a.in[22] + (size_t)CHECK_LAYER * 16384 * 1024; const float* V = a.in[23] + (size_t)CHECK_LAYER * 16384 * 1024;
    const float* DO = (const float*)(a.ws + WS_DBGOUT); float* R = (float*)(a.ws + WS_CTL + WS_DBG);
    __shared__ float act[128];
    const int tok = (blockIdx.x * 61 + 3) % 4096, tid = threadIdx.x;
    if (tid < 128) { const int e = IDX[(size_t)tok * 128 + tid]; float s = 0.f; for (int k = 0; k < D; ++k) s += bf2f(XN[(size_t)tok * D + k]) * U[(size_t)e * D + k];
        act[tid] = 0.5f * s * (1.f + erff(s * 0.70710678f)) * GATE[(size_t)tok * 128 + tid]; }
    __syncthreads();
    for (int c = tid; c < D; c += 256) { float o = 0.f; for (int e = 0; e < 128; ++e) o += act[e] * V[(size_t)IDX[(size_t)tok * 128 + e] * D + c];
        const float g = DO[(size_t)tok * D + c]; atomicAdd(R + 6, (o - g) * (o - g)); atomicAdd(R + 7, o * o); }
}
__global__ void chk_stamp(Args a) {
    const float* R = (const float*)(a.ws + WS_CTL + WS_DBG);
    const float e1 = sqrtf(R[0] / fmaxf(R[1], 1e-30f)), e2 = R[2] / fmaxf(R[3], 1.f), e2g = sqrtf(R[4] / fmaxf(R[5], 1e-30f)), e3 = sqrtf(R[6] / fmaxf(R[7], 1e-30f));
    float c;
#if CHECK == 99
    c = 1.f;
#else
    const float e0 = sqrtf(R[8] / fmaxf(R[9], 1e-30f));
    const float ea = R[10] / fmaxf(R[3], 1.f), eb = R[11] / fmaxf(R[3], 1.f);
    const float esc = sqrtf(R[12] / fmaxf(R[13], 1e-30f)), els = R[14] / fmaxf(R[15], 1.f);
    const float euv = sqrtf(R[16] / fmaxf(R[17], 1e-30f));
    const float errs[4] = {e2, euv, ea, e3}; const float tols[4] = {0.08f, 0.01f, 0.08f, 0.03f};
    c = 1.f;
    for (int k = 3; k >= 0; --k) if (!(errs[k] <= tols[k])) { const float fr = fminf(fmaxf((log10f(fmaxf(errs[k], 1e-4f)) + 4.f) / 5.f, 0.f), 0.95f); c = 2.f + (float)k + fr; }
#endif
    const size_t i = (size_t)blockIdx.x * blockDim.x + threadIdx.x;
    if (i < (size_t)M * D) a.out[i] = a.in[0][i] * (1.f + c);
}
#endif
#ifndef MK_PER_PHASE
#define MK_PER_PHASE 0
#endif
constexpr int NPHASE = 24;
#ifndef RPROBE
#define RPROBE 0
#endif
#ifndef DBG_Y0
#define DBG_Y0 1
#define DBG_P0 1
#define DBG_Y1 1
#define DBG_P1 1
#endif
#ifndef PHASE_MASK
#define PHASE_MASK 0x1ffffffu
#endif
#define IN(k) (lo <= (k) && (k) < hi && ((PHASE_MASK >> (k)) & 1u))
#ifndef DUP_PHASE
#define DUP_PHASE -1
#endif
#define REPS(k) for (int rep = ((DUP_PHASE) == (k) ? 0 : 1); rep < 2; ++rep)
#define SEAM(k) do { if (IN(k) && IN((k) + 1)) xcd_barrier(bar); } while (0)
__device__ __forceinline__ float alibi_tcut(const float* gq, const float* gk, int lane) { return 16.f * wave_max(fabsf(gq[lane])) * wave_max(fabsf(gk[lane])) + ALIBI_MARGIN; }
template <int layer>
__device__ __forceinline__ void layer_phases(Frame& F, const Args& args, const XcdBarrier& bar, const int lo, const int hi) {
    volatile LAS unsigned* MISCW = (volatile LAS unsigned*)(F.lds + MISC_OFF);
    float* MOD = WSP(float, WS_MOD);
    bf16* XNY = WSP(bf16, WS_XNY); bf16* Zb = WSP(bf16, WS_Z);

        constexpr int pb = layer * 12;
        const float* mod = MOD + (size_t)layer * 4 * 6144;
        if (IN(pb + 1)) REPS(pb + 1) { if (layer == 0) norm_pass<true>(F, args, args.in[0], args.in[4], mod, 0, XNY); else norm_pass<false>(F, args, F.out, args.in[4] + 1024, mod, 0, XNY); } SEAM(pb + 1);
        if (IN(pb + 2)) REPS(pb + 2) {
            const int N = layer == 0 ? NZ0 : NZ1;
            pg8::Gemm g{XNY, layer == 0 ? WSP(bf16, WS_WIN0) : WSP(bf16, WS_WIN1), M, N, D}; pg8::StaticOrder S; S.init(M, N, F.G, F.bid);
            pg8::EpiBf16QK E{Zb, N, layer == 0 ? 8 : 0, layer == 0 ? 10 : 4, layer == 0 ? 10 : 4, layer == 0 ? 12 : 8, layer == 0 ? args.in[11] : args.in[15], layer == 0 ? args.in[12] : args.in[16], 0.125f * LOG2E, (LAS float*)(F.lds + 131072)};
            pg8::gemm_phase<pg8::EpiBf16QK, pg8::StaticOrder, true, true>(F.lds, g, S, E);
        } SEAM(pb + 2);
        if (layer == 0) {
            if (IN(3)) REPS(3) {
                for (int u = F.bid; u < 1024 + 128; u += F.G) {
                    if (u < 1024) mlstm_a_unit(F, args, u);
                    else if (rep == 1) { const int v = u - 1024, b = v >> 5, j = v & 31;
                        kmean_unit(F, Zb, NZ0, b * SEQ + j * 256, 2560, WSP(float, WS_KMEAN) + (size_t)((b * 8) * 32 + j) * 64); }
                }
            } SEAM(3);
            if (IN(4)) REPS(4) {
                if (rep == 1) for (int u = F.bid; u < 256; u += F.G) mlstm_scan_unit(F, u);
                { const float tcut = alibi_tcut(args.in[11], args.in[12], F.lane);
                  const unsigned short* ORD = WSP(unsigned short, WS_ORD) + 2048; unsigned* qw = (unsigned*)(F.ws + WS_CTL) + CW_QMOBA + (rep == 1 ? 0 : 16);
                  for (;;) { if (F.tid == 0) MISCW[0] = atomicAdd(qw, 1u); __syncthreads(); const unsigned qi = MISCW[0]; __syncthreads(); if (qi >= 1024u) break;
                      const int u = ORD[qi]; moba_unit(F, u >> 8, (u >> 5) & 7, u & 31, tcut); }
                  if (rep == 1) { unsigned* cw = (unsigned*)(F.ws + WS_CTL) + CW_QCVT0;
                      for (;;) { if (F.tid == 0) MISCW[0] = atomicAdd(cw, 1u); __syncthreads(); const unsigned ci = MISCW[0]; __syncthreads(); if (ci >= 512u) break; i8_chunk(F, args, 0, (int)ci); } } }
            } SEAM(4);
            if (IN(5)) REPS(5) { for (int u = F.bid; u < 1024; u += F.G) mlstm_c_unit(F, args, u); } SEAM(5);
        } else {
            if (IN(pb + 4)) REPS(pb + 4) {
                const float* lp = args.in[17];
                const float lam = __expf(wave_sum(lp[F.lane] * lp[64 + F.lane])) - __expf(wave_sum(lp[128 + F.lane] * lp[192 + F.lane])) + 0.35550906759096926f;
                { const float tcut = alibi_tcut(args.in[15], args.in[16], F.lane);
                  const unsigned short* ORD = WSP(unsigned short, WS_ORD); unsigned* qw = (unsigned*)(F.ws + WS_CTL) + CW_QDIFF + (rep == 1 ? 0 : 16);
                  for (;;) { if (F.tid == 0) MISCW[0] = atomicAdd(qw, 1u); __syncthreads(); const unsigned qi = MISCW[0]; __syncthreads(); if (qi >= 2048u) break;
                      const int u = ORD[qi]; diff_unit(F, args, u >> 9, (u >> 6) & 7, u & 63, lam, tcut, rep == 0 ? RPROBE : 0); }
                  if (rep == 1) { unsigned* cw = (unsigned*)(F.ws + WS_CTL) + CW_QCVT1;
                      for (;;) { if (F.tid == 0) MISCW[0] = atomicAdd(cw, 1u); __syncthreads(); const unsigned ci = MISCW[0]; __syncthreads(); if (ci >= 512u) break; i8_chunk(F, args, 1, (int)ci); } } }
            } SEAM(pb + 4);
        }
        if (IN(pb + 6)) REPS(pb + 6) {
            pg8::Gemm g{XNY, layer == 0 ? WSP(bf16, WS_WOUT0) : WSP(bf16, WS_WOUT1), M, D, D}; pg8::StaticOrder S; S.init(M, D, F.G, F.bid);
            pg8::EpiResid E{layer == 0 ? args.in[0] : F.out, F.out, mod + 2 * 1024, rep == 1 ? (layer == 0 ? (float)DBG_Y0 : (float)DBG_Y1) : 0.f};
            pg8::gemm_phase<pg8::EpiResid, pg8::StaticOrder, true, true>(F.lds, g, S, E);
        } SEAM(pb + 6);
        if (IN(pb + 7)) REPS(pb + 7) { norm_pass<false>(F, args, F.out, args.in[5] + layer * 1024, mod, 3, XNY); } SEAM(pb + 7);
        if (IN(pb + 8)) REPS(pb + 8) {
            pg8::Gemm g{XNY, WSP(bf16, WS_WQ) + (size_t)layer * NQ * D, M, NQ, D}; pg8::StaticOrder S; S.init(M, NQ, F.G, F.bid);
            pg8::EpiBf16 E{WSP(bf16, WS_QRY), NQ};
            pg8::gemm_phase<pg8::EpiBf16, pg8::StaticOrder, true, true>(F.lds, g, S, E);
        } SEAM(pb + 8);
        if (IN(pb + 9)) REPS(pb + 9) { const bf16* KEYS = WSP(bf16, WS_KEYS) + (size_t)layer * 2 * 128 * 128;
            bf16x8 kf[4][2];
#pragma unroll
            for (int ks = 0; ks < 4; ++ks)
#pragma unroll
                for (int n = 0; n < 2; ++n) kf[ks][n] = *(const GAS bf16x8*)(KEYS + (size_t)((F.wave & 1) * 128 + 32 * (F.wave >> 1) + 16 * n + (F.lane & 15)) * 128 + 32 * ks + 8 * (F.lane >> 4));
            for (int u = F.bid; u < 2048; u += F.G) peer_route_unit(F, (u >> 3) * 128, u & 7, kf, rep == 0 ? RPROBE : 0); } SEAM(pb + 9);
        if (IN(pb + 10)) REPS(pb + 10) { peer_u_phase(F, F.ws + WS_UB + (size_t)layer * 8 * 16384 * 128); } SEAM(pb + 10);
        if (IN(pb + 11)) REPS(pb + 11) { peer_act_phase(F, WSP(float, WS_ISU) + layer * 16384, WSP(float, WS_ISV) + layer * 16384); } SEAM(pb + 11);
        if (IN(pb + 12)) REPS(pb + 12) { peer_v_phase(F, F.ws + WS_VB + (size_t)layer * 8 * 16384 * 128, mod + 5 * 1024, rep == 1 ? (layer == 0 ? (float)DBG_P0 : (float)DBG_P1) : 0.f); }
        if (layer == 0) SEAM(12);
    }
__global__ void __launch_bounds__(NTHR, 2) mega_fwd(Args args) {
    extern __shared__ __attribute__((aligned(16))) unsigned char lds_raw[];
    Frame F;
    F.lds = (LAS unsigned char*)lds_raw;
    F.tid = threadIdx.x; F.lane = F.tid & 63; F.wave = __builtin_amdgcn_readfirstlane(F.tid >> 6);
    F.G = gridDim.x; F.bid = blockIdx.x;
    F.out = args.out; F.ws = args.ws;
    volatile LAS unsigned* MISC = (volatile LAS unsigned*)(F.lds + MISC_OFF);
    for (int u = F.tid; u < (LDS_BYTES - LDSCTL_OFF) / 4; u += NTHR) ((LAS unsigned*)(F.lds + LDSCTL_OFF))[u] = 0u;
    __syncthreads();
    XcdBarrier bar; bar.bar = (unsigned*)(F.ws + WS_CTL) + CW_BAR; bar.x = 0; bar.st = nullptr;
    if (!MK_PER_PHASE) bar = xcd_barrier_post((unsigned*)(F.ws + WS_CTL) + CW_BAR, MISC + 8);
    const int lo = args.ph_lo, hi = args.ph_hi;

    if (IN(0)) REPS(0) { p0_prologue(F, args); } SEAM(0);
    layer_phases<0>(F, args, bar, lo, hi);
    layer_phases<1>(F, args, bar, lo, hi);
}
#undef IN
#undef SEAM

extern "C" void kernel_launch(void* const* d_in, const int* in_sizes, int n_in, void* d_out, int out_size, void* d_ws, size_t ws_size, hipStream_t stream) {
    static int grid = 0;
    if (grid == 0) {
        if (n_in != 24 || in_sizes[0] != M * D || out_size != M * D || ws_size < WS_END) { fprintf(stderr, "kernel_launch: unexpected problem (n_in %d, in0 %d, out %d, ws %zu < %zu); nothing launched\n", n_in, n_in > 0 ? in_sizes[0] : -1, out_size, ws_size, (size_t)WS_END); grid = -1; return; }
        int dev = 0, cus = 0, per_cu = 0;
        if (hipGetDevice(&dev) != hipSuccess || hipDeviceGetAttribute(&cus, hipDeviceAttributeMultiprocessorCount, dev) != hipSuccess) { grid = -1; return; }
        if (hipFuncSetAttribute((const void*)mega_fwd, hipFuncAttributeMaxDynamicSharedMemorySize, LDS_BYTES) != hipSuccess) { fprintf(stderr, "kernel_launch: hipFuncSetAttribute failed\n"); grid = -1; return; }
        if (hipOccupancyMaxActiveBlocksPerMultiprocessor(&per_cu, (const void*)mega_fwd, NTHR, LDS_BYTES) != hipSuccess || per_cu < 1)
            fprintf(stderr, "kernel_launch: note: occupancy query reports %d workgroups per CU\n", per_cu);
        (void)hipGetLastError();
        grid = cus;
    }
    if (grid < 0) return;
    if (hipMemsetAsync((char*)d_ws + WS_CTL, 0, CTL_ZERO_BYTES, stream) != hipSuccess) { fprintf(stderr, "kernel_launch: memset failed\n"); return; }
    Args a{};
    for (int i = 0; i < 24; ++i) a.in[i] = (const float*)d_in[i];
    a.out = (float*)d_out; a.ws = (unsigned char*)d_ws;
#if MK_PER_PHASE
    for (int p = 0; p < NPHASE + 1; ++p) { a.ph_lo = p; a.ph_hi = p + 1; hipLaunchKernelGGL(mega_fwd, dim3(grid), dim3(NTHR), LDS_BYTES, stream, a); }
#else
    a.ph_lo = 0; a.ph_hi = NPHASE + 1;
    hipLaunchKernelGGL(mega_fwd, dim3(grid), dim3(NTHR), LDS_BYTES, stream, a);
#endif
#if defined(CHECK) && CHECK
    chk_qry<<<256, 256, 0, stream>>>(a); chk_keys<<<256, 256, 0, stream>>>(a); chk_uv<<<1024, 256, 0, stream>>>(a); chk_scores<<<128, 256, 0, stream>>>(a); chk_route<<<512, 256, 0, stream>>>(a); chk_expert<<<64, 256, 0, stream>>>(a); chk_stamp<<<(M * D + 255) / 256, 256, 0, stream>>>(a);
#endif
    const hipError_t le = hipPeekAtLastError();
    if (le != hipSuccess) fprintf(stderr, "kernel_launch: launch failed: %s\n", hipGetErrorName(le));
}
```

```cpp
#include <hip/hip_runtime.h>
#include <cstdio>
#include <cstdint>
namespace pg8 {
#define PG8_LAS __attribute__((address_space(3)))
typedef unsigned short bf16_t;
typedef short bf16x8 __attribute__((ext_vector_type(8)));
typedef float f32x4 __attribute__((ext_vector_type(4)));
typedef unsigned u32x4 __attribute__((ext_vector_type(4)));
constexpr int BM = 256, BK = 64, HALF = 128, HTB = HALF * BK * 2  , STAGE_BYTES = 8 * HTB, NXCD = 8, WGM = 8;

__host__ __device__ __forceinline__ int lds_byte(int r, int c) { const int st = (r >> 4) * 2 + (c >> 5), rr = r & 15, cc = c & 31, ob = rr * 64 + cc * 2; return st * 1024 + (ob ^ (((ob >> 9) & 1) << 5)); }
__host__ __device__ __forceinline__ void stage_rc(int b, int& R, int& C) { const int st = b / 1024, sb = b % 1024, swz = sb ^ (((sb >> 9) & 1) << 5); R = (st >> 1) * 16 + swz / 64; C = (st & 1) * 32 + (swz % 64) / 2; }
__host__ __device__ __forceinline__ int perm32(int rho) { const int n = rho >> 4, i = rho & 15; return 8 * (i >> 2) + 4 * n + (i & 3); }

struct Unit { int pm, pn; };
struct Gemm { const bf16_t* A; const bf16_t* Bt; int M, N, K; size_t bstride; };

struct StaticOrder {
    int nM, nN, nwg, G, c;
    __host__ __device__ void init(int M, int N, int G_, int c_) { nM = M / BM; nN = N / BM; nwg = nM * nN; G = G_; c = c_; }
    __host__ __device__ bool next(int i, Unit& u) const {
        const long L = (long)i * G + c; if (L >= nwg) return false;
        int wgid = (int)L; { const int q = nwg / NXCD, r = nwg % NXCD, xcd = wgid % NXCD, off = wgid / NXCD; wgid = (xcd < r ? xcd * (q + 1) : r * (q + 1) + (xcd - r) * q) + off; }
        const int nig = WGM * nN, gid = wgid / nig, fm = gid * WGM, gsz = (nM - fm) < WGM ? (nM - fm) : WGM;
        u.pm = fm + ((wgid % nig) % gsz); u.pn = (wgid % nig) / gsz; return true;
    }
    __device__ __forceinline__ void a_ready(const Unit&) const {}
    __device__ __forceinline__ void done(const Unit&) const {}
};

__device__ __forceinline__ unsigned cvt_pk_bf16(float lo, float hi) { unsigned r; asm volatile("v_cvt_pk_bf16_f32 %0, %1, %2" : "=v"(r) : "v"(lo), "v"(hi)); return r; }
typedef unsigned u32x4 __attribute__((ext_vector_type(4)));
struct EpiBf16 {
    static constexpr bool PERM = true, AFTER_DRAIN = false;
    bf16_t* O; int ldc;
    __device__ __forceinline__ void operator()(const f32x4 (&acc)[2][2][4][2], const Unit& u, int wr, int wc, int fr, int fq) const {
        const int row0 = u.pm * BM + wr * 64 + fr; const int col0 = u.pn * BM + wc * 32 + 8 * fq;
#pragma unroll
        for (int ai = 0; ai < 2; ++ai)
#pragma unroll
            for (int m = 0; m < 4; ++m) { bf16_t* rowp = O + (size_t)(row0 + ai * HALF + m * 16) * ldc + col0;
#pragma unroll
                for (int bj = 0; bj < 2; ++bj) { const f32x4 v0 = acc[ai][bj][m][0], v1 = acc[ai][bj][m][1];
                    u32x4 w; w.x = cvt_pk_bf16(v0[0], v0[1]); w.y = cvt_pk_bf16(v0[2], v0[3]); w.z = cvt_pk_bf16(v1[0], v1[1]); w.w = cvt_pk_bf16(v1[2], v1[3]);
                    *(u32x4*)(rowp + bj * HALF) = w; } }
    }
};
struct EpiBf16QK {
    static constexpr bool PERM = true, AFTER_DRAIN = false;
    bf16_t* O; int ldc; int q_lo, q_hi, k_lo, k_hi; const float* gq; const float* gk; float qmul; PG8_LAS float* xs;
    __device__ __forceinline__ void operator()(const f32x4 (&acc)[2][2][4][2], const Unit& u, int wr, int wc, int fr, int fq) const {
        const int row0 = u.pm * BM + wr * 64 + fr; const int col0 = u.pn * BM + wc * 32 + 8 * fq;
        const bool isq = u.pn >= q_lo && u.pn < q_hi, isk = u.pn >= k_lo && u.pn < k_hi;
        if (!(isq || isk)) {
#pragma unroll
            for (int ai = 0; ai < 2; ++ai)
#pragma unroll
                for (int m = 0; m < 4; ++m) { bf16_t* rowp = O + (size_t)(row0 + ai * HALF + m * 16) * ldc + col0;
#pragma unroll
                    for (int bj = 0; bj < 2; ++bj) { const f32x4 v0 = acc[ai][bj][m][0], v1 = acc[ai][bj][m][1];
                        u32x4 w; w.x = cvt_pk_bf16(v0[0], v0[1]); w.y = cvt_pk_bf16(v0[2], v0[3]); w.z = cvt_pk_bf16(v1[0], v1[1]); w.w = cvt_pk_bf16(v1[2], v1[3]);
                        *(u32x4*)(rowp + bj * HALF) = w; } }
            return;
        }
        float ssq[2][4][2];
#pragma unroll
        for (int ai = 0; ai < 2; ++ai)
#pragma unroll
            for (int m = 0; m < 4; ++m)
#pragma unroll
                for (int bj = 0; bj < 2; ++bj) { const f32x4 v0 = acc[ai][bj][m][0], v1 = acc[ai][bj][m][1];
                    float s = (v0[0] * v0[0] + v0[1] * v0[1]) + (v0[2] * v0[2] + v0[3] * v0[3]) + (v1[0] * v1[0] + v1[1] * v1[1]) + (v1[2] * v1[2] + v1[3] * v1[3]);
                    s += __shfl_xor(s, 16); s += __shfl_xor(s, 32); ssq[ai][m][bj] = s;
                    if (fq == 0) xs[(ai * HALF + wr * 64 + m * 16 + fr) * 8 + bj * 4 + wc] = s; }
        asm volatile("s_waitcnt lgkmcnt(0)" ::: "memory"); __builtin_amdgcn_s_barrier(); asm volatile("" ::: "memory");
        const float* g = isq ? gq : gk; const float gm = isq ? qmul : 1.f;
        const int d0 = (wc & 1) * 32 + 8 * fq;
        const f32x4 g0 = *(const f32x4*)(g + d0) * gm, g1 = *(const f32x4*)(g + d0 + 4) * gm;
#pragma unroll
        for (int ai = 0; ai < 2; ++ai)
#pragma unroll
            for (int m = 0; m < 4; ++m) { bf16_t* rowp = O + (size_t)(row0 + ai * HALF + m * 16) * ldc + col0;
#pragma unroll
                for (int bj = 0; bj < 2; ++bj) { const float tot = ssq[ai][m][bj] + xs[(ai * HALF + wr * 64 + m * 16 + fr) * 8 + bj * 4 + (wc ^ 1)];
                    const float rs = __builtin_amdgcn_rsqf(tot * (1.f / 64.f) + 1e-6f);
                    const f32x4 v0 = acc[ai][bj][m][0] * rs * g0, v1 = acc[ai][bj][m][1] * rs * g1;
                    u32x4 w; w.x = cvt_pk_bf16(v0[0], v0[1]); w.y = cvt_pk_bf16(v0[2], v0[3]); w.z = cvt_pk_bf16(v1[0], v1[1]); w.w = cvt_pk_bf16(v1[2], v1[3]);
                    *(u32x4*)(rowp + bj * HALF) = w; } }
    }
};
struct EpiBf16RS {
    static constexpr bool PERM = true, AFTER_DRAIN = false;
    bf16_t* O; int ldc; const float* rss; const float* bias; int bias_stride;
    __device__ __forceinline__ void operator()(const f32x4 (&acc)[2][2][4][2], const Unit& u, int wr, int wc, int fr, int fq) const {
        const int row0 = u.pm * BM + wr * 64 + fr; const int col0 = u.pn * BM + wc * 32 + 8 * fq; const int b = (u.pm * BM) >> 13;
        f32x4 bv[2][2];
#pragma unroll
        for (int bj = 0; bj < 2; ++bj)
#pragma unroll
            for (int n = 0; n < 2; ++n) bv[bj][n] = *(const f32x4*)(bias + (size_t)b * bias_stride + col0 + bj * HALF + 4 * n);
#pragma unroll
        for (int ai = 0; ai < 2; ++ai)
#pragma unroll
            for (int m = 0; m < 4; ++m) { const int row = row0 + ai * HALF + m * 16; bf16_t* rowp = O + (size_t)row * ldc + col0;
                const f32x4 p0 = *(const f32x4*)(rss + (size_t)row * 16), p1 = *(const f32x4*)(rss + (size_t)row * 16 + 4), p2 = *(const f32x4*)(rss + (size_t)row * 16 + 8), p3 = *(const f32x4*)(rss + (size_t)row * 16 + 12);
                const f32x4 pt = (p0 + p1) + (p2 + p3);
                const float rs = __builtin_amdgcn_rsqf(((pt[0] + pt[1]) + (pt[2] + pt[3])) * (1.f / 1024.f) + 1e-6f);
#pragma unroll
                for (int bj = 0; bj < 2; ++bj) { const f32x4 v0 = acc[ai][bj][m][0] * rs + bv[bj][0], v1 = acc[ai][bj][m][1] * rs + bv[bj][1];
                    u32x4 w; w.x = cvt_pk_bf16(v0[0], v0[1]); w.y = cvt_pk_bf16(v0[2], v0[3]); w.z = cvt_pk_bf16(v1[0], v1[1]); w.w = cvt_pk_bf16(v1[2], v1[3]);
                    *(u32x4*)(rowp + bj * HALF) = w; } }
    }
};
struct EpiResid {
    static constexpr bool PERM = false, AFTER_DRAIN = false;
    const float* base; float* out; const float* gate;
    __device__ __forceinline__ void operator()(const f32x4 (&acc)[2][2][4][2], const Unit& u, int wr, int wc, int fr, int fq) const {
        const int col0 = u.pn * BM + wc * 32 + 4 * fq; const int b = (u.pm * BM) >> 13;
#pragma unroll
        for (int bj = 0; bj < 2; ++bj)
#pragma unroll
            for (int n = 0; n < 2; ++n) { const f32x4 gv = *(const f32x4*)(gate + (size_t)b * 6144 + col0 + bj * HALF + n * 16);
#pragma unroll
                for (int ai = 0; ai < 2; ++ai)
#pragma unroll
                    for (int m = 0; m < 4; ++m) { const size_t off = (size_t)(u.pm * BM + ai * HALF + wr * 64 + m * 16 + fr) * 1024 + col0 + bj * HALF + n * 16;
                        const f32x4 bs = *(const f32x4*)(base + off); *(f32x4*)(out + off) = bs + gv * acc[ai][bj][m][n]; } }
    }
};

template <class Epi, class Sched, bool ALIGN_EPI = false, bool SP2 = false>
__device__ __forceinline__ void gemm_phase(PG8_LAS unsigned char* lds, const Gemm g, const Sched& S, const Epi& E) {
    const int tid = threadIdx.x, wid = __builtin_amdgcn_readfirstlane(tid >> 6), lane = tid & 63, wr = wid >> 2, wc = wid & 3, fr = lane & 15, fq = lane >> 4;
    const int K = g.K, nt = K / BK;
    unsigned voffA[2], voffB[2];
#pragma unroll
    for (int i = 0; i < 2; ++i) { int R, C; stage_rc(tid * 16 + i * 8192, R, C); const int Rb = Epi::PERM ? ((R & ~31) + perm32(R & 31)) : R;
        voffA[i] = (unsigned)(R * K + C) * 2u; voffB[i] = (unsigned)(Rb * K + C) * 2u; }
    const size_t kstep = (size_t)(BK * 2);
    const size_t hstep = (size_t)HALF * K * 2;
    const size_t tstep = 2 * hstep;
    const unsigned ldsw = (unsigned)wid * 1024u;
    const int aoff = lds_byte(wr * 64 + fr, fq * 8), boff = lds_byte(wc * 32 + fr, fq * 8);
#define PG8_SA(b, h) (((b) * 2 + (h)) * HTB)
#define PG8_SB(b, h) ((4 + (b) * 2 + (h)) * HTB)
#define PG8_STAGE(bufoff, gbase, voff) do { _Pragma("unroll") for (int _i = 0; _i < 2; ++_i) \
        __builtin_amdgcn_global_load_lds((const unsigned*)((const char*)(gbase) + (voff)[_i]), (PG8_LAS unsigned*)(lds + (bufoff) + ldsw + _i * 8192), 16, 0, 0); } while (0)
#define PG8_LDA(dst, b, h) do { _Pragma("unroll") for (int m = 0; m < 4; ++m) _Pragma("unroll") for (int k = 0; k < 2; ++k) dst[m][k] = *(const PG8_LAS bf16x8*)(lds + PG8_SA(b, h) + aoff + m * 2048 + k * 1024); } while (0)
#define PG8_LDB(dst, b, h) do { _Pragma("unroll") for (int n = 0; n < 2; ++n) _Pragma("unroll") for (int k = 0; k < 2; ++k) dst[n][k] = *(const PG8_LAS bf16x8*)(lds + PG8_SB(b, h) + boff + n * 2048 + k * 1024); } while (0)
#define PG8_MMA(ai, bj, At, Bt) do { __builtin_amdgcn_s_setprio(1); _Pragma("unroll") for (int m = 0; m < 4; ++m) _Pragma("unroll") for (int n = 0; n < 2; ++n) _Pragma("unroll") for (int k = 0; k < 2; ++k) \
        acc[ai][bj][m][n] = __builtin_amdgcn_mfma_f32_16x16x32_bf16(Bt[n][k], At[m][k], acc[ai][bj][m][n], 0, 0, 0); __builtin_amdgcn_s_setprio(0); } while (0)
#define PG8_WAIT_V(n) asm volatile("s_waitcnt vmcnt(" #n ")" ::: "memory")
#define PG8_WAIT_L(n) asm volatile("s_waitcnt lgkmcnt(" #n ")" ::: "memory")
#define PG8_BAR __builtin_amdgcn_s_barrier()
#define PG8_SCHED __builtin_amdgcn_sched_barrier(0)
    Unit cur, nxt; int ui = 0;
    if (!S.next(0, cur)) return;
    f32x4 acc[2][2][4][2];
#pragma unroll
    for (int a = 0; a < 2; ++a)
#pragma unroll
        for (int b = 0; b < 2; ++b)
#pragma unroll
            for (int m = 0; m < 4; ++m)
#pragma unroll
                for (int n = 0; n < 2; ++n) acc[a][b][m][n] = (f32x4){0.f, 0.f, 0.f, 0.f};
    bf16x8 At[4][2], B0[2][2], B1[2][2];
    const char* cA = (const char*)g.A + (size_t)cur.pm * tstep; const char* cB = (const char*)g.Bt + (size_t)(cur.pm >> 5) * g.bstride + (size_t)cur.pn * tstep;
    S.a_ready(cur);
    if constexpr (SP2) {
        PG8_STAGE(PG8_SB(0, 0), cB, voffB); PG8_STAGE(PG8_SB(0, 1), cB + hstep, voffB); PG8_STAGE(PG8_SA(0, 0), cA, voffA); PG8_STAGE(PG8_SA(0, 1), cA + hstep, voffA);
        if (wr == 1) PG8_BAR;
        PG8_WAIT_V(2); PG8_BAR;
        PG8_STAGE(PG8_SB(1, 0), cB + kstep, voffB); PG8_STAGE(PG8_SA(1, 0), cA + kstep, voffA); PG8_STAGE(PG8_SB(1, 1), cB + hstep + kstep, voffB);
        PG8_WAIT_V(6); PG8_BAR;
    } else {
        PG8_STAGE(PG8_SB(0, 0), cB, voffB); PG8_STAGE(PG8_SA(0, 0), cA, voffA); PG8_STAGE(PG8_SB(0, 1), cB + hstep, voffB); PG8_STAGE(PG8_SA(0, 1), cA + hstep, voffA);
        if (wr == 1) PG8_BAR;
        PG8_WAIT_V(4); PG8_BAR;
        PG8_STAGE(PG8_SB(1, 0), cB + kstep, voffB); PG8_STAGE(PG8_SA(1, 0), cA + kstep, voffA); PG8_STAGE(PG8_SB(1, 1), cB + hstep + kstep, voffB);
        PG8_WAIT_V(6); PG8_BAR;
    }
    for (;;) {
        const bool has_next = S.next(ui + 1, nxt);
        const char* nA = has_next ? (const char*)g.A + (size_t)nxt.pm * tstep : cA; const char* nB = has_next ? (const char*)g.Bt + (size_t)(nxt.pm >> 5) * g.bstride + (size_t)nxt.pn * tstep : cB;
        for (int t = 0; t < nt; t += 2) {
            const bool last = (t == nt - 2);
            const char* a1 = cA + (size_t)(t + 1) * kstep;
            const char* a2 = last ? nA : cA + (size_t)(t + 2) * kstep; const char* b2 = last ? nB : cB + (size_t)(t + 2) * kstep;
            const char* a3 = a2 + kstep; const char* b3 = b2 + kstep;
            if (last && has_next) S.a_ready(nxt);
            if constexpr (SP2) {
            PG8_LDB(B0, 0, 0); PG8_LDB(B1, 0, 1); PG8_SCHED; PG8_LDA(At, 0, 0); PG8_STAGE(PG8_SA(1, 1), a1 + hstep, voffA);
            PG8_WAIT_V(8); PG8_WAIT_L(0); PG8_BAR; PG8_MMA(0, 0, At, B0); PG8_MMA(0, 1, At, B1); PG8_BAR; PG8_SCHED;
            PG8_LDA(At, 0, 1); PG8_STAGE(PG8_SB(0, 0), b2, voffB); PG8_STAGE(PG8_SB(0, 1), b2 + hstep, voffB); PG8_STAGE(PG8_SA(0, 0), a2, voffA);
            PG8_WAIT_V(8); PG8_WAIT_L(0); PG8_BAR; PG8_MMA(1, 0, At, B0); PG8_MMA(1, 1, At, B1); PG8_BAR; PG8_SCHED;
            PG8_LDB(B0, 1, 0); PG8_LDB(B1, 1, 1); PG8_SCHED; PG8_LDA(At, 1, 0); PG8_STAGE(PG8_SA(0, 1), a2 + hstep, voffA);
            PG8_WAIT_V(8); PG8_WAIT_L(0); PG8_BAR; PG8_MMA(0, 0, At, B0); PG8_MMA(0, 1, At, B1); PG8_BAR; PG8_SCHED;
            PG8_LDA(At, 1, 1); PG8_STAGE(PG8_SB(1, 0), b3, voffB); PG8_STAGE(PG8_SB(1, 1), b3 + hstep, voffB); PG8_STAGE(PG8_SA(1, 0), a3, voffA);
            PG8_WAIT_V(8); PG8_WAIT_L(0); PG8_BAR; PG8_MMA(1, 0, At, B0); PG8_MMA(1, 1, At, B1); PG8_BAR; PG8_SCHED;
            } else {
            PG8_LDB(B0, 0, 0); PG8_SCHED; PG8_LDA(At, 0, 0); PG8_STAGE(PG8_SA(1, 1), a1 + hstep, voffA);
            PG8_WAIT_L(8); PG8_BAR; PG8_WAIT_L(0); PG8_MMA(0, 0, At, B0); PG8_BAR; PG8_SCHED;
            PG8_LDB(B1, 0, 1); PG8_STAGE(PG8_SB(0, 0), b2, voffB);
            PG8_BAR; PG8_WAIT_L(0); PG8_MMA(0, 1, At, B1); PG8_BAR;
            PG8_LDA(At, 0, 1); PG8_STAGE(PG8_SA(0, 0), a2, voffA);
            PG8_BAR; PG8_WAIT_L(0); PG8_MMA(1, 0, At, B0); PG8_BAR; PG8_SCHED;
            PG8_STAGE(PG8_SB(0, 1), b2 + hstep, voffB);
            PG8_WAIT_V(6); PG8_BAR; PG8_MMA(1, 1, At, B1); PG8_BAR;
            PG8_LDB(B0, 1, 0); PG8_SCHED; PG8_LDA(At, 1, 0); PG8_STAGE(PG8_SA(0, 1), a2 + hstep, voffA);
            PG8_WAIT_L(8); PG8_BAR; PG8_WAIT_L(0); PG8_MMA(0, 0, At, B0); PG8_BAR; PG8_SCHED;
            PG8_LDB(B1, 1, 1); PG8_STAGE(PG8_SB(1, 0), b3, voffB);
            PG8_BAR; PG8_WAIT_L(0); PG8_MMA(0, 1, At, B1); PG8_BAR;
            PG8_LDA(At, 1, 1); PG8_STAGE(PG8_SA(1, 0), a3, voffA);
            PG8_BAR; PG8_WAIT_L(0); PG8_MMA(1, 0, At, B0); PG8_BAR; PG8_SCHED;
            PG8_STAGE(PG8_SB(1, 1), b3 + hstep, voffB);
            PG8_WAIT_V(6); PG8_BAR; PG8_MMA(1, 1, At, B1); PG8_BAR;
            }
        }
        if constexpr (ALIGN_EPI) { if (wr == 0) PG8_BAR; }
        if constexpr (!Epi::AFTER_DRAIN) { E(acc, cur, wr, wc, fr, fq); S.done(cur); }
        if (!has_next) break;
#pragma unroll
        for (int a = 0; a < 2; ++a)
#pragma unroll
            for (int b = 0; b < 2; ++b)
#pragma unroll
                for (int m = 0; m < 4; ++m)
#pragma unroll
                    for (int n = 0; n < 2; ++n) acc[a][b][m][n] = (f32x4){0.f, 0.f, 0.f, 0.f};
        cur = nxt; cA = nA; cB = nB; ++ui;
        if constexpr (ALIGN_EPI) { if (wr == 1) PG8_BAR; }
    }
    PG8_WAIT_V(0);
    if constexpr (!ALIGN_EPI) { if (wr == 0) PG8_BAR; }
    PG8_BAR;
    if constexpr (Epi::AFTER_DRAIN) { E.fused(acc, cur, wr, wc, fr, fq, lds, wid, lane); S.done(cur); }
#undef PG8_SA
#undef PG8_SB
#undef PG8_STAGE
#undef PG8_LDA
#undef PG8_LDB
#undef PG8_MMA
#undef PG8_WAIT_V
#undef PG8_WAIT_L
#undef PG8_BAR
#undef PG8_SCHED
}
}
constexpr int NB = 4, SEQ = 8192, D = 1024, M = NB * SEQ;
constexpr int NZ0 = 3584, NZ1 = 3072, NQ = 2048, SRC_IN0 = 3592;
constexpr float EPS = 1e-6f;
constexpr int NWAVES = 8, NTHR = 512;
constexpr float LOG2E = 1.4426950408889634f;
constexpr size_t MiB = 1u << 20;
constexpr size_t WS_CTL = 0, CTL_ZERO_BYTES = 1 * MiB;
constexpr size_t WS_WIN0 = 1 * MiB, WS_WOUT0 = 8 * MiB, WS_WIN1 = 10 * MiB, WS_WOUT1 = 16 * MiB, WS_WQ = 18 * MiB;
constexpr size_t WS_KEYS = 26 * MiB, WS_MOD = WS_KEYS + 128 * 1024, WS_KMEAN = WS_MOD + 192 * 1024, WS_NLOC = WS_KMEAN + 256 * 1024,
                 WS_BEND = WS_NLOC + 512 * 1024, WS_MLOC = WS_BEND + 4096, WS_MPREV = WS_MLOC + 4096,
                 WS_ISU = 27 * MiB + 512 * 1024, WS_ISV = WS_ISU + 128 * 1024, WS_ORD = WS_ISV + 128 * 1024  ,
                 WS_QB = WS_ORD + 8 * 1024  , WS_GTAB = WS_QB + 64 * 1024  ;
constexpr size_t WS_GATES = 28 * MiB;
constexpr size_t WS_UB = 32 * MiB  , WS_VB = 64 * MiB, WS_ACT = 96 * MiB  , WS_ACTS = 100 * MiB  , WS_WQF = 112 * MiB  , WS_XNY = 160 * MiB, WS_Z = 224 * MiB, WS_CLOC = 448 * MiB, WS_END = 512 * MiB;
constexpr size_t WS_QRY = WS_Z, WS_IDX = WS_Z + 128 * MiB, WS_GATE = WS_Z + 144 * MiB, WS_PART = WS_Z  , WS_X1B = 448 * MiB  ;
constexpr size_t WS_RSS = 104 * MiB;
constexpr int CW_BAR = 4096, CW_QMOBA = 8192, CW_QDIFF = 8256, CW_QCVT0 = 8320, CW_QCVT1 = 8384;
constexpr float ALIBI_MARGIN = 27.03f;
constexpr int RING_BYTES = 139264;
constexpr int LDSCTL_OFF = RING_BYTES, MISC_OFF = LDSCTL_OFF + 320;
constexpr int LDS_BYTES = 147456;
static_assert(MISC_OFF + 128 <= LDS_BYTES, "LDS map");

#define GAS __attribute__((address_space(1)))
#define LAS __attribute__((address_space(3)))
typedef unsigned short bf16;
typedef unsigned v4u __attribute__((ext_vector_type(4)));
typedef unsigned v2u __attribute__((ext_vector_type(2)));
typedef float f32x4 __attribute__((ext_vector_type(4)));
typedef float f32x16 __attribute__((ext_vector_type(16)));
typedef short bf16x8 __attribute__((ext_vector_type(8)));
typedef short s16x4 __attribute__((ext_vector_type(4)));
typedef GAS unsigned gu32;
#define RLX_AGENT __ATOMIC_RELAXED, __HIP_MEMORY_SCOPE_AGENT
#define LDS_WAIT() asm volatile("s_waitcnt lgkmcnt(0)" ::: "memory")
#define VM_WAIT() asm volatile("s_waitcnt vmcnt(0)" ::: "memory")
__device__ __forceinline__ unsigned f2bf(float f) { unsigned u = __builtin_bit_cast(unsigned, f); return (u + 0x7fffu + ((u >> 16) & 1u)) >> 16; }
__device__ __forceinline__ unsigned pk2(float lo, float hi) { return f2bf(lo) | (f2bf(hi) << 16); }
__device__ __forceinline__ float bflo(unsigned w) { return __builtin_bit_cast(float, w << 16); }
__device__ __forceinline__ float bfhi(unsigned w) { return __builtin_bit_cast(float, w & 0xffff0000u); }
__device__ __forceinline__ float bf2f(bf16 h) { return __builtin_bit_cast(float, (unsigned)h << 16); }
__device__ __forceinline__ unsigned f2u(float x) { return __builtin_bit_cast(unsigned, x); }
__device__ __forceinline__ float u2f(unsigned x) { return __builtin_bit_cast(float, x); }
__device__ __forceinline__ float dot2bf(unsigned a, unsigned b, float acc) { typedef __bf16 bf2_ __attribute__((ext_vector_type(2))); return __builtin_amdgcn_fdot2_f32_bf16(__builtin_bit_cast(bf2_, a), __builtin_bit_cast(bf2_, b), acc, false); }
__device__ __forceinline__ float wave_sum(float v) {
#pragma unroll
    for (int o = 1; o < 64; o <<= 1) v += __shfl_xor(v, o);
    return v;
}
__device__ __forceinline__ float wave_max(float v) {
#pragma unroll
    for (int o = 1; o < 64; o <<= 1) v = fmaxf(v, __shfl_xor(v, o));
    return v;
}
__device__ __forceinline__ float silu_f(float x) { return x / (1.f + __expf(-x)); }
__device__ __forceinline__ float sigmoid_f(float x) { return 1.f / (1.f + __expf(-x)); }
__device__ __forceinline__ float logsigmoid_f(float x) { return fminf(x, 0.f) - log1pf(__expf(-fabsf(x))); }
struct Args { const float* in[24]; float* out; unsigned char* ws; int ph_lo, ph_hi; };
#define XB_TMO      128
#define XB_XCNT(j)  (256  + 64 * (j))
#define XB_XSUB(j)  (1280 + 64 * (j))
#define XB_XGEN(j)  (2304 + 64 * (j))
#define XB_TOP      3328
#define XB_TOPGEN   3392
#define XCD_BAR_WORDS 3456
#define XB_SPIN_CAP (1u << 18)

__device__ __forceinline__ unsigned xb_ld(unsigned* p)              { return __hip_atomic_load(p, __ATOMIC_RELAXED, __HIP_MEMORY_SCOPE_AGENT); }
__device__ __forceinline__ unsigned xb_add(unsigned* p, unsigned v) { return __hip_atomic_fetch_add(p, v, __ATOMIC_RELAXED, __HIP_MEMORY_SCOPE_AGENT); }
__device__ __forceinline__ unsigned xb_xcc_id() { return (unsigned)__builtin_amdgcn_s_getreg((3 << 11) | 20) & 0xFu; }
#define XB_SPIN(cond, bar) do { unsigned _sp = 0; while (cond) { __builtin_amdgcn_s_sleep(1); \
    if ((++_sp & 255u) == 0u) { if (xb_ld(&(bar)[XB_TMO])) break; if (_sp > XB_SPIN_CAP) { atomicAdd(&(bar)[XB_TMO], 1u); break; } } } } while (0)

struct XcdBarrier {
    unsigned* bar; unsigned x;
    volatile LAS unsigned* st;
};

__device__ __forceinline__ XcdBarrier xcd_barrier_post(unsigned* bar, volatile LAS unsigned* st) {
    XcdBarrier b; b.bar = bar; b.x = xb_xcc_id(); b.st = st;
    if (threadIdx.x == 0) (void)xb_add(&bar[XB_XCNT(b.x)], 1u);
    return b;
}
__device__ __forceinline__ void xcd_barrier_complete(unsigned* bar, unsigned x, unsigned& nloc, unsigned& nx) {
    const unsigned G = gridDim.x * gridDim.y * gridDim.z;
    unsigned sum, cnt, mine, sp = 0u;
    for (;;) {
        sum = 0u; cnt = 0u; mine = 0u;
#pragma unroll
        for (unsigned j = 0; j < 16; ++j) { const unsigned c = xb_ld(&bar[XB_XCNT(j)]); sum += c; cnt += (c > 0u) ? 1u : 0u; mine = (j == x) ? c : mine; }
        if (sum == G) break;
        __builtin_amdgcn_s_sleep(1);
        if ((++sp & 255u) == 0u) { if (xb_ld(&bar[XB_TMO])) break; if (sp > XB_SPIN_CAP) { atomicAdd(&bar[XB_TMO], 1u); break; } }
    }
    nloc = mine > 0u ? mine : 1u; nx = cnt > 0u ? cnt : 1u;
}

__device__ __forceinline__ void xcd_barrier(const XcdBarrier& b) {
    asm volatile("s_waitcnt vmcnt(0)" ::: "memory");
    __syncthreads();
    if (threadIdx.x == 0) {
        unsigned* bar = b.bar;
        __builtin_amdgcn_s_waitcnt(0);
        unsigned nloc = b.st[0], nx = b.st[1];
        if (nloc == 0u) { xcd_barrier_complete(bar, b.x, nloc, nx); b.st[0] = nloc; b.st[1] = nx; }
        const unsigned old = xb_add(&bar[XB_XSUB(b.x)], 1u);
        const unsigned gen = old / nloc;
        if (old + 1u == (gen + 1u) * nloc) {
            __builtin_amdgcn_fence(__ATOMIC_RELEASE, "agent");
            asm volatile("s_waitcnt vmcnt(0)" ::: "memory");
            const unsigned og = xb_add(&bar[XB_TOP], 1u);
            const unsigned tg = og / nx;
            if (og + 1u == (tg + 1u) * nx) xb_add(&bar[XB_TOPGEN], 1u);
            else XB_SPIN(xb_ld(&bar[XB_TOPGEN]) == tg, bar);
            __builtin_amdgcn_fence(__ATOMIC_ACQUIRE, "agent");
            xb_add(&bar[XB_XGEN(b.x)], 1u);
            asm volatile("s_waitcnt vmcnt(0)" ::: "memory");
        } else {
            XB_SPIN(xb_ld(&bar[XB_XGEN(b.x)]) == gen, bar);
            __builtin_amdgcn_fence(__ATOMIC_ACQUIRE, "agent");
            asm volatile("s_waitcnt vmcnt(0)" ::: "memory");
        }
    }
    __syncthreads();
}
struct Frame {
    LAS unsigned char* lds;
    int wave, G, bid;
    float* out; unsigned char* ws;
};
#define WSP(T, off) ((T*)(F.ws + (off)))

__device__ __forceinline__ void p0_transpose_item(const float* W, int K, int ldw, int nblk, int thr, int shift, bf16* WT, LAS float* scr, int item, int lane) {
    const int kb = item / nblk, nb = item % nblk, k0 = 64 * kb, n0 = 32 * nb, ns = n0 + (n0 >= thr ? shift : 0);
#pragma unroll 8
    for (int i = 0; i < 32; ++i) { const int kk = 2 * i + (lane >> 5); scr[kk * 33 + (lane & 31)] = W[(size_t)(k0 + kk) * ldw + ns + (lane & 31)]; }
    LDS_WAIT(); asm volatile("" ::: "memory");
    const int c = lane & 7;
#pragma unroll
    for (int j = 0; j < 4; ++j) { const int n = (lane >> 3) + 8 * j; const LAS float* s = scr + (8 * c) * 33 + n;
        v4u o; o.x = pk2(s[0 * 33], s[1 * 33]); o.y = pk2(s[2 * 33], s[3 * 33]); o.z = pk2(s[4 * 33], s[5 * 33]); o.w = pk2(s[6 * 33], s[7 * 33]);
        *(GAS v4u*)(WT + (size_t)(n0 + n) * K + k0 + 8 * c) = o; }
    LDS_WAIT(); asm volatile("" ::: "memory");
}
__device__ __forceinline__ void cvt_f32_bf16_stream(const float* src, bf16* dst, size_t n8, size_t gtid, size_t gthreads) {
    for (size_t i = gtid; i < n8; i += gthreads) {
        const f32x4 a = *(const GAS f32x4*)(src + i * 8), b = *(const GAS f32x4*)(src + i * 8 + 4);
        v4u o; o.x = pk2(a.x, a.y); o.y = pk2(a.z, a.w); o.z = pk2(b.x, b.y); o.w = pk2(b.z, b.w);
        *(GAS v4u*)(dst + i * 8) = o; }
}
__device__ __forceinline__ void i8_row(const float* src_row, unsigned char* dst  , float* scale  , int er, int lane) {
    const float* r = src_row + 16 * lane;
    float x[16];
#pragma unroll
    for (int q4 = 0; q4 < 4; ++q4) { const f32x4 a = *(const GAS f32x4*)(r + 4 * q4); x[4 * q4] = a.x; x[4 * q4 + 1] = a.y; x[4 * q4 + 2] = a.z; x[4 * q4 + 3] = a.w; }
    float am = 0.f;
#pragma unroll
    for (int i = 0; i < 16; ++i) am = fmaxf(am, fabsf(x[i]));
    am = wave_max(am);
    const float inv = am > 1e-30f ? 127.f / am : 0.f;
    unsigned wd[4];
#pragma unroll
    for (int q4 = 0; q4 < 4; ++q4) { unsigned w = 0;
#pragma unroll
        for (int e = 0; e < 4; ++e) { const int qv = (int)rintf(x[4 * q4 + e] * inv); w |= ((unsigned)qv & 0xffu) << (8 * e); }
        wd[q4] = w; }
    v4u o; o.x = wd[0]; o.y = wd[1]; o.z = wd[2]; o.w = wd[3];
    *(GAS v4u*)(dst + ((size_t)((lane >> 3) * 16384 + er)) * 128 + 16 * (lane & 7)) = o;
    if (lane == 0) scale[er] = am * (1.f / 127.f);
}
__device__ __forceinline__ void i8_chunk(Frame& F, const Args& A, int layer, int c) {
    const int tbl = c >> 8, row0 = (c & 255) * 64 + F.wave * 8;
    const float* src = A.in[22 + tbl] + (size_t)layer * 16384 * 1024;
    unsigned char* dst = F.ws + (tbl ? WS_VB : WS_UB) + (size_t)layer * 8 * 16384 * 128;
    float* sc = WSP(float, tbl ? WS_ISV : WS_ISU) + layer * 16384;
    for (int i = 0; i < 8; ++i) i8_row(src + (size_t)(row0 + i) * 1024, dst, sc, row0 + i, ((int)(threadIdx.x & 63u)));
}
__device__ __forceinline__ void p0_prologue(Frame& F, const Args& A) {
    {
        const float* c = A.in[1]; const float* aw = A.in[2]; const float* ab = A.in[3]; float* MOD = WSP(float, WS_MOD);
        LAS float* red = (LAS float*)F.lds;
        for (int item = F.bid; item < 192; item += F.G) {
            const int l = item / 96, n0 = (item % 96) * 64;
            float acc[4] = {0.f, 0.f, 0.f, 0.f};
            const int kbeg = F.wave * 128;
#pragma unroll 4
            for (int k = kbeg; k < kbeg + 128; ++k) {
                const float wv = aw[((size_t)l * 1024 + k) * 6144 + n0 + ((int)(threadIdx.x & 63u))];
#pragma unroll
                for (int b = 0; b < 4; ++b) acc[b] += silu_f(c[b * 1024 + k]) * wv;
            }
#pragma unroll
            for (int b = 0; b < 4; ++b) red[(F.wave * 4 + b) * 64 + ((int)(threadIdx.x & 63u))] = acc[b];
            __syncthreads();
            if (((int)threadIdx.x) < 256) { const int b = ((int)threadIdx.x) >> 6, ln = ((int)threadIdx.x) & 63; float s = ab[l * 6144 + n0 + ln];
#pragma unroll
                for (int w = 0; w < 8; ++w) s += red[(w * 4 + b) * 64 + ln];
                MOD[(size_t)(l * 4 + b) * 6144 + n0 + ln] = s; }
            __syncthreads();
        }
    }
    if (F.bid == 0) {
        LAS unsigned* hist = (LAS unsigned*)F.lds;
        unsigned short* ORD = WSP(unsigned short, WS_ORD);
        for (int pass = 0; pass < 2; ++pass) {
            const int nunits = pass == 0 ? 2048 : 1024;
            if (((int)threadIdx.x) < 160) hist[((int)threadIdx.x)] = 0u;
            __syncthreads();
            for (int u = ((int)threadIdx.x); u < nunits; u += NTHR) {
                const int q = pass == 0 ? (u & 63) : (u & 31), h = pass == 0 ? ((u >> 6) & 7) : ((u >> 5) & 7);
                const float dcut = 46.f * (float)(2 << h);
                int cost;
                if (pass == 0) { const int nt = 2 * q + 2; int lo = (int)ceilf(((float)(q * 128) - dcut - 63.f) * (1.f / 64.f)); if (lo < 0) lo = 0; cost = nt - lo; }
                else { int lo = (int)ceilf(((float)(q * 256) - dcut - 255.f) * (1.f / 256.f)); if (lo < 0) lo = 0; int nb = q - lo; if (nb > 3 * 8) nb = 24; cost = 4 * (nb + 1); }
                if (cost > 159) cost = 159;
                atomicAdd((unsigned*)(hist + (159 - cost)), 1u);
            }
            __syncthreads();
            if (((int)threadIdx.x) == 0) { unsigned acc = 0; for (int i = 0; i < 160; ++i) { const unsigned c = hist[i]; hist[i] = acc; acc += c; } }
            __syncthreads();
            for (int u = ((int)threadIdx.x); u < nunits; u += NTHR) {
                const int q = pass == 0 ? (u & 63) : (u & 31), h = pass == 0 ? ((u >> 6) & 7) : ((u >> 5) & 7);
                const float dcut = 46.f * (float)(2 << h);
                int cost;
                if (pass == 0) { const int nt = 2 * q + 2; int lo = (int)ceilf(((float)(q * 128) - dcut - 63.f) * (1.f / 64.f)); if (lo < 0) lo = 0; cost = nt - lo; }
                else { int lo = (int)ceilf(((float)(q * 256) - dcut - 255.f) * (1.f / 256.f)); if (lo < 0) lo = 0; int nb = q - lo; if (nb > 3 * 8) nb = 24; cost = 4 * (nb + 1); }
                if (cost > 159) cost = 159;
                const unsigned pos = atomicAdd((unsigned*)(hist + (159 - cost)), 1u);
                ORD[(pass == 0 ? 0 : 2048) + pos] = (unsigned short)u;
            }
            __syncthreads();
        }
    }
    {
        LAS float* scr = (LAS float*)(F.lds + F.wave * 8704);
        const int gw = F.bid * NWAVES + F.wave, NGW = F.G * NWAVES;
        constexpr int I_IN0 = 16 * (NZ0 / 32), I_OUT = 16 * 32, I_IN1 = 16 * (NZ1 / 32), I_Q = 16 * (NQ / 32);
        constexpr int NITEMS = I_IN0 + 2 * I_OUT + I_IN1 + 2 * I_Q;
        for (int it = gw; it < NITEMS; it += NGW) {
            int r = it;
            if (r < I_IN0) { p0_transpose_item(A.in[6], D, SRC_IN0, NZ0 / 32, 2048, 8, WSP(bf16, WS_WIN0), scr, r, ((int)(threadIdx.x & 63u))); continue; } r -= I_IN0;
            if (r < I_OUT) { p0_transpose_item(A.in[13], D, D, 32, 1 << 30, 0, WSP(bf16, WS_WOUT0), scr, r, ((int)(threadIdx.x & 63u))); continue; } r -= I_OUT;
            if (r < I_IN1) { p0_transpose_item(A.in[14], D, NZ1, NZ1 / 32, 1 << 30, 0, WSP(bf16, WS_WIN1), scr, r, ((int)(threadIdx.x & 63u))); continue; } r -= I_IN1;
            if (r < I_OUT) { p0_transpose_item(A.in[19], D, D, 32, 1 << 30, 0, WSP(bf16, WS_WOUT1), scr, r, ((int)(threadIdx.x & 63u))); continue; } r -= I_OUT;
            if (r < I_Q) { p0_transpose_item(A.in[20], D, NQ, NQ / 32, 1 << 30, 0, WSP(bf16, WS_WQ), scr, r, ((int)(threadIdx.x & 63u))); continue; } r -= I_Q;
            p0_transpose_item(A.in[20] + (size_t)D * NQ, D, NQ, NQ / 32, 1 << 30, 0, WSP(bf16, WS_WQ) + (size_t)NQ * D, scr, r, ((int)(threadIdx.x & 63u)));
        }
    }
    {
        const size_t gtid = (size_t)F.bid * NTHR + ((int)threadIdx.x), gth = (size_t)F.G * NTHR;
        cvt_f32_bf16_stream(A.in[21], WSP(bf16, WS_KEYS), (size_t)2 * 2 * 128 * 128 / 8, gtid, gth);
    }
}

template <bool GATES>
__device__ __forceinline__ void norm_pass(Frame& F, const Args& A, const float* X, const float* g, const float* mod, int shc, bf16* XN) {
    LAS float* wgT = (LAS float*)F.lds;
    if (GATES) {
        const float* win = A.in[6];
        for (int i = ((int)threadIdx.x); i < 8 * 1024; i += NTHR) { const int cg = i >> 10, k = i & 1023; wgT[i] = win[(size_t)k * SRC_IN0 + 2048 + cg]; }
        __syncthreads();
    }
    const int gw = F.bid * NWAVES + F.wave, NGW = F.G * NWAVES;
    for (int row = gw; row < M; row += NGW) {
        const int b = row >> 13;
        const GAS f32x4* xr = (const GAS f32x4*)(X + (size_t)row * D) + ((int)(threadIdx.x & 63u));
        f32x4 v[4]; float ss = 0.f;
#pragma unroll
        for (int j = 0; j < 4; ++j) { v[j] = xr[64 * j]; ss += (v[j].x * v[j].x + v[j].y * v[j].y) + (v[j].z * v[j].z + v[j].w * v[j].w); }
        const float rstd = rsqrtf(wave_sum(ss) * (1.f / D) + EPS);
        const float* shp = mod + (size_t)b * 6144 + shc * 1024; const float* scp = shp + 1024;
#pragma unroll
        for (int j = 0; j < 4; ++j) { const int c = 4 * ((int)(threadIdx.x & 63u)) + 256 * j;
            const f32x4 gg = *(const f32x4*)(g + c), sc = *(const f32x4*)(scp + c), sh = *(const f32x4*)(shp + c);
            v[j] = v[j] * rstd * gg * (sc + 1.f) + sh;
            v2u o; o.x = pk2(v[j].x, v[j].y); o.y = pk2(v[j].z, v[j].w);
            *(GAS v2u*)(XN + (size_t)row * D + c) = o; }
        if (GATES) {
            float* GT = WSP(float, WS_GATES);
#pragma unroll
            for (int cg = 0; cg < 8; ++cg) { float p = 0.f;
#pragma unroll
                for (int j = 0; j < 4; ++j) { const f32x4 w = *(const LAS f32x4*)(wgT + cg * 1024 + 4 * ((int)(threadIdx.x & 63u)) + 256 * j); p += (v[j].x * w.x + v[j].y * w.y) + (v[j].z * w.z + v[j].w * w.w); }
                p = wave_sum(p);
                if (((int)(threadIdx.x & 63u)) == 0) GT[(size_t)row * 8 + cg] = p + (cg < 4 ? A.in[8][cg] : A.in[9][cg - 4]); }
        }
    }
}

__device__ __forceinline__ void qknorm_unit(Frame& F, bf16* Z, int ldz, int row0, int col0, const float* g, float gmul, float* kmean  ) {
    const int c = col0 + 8 * ((int)(threadIdx.x & 63u)), d0 = (8 * ((int)(threadIdx.x & 63u))) & 63;
    float gv[8];
#pragma unroll
    for (int i = 0; i < 8; ++i) gv[i] = g[d0 + i] * gmul;
    float ks[8] = {0.f, 0.f, 0.f, 0.f, 0.f, 0.f, 0.f, 0.f};
    for (int r = 0; r < 32; ++r) {
        bf16* p = Z + (size_t)(row0 + F.wave * 32 + r) * ldz + c;
        const v4u w = *(const GAS v4u*)p;
        float x[8] = {bflo(w.x), bfhi(w.x), bflo(w.y), bfhi(w.y), bflo(w.z), bfhi(w.z), bflo(w.w), bfhi(w.w)};
        float ss = 0.f;
#pragma unroll
        for (int i = 0; i < 8; ++i) ss += x[i] * x[i];
        ss += __shfl_xor(ss, 1); ss += __shfl_xor(ss, 2); ss += __shfl_xor(ss, 4);
        const float rstd = rsqrtf(ss * (1.f / 64.f) + EPS);
#pragma unroll
        for (int i = 0; i < 8; ++i) { x[i] = x[i] * rstd * gv[i]; ks[i] += x[i]; }
        v4u o; o.x = pk2(x[0], x[1]); o.y = pk2(x[2], x[3]); o.z = pk2(x[4], x[5]); o.w = pk2(x[6], x[7]);
        *(GAS v4u*)p = o;
    }
    if (kmean) {
        LAS float* red = (LAS float*)F.lds;
#pragma unroll
        for (int i = 0; i < 8; ++i) red[F.wave * 512 + 8 * ((int)(threadIdx.x & 63u)) + i] = ks[i];
        __syncthreads();
        { float s = 0.f;
#pragma unroll
          for (int w = 0; w < 8; ++w) s += red[w * 512 + ((int)threadIdx.x)];
          kmean[(size_t)(((int)threadIdx.x) >> 6) * (32 * 64) + (((int)threadIdx.x) & 63)] = s * (1.f / 256.f); }
        __syncthreads();
    }
}

__device__ __forceinline__ void kmean_unit(Frame& F, const bf16* Z, int ldz, int row0, int col0, float* kmean) {
    const int c = col0 + 8 * ((int)(threadIdx.x & 63u));
    float ks[8] = {0.f, 0.f, 0.f, 0.f, 0.f, 0.f, 0.f, 0.f};
#pragma unroll 4
    for (int r = 0; r < 32; ++r) {
        const v4u w = *(const GAS v4u*)(Z + (size_t)(row0 + F.wave * 32 + r) * ldz + c);
        ks[0] += bflo(w.x); ks[1] += bfhi(w.x); ks[2] += bflo(w.y); ks[3] += bfhi(w.y); ks[4] += bflo(w.z); ks[5] += bfhi(w.z); ks[6] += bflo(w.w); ks[7] += bfhi(w.w);
    }
    LAS float* red = (LAS float*)F.lds;
#pragma unroll
    for (int i = 0; i < 8; ++i) red[F.wave * 512 + 8 * ((int)(threadIdx.x & 63u)) + i] = ks[i];
    __syncthreads();
    { float s = 0.f;
#pragma unroll
      for (int w = 0; w < 8; ++w) s += red[w * 512 + ((int)threadIdx.x)];
      kmean[(size_t)(((int)threadIdx.x) >> 6) * (32 * 64) + (((int)threadIdx.x) & 63)] = s * (1.f / 256.f); }
    __syncthreads();
}

constexpr int KSTRB = 144;
template <int DV> struct VStr { static constexpr int B = (DV == 64) ? 192 : 320; };
typedef short v4i16_t __attribute__((ext_vector_type(4)));
__device__ __forceinline__ s16x4 vtr(const LAS unsigned char* p) { return __builtin_bit_cast(s16x4, __builtin_amdgcn_ds_read_tr16_b64_v4i16((LAS v4i16_t*)p)); }
__device__ __forceinline__ unsigned cvtpk(float lo, float hi) { typedef float f2 __attribute__((ext_vector_type(2))); typedef __bf16 b2 __attribute__((ext_vector_type(2)));
    f2 v = {lo, hi}; b2 b = __builtin_convertvector(v, b2); return __builtin_bit_cast(unsigned, b); }
__device__ __forceinline__ float xhalf(float v) {
    auto rr = __builtin_amdgcn_permlane32_swap(__builtin_bit_cast(unsigned, v), __builtin_bit_cast(unsigned, v), false, false);
    const unsigned r0 = rr[0], r1 = rr[1]; return u2f((threadIdx.x & 32) ? r0 : r1);
}
template <int DV> struct AttnSt { f32x16 o[DV / 32]; float m, l; };
template <int DV> __device__ __forceinline__ void attn_init(AttnSt<DV>& st) {
#pragma unroll
    for (int t = 0; t < DV / 32; ++t)
#pragma unroll
        for (int r = 0; r < 16; ++r) st.o[t][r] = 0.f;
    st.m = -1e30f; st.l = 0.f;
}
template <int DV>
__device__ __forceinline__ void attn_tile(AttnSt<DV>& st, const LAS unsigned char* Kt, const LAS unsigned char* Vt, const bf16x8 (&qf)[4], float sc2, float sl2, int tq, int kt0, bool diag, bool rowok, int lane, const int probe = 0) {
    const int r32 = lane & 31, hi = lane >> 5;
    const int kb = kt0 + 4 * hi;
    const float c0 = -sl2 * (float)(tq - kb);
    f32x16 s0, s1;
#pragma unroll
    for (int r = 0; r < 16; ++r) { const int ko = (r & 3) + 8 * (r >> 2); s0[r] = c0 + sl2 * (float)ko; s1[r] = c0 + sl2 * (float)(ko + 32); }
    const LAS unsigned char* kp = Kt + r32 * KSTRB + hi * 16;
#pragma unroll
    for (int ks = 0; ks < 4; ++ks) {
        const bf16x8 k0 = *(const LAS bf16x8*)(kp + ks * 32), k1 = *(const LAS bf16x8*)(kp + 32 * KSTRB + ks * 32);
        s0 = __builtin_amdgcn_mfma_f32_32x32x16_bf16(k0, qf[ks], s0, 0, 0, 0);
        s1 = __builtin_amdgcn_mfma_f32_32x32x16_bf16(k1, qf[ks], s1, 0, 0, 0);
    }
    if (diag || !rowok) {
#pragma unroll
        for (int r = 0; r < 16; ++r) { const int ko = (r & 3) + 8 * (r >> 2);
            if (!rowok || kb + ko > tq) s0[r] = -INFINITY;
            if (!rowok || kb + ko + 32 > tq) s1[r] = -INFINITY; }
    }
    if (probe != 1) {
    float mx = fmaxf(s0[0], s1[0]);
#pragma unroll
    for (int r = 1; r < 16; ++r) mx = fmaxf(mx, fmaxf(s0[r], s1[r]));
    mx = fmaxf(mx, xhalf(mx));
    if (__any(mx > st.m)) {
        const float mn = fmaxf(st.m, mx);
        const float alpha = __builtin_amdgcn_exp2f(st.m - mn);
        st.m = mn; st.l *= alpha;
#pragma unroll
        for (int t = 0; t < DV / 32; ++t)
#pragma unroll
            for (int r = 0; r < 16; ++r) st.o[t][r] *= alpha;
    }
    const float mn = st.m;
    float ps = 0.f;
#pragma unroll
    for (int r = 0; r < 16; ++r) { s0[r] = __builtin_amdgcn_exp2f(s0[r] - mn); s1[r] = __builtin_amdgcn_exp2f(s1[r] - mn); ps += s0[r] + s1[r]; }
    st.l += ps;
    }
    bf16x8 pf[2][2];
#pragma unroll
    for (int s = 0; s < 2; ++s) {
        v4u a, b;
        a.x = cvtpk(s0[8 * s + 0], s0[8 * s + 1]); a.y = cvtpk(s0[8 * s + 2], s0[8 * s + 3]); a.z = cvtpk(s0[8 * s + 4], s0[8 * s + 5]); a.w = cvtpk(s0[8 * s + 6], s0[8 * s + 7]);
        b.x = cvtpk(s1[8 * s + 0], s1[8 * s + 1]); b.y = cvtpk(s1[8 * s + 2], s1[8 * s + 3]); b.z = cvtpk(s1[8 * s + 4], s1[8 * s + 5]); b.w = cvtpk(s1[8 * s + 6], s1[8 * s + 7]);
        pf[0][s] = __builtin_bit_cast(bf16x8, a); pf[1][s] = __builtin_bit_cast(bf16x8, b);
    }
    constexpr int VS = VStr<DV>::B;
    const int g = lane >> 4, i16 = lane & 15;
    const LAS unsigned char* vp = Vt + (4 * (g >> 1) + (i16 >> 2)) * VS + (16 * (g & 1) + 4 * (i16 & 3)) * 2;
    if (probe != 2)
#pragma unroll
    for (int kbk = 0; kbk < 2; ++kbk)
#pragma unroll
        for (int s = 0; s < 2; ++s)
#pragma unroll
            for (int t = 0; t < DV / 32; ++t) {
                const s16x4 lo = vtr(vp + (kbk * 32 + 16 * s) * VS + t * 64), h8 = vtr(vp + (kbk * 32 + 16 * s + 8) * VS + t * 64);
                const bf16x8 va = {lo[0], lo[1], lo[2], lo[3], h8[0], h8[1], h8[2], h8[3]};
                st.o[t] = __builtin_amdgcn_mfma_f32_32x32x16_bf16(va, pf[kbk][s], st.o[t], 0, 0, 0);
            }
}
template <int NK, int DV> struct TileRegs { v4u k[NK]; v4u v[DV / 64]; };
template <int NK, int DV>
__device__ __forceinline__ void tile_load(TileRegs<NK, DV>& R, const bf16* Z, int ldz, size_t zrow0, int kcol, int vcol, int tid) {
#pragma unroll
    for (int i = 0; i < NK; ++i) { const int ch = tid + 512 * i; const int row = ch / (8 * NK), cc = ch % (8 * NK);
        R.k[i] = *(const GAS v4u*)(Z + (zrow0 + row) * ldz + kcol + cc * 8); }
#pragma unroll
    for (int i = 0; i < DV / 64; ++i) { const int ch = tid + 512 * i; const int row = ch / (DV / 8), cc = ch % (DV / 8);
        R.v[i] = *(const GAS v4u*)(Z + (zrow0 + row) * ldz + vcol + cc * 8); }
}
template <int NK, int DV>
__device__ __forceinline__ void tile_store(const TileRegs<NK, DV>& R, LAS unsigned char* Kt  , LAS unsigned char* Vt, int tid) {
#pragma unroll
    for (int i = 0; i < NK; ++i) { const int ch = tid + 512 * i; const int row = ch / (8 * NK), cc = ch % (8 * NK);
        *(LAS v4u*)(Kt + (cc >> 3) * (64 * KSTRB) + row * KSTRB + (cc & 7) * 16) = R.k[i]; }
#pragma unroll
    for (int i = 0; i < DV / 64; ++i) { const int ch = tid + 512 * i; const int row = ch / (DV / 8), cc = ch % (DV / 8);
        *(LAS v4u*)(Vt + row * VStr<DV>::B + cc * 16) = R.v[i]; }
}
__device__ __forceinline__ void moba_unit(Frame& F, int b, int h, int j, float tcut  ) {
    const bf16* Z = WSP(bf16, WS_Z); constexpr int ldz = NZ0;
    const int lane = ((int)(threadIdx.x & 63u)), w = F.wave, r32 = lane & 31, hi = lane >> 5, tid = ((int)threadIdx.x);
    const size_t rowb = (size_t)b * SEQ;
    const int qpos = j * 256 + w * 32 + r32;
    const int qcol = 2048 + h * 64, kcol = 2560 + h * 64, vcol = 3072 + h * 64;
    LAS unsigned char* lds = F.lds;
    constexpr int BUFB = 64 * KSTRB + 64 * VStr<64>::B;
    LAS unsigned char* kmh = lds + 2 * BUFB;
    LAS unsigned char* kml = lds + 2 * BUFB + 32 * KSTRB;
    LAS unsigned* msk = (LAS unsigned*)(lds + 2 * BUFB + 64 * KSTRB);
    { const float* KM = WSP(float, WS_KMEAN) + (size_t)((b * 8 + h) * 32) * 64; const f32x4 x = *(const f32x4*)(KM + 4 * tid);
      const int n = tid >> 4, d0 = (tid & 15) * 4;
      const unsigned h0 = f2bf(x.x), h1 = f2bf(x.y), h2 = f2bf(x.z), h3 = f2bf(x.w);
      v2u hv; hv.x = h0 | (h1 << 16); hv.y = h2 | (h3 << 16);
      v2u lv; lv.x = pk2(x.x - u2f(h0 << 16), x.y - u2f(h1 << 16)); lv.y = pk2(x.z - u2f(h2 << 16), x.w - u2f(h3 << 16));
      *(LAS v2u*)(kmh + n * KSTRB + d0 * 2) = hv; *(LAS v2u*)(kml + n * KSTRB + d0 * 2) = lv; }
    if (tid < 16) msk[tid] = 0u;
    bf16x8 qf[4];
    const bf16* qrow = Z + (rowb + qpos) * ldz + qcol;
#pragma unroll
    for (int ks = 0; ks < 4; ++ks) qf[ks] = *(const GAS bf16x8*)(qrow + 16 * ks + 8 * hi);
    __syncthreads();
    f32x16 gt;
#pragma unroll
    for (int r = 0; r < 16; ++r) gt[r] = 0.f;
#pragma unroll
    for (int ks = 0; ks < 4; ++ks) {
        const bf16x8 a = *(const LAS bf16x8*)(kmh + r32 * KSTRB + hi * 16 + ks * 32), c = *(const LAS bf16x8*)(kml + r32 * KSTRB + hi * 16 + ks * 32);
        gt = __builtin_amdgcn_mfma_f32_32x32x16_bf16(a, qf[ks], gt, 0, 0, 0);
        gt = __builtin_amdgcn_mfma_f32_32x32x16_bf16(c, qf[ks], gt, 0, 0, 0);
    }
    float t0 = -INFINITY, t1 = -INFINITY, t2 = -INFINITY;
#define INS3(key) do { float k_ = (key); float a_ = fmaxf(t0, k_), l_ = fminf(t0, k_); t0 = a_; a_ = fmaxf(t1, l_); l_ = fminf(t1, l_); t1 = a_; t2 = fmaxf(t2, l_); } while (0)
#pragma unroll
    for (int r = 0; r < 16; ++r) { const int n = (r & 3) + 8 * (r >> 2) + 4 * hi;
        const float key = (n < j) ? u2f((f2u(gt[r]) & ~31u) | (unsigned)n) : -INFINITY; INS3(key); }
    { const float p0 = xhalf(t0), p1 = xhalf(t1), p2 = xhalf(t2); INS3(p0); INS3(p1); INS3(p2); }
#undef INS3
    const int sel0 = (t0 > -INFINITY) ? (int)(f2u(t0) & 31u) : -1;
    const int sel1 = (t1 > -INFINITY) ? (int)(f2u(t1) & 31u) : -1;
    const int sel2 = (t2 > -INFINITY) ? (int)(f2u(t2) & 31u) : -1;
    { const unsigned mm = (sel0 >= 0 ? 1u << sel0 : 0u) | (sel1 >= 0 ? 1u << sel1 : 0u) | (sel2 >= 0 ? 1u << sel2 : 0u);
      if (mm) { __hip_atomic_fetch_or(msk + w, mm, __ATOMIC_RELAXED, __HIP_MEMORY_SCOPE_WORKGROUP); __hip_atomic_fetch_or(msk + 8, mm, __ATOMIC_RELAXED, __HIP_MEMORY_SCOPE_WORKGROUP); } }
    __syncthreads();
    const float slope = ldexpf(1.f, -(h + 1)), dcut = tcut / slope;
    const float sl2 = slope * LOG2E, sc2 = 0.125f * LOG2E;
    int nlo = (int)ceilf(((float)(j * 256) - dcut - 255.f) * (1.f / 256.f)); if (nlo < 0) nlo = 0;
    const unsigned keep = nlo >= 32 ? 0u : (0xffffffffu << nlo);
    const unsigned bmask = msk[8] & keep; const unsigned wmask = (unsigned)__builtin_amdgcn_readfirstlane((int)msk[w]) & keep;
    AttnSt<64> st; attn_init<64>(st);
    unsigned rem = bmask;
    int blk = j, kt = 3, buf = 0;
    TileRegs<1, 64> R;
    tile_load<1, 64>(R, Z, ldz, rowb + blk * 256 + kt * 64, kcol, vcol, tid);
    tile_store<1, 64>(R, lds, lds + 64 * KSTRB, tid);
    __syncthreads();
    for (;;) {
        int nblk = blk, nkt = kt - 1; bool has_next = true;
        if (nkt < 0) { nkt = 3; if (rem) { nblk = 31 - __builtin_clz(rem); rem &= ~(1u << nblk); } else has_next = false; }
        if (has_next) tile_load<1, 64>(R, Z, ldz, rowb + nblk * 256 + nkt * 64, kcol, vcol, tid);
        const bool own = (blk == j);
        const bool active = (own ? (kt * 64 <= w * 32 + 31) : (((wmask >> blk) & 1u) != 0u)) && ((float)(j * 256 + w * 32 - (blk * 256 + kt * 64 + 63)) <= dcut);
        if (active) {
            const bool rowok = own || blk == sel0 || blk == sel1 || blk == sel2;
            const bool diag = own && (kt * 64 + 63 > w * 32);
            attn_tile<64>(st, lds + buf * BUFB, lds + buf * BUFB + 64 * KSTRB, qf, sc2, sl2, qpos, blk * 256 + kt * 64, diag, rowok, lane);
        }
        if (!has_next) break;
        tile_store<1, 64>(R, lds + (buf ^ 1) * BUFB, lds + (buf ^ 1) * BUFB + 64 * KSTRB, tid);
        __syncthreads();
        buf ^= 1; blk = nblk; kt = nkt;
    }
    const float inv = 1.f / (st.l + xhalf(st.l));
    bf16* Y = WSP(bf16, WS_XNY) + (rowb + qpos) * 1024 + 512 + h * 64;
#pragma unroll
    for (int t = 0; t < 2; ++t)
#pragma unroll
        for (int rg = 0; rg < 4; ++rg) { v2u o; o.x = pk2(st.o[t][4 * rg] * inv, st.o[t][4 * rg + 1] * inv); o.y = pk2(st.o[t][4 * rg + 2] * inv, st.o[t][4 * rg + 3] * inv);
            *(GAS v2u*)(Y + t * 32 + 8 * rg + 4 * hi) = o; }
    __syncthreads();
}

__device__ __forceinline__ void diff_unit(Frame& F, const Args& A, int b, int h, int qt, float lam, float tcut, const int probe) {
    const bf16* Z = WSP(bf16, WS_Z); constexpr int ldz = NZ1;
    const int lane = ((int)(threadIdx.x & 63u)), w = F.wave, r32 = lane & 31, hi = lane >> 5, tid = ((int)threadIdx.x);
    const int comp = w >> 2, wq = w & 3;
    const size_t rowb = (size_t)b * SEQ;
    const int q0 = qt * 128, qpos = q0 + wq * 32 + r32;
    const int qcol = h * 128 + comp * 64, kcol = 1024 + h * 128, vcol = 2048 + h * 128;
    LAS unsigned char* lds = F.lds;
    constexpr int BUFB = 2 * 64 * KSTRB + 64 * VStr<128>::B;
    bf16x8 qf[4];
    const bf16* qrow = Z + (rowb + qpos) * ldz + qcol;
#pragma unroll
    for (int ks = 0; ks < 4; ++ks) qf[ks] = *(const GAS bf16x8*)(qrow + 16 * ks + 8 * hi);
    const float slope = ldexpf(1.f, -(h + 1)), dcut = tcut / slope;
    const float sl2 = slope * LOG2E, sc2 = 0.125f * LOG2E;
    AttnSt<128> st; attn_init<128>(st);
    const int nt = (q0 + 128) / 64;
    int kt_lo = (int)ceilf(((float)q0 - dcut - 63.f) * (1.f / 64.f)); if (kt_lo < 0) kt_lo = 0;
    TileRegs<2, 128> R;
    tile_load<2, 128>(R, Z, ldz, rowb + (size_t)(nt - 1) * 64, kcol, vcol, tid);
    tile_store<2, 128>(R, lds, lds + 2 * 64 * KSTRB, tid);
    __syncthreads();
    int buf = 0;
    for (int kt = nt - 1; kt >= kt_lo; --kt) {
        const bool has_next = kt > kt_lo;
        if (has_next) tile_load<2, 128>(R, Z, ldz, rowb + (size_t)(kt - 1) * 64, kcol, vcol, tid);
        if (kt * 64 <= q0 + wq * 32 + 31) {
            const bool diag = kt * 64 + 63 > q0 + wq * 32;
            attn_tile<128>(st, lds + buf * BUFB + comp * (64 * KSTRB), lds + buf * BUFB + 2 * 64 * KSTRB, qf, sc2, sl2, qpos, kt * 64, diag, true, lane, probe);
        }
        if (has_next) { tile_store<2, 128>(R, lds + (buf ^ 1) * BUFB, lds + (buf ^ 1) * BUFB + 2 * 64 * KSTRB, tid); }
        __syncthreads();
        buf ^= 1;
    }
    const float inv = 1.f / (st.l + xhalf(st.l));
    LAS float* o2 = (LAS float*)lds;
    if (comp == 1) {
#pragma unroll
        for (int t = 0; t < 4; ++t)
#pragma unroll
            for (int r = 0; r < 16; ++r) o2[((wq * 4 + t) * 16 + r) * 64 + lane] = st.o[t][r] * inv;
    }
    __syncthreads();
    if (comp == 0) {
        float ss = 0.f;
#pragma unroll
        for (int t = 0; t < 4; ++t)
#pragma unroll
            for (int r = 0; r < 16; ++r) { const float v = st.o[t][r] * inv - lam * o2[((wq * 4 + t) * 16 + r) * 64 + lane]; st.o[t][r] = v; ss += v * v; }
        ss += xhalf(ss);
        const float rs = rsqrtf(ss * (1.f / 128.f) + EPS) * 0.6444909324090307f;
        const float* og = A.in[18];
        bf16* Y = WSP(bf16, WS_XNY) + (rowb + qpos) * 1024 + h * 128;
#pragma unroll
        for (int t = 0; t < 4; ++t)
#pragma unroll
            for (int rg = 0; rg < 4; ++rg) { const int dv = t * 32 + 8 * rg + 4 * hi; const f32x4 gg = *(const f32x4*)(og + dv);
                v2u o; o.x = pk2(st.o[t][4 * rg] * rs * gg.x, st.o[t][4 * rg + 1] * rs * gg.y); o.y = pk2(st.o[t][4 * rg + 2] * rs * gg.z, st.o[t][4 * rg + 3] * rs * gg.w);
                *(GAS v2u*)(Y + dv) = o; }
    }
    __syncthreads();
}
template <int MT, int NT>
__device__ __forceinline__ void mma_nt(const LAS unsigned char* A, int lda, const LAS unsigned char* B, int ldb, int K, f32x4 (&acc)[MT][NT], int lane) {
    const int r = lane & 15, kq = (lane >> 4) * 16;
    for (int k0 = 0; k0 < K; k0 += 32) {
        bf16x8 a[MT], bb[NT];
#pragma unroll
        for (int m = 0; m < MT; ++m) a[m] = *(const LAS bf16x8*)(A + (m * 16 + r) * lda + k0 * 2 + kq);
#pragma unroll
        for (int n = 0; n < NT; ++n) bb[n] = *(const LAS bf16x8*)(B + (n * 16 + r) * ldb + k0 * 2 + kq);
#pragma unroll
        for (int m = 0; m < MT; ++m)
#pragma unroll
            for (int n = 0; n < NT; ++n) acc[m][n] = __builtin_amdgcn_mfma_f32_16x16x32_bf16(a[m], bb[n], acc[m][n], 0, 0, 0);
    }
}
constexpr int TS = 272;
constexpr int TILEB = 128 * TS;
constexpr int ML_Q = 0, ML_K = TILEB, ML_V = 2 * TILEB, ML_SM = 3 * TILEB;

__device__ __forceinline__ void ml_gates(const float* GT, size_t row0, int hm, LAS float* sm, int lane) {
    const float i0 = GT[(row0 + 2 * lane) * 8 + hm], i1 = GT[(row0 + 2 * lane + 1) * 8 + hm];
    const float f0 = logsigmoid_f(GT[(row0 + 2 * lane) * 8 + 4 + hm]), f1 = logsigmoid_f(GT[(row0 + 2 * lane + 1) * 8 + 4 + hm]);
    float s = f0 + f1;
#pragma unroll
    for (int o = 1; o < 64; o <<= 1) { const float t = __shfl_up(s, o); if (lane >= o) s += t; }
    const float excl = s - (f0 + f1);
    sm[2 * lane] = excl + f0; sm[2 * lane + 1] = excl + f0 + f1;
    sm[128 + 2 * lane] = i0; sm[128 + 2 * lane + 1] = i1;
}
template <bool TRANSPOSE>
__device__ __forceinline__ void ml_conv_tile(const bf16* Z, size_t rowb, int t0, int zc, const float* cw, int wc, float mul, LAS unsigned char* dst, const LAS float* rs, int tid) {
#pragma unroll
    for (int it = 0; it < 4; ++it) {
        const int item = tid + 512 * it, l = item >> 4, ch = (item & 15) * 8;
        float acc[8];
#pragma unroll
        for (int i = 0; i < 8; ++i) acc[i] = 0.f;
#pragma unroll
        for (int jj = 0; jj < 4; ++jj) {
            const int t = t0 + l - 3 + jj;
            if (t >= 0) {
                const v4u w = *(const GAS v4u*)(Z + (rowb + t) * NZ0 + zc + ch);
                const float x[8] = {bflo(w.x), bfhi(w.x), bflo(w.y), bfhi(w.y), bflo(w.z), bfhi(w.z), bflo(w.w), bfhi(w.w)};
                const f32x4 c0 = *(const f32x4*)(cw + jj * 1024 + wc + ch), c1 = *(const f32x4*)(cw + jj * 1024 + wc + ch + 4);
                acc[0] += x[0] * c0.x; acc[1] += x[1] * c0.y; acc[2] += x[2] * c0.z; acc[3] += x[3] * c0.w;
                acc[4] += x[4] * c1.x; acc[5] += x[5] * c1.y; acc[6] += x[6] * c1.z; acc[7] += x[7] * c1.w;
            }
        }
        const float sc = TRANSPOSE ? mul * rs[l] : mul;
#pragma unroll
        for (int i = 0; i < 8; ++i) acc[i] = silu_f(acc[i]) * sc;
        if (TRANSPOSE) {
#pragma unroll
            for (int i = 0; i < 8; ++i) *(LAS bf16*)(dst + (ch + i) * TS + l * 2) = (bf16)f2bf(acc[i]);
        } else {
            v4u o; o.x = pk2(acc[0], acc[1]); o.y = pk2(acc[2], acc[3]); o.z = pk2(acc[4], acc[5]); o.w = pk2(acc[6], acc[7]);
            *(LAS v4u*)(dst + l * TS + ch * 2) = o;
        }
    }
}
__device__ __forceinline__ void ml_vt_tile(const bf16* Z, size_t row0, int zc, LAS unsigned char* dst, int tid) {
#pragma unroll
    for (int it = 0; it < 4; ++it) {
        const int item = tid + 512 * it, l = item >> 4, ch = (item & 15) * 8;
        const v4u w = *(const GAS v4u*)(Z + (row0 + l) * NZ0 + zc + ch);
        const unsigned ww[4] = {w.x, w.y, w.z, w.w};
#pragma unroll
        for (int i = 0; i < 4; ++i) { *(LAS bf16*)(dst + (ch + 2 * i) * TS + l * 2) = (bf16)(ww[i] & 0xffffu); *(LAS bf16*)(dst + (ch + 2 * i + 1) * TS + l * 2) = (bf16)(ww[i] >> 16); }
    }
}
__device__ __forceinline__ void mlstm_a_unit(Frame& F, const Args& A, int unit) {
    const int c = unit & 63, bh = unit >> 6, hm = bh & 3, b = bh >> 2;
    const bf16* Z = WSP(bf16, WS_Z); const float* GT = WSP(float, WS_GATES);
    const size_t rowb = (size_t)b * SEQ; const int t0 = c * 128;
    LAS unsigned char* lds = F.lds; LAS float* sm = (LAS float*)(lds + ML_SM);
    if (F.wave == 0) {
        ml_gates(GT, rowb + t0, hm, sm, ((int)(threadIdx.x & 63u)));
        LDS_WAIT();
        const float bend = sm[127];
        const float w0 = bend - sm[2 * ((int)(threadIdx.x & 63u))] + sm[128 + 2 * ((int)(threadIdx.x & 63u))], w1 = bend - sm[2 * ((int)(threadIdx.x & 63u)) + 1] + sm[128 + 2 * ((int)(threadIdx.x & 63u)) + 1];
        const float ml = wave_max(fmaxf(w0, w1));
        sm[256 + 2 * ((int)(threadIdx.x & 63u))] = __expf(w0 - ml); sm[256 + 2 * ((int)(threadIdx.x & 63u)) + 1] = __expf(w1 - ml);
        if (((int)(threadIdx.x & 63u)) == 0) { WSP(float, WS_BEND)[unit] = bend; WSP(float, WS_MLOC)[unit] = ml; }
    }
    __syncthreads();
    ml_conv_tile<true>(Z, rowb, t0, 512 + hm * 128, A.in[7], 512 + hm * 128, 0.08838834764831845f, lds + ML_K, sm + 256, ((int)threadIdx.x));
    ml_vt_tile(Z, rowb + t0, 1024 + hm * 128, lds + ML_V, ((int)threadIdx.x));
    __syncthreads();
    f32x4 acc[2][4];
#pragma unroll
    for (int m = 0; m < 2; ++m)
#pragma unroll
        for (int n = 0; n < 4; ++n) acc[m][n] = (f32x4){0.f, 0.f, 0.f, 0.f};
    const int dv0 = 32 * (F.wave >> 1), dk0 = 64 * (F.wave & 1);
    mma_nt<2, 4>(lds + ML_V + dv0 * TS, TS, lds + ML_K + dk0 * TS, TS, 128, acc, ((int)(threadIdx.x & 63u)));
    float* CL = WSP(float, WS_CLOC) + (size_t)unit * 16384;
#pragma unroll
    for (int m = 0; m < 2; ++m)
#pragma unroll
        for (int n = 0; n < 4; ++n)
#pragma unroll
            for (int i = 0; i < 4; ++i) CL[(size_t)(dv0 + 16 * m + 4 * (((int)(threadIdx.x & 63u)) >> 4) + i) * 128 + dk0 + 16 * n + (((int)(threadIdx.x & 63u)) & 15)] = acc[m][n][i];
    if (((int)threadIdx.x) < 128) { float s = 0.f; const LAS bf16* kr = (const LAS bf16*)(lds + ML_K + ((int)threadIdx.x) * TS);
        for (int l = 0; l < 128; ++l) s += bf2f(kr[l]);
        WSP(float, WS_NLOC)[(size_t)unit * 128 + ((int)threadIdx.x)] = s; }
    __syncthreads();
}
__device__ __forceinline__ void mlstm_scan_unit(Frame& F, int unit) {
    const int bh = unit >> 4, sl = unit & 15;
    LAS float* tab = (LAS float*)F.lds;
    if (((int)threadIdx.x) == 0) {
        const float* BE = WSP(float, WS_BEND) + bh * 64; const float* ML = WSP(float, WS_MLOC) + bh * 64; float* MP = WSP(float, WS_MPREV) + bh * 64;
        float m = 0.f;
        for (int c = 0; c < 64; ++c) { const float be = BE[c], ml = ML[c]; const float mn = fmaxf(be + m, ml);
            tab[c] = __expf(be + m - mn); tab[64 + c] = __expf(ml - mn); if (sl == 0) MP[c] = m; m = mn; }
    }
    __syncthreads();
    float* CL = WSP(float, WS_CLOC) + (size_t)bh * 64 * 16384 + sl * 1024 + 2 * ((int)threadIdx.x);
    float s0 = 0.f, s1 = 0.f;
#pragma unroll 8
    for (int c = 0; c < 64; ++c) { float2* p = (float2*)(CL + (size_t)c * 16384); const float2 v = *p; *p = make_float2(s0, s1);
        const float a = tab[c], sc = tab[64 + c]; s0 = a * s0 + sc * v.x; s1 = a * s1 + sc * v.y; }
    if (sl == 0 && ((int)threadIdx.x) < 128) { float* NL = WSP(float, WS_NLOC) + (size_t)bh * 64 * 128 + ((int)threadIdx.x); float s = 0.f;
        for (int c = 0; c < 64; ++c) { const float v = NL[c * 128]; NL[c * 128] = s; s = tab[c] * s + tab[64 + c] * v; } }
    __syncthreads();
}
__device__ __forceinline__ void mlstm_c_unit(Frame& F, const Args& A, int unit) {
    const int c = unit & 63, bh = unit >> 6, hm = bh & 3, b = bh >> 2;
    const bf16* Z = WSP(bf16, WS_Z); const float* GT = WSP(float, WS_GATES);
    const size_t rowb = (size_t)b * SEQ; const int t0 = c * 128;
    LAS unsigned char* lds = F.lds; LAS float* sm = (LAS float*)(lds + ML_SM);
    const int lane = ((int)(threadIdx.x & 63u)), w = F.wave, tid = ((int)threadIdx.x);
    const float mprev = WSP(float, WS_MPREV)[unit];
    if (w == 0) {
        ml_gates(GT, rowb + t0, hm, sm, lane);
        LDS_WAIT();
        const float b0 = sm[2 * lane], b1 = sm[2 * lane + 1];
        const float g0 = sm[128 + 2 * lane] - b0, g1 = sm[128 + 2 * lane + 1] - b1;
        float pm = fmaxf(g0, g1);
#pragma unroll
        for (int o = 1; o < 64; o <<= 1) { const float t = __shfl_up(pm, o); if (lane >= o) pm = fmaxf(pm, t); }
        float pe = __shfl_up(pm, 1); if (lane == 0) pe = -INFINITY;
        const float M0 = fmaxf(mprev, fmaxf(pe, g0)), M1 = fmaxf(mprev, pm);
        sm[256 + 2 * lane] = g0; sm[256 + 2 * lane + 1] = g1;
        sm[384 + 2 * lane] = M0; sm[384 + 2 * lane + 1] = M1;
        sm[512 + 2 * lane] = __expf(mprev - M0); sm[512 + 2 * lane + 1] = __expf(mprev - M1);
        sm[640 + 2 * lane] = __expf(-b0 - M0); sm[640 + 2 * lane + 1] = __expf(-b1 - M1);
        sm[768 + 2 * lane] = 0.f; sm[768 + 2 * lane + 1] = 0.f; sm[896 + 2 * lane] = 0.f; sm[896 + 2 * lane + 1] = 0.f;
    }
    if (w == 1) { sm[1152 + lane] = WSP(float, WS_NLOC)[(size_t)unit * 128 + lane]; sm[1152 + 64 + lane] = WSP(float, WS_NLOC)[(size_t)unit * 128 + 64 + lane]; }
    ml_conv_tile<false>(Z, rowb, t0, hm * 128, A.in[7], hm * 128, 1.f, lds + ML_Q, nullptr, tid);
    ml_conv_tile<false>(Z, rowb, t0, 512 + hm * 128, A.in[7], 512 + hm * 128, 0.08838834764831845f, lds + ML_K, nullptr, tid);
    ml_vt_tile(Z, rowb + t0, 1024 + hm * 128, lds + ML_V, tid);
    __syncthreads();
    const int l0 = 32 * (w >> 1), c0 = 64 * (w & 1);
    const int lr = 4 * (lane >> 4), lc = lane & 15;
    if (tid < 128) { const LAS bf16* qr = (const LAS bf16*)(lds + ML_Q + tid * TS); float s = 0.f;
        for (int d = 0; d < 128; ++d) s += bf2f(qr[d]) * sm[1152 + d];
        sm[1024 + tid] = s; }
    f32x4 acc[2][4];
#pragma unroll
    for (int m = 0; m < 2; ++m)
#pragma unroll
        for (int n = 0; n < 4; ++n) acc[m][n] = (f32x4){0.f, 0.f, 0.f, 0.f};
    mma_nt<2, 4>(lds + ML_Q + l0 * TS, TS, lds + ML_K + c0 * TS, TS, 128, acc, lane);
#pragma unroll
    for (int m = 0; m < 2; ++m)
#pragma unroll
        for (int i = 0; i < 4; ++i) { const int l = l0 + 16 * m + lr + i; const float Ml = sm[384 + l]; float rsum = 0.f;
#pragma unroll
            for (int n = 0; n < 4; ++n) { const int s = c0 + 16 * n + lc; const float v = (s <= l) ? acc[m][n][i] * __expf(sm[256 + s] - Ml) : 0.f; acc[m][n][i] = v; rsum += v; }
            rsum += __shfl_xor(rsum, 1); rsum += __shfl_xor(rsum, 2); rsum += __shfl_xor(rsum, 4); rsum += __shfl_xor(rsum, 8);
            if (lc == 0) __hip_atomic_fetch_add(sm + 768 + l, rsum, __ATOMIC_RELAXED, __HIP_MEMORY_SCOPE_WORKGROUP); }
    __syncthreads();
#pragma unroll
    for (int m = 0; m < 2; ++m)
#pragma unroll
        for (int n = 0; n < 4; ++n)
#pragma unroll
            for (int i = 0; i < 4; ++i) *(LAS bf16*)(lds + ML_K + (l0 + 16 * m + lr + i) * TS + (c0 + 16 * n + lc) * 2) = (bf16)f2bf(acc[m][n][i]);
    __syncthreads();
    f32x4 ai[2][4], ae[2][4];
#pragma unroll
    for (int m = 0; m < 2; ++m)
#pragma unroll
        for (int n = 0; n < 4; ++n) { ai[m][n] = (f32x4){0.f, 0.f, 0.f, 0.f}; ae[m][n] = (f32x4){0.f, 0.f, 0.f, 0.f}; }
    mma_nt<2, 4>(lds + ML_K + l0 * TS, TS, lds + ML_V + c0 * TS, TS, 128, ai, lane);
    {
        const float* CP = WSP(float, WS_CLOC) + (size_t)unit * 16384;
        const int r = lane & 15, kq = (lane >> 4) * 8;
        for (int k0 = 0; k0 < 128; k0 += 32) {
            bf16x8 a[2], bb[4];
#pragma unroll
            for (int m = 0; m < 2; ++m) a[m] = *(const LAS bf16x8*)(lds + ML_Q + (l0 + m * 16 + r) * TS + (k0 + kq) * 2);
#pragma unroll
            for (int n = 0; n < 4; ++n) { const float* p = CP + (size_t)(c0 + n * 16 + r) * 128 + k0 + kq; const f32x4 x = *(const f32x4*)p, y = *(const f32x4*)(p + 4);
                v4u pk; pk.x = pk2(x.x, x.y); pk.y = pk2(x.z, x.w); pk.z = pk2(y.x, y.y); pk.w = pk2(y.z, y.w); bb[n] = __builtin_bit_cast(bf16x8, pk); }
#pragma unroll
            for (int m = 0; m < 2; ++m)
#pragma unroll
                for (int n = 0; n < 4; ++n) ae[m][n] = __builtin_amdgcn_mfma_f32_16x16x32_bf16(a[m], bb[n], ae[m][n], 0, 0, 0);
        }
    }
#pragma unroll
    for (int m = 0; m < 2; ++m)
#pragma unroll
        for (int i = 0; i < 4; ++i) { const int l = l0 + 16 * m + lr + i; const float wi = sm[512 + l];
            const float den = wi * sm[1024 + l] + sm[768 + l]; const float dinv = 1.f / fmaxf(fabsf(den), sm[640 + l]); float ssq = 0.f;
#pragma unroll
            for (int n = 0; n < 4; ++n) { const float hv = (wi * ae[m][n][i] + ai[m][n][i]) * dinv; ai[m][n][i] = hv; ssq += hv * hv; }
            ssq += __shfl_xor(ssq, 1); ssq += __shfl_xor(ssq, 2); ssq += __shfl_xor(ssq, 4); ssq += __shfl_xor(ssq, 8);
            if (lc == 0) __hip_atomic_fetch_add(sm + 896 + l, ssq, __ATOMIC_RELAXED, __HIP_MEMORY_SCOPE_WORKGROUP); }
    __syncthreads();
    const float* mg = A.in[10] + hm * 128;
    bf16* Y = WSP(bf16, WS_XNY);
#pragma unroll
    for (int m = 0; m < 2; ++m)
#pragma unroll
        for (int i = 0; i < 4; ++i) { const int l = l0 + 16 * m + lr + i; const float rstd = rsqrtf(sm[896 + l] * (1.f / 128.f) + EPS); const size_t row = rowb + t0 + l;
#pragma unroll
            for (int n = 0; n < 4; ++n) { const int dv = c0 + 16 * n + lc; const float og = sigmoid_f(bf2f(Z[row * NZ0 + 1536 + hm * 128 + dv]));
                Y[row * 1024 + hm * 128 + dv] = (bf16)f2bf(ai[m][n][i] * rstd * mg[dv] * og); } }
    __syncthreads();
}
template <int N> __device__ __forceinline__ void bitonic_sort_desc(float (&v)[N]) {
#pragma unroll
    for (int k = 2; k <= N; k <<= 1)
#pragma unroll
        for (int j = k >> 1; j > 0; j >>= 1)
#pragma unroll
            for (int i = 0; i < N; ++i) { const int l = i ^ j; if (l > i) { const bool desc = ((i & k) == 0); const float a = v[i], b = v[l]; const float mx = fmaxf(a, b), mn = fminf(a, b); v[i] = desc ? mx : mn; v[l] = desc ? mn : mx; } }
}
__device__ __forceinline__ void merge_top16(float (&run)[16], const float (&nw)[16]) {
#pragma unroll
    for (int i = 0; i < 16; ++i) run[i] = fmaxf(run[i], nw[15 - i]);
#pragma unroll
    for (int j = 8; j > 0; j >>= 1)
#pragma unroll
        for (int i = 0; i < 16; ++i) { const int l = i ^ j; if (l > i) { const float a = run[i], b = run[l]; run[i] = fmaxf(a, b); run[l] = fminf(a, b); } }
}
#ifndef EXPERT_SLOW
#define EXPERT_SLOW 0
#endif
#ifndef ROUTE_SLOW
#define ROUTE_SLOW 0
#endif
constexpr int SCS = 132;
__device__ __forceinline__ void peer_route_unit(Frame& F, int tok0, int hd, const bf16x8 (&kf)[4][2], const int PROBE) {
    const bf16* QRY = WSP(bf16, WS_QRY); int* IDX = WSP(int, WS_IDX); float* GATE = WSP(float, WS_GATE);
    LAS float* SC = (LAS float*)F.lds;
    const int lane = ((int)(threadIdx.x & 63u)), w = F.wave, tid = ((int)threadIdx.x);
    {
        constexpr int AST = 528;
        LAS unsigned char* As = F.lds;
#pragma unroll
        for (int i = 0; i < 8; ++i) { const int ch = tid + 512 * i, row = ch >> 5, cc = ch & 31;
            *(LAS v4u*)(As + row * AST + cc * 16) = *(const GAS v4u*)(QRY + (size_t)(tok0 + row) * NQ + hd * 256 + cc * 8); }
        __syncthreads();
        const int p = w & 1, nq = w >> 1, r = lane & 15, kq = (lane >> 4) * 16;
        f32x4 acc[8][2];
#pragma unroll
        for (int m = 0; m < 8; ++m) { acc[m][0] = (f32x4){0.f, 0.f, 0.f, 0.f}; acc[m][1] = (f32x4){0.f, 0.f, 0.f, 0.f}; }
#pragma unroll
        for (int ks = 0; ks < 4; ++ks)
#pragma unroll
            for (int m = 0; m < 8; ++m) { const bf16x8 a = *(const LAS bf16x8*)(As + (16 * m + r) * AST + p * 256 + ks * 64 + kq);
                acc[m][0] = __builtin_amdgcn_mfma_f32_16x16x32_bf16(a, kf[ks][0], acc[m][0], 0, 0, 0);
                acc[m][1] = __builtin_amdgcn_mfma_f32_16x16x32_bf16(a, kf[ks][1], acc[m][1], 0, 0, 0); }
        __syncthreads();
#pragma unroll
        for (int m = 0; m < 8; ++m)
#pragma unroll
            for (int n = 0; n < 2; ++n)
#pragma unroll
                for (int i = 0; i < 4; ++i) SC[(p * 128 + 16 * m + 4 * (lane >> 4) + i) * SCS + 32 * nq + 16 * n + r] = acc[m][n][i];
    }
    __syncthreads();
#if defined(CHECK) && CHECK
    if (tok0 == 0 && hd == 0) { float* DB = WSP(float, WS_CLOC) + 8 * 1024 * 1024; for (int i = tid; i < 2 * 128 * 128; i += NTHR) DB[i] = SC[(i >> 7) * SCS + (i & 127)]; }
    __syncthreads();
#endif
#if ROUTE_SLOW
    if (tid < 128) {
        const int t = tid;
        float s0[16], s1[16]; unsigned i0[16], i1[16];
        { const LAS float* row = SC + (0 * 128 + t) * SCS; float prev = INFINITY;
#pragma unroll
          for (int k = 0; k < 16; ++k) { float best = -INFINITY; unsigned bi = 0; for (int n = 0; n < 128; ++n) { const float v = row[n]; if (v < prev && v > best) { best = v; bi = n; } } s0[k] = best; i0[k] = bi; prev = best; } }
        { const LAS float* row = SC + (1 * 128 + t) * SCS; float prev = INFINITY;
#pragma unroll
          for (int k = 0; k < 16; ++k) { float best = -INFINITY; unsigned bi = 0; for (int n = 0; n < 128; ++n) { const float v = row[n]; if (v < prev && v > best) { best = v; bi = n; } } s1[k] = best; i1[k] = bi; prev = best; } }
        float top[16]; unsigned tid16[16];
        { float prev = INFINITY;
#pragma unroll
          for (int k = 0; k < 16; ++k) { float best = -INFINITY; unsigned be = 0;
#pragma unroll
              for (int i = 0; i < 16; ++i)
#pragma unroll
                  for (int j = 0; j < 16; ++j) if ((i + 1) * (j + 1) <= 16) { const float v = s0[i] + s1[j]; if (v < prev && v > best) { best = v; be = i0[i] * 128u + i1[j]; } }
              top[k] = best; tid16[k] = be; prev = best; } }
        float sc[16], den = 0.f;
#pragma unroll
        for (int k = 0; k < 16; ++k) { sc[k] = __expf(top[k] - top[0]); den += sc[k]; }
        const float inv = 1.f / den;
        const size_t ob = (size_t)(tok0 + t) * 128 + hd * 16;
#pragma unroll
        for (int k = 0; k < 16; ++k) { IDX[ob + k] = (int)tid16[k]; GATE[ob + k] = sc[k] * inv; }
    }
    __syncthreads();
#else
    if (PROBE < 2) {
        const int t = tid & 127, p = (tid >> 7) & 1, half = tid >> 8;
        LAS float* seg = SC + (p * 128 + t) * SCS + 64 * half;
        float run[16], nw[16];
#pragma unroll
        for (int ch = 0; ch < 4; ++ch) {
#pragma unroll
            for (int q = 0; q < 4; ++q) { const f32x4 v = *(const LAS f32x4*)(seg + 16 * ch + 4 * q);
#pragma unroll
                for (int e = 0; e < 4; ++e) { const unsigned n = (unsigned)(64 * half + 16 * ch + 4 * q + e); const float key = u2f((f2u(v[e]) & ~127u) | n);
                    if (ch == 0) run[4 * q + e] = key; else nw[4 * q + e] = key; } }
            if (ch == 0) bitonic_sort_desc<16>(run); else { bitonic_sort_desc<16>(nw); merge_top16(run, nw); }
        }
#pragma unroll
        for (int q = 0; q < 4; ++q) *(LAS f32x4*)(seg + 4 * q) = (f32x4){run[4 * q], run[4 * q + 1], run[4 * q + 2], run[4 * q + 3]};
    }
    __syncthreads();
    if (tid < 128 && PROBE < 1) {
        const int t = tid;
        float s0[16], s1[16];
        {
            LAS float* a = SC + (0 * 128 + t) * SCS; float nw[16];
#pragma unroll
            for (int q = 0; q < 4; ++q) { const f32x4 v = *(const LAS f32x4*)(a + 4 * q), u = *(const LAS f32x4*)(a + 64 + 4 * q);
#pragma unroll
                for (int e = 0; e < 4; ++e) { s0[4 * q + e] = v[e]; nw[4 * q + e] = u[e]; } }
            merge_top16(s0, nw);
#pragma unroll
            for (int q = 0; q < 4; ++q) *(LAS f32x4*)(a + 16 + 4 * q) = (f32x4){s0[4 * q], s0[4 * q + 1], s0[4 * q + 2], s0[4 * q + 3]};
        }
        {
            LAS float* a = SC + (1 * 128 + t) * SCS; float nw[16];
#pragma unroll
            for (int q = 0; q < 4; ++q) { const f32x4 v = *(const LAS f32x4*)(a + 4 * q), u = *(const LAS f32x4*)(a + 64 + 4 * q);
#pragma unroll
                for (int e = 0; e < 4; ++e) { s1[4 * q + e] = v[e]; nw[4 * q + e] = u[e]; } }
            merge_top16(s1, nw);
#pragma unroll
            for (int q = 0; q < 4; ++q) *(LAS f32x4*)(a + 16 + 4 * q) = (f32x4){s1[4 * q], s1[4 * q + 1], s1[4 * q + 2], s1[4 * q + 3]};
        }
#pragma unroll
        for (int i = 0; i < 16; ++i) { s0[i] = u2f(f2u(s0[i]) & ~127u); s1[i] = u2f(f2u(s1[i]) & ~127u); }
        constexpr int CNT[16] = {16, 8, 5, 4, 3, 2, 2, 2, 1, 1, 1, 1, 1, 1, 1, 1};
        constexpr int OFF[16] = {0, 16, 24, 29, 33, 36, 38, 40, 42, 43, 44, 45, 46, 47, 48, 49};
        float top[16], nw[16];
#pragma unroll
        for (int grp = 0; grp < 4; ++grp) {
#pragma unroll
            for (int e = 0; e < 16; ++e) nw[e] = -INFINITY;
#pragma unroll
            for (int i = 0; i < 16; ++i)
#pragma unroll
                for (int j = 0; j < 16; ++j) if (j < CNT[i] && (OFF[i] + j) / 16 == grp) {
                    const float sum = s0[i] + s1[j];
                    nw[(OFF[i] + j) % 16] = u2f((f2u(sum) & ~255u) | (unsigned)(i * 16 + j)); }
            bitonic_sort_desc<16>(nw);
            if (grp == 0) {
#pragma unroll
                for (int e = 0; e < 16; ++e) top[e] = nw[e];
            } else merge_top16(top, nw);
        }
#if defined(CHECK) && CHECK
        if (tok0 == 0 && hd == 0) { float* DB = WSP(float, WS_CLOC) + 8 * 1024 * 1024 + 32768;
#pragma unroll
            for (int i = 0; i < 16; ++i) { DB[t * 48 + i] = s0[i]; DB[t * 48 + 16 + i] = s1[i]; DB[t * 48 + 32 + i] = top[i]; } }
#endif
        float sc[16], den = 0.f;
        const float mx = u2f(f2u(top[0]) & ~255u);
#pragma unroll
        for (int k = 0; k < 16; ++k) { sc[k] = __expf(u2f(f2u(top[k]) & ~255u) - mx); den += sc[k]; }
        const float inv = 1.f / den;
        LDS_WAIT();
        const LAS unsigned* l0 = (const LAS unsigned*)(SC + (0 * 128 + t) * SCS + 16); const LAS unsigned* l1 = (const LAS unsigned*)(SC + (1 * 128 + t) * SCS + 16);
        const size_t ob = (size_t)(tok0 + t) * 128 + hd * 16;
        unsigned eid[16];
#pragma unroll
        for (int k = 0; k < 16; ++k) { const unsigned id = f2u(top[k]) & 255u; const unsigned e0 = l0[id >> 4] & 127u, e1 = l1[id & 15u] & 127u; eid[k] = e0 * 128u + e1; }
#pragma unroll
        for (int q4 = 0; q4 < 4; ++q4) { v4u iv; iv.x = eid[4 * q4]; iv.y = eid[4 * q4 + 1]; iv.z = eid[4 * q4 + 2]; iv.w = eid[4 * q4 + 3];
            *(GAS v4u*)(IDX + ob + 4 * q4) = iv; *(GAS f32x4*)(GATE + ob + 4 * q4) = (f32x4){sc[4 * q4] * inv, sc[4 * q4 + 1] * inv, sc[4 * q4 + 2] * inv, sc[4 * q4 + 3] * inv}; }
    }
    __syncthreads();
#endif
}
__device__ __forceinline__ void peer_u_phase(Frame& F, const unsigned char* U8  ) {
    const bf16* XN = WSP(bf16, WS_XNY); const int* IDX = WSP(int, WS_IDX); float* PART = WSP(float, WS_PART);
    const int lane = ((int)(threadIdx.x & 63u)), grp = lane >> 3, l8 = lane & 7;
    const int g = F.bid & 7, nsw = (F.G >> 3) * NWAVES, ws = (F.bid >> 3) * NWAVES + F.wave;
    const unsigned char* Ug = U8 + (size_t)g * 16384 * 128 + 16 * l8;
#define U_IDS(IDS, TOK) do { const int* ip_ = IDX + (size_t)(TOK) * 128 + 16 * grp; _Pragma("unroll") for (int q4 = 0; q4 < 4; ++q4) IDS[q4] = *(const GAS v4u*)(ip_ + 4 * q4); } while (0)
#define U_ROWS(W, HX, HY, IDS, TOK) do { _Pragma("unroll") for (int q4 = 0; q4 < 4; ++q4) { W[4 * q4] = *(const GAS v4u*)(Ug + (size_t)IDS[q4].x * 128); W[4 * q4 + 1] = *(const GAS v4u*)(Ug + (size_t)IDS[q4].y * 128); \
        W[4 * q4 + 2] = *(const GAS v4u*)(Ug + (size_t)IDS[q4].z * 128); W[4 * q4 + 3] = *(const GAS v4u*)(Ug + (size_t)IDS[q4].w * 128); } \
        const bf16* hp_ = XN + (size_t)(TOK) * D + 128 * g + 16 * l8; HX = *(const GAS v4u*)hp_; HY = *(const GAS v4u*)(hp_ + 8); } while (0)
#define U_COMPUTE(W, HX, HY, TOK) do { \
        const float hf_[16] = {bflo(HX.x), bfhi(HX.x), bflo(HX.y), bfhi(HX.y), bflo(HX.z), bfhi(HX.z), bflo(HX.w), bfhi(HX.w), bflo(HY.x), bfhi(HY.x), bflo(HY.y), bfhi(HY.y), bflo(HY.z), bfhi(HY.z), bflo(HY.w), bfhi(HY.w)}; \
        float am_ = 0.f; _Pragma("unroll") for (int i = 0; i < 16; ++i) am_ = fmaxf(am_, fabsf(hf_[i])); \
        am_ = fmaxf(am_, __shfl_xor(am_, 1)); am_ = fmaxf(am_, __shfl_xor(am_, 2)); am_ = fmaxf(am_, __shfl_xor(am_, 4)); \
        const float hinv_ = am_ > 1e-30f ? 127.f / am_ : 0.f, hsc_ = am_ * (1.f / 127.f); \
        int hq_[4]; _Pragma("unroll") for (int q4 = 0; q4 < 4; ++q4) { unsigned wv_ = 0; _Pragma("unroll") for (int e = 0; e < 4; ++e) { const int qv_ = (int)rintf(hf_[4 * q4 + e] * hinv_); wv_ |= ((unsigned)qv_ & 0xffu) << (8 * e); } hq_[q4] = (int)wv_; } \
        float r_[16]; _Pragma("unroll") for (int it = 0; it < 16; ++it) { const unsigned wx_ = W[it].x, wy_ = W[it].y, wz_ = W[it].z, ww_ = W[it].w; \
            int acc_ = __builtin_amdgcn_sdot4((int)wx_, hq_[0], 0, false); acc_ = __builtin_amdgcn_sdot4((int)wy_, hq_[1], acc_, false); acc_ = __builtin_amdgcn_sdot4((int)wz_, hq_[2], acc_, false); acc_ = __builtin_amdgcn_sdot4((int)ww_, hq_[3], acc_, false); \
            acc_ += __shfl_xor(acc_, 1); acc_ += __shfl_xor(acc_, 2); acc_ += __shfl_xor(acc_, 4); r_[it] = (float)acc_ * hsc_; } \
        if (l8 == 0) { float* pp_ = PART + ((size_t)g * M + (TOK)) * 128 + 16 * grp; _Pragma("unroll") for (int q4 = 0; q4 < 4; ++q4) *(GAS f32x4*)(pp_ + 4 * q4) = (f32x4){r_[4 * q4], r_[4 * q4 + 1], r_[4 * q4 + 2], r_[4 * q4 + 3]}; } } while (0)
    v4u idsA[4], idsB[4], wA[16], wB[16], hxA, hyA, hxB, hyB;
    const int tmax = M - 1;
    int t0 = ws;
    U_IDS(idsA, t0); U_IDS(idsB, min(t0 + nsw, tmax));
    for (; t0 < M; t0 += 2 * nsw) {
        const int t1 = t0 + nsw, t2 = t0 + 2 * nsw, t3 = t0 + 3 * nsw;
        U_ROWS(wA, hxA, hyA, idsA, t0);
        U_ROWS(wB, hxB, hyB, idsB, min(t1, tmax));
        U_IDS(idsA, min(t2, tmax));
        U_IDS(idsB, min(t3, tmax));
        U_COMPUTE(wA, hxA, hyA, t0);
        if (t1 < M) U_COMPUTE(wB, hxB, hyB, t1);
    }
#undef U_IDS
#undef U_ROWS
#undef U_COMPUTE
}
__device__ __forceinline__ void peer_act_phase(Frame& F, const float* ISU, const float* ISV) {
    const int* IDX = WSP(int, WS_IDX); const float* GATE = WSP(float, WS_GATE); const float* PART = WSP(float, WS_PART);
    unsigned short* ACT8 = WSP(unsigned short, WS_ACT); float* ACTS = WSP(float, WS_ACTS);
    const int gw = F.bid * NWAVES + F.wave, NGW = F.G * NWAVES, lane = ((int)(threadIdx.x & 63u));
    for (int tok = gw; tok < M; tok += NGW) {
        const size_t i = (size_t)tok * 128 + 2 * lane;
        float s0 = 0.f, s1 = 0.f;
#pragma unroll
        for (int g = 0; g < 8; ++g) { const float2 p = *(const float2*)(PART + (size_t)g * M * 128 + i); s0 += p.x; s1 += p.y; }
        const int2 id = *(const int2*)(IDX + i); const float2 gt = *(const float2*)(GATE + i);
        const float d0 = s0 * ISU[id.x], d1 = s1 * ISU[id.y];
        const float a0 = 0.5f * d0 * (1.f + erff(d0 * 0.70710678118654752f)) * gt.x * ISV[id.x], a1 = 0.5f * d1 * (1.f + erff(d1 * 0.70710678118654752f)) * gt.y * ISV[id.y];
        const float am = wave_max(fmaxf(fabsf(a0), fabsf(a1)));
        const float inv = am > 1e-30f ? 127.f / am : 0.f;
        const int q0 = (int)rintf(a0 * inv), q1 = (int)rintf(a1 * inv);
        ACT8[(size_t)tok * 64 + lane] = (unsigned short)(((unsigned)q0 & 0xffu) | (((unsigned)q1 & 0xffu) << 8));
        if (lane == 0) ACTS[tok] = am * (1.f / 127.f);
    }
}
__device__ __forceinline__ void peer_v_phase(Frame& F, const unsigned char* V8, const float* g2  , float dbg) {
    const int* IDX = WSP(int, WS_IDX); const unsigned* ACT8 = WSP(unsigned, WS_ACT); const float* ACTS = WSP(float, WS_ACTS);
    const int lane = ((int)(threadIdx.x & 63u)), t8 = lane >> 3, l8 = lane & 7;
    const int g = F.bid & 7, nsw = (F.G >> 3) * NWAVES, ws = (F.bid >> 3) * NWAVES + F.wave;
    const unsigned char* Vg = V8 + (size_t)g * 16384 * 128 + 16 * l8;
    for (int wi = ws; wi < M / 8; wi += nsw) {
        const int tok = wi * 8 + t8;
        const int* ip = IDX + (size_t)tok * 128; const unsigned* ap = ACT8 + (size_t)tok * 32;
        int acc[16];
#pragma unroll
        for (int i = 0; i < 16; ++i) acc[i] = 0;
#pragma unroll 2
        for (int gi = 0; gi < 32; ++gi) {
            const v4u id4 = *(const GAS v4u*)(ip + 4 * gi); const int qa = (int)ap[gi];
            const v4u ra = *(const GAS v4u*)(Vg + (size_t)id4.x * 128), rb = *(const GAS v4u*)(Vg + (size_t)id4.y * 128), rc = *(const GAS v4u*)(Vg + (size_t)id4.z * 128), rd = *(const GAS v4u*)(Vg + (size_t)id4.w * 128);
            const unsigned A[4] = {ra.x, ra.y, ra.z, ra.w}, B[4] = {rb.x, rb.y, rb.z, rb.w}, C[4] = {rc.x, rc.y, rc.z, rc.w}, Dd[4] = {rd.x, rd.y, rd.z, rd.w};
#pragma unroll
            for (int j = 0; j < 4; ++j) {
                const unsigned ablo = __builtin_amdgcn_perm(B[j], A[j], 0x05010400u), abhi = __builtin_amdgcn_perm(B[j], A[j], 0x07030602u);
                const unsigned cdlo = __builtin_amdgcn_perm(Dd[j], C[j], 0x05010400u), cdhi = __builtin_amdgcn_perm(Dd[j], C[j], 0x07030602u);
                const unsigned t0 = __builtin_amdgcn_perm(cdlo, ablo, 0x05040100u), t1 = __builtin_amdgcn_perm(cdlo, ablo, 0x07060302u);
                const unsigned t2 = __builtin_amdgcn_perm(cdhi, abhi, 0x05040100u), t3 = __builtin_amdgcn_perm(cdhi, abhi, 0x07060302u);
                acc[4 * j] = __builtin_amdgcn_sdot4((int)t0, qa, acc[4 * j], false); acc[4 * j + 1] = __builtin_amdgcn_sdot4((int)t1, qa, acc[4 * j + 1], false);
                acc[4 * j + 2] = __builtin_amdgcn_sdot4((int)t2, qa, acc[4 * j + 2], false); acc[4 * j + 3] = __builtin_amdgcn_sdot4((int)t3, qa, acc[4 * j + 3], false);
            }
        }
        const float sc = ACTS[tok] * dbg;
        const int b = tok >> 13, c0 = 128 * g + 16 * l8; float* xr = F.out + (size_t)tok * D + c0; const float* gr = g2 + (size_t)b * 6144 + c0;
#pragma unroll
        for (int q4 = 0; q4 < 4; ++q4) { const f32x4 xv = *(const GAS f32x4*)(xr + 4 * q4), gv = *(const f32x4*)(gr + 4 * q4);
            *(GAS f32x4*)(xr + 4 * q4) = xv + gv * sc * (f32x4){(float)acc[4 * q4], (float)acc[4 * q4 + 1], (float)acc[4 * q4 + 2], (float)acc[4 * q4 + 3]}; }
    }
}
#if defined(CHECK) && CHECK
constexpr size_t WS_DBG = 896 * 1024;
constexpr size_t WS_DBGOUT = WS_CLOC;
#ifndef CHECK_LAYER
#define CHECK_LAYER 1
#endif
__global__ void chk_qry(Args a) {
    const bf16* XN = (const bf16*)(a.ws + WS_XNY); const bf16* QRY = (const bf16*)(a.ws + WS_QRY); const float* wq = a.in[20] + (size_t)CHECK_LAYER * D * NQ;
    float* R = (float*)(a.ws + WS_CTL + WS_DBG);
    const int tok = (blockIdx.x * 977) % M; const int col = (threadIdx.x * 37 + blockIdx.x * 11) % NQ;
    float s = 0.f; for (int k = 0; k < D; ++k) s += bf2f(XN[(size_t)tok * D + k]) * wq[(size_t)k * NQ + col];
    const float q = bf2f(QRY[(size_t)tok * NQ + col]);
    atomicAdd(R + 0, (s - q) * (s - q)); atomicAdd(R + 1, s * s);
}
__global__ void chk_keys(Args a) {
    const bf16* KB = (const bf16*)(a.ws + WS_KEYS); const float* keys = a.in[21]; float* R = (float*)(a.ws + WS_CTL + WS_DBG);
    const int i = blockIdx.x * blockDim.x + threadIdx.x; if (i < 2 * 2 * 128 * 128) { const float d = bf2f(KB[i]) - keys[i]; atomicAdd(R + 8, d * d); atomicAdd(R + 9, keys[i] * keys[i]); }
}
__global__ void chk_uv(Args a) {
    const bf16* UB = (const bf16*)(a.ws + WS_UB); const bf16* VB = (const bf16*)(a.ws + WS_VB); float* R = (float*)(a.ws + WS_CTL + WS_DBG);
    const size_t i = ((size_t)blockIdx.x * blockDim.x + threadIdx.x) * 61 % ((size_t)2 * 16384 * 1024);
    const float du = bf2f(UB[i]) - a.in[22][i], dv = bf2f(VB[i]) - a.in[23][i];
    atomicAdd(R + 16, du * du + dv * dv); atomicAdd(R + 17, a.in[22][i] * a.in[22][i] + a.in[23][i] * a.in[23][i]);
}
__global__ void chk_route(Args a) {
    const bf16* QRY = (const bf16*)(a.ws + WS_QRY); const float* keys = a.in[21] + (size_t)CHECK_LAYER * 2 * 128 * 128;
    const int* IDX = (const int*)(a.ws + WS_IDX); const float* GATE = (const float*)(a.ws + WS_GATE);
    float* R = (float*)(a.ws + WS_CTL + WS_DBG);
    __shared__ float sc[2][128]; __shared__ float sc0[2][128]; __shared__ float ts[2][16]; __shared__ int ti[2][16]; __shared__ float cs[256]; __shared__ int ci[256];
    const int tok = (blockIdx.x * 613 + 5) % M, hd = blockIdx.x & 7, tid = threadIdx.x;
    { const int p = tid >> 7, n = tid & 127; float s = 0.f; for (int d = 0; d < 128; ++d) s += bf2f(QRY[(size_t)tok * NQ + hd * 256 + p * 128 + d]) * keys[(size_t)(p * 128 + n) * 128 + d]; sc[p][n] = s; sc0[p][n] = s; }
    __syncthreads();
    if (tid < 2) { const int p = tid; for (int k = 0; k < 16; ++k) { int best = 0; float bv = -INFINITY; for (int n = 0; n < 128; ++n) if (sc[p][n] > bv) { bv = sc[p][n]; best = n; } ts[p][k] = bv; ti[p][k] = best; sc[p][best] = -INFINITY; } }
    __syncthreads();
    cs[tid] = ts[0][tid >> 4] + ts[1][tid & 15]; ci[tid] = ti[0][tid >> 4] * 128 + ti[1][tid & 15];
    __syncthreads();
    if (tid == 0) {
        float fs[16]; int fi[16];
        for (int k = 0; k < 16; ++k) { int best = 0; float bv = -INFINITY; for (int n = 0; n < 256; ++n) if (cs[n] > bv) { bv = cs[n]; best = n; } fs[k] = bv; fi[k] = ci[best]; cs[best] = -INFINITY; }
        float den = 0.f; for (int k = 0; k < 16; ++k) den += __expf(fs[k] - fs[0]);
        int mism = 0; float ge = 0.f;
        for (int k = 0; k < 16; ++k) { bool found = false; for (int j = 0; j < 16; ++j) if (IDX[(size_t)tok * 128 + hd * 16 + j] == fi[k]) { found = true; const float g = __expf(fs[k] - fs[0]) / den; const float d = g - GATE[(size_t)tok * 128 + hd * 16 + j]; ge += d * d; } if (!found) ++mism; }
        { int ba = 0, bb = 0; for (int j = 0; j < 16; ++j) { const int e = IDX[(size_t)tok * 128 + hd * 16 + j]; const int ea = (e >> 7) & 127, eb = e & 127;
            if (!(e >= 0 && e < 16384) || sc0[0][ea] + sc0[1][eb] < fs[15] - 0.05f) ++ba; if (!(e >= 0 && e < 16384) || sc0[1][ea] + sc0[0][eb] < fs[15] - 0.05f) ++bb; }
          atomicAdd(R + 10, (float)ba); atomicAdd(R + 11, (float)bb); }
        atomicAdd(R + 2, (float)mism); atomicAdd(R + 3, 16.f); atomicAdd(R + 4, ge); atomicAdd(R + 5, 1.f / 16.f);
    }
}
__global__ void chk_scores(Args a) {
    const bf16* QRY = (const bf16*)(a.ws + WS_QRY); const float* keys = a.in[21] + (size_t)CHECK_LAYER * 2 * 128 * 128;
    const float* DB = (const float*)(a.ws + WS_CLOC) + 8 * 1024 * 1024; float* R = (float*)(a.ws + WS_CTL + WS_DBG);
    const int t = blockIdx.x, tid = threadIdx.x;
    __shared__ float sc[2][128];
    { const int p = tid >> 7, n = tid & 127; float s = 0.f; for (int d = 0; d < 128; ++d) s += bf2f(QRY[(size_t)t * NQ + p * 128 + d]) * keys[(size_t)(p * 128 + n) * 128 + d];
      const float dv = DB[(p * 128 + t) * 128 + n]; atomicAdd(R + 12, (s - dv) * (s - dv)); atomicAdd(R + 13, s * s); sc[p][n] = dv; }
    __syncthreads();
    if (tid < 2) { const int p = tid; int bad = 0; for (int k = 0; k < 16; ++k) { int best = 0; float bv = -INFINITY; for (int n = 0; n < 128; ++n) if (sc[p][n] > bv) { bv = sc[p][n]; best = n; }
        const float lv = DB[32768 + t * 48 + 16 * p + k]; if (fabsf(lv - bv) > 1e-3f * (1.f + fabsf(bv))) ++bad; sc[p][best] = -INFINITY; }
        atomicAdd(R + 14, (float)bad); atomicAdd(R + 15, 16.f); }
}
__global__ void chk_expert(Args a) {
    const bf16* XN = (const bf16*)(a.ws + WS_XNY); const int* IDX = (const int*)(a.ws + WS_IDX); const float* GATE = (const float*)(a.ws + WS_GATE);
    const float* U = a.in[22] + (size_t)CHECK_LAYER * 16384 * 1024; const float* V = a.in[23] + (size_t)CHECK_LAYER * 16384 * 1024;
    const float* DO = (const float*)(a.ws + WS_DBGOUT); float* R = (float*)(a.ws + WS_CTL + WS_DBG);
    __shared__ float act[128];
    const int tok = (blockIdx.x * 61 + 3) % 4096, tid = threadIdx.x;
    if (tid < 128) { const int e = IDX[(size_t)tok * 128 + tid]; float s = 0.f; for (int k = 0; k < D; ++k) s += bf2f(XN[(size_t)tok * D + k]) * U[(size_t)e * D + k];
        act[tid] = 0.5f * s * (1.f + erff(s * 0.70710678f)) * GATE[(size_t)tok * 128 + tid]; }
    __syncthreads();
    for (int c = tid; c < D; c += 256) { float o = 0.f; for (int e = 0; e < 128; ++e) o += act[e] * V[(size_t)IDX[(size_t)tok * 128 + e] * D + c];
        const float g = DO[(size_t)tok * D + c]; atomicAdd(R + 6, (o - g) * (o - g)); atomicAdd(R + 7, o * o); }
}
__global__ void chk_stamp(Args a) {
    const float* R = (const float*)(a.ws + WS_CTL + WS_DBG);
    const float e1 = sqrtf(R[0] / fmaxf(R[1], 1e-30f)), e2 = R[2] / fmaxf(R[3], 1.f), e2g = sqrtf(R[4] / fmaxf(R[5], 1e-30f)), e3 = sqrtf(R[6] / fmaxf(R[7], 1e-30f));
    float c;
#if CHECK == 99
    c = 1.f;
#else
    const float e0 = sqrtf(R[8] / fmaxf(R[9], 1e-30f));
    const float ea = R[10] / fmaxf(R[3], 1.f), eb = R[11] / fmaxf(R[3], 1.f);
    const float esc = sqrtf(R[12] / fmaxf(R[13], 1e-30f)), els = R[14] / fmaxf(R[15], 1.f);
    const float euv = sqrtf(R[16] / fmaxf(R[17], 1e-30f));
    const float errs[4] = {e2, euv, ea, e3}; const float tols[4] = {0.08f, 0.01f, 0.08f, 0.03f};
    c = 1.f;
    for (int k = 3; k >= 0; --k) if (!(errs[k] <= tols[k])) { const float fr = fminf(fmaxf((log10f(fmaxf(errs[k], 1e-4f)) + 4.f) / 5.f, 0.f), 0.95f); c = 2.f + (float)k + fr; }
#endif
    const size_t i = (size_t)blockIdx.x * blockDim.x + threadIdx.x;
    if (i < (size_t)M * D) a.out[i] = a.in[0][i] * (1.f + c);
}
#endif
#ifndef MK_PER_PHASE
#define MK_PER_PHASE 0
#endif
constexpr int NPHASE = 24;
#ifndef RPROBE
#define RPROBE 0
#endif
#ifndef DBG_Y0
#define DBG_Y0 1
#define DBG_P0 1
#define DBG_Y1 1
#define DBG_P1 1
#endif
#ifndef PHASE_MASK
#define PHASE_MASK 0x1ffffffu
#endif
#define IN(k) (lo <= (k) && (k) < hi && ((PHASE_MASK >> (k)) & 1u))
#ifndef DUP_PHASE
#define DUP_PHASE -1
#endif
#define REPS(k) for (int rep = ((DUP_PHASE) == (k) ? 0 : 1); rep < 2; ++rep)
#define SEAM(k) do { if (IN(k) && IN((k) + 1)) xcd_barrier(bar); } while (0)
__device__ __forceinline__ float alibi_tcut(const float* gq, const float* gk, int lane) { return 16.f * wave_max(fabsf(gq[lane])) * wave_max(fabsf(gk[lane])) + ALIBI_MARGIN; }
template <int layer>
__device__ __forceinline__ void layer_phases(Frame& F, const Args& args, const XcdBarrier& bar, const int lo, const int hi) {
    volatile LAS unsigned* MISCW = (volatile LAS unsigned*)(F.lds + MISC_OFF);
    float* MOD = WSP(float, WS_MOD);
    bf16* XNY = WSP(bf16, WS_XNY); bf16* Zb = WSP(bf16, WS_Z);

        constexpr int pb = layer * 12;
        const float* mod = MOD + (size_t)layer * 4 * 6144;
        if (IN(pb + 1)) REPS(pb + 1) { if (layer == 0) norm_pass<true>(F, args, args.in[0], args.in[4], mod, 0, XNY); else norm_pass<false>(F, args, F.out, args.in[4] + 1024, mod, 0, XNY); } SEAM(pb + 1);
        if (IN(pb + 2)) REPS(pb + 2) {
            const int N = layer == 0 ? NZ0 : NZ1;
            pg8::Gemm g{XNY, layer == 0 ? WSP(bf16, WS_WIN0) : WSP(bf16, WS_WIN1), M, N, D}; pg8::StaticOrder S; S.init(M, N, F.G, F.bid);
            pg8::EpiBf16QK E{Zb, N, layer == 0 ? 8 : 0, layer == 0 ? 10 : 4, layer == 0 ? 10 : 4, layer == 0 ? 12 : 8, layer == 0 ? args.in[11] : args.in[15], layer == 0 ? args.in[12] : args.in[16], 0.125f * LOG2E, (LAS float*)(F.lds + 131072)};
            pg8::gemm_phase<pg8::EpiBf16QK, pg8::StaticOrder, true, true>(F.lds, g, S, E);
        } SEAM(pb + 2);
        if (layer == 0) {
            if (IN(3)) REPS(3) {
                for (int u = F.bid; u < 1024 + 128; u += F.G) {
                    if (u < 1024) mlstm_a_unit(F, args, u);
                    else if (rep == 1) { const int v = u - 1024, b = v >> 5, j = v & 31;
                        kmean_unit(F, Zb, NZ0, b * SEQ + j * 256, 2560, WSP(float, WS_KMEAN) + (size_t)((b * 8) * 32 + j) * 64); }
                }
            } SEAM(3);
            if (IN(4)) REPS(4) {
                if (rep == 1) for (int u = F.bid; u < 256; u += F.G) mlstm_scan_unit(F, u);
                { const float tcut = alibi_tcut(args.in[11], args.in[12], ((int)(threadIdx.x & 63u)));
                  const unsigned short* ORD = WSP(unsigned short, WS_ORD) + 2048; unsigned* qw = (unsigned*)(F.ws + WS_CTL) + CW_QMOBA + (rep == 1 ? 0 : 16);
                  for (;;) { if (((int)threadIdx.x) == 0) MISCW[0] = atomicAdd(qw, 1u); __syncthreads(); const unsigned qi = MISCW[0]; __syncthreads(); if (qi >= 1024u) break;
                      const int u = ORD[qi]; moba_unit(F, u >> 8, (u >> 5) & 7, u & 31, tcut); }
                  if (rep == 1) { unsigned* cw = (unsigned*)(F.ws + WS_CTL) + CW_QCVT0;
                      for (;;) { if (((int)threadIdx.x) == 0) MISCW[0] = atomicAdd(cw, 1u); __syncthreads(); const unsigned ci = MISCW[0]; __syncthreads(); if (ci >= 512u) break; i8_chunk(F, args, 0, (int)ci); } } }
            } SEAM(4);
            if (IN(5)) REPS(5) { for (int u = F.bid; u < 1024; u += F.G) mlstm_c_unit(F, args, u); } SEAM(5);
        } else {
            if (IN(pb + 4)) REPS(pb + 4) {
                const float* lp = args.in[17];
                const float lam = __expf(wave_sum(lp[((int)(threadIdx.x & 63u))] * lp[64 + ((int)(threadIdx.x & 63u))])) - __expf(wave_sum(lp[128 + ((int)(threadIdx.x & 63u))] * lp[192 + ((int)(threadIdx.x & 63u))])) + 0.35550906759096926f;
                { const float tcut = alibi_tcut(args.in[15], args.in[16], ((int)(threadIdx.x & 63u)));
                  const unsigned short* ORD = WSP(unsigned short, WS_ORD); unsigned* qw = (unsigned*)(F.ws + WS_CTL) + CW_QDIFF + (rep == 1 ? 0 : 16);
                  for (;;) { if (((int)threadIdx.x) == 0) MISCW[0] = atomicAdd(qw, 1u); __syncthreads(); const unsigned qi = MISCW[0]; __syncthreads(); if (qi >= 2048u) break;
                      const int u = ORD[qi]; diff_unit(F, args, u >> 9, (u >> 6) & 7, u & 63, lam, tcut, rep == 0 ? RPROBE : 0); }
                  if (rep == 1) { unsigned* cw = (unsigned*)(F.ws + WS_CTL) + CW_QCVT1;
                      for (;;) { if (((int)threadIdx.x) == 0) MISCW[0] = atomicAdd(cw, 1u); __syncthreads(); const unsigned ci = MISCW[0]; __syncthreads(); if (ci >= 512u) break; i8_chunk(F, args, 1, (int)ci); } } }
            } SEAM(pb + 4);
        }
        if (IN(pb + 6)) {
            pg8::Gemm g{XNY, layer == 0 ? WSP(bf16, WS_WOUT0) : WSP(bf16, WS_WOUT1), M, D, D}; pg8::StaticOrder S; S.init(M, D, F.G, F.bid);
            pg8::EpiResid E{layer == 0 ? args.in[0] : F.out, F.out, mod + 2 * 1024};
            pg8::gemm_phase<pg8::EpiResid, pg8::StaticOrder, true, true>(F.lds, g, S, E);
        } SEAM(pb + 6);
        if (IN(pb + 7)) REPS(pb + 7) { norm_pass<false>(F, args, F.out, args.in[5] + layer * 1024, mod, 3, XNY); } SEAM(pb + 7);
        if (IN(pb + 8)) REPS(pb + 8) {
            pg8::Gemm g{XNY, WSP(bf16, WS_WQ) + (size_t)layer * NQ * D, M, NQ, D}; pg8::StaticOrder S; S.init(M, NQ, F.G, F.bid);
            pg8::EpiBf16 E{WSP(bf16, WS_QRY), NQ};
            pg8::gemm_phase<pg8::EpiBf16, pg8::StaticOrder, true, true>(F.lds, g, S, E);
        } SEAM(pb + 8);
        if (IN(pb + 9)) REPS(pb + 9) { const bf16* KEYS = WSP(bf16, WS_KEYS) + (size_t)layer * 2 * 128 * 128;
            bf16x8 kf[4][2];
#pragma unroll
            for (int ks = 0; ks < 4; ++ks)
#pragma unroll
                for (int n = 0; n < 2; ++n) kf[ks][n] = *(const GAS bf16x8*)(KEYS + (size_t)((F.wave & 1) * 128 + 32 * (F.wave >> 1) + 16 * n + (((int)(threadIdx.x & 63u)) & 15)) * 128 + 32 * ks + 8 * (((int)(threadIdx.x & 63u)) >> 4));
            for (int u = F.bid; u < 2048; u += F.G) peer_route_unit(F, (u >> 3) * 128, u & 7, kf, rep == 0 ? RPROBE : 0); } SEAM(pb + 9);
        if (IN(pb + 10)) REPS(pb + 10) { peer_u_phase(F, F.ws + WS_UB + (size_t)layer * 8 * 16384 * 128); } SEAM(pb + 10);
        if (IN(pb + 11)) REPS(pb + 11) { peer_act_phase(F, WSP(float, WS_ISU) + layer * 16384, WSP(float, WS_ISV) + layer * 16384); } SEAM(pb + 11);
        if (IN(pb + 12)) REPS(pb + 12) { peer_v_phase(F, F.ws + WS_VB + (size_t)layer * 8 * 16384 * 128, mod + 5 * 1024, rep == 1 ? (layer == 0 ? (float)DBG_P0 : (float)DBG_P1) : 0.f); }
        if (layer == 0) SEAM(12);
    }
__global__ void __launch_bounds__(NTHR, 2) mega_fwd(Args args) {
    extern __shared__ __attribute__((aligned(16))) unsigned char lds_raw[];
    Frame F;
    F.lds = (LAS unsigned char*)lds_raw;
    F.wave = __builtin_amdgcn_readfirstlane((int)threadIdx.x >> 6);
    F.G = gridDim.x; F.bid = blockIdx.x;
    F.out = args.out; F.ws = args.ws;
    volatile LAS unsigned* MISC = (volatile LAS unsigned*)(F.lds + MISC_OFF);
    for (int u = ((int)threadIdx.x); u < (LDS_BYTES - LDSCTL_OFF) / 4; u += NTHR) ((LAS unsigned*)(F.lds + LDSCTL_OFF))[u] = 0u;
    __syncthreads();
    XcdBarrier bar; bar.bar = (unsigned*)(F.ws + WS_CTL) + CW_BAR; bar.x = 0; bar.st = nullptr;
    if (!MK_PER_PHASE) bar = xcd_barrier_post((unsigned*)(F.ws + WS_CTL) + CW_BAR, MISC + 8);
    const int lo = args.ph_lo, hi = args.ph_hi;

#ifdef EXTRA_BAR
    for (int i = 0; i < EXTRA_BAR; ++i) xcd_barrier(bar);
#endif
    if (IN(0)) REPS(0) { p0_prologue(F, args); } SEAM(0);
    layer_phases<0>(F, args, bar, lo, hi);
    layer_phases<1>(F, args, bar, lo, hi);
}
#undef IN
#undef SEAM

extern "C" void kernel_launch(void* const* d_in, const int* in_sizes, int n_in, void* d_out, int out_size, void* d_ws, size_t ws_size, hipStream_t stream) {
    static int grid = 0;
    if (grid == 0) {
        if (n_in != 24 || in_sizes[0] != M * D || out_size != M * D || ws_size < WS_END) { fprintf(stderr, "kernel_launch: unexpected problem (n_in %d, in0 %d, out %d, ws %zu < %zu); nothing launched\n", n_in, n_in > 0 ? in_sizes[0] : -1, out_size, ws_size, (size_t)WS_END); grid = -1; return; }
        int dev = 0, cus = 0, per_cu = 0;
        if (hipGetDevice(&dev) != hipSuccess || hipDeviceGetAttribute(&cus, hipDeviceAttributeMultiprocessorCount, dev) != hipSuccess) { grid = -1; return; }
        if (hipFuncSetAttribute((const void*)mega_fwd, hipFuncAttributeMaxDynamicSharedMemorySize, LDS_BYTES) != hipSuccess) { fprintf(stderr, "kernel_launch: hipFuncSetAttribute failed\n"); grid = -1; return; }
        if (hipOccupancyMaxActiveBlocksPerMultiprocessor(&per_cu, (const void*)mega_fwd, NTHR, LDS_BYTES) != hipSuccess || per_cu < 1)
            fprintf(stderr, "kernel_launch: note: occupancy query reports %d workgroups per CU\n", per_cu);
        (void)hipGetLastError();
        grid = cus;
    }
    if (grid < 0) return;
    if (hipMemsetAsync((char*)d_ws + WS_CTL, 0, CTL_ZERO_BYTES, stream) != hipSuccess) { fprintf(stderr, "kernel_launch: memset failed\n"); return; }
    Args a{};
    for (int i = 0; i < 24; ++i) a.in[i] = (const float*)d_in[i];
    a.out = (float*)d_out; a.ws = (unsigned char*)d_ws;
#if MK_PER_PHASE
    for (int p = 0; p < NPHASE + 1; ++p) { a.ph_lo = p; a.ph_hi = p + 1; hipLaunchKernelGGL(mega_fwd, dim3(grid), dim3(NTHR), LDS_BYTES, stream, a); }
#else
    a.ph_lo = 0; a.ph_hi = NPHASE + 1;
    hipLaunchKernelGGL(mega_fwd, dim3(grid), dim3(NTHR), LDS_BYTES, stream, a);
#endif
#if defined(CHECK) && CHECK
    chk_qry<<<256, 256, 0, stream>>>(a); chk_keys<<<256, 256, 0, stream>>>(a); chk_uv<<<1024, 256, 0, stream>>>(a); chk_scores<<<128, 256, 0, stream>>>(a); chk_route<<<512, 256, 0, stream>>>(a); chk_expert<<<64, 256, 0, stream>>>(a); chk_stamp<<<(M * D + 255) / 256, 256, 0, stream>>>(a);
#endif
    const hipError_t le = hipPeekAtLastError();
    if (le != hipSuccess) fprintf(stderr, "kernel_launch: launch failed: %s\n", hipGetErrorName(le));
}
```

```cpp
#include <hip/hip_runtime.h>
#include <cstdio>
#include <cstdint>
namespace pg8 {
#define PG8_LAS __attribute__((address_space(3)))
typedef unsigned short bf16_t;
typedef short bf16x8 __attribute__((ext_vector_type(8)));
typedef float f32x4 __attribute__((ext_vector_type(4)));
typedef unsigned u32x4 __attribute__((ext_vector_type(4)));
constexpr int BM = 256, BK = 64, HALF = 128, HTB = HALF * BK * 2  , STAGE_BYTES = 8 * HTB, NXCD = 8, WGM = 8;

__host__ __device__ __forceinline__ int lds_byte(int r, int c) { const int st = (r >> 4) * 2 + (c >> 5), rr = r & 15, cc = c & 31, ob = rr * 64 + cc * 2; return st * 1024 + (ob ^ (((ob >> 9) & 1) << 5)); }
__host__ __device__ __forceinline__ void stage_rc(int b, int& R, int& C) { const int st = b / 1024, sb = b % 1024, swz = sb ^ (((sb >> 9) & 1) << 5); R = (st >> 1) * 16 + swz / 64; C = (st & 1) * 32 + (swz % 64) / 2; }
__host__ __device__ __forceinline__ int perm32(int rho) { const int n = rho >> 4, i = rho & 15; return 8 * (i >> 2) + 4 * n + (i & 3); }

struct Unit { int pm, pn; };
struct Gemm { const bf16_t* A; const bf16_t* Bt; int M, N, K; size_t bstride; };

struct StaticOrder {
    int nM, nN, nwg, G, c;
    __host__ __device__ void init(int M, int N, int G_, int c_) { nM = M / BM; nN = N / BM; nwg = nM * nN; G = G_; c = c_; }
    __host__ __device__ bool next(int i, Unit& u) const {
        const long L = (long)i * G + c; if (L >= nwg) return false;
        int wgid = (int)L; { const int q = nwg / NXCD, r = nwg % NXCD, xcd = wgid % NXCD, off = wgid / NXCD; wgid = (xcd < r ? xcd * (q + 1) : r * (q + 1) + (xcd - r) * q) + off; }
        const int nig = WGM * nN, gid = wgid / nig, fm = gid * WGM, gsz = (nM - fm) < WGM ? (nM - fm) : WGM;
        u.pm = fm + ((wgid % nig) % gsz); u.pn = (wgid % nig) / gsz; return true;
    }
    __device__ __forceinline__ void a_ready(const Unit&) const {}
    __device__ __forceinline__ void done(const Unit&) const {}
};

__device__ __forceinline__ unsigned cvt_pk_bf16(float lo, float hi) { unsigned r; asm volatile("v_cvt_pk_bf16_f32 %0, %1, %2" : "=v"(r) : "v"(lo), "v"(hi)); return r; }
typedef unsigned u32x4 __attribute__((ext_vector_type(4)));
struct EpiBf16 {
    static constexpr bool PERM = true, AFTER_DRAIN = false;
    bf16_t* O; int ldc;
    __device__ __forceinline__ void operator()(const f32x4 (&acc)[2][2][4][2], const Unit& u, int wr, int wc, int fr, int fq) const {
        const int row0 = u.pm * BM + wr * 64 + fr; const int col0 = u.pn * BM + wc * 32 + 8 * fq;
#pragma unroll
        for (int ai = 0; ai < 2; ++ai)
#pragma unroll
            for (int m = 0; m < 4; ++m) { bf16_t* rowp = O + (size_t)(row0 + ai * HALF + m * 16) * ldc + col0;
#pragma unroll
                for (int bj = 0; bj < 2; ++bj) { const f32x4 v0 = acc[ai][bj][m][0], v1 = acc[ai][bj][m][1];
                    u32x4 w; w.x = cvt_pk_bf16(v0[0], v0[1]); w.y = cvt_pk_bf16(v0[2], v0[3]); w.z = cvt_pk_bf16(v1[0], v1[1]); w.w = cvt_pk_bf16(v1[2], v1[3]);
                    *(u32x4*)(rowp + bj * HALF) = w; } }
    }
};
struct EpiBf16QK {
    static constexpr bool PERM = true, AFTER_DRAIN = false;
    bf16_t* O; int ldc; int q_lo, q_hi, k_lo, k_hi; const float* gq; const float* gk; float qmul; PG8_LAS float* xs;
    __device__ __forceinline__ void operator()(const f32x4 (&acc)[2][2][4][2], const Unit& u, int wr, int wc, int fr, int fq) const {
        const int row0 = u.pm * BM + wr * 64 + fr; const int col0 = u.pn * BM + wc * 32 + 8 * fq;
        const bool isq = u.pn >= q_lo && u.pn < q_hi, isk = u.pn >= k_lo && u.pn < k_hi;
        if (!(isq || isk)) {
#pragma unroll
            for (int ai = 0; ai < 2; ++ai)
#pragma unroll
                for (int m = 0; m < 4; ++m) { bf16_t* rowp = O + (size_t)(row0 + ai * HALF + m * 16) * ldc + col0;
#pragma unroll
                    for (int bj = 0; bj < 2; ++bj) { const f32x4 v0 = acc[ai][bj][m][0], v1 = acc[ai][bj][m][1];
                        u32x4 w; w.x = cvt_pk_bf16(v0[0], v0[1]); w.y = cvt_pk_bf16(v0[2], v0[3]); w.z = cvt_pk_bf16(v1[0], v1[1]); w.w = cvt_pk_bf16(v1[2], v1[3]);
                        *(u32x4*)(rowp + bj * HALF) = w; } }
            return;
        }
        float ssq[2][4][2];
#pragma unroll
        for (int ai = 0; ai < 2; ++ai)
#pragma unroll
            for (int m = 0; m < 4; ++m)
#pragma unroll
                for (int bj = 0; bj < 2; ++bj) { const f32x4 v0 = acc[ai][bj][m][0], v1 = acc[ai][bj][m][1];
                    float s = (v0[0] * v0[0] + v0[1] * v0[1]) + (v0[2] * v0[2] + v0[3] * v0[3]) + (v1[0] * v1[0] + v1[1] * v1[1]) + (v1[2] * v1[2] + v1[3] * v1[3]);
                    s += __shfl_xor(s, 16); s += __shfl_xor(s, 32); ssq[ai][m][bj] = s;
                    if (fq == 0) xs[(ai * HALF + wr * 64 + m * 16 + fr) * 8 + bj * 4 + wc] = s; }
        asm volatile("s_waitcnt lgkmcnt(0)" ::: "memory"); __builtin_amdgcn_s_barrier(); asm volatile("" ::: "memory");
        const float* g = isq ? gq : gk; const float gm = isq ? qmul : 1.f;
        const int d0 = (wc & 1) * 32 + 8 * fq;
        const f32x4 g0 = *(const f32x4*)(g + d0) * gm, g1 = *(const f32x4*)(g + d0 + 4) * gm;
#pragma unroll
        for (int ai = 0; ai < 2; ++ai)
#pragma unroll
            for (int m = 0; m < 4; ++m) { bf16_t* rowp = O + (size_t)(row0 + ai * HALF + m * 16) * ldc + col0;
#pragma unroll
                for (int bj = 0; bj < 2; ++bj) { const float tot = ssq[ai][m][bj] + xs[(ai * HALF + wr * 64 + m * 16 + fr) * 8 + bj * 4 + (wc ^ 1)];
                    const float rs = __builtin_amdgcn_rsqf(tot * (1.f / 64.f) + 1e-6f);
                    const f32x4 v0 = acc[ai][bj][m][0] * rs * g0, v1 = acc[ai][bj][m][1] * rs * g1;
                    u32x4 w; w.x = cvt_pk_bf16(v0[0], v0[1]); w.y = cvt_pk_bf16(v0[2], v0[3]); w.z = cvt_pk_bf16(v1[0], v1[1]); w.w = cvt_pk_bf16(v1[2], v1[3]);
                    *(u32x4*)(rowp + bj * HALF) = w; } }
    }
};
struct EpiBf16RS {
    static constexpr bool PERM = true, AFTER_DRAIN = false;
    bf16_t* O; int ldc; const float* rss; const float* bias; int bias_stride;
    __device__ __forceinline__ void operator()(const f32x4 (&acc)[2][2][4][2], const Unit& u, int wr, int wc, int fr, int fq) const {
        const int row0 = u.pm * BM + wr * 64 + fr; const int col0 = u.pn * BM + wc * 32 + 8 * fq; const int b = (u.pm * BM) >> 13;
        f32x4 bv[2][2];
#pragma unroll
        for (int bj = 0; bj < 2; ++bj)
#pragma unroll
            for (int n = 0; n < 2; ++n) bv[bj][n] = *(const f32x4*)(bias + (size_t)b * bias_stride + col0 + bj * HALF + 4 * n);
#pragma unroll
        for (int ai = 0; ai < 2; ++ai)
#pragma unroll
            for (int m = 0; m < 4; ++m) { const int row = row0 + ai * HALF + m * 16; bf16_t* rowp = O + (size_t)row * ldc + col0;
                const f32x4 p0 = *(const f32x4*)(rss + (size_t)row * 16), p1 = *(const f32x4*)(rss + (size_t)row * 16 + 4), p2 = *(const f32x4*)(rss + (size_t)row * 16 + 8), p3 = *(const f32x4*)(rss + (size_t)row * 16 + 12);
                const f32x4 pt = (p0 + p1) + (p2 + p3);
                const float rs = __builtin_amdgcn_rsqf(((pt[0] + pt[1]) + (pt[2] + pt[3])) * (1.f / 1024.f) + 1e-6f);
#pragma unroll
                for (int bj = 0; bj < 2; ++bj) { const f32x4 v0 = acc[ai][bj][m][0] * rs + bv[bj][0], v1 = acc[ai][bj][m][1] * rs + bv[bj][1];
                    u32x4 w; w.x = cvt_pk_bf16(v0[0], v0[1]); w.y = cvt_pk_bf16(v0[2], v0[3]); w.z = cvt_pk_bf16(v1[0], v1[1]); w.w = cvt_pk_bf16(v1[2], v1[3]);
                    *(u32x4*)(rowp + bj * HALF) = w; } }
    }
};
struct EpiResid {
    static constexpr bool PERM = false, AFTER_DRAIN = false;
    const float* base; float* out; const float* gate;
    __device__ __forceinline__ void operator()(const f32x4 (&acc)[2][2][4][2], const Unit& u, int wr, int wc, int fr, int fq) const {
        const int col0 = u.pn * BM + wc * 32 + 4 * fq; const int b = (u.pm * BM) >> 13;
#pragma unroll
        for (int bj = 0; bj < 2; ++bj)
#pragma unroll
            for (int n = 0; n < 2; ++n) { const f32x4 gv = *(const f32x4*)(gate + (size_t)b * 6144 + col0 + bj * HALF + n * 16);
#pragma unroll
                for (int ai = 0; ai < 2; ++ai)
#pragma unroll
                    for (int m = 0; m < 4; ++m) { const size_t off = (size_t)(u.pm * BM + ai * HALF + wr * 64 + m * 16 + fr) * 1024 + col0 + bj * HALF + n * 16;
                        const f32x4 bs = *(const f32x4*)(base + off); *(f32x4*)(out + off) = bs + gv * acc[ai][bj][m][n]; } }
    }
};

template <class Epi, class Sched, bool ALIGN_EPI = false, bool SP2 = false>
__device__ __forceinline__ void gemm_phase(PG8_LAS unsigned char* lds, const Gemm g, const Sched& S, const Epi& E) {
    const int tid = threadIdx.x, wid = __builtin_amdgcn_readfirstlane(tid >> 6), lane = tid & 63, wr = wid >> 2, wc = wid & 3, fr = lane & 15, fq = lane >> 4;
    const int K = g.K, nt = K / BK;
    unsigned voffA[2], voffB[2];
#pragma unroll
    for (int i = 0; i < 2; ++i) { int R, C; stage_rc(tid * 16 + i * 8192, R, C); const int Rb = Epi::PERM ? ((R & ~31) + perm32(R & 31)) : R;
        voffA[i] = (unsigned)(R * K + C) * 2u; voffB[i] = (unsigned)(Rb * K + C) * 2u; }
    const size_t kstep = (size_t)(BK * 2);
    const size_t hstep = (size_t)HALF * K * 2;
    const size_t tstep = 2 * hstep;
    const unsigned ldsw = (unsigned)wid * 1024u;
    const int aoff = lds_byte(wr * 64 + fr, fq * 8), boff = lds_byte(wc * 32 + fr, fq * 8);
#define PG8_SA(b, h) (((b) * 2 + (h)) * HTB)
#define PG8_SB(b, h) ((4 + (b) * 2 + (h)) * HTB)
#define PG8_STAGE(bufoff, gbase, voff) do { _Pragma("unroll") for (int _i = 0; _i < 2; ++_i) \
        __builtin_amdgcn_global_load_lds((const unsigned*)((const char*)(gbase) + (voff)[_i]), (PG8_LAS unsigned*)(lds + (bufoff) + ldsw + _i * 8192), 16, 0, 0); } while (0)
#define PG8_LDA(dst, b, h) do { _Pragma("unroll") for (int m = 0; m < 4; ++m) _Pragma("unroll") for (int k = 0; k < 2; ++k) dst[m][k] = *(const PG8_LAS bf16x8*)(lds + PG8_SA(b, h) + aoff + m * 2048 + k * 1024); } while (0)
#define PG8_LDB(dst, b, h) do { _Pragma("unroll") for (int n = 0; n < 2; ++n) _Pragma("unroll") for (int k = 0; k < 2; ++k) dst[n][k] = *(const PG8_LAS bf16x8*)(lds + PG8_SB(b, h) + boff + n * 2048 + k * 1024); } while (0)
#define PG8_MMA(ai, bj, At, Bt) do { __builtin_amdgcn_s_setprio(1); _Pragma("unroll") for (int m = 0; m < 4; ++m) _Pragma("unroll") for (int n = 0; n < 2; ++n) _Pragma("unroll") for (int k = 0; k < 2; ++k) \
        acc[ai][bj][m][n] = __builtin_amdgcn_mfma_f32_16x16x32_bf16(Bt[n][k], At[m][k], acc[ai][bj][m][n], 0, 0, 0); __builtin_amdgcn_s_setprio(0); } while (0)
#define PG8_WAIT_V(n) asm volatile("s_waitcnt vmcnt(" #n ")" ::: "memory")
#define PG8_WAIT_L(n) asm volatile("s_waitcnt lgkmcnt(" #n ")" ::: "memory")
#define PG8_BAR __builtin_amdgcn_s_barrier()
#define PG8_SCHED __builtin_amdgcn_sched_barrier(0)
    Unit cur, nxt; int ui = 0;
    if (!S.next(0, cur)) return;
    f32x4 acc[2][2][4][2];
#pragma unroll
    for (int a = 0; a < 2; ++a)
#pragma unroll
        for (int b = 0; b < 2; ++b)
#pragma unroll
            for (int m = 0; m < 4; ++m)
#pragma unroll
                for (int n = 0; n < 2; ++n) acc[a][b][m][n] = (f32x4){0.f, 0.f, 0.f, 0.f};
    bf16x8 At[4][2], B0[2][2], B1[2][2];
    const char* cA = (const char*)g.A + (size_t)cur.pm * tstep; const char* cB = (const char*)g.Bt + (size_t)(cur.pm >> 5) * g.bstride + (size_t)cur.pn * tstep;
    S.a_ready(cur);
    if constexpr (SP2) {
        PG8_STAGE(PG8_SB(0, 0), cB, voffB); PG8_STAGE(PG8_SB(0, 1), cB + hstep, voffB); PG8_STAGE(PG8_SA(0, 0), cA, voffA); PG8_STAGE(PG8_SA(0, 1), cA + hstep, voffA);
        if (wr == 1) PG8_BAR;
        PG8_WAIT_V(2); PG8_BAR;
        PG8_STAGE(PG8_SB(1, 0), cB + kstep, voffB); PG8_STAGE(PG8_SA(1, 0), cA + kstep, voffA); PG8_STAGE(PG8_SB(1, 1), cB + hstep + kstep, voffB);
        PG8_WAIT_V(6); PG8_BAR;
    } else {
        PG8_STAGE(PG8_SB(0, 0), cB, voffB); PG8_STAGE(PG8_SA(0, 0), cA, voffA); PG8_STAGE(PG8_SB(0, 1), cB + hstep, voffB); PG8_STAGE(PG8_SA(0, 1), cA + hstep, voffA);
        if (wr == 1) PG8_BAR;
        PG8_WAIT_V(4); PG8_BAR;
        PG8_STAGE(PG8_SB(1, 0), cB + kstep, voffB); PG8_STAGE(PG8_SA(1, 0), cA + kstep, voffA); PG8_STAGE(PG8_SB(1, 1), cB + hstep + kstep, voffB);
        PG8_WAIT_V(6); PG8_BAR;
    }
    for (;;) {
        const bool has_next = S.next(ui + 1, nxt);
        const char* nA = has_next ? (const char*)g.A + (size_t)nxt.pm * tstep : cA; const char* nB = has_next ? (const char*)g.Bt + (size_t)(nxt.pm >> 5) * g.bstride + (size_t)nxt.pn * tstep : cB;
        for (int t = 0; t < nt; t += 2) {
            const bool last = (t == nt - 2);
            const char* a1 = cA + (size_t)(t + 1) * kstep;
            const char* a2 = last ? nA : cA + (size_t)(t + 2) * kstep; const char* b2 = last ? nB : cB + (size_t)(t + 2) * kstep;
            const char* a3 = a2 + kstep; const char* b3 = b2 + kstep;
            if (last && has_next) S.a_ready(nxt);
            if constexpr (SP2) {
            PG8_LDB(B0, 0, 0); PG8_LDB(B1, 0, 1); PG8_SCHED; PG8_LDA(At, 0, 0); PG8_STAGE(PG8_SA(1, 1), a1 + hstep, voffA);
            PG8_WAIT_V(8); PG8_WAIT_L(0); PG8_BAR; PG8_MMA(0, 0, At, B0); PG8_MMA(0, 1, At, B1); PG8_BAR; PG8_SCHED;
            PG8_LDA(At, 0, 1); PG8_STAGE(PG8_SB(0, 0), b2, voffB); PG8_STAGE(PG8_SB(0, 1), b2 + hstep, voffB); PG8_STAGE(PG8_SA(0, 0), a2, voffA);
            PG8_WAIT_V(8); PG8_WAIT_L(0); PG8_BAR; PG8_MMA(1, 0, At, B0); PG8_MMA(1, 1, At, B1); PG8_BAR; PG8_SCHED;
            PG8_LDB(B0, 1, 0); PG8_LDB(B1, 1, 1); PG8_SCHED; PG8_LDA(At, 1, 0); PG8_STAGE(PG8_SA(0, 1), a2 + hstep, voffA);
            PG8_WAIT_V(8); PG8_WAIT_L(0); PG8_BAR; PG8_MMA(0, 0, At, B0); PG8_MMA(0, 1, At, B1); PG8_BAR; PG8_SCHED;
            PG8_LDA(At, 1, 1); PG8_STAGE(PG8_SB(1, 0), b3, voffB); PG8_STAGE(PG8_SB(1, 1), b3 + hstep, voffB); PG8_STAGE(PG8_SA(1, 0), a3, voffA);
            PG8_WAIT_V(8); PG8_WAIT_L(0); PG8_BAR; PG8_MMA(1, 0, At, B0); PG8_MMA(1, 1, At, B1); PG8_BAR; PG8_SCHED;
            } else {
            PG8_LDB(B0, 0, 0); PG8_SCHED; PG8_LDA(At, 0, 0); PG8_STAGE(PG8_SA(1, 1), a1 + hstep, voffA);
            PG8_WAIT_L(8); PG8_BAR; PG8_WAIT_L(0); PG8_MMA(0, 0, At, B0); PG8_BAR; PG8_SCHED;
            PG8_LDB(B1, 0, 1); PG8_STAGE(PG8_SB(0, 0), b2, voffB);
            PG8_BAR; PG8_WAIT_L(0); PG8_MMA(0, 1, At, B1); PG8_BAR;
            PG8_LDA(At, 0, 1); PG8_STAGE(PG8_SA(0, 0), a2, voffA);
            PG8_BAR; PG8_WAIT_L(0); PG8_MMA(1, 0, At, B0); PG8_BAR; PG8_SCHED;
            PG8_STAGE(PG8_SB(0, 1), b2 + hstep, voffB);
            PG8_WAIT_V(6); PG8_BAR; PG8_MMA(1, 1, At, B1); PG8_BAR;
            PG8_LDB(B0, 1, 0); PG8_SCHED; PG8_LDA(At, 1, 0); PG8_STAGE(PG8_SA(0, 1), a2 + hstep, voffA);
            PG8_WAIT_L(8); PG8_BAR; PG8_WAIT_L(0); PG8_MMA(0, 0, At, B0); PG8_BAR; PG8_SCHED;
            PG8_LDB(B1, 1, 1); PG8_STAGE(PG8_SB(1, 0), b3, voffB);
            PG8_BAR; PG8_WAIT_L(0); PG8_MMA(0, 1, At, B1); PG8_BAR;
            PG8_LDA(At, 1, 1); PG8_STAGE(PG8_SA(1, 0), a3, voffA);
            PG8_BAR; PG8_WAIT_L(0); PG8_MMA(1, 0, At, B0); PG8_BAR; PG8_SCHED;
            PG8_STAGE(PG8_SB(1, 1), b3 + hstep, voffB);
            PG8_WAIT_V(6); PG8_BAR; PG8_MMA(1, 1, At, B1); PG8_BAR;
            }
        }
        if constexpr (ALIGN_EPI) { if (wr == 0) PG8_BAR; }
        if constexpr (!Epi::AFTER_DRAIN) { E(acc, cur, wr, wc, fr, fq); S.done(cur); }
        if (!has_next) break;
#pragma unroll
        for (int a = 0; a < 2; ++a)
#pragma unroll
            for (int b = 0; b < 2; ++b)
#pragma unroll
                for (int m = 0; m < 4; ++m)
#pragma unroll
                    for (int n = 0; n < 2; ++n) acc[a][b][m][n] = (f32x4){0.f, 0.f, 0.f, 0.f};
        cur = nxt; cA = nA; cB = nB; ++ui;
        if constexpr (ALIGN_EPI) { if (wr == 1) PG8_BAR; }
    }
    PG8_WAIT_V(0);
    if constexpr (!ALIGN_EPI) { if (wr == 0) PG8_BAR; }
    PG8_BAR;
    if constexpr (Epi::AFTER_DRAIN) { E.fused(acc, cur, wr, wc, fr, fq, lds, wid, lane); S.done(cur); }
#undef PG8_SA
#undef PG8_SB
#undef PG8_STAGE
#undef PG8_LDA
#undef PG8_LDB
#undef PG8_MMA
#undef PG8_WAIT_V
#undef PG8_WAIT_L
#undef PG8_BAR
#undef PG8_SCHED
}
}
constexpr int NB = 4, SEQ = 8192, D = 1024, M = NB * SEQ;
constexpr int NZ0 = 3584, NZ1 = 3072, NQ = 2048, SRC_IN0 = 3592;
constexpr float EPS = 1e-6f;
constexpr int NWAVES = 8, NTHR = 512;
constexpr float LOG2E = 1.4426950408889634f;
constexpr size_t MiB = 1u << 20;
constexpr size_t WS_CTL = 0, CTL_ZERO_BYTES = 1 * MiB;
constexpr size_t WS_WIN0 = 1 * MiB, WS_WOUT0 = 8 * MiB, WS_WIN1 = 10 * MiB, WS_WOUT1 = 16 * MiB, WS_WQ = 18 * MiB;
constexpr size_t WS_KEYS = 26 * MiB, WS_MOD = WS_KEYS + 128 * 1024, WS_KMEAN = WS_MOD + 192 * 1024, WS_NLOC = WS_KMEAN + 256 * 1024,
                 WS_BEND = WS_NLOC + 512 * 1024, WS_MLOC = WS_BEND + 4096, WS_MPREV = WS_MLOC + 4096,
                 WS_ISU = 27 * MiB + 512 * 1024, WS_ISV = WS_ISU + 128 * 1024, WS_ORD = WS_ISV + 128 * 1024  ,
                 WS_QB = WS_ORD + 8 * 1024  , WS_GTAB = WS_QB + 64 * 1024  ;
constexpr size_t WS_GATES = 28 * MiB;
constexpr size_t WS_UB = 32 * MiB  , WS_VB = 64 * MiB, WS_ACT = 96 * MiB  , WS_ACTS = 100 * MiB  , WS_WQF = 112 * MiB  , WS_XNY = 160 * MiB, WS_Z = 224 * MiB, WS_CLOC = 448 * MiB, WS_END = 512 * MiB;
constexpr size_t WS_QRY = WS_Z, WS_IDX = WS_Z + 128 * MiB, WS_GATE = WS_Z + 144 * MiB, WS_PART = WS_Z  , WS_X1B = 448 * MiB  ;
constexpr size_t WS_RSS = 104 * MiB;
constexpr int CW_BAR = 4096, CW_QMOBA = 8192, CW_QDIFF = 8256, CW_QCVT0 = 8320, CW_QCVT1 = 8384;
constexpr float ALIBI_MARGIN = 27.03f;
constexpr int RING_BYTES = 139264;
constexpr int LDSCTL_OFF = RING_BYTES, MISC_OFF = LDSCTL_OFF + 320;
constexpr int LDS_BYTES = 147456;
static_assert(MISC_OFF + 128 <= LDS_BYTES, "LDS map");

#define GAS __attribute__((address_space(1)))
#define LAS __attribute__((address_space(3)))
typedef unsigned short bf16;
typedef unsigned v4u __attribute__((ext_vector_type(4)));
typedef unsigned v2u __attribute__((ext_vector_type(2)));
typedef float f32x4 __attribute__((ext_vector_type(4)));
typedef float f32x16 __attribute__((ext_vector_type(16)));
typedef short bf16x8 __attribute__((ext_vector_type(8)));
typedef short s16x4 __attribute__((ext_vector_type(4)));
typedef GAS unsigned gu32;
#define RLX_AGENT __ATOMIC_RELAXED, __HIP_MEMORY_SCOPE_AGENT
#define LDS_WAIT() asm volatile("s_waitcnt lgkmcnt(0)" ::: "memory")
#define VM_WAIT() asm volatile("s_waitcnt vmcnt(0)" ::: "memory")
__device__ __forceinline__ unsigned f2bf(float f) { unsigned u = __builtin_bit_cast(unsigned, f); return (u + 0x7fffu + ((u >> 16) & 1u)) >> 16; }
__device__ __forceinline__ unsigned pk2(float lo, float hi) { return f2bf(lo) | (f2bf(hi) << 16); }
__device__ __forceinline__ float bflo(unsigned w) { return __builtin_bit_cast(float, w << 16); }
__device__ __forceinline__ float bfhi(unsigned w) { return __builtin_bit_cast(float, w & 0xffff0000u); }
__device__ __forceinline__ float bf2f(bf16 h) { return __builtin_bit_cast(float, (unsigned)h << 16); }
__device__ __forceinline__ unsigned f2u(float x) { return __builtin_bit_cast(unsigned, x); }
__device__ __forceinline__ float u2f(unsigned x) { return __builtin_bit_cast(float, x); }
__device__ __forceinline__ float dot2bf(unsigned a, unsigned b, float acc) { typedef __bf16 bf2_ __attribute__((ext_vector_type(2))); return __builtin_amdgcn_fdot2_f32_bf16(__builtin_bit_cast(bf2_, a), __builtin_bit_cast(bf2_, b), acc, false); }
__device__ __forceinline__ float wave_sum(float v) {
#pragma unroll
    for (int o = 1; o < 64; o <<= 1) v += __shfl_xor(v, o);
    return v;
}
__device__ __forceinline__ float wave_max(float v) {
#pragma unroll
    for (int o = 1; o < 64; o <<= 1) v = fmaxf(v, __shfl_xor(v, o));
    return v;
}
__device__ __forceinline__ float silu_f(float x) { return x / (1.f + __expf(-x)); }
__device__ __forceinline__ float sigmoid_f(float x) { return 1.f / (1.f + __expf(-x)); }
__device__ __forceinline__ float logsigmoid_f(float x) { return fminf(x, 0.f) - log1pf(__expf(-fabsf(x))); }
struct Args { const float* in[24]; float* out; unsigned char* ws; int ph_lo, ph_hi; };
#define XB_TMO      128
#define XB_XCNT(j)  (256  + 64 * (j))
#define XB_XSUB(j)  (1280 + 64 * (j))
#define XB_XGEN(j)  (2304 + 64 * (j))
#define XB_TOP      3328
#define XB_TOPGEN   3392
#define XCD_BAR_WORDS 3456
#define XB_SPIN_CAP (1u << 18)

__device__ __forceinline__ unsigned xb_ld(unsigned* p)              { return __hip_atomic_load(p, __ATOMIC_RELAXED, __HIP_MEMORY_SCOPE_AGENT); }
__device__ __forceinline__ unsigned xb_add(unsigned* p, unsigned v) { return __hip_atomic_fetch_add(p, v, __ATOMIC_RELAXED, __HIP_MEMORY_SCOPE_AGENT); }
__device__ __forceinline__ unsigned xb_xcc_id() { return (unsigned)__builtin_amdgcn_s_getreg((3 << 11) | 20) & 0xFu; }
#define XB_SPIN(cond, bar) do { unsigned _sp = 0; while (cond) { __builtin_amdgcn_s_sleep(1); \
    if ((++_sp & 255u) == 0u) { if (xb_ld(&(bar)[XB_TMO])) break; if (_sp > XB_SPIN_CAP) { atomicAdd(&(bar)[XB_TMO], 1u); break; } } } } while (0)

struct XcdBarrier {
    unsigned* bar; unsigned x;
    volatile LAS unsigned* st;
};

__device__ __forceinline__ XcdBarrier xcd_barrier_post(unsigned* bar, volatile LAS unsigned* st) {
    XcdBarrier b; b.bar = bar; b.x = xb_xcc_id(); b.st = st;
    if (threadIdx.x == 0) (void)xb_add(&bar[XB_XCNT(b.x)], 1u);
    return b;
}
__device__ __forceinline__ void xcd_barrier_complete(unsigned* bar, unsigned x, unsigned& nloc, unsigned& nx) {
    const unsigned G = gridDim.x * gridDim.y * gridDim.z;
    unsigned sum, cnt, mine, sp = 0u;
    for (;;) {
        sum = 0u; cnt = 0u; mine = 0u;
#pragma unroll
        for (unsigned j = 0; j < 16; ++j) { const unsigned c = xb_ld(&bar[XB_XCNT(j)]); sum += c; cnt += (c > 0u) ? 1u : 0u; mine = (j == x) ? c : mine; }
        if (sum == G) break;
        __builtin_amdgcn_s_sleep(1);
        if ((++sp & 255u) == 0u) { if (xb_ld(&bar[XB_TMO])) break; if (sp > XB_SPIN_CAP) { atomicAdd(&bar[XB_TMO], 1u); break; } }
    }
    nloc = mine > 0u ? mine : 1u; nx = cnt > 0u ? cnt : 1u;
}

__device__ __forceinline__ void xcd_barrier(const XcdBarrier& b) {
    asm volatile("s_waitcnt vmcnt(0)" ::: "memory");
    __syncthreads();
    if (threadIdx.x == 0) {
        unsigned* bar = b.bar;
        __builtin_amdgcn_s_waitcnt(0);
        unsigned nloc = b.st[0], nx = b.st[1];
        if (nloc == 0u) { xcd_barrier_complete(bar, b.x, nloc, nx); b.st[0] = nloc; b.st[1] = nx; }
        const unsigned old = xb_add(&bar[XB_XSUB(b.x)], 1u);
        const unsigned gen = old / nloc;
        if (old + 1u == (gen + 1u) * nloc) {
            __builtin_amdgcn_fence(__ATOMIC_RELEASE, "agent");
            asm volatile("s_waitcnt vmcnt(0)" ::: "memory");
            const unsigned og = xb_add(&bar[XB_TOP], 1u);
            const unsigned tg = og / nx;
            if (og + 1u == (tg + 1u) * nx) xb_add(&bar[XB_TOPGEN], 1u);
            else XB_SPIN(xb_ld(&bar[XB_TOPGEN]) == tg, bar);
            __builtin_amdgcn_fence(__ATOMIC_ACQUIRE, "agent");
            xb_add(&bar[XB_XGEN(b.x)], 1u);
            asm volatile("s_waitcnt vmcnt(0)" ::: "memory");
        } else {
            XB_SPIN(xb_ld(&bar[XB_XGEN(b.x)]) == gen, bar);
            __builtin_amdgcn_fence(__ATOMIC_ACQUIRE, "agent");
            asm volatile("s_waitcnt vmcnt(0)" ::: "memory");
        }
    }
    __syncthreads();
}
struct Frame {
    LAS unsigned char* lds;
    int wave, G, bid;
    float* out; unsigned char* ws;
};
#define WSP(T, off) ((T*)(F.ws + (off)))

__device__ __forceinline__ void p0_transpose_item(const float* W, int K, int ldw, int nblk, int thr, int shift, bf16* WT, LAS float* scr, int item, int lane) {
    const int kb = item / nblk, nb = item % nblk, k0 = 64 * kb, n0 = 32 * nb, ns = n0 + (n0 >= thr ? shift : 0);
#pragma unroll 8
    for (int i = 0; i < 32; ++i) { const int kk = 2 * i + (lane >> 5); scr[kk * 33 + (lane & 31)] = W[(size_t)(k0 + kk) * ldw + ns + (lane & 31)]; }
    LDS_WAIT(); asm volatile("" ::: "memory");
    const int c = lane & 7;
#pragma unroll
    for (int j = 0; j < 4; ++j) { const int n = (lane >> 3) + 8 * j; const LAS float* s = scr + (8 * c) * 33 + n;
        v4u o; o.x = pk2(s[0 * 33], s[1 * 33]); o.y = pk2(s[2 * 33], s[3 * 33]); o.z = pk2(s[4 * 33], s[5 * 33]); o.w = pk2(s[6 * 33], s[7 * 33]);
        *(GAS v4u*)(WT + (size_t)(n0 + n) * K + k0 + 8 * c) = o; }
    LDS_WAIT(); asm volatile("" ::: "memory");
}
__device__ __forceinline__ void cvt_f32_bf16_stream(const float* src, bf16* dst, size_t n8, size_t gtid, size_t gthreads) {
    for (size_t i = gtid; i < n8; i += gthreads) {
        const f32x4 a = *(const GAS f32x4*)(src + i * 8), b = *(const GAS f32x4*)(src + i * 8 + 4);
        v4u o; o.x = pk2(a.x, a.y); o.y = pk2(a.z, a.w); o.z = pk2(b.x, b.y); o.w = pk2(b.z, b.w);
        *(GAS v4u*)(dst + i * 8) = o; }
}
__device__ __forceinline__ void i8_row(const float* src_row, unsigned char* dst  , float* scale  , int er, int lane) {
    const float* r = src_row + 16 * lane;
    float x[16];
#pragma unroll
    for (int q4 = 0; q4 < 4; ++q4) { const f32x4 a = *(const GAS f32x4*)(r + 4 * q4); x[4 * q4] = a.x; x[4 * q4 + 1] = a.y; x[4 * q4 + 2] = a.z; x[4 * q4 + 3] = a.w; }
    float am = 0.f;
#pragma unroll
    for (int i = 0; i < 16; ++i) am = fmaxf(am, fabsf(x[i]));
    am = wave_max(am);
    const float inv = am > 1e-30f ? 127.f / am : 0.f;
    unsigned wd[4];
#pragma unroll
    for (int q4 = 0; q4 < 4; ++q4) { unsigned w = 0;
#pragma unroll
        for (int e = 0; e < 4; ++e) { const int qv = (int)rintf(x[4 * q4 + e] * inv); w |= ((unsigned)qv & 0xffu) << (8 * e); }
        wd[q4] = w; }
    v4u o; o.x = wd[0]; o.y = wd[1]; o.z = wd[2]; o.w = wd[3];
    *(GAS v4u*)(dst + ((size_t)((lane >> 3) * 16384 + er)) * 128 + 16 * (lane & 7)) = o;
    if (lane == 0) scale[er] = am * (1.f / 127.f);
}
__device__ __forceinline__ void i8_chunk(Frame& F, const Args& A, int layer, int c) {
    const int tbl = c >> 8, row0 = (c & 255) * 64 + F.wave * 8;
    const float* src = A.in[22 + tbl] + (size_t)layer * 16384 * 1024;
    unsigned char* dst = F.ws + (tbl ? WS_VB : WS_UB) + (size_t)layer * 8 * 16384 * 128;
    float* sc = WSP(float, tbl ? WS_ISV : WS_ISU) + layer * 16384;
    for (int i = 0; i < 8; ++i) i8_row(src + (size_t)(row0 + i) * 1024, dst, sc, row0 + i, ((int)(threadIdx.x & 63u)));
}
__device__ __forceinline__ void p0_prologue(Frame& F, const Args& A) {
    {
        const float* c = A.in[1]; const float* aw = A.in[2]; const float* ab = A.in[3]; float* MOD = WSP(float, WS_MOD);
        LAS float* red = (LAS float*)F.lds;
        for (int item = F.bid; item < 192; item += F.G) {
            const int l = item / 96, n0 = (item % 96) * 64;
            float acc[4] = {0.f, 0.f, 0.f, 0.f};
            const int kbeg = F.wave * 128;
#pragma unroll 4
            for (int k = kbeg; k < kbeg + 128; ++k) {
                const float wv = aw[((size_t)l * 1024 + k) * 6144 + n0 + ((int)(threadIdx.x & 63u))];
#pragma unroll
                for (int b = 0; b < 4; ++b) acc[b] += silu_f(c[b * 1024 + k]) * wv;
            }
#pragma unroll
            for (int b = 0; b < 4; ++b) red[(F.wave * 4 + b) * 64 + ((int)(threadIdx.x & 63u))] = acc[b];
            __syncthreads();
            if (((int)threadIdx.x) < 256) { const int b = ((int)threadIdx.x) >> 6, ln = ((int)threadIdx.x) & 63; float s = ab[l * 6144 + n0 + ln];
#pragma unroll
                for (int w = 0; w < 8; ++w) s += red[(w * 4 + b) * 64 + ln];
                MOD[(size_t)(l * 4 + b) * 6144 + n0 + ln] = s; }
            __syncthreads();
        }
    }
    if (F.bid == 0) {
        LAS unsigned* hist = (LAS unsigned*)F.lds;
        unsigned short* ORD = WSP(unsigned short, WS_ORD);
        for (int pass = 0; pass < 2; ++pass) {
            const int nunits = pass == 0 ? 2048 : 1024;
            if (((int)threadIdx.x) < 160) hist[((int)threadIdx.x)] = 0u;
            __syncthreads();
            for (int u = ((int)threadIdx.x); u < nunits; u += NTHR) {
                const int q = pass == 0 ? (u & 63) : (u & 31), h = pass == 0 ? ((u >> 6) & 7) : ((u >> 5) & 7);
                const float dcut = 46.f * (float)(2 << h);
                int cost;
                if (pass == 0) { const int nt = 2 * q + 2; int lo = (int)ceilf(((float)(q * 128) - dcut - 63.f) * (1.f / 64.f)); if (lo < 0) lo = 0; cost = nt - lo; }
                else { int lo = (int)ceilf(((float)(q * 256) - dcut - 255.f) * (1.f / 256.f)); if (lo < 0) lo = 0; int nb = q - lo; if (nb > 3 * 8) nb = 24; cost = 4 * (nb + 1); }
                if (cost > 159) cost = 159;
                atomicAdd((unsigned*)(hist + (159 - cost)), 1u);
            }
            __syncthreads();
            if (((int)threadIdx.x) == 0) { unsigned acc = 0; for (int i = 0; i < 160; ++i) { const unsigned c = hist[i]; hist[i] = acc; acc += c; } }
            __syncthreads();
            for (int u = ((int)threadIdx.x); u < nunits; u += NTHR) {
                const int q = pass == 0 ? (u & 63) : (u & 31), h = pass == 0 ? ((u >> 6) & 7) : ((u >> 5) & 7);
                const float dcut = 46.f * (float)(2 << h);
                int cost;
                if (pass == 0) { const int nt = 2 * q + 2; int lo = (int)ceilf(((float)(q * 128) - dcut - 63.f) * (1.f / 64.f)); if (lo < 0) lo = 0; cost = nt - lo; }
                else { int lo = (int)ceilf(((float)(q * 256) - dcut - 255.f) * (1.f / 256.f)); if (lo < 0) lo = 0; int nb = q - lo; if (nb > 3 * 8) nb = 24; cost = 4 * (nb + 1); }
                if (cost > 159) cost = 159;
                const unsigned pos = atomicAdd((unsigned*)(hist + (159 - cost)), 1u);
                ORD[(pass == 0 ? 0 : 2048) + pos] = (unsigned short)u;
            }
            __syncthreads();
        }
    }
    {
        LAS float* scr = (LAS float*)(F.lds + F.wave * 8704);
        const int gw = F.bid * NWAVES + F.wave, NGW = F.G * NWAVES;
        constexpr int I_IN0 = 16 * (NZ0 / 32), I_OUT = 16 * 32, I_IN1 = 16 * (NZ1 / 32), I_Q = 16 * (NQ / 32);
        constexpr int NITEMS = I_IN0 + 2 * I_OUT + I_IN1 + 2 * I_Q;
        for (int it = gw; it < NITEMS; it += NGW) {
            int r = it;
            if (r < I_IN0) { p0_transpose_item(A.in[6], D, SRC_IN0, NZ0 / 32, 2048, 8, WSP(bf16, WS_WIN0), scr, r, ((int)(threadIdx.x & 63u))); continue; } r -= I_IN0;
            if (r < I_OUT) { p0_transpose_item(A.in[13], D, D, 32, 1 << 30, 0, WSP(bf16, WS_WOUT0), scr, r, ((int)(threadIdx.x & 63u))); continue; } r -= I_OUT;
            if (r < I_IN1) { p0_transpose_item(A.in[14], D, NZ1, NZ1 / 32, 1 << 30, 0, WSP(bf16, WS_WIN1), scr, r, ((int)(threadIdx.x & 63u))); continue; } r -= I_IN1;
            if (r < I_OUT) { p0_transpose_item(A.in[19], D, D, 32, 1 << 30, 0, WSP(bf16, WS_WOUT1), scr, r, ((int)(threadIdx.x & 63u))); continue; } r -= I_OUT;
            if (r < I_Q) { p0_transpose_item(A.in[20], D, NQ, NQ / 32, 1 << 30, 0, WSP(bf16, WS_WQ), scr, r, ((int)(threadIdx.x & 63u))); continue; } r -= I_Q;
            p0_transpose_item(A.in[20] + (size_t)D * NQ, D, NQ, NQ / 32, 1 << 30, 0, WSP(bf16, WS_WQ) + (size_t)NQ * D, scr, r, ((int)(threadIdx.x & 63u)));
        }
    }
    {
        const size_t gtid = (size_t)F.bid * NTHR + ((int)threadIdx.x), gth = (size_t)F.G * NTHR;
        cvt_f32_bf16_stream(A.in[21], WSP(bf16, WS_KEYS), (size_t)2 * 2 * 128 * 128 / 8, gtid, gth);
    }
}

template <bool GATES>
__device__ __forceinline__ void norm_pass(Frame& F, const Args& A, const float* X, const float* g, const float* mod, int shc, bf16* XN) {
    LAS float* wgT = (LAS float*)F.lds;
    if (GATES) {
        const float* win = A.in[6];
        for (int i = ((int)threadIdx.x); i < 8 * 1024; i += NTHR) { const int cg = i >> 10, k = i & 1023; wgT[i] = win[(size_t)k * SRC_IN0 + 2048 + cg]; }
        __syncthreads();
    }
    const int gw = F.bid * NWAVES + F.wave, NGW = F.G * NWAVES;
    for (int row = gw; row < M; row += NGW) {
        const int b = row >> 13;
        const GAS f32x4* xr = (const GAS f32x4*)(X + (size_t)row * D) + ((int)(threadIdx.x & 63u));
        f32x4 v[4]; float ss = 0.f;
#pragma unroll
        for (int j = 0; j < 4; ++j) { v[j] = xr[64 * j]; ss += (v[j].x * v[j].x + v[j].y * v[j].y) + (v[j].z * v[j].z + v[j].w * v[j].w); }
        const float rstd = rsqrtf(wave_sum(ss) * (1.f / D) + EPS);
        const float* shp = mod + (size_t)b * 6144 + shc * 1024; const float* scp = shp + 1024;
#pragma unroll
        for (int j = 0; j < 4; ++j) { const int c = 4 * ((int)(threadIdx.x & 63u)) + 256 * j;
            const f32x4 gg = *(const f32x4*)(g + c), sc = *(const f32x4*)(scp + c), sh = *(const f32x4*)(shp + c);
            v[j] = v[j] * rstd * gg * (sc + 1.f) + sh;
            v2u o; o.x = pk2(v[j].x, v[j].y); o.y = pk2(v[j].z, v[j].w);
            *(GAS v2u*)(XN + (size_t)row * D + c) = o; }
        if (GATES) {
            float* GT = WSP(float, WS_GATES);
#pragma unroll
            for (int cg = 0; cg < 8; ++cg) { float p = 0.f;
#pragma unroll
                for (int j = 0; j < 4; ++j) { const f32x4 w = *(const LAS f32x4*)(wgT + cg * 1024 + 4 * ((int)(threadIdx.x & 63u)) + 256 * j); p += (v[j].x * w.x + v[j].y * w.y) + (v[j].z * w.z + v[j].w * w.w); }
                p = wave_sum(p);
                if (((int)(threadIdx.x & 63u)) == 0) GT[(size_t)row * 8 + cg] = p + (cg < 4 ? A.in[8][cg] : A.in[9][cg - 4]); }
        }
    }
}

__device__ __forceinline__ void qknorm_unit(Frame& F, bf16* Z, int ldz, int row0, int col0, const float* g, float gmul, float* kmean  ) {
    const int c = col0 + 8 * ((int)(threadIdx.x & 63u)), d0 = (8 * ((int)(threadIdx.x & 63u))) & 63;
    float gv[8];
#pragma unroll
    for (int i = 0; i < 8; ++i) gv[i] = g[d0 + i] * gmul;
    float ks[8] = {0.f, 0.f, 0.f, 0.f, 0.f, 0.f, 0.f, 0.f};
    for (int r = 0; r < 32; ++r) {
        bf16* p = Z + (size_t)(row0 + F.wave * 32 + r) * ldz + c;
        const v4u w = *(const GAS v4u*)p;
        float x[8] = {bflo(w.x), bfhi(w.x), bflo(w.y), bfhi(w.y), bflo(w.z), bfhi(w.z), bflo(w.w), bfhi(w.w)};
        float ss = 0.f;
#pragma unroll
        for (int i = 0; i < 8; ++i) ss += x[i] * x[i];
        ss += __shfl_xor(ss, 1); ss += __shfl_xor(ss, 2); ss += __shfl_xor(ss, 4);
        const float rstd = rsqrtf(ss * (1.f / 64.f) + EPS);
#pragma unroll
        for (int i = 0; i < 8; ++i) { x[i] = x[i] * rstd * gv[i]; ks[i] += x[i]; }
        v4u o; o.x = pk2(x[0], x[1]); o.y = pk2(x[2], x[3]); o.z = pk2(x[4], x[5]); o.w = pk2(x[6], x[7]);
        *(GAS v4u*)p = o;
    }
    if (kmean) {
        LAS float* red = (LAS float*)F.lds;
#pragma unroll
        for (int i = 0; i < 8; ++i) red[F.wave * 512 + 8 * ((int)(threadIdx.x & 63u)) + i] = ks[i];
        __syncthreads();
        { float s = 0.f;
#pragma unroll
          for (int w = 0; w < 8; ++w) s += red[w * 512 + ((int)threadIdx.x)];
          kmean[(size_t)(((int)threadIdx.x) >> 6) * (32 * 64) + (((int)threadIdx.x) & 63)] = s * (1.f / 256.f); }
        __syncthreads();
    }
}

__device__ __forceinline__ void kmean_unit(Frame& F, const bf16* Z, int ldz, int row0, int col0, float* kmean) {
    const int c = col0 + 8 * ((int)(threadIdx.x & 63u));
    float ks[8] = {0.f, 0.f, 0.f, 0.f, 0.f, 0.f, 0.f, 0.f};
#pragma unroll 4
    for (int r = 0; r < 32; ++r) {
        const v4u w = *(const GAS v4u*)(Z + (size_t)(row0 + F.wave * 32 + r) * ldz + c);
        ks[0] += bflo(w.x); ks[1] += bfhi(w.x); ks[2] += bflo(w.y); ks[3] += bfhi(w.y); ks[4] += bflo(w.z); ks[5] += bfhi(w.z); ks[6] += bflo(w.w); ks[7] += bfhi(w.w);
    }
    LAS float* red = (LAS float*)F.lds;
#pragma unroll
    for (int i = 0; i < 8; ++i) red[F.wave * 512 + 8 * ((int)(threadIdx.x & 63u)) + i] = ks[i];
    __syncthreads();
    { float s = 0.f;
#pragma unroll
      for (int w = 0; w < 8; ++w) s += red[w * 512 + ((int)threadIdx.x)];
      kmean[(size_t)(((int)threadIdx.x) >> 6) * (32 * 64) + (((int)threadIdx.x) & 63)] = s * (1.f / 256.f); }
    __syncthreads();
}

constexpr int KSTRB = 144;
template <int DV> struct VStr { static constexpr int B = (DV == 64) ? 192 : 320; };
typedef short v4i16_t __attribute__((ext_vector_type(4)));
__device__ __forceinline__ s16x4 vtr(const LAS unsigned char* p) { return __builtin_bit_cast(s16x4, __builtin_amdgcn_ds_read_tr16_b64_v4i16((LAS v4i16_t*)p)); }
__device__ __forceinline__ unsigned cvtpk(float lo, float hi) { typedef float f2 __attribute__((ext_vector_type(2))); typedef __bf16 b2 __attribute__((ext_vector_type(2)));
    f2 v = {lo, hi}; b2 b = __builtin_convertvector(v, b2); return __builtin_bit_cast(unsigned, b); }
__device__ __forceinline__ float xhalf(float v) {
    auto rr = __builtin_amdgcn_permlane32_swap(__builtin_bit_cast(unsigned, v), __builtin_bit_cast(unsigned, v), false, false);
    const unsigned r0 = rr[0], r1 = rr[1]; return u2f((threadIdx.x & 32) ? r0 : r1);
}
template <int DV> struct AttnSt { f32x16 o[DV / 32]; float m, l; };
template <int DV> __device__ __forceinline__ void attn_init(AttnSt<DV>& st) {
#pragma unroll
    for (int t = 0; t < DV / 32; ++t)
#pragma unroll
        for (int r = 0; r < 16; ++r) st.o[t][r] = 0.f;
    st.m = -1e30f; st.l = 0.f;
}
template <int DV>
__device__ __forceinline__ void attn_qk(AttnSt<DV>& st, const LAS unsigned char* Kt, const bf16x8 (&qf)[4], float sl2, int tq, int kt0, bool diag, bool rowok, int lane, bf16x8 (&pf)[2][2]) {
    const int r32 = lane & 31, hi = lane >> 5;
    const int kb = kt0 + 4 * hi;
    const float c0 = -sl2 * (float)(tq - kb);
    f32x16 s0, s1;
#pragma unroll
    for (int r = 0; r < 16; ++r) { const int ko = (r & 3) + 8 * (r >> 2); s0[r] = c0 + sl2 * (float)ko; s1[r] = c0 + sl2 * (float)(ko + 32); }
    const LAS unsigned char* kp = Kt + r32 * KSTRB + hi * 16;
#pragma unroll
    for (int ks = 0; ks < 4; ++ks) {
        const bf16x8 k0 = *(const LAS bf16x8*)(kp + ks * 32), k1 = *(const LAS bf16x8*)(kp + 32 * KSTRB + ks * 32);
        s0 = __builtin_amdgcn_mfma_f32_32x32x16_bf16(k0, qf[ks], s0, 0, 0, 0);
        s1 = __builtin_amdgcn_mfma_f32_32x32x16_bf16(k1, qf[ks], s1, 0, 0, 0);
    }
    if (diag || !rowok) {
#pragma unroll
        for (int r = 0; r < 16; ++r) { const int ko = (r & 3) + 8 * (r >> 2);
            if (!rowok || kb + ko > tq) s0[r] = -INFINITY;
            if (!rowok || kb + ko + 32 > tq) s1[r] = -INFINITY; }
    }
    float mx = fmaxf(s0[0], s1[0]);
#pragma unroll
    for (int r = 1; r < 16; ++r) mx = fmaxf(mx, fmaxf(s0[r], s1[r]));
    mx = fmaxf(mx, xhalf(mx));
    if (__any(mx > st.m)) {
        const float mn = fmaxf(st.m, mx);
        const float alpha = __builtin_amdgcn_exp2f(st.m - mn);
        st.m = mn; st.l *= alpha;
#pragma unroll
        for (int t = 0; t < DV / 32; ++t)
#pragma unroll
            for (int r = 0; r < 16; ++r) st.o[t][r] *= alpha;
    }
    const float mn = st.m;
    float ps = 0.f;
#pragma unroll
    for (int r = 0; r < 16; ++r) { s0[r] = __builtin_amdgcn_exp2f(s0[r] - mn); s1[r] = __builtin_amdgcn_exp2f(s1[r] - mn); ps += s0[r] + s1[r]; }
    st.l += ps;
#pragma unroll
    for (int s = 0; s < 2; ++s) {
        v4u a, b;
        a.x = cvtpk(s0[8 * s + 0], s0[8 * s + 1]); a.y = cvtpk(s0[8 * s + 2], s0[8 * s + 3]); a.z = cvtpk(s0[8 * s + 4], s0[8 * s + 5]); a.w = cvtpk(s0[8 * s + 6], s0[8 * s + 7]);
        b.x = cvtpk(s1[8 * s + 0], s1[8 * s + 1]); b.y = cvtpk(s1[8 * s + 2], s1[8 * s + 3]); b.z = cvtpk(s1[8 * s + 4], s1[8 * s + 5]); b.w = cvtpk(s1[8 * s + 6], s1[8 * s + 7]);
        pf[0][s] = __builtin_bit_cast(bf16x8, a); pf[1][s] = __builtin_bit_cast(bf16x8, b);
    }
}
template <int DV>
__device__ __forceinline__ void attn_pv(AttnSt<DV>& st, const LAS unsigned char* Vt, const bf16x8 (&pf)[2][2], int lane) {
    constexpr int VS = VStr<DV>::B;
    const int g = lane >> 4, i16 = lane & 15;
    const LAS unsigned char* vp = Vt + (4 * (g >> 1) + (i16 >> 2)) * VS + (16 * (g & 1) + 4 * (i16 & 3)) * 2;
#pragma unroll
    for (int kbk = 0; kbk < 2; ++kbk)
#pragma unroll
        for (int s = 0; s < 2; ++s)
#pragma unroll
            for (int t = 0; t < DV / 32; ++t) {
                const s16x4 lo = vtr(vp + (kbk * 32 + 16 * s) * VS + t * 64), h8 = vtr(vp + (kbk * 32 + 16 * s + 8) * VS + t * 64);
                const bf16x8 va = {lo[0], lo[1], lo[2], lo[3], h8[0], h8[1], h8[2], h8[3]};
                st.o[t] = __builtin_amdgcn_mfma_f32_32x32x16_bf16(va, pf[kbk][s], st.o[t], 0, 0, 0);
            }
}
template <int DV>
__device__ __forceinline__ void attn_tile(AttnSt<DV>& st, const LAS unsigned char* Kt, const LAS unsigned char* Vt, const bf16x8 (&qf)[4], float sc2, float sl2, int tq, int kt0, bool diag, bool rowok, int lane) {
    bf16x8 pf[2][2];
    attn_qk<DV>(st, Kt, qf, sl2, tq, kt0, diag, rowok, lane, pf);
    attn_pv<DV>(st, Vt, pf, lane);
}
template <int NK, int DV> struct TileRegs { v4u k[NK]; v4u v[DV / 64]; };
template <int NK, int DV>
__device__ __forceinline__ void tile_load(TileRegs<NK, DV>& R, const bf16* Z, int ldz, size_t zrow0, int kcol, int vcol, int tid) {
#pragma unroll
    for (int i = 0; i < NK; ++i) { const int ch = tid + 512 * i; const int row = ch / (8 * NK), cc = ch % (8 * NK);
        R.k[i] = *(const GAS v4u*)(Z + (zrow0 + row) * ldz + kcol + cc * 8); }
#pragma unroll
    for (int i = 0; i < DV / 64; ++i) { const int ch = tid + 512 * i; const int row = ch / (DV / 8), cc = ch % (DV / 8);
        R.v[i] = *(const GAS v4u*)(Z + (zrow0 + row) * ldz + vcol + cc * 8); }
}
template <int NK, int DV>
__device__ __forceinline__ void tile_store(const TileRegs<NK, DV>& R, LAS unsigned char* Kt  , LAS unsigned char* Vt, int tid) {
#pragma unroll
    for (int i = 0; i < NK; ++i) { const int ch = tid + 512 * i; const int row = ch / (8 * NK), cc = ch % (8 * NK);
        *(LAS v4u*)(Kt + (cc >> 3) * (64 * KSTRB) + row * KSTRB + (cc & 7) * 16) = R.k[i]; }
#pragma unroll
    for (int i = 0; i < DV / 64; ++i) { const int ch = tid + 512 * i; const int row = ch / (DV / 8), cc = ch % (DV / 8);
        *(LAS v4u*)(Vt + row * VStr<DV>::B + cc * 16) = R.v[i]; }
}
__device__ __forceinline__ void moba_unit(Frame& F, int b, int h, int j, float tcut  ) {
    const bf16* Z = WSP(bf16, WS_Z); constexpr int ldz = NZ0;
    const int lane = ((int)(threadIdx.x & 63u)), w = F.wave, r32 = lane & 31, hi = lane >> 5, tid = ((int)threadIdx.x);
    const size_t rowb = (size_t)b * SEQ;
    const int qpos = j * 256 + w * 32 + r32;
    const int qcol = 2048 + h * 64, kcol = 2560 + h * 64, vcol = 3072 + h * 64;
    LAS unsigned char* lds = F.lds;
    constexpr int BUFB = 64 * KSTRB + 64 * VStr<64>::B;
    LAS unsigned char* kmh = lds + 2 * BUFB;
    LAS unsigned char* kml = lds + 2 * BUFB + 32 * KSTRB;
    LAS unsigned* msk = (LAS unsigned*)(lds + 2 * BUFB + 64 * KSTRB);
    { const float* KM = WSP(float, WS_KMEAN) + (size_t)((b * 8 + h) * 32) * 64; const f32x4 x = *(const f32x4*)(KM + 4 * tid);
      const int n = tid >> 4, d0 = (tid & 15) * 4;
      const unsigned h0 = f2bf(x.x), h1 = f2bf(x.y), h2 = f2bf(x.z), h3 = f2bf(x.w);
      v2u hv; hv.x = h0 | (h1 << 16); hv.y = h2 | (h3 << 16);
      v2u lv; lv.x = pk2(x.x - u2f(h0 << 16), x.y - u2f(h1 << 16)); lv.y = pk2(x.z - u2f(h2 << 16), x.w - u2f(h3 << 16));
      *(LAS v2u*)(kmh + n * KSTRB + d0 * 2) = hv; *(LAS v2u*)(kml + n * KSTRB + d0 * 2) = lv; }
    if (tid < 16) msk[tid] = 0u;
    bf16x8 qf[4];
    const bf16* qrow = Z + (rowb + qpos) * ldz + qcol;
#pragma unroll
    for (int ks = 0; ks < 4; ++ks) qf[ks] = *(const GAS bf16x8*)(qrow + 16 * ks + 8 * hi);
    __syncthreads();
    f32x16 gt;
#pragma unroll
    for (int r = 0; r < 16; ++r) gt[r] = 0.f;
#pragma unroll
    for (int ks = 0; ks < 4; ++ks) {
        const bf16x8 a = *(const LAS bf16x8*)(kmh + r32 * KSTRB + hi * 16 + ks * 32), c = *(const LAS bf16x8*)(kml + r32 * KSTRB + hi * 16 + ks * 32);
        gt = __builtin_amdgcn_mfma_f32_32x32x16_bf16(a, qf[ks], gt, 0, 0, 0);
        gt = __builtin_amdgcn_mfma_f32_32x32x16_bf16(c, qf[ks], gt, 0, 0, 0);
    }
    float t0 = -INFINITY, t1 = -INFINITY, t2 = -INFINITY;
#define INS3(key) do { float k_ = (key); float a_ = fmaxf(t0, k_), l_ = fminf(t0, k_); t0 = a_; a_ = fmaxf(t1, l_); l_ = fminf(t1, l_); t1 = a_; t2 = fmaxf(t2, l_); } while (0)
#pragma unroll
    for (int r = 0; r < 16; ++r) { const int n = (r & 3) + 8 * (r >> 2) + 4 * hi;
        const float key = (n < j) ? u2f((f2u(gt[r]) & ~31u) | (unsigned)n) : -INFINITY; INS3(key); }
    { const float p0 = xhalf(t0), p1 = xhalf(t1), p2 = xhalf(t2); INS3(p0); INS3(p1); INS3(p2); }
#undef INS3
    const int sel0 = (t0 > -INFINITY) ? (int)(f2u(t0) & 31u) : -1;
    const int sel1 = (t1 > -INFINITY) ? (int)(f2u(t1) & 31u) : -1;
    const int sel2 = (t2 > -INFINITY) ? (int)(f2u(t2) & 31u) : -1;
    { const unsigned mm = (sel0 >= 0 ? 1u << sel0 : 0u) | (sel1 >= 0 ? 1u << sel1 : 0u) | (sel2 >= 0 ? 1u << sel2 : 0u);
      if (mm) { __hip_atomic_fetch_or(msk + w, mm, __ATOMIC_RELAXED, __HIP_MEMORY_SCOPE_WORKGROUP); __hip_atomic_fetch_or(msk + 8, mm, __ATOMIC_RELAXED, __HIP_MEMORY_SCOPE_WORKGROUP); } }
    __syncthreads();
    const float slope = ldexpf(1.f, -(h + 1)), dcut = tcut / slope;
    const float sl2 = slope * LOG2E, sc2 = 0.125f * LOG2E;
    int nlo = (int)ceilf(((float)(j * 256) - dcut - 255.f) * (1.f / 256.f)); if (nlo < 0) nlo = 0;
    const unsigned keep = nlo >= 32 ? 0u : (0xffffffffu << nlo);
    const unsigned bmask = msk[8] & keep; const unsigned wmask = (unsigned)__builtin_amdgcn_readfirstlane((int)msk[w]) & keep;
    AttnSt<64> st; attn_init<64>(st);
    unsigned rem = bmask;
    int blk = j, kt = 3, buf = 0;
    TileRegs<1, 64> R;
    tile_load<1, 64>(R, Z, ldz, rowb + blk * 256 + kt * 64, kcol, vcol, tid);
    tile_store<1, 64>(R, lds, lds + 64 * KSTRB, tid);
    __syncthreads();
    for (;;) {
        int nblk = blk, nkt = kt - 1; bool has_next = true;
        if (nkt < 0) { nkt = 3; if (rem) { nblk = 31 - __builtin_clz(rem); rem &= ~(1u << nblk); } else has_next = false; }
        if (has_next) tile_load<1, 64>(R, Z, ldz, rowb + nblk * 256 + nkt * 64, kcol, vcol, tid);
        const bool own = (blk == j);
        const bool active = (own ? (kt * 64 <= w * 32 + 31) : (((wmask >> blk) & 1u) != 0u)) && ((float)(j * 256 + w * 32 - (blk * 256 + kt * 64 + 63)) <= dcut);
        if (active) {
            const bool rowok = own || blk == sel0 || blk == sel1 || blk == sel2;
            const bool diag = own && (kt * 64 + 63 > w * 32);
            attn_tile<64>(st, lds + buf * BUFB, lds + buf * BUFB + 64 * KSTRB, qf, sc2, sl2, qpos, blk * 256 + kt * 64, diag, rowok, lane);
        }
        if (!has_next) break;
        tile_store<1, 64>(R, lds + (buf ^ 1) * BUFB, lds + (buf ^ 1) * BUFB + 64 * KSTRB, tid);
        __syncthreads();
        buf ^= 1; blk = nblk; kt = nkt;
    }
    const float inv = 1.f / (st.l + xhalf(st.l));
    bf16* Y = WSP(bf16, WS_XNY) + (rowb + qpos) * 1024 + 512 + h * 64;
#pragma unroll
    for (int t = 0; t < 2; ++t)
#pragma unroll
        for (int rg = 0; rg < 4; ++rg) { v2u o; o.x = pk2(st.o[t][4 * rg] * inv, st.o[t][4 * rg + 1] * inv); o.y = pk2(st.o[t][4 * rg + 2] * inv, st.o[t][4 * rg + 3] * inv);
            *(GAS v2u*)(Y + t * 32 + 8 * rg + 4 * hi) = o; }
    __syncthreads();
}

__device__ __forceinline__ void diff_unit(Frame& F, const Args& A, int b, int h, int qt, float lam, float tcut, const int probe) {
    (void)probe;
    const bf16* Z = WSP(bf16, WS_Z); constexpr int ldz = NZ1;
    const int lane = ((int)(threadIdx.x & 63u)), w = F.wave, r32 = lane & 31, hi = lane >> 5, tid = ((int)threadIdx.x);
    const int comp = w >> 2, wq = w & 3;
    const size_t rowb = (size_t)b * SEQ;
    const int q0 = qt * 128, qpos = q0 + wq * 32 + r32;
    const int qcol = h * 128 + comp * 64, kcol = 1024 + h * 128, vcol = 2048 + h * 128;
    LAS unsigned char* lds = F.lds;
    constexpr int BUFB = 2 * 64 * KSTRB + 64 * VStr<128>::B;
    bf16x8 qf[4];
    const bf16* qrow = Z + (rowb + qpos) * ldz + qcol;
#pragma unroll
    for (int ks = 0; ks < 4; ++ks) qf[ks] = *(const GAS bf16x8*)(qrow + 16 * ks + 8 * hi);
    const float slope = ldexpf(1.f, -(h + 1)), dcut = tcut / slope;
    const float sl2 = slope * LOG2E, sc2 = 0.125f * LOG2E;
    AttnSt<128> st; attn_init<128>(st);
    const int nt = (q0 + 128) / 64;
    int kt_lo = (int)ceilf(((float)q0 - dcut - 63.f) * (1.f / 64.f)); if (kt_lo < 0) kt_lo = 0;
    TileRegs<2, 128> R;
    tile_load<2, 128>(R, Z, ldz, rowb + (size_t)(nt - 1) * 64, kcol, vcol, tid);
    tile_store<2, 128>(R, lds, lds + 2 * 64 * KSTRB, tid);
    __syncthreads();
    int buf = 0;
    for (int kt = nt - 1; kt >= kt_lo; --kt) {
        const bool has_next = kt > kt_lo;
        if (has_next) tile_load<2, 128>(R, Z, ldz, rowb + (size_t)(kt - 1) * 64, kcol, vcol, tid);
        if (kt * 64 <= q0 + wq * 32 + 31) {
            const bool diag = kt * 64 + 63 > q0 + wq * 32;
            attn_tile<128>(st, lds + buf * BUFB + comp * (64 * KSTRB), lds + buf * BUFB + 2 * 64 * KSTRB, qf, sc2, sl2, qpos, kt * 64, diag, true, lane);
        }
        if (has_next) { tile_store<2, 128>(R, lds + (buf ^ 1) * BUFB, lds + (buf ^ 1) * BUFB + 2 * 64 * KSTRB, tid); }
        __syncthreads();
        buf ^= 1;
    }
    const float inv = 1.f / (st.l + xhalf(st.l));
    LAS float* o2 = (LAS float*)lds;
    if (comp == 1) {
#pragma unroll
        for (int t = 0; t < 4; ++t)
#pragma unroll
            for (int r = 0; r < 16; ++r) o2[((wq * 4 + t) * 16 + r) * 64 + lane] = st.o[t][r] * inv;
    }
    __syncthreads();
    if (comp == 0) {
        float ss = 0.f;
#pragma unroll
        for (int t = 0; t < 4; ++t)
#pragma unroll
            for (int r = 0; r < 16; ++r) { const float v = st.o[t][r] * inv - lam * o2[((wq * 4 + t) * 16 + r) * 64 + lane]; st.o[t][r] = v; ss += v * v; }
        ss += xhalf(ss);
        const float rs = rsqrtf(ss * (1.f / 128.f) + EPS) * 0.6444909324090307f;
        const float* og = A.in[18];
        bf16* Y = WSP(bf16, WS_XNY) + (rowb + qpos) * 1024 + h * 128;
#pragma unroll
        for (int t = 0; t < 4; ++t)
#pragma unroll
            for (int rg = 0; rg < 4; ++rg) { const int dv = t * 32 + 8 * rg + 4 * hi; const f32x4 gg = *(const f32x4*)(og + dv);
                v2u o; o.x = pk2(st.o[t][4 * rg] * rs * gg.x, st.o[t][4 * rg + 1] * rs * gg.y); o.y = pk2(st.o[t][4 * rg + 2] * rs * gg.z, st.o[t][4 * rg + 3] * rs * gg.w);
                *(GAS v2u*)(Y + dv) = o; }
    }
    __syncthreads();
}
template <int MT, int NT>
__device__ __forceinline__ void mma_nt(const LAS unsigned char* A, int lda, const LAS unsigned char* B, int ldb, int K, f32x4 (&acc)[MT][NT], int lane) {
    const int r = lane & 15, kq = (lane >> 4) * 16;
    for (int k0 = 0; k0 < K; k0 += 32) {
        bf16x8 a[MT], bb[NT];
#pragma unroll
        for (int m = 0; m < MT; ++m) a[m] = *(const LAS bf16x8*)(A + (m * 16 + r) * lda + k0 * 2 + kq);
#pragma unroll
        for (int n = 0; n < NT; ++n) bb[n] = *(const LAS bf16x8*)(B + (n * 16 + r) * ldb + k0 * 2 + kq);
#pragma unroll
        for (int m = 0; m < MT; ++m)
#pragma unroll
            for (int n = 0; n < NT; ++n) acc[m][n] = __builtin_amdgcn_mfma_f32_16x16x32_bf16(a[m], bb[n], acc[m][n], 0, 0, 0);
    }
}
constexpr int TS = 272;
constexpr int TILEB = 128 * TS;
constexpr int ML_Q = 0, ML_K = TILEB, ML_V = 2 * TILEB, ML_SM = 3 * TILEB;

__device__ __forceinline__ void ml_gates(const float* GT, size_t row0, int hm, LAS float* sm, int lane) {
    const float i0 = GT[(row0 + 2 * lane) * 8 + hm], i1 = GT[(row0 + 2 * lane + 1) * 8 + hm];
    const float f0 = logsigmoid_f(GT[(row0 + 2 * lane) * 8 + 4 + hm]), f1 = logsigmoid_f(GT[(row0 + 2 * lane + 1) * 8 + 4 + hm]);
    float s = f0 + f1;
#pragma unroll
    for (int o = 1; o < 64; o <<= 1) { const float t = __shfl_up(s, o); if (lane >= o) s += t; }
    const float excl = s - (f0 + f1);
    sm[2 * lane] = excl + f0; sm[2 * lane + 1] = excl + f0 + f1;
    sm[128 + 2 * lane] = i0; sm[128 + 2 * lane + 1] = i1;
}
template <bool TRANSPOSE>
__device__ __forceinline__ void ml_conv_tile(const bf16* Z, size_t rowb, int t0, int zc, const float* cw, int wc, float mul, LAS unsigned char* dst, const LAS float* rs, int tid) {
#pragma unroll
    for (int it = 0; it < 4; ++it) {
        const int item = tid + 512 * it, l = item >> 4, ch = (item & 15) * 8;
        float acc[8];
#pragma unroll
        for (int i = 0; i < 8; ++i) acc[i] = 0.f;
#pragma unroll
        for (int jj = 0; jj < 4; ++jj) {
            const int t = t0 + l - 3 + jj;
            if (t >= 0) {
                const v4u w = *(const GAS v4u*)(Z + (rowb + t) * NZ0 + zc + ch);
                const float x[8] = {bflo(w.x), bfhi(w.x), bflo(w.y), bfhi(w.y), bflo(w.z), bfhi(w.z), bflo(w.w), bfhi(w.w)};
                const f32x4 c0 = *(const f32x4*)(cw + jj * 1024 + wc + ch), c1 = *(const f32x4*)(cw + jj * 1024 + wc + ch + 4);
                acc[0] += x[0] * c0.x; acc[1] += x[1] * c0.y; acc[2] += x[2] * c0.z; acc[3] += x[3] * c0.w;
                acc[4] += x[4] * c1.x; acc[5] += x[5] * c1.y; acc[6] += x[6] * c1.z; acc[7] += x[7] * c1.w;
            }
        }
        const float sc = TRANSPOSE ? mul * rs[l] : mul;
#pragma unroll
        for (int i = 0; i < 8; ++i) acc[i] = silu_f(acc[i]) * sc;
        if (TRANSPOSE) {
#pragma unroll
            for (int i = 0; i < 8; ++i) *(LAS bf16*)(dst + (ch + i) * TS + l * 2) = (bf16)f2bf(acc[i]);
        } else {
            v4u o; o.x = pk2(acc[0], acc[1]); o.y = pk2(acc[2], acc[3]); o.z = pk2(acc[4], acc[5]); o.w = pk2(acc[6], acc[7]);
            *(LAS v4u*)(dst + l * TS + ch * 2) = o;
        }
    }
}
__device__ __forceinline__ void ml_vt_tile(const bf16* Z, size_t row0, int zc, LAS unsigned char* dst, int tid) {
#pragma unroll
    for (int it = 0; it < 4; ++it) {
        const int item = tid + 512 * it, l = item >> 4, ch = (item & 15) * 8;
        const v4u w = *(const GAS v4u*)(Z + (row0 + l) * NZ0 + zc + ch);
        const unsigned ww[4] = {w.x, w.y, w.z, w.w};
#pragma unroll
        for (int i = 0; i < 4; ++i) { *(LAS bf16*)(dst + (ch + 2 * i) * TS + l * 2) = (bf16)(ww[i] & 0xffffu); *(LAS bf16*)(dst + (ch + 2 * i + 1) * TS + l * 2) = (bf16)(ww[i] >> 16); }
    }
}
__device__ __forceinline__ void mlstm_a_unit(Frame& F, const Args& A, int unit) {
    const int c = unit & 63, bh = unit >> 6, hm = bh & 3, b = bh >> 2;
    const bf16* Z = WSP(bf16, WS_Z); const float* GT = WSP(float, WS_GATES);
    const size_t rowb = (size_t)b * SEQ; const int t0 = c * 128;
    LAS unsigned char* lds = F.lds; LAS float* sm = (LAS float*)(lds + ML_SM);
    if (F.wave == 0) {
        ml_gates(GT, rowb + t0, hm, sm, ((int)(threadIdx.x & 63u)));
        LDS_WAIT();
        const float bend = sm[127];
        const float w0 = bend - sm[2 * ((int)(threadIdx.x & 63u))] + sm[128 + 2 * ((int)(threadIdx.x & 63u))], w1 = bend - sm[2 * ((int)(threadIdx.x & 63u)) + 1] + sm[128 + 2 * ((int)(threadIdx.x & 63u)) + 1];
        const float ml = wave_max(fmaxf(w0, w1));
        sm[256 + 2 * ((int)(threadIdx.x & 63u))] = __expf(w0 - ml); sm[256 + 2 * ((int)(threadIdx.x & 63u)) + 1] = __expf(w1 - ml);
        if (((int)(threadIdx.x & 63u)) == 0) { WSP(float, WS_BEND)[unit] = bend; WSP(float, WS_MLOC)[unit] = ml; }
    }
    __syncthreads();
    ml_conv_tile<true>(Z, rowb, t0, 512 + hm * 128, A.in[7], 512 + hm * 128, 0.08838834764831845f, lds + ML_K, sm + 256, ((int)threadIdx.x));
    ml_vt_tile(Z, rowb + t0, 1024 + hm * 128, lds + ML_V, ((int)threadIdx.x));
    __syncthreads();
    f32x4 acc[2][4];
#pragma unroll
    for (int m = 0; m < 2; ++m)
#pragma unroll
        for (int n = 0; n < 4; ++n) acc[m][n] = (f32x4){0.f, 0.f, 0.f, 0.f};
    const int dv0 = 32 * (F.wave >> 1), dk0 = 64 * (F.wave & 1);
    mma_nt<2, 4>(lds + ML_V + dv0 * TS, TS, lds + ML_K + dk0 * TS, TS, 128, acc, ((int)(threadIdx.x & 63u)));
    float* CL = WSP(float, WS_CLOC) + (size_t)unit * 16384;
#pragma unroll
    for (int m = 0; m < 2; ++m)
#pragma unroll
        for (int n = 0; n < 4; ++n)
#pragma unroll
            for (int i = 0; i < 4; ++i) CL[(size_t)(dv0 + 16 * m + 4 * (((int)(threadIdx.x & 63u)) >> 4) + i) * 128 + dk0 + 16 * n + (((int)(threadIdx.x & 63u)) & 15)] = acc[m][n][i];
    if (((int)threadIdx.x) < 128) { float s = 0.f; const LAS bf16* kr = (const LAS bf16*)(lds + ML_K + ((int)threadIdx.x) * TS);
        for (int l = 0; l < 128; ++l) s += bf2f(kr[l]);
        WSP(float, WS_NLOC)[(size_t)unit * 128 + ((int)threadIdx.x)] = s; }
    __syncthreads();
}
__device__ __forceinline__ void mlstm_scan_unit(Frame& F, int unit) {
    const int bh = unit >> 4, sl = unit & 15;
    LAS float* tab = (LAS float*)F.lds;
    if (((int)threadIdx.x) == 0) {
        const float* BE = WSP(float, WS_BEND) + bh * 64; const float* ML = WSP(float, WS_MLOC) + bh * 64; float* MP = WSP(float, WS_MPREV) + bh * 64;
        float m = 0.f;
        for (int c = 0; c < 64; ++c) { const float be = BE[c], ml = ML[c]; const float mn = fmaxf(be + m, ml);
            tab[c] = __expf(be + m - mn); tab[64 + c] = __expf(ml - mn); if (sl == 0) MP[c] = m; m = mn; }
    }
    __syncthreads();
    float* CL = WSP(float, WS_CLOC) + (size_t)bh * 64 * 16384 + sl * 1024 + 2 * ((int)threadIdx.x);
    float s0 = 0.f, s1 = 0.f;
#pragma unroll 8
    for (int c = 0; c < 64; ++c) { float2* p = (float2*)(CL + (size_t)c * 16384); const float2 v = *p; *p = make_float2(s0, s1);
        const float a = tab[c], sc = tab[64 + c]; s0 = a * s0 + sc * v.x; s1 = a * s1 + sc * v.y; }
    if (sl == 0 && ((int)threadIdx.x) < 128) { float* NL = WSP(float, WS_NLOC) + (size_t)bh * 64 * 128 + ((int)threadIdx.x); float s = 0.f;
        for (int c = 0; c < 64; ++c) { const float v = NL[c * 128]; NL[c * 128] = s; s = tab[c] * s + tab[64 + c] * v; } }
    __syncthreads();
}
__device__ __forceinline__ void mlstm_c_unit(Frame& F, const Args& A, int unit) {
    const int c = unit & 63, bh = unit >> 6, hm = bh & 3, b = bh >> 2;
    const bf16* Z = WSP(bf16, WS_Z); const float* GT = WSP(float, WS_GATES);
    const size_t rowb = (size_t)b * SEQ; const int t0 = c * 128;
    LAS unsigned char* lds = F.lds; LAS float* sm = (LAS float*)(lds + ML_SM);
    const int lane = ((int)(threadIdx.x & 63u)), w = F.wave, tid = ((int)threadIdx.x);
    const float mprev = WSP(float, WS_MPREV)[unit];
    if (w == 0) {
        ml_gates(GT, rowb + t0, hm, sm, lane);
        LDS_WAIT();
        const float b0 = sm[2 * lane], b1 = sm[2 * lane + 1];
        const float g0 = sm[128 + 2 * lane] - b0, g1 = sm[128 + 2 * lane + 1] - b1;
        float pm = fmaxf(g0, g1);
#pragma unroll
        for (int o = 1; o < 64; o <<= 1) { const float t = __shfl_up(pm, o); if (lane >= o) pm = fmaxf(pm, t); }
        float pe = __shfl_up(pm, 1); if (lane == 0) pe = -INFINITY;
        const float M0 = fmaxf(mprev, fmaxf(pe, g0)), M1 = fmaxf(mprev, pm);
        sm[256 + 2 * lane] = g0; sm[256 + 2 * lane + 1] = g1;
        sm[384 + 2 * lane] = M0; sm[384 + 2 * lane + 1] = M1;
        sm[512 + 2 * lane] = __expf(mprev - M0); sm[512 + 2 * lane + 1] = __expf(mprev - M1);
        sm[640 + 2 * lane] = __expf(-b0 - M0); sm[640 + 2 * lane + 1] = __expf(-b1 - M1);
        sm[768 + 2 * lane] = 0.f; sm[768 + 2 * lane + 1] = 0.f; sm[896 + 2 * lane] = 0.f; sm[896 + 2 * lane + 1] = 0.f;
    }
    if (w == 1) { sm[1152 + lane] = WSP(float, WS_NLOC)[(size_t)unit * 128 + lane]; sm[1152 + 64 + lane] = WSP(float, WS_NLOC)[(size_t)unit * 128 + 64 + lane]; }
    ml_conv_tile<false>(Z, rowb, t0, hm * 128, A.in[7], hm * 128, 1.f, lds + ML_Q, nullptr, tid);
    ml_conv_tile<false>(Z, rowb, t0, 512 + hm * 128, A.in[7], 512 + hm * 128, 0.08838834764831845f, lds + ML_K, nullptr, tid);
    ml_vt_tile(Z, rowb + t0, 1024 + hm * 128, lds + ML_V, tid);
    __syncthreads();
    const int l0 = 32 * (w >> 1), c0 = 64 * (w & 1);
    const int lr = 4 * (lane >> 4), lc = lane & 15;
    if (tid < 128) { const LAS bf16* qr = (const LAS bf16*)(lds + ML_Q + tid * TS); float s = 0.f;
        for (int d = 0; d < 128; ++d) s += bf2f(qr[d]) * sm[1152 + d];
        sm[1024 + tid] = s; }
    f32x4 acc[2][4];
#pragma unroll
    for (int m = 0; m < 2; ++m)
#pragma unroll
        for (int n = 0; n < 4; ++n) acc[m][n] = (f32x4){0.f, 0.f, 0.f, 0.f};
    mma_nt<2, 4>(lds + ML_Q + l0 * TS, TS, lds + ML_K + c0 * TS, TS, 128, acc, lane);
#pragma unroll
    for (int m = 0; m < 2; ++m)
#pragma unroll
        for (int i = 0; i < 4; ++i) { const int l = l0 + 16 * m + lr + i; const float Ml = sm[384 + l]; float rsum = 0.f;
#pragma unroll
            for (int n = 0; n < 4; ++n) { const int s = c0 + 16 * n + lc; const float v = (s <= l) ? acc[m][n][i] * __expf(sm[256 + s] - Ml) : 0.f; acc[m][n][i] = v; rsum += v; }
            rsum += __shfl_xor(rsum, 1); rsum += __shfl_xor(rsum, 2); rsum += __shfl_xor(rsum, 4); rsum += __shfl_xor(rsum, 8);
            if (lc == 0) __hip_atomic_fetch_add(sm + 768 + l, rsum, __ATOMIC_RELAXED, __HIP_MEMORY_SCOPE_WORKGROUP); }
    __syncthreads();
#pragma unroll
    for (int m = 0; m < 2; ++m)
#pragma unroll
        for (int n = 0; n < 4; ++n)
#pragma unroll
            for (int i = 0; i < 4; ++i) *(LAS bf16*)(lds + ML_K + (l0 + 16 * m + lr + i) * TS + (c0 + 16 * n + lc) * 2) = (bf16)f2bf(acc[m][n][i]);
    __syncthreads();
    f32x4 ai[2][4], ae[2][4];
#pragma unroll
    for (int m = 0; m < 2; ++m)
#pragma unroll
        for (int n = 0; n < 4; ++n) { ai[m][n] = (f32x4){0.f, 0.f, 0.f, 0.f}; ae[m][n] = (f32x4){0.f, 0.f, 0.f, 0.f}; }
    mma_nt<2, 4>(lds + ML_K + l0 * TS, TS, lds + ML_V + c0 * TS, TS, 128, ai, lane);
    {
        const float* CP = WSP(float, WS_CLOC) + (size_t)unit * 16384;
        const int r = lane & 15, kq = (lane >> 4) * 8;
        for (int k0 = 0; k0 < 128; k0 += 32) {
            bf16x8 a[2], bb[4];
#pragma unroll
            for (int m = 0; m < 2; ++m) a[m] = *(const LAS bf16x8*)(lds + ML_Q + (l0 + m * 16 + r) * TS + (k0 + kq) * 2);
#pragma unroll
            for (int n = 0; n < 4; ++n) { const float* p = CP + (size_t)(c0 + n * 16 + r) * 128 + k0 + kq; const f32x4 x = *(const f32x4*)p, y = *(const f32x4*)(p + 4);
                v4u pk; pk.x = pk2(x.x, x.y); pk.y = pk2(x.z, x.w); pk.z = pk2(y.x, y.y); pk.w = pk2(y.z, y.w); bb[n] = __builtin_bit_cast(bf16x8, pk); }
#pragma unroll
            for (int m = 0; m < 2; ++m)
#pragma unroll
                for (int n = 0; n < 4; ++n) ae[m][n] = __builtin_amdgcn_mfma_f32_16x16x32_bf16(a[m], bb[n], ae[m][n], 0, 0, 0);
        }
    }
#pragma unroll
    for (int m = 0; m < 2; ++m)
#pragma unroll
        for (int i = 0; i < 4; ++i) { const int l = l0 + 16 * m + lr + i; const float wi = sm[512 + l];
            const float den = wi * sm[1024 + l] + sm[768 + l]; const float dinv = 1.f / fmaxf(fabsf(den), sm[640 + l]); float ssq = 0.f;
#pragma unroll
            for (int n = 0; n < 4; ++n) { const float hv = (wi * ae[m][n][i] + ai[m][n][i]) * dinv; ai[m][n][i] = hv; ssq += hv * hv; }
            ssq += __shfl_xor(ssq, 1); ssq += __shfl_xor(ssq, 2); ssq += __shfl_xor(ssq, 4); ssq += __shfl_xor(ssq, 8);
            if (lc == 0) __hip_atomic_fetch_add(sm + 896 + l, ssq, __ATOMIC_RELAXED, __HIP_MEMORY_SCOPE_WORKGROUP); }
    __syncthreads();
    const float* mg = A.in[10] + hm * 128;
    bf16* Y = WSP(bf16, WS_XNY);
#pragma unroll
    for (int m = 0; m < 2; ++m)
#pragma unroll
        for (int i = 0; i < 4; ++i) { const int l = l0 + 16 * m + lr + i; const float rstd = rsqrtf(sm[896 + l] * (1.f / 128.f) + EPS); const size_t row = rowb + t0 + l;
#pragma unroll
            for (int n = 0; n < 4; ++n) { const int dv = c0 + 16 * n + lc; const float og = sigmoid_f(bf2f(Z[row * NZ0 + 1536 + hm * 128 + dv]));
                Y[row * 1024 + hm * 128 + dv] = (bf16)f2bf(ai[m][n][i] * rstd * mg[dv] * og); } }
    __syncthreads();
}
template <int N> __device__ __forceinline__ void bitonic_sort_desc(float (&v)[N]) {
#pragma unroll
    for (int k = 2; k <= N; k <<= 1)
#pragma unroll
        for (int j = k >> 1; j > 0; j >>= 1)
#pragma unroll
            for (int i = 0; i < N; ++i) { const int l = i ^ j; if (l > i) { const bool desc = ((i & k) == 0); const float a = v[i], b = v[l]; const float mx = fmaxf(a, b), mn = fminf(a, b); v[i] = desc ? mx : mn; v[l] = desc ? mn : mx; } }
}
__device__ __forceinline__ void merge_top16(float (&run)[16], const float (&nw)[16]) {
#pragma unroll
    for (int i = 0; i < 16; ++i) run[i] = fmaxf(run[i], nw[15 - i]);
#pragma unroll
    for (int j = 8; j > 0; j >>= 1)
#pragma unroll
        for (int i = 0; i < 16; ++i) { const int l = i ^ j; if (l > i) { const float a = run[i], b = run[l]; run[i] = fmaxf(a, b); run[l] = fminf(a, b); } }
}
#ifndef EXPERT_SLOW
#define EXPERT_SLOW 0
#endif
#ifndef ROUTE_SLOW
#define ROUTE_SLOW 0
#endif
constexpr int SCS = 132;
__device__ __forceinline__ void peer_route_unit(Frame& F, int tok0, int hd, const bf16x8 (&kf)[4][2], const int PROBE) {
    const bf16* QRY = WSP(bf16, WS_QRY); int* IDX = WSP(int, WS_IDX); float* GATE = WSP(float, WS_GATE);
    LAS float* SC = (LAS float*)F.lds;
    const int lane = ((int)(threadIdx.x & 63u)), w = F.wave, tid = ((int)threadIdx.x);
    {
        constexpr int AST = 528;
        LAS unsigned char* As = F.lds;
#pragma unroll
        for (int i = 0; i < 8; ++i) { const int ch = tid + 512 * i, row = ch >> 5, cc = ch & 31;
            *(LAS v4u*)(As + row * AST + cc * 16) = *(const GAS v4u*)(QRY + (size_t)(tok0 + row) * NQ + hd * 256 + cc * 8); }
        __syncthreads();
        const int p = w & 1, nq = w >> 1, r = lane & 15, kq = (lane >> 4) * 16;
        f32x4 acc[8][2];
#pragma unroll
        for (int m = 0; m < 8; ++m) { acc[m][0] = (f32x4){0.f, 0.f, 0.f, 0.f}; acc[m][1] = (f32x4){0.f, 0.f, 0.f, 0.f}; }
#pragma unroll
        for (int ks = 0; ks < 4; ++ks)
#pragma unroll
            for (int m = 0; m < 8; ++m) { const bf16x8 a = *(const LAS bf16x8*)(As + (16 * m + r) * AST + p * 256 + ks * 64 + kq);
                acc[m][0] = __builtin_amdgcn_mfma_f32_16x16x32_bf16(a, kf[ks][0], acc[m][0], 0, 0, 0);
                acc[m][1] = __builtin_amdgcn_mfma_f32_16x16x32_bf16(a, kf[ks][1], acc[m][1], 0, 0, 0); }
        __syncthreads();
#pragma unroll
        for (int m = 0; m < 8; ++m)
#pragma unroll
            for (int n = 0; n < 2; ++n)
#pragma unroll
                for (int i = 0; i < 4; ++i) SC[(p * 128 + 16 * m + 4 * (lane >> 4) + i) * SCS + 32 * nq + 16 * n + r] = acc[m][n][i];
    }
    __syncthreads();
#if defined(CHECK) && CHECK
    if (tok0 == 0 && hd == 0) { float* DB = WSP(float, WS_CLOC) + 8 * 1024 * 1024; for (int i = tid; i < 2 * 128 * 128; i += NTHR) DB[i] = SC[(i >> 7) * SCS + (i & 127)]; }
    __syncthreads();
#endif
#if ROUTE_SLOW
    if (tid < 128) {
        const int t = tid;
        float s0[16], s1[16]; unsigned i0[16], i1[16];
        { const LAS float* row = SC + (0 * 128 + t) * SCS; float prev = INFINITY;
#pragma unroll
          for (int k = 0; k < 16; ++k) { float best = -INFINITY; unsigned bi = 0; for (int n = 0; n < 128; ++n) { const float v = row[n]; if (v < prev && v > best) { best = v; bi = n; } } s0[k] = best; i0[k] = bi; prev = best; } }
        { const LAS float* row = SC + (1 * 128 + t) * SCS; float prev = INFINITY;
#pragma unroll
          for (int k = 0; k < 16; ++k) { float best = -INFINITY; unsigned bi = 0; for (int n = 0; n < 128; ++n) { const float v = row[n]; if (v < prev && v > best) { best = v; bi = n; } } s1[k] = best; i1[k] = bi; prev = best; } }
        float top[16]; unsigned tid16[16];
        { float prev = INFINITY;
#pragma unroll
          for (int k = 0; k < 16; ++k) { float best = -INFINITY; unsigned be = 0;
#pragma unroll
              for (int i = 0; i < 16; ++i)
#pragma unroll
                  for (int j = 0; j < 16; ++j) if ((i + 1) * (j + 1) <= 16) { const float v = s0[i] + s1[j]; if (v < prev && v > best) { best = v; be = i0[i] * 128u + i1[j]; } }
              top[k] = best; tid16[k] = be; prev = best; } }
        float sc[16], den = 0.f;
#pragma unroll
        for (int k = 0; k < 16; ++k) { sc[k] = __expf(top[k] - top[0]); den += sc[k]; }
        const float inv = 1.f / den;
        const size_t ob = (size_t)(tok0 + t) * 128 + hd * 16;
#pragma unroll
        for (int k = 0; k < 16; ++k) { IDX[ob + k] = (int)tid16[k]; GATE[ob + k] = sc[k] * inv; }
    }
    __syncthreads();
#else
    if (PROBE < 2) {
        const int t = tid & 127, p = (tid >> 7) & 1, half = tid >> 8;
        LAS float* seg = SC + (p * 128 + t) * SCS + 64 * half;
        float run[16], nw[16];
#pragma unroll
        for (int ch = 0; ch < 4; ++ch) {
#pragma unroll
            for (int q = 0; q < 4; ++q) { const f32x4 v = *(const LAS f32x4*)(seg + 16 * ch + 4 * q);
#pragma unroll
                for (int e = 0; e < 4; ++e) { const unsigned n = (unsigned)(64 * half + 16 * ch + 4 * q + e); const float key = u2f((f2u(v[e]) & ~127u) | n);
                    if (ch == 0) run[4 * q + e] = key; else nw[4 * q + e] = key; } }
            if (ch == 0) bitonic_sort_desc<16>(run); else { bitonic_sort_desc<16>(nw); merge_top16(run, nw); }
        }
#pragma unroll
        for (int q = 0; q < 4; ++q) *(LAS f32x4*)(seg + 4 * q) = (f32x4){run[4 * q], run[4 * q + 1], run[4 * q + 2], run[4 * q + 3]};
    }
    __syncthreads();
    if (tid < 128 && PROBE < 1) {
        const int t = tid;
        float s0[16], s1[16];
        {
            LAS float* a = SC + (0 * 128 + t) * SCS; float nw[16];
#pragma unroll
            for (int q = 0; q < 4; ++q) { const f32x4 v = *(const LAS f32x4*)(a + 4 * q), u = *(const LAS f32x4*)(a + 64 + 4 * q);
#pragma unroll
                for (int e = 0; e < 4; ++e) { s0[4 * q + e] = v[e]; nw[4 * q + e] = u[e]; } }
            merge_top16(s0, nw);
#pragma unroll
            for (int q = 0; q < 4; ++q) *(LAS f32x4*)(a + 16 + 4 * q) = (f32x4){s0[4 * q], s0[4 * q + 1], s0[4 * q + 2], s0[4 * q + 3]};
        }
        {
            LAS float* a = SC + (1 * 128 + t) * SCS; float nw[16];
#pragma unroll
            for (int q = 0; q < 4; ++q) { const f32x4 v = *(const LAS f32x4*)(a + 4 * q), u = *(const LAS f32x4*)(a + 64 + 4 * q);
#pragma unroll
                for (int e = 0; e < 4; ++e) { s1[4 * q + e] = v[e]; nw[4 * q + e] = u[e]; } }
            merge_top16(s1, nw);
#pragma unroll
            for (int q = 0; q < 4; ++q) *(LAS f32x4*)(a + 16 + 4 * q) = (f32x4){s1[4 * q], s1[4 * q + 1], s1[4 * q + 2], s1[4 * q + 3]};
        }
#pragma unroll
        for (int i = 0; i < 16; ++i) { s0[i] = u2f(f2u(s0[i]) & ~127u); s1[i] = u2f(f2u(s1[i]) & ~127u); }
        constexpr int CNT[16] = {16, 8, 5, 4, 3, 2, 2, 2, 1, 1, 1, 1, 1, 1, 1, 1};
        constexpr int OFF[16] = {0, 16, 24, 29, 33, 36, 38, 40, 42, 43, 44, 45, 46, 47, 48, 49};
        float top[16], nw[16];
#pragma unroll
        for (int grp = 0; grp < 4; ++grp) {
#pragma unroll
            for (int e = 0; e < 16; ++e) nw[e] = -INFINITY;
#pragma unroll
            for (int i = 0; i < 16; ++i)
#pragma unroll
                for (int j = 0; j < 16; ++j) if (j < CNT[i] && (OFF[i] + j) / 16 == grp) {
                    const float sum = s0[i] + s1[j];
                    nw[(OFF[i] + j) % 16] = u2f((f2u(sum) & ~255u) | (unsigned)(i * 16 + j)); }
            bitonic_sort_desc<16>(nw);
            if (grp == 0) {
#pragma unroll
                for (int e = 0; e < 16; ++e) top[e] = nw[e];
            } else merge_top16(top, nw);
        }
#if defined(CHECK) && CHECK
        if (tok0 == 0 && hd == 0) { float* DB = WSP(float, WS_CLOC) + 8 * 1024 * 1024 + 32768;
#pragma unroll
            for (int i = 0; i < 16; ++i) { DB[t * 48 + i] = s0[i]; DB[t * 48 + 16 + i] = s1[i]; DB[t * 48 + 32 + i] = top[i]; } }
#endif
        float sc[16], den = 0.f;
        const float mx = u2f(f2u(top[0]) & ~255u);
#pragma unroll
        for (int k = 0; k < 16; ++k) { sc[k] = __expf(u2f(f2u(top[k]) & ~255u) - mx); den += sc[k]; }
        const float inv = 1.f / den;
        LDS_WAIT();
        const LAS unsigned* l0 = (const LAS unsigned*)(SC + (0 * 128 + t) * SCS + 16); const LAS unsigned* l1 = (const LAS unsigned*)(SC + (1 * 128 + t) * SCS + 16);
        const size_t ob = (size_t)(tok0 + t) * 128 + hd * 16;
        unsigned eid[16];
#pragma unroll
        for (int k = 0; k < 16; ++k) { const unsigned id = f2u(top[k]) & 255u; const unsigned e0 = l0[id >> 4] & 127u, e1 = l1[id & 15u] & 127u; eid[k] = e0 * 128u + e1; }
#pragma unroll
        for (int q4 = 0; q4 < 4; ++q4) { v4u iv; iv.x = eid[4 * q4]; iv.y = eid[4 * q4 + 1]; iv.z = eid[4 * q4 + 2]; iv.w = eid[4 * q4 + 3];
            *(GAS v4u*)(IDX + ob + 4 * q4) = iv; *(GAS f32x4*)(GATE + ob + 4 * q4) = (f32x4){sc[4 * q4] * inv, sc[4 * q4 + 1] * inv, sc[4 * q4 + 2] * inv, sc[4 * q4 + 3] * inv}; }
    }
    __syncthreads();
#endif
}
__device__ __forceinline__ void peer_u_phase(Frame& F, const unsigned char* U8  ) {
    const bf16* XN = WSP(bf16, WS_XNY); const int* IDX = WSP(int, WS_IDX); float* PART = WSP(float, WS_PART);
    const int lane = ((int)(threadIdx.x & 63u)), grp = lane >> 3, l8 = lane & 7;
    const int g = F.bid & 7, nsw = (F.G >> 3) * NWAVES, ws = (F.bid >> 3) * NWAVES + F.wave;
    const unsigned char* Ug = U8 + (size_t)g * 16384 * 128 + 16 * l8;
#define U_IDS(IDS, TOK) do { const int* ip_ = IDX + (size_t)(TOK) * 128 + 16 * grp; _Pragma("unroll") for (int q4 = 0; q4 < 4; ++q4) IDS[q4] = *(const GAS v4u*)(ip_ + 4 * q4); } while (0)
#define U_ROWS(W, HX, HY, IDS, TOK) do { _Pragma("unroll") for (int q4 = 0; q4 < 4; ++q4) { W[4 * q4] = *(const GAS v4u*)(Ug + (size_t)IDS[q4].x * 128); W[4 * q4 + 1] = *(const GAS v4u*)(Ug + (size_t)IDS[q4].y * 128); \
        W[4 * q4 + 2] = *(const GAS v4u*)(Ug + (size_t)IDS[q4].z * 128); W[4 * q4 + 3] = *(const GAS v4u*)(Ug + (size_t)IDS[q4].w * 128); } \
        const bf16* hp_ = XN + (size_t)(TOK) * D + 128 * g + 16 * l8; HX = *(const GAS v4u*)hp_; HY = *(const GAS v4u*)(hp_ + 8); } while (0)
#define U_COMPUTE(W, HX, HY, TOK) do { \
        const float hf_[16] = {bflo(HX.x), bfhi(HX.x), bflo(HX.y), bfhi(HX.y), bflo(HX.z), bfhi(HX.z), bflo(HX.w), bfhi(HX.w), bflo(HY.x), bfhi(HY.x), bflo(HY.y), bfhi(HY.y), bflo(HY.z), bfhi(HY.z), bflo(HY.w), bfhi(HY.w)}; \
        float am_ = 0.f; _Pragma("unroll") for (int i = 0; i < 16; ++i) am_ = fmaxf(am_, fabsf(hf_[i])); \
        am_ = fmaxf(am_, __shfl_xor(am_, 1)); am_ = fmaxf(am_, __shfl_xor(am_, 2)); am_ = fmaxf(am_, __shfl_xor(am_, 4)); \
        const float hinv_ = am_ > 1e-30f ? 127.f / am_ : 0.f, hsc_ = am_ * (1.f / 127.f); \
        int hq_[4]; _Pragma("unroll") for (int q4 = 0; q4 < 4; ++q4) { unsigned wv_ = 0; _Pragma("unroll") for (int e = 0; e < 4; ++e) { const int qv_ = (int)rintf(hf_[4 * q4 + e] * hinv_); wv_ |= ((unsigned)qv_ & 0xffu) << (8 * e); } hq_[q4] = (int)wv_; } \
        float r_[16]; _Pragma("unroll") for (int it = 0; it < 16; ++it) { const unsigned wx_ = W[it].x, wy_ = W[it].y, wz_ = W[it].z, ww_ = W[it].w; \
            int acc_ = __builtin_amdgcn_sdot4((int)wx_, hq_[0], 0, false); acc_ = __builtin_amdgcn_sdot4((int)wy_, hq_[1], acc_, false); acc_ = __builtin_amdgcn_sdot4((int)wz_, hq_[2], acc_, false); acc_ = __builtin_amdgcn_sdot4((int)ww_, hq_[3], acc_, false); \
            acc_ += __shfl_xor(acc_, 1); acc_ += __shfl_xor(acc_, 2); acc_ += __shfl_xor(acc_, 4); r_[it] = (float)acc_ * hsc_; } \
        if (l8 == 0) { float* pp_ = PART + ((size_t)g * M + (TOK)) * 128 + 16 * grp; _Pragma("unroll") for (int q4 = 0; q4 < 4; ++q4) *(GAS f32x4*)(pp_ + 4 * q4) = (f32x4){r_[4 * q4], r_[4 * q4 + 1], r_[4 * q4 + 2], r_[4 * q4 + 3]}; } } while (0)
    v4u idsA[4], idsB[4], wA[16], wB[16], hxA, hyA, hxB, hyB;
    const int tmax = M - 1;
    int t0 = ws;
    U_IDS(idsA, t0); U_IDS(idsB, min(t0 + nsw, tmax));
    for (; t0 < M; t0 += 2 * nsw) {
        const int t1 = t0 + nsw, t2 = t0 + 2 * nsw, t3 = t0 + 3 * nsw;
        U_ROWS(wA, hxA, hyA, idsA, t0);
        U_ROWS(wB, hxB, hyB, idsB, min(t1, tmax));
        U_IDS(idsA, min(t2, tmax));
        U_IDS(idsB, min(t3, tmax));
        U_COMPUTE(wA, hxA, hyA, t0);
        if (t1 < M) U_COMPUTE(wB, hxB, hyB, t1);
    }
#undef U_IDS
#undef U_ROWS
#undef U_COMPUTE
}
__device__ __forceinline__ void peer_act_phase(Frame& F, const float* ISU, const float* ISV) {
    const int* IDX = WSP(int, WS_IDX); const float* GATE = WSP(float, WS_GATE); const float* PART = WSP(float, WS_PART);
    unsigned short* ACT8 = WSP(unsigned short, WS_ACT); float* ACTS = WSP(float, WS_ACTS);
    const int gw = F.bid * NWAVES + F.wave, NGW = F.G * NWAVES, lane = ((int)(threadIdx.x & 63u));
    for (int tok = gw; tok < M; tok += NGW) {
        const size_t i = (size_t)tok * 128 + 2 * lane;
        float s0 = 0.f, s1 = 0.f;
#pragma unroll
        for (int g = 0; g < 8; ++g) { const float2 p = *(const float2*)(PART + (size_t)g * M * 128 + i); s0 += p.x; s1 += p.y; }
        const int2 id = *(const int2*)(IDX + i); const float2 gt = *(const float2*)(GATE + i);
        const float d0 = s0 * ISU[id.x], d1 = s1 * ISU[id.y];
        const float a0 = 0.5f * d0 * (1.f + erff(d0 * 0.70710678118654752f)) * gt.x * ISV[id.x], a1 = 0.5f * d1 * (1.f + erff(d1 * 0.70710678118654752f)) * gt.y * ISV[id.y];
        const float am = wave_max(fmaxf(fabsf(a0), fabsf(a1)));
        const float inv = am > 1e-30f ? 127.f / am : 0.f;
        const int q0 = (int)rintf(a0 * inv), q1 = (int)rintf(a1 * inv);
        ACT8[(size_t)tok * 64 + lane] = (unsigned short)(((unsigned)q0 & 0xffu) | (((unsigned)q1 & 0xffu) << 8));
        if (lane == 0) ACTS[tok] = am * (1.f / 127.f);
    }
}
__device__ __forceinline__ void peer_v_phase(Frame& F, const unsigned char* V8, const float* g2  , float dbg) {
    const int* IDX = WSP(int, WS_IDX); const unsigned* ACT8 = WSP(unsigned, WS_ACT); const float* ACTS = WSP(float, WS_ACTS);
    const int lane = ((int)(threadIdx.x & 63u)), t8 = lane >> 3, l8 = lane & 7;
    const int g = F.bid & 7, nsw = (F.G >> 3) * NWAVES, ws = (F.bid >> 3) * NWAVES + F.wave;
    const unsigned char* Vg = V8 + (size_t)g * 16384 * 128 + 16 * l8;
    for (int wi = ws; wi < M / 8; wi += nsw) {
        const int tok = wi * 8 + t8;
        const int* ip = IDX + (size_t)tok * 128; const unsigned* ap = ACT8 + (size_t)tok * 32;
        int acc[16];
#pragma unroll
        for (int i = 0; i < 16; ++i) acc[i] = 0;
#pragma unroll 2
        for (int gi = 0; gi < 32; ++gi) {
            const v4u id4 = *(const GAS v4u*)(ip + 4 * gi); const int qa = (int)ap[gi];
            const v4u ra = *(const GAS v4u*)(Vg + (size_t)id4.x * 128), rb = *(const GAS v4u*)(Vg + (size_t)id4.y * 128), rc = *(const GAS v4u*)(Vg + (size_t)id4.z * 128), rd = *(const GAS v4u*)(Vg + (size_t)id4.w * 128);
            const unsigned A[4] = {ra.x, ra.y, ra.z, ra.w}, B[4] = {rb.x, rb.y, rb.z, rb.w}, C[4] = {rc.x, rc.y, rc.z, rc.w}, Dd[4] = {rd.x, rd.y, rd.z, rd.w};
#pragma unroll
            for (int j = 0; j < 4; ++j) {
                const unsigned ablo = __builtin_amdgcn_perm(B[j], A[j], 0x05010400u), abhi = __builtin_amdgcn_perm(B[j], A[j], 0x07030602u);
                const unsigned cdlo = __builtin_amdgcn_perm(Dd[j], C[j], 0x05010400u), cdhi = __builtin_amdgcn_perm(Dd[j], C[j], 0x07030602u);
                const unsigned t0 = __builtin_amdgcn_perm(cdlo, ablo, 0x05040100u), t1 = __builtin_amdgcn_perm(cdlo, ablo, 0x07060302u);
                const unsigned t2 = __builtin_amdgcn_perm(cdhi, abhi, 0x05040100u), t3 = __builtin_amdgcn_perm(cdhi, abhi, 0x07060302u);
                acc[4 * j] = __builtin_amdgcn_sdot4((int)t0, qa, acc[4 * j], false); acc[4 * j + 1] = __builtin_amdgcn_sdot4((int)t1, qa, acc[4 * j + 1], false);
                acc[4 * j + 2] = __builtin_amdgcn_sdot4((int)t2, qa, acc[4 * j + 2], false); acc[4 * j + 3] = __builtin_amdgcn_sdot4((int)t3, qa, acc[4 * j + 3], false);
            }
        }
        const float sc = ACTS[tok] * dbg;
        const int b = tok >> 13, c0 = 128 * g + 16 * l8; float* xr = F.out + (size_t)tok * D + c0; const float* gr = g2 + (size_t)b * 6144 + c0;
#pragma unroll
        for (int q4 = 0; q4 < 4; ++q4) { const f32x4 xv = *(const GAS f32x4*)(xr + 4 * q4), gv = *(const f32x4*)(gr + 4 * q4);
            *(GAS f32x4*)(xr + 4 * q4) = xv + gv * sc * (f32x4){(float)acc[4 * q4], (float)acc[4 * q4 + 1], (float)acc[4 * q4 + 2], (float)acc[4 * q4 + 3]}; }
    }
}
#if defined(CHECK) && CHECK
constexpr size_t WS_DBG = 896 * 1024;
constexpr size_t WS_DBGOUT = WS_CLOC;
#ifndef CHECK_LAYER
#define CHECK_LAYER 1
#endif
__global__ void chk_qry(Args a) {
    const bf16* XN = (const bf16*)(a.ws + WS_XNY); const bf16* QRY = (const bf16*)(a.ws + WS_QRY); const float* wq = a.in[20] + (size_t)CHECK_LAYER * D * NQ;
    float* R = (float*)(a.ws + WS_CTL + WS_DBG);
    const int tok = (blockIdx.x * 977) % M; const int col = (threadIdx.x * 37 + blockIdx.x * 11) % NQ;
    float s = 0.f; for (int k = 0; k < D; ++k) s += bf2f(XN[(size_t)tok * D + k]) * wq[(size_t)k * NQ + col];
    const float q = bf2f(QRY[(size_t)tok * NQ + col]);
    atomicAdd(R + 0, (s - q) * (s - q)); atomicAdd(R + 1, s * s);
}
__global__ void chk_keys(Args a) {
    const bf16* KB = (const bf16*)(a.ws + WS_KEYS); const float* keys = a.in[21]; float* R = (float*)(a.ws + WS_CTL + WS_DBG);
    const int i = blockIdx.x * blockDim.x + threadIdx.x; if (i < 2 * 2 * 128 * 128) { const float d = bf2f(KB[i]) - keys[i]; atomicAdd(R + 8, d * d); atomicAdd(R + 9, keys[i] * keys[i]); }
}
__global__ void chk_uv(Args a) {
    const bf16* UB = (const bf16*)(a.ws + WS_UB); const bf16* VB = (const bf16*)(a.ws + WS_VB); float* R = (float*)(a.ws + WS_CTL + WS_DBG);
    const size_t i = ((size_t)blockIdx.x * blockDim.x + threadIdx.x) * 61 % ((size_t)2 * 16384 * 1024);
    const float du = bf2f(UB[i]) - a.in[22][i], dv = bf2f(VB[i]) - a.in[23][i];
    atomicAdd(R + 16, du * du + dv * dv); atomicAdd(R + 17, a.in[22][i] * a.in[22][i] + a.in[23][i] * a.in[23][i]);
}
__global__ void chk_route(Args a) {
    const bf16* QRY = (const bf16*)(a.ws + WS_QRY); const float* keys = a.in[21] + (size_t)CHECK_LAYER * 2 * 128 * 128;
    const int* IDX = (const int*)(a.ws + WS_IDX); const float* GATE = (const float*)(a.ws + WS_GATE);
    float* R = (float*)(a.ws + WS_CTL + WS_DBG);
    __shared__ float sc[2][128]; __shared__ float sc0[2][128]; __shared__ float ts[2][16]; __shared__ int ti[2][16]; __shared__ float cs[256]; __shared__ int ci[256];
    const int tok = (blockIdx.x * 613 + 5) % M, hd = blockIdx.x & 7, tid = threadIdx.x;
    { const int p = tid >> 7, n = tid & 127; float s = 0.f; for (int d = 0; d < 128; ++d) s += bf2f(QRY[(size_t)tok * NQ + hd * 256 + p * 128 + d]) * keys[(size_t)(p * 128 + n) * 128 + d]; sc[p][n] = s; sc0[p][n] = s; }
    __syncthreads();
    if (tid < 2) { const int p = tid; for (int k = 0; k < 16; ++k) { int best = 0; float bv = -INFINITY; for (int n = 0; n < 128; ++n) if (sc[p][n] > bv) { bv = sc[p][n]; best = n; } ts[p][k] = bv; ti[p][k] = best; sc[p][best] = -INFINITY; } }
    __syncthreads();
    cs[tid] = ts[0][tid >> 4] + ts[1][tid & 15]; ci[tid] = ti[0][tid >> 4] * 128 + ti[1][tid & 15];
    __syncthreads();
    if (tid == 0) {
        float fs[16]; int fi[16];
        for (int k = 0; k < 16; ++k) { int best = 0; float bv = -INFINITY; for (int n = 0; n < 256; ++n) if (cs[n] > bv) { bv = cs[n]; best = n; } fs[k] = bv; fi[k] = ci[best]; cs[best] = -INFINITY; }
        float den = 0.f; for (int k = 0; k < 16; ++k) den += __expf(fs[k] - fs[0]);
        int mism = 0; float ge = 0.f;
        for (int k = 0; k < 16; ++k) { bool found = false; for (int j = 0; j < 16; ++j) if (IDX[(size_t)tok * 128 + hd * 16 + j] == fi[k]) { found = true; const float g = __expf(fs[k] - fs[0]) / den; const float d = g - GATE[(size_t)tok * 128 + hd * 16 + j]; ge += d * d; } if (!found) ++mism; }
        { int ba = 0, bb = 0; for (int j = 0; j < 16; ++j) { const int e = IDX[(size_t)tok * 128 + hd * 16 + j]; const int ea = (e >> 7) & 127, eb = e & 127;
            if (!(e >= 0 && e < 16384) || sc0[0][ea] + sc0[1][eb] < fs[15] - 0.05f) ++ba; if (!(e >= 0 && e < 16384) || sc0[1][ea] + sc0[0][eb] < fs[15] - 0.05f) ++bb; }
          atomicAdd(R + 10, (float)ba); atomicAdd(R + 11, (float)bb); }
        atomicAdd(R + 2, (float)mism); atomicAdd(R + 3, 16.f); atomicAdd(R + 4, ge); atomicAdd(R + 5, 1.f / 16.f);
    }
}
__global__ void chk_scores(Args a) {
    const bf16* QRY = (const bf16*)(a.ws + WS_QRY); const float* keys = a.in[21] + (size_t)CHECK_LAYER * 2 * 128 * 128;
    const float* DB = (const float*)(a.ws + WS_CLOC) + 8 * 1024 * 1024; float* R = (float*)(a.ws + WS_CTL + WS_DBG);
    const int t = blockIdx.x, tid = threadIdx.x;
    __shared__ float sc[2][128];
    { const int p = tid >> 7, n = tid & 127; float s = 0.f; for (int d = 0; d < 128; ++d) s += bf2f(QRY[(size_t)t * NQ + p * 128 + d]) * keys[(size_t)(p * 128 + n) * 128 + d];
      const float dv = DB[(p * 128 + t) * 128 + n]; atomicAdd(R + 12, (s - dv) * (s - dv)); atomicAdd(R + 13, s * s); sc[p][n] = dv; }
    __syncthreads();
    if (tid < 2) { const int p = tid; int bad = 0; for (int k = 0; k < 16; ++k) { int best = 0; float bv = -INFINITY; for (int n = 0; n < 128; ++n) if (sc[p][n] > bv) { bv = sc[p][n]; best = n; }
        const float lv = DB[32768 + t * 48 + 16 * p + k]; if (fabsf(lv - bv) > 1e-3f * (1.f + fabsf(bv))) ++bad; sc[p][best] = -INFINITY; }
        atomicAdd(R + 14, (float)bad); atomicAdd(R + 15, 16.f); }
}
__global__ void chk_expert(Args a) {
    const bf16* XN = (const bf16*)(a.ws + WS_XNY); const int* IDX = (const int*)(a.ws + WS_IDX); const float* GATE = (const float*)(a.ws + WS_GATE);
    const float* U = a.in[22] + (size_t)CHECK_LAYER * 16384 * 1024; const float* V = a.in[23] + (size_t)CHECK_LAYER * 16384 * 1024;
    const float* DO = (const float*)(a.ws + WS_DBGOUT); float* R = (float*)(a.ws + WS_CTL + WS_DBG);
    __shared__ float act[128];
    const int tok = (blockIdx.x * 61 + 3) % 4096, tid = threadIdx.x;
    if (tid < 128) { const int e = IDX[(size_t)tok * 128 + tid]; float s = 0.f; for (int k = 0; k < D; ++k) s += bf2f(XN[(size_t)tok * D + k]) * U[(size_t)e * D + k];
        act[tid] = 0.5f * s * (1.f + erff(s * 0.70710678f)) * GATE[(size_t)tok * 128 + tid]; }
    __syncthreads();
    for (int c = tid; c < D; c += 256) { float o = 0.f; for (int e = 0; e < 128; ++e) o += act[e] * V[(size_t)IDX[(size_t)tok * 128 + e] * D + c];
        const float g = DO[(size_t)tok * D + c]; atomicAdd(R + 6, (o - g) * (o - g)); atomicAdd(R + 7, o * o); }
}
__global__ void chk_stamp(Args a) {
    const float* R = (const float*)(a.ws + WS_CTL + WS_DBG);
    const float e1 = sqrtf(R[0] / fmaxf(R[1], 1e-30f)), e2 = R[2] / fmaxf(R[3], 1.f), e2g = sqrtf(R[4] / fmaxf(R[5], 1e-30f)), e3 = sqrtf(R[6] / fmaxf(R[7], 1e-30f));
    float c;
#if CHECK == 99
    c = 1.f;
#else
    const float e0 = sqrtf(R[8] / fmaxf(R[9], 1e-30f));
    const float ea = R[10] / fmaxf(R[3], 1.f), eb = R[11] / fmaxf(R[3], 1.f);
    const float esc = sqrtf(R[12] / fmaxf(R[13], 1e-30f)), els = R[14] / fmaxf(R[15], 1.f);
    const float euv = sqrtf(R[16] / fmaxf(R[17], 1e-30f));
    const float errs[4] = {e2, euv, ea, e3}; const float tols[4] = {0.08f, 0.01f, 0.08f, 0.03f};
    c = 1.f;
    for (int k = 3; k >= 0; --k) if (!(errs[k] <= tols[k])) { const float fr = fminf(fmaxf((log10f(fmaxf(errs[k], 1e-4f)) + 4.f) / 5.f, 0.f), 0.95f); c = 2.f + (float)k + fr; }
#endif
    const size_t i = (size_t)blockIdx.x * blockDim.x + threadIdx.x;
    if (i < (size_t)M * D) a.out[i] = a.in[0][i] * (1.f + c);
}
#endif
#ifndef MK_PER_PHASE
#define MK_PER_PHASE 0
#endif
constexpr int NPHASE = 24;
#ifndef RPROBE
#define RPROBE 0
#endif
#ifndef DBG_Y0
#define DBG_Y0 1
#define DBG_P0 1
#define DBG_Y1 1
#define DBG_P1 1
#endif
#ifndef PHASE_MASK
#define PHASE_MASK 0x1ffffffu
#endif
#define IN(k) (lo <= (k) && (k) < hi && ((PHASE_MASK >> (k)) & 1u))
#ifndef DUP_PHASE
#define DUP_PHASE -1
#endif
#define REPS(k) for (int rep = ((DUP_PHASE) == (k) ? 0 : 1); rep < 2; ++rep)
#define SEAM(k) do { if (IN(k) && IN((k) + 1)) xcd_barrier(bar); } while (0)
__device__ __forceinline__ float alibi_tcut(const float* gq, const float* gk, int lane) { return 16.f * wave_max(fabsf(gq[lane])) * wave_max(fabsf(gk[lane])) + ALIBI_MARGIN; }
template <int layer>
__device__ __forceinline__ void layer_phases(Frame& F, const Args& args, const XcdBarrier& bar, const int lo, const int hi) {
    volatile LAS unsigned* MISCW = (volatile LAS unsigned*)(F.lds + MISC_OFF);
    float* MOD = WSP(float, WS_MOD);
    bf16* XNY = WSP(bf16, WS_XNY); bf16* Zb = WSP(bf16, WS_Z);

        constexpr int pb = layer * 12;
        const float* mod = MOD + (size_t)layer * 4 * 6144;
        if (IN(pb + 1)) REPS(pb + 1) { if (layer == 0) norm_pass<true>(F, args, args.in[0], args.in[4], mod, 0, XNY); else norm_pass<false>(F, args, F.out, args.in[4] + 1024, mod, 0, XNY); } SEAM(pb + 1);
        if (IN(pb + 2)) REPS(pb + 2) {
            const int N = layer == 0 ? NZ0 : NZ1;
            pg8::Gemm g{XNY, layer == 0 ? WSP(bf16, WS_WIN0) : WSP(bf16, WS_WIN1), M, N, D}; pg8::StaticOrder S; S.init(M, N, F.G, F.bid);
            pg8::EpiBf16QK E{Zb, N, layer == 0 ? 8 : 0, layer == 0 ? 10 : 4, layer == 0 ? 10 : 4, layer == 0 ? 12 : 8, layer == 0 ? args.in[11] : args.in[15], layer == 0 ? args.in[12] : args.in[16], 0.125f * LOG2E, (LAS float*)(F.lds + 131072)};
            pg8::gemm_phase<pg8::EpiBf16QK, pg8::StaticOrder, true, true>(F.lds, g, S, E);
        } SEAM(pb + 2);
        if (layer == 0) {
            if (IN(3)) REPS(3) {
                for (int u = F.bid; u < 1024 + 128; u += F.G) {
                    if (u < 1024) mlstm_a_unit(F, args, u);
                    else if (rep == 1) { const int v = u - 1024, b = v >> 5, j = v & 31;
                        kmean_unit(F, Zb, NZ0, b * SEQ + j * 256, 2560, WSP(float, WS_KMEAN) + (size_t)((b * 8) * 32 + j) * 64); }
                }
            } SEAM(3);
            if (IN(4)) REPS(4) {
                if (rep == 1) for (int u = F.bid; u < 256; u += F.G) mlstm_scan_unit(F, u);
                { const float tcut = alibi_tcut(args.in[11], args.in[12], ((int)(threadIdx.x & 63u)));
                  const unsigned short* ORD = WSP(unsigned short, WS_ORD) + 2048; unsigned* qw = (unsigned*)(F.ws + WS_CTL) + CW_QMOBA + (rep == 1 ? 0 : 16);
                  for (;;) { if (((int)threadIdx.x) == 0) MISCW[0] = atomicAdd(qw, 1u); __syncthreads(); const unsigned qi = MISCW[0]; __syncthreads(); if (qi >= 1024u) break;
                      const int u = ORD[qi]; moba_unit(F, u >> 8, (u >> 5) & 7, u & 31, tcut); }
                  if (rep == 1) { unsigned* cw = (unsigned*)(F.ws + WS_CTL) + CW_QCVT0;
                      for (;;) { if (((int)threadIdx.x) == 0) MISCW[0] = atomicAdd(cw, 1u); __syncthreads(); const unsigned ci = MISCW[0]; __syncthreads(); if (ci >= 512u) break; i8_chunk(F, args, 0, (int)ci); } } }
            } SEAM(4);
            if (IN(5)) REPS(5) { for (int u = F.bid; u < 1024; u += F.G) mlstm_c_unit(F, args, u); } SEAM(5);
        } else {
            if (IN(pb + 4)) REPS(pb + 4) {
                const float* lp = args.in[17];
                const float lam = __expf(wave_sum(lp[((int)(threadIdx.x & 63u))] * lp[64 + ((int)(threadIdx.x & 63u))])) - __expf(wave_sum(lp[128 + ((int)(threadIdx.x & 63u))] * lp[192 + ((int)(threadIdx.x & 63u))])) + 0.35550906759096926f;
                { const float tcut = alibi_tcut(args.in[15], args.in[16], ((int)(threadIdx.x & 63u)));
                  const unsigned short* ORD = WSP(unsigned short, WS_ORD); unsigned* qw = (unsigned*)(F.ws + WS_CTL) + CW_QDIFF + (rep == 1 ? 0 : 16);
                  for (;;) { if (((int)threadIdx.x) == 0) MISCW[0] = atomicAdd(qw, 1u); __syncthreads(); const unsigned qi = MISCW[0]; __syncthreads(); if (qi >= 2048u) break;
                      const int u = ORD[qi]; diff_unit(F, args, u >> 9, (u >> 6) & 7, u & 63, lam, tcut, rep == 0 ? RPROBE : 0); }
                  if (rep == 1) { unsigned* cw = (unsigned*)(F.ws + WS_CTL) + CW_QCVT1;
                      for (;;) { if (((int)threadIdx.x) == 0) MISCW[0] = atomicAdd(cw, 1u); __syncthreads(); const unsigned ci = MISCW[0]; __syncthreads(); if (ci >= 512u) break; i8_chunk(F, args, 1, (int)ci); } } }
            } SEAM(pb + 4);
        }
        if (IN(pb + 6)) {
            pg8::Gemm g{XNY, layer == 0 ? WSP(bf16, WS_WOUT0) : WSP(bf16, WS_WOUT1), M, D, D}; pg8::StaticOrder S; S.init(M, D, F.G, F.bid);
            pg8::EpiResid E{layer == 0 ? args.in[0] : F.out, F.out, mod + 2 * 1024};
            pg8::gemm_phase<pg8::EpiResid, pg8::StaticOrder, true, true>(F.lds, g, S, E);
        } SEAM(pb + 6);
        if (IN(pb + 7)) REPS(pb + 7) { norm_pass<false>(F, args, F.out, args.in[5] + layer * 1024, mod, 3, XNY); } SEAM(pb + 7);
        if (IN(pb + 8)) REPS(pb + 8) {
            pg8::Gemm g{XNY, WSP(bf16, WS_WQ) + (size_t)layer * NQ * D, M, NQ, D}; pg8::StaticOrder S; S.init(M, NQ, F.G, F.bid);
            pg8::EpiBf16 E{WSP(bf16, WS_QRY), NQ};
            pg8::gemm_phase<pg8::EpiBf16, pg8::StaticOrder, true, true>(F.lds, g, S, E);
        } SEAM(pb + 8);
        if (IN(pb + 9)) REPS(pb + 9) { const bf16* KEYS = WSP(bf16, WS_KEYS) + (size_t)layer * 2 * 128 * 128;
            bf16x8 kf[4][2];
#pragma unroll
            for (int ks = 0; ks < 4; ++ks)
#pragma unroll
                for (int n = 0; n < 2; ++n) kf[ks][n] = *(const GAS bf16x8*)(KEYS + (size_t)((F.wave & 1) * 128 + 32 * (F.wave >> 1) + 16 * n + (((int)(threadIdx.x & 63u)) & 15)) * 128 + 32 * ks + 8 * (((int)(threadIdx.x & 63u)) >> 4));
            for (int u = F.bid; u < 2048; u += F.G) peer_route_unit(F, (u >> 3) * 128, u & 7, kf, rep == 0 ? RPROBE : 0); } SEAM(pb + 9);
        if (IN(pb + 10)) REPS(pb + 10) { peer_u_phase(F, F.ws + WS_UB + (size_t)layer * 8 * 16384 * 128); } SEAM(pb + 10);
        if (IN(pb + 11)) REPS(pb + 11) { peer_act_phase(F, WSP(float, WS_ISU) + layer * 16384, WSP(float, WS_ISV) + layer * 16384); } SEAM(pb + 11);
        if (IN(pb + 12)) REPS(pb + 12) { peer_v_phase(F, F.ws + WS_VB + (size_t)layer * 8 * 16384 * 128, mod + 5 * 1024, rep == 1 ? (layer == 0 ? (float)DBG_P0 : (float)DBG_P1) : 0.f); }
        if (layer == 0) SEAM(12);
    }
__global__ void __launch_bounds__(NTHR, 2) mega_fwd(Args args) {
    extern __shared__ __attribute__((aligned(16))) unsigned char lds_raw[];
    Frame F;
    F.lds = (LAS unsigned char*)lds_raw;
    F.wave = __builtin_amdgcn_readfirstlane((int)threadIdx.x >> 6);
    F.G = gridDim.x; F.bid = blockIdx.x;
    F.out = args.out; F.ws = args.ws;
    volatile LAS unsigned* MISC = (volatile LAS unsigned*)(F.lds + MISC_OFF);
    for (int u = ((int)threadIdx.x); u < (LDS_BYTES - LDSCTL_OFF) / 4; u += NTHR) ((LAS unsigned*)(F.lds + LDSCTL_OFF))[u] = 0u;
    __syncthreads();
    XcdBarrier bar; bar.bar = (unsigned*)(F.ws + WS_CTL) + CW_BAR; bar.x = 0; bar.st = nullptr;
    if (!MK_PER_PHASE) bar = xcd_barrier_post((unsigned*)(F.ws + WS_CTL) + CW_BAR, MISC + 8);
    const int lo = args.ph_lo, hi = args.ph_hi;

#ifdef EXTRA_BAR
    for (int i = 0; i < EXTRA_BAR; ++i) xcd_barrier(bar);
#endif
    if (IN(0)) REPS(0) { p0_prologue(F, args); } SEAM(0);
    layer_phases<0>(F, args, bar, lo, hi);
    layer_phases<1>(F, args, bar, lo, hi);
}
#undef IN
#undef SEAM

extern "C" void kernel_launch(void* const* d_in, const int* in_sizes, int n_in, void* d_out, int out_size, void* d_ws, size_t ws_size, hipStream_t stream) {
    static int grid = 0;
    if (grid == 0) {
        if (n_in != 24 || in_sizes[0] != M * D || out_size != M * D || ws_size < WS_END) { fprintf(stderr, "kernel_launch: unexpected problem (n_in %d, in0 %d, out %d, ws %zu < %zu); nothing launched\n", n_in, n_in > 0 ? in_sizes[0] : -1, out_size, ws_size, (size_t)WS_END); grid = -1; return; }
        int dev = 0, cus = 0, per_cu = 0;
        if (hipGetDevice(&dev) != hipSuccess || hipDeviceGetAttribute(&cus, hipDeviceAttributeMultiprocessorCount, dev) != hipSuccess) { grid = -1; return; }
        if (hipFuncSetAttribute((const void*)mega_fwd, hipFuncAttributeMaxDynamicSharedMemorySize, LDS_BYTES) != hipSuccess) { fprintf(stderr, "kernel_launch: hipFuncSetAttribute failed\n"); grid = -1; return; }
        if (hipOccupancyMaxActiveBlocksPerMultiprocessor(&per_cu, (const void*)mega_fwd, NTHR, LDS_BYTES) != hipSuccess || per_cu < 1)
            fprintf(stderr, "kernel_launch: note: occupancy query reports %d workgroups per CU\n", per_cu);
        (void)hipGetLastError();
        grid = cus;
    }
    if (grid < 0) return;
    if (hipMemsetAsync((char*)d_ws + WS_CTL, 0, CTL_ZERO_BYTES, stream) != hipSuccess) { fprintf(stderr, "kernel_launch: memset failed\n"); return; }
    Args a{};
    for (int i = 0; i < 24; ++i) a.in[i] = (const float*)d_in[i];
    a.out = (float*)d_out; a.ws = (unsigned char*)d_ws;
#if MK_PER_PHASE
    for (int p = 0; p < NPHASE + 1; ++p) { a.ph_lo = p; a.ph_hi = p + 1; hipLaunchKernelGGL(mega_fwd, dim3(grid), dim3(NTHR), LDS_BYTES, stream, a); }
#else
    a.ph_lo = 0; a.ph_hi = NPHASE + 1;
    hipLaunchKernelGGL(mega_fwd, dim3(grid), dim3(NTHR), LDS_BYTES, stream, a);
#endif
#if defined(CHECK) && CHECK
    chk_qry<<<256, 256, 0, stream>>>(a); chk_keys<<<256, 256, 0, stream>>>(a); chk_uv<<<1024, 256, 0, stream>>>(a); chk_scores<<<128, 256, 0, stream>>>(a); chk_route<<<512, 256, 0, stream>>>(a); chk_expert<<<64, 256, 0, stream>>>(a); chk_stamp<<<(M * D + 255) / 256, 256, 0, stream>>>(a);
#endif
    const hipError_t le = hipPeekAtLastError();
    if (le != hipSuccess) fprintf(stderr, "kernel_launch: launch failed: %s\n", hipGetErrorName(le));
}
```

```cpp
#include <hip/hip_runtime.h>
#include <cstdio>
#include <cstdint>
namespace pg8 {
#define PG8_LAS __attribute__((address_space(3)))
typedef unsigned short bf16_t;
typedef short bf16x8 __attribute__((ext_vector_type(8)));
typedef float f32x4 __attribute__((ext_vector_type(4)));
typedef unsigned u32x4 __attribute__((ext_vector_type(4)));
constexpr int BM = 256, BK = 64, HALF = 128, HTB = HALF * BK * 2  , STAGE_BYTES = 8 * HTB, NXCD = 8, WGM = 8;

__host__ __device__ __forceinline__ int lds_byte(int r, int c) { const int st = (r >> 4) * 2 + (c >> 5), rr = r & 15, cc = c & 31, ob = rr * 64 + cc * 2; return st * 1024 + (ob ^ (((ob >> 9) & 1) << 5)); }
__host__ __device__ __forceinline__ void stage_rc(int b, int& R, int& C) { const int st = b / 1024, sb = b % 1024, swz = sb ^ (((sb >> 9) & 1) << 5); R = (st >> 1) * 16 + swz / 64; C = (st & 1) * 32 + (swz % 64) / 2; }
__host__ __device__ __forceinline__ int perm32(int rho) { const int n = rho >> 4, i = rho & 15; return 8 * (i >> 2) + 4 * n + (i & 3); }

struct Unit { int pm, pn; };
struct Gemm { const bf16_t* A; const bf16_t* Bt; int M, N, K; size_t bstride; };

struct StaticOrder {
    int nM, nN, nwg, G, c;
    __host__ __device__ void init(int M, int N, int G_, int c_) { nM = M / BM; nN = N / BM; nwg = nM * nN; G = G_; c = c_; }
    __host__ __device__ bool next(int i, Unit& u) const {
        const long L = (long)i * G + c; if (L >= nwg) return false;
        int wgid = (int)L; { const int q = nwg / NXCD, r = nwg % NXCD, xcd = wgid % NXCD, off = wgid / NXCD; wgid = (xcd < r ? xcd * (q + 1) : r * (q + 1) + (xcd - r) * q) + off; }
        const int nig = WGM * nN, gid = wgid / nig, fm = gid * WGM, gsz = (nM - fm) < WGM ? (nM - fm) : WGM;
        u.pm = fm + ((wgid % nig) % gsz); u.pn = (wgid % nig) / gsz; return true;
    }
    __device__ __forceinline__ void a_ready(const Unit&) const {}
    __device__ __forceinline__ void done(const Unit&) const {}
};

__device__ __forceinline__ unsigned cvt_pk_bf16(float lo, float hi) { unsigned r; asm volatile("v_cvt_pk_bf16_f32 %0, %1, %2" : "=v"(r) : "v"(lo), "v"(hi)); return r; }
typedef unsigned u32x4 __attribute__((ext_vector_type(4)));
struct EpiBf16 {
    static constexpr bool PERM = true, AFTER_DRAIN = false;
    bf16_t* O; int ldc;
    __device__ __forceinline__ void operator()(const f32x4 (&acc)[2][2][4][2], const Unit& u, int wr, int wc, int fr, int fq) const {
        const int row0 = u.pm * BM + wr * 64 + fr; const int col0 = u.pn * BM + wc * 32 + 8 * fq;
#pragma unroll
        for (int ai = 0; ai < 2; ++ai)
#pragma unroll
            for (int m = 0; m < 4; ++m) { bf16_t* rowp = O + (size_t)(row0 + ai * HALF + m * 16) * ldc + col0;
#pragma unroll
                for (int bj = 0; bj < 2; ++bj) { const f32x4 v0 = acc[ai][bj][m][0], v1 = acc[ai][bj][m][1];
                    u32x4 w; w.x = cvt_pk_bf16(v0[0], v0[1]); w.y = cvt_pk_bf16(v0[2], v0[3]); w.z = cvt_pk_bf16(v1[0], v1[1]); w.w = cvt_pk_bf16(v1[2], v1[3]);
                    *(u32x4*)(rowp + bj * HALF) = w; } }
    }
};
struct EpiBf16QK {
    static constexpr bool PERM = true, AFTER_DRAIN = false;
    bf16_t* O; int ldc; int q_lo, q_hi, k_lo, k_hi; const float* gq; const float* gk; float qmul; PG8_LAS float* xs;
    __device__ __forceinline__ void operator()(const f32x4 (&acc)[2][2][4][2], const Unit& u, int wr, int wc, int fr, int fq) const {
        const int row0 = u.pm * BM + wr * 64 + fr; const int col0 = u.pn * BM + wc * 32 + 8 * fq;
        const bool isq = u.pn >= q_lo && u.pn < q_hi, isk = u.pn >= k_lo && u.pn < k_hi;
        if (!(isq || isk)) {
#pragma unroll
            for (int ai = 0; ai < 2; ++ai)
#pragma unroll
                for (int m = 0; m < 4; ++m) { bf16_t* rowp = O + (size_t)(row0 + ai * HALF + m * 16) * ldc + col0;
#pragma unroll
                    for (int bj = 0; bj < 2; ++bj) { const f32x4 v0 = acc[ai][bj][m][0], v1 = acc[ai][bj][m][1];
                        u32x4 w; w.x = cvt_pk_bf16(v0[0], v0[1]); w.y = cvt_pk_bf16(v0[2], v0[3]); w.z = cvt_pk_bf16(v1[0], v1[1]); w.w = cvt_pk_bf16(v1[2], v1[3]);
                        *(u32x4*)(rowp + bj * HALF) = w; } }
            return;
        }
        float ssq[2][4][2];
#pragma unroll
        for (int ai = 0; ai < 2; ++ai)
#pragma unroll
            for (int m = 0; m < 4; ++m)
#pragma unroll
                for (int bj = 0; bj < 2; ++bj) { const f32x4 v0 = acc[ai][bj][m][0], v1 = acc[ai][bj][m][1];
                    float s = (v0[0] * v0[0] + v0[1] * v0[1]) + (v0[2] * v0[2] + v0[3] * v0[3]) + (v1[0] * v1[0] + v1[1] * v1[1]) + (v1[2] * v1[2] + v1[3] * v1[3]);
                    s += __shfl_xor(s, 16); s += __shfl_xor(s, 32); ssq[ai][m][bj] = s;
                    if (fq == 0) xs[(ai * HALF + wr * 64 + m * 16 + fr) * 8 + bj * 4 + wc] = s; }
        asm volatile("s_waitcnt lgkmcnt(0)" ::: "memory"); __builtin_amdgcn_s_barrier(); asm volatile("" ::: "memory");
        const float* g = isq ? gq : gk; const float gm = isq ? qmul : 1.f;
        const int d0 = (wc & 1) * 32 + 8 * fq;
        const f32x4 g0 = *(const f32x4*)(g + d0) * gm, g1 = *(const f32x4*)(g + d0 + 4) * gm;
#pragma unroll
        for (int ai = 0; ai < 2; ++ai)
#pragma unroll
            for (int m = 0; m < 4; ++m) { bf16_t* rowp = O + (size_t)(row0 + ai * HALF + m * 16) * ldc + col0;
#pragma unroll
                for (int bj = 0; bj < 2; ++bj) { const float tot = ssq[ai][m][bj] + xs[(ai * HALF + wr * 64 + m * 16 + fr) * 8 + bj * 4 + (wc ^ 1)];
                    const float rs = __builtin_amdgcn_rsqf(tot * (1.f / 64.f) + 1e-6f);
                    const f32x4 v0 = acc[ai][bj][m][0] * rs * g0, v1 = acc[ai][bj][m][1] * rs * g1;
                    u32x4 w; w.x = cvt_pk_bf16(v0[0], v0[1]); w.y = cvt_pk_bf16(v0[2], v0[3]); w.z = cvt_pk_bf16(v1[0], v1[1]); w.w = cvt_pk_bf16(v1[2], v1[3]);
                    *(u32x4*)(rowp + bj * HALF) = w; } }
    }
};
struct EpiBf16RS {
    static constexpr bool PERM = true, AFTER_DRAIN = false;
    bf16_t* O; int ldc; const float* rss; const float* bias; int bias_stride;
    __device__ __forceinline__ void operator()(const f32x4 (&acc)[2][2][4][2], const Unit& u, int wr, int wc, int fr, int fq) const {
        const int row0 = u.pm * BM + wr * 64 + fr; const int col0 = u.pn * BM + wc * 32 + 8 * fq; const int b = (u.pm * BM) >> 13;
        f32x4 bv[2][2];
#pragma unroll
        for (int bj = 0; bj < 2; ++bj)
#pragma unroll
            for (int n = 0; n < 2; ++n) bv[bj][n] = *(const f32x4*)(bias + (size_t)b * bias_stride + col0 + bj * HALF + 4 * n);
#pragma unroll
        for (int ai = 0; ai < 2; ++ai)
#pragma unroll
            for (int m = 0; m < 4; ++m) { const int row = row0 + ai * HALF + m * 16; bf16_t* rowp = O + (size_t)row * ldc + col0;
                const f32x4 p0 = *(const f32x4*)(rss + (size_t)row * 16), p1 = *(const f32x4*)(rss + (size_t)row * 16 + 4), p2 = *(const f32x4*)(rss + (size_t)row * 16 + 8), p3 = *(const f32x4*)(rss + (size_t)row * 16 + 12);
                const f32x4 pt = (p0 + p1) + (p2 + p3);
                const float rs = __builtin_amdgcn_rsqf(((pt[0] + pt[1]) + (pt[2] + pt[3])) * (1.f / 1024.f) + 1e-6f);
#pragma unroll
                for (int bj = 0; bj < 2; ++bj) { const f32x4 v0 = acc[ai][bj][m][0] * rs + bv[bj][0], v1 = acc[ai][bj][m][1] * rs + bv[bj][1];
                    u32x4 w; w.x = cvt_pk_bf16(v0[0], v0[1]); w.y = cvt_pk_bf16(v0[2], v0[3]); w.z = cvt_pk_bf16(v1[0], v1[1]); w.w = cvt_pk_bf16(v1[2], v1[3]);
                    *(u32x4*)(rowp + bj * HALF) = w; } }
    }
};
struct EpiResid {
    static constexpr bool PERM = false, AFTER_DRAIN = false;
    const float* base; float* out; const float* gate;
    __device__ __forceinline__ void operator()(const f32x4 (&acc)[2][2][4][2], const Unit& u, int wr, int wc, int fr, int fq) const {
        const int col0 = u.pn * BM + wc * 32 + 4 * fq; const int b = (u.pm * BM) >> 13;
#pragma unroll
        for (int bj = 0; bj < 2; ++bj)
#pragma unroll
            for (int n = 0; n < 2; ++n) { const f32x4 gv = *(const f32x4*)(gate + (size_t)b * 6144 + col0 + bj * HALF + n * 16);
#pragma unroll
                for (int ai = 0; ai < 2; ++ai)
#pragma unroll
                    for (int m = 0; m < 4; ++m) { const size_t off = (size_t)(u.pm * BM + ai * HALF + wr * 64 + m * 16 + fr) * 1024 + col0 + bj * HALF + n * 16;
                        const f32x4 bs = *(const f32x4*)(base + off); *(f32x4*)(out + off) = bs + gv * acc[ai][bj][m][n]; } }
    }
};

template <class Epi, class Sched, bool ALIGN_EPI = false, bool SP2 = false>
__device__ __forceinline__ void gemm_phase(PG8_LAS unsigned char* lds, const Gemm g, const Sched& S, const Epi& E) {
    const int tid = threadIdx.x, wid = __builtin_amdgcn_readfirstlane(tid >> 6), lane = tid & 63, wr = wid >> 2, wc = wid & 3, fr = lane & 15, fq = lane >> 4;
    const int K = g.K, nt = K / BK;
    unsigned voffA[2], voffB[2];
#pragma unroll
    for (int i = 0; i < 2; ++i) { int R, C; stage_rc(tid * 16 + i * 8192, R, C); const int Rb = Epi::PERM ? ((R & ~31) + perm32(R & 31)) : R;
        voffA[i] = (unsigned)(R * K + C) * 2u; voffB[i] = (unsigned)(Rb * K + C) * 2u; }
    const size_t kstep = (size_t)(BK * 2);
    const size_t hstep = (size_t)HALF * K * 2;
    const size_t tstep = 2 * hstep;
    const unsigned ldsw = (unsigned)wid * 1024u;
    const int aoff = lds_byte(wr * 64 + fr, fq * 8), boff = lds_byte(wc * 32 + fr, fq * 8);
#define PG8_SA(b, h) (((b) * 2 + (h)) * HTB)
#define PG8_SB(b, h) ((4 + (b) * 2 + (h)) * HTB)
#define PG8_STAGE(bufoff, gbase, voff) do { _Pragma("unroll") for (int _i = 0; _i < 2; ++_i) \
        __builtin_amdgcn_global_load_lds((const unsigned*)((const char*)(gbase) + (voff)[_i]), (PG8_LAS unsigned*)(lds + (bufoff) + ldsw + _i * 8192), 16, 0, 0); } while (0)
#define PG8_LDA(dst, b, h) do { _Pragma("unroll") for (int m = 0; m < 4; ++m) _Pragma("unroll") for (int k = 0; k < 2; ++k) dst[m][k] = *(const PG8_LAS bf16x8*)(lds + PG8_SA(b, h) + aoff + m * 2048 + k * 1024); } while (0)
#define PG8_LDB(dst, b, h) do { _Pragma("unroll") for (int n = 0; n < 2; ++n) _Pragma("unroll") for (int k = 0; k < 2; ++k) dst[n][k] = *(const PG8_LAS bf16x8*)(lds + PG8_SB(b, h) + boff + n * 2048 + k * 1024); } while (0)
#define PG8_MMA(ai, bj, At, Bt) do { __builtin_amdgcn_s_setprio(1); _Pragma("unroll") for (int m = 0; m < 4; ++m) _Pragma("unroll") for (int n = 0; n < 2; ++n) _Pragma("unroll") for (int k = 0; k < 2; ++k) \
        acc[ai][bj][m][n] = __builtin_amdgcn_mfma_f32_16x16x32_bf16(Bt[n][k], At[m][k], acc[ai][bj][m][n], 0, 0, 0); __builtin_amdgcn_s_setprio(0); } while (0)
#define PG8_WAIT_V(n) asm volatile("s_waitcnt vmcnt(" #n ")" ::: "memory")
#define PG8_WAIT_L(n) asm volatile("s_waitcnt lgkmcnt(" #n ")" ::: "memory")
#define PG8_BAR __builtin_amdgcn_s_barrier()
#define PG8_SCHED __builtin_amdgcn_sched_barrier(0)
    Unit cur, nxt; int ui = 0;
    if (!S.next(0, cur)) return;
    f32x4 acc[2][2][4][2];
#pragma unroll
    for (int a = 0; a < 2; ++a)
#pragma unroll
        for (int b = 0; b < 2; ++b)
#pragma unroll
            for (int m = 0; m < 4; ++m)
#pragma unroll
                for (int n = 0; n < 2; ++n) acc[a][b][m][n] = (f32x4){0.f, 0.f, 0.f, 0.f};
    bf16x8 At[4][2], B0[2][2], B1[2][2];
    const char* cA = (const char*)g.A + (size_t)cur.pm * tstep; const char* cB = (const char*)g.Bt + (size_t)(cur.pm >> 5) * g.bstride + (size_t)cur.pn * tstep;
    S.a_ready(cur);
    if constexpr (SP2) {
        PG8_STAGE(PG8_SB(0, 0), cB, voffB); PG8_STAGE(PG8_SB(0, 1), cB + hstep, voffB); PG8_STAGE(PG8_SA(0, 0), cA, voffA); PG8_STAGE(PG8_SA(0, 1), cA + hstep, voffA);
        if (wr == 1) PG8_BAR;
        PG8_WAIT_V(2); PG8_BAR;
        PG8_STAGE(PG8_SB(1, 0), cB + kstep, voffB); PG8_STAGE(PG8_SA(1, 0), cA + kstep, voffA); PG8_STAGE(PG8_SB(1, 1), cB + hstep + kstep, voffB);
        PG8_WAIT_V(6); PG8_BAR;
    } else {
        PG8_STAGE(PG8_SB(0, 0), cB, voffB); PG8_STAGE(PG8_SA(0, 0), cA, voffA); PG8_STAGE(PG8_SB(0, 1), cB + hstep, voffB); PG8_STAGE(PG8_SA(0, 1), cA + hstep, voffA);
        if (wr == 1) PG8_BAR;
        PG8_WAIT_V(4); PG8_BAR;
        PG8_STAGE(PG8_SB(1, 0), cB + kstep, voffB); PG8_STAGE(PG8_SA(1, 0), cA + kstep, voffA); PG8_STAGE(PG8_SB(1, 1), cB + hstep + kstep, voffB);
        PG8_WAIT_V(6); PG8_BAR;
    }
    for (;;) {
        const bool has_next = S.next(ui + 1, nxt);
        const char* nA = has_next ? (const char*)g.A + (size_t)nxt.pm * tstep : cA; const char* nB = has_next ? (const char*)g.Bt + (size_t)(nxt.pm >> 5) * g.bstride + (size_t)nxt.pn * tstep : cB;
        for (int t = 0; t < nt; t += 2) {
            const bool last = (t == nt - 2);
            const char* a1 = cA + (size_t)(t + 1) * kstep;
            const char* a2 = last ? nA : cA + (size_t)(t + 2) * kstep; const char* b2 = last ? nB : cB + (size_t)(t + 2) * kstep;
            const char* a3 = a2 + kstep; const char* b3 = b2 + kstep;
            if (last && has_next) S.a_ready(nxt);
            if constexpr (SP2) {
            PG8_LDB(B0, 0, 0); PG8_LDB(B1, 0, 1); PG8_SCHED; PG8_LDA(At, 0, 0); PG8_STAGE(PG8_SA(1, 1), a1 + hstep, voffA);
            PG8_WAIT_V(8); PG8_WAIT_L(0); PG8_BAR; PG8_MMA(0, 0, At, B0); PG8_MMA(0, 1, At, B1); PG8_BAR; PG8_SCHED;
            PG8_LDA(At, 0, 1); PG8_STAGE(PG8_SB(0, 0), b2, voffB); PG8_STAGE(PG8_SB(0, 1), b2 + hstep, voffB); PG8_STAGE(PG8_SA(0, 0), a2, voffA);
            PG8_WAIT_V(8); PG8_WAIT_L(0); PG8_BAR; PG8_MMA(1, 0, At, B0); PG8_MMA(1, 1, At, B1); PG8_BAR; PG8_SCHED;
            PG8_LDB(B0, 1, 0); PG8_LDB(B1, 1, 1); PG8_SCHED; PG8_LDA(At, 1, 0); PG8_STAGE(PG8_SA(0, 1), a2 + hstep, voffA);
            PG8_WAIT_V(8); PG8_WAIT_L(0); PG8_BAR; PG8_MMA(0, 0, At, B0); PG8_MMA(0, 1, At, B1); PG8_BAR; PG8_SCHED;
            PG8_LDA(At, 1, 1); PG8_STAGE(PG8_SB(1, 0), b3, voffB); PG8_STAGE(PG8_SB(1, 1), b3 + hstep, voffB); PG8_STAGE(PG8_SA(1, 0), a3, voffA);
            PG8_WAIT_V(8); PG8_WAIT_L(0); PG8_BAR; PG8_MMA(1, 0, At, B0); PG8_MMA(1, 1, At, B1); PG8_BAR; PG8_SCHED;
            } else {
            PG8_LDB(B0, 0, 0); PG8_SCHED; PG8_LDA(At, 0, 0); PG8_STAGE(PG8_SA(1, 1), a1 + hstep, voffA);
            PG8_WAIT_L(8); PG8_BAR; PG8_WAIT_L(0); PG8_MMA(0, 0, At, B0); PG8_BAR; PG8_SCHED;
            PG8_LDB(B1, 0, 1); PG8_STAGE(PG8_SB(0, 0), b2, voffB);
            PG8_BAR; PG8_WAIT_L(0); PG8_MMA(0, 1, At, B1); PG8_BAR;
            PG8_LDA(At, 0, 1); PG8_STAGE(PG8_SA(0, 0), a2, voffA);
            PG8_BAR; PG8_WAIT_L(0); PG8_MMA(1, 0, At, B0); PG8_BAR; PG8_SCHED;
            PG8_STAGE(PG8_SB(0, 1), b2 + hstep, voffB);
            PG8_WAIT_V(6); PG8_BAR; PG8_MMA(1, 1, At, B1); PG8_BAR;
            PG8_LDB(B0, 1, 0); PG8_SCHED; PG8_LDA(At, 1, 0); PG8_STAGE(PG8_SA(0, 1), a2 + hstep, voffA);
            PG8_WAIT_L(8); PG8_BAR; PG8_WAIT_L(0); PG8_MMA(0, 0, At, B0); PG8_BAR; PG8_SCHED;
            PG8_LDB(B1, 1, 1); PG8_STAGE(PG8_SB(1, 0), b3, voffB);
            PG8_BAR; PG8_WAIT_L(0); PG8_MMA(0, 1, At, B1); PG8_BAR;
            PG8_LDA(At, 1, 1); PG8_STAGE(PG8_SA(1, 0), a3, voffA);
            PG8_BAR; PG8_WAIT_L(0); PG8_MMA(1, 0, At, B0); PG8_BAR; PG8_SCHED;
            PG8_STAGE(PG8_SB(1, 1), b3 + hstep, voffB);
            PG8_WAIT_V(6); PG8_BAR; PG8_MMA(1, 1, At, B1); PG8_BAR;
            }
        }
        if constexpr (ALIGN_EPI) { if (wr == 0) PG8_BAR; }
        if constexpr (!Epi::AFTER_DRAIN) { E(acc, cur, wr, wc, fr, fq); S.done(cur); }
        if (!has_next) break;
#pragma unroll
        for (int a = 0; a < 2; ++a)
#pragma unroll
            for (int b = 0; b < 2; ++b)
#pragma unroll
                for (int m = 0; m < 4; ++m)
#pragma unroll
                    for (int n = 0; n < 2; ++n) acc[a][b][m][n] = (f32x4){0.f, 0.f, 0.f, 0.f};
        cur = nxt; cA = nA; cB = nB; ++ui;
        if constexpr (ALIGN_EPI) { if (wr == 1) PG8_BAR; }
    }
    PG8_WAIT_V(0);
    if constexpr (!ALIGN_EPI) { if (wr == 0) PG8_BAR; }
    PG8_BAR;
    if constexpr (Epi::AFTER_DRAIN) { E.fused(acc, cur, wr, wc, fr, fq, lds, wid, lane); S.done(cur); }
#undef PG8_SA
#undef PG8_SB
#undef PG8_STAGE
#undef PG8_LDA
#undef PG8_LDB
#undef PG8_MMA
#undef PG8_WAIT_V
#undef PG8_WAIT_L
#undef PG8_BAR
#undef PG8_SCHED
}
}
constexpr int NB = 4, SEQ = 8192, D = 1024, M = NB * SEQ;
constexpr int NZ0 = 3584, NZ1 = 3072, NQ = 2048, SRC_IN0 = 3592;
constexpr float EPS = 1e-6f;
constexpr int NWAVES = 8, NTHR = 512;
constexpr float LOG2E = 1.4426950408889634f;
constexpr size_t MiB = 1u << 20;
constexpr size_t WS_CTL = 0, CTL_ZERO_BYTES = 1 * MiB;
constexpr size_t WS_WIN0 = 1 * MiB, WS_WOUT0 = 8 * MiB, WS_WIN1 = 10 * MiB, WS_WOUT1 = 16 * MiB, WS_WQ = 18 * MiB;
constexpr size_t WS_KEYS = 26 * MiB, WS_MOD = WS_KEYS + 128 * 1024, WS_KMEAN = WS_MOD + 192 * 1024, WS_NLOC = WS_KMEAN + 256 * 1024,
                 WS_BEND = WS_NLOC + 512 * 1024, WS_MLOC = WS_BEND + 4096, WS_MPREV = WS_MLOC + 4096,
                 WS_ISU = 27 * MiB + 512 * 1024, WS_ISV = WS_ISU + 128 * 1024, WS_ORD = WS_ISV + 128 * 1024  ,
                 WS_QB = WS_ORD + 8 * 1024  , WS_GTAB = WS_QB + 64 * 1024  ;
constexpr size_t WS_GATES = 28 * MiB;
constexpr size_t WS_UB = 32 * MiB  , WS_VB = 64 * MiB, WS_ACT = 96 * MiB  , WS_ACTS = 100 * MiB  , WS_WQF = 112 * MiB  , WS_XNY = 160 * MiB, WS_Z = 224 * MiB, WS_CLOC = 448 * MiB, WS_END = 512 * MiB;
constexpr size_t WS_QRY = WS_Z, WS_IDX = WS_Z + 128 * MiB, WS_GATE = WS_Z + 144 * MiB, WS_PART = WS_Z  , WS_X1B = 448 * MiB  ;
constexpr size_t WS_RSS = 104 * MiB;
constexpr int CW_BAR = 4096, CW_QMOBA = 8192, CW_QDIFF = 8256, CW_QCVT0 = 8320, CW_QCVT1 = 8384;
constexpr float ALIBI_MARGIN = 27.03f;
constexpr int RING_BYTES = 139264;
constexpr int LDSCTL_OFF = RING_BYTES, MISC_OFF = LDSCTL_OFF + 320;
constexpr int LDS_BYTES = 147456;
static_assert(MISC_OFF + 128 <= LDS_BYTES, "LDS map");

#define GAS __attribute__((address_space(1)))
#define LAS __attribute__((address_space(3)))
typedef unsigned short bf16;
typedef unsigned v4u __attribute__((ext_vector_type(4)));
typedef unsigned v2u __attribute__((ext_vector_type(2)));
typedef float f32x4 __attribute__((ext_vector_type(4)));
typedef float f32x16 __attribute__((ext_vector_type(16)));
typedef short bf16x8 __attribute__((ext_vector_type(8)));
typedef short s16x4 __attribute__((ext_vector_type(4)));
typedef GAS unsigned gu32;
#define RLX_AGENT __ATOMIC_RELAXED, __HIP_MEMORY_SCOPE_AGENT
#define LDS_WAIT() asm volatile("s_waitcnt lgkmcnt(0)" ::: "memory")
#define VM_WAIT() asm volatile("s_waitcnt vmcnt(0)" ::: "memory")
__device__ __forceinline__ unsigned f2bf(float f) { unsigned u = __builtin_bit_cast(unsigned, f); return (u + 0x7fffu + ((u >> 16) & 1u)) >> 16; }
__device__ __forceinline__ unsigned pk2(float lo, float hi) { return f2bf(lo) | (f2bf(hi) << 16); }
__device__ __forceinline__ float bflo(unsigned w) { return __builtin_bit_cast(float, w << 16); }
__device__ __forceinline__ float bfhi(unsigned w) { return __builtin_bit_cast(float, w & 0xffff0000u); }
__device__ __forceinline__ float bf2f(bf16 h) { return __builtin_bit_cast(float, (unsigned)h << 16); }
__device__ __forceinline__ unsigned f2u(float x) { return __builtin_bit_cast(unsigned, x); }
__device__ __forceinline__ float u2f(unsigned x) { return __builtin_bit_cast(float, x); }
__device__ __forceinline__ float dot2bf(unsigned a, unsigned b, float acc) { typedef __bf16 bf2_ __attribute__((ext_vector_type(2))); return __builtin_amdgcn_fdot2_f32_bf16(__builtin_bit_cast(bf2_, a), __builtin_bit_cast(bf2_, b), acc, false); }
__device__ __forceinline__ float wave_sum(float v) {
#pragma unroll
    for (int o = 1; o < 64; o <<= 1) v += __shfl_xor(v, o);
    return v;
}
__device__ __forceinline__ float wave_max(float v) {
#pragma unroll
    for (int o = 1; o < 64; o <<= 1) v = fmaxf(v, __shfl_xor(v, o));
    return v;
}
__device__ __forceinline__ float silu_f(float x) { return x / (1.f + __expf(-x)); }
__device__ __forceinline__ float sigmoid_f(float x) { return 1.f / (1.f + __expf(-x)); }
__device__ __forceinline__ float logsigmoid_f(float x) { return fminf(x, 0.f) - log1pf(__expf(-fabsf(x))); }
struct Args { const float* in[24]; float* out; unsigned char* ws; int ph_lo, ph_hi; };
#define XB_TMO      128
#define XB_XCNT(j)  (256  + 64 * (j))
#define XB_XSUB(j)  (1280 + 64 * (j))
#define XB_XGEN(j)  (2304 + 64 * (j))
#define XB_TOP      3328
#define XB_TOPGEN   3392
#define XCD_BAR_WORDS 3456
#define XB_SPIN_CAP (1u << 18)

__device__ __forceinline__ unsigned xb_ld(unsigned* p)              { return __hip_atomic_load(p, __ATOMIC_RELAXED, __HIP_MEMORY_SCOPE_AGENT); }
__device__ __forceinline__ unsigned xb_add(unsigned* p, unsigned v) { return __hip_atomic_fetch_add(p, v, __ATOMIC_RELAXED, __HIP_MEMORY_SCOPE_AGENT); }
__device__ __forceinline__ unsigned xb_xcc_id() { return (unsigned)__builtin_amdgcn_s_getreg((3 << 11) | 20) & 0xFu; }
#define XB_SPIN(cond, bar) do { unsigned _sp = 0; while (cond) { __builtin_amdgcn_s_sleep(1); \
    if ((++_sp & 255u) == 0u) { if (xb_ld(&(bar)[XB_TMO])) break; if (_sp > XB_SPIN_CAP) { atomicAdd(&(bar)[XB_TMO], 1u); break; } } } } while (0)

struct XcdBarrier {
    unsigned* bar; unsigned x;
    volatile LAS unsigned* st;
};

__device__ __forceinline__ XcdBarrier xcd_barrier_post(unsigned* bar, volatile LAS unsigned* st) {
    XcdBarrier b; b.bar = bar; b.x = xb_xcc_id(); b.st = st;
    if (threadIdx.x == 0) (void)xb_add(&bar[XB_XCNT(b.x)], 1u);
    return b;
}
__device__ __forceinline__ void xcd_barrier_complete(unsigned* bar, unsigned x, unsigned& nloc, unsigned& nx) {
    const unsigned G = gridDim.x * gridDim.y * gridDim.z;
    unsigned sum, cnt, mine, sp = 0u;
    for (;;) {
        sum = 0u; cnt = 0u; mine = 0u;
#pragma unroll
        for (unsigned j = 0; j < 16; ++j) { const unsigned c = xb_ld(&bar[XB_XCNT(j)]); sum += c; cnt += (c > 0u) ? 1u : 0u; mine = (j == x) ? c : mine; }
        if (sum == G) break;
        __builtin_amdgcn_s_sleep(1);
        if ((++sp & 255u) == 0u) { if (xb_ld(&bar[XB_TMO])) break; if (sp > XB_SPIN_CAP) { atomicAdd(&bar[XB_TMO], 1u); break; } }
    }
    nloc = mine > 0u ? mine : 1u; nx = cnt > 0u ? cnt : 1u;
}

__device__ __forceinline__ void xcd_barrier(const XcdBarrier& b) {
    asm volatile("s_waitcnt vmcnt(0)" ::: "memory");
    __syncthreads();
    if (threadIdx.x == 0) {
        unsigned* bar = b.bar;
        __builtin_amdgcn_s_waitcnt(0);
        unsigned nloc = b.st[0], nx = b.st[1];
        if (nloc == 0u) { xcd_barrier_complete(bar, b.x, nloc, nx); b.st[0] = nloc; b.st[1] = nx; }
        const unsigned old = xb_add(&bar[XB_XSUB(b.x)], 1u);
        const unsigned gen = old / nloc;
        if (old + 1u == (gen + 1u) * nloc) {
            __builtin_amdgcn_fence(__ATOMIC_RELEASE, "agent");
            asm volatile("s_waitcnt vmcnt(0)" ::: "memory");
            const unsigned og = xb_add(&bar[XB_TOP], 1u);
            const unsigned tg = og / nx;
            if (og + 1u == (tg + 1u) * nx) xb_add(&bar[XB_TOPGEN], 1u);
            else XB_SPIN(xb_ld(&bar[XB_TOPGEN]) == tg, bar);
            __builtin_amdgcn_fence(__ATOMIC_ACQUIRE, "agent");
            xb_add(&bar[XB_XGEN(b.x)], 1u);
            asm volatile("s_waitcnt vmcnt(0)" ::: "memory");
        } else {
            XB_SPIN(xb_ld(&bar[XB_XGEN(b.x)]) == gen, bar);
            __builtin_amdgcn_fence(__ATOMIC_ACQUIRE, "agent");
            asm volatile("s_waitcnt vmcnt(0)" ::: "memory");
        }
    }
    __syncthreads();
}
struct Frame {
    LAS unsigned char* lds;
    int wave, G, bid;
    float* out; unsigned char* ws;
};
#define WSP(T, off) ((T*)(F.ws + (off)))

__device__ __forceinline__ void p0_transpose_item(const float* W, int K, int ldw, int nblk, int thr, int shift, bf16* WT, LAS float* scr, int item, int lane) {
    const int kb = item / nblk, nb = item % nblk, k0 = 64 * kb, n0 = 32 * nb, ns = n0 + (n0 >= thr ? shift : 0);
#pragma unroll 8
    for (int i = 0; i < 32; ++i) { const int kk = 2 * i + (lane >> 5); scr[kk * 33 + (lane & 31)] = W[(size_t)(k0 + kk) * ldw + ns + (lane & 31)]; }
    LDS_WAIT(); asm volatile("" ::: "memory");
    const int c = lane & 7;
#pragma unroll
    for (int j = 0; j < 4; ++j) { const int n = (lane >> 3) + 8 * j; const LAS float* s = scr + (8 * c) * 33 + n;
        v4u o; o.x = pk2(s[0 * 33], s[1 * 33]); o.y = pk2(s[2 * 33], s[3 * 33]); o.z = pk2(s[4 * 33], s[5 * 33]); o.w = pk2(s[6 * 33], s[7 * 33]);
        *(GAS v4u*)(WT + (size_t)(n0 + n) * K + k0 + 8 * c) = o; }
    LDS_WAIT(); asm volatile("" ::: "memory");
}
__device__ __forceinline__ void cvt_f32_bf16_stream(const float* src, bf16* dst, size_t n8, size_t gtid, size_t gthreads) {
    for (size_t i = gtid; i < n8; i += gthreads) {
        const f32x4 a = *(const GAS f32x4*)(src + i * 8), b = *(const GAS f32x4*)(src + i * 8 + 4);
        v4u o; o.x = pk2(a.x, a.y); o.y = pk2(a.z, a.w); o.z = pk2(b.x, b.y); o.w = pk2(b.z, b.w);
        *(GAS v4u*)(dst + i * 8) = o; }
}
__device__ __forceinline__ void i8_row(const float* src_row, unsigned char* dst  , float* scale  , int er, int lane) {
    const float* r = src_row + 16 * lane;
    float x[16];
#pragma unroll
    for (int q4 = 0; q4 < 4; ++q4) { const f32x4 a = *(const GAS f32x4*)(r + 4 * q4); x[4 * q4] = a.x; x[4 * q4 + 1] = a.y; x[4 * q4 + 2] = a.z; x[4 * q4 + 3] = a.w; }
    float am = 0.f;
#pragma unroll
    for (int i = 0; i < 16; ++i) am = fmaxf(am, fabsf(x[i]));
    am = wave_max(am);
    const float inv = am > 1e-30f ? 127.f / am : 0.f;
    unsigned wd[4];
#pragma unroll
    for (int q4 = 0; q4 < 4; ++q4) { unsigned w = 0;
#pragma unroll
        for (int e = 0; e < 4; ++e) { const int qv = (int)rintf(x[4 * q4 + e] * inv); w |= ((unsigned)qv & 0xffu) << (8 * e); }
        wd[q4] = w; }
    v4u o; o.x = wd[0]; o.y = wd[1]; o.z = wd[2]; o.w = wd[3];
    *(GAS v4u*)(dst + ((size_t)((lane >> 3) * 16384 + er)) * 128 + 16 * (lane & 7)) = o;
    if (lane == 0) scale[er] = am * (1.f / 127.f);
}
__device__ __forceinline__ void i8_chunk(Frame& F, const Args& A, int layer, int c) {
    const int tbl = c >> 8, row0 = (c & 255) * 64 + F.wave * 8;
    const float* src = A.in[22 + tbl] + (size_t)layer * 16384 * 1024;
    unsigned char* dst = F.ws + (tbl ? WS_VB : WS_UB) + (size_t)layer * 8 * 16384 * 128;
    float* sc = WSP(float, tbl ? WS_ISV : WS_ISU) + layer * 16384;
    for (int i = 0; i < 8; ++i) i8_row(src + (size_t)(row0 + i) * 1024, dst, sc, row0 + i, ((int)(threadIdx.x & 63u)));
}
__device__ __forceinline__ void p0_prologue(Frame& F, const Args& A) {
    {
        const float* c = A.in[1]; const float* aw = A.in[2]; const float* ab = A.in[3]; float* MOD = WSP(float, WS_MOD);
        LAS float* red = (LAS float*)F.lds;
        for (int item = F.bid; item < 192; item += F.G) {
            const int l = item / 96, n0 = (item % 96) * 64;
            float acc[4] = {0.f, 0.f, 0.f, 0.f};
            const int kbeg = F.wave * 128;
#pragma unroll 4
            for (int k = kbeg; k < kbeg + 128; ++k) {
                const float wv = aw[((size_t)l * 1024 + k) * 6144 + n0 + ((int)(threadIdx.x & 63u))];
#pragma unroll
                for (int b = 0; b < 4; ++b) acc[b] += silu_f(c[b * 1024 + k]) * wv;
            }
#pragma unroll
            for (int b = 0; b < 4; ++b) red[(F.wave * 4 + b) * 64 + ((int)(threadIdx.x & 63u))] = acc[b];
            __syncthreads();
            if (((int)threadIdx.x) < 256) { const int b = ((int)threadIdx.x) >> 6, ln = ((int)threadIdx.x) & 63; float s = ab[l * 6144 + n0 + ln];
#pragma unroll
                for (int w = 0; w < 8; ++w) s += red[(w * 4 + b) * 64 + ln];
                MOD[(size_t)(l * 4 + b) * 6144 + n0 + ln] = s; }
            __syncthreads();
        }
    }
    if (F.bid == 0) {
        LAS unsigned* hist = (LAS unsigned*)F.lds;
        unsigned short* ORD = WSP(unsigned short, WS_ORD);
        for (int pass = 0; pass < 2; ++pass) {
            const int nunits = pass == 0 ? 2048 : 1024;
            if (((int)threadIdx.x) < 160) hist[((int)threadIdx.x)] = 0u;
            __syncthreads();
            for (int u = ((int)threadIdx.x); u < nunits; u += NTHR) {
                const int q = pass == 0 ? (u & 63) : (u & 31), h = pass == 0 ? ((u >> 6) & 7) : ((u >> 5) & 7);
                const float dcut = 46.f * (float)(2 << h);
                int cost;
                if (pass == 0) { const int nt = 2 * q + 2; int lo = (int)ceilf(((float)(q * 128) - dcut - 63.f) * (1.f / 64.f)); if (lo < 0) lo = 0; cost = nt - lo; }
                else { int lo = (int)ceilf(((float)(q * 256) - dcut - 255.f) * (1.f / 256.f)); if (lo < 0) lo = 0; int nb = q - lo; if (nb > 3 * 8) nb = 24; cost = 4 * (nb + 1); }
                if (cost > 159) cost = 159;
                atomicAdd((unsigned*)(hist + (159 - cost)), 1u);
            }
            __syncthreads();
            if (((int)threadIdx.x) == 0) { unsigned acc = 0; for (int i = 0; i < 160; ++i) { const unsigned c = hist[i]; hist[i] = acc; acc += c; } }
            __syncthreads();
            for (int u = ((int)threadIdx.x); u < nunits; u += NTHR) {
                const int q = pass == 0 ? (u & 63) : (u & 31), h = pass == 0 ? ((u >> 6) & 7) : ((u >> 5) & 7);
                const float dcut = 46.f * (float)(2 << h);
                int cost;
                if (pass == 0) { const int nt = 2 * q + 2; int lo = (int)ceilf(((float)(q * 128) - dcut - 63.f) * (1.f / 64.f)); if (lo < 0) lo = 0; cost = nt - lo; }
                else { int lo = (int)ceilf(((float)(q * 256) - dcut - 255.f) * (1.f / 256.f)); if (lo < 0) lo = 0; int nb = q - lo; if (nb > 3 * 8) nb = 24; cost = 4 * (nb + 1); }
                if (cost > 159) cost = 159;
                const unsigned pos = atomicAdd((unsigned*)(hist + (159 - cost)), 1u);
                ORD[(pass == 0 ? 0 : 2048) + pos] = (unsigned short)u;
            }
            __syncthreads();
        }
    }
    {
        LAS float* scr = (LAS float*)(F.lds + F.wave * 8704);
        const int gw = F.bid * NWAVES + F.wave, NGW = F.G * NWAVES;
        constexpr int I_IN0 = 16 * (NZ0 / 32), I_OUT = 16 * 32, I_IN1 = 16 * (NZ1 / 32), I_Q = 16 * (NQ / 32);
        constexpr int NITEMS = I_IN0 + 2 * I_OUT + I_IN1 + 2 * I_Q;
        for (int it = gw; it < NITEMS; it += NGW) {
            int r = it;
            if (r < I_IN0) { p0_transpose_item(A.in[6], D, SRC_IN0, NZ0 / 32, 2048, 8, WSP(bf16, WS_WIN0), scr, r, ((int)(threadIdx.x & 63u))); continue; } r -= I_IN0;
            if (r < I_OUT) { p0_transpose_item(A.in[13], D, D, 32, 1 << 30, 0, WSP(bf16, WS_WOUT0), scr, r, ((int)(threadIdx.x & 63u))); continue; } r -= I_OUT;
            if (r < I_IN1) { p0_transpose_item(A.in[14], D, NZ1, NZ1 / 32, 1 << 30, 0, WSP(bf16, WS_WIN1), scr, r, ((int)(threadIdx.x & 63u))); continue; } r -= I_IN1;
            if (r < I_OUT) { p0_transpose_item(A.in[19], D, D, 32, 1 << 30, 0, WSP(bf16, WS_WOUT1), scr, r, ((int)(threadIdx.x & 63u))); continue; } r -= I_OUT;
            if (r < I_Q) { p0_transpose_item(A.in[20], D, NQ, NQ / 32, 1 << 30, 0, WSP(bf16, WS_WQ), scr, r, ((int)(threadIdx.x & 63u))); continue; } r -= I_Q;
            p0_transpose_item(A.in[20] + (size_t)D * NQ, D, NQ, NQ / 32, 1 << 30, 0, WSP(bf16, WS_WQ) + (size_t)NQ * D, scr, r, ((int)(threadIdx.x & 63u)));
        }
    }
    {
        const size_t gtid = (size_t)F.bid * NTHR + ((int)threadIdx.x), gth = (size_t)F.G * NTHR;
        cvt_f32_bf16_stream(A.in[21], WSP(bf16, WS_KEYS), (size_t)2 * 2 * 128 * 128 / 8, gtid, gth);
    }
}

template <bool GATES>
__device__ __forceinline__ void norm_pass(Frame& F, const Args& A, const float* X, const float* g, const float* mod, int shc, bf16* XN) {
    LAS float* wgT = (LAS float*)F.lds;
    if (GATES) {
        const float* win = A.in[6];
        for (int i = ((int)threadIdx.x); i < 8 * 1024; i += NTHR) { const int cg = i >> 10, k = i & 1023; wgT[i] = win[(size_t)k * SRC_IN0 + 2048 + cg]; }
        __syncthreads();
    }
    const int gw = F.bid * NWAVES + F.wave, NGW = F.G * NWAVES;
    for (int row = gw; row < M; row += NGW) {
        const int b = row >> 13;
        const GAS f32x4* xr = (const GAS f32x4*)(X + (size_t)row * D) + ((int)(threadIdx.x & 63u));
        f32x4 v[4]; float ss = 0.f;
#pragma unroll
        for (int j = 0; j < 4; ++j) { v[j] = xr[64 * j]; ss += (v[j].x * v[j].x + v[j].y * v[j].y) + (v[j].z * v[j].z + v[j].w * v[j].w); }
        const float rstd = rsqrtf(wave_sum(ss) * (1.f / D) + EPS);
        const float* shp = mod + (size_t)b * 6144 + shc * 1024; const float* scp = shp + 1024;
#pragma unroll
        for (int j = 0; j < 4; ++j) { const int c = 4 * ((int)(threadIdx.x & 63u)) + 256 * j;
            const f32x4 gg = *(const f32x4*)(g + c), sc = *(const f32x4*)(scp + c), sh = *(const f32x4*)(shp + c);
            v[j] = v[j] * rstd * gg * (sc + 1.f) + sh;
            v2u o; o.x = pk2(v[j].x, v[j].y); o.y = pk2(v[j].z, v[j].w);
            *(GAS v2u*)(XN + (size_t)row * D + c) = o; }
        if (GATES) {
            float* GT = WSP(float, WS_GATES);
#pragma unroll
            for (int cg = 0; cg < 8; ++cg) { float p = 0.f;
#pragma unroll
                for (int j = 0; j < 4; ++j) { const f32x4 w = *(const LAS f32x4*)(wgT + cg * 1024 + 4 * ((int)(threadIdx.x & 63u)) + 256 * j); p += (v[j].x * w.x + v[j].y * w.y) + (v[j].z * w.z + v[j].w * w.w); }
                p = wave_sum(p);
                if (((int)(threadIdx.x & 63u)) == 0) GT[(size_t)row * 8 + cg] = p + (cg < 4 ? A.in[8][cg] : A.in[9][cg - 4]); }
        }
    }
}

__device__ __forceinline__ void qknorm_unit(Frame& F, bf16* Z, int ldz, int row0, int col0, const float* g, float gmul, float* kmean  ) {
    const int c = col0 + 8 * ((int)(threadIdx.x & 63u)), d0 = (8 * ((int)(threadIdx.x & 63u))) & 63;
    float gv[8];
#pragma unroll
    for (int i = 0; i < 8; ++i) gv[i] = g[d0 + i] * gmul;
    float ks[8] = {0.f, 0.f, 0.f, 0.f, 0.f, 0.f, 0.f, 0.f};
    for (int r = 0; r < 32; ++r) {
        bf16* p = Z + (size_t)(row0 + F.wave * 32 + r) * ldz + c;
        const v4u w = *(const GAS v4u*)p;
        float x[8] = {bflo(w.x), bfhi(w.x), bflo(w.y), bfhi(w.y), bflo(w.z), bfhi(w.z), bflo(w.w), bfhi(w.w)};
        float ss = 0.f;
#pragma unroll
        for (int i = 0; i < 8; ++i) ss += x[i] * x[i];
        ss += __shfl_xor(ss, 1); ss += __shfl_xor(ss, 2); ss += __shfl_xor(ss, 4);
        const float rstd = rsqrtf(ss * (1.f / 64.f) + EPS);
#pragma unroll
        for (int i = 0; i < 8; ++i) { x[i] = x[i] * rstd * gv[i]; ks[i] += x[i]; }
        v4u o; o.x = pk2(x[0], x[1]); o.y = pk2(x[2], x[3]); o.z = pk2(x[4], x[5]); o.w = pk2(x[6], x[7]);
        *(GAS v4u*)p = o;
    }
    if (kmean) {
        LAS float* red = (LAS float*)F.lds;
#pragma unroll
        for (int i = 0; i < 8; ++i) red[F.wave * 512 + 8 * ((int)(threadIdx.x & 63u)) + i] = ks[i];
        __syncthreads();
        { float s = 0.f;
#pragma unroll
          for (int w = 0; w < 8; ++w) s += red[w * 512 + ((int)threadIdx.x)];
          kmean[(size_t)(((int)threadIdx.x) >> 6) * (32 * 64) + (((int)threadIdx.x) & 63)] = s * (1.f / 256.f); }
        __syncthreads();
    }
}

__device__ __forceinline__ void kmean_unit(Frame& F, const bf16* Z, int ldz, int row0, int col0, float* kmean) {
    const int c = col0 + 8 * ((int)(threadIdx.x & 63u));
    float ks[8] = {0.f, 0.f, 0.f, 0.f, 0.f, 0.f, 0.f, 0.f};
#pragma unroll 4
    for (int r = 0; r < 32; ++r) {
        const v4u w = *(const GAS v4u*)(Z + (size_t)(row0 + F.wave * 32 + r) * ldz + c);
        ks[0] += bflo(w.x); ks[1] += bfhi(w.x); ks[2] += bflo(w.y); ks[3] += bfhi(w.y); ks[4] += bflo(w.z); ks[5] += bfhi(w.z); ks[6] += bflo(w.w); ks[7] += bfhi(w.w);
    }
    LAS float* red = (LAS float*)F.lds;
#pragma unroll
    for (int i = 0; i < 8; ++i) red[F.wave * 512 + 8 * ((int)(threadIdx.x & 63u)) + i] = ks[i];
    __syncthreads();
    { float s = 0.f;
#pragma unroll
      for (int w = 0; w < 8; ++w) s += red[w * 512 + ((int)threadIdx.x)];
      kmean[(size_t)(((int)threadIdx.x) >> 6) * (32 * 64) + (((int)threadIdx.x) & 63)] = s * (1.f / 256.f); }
    __syncthreads();
}

constexpr int KSTRB = 144;
template <int DV> struct VStr { static constexpr int B = (DV == 64) ? 192 : 320; };
typedef short v4i16_t __attribute__((ext_vector_type(4)));
__device__ __forceinline__ s16x4 vtr(const LAS unsigned char* p) { return __builtin_bit_cast(s16x4, __builtin_amdgcn_ds_read_tr16_b64_v4i16((LAS v4i16_t*)p)); }
__device__ __forceinline__ unsigned cvtpk(float lo, float hi) { typedef float f2 __attribute__((ext_vector_type(2))); typedef __bf16 b2 __attribute__((ext_vector_type(2)));
    f2 v = {lo, hi}; b2 b = __builtin_convertvector(v, b2); return __builtin_bit_cast(unsigned, b); }
__device__ __forceinline__ float xhalf(float v) {
    auto rr = __builtin_amdgcn_permlane32_swap(__builtin_bit_cast(unsigned, v), __builtin_bit_cast(unsigned, v), false, false);
    const unsigned r0 = rr[0], r1 = rr[1]; return u2f((threadIdx.x & 32) ? r0 : r1);
}
template <int DV> struct AttnSt { f32x16 o[DV / 32]; float m, l; };
template <int DV> __device__ __forceinline__ void attn_init(AttnSt<DV>& st) {
#pragma unroll
    for (int t = 0; t < DV / 32; ++t)
#pragma unroll
        for (int r = 0; r < 16; ++r) st.o[t][r] = 0.f;
    st.m = -1e30f; st.l = 0.f;
}
template <int DV>
__device__ __forceinline__ void attn_qk(AttnSt<DV>& st, const LAS unsigned char* Kt, const bf16x8 (&qf)[4], float sl2, int tq, int kt0, bool diag, bool rowok, int lane, bf16x8 (&pf)[2][2]) {
    const int r32 = lane & 31, hi = lane >> 5;
    const int kb = kt0 + 4 * hi;
    const float c0 = -sl2 * (float)(tq - kb);
    f32x16 s0, s1;
#pragma unroll
    for (int r = 0; r < 16; ++r) { const int ko = (r & 3) + 8 * (r >> 2); s0[r] = c0 + sl2 * (float)ko; s1[r] = c0 + sl2 * (float)(ko + 32); }
    const LAS unsigned char* kp = Kt + r32 * KSTRB + hi * 16;
#pragma unroll
    for (int ks = 0; ks < 4; ++ks) {
        const bf16x8 k0 = *(const LAS bf16x8*)(kp + ks * 32), k1 = *(const LAS bf16x8*)(kp + 32 * KSTRB + ks * 32);
        s0 = __builtin_amdgcn_mfma_f32_32x32x16_bf16(k0, qf[ks], s0, 0, 0, 0);
        s1 = __builtin_amdgcn_mfma_f32_32x32x16_bf16(k1, qf[ks], s1, 0, 0, 0);
    }
    if (diag || !rowok) {
#pragma unroll
        for (int r = 0; r < 16; ++r) { const int ko = (r & 3) + 8 * (r >> 2);
            if (!rowok || kb + ko > tq) s0[r] = -INFINITY;
            if (!rowok || kb + ko + 32 > tq) s1[r] = -INFINITY; }
    }
    float mx = fmaxf(s0[0], s1[0]);
#pragma unroll
    for (int r = 1; r < 16; ++r) mx = fmaxf(mx, fmaxf(s0[r], s1[r]));
    mx = fmaxf(mx, xhalf(mx));
    if (__any(mx > st.m)) {
        const float mn = fmaxf(st.m, mx);
        const float alpha = __builtin_amdgcn_exp2f(st.m - mn);
        st.m = mn; st.l *= alpha;
#pragma unroll
        for (int t = 0; t < DV / 32; ++t)
#pragma unroll
            for (int r = 0; r < 16; ++r) st.o[t][r] *= alpha;
    }
    const float mn = st.m;
    float ps = 0.f;
#pragma unroll
    for (int r = 0; r < 16; ++r) { s0[r] = __builtin_amdgcn_exp2f(s0[r] - mn); s1[r] = __builtin_amdgcn_exp2f(s1[r] - mn); ps += s0[r] + s1[r]; }
    st.l += ps;
#pragma unroll
    for (int s = 0; s < 2; ++s) {
        v4u a, b;
        a.x = cvtpk(s0[8 * s + 0], s0[8 * s + 1]); a.y = cvtpk(s0[8 * s + 2], s0[8 * s + 3]); a.z = cvtpk(s0[8 * s + 4], s0[8 * s + 5]); a.w = cvtpk(s0[8 * s + 6], s0[8 * s + 7]);
        b.x = cvtpk(s1[8 * s + 0], s1[8 * s + 1]); b.y = cvtpk(s1[8 * s + 2], s1[8 * s + 3]); b.z = cvtpk(s1[8 * s + 4], s1[8 * s + 5]); b.w = cvtpk(s1[8 * s + 6], s1[8 * s + 7]);
        pf[0][s] = __builtin_bit_cast(bf16x8, a); pf[1][s] = __builtin_bit_cast(bf16x8, b);
    }
}
template <int DV>
__device__ __forceinline__ void attn_pv(AttnSt<DV>& st, const LAS unsigned char* Vt, const bf16x8 (&pf)[2][2], int lane) {
    constexpr int VS = VStr<DV>::B;
    const int g = lane >> 4, i16 = lane & 15;
    const LAS unsigned char* vp = Vt + (4 * (g >> 1) + (i16 >> 2)) * VS + (16 * (g & 1) + 4 * (i16 & 3)) * 2;
#pragma unroll
    for (int kbk = 0; kbk < 2; ++kbk)
#pragma unroll
        for (int s = 0; s < 2; ++s)
#pragma unroll
            for (int t = 0; t < DV / 32; ++t) {
                const s16x4 lo = vtr(vp + (kbk * 32 + 16 * s) * VS + t * 64), h8 = vtr(vp + (kbk * 32 + 16 * s + 8) * VS + t * 64);
                const bf16x8 va = {lo[0], lo[1], lo[2], lo[3], h8[0], h8[1], h8[2], h8[3]};
                st.o[t] = __builtin_amdgcn_mfma_f32_32x32x16_bf16(va, pf[kbk][s], st.o[t], 0, 0, 0);
            }
}
template <int DV>
__device__ __forceinline__ void attn_tile(AttnSt<DV>& st, const LAS unsigned char* Kt, const LAS unsigned char* Vt, const bf16x8 (&qf)[4], float sc2, float sl2, int tq, int kt0, bool diag, bool rowok, int lane) {
    bf16x8 pf[2][2];
    attn_qk<DV>(st, Kt, qf, sl2, tq, kt0, diag, rowok, lane, pf);
    attn_pv<DV>(st, Vt, pf, lane);
}
template <int NK, int DV> struct TileRegs { v4u k[NK]; v4u v[DV / 64]; };
template <int NK, int DV>
__device__ __forceinline__ void tile_load(TileRegs<NK, DV>& R, const bf16* Z, int ldz, size_t zrow0, int kcol, int vcol, int tid) {
#pragma unroll
    for (int i = 0; i < NK; ++i) { const int ch = tid + 512 * i; const int row = ch / (8 * NK), cc = ch % (8 * NK);
        R.k[i] = *(const GAS v4u*)(Z + (zrow0 + row) * ldz + kcol + cc * 8); }
#pragma unroll
    for (int i = 0; i < DV / 64; ++i) { const int ch = tid + 512 * i; const int row = ch / (DV / 8), cc = ch % (DV / 8);
        R.v[i] = *(const GAS v4u*)(Z + (zrow0 + row) * ldz + vcol + cc * 8); }
}
template <int NK, int DV>
__device__ __forceinline__ void tile_store(const TileRegs<NK, DV>& R, LAS unsigned char* Kt  , LAS unsigned char* Vt, int tid) {
#pragma unroll
    for (int i = 0; i < NK; ++i) { const int ch = tid + 512 * i; const int row = ch / (8 * NK), cc = ch % (8 * NK);
        *(LAS v4u*)(Kt + (cc >> 3) * (64 * KSTRB) + row * KSTRB + (cc & 7) * 16) = R.k[i]; }
#pragma unroll
    for (int i = 0; i < DV / 64; ++i) { const int ch = tid + 512 * i; const int row = ch / (DV / 8), cc = ch % (DV / 8);
        *(LAS v4u*)(Vt + row * VStr<DV>::B + cc * 16) = R.v[i]; }
}
__device__ __forceinline__ void moba_unit(Frame& F, int b, int h, int j, float tcut  ) {
    const bf16* Z = WSP(bf16, WS_Z); constexpr int ldz = NZ0;
    const int lane = ((int)(threadIdx.x & 63u)), w = F.wave, r32 = lane & 31, hi = lane >> 5, tid = ((int)threadIdx.x);
    const size_t rowb = (size_t)b * SEQ;
    const int qpos = j * 256 + w * 32 + r32;
    const int qcol = 2048 + h * 64, kcol = 2560 + h * 64, vcol = 3072 + h * 64;
    LAS unsigned char* lds = F.lds;
    constexpr int BUFB = 64 * KSTRB + 64 * VStr<64>::B;
    LAS unsigned char* kmh = lds + 2 * BUFB;
    LAS unsigned char* kml = lds + 2 * BUFB + 32 * KSTRB;
    LAS unsigned* msk = (LAS unsigned*)(lds + 2 * BUFB + 64 * KSTRB);
    { const float* KM = WSP(float, WS_KMEAN) + (size_t)((b * 8 + h) * 32) * 64; const f32x4 x = *(const f32x4*)(KM + 4 * tid);
      const int n = tid >> 4, d0 = (tid & 15) * 4;
      const unsigned h0 = f2bf(x.x), h1 = f2bf(x.y), h2 = f2bf(x.z), h3 = f2bf(x.w);
      v2u hv; hv.x = h0 | (h1 << 16); hv.y = h2 | (h3 << 16);
      v2u lv; lv.x = pk2(x.x - u2f(h0 << 16), x.y - u2f(h1 << 16)); lv.y = pk2(x.z - u2f(h2 << 16), x.w - u2f(h3 << 16));
      *(LAS v2u*)(kmh + n * KSTRB + d0 * 2) = hv; *(LAS v2u*)(kml + n * KSTRB + d0 * 2) = lv; }
    if (tid < 16) msk[tid] = 0u;
    bf16x8 qf[4];
    const bf16* qrow = Z + (rowb + qpos) * ldz + qcol;
#pragma unroll
    for (int ks = 0; ks < 4; ++ks) qf[ks] = *(const GAS bf16x8*)(qrow + 16 * ks + 8 * hi);
    __syncthreads();
    f32x16 gt;
#pragma unroll
    for (int r = 0; r < 16; ++r) gt[r] = 0.f;
#pragma unroll
    for (int ks = 0; ks < 4; ++ks) {
        const bf16x8 a = *(const LAS bf16x8*)(kmh + r32 * KSTRB + hi * 16 + ks * 32), c = *(const LAS bf16x8*)(kml + r32 * KSTRB + hi * 16 + ks * 32);
        gt = __builtin_amdgcn_mfma_f32_32x32x16_bf16(a, qf[ks], gt, 0, 0, 0);
        gt = __builtin_amdgcn_mfma_f32_32x32x16_bf16(c, qf[ks], gt, 0, 0, 0);
    }
    float t0 = -INFINITY, t1 = -INFINITY, t2 = -INFINITY;
#define INS3(key) do { float k_ = (key); float a_ = fmaxf(t0, k_), l_ = fminf(t0, k_); t0 = a_; a_ = fmaxf(t1, l_); l_ = fminf(t1, l_); t1 = a_; t2 = fmaxf(t2, l_); } while (0)
#pragma unroll
    for (int r = 0; r < 16; ++r) { const int n = (r & 3) + 8 * (r >> 2) + 4 * hi;
        const float key = (n < j) ? u2f((f2u(gt[r]) & ~31u) | (unsigned)n) : -INFINITY; INS3(key); }
    { const float p0 = xhalf(t0), p1 = xhalf(t1), p2 = xhalf(t2); INS3(p0); INS3(p1); INS3(p2); }
#undef INS3
    const int sel0 = (t0 > -INFINITY) ? (int)(f2u(t0) & 31u) : -1;
    const int sel1 = (t1 > -INFINITY) ? (int)(f2u(t1) & 31u) : -1;
    const int sel2 = (t2 > -INFINITY) ? (int)(f2u(t2) & 31u) : -1;
    { const unsigned mm = (sel0 >= 0 ? 1u << sel0 : 0u) | (sel1 >= 0 ? 1u << sel1 : 0u) | (sel2 >= 0 ? 1u << sel2 : 0u);
      if (mm) { __hip_atomic_fetch_or(msk + w, mm, __ATOMIC_RELAXED, __HIP_MEMORY_SCOPE_WORKGROUP); __hip_atomic_fetch_or(msk + 8, mm, __ATOMIC_RELAXED, __HIP_MEMORY_SCOPE_WORKGROUP); } }
    __syncthreads();
    const float slope = ldexpf(1.f, -(h + 1)), dcut = tcut / slope;
    const float sl2 = slope * LOG2E, sc2 = 0.125f * LOG2E;
    int nlo = (int)ceilf(((float)(j * 256) - dcut - 255.f) * (1.f / 256.f)); if (nlo < 0) nlo = 0;
    const unsigned keep = nlo >= 32 ? 0u : (0xffffffffu << nlo);
    const unsigned bmask = msk[8] & keep; const unsigned wmask = (unsigned)__builtin_amdgcn_readfirstlane((int)msk[w]) & keep;
    AttnSt<64> st; attn_init<64>(st);
    unsigned rem = bmask;
    int blk = j, kt = 3, buf = 0;
    TileRegs<1, 64> R;
    tile_load<1, 64>(R, Z, ldz, rowb + blk * 256 + kt * 64, kcol, vcol, tid);
    tile_store<1, 64>(R, lds, lds + 64 * KSTRB, tid);
    __syncthreads();
    for (;;) {
        int nblk = blk, nkt = kt - 1; bool has_next = true;
        if (nkt < 0) { nkt = 3; if (rem) { nblk = 31 - __builtin_clz(rem); rem &= ~(1u << nblk); } else has_next = false; }
        if (has_next) tile_load<1, 64>(R, Z, ldz, rowb + nblk * 256 + nkt * 64, kcol, vcol, tid);
        const bool own = (blk == j);
        const bool active = (own ? (kt * 64 <= w * 32 + 31) : (((wmask >> blk) & 1u) != 0u)) && ((float)(j * 256 + w * 32 - (blk * 256 + kt * 64 + 63)) <= dcut);
        if (active) {
            const bool rowok = own || blk == sel0 || blk == sel1 || blk == sel2;
            const bool diag = own && (kt * 64 + 63 > w * 32);
            attn_tile<64>(st, lds + buf * BUFB, lds + buf * BUFB + 64 * KSTRB, qf, sc2, sl2, qpos, blk * 256 + kt * 64, diag, rowok, lane);
        }
        if (!has_next) break;
        tile_store<1, 64>(R, lds + (buf ^ 1) * BUFB, lds + (buf ^ 1) * BUFB + 64 * KSTRB, tid);
        __syncthreads();
        buf ^= 1; blk = nblk; kt = nkt;
    }
    const float inv = 1.f / (st.l + xhalf(st.l));
    bf16* Y = WSP(bf16, WS_XNY) + (rowb + qpos) * 1024 + 512 + h * 64;
#pragma unroll
    for (int t = 0; t < 2; ++t)
#pragma unroll
        for (int rg = 0; rg < 4; ++rg) { v2u o; o.x = pk2(st.o[t][4 * rg] * inv, st.o[t][4 * rg + 1] * inv); o.y = pk2(st.o[t][4 * rg + 2] * inv, st.o[t][4 * rg + 3] * inv);
            *(GAS v2u*)(Y + t * 32 + 8 * rg + 4 * hi) = o; }
    __syncthreads();
}

__device__ __forceinline__ void diff_unit(Frame& F, const Args& A, int b, int h, int qt, float lam, float tcut, const int probe) {
    (void)probe;
    const bf16* Z = WSP(bf16, WS_Z); constexpr int ldz = NZ1;
    const int lane = ((int)(threadIdx.x & 63u)), w = F.wave, r32 = lane & 31, hi = lane >> 5, tid = ((int)threadIdx.x);
    const int comp = w >> 2, wq = w & 3;
    const size_t rowb = (size_t)b * SEQ;
    const int q0 = qt * 128, qpos = q0 + wq * 32 + r32;
    const int qcol = h * 128 + comp * 64, kcol = 1024 + h * 128, vcol = 2048 + h * 128;
    LAS unsigned char* lds = F.lds;
    constexpr int BUFB = 2 * 64 * KSTRB + 64 * VStr<128>::B;
    bf16x8 qf[4];
    const bf16* qrow = Z + (rowb + qpos) * ldz + qcol;
#pragma unroll
    for (int ks = 0; ks < 4; ++ks) qf[ks] = *(const GAS bf16x8*)(qrow + 16 * ks + 8 * hi);
    const float slope = ldexpf(1.f, -(h + 1)), dcut = tcut / slope;
    const float sl2 = slope * LOG2E, sc2 = 0.125f * LOG2E;
    AttnSt<128> st; attn_init<128>(st);
    const int nt = (q0 + 128) / 64;
    int kt_lo = (int)ceilf(((float)q0 - dcut - 63.f) * (1.f / 64.f)); if (kt_lo < 0) kt_lo = 0;
    TileRegs<2, 128> R;
    tile_load<2, 128>(R, Z, ldz, rowb + (size_t)(nt - 1) * 64, kcol, vcol, tid);
    tile_store<2, 128>(R, lds, lds + 2 * 64 * KSTRB, tid);
    __syncthreads();
    int buf = 0;
    for (int kt = nt - 1; kt >= kt_lo; --kt) {
        const bool has_next = kt > kt_lo;
        if (has_next) tile_load<2, 128>(R, Z, ldz, rowb + (size_t)(kt - 1) * 64, kcol, vcol, tid);
        if (kt * 64 <= q0 + wq * 32 + 31) {
            const bool diag = kt * 64 + 63 > q0 + wq * 32;
            attn_tile<128>(st, lds + buf * BUFB + comp * (64 * KSTRB), lds + buf * BUFB + 2 * 64 * KSTRB, qf, sc2, sl2, qpos, kt * 64, diag, true, lane);
        }
        if (has_next) { tile_store<2, 128>(R, lds + (buf ^ 1) * BUFB, lds + (buf ^ 1) * BUFB + 2 * 64 * KSTRB, tid); }
        __syncthreads();
        buf ^= 1;
    }
    const float inv = 1.f / (st.l + xhalf(st.l));
    LAS float* o2 = (LAS float*)lds;
    if (comp == 1) {
#pragma unroll
        for (int t = 0; t < 4; ++t)
#pragma unroll
            for (int r = 0; r < 16; ++r) o2[((wq * 4 + t) * 16 + r) * 64 + lane] = st.o[t][r] * inv;
    }
    __syncthreads();
    if (comp == 0) {
        float ss = 0.f;
#pragma unroll
        for (int t = 0; t < 4; ++t)
#pragma unroll
            for (int r = 0; r < 16; ++r) { const float v = st.o[t][r] * inv - lam * o2[((wq * 4 + t) * 16 + r) * 64 + lane]; st.o[t][r] = v; ss += v * v; }
        ss += xhalf(ss);
        const float rs = rsqrtf(ss * (1.f / 128.f) + EPS) * 0.6444909324090307f;
        const float* og = A.in[18];
        bf16* Y = WSP(bf16, WS_XNY) + (rowb + qpos) * 1024 + h * 128;
#pragma unroll
        for (int t = 0; t < 4; ++t)
#pragma unroll
            for (int rg = 0; rg < 4; ++rg) { const int dv = t * 32 + 8 * rg + 4 * hi; const f32x4 gg = *(const f32x4*)(og + dv);
                v2u o; o.x = pk2(st.o[t][4 * rg] * rs * gg.x, st.o[t][4 * rg + 1] * rs * gg.y); o.y = pk2(st.o[t][4 * rg + 2] * rs * gg.z, st.o[t][4 * rg + 3] * rs * gg.w);
                *(GAS v2u*)(Y + dv) = o; }
    }
    __syncthreads();
}
template <int MT, int NT>
__device__ __forceinline__ void mma_nt(const LAS unsigned char* A, int lda, const LAS unsigned char* B, int ldb, int K, f32x4 (&acc)[MT][NT], int lane) {
    const int r = lane & 15, kq = (lane >> 4) * 16;
    for (int k0 = 0; k0 < K; k0 += 32) {
        bf16x8 a[MT], bb[NT];
#pragma unroll
        for (int m = 0; m < MT; ++m) a[m] = *(const LAS bf16x8*)(A + (m * 16 + r) * lda + k0 * 2 + kq);
#pragma unroll
        for (int n = 0; n < NT; ++n) bb[n] = *(const LAS bf16x8*)(B + (n * 16 + r) * ldb + k0 * 2 + kq);
#pragma unroll
        for (int m = 0; m < MT; ++m)
#pragma unroll
            for (int n = 0; n < NT; ++n) acc[m][n] = __builtin_amdgcn_mfma_f32_16x16x32_bf16(a[m], bb[n], acc[m][n], 0, 0, 0);
    }
}
constexpr int TS = 272;
constexpr int TILEB = 128 * TS;
constexpr int ML_Q = 0, ML_K = TILEB, ML_V = 2 * TILEB, ML_SM = 3 * TILEB;

__device__ __forceinline__ void ml_gates(const float* GT, size_t row0, int hm, LAS float* sm, int lane) {
    const float i0 = GT[(row0 + 2 * lane) * 8 + hm], i1 = GT[(row0 + 2 * lane + 1) * 8 + hm];
    const float f0 = logsigmoid_f(GT[(row0 + 2 * lane) * 8 + 4 + hm]), f1 = logsigmoid_f(GT[(row0 + 2 * lane + 1) * 8 + 4 + hm]);
    float s = f0 + f1;
#pragma unroll
    for (int o = 1; o < 64; o <<= 1) { const float t = __shfl_up(s, o); if (lane >= o) s += t; }
    const float excl = s - (f0 + f1);
    sm[2 * lane] = excl + f0; sm[2 * lane + 1] = excl + f0 + f1;
    sm[128 + 2 * lane] = i0; sm[128 + 2 * lane + 1] = i1;
}
template <bool TRANSPOSE>
__device__ __forceinline__ void ml_conv_tile(const bf16* Z, size_t rowb, int t0, int zc, const float* cw, int wc, float mul, LAS unsigned char* dst, const LAS float* rs, int tid) {
#pragma unroll
    for (int it = 0; it < 4; ++it) {
        const int item = tid + 512 * it, l = item >> 4, ch = (item & 15) * 8;
        float acc[8];
#pragma unroll
        for (int i = 0; i < 8; ++i) acc[i] = 0.f;
#pragma unroll
        for (int jj = 0; jj < 4; ++jj) {
            const int t = t0 + l - 3 + jj;
            if (t >= 0) {
                const v4u w = *(const GAS v4u*)(Z + (rowb + t) * NZ0 + zc + ch);
                const float x[8] = {bflo(w.x), bfhi(w.x), bflo(w.y), bfhi(w.y), bflo(w.z), bfhi(w.z), bflo(w.w), bfhi(w.w)};
                const f32x4 c0 = *(const f32x4*)(cw + jj * 1024 + wc + ch), c1 = *(const f32x4*)(cw + jj * 1024 + wc + ch + 4);
                acc[0] += x[0] * c0.x; acc[1] += x[1] * c0.y; acc[2] += x[2] * c0.z; acc[3] += x[3] * c0.w;
                acc[4] += x[4] * c1.x; acc[5] += x[5] * c1.y; acc[6] += x[6] * c1.z; acc[7] += x[7] * c1.w;
            }
        }
        const float sc = TRANSPOSE ? mul * rs[l] : mul;
#pragma unroll
        for (int i = 0; i < 8; ++i) acc[i] = silu_f(acc[i]) * sc;
        if (TRANSPOSE) {
#pragma unroll
            for (int i = 0; i < 8; ++i) *(LAS bf16*)(dst + (ch + i) * TS + l * 2) = (bf16)f2bf(acc[i]);
        } else {
            v4u o; o.x = pk2(acc[0], acc[1]); o.y = pk2(acc[2], acc[3]); o.z = pk2(acc[4], acc[5]); o.w = pk2(acc[6], acc[7]);
            *(LAS v4u*)(dst + l * TS + ch * 2) = o;
        }
    }
}
__device__ __forceinline__ void ml_vt_tile(const bf16* Z, size_t row0, int zc, LAS unsigned char* dst, int tid) {
#pragma unroll
    for (int it = 0; it < 4; ++it) {
        const int item = tid + 512 * it, l = item >> 4, ch = (item & 15) * 8;
        const v4u w = *(const GAS v4u*)(Z + (row0 + l) * NZ0 + zc + ch);
        const unsigned ww[4] = {w.x, w.y, w.z, w.w};
#pragma unroll
        for (int i = 0; i < 4; ++i) { *(LAS bf16*)(dst + (ch + 2 * i) * TS + l * 2) = (bf16)(ww[i] & 0xffffu); *(LAS bf16*)(dst + (ch + 2 * i + 1) * TS + l * 2) = (bf16)(ww[i] >> 16); }
    }
}
__device__ __forceinline__ void mlstm_a_unit(Frame& F, const Args& A, int unit) {
    const int c = unit & 63, bh = unit >> 6, hm = bh & 3, b = bh >> 2;
    const bf16* Z = WSP(bf16, WS_Z); const float* GT = WSP(float, WS_GATES);
    const size_t rowb = (size_t)b * SEQ; const int t0 = c * 128;
    LAS unsigned char* lds = F.lds; LAS float* sm = (LAS float*)(lds + ML_SM);
    if (F.wave == 0) {
        ml_gates(GT, rowb + t0, hm, sm, ((int)(threadIdx.x & 63u)));
        LDS_WAIT();
        const float bend = sm[127];
        const float w0 = bend - sm[2 * ((int)(threadIdx.x & 63u))] + sm[128 + 2 * ((int)(threadIdx.x & 63u))], w1 = bend - sm[2 * ((int)(threadIdx.x & 63u)) + 1] + sm[128 + 2 * ((int)(threadIdx.x & 63u)) + 1];
        const float ml = wave_max(fmaxf(w0, w1));
        sm[256 + 2 * ((int)(threadIdx.x & 63u))] = __expf(w0 - ml); sm[256 + 2 * ((int)(threadIdx.x & 63u)) + 1] = __expf(w1 - ml);
        if (((int)(threadIdx.x & 63u)) == 0) { WSP(float, WS_BEND)[unit] = bend; WSP(float, WS_MLOC)[unit] = ml; }
    }
    __syncthreads();
    ml_conv_tile<true>(Z, rowb, t0, 512 + hm * 128, A.in[7], 512 + hm * 128, 0.08838834764831845f, lds + ML_K, sm + 256, ((int)threadIdx.x));
    ml_vt_tile(Z, rowb + t0, 1024 + hm * 128, lds + ML_V, ((int)threadIdx.x));
    __syncthreads();
    f32x4 acc[2][4];
#pragma unroll
    for (int m = 0; m < 2; ++m)
#pragma unroll
        for (int n = 0; n < 4; ++n) acc[m][n] = (f32x4){0.f, 0.f, 0.f, 0.f};
    const int dv0 = 32 * (F.wave >> 1), dk0 = 64 * (F.wave & 1);
    mma_nt<2, 4>(lds + ML_V + dv0 * TS, TS, lds + ML_K + dk0 * TS, TS, 128, acc, ((int)(threadIdx.x & 63u)));
    float* CL = WSP(float, WS_CLOC) + (size_t)unit * 16384;
#pragma unroll
    for (int m = 0; m < 2; ++m)
#pragma unroll
        for (int n = 0; n < 4; ++n)
#pragma unroll
            for (int i = 0; i < 4; ++i) CL[(size_t)(dv0 + 16 * m + 4 * (((int)(threadIdx.x & 63u)) >> 4) + i) * 128 + dk0 + 16 * n + (((int)(threadIdx.x & 63u)) & 15)] = acc[m][n][i];
    if (((int)threadIdx.x) < 128) { float s = 0.f; const LAS bf16* kr = (const LAS bf16*)(lds + ML_K + ((int)threadIdx.x) * TS);
        for (int l = 0; l < 128; ++l) s += bf2f(kr[l]);
        WSP(float, WS_NLOC)[(size_t)unit * 128 + ((int)threadIdx.x)] = s; }
    __syncthreads();
}
__device__ __forceinline__ void mlstm_scan_unit(Frame& F, int unit) {
    const int bh = unit >> 4, sl = unit & 15;
    LAS float* tab = (LAS float*)F.lds;
    if (((int)threadIdx.x) == 0) {
        const float* BE = WSP(float, WS_BEND) + bh * 64; const float* ML = WSP(float, WS_MLOC) + bh * 64; float* MP = WSP(float, WS_MPREV) + bh * 64;
        float m = 0.f;
        for (int c = 0; c < 64; ++c) { const float be = BE[c], ml = ML[c]; const float mn = fmaxf(be + m, ml);
            tab[c] = __expf(be + m - mn); tab[64 + c] = __expf(ml - mn); if (sl == 0) MP[c] = m; m = mn; }
    }
    __syncthreads();
    float* CL = WSP(float, WS_CLOC) + (size_t)bh * 64 * 16384 + sl * 1024 + 2 * ((int)threadIdx.x);
    float s0 = 0.f, s1 = 0.f;
#pragma unroll 8
    for (int c = 0; c < 64; ++c) { float2* p = (float2*)(CL + (size_t)c * 16384); const float2 v = *p; *p = make_float2(s0, s1);
        const float a = tab[c], sc = tab[64 + c]; s0 = a * s0 + sc * v.x; s1 = a * s1 + sc * v.y; }
    if (sl == 0 && ((int)threadIdx.x) < 128) { float* NL = WSP(float, WS_NLOC) + (size_t)bh * 64 * 128 + ((int)threadIdx.x); float s = 0.f;
        for (int c = 0; c < 64; ++c) { const float v = NL[c * 128]; NL[c * 128] = s; s = tab[c] * s + tab[64 + c] * v; } }
    __syncthreads();
}
__device__ __forceinline__ void mlstm_c_unit(Frame& F, const Args& A, int unit) {
    const int c = unit & 63, bh = unit >> 6, hm = bh & 3, b = bh >> 2;
    const bf16* Z = WSP(bf16, WS_Z); const float* GT = WSP(float, WS_GATES);
    const size_t rowb = (size_t)b * SEQ; const int t0 = c * 128;
    LAS unsigned char* lds = F.lds; LAS float* sm = (LAS float*)(lds + ML_SM);
    const int lane = ((int)(threadIdx.x & 63u)), w = F.wave, tid = ((int)threadIdx.x);
    const float mprev = WSP(float, WS_MPREV)[unit];
    if (w == 0) {
        ml_gates(GT, rowb + t0, hm, sm, lane);
        LDS_WAIT();
        const float b0 = sm[2 * lane], b1 = sm[2 * lane + 1];
        const float g0 = sm[128 + 2 * lane] - b0, g1 = sm[128 + 2 * lane + 1] - b1;
        float pm = fmaxf(g0, g1);
#pragma unroll
        for (int o = 1; o < 64; o <<= 1) { const float t = __shfl_up(pm, o); if (lane >= o) pm = fmaxf(pm, t); }
        float pe = __shfl_up(pm, 1); if (lane == 0) pe = -INFINITY;
        const float M0 = fmaxf(mprev, fmaxf(pe, g0)), M1 = fmaxf(mprev, pm);
        sm[256 + 2 * lane] = g0; sm[256 + 2 * lane + 1] = g1;
        sm[384 + 2 * lane] = M0; sm[384 + 2 * lane + 1] = M1;
        sm[512 + 2 * lane] = __expf(mprev - M0); sm[512 + 2 * lane + 1] = __expf(mprev - M1);
        sm[640 + 2 * lane] = __expf(-b0 - M0); sm[640 + 2 * lane + 1] = __expf(-b1 - M1);
        sm[768 + 2 * lane] = 0.f; sm[768 + 2 * lane + 1] = 0.f; sm[896 + 2 * lane] = 0.f; sm[896 + 2 * lane + 1] = 0.f;
    }
    if (w == 1) { sm[1152 + lane] = WSP(float, WS_NLOC)[(size_t)unit * 128 + lane]; sm[1152 + 64 + lane] = WSP(float, WS_NLOC)[(size_t)unit * 128 + 64 + lane]; }
    ml_conv_tile<false>(Z, rowb, t0, hm * 128, A.in[7], hm * 128, 1.f, lds + ML_Q, nullptr, tid);
    ml_conv_tile<false>(Z, rowb, t0, 512 + hm * 128, A.in[7], 512 + hm * 128, 0.08838834764831845f, lds + ML_K, nullptr, tid);
    ml_vt_tile(Z, rowb + t0, 1024 + hm * 128, lds + ML_V, tid);
    __syncthreads();
    const int l0 = 32 * (w >> 1), c0 = 64 * (w & 1);
    const int lr = 4 * (lane >> 4), lc = lane & 15;
    if (tid < 128) { const LAS bf16* qr = (const LAS bf16*)(lds + ML_Q + tid * TS); float s = 0.f;
        for (int d = 0; d < 128; ++d) s += bf2f(qr[d]) * sm[1152 + d];
        sm[1024 + tid] = s; }
    f32x4 acc[2][4];
#pragma unroll
    for (int m = 0; m < 2; ++m)
#pragma unroll
        for (int n = 0; n < 4; ++n) acc[m][n] = (f32x4){0.f, 0.f, 0.f, 0.f};
    mma_nt<2, 4>(lds + ML_Q + l0 * TS, TS, lds + ML_K + c0 * TS, TS, 128, acc, lane);
#pragma unroll
    for (int m = 0; m < 2; ++m)
#pragma unroll
        for (int i = 0; i < 4; ++i) { const int l = l0 + 16 * m + lr + i; const float Ml = sm[384 + l]; float rsum = 0.f;
#pragma unroll
            for (int n = 0; n < 4; ++n) { const int s = c0 + 16 * n + lc; const float v = (s <= l) ? acc[m][n][i] * __expf(sm[256 + s] - Ml) : 0.f; acc[m][n][i] = v; rsum += v; }
            rsum += __shfl_xor(rsum, 1); rsum += __shfl_xor(rsum, 2); rsum += __shfl_xor(rsum, 4); rsum += __shfl_xor(rsum, 8);
            if (lc == 0) __hip_atomic_fetch_add(sm + 768 + l, rsum, __ATOMIC_RELAXED, __HIP_MEMORY_SCOPE_WORKGROUP); }
    __syncthreads();
#pragma unroll
    for (int m = 0; m < 2; ++m)
#pragma unroll
        for (int n = 0; n < 4; ++n)
#pragma unroll
            for (int i = 0; i < 4; ++i) *(LAS bf16*)(lds + ML_K + (l0 + 16 * m + lr + i) * TS + (c0 + 16 * n + lc) * 2) = (bf16)f2bf(acc[m][n][i]);
    __syncthreads();
    f32x4 ai[2][4], ae[2][4];
#pragma unroll
    for (int m = 0; m < 2; ++m)
#pragma unroll
        for (int n = 0; n < 4; ++n) { ai[m][n] = (f32x4){0.f, 0.f, 0.f, 0.f}; ae[m][n] = (f32x4){0.f, 0.f, 0.f, 0.f}; }
    mma_nt<2, 4>(lds + ML_K + l0 * TS, TS, lds + ML_V + c0 * TS, TS, 128, ai, lane);
    {
        const float* CP = WSP(float, WS_CLOC) + (size_t)unit * 16384;
        const int r = lane & 15, kq = (lane >> 4) * 8;
        for (int k0 = 0; k0 < 128; k0 += 32) {
            bf16x8 a[2], bb[4];
#pragma unroll
            for (int m = 0; m < 2; ++m) a[m] = *(const LAS bf16x8*)(lds + ML_Q + (l0 + m * 16 + r) * TS + (k0 + kq) * 2);
#pragma unroll
            for (int n = 0; n < 4; ++n) { const float* p = CP + (size_t)(c0 + n * 16 + r) * 128 + k0 + kq; const f32x4 x = *(const f32x4*)p, y = *(const f32x4*)(p + 4);
                v4u pk; pk.x = pk2(x.x, x.y); pk.y = pk2(x.z, x.w); pk.z = pk2(y.x, y.y); pk.w = pk2(y.z, y.w); bb[n] = __builtin_bit_cast(bf16x8, pk); }
#pragma unroll
            for (int m = 0; m < 2; ++m)
#pragma unroll
                for (int n = 0; n < 4; ++n) ae[m][n] = __builtin_amdgcn_mfma_f32_16x16x32_bf16(a[m], bb[n], ae[m][n], 0, 0, 0);
        }
    }
#pragma unroll
    for (int m = 0; m < 2; ++m)
#pragma unroll
        for (int i = 0; i < 4; ++i) { const int l = l0 + 16 * m + lr + i; const float wi = sm[512 + l];
            const float den = wi * sm[1024 + l] + sm[768 + l]; const float dinv = 1.f / fmaxf(fabsf(den), sm[640 + l]); float ssq = 0.f;
#pragma unroll
            for (int n = 0; n < 4; ++n) { const float hv = (wi * ae[m][n][i] + ai[m][n][i]) * dinv; ai[m][n][i] = hv; ssq += hv * hv; }
            ssq += __shfl_xor(ssq, 1); ssq += __shfl_xor(ssq, 2); ssq += __shfl_xor(ssq, 4); ssq += __shfl_xor(ssq, 8);
            if (lc == 0) __hip_atomic_fetch_add(sm + 896 + l, ssq, __ATOMIC_RELAXED, __HIP_MEMORY_SCOPE_WORKGROUP); }
    __syncthreads();
    const float* mg = A.in[10] + hm * 128;
    bf16* Y = WSP(bf16, WS_XNY);
#pragma unroll
    for (int m = 0; m < 2; ++m)
#pragma unroll
        for (int i = 0; i < 4; ++i) { const int l = l0 + 16 * m + lr + i; const float rstd = rsqrtf(sm[896 + l] * (1.f / 128.f) + EPS); const size_t row = rowb + t0 + l;
#pragma unroll
            for (int n = 0; n < 4; ++n) { const int dv = c0 + 16 * n + lc; const float og = sigmoid_f(bf2f(Z[row * NZ0 + 1536 + hm * 128 + dv]));
                Y[row * 1024 + hm * 128 + dv] = (bf16)f2bf(ai[m][n][i] * rstd * mg[dv] * og); } }
    __syncthreads();
}
template <int N> __device__ __forceinline__ void bitonic_sort_desc(float (&v)[N]) {
#pragma unroll
    for (int k = 2; k <= N; k <<= 1)
#pragma unroll
        for (int j = k >> 1; j > 0; j >>= 1)
#pragma unroll
            for (int i = 0; i < N; ++i) { const int l = i ^ j; if (l > i) { const bool desc = ((i & k) == 0); const float a = v[i], b = v[l]; const float mx = fmaxf(a, b), mn = fminf(a, b); v[i] = desc ? mx : mn; v[l] = desc ? mn : mx; } }
}
__device__ __forceinline__ void merge_top16(float (&run)[16], const float (&nw)[16]) {
#pragma unroll
    for (int i = 0; i < 16; ++i) run[i] = fmaxf(run[i], nw[15 - i]);
#pragma unroll
    for (int j = 8; j > 0; j >>= 1)
#pragma unroll
        for (int i = 0; i < 16; ++i) { const int l = i ^ j; if (l > i) { const float a = run[i], b = run[l]; run[i] = fmaxf(a, b); run[l] = fminf(a, b); } }
}
#ifndef EXPERT_SLOW
#define EXPERT_SLOW 0
#endif
#ifndef ROUTE_SLOW
#define ROUTE_SLOW 0
#endif
constexpr int SCS = 132;
__device__ __forceinline__ void peer_route_unit(Frame& F, int tok0, int hd, const bf16x8 (&kf)[4][2], const int PROBE) {
    const bf16* QRY = WSP(bf16, WS_QRY); int* IDX = WSP(int, WS_IDX); float* GATE = WSP(float, WS_GATE);
    LAS float* SC = (LAS float*)F.lds;
    const int lane = ((int)(threadIdx.x & 63u)), w = F.wave, tid = ((int)threadIdx.x);
    {
        constexpr int AST = 528;
        LAS unsigned char* As = F.lds;
#pragma unroll
        for (int i = 0; i < 8; ++i) { const int ch = tid + 512 * i, row = ch >> 5, cc = ch & 31;
            *(LAS v4u*)(As + row * AST + cc * 16) = *(const GAS v4u*)(QRY + (size_t)(tok0 + row) * NQ + hd * 256 + cc * 8); }
        __syncthreads();
        const int p = w & 1, nq = w >> 1, r = lane & 15, kq = (lane >> 4) * 16;
        f32x4 acc[8][2];
#pragma unroll
        for (int m = 0; m < 8; ++m) { acc[m][0] = (f32x4){0.f, 0.f, 0.f, 0.f}; acc[m][1] = (f32x4){0.f, 0.f, 0.f, 0.f}; }
#pragma unroll
        for (int ks = 0; ks < 4; ++ks)
#pragma unroll
            for (int m = 0; m < 8; ++m) { const bf16x8 a = *(const LAS bf16x8*)(As + (16 * m + r) * AST + p * 256 + ks * 64 + kq);
                acc[m][0] = __builtin_amdgcn_mfma_f32_16x16x32_bf16(a, kf[ks][0], acc[m][0], 0, 0, 0);
                acc[m][1] = __builtin_amdgcn_mfma_f32_16x16x32_bf16(a, kf[ks][1], acc[m][1], 0, 0, 0); }
        __syncthreads();
#pragma unroll
        for (int m = 0; m < 8; ++m)
#pragma unroll
            for (int n = 0; n < 2; ++n)
#pragma unroll
                for (int i = 0; i < 4; ++i) SC[(p * 128 + 16 * m + 4 * (lane >> 4) + i) * SCS + 32 * nq + 16 * n + r] = acc[m][n][i];
    }
    __syncthreads();
#if defined(CHECK) && CHECK
    if (tok0 == 0 && hd == 0) { float* DB = WSP(float, WS_CLOC) + 8 * 1024 * 1024; for (int i = tid; i < 2 * 128 * 128; i += NTHR) DB[i] = SC[(i >> 7) * SCS + (i & 127)]; }
    __syncthreads();
#endif
#if ROUTE_SLOW
    if (tid < 128) {
        const int t = tid;
        float s0[16], s1[16]; unsigned i0[16], i1[16];
        { const LAS float* row = SC + (0 * 128 + t) * SCS; float prev = INFINITY;
#pragma unroll
          for (int k = 0; k < 16; ++k) { float best = -INFINITY; unsigned bi = 0; for (int n = 0; n < 128; ++n) { const float v = row[n]; if (v < prev && v > best) { best = v; bi = n; } } s0[k] = best; i0[k] = bi; prev = best; } }
        { const LAS float* row = SC + (1 * 128 + t) * SCS; float prev = INFINITY;
#pragma unroll
          for (int k = 0; k < 16; ++k) { float best = -INFINITY; unsigned bi = 0; for (int n = 0; n < 128; ++n) { const float v = row[n]; if (v < prev && v > best) { best = v; bi = n; } } s1[k] = best; i1[k] = bi; prev = best; } }
        float top[16]; unsigned tid16[16];
        { float prev = INFINITY;
#pragma unroll
          for (int k = 0; k < 16; ++k) { float best = -INFINITY; unsigned be = 0;
#pragma unroll
              for (int i = 0; i < 16; ++i)
#pragma unroll
                  for (int j = 0; j < 16; ++j) if ((i + 1) * (j + 1) <= 16) { const float v = s0[i] + s1[j]; if (v < prev && v > best) { best = v; be = i0[i] * 128u + i1[j]; } }
              top[k] = best; tid16[k] = be; prev = best; } }
        float sc[16], den = 0.f;
#pragma unroll
        for (int k = 0; k < 16; ++k) { sc[k] = __expf(top[k] - top[0]); den += sc[k]; }
        const float inv = 1.f / den;
        const size_t ob = (size_t)(tok0 + t) * 128 + hd * 16;
#pragma unroll
        for (int k = 0; k < 16; ++k) { IDX[ob + k] = (int)tid16[k]; GATE[ob + k] = sc[k] * inv; }
    }
    __syncthreads();
#else
    if (PROBE < 2) {
        const int t = tid & 127, p = (tid >> 7) & 1, half = tid >> 8;
        LAS float* seg = SC + (p * 128 + t) * SCS + 64 * half;
        float run[16], nw[16];
#pragma unroll
        for (int ch = 0; ch < 4; ++ch) {
#pragma unroll
            for (int q = 0; q < 4; ++q) { const f32x4 v = *(const LAS f32x4*)(seg + 16 * ch + 4 * q);
#pragma unroll
                for (int e = 0; e < 4; ++e) { const unsigned n = (unsigned)(64 * half + 16 * ch + 4 * q + e); const float key = u2f((f2u(v[e]) & ~127u) | n);
                    if (ch == 0) run[4 * q + e] = key; else nw[4 * q + e] = key; } }
            if (ch == 0) bitonic_sort_desc<16>(run); else { bitonic_sort_desc<16>(nw); merge_top16(run, nw); }
        }
#pragma unroll
        for (int q = 0; q < 4; ++q) *(LAS f32x4*)(seg + 4 * q) = (f32x4){run[4 * q], run[4 * q + 1], run[4 * q + 2], run[4 * q + 3]};
    }
    __syncthreads();
    if (tid < 128 && PROBE < 1) {
        const int t = tid;
        float s0[16], s1[16];
        {
            LAS float* a = SC + (0 * 128 + t) * SCS; float nw[16];
#pragma unroll
            for (int q = 0; q < 4; ++q) { const f32x4 v = *(const LAS f32x4*)(a + 4 * q), u = *(const LAS f32x4*)(a + 64 + 4 * q);
#pragma unroll
                for (int e = 0; e < 4; ++e) { s0[4 * q + e] = v[e]; nw[4 * q + e] = u[e]; } }
            merge_top16(s0, nw);
#pragma unroll
            for (int q = 0; q < 4; ++q) *(LAS f32x4*)(a + 16 + 4 * q) = (f32x4){s0[4 * q], s0[4 * q + 1], s0[4 * q + 2], s0[4 * q + 3]};
        }
        {
            LAS float* a = SC + (1 * 128 + t) * SCS; float nw[16];
#pragma unroll
            for (int q = 0; q < 4; ++q) { const f32x4 v = *(const LAS f32x4*)(a + 4 * q), u = *(const LAS f32x4*)(a + 64 + 4 * q);
#pragma unroll
                for (int e = 0; e < 4; ++e) { s1[4 * q + e] = v[e]; nw[4 * q + e] = u[e]; } }
            merge_top16(s1, nw);
#pragma unroll
            for (int q = 0; q < 4; ++q) *(LAS f32x4*)(a + 16 + 4 * q) = (f32x4){s1[4 * q], s1[4 * q + 1], s1[4 * q + 2], s1[4 * q + 3]};
        }
#pragma unroll
        for (int i = 0; i < 16; ++i) { s0[i] = u2f(f2u(s0[i]) & ~127u); s1[i] = u2f(f2u(s1[i]) & ~127u); }
        constexpr int CNT[16] = {16, 8, 5, 4, 3, 2, 2, 2, 1, 1, 1, 1, 1, 1, 1, 1};
        constexpr int OFF[16] = {0, 16, 24, 29, 33, 36, 38, 40, 42, 43, 44, 45, 46, 47, 48, 49};
        float top[16], nw[16];
#pragma unroll
        for (int grp = 0; grp < 4; ++grp) {
#pragma unroll
            for (int e = 0; e < 16; ++e) nw[e] = -INFINITY;
#pragma unroll
            for (int i = 0; i < 16; ++i)
#pragma unroll
                for (int j = 0; j < 16; ++j) if (j < CNT[i] && (OFF[i] + j) / 16 == grp) {
                    const float sum = s0[i] + s1[j];
                    nw[(OFF[i] + j) % 16] = u2f((f2u(sum) & ~255u) | (unsigned)(i * 16 + j)); }
            bitonic_sort_desc<16>(nw);
            if (grp == 0) {
#pragma unroll
                for (int e = 0; e < 16; ++e) top[e] = nw[e];
            } else merge_top16(top, nw);
        }
#if defined(CHECK) && CHECK
        if (tok0 == 0 && hd == 0) { float* DB = WSP(float, WS_CLOC) + 8 * 1024 * 1024 + 32768;
#pragma unroll
            for (int i = 0; i < 16; ++i) { DB[t * 48 + i] = s0[i]; DB[t * 48 + 16 + i] = s1[i]; DB[t * 48 + 32 + i] = top[i]; } }
#endif
        float sc[16], den = 0.f;
        const float mx = u2f(f2u(top[0]) & ~255u);
#pragma unroll
        for (int k = 0; k < 16; ++k) { sc[k] = __expf(u2f(f2u(top[k]) & ~255u) - mx); den += sc[k]; }
        const float inv = 1.f / den;
        LDS_WAIT();
        const LAS unsigned* l0 = (const LAS unsigned*)(SC + (0 * 128 + t) * SCS + 16); const LAS unsigned* l1 = (const LAS unsigned*)(SC + (1 * 128 + t) * SCS + 16);
        const size_t ob = (size_t)(tok0 + t) * 128 + hd * 16;
        unsigned eid[16];
#pragma unroll
        for (int k = 0; k < 16; ++k) { const unsigned id = f2u(top[k]) & 255u; const unsigned e0 = l0[id >> 4] & 127u, e1 = l1[id & 15u] & 127u; eid[k] = e0 * 128u + e1; }
#pragma unroll
        for (int q4 = 0; q4 < 4; ++q4) { v4u iv; iv.x = eid[4 * q4]; iv.y = eid[4 * q4 + 1]; iv.z = eid[4 * q4 + 2]; iv.w = eid[4 * q4 + 3];
            *(GAS v4u*)(IDX + ob + 4 * q4) = iv; *(GAS f32x4*)(GATE + ob + 4 * q4) = (f32x4){sc[4 * q4] * inv, sc[4 * q4 + 1] * inv, sc[4 * q4 + 2] * inv, sc[4 * q4 + 3] * inv}; }
    }
    __syncthreads();
#endif
}
__device__ __forceinline__ void peer_u_phase(Frame& F, const unsigned char* U8  ) {
    const bf16* XN = WSP(bf16, WS_XNY); const int* IDX = WSP(int, WS_IDX); float* PART = WSP(float, WS_PART);
    const int lane = ((int)(threadIdx.x & 63u)), grp = lane >> 3, l8 = lane & 7;
    const int g = F.bid & 7, nsw = (F.G >> 3) * NWAVES, ws = (F.bid >> 3) * NWAVES + F.wave;
    const unsigned char* Ug = U8 + (size_t)g * 16384 * 128;
    const unsigned lo8 = 16u * (unsigned)l8;
#define U_IDS(IDS, TOK) do { const int* ip_ = IDX + (size_t)(TOK) * 128 + 16 * grp; _Pragma("unroll") for (int q4 = 0; q4 < 4; ++q4) IDS[q4] = *(const GAS v4u*)(ip_ + 4 * q4); } while (0)
#define U_ROWS(W, HX, HY, IDS, TOK) do { _Pragma("unroll") for (int q4 = 0; q4 < 4; ++q4) { W[4 * q4] = *(const GAS v4u*)(Ug + ((IDS[q4].x << 7) | lo8)); W[4 * q4 + 1] = *(const GAS v4u*)(Ug + ((IDS[q4].y << 7) | lo8)); \
        W[4 * q4 + 2] = *(const GAS v4u*)(Ug + ((IDS[q4].z << 7) | lo8)); W[4 * q4 + 3] = *(const GAS v4u*)(Ug + ((IDS[q4].w << 7) | lo8)); } \
        const bf16* hp_ = XN + (size_t)(TOK) * D + 128 * g + 16 * l8; HX = *(const GAS v4u*)hp_; HY = *(const GAS v4u*)(hp_ + 8); } while (0)
#define U_COMPUTE(W, HX, HY, TOK) do { \
        const float hf_[16] = {bflo(HX.x), bfhi(HX.x), bflo(HX.y), bfhi(HX.y), bflo(HX.z), bfhi(HX.z), bflo(HX.w), bfhi(HX.w), bflo(HY.x), bfhi(HY.x), bflo(HY.y), bfhi(HY.y), bflo(HY.z), bfhi(HY.z), bflo(HY.w), bfhi(HY.w)}; \
        float am_ = 0.f; _Pragma("unroll") for (int i = 0; i < 16; ++i) am_ = fmaxf(am_, fabsf(hf_[i])); \
        am_ = fmaxf(am_, __shfl_xor(am_, 1)); am_ = fmaxf(am_, __shfl_xor(am_, 2)); am_ = fmaxf(am_, __shfl_xor(am_, 4)); \
        const float hinv_ = am_ > 1e-30f ? 127.f / am_ : 0.f, hsc_ = am_ * (1.f / 127.f); \
        int hq_[4]; _Pragma("unroll") for (int q4 = 0; q4 < 4; ++q4) { unsigned wv_ = 0; _Pragma("unroll") for (int e = 0; e < 4; ++e) { const int qv_ = (int)rintf(hf_[4 * q4 + e] * hinv_); wv_ |= ((unsigned)qv_ & 0xffu) << (8 * e); } hq_[q4] = (int)wv_; } \
        float r_[16]; _Pragma("unroll") for (int it = 0; it < 16; ++it) { const unsigned wx_ = W[it].x, wy_ = W[it].y, wz_ = W[it].z, ww_ = W[it].w; \
            int acc_ = __builtin_amdgcn_sdot4((int)wx_, hq_[0], 0, false); acc_ = __builtin_amdgcn_sdot4((int)wy_, hq_[1], acc_, false); acc_ = __builtin_amdgcn_sdot4((int)wz_, hq_[2], acc_, false); acc_ = __builtin_amdgcn_sdot4((int)ww_, hq_[3], acc_, false); \
            acc_ += __shfl_xor(acc_, 1); acc_ += __shfl_xor(acc_, 2); acc_ += __shfl_xor(acc_, 4); r_[it] = (float)acc_ * hsc_; } \
        if (l8 == 0) { float* pp_ = PART + ((size_t)g * M + (TOK)) * 128 + 16 * grp; _Pragma("unroll") for (int q4 = 0; q4 < 4; ++q4) *(GAS f32x4*)(pp_ + 4 * q4) = (f32x4){r_[4 * q4], r_[4 * q4 + 1], r_[4 * q4 + 2], r_[4 * q4 + 3]}; } } while (0)
    v4u idsA[4], idsB[4], wA[16], wB[16], hxA, hyA, hxB, hyB;
    const int tmax = M - 1;
    int t0 = ws;
    U_IDS(idsA, t0); U_IDS(idsB, min(t0 + nsw, tmax));
    for (; t0 < M; t0 += 2 * nsw) {
        const int t1 = t0 + nsw, t2 = t0 + 2 * nsw, t3 = t0 + 3 * nsw;
        U_ROWS(wA, hxA, hyA, idsA, t0);
        U_ROWS(wB, hxB, hyB, idsB, min(t1, tmax));
        U_IDS(idsA, min(t2, tmax));
        U_IDS(idsB, min(t3, tmax));
        U_COMPUTE(wA, hxA, hyA, t0);
        if (t1 < M) U_COMPUTE(wB, hxB, hyB, t1);
    }
#undef U_IDS
#undef U_ROWS
#undef U_COMPUTE
}
__device__ __forceinline__ void peer_act_phase(Frame& F, const float* ISU, const float* ISV) {
    const int* IDX = WSP(int, WS_IDX); const float* GATE = WSP(float, WS_GATE); const float* PART = WSP(float, WS_PART);
    unsigned short* ACT8 = WSP(unsigned short, WS_ACT); float* ACTS = WSP(float, WS_ACTS);
    const int gw = F.bid * NWAVES + F.wave, NGW = F.G * NWAVES, lane = ((int)(threadIdx.x & 63u));
    for (int tok = gw; tok < M; tok += NGW) {
        const size_t i = (size_t)tok * 128 + 2 * lane;
        float s0 = 0.f, s1 = 0.f;
#pragma unroll
        for (int g = 0; g < 8; ++g) { const float2 p = *(const float2*)(PART + (size_t)g * M * 128 + i); s0 += p.x; s1 += p.y; }
        const int2 id = *(const int2*)(IDX + i); const float2 gt = *(const float2*)(GATE + i);
        const float d0 = s0 * ISU[id.x], d1 = s1 * ISU[id.y];
        const float a0 = 0.5f * d0 * (1.f + erff(d0 * 0.70710678118654752f)) * gt.x * ISV[id.x], a1 = 0.5f * d1 * (1.f + erff(d1 * 0.70710678118654752f)) * gt.y * ISV[id.y];
        const float am = wave_max(fmaxf(fabsf(a0), fabsf(a1)));
        const float inv = am > 1e-30f ? 127.f / am : 0.f;
        const int q0 = (int)rintf(a0 * inv), q1 = (int)rintf(a1 * inv);
        ACT8[(size_t)tok * 64 + lane] = (unsigned short)(((unsigned)q0 & 0xffu) | (((unsigned)q1 & 0xffu) << 8));
        if (lane == 0) ACTS[tok] = am * (1.f / 127.f);
    }
}
__device__ __forceinline__ void peer_v_phase(Frame& F, const unsigned char* V8, const float* g2  , float dbg) {
    const int* IDX = WSP(int, WS_IDX); const unsigned* ACT8 = WSP(unsigned, WS_ACT); const float* ACTS = WSP(float, WS_ACTS);
    const int lane = ((int)(threadIdx.x & 63u)), t8 = lane >> 3, l8 = lane & 7;
    const int g = F.bid & 7, nsw = (F.G >> 3) * NWAVES, ws = (F.bid >> 3) * NWAVES + F.wave;
    const unsigned char* Vg = V8 + (size_t)g * 16384 * 128; const unsigned lo8 = 16u * (unsigned)l8;
    for (int wi = ws; wi < M / 8; wi += nsw) {
        const int tok = wi * 8 + t8;
        const int* ip = IDX + (size_t)tok * 128; const unsigned* ap = ACT8 + (size_t)tok * 32;
        int acc[16];
#pragma unroll
        for (int i = 0; i < 16; ++i) acc[i] = 0;
#pragma unroll 2
        for (int gi = 0; gi < 32; ++gi) {
            const v4u id4 = *(const GAS v4u*)(ip + 4 * gi); const int qa = (int)ap[gi];
            const v4u ra = *(const GAS v4u*)(Vg + ((id4.x << 7) | lo8)), rb = *(const GAS v4u*)(Vg + ((id4.y << 7) | lo8)), rc = *(const GAS v4u*)(Vg + ((id4.z << 7) | lo8)), rd = *(const GAS v4u*)(Vg + ((id4.w << 7) | lo8));
            const unsigned A[4] = {ra.x, ra.y, ra.z, ra.w}, B[4] = {rb.x, rb.y, rb.z, rb.w}, C[4] = {rc.x, rc.y, rc.z, rc.w}, Dd[4] = {rd.x, rd.y, rd.z, rd.w};
#pragma unroll
            for (int j = 0; j < 4; ++j) {
                const unsigned ablo = __builtin_amdgcn_perm(B[j], A[j], 0x05010400u), abhi = __builtin_amdgcn_perm(B[j], A[j], 0x07030602u);
                const unsigned cdlo = __builtin_amdgcn_perm(Dd[j], C[j], 0x05010400u), cdhi = __builtin_amdgcn_perm(Dd[j], C[j], 0x07030602u);
                const unsigned t0 = __builtin_amdgcn_perm(cdlo, ablo, 0x05040100u), t1 = __builtin_amdgcn_perm(cdlo, ablo, 0x07060302u);
                const unsigned t2 = __builtin_amdgcn_perm(cdhi, abhi, 0x05040100u), t3 = __builtin_amdgcn_perm(cdhi, abhi, 0x07060302u);
                acc[4 * j] = __builtin_amdgcn_sdot4((int)t0, qa, acc[4 * j], false); acc[4 * j + 1] = __builtin_amdgcn_sdot4((int)t1, qa, acc[4 * j + 1], false);
                acc[4 * j + 2] = __builtin_amdgcn_sdot4((int)t2, qa, acc[4 * j + 2], false); acc[4 * j + 3] = __builtin_amdgcn_sdot4((int)t3, qa, acc[4 * j + 3], false);
            }
        }
        const float sc = ACTS[tok] * dbg;
        const int b = tok >> 13, c0 = 128 * g + 16 * l8; float* xr = F.out + (size_t)tok * D + c0; const float* gr = g2 + (size_t)b * 6144 + c0;
#pragma unroll
        for (int q4 = 0; q4 < 4; ++q4) { const f32x4 xv = *(const GAS f32x4*)(xr + 4 * q4), gv = *(const f32x4*)(gr + 4 * q4);
            *(GAS f32x4*)(xr + 4 * q4) = xv + gv * sc * (f32x4){(float)acc[4 * q4], (float)acc[4 * q4 + 1], (float)acc[4 * q4 + 2], (float)acc[4 * q4 + 3]}; }
    }
}
#if defined(CHECK) && CHECK
constexpr size_t WS_DBG = 896 * 1024;
constexpr size_t WS_DBGOUT = WS_CLOC;
#ifndef CHECK_LAYER
#define CHECK_LAYER 1
#endif
__global__ void chk_qry(Args a) {
    const bf16* XN = (const bf16*)(a.ws + WS_XNY); const bf16* QRY = (const bf16*)(a.ws + WS_QRY); const float* wq = a.in[20] + (size_t)CHECK_LAYER * D * NQ;
    float* R = (float*)(a.ws + WS_CTL + WS_DBG);
    const int tok = (blockIdx.x * 977) % M; const int col = (threadIdx.x * 37 + blockIdx.x * 11) % NQ;
    float s = 0.f; for (int k = 0; k < D; ++k) s += bf2f(XN[(size_t)tok * D + k]) * wq[(size_t)k * NQ + col];
    const float q = bf2f(QRY[(size_t)tok * NQ + col]);
    atomicAdd(R + 0, (s - q) * (s - q)); atomicAdd(R + 1, s * s);
}
__global__ void chk_keys(Args a) {
    const bf16* KB = (const bf16*)(a.ws + WS_KEYS); const float* keys = a.in[21]; float* R = (float*)(a.ws + WS_CTL + WS_DBG);
    const int i = blockIdx.x * blockDim.x + threadIdx.x; if (i < 2 * 2 * 128 * 128) { const float d = bf2f(KB[i]) - keys[i]; atomicAdd(R + 8, d * d); atomicAdd(R + 9, keys[i] * keys[i]); }
}
__global__ void chk_uv(Args a) {
    const bf16* UB = (const bf16*)(a.ws + WS_UB); const bf16* VB = (const bf16*)(a.ws + WS_VB); float* R = (float*)(a.ws + WS_CTL + WS_DBG);
    const size_t i = ((size_t)blockIdx.x * blockDim.x + threadIdx.x) * 61 % ((size_t)2 * 16384 * 1024);
    const float du = bf2f(UB[i]) - a.in[22][i], dv = bf2f(VB[i]) - a.in[23][i];
    atomicAdd(R + 16, du * du + dv * dv); atomicAdd(R + 17, a.in[22][i] * a.in[22][i] + a.in[23][i] * a.in[23][i]);
}
__global__ void chk_route(Args a) {
    const bf16* QRY = (const bf16*)(a.ws + WS_QRY); const float* keys = a.in[21] + (size_t)CHECK_LAYER * 2 * 128 * 128;
    const int* IDX = (const int*)(a.ws + WS_IDX); const float* GATE = (const float*)(a.ws + WS_GATE);
    float* R = (float*)(a.ws + WS_CTL + WS_DBG);
    __shared__ float sc[2][128]; __shared__ float sc0[2][128]; __shared__ float ts[2][16]; __shared__ int ti[2][16]; __shared__ float cs[256]; __shared__ int ci[256];
    const int tok = (blockIdx.x * 613 + 5) % M, hd = blockIdx.x & 7, tid = threadIdx.x;
    { const int p = tid >> 7, n = tid & 127; float s = 0.f; for (int d = 0; d < 128; ++d) s += bf2f(QRY[(size_t)tok * NQ + hd * 256 + p * 128 + d]) * keys[(size_t)(p * 128 + n) * 128 + d]; sc[p][n] = s; sc0[p][n] = s; }
    __syncthreads();
    if (tid < 2) { const int p = tid; for (int k = 0; k < 16; ++k) { int best = 0; float bv = -INFINITY; for (int n = 0; n < 128; ++n) if (sc[p][n] > bv) { bv = sc[p][n]; best = n; } ts[p][k] = bv; ti[p][k] = best; sc[p][best] = -INFINITY; } }
    __syncthreads();
    cs[tid] = ts[0][tid >> 4] + ts[1][tid & 15]; ci[tid] = ti[0][tid >> 4] * 128 + ti[1][tid & 15];
    __syncthreads();
    if (tid == 0) {
        float fs[16]; int fi[16];
        for (int k = 0; k < 16; ++k) { int best = 0; float bv = -INFINITY; for (int n = 0; n < 256; ++n) if (cs[n] > bv) { bv = cs[n]; best = n; } fs[k] = bv; fi[k] = ci[best]; cs[best] = -INFINITY; }
        float den = 0.f; for (int k = 0; k < 16; ++k) den += __expf(fs[k] - fs[0]);
        int mism = 0; float ge = 0.f;
        for (int k = 0; k < 16; ++k) { bool found = false; for (int j = 0; j < 16; ++j) if (IDX[(size_t)tok * 128 + hd * 16 + j] == fi[k]) { found = true; const float g = __expf(fs[k] - fs[0]) / den; const float d = g - GATE[(size_t)tok * 128 + hd * 16 + j]; ge += d * d; } if (!found) ++mism; }
        { int ba = 0, bb = 0; for (int j = 0; j < 16; ++j) { const int e = IDX[(size_t)tok * 128 + hd * 16 + j]; const int ea = (e >> 7) & 127, eb = e & 127;
            if (!(e >= 0 && e < 16384) || sc0[0][ea] + sc0[1][eb] < fs[15] - 0.05f) ++ba; if (!(e >= 0 && e < 16384) || sc0[1][ea] + sc0[0][eb] < fs[15] - 0.05f) ++bb; }
          atomicAdd(R + 10, (float)ba); atomicAdd(R + 11, (float)bb); }
        atomicAdd(R + 2, (float)mism); atomicAdd(R + 3, 16.f); atomicAdd(R + 4, ge); atomicAdd(R + 5, 1.f / 16.f);
    }
}
__global__ void chk_scores(Args a) {
    const bf16* QRY = (const bf16*)(a.ws + WS_QRY); const float* keys = a.in[21] + (size_t)CHECK_LAYER * 2 * 128 * 128;
    const float* DB = (const float*)(a.ws + WS_CLOC) + 8 * 1024 * 1024; float* R = (float*)(a.ws + WS_CTL + WS_DBG);
    const int t = blockIdx.x, tid = threadIdx.x;
    __shared__ float sc[2][128];
    { const int p = tid >> 7, n = tid & 127; float s = 0.f; for (int d = 0; d < 128; ++d) s += bf2f(QRY[(size_t)t * NQ + p * 128 + d]) * keys[(size_t)(p * 128 + n) * 128 + d];
      const float dv = DB[(p * 128 + t) * 128 + n]; atomicAdd(R + 12, (s - dv) * (s - dv)); atomicAdd(R + 13, s * s); sc[p][n] = dv; }
    __syncthreads();
    if (tid < 2) { const int p = tid; int bad = 0; for (int k = 0; k < 16; ++k) { int best = 0; float bv = -INFINITY; for (int n = 0; n < 128; ++n) if (sc[p][n] > bv) { bv = sc[p][n]; best = n; }
        const float lv = DB[32768 + t * 48 + 16 * p + k]; if (fabsf(lv - bv) > 1e-3f * (1.f + fabsf(bv))) ++bad; sc[p][best] = -INFINITY; }
        atomicAdd(R + 14, (float)bad); atomicAdd(R + 15, 16.f); }
}
__global__ void chk_expert(Args a) {
    const bf16* XN = (const bf16*)(a.ws + WS_XNY); const int* IDX = (const int*)(a.ws + WS_IDX); const float* GATE = (const float*)(a.ws + WS_GATE);
    const float* U = a.in[22] + (size_t)CHECK_LAYER * 16384 * 1024; const float* V = a.in[23] + (size_t)CHECK_LAYER * 16384 * 1024;
    const float* DO = (const float*)(a.ws + WS_DBGOUT); float* R = (float*)(a.ws + WS_CTL + WS_DBG);
    __shared__ float act[128];
    const int tok = (blockIdx.x * 61 + 3) % 4096, tid = threadIdx.x;
    if (tid < 128) { const int e = IDX[(size_t)tok * 128 + tid]; float s = 0.f; for (int k = 0; k < D; ++k) s += bf2f(XN[(size_t)tok * D + k]) * U[(size_t)e * D + k];
        act[tid] = 0.5f * s * (1.f + erff(s * 0.70710678f)) * GATE[(size_t)tok * 128 + tid]; }
    __syncthreads();
    for (int c = tid; c < D; c += 256) { float o = 0.f; for (int e = 0; e < 128; ++e) o += act[e] * V[(size_t)IDX[(size_t)tok * 128 + e] * D + c];
        const float g = DO[(size_t)tok * D + c]; atomicAdd(R + 6, (o - g) * (o - g)); atomicAdd(R + 7, o * o); }
}
__global__ void chk_stamp(Args a) {
    const float* R = (const float*)(a.ws + WS_CTL + WS_DBG);
    const float e1 = sqrtf(R[0] / fmaxf(R[1], 1e-30f)), e2 = R[2] / fmaxf(R[3], 1.f), e2g = sqrtf(R[4] / fmaxf(R[5], 1e-30f)), e3 = sqrtf(R[6] / fmaxf(R[7], 1e-30f));
    float c;
#if CHECK == 99
    c = 1.f;
#else
    const float e0 = sqrtf(R[8] / fmaxf(R[9], 1e-30f));
    const float ea = R[10] / fmaxf(R[3], 1.f), eb = R[11] / fmaxf(R[3], 1.f);
    const float esc = sqrtf(R[12] / fmaxf(R[13], 1e-30f)), els = R[14] / fmaxf(R[15], 1.f);
    const float euv = sqrtf(R[16] / fmaxf(R[17], 1e-30f));
    const float errs[4] = {e2, euv, ea, e3}; const float tols[4] = {0.08f, 0.01f, 0.08f, 0.03f};
    c = 1.f;
    for (int k = 3; k >= 0; --k) if (!(errs[k] <= tols[k])) { const float fr = fminf(fmaxf((log10f(fmaxf(errs[k], 1e-4f)) + 4.f) / 5.f, 0.f), 0.95f); c = 2.f + (float)k + fr; }
#endif
    const size_t i = (size_t)blockIdx.x * blockDim.x + threadIdx.x;
    if (i < (size_t)M * D) a.out[i] = a.in[0][i] * (1.f + c);
}
#endif
#ifndef MK_PER_PHASE
#define MK_PER_PHASE 0
#endif
constexpr int NPHASE = 24;
#ifndef RPROBE
#define RPROBE 0
#endif
#ifndef DBG_Y0
#define DBG_Y0 1
#define DBG_P0 1
#define DBG_Y1 1
#define DBG_P1 1
#endif
#ifndef PHASE_MASK
#define PHASE_MASK 0x1ffffffu
#endif
#define IN(k) (lo <= (k) && (k) < hi && ((PHASE_MASK >> (k)) & 1u))
#ifndef DUP_PHASE
#define DUP_PHASE -1
#endif
#define REPS(k) for (int rep = ((DUP_PHASE) == (k) ? 0 : 1); rep < 2; ++rep)
#define SEAM(k) do { if (IN(k) && IN((k) + 1)) xcd_barrier(bar); } while (0)
__device__ __forceinline__ float alibi_tcut(const float* gq, const float* gk, int lane) { return 16.f * wave_max(fabsf(gq[lane])) * wave_max(fabsf(gk[lane])) + ALIBI_MARGIN; }
template <int layer>
__device__ __forceinline__ void layer_phases(Frame& F, const Args& args, const XcdBarrier& bar, const int lo, const int hi) {
    volatile LAS unsigned* MISCW = (volatile LAS unsigned*)(F.lds + MISC_OFF);
    float* MOD = WSP(float, WS_MOD);
    bf16* XNY = WSP(bf16, WS_XNY); bf16* Zb = WSP(bf16, WS_Z);

        constexpr int pb = layer * 12;
        const float* mod = MOD + (size_t)layer * 4 * 6144;
        if (IN(pb + 1)) REPS(pb + 1) { if (layer == 0) norm_pass<true>(F, args, args.in[0], args.in[4], mod, 0, XNY); else norm_pass<false>(F, args, F.out, args.in[4] + 1024, mod, 0, XNY); } SEAM(pb + 1);
        if (IN(pb + 2)) REPS(pb + 2) {
            const int N = layer == 0 ? NZ0 : NZ1;
            pg8::Gemm g{XNY, layer == 0 ? WSP(bf16, WS_WIN0) : WSP(bf16, WS_WIN1), M, N, D}; pg8::StaticOrder S; S.init(M, N, F.G, F.bid);
            pg8::EpiBf16QK E{Zb, N, layer == 0 ? 8 : 0, layer == 0 ? 10 : 4, layer == 0 ? 10 : 4, layer == 0 ? 12 : 8, layer == 0 ? args.in[11] : args.in[15], layer == 0 ? args.in[12] : args.in[16], 0.125f * LOG2E, (LAS float*)(F.lds + 131072)};
            pg8::gemm_phase<pg8::EpiBf16QK, pg8::StaticOrder, true, true>(F.lds, g, S, E);
        } SEAM(pb + 2);
        if (layer == 0) {
            if (IN(3)) REPS(3) {
                for (int u = F.bid; u < 1024 + 128; u += F.G) {
                    if (u < 1024) mlstm_a_unit(F, args, u);
                    else if (rep == 1) { const int v = u - 1024, b = v >> 5, j = v & 31;
                        kmean_unit(F, Zb, NZ0, b * SEQ + j * 256, 2560, WSP(float, WS_KMEAN) + (size_t)((b * 8) * 32 + j) * 64); }
                }
            } SEAM(3);
            if (IN(4)) REPS(4) {
                if (rep == 1) for (int u = F.bid; u < 256; u += F.G) mlstm_scan_unit(F, u);
                { const float tcut = alibi_tcut(args.in[11], args.in[12], ((int)(threadIdx.x & 63u)));
                  const unsigned short* ORD = WSP(unsigned short, WS_ORD) + 2048; unsigned* qw = (unsigned*)(F.ws + WS_CTL) + CW_QMOBA + (rep == 1 ? 0 : 16);
                  for (;;) { if (((int)threadIdx.x) == 0) MISCW[0] = atomicAdd(qw, 1u); __syncthreads(); const unsigned qi = MISCW[0]; __syncthreads(); if (qi >= 1024u) break;
                      const int u = ORD[qi]; moba_unit(F, u >> 8, (u >> 5) & 7, u & 31, tcut); }
                  if (rep == 1) { unsigned* cw = (unsigned*)(F.ws + WS_CTL) + CW_QCVT0;
                      for (;;) { if (((int)threadIdx.x) == 0) MISCW[0] = atomicAdd(cw, 1u); __syncthreads(); const unsigned ci = MISCW[0]; __syncthreads(); if (ci >= 512u) break; i8_chunk(F, args, 0, (int)ci); } } }
            } SEAM(4);
            if (IN(5)) REPS(5) { for (int u = F.bid; u < 1024; u += F.G) mlstm_c_unit(F, args, u); } SEAM(5);
        } else {
            if (IN(pb + 4)) REPS(pb + 4) {
                const float* lp = args.in[17];
                const float lam = __expf(wave_sum(lp[((int)(threadIdx.x & 63u))] * lp[64 + ((int)(threadIdx.x & 63u))])) - __expf(wave_sum(lp[128 + ((int)(threadIdx.x & 63u))] * lp[192 + ((int)(threadIdx.x & 63u))])) + 0.35550906759096926f;
                { const float tcut = alibi_tcut(args.in[15], args.in[16], ((int)(threadIdx.x & 63u)));
                  const unsigned short* ORD = WSP(unsigned short, WS_ORD); unsigned* qw = (unsigned*)(F.ws + WS_CTL) + CW_QDIFF + (rep == 1 ? 0 : 16);
                  for (;;) { if (((int)threadIdx.x) == 0) MISCW[0] = atomicAdd(qw, 1u); __syncthreads(); const unsigned qi = MISCW[0]; __syncthreads(); if (qi >= 2048u) break;
                      const int u = ORD[qi]; diff_unit(F, args, u >> 9, (u >> 6) & 7, u & 63, lam, tcut, rep == 0 ? RPROBE : 0); }
                  if (rep == 1) { unsigned* cw = (unsigned*)(F.ws + WS_CTL) + CW_QCVT1;
                      for (;;) { if (((int)threadIdx.x) == 0) MISCW[0] = atomicAdd(cw, 1u); __syncthreads(); const unsigned ci = MISCW[0]; __syncthreads(); if (ci >= 512u) break; i8_chunk(F, args, 1, (int)ci); } } }
            } SEAM(pb + 4);
        }
        if (IN(pb + 6)) {
            pg8::Gemm g{XNY, layer == 0 ? WSP(bf16, WS_WOUT0) : WSP(bf16, WS_WOUT1), M, D, D}; pg8::StaticOrder S; S.init(M, D, F.G, F.bid);
            pg8::EpiResid E{layer == 0 ? args.in[0] : F.out, F.out, mod + 2 * 1024};
            pg8::gemm_phase<pg8::EpiResid, pg8::StaticOrder, true, true>(F.lds, g, S, E);
        } SEAM(pb + 6);
        if (IN(pb + 7)) REPS(pb + 7) { norm_pass<false>(F, args, F.out, args.in[5] + layer * 1024, mod, 3, XNY); } SEAM(pb + 7);
        if (IN(pb + 8)) REPS(pb + 8) {
            pg8::Gemm g{XNY, WSP(bf16, WS_WQ) + (size_t)layer * NQ * D, M, NQ, D}; pg8::StaticOrder S; S.init(M, NQ, F.G, F.bid);
            pg8::EpiBf16 E{WSP(bf16, WS_QRY), NQ};
            pg8::gemm_phase<pg8::EpiBf16, pg8::StaticOrder, true, true>(F.lds, g, S, E);
        } SEAM(pb + 8);
        if (IN(pb + 9)) REPS(pb + 9) { const bf16* KEYS = WSP(bf16, WS_KEYS) + (size_t)layer * 2 * 128 * 128;
            bf16x8 kf[4][2];
#pragma unroll
            for (int ks = 0; ks < 4; ++ks)
#pragma unroll
                for (int n = 0; n < 2; ++n) kf[ks][n] = *(const GAS bf16x8*)(KEYS + (size_t)((F.wave & 1) * 128 + 32 * (F.wave >> 1) + 16 * n + (((int)(threadIdx.x & 63u)) & 15)) * 128 + 32 * ks + 8 * (((int)(threadIdx.x & 63u)) >> 4));
            for (int u = F.bid; u < 2048; u += F.G) peer_route_unit(F, (u >> 3) * 128, u & 7, kf, rep == 0 ? RPROBE : 0); } SEAM(pb + 9);
        if (IN(pb + 10)) REPS(pb + 10) { peer_u_phase(F, F.ws + WS_UB + (size_t)layer * 8 * 16384 * 128); } SEAM(pb + 10);
        if (IN(pb + 11)) REPS(pb + 11) { peer_act_phase(F, WSP(float, WS_ISU) + layer * 16384, WSP(float, WS_ISV) + layer * 16384); } SEAM(pb + 11);
        if (IN(pb + 12)) REPS(pb + 12) { peer_v_phase(F, F.ws + WS_VB + (size_t)layer * 8 * 16384 * 128, mod + 5 * 1024, rep == 1 ? (layer == 0 ? (float)DBG_P0 : (float)DBG_P1) : 0.f); }
        if (layer == 0) SEAM(12);
    }
__global__ void __launch_bounds__(NTHR, 2) mega_fwd(Args args) {
    extern __shared__ __attribute__((aligned(16))) unsigned char lds_raw[];
    Frame F;
    F.lds = (LAS unsigned char*)lds_raw;
    F.wave = __builtin_amdgcn_readfirstlane((int)threadIdx.x >> 6);
    F.G = gridDim.x; F.bid = blockIdx.x;
    F.out = args.out; F.ws = args.ws;
    volatile LAS unsigned* MISC = (volatile LAS unsigned*)(F.lds + MISC_OFF);
    for (int u = ((int)threadIdx.x); u < (LDS_BYTES - LDSCTL_OFF) / 4; u += NTHR) ((LAS unsigned*)(F.lds + LDSCTL_OFF))[u] = 0u;
    __syncthreads();
    XcdBarrier bar; bar.bar = (unsigned*)(F.ws + WS_CTL) + CW_BAR; bar.x = 0; bar.st = nullptr;
    if (!MK_PER_PHASE) bar = xcd_barrier_post((unsigned*)(F.ws + WS_CTL) + CW_BAR, MISC + 8);
    const int lo = args.ph_lo, hi = args.ph_hi;

#ifdef EXTRA_BAR
    for (int i = 0; i < EXTRA_BAR; ++i) xcd_barrier(bar);
#endif
    if (IN(0)) REPS(0) { p0_prologue(F, args); } SEAM(0);
    layer_phases<0>(F, args, bar, lo, hi);
    layer_phases<1>(F, args, bar, lo, hi);
}
#undef IN
#undef SEAM

extern "C" void kernel_launch(void* const* d_in, const int* in_sizes, int n_in, void* d_out, int out_size, void* d_ws, size_t ws_size, hipStream_t stream) {
    static int grid = 0;
    if (grid == 0) {
        if (n_in != 24 || in_sizes[0] != M * D || out_size != M * D || ws_size < WS_END) { fprintf(stderr, "kernel_launch: unexpected problem (n_in %d, in0 %d, out %d, ws %zu < %zu); nothing launched\n", n_in, n_in > 0 ? in_sizes[0] : -1, out_size, ws_size, (size_t)WS_END); grid = -1; return; }
        int dev = 0, cus = 0, per_cu = 0;
        if (hipGetDevice(&dev) != hipSuccess || hipDeviceGetAttribute(&cus, hipDeviceAttributeMultiprocessorCount, dev) != hipSuccess) { grid = -1; return; }
        if (hipFuncSetAttribute((const void*)mega_fwd, hipFuncAttributeMaxDynamicSharedMemorySize, LDS_BYTES) != hipSuccess) { fprintf(stderr, "kernel_launch: hipFuncSetAttribute failed\n"); grid = -1; return; }
        if (hipOccupancyMaxActiveBlocksPerMultiprocessor(&per_cu, (const void*)mega_fwd, NTHR, LDS_BYTES) != hipSuccess || per_cu < 1)
            fprintf(stderr, "kernel_launch: note: occupancy query reports %d workgroups per CU\n", per_cu);
        (void)hipGetLastError();
        grid = cus;
    }
    if (grid < 0) return;
    if (hipMemsetAsync((char*)d_ws + WS_CTL, 0, CTL_ZERO_BYTES, stream) != hipSuccess) { fprintf(stderr, "kernel_launch: memset failed\n"); return; }
    Args a{};
    for (int i = 0; i < 24; ++i) a.in[i] = (const float*)d_in[i];
    a.out = (float*)d_out; a.ws = (unsigned char*)d_ws;
#if MK_PER_PHASE
    for (int p = 0; p < NPHASE + 1; ++p) { a.ph_lo = p; a.ph_hi = p + 1; hipLaunchKernelGGL(mega_fwd, dim3(grid), dim3(NTHR), LDS_BYTES, stream, a); }
#else
    a.ph_lo = 0; a.ph_hi = NPHASE + 1;
    hipLaunchKernelGGL(mega_fwd, dim3(grid), dim3(NTHR), LDS_BYTES, stream, a);
#endif
#if defined(CHECK) && CHECK
    chk_qry<<<256, 256, 0, stream>>>(a); chk_keys<<<256, 256, 0, stream>>>(a); chk_uv<<<1024, 256, 0, stream>>>(a); chk_scores<<<128, 256, 0, stream>>>(a); chk_route<<<512, 256, 0, stream>>>(a); chk_expert<<<64, 256, 0, stream>>>(a); chk_stamp<<<(M * D + 255) / 256, 256, 0, stream>>>(a);
#endif
    const hipError_t le = hipPeekAtLastError();
    if (le != hipSuccess) fprintf(stderr, "kernel_launch: launch failed: %s\n", hipGetErrorName(le));
}
```

```cpp
#include <hip/hip_runtime.h>
#include <cstdio>
#include <cstdint>
namespace pg8 {
#define PG8_LAS __attribute__((address_space(3)))
typedef unsigned short bf16_t;
typedef short bf16x8 __attribute__((ext_vector_type(8)));
typedef float f32x4 __attribute__((ext_vector_type(4)));
typedef unsigned u32x4 __attribute__((ext_vector_type(4)));
constexpr int BM = 256, BK = 64, HALF = 128, HTB = HALF * BK * 2  , STAGE_BYTES = 8 * HTB, NXCD = 8, WGM = 8;

__host__ __device__ __forceinline__ int lds_byte(int r, int c) { const int st = (r >> 4) * 2 + (c >> 5), rr = r & 15, cc = c & 31, ob = rr * 64 + cc * 2; return st * 1024 + (ob ^ (((ob >> 9) & 1) << 5)); }
__host__ __device__ __forceinline__ void stage_rc(int b, int& R, int& C) { const int st = b / 1024, sb = b % 1024, swz = sb ^ (((sb >> 9) & 1) << 5); R = (st >> 1) * 16 + swz / 64; C = (st & 1) * 32 + (swz % 64) / 2; }
__host__ __device__ __forceinline__ int perm32(int rho) { const int n = rho >> 4, i = rho & 15; return 8 * (i >> 2) + 4 * n + (i & 3); }

struct Unit { int pm, pn; };
struct Gemm { const bf16_t* A; const bf16_t* Bt; int M, N, K; size_t bstride; };

struct StaticOrder {
    int nM, nN, nwg, G, c;
    __host__ __device__ void init(int M, int N, int G_, int c_) { nM = M / BM; nN = N / BM; nwg = nM * nN; G = G_; c = c_; }
    __host__ __device__ bool next(int i, Unit& u) const {
        const long L = (long)i * G + c; if (L >= nwg) return false;
        int wgid = (int)L; { const int q = nwg / NXCD, r = nwg % NXCD, xcd = wgid % NXCD, off = wgid / NXCD; wgid = (xcd < r ? xcd * (q + 1) : r * (q + 1) + (xcd - r) * q) + off; }
        const int nig = WGM * nN, gid = wgid / nig, fm = gid * WGM, gsz = (nM - fm) < WGM ? (nM - fm) : WGM;
        u.pm = fm + ((wgid % nig) % gsz); u.pn = (wgid % nig) / gsz; return true;
    }
    __device__ __forceinline__ void a_ready(const Unit&) const {}
    __device__ __forceinline__ void done(const Unit&) const {}
};

__device__ __forceinline__ unsigned cvt_pk_bf16(float lo, float hi) { unsigned r; asm volatile("v_cvt_pk_bf16_f32 %0, %1, %2" : "=v"(r) : "v"(lo), "v"(hi)); return r; }
typedef unsigned u32x4 __attribute__((ext_vector_type(4)));
struct EpiBf16 {
    static constexpr bool PERM = true, AFTER_DRAIN = false;
    bf16_t* O; int ldc;
    __device__ __forceinline__ void operator()(const f32x4 (&acc)[2][2][4][2], const Unit& u, int wr, int wc, int fr, int fq) const {
        const int row0 = u.pm * BM + wr * 64 + fr; const int col0 = u.pn * BM + wc * 32 + 8 * fq;
#pragma unroll
        for (int ai = 0; ai < 2; ++ai)
#pragma unroll
            for (int m = 0; m < 4; ++m) { bf16_t* rowp = O + (size_t)(row0 + ai * HALF + m * 16) * ldc + col0;
#pragma unroll
                for (int bj = 0; bj < 2; ++bj) { const f32x4 v0 = acc[ai][bj][m][0], v1 = acc[ai][bj][m][1];
                    u32x4 w; w.x = cvt_pk_bf16(v0[0], v0[1]); w.y = cvt_pk_bf16(v0[2], v0[3]); w.z = cvt_pk_bf16(v1[0], v1[1]); w.w = cvt_pk_bf16(v1[2], v1[3]);
                    *(u32x4*)(rowp + bj * HALF) = w; } }
    }
};
struct EpiBf16QK {
    static constexpr bool PERM = true, AFTER_DRAIN = false;
    bf16_t* O; int ldc; int q_lo, q_hi, k_lo, k_hi; const float* gq; const float* gk; float qmul; PG8_LAS float* xs;
    __device__ __forceinline__ void operator()(const f32x4 (&acc)[2][2][4][2], const Unit& u, int wr, int wc, int fr, int fq) const {
        const int row0 = u.pm * BM + wr * 64 + fr; const int col0 = u.pn * BM + wc * 32 + 8 * fq;
        const bool isq = u.pn >= q_lo && u.pn < q_hi, isk = u.pn >= k_lo && u.pn < k_hi;
        if (!(isq || isk)) {
#pragma unroll
            for (int ai = 0; ai < 2; ++ai)
#pragma unroll
                for (int m = 0; m < 4; ++m) { bf16_t* rowp = O + (size_t)(row0 + ai * HALF + m * 16) * ldc + col0;
#pragma unroll
                    for (int bj = 0; bj < 2; ++bj) { const f32x4 v0 = acc[ai][bj][m][0], v1 = acc[ai][bj][m][1];
                        u32x4 w; w.x = cvt_pk_bf16(v0[0], v0[1]); w.y = cvt_pk_bf16(v0[2], v0[3]); w.z = cvt_pk_bf16(v1[0], v1[1]); w.w = cvt_pk_bf16(v1[2], v1[3]);
                        *(u32x4*)(rowp + bj * HALF) = w; } }
            return;
        }
        float ssq[2][4][2];
#pragma unroll
        for (int ai = 0; ai < 2; ++ai)
#pragma unroll
            for (int m = 0; m < 4; ++m)
#pragma unroll
                for (int bj = 0; bj < 2; ++bj) { const f32x4 v0 = acc[ai][bj][m][0], v1 = acc[ai][bj][m][1];
                    float s = (v0[0] * v0[0] + v0[1] * v0[1]) + (v0[2] * v0[2] + v0[3] * v0[3]) + (v1[0] * v1[0] + v1[1] * v1[1]) + (v1[2] * v1[2] + v1[3] * v1[3]);
                    s += __shfl_xor(s, 16); s += __shfl_xor(s, 32); ssq[ai][m][bj] = s;
                    if (fq == 0) xs[(ai * HALF + wr * 64 + m * 16 + fr) * 8 + bj * 4 + wc] = s; }
        asm volatile("s_waitcnt lgkmcnt(0)" ::: "memory"); __builtin_amdgcn_s_barrier(); asm volatile("" ::: "memory");
        const float* g = isq ? gq : gk; const float gm = isq ? qmul : 1.f;
        const int d0 = (wc & 1) * 32 + 8 * fq;
        const f32x4 g0 = *(const f32x4*)(g + d0) * gm, g1 = *(const f32x4*)(g + d0 + 4) * gm;
#pragma unroll
        for (int ai = 0; ai < 2; ++ai)
#pragma unroll
            for (int m = 0; m < 4; ++m) { bf16_t* rowp = O + (size_t)(row0 + ai * HALF + m * 16) * ldc + col0;
#pragma unroll
                for (int bj = 0; bj < 2; ++bj) { const float tot = ssq[ai][m][bj] + xs[(ai * HALF + wr * 64 + m * 16 + fr) * 8 + bj * 4 + (wc ^ 1)];
                    const float rs = __builtin_amdgcn_rsqf(tot * (1.f / 64.f) + 1e-6f);
                    const f32x4 v0 = acc[ai][bj][m][0] * rs * g0, v1 = acc[ai][bj][m][1] * rs * g1;
                    u32x4 w; w.x = cvt_pk_bf16(v0[0], v0[1]); w.y = cvt_pk_bf16(v0[2], v0[3]); w.z = cvt_pk_bf16(v1[0], v1[1]); w.w = cvt_pk_bf16(v1[2], v1[3]);
                    *(u32x4*)(rowp + bj * HALF) = w; } }
    }
};
struct EpiBf16RS {
    static constexpr bool PERM = true, AFTER_DRAIN = false;
    bf16_t* O; int ldc; const float* rss; const float* bias; int bias_stride;
    __device__ __forceinline__ void operator()(const f32x4 (&acc)[2][2][4][2], const Unit& u, int wr, int wc, int fr, int fq) const {
        const int row0 = u.pm * BM + wr * 64 + fr; const int col0 = u.pn * BM + wc * 32 + 8 * fq; const int b = (u.pm * BM) >> 13;
        f32x4 bv[2][2];
#pragma unroll
        for (int bj = 0; bj < 2; ++bj)
#pragma unroll
            for (int n = 0; n < 2; ++n) bv[bj][n] = *(const f32x4*)(bias + (size_t)b * bias_stride + col0 + bj * HALF + 4 * n);
#pragma unroll
        for (int ai = 0; ai < 2; ++ai)
#pragma unroll
            for (int m = 0; m < 4; ++m) { const int row = row0 + ai * HALF + m * 16; bf16_t* rowp = O + (size_t)row * ldc + col0;
                const f32x4 p0 = *(const f32x4*)(rss + (size_t)row * 16), p1 = *(const f32x4*)(rss + (size_t)row * 16 + 4), p2 = *(const f32x4*)(rss + (size_t)row * 16 + 8), p3 = *(const f32x4*)(rss + (size_t)row * 16 + 12);
                const f32x4 pt = (p0 + p1) + (p2 + p3);
                const float rs = __builtin_amdgcn_rsqf(((pt[0] + pt[1]) + (pt[2] + pt[3])) * (1.f / 1024.f) + 1e-6f);
#pragma unroll
                for (int bj = 0; bj < 2; ++bj) { const f32x4 v0 = acc[ai][bj][m][0] * rs + bv[bj][0], v1 = acc[ai][bj][m][1] * rs + bv[bj][1];
                    u32x4 w; w.x = cvt_pk_bf16(v0[0], v0[1]); w.y = cvt_pk_bf16(v0[2], v0[3]); w.z = cvt_pk_bf16(v1[0], v1[1]); w.w = cvt_pk_bf16(v1[2], v1[3]);
                    *(u32x4*)(rowp + bj * HALF) = w; } }
    }
};
struct EpiResid {
    static constexpr bool PERM = false, AFTER_DRAIN = false;
    const float* base; float* out; const float* gate;
    __device__ __forceinline__ void operator()(const f32x4 (&acc)[2][2][4][2], const Unit& u, int wr, int wc, int fr, int fq) const {
        const int col0 = u.pn * BM + wc * 32 + 4 * fq; const int b = (u.pm * BM) >> 13;
#pragma unroll
        for (int bj = 0; bj < 2; ++bj)
#pragma unroll
            for (int n = 0; n < 2; ++n) { const f32x4 gv = *(const f32x4*)(gate + (size_t)b * 6144 + col0 + bj * HALF + n * 16);
#pragma unroll
                for (int ai = 0; ai < 2; ++ai)
#pragma unroll
                    for (int m = 0; m < 4; ++m) { const size_t off = (size_t)(u.pm * BM + ai * HALF + wr * 64 + m * 16 + fr) * 1024 + col0 + bj * HALF + n * 16;
                        const f32x4 bs = *(const f32x4*)(base + off); *(f32x4*)(out + off) = bs + gv * acc[ai][bj][m][n]; } }
    }
};

template <class Epi, class Sched, bool ALIGN_EPI = false, bool SP2 = false>
__device__ __forceinline__ void gemm_phase(PG8_LAS unsigned char* lds, const Gemm g, const Sched& S, const Epi& E) {
    const int tid = threadIdx.x, wid = __builtin_amdgcn_readfirstlane(tid >> 6), lane = tid & 63, wr = wid >> 2, wc = wid & 3, fr = lane & 15, fq = lane >> 4;
    const int K = g.K, nt = K / BK;
    unsigned voffA[2], voffB[2];
#pragma unroll
    for (int i = 0; i < 2; ++i) { int R, C; stage_rc(tid * 16 + i * 8192, R, C); const int Rb = Epi::PERM ? ((R & ~31) + perm32(R & 31)) : R;
        voffA[i] = (unsigned)(R * K + C) * 2u; voffB[i] = (unsigned)(Rb * K + C) * 2u; }
    const size_t kstep = (size_t)(BK * 2);
    const size_t hstep = (size_t)HALF * K * 2;
    const size_t tstep = 2 * hstep;
    const unsigned ldsw = (unsigned)wid * 1024u;
    const int aoff = lds_byte(wr * 64 + fr, fq * 8), boff = lds_byte(wc * 32 + fr, fq * 8);
#define PG8_SA(b, h) (((b) * 2 + (h)) * HTB)
#define PG8_SB(b, h) ((4 + (b) * 2 + (h)) * HTB)
#define PG8_STAGE(bufoff, gbase, voff) do { _Pragma("unroll") for (int _i = 0; _i < 2; ++_i) \
        __builtin_amdgcn_global_load_lds((const unsigned*)((const char*)(gbase) + (voff)[_i]), (PG8_LAS unsigned*)(lds + (bufoff) + ldsw + _i * 8192), 16, 0, 0); } while (0)
#define PG8_LDA(dst, b, h) do { _Pragma("unroll") for (int m = 0; m < 4; ++m) _Pragma("unroll") for (int k = 0; k < 2; ++k) dst[m][k] = *(const PG8_LAS bf16x8*)(lds + PG8_SA(b, h) + aoff + m * 2048 + k * 1024); } while (0)
#define PG8_LDB(dst, b, h) do { _Pragma("unroll") for (int n = 0; n < 2; ++n) _Pragma("unroll") for (int k = 0; k < 2; ++k) dst[n][k] = *(const PG8_LAS bf16x8*)(lds + PG8_SB(b, h) + boff + n * 2048 + k * 1024); } while (0)
#define PG8_MMA(ai, bj, At, Bt) do { __builtin_amdgcn_s_setprio(1); _Pragma("unroll") for (int m = 0; m < 4; ++m) _Pragma("unroll") for (int n = 0; n < 2; ++n) _Pragma("unroll") for (int k = 0; k < 2; ++k) \
        acc[ai][bj][m][n] = __builtin_amdgcn_mfma_f32_16x16x32_bf16(Bt[n][k], At[m][k], acc[ai][bj][m][n], 0, 0, 0); __builtin_amdgcn_s_setprio(0); } while (0)
#define PG8_WAIT_V(n) asm volatile("s_waitcnt vmcnt(" #n ")" ::: "memory")
#define PG8_WAIT_L(n) asm volatile("s_waitcnt lgkmcnt(" #n ")" ::: "memory")
#define PG8_BAR __builtin_amdgcn_s_barrier()
#define PG8_SCHED __builtin_amdgcn_sched_barrier(0)
    Unit cur, nxt; int ui = 0;
    if (!S.next(0, cur)) return;
    f32x4 acc[2][2][4][2];
#pragma unroll
    for (int a = 0; a < 2; ++a)
#pragma unroll
        for (int b = 0; b < 2; ++b)
#pragma unroll
            for (int m = 0; m < 4; ++m)
#pragma unroll
                for (int n = 0; n < 2; ++n) acc[a][b][m][n] = (f32x4){0.f, 0.f, 0.f, 0.f};
    bf16x8 At[4][2], B0[2][2], B1[2][2];
    const char* cA = (const char*)g.A + (size_t)cur.pm * tstep; const char* cB = (const char*)g.Bt + (size_t)(cur.pm >> 5) * g.bstride + (size_t)cur.pn * tstep;
    S.a_ready(cur);
    if constexpr (SP2) {
        PG8_STAGE(PG8_SB(0, 0), cB, voffB); PG8_STAGE(PG8_SB(0, 1), cB + hstep, voffB); PG8_STAGE(PG8_SA(0, 0), cA, voffA); PG8_STAGE(PG8_SA(0, 1), cA + hstep, voffA);
        if (wr == 1) PG8_BAR;
        PG8_WAIT_V(2); PG8_BAR;
        PG8_STAGE(PG8_SB(1, 0), cB + kstep, voffB); PG8_STAGE(PG8_SA(1, 0), cA + kstep, voffA); PG8_STAGE(PG8_SB(1, 1), cB + hstep + kstep, voffB);
        PG8_WAIT_V(6); PG8_BAR;
    } else {
        PG8_STAGE(PG8_SB(0, 0), cB, voffB); PG8_STAGE(PG8_SA(0, 0), cA, voffA); PG8_STAGE(PG8_SB(0, 1), cB + hstep, voffB); PG8_STAGE(PG8_SA(0, 1), cA + hstep, voffA);
        if (wr == 1) PG8_BAR;
        PG8_WAIT_V(4); PG8_BAR;
        PG8_STAGE(PG8_SB(1, 0), cB + kstep, voffB); PG8_STAGE(PG8_SA(1, 0), cA + kstep, voffA); PG8_STAGE(PG8_SB(1, 1), cB + hstep + kstep, voffB);
        PG8_WAIT_V(6); PG8_BAR;
    }
    for (;;) {
        const bool has_next = S.next(ui + 1, nxt);
        const char* nA = has_next ? (const char*)g.A + (size_t)nxt.pm * tstep : cA; const char* nB = has_next ? (const char*)g.Bt + (size_t)(nxt.pm >> 5) * g.bstride + (size_t)nxt.pn * tstep : cB;
        for (int t = 0; t < nt; t += 2) {
            const bool last = (t == nt - 2);
            const char* a1 = cA + (size_t)(t + 1) * kstep;
            const char* a2 = last ? nA : cA + (size_t)(t + 2) * kstep; const char* b2 = last ? nB : cB + (size_t)(t + 2) * kstep;
            const char* a3 = a2 + kstep; const char* b3 = b2 + kstep;
            if (last && has_next) S.a_ready(nxt);
            if constexpr (SP2) {
            PG8_LDB(B0, 0, 0); PG8_LDB(B1, 0, 1); PG8_SCHED; PG8_LDA(At, 0, 0); PG8_STAGE(PG8_SA(1, 1), a1 + hstep, voffA);
            PG8_WAIT_V(8); PG8_WAIT_L(0); PG8_BAR; PG8_MMA(0, 0, At, B0); PG8_MMA(0, 1, At, B1); PG8_BAR; PG8_SCHED;
            PG8_LDA(At, 0, 1); PG8_STAGE(PG8_SB(0, 0), b2, voffB); PG8_STAGE(PG8_SB(0, 1), b2 + hstep, voffB); PG8_STAGE(PG8_SA(0, 0), a2, voffA);
            PG8_WAIT_V(8); PG8_WAIT_L(0); PG8_BAR; PG8_MMA(1, 0, At, B0); PG8_MMA(1, 1, At, B1); PG8_BAR; PG8_SCHED;
            PG8_LDB(B0, 1, 0); PG8_LDB(B1, 1, 1); PG8_SCHED; PG8_LDA(At, 1, 0); PG8_STAGE(PG8_SA(0, 1), a2 + hstep, voffA);
            PG8_WAIT_V(8); PG8_WAIT_L(0); PG8_BAR; PG8_MMA(0, 0, At, B0); PG8_MMA(0, 1, At, B1); PG8_BAR; PG8_SCHED;
            PG8_LDA(At, 1, 1); PG8_STAGE(PG8_SB(1, 0), b3, voffB); PG8_STAGE(PG8_SB(1, 1), b3 + hstep, voffB); PG8_STAGE(PG8_SA(1, 0), a3, voffA);
            PG8_WAIT_V(8); PG8_WAIT_L(0); PG8_BAR; PG8_MMA(1, 0, At, B0); PG8_MMA(1, 1, At, B1); PG8_BAR; PG8_SCHED;
            } else {
            PG8_LDB(B0, 0, 0); PG8_SCHED; PG8_LDA(At, 0, 0); PG8_STAGE(PG8_SA(1, 1), a1 + hstep, voffA);
            PG8_WAIT_L(8); PG8_BAR; PG8_WAIT_L(0); PG8_MMA(0, 0, At, B0); PG8_BAR; PG8_SCHED;
            PG8_LDB(B1, 0, 1); PG8_STAGE(PG8_SB(0, 0), b2, voffB);
            PG8_BAR; PG8_WAIT_L(0); PG8_MMA(0, 1, At, B1); PG8_BAR;
            PG8_LDA(At, 0, 1); PG8_STAGE(PG8_SA(0, 0), a2, voffA);
            PG8_BAR; PG8_WAIT_L(0); PG8_MMA(1, 0, At, B0); PG8_BAR; PG8_SCHED;
            PG8_STAGE(PG8_SB(0, 1), b2 + hstep, voffB);
            PG8_WAIT_V(6); PG8_BAR; PG8_MMA(1, 1, At, B1); PG8_BAR;
            PG8_LDB(B0, 1, 0); PG8_SCHED; PG8_LDA(At, 1, 0); PG8_STAGE(PG8_SA(0, 1), a2 + hstep, voffA);
            PG8_WAIT_L(8); PG8_BAR; PG8_WAIT_L(0); PG8_MMA(0, 0, At, B0); PG8_BAR; PG8_SCHED;
            PG8_LDB(B1, 1, 1); PG8_STAGE(PG8_SB(1, 0), b3, voffB);
            PG8_BAR; PG8_WAIT_L(0); PG8_MMA(0, 1, At, B1); PG8_BAR;
            PG8_LDA(At, 1, 1); PG8_STAGE(PG8_SA(1, 0), a3, voffA);
            PG8_BAR; PG8_WAIT_L(0); PG8_MMA(1, 0, At, B0); PG8_BAR; PG8_SCHED;
            PG8_STAGE(PG8_SB(1, 1), b3 + hstep, voffB);
            PG8_WAIT_V(6); PG8_BAR; PG8_MMA(1, 1, At, B1); PG8_BAR;
            }
        }
        if constexpr (ALIGN_EPI) { if (wr == 0) PG8_BAR; }
        if constexpr (!Epi::AFTER_DRAIN) { E(acc, cur, wr, wc, fr, fq); S.done(cur); }
        if (!has_next) break;
#pragma unroll
        for (int a = 0; a < 2; ++a)
#pragma unroll
            for (int b = 0; b < 2; ++b)
#pragma unroll
                for (int m = 0; m < 4; ++m)
#pragma unroll
                    for (int n = 0; n < 2; ++n) acc[a][b][m][n] = (f32x4){0.f, 0.f, 0.f, 0.f};
        cur = nxt; cA = nA; cB = nB; ++ui;
        if constexpr (ALIGN_EPI) { if (wr == 1) PG8_BAR; }
    }
    PG8_WAIT_V(0);
    if constexpr (!ALIGN_EPI) { if (wr == 0) PG8_BAR; }
    PG8_BAR;
    if constexpr (Epi::AFTER_DRAIN) { E.fused(acc, cur, wr, wc, fr, fq, lds, wid, lane); S.done(cur); }
#undef PG8_SA
#undef PG8_SB
#undef PG8_STAGE
#undef PG8_LDA
#undef PG8_LDB
#undef PG8_MMA
#undef PG8_WAIT_V
#undef PG8_WAIT_L
#undef PG8_BAR
#undef PG8_SCHED
}
}
constexpr int NB = 4, SEQ = 8192, D = 1024, M = NB * SEQ;
constexpr int NZ0 = 3584, NZ1 = 3072, NQ = 2048, SRC_IN0 = 3592;
constexpr float EPS = 1e-6f;
constexpr int NWAVES = 8, NTHR = 512;
constexpr float LOG2E = 1.4426950408889634f;
constexpr size_t MiB = 1u << 20;
constexpr size_t WS_CTL = 0, CTL_ZERO_BYTES = 1 * MiB;
constexpr size_t WS_WIN0 = 1 * MiB, WS_WOUT0 = 8 * MiB, WS_WIN1 = 10 * MiB, WS_WOUT1 = 16 * MiB, WS_WQ = 18 * MiB;
constexpr size_t WS_KEYS = 26 * MiB, WS_MOD = WS_KEYS + 128 * 1024, WS_KMEAN = WS_MOD + 192 * 1024, WS_NLOC = WS_KMEAN + 256 * 1024,
                 WS_BEND = WS_NLOC + 512 * 1024, WS_MLOC = WS_BEND + 4096, WS_MPREV = WS_MLOC + 4096,
                 WS_ISU = 27 * MiB + 512 * 1024, WS_ISV = WS_ISU + 128 * 1024, WS_ORD = WS_ISV + 128 * 1024  ,
                 WS_QB = WS_ORD + 8 * 1024  , WS_GTAB = WS_QB + 64 * 1024  ;
constexpr size_t WS_GATES = 28 * MiB;
constexpr size_t WS_UB = 32 * MiB  , WS_VB = 64 * MiB, WS_ACT = 96 * MiB  , WS_ACTS = 100 * MiB  , WS_WQF = 112 * MiB  , WS_XNY = 160 * MiB, WS_Z = 224 * MiB, WS_CLOC = 448 * MiB, WS_END = 512 * MiB;
constexpr size_t WS_QRY = WS_Z, WS_IDX = WS_Z + 128 * MiB, WS_GATE = WS_Z + 144 * MiB, WS_PART = WS_Z  , WS_X1B = 448 * MiB  ;
constexpr size_t WS_RSS = 104 * MiB;
constexpr int CW_BAR = 4096, CW_QMOBA = 8192  , CW_QDIFF = 8448, CW_QCVT0 = 8704, CW_QCVT1 = 8768;
constexpr float ALIBI_MARGIN = 27.03f;
constexpr int RING_BYTES = 139264;
constexpr int LDSCTL_OFF = RING_BYTES, MISC_OFF = LDSCTL_OFF + 320;
constexpr int LDS_BYTES = 147456;
static_assert(MISC_OFF + 128 <= LDS_BYTES, "LDS map");

#define GAS __attribute__((address_space(1)))
#define LAS __attribute__((address_space(3)))
typedef unsigned short bf16;
typedef unsigned v4u __attribute__((ext_vector_type(4)));
typedef unsigned v2u __attribute__((ext_vector_type(2)));
typedef float f32x4 __attribute__((ext_vector_type(4)));
typedef float f32x16 __attribute__((ext_vector_type(16)));
typedef short bf16x8 __attribute__((ext_vector_type(8)));
typedef short s16x4 __attribute__((ext_vector_type(4)));
typedef GAS unsigned gu32;
#define RLX_AGENT __ATOMIC_RELAXED, __HIP_MEMORY_SCOPE_AGENT
#define LDS_WAIT() asm volatile("s_waitcnt lgkmcnt(0)" ::: "memory")
#define VM_WAIT() asm volatile("s_waitcnt vmcnt(0)" ::: "memory")
__device__ __forceinline__ unsigned f2bf(float f) { unsigned u = __builtin_bit_cast(unsigned, f); return (u + 0x7fffu + ((u >> 16) & 1u)) >> 16; }
__device__ __forceinline__ unsigned pk2(float lo, float hi) { return f2bf(lo) | (f2bf(hi) << 16); }
__device__ __forceinline__ float bflo(unsigned w) { return __builtin_bit_cast(float, w << 16); }
__device__ __forceinline__ float bfhi(unsigned w) { return __builtin_bit_cast(float, w & 0xffff0000u); }
__device__ __forceinline__ float bf2f(bf16 h) { return __builtin_bit_cast(float, (unsigned)h << 16); }
__device__ __forceinline__ unsigned f2u(float x) { return __builtin_bit_cast(unsigned, x); }
__device__ __forceinline__ float u2f(unsigned x) { return __builtin_bit_cast(float, x); }
__device__ __forceinline__ float dot2bf(unsigned a, unsigned b, float acc) { typedef __bf16 bf2_ __attribute__((ext_vector_type(2))); return __builtin_amdgcn_fdot2_f32_bf16(__builtin_bit_cast(bf2_, a), __builtin_bit_cast(bf2_, b), acc, false); }
__device__ __forceinline__ float wave_sum(float v) {
#pragma unroll
    for (int o = 1; o < 64; o <<= 1) v += __shfl_xor(v, o);
    return v;
}
__device__ __forceinline__ float wave_max(float v) {
#pragma unroll
    for (int o = 1; o < 64; o <<= 1) v = fmaxf(v, __shfl_xor(v, o));
    return v;
}
__device__ __forceinline__ float silu_f(float x) { return x / (1.f + __expf(-x)); }
__device__ __forceinline__ float sigmoid_f(float x) { return 1.f / (1.f + __expf(-x)); }
__device__ __forceinline__ float logsigmoid_f(float x) { return fminf(x, 0.f) - log1pf(__expf(-fabsf(x))); }
struct Args { const float* in[24]; float* out; unsigned char* ws; int ph_lo, ph_hi; };
#define XB_TMO      128
#define XB_XCNT(j)  (256  + 64 * (j))
#define XB_XSUB(j)  (1280 + 64 * (j))
#define XB_XGEN(j)  (2304 + 64 * (j))
#define XB_TOP      3328
#define XB_TOPGEN   3392
#define XCD_BAR_WORDS 3456
#define XB_SPIN_CAP (1u << 18)

__device__ __forceinline__ unsigned xb_ld(unsigned* p)              { return __hip_atomic_load(p, __ATOMIC_RELAXED, __HIP_MEMORY_SCOPE_AGENT); }
__device__ __forceinline__ unsigned xb_add(unsigned* p, unsigned v) { return __hip_atomic_fetch_add(p, v, __ATOMIC_RELAXED, __HIP_MEMORY_SCOPE_AGENT); }
__device__ __forceinline__ unsigned xb_xcc_id() { return (unsigned)__builtin_amdgcn_s_getreg((3 << 11) | 20) & 0xFu; }
#define XB_SPIN(cond, bar) do { unsigned _sp = 0; while (cond) { __builtin_amdgcn_s_sleep(1); \
    if ((++_sp & 255u) == 0u) { if (xb_ld(&(bar)[XB_TMO])) break; if (_sp > XB_SPIN_CAP) { atomicAdd(&(bar)[XB_TMO], 1u); break; } } } } while (0)

struct XcdBarrier {
    unsigned* bar; unsigned x;
    volatile LAS unsigned* st;
};

__device__ __forceinline__ XcdBarrier xcd_barrier_post(unsigned* bar, volatile LAS unsigned* st) {
    XcdBarrier b; b.bar = bar; b.x = xb_xcc_id(); b.st = st;
    if (threadIdx.x == 0) (void)xb_add(&bar[XB_XCNT(b.x)], 1u);
    return b;
}
__device__ __forceinline__ void xcd_barrier_complete(unsigned* bar, unsigned x, unsigned& nloc, unsigned& nx) {
    const unsigned G = gridDim.x * gridDim.y * gridDim.z;
    unsigned sum, cnt, mine, sp = 0u;
    for (;;) {
        sum = 0u; cnt = 0u; mine = 0u;
#pragma unroll
        for (unsigned j = 0; j < 16; ++j) { const unsigned c = xb_ld(&bar[XB_XCNT(j)]); sum += c; cnt += (c > 0u) ? 1u : 0u; mine = (j == x) ? c : mine; }
        if (sum == G) break;
        __builtin_amdgcn_s_sleep(1);
        if ((++sp & 255u) == 0u) { if (xb_ld(&bar[XB_TMO])) break; if (sp > XB_SPIN_CAP) { atomicAdd(&bar[XB_TMO], 1u); break; } }
    }
    nloc = mine > 0u ? mine : 1u; nx = cnt > 0u ? cnt : 1u;
}

__device__ __forceinline__ void xcd_barrier(const XcdBarrier& b) {
    asm volatile("s_waitcnt vmcnt(0)" ::: "memory");
    __syncthreads();
    if (threadIdx.x == 0) {
        unsigned* bar = b.bar;
        __builtin_amdgcn_s_waitcnt(0);
        unsigned nloc = b.st[0], nx = b.st[1];
        if (nloc == 0u) { xcd_barrier_complete(bar, b.x, nloc, nx); b.st[0] = nloc; b.st[1] = nx; }
        const unsigned old = xb_add(&bar[XB_XSUB(b.x)], 1u);
        const unsigned gen = old / nloc;
        if (old + 1u == (gen + 1u) * nloc) {
            __builtin_amdgcn_fence(__ATOMIC_RELEASE, "agent");
            asm volatile("s_waitcnt vmcnt(0)" ::: "memory");
            const unsigned og = xb_add(&bar[XB_TOP], 1u);
            const unsigned tg = og / nx;
            if (og + 1u == (tg + 1u) * nx) xb_add(&bar[XB_TOPGEN], 1u);
            else XB_SPIN(xb_ld(&bar[XB_TOPGEN]) == tg, bar);
            __builtin_amdgcn_fence(__ATOMIC_ACQUIRE, "agent");
            xb_add(&bar[XB_XGEN(b.x)], 1u);
            asm volatile("s_waitcnt vmcnt(0)" ::: "memory");
        } else {
            XB_SPIN(xb_ld(&bar[XB_XGEN(b.x)]) == gen, bar);
            __builtin_amdgcn_fence(__ATOMIC_ACQUIRE, "agent");
            asm volatile("s_waitcnt vmcnt(0)" ::: "memory");
        }
    }
    __syncthreads();
}
struct Frame {
    LAS unsigned char* lds;
    int wave, G, bid;
    float* out; unsigned char* ws;
};
#define WSP(T, off) ((T*)(F.ws + (off)))

__device__ __forceinline__ void p0_transpose_item(const float* W, int K, int ldw, int nblk, int thr, int shift, bf16* WT, LAS float* scr, int item, int lane) {
    const int kb = item / nblk, nb = item % nblk, k0 = 64 * kb, n0 = 32 * nb, ns = n0 + (n0 >= thr ? shift : 0);
#pragma unroll 8
    for (int i = 0; i < 32; ++i) { const int kk = 2 * i + (lane >> 5); scr[kk * 33 + (lane & 31)] = W[(size_t)(k0 + kk) * ldw + ns + (lane & 31)]; }
    LDS_WAIT(); asm volatile("" ::: "memory");
    const int c = lane & 7;
#pragma unroll
    for (int j = 0; j < 4; ++j) { const int n = (lane >> 3) + 8 * j; const LAS float* s = scr + (8 * c) * 33 + n;
        v4u o; o.x = pk2(s[0 * 33], s[1 * 33]); o.y = pk2(s[2 * 33], s[3 * 33]); o.z = pk2(s[4 * 33], s[5 * 33]); o.w = pk2(s[6 * 33], s[7 * 33]);
        *(GAS v4u*)(WT + (size_t)(n0 + n) * K + k0 + 8 * c) = o; }
    LDS_WAIT(); asm volatile("" ::: "memory");
}
__device__ __forceinline__ void cvt_f32_bf16_stream(const float* src, bf16* dst, size_t n8, size_t gtid, size_t gthreads) {
    for (size_t i = gtid; i < n8; i += gthreads) {
        const f32x4 a = *(const GAS f32x4*)(src + i * 8), b = *(const GAS f32x4*)(src + i * 8 + 4);
        v4u o; o.x = pk2(a.x, a.y); o.y = pk2(a.z, a.w); o.z = pk2(b.x, b.y); o.w = pk2(b.z, b.w);
        *(GAS v4u*)(dst + i * 8) = o; }
}
__device__ __forceinline__ void i8_row(const float* src_row, unsigned char* dst  , float* scale  , int er, int lane) {
    const float* r = src_row + 16 * lane;
    float x[16];
#pragma unroll
    for (int q4 = 0; q4 < 4; ++q4) { const f32x4 a = *(const GAS f32x4*)(r + 4 * q4); x[4 * q4] = a.x; x[4 * q4 + 1] = a.y; x[4 * q4 + 2] = a.z; x[4 * q4 + 3] = a.w; }
    float am = 0.f;
#pragma unroll
    for (int i = 0; i < 16; ++i) am = fmaxf(am, fabsf(x[i]));
    am = wave_max(am);
    const float inv = am > 1e-30f ? 127.f / am : 0.f;
    unsigned wd[4];
#pragma unroll
    for (int q4 = 0; q4 < 4; ++q4) { unsigned w = 0;
#pragma unroll
        for (int e = 0; e < 4; ++e) { const int qv = (int)rintf(x[4 * q4 + e] * inv); w |= ((unsigned)qv & 0xffu) << (8 * e); }
        wd[q4] = w; }
    v4u o; o.x = wd[0]; o.y = wd[1]; o.z = wd[2]; o.w = wd[3];
    *(GAS v4u*)(dst + ((size_t)((lane >> 3) * 16384 + er)) * 128 + 16 * (lane & 7)) = o;
    if (lane == 0) scale[er] = am * (1.f / 127.f);
}
__device__ __forceinline__ void i8_chunk(Frame& F, const Args& A, int layer, int c) {
    const int tbl = c >> 8, row0 = (c & 255) * 64 + F.wave * 8;
    const float* src = A.in[22 + tbl] + (size_t)layer * 16384 * 1024;
    unsigned char* dst = F.ws + (tbl ? WS_VB : WS_UB) + (size_t)layer * 8 * 16384 * 128;
    float* sc = WSP(float, tbl ? WS_ISV : WS_ISU) + layer * 16384;
    for (int i = 0; i < 8; ++i) i8_row(src + (size_t)(row0 + i) * 1024, dst, sc, row0 + i, ((int)(threadIdx.x & 63u)));
}
__device__ __forceinline__ void p0_prologue(Frame& F, const Args& A) {
    {
        const float* c = A.in[1]; const float* aw = A.in[2]; const float* ab = A.in[3]; float* MOD = WSP(float, WS_MOD);
        LAS float* red = (LAS float*)F.lds;
        for (int item = F.bid; item < 192; item += F.G) {
            const int l = item / 96, n0 = (item % 96) * 64;
            float acc[4] = {0.f, 0.f, 0.f, 0.f};
            const int kbeg = F.wave * 128;
#pragma unroll 4
            for (int k = kbeg; k < kbeg + 128; ++k) {
                const float wv = aw[((size_t)l * 1024 + k) * 6144 + n0 + ((int)(threadIdx.x & 63u))];
#pragma unroll
                for (int b = 0; b < 4; ++b) acc[b] += silu_f(c[b * 1024 + k]) * wv;
            }
#pragma unroll
            for (int b = 0; b < 4; ++b) red[(F.wave * 4 + b) * 64 + ((int)(threadIdx.x & 63u))] = acc[b];
            __syncthreads();
            if (((int)threadIdx.x) < 256) { const int b = ((int)threadIdx.x) >> 6, ln = ((int)threadIdx.x) & 63; float s = ab[l * 6144 + n0 + ln];
#pragma unroll
                for (int w = 0; w < 8; ++w) s += red[(w * 4 + b) * 64 + ln];
                MOD[(size_t)(l * 4 + b) * 6144 + n0 + ln] = s; }
            __syncthreads();
        }
    }
    if (F.bid == 0) {
        LAS unsigned* hist = (LAS unsigned*)F.lds;
        unsigned short* ORD = WSP(unsigned short, WS_ORD);
        const int tid = (int)threadIdx.x;
        for (int pass = 0; pass < 2; ++pass) {
            const int nq = pass == 0 ? 64 : 32, nper = 4 * nq;
            for (int x = 0; x < 8; ++x) {
                if (tid < 160) hist[tid] = 0u;
                __syncthreads();
                int cost = 0, u = 0;
                if (tid < nper) {
                    const int hs = tid / nq, q = tid % nq, h = (x >> 2) ? (hs == 0 ? 6 : hs == 1 ? 5 : hs == 2 ? 1 : 0) : (hs == 0 ? 7 : hs == 1 ? 4 : hs == 2 ? 3 : 2), b = x & 3;
                    const float dcut = 46.f * (float)(2 << h);
                    if (pass == 0) { const int nt = 2 * q + 2; int lo = (int)ceilf(((float)(q * 128) - dcut - 63.f) * (1.f / 64.f)); if (lo < 0) lo = 0; cost = nt - lo; u = (b << 9) | (h << 6) | q; }
                    else { int lo = (int)ceilf(((float)(q * 256) - dcut - 255.f) * (1.f / 256.f)); if (lo < 0) lo = 0; int nb = q - lo; if (nb > 24) nb = 24; cost = 4 * (nb + 1); u = (b << 8) | (h << 5) | q; }
                    if (cost > 159) cost = 159;
                    atomicAdd((unsigned*)(hist + (159 - cost)), 1u);
                }
                __syncthreads();
                if (tid == 0) { unsigned acc = 0; for (int i = 0; i < 160; ++i) { const unsigned c = hist[i]; hist[i] = acc; acc += c; } }
                __syncthreads();
                if (tid < nper) { const unsigned pos = atomicAdd((unsigned*)(hist + (159 - cost)), 1u); ORD[(pass == 0 ? 0 : 2048) + x * nper + pos] = (unsigned short)u; }
                __syncthreads();
            }
        }
    }
    {
        LAS float* scr = (LAS float*)(F.lds + F.wave * 8704);
        const int gw = F.bid * NWAVES + F.wave, NGW = F.G * NWAVES;
        constexpr int I_IN0 = 16 * (NZ0 / 32), I_OUT = 16 * 32, I_IN1 = 16 * (NZ1 / 32), I_Q = 16 * (NQ / 32);
        constexpr int NITEMS = I_IN0 + 2 * I_OUT + I_IN1 + 2 * I_Q;
        for (int it = gw; it < NITEMS; it += NGW) {
            int r = it;
            if (r < I_IN0) { p0_transpose_item(A.in[6], D, SRC_IN0, NZ0 / 32, 2048, 8, WSP(bf16, WS_WIN0), scr, r, ((int)(threadIdx.x & 63u))); continue; } r -= I_IN0;
            if (r < I_OUT) { p0_transpose_item(A.in[13], D, D, 32, 1 << 30, 0, WSP(bf16, WS_WOUT0), scr, r, ((int)(threadIdx.x & 63u))); continue; } r -= I_OUT;
            if (r < I_IN1) { p0_transpose_item(A.in[14], D, NZ1, NZ1 / 32, 1 << 30, 0, WSP(bf16, WS_WIN1), scr, r, ((int)(threadIdx.x & 63u))); continue; } r -= I_IN1;
            if (r < I_OUT) { p0_transpose_item(A.in[19], D, D, 32, 1 << 30, 0, WSP(bf16, WS_WOUT1), scr, r, ((int)(threadIdx.x & 63u))); continue; } r -= I_OUT;
            if (r < I_Q) { p0_transpose_item(A.in[20], D, NQ, NQ / 32, 1 << 30, 0, WSP(bf16, WS_WQ), scr, r, ((int)(threadIdx.x & 63u))); continue; } r -= I_Q;
            p0_transpose_item(A.in[20] + (size_t)D * NQ, D, NQ, NQ / 32, 1 << 30, 0, WSP(bf16, WS_WQ) + (size_t)NQ * D, scr, r, ((int)(threadIdx.x & 63u)));
        }
    }
    {
        const size_t gtid = (size_t)F.bid * NTHR + ((int)threadIdx.x), gth = (size_t)F.G * NTHR;
        cvt_f32_bf16_stream(A.in[21], WSP(bf16, WS_KEYS), (size_t)2 * 2 * 128 * 128 / 8, gtid, gth);
    }
}

template <bool GATES>
__device__ __forceinline__ void norm_pass(Frame& F, const Args& A, const float* X, const float* g, const float* mod, int shc, bf16* XN) {
    LAS float* wgT = (LAS float*)F.lds;
    if (GATES) {
        const float* win = A.in[6];
        for (int i = ((int)threadIdx.x); i < 8 * 1024; i += NTHR) { const int cg = i >> 10, k = i & 1023; wgT[i] = win[(size_t)k * SRC_IN0 + 2048 + cg]; }
        __syncthreads();
    }
    const int gw = F.bid * NWAVES + F.wave, NGW = F.G * NWAVES;
    for (int row = gw; row < M; row += NGW) {
        const int b = row >> 13;
        const GAS f32x4* xr = (const GAS f32x4*)(X + (size_t)row * D) + ((int)(threadIdx.x & 63u));
        f32x4 v[4]; float ss = 0.f;
#pragma unroll
        for (int j = 0; j < 4; ++j) { v[j] = xr[64 * j]; ss += (v[j].x * v[j].x + v[j].y * v[j].y) + (v[j].z * v[j].z + v[j].w * v[j].w); }
        const float rstd = rsqrtf(wave_sum(ss) * (1.f / D) + EPS);
        const float* shp = mod + (size_t)b * 6144 + shc * 1024; const float* scp = shp + 1024;
#pragma unroll
        for (int j = 0; j < 4; ++j) { const int c = 4 * ((int)(threadIdx.x & 63u)) + 256 * j;
            const f32x4 gg = *(const f32x4*)(g + c), sc = *(const f32x4*)(scp + c), sh = *(const f32x4*)(shp + c);
            v[j] = v[j] * rstd * gg * (sc + 1.f) + sh;
            v2u o; o.x = pk2(v[j].x, v[j].y); o.y = pk2(v[j].z, v[j].w);
            *(GAS v2u*)(XN + (size_t)row * D + c) = o; }
        if (GATES) {
            float* GT = WSP(float, WS_GATES);
#pragma unroll
            for (int cg = 0; cg < 8; ++cg) { float p = 0.f;
#pragma unroll
                for (int j = 0; j < 4; ++j) { const f32x4 w = *(const LAS f32x4*)(wgT + cg * 1024 + 4 * ((int)(threadIdx.x & 63u)) + 256 * j); p += (v[j].x * w.x + v[j].y * w.y) + (v[j].z * w.z + v[j].w * w.w); }
                p = wave_sum(p);
                if (((int)(threadIdx.x & 63u)) == 0) GT[(size_t)row * 8 + cg] = p + (cg < 4 ? A.in[8][cg] : A.in[9][cg - 4]); }
        }
    }
}

__device__ __forceinline__ void qknorm_unit(Frame& F, bf16* Z, int ldz, int row0, int col0, const float* g, float gmul, float* kmean  ) {
    const int c = col0 + 8 * ((int)(threadIdx.x & 63u)), d0 = (8 * ((int)(threadIdx.x & 63u))) & 63;
    float gv[8];
#pragma unroll
    for (int i = 0; i < 8; ++i) gv[i] = g[d0 + i] * gmul;
    float ks[8] = {0.f, 0.f, 0.f, 0.f, 0.f, 0.f, 0.f, 0.f};
    for (int r = 0; r < 32; ++r) {
        bf16* p = Z + (size_t)(row0 + F.wave * 32 + r) * ldz + c;
        const v4u w = *(const GAS v4u*)p;
        float x[8] = {bflo(w.x), bfhi(w.x), bflo(w.y), bfhi(w.y), bflo(w.z), bfhi(w.z), bflo(w.w), bfhi(w.w)};
        float ss = 0.f;
#pragma unroll
        for (int i = 0; i < 8; ++i) ss += x[i] * x[i];
        ss += __shfl_xor(ss, 1); ss += __shfl_xor(ss, 2); ss += __shfl_xor(ss, 4);
        const float rstd = rsqrtf(ss * (1.f / 64.f) + EPS);
#pragma unroll
        for (int i = 0; i < 8; ++i) { x[i] = x[i] * rstd * gv[i]; ks[i] += x[i]; }
        v4u o; o.x = pk2(x[0], x[1]); o.y = pk2(x[2], x[3]); o.z = pk2(x[4], x[5]); o.w = pk2(x[6], x[7]);
        *(GAS v4u*)p = o;
    }
    if (kmean) {
        LAS float* red = (LAS float*)F.lds;
#pragma unroll
        for (int i = 0; i < 8; ++i) red[F.wave * 512 + 8 * ((int)(threadIdx.x & 63u)) + i] = ks[i];
        __syncthreads();
        { float s = 0.f;
#pragma unroll
          for (int w = 0; w < 8; ++w) s += red[w * 512 + ((int)threadIdx.x)];
          kmean[(size_t)(((int)threadIdx.x) >> 6) * (32 * 64) + (((int)threadIdx.x) & 63)] = s * (1.f / 256.f); }
        __syncthreads();
    }
}

__device__ __forceinline__ void kmean_unit(Frame& F, const bf16* Z, int ldz, int row0, int col0, float* kmean) {
    const int c = col0 + 8 * ((int)(threadIdx.x & 63u));
    float ks[8] = {0.f, 0.f, 0.f, 0.f, 0.f, 0.f, 0.f, 0.f};
#pragma unroll 4
    for (int r = 0; r < 32; ++r) {
        const v4u w = *(const GAS v4u*)(Z + (size_t)(row0 + F.wave * 32 + r) * ldz + c);
        ks[0] += bflo(w.x); ks[1] += bfhi(w.x); ks[2] += bflo(w.y); ks[3] += bfhi(w.y); ks[4] += bflo(w.z); ks[5] += bfhi(w.z); ks[6] += bflo(w.w); ks[7] += bfhi(w.w);
    }
    LAS float* red = (LAS float*)F.lds;
#pragma unroll
    for (int i = 0; i < 8; ++i) red[F.wave * 512 + 8 * ((int)(threadIdx.x & 63u)) + i] = ks[i];
    __syncthreads();
    { float s = 0.f;
#pragma unroll
      for (int w = 0; w < 8; ++w) s += red[w * 512 + ((int)threadIdx.x)];
      kmean[(size_t)(((int)threadIdx.x) >> 6) * (32 * 64) + (((int)threadIdx.x) & 63)] = s * (1.f / 256.f); }
    __syncthreads();
}

constexpr int KSTRB = 144;
template <int DV> struct VStr { static constexpr int B = (DV == 64) ? 192 : 320; };
typedef short v4i16_t __attribute__((ext_vector_type(4)));
__device__ __forceinline__ s16x4 vtr(const LAS unsigned char* p) { return __builtin_bit_cast(s16x4, __builtin_amdgcn_ds_read_tr16_b64_v4i16((LAS v4i16_t*)p)); }
__device__ __forceinline__ unsigned cvtpk(float lo, float hi) { typedef float f2 __attribute__((ext_vector_type(2))); typedef __bf16 b2 __attribute__((ext_vector_type(2)));
    f2 v = {lo, hi}; b2 b = __builtin_convertvector(v, b2); return __builtin_bit_cast(unsigned, b); }
__device__ __forceinline__ float xhalf(float v) {
    auto rr = __builtin_amdgcn_permlane32_swap(__builtin_bit_cast(unsigned, v), __builtin_bit_cast(unsigned, v), false, false);
    const unsigned r0 = rr[0], r1 = rr[1]; return u2f((threadIdx.x & 32) ? r0 : r1);
}
template <int DV> struct AttnSt { f32x16 o[DV / 32]; float m, l; };
template <int DV> __device__ __forceinline__ void attn_init(AttnSt<DV>& st) {
#pragma unroll
    for (int t = 0; t < DV / 32; ++t)
#pragma unroll
        for (int r = 0; r < 16; ++r) st.o[t][r] = 0.f;
    st.m = -1e30f; st.l = 0.f;
}
template <int DV>
__device__ __forceinline__ void attn_qk(AttnSt<DV>& st, const LAS unsigned char* Kt, const bf16x8 (&qf)[4], float sl2, int tq, int kt0, bool diag, bool rowok, int lane, bf16x8 (&pf)[2][2]) {
    const int r32 = lane & 31, hi = lane >> 5;
    const int kb = kt0 + 4 * hi;
    const float ref = st.m > -1e29f ? st.m : 0.f;
    const float c0 = -sl2 * (float)(tq - kb) - ref;
    f32x16 s0, s1;
#pragma unroll
    for (int r = 0; r < 16; ++r) { const int ko = (r & 3) + 8 * (r >> 2); s0[r] = c0 + sl2 * (float)ko; s1[r] = c0 + sl2 * (float)(ko + 32); }
    const LAS unsigned char* kp = Kt + r32 * KSTRB + hi * 16;
#pragma unroll
    for (int ks = 0; ks < 4; ++ks) {
        const bf16x8 k0 = *(const LAS bf16x8*)(kp + ks * 32), k1 = *(const LAS bf16x8*)(kp + 32 * KSTRB + ks * 32);
        s0 = __builtin_amdgcn_mfma_f32_32x32x16_bf16(k0, qf[ks], s0, 0, 0, 0);
        s1 = __builtin_amdgcn_mfma_f32_32x32x16_bf16(k1, qf[ks], s1, 0, 0, 0);
    }
    if (diag || !rowok) {
#pragma unroll
        for (int r = 0; r < 16; ++r) { const int ko = (r & 3) + 8 * (r >> 2);
            if (!rowok || kb + ko > tq) s0[r] = -INFINITY;
            if (!rowok || kb + ko + 32 > tq) s1[r] = -INFINITY; }
    }
    float mx = fmaxf(s0[0], s1[0]);
#pragma unroll
    for (int r = 1; r < 16; ++r) mx = fmaxf(mx, fmaxf(s0[r], s1[r]));
    mx = fmaxf(mx, xhalf(mx));
    const float mnew = fmaxf(st.m, ref + mx);
    if (__any(mnew > st.m)) {
        const float alpha = __builtin_amdgcn_exp2f(st.m - mnew), dd = mnew - ref;
        st.m = mnew; st.l *= alpha;
#pragma unroll
        for (int t = 0; t < DV / 32; ++t)
#pragma unroll
            for (int r = 0; r < 16; ++r) st.o[t][r] *= alpha;
#pragma unroll
        for (int r = 0; r < 16; ++r) { s0[r] -= dd; s1[r] -= dd; }
    }
#pragma unroll
    for (int r = 0; r < 16; ++r) { s0[r] = __builtin_amdgcn_exp2f(s0[r]); s1[r] = __builtin_amdgcn_exp2f(s1[r]); }
#pragma unroll
    for (int s = 0; s < 2; ++s) {
        v4u a, b;
        a.x = cvtpk(s0[8 * s + 0], s0[8 * s + 1]); a.y = cvtpk(s0[8 * s + 2], s0[8 * s + 3]); a.z = cvtpk(s0[8 * s + 4], s0[8 * s + 5]); a.w = cvtpk(s0[8 * s + 6], s0[8 * s + 7]);
        b.x = cvtpk(s1[8 * s + 0], s1[8 * s + 1]); b.y = cvtpk(s1[8 * s + 2], s1[8 * s + 3]); b.z = cvtpk(s1[8 * s + 4], s1[8 * s + 5]); b.w = cvtpk(s1[8 * s + 6], s1[8 * s + 7]);
        pf[0][s] = __builtin_bit_cast(bf16x8, a); pf[1][s] = __builtin_bit_cast(bf16x8, b);
    }
}
template <int DV>
__device__ __forceinline__ void attn_pv(AttnSt<DV>& st, const LAS unsigned char* Vt, const bf16x8 (&pf)[2][2], int lane) {
    { const bf16x8 ones = {0x3F80, 0x3F80, 0x3F80, 0x3F80, 0x3F80, 0x3F80, 0x3F80, 0x3F80};
      f32x16 rs = __builtin_amdgcn_mfma_f32_32x32x16_bf16(ones, pf[0][0], (f32x16){0.f, 0.f, 0.f, 0.f, 0.f, 0.f, 0.f, 0.f, 0.f, 0.f, 0.f, 0.f, 0.f, 0.f, 0.f, 0.f}, 0, 0, 0);
      rs = __builtin_amdgcn_mfma_f32_32x32x16_bf16(ones, pf[0][1], rs, 0, 0, 0); rs = __builtin_amdgcn_mfma_f32_32x32x16_bf16(ones, pf[1][0], rs, 0, 0, 0); rs = __builtin_amdgcn_mfma_f32_32x32x16_bf16(ones, pf[1][1], rs, 0, 0, 0);
      st.l += rs[0]; }
    constexpr int VS = VStr<DV>::B;
    const int g = lane >> 4, i16 = lane & 15;
    const LAS unsigned char* vp = Vt + (4 * (g >> 1) + (i16 >> 2)) * VS + (16 * (g & 1) + 4 * (i16 & 3)) * 2;
#pragma unroll
    for (int kbk = 0; kbk < 2; ++kbk)
#pragma unroll
        for (int s = 0; s < 2; ++s)
#pragma unroll
            for (int t = 0; t < DV / 32; ++t) {
                const s16x4 lo = vtr(vp + (kbk * 32 + 16 * s) * VS + t * 64), h8 = vtr(vp + (kbk * 32 + 16 * s + 8) * VS + t * 64);
                const bf16x8 va = {lo[0], lo[1], lo[2], lo[3], h8[0], h8[1], h8[2], h8[3]};
                st.o[t] = __builtin_amdgcn_mfma_f32_32x32x16_bf16(va, pf[kbk][s], st.o[t], 0, 0, 0);
            }
}
template <int DV>
__device__ __forceinline__ void attn_tile(AttnSt<DV>& st, const LAS unsigned char* Kt, const LAS unsigned char* Vt, const bf16x8 (&qf)[4], float sc2, float sl2, int tq, int kt0, bool diag, bool rowok, int lane) {
    bf16x8 pf[2][2];
    attn_qk<DV>(st, Kt, qf, sl2, tq, kt0, diag, rowok, lane, pf);
    attn_pv<DV>(st, Vt, pf, lane);
}
template <int NK, int DV> struct TileRegs { v4u k[NK]; v4u v[DV / 64]; };
template <int NK, int DV>
__device__ __forceinline__ void tile_load(TileRegs<NK, DV>& R, const bf16* Z, int ldz, size_t zrow0, int kcol, int vcol, int tid) {
#pragma unroll
    for (int i = 0; i < NK; ++i) { const int ch = tid + 512 * i; const int row = ch / (8 * NK), cc = ch % (8 * NK);
        R.k[i] = *(const GAS v4u*)(Z + (zrow0 + row) * ldz + kcol + cc * 8); }
#pragma unroll
    for (int i = 0; i < DV / 64; ++i) { const int ch = tid + 512 * i; const int row = ch / (DV / 8), cc = ch % (DV / 8);
        R.v[i] = *(const GAS v4u*)(Z + (zrow0 + row) * ldz + vcol + cc * 8); }
}
template <int NK, int DV>
__device__ __forceinline__ void tile_store(const TileRegs<NK, DV>& R, LAS unsigned char* Kt  , LAS unsigned char* Vt, int tid) {
#pragma unroll
    for (int i = 0; i < NK; ++i) { const int ch = tid + 512 * i; const int row = ch / (8 * NK), cc = ch % (8 * NK);
        *(LAS v4u*)(Kt + (cc >> 3) * (64 * KSTRB) + row * KSTRB + (cc & 7) * 16) = R.k[i]; }
#pragma unroll
    for (int i = 0; i < DV / 64; ++i) { const int ch = tid + 512 * i; const int row = ch / (DV / 8), cc = ch % (DV / 8);
        *(LAS v4u*)(Vt + row * VStr<DV>::B + cc * 16) = R.v[i]; }
}
__device__ __forceinline__ void moba_unit(Frame& F, int b, int h, int j, float tcut  ) {
    const bf16* Z = WSP(bf16, WS_Z); constexpr int ldz = NZ0;
    const int lane = ((int)(threadIdx.x & 63u)), w = F.wave, r32 = lane & 31, hi = lane >> 5, tid = ((int)threadIdx.x);
    const size_t rowb = (size_t)b * SEQ;
    const int qpos = j * 256 + w * 32 + r32;
    const int qcol = 2048 + h * 64, kcol = 2560 + h * 64, vcol = 3072 + h * 64;
    LAS unsigned char* lds = F.lds;
    constexpr int BUFB = 64 * KSTRB + 64 * VStr<64>::B;
    LAS unsigned char* kmh = lds + 2 * BUFB;
    LAS unsigned char* kml = lds + 2 * BUFB + 32 * KSTRB;
    LAS unsigned* msk = (LAS unsigned*)(lds + 2 * BUFB + 64 * KSTRB);
    { const float* KM = WSP(float, WS_KMEAN) + (size_t)((b * 8 + h) * 32) * 64; const f32x4 x = *(const f32x4*)(KM + 4 * tid);
      const int n = tid >> 4, d0 = (tid & 15) * 4;
      const unsigned h0 = f2bf(x.x), h1 = f2bf(x.y), h2 = f2bf(x.z), h3 = f2bf(x.w);
      v2u hv; hv.x = h0 | (h1 << 16); hv.y = h2 | (h3 << 16);
      v2u lv; lv.x = pk2(x.x - u2f(h0 << 16), x.y - u2f(h1 << 16)); lv.y = pk2(x.z - u2f(h2 << 16), x.w - u2f(h3 << 16));
      *(LAS v2u*)(kmh + n * KSTRB + d0 * 2) = hv; *(LAS v2u*)(kml + n * KSTRB + d0 * 2) = lv; }
    if (tid < 16) msk[tid] = 0u;
    bf16x8 qf[4];
    const bf16* qrow = Z + (rowb + qpos) * ldz + qcol;
#pragma unroll
    for (int ks = 0; ks < 4; ++ks) qf[ks] = *(const GAS bf16x8*)(qrow + 16 * ks + 8 * hi);
    __syncthreads();
    f32x16 gt;
#pragma unroll
    for (int r = 0; r < 16; ++r) gt[r] = 0.f;
#pragma unroll
    for (int ks = 0; ks < 4; ++ks) {
        const bf16x8 a = *(const LAS bf16x8*)(kmh + r32 * KSTRB + hi * 16 + ks * 32), c = *(const LAS bf16x8*)(kml + r32 * KSTRB + hi * 16 + ks * 32);
        gt = __builtin_amdgcn_mfma_f32_32x32x16_bf16(a, qf[ks], gt, 0, 0, 0);
        gt = __builtin_amdgcn_mfma_f32_32x32x16_bf16(c, qf[ks], gt, 0, 0, 0);
    }
    float t0 = -INFINITY, t1 = -INFINITY, t2 = -INFINITY;
#define INS3(key) do { float k_ = (key); float a_ = fmaxf(t0, k_), l_ = fminf(t0, k_); t0 = a_; a_ = fmaxf(t1, l_); l_ = fminf(t1, l_); t1 = a_; t2 = fmaxf(t2, l_); } while (0)
#pragma unroll
    for (int r = 0; r < 16; ++r) { const int n = (r & 3) + 8 * (r >> 2) + 4 * hi;
        const float key = (n < j) ? u2f((f2u(gt[r]) & ~31u) | (unsigned)n) : -INFINITY; INS3(key); }
    { const float p0 = xhalf(t0), p1 = xhalf(t1), p2 = xhalf(t2); INS3(p0); INS3(p1); INS3(p2); }
#undef INS3
    const int sel0 = (t0 > -INFINITY) ? (int)(f2u(t0) & 31u) : -1;
    const int sel1 = (t1 > -INFINITY) ? (int)(f2u(t1) & 31u) : -1;
    const int sel2 = (t2 > -INFINITY) ? (int)(f2u(t2) & 31u) : -1;
    { const unsigned mm = (sel0 >= 0 ? 1u << sel0 : 0u) | (sel1 >= 0 ? 1u << sel1 : 0u) | (sel2 >= 0 ? 1u << sel2 : 0u);
      if (mm) { __hip_atomic_fetch_or(msk + w, mm, __ATOMIC_RELAXED, __HIP_MEMORY_SCOPE_WORKGROUP); __hip_atomic_fetch_or(msk + 8, mm, __ATOMIC_RELAXED, __HIP_MEMORY_SCOPE_WORKGROUP); } }
    __syncthreads();
    const float slope = ldexpf(1.f, -(h + 1)), dcut = tcut / slope;
    const float sl2 = slope * LOG2E, sc2 = 0.125f * LOG2E;
    int nlo = (int)ceilf(((float)(j * 256) - dcut - 255.f) * (1.f / 256.f)); if (nlo < 0) nlo = 0;
    const unsigned keep = nlo >= 32 ? 0u : (0xffffffffu << nlo);
    const unsigned bmask = msk[8] & keep; const unsigned wmask = (unsigned)__builtin_amdgcn_readfirstlane((int)msk[w]) & keep;
    AttnSt<64> st; attn_init<64>(st);
    unsigned rem = bmask;
    int blk = j, kt = 3, buf = 0;
    TileRegs<1, 64> R;
    tile_load<1, 64>(R, Z, ldz, rowb + blk * 256 + kt * 64, kcol, vcol, tid);
    tile_store<1, 64>(R, lds, lds + 64 * KSTRB, tid);
    __syncthreads();
    for (;;) {
        int nblk = blk, nkt = kt - 1; bool has_next = true;
        if (nkt < 0) { nkt = 3; if (rem) { nblk = 31 - __builtin_clz(rem); rem &= ~(1u << nblk); } else has_next = false; }
        if (has_next) tile_load<1, 64>(R, Z, ldz, rowb + nblk * 256 + nkt * 64, kcol, vcol, tid);
        const bool own = (blk == j);
        const bool active = (own ? (kt * 64 <= w * 32 + 31) : (((wmask >> blk) & 1u) != 0u)) && ((float)(j * 256 + w * 32 - (blk * 256 + kt * 64 + 63)) <= dcut);
        if (active) {
            const bool rowok = own || blk == sel0 || blk == sel1 || blk == sel2;
            const bool diag = own && (kt * 64 + 63 > w * 32);
            attn_tile<64>(st, lds + buf * BUFB, lds + buf * BUFB + 64 * KSTRB, qf, sc2, sl2, qpos, blk * 256 + kt * 64, diag, rowok, lane);
        }
        if (!has_next) break;
        tile_store<1, 64>(R, lds + (buf ^ 1) * BUFB, lds + (buf ^ 1) * BUFB + 64 * KSTRB, tid);
        __syncthreads();
        buf ^= 1; blk = nblk; kt = nkt;
    }
    const float inv = 1.f / st.l;
    bf16* Y = WSP(bf16, WS_XNY) + (rowb + qpos) * 1024 + 512 + h * 64;
#pragma unroll
    for (int t = 0; t < 2; ++t)
#pragma unroll
        for (int rg = 0; rg < 4; ++rg) { v2u o; o.x = pk2(st.o[t][4 * rg] * inv, st.o[t][4 * rg + 1] * inv); o.y = pk2(st.o[t][4 * rg + 2] * inv, st.o[t][4 * rg + 3] * inv);
            *(GAS v2u*)(Y + t * 32 + 8 * rg + 4 * hi) = o; }
    __syncthreads();
}

__device__ __forceinline__ void diff_unit(Frame& F, const Args& A, int b, int h, int qt, float lam, float tcut, const int probe) {
    (void)probe;
    const bf16* Z = WSP(bf16, WS_Z); constexpr int ldz = NZ1;
    const int lane = ((int)(threadIdx.x & 63u)), w = F.wave, r32 = lane & 31, hi = lane >> 5, tid = ((int)threadIdx.x);
    const int comp = w >> 2, wq = w & 3;
    const size_t rowb = (size_t)b * SEQ;
    const int q0 = qt * 128, qpos = q0 + wq * 32 + r32;
    const int qcol = h * 128 + comp * 64, kcol = 1024 + h * 128, vcol = 2048 + h * 128;
    LAS unsigned char* lds = F.lds;
    constexpr int BUFB = 2 * 64 * KSTRB + 64 * VStr<128>::B;
    bf16x8 qf[4];
    const bf16* qrow = Z + (rowb + qpos) * ldz + qcol;
#pragma unroll
    for (int ks = 0; ks < 4; ++ks) qf[ks] = *(const GAS bf16x8*)(qrow + 16 * ks + 8 * hi);
    const float slope = ldexpf(1.f, -(h + 1)), dcut = tcut / slope;
    const float sl2 = slope * LOG2E, sc2 = 0.125f * LOG2E;
    AttnSt<128> st; attn_init<128>(st);
    const int nt = (q0 + 128) / 64;
    int kt_lo = (int)ceilf(((float)q0 - dcut - 63.f) * (1.f / 64.f)); if (kt_lo < 0) kt_lo = 0;
    TileRegs<2, 128> R;
    tile_load<2, 128>(R, Z, ldz, rowb + (size_t)(nt - 1) * 64, kcol, vcol, tid);
    tile_store<2, 128>(R, lds, lds + 2 * 64 * KSTRB, tid);
    __syncthreads();
    int buf = 0;
    for (int kt = nt - 1; kt >= kt_lo; --kt) {
        const bool has_next = kt > kt_lo;
        if (has_next) tile_load<2, 128>(R, Z, ldz, rowb + (size_t)(kt - 1) * 64, kcol, vcol, tid);
        if (kt * 64 <= q0 + wq * 32 + 31) {
            const bool diag = kt * 64 + 63 > q0 + wq * 32;
            attn_tile<128>(st, lds + buf * BUFB + comp * (64 * KSTRB), lds + buf * BUFB + 2 * 64 * KSTRB, qf, sc2, sl2, qpos, kt * 64, diag, true, lane);
        }
        if (has_next) { tile_store<2, 128>(R, lds + (buf ^ 1) * BUFB, lds + (buf ^ 1) * BUFB + 2 * 64 * KSTRB, tid); }
        __syncthreads();
        buf ^= 1;
    }
    const float inv = 1.f / st.l;
    LAS float* o2 = (LAS float*)lds;
    if (comp == 1) {
#pragma unroll
        for (int t = 0; t < 4; ++t)
#pragma unroll
            for (int r = 0; r < 16; ++r) o2[((wq * 4 + t) * 16 + r) * 64 + lane] = st.o[t][r] * inv;
    }
    __syncthreads();
    if (comp == 0) {
        float ss = 0.f;
#pragma unroll
        for (int t = 0; t < 4; ++t)
#pragma unroll
            for (int r = 0; r < 16; ++r) { const float v = st.o[t][r] * inv - lam * o2[((wq * 4 + t) * 16 + r) * 64 + lane]; st.o[t][r] = v; ss += v * v; }
        ss += xhalf(ss);
        const float rs = rsqrtf(ss * (1.f / 128.f) + EPS) * 0.6444909324090307f;
        const float* og = A.in[18];
        bf16* Y = WSP(bf16, WS_XNY) + (rowb + qpos) * 1024 + h * 128;
#pragma unroll
        for (int t = 0; t < 4; ++t)
#pragma unroll
            for (int rg = 0; rg < 4; ++rg) { const int dv = t * 32 + 8 * rg + 4 * hi; const f32x4 gg = *(const f32x4*)(og + dv);
                v2u o; o.x = pk2(st.o[t][4 * rg] * rs * gg.x, st.o[t][4 * rg + 1] * rs * gg.y); o.y = pk2(st.o[t][4 * rg + 2] * rs * gg.z, st.o[t][4 * rg + 3] * rs * gg.w);
                *(GAS v2u*)(Y + dv) = o; }
    }
    __syncthreads();
}
template <int MT, int NT>
__device__ __forceinline__ void mma_nt(const LAS unsigned char* A, int lda, const LAS unsigned char* B, int ldb, int K, f32x4 (&acc)[MT][NT], int lane) {
    const int r = lane & 15, kq = (lane >> 4) * 16;
    for (int k0 = 0; k0 < K; k0 += 32) {
        bf16x8 a[MT], bb[NT];
#pragma unroll
        for (int m = 0; m < MT; ++m) a[m] = *(const LAS bf16x8*)(A + (m * 16 + r) * lda + k0 * 2 + kq);
#pragma unroll
        for (int n = 0; n < NT; ++n) bb[n] = *(const LAS bf16x8*)(B + (n * 16 + r) * ldb + k0 * 2 + kq);
#pragma unroll
        for (int m = 0; m < MT; ++m)
#pragma unroll
            for (int n = 0; n < NT; ++n) acc[m][n] = __builtin_amdgcn_mfma_f32_16x16x32_bf16(a[m], bb[n], acc[m][n], 0, 0, 0);
    }
}
constexpr int TS = 272;
constexpr int TILEB = 128 * TS;
constexpr int ML_Q = 0, ML_K = TILEB, ML_V = 2 * TILEB, ML_SM = 3 * TILEB;

__device__ __forceinline__ void ml_gates(const float* GT, size_t row0, int hm, LAS float* sm, int lane) {
    const float i0 = GT[(row0 + 2 * lane) * 8 + hm], i1 = GT[(row0 + 2 * lane + 1) * 8 + hm];
    const float f0 = logsigmoid_f(GT[(row0 + 2 * lane) * 8 + 4 + hm]), f1 = logsigmoid_f(GT[(row0 + 2 * lane + 1) * 8 + 4 + hm]);
    float s = f0 + f1;
#pragma unroll
    for (int o = 1; o < 64; o <<= 1) { const float t = __shfl_up(s, o); if (lane >= o) s += t; }
    const float excl = s - (f0 + f1);
    sm[2 * lane] = excl + f0; sm[2 * lane + 1] = excl + f0 + f1;
    sm[128 + 2 * lane] = i0; sm[128 + 2 * lane + 1] = i1;
}
template <bool TRANSPOSE>
__device__ __forceinline__ void ml_conv_tile(const bf16* Z, size_t rowb, int t0, int zc, const float* cw, int wc, float mul, LAS unsigned char* dst, const LAS float* rs, int tid) {
#pragma unroll
    for (int it = 0; it < 4; ++it) {
        const int item = tid + 512 * it, l = item >> 4, ch = (item & 15) * 8;
        float acc[8];
#pragma unroll
        for (int i = 0; i < 8; ++i) acc[i] = 0.f;
#pragma unroll
        for (int jj = 0; jj < 4; ++jj) {
            const int t = t0 + l - 3 + jj;
            if (t >= 0) {
                const v4u w = *(const GAS v4u*)(Z + (rowb + t) * NZ0 + zc + ch);
                const float x[8] = {bflo(w.x), bfhi(w.x), bflo(w.y), bfhi(w.y), bflo(w.z), bfhi(w.z), bflo(w.w), bfhi(w.w)};
                const f32x4 c0 = *(const f32x4*)(cw + jj * 1024 + wc + ch), c1 = *(const f32x4*)(cw + jj * 1024 + wc + ch + 4);
                acc[0] += x[0] * c0.x; acc[1] += x[1] * c0.y; acc[2] += x[2] * c0.z; acc[3] += x[3] * c0.w;
                acc[4] += x[4] * c1.x; acc[5] += x[5] * c1.y; acc[6] += x[6] * c1.z; acc[7] += x[7] * c1.w;
            }
        }
        const float sc = TRANSPOSE ? mul * rs[l] : mul;
#pragma unroll
        for (int i = 0; i < 8; ++i) acc[i] = silu_f(acc[i]) * sc;
        if (TRANSPOSE) {
#pragma unroll
            for (int i = 0; i < 8; ++i) *(LAS bf16*)(dst + (ch + i) * TS + l * 2) = (bf16)f2bf(acc[i]);
        } else {
            v4u o; o.x = pk2(acc[0], acc[1]); o.y = pk2(acc[2], acc[3]); o.z = pk2(acc[4], acc[5]); o.w = pk2(acc[6], acc[7]);
            *(LAS v4u*)(dst + l * TS + ch * 2) = o;
        }
    }
}
__device__ __forceinline__ void ml_vt_tile(const bf16* Z, size_t row0, int zc, LAS unsigned char* dst, int tid) {
#pragma unroll
    for (int it = 0; it < 4; ++it) {
        const int item = tid + 512 * it, l = item >> 4, ch = (item & 15) * 8;
        const v4u w = *(const GAS v4u*)(Z + (row0 + l) * NZ0 + zc + ch);
        const unsigned ww[4] = {w.x, w.y, w.z, w.w};
#pragma unroll
        for (int i = 0; i < 4; ++i) { *(LAS bf16*)(dst + (ch + 2 * i) * TS + l * 2) = (bf16)(ww[i] & 0xffffu); *(LAS bf16*)(dst + (ch + 2 * i + 1) * TS + l * 2) = (bf16)(ww[i] >> 16); }
    }
}
__device__ __forceinline__ void mlstm_a_unit(Frame& F, const Args& A, int unit) {
    const int c = unit & 63, bh = unit >> 6, hm = bh & 3, b = bh >> 2;
    const bf16* Z = WSP(bf16, WS_Z); const float* GT = WSP(float, WS_GATES);
    const size_t rowb = (size_t)b * SEQ; const int t0 = c * 128;
    LAS unsigned char* lds = F.lds; LAS float* sm = (LAS float*)(lds + ML_SM);
    if (F.wave == 0) {
        ml_gates(GT, rowb + t0, hm, sm, ((int)(threadIdx.x & 63u)));
        LDS_WAIT();
        const float bend = sm[127];
        const float w0 = bend - sm[2 * ((int)(threadIdx.x & 63u))] + sm[128 + 2 * ((int)(threadIdx.x & 63u))], w1 = bend - sm[2 * ((int)(threadIdx.x & 63u)) + 1] + sm[128 + 2 * ((int)(threadIdx.x & 63u)) + 1];
        const float ml = wave_max(fmaxf(w0, w1));
        sm[256 + 2 * ((int)(threadIdx.x & 63u))] = __expf(w0 - ml); sm[256 + 2 * ((int)(threadIdx.x & 63u)) + 1] = __expf(w1 - ml);
        if (((int)(threadIdx.x & 63u)) == 0) { WSP(float, WS_BEND)[unit] = bend; WSP(float, WS_MLOC)[unit] = ml; }
    }
    __syncthreads();
    ml_conv_tile<true>(Z, rowb, t0, 512 + hm * 128, A.in[7], 512 + hm * 128, 0.08838834764831845f, lds + ML_K, sm + 256, ((int)threadIdx.x));
    ml_vt_tile(Z, rowb + t0, 1024 + hm * 128, lds + ML_V, ((int)threadIdx.x));
    __syncthreads();
    f32x4 acc[2][4];
#pragma unroll
    for (int m = 0; m < 2; ++m)
#pragma unroll
        for (int n = 0; n < 4; ++n) acc[m][n] = (f32x4){0.f, 0.f, 0.f, 0.f};
    const int dv0 = 32 * (F.wave >> 1), dk0 = 64 * (F.wave & 1);
    mma_nt<2, 4>(lds + ML_V + dv0 * TS, TS, lds + ML_K + dk0 * TS, TS, 128, acc, ((int)(threadIdx.x & 63u)));
    float* CL = WSP(float, WS_CLOC) + (size_t)unit * 16384;
#pragma unroll
    for (int m = 0; m < 2; ++m)
#pragma unroll
        for (int n = 0; n < 4; ++n)
#pragma unroll
            for (int i = 0; i < 4; ++i) CL[(size_t)(dv0 + 16 * m + 4 * (((int)(threadIdx.x & 63u)) >> 4) + i) * 128 + dk0 + 16 * n + (((int)(threadIdx.x & 63u)) & 15)] = acc[m][n][i];
    if (((int)threadIdx.x) < 128) { float s = 0.f; const LAS bf16* kr = (const LAS bf16*)(lds + ML_K + ((int)threadIdx.x) * TS);
        for (int l = 0; l < 128; ++l) s += bf2f(kr[l]);
        WSP(float, WS_NLOC)[(size_t)unit * 128 + ((int)threadIdx.x)] = s; }
    __syncthreads();
}
__device__ __forceinline__ void mlstm_scan_unit(Frame& F, int unit) {
    const int bh = unit >> 4, sl = unit & 15;
    LAS float* tab = (LAS float*)F.lds;
    if (((int)threadIdx.x) == 0) {
        const float* BE = WSP(float, WS_BEND) + bh * 64; const float* ML = WSP(float, WS_MLOC) + bh * 64; float* MP = WSP(float, WS_MPREV) + bh * 64;
        float m = 0.f;
        for (int c = 0; c < 64; ++c) { const float be = BE[c], ml = ML[c]; const float mn = fmaxf(be + m, ml);
            tab[c] = __expf(be + m - mn); tab[64 + c] = __expf(ml - mn); if (sl == 0) MP[c] = m; m = mn; }
    }
    __syncthreads();
    float* CL = WSP(float, WS_CLOC) + (size_t)bh * 64 * 16384 + sl * 1024 + 2 * ((int)threadIdx.x);
    float s0 = 0.f, s1 = 0.f;
#pragma unroll 8
    for (int c = 0; c < 64; ++c) { float2* p = (float2*)(CL + (size_t)c * 16384); const float2 v = *p; *p = make_float2(s0, s1);
        const float a = tab[c], sc = tab[64 + c]; s0 = a * s0 + sc * v.x; s1 = a * s1 + sc * v.y; }
    if (sl == 0 && ((int)threadIdx.x) < 128) { float* NL = WSP(float, WS_NLOC) + (size_t)bh * 64 * 128 + ((int)threadIdx.x); float s = 0.f;
        for (int c = 0; c < 64; ++c) { const float v = NL[c * 128]; NL[c * 128] = s; s = tab[c] * s + tab[64 + c] * v; } }
    __syncthreads();
}
__device__ __forceinline__ void mlstm_c_unit(Frame& F, const Args& A, int unit) {
    const int c = unit & 63, bh = unit >> 6, hm = bh & 3, b = bh >> 2;
    const bf16* Z = WSP(bf16, WS_Z); const float* GT = WSP(float, WS_GATES);
    const size_t rowb = (size_t)b * SEQ; const int t0 = c * 128;
    LAS unsigned char* lds = F.lds; LAS float* sm = (LAS float*)(lds + ML_SM);
    const int lane = ((int)(threadIdx.x & 63u)), w = F.wave, tid = ((int)threadIdx.x);
    const float mprev = WSP(float, WS_MPREV)[unit];
    if (w == 0) {
        ml_gates(GT, rowb + t0, hm, sm, lane);
        LDS_WAIT();
        const float b0 = sm[2 * lane], b1 = sm[2 * lane + 1];
        const float g0 = sm[128 + 2 * lane] - b0, g1 = sm[128 + 2 * lane + 1] - b1;
        float pm = fmaxf(g0, g1);
#pragma unroll
        for (int o = 1; o < 64; o <<= 1) { const float t = __shfl_up(pm, o); if (lane >= o) pm = fmaxf(pm, t); }
        float pe = __shfl_up(pm, 1); if (lane == 0) pe = -INFINITY;
        const float M0 = fmaxf(mprev, fmaxf(pe, g0)), M1 = fmaxf(mprev, pm);
        sm[256 + 2 * lane] = g0; sm[256 + 2 * lane + 1] = g1;
        sm[384 + 2 * lane] = M0; sm[384 + 2 * lane + 1] = M1;
        sm[512 + 2 * lane] = __expf(mprev - M0); sm[512 + 2 * lane + 1] = __expf(mprev - M1);
        sm[640 + 2 * lane] = __expf(-b0 - M0); sm[640 + 2 * lane + 1] = __expf(-b1 - M1);
        sm[768 + 2 * lane] = 0.f; sm[768 + 2 * lane + 1] = 0.f; sm[896 + 2 * lane] = 0.f; sm[896 + 2 * lane + 1] = 0.f;
    }
    if (w == 1) { sm[1152 + lane] = WSP(float, WS_NLOC)[(size_t)unit * 128 + lane]; sm[1152 + 64 + lane] = WSP(float, WS_NLOC)[(size_t)unit * 128 + 64 + lane]; }
    ml_conv_tile<false>(Z, rowb, t0, hm * 128, A.in[7], hm * 128, 1.f, lds + ML_Q, nullptr, tid);
    ml_conv_tile<false>(Z, rowb, t0, 512 + hm * 128, A.in[7], 512 + hm * 128, 0.08838834764831845f, lds + ML_K, nullptr, tid);
    ml_vt_tile(Z, rowb + t0, 1024 + hm * 128, lds + ML_V, tid);
    __syncthreads();
    const int l0 = 32 * (w >> 1), c0 = 64 * (w & 1);
    const int lr = 4 * (lane >> 4), lc = lane & 15;
    if (tid < 128) { const LAS bf16* qr = (const LAS bf16*)(lds + ML_Q + tid * TS); float s = 0.f;
        for (int d = 0; d < 128; ++d) s += bf2f(qr[d]) * sm[1152 + d];
        sm[1024 + tid] = s; }
    f32x4 acc[2][4];
#pragma unroll
    for (int m = 0; m < 2; ++m)
#pragma unroll
        for (int n = 0; n < 4; ++n) acc[m][n] = (f32x4){0.f, 0.f, 0.f, 0.f};
    mma_nt<2, 4>(lds + ML_Q + l0 * TS, TS, lds + ML_K + c0 * TS, TS, 128, acc, lane);
#pragma unroll
    for (int m = 0; m < 2; ++m)
#pragma unroll
        for (int i = 0; i < 4; ++i) { const int l = l0 + 16 * m + lr + i; const float Ml = sm[384 + l]; float rsum = 0.f;
#pragma unroll
            for (int n = 0; n < 4; ++n) { const int s = c0 + 16 * n + lc; const float v = (s <= l) ? acc[m][n][i] * __expf(sm[256 + s] - Ml) : 0.f; acc[m][n][i] = v; rsum += v; }
            rsum += __shfl_xor(rsum, 1); rsum += __shfl_xor(rsum, 2); rsum += __shfl_xor(rsum, 4); rsum += __shfl_xor(rsum, 8);
            if (lc == 0) __hip_atomic_fetch_add(sm + 768 + l, rsum, __ATOMIC_RELAXED, __HIP_MEMORY_SCOPE_WORKGROUP); }
    __syncthreads();
#pragma unroll
    for (int m = 0; m < 2; ++m)
#pragma unroll
        for (int n = 0; n < 4; ++n)
#pragma unroll
            for (int i = 0; i < 4; ++i) *(LAS bf16*)(lds + ML_K + (l0 + 16 * m + lr + i) * TS + (c0 + 16 * n + lc) * 2) = (bf16)f2bf(acc[m][n][i]);
    __syncthreads();
    f32x4 ai[2][4], ae[2][4];
#pragma unroll
    for (int m = 0; m < 2; ++m)
#pragma unroll
        for (int n = 0; n < 4; ++n) { ai[m][n] = (f32x4){0.f, 0.f, 0.f, 0.f}; ae[m][n] = (f32x4){0.f, 0.f, 0.f, 0.f}; }
    mma_nt<2, 4>(lds + ML_K + l0 * TS, TS, lds + ML_V + c0 * TS, TS, 128, ai, lane);
    {
        const float* CP = WSP(float, WS_CLOC) + (size_t)unit * 16384;
        const int r = lane & 15, kq = (lane >> 4) * 8;
        for (int k0 = 0; k0 < 128; k0 += 32) {
            bf16x8 a[2], bb[4];
#pragma unroll
            for (int m = 0; m < 2; ++m) a[m] = *(const LAS bf16x8*)(lds + ML_Q + (l0 + m * 16 + r) * TS + (k0 + kq) * 2);
#pragma unroll
            for (int n = 0; n < 4; ++n) { const float* p = CP + (size_t)(c0 + n * 16 + r) * 128 + k0 + kq; const f32x4 x = *(const f32x4*)p, y = *(const f32x4*)(p + 4);
                v4u pk; pk.x = pk2(x.x, x.y); pk.y = pk2(x.z, x.w); pk.z = pk2(y.x, y.y); pk.w = pk2(y.z, y.w); bb[n] = __builtin_bit_cast(bf16x8, pk); }
#pragma unroll
            for (int m = 0; m < 2; ++m)
#pragma unroll
                for (int n = 0; n < 4; ++n) ae[m][n] = __builtin_amdgcn_mfma_f32_16x16x32_bf16(a[m], bb[n], ae[m][n], 0, 0, 0);
        }
    }
#pragma unroll
    for (int m = 0; m < 2; ++m)
#pragma unroll
        for (int i = 0; i < 4; ++i) { const int l = l0 + 16 * m + lr + i; const float wi = sm[512 + l];
            const float den = wi * sm[1024 + l] + sm[768 + l]; const float dinv = 1.f / fmaxf(fabsf(den), sm[640 + l]); float ssq = 0.f;
#pragma unroll
            for (int n = 0; n < 4; ++n) { const float hv = (wi * ae[m][n][i] + ai[m][n][i]) * dinv; ai[m][n][i] = hv; ssq += hv * hv; }
            ssq += __shfl_xor(ssq, 1); ssq += __shfl_xor(ssq, 2); ssq += __shfl_xor(ssq, 4); ssq += __shfl_xor(ssq, 8);
            if (lc == 0) __hip_atomic_fetch_add(sm + 896 + l, ssq, __ATOMIC_RELAXED, __HIP_MEMORY_SCOPE_WORKGROUP); }
    __syncthreads();
    const float* mg = A.in[10] + hm * 128;
    bf16* Y = WSP(bf16, WS_XNY);
#pragma unroll
    for (int m = 0; m < 2; ++m)
#pragma unroll
        for (int i = 0; i < 4; ++i) { const int l = l0 + 16 * m + lr + i; const float rstd = rsqrtf(sm[896 + l] * (1.f / 128.f) + EPS); const size_t row = rowb + t0 + l;
#pragma unroll
            for (int n = 0; n < 4; ++n) { const int dv = c0 + 16 * n + lc; const float og = sigmoid_f(bf2f(Z[row * NZ0 + 1536 + hm * 128 + dv]));
                Y[row * 1024 + hm * 128 + dv] = (bf16)f2bf(ai[m][n][i] * rstd * mg[dv] * og); } }
    __syncthreads();
}
template <int N> __device__ __forceinline__ void bitonic_sort_desc(float (&v)[N]) {
#pragma unroll
    for (int k = 2; k <= N; k <<= 1)
#pragma unroll
        for (int j = k >> 1; j > 0; j >>= 1)
#pragma unroll
            for (int i = 0; i < N; ++i) { const int l = i ^ j; if (l > i) { const bool desc = ((i & k) == 0); const float a = v[i], b = v[l]; const float mx = fmaxf(a, b), mn = fminf(a, b); v[i] = desc ? mx : mn; v[l] = desc ? mn : mx; } }
}
__device__ __forceinline__ void merge_top16(float (&run)[16], const float (&nw)[16]) {
#pragma unroll
    for (int i = 0; i < 16; ++i) run[i] = fmaxf(run[i], nw[15 - i]);
#pragma unroll
    for (int j = 8; j > 0; j >>= 1)
#pragma unroll
        for (int i = 0; i < 16; ++i) { const int l = i ^ j; if (l > i) { const float a = run[i], b = run[l]; run[i] = fmaxf(a, b); run[l] = fminf(a, b); } }
}
#ifndef EXPERT_SLOW
#define EXPERT_SLOW 0
#endif
#ifndef ROUTE_SLOW
#define ROUTE_SLOW 0
#endif
constexpr int SCS = 132;
__device__ __forceinline__ void peer_route_unit(Frame& F, int tok0, int hd, const bf16x8 (&kf)[4][2], const int PROBE) {
    const bf16* QRY = WSP(bf16, WS_QRY); int* IDX = WSP(int, WS_IDX); float* GATE = WSP(float, WS_GATE);
    LAS float* SC = (LAS float*)F.lds;
    const int lane = ((int)(threadIdx.x & 63u)), w = F.wave, tid = ((int)threadIdx.x);
    {
        constexpr int AST = 528;
        LAS unsigned char* As = F.lds;
#pragma unroll
        for (int i = 0; i < 8; ++i) { const int ch = tid + 512 * i, row = ch >> 5, cc = ch & 31;
            *(LAS v4u*)(As + row * AST + cc * 16) = *(const GAS v4u*)(QRY + (size_t)(tok0 + row) * NQ + hd * 256 + cc * 8); }
        __syncthreads();
        const int p = w & 1, nq = w >> 1, r = lane & 15, kq = (lane >> 4) * 16;
        f32x4 acc[8][2];
#pragma unroll
        for (int m = 0; m < 8; ++m) { acc[m][0] = (f32x4){0.f, 0.f, 0.f, 0.f}; acc[m][1] = (f32x4){0.f, 0.f, 0.f, 0.f}; }
#pragma unroll
        for (int ks = 0; ks < 4; ++ks)
#pragma unroll
            for (int m = 0; m < 8; ++m) { const bf16x8 a = *(const LAS bf16x8*)(As + (16 * m + r) * AST + p * 256 + ks * 64 + kq);
                acc[m][0] = __builtin_amdgcn_mfma_f32_16x16x32_bf16(a, kf[ks][0], acc[m][0], 0, 0, 0);
                acc[m][1] = __builtin_amdgcn_mfma_f32_16x16x32_bf16(a, kf[ks][1], acc[m][1], 0, 0, 0); }
        __syncthreads();
#pragma unroll
        for (int m = 0; m < 8; ++m)
#pragma unroll
            for (int n = 0; n < 2; ++n)
#pragma unroll
                for (int i = 0; i < 4; ++i) SC[(p * 128 + 16 * m + 4 * (lane >> 4) + i) * SCS + 32 * nq + 16 * n + r] = acc[m][n][i];
    }
    __syncthreads();
#if defined(CHECK) && CHECK
    if (tok0 == 0 && hd == 0) { float* DB = WSP(float, WS_CLOC) + 8 * 1024 * 1024; for (int i = tid; i < 2 * 128 * 128; i += NTHR) DB[i] = SC[(i >> 7) * SCS + (i & 127)]; }
    __syncthreads();
#endif
#if ROUTE_SLOW
    if (tid < 128) {
        const int t = tid;
        float s0[16], s1[16]; unsigned i0[16], i1[16];
        { const LAS float* row = SC + (0 * 128 + t) * SCS; float prev = INFINITY;
#pragma unroll
          for (int k = 0; k < 16; ++k) { float best = -INFINITY; unsigned bi = 0; for (int n = 0; n < 128; ++n) { const float v = row[n]; if (v < prev && v > best) { best = v; bi = n; } } s0[k] = best; i0[k] = bi; prev = best; } }
        { const LAS float* row = SC + (1 * 128 + t) * SCS; float prev = INFINITY;
#pragma unroll
          for (int k = 0; k < 16; ++k) { float best = -INFINITY; unsigned bi = 0; for (int n = 0; n < 128; ++n) { const float v = row[n]; if (v < prev && v > best) { best = v; bi = n; } } s1[k] = best; i1[k] = bi; prev = best; } }
        float top[16]; unsigned tid16[16];
        { float prev = INFINITY;
#pragma unroll
          for (int k = 0; k < 16; ++k) { float best = -INFINITY; unsigned be = 0;
#pragma unroll
              for (int i = 0; i < 16; ++i)
#pragma unroll
                  for (int j = 0; j < 16; ++j) if ((i + 1) * (j + 1) <= 16) { const float v = s0[i] + s1[j]; if (v < prev && v > best) { best = v; be = i0[i] * 128u + i1[j]; } }
              top[k] = best; tid16[k] = be; prev = best; } }
        float sc[16], den = 0.f;
#pragma unroll
        for (int k = 0; k < 16; ++k) { sc[k] = __expf(top[k] - top[0]); den += sc[k]; }
        const float inv = 1.f / den;
        const size_t ob = (size_t)(tok0 + t) * 128 + hd * 16;
#pragma unroll
        for (int k = 0; k < 16; ++k) { IDX[ob + k] = (int)tid16[k]; GATE[ob + k] = sc[k] * inv; }
    }
    __syncthreads();
#else
    if (PROBE < 2) {
        const int t = tid & 127, p = (tid >> 7) & 1, half = tid >> 8;
        LAS float* seg = SC + (p * 128 + t) * SCS + 64 * half;
        float run[16], nw[16];
#pragma unroll
        for (int ch = 0; ch < 4; ++ch) {
#pragma unroll
            for (int q = 0; q < 4; ++q) { const f32x4 v = *(const LAS f32x4*)(seg + 16 * ch + 4 * q);
#pragma unroll
                for (int e = 0; e < 4; ++e) { const unsigned n = (unsigned)(64 * half + 16 * ch + 4 * q + e); const float key = u2f((f2u(v[e]) & ~127u) | n);
                    if (ch == 0) run[4 * q + e] = key; else nw[4 * q + e] = key; } }
            if (ch == 0) bitonic_sort_desc<16>(run); else { bitonic_sort_desc<16>(nw); merge_top16(run, nw); }
        }
#pragma unroll
        for (int q = 0; q < 4; ++q) *(LAS f32x4*)(seg + 4 * q) = (f32x4){run[4 * q], run[4 * q + 1], run[4 * q + 2], run[4 * q + 3]};
    }
    __syncthreads();
    if (tid < 128 && PROBE < 1) {
        const int t = tid;
        float s0[16], s1[16];
        {
            LAS float* a = SC + (0 * 128 + t) * SCS; float nw[16];
#pragma unroll
            for (int q = 0; q < 4; ++q) { const f32x4 v = *(const LAS f32x4*)(a + 4 * q), u = *(const LAS f32x4*)(a + 64 + 4 * q);
#pragma unroll
                for (int e = 0; e < 4; ++e) { s0[4 * q + e] = v[e]; nw[4 * q + e] = u[e]; } }
            merge_top16(s0, nw);
#pragma unroll
            for (int q = 0; q < 4; ++q) *(LAS f32x4*)(a + 16 + 4 * q) = (f32x4){s0[4 * q], s0[4 * q + 1], s0[4 * q + 2], s0[4 * q + 3]};
        }
        {
            LAS float* a = SC + (1 * 128 + t) * SCS; float nw[16];
#pragma unroll
            for (int q = 0; q < 4; ++q) { const f32x4 v = *(const LAS f32x4*)(a + 4 * q), u = *(const LAS f32x4*)(a + 64 + 4 * q);
#pragma unroll
                for (int e = 0; e < 4; ++e) { s1[4 * q + e] = v[e]; nw[4 * q + e] = u[e]; } }
            merge_top16(s1, nw);
#pragma unroll
            for (int q = 0; q < 4; ++q) *(LAS f32x4*)(a + 16 + 4 * q) = (f32x4){s1[4 * q], s1[4 * q + 1], s1[4 * q + 2], s1[4 * q + 3]};
        }
#pragma unroll
        for (int i = 0; i < 16; ++i) { s0[i] = u2f(f2u(s0[i]) & ~127u); s1[i] = u2f(f2u(s1[i]) & ~127u); }
        constexpr int CNT[16] = {16, 8, 5, 4, 3, 2, 2, 2, 1, 1, 1, 1, 1, 1, 1, 1};
        constexpr int OFF[16] = {0, 16, 24, 29, 33, 36, 38, 40, 42, 43, 44, 45, 46, 47, 48, 49};
        float top[16], nw[16];
#pragma unroll
        for (int grp = 0; grp < 4; ++grp) {
#pragma unroll
            for (int e = 0; e < 16; ++e) nw[e] = -INFINITY;
#pragma unroll
            for (int i = 0; i < 16; ++i)
#pragma unroll
                for (int j = 0; j < 16; ++j) if (j < CNT[i] && (OFF[i] + j) / 16 == grp) {
                    const float sum = s0[i] + s1[j];
                    nw[(OFF[i] + j) % 16] = u2f((f2u(sum) & ~255u) | (unsigned)(i * 16 + j)); }
            bitonic_sort_desc<16>(nw);
            if (grp == 0) {
#pragma unroll
                for (int e = 0; e < 16; ++e) top[e] = nw[e];
            } else merge_top16(top, nw);
        }
#if defined(CHECK) && CHECK
        if (tok0 == 0 && hd == 0) { float* DB = WSP(float, WS_CLOC) + 8 * 1024 * 1024 + 32768;
#pragma unroll
            for (int i = 0; i < 16; ++i) { DB[t * 48 + i] = s0[i]; DB[t * 48 + 16 + i] = s1[i]; DB[t * 48 + 32 + i] = top[i]; } }
#endif
        float sc[16], den = 0.f;
        const float mx = u2f(f2u(top[0]) & ~255u);
#pragma unroll
        for (int k = 0; k < 16; ++k) { sc[k] = __expf(u2f(f2u(top[k]) & ~255u) - mx); den += sc[k]; }
        const float inv = 1.f / den;
        LDS_WAIT();
        const LAS unsigned* l0 = (const LAS unsigned*)(SC + (0 * 128 + t) * SCS + 16); const LAS unsigned* l1 = (const LAS unsigned*)(SC + (1 * 128 + t) * SCS + 16);
        const size_t ob = (size_t)(tok0 + t) * 128 + hd * 16;
        unsigned eid[16];
#pragma unroll
        for (int k = 0; k < 16; ++k) { const unsigned id = f2u(top[k]) & 255u; const unsigned e0 = l0[id >> 4] & 127u, e1 = l1[id & 15u] & 127u; eid[k] = e0 * 128u + e1; }
#pragma unroll
        for (int q4 = 0; q4 < 4; ++q4) { v4u iv; iv.x = eid[4 * q4]; iv.y = eid[4 * q4 + 1]; iv.z = eid[4 * q4 + 2]; iv.w = eid[4 * q4 + 3];
            *(GAS v4u*)(IDX + ob + 4 * q4) = iv; *(GAS f32x4*)(GATE + ob + 4 * q4) = (f32x4){sc[4 * q4] * inv, sc[4 * q4 + 1] * inv, sc[4 * q4 + 2] * inv, sc[4 * q4 + 3] * inv}; }
    }
    __syncthreads();
#endif
}
__device__ __forceinline__ void peer_u_phase(Frame& F, const unsigned char* U8  ) {
    const bf16* XN = WSP(bf16, WS_XNY); const int* IDX = WSP(int, WS_IDX); float* PART = WSP(float, WS_PART);
    const int lane = ((int)(threadIdx.x & 63u)), grp = lane >> 3, l8 = lane & 7;
    const int g = F.bid & 7, nsw = (F.G >> 3) * NWAVES, ws = (F.bid >> 3) * NWAVES + F.wave;
    const unsigned char* Ug = U8 + (size_t)g * 16384 * 128;
    const unsigned lo8 = 16u * (unsigned)l8;
#define U_IDS(IDS, TOK) do { const int* ip_ = IDX + (size_t)(TOK) * 128 + 16 * grp; _Pragma("unroll") for (int q4 = 0; q4 < 4; ++q4) IDS[q4] = *(const GAS v4u*)(ip_ + 4 * q4); } while (0)
#define U_ROWS(W, HX, HY, IDS, TOK) do { _Pragma("unroll") for (int q4 = 0; q4 < 4; ++q4) { W[4 * q4] = *(const GAS v4u*)(Ug + ((IDS[q4].x << 7) | lo8)); W[4 * q4 + 1] = *(const GAS v4u*)(Ug + ((IDS[q4].y << 7) | lo8)); \
        W[4 * q4 + 2] = *(const GAS v4u*)(Ug + ((IDS[q4].z << 7) | lo8)); W[4 * q4 + 3] = *(const GAS v4u*)(Ug + ((IDS[q4].w << 7) | lo8)); } \
        const bf16* hp_ = XN + (size_t)(TOK) * D + 128 * g + 16 * l8; HX = *(const GAS v4u*)hp_; HY = *(const GAS v4u*)(hp_ + 8); } while (0)
#define U_COMPUTE(W, HX, HY, TOK) do { \
        const float hf_[16] = {bflo(HX.x), bfhi(HX.x), bflo(HX.y), bfhi(HX.y), bflo(HX.z), bfhi(HX.z), bflo(HX.w), bfhi(HX.w), bflo(HY.x), bfhi(HY.x), bflo(HY.y), bfhi(HY.y), bflo(HY.z), bfhi(HY.z), bflo(HY.w), bfhi(HY.w)}; \
        float am_ = 0.f; _Pragma("unroll") for (int i = 0; i < 16; ++i) am_ = fmaxf(am_, fabsf(hf_[i])); \
        am_ = fmaxf(am_, __shfl_xor(am_, 1)); am_ = fmaxf(am_, __shfl_xor(am_, 2)); am_ = fmaxf(am_, __shfl_xor(am_, 4)); \
        const float hinv_ = am_ > 1e-30f ? 127.f / am_ : 0.f, hsc_ = am_ * (1.f / 127.f); \
        int hq_[4]; _Pragma("unroll") for (int q4 = 0; q4 < 4; ++q4) { unsigned wv_ = 0; _Pragma("unroll") for (int e = 0; e < 4; ++e) { const int qv_ = (int)rintf(hf_[4 * q4 + e] * hinv_); wv_ |= ((unsigned)qv_ & 0xffu) << (8 * e); } hq_[q4] = (int)wv_; } \
        float r_[16]; _Pragma("unroll") for (int it = 0; it < 16; ++it) { const unsigned wx_ = W[it].x, wy_ = W[it].y, wz_ = W[it].z, ww_ = W[it].w; \
            int acc_ = __builtin_amdgcn_sdot4((int)wx_, hq_[0], 0, false); acc_ = __builtin_amdgcn_sdot4((int)wy_, hq_[1], acc_, false); acc_ = __builtin_amdgcn_sdot4((int)wz_, hq_[2], acc_, false); acc_ = __builtin_amdgcn_sdot4((int)ww_, hq_[3], acc_, false); \
            acc_ += __shfl_xor(acc_, 1); acc_ += __shfl_xor(acc_, 2); acc_ += __shfl_xor(acc_, 4); r_[it] = (float)acc_ * hsc_; } \
        if (l8 == 0) { float* pp_ = PART + ((size_t)g * M + (TOK)) * 128 + 16 * grp; _Pragma("unroll") for (int q4 = 0; q4 < 4; ++q4) *(GAS f32x4*)(pp_ + 4 * q4) = (f32x4){r_[4 * q4], r_[4 * q4 + 1], r_[4 * q4 + 2], r_[4 * q4 + 3]}; } } while (0)
    v4u idsA[4], idsB[4], wA[16], wB[16], hxA, hyA, hxB, hyB;
    const int tmax = M - 1;
    int t0 = ws;
    U_IDS(idsA, t0); U_IDS(idsB, min(t0 + nsw, tmax));
    for (; t0 < M; t0 += 2 * nsw) {
        const int t1 = t0 + nsw, t2 = t0 + 2 * nsw, t3 = t0 + 3 * nsw;
        U_ROWS(wA, hxA, hyA, idsA, t0);
        U_ROWS(wB, hxB, hyB, idsB, min(t1, tmax));
        U_IDS(idsA, min(t2, tmax));
        U_IDS(idsB, min(t3, tmax));
        U_COMPUTE(wA, hxA, hyA, t0);
        if (t1 < M) U_COMPUTE(wB, hxB, hyB, t1);
    }
#undef U_IDS
#undef U_ROWS
#undef U_COMPUTE
}
__device__ __forceinline__ void peer_act_phase(Frame& F, const float* ISU, const float* ISV) {
    const int* IDX = WSP(int, WS_IDX); const float* GATE = WSP(float, WS_GATE); const float* PART = WSP(float, WS_PART);
    unsigned short* ACT8 = WSP(unsigned short, WS_ACT); float* ACTS = WSP(float, WS_ACTS);
    const int gw = F.bid * NWAVES + F.wave, NGW = F.G * NWAVES, lane = ((int)(threadIdx.x & 63u));
    for (int tok = gw; tok < M; tok += NGW) {
        const size_t i = (size_t)tok * 128 + 2 * lane;
        float s0 = 0.f, s1 = 0.f;
#pragma unroll
        for (int g = 0; g < 8; ++g) { const float2 p = *(const float2*)(PART + (size_t)g * M * 128 + i); s0 += p.x; s1 += p.y; }
        const int2 id = *(const int2*)(IDX + i); const float2 gt = *(const float2*)(GATE + i);
        const float d0 = s0 * ISU[id.x], d1 = s1 * ISU[id.y];
        const float a0 = 0.5f * d0 * (1.f + erff(d0 * 0.70710678118654752f)) * gt.x * ISV[id.x], a1 = 0.5f * d1 * (1.f + erff(d1 * 0.70710678118654752f)) * gt.y * ISV[id.y];
        const float am = wave_max(fmaxf(fabsf(a0), fabsf(a1)));
        const float inv = am > 1e-30f ? 127.f / am : 0.f;
        const int q0 = (int)rintf(a0 * inv), q1 = (int)rintf(a1 * inv);
        ACT8[(size_t)tok * 64 + lane] = (unsigned short)(((unsigned)q0 & 0xffu) | (((unsigned)q1 & 0xffu) << 8));
        if (lane == 0) ACTS[tok] = am * (1.f / 127.f);
    }
}
__device__ __forceinline__ void peer_v_phase(Frame& F, const unsigned char* V8, const float* g2  , float dbg) {
    const int* IDX = WSP(int, WS_IDX); const unsigned* ACT8 = WSP(unsigned, WS_ACT); const float* ACTS = WSP(float, WS_ACTS);
    const int lane = ((int)(threadIdx.x & 63u)), t8 = lane >> 3, l8 = lane & 7;
    const int g = F.bid & 7, nsw = (F.G >> 3) * NWAVES, ws = (F.bid >> 3) * NWAVES + F.wave;
    const unsigned char* Vg = V8 + (size_t)g * 16384 * 128; const unsigned lo8 = 16u * (unsigned)l8;
    for (int wi = ws; wi < M / 8; wi += nsw) {
        const int tok = wi * 8 + t8;
        const int* ip = IDX + (size_t)tok * 128; const unsigned* ap = ACT8 + (size_t)tok * 32;
        int acc[16];
#pragma unroll
        for (int i = 0; i < 16; ++i) acc[i] = 0;
#pragma unroll 2
        for (int gi = 0; gi < 32; ++gi) {
            const v4u id4 = *(const GAS v4u*)(ip + 4 * gi); const int qa = (int)ap[gi];
            const v4u ra = *(const GAS v4u*)(Vg + ((id4.x << 7) | lo8)), rb = *(const GAS v4u*)(Vg + ((id4.y << 7) | lo8)), rc = *(const GAS v4u*)(Vg + ((id4.z << 7) | lo8)), rd = *(const GAS v4u*)(Vg + ((id4.w << 7) | lo8));
            const unsigned A[4] = {ra.x, ra.y, ra.z, ra.w}, B[4] = {rb.x, rb.y, rb.z, rb.w}, C[4] = {rc.x, rc.y, rc.z, rc.w}, Dd[4] = {rd.x, rd.y, rd.z, rd.w};
#pragma unroll
            for (int j = 0; j < 4; ++j) {
                const unsigned ablo = __builtin_amdgcn_perm(B[j], A[j], 0x05010400u), abhi = __builtin_amdgcn_perm(B[j], A[j], 0x07030602u);
                const unsigned cdlo = __builtin_amdgcn_perm(Dd[j], C[j], 0x05010400u), cdhi = __builtin_amdgcn_perm(Dd[j], C[j], 0x07030602u);
                const unsigned t0 = __builtin_amdgcn_perm(cdlo, ablo, 0x05040100u), t1 = __builtin_amdgcn_perm(cdlo, ablo, 0x07060302u);
                const unsigned t2 = __builtin_amdgcn_perm(cdhi, abhi, 0x05040100u), t3 = __builtin_amdgcn_perm(cdhi, abhi, 0x07060302u);
                acc[4 * j] = __builtin_amdgcn_sdot4((int)t0, qa, acc[4 * j], false); acc[4 * j + 1] = __builtin_amdgcn_sdot4((int)t1, qa, acc[4 * j + 1], false);
                acc[4 * j + 2] = __builtin_amdgcn_sdot4((int)t2, qa, acc[4 * j + 2], false); acc[4 * j + 3] = __builtin_amdgcn_sdot4((int)t3, qa, acc[4 * j + 3], false);
            }
        }
        const float sc = ACTS[tok] * dbg;
        const int b = tok >> 13, c0 = 128 * g + 16 * l8; float* xr = F.out + (size_t)tok * D + c0; const float* gr = g2 + (size_t)b * 6144 + c0;
#pragma unroll
        for (int q4 = 0; q4 < 4; ++q4) { const f32x4 xv = *(const GAS f32x4*)(xr + 4 * q4), gv = *(const f32x4*)(gr + 4 * q4);
            *(GAS f32x4*)(xr + 4 * q4) = xv + gv * sc * (f32x4){(float)acc[4 * q4], (float)acc[4 * q4 + 1], (float)acc[4 * q4 + 2], (float)acc[4 * q4 + 3]}; }
    }
}
#if defined(CHECK) && CHECK
constexpr size_t WS_DBG = 896 * 1024;
constexpr size_t WS_DBGOUT = WS_CLOC;
#ifndef CHECK_LAYER
#define CHECK_LAYER 1
#endif
__global__ void chk_qry(Args a) {
    const bf16* XN = (const bf16*)(a.ws + WS_XNY); const bf16* QRY = (const bf16*)(a.ws + WS_QRY); const float* wq = a.in[20] + (size_t)CHECK_LAYER * D * NQ;
    float* R = (float*)(a.ws + WS_CTL + WS_DBG);
    const int tok = (blockIdx.x * 977) % M; const int col = (threadIdx.x * 37 + blockIdx.x * 11) % NQ;
    float s = 0.f; for (int k = 0; k < D; ++k) s += bf2f(XN[(size_t)tok * D + k]) * wq[(size_t)k * NQ + col];
    const float q = bf2f(QRY[(size_t)tok * NQ + col]);
    atomicAdd(R + 0, (s - q) * (s - q)); atomicAdd(R + 1, s * s);
}
__global__ void chk_keys(Args a) {
    const bf16* KB = (const bf16*)(a.ws + WS_KEYS); const float* keys = a.in[21]; float* R = (float*)(a.ws + WS_CTL + WS_DBG);
    const int i = blockIdx.x * blockDim.x + threadIdx.x; if (i < 2 * 2 * 128 * 128) { const float d = bf2f(KB[i]) - keys[i]; atomicAdd(R + 8, d * d); atomicAdd(R + 9, keys[i] * keys[i]); }
}
__global__ void chk_uv(Args a) {
    const bf16* UB = (const bf16*)(a.ws + WS_UB); const bf16* VB = (const bf16*)(a.ws + WS_VB); float* R = (float*)(a.ws + WS_CTL + WS_DBG);
    const size_t i = ((size_t)blockIdx.x * blockDim.x + threadIdx.x) * 61 % ((size_t)2 * 16384 * 1024);
    const float du = bf2f(UB[i]) - a.in[22][i], dv = bf2f(VB[i]) - a.in[23][i];
    atomicAdd(R + 16, du * du + dv * dv); atomicAdd(R + 17, a.in[22][i] * a.in[22][i] + a.in[23][i] * a.in[23][i]);
}
__global__ void chk_route(Args a) {
    const bf16* QRY = (const bf16*)(a.ws + WS_QRY); const float* keys = a.in[21] + (size_t)CHECK_LAYER * 2 * 128 * 128;
    const int* IDX = (const int*)(a.ws + WS_IDX); const float* GATE = (const float*)(a.ws + WS_GATE);
    float* R = (float*)(a.ws + WS_CTL + WS_DBG);
    __shared__ float sc[2][128]; __shared__ float sc0[2][128]; __shared__ float ts[2][16]; __shared__ int ti[2][16]; __shared__ float cs[256]; __shared__ int ci[256];
    const int tok = (blockIdx.x * 613 + 5) % M, hd = blockIdx.x & 7, tid = threadIdx.x;
    { const int p = tid >> 7, n = tid & 127; float s = 0.f; for (int d = 0; d < 128; ++d) s += bf2f(QRY[(size_t)tok * NQ + hd * 256 + p * 128 + d]) * keys[(size_t)(p * 128 + n) * 128 + d]; sc[p][n] = s; sc0[p][n] = s; }
    __syncthreads();
    if (tid < 2) { const int p = tid; for (int k = 0; k < 16; ++k) { int best = 0; float bv = -INFINITY; for (int n = 0; n < 128; ++n) if (sc[p][n] > bv) { bv = sc[p][n]; best = n; } ts[p][k] = bv; ti[p][k] = best; sc[p][best] = -INFINITY; } }
    __syncthreads();
    cs[tid] = ts[0][tid >> 4] + ts[1][tid & 15]; ci[tid] = ti[0][tid >> 4] * 128 + ti[1][tid & 15];
    __syncthreads();
    if (tid == 0) {
        float fs[16]; int fi[16];
        for (int k = 0; k < 16; ++k) { int best = 0; float bv = -INFINITY; for (int n = 0; n < 256; ++n) if (cs[n] > bv) { bv = cs[n]; best = n; } fs[k] = bv; fi[k] = ci[best]; cs[best] = -INFINITY; }
        float den = 0.f; for (int k = 0; k < 16; ++k) den += __expf(fs[k] - fs[0]);
        int mism = 0; float ge = 0.f;
        for (int k = 0; k < 16; ++k) { bool found = false; for (int j = 0; j < 16; ++j) if (IDX[(size_t)tok * 128 + hd * 16 + j] == fi[k]) { found = true; const float g = __expf(fs[k] - fs[0]) / den; const float d = g - GATE[(size_t)tok * 128 + hd * 16 + j]; ge += d * d; } if (!found) ++mism; }
        { int ba = 0, bb = 0; for (int j = 0; j < 16; ++j) { const int e = IDX[(size_t)tok * 128 + hd * 16 + j]; const int ea = (e >> 7) & 127, eb = e & 127;
            if (!(e >= 0 && e < 16384) || sc0[0][ea] + sc0[1][eb] < fs[15] - 0.05f) ++ba; if (!(e >= 0 && e < 16384) || sc0[1][ea] + sc0[0][eb] < fs[15] - 0.05f) ++bb; }
          atomicAdd(R + 10, (float)ba); atomicAdd(R + 11, (float)bb); }
        atomicAdd(R + 2, (float)mism); atomicAdd(R + 3, 16.f); atomicAdd(R + 4, ge); atomicAdd(R + 5, 1.f / 16.f);
    }
}
__global__ void chk_scores(Args a) {
    const bf16* QRY = (const bf16*)(a.ws + WS_QRY); const float* keys = a.in[21] + (size_t)CHECK_LAYER * 2 * 128 * 128;
    const float* DB = (const float*)(a.ws + WS_CLOC) + 8 * 1024 * 1024; float* R = (float*)(a.ws + WS_CTL + WS_DBG);
    const int t = blockIdx.x, tid = threadIdx.x;
    __shared__ float sc[2][128];
    { const int p = tid >> 7, n = tid & 127; float s = 0.f; for (int d = 0; d < 128; ++d) s += bf2f(QRY[(size_t)t * NQ + p * 128 + d]) * keys[(size_t)(p * 128 + n) * 128 + d];
      const float dv = DB[(p * 128 + t) * 128 + n]; atomicAdd(R + 12, (s - dv) * (s - dv)); atomicAdd(R + 13, s * s); sc[p][n] = dv; }
    __syncthreads();
    if (tid < 2) { const int p = tid; int bad = 0; for (int k = 0; k < 16; ++k) { int best = 0; float bv = -INFINITY; for (int n = 0; n < 128; ++n) if (sc[p][n] > bv) { bv = sc[p][n]; best = n; }
        const float lv = DB[32768 + t * 48 + 16 * p + k]; if (fabsf(lv - bv) > 1e-3f * (1.f + fabsf(bv))) ++bad; sc[p][best] = -INFINITY; }
        atomicAdd(R + 14, (float)bad); atomicAdd(R + 15, 16.f); }
}
__global__ void chk_expert(Args a) {
    const bf16* XN = (const bf16*)(a.ws + WS_XNY); const int* IDX = (const int*)(a.ws + WS_IDX); const float* GATE = (const float*)(a.ws + WS_GATE);
    const float* U = a.in[22] + (size_t)CHECK_LAYER * 16384 * 1024; const float* V = a.in[23] + (size_t)CHECK_LAYER * 16384 * 1024;
    const float* DO = (const float*)(a.ws + WS_DBGOUT); float* R = (float*)(a.ws + WS_CTL + WS_DBG);
    __shared__ float act[128];
    const int tok = (blockIdx.x * 61 + 3) % 4096, tid = threadIdx.x;
    if (tid < 128) { const int e = IDX[(size_t)tok * 128 + tid]; float s = 0.f; for (int k = 0; k < D; ++k) s += bf2f(XN[(size_t)tok * D + k]) * U[(size_t)e * D + k];
        act[tid] = 0.5f * s * (1.f + erff(s * 0.70710678f)) * GATE[(size_t)tok * 128 + tid]; }
    __syncthreads();
    for (int c = tid; c < D; c += 256) { float o = 0.f; for (int e = 0; e < 128; ++e) o += act[e] * V[(size_t)IDX[(size_t)tok * 128 + e] * D + c];
        const float g = DO[(size_t)tok * D + c]; atomicAdd(R + 6, (o - g) * (o - g)); atomicAdd(R + 7, o * o); }
}
__global__ void chk_stamp(Args a) {
    const float* R = (const float*)(a.ws + WS_CTL + WS_DBG);
    const float e1 = sqrtf(R[0] / fmaxf(R[1], 1e-30f)), e2 = R[2] / fmaxf(R[3], 1.f), e2g = sqrtf(R[4] / fmaxf(R[5], 1e-30f)), e3 = sqrtf(R[6] / fmaxf(R[7], 1e-30f));
    float c;
#if CHECK == 99
    c = 1.f;
#else
    const float e0 = sqrtf(R[8] / fmaxf(R[9], 1e-30f));
    const float ea = R[10] / fmaxf(R[3], 1.f), eb = R[11] / fmaxf(R[3], 1.f);
    const float esc = sqrtf(R[12] / fmaxf(R[13], 1e-30f)), els = R[14] / fmaxf(R[15], 1.f);
    const float euv = sqrtf(R[16] / fmaxf(R[17], 1e-30f));
    const float errs[4] = {e2, euv, ea, e3}; const float tols[4] = {0.08f, 0.01f, 0.08f, 0.03f};
    c = 1.f;
    for (int k = 3; k >= 0; --k) if (!(errs[k] <= tols[k])) { const float fr = fminf(fmaxf((log10f(fmaxf(errs[k], 1e-4f)) + 4.f) / 5.f, 0.f), 0.95f); c = 2.f + (float)k + fr; }
#endif
    const size_t i = (size_t)blockIdx.x * blockDim.x + threadIdx.x;
    if (i < (size_t)M * D) a.out[i] = a.in[0][i] * (1.f + c);
}
#endif
#ifndef MK_PER_PHASE
#define MK_PER_PHASE 0
#endif
constexpr int NPHASE = 24;
#ifndef RPROBE
#define RPROBE 0
#endif
#ifndef DBG_Y0
#define DBG_Y0 1
#define DBG_P0 1
#define DBG_Y1 1
#define DBG_P1 1
#endif
#ifndef PHASE_MASK
#define PHASE_MASK 0x1ffffffu
#endif
#define IN(k) (lo <= (k) && (k) < hi && ((PHASE_MASK >> (k)) & 1u))
#ifndef DUP_PHASE
#define DUP_PHASE -1
#endif
#define REPS(k) for (int rep = ((DUP_PHASE) == (k) ? 0 : 1); rep < 2; ++rep)
#define SEAM(k) do { if (IN(k) && IN((k) + 1)) xcd_barrier(bar); } while (0)
__device__ __forceinline__ float alibi_tcut(const float* gq, const float* gk, int lane) { return 16.f * wave_max(fabsf(gq[lane])) * wave_max(fabsf(gk[lane])) + ALIBI_MARGIN; }
template <int layer>
__device__ __forceinline__ void layer_phases(Frame& F, const Args& args, const XcdBarrier& bar, const int lo, const int hi) {
    volatile LAS unsigned* MISCW = (volatile LAS unsigned*)(F.lds + MISC_OFF);
    float* MOD = WSP(float, WS_MOD);
    bf16* XNY = WSP(bf16, WS_XNY); bf16* Zb = WSP(bf16, WS_Z);

        constexpr int pb = layer * 12;
        const float* mod = MOD + (size_t)layer * 4 * 6144;
        if (IN(pb + 1)) REPS(pb + 1) { if (layer == 0) norm_pass<true>(F, args, args.in[0], args.in[4], mod, 0, XNY); else norm_pass<false>(F, args, F.out, args.in[4] + 1024, mod, 0, XNY); } SEAM(pb + 1);
        if (IN(pb + 2)) REPS(pb + 2) {
            const int N = layer == 0 ? NZ0 : NZ1;
            pg8::Gemm g{XNY, layer == 0 ? WSP(bf16, WS_WIN0) : WSP(bf16, WS_WIN1), M, N, D}; pg8::StaticOrder S; S.init(M, N, F.G, F.bid);
            pg8::EpiBf16QK E{Zb, N, layer == 0 ? 8 : 0, layer == 0 ? 10 : 4, layer == 0 ? 10 : 4, layer == 0 ? 12 : 8, layer == 0 ? args.in[11] : args.in[15], layer == 0 ? args.in[12] : args.in[16], 0.125f * LOG2E, (LAS float*)(F.lds + 131072)};
            pg8::gemm_phase<pg8::EpiBf16QK, pg8::StaticOrder, true, true>(F.lds, g, S, E);
        } SEAM(pb + 2);
        if (layer == 0) {
            if (IN(3)) REPS(3) {
                for (int u = F.bid; u < 1024 + 128; u += F.G) {
                    if (u < 1024) mlstm_a_unit(F, args, u);
                    else if (rep == 1) { const int v = u - 1024, b = v >> 5, j = v & 31;
                        kmean_unit(F, Zb, NZ0, b * SEQ + j * 256, 2560, WSP(float, WS_KMEAN) + (size_t)((b * 8) * 32 + j) * 64); }
                }
            } SEAM(3);
            if (IN(4)) REPS(4) {
                if (rep == 1) for (int u = F.bid; u < 256; u += F.G) mlstm_scan_unit(F, u);
                { const float tcut = alibi_tcut(args.in[11], args.in[12], ((int)(threadIdx.x & 63u)));
                  const unsigned short* ORD = WSP(unsigned short, WS_ORD) + 2048; unsigned* qw = (unsigned*)(F.ws + WS_CTL) + CW_QMOBA + (rep == 1 ? 0 : 8);
                  for (int xi = 0; xi < 8; ++xi) { const int x = (F.bid + xi) & 7;
                      for (;;) { if (((int)threadIdx.x) == 0) MISCW[0] = atomicAdd(qw + 16 * x, 1u); __syncthreads(); const unsigned qi = MISCW[0]; __syncthreads(); if (qi >= 128u) break;
                          const int u = ORD[x * 128 + qi]; moba_unit(F, u >> 8, (u >> 5) & 7, u & 31, tcut); } }
                  if (rep == 1) { unsigned* cw = (unsigned*)(F.ws + WS_CTL) + CW_QCVT0;
                      for (;;) { if (((int)threadIdx.x) == 0) MISCW[0] = atomicAdd(cw, 1u); __syncthreads(); const unsigned ci = MISCW[0]; __syncthreads(); if (ci >= 512u) break; i8_chunk(F, args, 0, (int)ci); } } }
            } SEAM(4);
            if (IN(5)) REPS(5) { for (int u = F.bid; u < 1024; u += F.G) mlstm_c_unit(F, args, u); } SEAM(5);
        } else {
            if (IN(pb + 4)) REPS(pb + 4) {
                const float* lp = args.in[17];
                const float lam = __expf(wave_sum(lp[((int)(threadIdx.x & 63u))] * lp[64 + ((int)(threadIdx.x & 63u))])) - __expf(wave_sum(lp[128 + ((int)(threadIdx.x & 63u))] * lp[192 + ((int)(threadIdx.x & 63u))])) + 0.35550906759096926f;
                { const float tcut = alibi_tcut(args.in[15], args.in[16], ((int)(threadIdx.x & 63u)));
                  const unsigned short* ORD = WSP(unsigned short, WS_ORD); unsigned* qw = (unsigned*)(F.ws + WS_CTL) + CW_QDIFF + (rep == 1 ? 0 : 8);
                  for (int xi = 0; xi < 8; ++xi) { const int x = (F.bid + xi) & 7;
                      for (;;) { if (((int)threadIdx.x) == 0) MISCW[0] = atomicAdd(qw + 16 * x, 1u); __syncthreads(); const unsigned qi = MISCW[0]; __syncthreads(); if (qi >= 256u) break;
                          const int u = ORD[x * 256 + qi]; diff_unit(F, args, u >> 9, (u >> 6) & 7, u & 63, lam, tcut, rep == 0 ? RPROBE : 0); } }
                  if (rep == 1) { unsigned* cw = (unsigned*)(F.ws + WS_CTL) + CW_QCVT1;
                      for (;;) { if (((int)threadIdx.x) == 0) MISCW[0] = atomicAdd(cw, 1u); __syncthreads(); const unsigned ci = MISCW[0]; __syncthreads(); if (ci >= 512u) break; i8_chunk(F, args, 1, (int)ci); } } }
            } SEAM(pb + 4);
        }
        if (IN(pb + 6)) {
            pg8::Gemm g{XNY, layer == 0 ? WSP(bf16, WS_WOUT0) : WSP(bf16, WS_WOUT1), M, D, D}; pg8::StaticOrder S; S.init(M, D, F.G, F.bid);
            pg8::EpiResid E{layer == 0 ? args.in[0] : F.out, F.out, mod + 2 * 1024};
            pg8::gemm_phase<pg8::EpiResid, pg8::StaticOrder, true, true>(F.lds, g, S, E);
        } SEAM(pb + 6);
        if (IN(pb + 7)) REPS(pb + 7) { norm_pass<false>(F, args, F.out, args.in[5] + layer * 1024, mod, 3, XNY); } SEAM(pb + 7);
        if (IN(pb + 8)) REPS(pb + 8) {
            pg8::Gemm g{XNY, WSP(bf16, WS_WQ) + (size_t)layer * NQ * D, M, NQ, D}; pg8::StaticOrder S; S.init(M, NQ, F.G, F.bid);
            pg8::EpiBf16 E{WSP(bf16, WS_QRY), NQ};
            pg8::gemm_phase<pg8::EpiBf16, pg8::StaticOrder, true, true>(F.lds, g, S, E);
        } SEAM(pb + 8);
        if (IN(pb + 9)) REPS(pb + 9) { const bf16* KEYS = WSP(bf16, WS_KEYS) + (size_t)layer * 2 * 128 * 128;
            bf16x8 kf[4][2];
#pragma unroll
            for (int ks = 0; ks < 4; ++ks)
#pragma unroll
                for (int n = 0; n < 2; ++n) kf[ks][n] = *(const GAS bf16x8*)(KEYS + (size_t)((F.wave & 1) * 128 + 32 * (F.wave >> 1) + 16 * n + (((int)(threadIdx.x & 63u)) & 15)) * 128 + 32 * ks + 8 * (((int)(threadIdx.x & 63u)) >> 4));
            for (int u = F.bid; u < 2048; u += F.G) peer_route_unit(F, (u >> 3) * 128, u & 7, kf, rep == 0 ? RPROBE : 0); } SEAM(pb + 9);
        if (IN(pb + 10)) REPS(pb + 10) { peer_u_phase(F, F.ws + WS_UB + (size_t)layer * 8 * 16384 * 128); } SEAM(pb + 10);
        if (IN(pb + 11)) REPS(pb + 11) { peer_act_phase(F, WSP(float, WS_ISU) + layer * 16384, WSP(float, WS_ISV) + layer * 16384); } SEAM(pb + 11);
        if (IN(pb + 12)) REPS(pb + 12) { peer_v_phase(F, F.ws + WS_VB + (size_t)layer * 8 * 16384 * 128, mod + 5 * 1024, rep == 1 ? (layer == 0 ? (float)DBG_P0 : (float)DBG_P1) : 0.f); }
        if (layer == 0) SEAM(12);
    }
__global__ void __launch_bounds__(NTHR, 2) mega_fwd(Args args) {
    extern __shared__ __attribute__((aligned(16))) unsigned char lds_raw[];
    Frame F;
    F.lds = (LAS unsigned char*)lds_raw;
    F.wave = __builtin_amdgcn_readfirstlane((int)threadIdx.x >> 6);
    F.G = gridDim.x; F.bid = blockIdx.x;
    F.out = args.out; F.ws = args.ws;
    volatile LAS unsigned* MISC = (volatile LAS unsigned*)(F.lds + MISC_OFF);
    for (int u = ((int)threadIdx.x); u < (LDS_BYTES - LDSCTL_OFF) / 4; u += NTHR) ((LAS unsigned*)(F.lds + LDSCTL_OFF))[u] = 0u;
    __syncthreads();
    XcdBarrier bar; bar.bar = (unsigned*)(F.ws + WS_CTL) + CW_BAR; bar.x = 0; bar.st = nullptr;
    if (!MK_PER_PHASE) bar = xcd_barrier_post((unsigned*)(F.ws + WS_CTL) + CW_BAR, MISC + 8);
    const int lo = args.ph_lo, hi = args.ph_hi;

#ifdef EXTRA_BAR
    for (int i = 0; i < EXTRA_BAR; ++i) xcd_barrier(bar);
#endif
    if (IN(0)) REPS(0) { p0_prologue(F, args); } SEAM(0);
    layer_phases<0>(F, args, bar, lo, hi);
    layer_phases<1>(F, args, bar, lo, hi);
}
#undef IN
#undef SEAM

extern "C" void kernel_launch(void* const* d_in, const int* in_sizes, int n_in, void* d_out, int out_size, void* d_ws, size_t ws_size, hipStream_t stream) {
    static int grid = 0;
    if (grid == 0) {
        if (n_in != 24 || in_sizes[0] != M * D || out_size != M * D || ws_size < WS_END) { fprintf(stderr, "kernel_launch: unexpected problem (n_in %d, in0 %d, out %d, ws %zu < %zu); nothing launched\n", n_in, n_in > 0 ? in_sizes[0] : -1, out_size, ws_size, (size_t)WS_END); grid = -1; return; }
        int dev = 0, cus = 0, per_cu = 0;
        if (hipGetDevice(&dev) != hipSuccess || hipDeviceGetAttribute(&cus, hipDeviceAttributeMultiprocessorCount, dev) != hipSuccess) { grid = -1; return; }
        if (hipFuncSetAttribute((const void*)mega_fwd, hipFuncAttributeMaxDynamicSharedMemorySize, LDS_BYTES) != hipSuccess) { fprintf(stderr, "kernel_launch: hipFuncSetAttribute failed\n"); grid = -1; return; }
        if (hipOccupancyMaxActiveBlocksPerMultiprocessor(&per_cu, (const void*)mega_fwd, NTHR, LDS_BYTES) != hipSuccess || per_cu < 1)
            fprintf(stderr, "kernel_launch: note: occupancy query reports %d workgroups per CU\n", per_cu);
        (void)hipGetLastError();
        grid = cus;
    }
    if (grid < 0) return;
    if (hipMemsetAsync((char*)d_ws + WS_CTL, 0, CTL_ZERO_BYTES, stream) != hipSuccess) { fprintf(stderr, "kernel_launch: memset failed\n"); return; }
    Args a{};
    for (int i = 0; i < 24; ++i) a.in[i] = (const float*)d_in[i];
    a.out = (float*)d_out; a.ws = (unsigned char*)d_ws;
#if MK_PER_PHASE
    for (int p = 0; p < NPHASE + 1; ++p) { a.ph_lo = p; a.ph_hi = p + 1; hipLaunchKernelGGL(mega_fwd, dim3(grid), dim3(NTHR), LDS_BYTES, stream, a); }
#else
    a.ph_lo = 0; a.ph_hi = NPHASE + 1;
    hipLaunchKernelGGL(mega_fwd, dim3(grid), dim3(NTHR), LDS_BYTES, stream, a);
#endif
#if defined(CHECK) && CHECK
    chk_qry<<<256, 256, 0, stream>>>(a); chk_keys<<<256, 256, 0, stream>>>(a); chk_uv<<<1024, 256, 0, stream>>>(a); chk_scores<<<128, 256, 0, stream>>>(a); chk_route<<<512, 256, 0, stream>>>(a); chk_expert<<<64, 256, 0, stream>>>(a); chk_stamp<<<(M * D + 255) / 256, 256, 0, stream>>>(a);
#endif
    const hipError_t le = hipPeekAtLastError();
    if (le != hipSuccess) fprintf(stderr, "kernel_launch: launch failed: %s\n", hipGetErrorName(le));
}
```

```cpp
#include <hip/hip_runtime.h>
#include <cstdio>
#include <cstdint>
namespace pg8 {
#define PG8_LAS __attribute__((address_space(3)))
typedef unsigned short bf16_t;
typedef short bf16x8 __attribute__((ext_vector_type(8)));
typedef float f32x4 __attribute__((ext_vector_type(4)));
typedef unsigned u32x4 __attribute__((ext_vector_type(4)));
constexpr int BM = 256, BK = 64, HALF = 128, HTB = HALF * BK * 2  , STAGE_BYTES = 8 * HTB, NXCD = 8, WGM = 8;

__host__ __device__ __forceinline__ int lds_byte(int r, int c) { const int st = (r >> 4) * 2 + (c >> 5), rr = r & 15, cc = c & 31, ob = rr * 64 + cc * 2; return st * 1024 + (ob ^ (((ob >> 9) & 1) << 5)); }
__host__ __device__ __forceinline__ void stage_rc(int b, int& R, int& C) { const int st = b / 1024, sb = b % 1024, swz = sb ^ (((sb >> 9) & 1) << 5); R = (st >> 1) * 16 + swz / 64; C = (st & 1) * 32 + (swz % 64) / 2; }
__host__ __device__ __forceinline__ int perm32(int rho) { const int n = rho >> 4, i = rho & 15; return 8 * (i >> 2) + 4 * n + (i & 3); }

struct Unit { int pm, pn; };
struct Gemm { const bf16_t* A; const bf16_t* Bt; int M, N, K; size_t bstride; };

struct StaticOrder {
    int nM, nN, nwg, G, c;
    __host__ __device__ void init(int M, int N, int G_, int c_) { nM = M / BM; nN = N / BM; nwg = nM * nN; G = G_; c = c_; }
    __host__ __device__ bool next(int i, Unit& u) const {
        const long L = (long)i * G + c; if (L >= nwg) return false;
        int wgid = (int)L; { const int q = nwg / NXCD, r = nwg % NXCD, xcd = wgid % NXCD, off = wgid / NXCD; wgid = (xcd < r ? xcd * (q + 1) : r * (q + 1) + (xcd - r) * q) + off; }
        const int nig = WGM * nN, gid = wgid / nig, fm = gid * WGM, gsz = (nM - fm) < WGM ? (nM - fm) : WGM;
        u.pm = fm + ((wgid % nig) % gsz); u.pn = (wgid % nig) / gsz; return true;
    }
    __device__ __forceinline__ void a_ready(const Unit&) const {}
    __device__ __forceinline__ void done(const Unit&) const {}
};

__device__ __forceinline__ unsigned cvt_pk_bf16(float lo, float hi) { unsigned r; asm volatile("v_cvt_pk_bf16_f32 %0, %1, %2" : "=v"(r) : "v"(lo), "v"(hi)); return r; }
typedef unsigned u32x4 __attribute__((ext_vector_type(4)));
struct EpiBf16 {
    static constexpr bool PERM = true, AFTER_DRAIN = false;
    bf16_t* O; int ldc;
    __device__ __forceinline__ void operator()(const f32x4 (&acc)[2][2][4][2], const Unit& u, int wr, int wc, int fr, int fq) const {
        const int row0 = u.pm * BM + wr * 64 + fr; const int col0 = u.pn * BM + wc * 32 + 8 * fq;
#pragma unroll
        for (int ai = 0; ai < 2; ++ai)
#pragma unroll
            for (int m = 0; m < 4; ++m) { bf16_t* rowp = O + (size_t)(row0 + ai * HALF + m * 16) * ldc + col0;
#pragma unroll
                for (int bj = 0; bj < 2; ++bj) { const f32x4 v0 = acc[ai][bj][m][0], v1 = acc[ai][bj][m][1];
                    u32x4 w; w.x = cvt_pk_bf16(v0[0], v0[1]); w.y = cvt_pk_bf16(v0[2], v0[3]); w.z = cvt_pk_bf16(v1[0], v1[1]); w.w = cvt_pk_bf16(v1[2], v1[3]);
                    *(u32x4*)(rowp + bj * HALF) = w; } }
    }
};
struct EpiBf16QK {
    static constexpr bool PERM = true, AFTER_DRAIN = false;
    bf16_t* O; int ldc; int q_lo, q_hi, k_lo, k_hi; const float* gq; const float* gk; float qmul; PG8_LAS float* xs;
    __device__ __forceinline__ void operator()(const f32x4 (&acc)[2][2][4][2], const Unit& u, int wr, int wc, int fr, int fq) const {
        const int row0 = u.pm * BM + wr * 64 + fr; const int col0 = u.pn * BM + wc * 32 + 8 * fq;
        const bool isq = u.pn >= q_lo && u.pn < q_hi, isk = u.pn >= k_lo && u.pn < k_hi;
        if (!(isq || isk)) {
#pragma unroll
            for (int ai = 0; ai < 2; ++ai)
#pragma unroll
                for (int m = 0; m < 4; ++m) { bf16_t* rowp = O + (size_t)(row0 + ai * HALF + m * 16) * ldc + col0;
#pragma unroll
                    for (int bj = 0; bj < 2; ++bj) { const f32x4 v0 = acc[ai][bj][m][0], v1 = acc[ai][bj][m][1];
                        u32x4 w; w.x = cvt_pk_bf16(v0[0], v0[1]); w.y = cvt_pk_bf16(v0[2], v0[3]); w.z = cvt_pk_bf16(v1[0], v1[1]); w.w = cvt_pk_bf16(v1[2], v1[3]);
                        *(u32x4*)(rowp + bj * HALF) = w; } }
            return;
        }
        float ssq[2][4][2];
#pragma unroll
        for (int ai = 0; ai < 2; ++ai)
#pragma unroll
            for (int m = 0; m < 4; ++m)
#pragma unroll
                for (int bj = 0; bj < 2; ++bj) { const f32x4 v0 = acc[ai][bj][m][0], v1 = acc[ai][bj][m][1];
                    float s = (v0[0] * v0[0] + v0[1] * v0[1]) + (v0[2] * v0[2] + v0[3] * v0[3]) + (v1[0] * v1[0] + v1[1] * v1[1]) + (v1[2] * v1[2] + v1[3] * v1[3]);
                    s += __shfl_xor(s, 16); s += __shfl_xor(s, 32); ssq[ai][m][bj] = s;
                    if (fq == 0) xs[(ai * HALF + wr * 64 + m * 16 + fr) * 8 + bj * 4 + wc] = s; }
        asm volatile("s_waitcnt lgkmcnt(0)" ::: "memory"); __builtin_amdgcn_s_barrier(); asm volatile("" ::: "memory");
        const float* g = isq ? gq : gk; const float gm = isq ? qmul : 1.f;
        const int d0 = (wc & 1) * 32 + 8 * fq;
        const f32x4 g0 = *(const f32x4*)(g + d0) * gm, g1 = *(const f32x4*)(g + d0 + 4) * gm;
#pragma unroll
        for (int ai = 0; ai < 2; ++ai)
#pragma unroll
            for (int m = 0; m < 4; ++m) { bf16_t* rowp = O + (size_t)(row0 + ai * HALF + m * 16) * ldc + col0;
#pragma unroll
                for (int bj = 0; bj < 2; ++bj) { const float tot = ssq[ai][m][bj] + xs[(ai * HALF + wr * 64 + m * 16 + fr) * 8 + bj * 4 + (wc ^ 1)];
                    const float rs = __builtin_amdgcn_rsqf(tot * (1.f / 64.f) + 1e-6f);
                    const f32x4 v0 = acc[ai][bj][m][0] * rs * g0, v1 = acc[ai][bj][m][1] * rs * g1;
                    u32x4 w; w.x = cvt_pk_bf16(v0[0], v0[1]); w.y = cvt_pk_bf16(v0[2], v0[3]); w.z = cvt_pk_bf16(v1[0], v1[1]); w.w = cvt_pk_bf16(v1[2], v1[3]);
                    *(u32x4*)(rowp + bj * HALF) = w; } }
    }
};
struct EpiBf16RS {
    static constexpr bool PERM = true, AFTER_DRAIN = false;
    bf16_t* O; int ldc; const float* rss; const float* bias; int bias_stride;
    __device__ __forceinline__ void operator()(const f32x4 (&acc)[2][2][4][2], const Unit& u, int wr, int wc, int fr, int fq) const {
        const int row0 = u.pm * BM + wr * 64 + fr; const int col0 = u.pn * BM + wc * 32 + 8 * fq; const int b = (u.pm * BM) >> 13;
        f32x4 bv[2][2];
#pragma unroll
        for (int bj = 0; bj < 2; ++bj)
#pragma unroll
            for (int n = 0; n < 2; ++n) bv[bj][n] = *(const f32x4*)(bias + (size_t)b * bias_stride + col0 + bj * HALF + 4 * n);
#pragma unroll
        for (int ai = 0; ai < 2; ++ai)
#pragma unroll
            for (int m = 0; m < 4; ++m) { const int row = row0 + ai * HALF + m * 16; bf16_t* rowp = O + (size_t)row * ldc + col0;
                const f32x4 p0 = *(const f32x4*)(rss + (size_t)row * 16), p1 = *(const f32x4*)(rss + (size_t)row * 16 + 4), p2 = *(const f32x4*)(rss + (size_t)row * 16 + 8), p3 = *(const f32x4*)(rss + (size_t)row * 16 + 12);
                const f32x4 pt = (p0 + p1) + (p2 + p3);
                const float rs = __builtin_amdgcn_rsqf(((pt[0] + pt[1]) + (pt[2] + pt[3])) * (1.f / 1024.f) + 1e-6f);
#pragma unroll
                for (int bj = 0; bj < 2; ++bj) { const f32x4 v0 = acc[ai][bj][m][0] * rs + bv[bj][0], v1 = acc[ai][bj][m][1] * rs + bv[bj][1];
                    u32x4 w; w.x = cvt_pk_bf16(v0[0], v0[1]); w.y = cvt_pk_bf16(v0[2], v0[3]); w.z = cvt_pk_bf16(v1[0], v1[1]); w.w = cvt_pk_bf16(v1[2], v1[3]);
                    *(u32x4*)(rowp + bj * HALF) = w; } }
    }
};
template <bool BASE_BF16> struct EpiResid {
    static constexpr bool PERM = false, AFTER_DRAIN = false;
    const void* base; bf16_t* out; const float* gate;
    __device__ __forceinline__ void operator()(const f32x4 (&acc)[2][2][4][2], const Unit& u, int wr, int wc, int fr, int fq) const {
        typedef unsigned u32x2_ __attribute__((ext_vector_type(2)));
        const int col0 = u.pn * BM + wc * 32 + 4 * fq; const int b = (u.pm * BM) >> 13;
#pragma unroll
        for (int bj = 0; bj < 2; ++bj)
#pragma unroll
            for (int n = 0; n < 2; ++n) { const f32x4 gv = *(const f32x4*)(gate + (size_t)b * 6144 + col0 + bj * HALF + n * 16);
#pragma unroll
                for (int ai = 0; ai < 2; ++ai)
#pragma unroll
                    for (int m = 0; m < 4; ++m) { const size_t off = (size_t)(u.pm * BM + ai * HALF + wr * 64 + m * 16 + fr) * 1024 + col0 + bj * HALF + n * 16;
                        f32x4 bs;
                        if (BASE_BF16) { const u32x2_ w = *(const u32x2_*)((const bf16_t*)base + off); const unsigned w0 = w.x, w1 = w.y;
                            bs = (f32x4){__builtin_bit_cast(float, w0 << 16), __builtin_bit_cast(float, w0 & 0xffff0000u), __builtin_bit_cast(float, w1 << 16), __builtin_bit_cast(float, w1 & 0xffff0000u)}; }
                        else bs = *(const f32x4*)((const float*)base + off);
                        const f32x4 o = bs + gv * acc[ai][bj][m][n];
                        u32x2_ ow; ow.x = cvt_pk_bf16(o[0], o[1]); ow.y = cvt_pk_bf16(o[2], o[3]); *(u32x2_*)(out + off) = ow; } }
    }
};

template <class Epi, class Sched, bool ALIGN_EPI = false, bool SP2 = false>
__device__ __forceinline__ void gemm_phase(PG8_LAS unsigned char* lds, const Gemm g, const Sched& S, const Epi& E) {
    const int tid = threadIdx.x, wid = __builtin_amdgcn_readfirstlane(tid >> 6), lane = tid & 63, wr = wid >> 2, wc = wid & 3, fr = lane & 15, fq = lane >> 4;
    const int K = g.K, nt = K / BK;
    unsigned voffA[2], voffB[2];
#pragma unroll
    for (int i = 0; i < 2; ++i) { int R, C; stage_rc(tid * 16 + i * 8192, R, C); const int Rb = Epi::PERM ? ((R & ~31) + perm32(R & 31)) : R;
        voffA[i] = (unsigned)(R * K + C) * 2u; voffB[i] = (unsigned)(Rb * K + C) * 2u; }
    const size_t kstep = (size_t)(BK * 2);
    const size_t hstep = (size_t)HALF * K * 2;
    const size_t tstep = 2 * hstep;
    const unsigned ldsw = (unsigned)wid * 1024u;
    const int aoff = lds_byte(wr * 64 + fr, fq * 8), boff = lds_byte(wc * 32 + fr, fq * 8);
#define PG8_SA(b, h) (((b) * 2 + (h)) * HTB)
#define PG8_SB(b, h) ((4 + (b) * 2 + (h)) * HTB)
#define PG8_STAGE(bufoff, gbase, voff) do { _Pragma("unroll") for (int _i = 0; _i < 2; ++_i) \
        __builtin_amdgcn_global_load_lds((const unsigned*)((const char*)(gbase) + (voff)[_i]), (PG8_LAS unsigned*)(lds + (bufoff) + ldsw + _i * 8192), 16, 0, 0); } while (0)
#define PG8_LDA(dst, b, h) do { _Pragma("unroll") for (int m = 0; m < 4; ++m) _Pragma("unroll") for (int k = 0; k < 2; ++k) dst[m][k] = *(const PG8_LAS bf16x8*)(lds + PG8_SA(b, h) + aoff + m * 2048 + k * 1024); } while (0)
#define PG8_LDB(dst, b, h) do { _Pragma("unroll") for (int n = 0; n < 2; ++n) _Pragma("unroll") for (int k = 0; k < 2; ++k) dst[n][k] = *(const PG8_LAS bf16x8*)(lds + PG8_SB(b, h) + boff + n * 2048 + k * 1024); } while (0)
#define PG8_MMA(ai, bj, At, Bt) do { __builtin_amdgcn_s_setprio(1); _Pragma("unroll") for (int m = 0; m < 4; ++m) _Pragma("unroll") for (int n = 0; n < 2; ++n) _Pragma("unroll") for (int k = 0; k < 2; ++k) \
        acc[ai][bj][m][n] = __builtin_amdgcn_mfma_f32_16x16x32_bf16(Bt[n][k], At[m][k], acc[ai][bj][m][n], 0, 0, 0); __builtin_amdgcn_s_setprio(0); } while (0)
#define PG8_WAIT_V(n) asm volatile("s_waitcnt vmcnt(" #n ")" ::: "memory")
#define PG8_WAIT_L(n) asm volatile("s_waitcnt lgkmcnt(" #n ")" ::: "memory")
#define PG8_BAR __builtin_amdgcn_s_barrier()
#define PG8_SCHED __builtin_amdgcn_sched_barrier(0)
    Unit cur, nxt; int ui = 0;
    if (!S.next(0, cur)) return;
    f32x4 acc[2][2][4][2];
#pragma unroll
    for (int a = 0; a < 2; ++a)
#pragma unroll
        for (int b = 0; b < 2; ++b)
#pragma unroll
            for (int m = 0; m < 4; ++m)
#pragma unroll
                for (int n = 0; n < 2; ++n) acc[a][b][m][n] = (f32x4){0.f, 0.f, 0.f, 0.f};
    bf16x8 At[4][2], B0[2][2], B1[2][2];
    const char* cA = (const char*)g.A + (size_t)cur.pm * tstep; const char* cB = (const char*)g.Bt + (size_t)(cur.pm >> 5) * g.bstride + (size_t)cur.pn * tstep;
    S.a_ready(cur);
    if constexpr (SP2) {
        PG8_STAGE(PG8_SB(0, 0), cB, voffB); PG8_STAGE(PG8_SB(0, 1), cB + hstep, voffB); PG8_STAGE(PG8_SA(0, 0), cA, voffA); PG8_STAGE(PG8_SA(0, 1), cA + hstep, voffA);
        if (wr == 1) PG8_BAR;
        PG8_WAIT_V(2); PG8_BAR;
        PG8_STAGE(PG8_SB(1, 0), cB + kstep, voffB); PG8_STAGE(PG8_SA(1, 0), cA + kstep, voffA); PG8_STAGE(PG8_SB(1, 1), cB + hstep + kstep, voffB);
        PG8_WAIT_V(6); PG8_BAR;
    } else {
        PG8_STAGE(PG8_SB(0, 0), cB, voffB); PG8_STAGE(PG8_SA(0, 0), cA, voffA); PG8_STAGE(PG8_SB(0, 1), cB + hstep, voffB); PG8_STAGE(PG8_SA(0, 1), cA + hstep, voffA);
        if (wr == 1) PG8_BAR;
        PG8_WAIT_V(4); PG8_BAR;
        PG8_STAGE(PG8_SB(1, 0), cB + kstep, voffB); PG8_STAGE(PG8_SA(1, 0), cA + kstep, voffA); PG8_STAGE(PG8_SB(1, 1), cB + hstep + kstep, voffB);
        PG8_WAIT_V(6); PG8_BAR;
    }
    for (;;) {
        const bool has_next = S.next(ui + 1, nxt);
        const char* nA = has_next ? (const char*)g.A + (size_t)nxt.pm * tstep : cA; const char* nB = has_next ? (const char*)g.Bt + (size_t)(nxt.pm >> 5) * g.bstride + (size_t)nxt.pn * tstep : cB;
        for (int t = 0; t < nt; t += 2) {
            const bool last = (t == nt - 2);
            const char* a1 = cA + (size_t)(t + 1) * kstep;
            const char* a2 = last ? nA : cA + (size_t)(t + 2) * kstep; const char* b2 = last ? nB : cB + (size_t)(t + 2) * kstep;
            const char* a3 = a2 + kstep; const char* b3 = b2 + kstep;
            if (last && has_next) S.a_ready(nxt);
            if constexpr (SP2) {
            PG8_LDB(B0, 0, 0); PG8_LDB(B1, 0, 1); PG8_SCHED; PG8_LDA(At, 0, 0); PG8_STAGE(PG8_SA(1, 1), a1 + hstep, voffA);
            PG8_WAIT_V(8); PG8_WAIT_L(0); PG8_BAR; PG8_MMA(0, 0, At, B0); PG8_MMA(0, 1, At, B1); PG8_BAR; PG8_SCHED;
            PG8_LDA(At, 0, 1); PG8_STAGE(PG8_SB(0, 0), b2, voffB); PG8_STAGE(PG8_SB(0, 1), b2 + hstep, voffB); PG8_STAGE(PG8_SA(0, 0), a2, voffA);
            PG8_WAIT_V(8); PG8_WAIT_L(0); PG8_BAR; PG8_MMA(1, 0, At, B0); PG8_MMA(1, 1, At, B1); PG8_BAR; PG8_SCHED;
            PG8_LDB(B0, 1, 0); PG8_LDB(B1, 1, 1); PG8_SCHED; PG8_LDA(At, 1, 0); PG8_STAGE(PG8_SA(0, 1), a2 + hstep, voffA);
            PG8_WAIT_V(8); PG8_WAIT_L(0); PG8_BAR; PG8_MMA(0, 0, At, B0); PG8_MMA(0, 1, At, B1); PG8_BAR; PG8_SCHED;
            PG8_LDA(At, 1, 1); PG8_STAGE(PG8_SB(1, 0), b3, voffB); PG8_STAGE(PG8_SB(1, 1), b3 + hstep, voffB); PG8_STAGE(PG8_SA(1, 0), a3, voffA);
            PG8_WAIT_V(8); PG8_WAIT_L(0); PG8_BAR; PG8_MMA(1, 0, At, B0); PG8_MMA(1, 1, At, B1); PG8_BAR; PG8_SCHED;
            } else {
            PG8_LDB(B0, 0, 0); PG8_SCHED; PG8_LDA(At, 0, 0); PG8_STAGE(PG8_SA(1, 1), a1 + hstep, voffA);
            PG8_WAIT_L(8); PG8_BAR; PG8_WAIT_L(0); PG8_MMA(0, 0, At, B0); PG8_BAR; PG8_SCHED;
            PG8_LDB(B1, 0, 1); PG8_STAGE(PG8_SB(0, 0), b2, voffB);
            PG8_BAR; PG8_WAIT_L(0); PG8_MMA(0, 1, At, B1); PG8_BAR;
            PG8_LDA(At, 0, 1); PG8_STAGE(PG8_SA(0, 0), a2, voffA);
            PG8_BAR; PG8_WAIT_L(0); PG8_MMA(1, 0, At, B0); PG8_BAR; PG8_SCHED;
            PG8_STAGE(PG8_SB(0, 1), b2 + hstep, voffB);
            PG8_WAIT_V(6); PG8_BAR; PG8_MMA(1, 1, At, B1); PG8_BAR;
            PG8_LDB(B0, 1, 0); PG8_SCHED; PG8_LDA(At, 1, 0); PG8_STAGE(PG8_SA(0, 1), a2 + hstep, voffA);
            PG8_WAIT_L(8); PG8_BAR; PG8_WAIT_L(0); PG8_MMA(0, 0, At, B0); PG8_BAR; PG8_SCHED;
            PG8_LDB(B1, 1, 1); PG8_STAGE(PG8_SB(1, 0), b3, voffB);
            PG8_BAR; PG8_WAIT_L(0); PG8_MMA(0, 1, At, B1); PG8_BAR;
            PG8_LDA(At, 1, 1); PG8_STAGE(PG8_SA(1, 0), a3, voffA);
            PG8_BAR; PG8_WAIT_L(0); PG8_MMA(1, 0, At, B0); PG8_BAR; PG8_SCHED;
            PG8_STAGE(PG8_SB(1, 1), b3 + hstep, voffB);
            PG8_WAIT_V(6); PG8_BAR; PG8_MMA(1, 1, At, B1); PG8_BAR;
            }
        }
        if constexpr (ALIGN_EPI) { if (wr == 0) PG8_BAR; }
        if constexpr (!Epi::AFTER_DRAIN) { E(acc, cur, wr, wc, fr, fq); S.done(cur); }
        if (!has_next) break;
#pragma unroll
        for (int a = 0; a < 2; ++a)
#pragma unroll
            for (int b = 0; b < 2; ++b)
#pragma unroll
                for (int m = 0; m < 4; ++m)
#pragma unroll
                    for (int n = 0; n < 2; ++n) acc[a][b][m][n] = (f32x4){0.f, 0.f, 0.f, 0.f};
        cur = nxt; cA = nA; cB = nB; ++ui;
        if constexpr (ALIGN_EPI) { if (wr == 1) PG8_BAR; }
    }
    PG8_WAIT_V(0);
    if constexpr (!ALIGN_EPI) { if (wr == 0) PG8_BAR; }
    PG8_BAR;
    if constexpr (Epi::AFTER_DRAIN) { E.fused(acc, cur, wr, wc, fr, fq, lds, wid, lane); S.done(cur); }
#undef PG8_SA
#undef PG8_SB
#undef PG8_STAGE
#undef PG8_LDA
#undef PG8_LDB
#undef PG8_MMA
#undef PG8_WAIT_V
#undef PG8_WAIT_L
#undef PG8_BAR
#undef PG8_SCHED
}
}
constexpr int NB = 4, SEQ = 8192, D = 1024, M = NB * SEQ;
constexpr int NZ0 = 3584, NZ1 = 3072, NQ = 2048, SRC_IN0 = 3592;
constexpr float EPS = 1e-6f;
constexpr int NWAVES = 8, NTHR = 512;
constexpr float LOG2E = 1.4426950408889634f;
constexpr size_t MiB = 1u << 20;
constexpr size_t WS_CTL = 0, CTL_ZERO_BYTES = 1 * MiB;
constexpr size_t WS_WIN0 = 1 * MiB, WS_WOUT0 = 8 * MiB, WS_WIN1 = 10 * MiB, WS_WOUT1 = 16 * MiB, WS_WQ = 18 * MiB;
constexpr size_t WS_KEYS = 26 * MiB, WS_MOD = WS_KEYS + 128 * 1024, WS_KMEAN = WS_MOD + 192 * 1024, WS_NLOC = WS_KMEAN + 256 * 1024,
                 WS_BEND = WS_NLOC + 512 * 1024, WS_MLOC = WS_BEND + 4096, WS_MPREV = WS_MLOC + 4096,
                 WS_ISU = 27 * MiB + 512 * 1024, WS_ISV = WS_ISU + 128 * 1024, WS_ORD = WS_ISV + 128 * 1024  ,
                 WS_QB = WS_ORD + 8 * 1024  , WS_GTAB = WS_QB + 64 * 1024  ;
constexpr size_t WS_GATES = 28 * MiB;
constexpr size_t WS_UB = 32 * MiB  , WS_VB = 64 * MiB, WS_ACT = 96 * MiB  , WS_ACTS = 100 * MiB  , WS_WQF = 112 * MiB  , WS_XNY = 160 * MiB, WS_Z = 224 * MiB, WS_CLOC = 448 * MiB, WS_END = 512 * MiB;
constexpr size_t WS_QRY = WS_Z, WS_IDX = WS_Z + 128 * MiB, WS_GATE = WS_Z + 144 * MiB, WS_PART = WS_Z  , WS_XS = 448 * MiB  ;
constexpr size_t WS_RSS = 104 * MiB;
constexpr int CW_BAR = 4096, CW_QMOBA = 8192  , CW_QDIFF = 8448, CW_QCVT0 = 8704, CW_QCVT1 = 8768, CW_SCANF = 8832  , CW_QMLC = 9216  ;
constexpr float ALIBI_MARGIN = 27.03f;
constexpr int RING_BYTES = 139264;
constexpr int LDSCTL_OFF = RING_BYTES, MISC_OFF = LDSCTL_OFF + 320;
constexpr int LDS_BYTES = 147456;
static_assert(MISC_OFF + 128 <= LDS_BYTES, "LDS map");

#define GAS __attribute__((address_space(1)))
#define LAS __attribute__((address_space(3)))
typedef unsigned short bf16;
typedef unsigned v4u __attribute__((ext_vector_type(4)));
typedef unsigned v2u __attribute__((ext_vector_type(2)));
typedef float f32x4 __attribute__((ext_vector_type(4)));
typedef float f32x16 __attribute__((ext_vector_type(16)));
typedef short bf16x8 __attribute__((ext_vector_type(8)));
typedef short s16x4 __attribute__((ext_vector_type(4)));
typedef GAS unsigned gu32;
#define RLX_AGENT __ATOMIC_RELAXED, __HIP_MEMORY_SCOPE_AGENT
#define LDS_WAIT() asm volatile("s_waitcnt lgkmcnt(0)" ::: "memory")
#define VM_WAIT() asm volatile("s_waitcnt vmcnt(0)" ::: "memory")
__device__ __forceinline__ unsigned f2bf(float f) { unsigned u = __builtin_bit_cast(unsigned, f); return (u + 0x7fffu + ((u >> 16) & 1u)) >> 16; }
__device__ __forceinline__ unsigned pk2(float lo, float hi) { return f2bf(lo) | (f2bf(hi) << 16); }
__device__ __forceinline__ float bflo(unsigned w) { return __builtin_bit_cast(float, w << 16); }
__device__ __forceinline__ float bfhi(unsigned w) { return __builtin_bit_cast(float, w & 0xffff0000u); }
__device__ __forceinline__ float bf2f(bf16 h) { return __builtin_bit_cast(float, (unsigned)h << 16); }
__device__ __forceinline__ unsigned f2u(float x) { return __builtin_bit_cast(unsigned, x); }
__device__ __forceinline__ float u2f(unsigned x) { return __builtin_bit_cast(float, x); }
__device__ __forceinline__ float dot2bf(unsigned a, unsigned b, float acc) { typedef __bf16 bf2_ __attribute__((ext_vector_type(2))); return __builtin_amdgcn_fdot2_f32_bf16(__builtin_bit_cast(bf2_, a), __builtin_bit_cast(bf2_, b), acc, false); }
__device__ __forceinline__ float wave_sum(float v) {
#pragma unroll
    for (int o = 1; o < 64; o <<= 1) v += __shfl_xor(v, o);
    return v;
}
__device__ __forceinline__ float wave_max(float v) {
#pragma unroll
    for (int o = 1; o < 64; o <<= 1) v = fmaxf(v, __shfl_xor(v, o));
    return v;
}
__device__ __forceinline__ float silu_f(float x) { return x / (1.f + __expf(-x)); }
__device__ __forceinline__ float sigmoid_f(float x) { return 1.f / (1.f + __expf(-x)); }
__device__ __forceinline__ float logsigmoid_f(float x) { return fminf(x, 0.f) - log1pf(__expf(-fabsf(x))); }
struct Args { const float* in[24]; float* out; unsigned char* ws; int ph_lo, ph_hi; };
#define XB_TMO      128
#define XB_XCNT(j)  (256  + 64 * (j))
#define XB_XSUB(j)  (1280 + 64 * (j))
#define XB_XGEN(j)  (2304 + 64 * (j))
#define XB_TOP      3328
#define XB_TOPGEN   3392
#define XCD_BAR_WORDS 3456
#define XB_SPIN_CAP (1u << 18)

__device__ __forceinline__ unsigned xb_ld(unsigned* p)              { return __hip_atomic_load(p, __ATOMIC_RELAXED, __HIP_MEMORY_SCOPE_AGENT); }
__device__ __forceinline__ unsigned xb_add(unsigned* p, unsigned v) { return __hip_atomic_fetch_add(p, v, __ATOMIC_RELAXED, __HIP_MEMORY_SCOPE_AGENT); }
__device__ __forceinline__ unsigned xb_xcc_id() { return (unsigned)__builtin_amdgcn_s_getreg((3 << 11) | 20) & 0xFu; }
#define XB_SPIN(cond, bar) do { unsigned _sp = 0; while (cond) { __builtin_amdgcn_s_sleep(1); \
    if ((++_sp & 255u) == 0u) { if (xb_ld(&(bar)[XB_TMO])) break; if (_sp > XB_SPIN_CAP) { atomicAdd(&(bar)[XB_TMO], 1u); break; } } } } while (0)

struct XcdBarrier {
    unsigned* bar; unsigned x;
    volatile LAS unsigned* st;
};

__device__ __forceinline__ XcdBarrier xcd_barrier_post(unsigned* bar, volatile LAS unsigned* st) {
    XcdBarrier b; b.bar = bar; b.x = xb_xcc_id(); b.st = st;
    if (threadIdx.x == 0) (void)xb_add(&bar[XB_XCNT(b.x)], 1u);
    return b;
}
__device__ __forceinline__ void xcd_barrier_complete(unsigned* bar, unsigned x, unsigned& nloc, unsigned& nx) {
    const unsigned G = gridDim.x * gridDim.y * gridDim.z;
    unsigned sum, cnt, mine, sp = 0u;
    for (;;) {
        sum = 0u; cnt = 0u; mine = 0u;
#pragma unroll
        for (unsigned j = 0; j < 16; ++j) { const unsigned c = xb_ld(&bar[XB_XCNT(j)]); sum += c; cnt += (c > 0u) ? 1u : 0u; mine = (j == x) ? c : mine; }
        if (sum == G) break;
        __builtin_amdgcn_s_sleep(1);
        if ((++sp & 255u) == 0u) { if (xb_ld(&bar[XB_TMO])) break; if (sp > XB_SPIN_CAP) { atomicAdd(&bar[XB_TMO], 1u); break; } }
    }
    nloc = mine > 0u ? mine : 1u; nx = cnt > 0u ? cnt : 1u;
}

__device__ __forceinline__ void xcd_barrier(const XcdBarrier& b) {
    asm volatile("s_waitcnt vmcnt(0)" ::: "memory");
    __syncthreads();
    if (threadIdx.x == 0) {
        unsigned* bar = b.bar;
        __builtin_amdgcn_s_waitcnt(0);
        unsigned nloc = b.st[0], nx = b.st[1];
        if (nloc == 0u) { xcd_barrier_complete(bar, b.x, nloc, nx); b.st[0] = nloc; b.st[1] = nx; }
        const unsigned old = xb_add(&bar[XB_XSUB(b.x)], 1u);
        const unsigned gen = old / nloc;
        if (old + 1u == (gen + 1u) * nloc) {
            __builtin_amdgcn_fence(__ATOMIC_RELEASE, "agent");
            asm volatile("s_waitcnt vmcnt(0)" ::: "memory");
            const unsigned og = xb_add(&bar[XB_TOP], 1u);
            const unsigned tg = og / nx;
            if (og + 1u == (tg + 1u) * nx) xb_add(&bar[XB_TOPGEN], 1u);
            else XB_SPIN(xb_ld(&bar[XB_TOPGEN]) == tg, bar);
            __builtin_amdgcn_fence(__ATOMIC_ACQUIRE, "agent");
            xb_add(&bar[XB_XGEN(b.x)], 1u);
            asm volatile("s_waitcnt vmcnt(0)" ::: "memory");
        } else {
            XB_SPIN(xb_ld(&bar[XB_XGEN(b.x)]) == gen, bar);
            __builtin_amdgcn_fence(__ATOMIC_ACQUIRE, "agent");
            asm volatile("s_waitcnt vmcnt(0)" ::: "memory");
        }
    }
    __syncthreads();
}
struct Frame {
    LAS unsigned char* lds;
    int wave, G, bid;
    float* out; unsigned char* ws;
};
#define WSP(T, off) ((T*)(F.ws + (off)))

__device__ __forceinline__ void p0_transpose_item(const float* W, int K, int ldw, int nblk, int thr, int shift, bf16* WT, LAS float* scr, int item, int lane) {
    const int kb = item / nblk, nb = item % nblk, k0 = 64 * kb, n0 = 32 * nb, ns = n0 + (n0 >= thr ? shift : 0);
#pragma unroll 8
    for (int i = 0; i < 32; ++i) { const int kk = 2 * i + (lane >> 5); scr[kk * 33 + (lane & 31)] = W[(size_t)(k0 + kk) * ldw + ns + (lane & 31)]; }
    LDS_WAIT(); asm volatile("" ::: "memory");
    const int c = lane & 7;
#pragma unroll
    for (int j = 0; j < 4; ++j) { const int n = (lane >> 3) + 8 * j; const LAS float* s = scr + (8 * c) * 33 + n;
        v4u o; o.x = pk2(s[0 * 33], s[1 * 33]); o.y = pk2(s[2 * 33], s[3 * 33]); o.z = pk2(s[4 * 33], s[5 * 33]); o.w = pk2(s[6 * 33], s[7 * 33]);
        *(GAS v4u*)(WT + (size_t)(n0 + n) * K + k0 + 8 * c) = o; }
    LDS_WAIT(); asm volatile("" ::: "memory");
}
__device__ __forceinline__ void cvt_f32_bf16_stream(const float* src, bf16* dst, size_t n8, size_t gtid, size_t gthreads) {
    for (size_t i = gtid; i < n8; i += gthreads) {
        const f32x4 a = *(const GAS f32x4*)(src + i * 8), b = *(const GAS f32x4*)(src + i * 8 + 4);
        v4u o; o.x = pk2(a.x, a.y); o.y = pk2(a.z, a.w); o.z = pk2(b.x, b.y); o.w = pk2(b.z, b.w);
        *(GAS v4u*)(dst + i * 8) = o; }
}
__device__ __forceinline__ void i8_row(const float* src_row, unsigned char* dst  , float* scale  , int er, int lane) {
    const float* r = src_row + 16 * lane;
    float x[16];
#pragma unroll
    for (int q4 = 0; q4 < 4; ++q4) { const f32x4 a = *(const GAS f32x4*)(r + 4 * q4); x[4 * q4] = a.x; x[4 * q4 + 1] = a.y; x[4 * q4 + 2] = a.z; x[4 * q4 + 3] = a.w; }
    float am = 0.f;
#pragma unroll
    for (int i = 0; i < 16; ++i) am = fmaxf(am, fabsf(x[i]));
    am = wave_max(am);
    const float inv = am > 1e-30f ? 127.f / am : 0.f;
    unsigned wd[4];
#pragma unroll
    for (int q4 = 0; q4 < 4; ++q4) { unsigned w = 0;
#pragma unroll
        for (int e = 0; e < 4; ++e) { const int qv = (int)rintf(x[4 * q4 + e] * inv); w |= ((unsigned)qv & 0xffu) << (8 * e); }
        wd[q4] = w; }
    v4u o; o.x = wd[0]; o.y = wd[1]; o.z = wd[2]; o.w = wd[3];
    *(GAS v4u*)(dst + ((size_t)((lane >> 3) * 16384 + er)) * 128 + 16 * (lane & 7)) = o;
    if (lane == 0) scale[er] = am * (1.f / 127.f);
}
__device__ __forceinline__ void i8_chunk(Frame& F, const Args& A, int layer, int c) {
    const int tbl = c >> 8, row0 = (c & 255) * 64 + F.wave * 8;
    const float* src = A.in[22 + tbl] + (size_t)layer * 16384 * 1024;
    unsigned char* dst = F.ws + (tbl ? WS_VB : WS_UB) + (size_t)layer * 8 * 16384 * 128;
    float* sc = WSP(float, tbl ? WS_ISV : WS_ISU) + layer * 16384;
    for (int i = 0; i < 8; ++i) i8_row(src + (size_t)(row0 + i) * 1024, dst, sc, row0 + i, ((int)(threadIdx.x & 63u)));
}
__device__ __forceinline__ void p0_prologue(Frame& F, const Args& A) {
    {
        const float* c = A.in[1]; const float* aw = A.in[2]; const float* ab = A.in[3]; float* MOD = WSP(float, WS_MOD);
        LAS float* red = (LAS float*)F.lds;
        for (int item = F.bid; item < 192; item += F.G) {
            const int l = item / 96, n0 = (item % 96) * 64;
            float acc[4] = {0.f, 0.f, 0.f, 0.f};
            const int kbeg = F.wave * 128;
#pragma unroll 4
            for (int k = kbeg; k < kbeg + 128; ++k) {
                const float wv = aw[((size_t)l * 1024 + k) * 6144 + n0 + ((int)(threadIdx.x & 63u))];
#pragma unroll
                for (int b = 0; b < 4; ++b) acc[b] += silu_f(c[b * 1024 + k]) * wv;
            }
#pragma unroll
            for (int b = 0; b < 4; ++b) red[(F.wave * 4 + b) * 64 + ((int)(threadIdx.x & 63u))] = acc[b];
            __syncthreads();
            if (((int)threadIdx.x) < 256) { const int b = ((int)threadIdx.x) >> 6, ln = ((int)threadIdx.x) & 63; float s = ab[l * 6144 + n0 + ln];
#pragma unroll
                for (int w = 0; w < 8; ++w) s += red[(w * 4 + b) * 64 + ln];
                MOD[(size_t)(l * 4 + b) * 6144 + n0 + ln] = s; }
            __syncthreads();
        }
    }
    if (F.bid == 0) {
        LAS unsigned* hist = (LAS unsigned*)F.lds;
        unsigned short* ORD = WSP(unsigned short, WS_ORD);
        const int tid = (int)threadIdx.x;
        for (int pass = 0; pass < 2; ++pass) {
            const int nq = pass == 0 ? 64 : 32, nper = 4 * nq;
            for (int x = 0; x < 8; ++x) {
                if (tid < 160) hist[tid] = 0u;
                __syncthreads();
                int cost = 0, u = 0;
                if (tid < nper) {
                    const int hs = tid / nq, q = tid % nq, h = (x >> 2) ? (hs == 0 ? 6 : hs == 1 ? 5 : hs == 2 ? 1 : 0) : (hs == 0 ? 7 : hs == 1 ? 4 : hs == 2 ? 3 : 2), b = x & 3;
                    const float dcut = 46.f * (float)(2 << h);
                    if (pass == 0) { const int nt = 2 * q + 2; int lo = (int)ceilf(((float)(q * 128) - dcut - 63.f) * (1.f / 64.f)); if (lo < 0) lo = 0; cost = nt - lo; u = (b << 9) | (h << 6) | q; }
                    else { int lo = (int)ceilf(((float)(q * 256) - dcut - 255.f) * (1.f / 256.f)); if (lo < 0) lo = 0; int nb = q - lo; if (nb > 24) nb = 24; cost = 4 * (nb + 1); u = (b << 8) | (h << 5) | q; }
                    if (cost > 159) cost = 159;
                    atomicAdd((unsigned*)(hist + (159 - cost)), 1u);
                }
                __syncthreads();
                if (tid == 0) { unsigned acc = 0; for (int i = 0; i < 160; ++i) { const unsigned c = hist[i]; hist[i] = acc; acc += c; } }
                __syncthreads();
                if (tid < nper) { const unsigned pos = atomicAdd((unsigned*)(hist + (159 - cost)), 1u); ORD[(pass == 0 ? 0 : 2048) + x * nper + pos] = (unsigned short)u; }
                __syncthreads();
            }
        }
    }
    {
        LAS float* scr = (LAS float*)(F.lds + F.wave * 8704);
        const int gw = F.bid * NWAVES + F.wave, NGW = F.G * NWAVES;
        constexpr int I_IN0 = 16 * (NZ0 / 32), I_OUT = 16 * 32, I_IN1 = 16 * (NZ1 / 32), I_Q = 16 * (NQ / 32);
        constexpr int NITEMS = I_IN0 + 2 * I_OUT + I_IN1 + 2 * I_Q;
        for (int it = gw; it < NITEMS; it += NGW) {
            int r = it;
            if (r < I_IN0) { p0_transpose_item(A.in[6], D, SRC_IN0, NZ0 / 32, 2048, 8, WSP(bf16, WS_WIN0), scr, r, ((int)(threadIdx.x & 63u))); continue; } r -= I_IN0;
            if (r < I_OUT) { p0_transpose_item(A.in[13], D, D, 32, 1 << 30, 0, WSP(bf16, WS_WOUT0), scr, r, ((int)(threadIdx.x & 63u))); continue; } r -= I_OUT;
            if (r < I_IN1) { p0_transpose_item(A.in[14], D, NZ1, NZ1 / 32, 1 << 30, 0, WSP(bf16, WS_WIN1), scr, r, ((int)(threadIdx.x & 63u))); continue; } r -= I_IN1;
            if (r < I_OUT) { p0_transpose_item(A.in[19], D, D, 32, 1 << 30, 0, WSP(bf16, WS_WOUT1), scr, r, ((int)(threadIdx.x & 63u))); continue; } r -= I_OUT;
            if (r < I_Q) { p0_transpose_item(A.in[20], D, NQ, NQ / 32, 1 << 30, 0, WSP(bf16, WS_WQ), scr, r, ((int)(threadIdx.x & 63u))); continue; } r -= I_Q;
            p0_transpose_item(A.in[20] + (size_t)D * NQ, D, NQ, NQ / 32, 1 << 30, 0, WSP(bf16, WS_WQ) + (size_t)NQ * D, scr, r, ((int)(threadIdx.x & 63u)));
        }
    }
    {
        const size_t gtid = (size_t)F.bid * NTHR + ((int)threadIdx.x), gth = (size_t)F.G * NTHR;
        cvt_f32_bf16_stream(A.in[21], WSP(bf16, WS_KEYS), (size_t)2 * 2 * 128 * 128 / 8, gtid, gth);
    }
}

template <bool GATES, bool IN_BF16>
__device__ __forceinline__ void norm_pass(Frame& F, const Args& A, const void* X, const float* g, const float* mod, int shc, bf16* XN) {
    LAS float* wgT = (LAS float*)F.lds;
    if (GATES) {
        const float* win = A.in[6];
        for (int i = ((int)threadIdx.x); i < 8 * 1024; i += NTHR) { const int cg = i >> 10, k = i & 1023; wgT[i] = win[(size_t)k * SRC_IN0 + 2048 + cg]; }
        __syncthreads();
    }
    const int gw = F.bid * NWAVES + F.wave, NGW = F.G * NWAVES;
    for (int row = gw; row < M; row += NGW) {
        const int b = row >> 13;
        f32x4 v[4]; float ss = 0.f;
        if (IN_BF16) { const GAS v2u* xr = (const GAS v2u*)((const bf16*)X + (size_t)row * D) + ((int)(threadIdx.x & 63u));
#pragma unroll
            for (int j = 0; j < 4; ++j) { const v2u w = xr[64 * j]; const unsigned w0 = w.x, w1 = w.y; v[j] = (f32x4){bflo(w0), bfhi(w0), bflo(w1), bfhi(w1)}; }
        } else { const GAS f32x4* xr = (const GAS f32x4*)((const float*)X + (size_t)row * D) + ((int)(threadIdx.x & 63u));
#pragma unroll
            for (int j = 0; j < 4; ++j) v[j] = xr[64 * j]; }
#pragma unroll
        for (int j = 0; j < 4; ++j) ss += (v[j].x * v[j].x + v[j].y * v[j].y) + (v[j].z * v[j].z + v[j].w * v[j].w);
        const float rstd = rsqrtf(wave_sum(ss) * (1.f / D) + EPS);
        const float* shp = mod + (size_t)b * 6144 + shc * 1024; const float* scp = shp + 1024;
#pragma unroll
        for (int j = 0; j < 4; ++j) { const int c = 4 * ((int)(threadIdx.x & 63u)) + 256 * j;
            const f32x4 gg = *(const f32x4*)(g + c), sc = *(const f32x4*)(scp + c), sh = *(const f32x4*)(shp + c);
            v[j] = v[j] * rstd * gg * (sc + 1.f) + sh;
            v2u o; o.x = pk2(v[j].x, v[j].y); o.y = pk2(v[j].z, v[j].w);
            *(GAS v2u*)(XN + (size_t)row * D + c) = o; }
        if (GATES) {
            float* GT = WSP(float, WS_GATES);
#pragma unroll
            for (int cg = 0; cg < 8; ++cg) { float p = 0.f;
#pragma unroll
                for (int j = 0; j < 4; ++j) { const f32x4 w = *(const LAS f32x4*)(wgT + cg * 1024 + 4 * ((int)(threadIdx.x & 63u)) + 256 * j); p += (v[j].x * w.x + v[j].y * w.y) + (v[j].z * w.z + v[j].w * w.w); }
                p = wave_sum(p);
                if (((int)(threadIdx.x & 63u)) == 0) GT[(size_t)row * 8 + cg] = p + (cg < 4 ? A.in[8][cg] : A.in[9][cg - 4]); }
        }
    }
}

__device__ __forceinline__ void qknorm_unit(Frame& F, bf16* Z, int ldz, int row0, int col0, const float* g, float gmul, float* kmean  ) {
    const int c = col0 + 8 * ((int)(threadIdx.x & 63u)), d0 = (8 * ((int)(threadIdx.x & 63u))) & 63;
    float gv[8];
#pragma unroll
    for (int i = 0; i < 8; ++i) gv[i] = g[d0 + i] * gmul;
    float ks[8] = {0.f, 0.f, 0.f, 0.f, 0.f, 0.f, 0.f, 0.f};
    for (int r = 0; r < 32; ++r) {
        bf16* p = Z + (size_t)(row0 + F.wave * 32 + r) * ldz + c;
        const v4u w = *(const GAS v4u*)p;
        float x[8] = {bflo(w.x), bfhi(w.x), bflo(w.y), bfhi(w.y), bflo(w.z), bfhi(w.z), bflo(w.w), bfhi(w.w)};
        float ss = 0.f;
#pragma unroll
        for (int i = 0; i < 8; ++i) ss += x[i] * x[i];
        ss += __shfl_xor(ss, 1); ss += __shfl_xor(ss, 2); ss += __shfl_xor(ss, 4);
        const float rstd = rsqrtf(ss * (1.f / 64.f) + EPS);
#pragma unroll
        for (int i = 0; i < 8; ++i) { x[i] = x[i] * rstd * gv[i]; ks[i] += x[i]; }
        v4u o; o.x = pk2(x[0], x[1]); o.y = pk2(x[2], x[3]); o.z = pk2(x[4], x[5]); o.w = pk2(x[6], x[7]);
        *(GAS v4u*)p = o;
    }
    if (kmean) {
        LAS float* red = (LAS float*)F.lds;
#pragma unroll
        for (int i = 0; i < 8; ++i) red[F.wave * 512 + 8 * ((int)(threadIdx.x & 63u)) + i] = ks[i];
        __syncthreads();
        { float s = 0.f;
#pragma unroll
          for (int w = 0; w < 8; ++w) s += red[w * 512 + ((int)threadIdx.x)];
          kmean[(size_t)(((int)threadIdx.x) >> 6) * (32 * 64) + (((int)threadIdx.x) & 63)] = s * (1.f / 256.f); }
        __syncthreads();
    }
}

__device__ __forceinline__ void kmean_unit(Frame& F, const bf16* Z, int ldz, int row0, int col0, float* kmean) {
    const int c = col0 + 8 * ((int)(threadIdx.x & 63u));
    float ks[8] = {0.f, 0.f, 0.f, 0.f, 0.f, 0.f, 0.f, 0.f};
#pragma unroll 4
    for (int r = 0; r < 32; ++r) {
        const v4u w = *(const GAS v4u*)(Z + (size_t)(row0 + F.wave * 32 + r) * ldz + c);
        ks[0] += bflo(w.x); ks[1] += bfhi(w.x); ks[2] += bflo(w.y); ks[3] += bfhi(w.y); ks[4] += bflo(w.z); ks[5] += bfhi(w.z); ks[6] += bflo(w.w); ks[7] += bfhi(w.w);
    }
    LAS float* red = (LAS float*)F.lds;
#pragma unroll
    for (int i = 0; i < 8; ++i) red[F.wave * 512 + 8 * ((int)(threadIdx.x & 63u)) + i] = ks[i];
    __syncthreads();
    { float s = 0.f;
#pragma unroll
      for (int w = 0; w < 8; ++w) s += red[w * 512 + ((int)threadIdx.x)];
      kmean[(size_t)(((int)threadIdx.x) >> 6) * (32 * 64) + (((int)threadIdx.x) & 63)] = s * (1.f / 256.f); }
    __syncthreads();
}

constexpr int KSTRB = 144;
template <int DV> struct VStr { static constexpr int B = (DV == 64) ? 192 : 320; };
typedef short v4i16_t __attribute__((ext_vector_type(4)));
__device__ __forceinline__ s16x4 vtr(const LAS unsigned char* p) { return __builtin_bit_cast(s16x4, __builtin_amdgcn_ds_read_tr16_b64_v4i16((LAS v4i16_t*)p)); }
__device__ __forceinline__ unsigned cvtpk(float lo, float hi) { typedef float f2 __attribute__((ext_vector_type(2))); typedef __bf16 b2 __attribute__((ext_vector_type(2)));
    f2 v = {lo, hi}; b2 b = __builtin_convertvector(v, b2); return __builtin_bit_cast(unsigned, b); }
__device__ __forceinline__ float xhalf(float v) {
    auto rr = __builtin_amdgcn_permlane32_swap(__builtin_bit_cast(unsigned, v), __builtin_bit_cast(unsigned, v), false, false);
    const unsigned r0 = rr[0], r1 = rr[1]; return u2f((threadIdx.x & 32) ? r0 : r1);
}
template <int DV> struct AttnSt { f32x16 o[DV / 32]; float m, l; };
template <int DV> __device__ __forceinline__ void attn_init(AttnSt<DV>& st) {
#pragma unroll
    for (int t = 0; t < DV / 32; ++t)
#pragma unroll
        for (int r = 0; r < 16; ++r) st.o[t][r] = 0.f;
    st.m = -1e30f; st.l = 0.f;
}
template <int DV>
__device__ __forceinline__ void attn_qk(AttnSt<DV>& st, const LAS unsigned char* Kt, const bf16x8 (&qf)[4], float sl2, int tq, int kt0, bool diag, bool rowok, int lane, bf16x8 (&pf)[2][2]) {
    const int r32 = lane & 31, hi = lane >> 5;
    const int kb = kt0 + 4 * hi;
    const float ref = st.m > -1e29f ? st.m : 0.f;
    const float c0 = -sl2 * (float)(tq - kb) - ref;
    f32x16 s0, s1;
#pragma unroll
    for (int r = 0; r < 16; ++r) { const int ko = (r & 3) + 8 * (r >> 2); s0[r] = c0 + sl2 * (float)ko; s1[r] = c0 + sl2 * (float)(ko + 32); }
    const LAS unsigned char* kp = Kt + r32 * KSTRB + hi * 16;
#pragma unroll
    for (int ks = 0; ks < 4; ++ks) {
        const bf16x8 k0 = *(const LAS bf16x8*)(kp + ks * 32), k1 = *(const LAS bf16x8*)(kp + 32 * KSTRB + ks * 32);
        s0 = __builtin_amdgcn_mfma_f32_32x32x16_bf16(k0, qf[ks], s0, 0, 0, 0);
        s1 = __builtin_amdgcn_mfma_f32_32x32x16_bf16(k1, qf[ks], s1, 0, 0, 0);
    }
    if (diag || !rowok) {
#pragma unroll
        for (int r = 0; r < 16; ++r) { const int ko = (r & 3) + 8 * (r >> 2);
            if (!rowok || kb + ko > tq) s0[r] = -INFINITY;
            if (!rowok || kb + ko + 32 > tq) s1[r] = -INFINITY; }
    }
    float mx = fmaxf(s0[0], s1[0]);
#pragma unroll
    for (int r = 1; r < 16; ++r) mx = fmaxf(mx, fmaxf(s0[r], s1[r]));
    mx = fmaxf(mx, xhalf(mx));
    const float mnew = fmaxf(st.m, ref + mx);
    if (__any(mnew > st.m)) {
        const float alpha = __builtin_amdgcn_exp2f(st.m - mnew), dd = mnew - ref;
        st.m = mnew; st.l *= alpha;
#pragma unroll
        for (int t = 0; t < DV / 32; ++t)
#pragma unroll
            for (int r = 0; r < 16; ++r) st.o[t][r] *= alpha;
#pragma unroll
        for (int r = 0; r < 16; ++r) { s0[r] -= dd; s1[r] -= dd; }
    }
#pragma unroll
    for (int r = 0; r < 16; ++r) { s0[r] = __builtin_amdgcn_exp2f(s0[r]); s1[r] = __builtin_amdgcn_exp2f(s1[r]); }
#pragma unroll
    for (int s = 0; s < 2; ++s) {
        v4u a, b;
        a.x = cvtpk(s0[8 * s + 0], s0[8 * s + 1]); a.y = cvtpk(s0[8 * s + 2], s0[8 * s + 3]); a.z = cvtpk(s0[8 * s + 4], s0[8 * s + 5]); a.w = cvtpk(s0[8 * s + 6], s0[8 * s + 7]);
        b.x = cvtpk(s1[8 * s + 0], s1[8 * s + 1]); b.y = cvtpk(s1[8 * s + 2], s1[8 * s + 3]); b.z = cvtpk(s1[8 * s + 4], s1[8 * s + 5]); b.w = cvtpk(s1[8 * s + 6], s1[8 * s + 7]);
        pf[0][s] = __builtin_bit_cast(bf16x8, a); pf[1][s] = __builtin_bit_cast(bf16x8, b);
    }
}
template <int DV>
__device__ __forceinline__ void attn_pv(AttnSt<DV>& st, const LAS unsigned char* Vt, const bf16x8 (&pf)[2][2], int lane) {
    { const bf16x8 ones = {0x3F80, 0x3F80, 0x3F80, 0x3F80, 0x3F80, 0x3F80, 0x3F80, 0x3F80};
      f32x16 rs = __builtin_amdgcn_mfma_f32_32x32x16_bf16(ones, pf[0][0], (f32x16){0.f, 0.f, 0.f, 0.f, 0.f, 0.f, 0.f, 0.f, 0.f, 0.f, 0.f, 0.f, 0.f, 0.f, 0.f, 0.f}, 0, 0, 0);
      rs = __builtin_amdgcn_mfma_f32_32x32x16_bf16(ones, pf[0][1], rs, 0, 0, 0); rs = __builtin_amdgcn_mfma_f32_32x32x16_bf16(ones, pf[1][0], rs, 0, 0, 0); rs = __builtin_amdgcn_mfma_f32_32x32x16_bf16(ones, pf[1][1], rs, 0, 0, 0);
      st.l += rs[0]; }
    constexpr int VS = VStr<DV>::B;
    const int g = lane >> 4, i16 = lane & 15;
    const LAS unsigned char* vp = Vt + (4 * (g >> 1) + (i16 >> 2)) * VS + (16 * (g & 1) + 4 * (i16 & 3)) * 2;
#pragma unroll
    for (int kbk = 0; kbk < 2; ++kbk)
#pragma unroll
        for (int s = 0; s < 2; ++s)
#pragma unroll
            for (int t = 0; t < DV / 32; ++t) {
                const s16x4 lo = vtr(vp + (kbk * 32 + 16 * s) * VS + t * 64), h8 = vtr(vp + (kbk * 32 + 16 * s + 8) * VS + t * 64);
                const bf16x8 va = {lo[0], lo[1], lo[2], lo[3], h8[0], h8[1], h8[2], h8[3]};
                st.o[t] = __builtin_amdgcn_mfma_f32_32x32x16_bf16(va, pf[kbk][s], st.o[t], 0, 0, 0);
            }
}
template <int DV>
__device__ __forceinline__ void attn_tile(AttnSt<DV>& st, const LAS unsigned char* Kt, const LAS unsigned char* Vt, const bf16x8 (&qf)[4], float sc2, float sl2, int tq, int kt0, bool diag, bool rowok, int lane) {
    bf16x8 pf[2][2];
    attn_qk<DV>(st, Kt, qf, sl2, tq, kt0, diag, rowok, lane, pf);
    attn_pv<DV>(st, Vt, pf, lane);
}
template <int NK, int DV> struct TileRegs { v4u k[NK]; v4u v[DV / 64]; };
template <int NK, int DV>
__device__ __forceinline__ void tile_load(TileRegs<NK, DV>& R, const bf16* Z, int ldz, size_t zrow0, int kcol, int vcol, int tid) {
#pragma unroll
    for (int i = 0; i < NK; ++i) { const int ch = tid + 512 * i; const int row = ch / (8 * NK), cc = ch % (8 * NK);
        R.k[i] = *(const GAS v4u*)(Z + (zrow0 + row) * ldz + kcol + cc * 8); }
#pragma unroll
    for (int i = 0; i < DV / 64; ++i) { const int ch = tid + 512 * i; const int row = ch / (DV / 8), cc = ch % (DV / 8);
        R.v[i] = *(const GAS v4u*)(Z + (zrow0 + row) * ldz + vcol + cc * 8); }
}
template <int NK, int DV>
__device__ __forceinline__ void tile_store(const TileRegs<NK, DV>& R, LAS unsigned char* Kt  , LAS unsigned char* Vt, int tid) {
#pragma unroll
    for (int i = 0; i < NK; ++i) { const int ch = tid + 512 * i; const int row = ch / (8 * NK), cc = ch % (8 * NK);
        *(LAS v4u*)(Kt + (cc >> 3) * (64 * KSTRB) + row * KSTRB + (cc & 7) * 16) = R.k[i]; }
#pragma unroll
    for (int i = 0; i < DV / 64; ++i) { const int ch = tid + 512 * i; const int row = ch / (DV / 8), cc = ch % (DV / 8);
        *(LAS v4u*)(Vt + row * VStr<DV>::B + cc * 16) = R.v[i]; }
}
__device__ __forceinline__ void moba_unit(Frame& F, int b, int h, int j, float tcut  ) {
    const bf16* Z = WSP(bf16, WS_Z); constexpr int ldz = NZ0;
    const int lane = ((int)(threadIdx.x & 63u)), w = F.wave, r32 = lane & 31, hi = lane >> 5, tid = ((int)threadIdx.x);
    const size_t rowb = (size_t)b * SEQ;
    const int qpos = j * 256 + w * 32 + r32;
    const int qcol = 2048 + h * 64, kcol = 2560 + h * 64, vcol = 3072 + h * 64;
    LAS unsigned char* lds = F.lds;
    constexpr int BUFB = 64 * KSTRB + 64 * VStr<64>::B;
    LAS unsigned char* kmh = lds + 2 * BUFB;
    LAS unsigned char* kml = lds + 2 * BUFB + 32 * KSTRB;
    LAS unsigned* msk = (LAS unsigned*)(lds + 2 * BUFB + 64 * KSTRB);
    { const float* KM = WSP(float, WS_KMEAN) + (size_t)((b * 8 + h) * 32) * 64; const f32x4 x = *(const f32x4*)(KM + 4 * tid);
      const int n = tid >> 4, d0 = (tid & 15) * 4;
      const unsigned h0 = f2bf(x.x), h1 = f2bf(x.y), h2 = f2bf(x.z), h3 = f2bf(x.w);
      v2u hv; hv.x = h0 | (h1 << 16); hv.y = h2 | (h3 << 16);
      v2u lv; lv.x = pk2(x.x - u2f(h0 << 16), x.y - u2f(h1 << 16)); lv.y = pk2(x.z - u2f(h2 << 16), x.w - u2f(h3 << 16));
      *(LAS v2u*)(kmh + n * KSTRB + d0 * 2) = hv; *(LAS v2u*)(kml + n * KSTRB + d0 * 2) = lv; }
    if (tid < 16) msk[tid] = 0u;
    bf16x8 qf[4];
    const bf16* qrow = Z + (rowb + qpos) * ldz + qcol;
#pragma unroll
    for (int ks = 0; ks < 4; ++ks) qf[ks] = *(const GAS bf16x8*)(qrow + 16 * ks + 8 * hi);
    __syncthreads();
    f32x16 gt;
#pragma unroll
    for (int r = 0; r < 16; ++r) gt[r] = 0.f;
#pragma unroll
    for (int ks = 0; ks < 4; ++ks) {
        const bf16x8 a = *(const LAS bf16x8*)(kmh + r32 * KSTRB + hi * 16 + ks * 32), c = *(const LAS bf16x8*)(kml + r32 * KSTRB + hi * 16 + ks * 32);
        gt = __builtin_amdgcn_mfma_f32_32x32x16_bf16(a, qf[ks], gt, 0, 0, 0);
        gt = __builtin_amdgcn_mfma_f32_32x32x16_bf16(c, qf[ks], gt, 0, 0, 0);
    }
    float t0 = -INFINITY, t1 = -INFINITY, t2 = -INFINITY;
#define INS3(key) do { float k_ = (key); float a_ = fmaxf(t0, k_), l_ = fminf(t0, k_); t0 = a_; a_ = fmaxf(t1, l_); l_ = fminf(t1, l_); t1 = a_; t2 = fmaxf(t2, l_); } while (0)
#pragma unroll
    for (int r = 0; r < 16; ++r) { const int n = (r & 3) + 8 * (r >> 2) + 4 * hi;
        const float key = (n < j) ? u2f((f2u(gt[r]) & ~31u) | (unsigned)n) : -INFINITY; INS3(key); }
    { const float p0 = xhalf(t0), p1 = xhalf(t1), p2 = xhalf(t2); INS3(p0); INS3(p1); INS3(p2); }
#undef INS3
    const int sel0 = (t0 > -INFINITY) ? (int)(f2u(t0) & 31u) : -1;
    const int sel1 = (t1 > -INFINITY) ? (int)(f2u(t1) & 31u) : -1;
    const int sel2 = (t2 > -INFINITY) ? (int)(f2u(t2) & 31u) : -1;
    { const unsigned mm = (sel0 >= 0 ? 1u << sel0 : 0u) | (sel1 >= 0 ? 1u << sel1 : 0u) | (sel2 >= 0 ? 1u << sel2 : 0u);
      if (mm) { __hip_atomic_fetch_or(msk + w, mm, __ATOMIC_RELAXED, __HIP_MEMORY_SCOPE_WORKGROUP); __hip_atomic_fetch_or(msk + 8, mm, __ATOMIC_RELAXED, __HIP_MEMORY_SCOPE_WORKGROUP); } }
    __syncthreads();
    const float slope = ldexpf(1.f, -(h + 1)), dcut = tcut / slope;
    const float sl2 = slope * LOG2E, sc2 = 0.125f * LOG2E;
    int nlo = (int)ceilf(((float)(j * 256) - dcut - 255.f) * (1.f / 256.f)); if (nlo < 0) nlo = 0;
    const unsigned keep = nlo >= 32 ? 0u : (0xffffffffu << nlo);
    const unsigned bmask = msk[8] & keep; const unsigned wmask = (unsigned)__builtin_amdgcn_readfirstlane((int)msk[w]) & keep;
    AttnSt<64> st; attn_init<64>(st);
    unsigned rem = bmask;
    int blk = j, kt = 3, buf = 0;
    TileRegs<1, 64> R;
    tile_load<1, 64>(R, Z, ldz, rowb + blk * 256 + kt * 64, kcol, vcol, tid);
    tile_store<1, 64>(R, lds, lds + 64 * KSTRB, tid);
    __syncthreads();
    for (;;) {
        int nblk = blk, nkt = kt - 1; bool has_next = true;
        if (nkt < 0) { nkt = 3; if (rem) { nblk = 31 - __builtin_clz(rem); rem &= ~(1u << nblk); } else has_next = false; }
        if (has_next) tile_load<1, 64>(R, Z, ldz, rowb + nblk * 256 + nkt * 64, kcol, vcol, tid);
        const bool own = (blk == j);
        const bool active = (own ? (kt * 64 <= w * 32 + 31) : (((wmask >> blk) & 1u) != 0u)) && ((float)(j * 256 + w * 32 - (blk * 256 + kt * 64 + 63)) <= dcut);
        if (active) {
            const bool rowok = own || blk == sel0 || blk == sel1 || blk == sel2;
            const bool diag = own && (kt * 64 + 63 > w * 32);
            attn_tile<64>(st, lds + buf * BUFB, lds + buf * BUFB + 64 * KSTRB, qf, sc2, sl2, qpos, blk * 256 + kt * 64, diag, rowok, lane);
        }
        if (!has_next) break;
        tile_store<1, 64>(R, lds + (buf ^ 1) * BUFB, lds + (buf ^ 1) * BUFB + 64 * KSTRB, tid);
        __syncthreads();
        buf ^= 1; blk = nblk; kt = nkt;
    }
    const float inv = 1.f / st.l;
    bf16* Y = WSP(bf16, WS_XNY) + (rowb + qpos) * 1024 + 512 + h * 64;
#pragma unroll
    for (int t = 0; t < 2; ++t)
#pragma unroll
        for (int rg = 0; rg < 4; ++rg) { v2u o; o.x = pk2(st.o[t][4 * rg] * inv, st.o[t][4 * rg + 1] * inv); o.y = pk2(st.o[t][4 * rg + 2] * inv, st.o[t][4 * rg + 3] * inv);
            *(GAS v2u*)(Y + t * 32 + 8 * rg + 4 * hi) = o; }
    __syncthreads();
}

__device__ __forceinline__ void diff_unit(Frame& F, const Args& A, int b, int h, int qt, float lam, float tcut, const int probe) {
    (void)probe;
    const bf16* Z = WSP(bf16, WS_Z); constexpr int ldz = NZ1;
    const int lane = ((int)(threadIdx.x & 63u)), w = F.wave, r32 = lane & 31, hi = lane >> 5, tid = ((int)threadIdx.x);
    const int comp = w >> 2, wq = w & 3;
    const size_t rowb = (size_t)b * SEQ;
    const int q0 = qt * 128, qpos = q0 + wq * 32 + r32;
    const int qcol = h * 128 + comp * 64, kcol = 1024 + h * 128, vcol = 2048 + h * 128;
    LAS unsigned char* lds = F.lds;
    constexpr int BUFB = 2 * 64 * KSTRB + 64 * VStr<128>::B;
    bf16x8 qf[4];
    const bf16* qrow = Z + (rowb + qpos) * ldz + qcol;
#pragma unroll
    for (int ks = 0; ks < 4; ++ks) qf[ks] = *(const GAS bf16x8*)(qrow + 16 * ks + 8 * hi);
    const float slope = ldexpf(1.f, -(h + 1)), dcut = tcut / slope;
    const float sl2 = slope * LOG2E, sc2 = 0.125f * LOG2E;
    AttnSt<128> st; attn_init<128>(st);
    const int nt = (q0 + 128) / 64;
    int kt_lo = (int)ceilf(((float)q0 - dcut - 63.f) * (1.f / 64.f)); if (kt_lo < 0) kt_lo = 0;
    TileRegs<2, 128> R;
    tile_load<2, 128>(R, Z, ldz, rowb + (size_t)(nt - 1) * 64, kcol, vcol, tid);
    tile_store<2, 128>(R, lds, lds + 2 * 64 * KSTRB, tid);
    __syncthreads();
    int buf = 0;
    for (int kt = nt - 1; kt >= kt_lo; --kt) {
        const bool has_next = kt > kt_lo;
        if (has_next) tile_load<2, 128>(R, Z, ldz, rowb + (size_t)(kt - 1) * 64, kcol, vcol, tid);
        if (kt * 64 <= q0 + wq * 32 + 31) {
            const bool diag = kt * 64 + 63 > q0 + wq * 32;
            attn_tile<128>(st, lds + buf * BUFB + comp * (64 * KSTRB), lds + buf * BUFB + 2 * 64 * KSTRB, qf, sc2, sl2, qpos, kt * 64, diag, true, lane);
        }
        if (has_next) { tile_store<2, 128>(R, lds + (buf ^ 1) * BUFB, lds + (buf ^ 1) * BUFB + 2 * 64 * KSTRB, tid); }
        __syncthreads();
        buf ^= 1;
    }
    const float inv = 1.f / st.l;
    LAS float* o2 = (LAS float*)lds;
    if (comp == 1) {
#pragma unroll
        for (int t = 0; t < 4; ++t)
#pragma unroll
            for (int r = 0; r < 16; ++r) o2[((wq * 4 + t) * 16 + r) * 64 + lane] = st.o[t][r] * inv;
    }
    __syncthreads();
    if (comp == 0) {
        float ss = 0.f;
#pragma unroll
        for (int t = 0; t < 4; ++t)
#pragma unroll
            for (int r = 0; r < 16; ++r) { const float v = st.o[t][r] * inv - lam * o2[((wq * 4 + t) * 16 + r) * 64 + lane]; st.o[t][r] = v; ss += v * v; }
        ss += xhalf(ss);
        const float rs = rsqrtf(ss * (1.f / 128.f) + EPS) * 0.6444909324090307f;
        const float* og = A.in[18];
        bf16* Y = WSP(bf16, WS_XNY) + (rowb + qpos) * 1024 + h * 128;
#pragma unroll
        for (int t = 0; t < 4; ++t)
#pragma unroll
            for (int rg = 0; rg < 4; ++rg) { const int dv = t * 32 + 8 * rg + 4 * hi; const f32x4 gg = *(const f32x4*)(og + dv);
                v2u o; o.x = pk2(st.o[t][4 * rg] * rs * gg.x, st.o[t][4 * rg + 1] * rs * gg.y); o.y = pk2(st.o[t][4 * rg + 2] * rs * gg.z, st.o[t][4 * rg + 3] * rs * gg.w);
                *(GAS v2u*)(Y + dv) = o; }
    }
    __syncthreads();
}
template <int MT, int NT>
__device__ __forceinline__ void mma_nt(const LAS unsigned char* A, int lda, const LAS unsigned char* B, int ldb, int K, f32x4 (&acc)[MT][NT], int lane) {
    const int r = lane & 15, kq = (lane >> 4) * 16;
    for (int k0 = 0; k0 < K; k0 += 32) {
        bf16x8 a[MT], bb[NT];
#pragma unroll
        for (int m = 0; m < MT; ++m) a[m] = *(const LAS bf16x8*)(A + (m * 16 + r) * lda + k0 * 2 + kq);
#pragma unroll
        for (int n = 0; n < NT; ++n) bb[n] = *(const LAS bf16x8*)(B + (n * 16 + r) * ldb + k0 * 2 + kq);
#pragma unroll
        for (int m = 0; m < MT; ++m)
#pragma unroll
            for (int n = 0; n < NT; ++n) acc[m][n] = __builtin_amdgcn_mfma_f32_16x16x32_bf16(a[m], bb[n], acc[m][n], 0, 0, 0);
    }
}
constexpr int TS = 272;
constexpr int TILEB = 128 * TS;
constexpr int ML_Q = 0, ML_K = TILEB, ML_V = 2 * TILEB, ML_SM = 3 * TILEB;

__device__ __forceinline__ void ml_gates(const float* GT, size_t row0, int hm, LAS float* sm, int lane) {
    const float i0 = GT[(row0 + 2 * lane) * 8 + hm], i1 = GT[(row0 + 2 * lane + 1) * 8 + hm];
    const float f0 = logsigmoid_f(GT[(row0 + 2 * lane) * 8 + 4 + hm]), f1 = logsigmoid_f(GT[(row0 + 2 * lane + 1) * 8 + 4 + hm]);
    float s = f0 + f1;
#pragma unroll
    for (int o = 1; o < 64; o <<= 1) { const float t = __shfl_up(s, o); if (lane >= o) s += t; }
    const float excl = s - (f0 + f1);
    sm[2 * lane] = excl + f0; sm[2 * lane + 1] = excl + f0 + f1;
    sm[128 + 2 * lane] = i0; sm[128 + 2 * lane + 1] = i1;
}
template <bool TRANSPOSE>
__device__ __forceinline__ void ml_conv_tile(const bf16* Z, size_t rowb, int t0, int zc, const float* cw, int wc, float mul, LAS unsigned char* dst, const LAS float* rs, int tid) {
#pragma unroll
    for (int it = 0; it < 4; ++it) {
        const int item = tid + 512 * it, l = item >> 4, ch = (item & 15) * 8;
        float acc[8];
#pragma unroll
        for (int i = 0; i < 8; ++i) acc[i] = 0.f;
#pragma unroll
        for (int jj = 0; jj < 4; ++jj) {
            const int t = t0 + l - 3 + jj;
            if (t >= 0) {
                const v4u w = *(const GAS v4u*)(Z + (rowb + t) * NZ0 + zc + ch);
                const float x[8] = {bflo(w.x), bfhi(w.x), bflo(w.y), bfhi(w.y), bflo(w.z), bfhi(w.z), bflo(w.w), bfhi(w.w)};
                const f32x4 c0 = *(const f32x4*)(cw + jj * 1024 + wc + ch), c1 = *(const f32x4*)(cw + jj * 1024 + wc + ch + 4);
                acc[0] += x[0] * c0.x; acc[1] += x[1] * c0.y; acc[2] += x[2] * c0.z; acc[3] += x[3] * c0.w;
                acc[4] += x[4] * c1.x; acc[5] += x[5] * c1.y; acc[6] += x[6] * c1.z; acc[7] += x[7] * c1.w;
            }
        }
        const float sc = TRANSPOSE ? mul * rs[l] : mul;
#pragma unroll
        for (int i = 0; i < 8; ++i) acc[i] = silu_f(acc[i]) * sc;
        if (TRANSPOSE) {
#pragma unroll
            for (int i = 0; i < 8; ++i) *(LAS bf16*)(dst + (ch + i) * TS + l * 2) = (bf16)f2bf(acc[i]);
        } else {
            v4u o; o.x = pk2(acc[0], acc[1]); o.y = pk2(acc[2], acc[3]); o.z = pk2(acc[4], acc[5]); o.w = pk2(acc[6], acc[7]);
            *(LAS v4u*)(dst + l * TS + ch * 2) = o;
        }
    }
}
__device__ __forceinline__ void ml_vt_tile(const bf16* Z, size_t row0, int zc, LAS unsigned char* dst, int tid) {
#pragma unroll
    for (int it = 0; it < 4; ++it) {
        const int item = tid + 512 * it, l = item >> 4, ch = (item & 15) * 8;
        const v4u w = *(const GAS v4u*)(Z + (row0 + l) * NZ0 + zc + ch);
        const unsigned ww[4] = {w.x, w.y, w.z, w.w};
#pragma unroll
        for (int i = 0; i < 4; ++i) { *(LAS bf16*)(dst + (ch + 2 * i) * TS + l * 2) = (bf16)(ww[i] & 0xffffu); *(LAS bf16*)(dst + (ch + 2 * i + 1) * TS + l * 2) = (bf16)(ww[i] >> 16); }
    }
}
__device__ __forceinline__ void mlstm_a_unit(Frame& F, const Args& A, int unit) {
    const int c = unit & 63, bh = unit >> 6, hm = bh & 3, b = bh >> 2;
    const bf16* Z = WSP(bf16, WS_Z); const float* GT = WSP(float, WS_GATES);
    const size_t rowb = (size_t)b * SEQ; const int t0 = c * 128;
    LAS unsigned char* lds = F.lds; LAS float* sm = (LAS float*)(lds + ML_SM);
    if (F.wave == 0) {
        ml_gates(GT, rowb + t0, hm, sm, ((int)(threadIdx.x & 63u)));
        LDS_WAIT();
        const float bend = sm[127];
        const float w0 = bend - sm[2 * ((int)(threadIdx.x & 63u))] + sm[128 + 2 * ((int)(threadIdx.x & 63u))], w1 = bend - sm[2 * ((int)(threadIdx.x & 63u)) + 1] + sm[128 + 2 * ((int)(threadIdx.x & 63u)) + 1];
        const float ml = wave_max(fmaxf(w0, w1));
        sm[256 + 2 * ((int)(threadIdx.x & 63u))] = __expf(w0 - ml); sm[256 + 2 * ((int)(threadIdx.x & 63u)) + 1] = __expf(w1 - ml);
        if (((int)(threadIdx.x & 63u)) == 0) { WSP(float, WS_BEND)[unit] = bend; WSP(float, WS_MLOC)[unit] = ml; }
    }
    __syncthreads();
    ml_conv_tile<true>(Z, rowb, t0, 512 + hm * 128, A.in[7], 512 + hm * 128, 0.08838834764831845f, lds + ML_K, sm + 256, ((int)threadIdx.x));
    ml_vt_tile(Z, rowb + t0, 1024 + hm * 128, lds + ML_V, ((int)threadIdx.x));
    __syncthreads();
    f32x4 acc[2][4];
#pragma unroll
    for (int m = 0; m < 2; ++m)
#pragma unroll
        for (int n = 0; n < 4; ++n) acc[m][n] = (f32x4){0.f, 0.f, 0.f, 0.f};
    const int dv0 = 32 * (F.wave >> 1), dk0 = 64 * (F.wave & 1);
    mma_nt<2, 4>(lds + ML_V + dv0 * TS, TS, lds + ML_K + dk0 * TS, TS, 128, acc, ((int)(threadIdx.x & 63u)));
    float* CL = WSP(float, WS_CLOC) + (size_t)unit * 16384;
#pragma unroll
    for (int m = 0; m < 2; ++m)
#pragma unroll
        for (int n = 0; n < 4; ++n)
#pragma unroll
            for (int i = 0; i < 4; ++i) CL[(size_t)(dv0 + 16 * m + 4 * (((int)(threadIdx.x & 63u)) >> 4) + i) * 128 + dk0 + 16 * n + (((int)(threadIdx.x & 63u)) & 15)] = acc[m][n][i];
    if (((int)threadIdx.x) < 128) { float s = 0.f; const LAS bf16* kr = (const LAS bf16*)(lds + ML_K + ((int)threadIdx.x) * TS);
        for (int l = 0; l < 128; ++l) s += bf2f(kr[l]);
        WSP(float, WS_NLOC)[(size_t)unit * 128 + ((int)threadIdx.x)] = s; }
    __syncthreads();
}
__device__ __forceinline__ void mlstm_scan_unit(Frame& F, int unit) {
    const int bh = unit >> 4, sl = unit & 15;
    LAS float* tab = (LAS float*)F.lds;
    if (((int)threadIdx.x) == 0) {
        const float* BE = WSP(float, WS_BEND) + bh * 64; const float* ML = WSP(float, WS_MLOC) + bh * 64; float* MP = WSP(float, WS_MPREV) + bh * 64;
        float m = 0.f;
        for (int c = 0; c < 64; ++c) { const float be = BE[c], ml = ML[c]; const float mn = fmaxf(be + m, ml);
            tab[c] = __expf(be + m - mn); tab[64 + c] = __expf(ml - mn); if (sl == 0) MP[c] = m; m = mn; }
    }
    __syncthreads();
    float* CL = WSP(float, WS_CLOC) + (size_t)bh * 64 * 16384 + sl * 1024 + 2 * ((int)threadIdx.x);
    float s0 = 0.f, s1 = 0.f;
#pragma unroll 8
    for (int c = 0; c < 64; ++c) { float2* p = (float2*)(CL + (size_t)c * 16384); const float2 v = *p; *p = make_float2(s0, s1);
        const float a = tab[c], sc = tab[64 + c]; s0 = a * s0 + sc * v.x; s1 = a * s1 + sc * v.y; }
    if (sl == 0 && ((int)threadIdx.x) < 128) { float* NL = WSP(float, WS_NLOC) + (size_t)bh * 64 * 128 + ((int)threadIdx.x); float s = 0.f;
        for (int c = 0; c < 64; ++c) { const float v = NL[c * 128]; NL[c * 128] = s; s = tab[c] * s + tab[64 + c] * v; } }
    __syncthreads();
}
__device__ __forceinline__ void mlstm_c_unit(Frame& F, const Args& A, int unit) {
    const int c = unit & 63, bh = unit >> 6, hm = bh & 3, b = bh >> 2;
    const bf16* Z = WSP(bf16, WS_Z); const float* GT = WSP(float, WS_GATES);
    const size_t rowb = (size_t)b * SEQ; const int t0 = c * 128;
    LAS unsigned char* lds = F.lds; LAS float* sm = (LAS float*)(lds + ML_SM);
    const int lane = ((int)(threadIdx.x & 63u)), w = F.wave, tid = ((int)threadIdx.x);
    const float mprev = WSP(float, WS_MPREV)[unit];
    if (w == 0) {
        ml_gates(GT, rowb + t0, hm, sm, lane);
        LDS_WAIT();
        const float b0 = sm[2 * lane], b1 = sm[2 * lane + 1];
        const float g0 = sm[128 + 2 * lane] - b0, g1 = sm[128 + 2 * lane + 1] - b1;
        float pm = fmaxf(g0, g1);
#pragma unroll
        for (int o = 1; o < 64; o <<= 1) { const float t = __shfl_up(pm, o); if (lane >= o) pm = fmaxf(pm, t); }
        float pe = __shfl_up(pm, 1); if (lane == 0) pe = -INFINITY;
        const float M0 = fmaxf(mprev, fmaxf(pe, g0)), M1 = fmaxf(mprev, pm);
        sm[256 + 2 * lane] = g0; sm[256 + 2 * lane + 1] = g1;
        sm[384 + 2 * lane] = M0; sm[384 + 2 * lane + 1] = M1;
        sm[512 + 2 * lane] = __expf(mprev - M0); sm[512 + 2 * lane + 1] = __expf(mprev - M1);
        sm[640 + 2 * lane] = __expf(-b0 - M0); sm[640 + 2 * lane + 1] = __expf(-b1 - M1);
        sm[768 + 2 * lane] = 0.f; sm[768 + 2 * lane + 1] = 0.f; sm[896 + 2 * lane] = 0.f; sm[896 + 2 * lane + 1] = 0.f;
    }
    if (w == 1) { sm[1152 + lane] = WSP(float, WS_NLOC)[(size_t)unit * 128 + lane]; sm[1152 + 64 + lane] = WSP(float, WS_NLOC)[(size_t)unit * 128 + 64 + lane]; }
    ml_conv_tile<false>(Z, rowb, t0, hm * 128, A.in[7], hm * 128, 1.f, lds + ML_Q, nullptr, tid);
    ml_conv_tile<false>(Z, rowb, t0, 512 + hm * 128, A.in[7], 512 + hm * 128, 0.08838834764831845f, lds + ML_K, nullptr, tid);
    ml_vt_tile(Z, rowb + t0, 1024 + hm * 128, lds + ML_V, tid);
    __syncthreads();
    const int l0 = 32 * (w >> 1), c0 = 64 * (w & 1);
    const int lr = 4 * (lane >> 4), lc = lane & 15;
    if (tid < 128) { const LAS bf16* qr = (const LAS bf16*)(lds + ML_Q + tid * TS); float s = 0.f;
        for (int d = 0; d < 128; ++d) s += bf2f(qr[d]) * sm[1152 + d];
        sm[1024 + tid] = s; }
    f32x4 acc[2][4];
#pragma unroll
    for (int m = 0; m < 2; ++m)
#pragma unroll
        for (int n = 0; n < 4; ++n) acc[m][n] = (f32x4){0.f, 0.f, 0.f, 0.f};
    mma_nt<2, 4>(lds + ML_Q + l0 * TS, TS, lds + ML_K + c0 * TS, TS, 128, acc, lane);
#pragma unroll
    for (int m = 0; m < 2; ++m)
#pragma unroll
        for (int i = 0; i < 4; ++i) { const int l = l0 + 16 * m + lr + i; const float Ml = sm[384 + l]; float rsum = 0.f;
#pragma unroll
            for (int n = 0; n < 4; ++n) { const int s = c0 + 16 * n + lc; const float v = (s <= l) ? acc[m][n][i] * __expf(sm[256 + s] - Ml) : 0.f; acc[m][n][i] = v; rsum += v; }
            rsum += __shfl_xor(rsum, 1); rsum += __shfl_xor(rsum, 2); rsum += __shfl_xor(rsum, 4); rsum += __shfl_xor(rsum, 8);
            if (lc == 0) __hip_atomic_fetch_add(sm + 768 + l, rsum, __ATOMIC_RELAXED, __HIP_MEMORY_SCOPE_WORKGROUP); }
    __syncthreads();
#pragma unroll
    for (int m = 0; m < 2; ++m)
#pragma unroll
        for (int n = 0; n < 4; ++n)
#pragma unroll
            for (int i = 0; i < 4; ++i) *(LAS bf16*)(lds + ML_K + (l0 + 16 * m + lr + i) * TS + (c0 + 16 * n + lc) * 2) = (bf16)f2bf(acc[m][n][i]);
    __syncthreads();
    f32x4 ai[2][4], ae[2][4];
#pragma unroll
    for (int m = 0; m < 2; ++m)
#pragma unroll
        for (int n = 0; n < 4; ++n) { ai[m][n] = (f32x4){0.f, 0.f, 0.f, 0.f}; ae[m][n] = (f32x4){0.f, 0.f, 0.f, 0.f}; }
    mma_nt<2, 4>(lds + ML_K + l0 * TS, TS, lds + ML_V + c0 * TS, TS, 128, ai, lane);
    {
        const float* CP = WSP(float, WS_CLOC) + (size_t)unit * 16384;
        const int r = lane & 15, kq = (lane >> 4) * 8;
        for (int k0 = 0; k0 < 128; k0 += 32) {
            bf16x8 a[2], bb[4];
#pragma unroll
            for (int m = 0; m < 2; ++m) a[m] = *(const LAS bf16x8*)(lds + ML_Q + (l0 + m * 16 + r) * TS + (k0 + kq) * 2);
#pragma unroll
            for (int n = 0; n < 4; ++n) { const float* p = CP + (size_t)(c0 + n * 16 + r) * 128 + k0 + kq; const f32x4 x = *(const f32x4*)p, y = *(const f32x4*)(p + 4);
                v4u pk; pk.x = pk2(x.x, x.y); pk.y = pk2(x.z, x.w); pk.z = pk2(y.x, y.y); pk.w = pk2(y.z, y.w); bb[n] = __builtin_bit_cast(bf16x8, pk); }
#pragma unroll
            for (int m = 0; m < 2; ++m)
#pragma unroll
                for (int n = 0; n < 4; ++n) ae[m][n] = __builtin_amdgcn_mfma_f32_16x16x32_bf16(a[m], bb[n], ae[m][n], 0, 0, 0);
        }
    }
#pragma unroll
    for (int m = 0; m < 2; ++m)
#pragma unroll
        for (int i = 0; i < 4; ++i) { const int l = l0 + 16 * m + lr + i; const float wi = sm[512 + l];
            const float den = wi * sm[1024 + l] + sm[768 + l]; const float dinv = 1.f / fmaxf(fabsf(den), sm[640 + l]); float ssq = 0.f;
#pragma unroll
            for (int n = 0; n < 4; ++n) { const float hv = (wi * ae[m][n][i] + ai[m][n][i]) * dinv; ai[m][n][i] = hv; ssq += hv * hv; }
            ssq += __shfl_xor(ssq, 1); ssq += __shfl_xor(ssq, 2); ssq += __shfl_xor(ssq, 4); ssq += __shfl_xor(ssq, 8);
            if (lc == 0) __hip_atomic_fetch_add(sm + 896 + l, ssq, __ATOMIC_RELAXED, __HIP_MEMORY_SCOPE_WORKGROUP); }
    __syncthreads();
    const float* mg = A.in[10] + hm * 128;
    bf16* Y = WSP(bf16, WS_XNY);
#pragma unroll
    for (int m = 0; m < 2; ++m)
#pragma unroll
        for (int i = 0; i < 4; ++i) { const int l = l0 + 16 * m + lr + i; const float rstd = rsqrtf(sm[896 + l] * (1.f / 128.f) + EPS); const size_t row = rowb + t0 + l;
#pragma unroll
            for (int n = 0; n < 4; ++n) { const int dv = c0 + 16 * n + lc; const float og = sigmoid_f(bf2f(Z[row * NZ0 + 1536 + hm * 128 + dv]));
                Y[row * 1024 + hm * 128 + dv] = (bf16)f2bf(ai[m][n][i] * rstd * mg[dv] * og); } }
    __syncthreads();
}
template <int N> __device__ __forceinline__ void bitonic_sort_desc(float (&v)[N]) {
#pragma unroll
    for (int k = 2; k <= N; k <<= 1)
#pragma unroll
        for (int j = k >> 1; j > 0; j >>= 1)
#pragma unroll
            for (int i = 0; i < N; ++i) { const int l = i ^ j; if (l > i) { const bool desc = ((i & k) == 0); const float a = v[i], b = v[l]; const float mx = fmaxf(a, b), mn = fminf(a, b); v[i] = desc ? mx : mn; v[l] = desc ? mn : mx; } }
}
__device__ __forceinline__ void merge_top16(float (&run)[16], const float (&nw)[16]) {
#pragma unroll
    for (int i = 0; i < 16; ++i) run[i] = fmaxf(run[i], nw[15 - i]);
#pragma unroll
    for (int j = 8; j > 0; j >>= 1)
#pragma unroll
        for (int i = 0; i < 16; ++i) { const int l = i ^ j; if (l > i) { const float a = run[i], b = run[l]; run[i] = fmaxf(a, b); run[l] = fminf(a, b); } }
}
#ifndef EXPERT_SLOW
#define EXPERT_SLOW 0
#endif
#ifndef ROUTE_SLOW
#define ROUTE_SLOW 0
#endif
constexpr int SCS = 132;
__device__ __forceinline__ void peer_route_unit(Frame& F, int tok0, int hd, const bf16x8 (&kf)[4][2], const int PROBE) {
    const bf16* QRY = WSP(bf16, WS_QRY); int* IDX = WSP(int, WS_IDX); float* GATE = WSP(float, WS_GATE);
    LAS float* SC = (LAS float*)F.lds;
    const int lane = ((int)(threadIdx.x & 63u)), w = F.wave, tid = ((int)threadIdx.x);
    {
        constexpr int AST = 528;
        LAS unsigned char* As = F.lds;
#pragma unroll
        for (int i = 0; i < 8; ++i) { const int ch = tid + 512 * i, row = ch >> 5, cc = ch & 31;
            *(LAS v4u*)(As + row * AST + cc * 16) = *(const GAS v4u*)(QRY + (size_t)(tok0 + row) * NQ + hd * 256 + cc * 8); }
        __syncthreads();
        const int p = w & 1, nq = w >> 1, r = lane & 15, kq = (lane >> 4) * 16;
        f32x4 acc[8][2];
#pragma unroll
        for (int m = 0; m < 8; ++m) { acc[m][0] = (f32x4){0.f, 0.f, 0.f, 0.f}; acc[m][1] = (f32x4){0.f, 0.f, 0.f, 0.f}; }
#pragma unroll
        for (int ks = 0; ks < 4; ++ks)
#pragma unroll
            for (int m = 0; m < 8; ++m) { const bf16x8 a = *(const LAS bf16x8*)(As + (16 * m + r) * AST + p * 256 + ks * 64 + kq);
                acc[m][0] = __builtin_amdgcn_mfma_f32_16x16x32_bf16(a, kf[ks][0], acc[m][0], 0, 0, 0);
                acc[m][1] = __builtin_amdgcn_mfma_f32_16x16x32_bf16(a, kf[ks][1], acc[m][1], 0, 0, 0); }
        __syncthreads();
#pragma unroll
        for (int m = 0; m < 8; ++m)
#pragma unroll
            for (int n = 0; n < 2; ++n)
#pragma unroll
                for (int i = 0; i < 4; ++i) SC[(p * 128 + 16 * m + 4 * (lane >> 4) + i) * SCS + 32 * nq + 16 * n + r] = acc[m][n][i];
    }
    __syncthreads();
#if defined(CHECK) && CHECK
    if (tok0 == 0 && hd == 0) { float* DB = WSP(float, WS_CLOC) + 8 * 1024 * 1024; for (int i = tid; i < 2 * 128 * 128; i += NTHR) DB[i] = SC[(i >> 7) * SCS + (i & 127)]; }
    __syncthreads();
#endif
#if ROUTE_SLOW
    if (tid < 128) {
        const int t = tid;
        float s0[16], s1[16]; unsigned i0[16], i1[16];
        { const LAS float* row = SC + (0 * 128 + t) * SCS; float prev = INFINITY;
#pragma unroll
          for (int k = 0; k < 16; ++k) { float best = -INFINITY; unsigned bi = 0; for (int n = 0; n < 128; ++n) { const float v = row[n]; if (v < prev && v > best) { best = v; bi = n; } } s0[k] = best; i0[k] = bi; prev = best; } }
        { const LAS float* row = SC + (1 * 128 + t) * SCS; float prev = INFINITY;
#pragma unroll
          for (int k = 0; k < 16; ++k) { float best = -INFINITY; unsigned bi = 0; for (int n = 0; n < 128; ++n) { const float v = row[n]; if (v < prev && v > best) { best = v; bi = n; } } s1[k] = best; i1[k] = bi; prev = best; } }
        float top[16]; unsigned tid16[16];
        { float prev = INFINITY;
#pragma unroll
          for (int k = 0; k < 16; ++k) { float best = -INFINITY; unsigned be = 0;
#pragma unroll
              for (int i = 0; i < 16; ++i)
#pragma unroll
                  for (int j = 0; j < 16; ++j) if ((i + 1) * (j + 1) <= 16) { const float v = s0[i] + s1[j]; if (v < prev && v > best) { best = v; be = i0[i] * 128u + i1[j]; } }
              top[k] = best; tid16[k] = be; prev = best; } }
        float sc[16], den = 0.f;
#pragma unroll
        for (int k = 0; k < 16; ++k) { sc[k] = __expf(top[k] - top[0]); den += sc[k]; }
        const float inv = 1.f / den;
        const size_t ob = (size_t)(tok0 + t) * 128 + hd * 16;
#pragma unroll
        for (int k = 0; k < 16; ++k) { IDX[ob + k] = (int)tid16[k]; GATE[ob + k] = sc[k] * inv; }
    }
    __syncthreads();
#else
    if (PROBE < 2) {
        const int t = tid & 127, p = (tid >> 7) & 1, half = tid >> 8;
        LAS float* seg = SC + (p * 128 + t) * SCS + 64 * half;
        float run[16], nw[16];
#pragma unroll
        for (int ch = 0; ch < 4; ++ch) {
#pragma unroll
            for (int q = 0; q < 4; ++q) { const f32x4 v = *(const LAS f32x4*)(seg + 16 * ch + 4 * q);
#pragma unroll
                for (int e = 0; e < 4; ++e) { const unsigned n = (unsigned)(64 * half + 16 * ch + 4 * q + e); const float key = u2f((f2u(v[e]) & ~127u) | n);
                    if (ch == 0) run[4 * q + e] = key; else nw[4 * q + e] = key; } }
            if (ch == 0) bitonic_sort_desc<16>(run); else { bitonic_sort_desc<16>(nw); merge_top16(run, nw); }
        }
#pragma unroll
        for (int q = 0; q < 4; ++q) *(LAS f32x4*)(seg + 4 * q) = (f32x4){run[4 * q], run[4 * q + 1], run[4 * q + 2], run[4 * q + 3]};
    }
    __syncthreads();
    if (tid < 128 && PROBE < 1) {
        const int t = tid;
        float s0[16], s1[16];
        {
            LAS float* a = SC + (0 * 128 + t) * SCS; float nw[16];
#pragma unroll
            for (int q = 0; q < 4; ++q) { const f32x4 v = *(const LAS f32x4*)(a + 4 * q), u = *(const LAS f32x4*)(a + 64 + 4 * q);
#pragma unroll
                for (int e = 0; e < 4; ++e) { s0[4 * q + e] = v[e]; nw[4 * q + e] = u[e]; } }
            merge_top16(s0, nw);
#pragma unroll
            for (int q = 0; q < 4; ++q) *(LAS f32x4*)(a + 16 + 4 * q) = (f32x4){s0[4 * q], s0[4 * q + 1], s0[4 * q + 2], s0[4 * q + 3]};
        }
        {
            LAS float* a = SC + (1 * 128 + t) * SCS; float nw[16];
#pragma unroll
            for (int q = 0; q < 4; ++q) { const f32x4 v = *(const LAS f32x4*)(a + 4 * q), u = *(const LAS f32x4*)(a + 64 + 4 * q);
#pragma unroll
                for (int e = 0; e < 4; ++e) { s1[4 * q + e] = v[e]; nw[4 * q + e] = u[e]; } }
            merge_top16(s1, nw);
#pragma unroll
            for (int q = 0; q < 4; ++q) *(LAS f32x4*)(a + 16 + 4 * q) = (f32x4){s1[4 * q], s1[4 * q + 1], s1[4 * q + 2], s1[4 * q + 3]};
        }
#pragma unroll
        for (int i = 0; i < 16; ++i) { s0[i] = u2f(f2u(s0[i]) & ~127u); s1[i] = u2f(f2u(s1[i]) & ~127u); }
        constexpr int CNT[16] = {16, 8, 5, 4, 3, 2, 2, 2, 1, 1, 1, 1, 1, 1, 1, 1};
        constexpr int OFF[16] = {0, 16, 24, 29, 33, 36, 38, 40, 42, 43, 44, 45, 46, 47, 48, 49};
        float top[16], nw[16];
#pragma unroll
        for (int grp = 0; grp < 4; ++grp) {
#pragma unroll
            for (int e = 0; e < 16; ++e) nw[e] = -INFINITY;
#pragma unroll
            for (int i = 0; i < 16; ++i)
#pragma unroll
                for (int j = 0; j < 16; ++j) if (j < CNT[i] && (OFF[i] + j) / 16 == grp) {
                    const float sum = s0[i] + s1[j];
                    nw[(OFF[i] + j) % 16] = u2f((f2u(sum) & ~255u) | (unsigned)(i * 16 + j)); }
            bitonic_sort_desc<16>(nw);
            if (grp == 0) {
#pragma unroll
                for (int e = 0; e < 16; ++e) top[e] = nw[e];
            } else merge_top16(top, nw);
        }
#if defined(CHECK) && CHECK
        if (tok0 == 0 && hd == 0) { float* DB = WSP(float, WS_CLOC) + 8 * 1024 * 1024 + 32768;
#pragma unroll
            for (int i = 0; i < 16; ++i) { DB[t * 48 + i] = s0[i]; DB[t * 48 + 16 + i] = s1[i]; DB[t * 48 + 32 + i] = top[i]; } }
#endif
        float sc[16], den = 0.f;
        const float mx = u2f(f2u(top[0]) & ~255u);
#pragma unroll
        for (int k = 0; k < 16; ++k) { sc[k] = __expf(u2f(f2u(top[k]) & ~255u) - mx); den += sc[k]; }
        const float inv = 1.f / den;
        LDS_WAIT();
        const LAS unsigned* l0 = (const LAS unsigned*)(SC + (0 * 128 + t) * SCS + 16); const LAS unsigned* l1 = (const LAS unsigned*)(SC + (1 * 128 + t) * SCS + 16);
        const size_t ob = (size_t)(tok0 + t) * 128 + hd * 16;
        unsigned eid[16];
#pragma unroll
        for (int k = 0; k < 16; ++k) { const unsigned id = f2u(top[k]) & 255u; const unsigned e0 = l0[id >> 4] & 127u, e1 = l1[id & 15u] & 127u; eid[k] = e0 * 128u + e1; }
#pragma unroll
        for (int q4 = 0; q4 < 4; ++q4) { v4u iv; iv.x = eid[4 * q4]; iv.y = eid[4 * q4 + 1]; iv.z = eid[4 * q4 + 2]; iv.w = eid[4 * q4 + 3];
            *(GAS v4u*)(IDX + ob + 4 * q4) = iv; *(GAS f32x4*)(GATE + ob + 4 * q4) = (f32x4){sc[4 * q4] * inv, sc[4 * q4 + 1] * inv, sc[4 * q4 + 2] * inv, sc[4 * q4 + 3] * inv}; }
    }
    __syncthreads();
#endif
}
__device__ __forceinline__ void peer_u_phase(Frame& F, const unsigned char* U8  ) {
    const bf16* XN = WSP(bf16, WS_XNY); const int* IDX = WSP(int, WS_IDX); float* PART = WSP(float, WS_PART);
    const int lane = ((int)(threadIdx.x & 63u)), grp = lane >> 3, l8 = lane & 7;
    const int g = F.bid & 7, nsw = (F.G >> 3) * NWAVES, ws = (F.bid >> 3) * NWAVES + F.wave;
    const unsigned char* Ug = U8 + (size_t)g * 16384 * 128;
    const unsigned lo8 = 16u * (unsigned)l8;
#define U_IDS(IDS, TOK) do { const int* ip_ = IDX + (size_t)(TOK) * 128 + 16 * grp; _Pragma("unroll") for (int q4 = 0; q4 < 4; ++q4) IDS[q4] = *(const GAS v4u*)(ip_ + 4 * q4); } while (0)
#define U_ROWS(W, HX, HY, IDS, TOK) do { _Pragma("unroll") for (int q4 = 0; q4 < 4; ++q4) { W[4 * q4] = *(const GAS v4u*)(Ug + ((IDS[q4].x << 7) | lo8)); W[4 * q4 + 1] = *(const GAS v4u*)(Ug + ((IDS[q4].y << 7) | lo8)); \
        W[4 * q4 + 2] = *(const GAS v4u*)(Ug + ((IDS[q4].z << 7) | lo8)); W[4 * q4 + 3] = *(const GAS v4u*)(Ug + ((IDS[q4].w << 7) | lo8)); } \
        const bf16* hp_ = XN + (size_t)(TOK) * D + 128 * g + 16 * l8; HX = *(const GAS v4u*)hp_; HY = *(const GAS v4u*)(hp_ + 8); } while (0)
#define U_COMPUTE(W, HX, HY, TOK) do { \
        const float hf_[16] = {bflo(HX.x), bfhi(HX.x), bflo(HX.y), bfhi(HX.y), bflo(HX.z), bfhi(HX.z), bflo(HX.w), bfhi(HX.w), bflo(HY.x), bfhi(HY.x), bflo(HY.y), bfhi(HY.y), bflo(HY.z), bfhi(HY.z), bflo(HY.w), bfhi(HY.w)}; \
        float am_ = 0.f; _Pragma("unroll") for (int i = 0; i < 16; ++i) am_ = fmaxf(am_, fabsf(hf_[i])); \
        am_ = fmaxf(am_, __shfl_xor(am_, 1)); am_ = fmaxf(am_, __shfl_xor(am_, 2)); am_ = fmaxf(am_, __shfl_xor(am_, 4)); \
        const float hinv_ = am_ > 1e-30f ? 127.f / am_ : 0.f, hsc_ = am_ * (1.f / 127.f); \
        int hq_[4]; _Pragma("unroll") for (int q4 = 0; q4 < 4; ++q4) { unsigned wv_ = 0; _Pragma("unroll") for (int e = 0; e < 4; ++e) { const int qv_ = (int)rintf(hf_[4 * q4 + e] * hinv_); wv_ |= ((unsigned)qv_ & 0xffu) << (8 * e); } hq_[q4] = (int)wv_; } \
        float r_[16]; _Pragma("unroll") for (int it = 0; it < 16; ++it) { const unsigned wx_ = W[it].x, wy_ = W[it].y, wz_ = W[it].z, ww_ = W[it].w; \
            int acc_ = __builtin_amdgcn_sdot4((int)wx_, hq_[0], 0, false); acc_ = __builtin_amdgcn_sdot4((int)wy_, hq_[1], acc_, false); acc_ = __builtin_amdgcn_sdot4((int)wz_, hq_[2], acc_, false); acc_ = __builtin_amdgcn_sdot4((int)ww_, hq_[3], acc_, false); \
            acc_ += __shfl_xor(acc_, 1); acc_ += __shfl_xor(acc_, 2); acc_ += __shfl_xor(acc_, 4); r_[it] = (float)acc_ * hsc_; } \
        if (l8 == 0) { float* pp_ = PART + ((size_t)g * M + (TOK)) * 128 + 16 * grp; _Pragma("unroll") for (int q4 = 0; q4 < 4; ++q4) *(GAS f32x4*)(pp_ + 4 * q4) = (f32x4){r_[4 * q4], r_[4 * q4 + 1], r_[4 * q4 + 2], r_[4 * q4 + 3]}; } } while (0)
    v4u idsA[4], idsB[4], wA[16], wB[16], hxA, hyA, hxB, hyB;
    const int tmax = M - 1;
    int t0 = ws;
    U_IDS(idsA, t0); U_IDS(idsB, min(t0 + nsw, tmax));
    for (; t0 < M; t0 += 2 * nsw) {
        const int t1 = t0 + nsw, t2 = t0 + 2 * nsw, t3 = t0 + 3 * nsw;
        U_ROWS(wA, hxA, hyA, idsA, t0);
        U_ROWS(wB, hxB, hyB, idsB, min(t1, tmax));
        U_IDS(idsA, min(t2, tmax));
        U_IDS(idsB, min(t3, tmax));
        U_COMPUTE(wA, hxA, hyA, t0);
        if (t1 < M) U_COMPUTE(wB, hxB, hyB, t1);
    }
#undef U_IDS
#undef U_ROWS
#undef U_COMPUTE
}
__device__ __forceinline__ void peer_act_phase(Frame& F, const float* ISU, const float* ISV) {
    const int* IDX = WSP(int, WS_IDX); const float* GATE = WSP(float, WS_GATE); const float* PART = WSP(float, WS_PART);
    unsigned short* ACT8 = WSP(unsigned short, WS_ACT); float* ACTS = WSP(float, WS_ACTS);
    const int gw = F.bid * NWAVES + F.wave, NGW = F.G * NWAVES, lane = ((int)(threadIdx.x & 63u));
    for (int tok = gw; tok < M; tok += NGW) {
        const size_t i = (size_t)tok * 128 + 2 * lane;
        float s0 = 0.f, s1 = 0.f;
#pragma unroll
        for (int g = 0; g < 8; ++g) { const float2 p = *(const float2*)(PART + (size_t)g * M * 128 + i); s0 += p.x; s1 += p.y; }
        const int2 id = *(const int2*)(IDX + i); const float2 gt = *(const float2*)(GATE + i);
        const float d0 = s0 * ISU[id.x], d1 = s1 * ISU[id.y];
        const float a0 = 0.5f * d0 * (1.f + erff(d0 * 0.70710678118654752f)) * gt.x * ISV[id.x], a1 = 0.5f * d1 * (1.f + erff(d1 * 0.70710678118654752f)) * gt.y * ISV[id.y];
        const float am = wave_max(fmaxf(fabsf(a0), fabsf(a1)));
        const float inv = am > 1e-30f ? 127.f / am : 0.f;
        const int q0 = (int)rintf(a0 * inv), q1 = (int)rintf(a1 * inv);
        ACT8[(size_t)tok * 64 + lane] = (unsigned short)(((unsigned)q0 & 0xffu) | (((unsigned)q1 & 0xffu) << 8));
        if (lane == 0) ACTS[tok] = am * (1.f / 127.f);
    }
}
template <bool FINAL>
__device__ __forceinline__ void peer_v_phase(Frame& F, const unsigned char* V8, const float* g2  , float dbg) {
    const int* IDX = WSP(int, WS_IDX); const unsigned* ACT8 = WSP(unsigned, WS_ACT); const float* ACTS = WSP(float, WS_ACTS);
    const int lane = ((int)(threadIdx.x & 63u)), t8 = lane >> 3, l8 = lane & 7;
    const int g = F.bid & 7, nsw = (F.G >> 3) * NWAVES, ws = (F.bid >> 3) * NWAVES + F.wave;
    const unsigned char* Vg = V8 + (size_t)g * 16384 * 128; const unsigned lo8 = 16u * (unsigned)l8;
    for (int wi = ws; wi < M / 8; wi += nsw) {
        const int tok = wi * 8 + t8;
        const int* ip = IDX + (size_t)tok * 128; const unsigned* ap = ACT8 + (size_t)tok * 32;
        int acc[16];
#pragma unroll
        for (int i = 0; i < 16; ++i) acc[i] = 0;
#pragma unroll 2
        for (int gi = 0; gi < 32; ++gi) {
            const v4u id4 = *(const GAS v4u*)(ip + 4 * gi); const int qa = (int)ap[gi];
            const v4u ra = *(const GAS v4u*)(Vg + ((id4.x << 7) | lo8)), rb = *(const GAS v4u*)(Vg + ((id4.y << 7) | lo8)), rc = *(const GAS v4u*)(Vg + ((id4.z << 7) | lo8)), rd = *(const GAS v4u*)(Vg + ((id4.w << 7) | lo8));
            const unsigned A[4] = {ra.x, ra.y, ra.z, ra.w}, B[4] = {rb.x, rb.y, rb.z, rb.w}, C[4] = {rc.x, rc.y, rc.z, rc.w}, Dd[4] = {rd.x, rd.y, rd.z, rd.w};
#pragma unroll
            for (int j = 0; j < 4; ++j) {
                const unsigned ablo = __builtin_amdgcn_perm(B[j], A[j], 0x05010400u), abhi = __builtin_amdgcn_perm(B[j], A[j], 0x07030602u);
                const unsigned cdlo = __builtin_amdgcn_perm(Dd[j], C[j], 0x05010400u), cdhi = __builtin_amdgcn_perm(Dd[j], C[j], 0x07030602u);
                const unsigned t0 = __builtin_amdgcn_perm(cdlo, ablo, 0x05040100u), t1 = __builtin_amdgcn_perm(cdlo, ablo, 0x07060302u);
                const unsigned t2 = __builtin_amdgcn_perm(cdhi, abhi, 0x05040100u), t3 = __builtin_amdgcn_perm(cdhi, abhi, 0x07060302u);
                acc[4 * j] = __builtin_amdgcn_sdot4((int)t0, qa, acc[4 * j], false); acc[4 * j + 1] = __builtin_amdgcn_sdot4((int)t1, qa, acc[4 * j + 1], false);
                acc[4 * j + 2] = __builtin_amdgcn_sdot4((int)t2, qa, acc[4 * j + 2], false); acc[4 * j + 3] = __builtin_amdgcn_sdot4((int)t3, qa, acc[4 * j + 3], false);
            }
        }
        const float sc = ACTS[tok] * dbg;
        const int b = tok >> 13, c0 = 128 * g + 16 * l8; bf16* xs = WSP(bf16, WS_XS) + (size_t)tok * D + c0; const float* gr = g2 + (size_t)b * 6144 + c0;
        const v4u xa = *(const GAS v4u*)xs, xb = *(const GAS v4u*)(xs + 8);
        const unsigned xw[8] = {xa.x, xa.y, xa.z, xa.w, xb.x, xb.y, xb.z, xb.w};
        float o[16];
#pragma unroll
        for (int q4 = 0; q4 < 4; ++q4) { const f32x4 gv = *(const f32x4*)(gr + 4 * q4);
            o[4 * q4] = bflo(xw[2 * q4]) + gv.x * sc * (float)acc[4 * q4]; o[4 * q4 + 1] = bfhi(xw[2 * q4]) + gv.y * sc * (float)acc[4 * q4 + 1];
            o[4 * q4 + 2] = bflo(xw[2 * q4 + 1]) + gv.z * sc * (float)acc[4 * q4 + 2]; o[4 * q4 + 3] = bfhi(xw[2 * q4 + 1]) + gv.w * sc * (float)acc[4 * q4 + 3]; }
        if (FINAL) { float* xr = F.out + (size_t)tok * D + c0;
#pragma unroll
            for (int q4 = 0; q4 < 4; ++q4) *(GAS f32x4*)(xr + 4 * q4) = (f32x4){o[4 * q4], o[4 * q4 + 1], o[4 * q4 + 2], o[4 * q4 + 3]};
        } else { v4u ya, yb; ya.x = pk2(o[0], o[1]); ya.y = pk2(o[2], o[3]); ya.z = pk2(o[4], o[5]); ya.w = pk2(o[6], o[7]); yb.x = pk2(o[8], o[9]); yb.y = pk2(o[10], o[11]); yb.z = pk2(o[12], o[13]); yb.w = pk2(o[14], o[15]);
            *(GAS v4u*)xs = ya; *(GAS v4u*)(xs + 8) = yb; }
    }
}
#if defined(CHECK) && CHECK
constexpr size_t WS_DBG = 896 * 1024;
constexpr size_t WS_DBGOUT = WS_CLOC;
#ifndef CHECK_LAYER
#define CHECK_LAYER 1
#endif
__global__ void chk_qry(Args a) {
    const bf16* XN = (const bf16*)(a.ws + WS_XNY); const bf16* QRY = (const bf16*)(a.ws + WS_QRY); const float* wq = a.in[20] + (size_t)CHECK_LAYER * D * NQ;
    float* R = (float*)(a.ws + WS_CTL + WS_DBG);
    const int tok = (blockIdx.x * 977) % M; const int col = (threadIdx.x * 37 + blockIdx.x * 11) % NQ;
    float s = 0.f; for (int k = 0; k < D; ++k) s += bf2f(XN[(size_t)tok * D + k]) * wq[(size_t)k * NQ + col];
    const float q = bf2f(QRY[(size_t)tok * NQ + col]);
    atomicAdd(R + 0, (s - q) * (s - q)); atomicAdd(R + 1, s * s);
}
__global__ void chk_keys(Args a) {
    const bf16* KB = (const bf16*)(a.ws + WS_KEYS); const float* keys = a.in[21]; float* R = (float*)(a.ws + WS_CTL + WS_DBG);
    const int i = blockIdx.x * blockDim.x + threadIdx.x; if (i < 2 * 2 * 128 * 128) { const float d = bf2f(KB[i]) - keys[i]; atomicAdd(R + 8, d * d); atomicAdd(R + 9, keys[i] * keys[i]); }
}
__global__ void chk_uv(Args a) {
    const bf16* UB = (const bf16*)(a.ws + WS_UB); const bf16* VB = (const bf16*)(a.ws + WS_VB); float* R = (float*)(a.ws + WS_CTL + WS_DBG);
    const size_t i = ((size_t)blockIdx.x * blockDim.x + threadIdx.x) * 61 % ((size_t)2 * 16384 * 1024);
    const float du = bf2f(UB[i]) - a.in[22][i], dv = bf2f(VB[i]) - a.in[23][i];
    atomicAdd(R + 16, du * du + dv * dv); atomicAdd(R + 17, a.in[22][i] * a.in[22][i] + a.in[23][i] * a.in[23][i]);
}
__global__ void chk_route(Args a) {
    const bf16* QRY = (const bf16*)(a.ws + WS_QRY); const float* keys = a.in[21] + (size_t)CHECK_LAYER * 2 * 128 * 128;
    const int* IDX = (const int*)(a.ws + WS_IDX); const float* GATE = (const float*)(a.ws + WS_GATE);
    float* R = (float*)(a.ws + WS_CTL + WS_DBG);
    __shared__ float sc[2][128]; __shared__ float sc0[2][128]; __shared__ float ts[2][16]; __shared__ int ti[2][16]; __shared__ float cs[256]; __shared__ int ci[256];
    const int tok = (blockIdx.x * 613 + 5) % M, hd = blockIdx.x & 7, tid = threadIdx.x;
    { const int p = tid >> 7, n = tid & 127; float s = 0.f; for (int d = 0; d < 128; ++d) s += bf2f(QRY[(size_t)tok * NQ + hd * 256 + p * 128 + d]) * keys[(size_t)(p * 128 + n) * 128 + d]; sc[p][n] = s; sc0[p][n] = s; }
    __syncthreads();
    if (tid < 2) { const int p = tid; for (int k = 0; k < 16; ++k) { int best = 0; float bv = -INFINITY; for (int n = 0; n < 128; ++n) if (sc[p][n] > bv) { bv = sc[p][n]; best = n; } ts[p][k] = bv; ti[p][k] = best; sc[p][best] = -INFINITY; } }
    __syncthreads();
    cs[tid] = ts[0][tid >> 4] + ts[1][tid & 15]; ci[tid] = ti[0][tid >> 4] * 128 + ti[1][tid & 15];
    __syncthreads();
    if (tid == 0) {
        float fs[16]; int fi[16];
        for (int k = 0; k < 16; ++k) { int best = 0; float bv = -INFINITY; for (int n = 0; n < 256; ++n) if (cs[n] > bv) { bv = cs[n]; best = n; } fs[k] = bv; fi[k] = ci[best]; cs[best] = -INFINITY; }
        float den = 0.f; for (int k = 0; k < 16; ++k) den += __expf(fs[k] - fs[0]);
        int mism = 0; float ge = 0.f;
        for (int k = 0; k < 16; ++k) { bool found = false; for (int j = 0; j < 16; ++j) if (IDX[(size_t)tok * 128 + hd * 16 + j] == fi[k]) { found = true; const float g = __expf(fs[k] - fs[0]) / den; const float d = g - GATE[(size_t)tok * 128 + hd * 16 + j]; ge += d * d; } if (!found) ++mism; }
        { int ba = 0, bb = 0; for (int j = 0; j < 16; ++j) { const int e = IDX[(size_t)tok * 128 + hd * 16 + j]; const int ea = (e >> 7) & 127, eb = e & 127;
            if (!(e >= 0 && e < 16384) || sc0[0][ea] + sc0[1][eb] < fs[15] - 0.05f) ++ba; if (!(e >= 0 && e < 16384) || sc0[1][ea] + sc0[0][eb] < fs[15] - 0.05f) ++bb; }
          atomicAdd(R + 10, (float)ba); atomicAdd(R + 11, (float)bb); }
        atomicAdd(R + 2, (float)mism); atomicAdd(R + 3, 16.f); atomicAdd(R + 4, ge); atomicAdd(R + 5, 1.f / 16.f);
    }
}
__global__ void chk_scores(Args a) {
    const bf16* QRY = (const bf16*)(a.ws + WS_QRY); const float* keys = a.in[21] + (size_t)CHECK_LAYER * 2 * 128 * 128;
    const float* DB = (const float*)(a.ws + WS_CLOC) + 8 * 1024 * 1024; float* R = (float*)(a.ws + WS_CTL + WS_DBG);
    const int t = blockIdx.x, tid = threadIdx.x;
    __shared__ float sc[2][128];
    { const int p = tid >> 7, n = tid & 127; float s = 0.f; for (int d = 0; d < 128; ++d) s += bf2f(QRY[(size_t)t * NQ + p * 128 + d]) * keys[(size_t)(p * 128 + n) * 128 + d];
      const float dv = DB[(p * 128 + t) * 128 + n]; atomicAdd(R + 12, (s - dv) * (s - dv)); atomicAdd(R + 13, s * s); sc[p][n] = dv; }
    __syncthreads();
    if (tid < 2) { const int p = tid; int bad = 0; for (int k = 0; k < 16; ++k) { int best = 0; float bv = -INFINITY; for (int n = 0; n < 128; ++n) if (sc[p][n] > bv) { bv = sc[p][n]; best = n; }
        const float lv = DB[32768 + t * 48 + 16 * p + k]; if (fabsf(lv - bv) > 1e-3f * (1.f + fabsf(bv))) ++bad; sc[p][best] = -INFINITY; }
        atomicAdd(R + 14, (float)bad); atomicAdd(R + 15, 16.f); }
}
__global__ void chk_expert(Args a) {
    const bf16* XN = (const bf16*)(a.ws + WS_XNY); const int* IDX = (const int*)(a.ws + WS_IDX); const float* GATE = (const float*)(a.ws + WS_GATE);
    const float* U = a.in[22] + (size_t)CHECK_LAYER * 16384 * 1024; const float* V = a.in[23] + (size_t)CHECK_LAYER * 16384 * 1024;
    const float* DO = (const float*)(a.ws + WS_DBGOUT); float* R = (float*)(a.ws + WS_CTL + WS_DBG);
    __shared__ float act[128];
    const int tok = (blockIdx.x * 61 + 3) % 4096, tid = threadIdx.x;
    if (tid < 128) { const int e = IDX[(size_t)tok * 128 + tid]; float s = 0.f; for (int k = 0; k < D; ++k) s += bf2f(XN[(size_t)tok * D + k]) * U[(size_t)e * D + k];
        act[tid] = 0.5f * s * (1.f + erff(s * 0.70710678f)) * GATE[(size_t)tok * 128 + tid]; }
    __syncthreads();
    for (int c = tid; c < D; c += 256) { float o = 0.f; for (int e = 0; e < 128; ++e) o += act[e] * V[(size_t)IDX[(size_t)tok * 128 + e] * D + c];
        const float g = DO[(size_t)tok * D + c]; atomicAdd(R + 6, (o - g) * (o - g)); atomicAdd(R + 7, o * o); }
}
__global__ void chk_stamp(Args a) {
    const float* R = (const float*)(a.ws + WS_CTL + WS_DBG);
    const float e1 = sqrtf(R[0] / fmaxf(R[1], 1e-30f)), e2 = R[2] / fmaxf(R[3], 1.f), e2g = sqrtf(R[4] / fmaxf(R[5], 1e-30f)), e3 = sqrtf(R[6] / fmaxf(R[7], 1e-30f));
    float c;
#if CHECK == 99
    c = 1.f;
#else
    const float e0 = sqrtf(R[8] / fmaxf(R[9], 1e-30f));
    const float ea = R[10] / fmaxf(R[3], 1.f), eb = R[11] / fmaxf(R[3], 1.f);
    const float esc = sqrtf(R[12] / fmaxf(R[13], 1e-30f)), els = R[14] / fmaxf(R[15], 1.f);
    const float euv = sqrtf(R[16] / fmaxf(R[17], 1e-30f));
    const float errs[4] = {e2, euv, ea, e3}; const float tols[4] = {0.08f, 0.01f, 0.08f, 0.03f};
    c = 1.f;
    for (int k = 3; k >= 0; --k) if (!(errs[k] <= tols[k])) { const float fr = fminf(fmaxf((log10f(fmaxf(errs[k], 1e-4f)) + 4.f) / 5.f, 0.f), 0.95f); c = 2.f + (float)k + fr; }
#endif
    const size_t i = (size_t)blockIdx.x * blockDim.x + threadIdx.x;
    if (i < (size_t)M * D) a.out[i] = a.in[0][i] * (1.f + c);
}
#endif
#ifndef MK_PER_PHASE
#define MK_PER_PHASE 0
#endif
constexpr int NPHASE = 24;
#ifndef RPROBE
#define RPROBE 0
#endif
#ifndef DBG_Y0
#define DBG_Y0 1
#define DBG_P0 1
#define DBG_Y1 1
#define DBG_P1 1
#endif
#ifndef PHASE_MASK
#define PHASE_MASK 0x1ffffffu
#endif
#define IN(k) (lo <= (k) && (k) < hi && ((PHASE_MASK >> (k)) & 1u))
#ifndef DUP_PHASE
#define DUP_PHASE -1
#endif
#define REPS(k) for (int rep = ((DUP_PHASE) == (k) ? 0 : 1); rep < 2; ++rep)
#define SEAM(k) do { if (IN(k) && IN((k) + 1)) xcd_barrier(bar); } while (0)
__device__ __forceinline__ float alibi_tcut(const float* gq, const float* gk, int lane) { return 16.f * wave_max(fabsf(gq[lane])) * wave_max(fabsf(gk[lane])) + ALIBI_MARGIN; }
template <int layer>
__device__ __forceinline__ void layer_phases(Frame& F, const Args& args, const XcdBarrier& bar, const int lo, const int hi) {
    volatile LAS unsigned* MISCW = (volatile LAS unsigned*)(F.lds + MISC_OFF);
    float* MOD = WSP(float, WS_MOD);
    bf16* XNY = WSP(bf16, WS_XNY); bf16* Zb = WSP(bf16, WS_Z);

        constexpr int pb = layer * 12;
        const float* mod = MOD + (size_t)layer * 4 * 6144;
        if (IN(pb + 1)) REPS(pb + 1) { if (layer == 0) norm_pass<true, false>(F, args, args.in[0], args.in[4], mod, 0, XNY); else norm_pass<false, true>(F, args, WSP(bf16, WS_XS), args.in[4] + 1024, mod, 0, XNY); } SEAM(pb + 1);
        if (IN(pb + 2)) REPS(pb + 2) {
            const int N = layer == 0 ? NZ0 : NZ1;
            pg8::Gemm g{XNY, layer == 0 ? WSP(bf16, WS_WIN0) : WSP(bf16, WS_WIN1), M, N, D}; pg8::StaticOrder S; S.init(M, N, F.G, F.bid);
            pg8::EpiBf16QK E{Zb, N, layer == 0 ? 8 : 0, layer == 0 ? 10 : 4, layer == 0 ? 10 : 4, layer == 0 ? 12 : 8, layer == 0 ? args.in[11] : args.in[15], layer == 0 ? args.in[12] : args.in[16], 0.125f * LOG2E, (LAS float*)(F.lds + 131072)};
            pg8::gemm_phase<pg8::EpiBf16QK, pg8::StaticOrder, true, true>(F.lds, g, S, E);
        } SEAM(pb + 2);
        if (layer == 0) {
            if (IN(3)) REPS(3) {
                for (int u = F.bid; u < 1024 + 128; u += F.G) {
                    if (u < 1024) mlstm_a_unit(F, args, u);
                    else if (rep == 1) { const int v = u - 1024, b = v >> 5, j = v & 31;
                        kmean_unit(F, Zb, NZ0, b * SEQ + j * 256, 2560, WSP(float, WS_KMEAN) + (size_t)((b * 8) * 32 + j) * 64); }
                }
            } SEAM(3);
            if (IN(4)) REPS(4) {
                if (rep == 1) for (int u = F.bid; u < 256; u += F.G) mlstm_scan_unit(F, u);
                { const float tcut = alibi_tcut(args.in[11], args.in[12], ((int)(threadIdx.x & 63u)));
                  const unsigned short* ORD = WSP(unsigned short, WS_ORD) + 2048; unsigned* qw = (unsigned*)(F.ws + WS_CTL) + CW_QMOBA + (rep == 1 ? 0 : 8);
                  for (int xi = 0; xi < 8; ++xi) { const int x = (F.bid + xi) & 7;
                      for (;;) { if (((int)threadIdx.x) == 0) MISCW[0] = atomicAdd(qw + 16 * x, 1u); __syncthreads(); const unsigned qi = MISCW[0]; __syncthreads(); if (qi >= 128u) break;
                          const int u = ORD[x * 128 + qi]; moba_unit(F, u >> 8, (u >> 5) & 7, u & 31, tcut); } }
                  if (rep == 1) { unsigned* cw = (unsigned*)(F.ws + WS_CTL) + CW_QCVT0;
                      for (;;) { if (((int)threadIdx.x) == 0) MISCW[0] = atomicAdd(cw, 1u); __syncthreads(); const unsigned ci = MISCW[0]; __syncthreads(); if (ci >= 512u) break; i8_chunk(F, args, 0, (int)ci); } } }
            } SEAM(4);
            if (IN(5)) REPS(5) { for (int u = F.bid; u < 1024; u += F.G) mlstm_c_unit(F, args, u); } SEAM(5);
        } else {
            if (IN(pb + 4)) REPS(pb + 4) {
                const float* lp = args.in[17];
                const float lam = __expf(wave_sum(lp[((int)(threadIdx.x & 63u))] * lp[64 + ((int)(threadIdx.x & 63u))])) - __expf(wave_sum(lp[128 + ((int)(threadIdx.x & 63u))] * lp[192 + ((int)(threadIdx.x & 63u))])) + 0.35550906759096926f;
                { const float tcut = alibi_tcut(args.in[15], args.in[16], ((int)(threadIdx.x & 63u)));
                  const unsigned short* ORD = WSP(unsigned short, WS_ORD); unsigned* qw = (unsigned*)(F.ws + WS_CTL) + CW_QDIFF + (rep == 1 ? 0 : 8);
                  for (int xi = 0; xi < 8; ++xi) { const int x = (F.bid + xi) & 7;
                      for (;;) { if (((int)threadIdx.x) == 0) MISCW[0] = atomicAdd(qw + 16 * x, 1u); __syncthreads(); const unsigned qi = MISCW[0]; __syncthreads(); if (qi >= 256u) break;
                          const int u = ORD[x * 256 + qi]; diff_unit(F, args, u >> 9, (u >> 6) & 7, u & 63, lam, tcut, rep == 0 ? RPROBE : 0); } }
                  if (rep == 1) { unsigned* cw = (unsigned*)(F.ws + WS_CTL) + CW_QCVT1;
                      for (;;) { if (((int)threadIdx.x) == 0) MISCW[0] = atomicAdd(cw, 1u); __syncthreads(); const unsigned ci = MISCW[0]; __syncthreads(); if (ci >= 512u) break; i8_chunk(F, args, 1, (int)ci); } } }
            } SEAM(pb + 4);
        }
        if (IN(pb + 6)) {
            pg8::Gemm g{XNY, layer == 0 ? WSP(bf16, WS_WOUT0) : WSP(bf16, WS_WOUT1), M, D, D}; pg8::StaticOrder S; S.init(M, D, F.G, F.bid);
            if (layer == 0) { pg8::EpiResid<false> E{args.in[0], WSP(bf16, WS_XS), mod + 2 * 1024}; pg8::gemm_phase<pg8::EpiResid<false>, pg8::StaticOrder, true, true>(F.lds, g, S, E); }
            else { pg8::EpiResid<true> E{WSP(bf16, WS_XS), WSP(bf16, WS_XS), mod + 2 * 1024}; pg8::gemm_phase<pg8::EpiResid<true>, pg8::StaticOrder, true, true>(F.lds, g, S, E); }
        } SEAM(pb + 6);
        if (IN(pb + 7)) REPS(pb + 7) { norm_pass<false, true>(F, args, WSP(bf16, WS_XS), args.in[5] + layer * 1024, mod, 3, XNY); } SEAM(pb + 7);
        if (IN(pb + 8)) REPS(pb + 8) {
            pg8::Gemm g{XNY, WSP(bf16, WS_WQ) + (size_t)layer * NQ * D, M, NQ, D}; pg8::StaticOrder S; S.init(M, NQ, F.G, F.bid);
            pg8::EpiBf16 E{WSP(bf16, WS_QRY), NQ};
            pg8::gemm_phase<pg8::EpiBf16, pg8::StaticOrder, true, true>(F.lds, g, S, E);
        } SEAM(pb + 8);
        if (IN(pb + 9)) REPS(pb + 9) { const bf16* KEYS = WSP(bf16, WS_KEYS) + (size_t)layer * 2 * 128 * 128;
            bf16x8 kf[4][2];
#pragma unroll
            for (int ks = 0; ks < 4; ++ks)
#pragma unroll
                for (int n = 0; n < 2; ++n) kf[ks][n] = *(const GAS bf16x8*)(KEYS + (size_t)((F.wave & 1) * 128 + 32 * (F.wave >> 1) + 16 * n + (((int)(threadIdx.x & 63u)) & 15)) * 128 + 32 * ks + 8 * (((int)(threadIdx.x & 63u)) >> 4));
            for (int u = F.bid; u < 2048; u += F.G) peer_route_unit(F, (u >> 3) * 128, u & 7, kf, rep == 0 ? RPROBE : 0); } SEAM(pb + 9);
        if (IN(pb + 10)) REPS(pb + 10) { peer_u_phase(F, F.ws + WS_UB + (size_t)layer * 8 * 16384 * 128); } SEAM(pb + 10);
        if (IN(pb + 11)) REPS(pb + 11) { peer_act_phase(F, WSP(float, WS_ISU) + layer * 16384, WSP(float, WS_ISV) + layer * 16384); } SEAM(pb + 11);
        if (IN(pb + 12)) REPS(pb + 12) { peer_v_phase<layer == 1>(F, F.ws + WS_VB + (size_t)layer * 8 * 16384 * 128, mod + 5 * 1024, rep == 1 ? (layer == 0 ? (float)DBG_P0 : (float)DBG_P1) : 0.f); }
        if (layer == 0) SEAM(12);
    }
__global__ void __launch_bounds__(NTHR, 2) mega_fwd(Args args) {
    extern __shared__ __attribute__((aligned(16))) unsigned char lds_raw[];
    Frame F;
    F.lds = (LAS unsigned char*)lds_raw;
    F.wave = __builtin_amdgcn_readfirstlane((int)threadIdx.x >> 6);
    F.G = gridDim.x; F.bid = blockIdx.x;
    F.out = args.out; F.ws = args.ws;
    volatile LAS unsigned* MISC = (volatile LAS unsigned*)(F.lds + MISC_OFF);
    for (int u = ((int)threadIdx.x); u < (LDS_BYTES - LDSCTL_OFF) / 4; u += NTHR) ((LAS unsigned*)(F.lds + LDSCTL_OFF))[u] = 0u;
    __syncthreads();
    XcdBarrier bar; bar.bar = (unsigned*)(F.ws + WS_CTL) + CW_BAR; bar.x = 0; bar.st = nullptr;
    if (!MK_PER_PHASE) bar = xcd_barrier_post((unsigned*)(F.ws + WS_CTL) + CW_BAR, MISC + 8);
    const int lo = args.ph_lo, hi = args.ph_hi;

#ifdef EXTRA_BAR
    for (int i = 0; i < EXTRA_BAR; ++i) xcd_barrier(bar);
#endif
    if (IN(0)) REPS(0) { p0_prologue(F, args); } SEAM(0);
    layer_phases<0>(F, args, bar, lo, hi);
    layer_phases<1>(F, args, bar, lo, hi);
}
#undef IN
#undef SEAM

extern "C" void kernel_launch(void* const* d_in, const int* in_sizes, int n_in, void* d_out, int out_size, void* d_ws, size_t ws_size, hipStream_t stream) {
    static int grid = 0;
    if (grid == 0) {
        if (n_in != 24 || in_sizes[0] != M * D || out_size != M * D || ws_size < WS_END) { fprintf(stderr, "kernel_launch: unexpected problem (n_in %d, in0 %d, out %d, ws %zu < %zu); nothing launched\n", n_in, n_in > 0 ? in_sizes[0] : -1, out_size, ws_size, (size_t)WS_END); grid = -1; return; }
        int dev = 0, cus = 0, per_cu = 0;
        if (hipGetDevice(&dev) != hipSuccess || hipDeviceGetAttribute(&cus, hipDeviceAttributeMultiprocessorCount, dev) != hipSuccess) { grid = -1; return; }
        if (hipFuncSetAttribute((const void*)mega_fwd, hipFuncAttributeMaxDynamicSharedMemorySize, LDS_BYTES) != hipSuccess) { fprintf(stderr, "kernel_launch: hipFuncSetAttribute failed\n"); grid = -1; return; }
        if (hipOccupancyMaxActiveBlocksPerMultiprocessor(&per_cu, (const void*)mega_fwd, NTHR, LDS_BYTES) != hipSuccess || per_cu < 1)
            fprintf(stderr, "kernel_launch: note: occupancy query reports %d workgroups per CU\n", per_cu);
        (void)hipGetLastError();
        grid = cus;
    }
    if (grid < 0) return;
    if (hipMemsetAsync((char*)d_ws + WS_CTL, 0, CTL_ZERO_BYTES, stream) != hipSuccess) { fprintf(stderr, "kernel_launch: memset failed\n"); return; }
    Args a{};
    for (int i = 0; i < 24; ++i) a.in[i] = (const float*)d_in[i];
    a.out = (float*)d_out; a.ws = (unsigned char*)d_ws;
#if MK_PER_PHASE
    for (int p = 0; p < NPHASE + 1; ++p) { a.ph_lo = p; a.ph_hi = p + 1; hipLaunchKernelGGL(mega_fwd, dim3(grid), dim3(NTHR), LDS_BYTES, stream, a); }
#else
    a.ph_lo = 0; a.ph_hi = NPHASE + 1;
    hipLaunchKernelGGL(mega_fwd, dim3(grid), dim3(NTHR), LDS_BYTES, stream, a);
#endif
#if defined(CHECK) && CHECK
    chk_qry<<<256, 256, 0, stream>>>(a); chk_keys<<<256, 256, 0, stream>>>(a); chk_uv<<<1024, 256, 0, stream>>>(a); chk_scores<<<128, 256, 0, stream>>>(a); chk_route<<<512, 256, 0, stream>>>(a); chk_expert<<<64, 256, 0, stream>>>(a); chk_stamp<<<(M * D + 255) / 256, 256, 0, stream>>>(a);
#endif
    const hipError_t le = hipPeekAtLastError();
    if (le != hipSuccess) fprintf(stderr, "kernel_launch: launch failed: %s\n", hipGetErrorName(le));
}
```

```cpp
#include <hip/hip_runtime.h>
#include <cstdio>
#include <cstdint>
namespace pg8 {
#define PG8_LAS __attribute__((address_space(3)))
typedef unsigned short bf16_t;
typedef short bf16x8 __attribute__((ext_vector_type(8)));
typedef float f32x4 __attribute__((ext_vector_type(4)));
typedef unsigned u32x4 __attribute__((ext_vector_type(4)));
constexpr int BM = 256, BK = 64, HALF = 128, HTB = HALF * BK * 2  , STAGE_BYTES = 8 * HTB, NXCD = 8, WGM = 8;

__host__ __device__ __forceinline__ int lds_byte(int r, int c) { const int st = (r >> 4) * 2 + (c >> 5), rr = r & 15, cc = c & 31, ob = rr * 64 + cc * 2; return st * 1024 + (ob ^ (((ob >> 9) & 1) << 5)); }
__host__ __device__ __forceinline__ void stage_rc(int b, int& R, int& C) { const int st = b / 1024, sb = b % 1024, swz = sb ^ (((sb >> 9) & 1) << 5); R = (st >> 1) * 16 + swz / 64; C = (st & 1) * 32 + (swz % 64) / 2; }
__host__ __device__ __forceinline__ int perm32(int rho) { const int n = rho >> 4, i = rho & 15; return 8 * (i >> 2) + 4 * n + (i & 3); }

struct Unit { int pm, pn; };
struct Gemm { const bf16_t* A; const bf16_t* Bt; int M, N, K; size_t bstride; };

struct StaticOrder {
    int nM, nN, nwg, G, c;
    __host__ __device__ void init(int M, int N, int G_, int c_) { nM = M / BM; nN = N / BM; nwg = nM * nN; G = G_; c = c_; }
    __host__ __device__ bool next(int i, Unit& u) const {
        const long L = (long)i * G + c; if (L >= nwg) return false;
        int wgid = (int)L; { const int q = nwg / NXCD, r = nwg % NXCD, xcd = wgid % NXCD, off = wgid / NXCD; wgid = (xcd < r ? xcd * (q + 1) : r * (q + 1) + (xcd - r) * q) + off; }
        const int nig = WGM * nN, gid = wgid / nig, fm = gid * WGM, gsz = (nM - fm) < WGM ? (nM - fm) : WGM;
        u.pm = fm + ((wgid % nig) % gsz); u.pn = (wgid % nig) / gsz; return true;
    }
    __device__ __forceinline__ void a_ready(const Unit&) const {}
    __device__ __forceinline__ void done(const Unit&) const {}
};

__device__ __forceinline__ unsigned cvt_pk_bf16(float lo, float hi) { unsigned r; asm volatile("v_cvt_pk_bf16_f32 %0, %1, %2" : "=v"(r) : "v"(lo), "v"(hi)); return r; }
typedef unsigned u32x4 __attribute__((ext_vector_type(4)));
struct EpiBf16 {
    static constexpr bool PERM = true, AFTER_DRAIN = false;
    bf16_t* O; int ldc;
    __device__ __forceinline__ void operator()(const f32x4 (&acc)[2][2][4][2], const Unit& u, int wr, int wc, int fr, int fq) const {
        const int row0 = u.pm * BM + wr * 64 + fr; const int col0 = u.pn * BM + wc * 32 + 8 * fq;
#pragma unroll
        for (int ai = 0; ai < 2; ++ai)
#pragma unroll
            for (int m = 0; m < 4; ++m) { bf16_t* rowp = O + (size_t)(row0 + ai * HALF + m * 16) * ldc + col0;
#pragma unroll
                for (int bj = 0; bj < 2; ++bj) { const f32x4 v0 = acc[ai][bj][m][0], v1 = acc[ai][bj][m][1];
                    u32x4 w; w.x = cvt_pk_bf16(v0[0], v0[1]); w.y = cvt_pk_bf16(v0[2], v0[3]); w.z = cvt_pk_bf16(v1[0], v1[1]); w.w = cvt_pk_bf16(v1[2], v1[3]);
                    *(u32x4*)(rowp + bj * HALF) = w; } }
    }
};
struct EpiBf16QK {
    static constexpr bool PERM = true, AFTER_DRAIN = false;
    bf16_t* O; int ldc; int q_lo, q_hi, k_lo, k_hi; const float* gq; const float* gk; float qmul; PG8_LAS float* xs;
    __device__ __forceinline__ void operator()(const f32x4 (&acc)[2][2][4][2], const Unit& u, int wr, int wc, int fr, int fq) const {
        const int row0 = u.pm * BM + wr * 64 + fr; const int col0 = u.pn * BM + wc * 32 + 8 * fq;
        const bool isq = u.pn >= q_lo && u.pn < q_hi, isk = u.pn >= k_lo && u.pn < k_hi;
        if (!(isq || isk)) {
#pragma unroll
            for (int ai = 0; ai < 2; ++ai)
#pragma unroll
                for (int m = 0; m < 4; ++m) { bf16_t* rowp = O + (size_t)(row0 + ai * HALF + m * 16) * ldc + col0;
#pragma unroll
                    for (int bj = 0; bj < 2; ++bj) { const f32x4 v0 = acc[ai][bj][m][0], v1 = acc[ai][bj][m][1];
                        u32x4 w; w.x = cvt_pk_bf16(v0[0], v0[1]); w.y = cvt_pk_bf16(v0[2], v0[3]); w.z = cvt_pk_bf16(v1[0], v1[1]); w.w = cvt_pk_bf16(v1[2], v1[3]);
                        *(u32x4*)(rowp + bj * HALF) = w; } }
            return;
        }
        float ssq[2][4][2];
#pragma unroll
        for (int ai = 0; ai < 2; ++ai)
#pragma unroll
            for (int m = 0; m < 4; ++m)
#pragma unroll
                for (int bj = 0; bj < 2; ++bj) { const f32x4 v0 = acc[ai][bj][m][0], v1 = acc[ai][bj][m][1];
                    float s = (v0[0] * v0[0] + v0[1] * v0[1]) + (v0[2] * v0[2] + v0[3] * v0[3]) + (v1[0] * v1[0] + v1[1] * v1[1]) + (v1[2] * v1[2] + v1[3] * v1[3]);
                    s += __shfl_xor(s, 16); s += __shfl_xor(s, 32); ssq[ai][m][bj] = s;
                    if (fq == 0) xs[(ai * HALF + wr * 64 + m * 16 + fr) * 8 + bj * 4 + wc] = s; }
        asm volatile("s_waitcnt lgkmcnt(0)" ::: "memory"); __builtin_amdgcn_s_barrier(); asm volatile("" ::: "memory");
        const float* g = isq ? gq : gk; const float gm = isq ? qmul : 1.f;
        const int d0 = (wc & 1) * 32 + 8 * fq;
        const f32x4 g0 = *(const f32x4*)(g + d0) * gm, g1 = *(const f32x4*)(g + d0 + 4) * gm;
#pragma unroll
        for (int ai = 0; ai < 2; ++ai)
#pragma unroll
            for (int m = 0; m < 4; ++m) { bf16_t* rowp = O + (size_t)(row0 + ai * HALF + m * 16) * ldc + col0;
#pragma unroll
                for (int bj = 0; bj < 2; ++bj) { const float tot = ssq[ai][m][bj] + xs[(ai * HALF + wr * 64 + m * 16 + fr) * 8 + bj * 4 + (wc ^ 1)];
                    const float rs = __builtin_amdgcn_rsqf(tot * (1.f / 64.f) + 1e-6f);
                    const f32x4 v0 = acc[ai][bj][m][0] * rs * g0, v1 = acc[ai][bj][m][1] * rs * g1;
                    u32x4 w; w.x = cvt_pk_bf16(v0[0], v0[1]); w.y = cvt_pk_bf16(v0[2], v0[3]); w.z = cvt_pk_bf16(v1[0], v1[1]); w.w = cvt_pk_bf16(v1[2], v1[3]);
                    *(u32x4*)(rowp + bj * HALF) = w; } }
    }
};
struct EpiBf16RS {
    static constexpr bool PERM = true, AFTER_DRAIN = false;
    bf16_t* O; int ldc; const float* rss; const float* bias; int bias_stride;
    __device__ __forceinline__ void operator()(const f32x4 (&acc)[2][2][4][2], const Unit& u, int wr, int wc, int fr, int fq) const {
        const int row0 = u.pm * BM + wr * 64 + fr; const int col0 = u.pn * BM + wc * 32 + 8 * fq; const int b = (u.pm * BM) >> 13;
        f32x4 bv[2][2];
#pragma unroll
        for (int bj = 0; bj < 2; ++bj)
#pragma unroll
            for (int n = 0; n < 2; ++n) bv[bj][n] = *(const f32x4*)(bias + (size_t)b * bias_stride + col0 + bj * HALF + 4 * n);
#pragma unroll
        for (int ai = 0; ai < 2; ++ai)
#pragma unroll
            for (int m = 0; m < 4; ++m) { const int row = row0 + ai * HALF + m * 16; bf16_t* rowp = O + (size_t)row * ldc + col0;
                const f32x4 p0 = *(const f32x4*)(rss + (size_t)row * 16), p1 = *(const f32x4*)(rss + (size_t)row * 16 + 4), p2 = *(const f32x4*)(rss + (size_t)row * 16 + 8), p3 = *(const f32x4*)(rss + (size_t)row * 16 + 12);
                const f32x4 pt = (p0 + p1) + (p2 + p3);
                const float rs = __builtin_amdgcn_rsqf(((pt[0] + pt[1]) + (pt[2] + pt[3])) * (1.f / 1024.f) + 1e-6f);
#pragma unroll
                for (int bj = 0; bj < 2; ++bj) { const f32x4 v0 = acc[ai][bj][m][0] * rs + bv[bj][0], v1 = acc[ai][bj][m][1] * rs + bv[bj][1];
                    u32x4 w; w.x = cvt_pk_bf16(v0[0], v0[1]); w.y = cvt_pk_bf16(v0[2], v0[3]); w.z = cvt_pk_bf16(v1[0], v1[1]); w.w = cvt_pk_bf16(v1[2], v1[3]);
                    *(u32x4*)(rowp + bj * HALF) = w; } }
    }
};
template <bool BASE_BF16> struct EpiResid {
    static constexpr bool PERM = true, AFTER_DRAIN = false;
    const void* base; bf16_t* out; const float* gate;
    __device__ __forceinline__ void operator()(const f32x4 (&acc)[2][2][4][2], const Unit& u, int wr, int wc, int fr, int fq) const {
        const int row0 = u.pm * BM + wr * 64 + fr; const int col0 = u.pn * BM + wc * 32 + 8 * fq; const int b = (u.pm * BM) >> 13;
        f32x4 gv[2][2];
#pragma unroll
        for (int bj = 0; bj < 2; ++bj)
#pragma unroll
            for (int n = 0; n < 2; ++n) gv[bj][n] = *(const f32x4*)(gate + (size_t)b * 6144 + col0 + bj * HALF + 4 * n);
#pragma unroll
        for (int ai = 0; ai < 2; ++ai)
#pragma unroll
            for (int m = 0; m < 4; ++m)
#pragma unroll
                for (int bj = 0; bj < 2; ++bj) { const size_t off = (size_t)(row0 + ai * HALF + m * 16) * 1024 + col0 + bj * HALF;
                    f32x4 b0, b1;
                    if (BASE_BF16) { const u32x4 w = *(const u32x4*)((const bf16_t*)base + off); const unsigned w0 = w.x, w1 = w.y, w2 = w.z, w3 = w.w;
                        b0 = (f32x4){__builtin_bit_cast(float, w0 << 16), __builtin_bit_cast(float, w0 & 0xffff0000u), __builtin_bit_cast(float, w1 << 16), __builtin_bit_cast(float, w1 & 0xffff0000u)};
                        b1 = (f32x4){__builtin_bit_cast(float, w2 << 16), __builtin_bit_cast(float, w2 & 0xffff0000u), __builtin_bit_cast(float, w3 << 16), __builtin_bit_cast(float, w3 & 0xffff0000u)}; }
                    else { b0 = *(const f32x4*)((const float*)base + off); b1 = *(const f32x4*)((const float*)base + off + 4); }
                    const f32x4 o0 = b0 + gv[bj][0] * acc[ai][bj][m][0], o1 = b1 + gv[bj][1] * acc[ai][bj][m][1];
                    u32x4 ow; ow.x = cvt_pk_bf16(o0[0], o0[1]); ow.y = cvt_pk_bf16(o0[2], o0[3]); ow.z = cvt_pk_bf16(o1[0], o1[1]); ow.w = cvt_pk_bf16(o1[2], o1[3]);
                    *(u32x4*)(out + off) = ow; }
    }
};

template <class Epi, class Sched, bool ALIGN_EPI = false, bool SP2 = false>
__device__ __forceinline__ void gemm_phase(PG8_LAS unsigned char* lds, const Gemm g, const Sched& S, const Epi& E) {
    const int tid = threadIdx.x, wid = __builtin_amdgcn_readfirstlane(tid >> 6), lane = tid & 63, wr = wid >> 2, wc = wid & 3, fr = lane & 15, fq = lane >> 4;
    const int K = g.K, nt = K / BK;
    unsigned voffA[2], voffB[2];
#pragma unroll
    for (int i = 0; i < 2; ++i) { int R, C; stage_rc(tid * 16 + i * 8192, R, C); const int Rb = Epi::PERM ? ((R & ~31) + perm32(R & 31)) : R;
        voffA[i] = (unsigned)(R * K + C) * 2u; voffB[i] = (unsigned)(Rb * K + C) * 2u; }
    const size_t kstep = (size_t)(BK * 2);
    const size_t hstep = (size_t)HALF * K * 2;
    const size_t tstep = 2 * hstep;
    const unsigned ldsw = (unsigned)wid * 1024u;
    const int aoff = lds_byte(wr * 64 + fr, fq * 8), boff = lds_byte(wc * 32 + fr, fq * 8);
#define PG8_SA(b, h) (((b) * 2 + (h)) * HTB)
#define PG8_SB(b, h) ((4 + (b) * 2 + (h)) * HTB)
#define PG8_STAGE(bufoff, gbase, voff) do { _Pragma("unroll") for (int _i = 0; _i < 2; ++_i) \
        __builtin_amdgcn_global_load_lds((const unsigned*)((const char*)(gbase) + (voff)[_i]), (PG8_LAS unsigned*)(lds + (bufoff) + ldsw + _i * 8192), 16, 0, 0); } while (0)
#define PG8_LDA(dst, b, h) do { _Pragma("unroll") for (int m = 0; m < 4; ++m) _Pragma("unroll") for (int k = 0; k < 2; ++k) dst[m][k] = *(const PG8_LAS bf16x8*)(lds + PG8_SA(b, h) + aoff + m * 2048 + k * 1024); } while (0)
#define PG8_LDB(dst, b, h) do { _Pragma("unroll") for (int n = 0; n < 2; ++n) _Pragma("unroll") for (int k = 0; k < 2; ++k) dst[n][k] = *(const PG8_LAS bf16x8*)(lds + PG8_SB(b, h) + boff + n * 2048 + k * 1024); } while (0)
#define PG8_MMA(ai, bj, At, Bt) do { __builtin_amdgcn_s_setprio(1); _Pragma("unroll") for (int m = 0; m < 4; ++m) _Pragma("unroll") for (int n = 0; n < 2; ++n) _Pragma("unroll") for (int k = 0; k < 2; ++k) \
        acc[ai][bj][m][n] = __builtin_amdgcn_mfma_f32_16x16x32_bf16(Bt[n][k], At[m][k], acc[ai][bj][m][n], 0, 0, 0); __builtin_amdgcn_s_setprio(0); } while (0)
#define PG8_WAIT_V(n) asm volatile("s_waitcnt vmcnt(" #n ")" ::: "memory")
#define PG8_WAIT_L(n) asm volatile("s_waitcnt lgkmcnt(" #n ")" ::: "memory")
#define PG8_BAR __builtin_amdgcn_s_barrier()
#define PG8_SCHED __builtin_amdgcn_sched_barrier(0)
    Unit cur, nxt; int ui = 0;
    if (!S.next(0, cur)) return;
    f32x4 acc[2][2][4][2];
#pragma unroll
    for (int a = 0; a < 2; ++a)
#pragma unroll
        for (int b = 0; b < 2; ++b)
#pragma unroll
            for (int m = 0; m < 4; ++m)
#pragma unroll
                for (int n = 0; n < 2; ++n) acc[a][b][m][n] = (f32x4){0.f, 0.f, 0.f, 0.f};
    bf16x8 At[4][2], B0[2][2], B1[2][2];
    const char* cA = (const char*)g.A + (size_t)cur.pm * tstep; const char* cB = (const char*)g.Bt + (size_t)(cur.pm >> 5) * g.bstride + (size_t)cur.pn * tstep;
    S.a_ready(cur);
    if constexpr (SP2) {
        PG8_STAGE(PG8_SB(0, 0), cB, voffB); PG8_STAGE(PG8_SB(0, 1), cB + hstep, voffB); PG8_STAGE(PG8_SA(0, 0), cA, voffA); PG8_STAGE(PG8_SA(0, 1), cA + hstep, voffA);
        if (wr == 1) PG8_BAR;
        PG8_WAIT_V(2); PG8_BAR;
        PG8_STAGE(PG8_SB(1, 0), cB + kstep, voffB); PG8_STAGE(PG8_SA(1, 0), cA + kstep, voffA); PG8_STAGE(PG8_SB(1, 1), cB + hstep + kstep, voffB);
        PG8_WAIT_V(6); PG8_BAR;
    } else {
        PG8_STAGE(PG8_SB(0, 0), cB, voffB); PG8_STAGE(PG8_SA(0, 0), cA, voffA); PG8_STAGE(PG8_SB(0, 1), cB + hstep, voffB); PG8_STAGE(PG8_SA(0, 1), cA + hstep, voffA);
        if (wr == 1) PG8_BAR;
        PG8_WAIT_V(4); PG8_BAR;
        PG8_STAGE(PG8_SB(1, 0), cB + kstep, voffB); PG8_STAGE(PG8_SA(1, 0), cA + kstep, voffA); PG8_STAGE(PG8_SB(1, 1), cB + hstep + kstep, voffB);
        PG8_WAIT_V(6); PG8_BAR;
    }
    for (;;) {
        const bool has_next = S.next(ui + 1, nxt);
        const char* nA = has_next ? (const char*)g.A + (size_t)nxt.pm * tstep : cA; const char* nB = has_next ? (const char*)g.Bt + (size_t)(nxt.pm >> 5) * g.bstride + (size_t)nxt.pn * tstep : cB;
        for (int t = 0; t < nt; t += 2) {
            const bool last = (t == nt - 2);
            const char* a1 = cA + (size_t)(t + 1) * kstep;
            const char* a2 = last ? nA : cA + (size_t)(t + 2) * kstep; const char* b2 = last ? nB : cB + (size_t)(t + 2) * kstep;
            const char* a3 = a2 + kstep; const char* b3 = b2 + kstep;
            if (last && has_next) S.a_ready(nxt);
            if constexpr (SP2) {
            PG8_LDB(B0, 0, 0); PG8_LDB(B1, 0, 1); PG8_SCHED; PG8_LDA(At, 0, 0); PG8_STAGE(PG8_SA(1, 1), a1 + hstep, voffA);
            PG8_WAIT_V(8); PG8_WAIT_L(0); PG8_BAR; PG8_MMA(0, 0, At, B0); PG8_MMA(0, 1, At, B1); PG8_BAR; PG8_SCHED;
            PG8_LDA(At, 0, 1); PG8_STAGE(PG8_SB(0, 0), b2, voffB); PG8_STAGE(PG8_SB(0, 1), b2 + hstep, voffB); PG8_STAGE(PG8_SA(0, 0), a2, voffA);
            PG8_WAIT_V(8); PG8_WAIT_L(0); PG8_BAR; PG8_MMA(1, 0, At, B0); PG8_MMA(1, 1, At, B1); PG8_BAR; PG8_SCHED;
            PG8_LDB(B0, 1, 0); PG8_LDB(B1, 1, 1); PG8_SCHED; PG8_LDA(At, 1, 0); PG8_STAGE(PG8_SA(0, 1), a2 + hstep, voffA);
            PG8_WAIT_V(8); PG8_WAIT_L(0); PG8_BAR; PG8_MMA(0, 0, At, B0); PG8_MMA(0, 1, At, B1); PG8_BAR; PG8_SCHED;
            PG8_LDA(At, 1, 1); PG8_STAGE(PG8_SB(1, 0), b3, voffB); PG8_STAGE(PG8_SB(1, 1), b3 + hstep, voffB); PG8_STAGE(PG8_SA(1, 0), a3, voffA);
            PG8_WAIT_V(8); PG8_WAIT_L(0); PG8_BAR; PG8_MMA(1, 0, At, B0); PG8_MMA(1, 1, At, B1); PG8_BAR; PG8_SCHED;
            } else {
            PG8_LDB(B0, 0, 0); PG8_SCHED; PG8_LDA(At, 0, 0); PG8_STAGE(PG8_SA(1, 1), a1 + hstep, voffA);
            PG8_WAIT_L(8); PG8_BAR; PG8_WAIT_L(0); PG8_MMA(0, 0, At, B0); PG8_BAR; PG8_SCHED;
            PG8_LDB(B1, 0, 1); PG8_STAGE(PG8_SB(0, 0), b2, voffB);
            PG8_BAR; PG8_WAIT_L(0); PG8_MMA(0, 1, At, B1); PG8_BAR;
            PG8_LDA(At, 0, 1); PG8_STAGE(PG8_SA(0, 0), a2, voffA);
            PG8_BAR; PG8_WAIT_L(0); PG8_MMA(1, 0, At, B0); PG8_BAR; PG8_SCHED;
            PG8_STAGE(PG8_SB(0, 1), b2 + hstep, voffB);
            PG8_WAIT_V(6); PG8_BAR; PG8_MMA(1, 1, At, B1); PG8_BAR;
            PG8_LDB(B0, 1, 0); PG8_SCHED; PG8_LDA(At, 1, 0); PG8_STAGE(PG8_SA(0, 1), a2 + hstep, voffA);
            PG8_WAIT_L(8); PG8_BAR; PG8_WAIT_L(0); PG8_MMA(0, 0, At, B0); PG8_BAR; PG8_SCHED;
            PG8_LDB(B1, 1, 1); PG8_STAGE(PG8_SB(1, 0), b3, voffB);
            PG8_BAR; PG8_WAIT_L(0); PG8_MMA(0, 1, At, B1); PG8_BAR;
            PG8_LDA(At, 1, 1); PG8_STAGE(PG8_SA(1, 0), a3, voffA);
            PG8_BAR; PG8_WAIT_L(0); PG8_MMA(1, 0, At, B0); PG8_BAR; PG8_SCHED;
            PG8_STAGE(PG8_SB(1, 1), b3 + hstep, voffB);
            PG8_WAIT_V(6); PG8_BAR; PG8_MMA(1, 1, At, B1); PG8_BAR;
            }
        }
        if constexpr (ALIGN_EPI) { if (wr == 0) PG8_BAR; }
        if constexpr (!Epi::AFTER_DRAIN) { E(acc, cur, wr, wc, fr, fq); S.done(cur); }
        if (!has_next) break;
#pragma unroll
        for (int a = 0; a < 2; ++a)
#pragma unroll
            for (int b = 0; b < 2; ++b)
#pragma unroll
                for (int m = 0; m < 4; ++m)
#pragma unroll
                    for (int n = 0; n < 2; ++n) acc[a][b][m][n] = (f32x4){0.f, 0.f, 0.f, 0.f};
        cur = nxt; cA = nA; cB = nB; ++ui;
        if constexpr (ALIGN_EPI) { if (wr == 1) PG8_BAR; }
    }
    PG8_WAIT_V(0);
    if constexpr (!ALIGN_EPI) { if (wr == 0) PG8_BAR; }
    PG8_BAR;
    if constexpr (Epi::AFTER_DRAIN) { E.fused(acc, cur, wr, wc, fr, fq, lds, wid, lane); S.done(cur); }
#undef PG8_SA
#undef PG8_SB
#undef PG8_STAGE
#undef PG8_LDA
#undef PG8_LDB
#undef PG8_MMA
#undef PG8_WAIT_V
#undef PG8_WAIT_L
#undef PG8_BAR
#undef PG8_SCHED
}
}
constexpr int NB = 4, SEQ = 8192, D = 1024, M = NB * SEQ;
constexpr int NZ0 = 3584, NZ1 = 3072, NQ = 2048, SRC_IN0 = 3592;
constexpr float EPS = 1e-6f;
constexpr int NWAVES = 8, NTHR = 512;
constexpr float LOG2E = 1.4426950408889634f;
constexpr size_t MiB = 1u << 20;
constexpr size_t WS_CTL = 0, CTL_ZERO_BYTES = 1 * MiB;
constexpr size_t WS_WIN0 = 1 * MiB, WS_WOUT0 = 8 * MiB, WS_WIN1 = 10 * MiB, WS_WOUT1 = 16 * MiB, WS_WQ = 18 * MiB;
constexpr size_t WS_KEYS = 26 * MiB, WS_MOD = WS_KEYS + 128 * 1024, WS_KMEAN = WS_MOD + 192 * 1024, WS_NLOC = WS_KMEAN + 256 * 1024,
                 WS_BEND = WS_NLOC + 512 * 1024, WS_MLOC = WS_BEND + 4096, WS_MPREV = WS_MLOC + 4096,
                 WS_ISU = 27 * MiB + 512 * 1024, WS_ISV = WS_ISU + 128 * 1024, WS_ORD = WS_ISV + 128 * 1024  ,
                 WS_QB = WS_ORD + 8 * 1024  , WS_GTAB = WS_QB + 64 * 1024  ;
constexpr size_t WS_GATES = 28 * MiB;
constexpr size_t WS_UB = 32 * MiB  , WS_VB = 64 * MiB, WS_ACT = 96 * MiB  , WS_ACTS = 100 * MiB  , WS_WQF = 112 * MiB  , WS_XNY = 160 * MiB, WS_Z = 224 * MiB, WS_CLOC = 448 * MiB, WS_END = 512 * MiB;
constexpr size_t WS_QRY = WS_Z, WS_IDX = WS_Z + 128 * MiB, WS_GATE = WS_Z + 144 * MiB, WS_PART = WS_Z  , WS_XS = 448 * MiB  ;
constexpr size_t WS_RSS = 104 * MiB;
constexpr int CW_BAR = 4096, CW_QMOBA = 8192  , CW_QDIFF = 8448, CW_QCVT0 = 8704, CW_QCVT1 = 8768, CW_SCANF = 8832  , CW_QMLC = 9216  ;
constexpr float ALIBI_MARGIN = 27.03f;
constexpr int RING_BYTES = 139264;
constexpr int LDSCTL_OFF = RING_BYTES, MISC_OFF = LDSCTL_OFF + 320;
constexpr int LDS_BYTES = 147456;
static_assert(MISC_OFF + 128 <= LDS_BYTES, "LDS map");

#define GAS __attribute__((address_space(1)))
#define LAS __attribute__((address_space(3)))
typedef unsigned short bf16;
typedef unsigned v4u __attribute__((ext_vector_type(4)));
typedef unsigned v2u __attribute__((ext_vector_type(2)));
typedef float f32x4 __attribute__((ext_vector_type(4)));
typedef float f32x16 __attribute__((ext_vector_type(16)));
typedef short bf16x8 __attribute__((ext_vector_type(8)));
typedef short s16x4 __attribute__((ext_vector_type(4)));
typedef GAS unsigned gu32;
#define RLX_AGENT __ATOMIC_RELAXED, __HIP_MEMORY_SCOPE_AGENT
#define LDS_WAIT() asm volatile("s_waitcnt lgkmcnt(0)" ::: "memory")
#define VM_WAIT() asm volatile("s_waitcnt vmcnt(0)" ::: "memory")
__device__ __forceinline__ unsigned f2bf(float f) { unsigned u = __builtin_bit_cast(unsigned, f); return (u + 0x7fffu + ((u >> 16) & 1u)) >> 16; }
__device__ __forceinline__ unsigned pk2(float lo, float hi) { return f2bf(lo) | (f2bf(hi) << 16); }
__device__ __forceinline__ float bflo(unsigned w) { return __builtin_bit_cast(float, w << 16); }
__device__ __forceinline__ float bfhi(unsigned w) { return __builtin_bit_cast(float, w & 0xffff0000u); }
__device__ __forceinline__ float bf2f(bf16 h) { return __builtin_bit_cast(float, (unsigned)h << 16); }
__device__ __forceinline__ unsigned f2u(float x) { return __builtin_bit_cast(unsigned, x); }
__device__ __forceinline__ float u2f(unsigned x) { return __builtin_bit_cast(float, x); }
__device__ __forceinline__ float dot2bf(unsigned a, unsigned b, float acc) { typedef __bf16 bf2_ __attribute__((ext_vector_type(2))); return __builtin_amdgcn_fdot2_f32_bf16(__builtin_bit_cast(bf2_, a), __builtin_bit_cast(bf2_, b), acc, false); }
__device__ __forceinline__ unsigned f2h2(float lo, float hi) { typedef _Float16 h2_ __attribute__((ext_vector_type(2))); typedef float f2_ __attribute__((ext_vector_type(2))); f2_ v = {lo, hi}; h2_ h = __builtin_convertvector(v, h2_); return __builtin_bit_cast(unsigned, h); }
__device__ __forceinline__ float h2f_lo(unsigned w) { return (float)__builtin_bit_cast(_Float16, (unsigned short)(w & 0xffffu)); }
__device__ __forceinline__ float h2f_hi(unsigned w) { return (float)__builtin_bit_cast(_Float16, (unsigned short)(w >> 16)); }
__device__ __forceinline__ float wave_sum(float v) {
#pragma unroll
    for (int o = 1; o < 64; o <<= 1) v += __shfl_xor(v, o);
    return v;
}
__device__ __forceinline__ float wave_max(float v) {
#pragma unroll
    for (int o = 1; o < 64; o <<= 1) v = fmaxf(v, __shfl_xor(v, o));
    return v;
}
__device__ __forceinline__ float silu_f(float x) { return x / (1.f + __expf(-x)); }
__device__ __forceinline__ float sigmoid_f(float x) { return 1.f / (1.f + __expf(-x)); }
__device__ __forceinline__ float logsigmoid_f(float x) { return fminf(x, 0.f) - log1pf(__expf(-fabsf(x))); }
struct Args { const float* in[24]; float* out; unsigned char* ws; int ph_lo, ph_hi; };
#define XB_TMO      128
#define XB_XCNT(j)  (256  + 64 * (j))
#define XB_XSUB(j)  (1280 + 64 * (j))
#define XB_XGEN(j)  (2304 + 64 * (j))
#define XB_TOP      3328
#define XB_TOPGEN   3392
#define XCD_BAR_WORDS 3456
#define XB_SPIN_CAP (1u << 18)

__device__ __forceinline__ unsigned xb_ld(unsigned* p)              { return __hip_atomic_load(p, __ATOMIC_RELAXED, __HIP_MEMORY_SCOPE_AGENT); }
__device__ __forceinline__ unsigned xb_add(unsigned* p, unsigned v) { return __hip_atomic_fetch_add(p, v, __ATOMIC_RELAXED, __HIP_MEMORY_SCOPE_AGENT); }
__device__ __forceinline__ unsigned xb_xcc_id() { return (unsigned)__builtin_amdgcn_s_getreg((3 << 11) | 20) & 0xFu; }
#define XB_SPIN(cond, bar) do { unsigned _sp = 0; while (cond) { __builtin_amdgcn_s_sleep(1); \
    if ((++_sp & 255u) == 0u) { if (xb_ld(&(bar)[XB_TMO])) break; if (_sp > XB_SPIN_CAP) { atomicAdd(&(bar)[XB_TMO], 1u); break; } } } } while (0)

struct XcdBarrier {
    unsigned* bar; unsigned x;
    volatile LAS unsigned* st;
};

__device__ __forceinline__ XcdBarrier xcd_barrier_post(unsigned* bar, volatile LAS unsigned* st) {
    XcdBarrier b; b.bar = bar; b.x = xb_xcc_id(); b.st = st;
    if (threadIdx.x == 0) (void)xb_add(&bar[XB_XCNT(b.x)], 1u);
    return b;
}
__device__ __forceinline__ void xcd_barrier_complete(unsigned* bar, unsigned x, unsigned& nloc, unsigned& nx) {
    const unsigned G = gridDim.x * gridDim.y * gridDim.z;
    unsigned sum, cnt, mine, sp = 0u;
    for (;;) {
        sum = 0u; cnt = 0u; mine = 0u;
#pragma unroll
        for (unsigned j = 0; j < 16; ++j) { const unsigned c = xb_ld(&bar[XB_XCNT(j)]); sum += c; cnt += (c > 0u) ? 1u : 0u; mine = (j == x) ? c : mine; }
        if (sum == G) break;
        __builtin_amdgcn_s_sleep(1);
        if ((++sp & 255u) == 0u) { if (xb_ld(&bar[XB_TMO])) break; if (sp > XB_SPIN_CAP) { atomicAdd(&bar[XB_TMO], 1u); break; } }
    }
    nloc = mine > 0u ? mine : 1u; nx = cnt > 0u ? cnt : 1u;
}

__device__ __forceinline__ void xcd_barrier(const XcdBarrier& b) {
    asm volatile("s_waitcnt vmcnt(0)" ::: "memory");
    __syncthreads();
    if (threadIdx.x == 0) {
        unsigned* bar = b.bar;
        __builtin_amdgcn_s_waitcnt(0);
        unsigned nloc = b.st[0], nx = b.st[1];
        if (nloc == 0u) { xcd_barrier_complete(bar, b.x, nloc, nx); b.st[0] = nloc; b.st[1] = nx; }
        const unsigned old = xb_add(&bar[XB_XSUB(b.x)], 1u);
        const unsigned gen = old / nloc;
        if (old + 1u == (gen + 1u) * nloc) {
            __builtin_amdgcn_fence(__ATOMIC_RELEASE, "agent");
            asm volatile("s_waitcnt vmcnt(0)" ::: "memory");
            const unsigned og = xb_add(&bar[XB_TOP], 1u);
            const unsigned tg = og / nx;
            if (og + 1u == (tg + 1u) * nx) xb_add(&bar[XB_TOPGEN], 1u);
            else XB_SPIN(xb_ld(&bar[XB_TOPGEN]) == tg, bar);
            __builtin_amdgcn_fence(__ATOMIC_ACQUIRE, "agent");
            xb_add(&bar[XB_XGEN(b.x)], 1u);
            asm volatile("s_waitcnt vmcnt(0)" ::: "memory");
        } else {
            XB_SPIN(xb_ld(&bar[XB_XGEN(b.x)]) == gen, bar);
            __builtin_amdgcn_fence(__ATOMIC_ACQUIRE, "agent");
            asm volatile("s_waitcnt vmcnt(0)" ::: "memory");
        }
    }
    __syncthreads();
}
struct Frame {
    LAS unsigned char* lds;
    int wave, G, bid;
    float* out; unsigned char* ws;
};
#define WSP(T, off) ((T*)(F.ws + (off)))

__device__ __forceinline__ void p0_transpose_item(const float* W, int K, int ldw, int nblk, int thr, int shift, bf16* WT, LAS float* scr, int item, int lane) {
    const int kb = item / nblk, nb = item % nblk, k0 = 64 * kb, n0 = 32 * nb, ns = n0 + (n0 >= thr ? shift : 0);
#pragma unroll 8
    for (int i = 0; i < 32; ++i) { const int kk = 2 * i + (lane >> 5); scr[kk * 33 + (lane & 31)] = W[(size_t)(k0 + kk) * ldw + ns + (lane & 31)]; }
    LDS_WAIT(); asm volatile("" ::: "memory");
    const int c = lane & 7;
#pragma unroll
    for (int j = 0; j < 4; ++j) { const int n = (lane >> 3) + 8 * j; const LAS float* s = scr + (8 * c) * 33 + n;
        v4u o; o.x = pk2(s[0 * 33], s[1 * 33]); o.y = pk2(s[2 * 33], s[3 * 33]); o.z = pk2(s[4 * 33], s[5 * 33]); o.w = pk2(s[6 * 33], s[7 * 33]);
        *(GAS v4u*)(WT + (size_t)(n0 + n) * K + k0 + 8 * c) = o; }
    LDS_WAIT(); asm volatile("" ::: "memory");
}
__device__ __forceinline__ void cvt_f32_bf16_stream(const float* src, bf16* dst, size_t n8, size_t gtid, size_t gthreads) {
    for (size_t i = gtid; i < n8; i += gthreads) {
        const f32x4 a = *(const GAS f32x4*)(src + i * 8), b = *(const GAS f32x4*)(src + i * 8 + 4);
        v4u o; o.x = pk2(a.x, a.y); o.y = pk2(a.z, a.w); o.z = pk2(b.x, b.y); o.w = pk2(b.z, b.w);
        *(GAS v4u*)(dst + i * 8) = o; }
}
__device__ __forceinline__ void i8_row(const float* src_row, unsigned char* dst  , float* scale  , int er, int lane) {
    const float* r = src_row + 16 * lane;
    float x[16];
#pragma unroll
    for (int q4 = 0; q4 < 4; ++q4) { const f32x4 a = *(const GAS f32x4*)(r + 4 * q4); x[4 * q4] = a.x; x[4 * q4 + 1] = a.y; x[4 * q4 + 2] = a.z; x[4 * q4 + 3] = a.w; }
    float am = 0.f;
#pragma unroll
    for (int i = 0; i < 16; ++i) am = fmaxf(am, fabsf(x[i]));
    am = wave_max(am);
    const float inv = am > 1e-30f ? 127.f / am : 0.f;
    unsigned wd[4];
#pragma unroll
    for (int q4 = 0; q4 < 4; ++q4) { unsigned w = 0;
#pragma unroll
        for (int e = 0; e < 4; ++e) { const int qv = (int)rintf(x[4 * q4 + e] * inv); w |= ((unsigned)qv & 0xffu) << (8 * e); }
        wd[q4] = w; }
    v4u o; o.x = wd[0]; o.y = wd[1]; o.z = wd[2]; o.w = wd[3];
    *(GAS v4u*)(dst + ((size_t)((lane >> 3) * 16384 + er)) * 128 + 16 * (lane & 7)) = o;
    if (lane == 0) scale[er] = am * (1.f / 127.f);
}
__device__ __forceinline__ void i8_chunk(Frame& F, const Args& A, int layer, int c) {
    const int tbl = c >> 8, row0 = (c & 255) * 64 + F.wave * 8;
    const float* src = A.in[22 + tbl] + (size_t)layer * 16384 * 1024;
    unsigned char* dst = F.ws + (tbl ? WS_VB : WS_UB) + (size_t)layer * 8 * 16384 * 128;
    float* sc = WSP(float, tbl ? WS_ISV : WS_ISU) + layer * 16384;
    for (int i = 0; i < 8; ++i) i8_row(src + (size_t)(row0 + i) * 1024, dst, sc, row0 + i, ((int)(threadIdx.x & 63u)));
}
__device__ __forceinline__ void p0_prologue(Frame& F, const Args& A) {
    {
        const float* c = A.in[1]; const float* aw = A.in[2]; const float* ab = A.in[3]; float* MOD = WSP(float, WS_MOD);
        LAS float* red = (LAS float*)F.lds;
        for (int item = F.bid; item < 192; item += F.G) {
            const int l = item / 96, n0 = (item % 96) * 64;
            float acc[4] = {0.f, 0.f, 0.f, 0.f};
            const int kbeg = F.wave * 128;
#pragma unroll 4
            for (int k = kbeg; k < kbeg + 128; ++k) {
                const float wv = aw[((size_t)l * 1024 + k) * 6144 + n0 + ((int)(threadIdx.x & 63u))];
#pragma unroll
                for (int b = 0; b < 4; ++b) acc[b] += silu_f(c[b * 1024 + k]) * wv;
            }
#pragma unroll
            for (int b = 0; b < 4; ++b) red[(F.wave * 4 + b) * 64 + ((int)(threadIdx.x & 63u))] = acc[b];
            __syncthreads();
            if (((int)threadIdx.x) < 256) { const int b = ((int)threadIdx.x) >> 6, ln = ((int)threadIdx.x) & 63; float s = ab[l * 6144 + n0 + ln];
#pragma unroll
                for (int w = 0; w < 8; ++w) s += red[(w * 4 + b) * 64 + ln];
                MOD[(size_t)(l * 4 + b) * 6144 + n0 + ln] = s; }
            __syncthreads();
        }
    }
    if (F.bid == 0) {
        LAS unsigned* hist = (LAS unsigned*)F.lds;
        unsigned short* ORD = WSP(unsigned short, WS_ORD);
        const int tid = (int)threadIdx.x;
        for (int pass = 0; pass < 2; ++pass) {
            const int nq = pass == 0 ? 64 : 32, nper = 4 * nq;
            for (int x = 0; x < 8; ++x) {
                if (tid < 160) hist[tid] = 0u;
                __syncthreads();
                int cost = 0, u = 0;
                if (tid < nper) {
                    const int hs = tid / nq, q = tid % nq, h = (x >> 2) ? (hs == 0 ? 6 : hs == 1 ? 5 : hs == 2 ? 1 : 0) : (hs == 0 ? 7 : hs == 1 ? 4 : hs == 2 ? 3 : 2), b = x & 3;
                    const float dcut = 46.f * (float)(2 << h);
                    if (pass == 0) { const int nt = 2 * q + 2; int lo = (int)ceilf(((float)(q * 128) - dcut - 63.f) * (1.f / 64.f)); if (lo < 0) lo = 0; cost = nt - lo; u = (b << 9) | (h << 6) | q; }
                    else { int lo = (int)ceilf(((float)(q * 256) - dcut - 255.f) * (1.f / 256.f)); if (lo < 0) lo = 0; int nb = q - lo; if (nb > 24) nb = 24; cost = 4 * (nb + 1); u = (b << 8) | (h << 5) | q; }
                    if (cost > 159) cost = 159;
                    atomicAdd((unsigned*)(hist + (159 - cost)), 1u);
                }
                __syncthreads();
                if (tid == 0) { unsigned acc = 0; for (int i = 0; i < 160; ++i) { const unsigned c = hist[i]; hist[i] = acc; acc += c; } }
                __syncthreads();
                if (tid < nper) { const unsigned pos = atomicAdd((unsigned*)(hist + (159 - cost)), 1u); ORD[(pass == 0 ? 0 : 2048) + x * nper + pos] = (unsigned short)u; }
                __syncthreads();
            }
        }
    }
    {
        LAS float* scr = (LAS float*)(F.lds + F.wave * 8704);
        const int gw = F.bid * NWAVES + F.wave, NGW = F.G * NWAVES;
        constexpr int I_IN0 = 16 * (NZ0 / 32), I_OUT = 16 * 32, I_IN1 = 16 * (NZ1 / 32), I_Q = 16 * (NQ / 32);
        constexpr int NITEMS = I_IN0 + 2 * I_OUT + I_IN1 + 2 * I_Q;
        for (int it = gw; it < NITEMS; it += NGW) {
            int r = it;
            if (r < I_IN0) { p0_transpose_item(A.in[6], D, SRC_IN0, NZ0 / 32, 2048, 8, WSP(bf16, WS_WIN0), scr, r, ((int)(threadIdx.x & 63u))); continue; } r -= I_IN0;
            if (r < I_OUT) { p0_transpose_item(A.in[13], D, D, 32, 1 << 30, 0, WSP(bf16, WS_WOUT0), scr, r, ((int)(threadIdx.x & 63u))); continue; } r -= I_OUT;
            if (r < I_IN1) { p0_transpose_item(A.in[14], D, NZ1, NZ1 / 32, 1 << 30, 0, WSP(bf16, WS_WIN1), scr, r, ((int)(threadIdx.x & 63u))); continue; } r -= I_IN1;
            if (r < I_OUT) { p0_transpose_item(A.in[19], D, D, 32, 1 << 30, 0, WSP(bf16, WS_WOUT1), scr, r, ((int)(threadIdx.x & 63u))); continue; } r -= I_OUT;
            if (r < I_Q) { p0_transpose_item(A.in[20], D, NQ, NQ / 32, 1 << 30, 0, WSP(bf16, WS_WQ), scr, r, ((int)(threadIdx.x & 63u))); continue; } r -= I_Q;
            p0_transpose_item(A.in[20] + (size_t)D * NQ, D, NQ, NQ / 32, 1 << 30, 0, WSP(bf16, WS_WQ) + (size_t)NQ * D, scr, r, ((int)(threadIdx.x & 63u)));
        }
    }
    {
        const size_t gtid = (size_t)F.bid * NTHR + ((int)threadIdx.x), gth = (size_t)F.G * NTHR;
        cvt_f32_bf16_stream(A.in[21], WSP(bf16, WS_KEYS), (size_t)2 * 2 * 128 * 128 / 8, gtid, gth);
    }
}

template <bool GATES, bool IN_BF16>
__device__ __forceinline__ void norm_pass(Frame& F, const Args& A, const void* X, const float* g, const float* mod, int shc, bf16* XN) {
    LAS float* wgT = (LAS float*)F.lds;
    if (GATES) {
        const float* win = A.in[6];
        for (int i = ((int)threadIdx.x); i < 8 * 1024; i += NTHR) { const int cg = i >> 10, k = i & 1023; wgT[i] = win[(size_t)k * SRC_IN0 + 2048 + cg]; }
        __syncthreads();
    }
    const int gw = F.bid * NWAVES + F.wave, NGW = F.G * NWAVES;
    for (int row = gw; row < M; row += NGW) {
        const int b = row >> 13;
        f32x4 v[4]; float ss = 0.f;
        if (IN_BF16) { const GAS v2u* xr = (const GAS v2u*)((const bf16*)X + (size_t)row * D) + ((int)(threadIdx.x & 63u));
#pragma unroll
            for (int j = 0; j < 4; ++j) { const v2u w = xr[64 * j]; const unsigned w0 = w.x, w1 = w.y; v[j] = (f32x4){bflo(w0), bfhi(w0), bflo(w1), bfhi(w1)}; }
        } else { const GAS f32x4* xr = (const GAS f32x4*)((const float*)X + (size_t)row * D) + ((int)(threadIdx.x & 63u));
#pragma unroll
            for (int j = 0; j < 4; ++j) v[j] = xr[64 * j]; }
#pragma unroll
        for (int j = 0; j < 4; ++j) ss += (v[j].x * v[j].x + v[j].y * v[j].y) + (v[j].z * v[j].z + v[j].w * v[j].w);
        const float rstd = rsqrtf(wave_sum(ss) * (1.f / D) + EPS);
        const float* shp = mod + (size_t)b * 6144 + shc * 1024; const float* scp = shp + 1024;
#pragma unroll
        for (int j = 0; j < 4; ++j) { const int c = 4 * ((int)(threadIdx.x & 63u)) + 256 * j;
            const f32x4 gg = *(const f32x4*)(g + c), sc = *(const f32x4*)(scp + c), sh = *(const f32x4*)(shp + c);
            v[j] = v[j] * rstd * gg * (sc + 1.f) + sh;
            v2u o; o.x = pk2(v[j].x, v[j].y); o.y = pk2(v[j].z, v[j].w);
            *(GAS v2u*)(XN + (size_t)row * D + c) = o; }
        if (GATES) {
            float* GT = WSP(float, WS_GATES);
#pragma unroll
            for (int cg = 0; cg < 8; ++cg) { float p = 0.f;
#pragma unroll
                for (int j = 0; j < 4; ++j) { const f32x4 w = *(const LAS f32x4*)(wgT + cg * 1024 + 4 * ((int)(threadIdx.x & 63u)) + 256 * j); p += (v[j].x * w.x + v[j].y * w.y) + (v[j].z * w.z + v[j].w * w.w); }
                p = wave_sum(p);
                if (((int)(threadIdx.x & 63u)) == 0) GT[(size_t)row * 8 + cg] = p + (cg < 4 ? A.in[8][cg] : A.in[9][cg - 4]); }
        }
    }
}

__device__ __forceinline__ void qknorm_unit(Frame& F, bf16* Z, int ldz, int row0, int col0, const float* g, float gmul, float* kmean  ) {
    const int c = col0 + 8 * ((int)(threadIdx.x & 63u)), d0 = (8 * ((int)(threadIdx.x & 63u))) & 63;
    float gv[8];
#pragma unroll
    for (int i = 0; i < 8; ++i) gv[i] = g[d0 + i] * gmul;
    float ks[8] = {0.f, 0.f, 0.f, 0.f, 0.f, 0.f, 0.f, 0.f};
    for (int r = 0; r < 32; ++r) {
        bf16* p = Z + (size_t)(row0 + F.wave * 32 + r) * ldz + c;
        const v4u w = *(const GAS v4u*)p;
        float x[8] = {bflo(w.x), bfhi(w.x), bflo(w.y), bfhi(w.y), bflo(w.z), bfhi(w.z), bflo(w.w), bfhi(w.w)};
        float ss = 0.f;
#pragma unroll
        for (int i = 0; i < 8; ++i) ss += x[i] * x[i];
        ss += __shfl_xor(ss, 1); ss += __shfl_xor(ss, 2); ss += __shfl_xor(ss, 4);
        const float rstd = rsqrtf(ss * (1.f / 64.f) + EPS);
#pragma unroll
        for (int i = 0; i < 8; ++i) { x[i] = x[i] * rstd * gv[i]; ks[i] += x[i]; }
        v4u o; o.x = pk2(x[0], x[1]); o.y = pk2(x[2], x[3]); o.z = pk2(x[4], x[5]); o.w = pk2(x[6], x[7]);
        *(GAS v4u*)p = o;
    }
    if (kmean) {
        LAS float* red = (LAS float*)F.lds;
#pragma unroll
        for (int i = 0; i < 8; ++i) red[F.wave * 512 + 8 * ((int)(threadIdx.x & 63u)) + i] = ks[i];
        __syncthreads();
        { float s = 0.f;
#pragma unroll
          for (int w = 0; w < 8; ++w) s += red[w * 512 + ((int)threadIdx.x)];
          kmean[(size_t)(((int)threadIdx.x) >> 6) * (32 * 64) + (((int)threadIdx.x) & 63)] = s * (1.f / 256.f); }
        __syncthreads();
    }
}

__device__ __forceinline__ void kmean_unit(Frame& F, const bf16* Z, int ldz, int row0, int col0, float* kmean) {
    const int c = col0 + 8 * ((int)(threadIdx.x & 63u));
    float ks[8] = {0.f, 0.f, 0.f, 0.f, 0.f, 0.f, 0.f, 0.f};
#pragma unroll 4
    for (int r = 0; r < 32; ++r) {
        const v4u w = *(const GAS v4u*)(Z + (size_t)(row0 + F.wave * 32 + r) * ldz + c);
        ks[0] += bflo(w.x); ks[1] += bfhi(w.x); ks[2] += bflo(w.y); ks[3] += bfhi(w.y); ks[4] += bflo(w.z); ks[5] += bfhi(w.z); ks[6] += bflo(w.w); ks[7] += bfhi(w.w);
    }
    LAS float* red = (LAS float*)F.lds;
#pragma unroll
    for (int i = 0; i < 8; ++i) red[F.wave * 512 + 8 * ((int)(threadIdx.x & 63u)) + i] = ks[i];
    __syncthreads();
    { float s = 0.f;
#pragma unroll
      for (int w = 0; w < 8; ++w) s += red[w * 512 + ((int)threadIdx.x)];
      kmean[(size_t)(((int)threadIdx.x) >> 6) * (32 * 64) + (((int)threadIdx.x) & 63)] = s * (1.f / 256.f); }
    __syncthreads();
}

constexpr int KSTRB = 144;
template <int DV> struct VStr { static constexpr int B = (DV == 64) ? 192 : 320; };
typedef short v4i16_t __attribute__((ext_vector_type(4)));
__device__ __forceinline__ s16x4 vtr(const LAS unsigned char* p) { return __builtin_bit_cast(s16x4, __builtin_amdgcn_ds_read_tr16_b64_v4i16((LAS v4i16_t*)p)); }
__device__ __forceinline__ unsigned cvtpk(float lo, float hi) { typedef float f2 __attribute__((ext_vector_type(2))); typedef __bf16 b2 __attribute__((ext_vector_type(2)));
    f2 v = {lo, hi}; b2 b = __builtin_convertvector(v, b2); return __builtin_bit_cast(unsigned, b); }
__device__ __forceinline__ float xhalf(float v) {
    auto rr = __builtin_amdgcn_permlane32_swap(__builtin_bit_cast(unsigned, v), __builtin_bit_cast(unsigned, v), false, false);
    const unsigned r0 = rr[0], r1 = rr[1]; return u2f((threadIdx.x & 32) ? r0 : r1);
}
template <int DV> struct AttnSt { f32x16 o[DV / 32]; float m, l; };
template <int DV> __device__ __forceinline__ void attn_init(AttnSt<DV>& st) {
#pragma unroll
    for (int t = 0; t < DV / 32; ++t)
#pragma unroll
        for (int r = 0; r < 16; ++r) st.o[t][r] = 0.f;
    st.m = -1e30f; st.l = 0.f;
}
template <int DV>
__device__ __forceinline__ void attn_qk(AttnSt<DV>& st, const LAS unsigned char* Kt, const bf16x8 (&qf)[4], float sl2, int tq, int kt0, bool diag, bool rowok, int lane, bf16x8 (&pf)[2][2]) {
    const int r32 = lane & 31, hi = lane >> 5;
    const int kb = kt0 + 4 * hi;
    const float ref = st.m > -1e29f ? st.m : 0.f;
    const float c0 = -sl2 * (float)(tq - kb) - ref;
    f32x16 s0, s1;
#pragma unroll
    for (int r = 0; r < 16; ++r) { const int ko = (r & 3) + 8 * (r >> 2); s0[r] = c0 + sl2 * (float)ko; s1[r] = c0 + sl2 * (float)(ko + 32); }
    const LAS unsigned char* kp = Kt + r32 * KSTRB + hi * 16;
#pragma unroll
    for (int ks = 0; ks < 4; ++ks) {
        const bf16x8 k0 = *(const LAS bf16x8*)(kp + ks * 32), k1 = *(const LAS bf16x8*)(kp + 32 * KSTRB + ks * 32);
        s0 = __builtin_amdgcn_mfma_f32_32x32x16_bf16(k0, qf[ks], s0, 0, 0, 0);
        s1 = __builtin_amdgcn_mfma_f32_32x32x16_bf16(k1, qf[ks], s1, 0, 0, 0);
    }
    if (diag || !rowok) {
#pragma unroll
        for (int r = 0; r < 16; ++r) { const int ko = (r & 3) + 8 * (r >> 2);
            if (!rowok || kb + ko > tq) s0[r] = -INFINITY;
            if (!rowok || kb + ko + 32 > tq) s1[r] = -INFINITY; }
    }
    float mx = fmaxf(s0[0], s1[0]);
#pragma unroll
    for (int r = 1; r < 16; ++r) mx = fmaxf(mx, fmaxf(s0[r], s1[r]));
    mx = fmaxf(mx, xhalf(mx));
    const float mnew = fmaxf(st.m, ref + mx);
    if (__any(mnew > st.m)) {
        const float alpha = __builtin_amdgcn_exp2f(st.m - mnew), dd = mnew - ref;
        st.m = mnew; st.l *= alpha;
#pragma unroll
        for (int t = 0; t < DV / 32; ++t)
#pragma unroll
            for (int r = 0; r < 16; ++r) st.o[t][r] *= alpha;
#pragma unroll
        for (int r = 0; r < 16; ++r) { s0[r] -= dd; s1[r] -= dd; }
    }
#pragma unroll
    for (int r = 0; r < 16; ++r) { s0[r] = __builtin_amdgcn_exp2f(s0[r]); s1[r] = __builtin_amdgcn_exp2f(s1[r]); }
#pragma unroll
    for (int s = 0; s < 2; ++s) {
        v4u a, b;
        a.x = cvtpk(s0[8 * s + 0], s0[8 * s + 1]); a.y = cvtpk(s0[8 * s + 2], s0[8 * s + 3]); a.z = cvtpk(s0[8 * s + 4], s0[8 * s + 5]); a.w = cvtpk(s0[8 * s + 6], s0[8 * s + 7]);
        b.x = cvtpk(s1[8 * s + 0], s1[8 * s + 1]); b.y = cvtpk(s1[8 * s + 2], s1[8 * s + 3]); b.z = cvtpk(s1[8 * s + 4], s1[8 * s + 5]); b.w = cvtpk(s1[8 * s + 6], s1[8 * s + 7]);
        pf[0][s] = __builtin_bit_cast(bf16x8, a); pf[1][s] = __builtin_bit_cast(bf16x8, b);
    }
}
template <int DV>
__device__ __forceinline__ void attn_pv(AttnSt<DV>& st, const LAS unsigned char* Vt, const bf16x8 (&pf)[2][2], int lane) {
    { const bf16x8 ones = {0x3F80, 0x3F80, 0x3F80, 0x3F80, 0x3F80, 0x3F80, 0x3F80, 0x3F80};
      f32x16 rs = __builtin_amdgcn_mfma_f32_32x32x16_bf16(ones, pf[0][0], (f32x16){0.f, 0.f, 0.f, 0.f, 0.f, 0.f, 0.f, 0.f, 0.f, 0.f, 0.f, 0.f, 0.f, 0.f, 0.f, 0.f}, 0, 0, 0);
      rs = __builtin_amdgcn_mfma_f32_32x32x16_bf16(ones, pf[0][1], rs, 0, 0, 0); rs = __builtin_amdgcn_mfma_f32_32x32x16_bf16(ones, pf[1][0], rs, 0, 0, 0); rs = __builtin_amdgcn_mfma_f32_32x32x16_bf16(ones, pf[1][1], rs, 0, 0, 0);
      st.l += rs[0]; }
    constexpr int VS = VStr<DV>::B;
    const int g = lane >> 4, i16 = lane & 15;
    const LAS unsigned char* vp = Vt + (4 * (g >> 1) + (i16 >> 2)) * VS + (16 * (g & 1) + 4 * (i16 & 3)) * 2;
#pragma unroll
    for (int kbk = 0; kbk < 2; ++kbk)
#pragma unroll
        for (int s = 0; s < 2; ++s)
#pragma unroll
            for (int t = 0; t < DV / 32; ++t) {
                const s16x4 lo = vtr(vp + (kbk * 32 + 16 * s) * VS + t * 64), h8 = vtr(vp + (kbk * 32 + 16 * s + 8) * VS + t * 64);
                const bf16x8 va = {lo[0], lo[1], lo[2], lo[3], h8[0], h8[1], h8[2], h8[3]};
                st.o[t] = __builtin_amdgcn_mfma_f32_32x32x16_bf16(va, pf[kbk][s], st.o[t], 0, 0, 0);
            }
}
template <int DV>
__device__ __forceinline__ void attn_tile(AttnSt<DV>& st, const LAS unsigned char* Kt, const LAS unsigned char* Vt, const bf16x8 (&qf)[4], float sc2, float sl2, int tq, int kt0, bool diag, bool rowok, int lane) {
    bf16x8 pf[2][2];
    attn_qk<DV>(st, Kt, qf, sl2, tq, kt0, diag, rowok, lane, pf);
    attn_pv<DV>(st, Vt, pf, lane);
}
template <int NK, int DV> struct TileRegs { v4u k[NK]; v4u v[DV / 64]; };
template <int NK, int DV>
__device__ __forceinline__ void tile_load(TileRegs<NK, DV>& R, const bf16* Z, int ldz, size_t zrow0, int kcol, int vcol, int tid) {
#pragma unroll
    for (int i = 0; i < NK; ++i) { const int ch = tid + 512 * i; const int row = ch / (8 * NK), cc = ch % (8 * NK);
        R.k[i] = *(const GAS v4u*)(Z + (zrow0 + row) * ldz + kcol + cc * 8); }
#pragma unroll
    for (int i = 0; i < DV / 64; ++i) { const int ch = tid + 512 * i; const int row = ch / (DV / 8), cc = ch % (DV / 8);
        R.v[i] = *(const GAS v4u*)(Z + (zrow0 + row) * ldz + vcol + cc * 8); }
}
template <int NK, int DV>
__device__ __forceinline__ void tile_store(const TileRegs<NK, DV>& R, LAS unsigned char* Kt  , LAS unsigned char* Vt, int tid) {
#pragma unroll
    for (int i = 0; i < NK; ++i) { const int ch = tid + 512 * i; const int row = ch / (8 * NK), cc = ch % (8 * NK);
        *(LAS v4u*)(Kt + (cc >> 3) * (64 * KSTRB) + row * KSTRB + (cc & 7) * 16) = R.k[i]; }
#pragma unroll
    for (int i = 0; i < DV / 64; ++i) { const int ch = tid + 512 * i; const int row = ch / (DV / 8), cc = ch % (DV / 8);
        *(LAS v4u*)(Vt + row * VStr<DV>::B + cc * 16) = R.v[i]; }
}
__device__ __forceinline__ void moba_unit(Frame& F, int b, int h, int j, float tcut  ) {
    const bf16* Z = WSP(bf16, WS_Z); constexpr int ldz = NZ0;
    const int lane = ((int)(threadIdx.x & 63u)), w = F.wave, r32 = lane & 31, hi = lane >> 5, tid = ((int)threadIdx.x);
    const size_t rowb = (size_t)b * SEQ;
    const int qpos = j * 256 + w * 32 + r32;
    const int qcol = 2048 + h * 64, kcol = 2560 + h * 64, vcol = 3072 + h * 64;
    LAS unsigned char* lds = F.lds;
    constexpr int BUFB = 64 * KSTRB + 64 * VStr<64>::B;
    LAS unsigned char* kmh = lds + 2 * BUFB;
    LAS unsigned char* kml = lds + 2 * BUFB + 32 * KSTRB;
    LAS unsigned* msk = (LAS unsigned*)(lds + 2 * BUFB + 64 * KSTRB);
    { const float* KM = WSP(float, WS_KMEAN) + (size_t)((b * 8 + h) * 32) * 64; const f32x4 x = *(const f32x4*)(KM + 4 * tid);
      const int n = tid >> 4, d0 = (tid & 15) * 4;
      const unsigned h0 = f2bf(x.x), h1 = f2bf(x.y), h2 = f2bf(x.z), h3 = f2bf(x.w);
      v2u hv; hv.x = h0 | (h1 << 16); hv.y = h2 | (h3 << 16);
      v2u lv; lv.x = pk2(x.x - u2f(h0 << 16), x.y - u2f(h1 << 16)); lv.y = pk2(x.z - u2f(h2 << 16), x.w - u2f(h3 << 16));
      *(LAS v2u*)(kmh + n * KSTRB + d0 * 2) = hv; *(LAS v2u*)(kml + n * KSTRB + d0 * 2) = lv; }
    if (tid < 16) msk[tid] = 0u;
    bf16x8 qf[4];
    const bf16* qrow = Z + (rowb + qpos) * ldz + qcol;
#pragma unroll
    for (int ks = 0; ks < 4; ++ks) qf[ks] = *(const GAS bf16x8*)(qrow + 16 * ks + 8 * hi);
    __syncthreads();
    f32x16 gt;
#pragma unroll
    for (int r = 0; r < 16; ++r) gt[r] = 0.f;
#pragma unroll
    for (int ks = 0; ks < 4; ++ks) {
        const bf16x8 a = *(const LAS bf16x8*)(kmh + r32 * KSTRB + hi * 16 + ks * 32), c = *(const LAS bf16x8*)(kml + r32 * KSTRB + hi * 16 + ks * 32);
        gt = __builtin_amdgcn_mfma_f32_32x32x16_bf16(a, qf[ks], gt, 0, 0, 0);
        gt = __builtin_amdgcn_mfma_f32_32x32x16_bf16(c, qf[ks], gt, 0, 0, 0);
    }
    float t0 = -INFINITY, t1 = -INFINITY, t2 = -INFINITY;
#define INS3(key) do { float k_ = (key); float a_ = fmaxf(t0, k_), l_ = fminf(t0, k_); t0 = a_; a_ = fmaxf(t1, l_); l_ = fminf(t1, l_); t1 = a_; t2 = fmaxf(t2, l_); } while (0)
#pragma unroll
    for (int r = 0; r < 16; ++r) { const int n = (r & 3) + 8 * (r >> 2) + 4 * hi;
        const float key = (n < j) ? u2f((f2u(gt[r]) & ~31u) | (unsigned)n) : -INFINITY; INS3(key); }
    { const float p0 = xhalf(t0), p1 = xhalf(t1), p2 = xhalf(t2); INS3(p0); INS3(p1); INS3(p2); }
#undef INS3
    const int sel0 = (t0 > -INFINITY) ? (int)(f2u(t0) & 31u) : -1;
    const int sel1 = (t1 > -INFINITY) ? (int)(f2u(t1) & 31u) : -1;
    const int sel2 = (t2 > -INFINITY) ? (int)(f2u(t2) & 31u) : -1;
    { const unsigned mm = (sel0 >= 0 ? 1u << sel0 : 0u) | (sel1 >= 0 ? 1u << sel1 : 0u) | (sel2 >= 0 ? 1u << sel2 : 0u);
      if (mm) { __hip_atomic_fetch_or(msk + w, mm, __ATOMIC_RELAXED, __HIP_MEMORY_SCOPE_WORKGROUP); __hip_atomic_fetch_or(msk + 8, mm, __ATOMIC_RELAXED, __HIP_MEMORY_SCOPE_WORKGROUP); } }
    __syncthreads();
    const float slope = ldexpf(1.f, -(h + 1)), dcut = tcut / slope;
    const float sl2 = slope * LOG2E, sc2 = 0.125f * LOG2E;
    int nlo = (int)ceilf(((float)(j * 256) - dcut - 255.f) * (1.f / 256.f)); if (nlo < 0) nlo = 0;
    const unsigned keep = nlo >= 32 ? 0u : (0xffffffffu << nlo);
    const unsigned bmask = msk[8] & keep; const unsigned wmask = (unsigned)__builtin_amdgcn_readfirstlane((int)msk[w]) & keep;
    AttnSt<64> st; attn_init<64>(st);
    unsigned rem = bmask;
    int blk = j, kt = 3, buf = 0;
    TileRegs<1, 64> R;
    tile_load<1, 64>(R, Z, ldz, rowb + blk * 256 + kt * 64, kcol, vcol, tid);
    tile_store<1, 64>(R, lds, lds + 64 * KSTRB, tid);
    __syncthreads();
    for (;;) {
        int nblk = blk, nkt = kt - 1; bool has_next = true;
        if (nkt < 0) { nkt = 3; if (rem) { nblk = 31 - __builtin_clz(rem); rem &= ~(1u << nblk); } else has_next = false; }
        if (has_next) tile_load<1, 64>(R, Z, ldz, rowb + nblk * 256 + nkt * 64, kcol, vcol, tid);
        const bool own = (blk == j);
        const bool active = (own ? (kt * 64 <= w * 32 + 31) : (((wmask >> blk) & 1u) != 0u)) && ((float)(j * 256 + w * 32 - (blk * 256 + kt * 64 + 63)) <= dcut);
        if (active) {
            const bool rowok = own || blk == sel0 || blk == sel1 || blk == sel2;
            const bool diag = own && (kt * 64 + 63 > w * 32);
            attn_tile<64>(st, lds + buf * BUFB, lds + buf * BUFB + 64 * KSTRB, qf, sc2, sl2, qpos, blk * 256 + kt * 64, diag, rowok, lane);
        }
        if (!has_next) break;
        tile_store<1, 64>(R, lds + (buf ^ 1) * BUFB, lds + (buf ^ 1) * BUFB + 64 * KSTRB, tid);
        __syncthreads();
        buf ^= 1; blk = nblk; kt = nkt;
    }
    const float inv = 1.f / st.l;
    bf16* Y = WSP(bf16, WS_XNY) + (rowb + qpos) * 1024 + 512 + h * 64;
#pragma unroll
    for (int t = 0; t < 2; ++t)
#pragma unroll
        for (int rg = 0; rg < 4; ++rg) { v2u o; o.x = pk2(st.o[t][4 * rg] * inv, st.o[t][4 * rg + 1] * inv); o.y = pk2(st.o[t][4 * rg + 2] * inv, st.o[t][4 * rg + 3] * inv);
            *(GAS v2u*)(Y + t * 32 + 8 * rg + 4 * hi) = o; }
    __syncthreads();
}

__device__ __forceinline__ void diff_unit(Frame& F, const Args& A, int b, int h, int qt, float lam, float tcut, const int probe) {
    (void)probe;
    const bf16* Z = WSP(bf16, WS_Z); constexpr int ldz = NZ1;
    const int lane = ((int)(threadIdx.x & 63u)), w = F.wave, r32 = lane & 31, hi = lane >> 5, tid = ((int)threadIdx.x);
    const int comp = w >> 2, wq = w & 3;
    const size_t rowb = (size_t)b * SEQ;
    const int q0 = qt * 128, qpos = q0 + wq * 32 + r32;
    const int qcol = h * 128 + comp * 64, kcol = 1024 + h * 128, vcol = 2048 + h * 128;
    LAS unsigned char* lds = F.lds;
    constexpr int BUFB = 2 * 64 * KSTRB + 64 * VStr<128>::B;
    bf16x8 qf[4];
    const bf16* qrow = Z + (rowb + qpos) * ldz + qcol;
#pragma unroll
    for (int ks = 0; ks < 4; ++ks) qf[ks] = *(const GAS bf16x8*)(qrow + 16 * ks + 8 * hi);
    const float slope = ldexpf(1.f, -(h + 1)), dcut = tcut / slope;
    const float sl2 = slope * LOG2E, sc2 = 0.125f * LOG2E;
    AttnSt<128> st; attn_init<128>(st);
    const int nt = (q0 + 128) / 64;
    int kt_lo = (int)ceilf(((float)q0 - dcut - 63.f) * (1.f / 64.f)); if (kt_lo < 0) kt_lo = 0;
    TileRegs<2, 128> R;
    tile_load<2, 128>(R, Z, ldz, rowb + (size_t)(nt - 1) * 64, kcol, vcol, tid);
    tile_store<2, 128>(R, lds, lds + 2 * 64 * KSTRB, tid);
    __syncthreads();
    int buf = 0;
    for (int kt = nt - 1; kt >= kt_lo; --kt) {
        const bool has_next = kt > kt_lo;
        if (has_next) tile_load<2, 128>(R, Z, ldz, rowb + (size_t)(kt - 1) * 64, kcol, vcol, tid);
        if (kt * 64 <= q0 + wq * 32 + 31) {
            const bool diag = kt * 64 + 63 > q0 + wq * 32;
            attn_tile<128>(st, lds + buf * BUFB + comp * (64 * KSTRB), lds + buf * BUFB + 2 * 64 * KSTRB, qf, sc2, sl2, qpos, kt * 64, diag, true, lane);
        }
        if (has_next) { tile_store<2, 128>(R, lds + (buf ^ 1) * BUFB, lds + (buf ^ 1) * BUFB + 2 * 64 * KSTRB, tid); }
        __syncthreads();
        buf ^= 1;
    }
    const float inv = 1.f / st.l;
    LAS float* o2 = (LAS float*)lds;
    if (comp == 1) {
#pragma unroll
        for (int t = 0; t < 4; ++t)
#pragma unroll
            for (int r = 0; r < 16; ++r) o2[((wq * 4 + t) * 16 + r) * 64 + lane] = st.o[t][r] * inv;
    }
    __syncthreads();
    if (comp == 0) {
        float ss = 0.f;
#pragma unroll
        for (int t = 0; t < 4; ++t)
#pragma unroll
            for (int r = 0; r < 16; ++r) { const float v = st.o[t][r] * inv - lam * o2[((wq * 4 + t) * 16 + r) * 64 + lane]; st.o[t][r] = v; ss += v * v; }
        ss += xhalf(ss);
        const float rs = rsqrtf(ss * (1.f / 128.f) + EPS) * 0.6444909324090307f;
        const float* og = A.in[18];
        bf16* Y = WSP(bf16, WS_XNY) + (rowb + qpos) * 1024 + h * 128;
#pragma unroll
        for (int t = 0; t < 4; ++t)
#pragma unroll
            for (int rg = 0; rg < 4; ++rg) { const int dv = t * 32 + 8 * rg + 4 * hi; const f32x4 gg = *(const f32x4*)(og + dv);
                v2u o; o.x = pk2(st.o[t][4 * rg] * rs * gg.x, st.o[t][4 * rg + 1] * rs * gg.y); o.y = pk2(st.o[t][4 * rg + 2] * rs * gg.z, st.o[t][4 * rg + 3] * rs * gg.w);
                *(GAS v2u*)(Y + dv) = o; }
    }
    __syncthreads();
}
template <int MT, int NT>
__device__ __forceinline__ void mma_nt(const LAS unsigned char* A, int lda, const LAS unsigned char* B, int ldb, int K, f32x4 (&acc)[MT][NT], int lane) {
    const int r = lane & 15, kq = (lane >> 4) * 16;
    for (int k0 = 0; k0 < K; k0 += 32) {
        bf16x8 a[MT], bb[NT];
#pragma unroll
        for (int m = 0; m < MT; ++m) a[m] = *(const LAS bf16x8*)(A + (m * 16 + r) * lda + k0 * 2 + kq);
#pragma unroll
        for (int n = 0; n < NT; ++n) bb[n] = *(const LAS bf16x8*)(B + (n * 16 + r) * ldb + k0 * 2 + kq);
#pragma unroll
        for (int m = 0; m < MT; ++m)
#pragma unroll
            for (int n = 0; n < NT; ++n) acc[m][n] = __builtin_amdgcn_mfma_f32_16x16x32_bf16(a[m], bb[n], acc[m][n], 0, 0, 0);
    }
}
constexpr int TS = 272;
constexpr int TILEB = 128 * TS;
constexpr int ML_Q = 0, ML_K = TILEB, ML_V = 2 * TILEB, ML_SM = 3 * TILEB;

__device__ __forceinline__ void ml_gates(const float* GT, size_t row0, int hm, LAS float* sm, int lane) {
    const float i0 = GT[(row0 + 2 * lane) * 8 + hm], i1 = GT[(row0 + 2 * lane + 1) * 8 + hm];
    const float f0 = logsigmoid_f(GT[(row0 + 2 * lane) * 8 + 4 + hm]), f1 = logsigmoid_f(GT[(row0 + 2 * lane + 1) * 8 + 4 + hm]);
    float s = f0 + f1;
#pragma unroll
    for (int o = 1; o < 64; o <<= 1) { const float t = __shfl_up(s, o); if (lane >= o) s += t; }
    const float excl = s - (f0 + f1);
    sm[2 * lane] = excl + f0; sm[2 * lane + 1] = excl + f0 + f1;
    sm[128 + 2 * lane] = i0; sm[128 + 2 * lane + 1] = i1;
}
template <bool TRANSPOSE>
__device__ __forceinline__ void ml_conv_tile(const bf16* Z, size_t rowb, int t0, int zc, const float* cw, int wc, float mul, LAS unsigned char* dst, const LAS float* rs, int tid) {
#pragma unroll
    for (int it = 0; it < 4; ++it) {
        const int item = tid + 512 * it, l = item >> 4, ch = (item & 15) * 8;
        float acc[8];
#pragma unroll
        for (int i = 0; i < 8; ++i) acc[i] = 0.f;
#pragma unroll
        for (int jj = 0; jj < 4; ++jj) {
            const int t = t0 + l - 3 + jj;
            if (t >= 0) {
                const v4u w = *(const GAS v4u*)(Z + (rowb + t) * NZ0 + zc + ch);
                const float x[8] = {bflo(w.x), bfhi(w.x), bflo(w.y), bfhi(w.y), bflo(w.z), bfhi(w.z), bflo(w.w), bfhi(w.w)};
                const f32x4 c0 = *(const f32x4*)(cw + jj * 1024 + wc + ch), c1 = *(const f32x4*)(cw + jj * 1024 + wc + ch + 4);
                acc[0] += x[0] * c0.x; acc[1] += x[1] * c0.y; acc[2] += x[2] * c0.z; acc[3] += x[3] * c0.w;
                acc[4] += x[4] * c1.x; acc[5] += x[5] * c1.y; acc[6] += x[6] * c1.z; acc[7] += x[7] * c1.w;
            }
        }
        const float sc = TRANSPOSE ? mul * rs[l] : mul;
#pragma unroll
        for (int i = 0; i < 8; ++i) acc[i] = silu_f(acc[i]) * sc;
        if (TRANSPOSE) {
#pragma unroll
            for (int i = 0; i < 8; ++i) *(LAS bf16*)(dst + (ch + i) * TS + l * 2) = (bf16)f2bf(acc[i]);
        } else {
            v4u o; o.x = pk2(acc[0], acc[1]); o.y = pk2(acc[2], acc[3]); o.z = pk2(acc[4], acc[5]); o.w = pk2(acc[6], acc[7]);
            *(LAS v4u*)(dst + l * TS + ch * 2) = o;
        }
    }
}
__device__ __forceinline__ void ml_vt_tile(const bf16* Z, size_t row0, int zc, LAS unsigned char* dst, int tid) {
#pragma unroll
    for (int it = 0; it < 4; ++it) {
        const int item = tid + 512 * it, l = item >> 4, ch = (item & 15) * 8;
        const v4u w = *(const GAS v4u*)(Z + (row0 + l) * NZ0 + zc + ch);
        const unsigned ww[4] = {w.x, w.y, w.z, w.w};
#pragma unroll
        for (int i = 0; i < 4; ++i) { *(LAS bf16*)(dst + (ch + 2 * i) * TS + l * 2) = (bf16)(ww[i] & 0xffffu); *(LAS bf16*)(dst + (ch + 2 * i + 1) * TS + l * 2) = (bf16)(ww[i] >> 16); }
    }
}
__device__ __forceinline__ void mlstm_a_unit(Frame& F, const Args& A, int unit) {
    const int c = unit & 63, bh = unit >> 6, hm = bh & 3, b = bh >> 2;
    const bf16* Z = WSP(bf16, WS_Z); const float* GT = WSP(float, WS_GATES);
    const size_t rowb = (size_t)b * SEQ; const int t0 = c * 128;
    LAS unsigned char* lds = F.lds; LAS float* sm = (LAS float*)(lds + ML_SM);
    if (F.wave == 0) {
        ml_gates(GT, rowb + t0, hm, sm, ((int)(threadIdx.x & 63u)));
        LDS_WAIT();
        const float bend = sm[127];
        const float w0 = bend - sm[2 * ((int)(threadIdx.x & 63u))] + sm[128 + 2 * ((int)(threadIdx.x & 63u))], w1 = bend - sm[2 * ((int)(threadIdx.x & 63u)) + 1] + sm[128 + 2 * ((int)(threadIdx.x & 63u)) + 1];
        const float ml = wave_max(fmaxf(w0, w1));
        sm[256 + 2 * ((int)(threadIdx.x & 63u))] = __expf(w0 - ml); sm[256 + 2 * ((int)(threadIdx.x & 63u)) + 1] = __expf(w1 - ml);
        if (((int)(threadIdx.x & 63u)) == 0) { WSP(float, WS_BEND)[unit] = bend; WSP(float, WS_MLOC)[unit] = ml; }
    }
    __syncthreads();
    ml_conv_tile<true>(Z, rowb, t0, 512 + hm * 128, A.in[7], 512 + hm * 128, 0.08838834764831845f, lds + ML_K, sm + 256, ((int)threadIdx.x));
    ml_vt_tile(Z, rowb + t0, 1024 + hm * 128, lds + ML_V, ((int)threadIdx.x));
    __syncthreads();
    f32x4 acc[2][4];
#pragma unroll
    for (int m = 0; m < 2; ++m)
#pragma unroll
        for (int n = 0; n < 4; ++n) acc[m][n] = (f32x4){0.f, 0.f, 0.f, 0.f};
    const int dv0 = 32 * (F.wave >> 1), dk0 = 64 * (F.wave & 1);
    mma_nt<2, 4>(lds + ML_V + dv0 * TS, TS, lds + ML_K + dk0 * TS, TS, 128, acc, ((int)(threadIdx.x & 63u)));
    float* CL = WSP(float, WS_CLOC) + (size_t)unit * 16384;
#pragma unroll
    for (int m = 0; m < 2; ++m)
#pragma unroll
        for (int n = 0; n < 4; ++n)
#pragma unroll
            for (int i = 0; i < 4; ++i) CL[(size_t)(dv0 + 16 * m + 4 * (((int)(threadIdx.x & 63u)) >> 4) + i) * 128 + dk0 + 16 * n + (((int)(threadIdx.x & 63u)) & 15)] = acc[m][n][i];
    if (((int)threadIdx.x) < 128) { float s = 0.f; const LAS bf16* kr = (const LAS bf16*)(lds + ML_K + ((int)threadIdx.x) * TS);
        for (int l = 0; l < 128; ++l) s += bf2f(kr[l]);
        WSP(float, WS_NLOC)[(size_t)unit * 128 + ((int)threadIdx.x)] = s; }
    __syncthreads();
}
__device__ __forceinline__ void mlstm_scan_unit(Frame& F, int unit) {
    const int bh = unit >> 4, sl = unit & 15;
    LAS float* tab = (LAS float*)F.lds;
    if (((int)threadIdx.x) == 0) {
        const float* BE = WSP(float, WS_BEND) + bh * 64; const float* ML = WSP(float, WS_MLOC) + bh * 64; float* MP = WSP(float, WS_MPREV) + bh * 64;
        float m = 0.f;
        for (int c = 0; c < 64; ++c) { const float be = BE[c], ml = ML[c]; const float mn = fmaxf(be + m, ml);
            tab[c] = __expf(be + m - mn); tab[64 + c] = __expf(ml - mn); if (sl == 0) MP[c] = m; m = mn; }
    }
    __syncthreads();
    float* CL = WSP(float, WS_CLOC) + (size_t)bh * 64 * 16384 + sl * 1024 + 2 * ((int)threadIdx.x);
    float s0 = 0.f, s1 = 0.f;
#pragma unroll 8
    for (int c = 0; c < 64; ++c) { float2* p = (float2*)(CL + (size_t)c * 16384); const float2 v = *p; *p = make_float2(s0, s1);
        const float a = tab[c], sc = tab[64 + c]; s0 = a * s0 + sc * v.x; s1 = a * s1 + sc * v.y; }
    if (sl == 0 && ((int)threadIdx.x) < 128) { float* NL = WSP(float, WS_NLOC) + (size_t)bh * 64 * 128 + ((int)threadIdx.x); float s = 0.f;
        for (int c = 0; c < 64; ++c) { const float v = NL[c * 128]; NL[c * 128] = s; s = tab[c] * s + tab[64 + c] * v; } }
    __syncthreads();
}
__device__ __forceinline__ void mlstm_c_unit(Frame& F, const Args& A, int unit) {
    const int c = unit & 63, bh = unit >> 6, hm = bh & 3, b = bh >> 2;
    const bf16* Z = WSP(bf16, WS_Z); const float* GT = WSP(float, WS_GATES);
    const size_t rowb = (size_t)b * SEQ; const int t0 = c * 128;
    LAS unsigned char* lds = F.lds; LAS float* sm = (LAS float*)(lds + ML_SM);
    const int lane = ((int)(threadIdx.x & 63u)), w = F.wave, tid = ((int)threadIdx.x);
    const float mprev = WSP(float, WS_MPREV)[unit];
    if (w == 0) {
        ml_gates(GT, rowb + t0, hm, sm, lane);
        LDS_WAIT();
        const float b0 = sm[2 * lane], b1 = sm[2 * lane + 1];
        const float g0 = sm[128 + 2 * lane] - b0, g1 = sm[128 + 2 * lane + 1] - b1;
        float pm = fmaxf(g0, g1);
#pragma unroll
        for (int o = 1; o < 64; o <<= 1) { const float t = __shfl_up(pm, o); if (lane >= o) pm = fmaxf(pm, t); }
        float pe = __shfl_up(pm, 1); if (lane == 0) pe = -INFINITY;
        const float M0 = fmaxf(mprev, fmaxf(pe, g0)), M1 = fmaxf(mprev, pm);
        sm[256 + 2 * lane] = g0; sm[256 + 2 * lane + 1] = g1;
        sm[384 + 2 * lane] = M0; sm[384 + 2 * lane + 1] = M1;
        sm[512 + 2 * lane] = __expf(mprev - M0); sm[512 + 2 * lane + 1] = __expf(mprev - M1);
        sm[640 + 2 * lane] = __expf(-b0 - M0); sm[640 + 2 * lane + 1] = __expf(-b1 - M1);
        sm[768 + 2 * lane] = 0.f; sm[768 + 2 * lane + 1] = 0.f; sm[896 + 2 * lane] = 0.f; sm[896 + 2 * lane + 1] = 0.f;
    }
    if (w == 1) { sm[1152 + lane] = WSP(float, WS_NLOC)[(size_t)unit * 128 + lane]; sm[1152 + 64 + lane] = WSP(float, WS_NLOC)[(size_t)unit * 128 + 64 + lane]; }
    ml_conv_tile<false>(Z, rowb, t0, hm * 128, A.in[7], hm * 128, 1.f, lds + ML_Q, nullptr, tid);
    ml_conv_tile<false>(Z, rowb, t0, 512 + hm * 128, A.in[7], 512 + hm * 128, 0.08838834764831845f, lds + ML_K, nullptr, tid);
    ml_vt_tile(Z, rowb + t0, 1024 + hm * 128, lds + ML_V, tid);
    __syncthreads();
    const int l0 = 32 * (w >> 1), c0 = 64 * (w & 1);
    const int lr = 4 * (lane >> 4), lc = lane & 15;
    if (tid < 128) { const LAS bf16* qr = (const LAS bf16*)(lds + ML_Q + tid * TS); float s = 0.f;
        for (int d = 0; d < 128; ++d) s += bf2f(qr[d]) * sm[1152 + d];
        sm[1024 + tid] = s; }
    f32x4 acc[2][4];
#pragma unroll
    for (int m = 0; m < 2; ++m)
#pragma unroll
        for (int n = 0; n < 4; ++n) acc[m][n] = (f32x4){0.f, 0.f, 0.f, 0.f};
    mma_nt<2, 4>(lds + ML_Q + l0 * TS, TS, lds + ML_K + c0 * TS, TS, 128, acc, lane);
#pragma unroll
    for (int m = 0; m < 2; ++m)
#pragma unroll
        for (int i = 0; i < 4; ++i) { const int l = l0 + 16 * m + lr + i; const float Ml = sm[384 + l]; float rsum = 0.f;
#pragma unroll
            for (int n = 0; n < 4; ++n) { const int s = c0 + 16 * n + lc; const float v = (s <= l) ? acc[m][n][i] * __expf(sm[256 + s] - Ml) : 0.f; acc[m][n][i] = v; rsum += v; }
            rsum += __shfl_xor(rsum, 1); rsum += __shfl_xor(rsum, 2); rsum += __shfl_xor(rsum, 4); rsum += __shfl_xor(rsum, 8);
            if (lc == 0) __hip_atomic_fetch_add(sm + 768 + l, rsum, __ATOMIC_RELAXED, __HIP_MEMORY_SCOPE_WORKGROUP); }
    __syncthreads();
#pragma unroll
    for (int m = 0; m < 2; ++m)
#pragma unroll
        for (int n = 0; n < 4; ++n)
#pragma unroll
            for (int i = 0; i < 4; ++i) *(LAS bf16*)(lds + ML_K + (l0 + 16 * m + lr + i) * TS + (c0 + 16 * n + lc) * 2) = (bf16)f2bf(acc[m][n][i]);
    __syncthreads();
    f32x4 ai[2][4], ae[2][4];
#pragma unroll
    for (int m = 0; m < 2; ++m)
#pragma unroll
        for (int n = 0; n < 4; ++n) { ai[m][n] = (f32x4){0.f, 0.f, 0.f, 0.f}; ae[m][n] = (f32x4){0.f, 0.f, 0.f, 0.f}; }
    mma_nt<2, 4>(lds + ML_K + l0 * TS, TS, lds + ML_V + c0 * TS, TS, 128, ai, lane);
    {
        const float* CP = WSP(float, WS_CLOC) + (size_t)unit * 16384;
        const int r = lane & 15, kq = (lane >> 4) * 8;
        for (int k0 = 0; k0 < 128; k0 += 32) {
            bf16x8 a[2], bb[4];
#pragma unroll
            for (int m = 0; m < 2; ++m) a[m] = *(const LAS bf16x8*)(lds + ML_Q + (l0 + m * 16 + r) * TS + (k0 + kq) * 2);
#pragma unroll
            for (int n = 0; n < 4; ++n) { const float* p = CP + (size_t)(c0 + n * 16 + r) * 128 + k0 + kq; const f32x4 x = *(const f32x4*)p, y = *(const f32x4*)(p + 4);
                v4u pk; pk.x = pk2(x.x, x.y); pk.y = pk2(x.z, x.w); pk.z = pk2(y.x, y.y); pk.w = pk2(y.z, y.w); bb[n] = __builtin_bit_cast(bf16x8, pk); }
#pragma unroll
            for (int m = 0; m < 2; ++m)
#pragma unroll
                for (int n = 0; n < 4; ++n) ae[m][n] = __builtin_amdgcn_mfma_f32_16x16x32_bf16(a[m], bb[n], ae[m][n], 0, 0, 0);
        }
    }
#pragma unroll
    for (int m = 0; m < 2; ++m)
#pragma unroll
        for (int i = 0; i < 4; ++i) { const int l = l0 + 16 * m + lr + i; const float wi = sm[512 + l];
            const float den = wi * sm[1024 + l] + sm[768 + l]; const float dinv = 1.f / fmaxf(fabsf(den), sm[640 + l]); float ssq = 0.f;
#pragma unroll
            for (int n = 0; n < 4; ++n) { const float hv = (wi * ae[m][n][i] + ai[m][n][i]) * dinv; ai[m][n][i] = hv; ssq += hv * hv; }
            ssq += __shfl_xor(ssq, 1); ssq += __shfl_xor(ssq, 2); ssq += __shfl_xor(ssq, 4); ssq += __shfl_xor(ssq, 8);
            if (lc == 0) __hip_atomic_fetch_add(sm + 896 + l, ssq, __ATOMIC_RELAXED, __HIP_MEMORY_SCOPE_WORKGROUP); }
    __syncthreads();
    const float* mg = A.in[10] + hm * 128;
    bf16* Y = WSP(bf16, WS_XNY);
#pragma unroll
    for (int m = 0; m < 2; ++m)
#pragma unroll
        for (int i = 0; i < 4; ++i) { const int l = l0 + 16 * m + lr + i; const float rstd = rsqrtf(sm[896 + l] * (1.f / 128.f) + EPS); const size_t row = rowb + t0 + l;
#pragma unroll
            for (int n = 0; n < 4; ++n) { const int dv = c0 + 16 * n + lc; const float og = sigmoid_f(bf2f(Z[row * NZ0 + 1536 + hm * 128 + dv]));
                Y[row * 1024 + hm * 128 + dv] = (bf16)f2bf(ai[m][n][i] * rstd * mg[dv] * og); } }
    __syncthreads();
}
template <int N> __device__ __forceinline__ void bitonic_sort_desc(float (&v)[N]) {
#pragma unroll
    for (int k = 2; k <= N; k <<= 1)
#pragma unroll
        for (int j = k >> 1; j > 0; j >>= 1)
#pragma unroll
            for (int i = 0; i < N; ++i) { const int l = i ^ j; if (l > i) { const bool desc = ((i & k) == 0); const float a = v[i], b = v[l]; const float mx = fmaxf(a, b), mn = fminf(a, b); v[i] = desc ? mx : mn; v[l] = desc ? mn : mx; } }
}
__device__ __forceinline__ void merge_top16(float (&run)[16], const float (&nw)[16]) {
#pragma unroll
    for (int i = 0; i < 16; ++i) run[i] = fmaxf(run[i], nw[15 - i]);
#pragma unroll
    for (int j = 8; j > 0; j >>= 1)
#pragma unroll
        for (int i = 0; i < 16; ++i) { const int l = i ^ j; if (l > i) { const float a = run[i], b = run[l]; run[i] = fmaxf(a, b); run[l] = fminf(a, b); } }
}
#ifndef EXPERT_SLOW
#define EXPERT_SLOW 0
#endif
#ifndef ROUTE_SLOW
#define ROUTE_SLOW 0
#endif
constexpr int SCS = 132;
__device__ __forceinline__ void peer_route_unit(Frame& F, int tok0, int hd, const bf16x8 (&kf)[4][2], const int PROBE) {
    const bf16* QRY = WSP(bf16, WS_QRY); unsigned short* IDX = WSP(unsigned short, WS_IDX); float* GATE = WSP(float, WS_GATE);
    LAS float* SC = (LAS float*)F.lds;
    const int lane = ((int)(threadIdx.x & 63u)), w = F.wave, tid = ((int)threadIdx.x);
    {
        constexpr int AST = 528;
        LAS unsigned char* As = F.lds;
#pragma unroll
        for (int i = 0; i < 8; ++i) { const int ch = tid + 512 * i, row = ch >> 5, cc = ch & 31;
            *(LAS v4u*)(As + row * AST + cc * 16) = *(const GAS v4u*)(QRY + (size_t)(tok0 + row) * NQ + hd * 256 + cc * 8); }
        __syncthreads();
        const int p = w & 1, nq = w >> 1, r = lane & 15, kq = (lane >> 4) * 16;
        f32x4 acc[8][2];
#pragma unroll
        for (int m = 0; m < 8; ++m) { acc[m][0] = (f32x4){0.f, 0.f, 0.f, 0.f}; acc[m][1] = (f32x4){0.f, 0.f, 0.f, 0.f}; }
#pragma unroll
        for (int ks = 0; ks < 4; ++ks)
#pragma unroll
            for (int m = 0; m < 8; ++m) { const bf16x8 a = *(const LAS bf16x8*)(As + (16 * m + r) * AST + p * 256 + ks * 64 + kq);
                acc[m][0] = __builtin_amdgcn_mfma_f32_16x16x32_bf16(a, kf[ks][0], acc[m][0], 0, 0, 0);
                acc[m][1] = __builtin_amdgcn_mfma_f32_16x16x32_bf16(a, kf[ks][1], acc[m][1], 0, 0, 0); }
        __syncthreads();
#pragma unroll
        for (int m = 0; m < 8; ++m)
#pragma unroll
            for (int n = 0; n < 2; ++n)
#pragma unroll
                for (int i = 0; i < 4; ++i) SC[(p * 128 + 16 * m + 4 * (lane >> 4) + i) * SCS + 32 * nq + 16 * n + r] = acc[m][n][i];
    }
    __syncthreads();
#if defined(CHECK) && CHECK
    if (tok0 == 0 && hd == 0) { float* DB = WSP(float, WS_CLOC) + 8 * 1024 * 1024; for (int i = tid; i < 2 * 128 * 128; i += NTHR) DB[i] = SC[(i >> 7) * SCS + (i & 127)]; }
    __syncthreads();
#endif
#if ROUTE_SLOW
    if (tid < 128) {
        const int t = tid;
        float s0[16], s1[16]; unsigned i0[16], i1[16];
        { const LAS float* row = SC + (0 * 128 + t) * SCS; float prev = INFINITY;
#pragma unroll
          for (int k = 0; k < 16; ++k) { float best = -INFINITY; unsigned bi = 0; for (int n = 0; n < 128; ++n) { const float v = row[n]; if (v < prev && v > best) { best = v; bi = n; } } s0[k] = best; i0[k] = bi; prev = best; } }
        { const LAS float* row = SC + (1 * 128 + t) * SCS; float prev = INFINITY;
#pragma unroll
          for (int k = 0; k < 16; ++k) { float best = -INFINITY; unsigned bi = 0; for (int n = 0; n < 128; ++n) { const float v = row[n]; if (v < prev && v > best) { best = v; bi = n; } } s1[k] = best; i1[k] = bi; prev = best; } }
        float top[16]; unsigned tid16[16];
        { float prev = INFINITY;
#pragma unroll
          for (int k = 0; k < 16; ++k) { float best = -INFINITY; unsigned be = 0;
#pragma unroll
              for (int i = 0; i < 16; ++i)
#pragma unroll
                  for (int j = 0; j < 16; ++j) if ((i + 1) * (j + 1) <= 16) { const float v = s0[i] + s1[j]; if (v < prev && v > best) { best = v; be = i0[i] * 128u + i1[j]; } }
              top[k] = best; tid16[k] = be; prev = best; } }
        float sc[16], den = 0.f;
#pragma unroll
        for (int k = 0; k < 16; ++k) { sc[k] = __expf(top[k] - top[0]); den += sc[k]; }
        const float inv = 1.f / den;
        const size_t ob = (size_t)(tok0 + t) * 128 + hd * 16;
#pragma unroll
        for (int k = 0; k < 16; ++k) { IDX[ob + k] = (unsigned short)tid16[k]; GATE[ob + k] = sc[k] * inv; }
    }
    __syncthreads();
#else
    if (PROBE < 2) {
        const int t = tid & 127, p = (tid >> 7) & 1, half = tid >> 8;
        LAS float* seg = SC + (p * 128 + t) * SCS + 64 * half;
        float run[16], nw[16];
#pragma unroll
        for (int ch = 0; ch < 4; ++ch) {
#pragma unroll
            for (int q = 0; q < 4; ++q) { const f32x4 v = *(const LAS f32x4*)(seg + 16 * ch + 4 * q);
#pragma unroll
                for (int e = 0; e < 4; ++e) { const unsigned n = (unsigned)(64 * half + 16 * ch + 4 * q + e); const float key = u2f((f2u(v[e]) & ~127u) | n);
                    if (ch == 0) run[4 * q + e] = key; else nw[4 * q + e] = key; } }
            if (ch == 0) bitonic_sort_desc<16>(run); else { bitonic_sort_desc<16>(nw); merge_top16(run, nw); }
        }
#pragma unroll
        for (int q = 0; q < 4; ++q) *(LAS f32x4*)(seg + 4 * q) = (f32x4){run[4 * q], run[4 * q + 1], run[4 * q + 2], run[4 * q + 3]};
    }
    __syncthreads();
    if (tid < 128 && PROBE < 1) {
        const int t = tid;
        float s0[16], s1[16];
        {
            LAS float* a = SC + (0 * 128 + t) * SCS; float nw[16];
#pragma unroll
            for (int q = 0; q < 4; ++q) { const f32x4 v = *(const LAS f32x4*)(a + 4 * q), u = *(const LAS f32x4*)(a + 64 + 4 * q);
#pragma unroll
                for (int e = 0; e < 4; ++e) { s0[4 * q + e] = v[e]; nw[4 * q + e] = u[e]; } }
            merge_top16(s0, nw);
#pragma unroll
            for (int q = 0; q < 4; ++q) *(LAS f32x4*)(a + 16 + 4 * q) = (f32x4){s0[4 * q], s0[4 * q + 1], s0[4 * q + 2], s0[4 * q + 3]};
        }
        {
            LAS float* a = SC + (1 * 128 + t) * SCS; float nw[16];
#pragma unroll
            for (int q = 0; q < 4; ++q) { const f32x4 v = *(const LAS f32x4*)(a + 4 * q), u = *(const LAS f32x4*)(a + 64 + 4 * q);
#pragma unroll
                for (int e = 0; e < 4; ++e) { s1[4 * q + e] = v[e]; nw[4 * q + e] = u[e]; } }
            merge_top16(s1, nw);
#pragma unroll
            for (int q = 0; q < 4; ++q) *(LAS f32x4*)(a + 16 + 4 * q) = (f32x4){s1[4 * q], s1[4 * q + 1], s1[4 * q + 2], s1[4 * q + 3]};
        }
#pragma unroll
        for (int i = 0; i < 16; ++i) { s0[i] = u2f(f2u(s0[i]) & ~127u); s1[i] = u2f(f2u(s1[i]) & ~127u); }
        constexpr int CNT[16] = {16, 8, 5, 4, 3, 2, 2, 2, 1, 1, 1, 1, 1, 1, 1, 1};
        constexpr int OFF[16] = {0, 16, 24, 29, 33, 36, 38, 40, 42, 43, 44, 45, 46, 47, 48, 49};
        float top[16], nw[16];
#pragma unroll
        for (int grp = 0; grp < 4; ++grp) {
#pragma unroll
            for (int e = 0; e < 16; ++e) nw[e] = -INFINITY;
#pragma unroll
            for (int i = 0; i < 16; ++i)
#pragma unroll
                for (int j = 0; j < 16; ++j) if (j < CNT[i] && (OFF[i] + j) / 16 == grp) {
                    const float sum = s0[i] + s1[j];
                    nw[(OFF[i] + j) % 16] = u2f((f2u(sum) & ~255u) | (unsigned)(i * 16 + j)); }
            bitonic_sort_desc<16>(nw);
            if (grp == 0) {
#pragma unroll
                for (int e = 0; e < 16; ++e) top[e] = nw[e];
            } else merge_top16(top, nw);
        }
#if defined(CHECK) && CHECK
        if (tok0 == 0 && hd == 0) { float* DB = WSP(float, WS_CLOC) + 8 * 1024 * 1024 + 32768;
#pragma unroll
            for (int i = 0; i < 16; ++i) { DB[t * 48 + i] = s0[i]; DB[t * 48 + 16 + i] = s1[i]; DB[t * 48 + 32 + i] = top[i]; } }
#endif
        float sc[16], den = 0.f;
        const float mx = u2f(f2u(top[0]) & ~255u);
#pragma unroll
        for (int k = 0; k < 16; ++k) { sc[k] = __expf(u2f(f2u(top[k]) & ~255u) - mx); den += sc[k]; }
        const float inv = 1.f / den;
        LDS_WAIT();
        const LAS unsigned* l0 = (const LAS unsigned*)(SC + (0 * 128 + t) * SCS + 16); const LAS unsigned* l1 = (const LAS unsigned*)(SC + (1 * 128 + t) * SCS + 16);
        const size_t ob = (size_t)(tok0 + t) * 128 + hd * 16;
        unsigned eid[16];
#pragma unroll
        for (int k = 0; k < 16; ++k) { const unsigned id = f2u(top[k]) & 255u; const unsigned e0 = l0[id >> 4] & 127u, e1 = l1[id & 15u] & 127u; eid[k] = e0 * 128u + e1; }
        { v4u i0, i1; i0.x = eid[0] | (eid[1] << 16); i0.y = eid[2] | (eid[3] << 16); i0.z = eid[4] | (eid[5] << 16); i0.w = eid[6] | (eid[7] << 16);
          i1.x = eid[8] | (eid[9] << 16); i1.y = eid[10] | (eid[11] << 16); i1.z = eid[12] | (eid[13] << 16); i1.w = eid[14] | (eid[15] << 16);
          *(GAS v4u*)(IDX + ob) = i0; *(GAS v4u*)(IDX + ob + 8) = i1; }
#pragma unroll
        for (int q4 = 0; q4 < 4; ++q4) *(GAS f32x4*)(GATE + ob + 4 * q4) = (f32x4){sc[4 * q4] * inv, sc[4 * q4 + 1] * inv, sc[4 * q4 + 2] * inv, sc[4 * q4 + 3] * inv};
    }
    __syncthreads();
#endif
}
__device__ __forceinline__ void peer_u_phase(Frame& F, const unsigned char* U8  ) {
    const bf16* XN = WSP(bf16, WS_XNY); const unsigned short* IDX = WSP(unsigned short, WS_IDX); unsigned short* PART = WSP(unsigned short, WS_PART);
    const int lane = ((int)(threadIdx.x & 63u)), grp = lane >> 3, l8 = lane & 7;
    const int g = F.bid & 7, nsw = (F.G >> 3) * NWAVES, ws = (F.bid >> 3) * NWAVES + F.wave;
    const unsigned char* Ug = U8 + (size_t)g * 16384 * 128;
    const unsigned lo8 = 16u * (unsigned)l8;
#define U_IDS(IDS, TOK) do { const unsigned short* ip_ = IDX + (size_t)(TOK) * 128 + 16 * grp; const v4u p0_ = *(const GAS v4u*)ip_, p1_ = *(const GAS v4u*)(ip_ + 8); \
        IDS[0].x = p0_.x & 0xffffu; IDS[0].y = p0_.x >> 16; IDS[0].z = p0_.y & 0xffffu; IDS[0].w = p0_.y >> 16; IDS[1].x = p0_.z & 0xffffu; IDS[1].y = p0_.z >> 16; IDS[1].z = p0_.w & 0xffffu; IDS[1].w = p0_.w >> 16; \
        IDS[2].x = p1_.x & 0xffffu; IDS[2].y = p1_.x >> 16; IDS[2].z = p1_.y & 0xffffu; IDS[2].w = p1_.y >> 16; IDS[3].x = p1_.z & 0xffffu; IDS[3].y = p1_.z >> 16; IDS[3].z = p1_.w & 0xffffu; IDS[3].w = p1_.w >> 16; } while (0)
#define U_ROWS(W, HX, HY, IDS, TOK) do { _Pragma("unroll") for (int q4 = 0; q4 < 4; ++q4) { W[4 * q4] = *(const GAS v4u*)(Ug + ((IDS[q4].x << 7) | lo8)); W[4 * q4 + 1] = *(const GAS v4u*)(Ug + ((IDS[q4].y << 7) | lo8)); \
        W[4 * q4 + 2] = *(const GAS v4u*)(Ug + ((IDS[q4].z << 7) | lo8)); W[4 * q4 + 3] = *(const GAS v4u*)(Ug + ((IDS[q4].w << 7) | lo8)); } \
        const bf16* hp_ = XN + (size_t)(TOK) * D + 128 * g + 16 * l8; HX = *(const GAS v4u*)hp_; HY = *(const GAS v4u*)(hp_ + 8); } while (0)
#define U_COMPUTE(W, HX, HY, TOK) do { \
        const float hf_[16] = {bflo(HX.x), bfhi(HX.x), bflo(HX.y), bfhi(HX.y), bflo(HX.z), bfhi(HX.z), bflo(HX.w), bfhi(HX.w), bflo(HY.x), bfhi(HY.x), bflo(HY.y), bfhi(HY.y), bflo(HY.z), bfhi(HY.z), bflo(HY.w), bfhi(HY.w)}; \
        float am_ = 0.f; _Pragma("unroll") for (int i = 0; i < 16; ++i) am_ = fmaxf(am_, fabsf(hf_[i])); \
        am_ = fmaxf(am_, __shfl_xor(am_, 1)); am_ = fmaxf(am_, __shfl_xor(am_, 2)); am_ = fmaxf(am_, __shfl_xor(am_, 4)); \
        const float hinv_ = am_ > 1e-30f ? 127.f / am_ : 0.f, hsc_ = am_ * (1.f / 127.f); \
        int hq_[4]; _Pragma("unroll") for (int q4 = 0; q4 < 4; ++q4) { unsigned wv_ = 0; _Pragma("unroll") for (int e = 0; e < 4; ++e) { const int qv_ = (int)rintf(hf_[4 * q4 + e] * hinv_); wv_ |= ((unsigned)qv_ & 0xffu) << (8 * e); } hq_[q4] = (int)wv_; } \
        float r_[16]; _Pragma("unroll") for (int it = 0; it < 16; ++it) { const unsigned wx_ = W[it].x, wy_ = W[it].y, wz_ = W[it].z, ww_ = W[it].w; \
            int acc_ = __builtin_amdgcn_sdot4((int)wx_, hq_[0], 0, false); acc_ = __builtin_amdgcn_sdot4((int)wy_, hq_[1], acc_, false); acc_ = __builtin_amdgcn_sdot4((int)wz_, hq_[2], acc_, false); acc_ = __builtin_amdgcn_sdot4((int)ww_, hq_[3], acc_, false); \
            acc_ += __shfl_xor(acc_, 1); acc_ += __shfl_xor(acc_, 2); acc_ += __shfl_xor(acc_, 4); r_[it] = (float)acc_ * (hsc_ * (1.f / 64.f)); } \
        if (l8 == 0) { unsigned short* pp_ = PART + ((size_t)g * M + (TOK)) * 128 + 16 * grp; v4u h0_, h1_; \
            h0_.x = f2h2(r_[0], r_[1]); h0_.y = f2h2(r_[2], r_[3]); h0_.z = f2h2(r_[4], r_[5]); h0_.w = f2h2(r_[6], r_[7]); h1_.x = f2h2(r_[8], r_[9]); h1_.y = f2h2(r_[10], r_[11]); h1_.z = f2h2(r_[12], r_[13]); h1_.w = f2h2(r_[14], r_[15]); \
            *(GAS v4u*)pp_ = h0_; *(GAS v4u*)(pp_ + 8) = h1_; } } while (0)
    v4u idsA[4], idsB[4], wA[16], wB[16], hxA, hyA, hxB, hyB;
    const int tmax = M - 1;
    int t0 = ws;
    U_IDS(idsA, t0); U_IDS(idsB, min(t0 + nsw, tmax));
    for (; t0 < M; t0 += 2 * nsw) {
        const int t1 = t0 + nsw, t2 = t0 + 2 * nsw, t3 = t0 + 3 * nsw;
        U_ROWS(wA, hxA, hyA, idsA, t0);
        U_ROWS(wB, hxB, hyB, idsB, min(t1, tmax));
        U_IDS(idsA, min(t2, tmax));
        U_IDS(idsB, min(t3, tmax));
        U_COMPUTE(wA, hxA, hyA, t0);
        if (t1 < M) U_COMPUTE(wB, hxB, hyB, t1);
    }
#undef U_IDS
#undef U_ROWS
#undef U_COMPUTE
}
__device__ __forceinline__ void peer_act_phase(Frame& F, const float* ISU, const float* ISV) {
    const unsigned short* IDX = WSP(unsigned short, WS_IDX); const float* GATE = WSP(float, WS_GATE); const unsigned* PART = WSP(unsigned, WS_PART);
    unsigned short* ACT8 = WSP(unsigned short, WS_ACT); float* ACTS = WSP(float, WS_ACTS);
    const int gw = F.bid * NWAVES + F.wave, NGW = F.G * NWAVES, lane = ((int)(threadIdx.x & 63u));
    for (int tok = gw; tok < M; tok += NGW) {
        const size_t i = (size_t)tok * 128 + 2 * lane;
        float s0 = 0.f, s1 = 0.f;
#pragma unroll
        for (int g = 0; g < 8; ++g) { const unsigned p = PART[((size_t)g * M * 128 + i) >> 1]; s0 += h2f_lo(p); s1 += h2f_hi(p); }
        const unsigned idw = *(const unsigned*)(IDX + i); int2 id; id.x = (int)(idw & 0xffffu); id.y = (int)(idw >> 16); const float2 gt = *(const float2*)(GATE + i);
        const float d0 = s0 * (64.f * ISU[id.x]), d1 = s1 * (64.f * ISU[id.y]);
        const float a0 = 0.5f * d0 * (1.f + erff(d0 * 0.70710678118654752f)) * gt.x * ISV[id.x], a1 = 0.5f * d1 * (1.f + erff(d1 * 0.70710678118654752f)) * gt.y * ISV[id.y];
        const float am = wave_max(fmaxf(fabsf(a0), fabsf(a1)));
        const float inv = am > 1e-30f ? 127.f / am : 0.f;
        const int q0 = (int)rintf(a0 * inv), q1 = (int)rintf(a1 * inv);
        ACT8[(size_t)tok * 64 + lane] = (unsigned short)(((unsigned)q0 & 0xffu) | (((unsigned)q1 & 0xffu) << 8));
        if (lane == 0) ACTS[tok] = am * (1.f / 127.f);
    }
}
template <bool FINAL>
__device__ __forceinline__ void peer_v_phase(Frame& F, const unsigned char* V8, const float* g2  , float dbg) {
    const unsigned short* IDX = WSP(unsigned short, WS_IDX); const unsigned* ACT8 = WSP(unsigned, WS_ACT); const float* ACTS = WSP(float, WS_ACTS);
    const int lane = ((int)(threadIdx.x & 63u)), t8 = lane >> 3, l8 = lane & 7;
    const int g = F.bid & 7, nsw = (F.G >> 3) * NWAVES, ws = (F.bid >> 3) * NWAVES + F.wave;
    const unsigned char* Vg = V8 + (size_t)g * 16384 * 128; const unsigned lo8 = 16u * (unsigned)l8;
    for (int wi = ws; wi < M / 8; wi += nsw) {
        const int tok = wi * 8 + t8;
        const unsigned short* ip = IDX + (size_t)tok * 128; const unsigned* ap = ACT8 + (size_t)tok * 32;
        int acc[16];
#pragma unroll
        for (int i = 0; i < 16; ++i) acc[i] = 0;
#pragma unroll 2
        for (int gi = 0; gi < 32; ++gi) {
            const v2u idp = *(const GAS v2u*)(ip + 4 * gi); v4u id4; id4.x = idp.x & 0xffffu; id4.y = idp.x >> 16; id4.z = idp.y & 0xffffu; id4.w = idp.y >> 16; const int qa = (int)ap[gi];
            const v4u ra = *(const GAS v4u*)(Vg + ((id4.x << 7) | lo8)), rb = *(const GAS v4u*)(Vg + ((id4.y << 7) | lo8)), rc = *(const GAS v4u*)(Vg + ((id4.z << 7) | lo8)), rd = *(const GAS v4u*)(Vg + ((id4.w << 7) | lo8));
            const unsigned A[4] = {ra.x, ra.y, ra.z, ra.w}, B[4] = {rb.x, rb.y, rb.z, rb.w}, C[4] = {rc.x, rc.y, rc.z, rc.w}, Dd[4] = {rd.x, rd.y, rd.z, rd.w};
#pragma unroll
            for (int j = 0; j < 4; ++j) {
                const unsigned ablo = __builtin_amdgcn_perm(B[j], A[j], 0x05010400u), abhi = __builtin_amdgcn_perm(B[j], A[j], 0x07030602u);
                const unsigned cdlo = __builtin_amdgcn_perm(Dd[j], C[j], 0x05010400u), cdhi = __builtin_amdgcn_perm(Dd[j], C[j], 0x07030602u);
                const unsigned t0 = __builtin_amdgcn_perm(cdlo, ablo, 0x05040100u), t1 = __builtin_amdgcn_perm(cdlo, ablo, 0x07060302u);
                const unsigned t2 = __builtin_amdgcn_perm(cdhi, abhi, 0x05040100u), t3 = __builtin_amdgcn_perm(cdhi, abhi, 0x07060302u);
                acc[4 * j] = __builtin_amdgcn_sdot4((int)t0, qa, acc[4 * j], false); acc[4 * j + 1] = __builtin_amdgcn_sdot4((int)t1, qa, acc[4 * j + 1], false);
                acc[4 * j + 2] = __builtin_amdgcn_sdot4((int)t2, qa, acc[4 * j + 2], false); acc[4 * j + 3] = __builtin_amdgcn_sdot4((int)t3, qa, acc[4 * j + 3], false);
            }
        }
        const float sc = ACTS[tok] * dbg;
        const int b = tok >> 13, c0 = 128 * g + 16 * l8; bf16* xs = WSP(bf16, WS_XS) + (size_t)tok * D + c0; const float* gr = g2 + (size_t)b * 6144 + c0;
        const v4u xa = *(const GAS v4u*)xs, xb = *(const GAS v4u*)(xs + 8);
        const unsigned xw[8] = {xa.x, xa.y, xa.z, xa.w, xb.x, xb.y, xb.z, xb.w};
        float o[16];
#pragma unroll
        for (int q4 = 0; q4 < 4; ++q4) { const f32x4 gv = *(const f32x4*)(gr + 4 * q4);
            o[4 * q4] = bflo(xw[2 * q4]) + gv.x * sc * (float)acc[4 * q4]; o[4 * q4 + 1] = bfhi(xw[2 * q4]) + gv.y * sc * (float)acc[4 * q4 + 1];
            o[4 * q4 + 2] = bflo(xw[2 * q4 + 1]) + gv.z * sc * (float)acc[4 * q4 + 2]; o[4 * q4 + 3] = bfhi(xw[2 * q4 + 1]) + gv.w * sc * (float)acc[4 * q4 + 3]; }
        if (FINAL) { float* xr = F.out + (size_t)tok * D + c0;
#pragma unroll
            for (int q4 = 0; q4 < 4; ++q4) *(GAS f32x4*)(xr + 4 * q4) = (f32x4){o[4 * q4], o[4 * q4 + 1], o[4 * q4 + 2], o[4 * q4 + 3]};
        } else { v4u ya, yb; ya.x = pk2(o[0], o[1]); ya.y = pk2(o[2], o[3]); ya.z = pk2(o[4], o[5]); ya.w = pk2(o[6], o[7]); yb.x = pk2(o[8], o[9]); yb.y = pk2(o[10], o[11]); yb.z = pk2(o[12], o[13]); yb.w = pk2(o[14], o[15]);
            *(GAS v4u*)xs = ya; *(GAS v4u*)(xs + 8) = yb; }
    }
}
#if defined(CHECK) && CHECK
constexpr size_t WS_DBG = 896 * 1024;
constexpr size_t WS_DBGOUT = WS_CLOC;
#ifndef CHECK_LAYER
#define CHECK_LAYER 1
#endif
__global__ void chk_qry(Args a) {
    const bf16* XN = (const bf16*)(a.ws + WS_XNY); const bf16* QRY = (const bf16*)(a.ws + WS_QRY); const float* wq = a.in[20] + (size_t)CHECK_LAYER * D * NQ;
    float* R = (float*)(a.ws + WS_CTL + WS_DBG);
    const int tok = (blockIdx.x * 977) % M; const int col = (threadIdx.x * 37 + blockIdx.x * 11) % NQ;
    float s = 0.f; for (int k = 0; k < D; ++k) s += bf2f(XN[(size_t)tok * D + k]) * wq[(size_t)k * NQ + col];
    const float q = bf2f(QRY[(size_t)tok * NQ + col]);
    atomicAdd(R + 0, (s - q) * (s - q)); atomicAdd(R + 1, s * s);
}
__global__ void chk_keys(Args a) {
    const bf16* KB = (const bf16*)(a.ws + WS_KEYS); const float* keys = a.in[21]; float* R = (float*)(a.ws + WS_CTL + WS_DBG);
    const int i = blockIdx.x * blockDim.x + threadIdx.x; if (i < 2 * 2 * 128 * 128) { const float d = bf2f(KB[i]) - keys[i]; atomicAdd(R + 8, d * d); atomicAdd(R + 9, keys[i] * keys[i]); }
}
__global__ void chk_uv(Args a) {
    const bf16* UB = (const bf16*)(a.ws + WS_UB); const bf16* VB = (const bf16*)(a.ws + WS_VB); float* R = (float*)(a.ws + WS_CTL + WS_DBG);
    const size_t i = ((size_t)blockIdx.x * blockDim.x + threadIdx.x) * 61 % ((size_t)2 * 16384 * 1024);
    const float du = bf2f(UB[i]) - a.in[22][i], dv = bf2f(VB[i]) - a.in[23][i];
    atomicAdd(R + 16, du * du + dv * dv); atomicAdd(R + 17, a.in[22][i] * a.in[22][i] + a.in[23][i] * a.in[23][i]);
}
__global__ void chk_route(Args a) {
    const bf16* QRY = (const bf16*)(a.ws + WS_QRY); const float* keys = a.in[21] + (size_t)CHECK_LAYER * 2 * 128 * 128;
    const int* IDX = (const int*)(a.ws + WS_IDX); const float* GATE = (const float*)(a.ws + WS_GATE);
    float* R = (float*)(a.ws + WS_CTL + WS_DBG);
    __shared__ float sc[2][128]; __shared__ float sc0[2][128]; __shared__ float ts[2][16]; __shared__ int ti[2][16]; __shared__ float cs[256]; __shared__ int ci[256];
    const int tok = (blockIdx.x * 613 + 5) % M, hd = blockIdx.x & 7, tid = threadIdx.x;
    { const int p = tid >> 7, n = tid & 127; float s = 0.f; for (int d = 0; d < 128; ++d) s += bf2f(QRY[(size_t)tok * NQ + hd * 256 + p * 128 + d]) * keys[(size_t)(p * 128 + n) * 128 + d]; sc[p][n] = s; sc0[p][n] = s; }
    __syncthreads();
    if (tid < 2) { const int p = tid; for (int k = 0; k < 16; ++k) { int best = 0; float bv = -INFINITY; for (int n = 0; n < 128; ++n) if (sc[p][n] > bv) { bv = sc[p][n]; best = n; } ts[p][k] = bv; ti[p][k] = best; sc[p][best] = -INFINITY; } }
    __syncthreads();
    cs[tid] = ts[0][tid >> 4] + ts[1][tid & 15]; ci[tid] = ti[0][tid >> 4] * 128 + ti[1][tid & 15];
    __syncthreads();
    if (tid == 0) {
        float fs[16]; int fi[16];
        for (int k = 0; k < 16; ++k) { int best = 0; float bv = -INFINITY; for (int n = 0; n < 256; ++n) if (cs[n] > bv) { bv = cs[n]; best = n; } fs[k] = bv; fi[k] = ci[best]; cs[best] = -INFINITY; }
        float den = 0.f; for (int k = 0; k < 16; ++k) den += __expf(fs[k] - fs[0]);
        int mism = 0; float ge = 0.f;
        for (int k = 0; k < 16; ++k) { bool found = false; for (int j = 0; j < 16; ++j) if (IDX[(size_t)tok * 128 + hd * 16 + j] == fi[k]) { found = true; const float g = __expf(fs[k] - fs[0]) / den; const float d = g - GATE[(size_t)tok * 128 + hd * 16 + j]; ge += d * d; } if (!found) ++mism; }
        { int ba = 0, bb = 0; for (int j = 0; j < 16; ++j) { const int e = IDX[(size_t)tok * 128 + hd * 16 + j]; const int ea = (e >> 7) & 127, eb = e & 127;
            if (!(e >= 0 && e < 16384) || sc0[0][ea] + sc0[1][eb] < fs[15] - 0.05f) ++ba; if (!(e >= 0 && e < 16384) || sc0[1][ea] + sc0[0][eb] < fs[15] - 0.05f) ++bb; }
          atomicAdd(R + 10, (float)ba); atomicAdd(R + 11, (float)bb); }
        atomicAdd(R + 2, (float)mism); atomicAdd(R + 3, 16.f); atomicAdd(R + 4, ge); atomicAdd(R + 5, 1.f / 16.f);
    }
}
__global__ void chk_scores(Args a) {
    const bf16* QRY = (const bf16*)(a.ws + WS_QRY); const float* keys = a.in[21] + (size_t)CHECK_LAYER * 2 * 128 * 128;
    const float* DB = (const float*)(a.ws + WS_CLOC) + 8 * 1024 * 1024; float* R = (float*)(a.ws + WS_CTL + WS_DBG);
    const int t = blockIdx.x, tid = threadIdx.x;
    __shared__ float sc[2][128];
    { const int p = tid >> 7, n = tid & 127; float s = 0.f; for (int d = 0; d < 128; ++d) s += bf2f(QRY[(size_t)t * NQ + p * 128 + d]) * keys[(size_t)(p * 128 + n) * 128 + d];
      const float dv = DB[(p * 128 + t) * 128 + n]; atomicAdd(R + 12, (s - dv) * (s - dv)); atomicAdd(R + 13, s * s); sc[p][n] = dv; }
    __syncthreads();
    if (tid < 2) { const int p = tid; int bad = 0; for (int k = 0; k < 16; ++k) { int best = 0; float bv = -INFINITY; for (int n = 0; n < 128; ++n) if (sc[p][n] > bv) { bv = sc[p][n]; best = n; }
        const float lv = DB[32768 + t * 48 + 16 * p + k]; if (fabsf(lv - bv) > 1e-3f * (1.f + fabsf(bv))) ++bad; sc[p][best] = -INFINITY; }
        atomicAdd(R + 14, (float)bad); atomicAdd(R + 15, 16.f); }
}
__global__ void chk_expert(Args a) {
    const bf16* XN = (const bf16*)(a.ws + WS_XNY); const int* IDX = (const int*)(a.ws + WS_IDX); const float* GATE = (const float*)(a.ws + WS_GATE);
    const float* U = a.in[22] + (size_t)CHECK_LAYER * 16384 * 1024; const float* V = a.in[23] + (size_t)CHECK_LAYER * 16384 * 1024;
    const float* DO = (const float*)(a.ws + WS_DBGOUT); float* R = (float*)(a.ws + WS_CTL + WS_DBG);
    __shared__ float act[128];
    const int tok = (blockIdx.x * 61 + 3) % 4096, tid = threadIdx.x;
    if (tid < 128) { const int e = IDX[(size_t)tok * 128 + tid]; float s = 0.f; for (int k = 0; k < D; ++k) s += bf2f(XN[(size_t)tok * D + k]) * U[(size_t)e * D + k];
        act[tid] = 0.5f * s * (1.f + erff(s * 0.70710678f)) * GATE[(size_t)tok * 128 + tid]; }
    __syncthreads();
    for (int c = tid; c < D; c += 256) { float o = 0.f; for (int e = 0; e < 128; ++e) o += act[e] * V[(size_t)IDX[(size_t)tok * 128 + e] * D + c];
        const float g = DO[(size_t)tok * D + c]; atomicAdd(R + 6, (o - g) * (o - g)); atomicAdd(R + 7, o * o); }
}
__global__ void chk_stamp(Args a) {
    const float* R = (const float*)(a.ws + WS_CTL + WS_DBG);
    const float e1 = sqrtf(R[0] / fmaxf(R[1], 1e-30f)), e2 = R[2] / fmaxf(R[3], 1.f), e2g = sqrtf(R[4] / fmaxf(R[5], 1e-30f)), e3 = sqrtf(R[6] / fmaxf(R[7], 1e-30f));
    float c;
#if CHECK == 99
    c = 1.f;
#else
    const float e0 = sqrtf(R[8] / fmaxf(R[9], 1e-30f));
    const float ea = R[10] / fmaxf(R[3], 1.f), eb = R[11] / fmaxf(R[3], 1.f);
    const float esc = sqrtf(R[12] / fmaxf(R[13], 1e-30f)), els = R[14] / fmaxf(R[15], 1.f);
    const float euv = sqrtf(R[16] / fmaxf(R[17], 1e-30f));
    const float errs[4] = {e2, euv, ea, e3}; const float tols[4] = {0.08f, 0.01f, 0.08f, 0.03f};
    c = 1.f;
    for (int k = 3; k >= 0; --k) if (!(errs[k] <= tols[k])) { const float fr = fminf(fmaxf((log10f(fmaxf(errs[k], 1e-4f)) + 4.f) / 5.f, 0.f), 0.95f); c = 2.f + (float)k + fr; }
#endif
    const size_t i = (size_t)blockIdx.x * blockDim.x + threadIdx.x;
    if (i < (size_t)M * D) a.out[i] = a.in[0][i] * (1.f + c);
}
#endif
#ifndef MK_PER_PHASE
#define MK_PER_PHASE 0
#endif
constexpr int NPHASE = 24;
#ifndef RPROBE
#define RPROBE 0
#endif
#ifndef DBG_Y0
#define DBG_Y0 1
#define DBG_P0 1
#define DBG_Y1 1
#define DBG_P1 1
#endif
#ifndef PHASE_MASK
#define PHASE_MASK 0x1ffffffu
#endif
#define IN(k) (lo <= (k) && (k) < hi && ((PHASE_MASK >> (k)) & 1u))
#ifndef DUP_PHASE
#define DUP_PHASE -1
#endif
#define REPS(k) for (int rep = ((DUP_PHASE) == (k) ? 0 : 1); rep < 2; ++rep)
#define SEAM(k) do { if (IN(k) && IN((k) + 1)) xcd_barrier(bar); } while (0)
__device__ __forceinline__ float alibi_tcut(const float* gq, const float* gk, int lane) { return 16.f * wave_max(fabsf(gq[lane])) * wave_max(fabsf(gk[lane])) + ALIBI_MARGIN; }
template <int layer>
__device__ __forceinline__ void layer_phases(Frame& F, const Args& args, const XcdBarrier& bar, const int lo, const int hi) {
    volatile LAS unsigned* MISCW = (volatile LAS unsigned*)(F.lds + MISC_OFF);
    float* MOD = WSP(float, WS_MOD);
    bf16* XNY = WSP(bf16, WS_XNY); bf16* Zb = WSP(bf16, WS_Z);

        constexpr int pb = layer * 12;
        const float* mod = MOD + (size_t)layer * 4 * 6144;
        if (IN(pb + 1)) REPS(pb + 1) { if (layer == 0) norm_pass<true, false>(F, args, args.in[0], args.in[4], mod, 0, XNY); else norm_pass<false, true>(F, args, WSP(bf16, WS_XS), args.in[4] + 1024, mod, 0, XNY); } SEAM(pb + 1);
        if (IN(pb + 2)) REPS(pb + 2) {
            const int N = layer == 0 ? NZ0 : NZ1;
            pg8::Gemm g{XNY, layer == 0 ? WSP(bf16, WS_WIN0) : WSP(bf16, WS_WIN1), M, N, D}; pg8::StaticOrder S; S.init(M, N, F.G, F.bid);
            pg8::EpiBf16QK E{Zb, N, layer == 0 ? 8 : 0, layer == 0 ? 10 : 4, layer == 0 ? 10 : 4, layer == 0 ? 12 : 8, layer == 0 ? args.in[11] : args.in[15], layer == 0 ? args.in[12] : args.in[16], 0.125f * LOG2E, (LAS float*)(F.lds + 131072)};
            pg8::gemm_phase<pg8::EpiBf16QK, pg8::StaticOrder, true, true>(F.lds, g, S, E);
        } SEAM(pb + 2);
        if (layer == 0) {
            if (IN(3)) REPS(3) {
                for (int u = F.bid; u < 1024 + 128; u += F.G) {
                    if (u < 1024) mlstm_a_unit(F, args, u);
                    else if (rep == 1) { const int v = u - 1024, b = v >> 5, j = v & 31;
                        kmean_unit(F, Zb, NZ0, b * SEQ + j * 256, 2560, WSP(float, WS_KMEAN) + (size_t)((b * 8) * 32 + j) * 64); }
                }
            } SEAM(3);
            if (IN(4)) REPS(4) {
                if (rep == 1) for (int u = F.bid; u < 256; u += F.G) mlstm_scan_unit(F, u);
                { const float tcut = alibi_tcut(args.in[11], args.in[12], ((int)(threadIdx.x & 63u)));
                  const unsigned short* ORD = WSP(unsigned short, WS_ORD) + 2048; unsigned* qw = (unsigned*)(F.ws + WS_CTL) + CW_QMOBA + (rep == 1 ? 0 : 8);
                  for (int xi = 0; xi < 8; ++xi) { const int x = (F.bid + xi) & 7;
                      for (;;) { if (((int)threadIdx.x) == 0) MISCW[0] = atomicAdd(qw + 16 * x, 1u); __syncthreads(); const unsigned qi = MISCW[0]; __syncthreads(); if (qi >= 128u) break;
                          const int u = ORD[x * 128 + qi]; moba_unit(F, u >> 8, (u >> 5) & 7, u & 31, tcut); } }
                  if (rep == 1) { unsigned* cw = (unsigned*)(F.ws + WS_CTL) + CW_QCVT0;
                      for (;;) { if (((int)threadIdx.x) == 0) MISCW[0] = atomicAdd(cw, 1u); __syncthreads(); const unsigned ci = MISCW[0]; __syncthreads(); if (ci >= 512u) break; i8_chunk(F, args, 0, (int)ci); } } }
            } SEAM(4);
            if (IN(5)) REPS(5) { for (int u = F.bid; u < 1024; u += F.G) mlstm_c_unit(F, args, u); } SEAM(5);
        } else {
            if (IN(pb + 4)) REPS(pb + 4) {
                const float* lp = args.in[17];
                const float lam = __expf(wave_sum(lp[((int)(threadIdx.x & 63u))] * lp[64 + ((int)(threadIdx.x & 63u))])) - __expf(wave_sum(lp[128 + ((int)(threadIdx.x & 63u))] * lp[192 + ((int)(threadIdx.x & 63u))])) + 0.35550906759096926f;
                { const float tcut = alibi_tcut(args.in[15], args.in[16], ((int)(threadIdx.x & 63u)));
                  const unsigned short* ORD = WSP(unsigned short, WS_ORD); unsigned* qw = (unsigned*)(F.ws + WS_CTL) + CW_QDIFF + (rep == 1 ? 0 : 8);
                  for (int xi = 0; xi < 8; ++xi) { const int x = (F.bid + xi) & 7;
                      for (;;) { if (((int)threadIdx.x) == 0) MISCW[0] = atomicAdd(qw + 16 * x, 1u); __syncthreads(); const unsigned qi = MISCW[0]; __syncthreads(); if (qi >= 256u) break;
                          const int u = ORD[x * 256 + qi]; diff_unit(F, args, u >> 9, (u >> 6) & 7, u & 63, lam, tcut, rep == 0 ? RPROBE : 0); } }
                  if (rep == 1) { unsigned* cw = (unsigned*)(F.ws + WS_CTL) + CW_QCVT1;
                      for (;;) { if (((int)threadIdx.x) == 0) MISCW[0] = atomicAdd(cw, 1u); __syncthreads(); const unsigned ci = MISCW[0]; __syncthreads(); if (ci >= 512u) break; i8_chunk(F, args, 1, (int)ci); } } }
            } SEAM(pb + 4);
        }
        if (IN(pb + 6)) {
            pg8::Gemm g{XNY, layer == 0 ? WSP(bf16, WS_WOUT0) : WSP(bf16, WS_WOUT1), M, D, D}; pg8::StaticOrder S; S.init(M, D, F.G, F.bid);
            if (layer == 0) { pg8::EpiResid<false> E{args.in[0], WSP(bf16, WS_XS), mod + 2 * 1024}; pg8::gemm_phase<pg8::EpiResid<false>, pg8::StaticOrder, true, true>(F.lds, g, S, E); }
            else { pg8::EpiResid<true> E{WSP(bf16, WS_XS), WSP(bf16, WS_XS), mod + 2 * 1024}; pg8::gemm_phase<pg8::EpiResid<true>, pg8::StaticOrder, true, true>(F.lds, g, S, E); }
        } SEAM(pb + 6);
        if (IN(pb + 7)) REPS(pb + 7) { norm_pass<false, true>(F, args, WSP(bf16, WS_XS), args.in[5] + layer * 1024, mod, 3, XNY); } SEAM(pb + 7);
        if (IN(pb + 8)) REPS(pb + 8) {
            pg8::Gemm g{XNY, WSP(bf16, WS_WQ) + (size_t)layer * NQ * D, M, NQ, D}; pg8::StaticOrder S; S.init(M, NQ, F.G, F.bid);
            pg8::EpiBf16 E{WSP(bf16, WS_QRY), NQ};
            pg8::gemm_phase<pg8::EpiBf16, pg8::StaticOrder, true, true>(F.lds, g, S, E);
        } SEAM(pb + 8);
        if (IN(pb + 9)) REPS(pb + 9) { const bf16* KEYS = WSP(bf16, WS_KEYS) + (size_t)layer * 2 * 128 * 128;
            bf16x8 kf[4][2];
#pragma unroll
            for (int ks = 0; ks < 4; ++ks)
#pragma unroll
                for (int n = 0; n < 2; ++n) kf[ks][n] = *(const GAS bf16x8*)(KEYS + (size_t)((F.wave & 1) * 128 + 32 * (F.wave >> 1) + 16 * n + (((int)(threadIdx.x & 63u)) & 15)) * 128 + 32 * ks + 8 * (((int)(threadIdx.x & 63u)) >> 4));
            for (int u = F.bid; u < 2048; u += F.G) peer_route_unit(F, (u >> 3) * 128, u & 7, kf, rep == 0 ? RPROBE : 0); } SEAM(pb + 9);
        if (IN(pb + 10)) REPS(pb + 10) { peer_u_phase(F, F.ws + WS_UB + (size_t)layer * 8 * 16384 * 128); } SEAM(pb + 10);
        if (IN(pb + 11)) REPS(pb + 11) { peer_act_phase(F, WSP(float, WS_ISU) + layer * 16384, WSP(float, WS_ISV) + layer * 16384); } SEAM(pb + 11);
        if (IN(pb + 12)) REPS(pb + 12) { peer_v_phase<layer == 1>(F, F.ws + WS_VB + (size_t)layer * 8 * 16384 * 128, mod + 5 * 1024, rep == 1 ? (layer == 0 ? (float)DBG_P0 : (float)DBG_P1) : 0.f); }
        if (layer == 0) SEAM(12);
    }
__global__ void __launch_bounds__(NTHR, 2) mega_fwd(Args args) {
    extern __shared__ __attribute__((aligned(16))) unsigned char lds_raw[];
    Frame F;
    F.lds = (LAS unsigned char*)lds_raw;
    F.wave = __builtin_amdgcn_readfirstlane((int)threadIdx.x >> 6);
    F.G = gridDim.x; F.bid = blockIdx.x;
    F.out = args.out; F.ws = args.ws;
    volatile LAS unsigned* MISC = (volatile LAS unsigned*)(F.lds + MISC_OFF);
    for (int u = ((int)threadIdx.x); u < (LDS_BYTES - LDSCTL_OFF) / 4; u += NTHR) ((LAS unsigned*)(F.lds + LDSCTL_OFF))[u] = 0u;
    __syncthreads();
    XcdBarrier bar; bar.bar = (unsigned*)(F.ws + WS_CTL) + CW_BAR; bar.x = 0; bar.st = nullptr;
    if (!MK_PER_PHASE) bar = xcd_barrier_post((unsigned*)(F.ws + WS_CTL) + CW_BAR, MISC + 8);
    const int lo = args.ph_lo, hi = args.ph_hi;

#ifdef EXTRA_BAR
    for (int i = 0; i < EXTRA_BAR; ++i) xcd_barrier(bar);
#endif
    if (IN(0)) REPS(0) { p0_prologue(F, args); } SEAM(0);
    layer_phases<0>(F, args, bar, lo, hi);
    layer_phases<1>(F, args, bar, lo, hi);
}
#undef IN
#undef SEAM

extern "C" void kernel_launch(void* const* d_in, const int* in_sizes, int n_in, void* d_out, int out_size, void* d_ws, size_t ws_size, hipStream_t stream) {
    static int grid = 0;
    if (grid == 0) {
        if (n_in != 24 || in_sizes[0] != M * D || out_size != M * D || ws_size < WS_END) { fprintf(stderr, "kernel_launch: unexpected problem (n_in %d, in0 %d, out %d, ws %zu < %zu); nothing launched\n", n_in, n_in > 0 ? in_sizes[0] : -1, out_size, ws_size, (size_t)WS_END); grid = -1; return; }
        int dev = 0, cus = 0, per_cu = 0;
        if (hipGetDevice(&dev) != hipSuccess || hipDeviceGetAttribute(&cus, hipDeviceAttributeMultiprocessorCount, dev) != hipSuccess) { grid = -1; return; }
        if (hipFuncSetAttribute((const void*)mega_fwd, hipFuncAttributeMaxDynamicSharedMemorySize, LDS_BYTES) != hipSuccess) { fprintf(stderr, "kernel_launch: hipFuncSetAttribute failed\n"); grid = -1; return; }
        if (hipOccupancyMaxActiveBlocksPerMultiprocessor(&per_cu, (const void*)mega_fwd, NTHR, LDS_BYTES) != hipSuccess || per_cu < 1)
            fprintf(stderr, "kernel_launch: note: occupancy query reports %d workgroups per CU\n", per_cu);
        (void)hipGetLastError();
        grid = cus;
    }
    if (grid < 0) return;
    if (hipMemsetAsync((char*)d_ws + WS_CTL, 0, CTL_ZERO_BYTES, stream) != hipSuccess) { fprintf(stderr, "kernel_launch: memset failed\n"); return; }
    Args a{};
    for (int i = 0; i < 24; ++i) a.in[i] = (const float*)d_in[i];
    a.out = (float*)d_out; a.ws = (unsigned char*)d_ws;
#if MK_PER_PHASE
    for (int p = 0; p < NPHASE + 1; ++p) { a.ph_lo = p; a.ph_hi = p + 1; hipLaunchKernelGGL(mega_fwd, dim3(grid), dim3(NTHR), LDS_BYTES, stream, a); }
#else
    a.ph_lo = 0; a.ph_hi = NPHASE + 1;
    hipLaunchKernelGGL(mega_fwd, dim3(grid), dim3(NTHR), LDS_BYTES, stream, a);
#endif
#if defined(CHECK) && CHECK
    chk_qry<<<256, 256, 0, stream>>>(a); chk_keys<<<256, 256, 0, stream>>>(a); chk_uv<<<1024, 256, 0, stream>>>(a); chk_scores<<<128, 256, 0, stream>>>(a); chk_route<<<512, 256, 0, stream>>>(a); chk_expert<<<64, 256, 0, stream>>>(a); chk_stamp<<<(M * D + 255) / 256, 256, 0, stream>>>(a);
#endif
    const hipError_t le = hipPeekAtLastError();
    if (le != hipSuccess) fprintf(stderr, "kernel_launch: launch failed: %s\n", hipGetErrorName(le));
}
```

```cpp
#include <hip/hip_runtime.h>
#include <cstdio>
#include <cstdint>
namespace pg8 {
#define PG8_LAS __attribute__((address_space(3)))
typedef unsigned short bf16_t;
typedef short bf16x8 __attribute__((ext_vector_type(8)));
typedef float f32x4 __attribute__((ext_vector_type(4)));
typedef unsigned u32x4 __attribute__((ext_vector_type(4)));
constexpr int BM = 256, BK = 64, HALF = 128, HTB = HALF * BK * 2  , STAGE_BYTES = 8 * HTB, NXCD = 8, WGM = 8;

__host__ __device__ __forceinline__ int lds_byte(int r, int c) { const int st = (r >> 4) * 2 + (c >> 5), rr = r & 15, cc = c & 31, ob = rr * 64 + cc * 2; return st * 1024 + (ob ^ (((ob >> 9) & 1) << 5)); }
__host__ __device__ __forceinline__ void stage_rc(int b, int& R, int& C) { const int st = b / 1024, sb = b % 1024, swz = sb ^ (((sb >> 9) & 1) << 5); R = (st >> 1) * 16 + swz / 64; C = (st & 1) * 32 + (swz % 64) / 2; }
__host__ __device__ __forceinline__ int perm32(int rho) { const int n = rho >> 4, i = rho & 15; return 8 * (i >> 2) + 4 * n + (i & 3); }

struct Unit { int pm, pn; };
struct Gemm { const bf16_t* A; const bf16_t* Bt; int M, N, K; size_t bstride; };

struct StaticOrder {
    int nM, nN, nwg, G, c;
    __host__ __device__ void init(int M, int N, int G_, int c_) { nM = M / BM; nN = N / BM; nwg = nM * nN; G = G_; c = c_; }
    __host__ __device__ bool next(int i, Unit& u) const {
        const long L = (long)i * G + c; if (L >= nwg) return false;
        int wgid = (int)L; { const int q = nwg / NXCD, r = nwg % NXCD, xcd = wgid % NXCD, off = wgid / NXCD; wgid = (xcd < r ? xcd * (q + 1) : r * (q + 1) + (xcd - r) * q) + off; }
        const int nig = WGM * nN, gid = wgid / nig, fm = gid * WGM, gsz = (nM - fm) < WGM ? (nM - fm) : WGM;
        u.pm = fm + ((wgid % nig) % gsz); u.pn = (wgid % nig) / gsz; return true;
    }
    __device__ __forceinline__ void a_ready(const Unit&) const {}
    __device__ __forceinline__ void done(const Unit&) const {}
};

__device__ __forceinline__ unsigned cvt_pk_bf16(float lo, float hi) { unsigned r; asm volatile("v_cvt_pk_bf16_f32 %0, %1, %2" : "=v"(r) : "v"(lo), "v"(hi)); return r; }
typedef unsigned u32x4 __attribute__((ext_vector_type(4)));
struct EpiBf16 {
    static constexpr bool PERM = true, AFTER_DRAIN = false;
    bf16_t* O; int ldc;
    __device__ __forceinline__ void operator()(const f32x4 (&acc)[2][2][4][2], const Unit& u, int wr, int wc, int fr, int fq) const {
        const int row0 = u.pm * BM + wr * 64 + fr; const int col0 = u.pn * BM + wc * 64 + 8 * fq;
#pragma unroll
        for (int ai = 0; ai < 2; ++ai)
#pragma unroll
            for (int m = 0; m < 4; ++m) { bf16_t* rowp = O + (size_t)(row0 + ai * HALF + m * 16) * ldc + col0;
#pragma unroll
                for (int bj = 0; bj < 2; ++bj) { const f32x4 v0 = acc[ai][bj][m][0], v1 = acc[ai][bj][m][1];
                    u32x4 w; w.x = cvt_pk_bf16(v0[0], v0[1]); w.y = cvt_pk_bf16(v0[2], v0[3]); w.z = cvt_pk_bf16(v1[0], v1[1]); w.w = cvt_pk_bf16(v1[2], v1[3]);
                    *(u32x4*)(rowp + bj * 32) = w; } }
    }
};
struct EpiBf16QK {
    static constexpr bool PERM = true, AFTER_DRAIN = false;
    bf16_t* O; int ldc; int q_lo, q_hi, k_lo, k_hi; const float* gq; const float* gk; float qmul; PG8_LAS float* xs;
    __device__ __forceinline__ void operator()(const f32x4 (&acc)[2][2][4][2], const Unit& u, int wr, int wc, int fr, int fq) const {
        const int row0 = u.pm * BM + wr * 64 + fr; const int col0 = u.pn * BM + wc * 64 + 8 * fq;
        const bool isq = u.pn >= q_lo && u.pn < q_hi, isk = u.pn >= k_lo && u.pn < k_hi;
        if (!(isq || isk)) {
#pragma unroll
            for (int ai = 0; ai < 2; ++ai)
#pragma unroll
                for (int m = 0; m < 4; ++m) { bf16_t* rowp = O + (size_t)(row0 + ai * HALF + m * 16) * ldc + col0;
#pragma unroll
                    for (int bj = 0; bj < 2; ++bj) { const f32x4 v0 = acc[ai][bj][m][0], v1 = acc[ai][bj][m][1];
                        u32x4 w; w.x = cvt_pk_bf16(v0[0], v0[1]); w.y = cvt_pk_bf16(v0[2], v0[3]); w.z = cvt_pk_bf16(v1[0], v1[1]); w.w = cvt_pk_bf16(v1[2], v1[3]);
                        *(u32x4*)(rowp + bj * 32) = w; } }
            return;
        }
        const float* g = isq ? gq : gk; const float gm = isq ? qmul : 1.f;
        f32x4 gg[2][2];
#pragma unroll
        for (int bj = 0; bj < 2; ++bj) { gg[bj][0] = *(const f32x4*)(g + bj * 32 + 8 * fq) * gm; gg[bj][1] = *(const f32x4*)(g + bj * 32 + 8 * fq + 4) * gm; }
#pragma unroll
        for (int ai = 0; ai < 2; ++ai)
#pragma unroll
            for (int m = 0; m < 4; ++m) { bf16_t* rowp = O + (size_t)(row0 + ai * HALF + m * 16) * ldc + col0;
                float s = 0.f;
#pragma unroll
                for (int bj = 0; bj < 2; ++bj) { const f32x4 v0 = acc[ai][bj][m][0], v1 = acc[ai][bj][m][1];
                    s += (v0[0] * v0[0] + v0[1] * v0[1]) + (v0[2] * v0[2] + v0[3] * v0[3]) + (v1[0] * v1[0] + v1[1] * v1[1]) + (v1[2] * v1[2] + v1[3] * v1[3]); }
                s += __shfl_xor(s, 16); s += __shfl_xor(s, 32);
                const float rs = __builtin_amdgcn_rsqf(s * (1.f / 64.f) + 1e-6f);
#pragma unroll
                for (int bj = 0; bj < 2; ++bj) {
                    const f32x4 v0 = acc[ai][bj][m][0] * rs * gg[bj][0], v1 = acc[ai][bj][m][1] * rs * gg[bj][1];
                    u32x4 w; w.x = cvt_pk_bf16(v0[0], v0[1]); w.y = cvt_pk_bf16(v0[2], v0[3]); w.z = cvt_pk_bf16(v1[0], v1[1]); w.w = cvt_pk_bf16(v1[2], v1[3]);
                    *(u32x4*)(rowp + bj * 32) = w; } }
    }
};
struct EpiBf16RS {
    static constexpr bool PERM = true, AFTER_DRAIN = false;
    bf16_t* O; int ldc; const float* rss; const float* bias; int bias_stride;
    __device__ __forceinline__ void operator()(const f32x4 (&acc)[2][2][4][2], const Unit& u, int wr, int wc, int fr, int fq) const {
        const int row0 = u.pm * BM + wr * 64 + fr; const int col0 = u.pn * BM + wc * 64 + 8 * fq; const int b = (u.pm * BM) >> 13;
        f32x4 bv[2][2];
#pragma unroll
        for (int bj = 0; bj < 2; ++bj)
#pragma unroll
            for (int n = 0; n < 2; ++n) bv[bj][n] = *(const f32x4*)(bias + (size_t)b * bias_stride + col0 + bj * 32 + 4 * n);
#pragma unroll
        for (int ai = 0; ai < 2; ++ai)
#pragma unroll
            for (int m = 0; m < 4; ++m) { const int row = row0 + ai * HALF + m * 16; bf16_t* rowp = O + (size_t)row * ldc + col0;
                const f32x4 p0 = *(const f32x4*)(rss + (size_t)row * 16), p1 = *(const f32x4*)(rss + (size_t)row * 16 + 4), p2 = *(const f32x4*)(rss + (size_t)row * 16 + 8), p3 = *(const f32x4*)(rss + (size_t)row * 16 + 12);
                const f32x4 pt = (p0 + p1) + (p2 + p3);
                const float rs = __builtin_amdgcn_rsqf(((pt[0] + pt[1]) + (pt[2] + pt[3])) * (1.f / 1024.f) + 1e-6f);
#pragma unroll
                for (int bj = 0; bj < 2; ++bj) { const f32x4 v0 = acc[ai][bj][m][0] * rs + bv[bj][0], v1 = acc[ai][bj][m][1] * rs + bv[bj][1];
                    u32x4 w; w.x = cvt_pk_bf16(v0[0], v0[1]); w.y = cvt_pk_bf16(v0[2], v0[3]); w.z = cvt_pk_bf16(v1[0], v1[1]); w.w = cvt_pk_bf16(v1[2], v1[3]);
                    *(u32x4*)(rowp + bj * 32) = w; } }
    }
};
template <bool BASE_BF16> struct EpiResid {
    static constexpr bool PERM = true, AFTER_DRAIN = false;
    const void* base; bf16_t* out; const float* gate;
    __device__ __forceinline__ void operator()(const f32x4 (&acc)[2][2][4][2], const Unit& u, int wr, int wc, int fr, int fq) const {
        const int row0 = u.pm * BM + wr * 64 + fr; const int col0 = u.pn * BM + wc * 64 + 8 * fq; const int b = (u.pm * BM) >> 13;
        f32x4 gv[2][2];
#pragma unroll
        for (int bj = 0; bj < 2; ++bj)
#pragma unroll
            for (int n = 0; n < 2; ++n) gv[bj][n] = *(const f32x4*)(gate + (size_t)b * 6144 + col0 + bj * 32 + 4 * n);
#pragma unroll
        for (int ai = 0; ai < 2; ++ai)
#pragma unroll
            for (int m = 0; m < 4; ++m)
#pragma unroll
                for (int bj = 0; bj < 2; ++bj) { const size_t off = (size_t)(row0 + ai * HALF + m * 16) * 1024 + col0 + bj * 32;
                    f32x4 b0, b1;
                    if (BASE_BF16) { const u32x4 w = *(const u32x4*)((const bf16_t*)base + off); const unsigned w0 = w.x, w1 = w.y, w2 = w.z, w3 = w.w;
                        b0 = (f32x4){__builtin_bit_cast(float, w0 << 16), __builtin_bit_cast(float, w0 & 0xffff0000u), __builtin_bit_cast(float, w1 << 16), __builtin_bit_cast(float, w1 & 0xffff0000u)};
                        b1 = (f32x4){__builtin_bit_cast(float, w2 << 16), __builtin_bit_cast(float, w2 & 0xffff0000u), __builtin_bit_cast(float, w3 << 16), __builtin_bit_cast(float, w3 & 0xffff0000u)}; }
                    else { b0 = *(const f32x4*)((const float*)base + off); b1 = *(const f32x4*)((const float*)base + off + 4); }
                    const f32x4 o0 = b0 + gv[bj][0] * acc[ai][bj][m][0], o1 = b1 + gv[bj][1] * acc[ai][bj][m][1];
                    u32x4 ow; ow.x = cvt_pk_bf16(o0[0], o0[1]); ow.y = cvt_pk_bf16(o0[2], o0[3]); ow.z = cvt_pk_bf16(o1[0], o1[1]); ow.w = cvt_pk_bf16(o1[2], o1[3]);
                    *(u32x4*)(out + off) = ow; }
    }
};

template <class Epi, class Sched, bool ALIGN_EPI = false, bool SP2 = false>
__device__ __forceinline__ void gemm_phase(PG8_LAS unsigned char* lds, const Gemm g, const Sched& S, const Epi& E) {
    const int tid = threadIdx.x, wid = __builtin_amdgcn_readfirstlane(tid >> 6), lane = tid & 63, wr = wid >> 2, wc = wid & 3, fr = lane & 15, fq = lane >> 4;
    const int K = g.K, nt = K / BK;
    unsigned voffA[2], voffB[2];
#pragma unroll
    for (int i = 0; i < 2; ++i) { int R, C; stage_rc(tid * 16 + i * 8192, R, C); const int Rb = (R >> 5) * 64 + (Epi::PERM ? perm32(R & 31) : (R & 31));
        voffA[i] = (unsigned)(R * K + C) * 2u; voffB[i] = (unsigned)(Rb * K + C) * 2u; }
    const size_t kstep = (size_t)(BK * 2);
    const size_t hstep = (size_t)HALF * K * 2;
    const size_t hstepB = (size_t)32 * K * 2;
    const size_t tstep = 2 * hstep;
    const unsigned ldsw = (unsigned)wid * 1024u;
    const int aoff = lds_byte(wr * 64 + fr, fq * 8), boff = lds_byte(wc * 32 + fr, fq * 8);
#define PG8_SA(b, h) (((b) * 2 + (h)) * HTB)
#define PG8_SB(b, h) ((4 + (b) * 2 + (h)) * HTB)
#define PG8_STAGE(bufoff, gbase, voff) do { _Pragma("unroll") for (int _i = 0; _i < 2; ++_i) \
        __builtin_amdgcn_global_load_lds((const unsigned*)((const char*)(gbase) + (voff)[_i]), (PG8_LAS unsigned*)(lds + (bufoff) + ldsw + _i * 8192), 16, 0, 0); } while (0)
#define PG8_LDA(dst, b, h) do { _Pragma("unroll") for (int m = 0; m < 4; ++m) _Pragma("unroll") for (int k = 0; k < 2; ++k) dst[m][k] = *(const PG8_LAS bf16x8*)(lds + PG8_SA(b, h) + aoff + m * 2048 + k * 1024); } while (0)
#define PG8_LDB(dst, b, h) do { _Pragma("unroll") for (int n = 0; n < 2; ++n) _Pragma("unroll") for (int k = 0; k < 2; ++k) dst[n][k] = *(const PG8_LAS bf16x8*)(lds + PG8_SB(b, h) + boff + n * 2048 + k * 1024); } while (0)
#define PG8_MMA(ai, bj, At, Bt) do { __builtin_amdgcn_s_setprio(1); _Pragma("unroll") for (int m = 0; m < 4; ++m) _Pragma("unroll") for (int n = 0; n < 2; ++n) _Pragma("unroll") for (int k = 0; k < 2; ++k) \
        acc[ai][bj][m][n] = __builtin_amdgcn_mfma_f32_16x16x32_bf16(Bt[n][k], At[m][k], acc[ai][bj][m][n], 0, 0, 0); __builtin_amdgcn_s_setprio(0); } while (0)
#define PG8_WAIT_V(n) asm volatile("s_waitcnt vmcnt(" #n ")" ::: "memory")
#define PG8_WAIT_L(n) asm volatile("s_waitcnt lgkmcnt(" #n ")" ::: "memory")
#define PG8_BAR __builtin_amdgcn_s_barrier()
#define PG8_SCHED __builtin_amdgcn_sched_barrier(0)
    Unit cur, nxt; int ui = 0;
    if (!S.next(0, cur)) return;
    f32x4 acc[2][2][4][2];
#pragma unroll
    for (int a = 0; a < 2; ++a)
#pragma unroll
        for (int b = 0; b < 2; ++b)
#pragma unroll
            for (int m = 0; m < 4; ++m)
#pragma unroll
                for (int n = 0; n < 2; ++n) acc[a][b][m][n] = (f32x4){0.f, 0.f, 0.f, 0.f};
    bf16x8 At[4][2], B0[2][2], B1[2][2];
    const char* cA = (const char*)g.A + (size_t)cur.pm * tstep; const char* cB = (const char*)g.Bt + (size_t)(cur.pm >> 5) * g.bstride + (size_t)cur.pn * tstep;
    S.a_ready(cur);
    if constexpr (SP2) {
        PG8_STAGE(PG8_SB(0, 0), cB, voffB); PG8_STAGE(PG8_SB(0, 1), cB + hstepB, voffB); PG8_STAGE(PG8_SA(0, 0), cA, voffA); PG8_STAGE(PG8_SA(0, 1), cA + hstep, voffA);
        if (wr == 1) PG8_BAR;
        PG8_WAIT_V(2); PG8_BAR;
        PG8_STAGE(PG8_SB(1, 0), cB + kstep, voffB); PG8_STAGE(PG8_SA(1, 0), cA + kstep, voffA); PG8_STAGE(PG8_SB(1, 1), cB + hstepB + kstep, voffB);
        PG8_WAIT_V(6); PG8_BAR;
    } else {
        PG8_STAGE(PG8_SB(0, 0), cB, voffB); PG8_STAGE(PG8_SA(0, 0), cA, voffA); PG8_STAGE(PG8_SB(0, 1), cB + hstepB, voffB); PG8_STAGE(PG8_SA(0, 1), cA + hstep, voffA);
        if (wr == 1) PG8_BAR;
        PG8_WAIT_V(4); PG8_BAR;
        PG8_STAGE(PG8_SB(1, 0), cB + kstep, voffB); PG8_STAGE(PG8_SA(1, 0), cA + kstep, voffA); PG8_STAGE(PG8_SB(1, 1), cB + hstepB + kstep, voffB);
        PG8_WAIT_V(6); PG8_BAR;
    }
    for (;;) {
        const bool has_next = S.next(ui + 1, nxt);
        const char* nA = has_next ? (const char*)g.A + (size_t)nxt.pm * tstep : cA; const char* nB = has_next ? (const char*)g.Bt + (size_t)(nxt.pm >> 5) * g.bstride + (size_t)nxt.pn * tstep : cB;
        for (int t = 0; t < nt; t += 2) {
            const bool last = (t == nt - 2);
            const char* a1 = cA + (size_t)(t + 1) * kstep;
            const char* a2 = last ? nA : cA + (size_t)(t + 2) * kstep; const char* b2 = last ? nB : cB + (size_t)(t + 2) * kstep;
            const char* a3 = a2 + kstep; const char* b3 = b2 + kstep;
            if (last && has_next) S.a_ready(nxt);
            if constexpr (SP2) {
            PG8_LDB(B0, 0, 0); PG8_LDB(B1, 0, 1); PG8_SCHED; PG8_LDA(At, 0, 0); PG8_STAGE(PG8_SA(1, 1), a1 + hstep, voffA);
            PG8_WAIT_V(8); PG8_WAIT_L(0); PG8_BAR; PG8_MMA(0, 0, At, B0); PG8_MMA(0, 1, At, B1); PG8_BAR; PG8_SCHED;
            PG8_LDA(At, 0, 1); PG8_STAGE(PG8_SB(0, 0), b2, voffB); PG8_STAGE(PG8_SB(0, 1), b2 + hstepB, voffB); PG8_STAGE(PG8_SA(0, 0), a2, voffA);
            PG8_WAIT_V(8); PG8_WAIT_L(0); PG8_BAR; PG8_MMA(1, 0, At, B0); PG8_MMA(1, 1, At, B1); PG8_BAR; PG8_SCHED;
            PG8_LDB(B0, 1, 0); PG8_LDB(B1, 1, 1); PG8_SCHED; PG8_LDA(At, 1, 0); PG8_STAGE(PG8_SA(0, 1), a2 + hstep, voffA);
            PG8_WAIT_V(8); PG8_WAIT_L(0); PG8_BAR; PG8_MMA(0, 0, At, B0); PG8_MMA(0, 1, At, B1); PG8_BAR; PG8_SCHED;
            PG8_LDA(At, 1, 1); PG8_STAGE(PG8_SB(1, 0), b3, voffB); PG8_STAGE(PG8_SB(1, 1), b3 + hstepB, voffB); PG8_STAGE(PG8_SA(1, 0), a3, voffA);
            PG8_WAIT_V(8); PG8_WAIT_L(0); PG8_BAR; PG8_MMA(1, 0, At, B0); PG8_MMA(1, 1, At, B1); PG8_BAR; PG8_SCHED;
            } else {
            PG8_LDB(B0, 0, 0); PG8_SCHED; PG8_LDA(At, 0, 0); PG8_STAGE(PG8_SA(1, 1), a1 + hstep, voffA);
            PG8_WAIT_L(8); PG8_BAR; PG8_WAIT_L(0); PG8_MMA(0, 0, At, B0); PG8_BAR; PG8_SCHED;
            PG8_LDB(B1, 0, 1); PG8_STAGE(PG8_SB(0, 0), b2, voffB);
            PG8_BAR; PG8_WAIT_L(0); PG8_MMA(0, 1, At, B1); PG8_BAR;
            PG8_LDA(At, 0, 1); PG8_STAGE(PG8_SA(0, 0), a2, voffA);
            PG8_BAR; PG8_WAIT_L(0); PG8_MMA(1, 0, At, B0); PG8_BAR; PG8_SCHED;
            PG8_STAGE(PG8_SB(0, 1), b2 + hstepB, voffB);
            PG8_WAIT_V(6); PG8_BAR; PG8_MMA(1, 1, At, B1); PG8_BAR;
            PG8_LDB(B0, 1, 0); PG8_SCHED; PG8_LDA(At, 1, 0); PG8_STAGE(PG8_SA(0, 1), a2 + hstep, voffA);
            PG8_WAIT_L(8); PG8_BAR; PG8_WAIT_L(0); PG8_MMA(0, 0, At, B0); PG8_BAR; PG8_SCHED;
            PG8_LDB(B1, 1, 1); PG8_STAGE(PG8_SB(1, 0), b3, voffB);
            PG8_BAR; PG8_WAIT_L(0); PG8_MMA(0, 1, At, B1); PG8_BAR;
            PG8_LDA(At, 1, 1); PG8_STAGE(PG8_SA(1, 0), a3, voffA);
            PG8_BAR; PG8_WAIT_L(0); PG8_MMA(1, 0, At, B0); PG8_BAR; PG8_SCHED;
            PG8_STAGE(PG8_SB(1, 1), b3 + hstepB, voffB);
            PG8_WAIT_V(6); PG8_BAR; PG8_MMA(1, 1, At, B1); PG8_BAR;
            }
        }
        if constexpr (ALIGN_EPI) { if (wr == 0) PG8_BAR; }
        if constexpr (!Epi::AFTER_DRAIN) { E(acc, cur, wr, wc, fr, fq); S.done(cur); }
        if (!has_next) break;
#pragma unroll
        for (int a = 0; a < 2; ++a)
#pragma unroll
            for (int b = 0; b < 2; ++b)
#pragma unroll
                for (int m = 0; m < 4; ++m)
#pragma unroll
                    for (int n = 0; n < 2; ++n) acc[a][b][m][n] = (f32x4){0.f, 0.f, 0.f, 0.f};
        cur = nxt; cA = nA; cB = nB; ++ui;
        if constexpr (ALIGN_EPI) { if (wr == 1) PG8_BAR; }
    }
    PG8_WAIT_V(0);
    if constexpr (!ALIGN_EPI) { if (wr == 0) PG8_BAR; }
    PG8_BAR;
    if constexpr (Epi::AFTER_DRAIN) { E.fused(acc, cur, wr, wc, fr, fq, lds, wid, lane); S.done(cur); }
#undef PG8_SA
#undef PG8_SB
#undef PG8_STAGE
#undef PG8_LDA
#undef PG8_LDB
#undef PG8_MMA
#undef PG8_WAIT_V
#undef PG8_WAIT_L
#undef PG8_BAR
#undef PG8_SCHED
}
}
constexpr int NB = 4, SEQ = 8192, D = 1024, M = NB * SEQ;
constexpr int NZ0 = 3584, NZ1 = 3072, NQ = 2048, SRC_IN0 = 3592;
constexpr float EPS = 1e-6f;
constexpr int NWAVES = 8, NTHR = 512;
constexpr float LOG2E = 1.4426950408889634f;
constexpr size_t MiB = 1u << 20;
constexpr size_t WS_CTL = 0, CTL_ZERO_BYTES = 1 * MiB;
constexpr size_t WS_WIN0 = 1 * MiB, WS_WOUT0 = 8 * MiB, WS_WIN1 = 10 * MiB, WS_WOUT1 = 16 * MiB, WS_WQ = 18 * MiB;
constexpr size_t WS_KEYS = 26 * MiB, WS_MOD = WS_KEYS + 128 * 1024, WS_KMEAN = WS_MOD + 192 * 1024, WS_NLOC = WS_KMEAN + 256 * 1024,
                 WS_BEND = WS_NLOC + 512 * 1024, WS_MLOC = WS_BEND + 4096, WS_MPREV = WS_MLOC + 4096,
                 WS_ISU = 27 * MiB + 512 * 1024, WS_ISV = WS_ISU + 128 * 1024, WS_ORD = WS_ISV + 128 * 1024  ;
constexpr size_t WS_GATES = 28 * MiB;
constexpr size_t WS_UB = 32 * MiB  , WS_VB = 64 * MiB, WS_ACT = 96 * MiB  , WS_ACTS = 100 * MiB  , WS_XNY = 160 * MiB, WS_Z = 224 * MiB, WS_CLOC = 448 * MiB, WS_END = 512 * MiB;
constexpr size_t WS_QRY = WS_Z, WS_IDX = WS_Z + 128 * MiB, WS_GATE = WS_Z + 144 * MiB, WS_PART = WS_Z  , WS_XS = 448 * MiB  ;
constexpr int CW_BAR = 4096, CW_QMOBA = 8192  , CW_QDIFF = 8448, CW_QCVT0 = 8704, CW_QCVT1 = 8768;
constexpr float ALIBI_MARGIN = 27.03f;
constexpr int RING_BYTES = 139264;
constexpr int LDSCTL_OFF = RING_BYTES, MISC_OFF = LDSCTL_OFF + 320;
constexpr int LDS_BYTES = 147456;
static_assert(MISC_OFF + 128 <= LDS_BYTES, "LDS map");

#define GAS __attribute__((address_space(1)))
#define LAS __attribute__((address_space(3)))
typedef unsigned short bf16;
typedef unsigned v4u __attribute__((ext_vector_type(4)));
typedef unsigned v2u __attribute__((ext_vector_type(2)));
typedef float f32x4 __attribute__((ext_vector_type(4)));
typedef float f32x16 __attribute__((ext_vector_type(16)));
typedef short bf16x8 __attribute__((ext_vector_type(8)));
typedef short s16x4 __attribute__((ext_vector_type(4)));
typedef GAS unsigned gu32;
#define RLX_AGENT __ATOMIC_RELAXED, __HIP_MEMORY_SCOPE_AGENT
#define LDS_WAIT() asm volatile("s_waitcnt lgkmcnt(0)" ::: "memory")
#define VM_WAIT() asm volatile("s_waitcnt vmcnt(0)" ::: "memory")
__device__ __forceinline__ unsigned f2bf(float f) { unsigned u = __builtin_bit_cast(unsigned, f); return (u + 0x7fffu + ((u >> 16) & 1u)) >> 16; }
__device__ __forceinline__ unsigned pk2(float lo, float hi) { return f2bf(lo) | (f2bf(hi) << 16); }
__device__ __forceinline__ float bflo(unsigned w) { return __builtin_bit_cast(float, w << 16); }
__device__ __forceinline__ float bfhi(unsigned w) { return __builtin_bit_cast(float, w & 0xffff0000u); }
__device__ __forceinline__ float bf2f(bf16 h) { return __builtin_bit_cast(float, (unsigned)h << 16); }
__device__ __forceinline__ unsigned f2u(float x) { return __builtin_bit_cast(unsigned, x); }
__device__ __forceinline__ float u2f(unsigned x) { return __builtin_bit_cast(float, x); }
__device__ __forceinline__ float dot2bf(unsigned a, unsigned b, float acc) { typedef __bf16 bf2_ __attribute__((ext_vector_type(2))); return __builtin_amdgcn_fdot2_f32_bf16(__builtin_bit_cast(bf2_, a), __builtin_bit_cast(bf2_, b), acc, false); }
__device__ __forceinline__ unsigned f2h2(float lo, float hi) { typedef _Float16 h2_ __attribute__((ext_vector_type(2))); typedef float f2_ __attribute__((ext_vector_type(2))); f2_ v = {lo, hi}; h2_ h = __builtin_convertvector(v, h2_); return __builtin_bit_cast(unsigned, h); }
__device__ __forceinline__ float h2f_lo(unsigned w) { return (float)__builtin_bit_cast(_Float16, (unsigned short)(w & 0xffffu)); }
__device__ __forceinline__ float h2f_hi(unsigned w) { return (float)__builtin_bit_cast(_Float16, (unsigned short)(w >> 16)); }
__device__ __forceinline__ float wave_sum(float v) {
#pragma unroll
    for (int o = 1; o < 64; o <<= 1) v += __shfl_xor(v, o);
    return v;
}
__device__ __forceinline__ float wave_max(float v) {
#pragma unroll
    for (int o = 1; o < 64; o <<= 1) v = fmaxf(v, __shfl_xor(v, o));
    return v;
}
__device__ __forceinline__ float silu_f(float x) { return x / (1.f + __expf(-x)); }
__device__ __forceinline__ float sigmoid_f(float x) { return 1.f / (1.f + __expf(-x)); }
__device__ __forceinline__ float logsigmoid_f(float x) { return fminf(x, 0.f) - log1pf(__expf(-fabsf(x))); }
struct Args { const float* in[24]; float* out; unsigned char* ws; int ph_lo, ph_hi; };
#define XB_TMO      128
#define XB_XCNT(j)  (256  + 64 * (j))
#define XB_XSUB(j)  (1280 + 64 * (j))
#define XB_XGEN(j)  (2304 + 64 * (j))
#define XB_TOP      3328
#define XB_TOPGEN   3392
#define XCD_BAR_WORDS 3456
#define XB_SPIN_CAP (1u << 18)

__device__ __forceinline__ unsigned xb_ld(unsigned* p)              { return __hip_atomic_load(p, __ATOMIC_RELAXED, __HIP_MEMORY_SCOPE_AGENT); }
__device__ __forceinline__ unsigned xb_add(unsigned* p, unsigned v) { return __hip_atomic_fetch_add(p, v, __ATOMIC_RELAXED, __HIP_MEMORY_SCOPE_AGENT); }
__device__ __forceinline__ unsigned xb_xcc_id() { return (unsigned)__builtin_amdgcn_s_getreg((3 << 11) | 20) & 0xFu; }
#define XB_SPIN(cond, bar) do { unsigned _sp = 0; while (cond) { __builtin_amdgcn_s_sleep(1); \
    if ((++_sp & 255u) == 0u) { if (xb_ld(&(bar)[XB_TMO])) break; if (_sp > XB_SPIN_CAP) { atomicAdd(&(bar)[XB_TMO], 1u); break; } } } } while (0)

struct XcdBarrier {
    unsigned* bar; unsigned x;
    volatile LAS unsigned* st;
};

__device__ __forceinline__ XcdBarrier xcd_barrier_post(unsigned* bar, volatile LAS unsigned* st) {
    XcdBarrier b; b.bar = bar; b.x = xb_xcc_id(); b.st = st;
    if (threadIdx.x == 0) (void)xb_add(&bar[XB_XCNT(b.x)], 1u);
    return b;
}
__device__ __forceinline__ void xcd_barrier_complete(unsigned* bar, unsigned x, unsigned& nloc, unsigned& nx) {
    const unsigned G = gridDim.x * gridDim.y * gridDim.z;
    unsigned sum, cnt, mine, sp = 0u;
    for (;;) {
        sum = 0u; cnt = 0u; mine = 0u;
#pragma unroll
        for (unsigned j = 0; j < 16; ++j) { const unsigned c = xb_ld(&bar[XB_XCNT(j)]); sum += c; cnt += (c > 0u) ? 1u : 0u; mine = (j == x) ? c : mine; }
        if (sum == G) break;
        __builtin_amdgcn_s_sleep(1);
        if ((++sp & 255u) == 0u) { if (xb_ld(&bar[XB_TMO])) break; if (sp > XB_SPIN_CAP) { atomicAdd(&bar[XB_TMO], 1u); break; } }
    }
    nloc = mine > 0u ? mine : 1u; nx = cnt > 0u ? cnt : 1u;
}

__device__ __forceinline__ void xcd_barrier(const XcdBarrier& b) {
    asm volatile("s_waitcnt vmcnt(0)" ::: "memory");
    __syncthreads();
    if (threadIdx.x == 0) {
        unsigned* bar = b.bar;
        __builtin_amdgcn_s_waitcnt(0);
        unsigned nloc = b.st[0], nx = b.st[1];
        if (nloc == 0u) { xcd_barrier_complete(bar, b.x, nloc, nx); b.st[0] = nloc; b.st[1] = nx; }
        const unsigned old = xb_add(&bar[XB_XSUB(b.x)], 1u);
        const unsigned gen = old / nloc;
        if (old + 1u == (gen + 1u) * nloc) {
            __builtin_amdgcn_fence(__ATOMIC_RELEASE, "agent");
            asm volatile("s_waitcnt vmcnt(0)" ::: "memory");
            const unsigned og = xb_add(&bar[XB_TOP], 1u);
            const unsigned tg = og / nx;
            if (og + 1u == (tg + 1u) * nx) xb_add(&bar[XB_TOPGEN], 1u);
            else XB_SPIN(xb_ld(&bar[XB_TOPGEN]) == tg, bar);
            __builtin_amdgcn_fence(__ATOMIC_ACQUIRE, "agent");
            xb_add(&bar[XB_XGEN(b.x)], 1u);
            asm volatile("s_waitcnt vmcnt(0)" ::: "memory");
        } else {
            XB_SPIN(xb_ld(&bar[XB_XGEN(b.x)]) == gen, bar);
            __builtin_amdgcn_fence(__ATOMIC_ACQUIRE, "agent");
            asm volatile("s_waitcnt vmcnt(0)" ::: "memory");
        }
    }
    __syncthreads();
}
struct Frame {
    LAS unsigned char* lds;
    int wave, G, bid;
    float* out; unsigned char* ws;
};
#define WSP(T, off) ((T*)(F.ws + (off)))

__device__ __forceinline__ void p0_transpose_item(const float* W, int K, int ldw, int nblk, int thr, int shift, bf16* WT, LAS float* scr, int item, int lane) {
    const int kb = item / nblk, nb = item % nblk, k0 = 64 * kb, n0 = 32 * nb, ns = n0 + (n0 >= thr ? shift : 0);
#pragma unroll 8
    for (int i = 0; i < 32; ++i) { const int kk = 2 * i + (lane >> 5); scr[kk * 33 + (lane & 31)] = W[(size_t)(k0 + kk) * ldw + ns + (lane & 31)]; }
    LDS_WAIT(); asm volatile("" ::: "memory");
    const int c = lane & 7;
#pragma unroll
    for (int j = 0; j < 4; ++j) { const int n = (lane >> 3) + 8 * j; const LAS float* s = scr + (8 * c) * 33 + n;
        v4u o; o.x = pk2(s[0 * 33], s[1 * 33]); o.y = pk2(s[2 * 33], s[3 * 33]); o.z = pk2(s[4 * 33], s[5 * 33]); o.w = pk2(s[6 * 33], s[7 * 33]);
        *(GAS v4u*)(WT + (size_t)(n0 + n) * K + k0 + 8 * c) = o; }
    LDS_WAIT(); asm volatile("" ::: "memory");
}
__device__ __forceinline__ void cvt_f32_bf16_stream(const float* src, bf16* dst, size_t n8, size_t gtid, size_t gthreads) {
    for (size_t i = gtid; i < n8; i += gthreads) {
        const f32x4 a = *(const GAS f32x4*)(src + i * 8), b = *(const GAS f32x4*)(src + i * 8 + 4);
        v4u o; o.x = pk2(a.x, a.y); o.y = pk2(a.z, a.w); o.z = pk2(b.x, b.y); o.w = pk2(b.z, b.w);
        *(GAS v4u*)(dst + i * 8) = o; }
}
__device__ __forceinline__ void i8_row(const float* src_row, unsigned char* dst  , float* scale  , int er, int lane) {
    const float* r = src_row + 16 * lane;
    float x[16];
#pragma unroll
    for (int q4 = 0; q4 < 4; ++q4) { const f32x4 a = *(const GAS f32x4*)(r + 4 * q4); x[4 * q4] = a.x; x[4 * q4 + 1] = a.y; x[4 * q4 + 2] = a.z; x[4 * q4 + 3] = a.w; }
    float am = 0.f;
#pragma unroll
    for (int i = 0; i < 16; ++i) am = fmaxf(am, fabsf(x[i]));
    am = wave_max(am);
    const float inv = am > 1e-30f ? 127.f / am : 0.f;
    unsigned wd[4];
#pragma unroll
    for (int q4 = 0; q4 < 4; ++q4) { unsigned w = 0;
#pragma unroll
        for (int e = 0; e < 4; ++e) { const int qv = (int)rintf(x[4 * q4 + e] * inv); w |= ((unsigned)qv & 0xffu) << (8 * e); }
        wd[q4] = w; }
    v4u o; o.x = wd[0]; o.y = wd[1]; o.z = wd[2]; o.w = wd[3];
    *(GAS v4u*)(dst + ((size_t)((lane >> 3) * 16384 + er)) * 128 + 16 * (lane & 7)) = o;
    if (lane == 0) scale[er] = am * (1.f / 127.f);
}
__device__ __forceinline__ void i8_chunk(Frame& F, const Args& A, int layer, int c) {
    const int tbl = c >> 8, row0 = (c & 255) * 64 + F.wave * 8;
    const float* src = A.in[22 + tbl] + (size_t)layer * 16384 * 1024;
    unsigned char* dst = F.ws + (tbl ? WS_VB : WS_UB) + (size_t)layer * 8 * 16384 * 128;
    float* sc = WSP(float, tbl ? WS_ISV : WS_ISU) + layer * 16384;
    for (int i = 0; i < 8; ++i) i8_row(src + (size_t)(row0 + i) * 1024, dst, sc, row0 + i, ((int)(threadIdx.x & 63u)));
}
__device__ __forceinline__ void p0_prologue(Frame& F, const Args& A) {
    {
        const float* c = A.in[1]; const float* aw = A.in[2]; const float* ab = A.in[3]; float* MOD = WSP(float, WS_MOD);
        LAS float* red = (LAS float*)F.lds;
        LAS float* cact = (LAS float*)(F.lds + 8192);
        if (F.bid < 192) { for (int i = (int)threadIdx.x; i < 4096; i += NTHR) cact[i] = silu_f(c[i]); __syncthreads(); }
        for (int item = F.bid; item < 192; item += F.G) {
            const int l = item / 96, n0 = (item % 96) * 64;
            float acc[4] = {0.f, 0.f, 0.f, 0.f};
            const int kbeg = F.wave * 128;
#pragma unroll 8
            for (int k = kbeg; k < kbeg + 128; ++k) {
                const float wv = aw[((size_t)l * 1024 + k) * 6144 + n0 + ((int)(threadIdx.x & 63u))];
#pragma unroll
                for (int b = 0; b < 4; ++b) acc[b] += cact[b * 1024 + k] * wv;
            }
#pragma unroll
            for (int b = 0; b < 4; ++b) red[(F.wave * 4 + b) * 64 + ((int)(threadIdx.x & 63u))] = acc[b];
            __syncthreads();
            if (((int)threadIdx.x) < 256) { const int b = ((int)threadIdx.x) >> 6, ln = ((int)threadIdx.x) & 63; float s = ab[l * 6144 + n0 + ln];
#pragma unroll
                for (int w = 0; w < 8; ++w) s += red[(w * 4 + b) * 64 + ln];
                MOD[(size_t)(l * 4 + b) * 6144 + n0 + ln] = s; }
            __syncthreads();
        }
    }
    if (F.bid >= F.G - 16) {
        LAS unsigned* hist = (LAS unsigned*)F.lds;
        unsigned short* ORD = WSP(unsigned short, WS_ORD);
        const int tid = (int)threadIdx.x, tbl = F.bid - (F.G - 16);
        { const int pass = tbl >> 3;
            const int nq = pass == 0 ? 64 : 32, nper = 4 * nq;
            { const int x = tbl & 7;
                if (tid < 160) hist[tid] = 0u;
                __syncthreads();
                int cost = 0, u = 0;
                if (tid < nper) {
                    const int hs = tid / nq, q = tid % nq, h = (x >> 2) ? (hs == 0 ? 6 : hs == 1 ? 5 : hs == 2 ? 1 : 0) : (hs == 0 ? 7 : hs == 1 ? 4 : hs == 2 ? 3 : 2), b = x & 3;
                    const float dcut = 46.f * (float)(2 << h);
                    if (pass == 0) { const int nt = 2 * q + 2; int lo = (int)ceilf(((float)(q * 128) - dcut - 63.f) * (1.f / 64.f)); if (lo < 0) lo = 0; cost = nt - lo; u = (b << 9) | (h << 6) | q; }
                    else { int lo = (int)ceilf(((float)(q * 256) - dcut - 255.f) * (1.f / 256.f)); if (lo < 0) lo = 0; int nb = q - lo; if (nb > 24) nb = 24; cost = 4 * (nb + 1); u = (b << 8) | (h << 5) | q; }
                    if (cost > 159) cost = 159;
                    atomicAdd((unsigned*)(hist + (159 - cost)), 1u);
                }
                __syncthreads();
                if (tid == 0) { unsigned acc = 0; for (int i = 0; i < 160; ++i) { const unsigned c = hist[i]; hist[i] = acc; acc += c; } }
                __syncthreads();
                if (tid < nper) { const unsigned pos = atomicAdd((unsigned*)(hist + (159 - cost)), 1u); ORD[(pass == 0 ? 0 : 2048) + x * nper + pos] = (unsigned short)u; }
                __syncthreads();
            }
        }
    }
    {
        LAS float* scr = (LAS float*)(F.lds + F.wave * 8704);
        const int gw = F.bid * NWAVES + F.wave, NGW = F.G * NWAVES;
        constexpr int I_IN0 = 16 * (NZ0 / 32), I_OUT = 16 * 32, I_IN1 = 16 * (NZ1 / 32), I_Q = 16 * (NQ / 32);
        constexpr int NITEMS = I_IN0 + 2 * I_OUT + I_IN1 + 2 * I_Q;
        for (int it = gw; it < NITEMS; it += NGW) {
            int r = it;
            if (r < I_IN0) { p0_transpose_item(A.in[6], D, SRC_IN0, NZ0 / 32, 2048, 8, WSP(bf16, WS_WIN0), scr, r, ((int)(threadIdx.x & 63u))); continue; } r -= I_IN0;
            if (r < I_OUT) { p0_transpose_item(A.in[13], D, D, 32, 1 << 30, 0, WSP(bf16, WS_WOUT0), scr, r, ((int)(threadIdx.x & 63u))); continue; } r -= I_OUT;
            if (r < I_IN1) { p0_transpose_item(A.in[14], D, NZ1, NZ1 / 32, 1 << 30, 0, WSP(bf16, WS_WIN1), scr, r, ((int)(threadIdx.x & 63u))); continue; } r -= I_IN1;
            if (r < I_OUT) { p0_transpose_item(A.in[19], D, D, 32, 1 << 30, 0, WSP(bf16, WS_WOUT1), scr, r, ((int)(threadIdx.x & 63u))); continue; } r -= I_OUT;
            if (r < I_Q) { p0_transpose_item(A.in[20], D, NQ, NQ / 32, 1 << 30, 0, WSP(bf16, WS_WQ), scr, r, ((int)(threadIdx.x & 63u))); continue; } r -= I_Q;
            p0_transpose_item(A.in[20] + (size_t)D * NQ, D, NQ, NQ / 32, 1 << 30, 0, WSP(bf16, WS_WQ) + (size_t)NQ * D, scr, r, ((int)(threadIdx.x & 63u)));
        }
    }
    {
        const size_t gtid = (size_t)F.bid * NTHR + ((int)threadIdx.x), gth = (size_t)F.G * NTHR;
        cvt_f32_bf16_stream(A.in[21], WSP(bf16, WS_KEYS), (size_t)2 * 2 * 128 * 128 / 8, gtid, gth);
    }
}

template <bool GATES, bool IN_BF16>
__device__ __forceinline__ void norm_pass(Frame& F, const Args& A, const void* X, const float* g, const float* mod, int shc, bf16* XN) {
    LAS float* wgT = (LAS float*)F.lds;
    if (GATES) {
        const float* win = A.in[6];
        for (int i = ((int)threadIdx.x); i < 8 * 1024; i += NTHR) { const int cg = i >> 10, k = i & 1023; wgT[i] = win[(size_t)k * SRC_IN0 + 2048 + cg]; }
        __syncthreads();
    }
    const int gw = F.bid * NWAVES + F.wave, NGW = F.G * NWAVES, lane = (int)(threadIdx.x & 63u);
    unsigned wpk[GATES ? 8 : 1][4][2]; float gbias = 0.f;
    if (GATES) {
#pragma unroll
        for (int cg = 0; cg < 8; ++cg)
#pragma unroll
            for (int j = 0; j < 4; ++j) { const f32x4 w = *(const LAS f32x4*)(wgT + cg * 1024 + 4 * lane + 256 * j); wpk[cg][j][0] = pk2(w.x, w.y); wpk[cg][j][1] = pk2(w.z, w.w); }
        const int cgl = ((lane >> 5) & 1) * 4 + ((lane >> 4) & 1) * 2 + ((lane >> 3) & 1);
        gbias = cgl < 4 ? A.in[8][cgl] : A.in[9][cgl - 4];
    }
    constexpr int NR = 2;
    for (int row0 = gw; row0 < M; row0 += NR * NGW) {
        f32x4 v[NR][4]; float ss[NR];
#pragma unroll
        for (int rr = 0; rr < NR; ++rr) { const int row = row0 + rr * NGW;
            if (IN_BF16) { const GAS v2u* xr = (const GAS v2u*)((const bf16*)X + (size_t)row * D) + lane;
#pragma unroll
                for (int j = 0; j < 4; ++j) { const v2u w = xr[64 * j]; const unsigned w0 = w.x, w1 = w.y; v[rr][j] = (f32x4){bflo(w0), bfhi(w0), bflo(w1), bfhi(w1)}; }
            } else { const GAS f32x4* xr = (const GAS f32x4*)((const float*)X + (size_t)row * D) + lane;
#pragma unroll
                for (int j = 0; j < 4; ++j) v[rr][j] = xr[64 * j]; } }
#pragma unroll
        for (int rr = 0; rr < NR; ++rr) { float s = 0.f;
#pragma unroll
            for (int j = 0; j < 4; ++j) s += (v[rr][j].x * v[rr][j].x + v[rr][j].y * v[rr][j].y) + (v[rr][j].z * v[rr][j].z + v[rr][j].w * v[rr][j].w);
            ss[rr] = s; }
#pragma unroll
        for (int o = 1; o < 64; o <<= 1) {
#pragma unroll
            for (int rr = 0; rr < NR; ++rr) ss[rr] += __shfl_xor(ss[rr], o); }
#pragma unroll
        for (int rr = 0; rr < NR; ++rr) { const int row = row0 + rr * NGW, b = row >> 13;
            const float rstd = rsqrtf(ss[rr] * (1.f / D) + EPS);
            const float* shp = mod + (size_t)b * 6144 + shc * 1024; const float* scp = shp + 1024;
            unsigned opk[4][2];
#pragma unroll
            for (int j = 0; j < 4; ++j) { const int c = 4 * lane + 256 * j;
                const f32x4 gg = *(const f32x4*)(g + c), sc = *(const f32x4*)(scp + c), sh = *(const f32x4*)(shp + c);
                v[rr][j] = v[rr][j] * rstd * gg * (sc + 1.f) + sh;
                v2u o; o.x = pk2(v[rr][j].x, v[rr][j].y); o.y = pk2(v[rr][j].z, v[rr][j].w);
                if (GATES) { opk[j][0] = o.x; opk[j][1] = o.y; }
                *(GAS v2u*)(XN + (size_t)row * D + c) = o; }
            if (GATES) {
                float* GT = WSP(float, WS_GATES);
                float p[8];
#pragma unroll
                for (int cg = 0; cg < 8; ++cg) { float a = 0.f;
#pragma unroll
                    for (int j = 0; j < 4; ++j) { a = dot2bf(opk[j][0], wpk[cg][j][0], a); a = dot2bf(opk[j][1], wpk[cg][j][1], a); }
                    p[cg] = a; }
                const bool u5 = (lane & 32) != 0, u4 = (lane & 16) != 0, u3 = (lane & 8) != 0;
                float q[4], r2[2];
#pragma unroll
                for (int i = 0; i < 4; ++i) { const float send = u5 ? p[i] : p[i + 4], keep = u5 ? p[i + 4] : p[i]; q[i] = keep + __shfl_xor(send, 32); }
#pragma unroll
                for (int i = 0; i < 2; ++i) { const float send = u4 ? q[i] : q[i + 2], keep = u4 ? q[i + 2] : q[i]; r2[i] = keep + __shfl_xor(send, 16); }
                float sg; { const float send = u3 ? r2[0] : r2[1], keep = u3 ? r2[1] : r2[0]; sg = keep + __shfl_xor(send, 8); }
                sg += __shfl_xor(sg, 4); sg += __shfl_xor(sg, 2); sg += __shfl_xor(sg, 1);
                if ((lane & 7) == 0) GT[(size_t)row * 8 + (lane >> 3)] = sg + gbias;
            }
        }
    }
}

__device__ __forceinline__ void qknorm_unit(Frame& F, bf16* Z, int ldz, int row0, int col0, const float* g, float gmul, float* kmean  ) {
    const int c = col0 + 8 * ((int)(threadIdx.x & 63u)), d0 = (8 * ((int)(threadIdx.x & 63u))) & 63;
    float gv[8];
#pragma unroll
    for (int i = 0; i < 8; ++i) gv[i] = g[d0 + i] * gmul;
    float ks[8] = {0.f, 0.f, 0.f, 0.f, 0.f, 0.f, 0.f, 0.f};
    for (int r = 0; r < 32; ++r) {
        bf16* p = Z + (size_t)(row0 + F.wave * 32 + r) * ldz + c;
        const v4u w = *(const GAS v4u*)p;
        float x[8] = {bflo(w.x), bfhi(w.x), bflo(w.y), bfhi(w.y), bflo(w.z), bfhi(w.z), bflo(w.w), bfhi(w.w)};
        float ss = 0.f;
#pragma unroll
        for (int i = 0; i < 8; ++i) ss += x[i] * x[i];
        ss += __shfl_xor(ss, 1); ss += __shfl_xor(ss, 2); ss += __shfl_xor(ss, 4);
        const float rstd = rsqrtf(ss * (1.f / 64.f) + EPS);
#pragma unroll
        for (int i = 0; i < 8; ++i) { x[i] = x[i] * rstd * gv[i]; ks[i] += x[i]; }
        v4u o; o.x = pk2(x[0], x[1]); o.y = pk2(x[2], x[3]); o.z = pk2(x[4], x[5]); o.w = pk2(x[6], x[7]);
        *(GAS v4u*)p = o;
    }
    if (kmean) {
        LAS float* red = (LAS float*)F.lds;
#pragma unroll
        for (int i = 0; i < 8; ++i) red[F.wave * 512 + 8 * ((int)(threadIdx.x & 63u)) + i] = ks[i];
        __syncthreads();
        { float s = 0.f;
#pragma unroll
          for (int w = 0; w < 8; ++w) s += red[w * 512 + ((int)threadIdx.x)];
          kmean[(size_t)(((int)threadIdx.x) >> 6) * (32 * 64) + (((int)threadIdx.x) & 63)] = s * (1.f / 256.f); }
        __syncthreads();
    }
}

__device__ __forceinline__ void kmean_unit(Frame& F, const bf16* Z, int ldz, int row0, int col0, float* kmean) {
    const int c = col0 + 8 * ((int)(threadIdx.x & 63u));
    float ks[8] = {0.f, 0.f, 0.f, 0.f, 0.f, 0.f, 0.f, 0.f};
#pragma unroll 4
    for (int r = 0; r < 32; ++r) {
        const v4u w = *(const GAS v4u*)(Z + (size_t)(row0 + F.wave * 32 + r) * ldz + c);
        ks[0] += bflo(w.x); ks[1] += bfhi(w.x); ks[2] += bflo(w.y); ks[3] += bfhi(w.y); ks[4] += bflo(w.z); ks[5] += bfhi(w.z); ks[6] += bflo(w.w); ks[7] += bfhi(w.w);
    }
    LAS float* red = (LAS float*)F.lds;
#pragma unroll
    for (int i = 0; i < 8; ++i) red[F.wave * 512 + 8 * ((int)(threadIdx.x & 63u)) + i] = ks[i];
    __syncthreads();
    { float s = 0.f;
#pragma unroll
      for (int w = 0; w < 8; ++w) s += red[w * 512 + ((int)threadIdx.x)];
      kmean[(size_t)(((int)threadIdx.x) >> 6) * (32 * 64) + (((int)threadIdx.x) & 63)] = s * (1.f / 256.f); }
    __syncthreads();
}

constexpr int KSTRB = 144;
template <int DV> struct VStr { static constexpr int B = (DV == 64) ? 192 : 320; };
typedef short v4i16_t __attribute__((ext_vector_type(4)));
__device__ __forceinline__ s16x4 vtr(const LAS unsigned char* p) { return __builtin_bit_cast(s16x4, __builtin_amdgcn_ds_read_tr16_b64_v4i16((LAS v4i16_t*)p)); }
__device__ __forceinline__ unsigned cvtpk(float lo, float hi) { typedef float f2 __attribute__((ext_vector_type(2))); typedef __bf16 b2 __attribute__((ext_vector_type(2)));
    f2 v = {lo, hi}; b2 b = __builtin_convertvector(v, b2); return __builtin_bit_cast(unsigned, b); }
__device__ __forceinline__ float xhalf(float v) {
    auto rr = __builtin_amdgcn_permlane32_swap(__builtin_bit_cast(unsigned, v), __builtin_bit_cast(unsigned, v), false, false);
    const unsigned r0 = rr[0], r1 = rr[1]; return u2f((threadIdx.x & 32) ? r0 : r1);
}
template <int DV> struct AttnSt { f32x16 o[DV / 32]; float m, l; };
template <int DV> __device__ __forceinline__ void attn_init(AttnSt<DV>& st) {
#pragma unroll
    for (int t = 0; t < DV / 32; ++t)
#pragma unroll
        for (int r = 0; r < 16; ++r) st.o[t][r] = 0.f;
    st.m = -1e30f; st.l = 0.f;
}
template <int DV>
__device__ __forceinline__ void attn_qk(AttnSt<DV>& st, const LAS unsigned char* Kt, const bf16x8 (&qf)[4], float sl2, int tq, int kt0, bool diag, bool rowok, int lane, bf16x8 (&pf)[2][2]) {
    const int r32 = lane & 31, hi = lane >> 5;
    const int kb = kt0 + 4 * hi;
    const float ref = st.m > -1e29f ? st.m : 0.f;
    const float c0 = -sl2 * (float)(tq - kb) - ref;
    f32x16 s0, s1;
#pragma unroll
    for (int r = 0; r < 16; ++r) { const int ko = (r & 3) + 8 * (r >> 2); s0[r] = c0 + sl2 * (float)ko; s1[r] = c0 + sl2 * (float)(ko + 32); }
    const LAS unsigned char* kp = Kt + r32 * KSTRB + hi * 16;
#pragma unroll
    for (int ks = 0; ks < 4; ++ks) {
        const bf16x8 k0 = *(const LAS bf16x8*)(kp + ks * 32), k1 = *(const LAS bf16x8*)(kp + 32 * KSTRB + ks * 32);
        s0 = __builtin_amdgcn_mfma_f32_32x32x16_bf16(k0, qf[ks], s0, 0, 0, 0);
        s1 = __builtin_amdgcn_mfma_f32_32x32x16_bf16(k1, qf[ks], s1, 0, 0, 0);
    }
    if (diag || !rowok) {
#pragma unroll
        for (int r = 0; r < 16; ++r) { const int ko = (r & 3) + 8 * (r >> 2);
            if (!rowok || kb + ko > tq) s0[r] = -INFINITY;
            if (!rowok || kb + ko + 32 > tq) s1[r] = -INFINITY; }
    }
    float mx = fmaxf(s0[0], s1[0]);
#pragma unroll
    for (int r = 1; r < 16; ++r) mx = fmaxf(mx, fmaxf(s0[r], s1[r]));
    mx = fmaxf(mx, xhalf(mx));
    const float mnew = fmaxf(st.m, ref + mx);
    if (__any(mnew > st.m)) {
        const float alpha = __builtin_amdgcn_exp2f(st.m - mnew), dd = mnew - ref;
        st.m = mnew; st.l *= alpha;
#pragma unroll
        for (int t = 0; t < DV / 32; ++t)
#pragma unroll
            for (int r = 0; r < 16; ++r) st.o[t][r] *= alpha;
#pragma unroll
        for (int r = 0; r < 16; ++r) { s0[r] -= dd; s1[r] -= dd; }
    }
#pragma unroll
    for (int r = 0; r < 16; ++r) { s0[r] = __builtin_amdgcn_exp2f(s0[r]); s1[r] = __builtin_amdgcn_exp2f(s1[r]); }
#pragma unroll
    for (int s = 0; s < 2; ++s) {
        v4u a, b;
        a.x = cvtpk(s0[8 * s + 0], s0[8 * s + 1]); a.y = cvtpk(s0[8 * s + 2], s0[8 * s + 3]); a.z = cvtpk(s0[8 * s + 4], s0[8 * s + 5]); a.w = cvtpk(s0[8 * s + 6], s0[8 * s + 7]);
        b.x = cvtpk(s1[8 * s + 0], s1[8 * s + 1]); b.y = cvtpk(s1[8 * s + 2], s1[8 * s + 3]); b.z = cvtpk(s1[8 * s + 4], s1[8 * s + 5]); b.w = cvtpk(s1[8 * s + 6], s1[8 * s + 7]);
        pf[0][s] = __builtin_bit_cast(bf16x8, a); pf[1][s] = __builtin_bit_cast(bf16x8, b);
    }
}
template <int DV>
__device__ __forceinline__ void attn_pv(AttnSt<DV>& st, const LAS unsigned char* Vt, const bf16x8 (&pf)[2][2], int lane) {
    { const bf16x8 ones = {0x3F80, 0x3F80, 0x3F80, 0x3F80, 0x3F80, 0x3F80, 0x3F80, 0x3F80};
      f32x16 rs = __builtin_amdgcn_mfma_f32_32x32x16_bf16(ones, pf[0][0], (f32x16){0.f, 0.f, 0.f, 0.f, 0.f, 0.f, 0.f, 0.f, 0.f, 0.f, 0.f, 0.f, 0.f, 0.f, 0.f, 0.f}, 0, 0, 0);
      rs = __builtin_amdgcn_mfma_f32_32x32x16_bf16(ones, pf[0][1], rs, 0, 0, 0); rs = __builtin_amdgcn_mfma_f32_32x32x16_bf16(ones, pf[1][0], rs, 0, 0, 0); rs = __builtin_amdgcn_mfma_f32_32x32x16_bf16(ones, pf[1][1], rs, 0, 0, 0);
      st.l += rs[0]; }
    constexpr int VS = VStr<DV>::B;
    const int g = lane >> 4, i16 = lane & 15;
    const LAS unsigned char* vp = Vt + (4 * (g >> 1) + (i16 >> 2)) * VS + (16 * (g & 1) + 4 * (i16 & 3)) * 2;
#pragma unroll
    for (int kbk = 0; kbk < 2; ++kbk)
#pragma unroll
        for (int s = 0; s < 2; ++s)
#pragma unroll
            for (int t = 0; t < DV / 32; ++t) {
                const s16x4 lo = vtr(vp + (kbk * 32 + 16 * s) * VS + t * 64), h8 = vtr(vp + (kbk * 32 + 16 * s + 8) * VS + t * 64);
                const bf16x8 va = {lo[0], lo[1], lo[2], lo[3], h8[0], h8[1], h8[2], h8[3]};
                st.o[t] = __builtin_amdgcn_mfma_f32_32x32x16_bf16(va, pf[kbk][s], st.o[t], 0, 0, 0);
            }
}
template <int DV>
__device__ __forceinline__ void attn_tile(AttnSt<DV>& st, const LAS unsigned char* Kt, const LAS unsigned char* Vt, const bf16x8 (&qf)[4], float sc2, float sl2, int tq, int kt0, bool diag, bool rowok, int lane) {
    bf16x8 pf[2][2];
    attn_qk<DV>(st, Kt, qf, sl2, tq, kt0, diag, rowok, lane, pf);
    attn_pv<DV>(st, Vt, pf, lane);
}
template <int NK, int DV> struct TileRegs { v4u k[NK]; v4u v[DV / 64]; };
template <int NK, int DV>
__device__ __forceinline__ void tile_load(TileRegs<NK, DV>& R, const bf16* Z, int ldz, size_t zrow0, int kcol, int vcol, int tid) {
#pragma unroll
    for (int i = 0; i < NK; ++i) { const int ch = tid + 512 * i; const int row = ch / (8 * NK), cc = ch % (8 * NK);
        R.k[i] = *(const GAS v4u*)(Z + (zrow0 + row) * ldz + kcol + cc * 8); }
#pragma unroll
    for (int i = 0; i < DV / 64; ++i) { const int ch = tid + 512 * i; const int row = ch / (DV / 8), cc = ch % (DV / 8);
        R.v[i] = *(const GAS v4u*)(Z + (zrow0 + row) * ldz + vcol + cc * 8); }
}
template <int NK, int DV>
__device__ __forceinline__ void tile_store(const TileRegs<NK, DV>& R, LAS unsigned char* Kt  , LAS unsigned char* Vt, int tid) {
#pragma unroll
    for (int i = 0; i < NK; ++i) { const int ch = tid + 512 * i; const int row = ch / (8 * NK), cc = ch % (8 * NK);
        *(LAS v4u*)(Kt + (cc >> 3) * (64 * KSTRB) + row * KSTRB + (cc & 7) * 16) = R.k[i]; }
#pragma unroll
    for (int i = 0; i < DV / 64; ++i) { const int ch = tid + 512 * i; const int row = ch / (DV / 8), cc = ch % (DV / 8);
        *(LAS v4u*)(Vt + row * VStr<DV>::B + cc * 16) = R.v[i]; }
}
__device__ __forceinline__ void moba_unit(Frame& F, int b, int h, int j, float tcut  ) {
    const bf16* Z = WSP(bf16, WS_Z); constexpr int ldz = NZ0;
    const int lane = ((int)(threadIdx.x & 63u)), w = F.wave, r32 = lane & 31, hi = lane >> 5, tid = ((int)threadIdx.x);
    const size_t rowb = (size_t)b * SEQ;
    const int qpos = j * 256 + w * 32 + r32;
    const int qcol = 2048 + h * 64, kcol = 2560 + h * 64, vcol = 3072 + h * 64;
    LAS unsigned char* lds = F.lds;
    constexpr int BUFB = 64 * KSTRB + 64 * VStr<64>::B;
    LAS unsigned char* kmh = lds + 2 * BUFB;
    LAS unsigned char* kml = lds + 2 * BUFB + 32 * KSTRB;
    LAS unsigned* msk = (LAS unsigned*)(lds + 2 * BUFB + 64 * KSTRB);
    { const float* KM = WSP(float, WS_KMEAN) + (size_t)((b * 8 + h) * 32) * 64; const f32x4 x = *(const f32x4*)(KM + 4 * tid);
      const int n = tid >> 4, d0 = (tid & 15) * 4;
      const unsigned h0 = f2bf(x.x), h1 = f2bf(x.y), h2 = f2bf(x.z), h3 = f2bf(x.w);
      v2u hv; hv.x = h0 | (h1 << 16); hv.y = h2 | (h3 << 16);
      v2u lv; lv.x = pk2(x.x - u2f(h0 << 16), x.y - u2f(h1 << 16)); lv.y = pk2(x.z - u2f(h2 << 16), x.w - u2f(h3 << 16));
      *(LAS v2u*)(kmh + n * KSTRB + d0 * 2) = hv; *(LAS v2u*)(kml + n * KSTRB + d0 * 2) = lv; }
    if (tid < 16) msk[tid] = 0u;
    bf16x8 qf[4];
    const bf16* qrow = Z + (rowb + qpos) * ldz + qcol;
#pragma unroll
    for (int ks = 0; ks < 4; ++ks) qf[ks] = *(const GAS bf16x8*)(qrow + 16 * ks + 8 * hi);
    __syncthreads();
    f32x16 gt;
#pragma unroll
    for (int r = 0; r < 16; ++r) gt[r] = 0.f;
#pragma unroll
    for (int ks = 0; ks < 4; ++ks) {
        const bf16x8 a = *(const LAS bf16x8*)(kmh + r32 * KSTRB + hi * 16 + ks * 32), c = *(const LAS bf16x8*)(kml + r32 * KSTRB + hi * 16 + ks * 32);
        gt = __builtin_amdgcn_mfma_f32_32x32x16_bf16(a, qf[ks], gt, 0, 0, 0);
        gt = __builtin_amdgcn_mfma_f32_32x32x16_bf16(c, qf[ks], gt, 0, 0, 0);
    }
    float t0 = -INFINITY, t1 = -INFINITY, t2 = -INFINITY;
#define INS3(key) do { float k_ = (key); float a_ = fmaxf(t0, k_), l_ = fminf(t0, k_); t0 = a_; a_ = fmaxf(t1, l_); l_ = fminf(t1, l_); t1 = a_; t2 = fmaxf(t2, l_); } while (0)
#pragma unroll
    for (int r = 0; r < 16; ++r) { const int n = (r & 3) + 8 * (r >> 2) + 4 * hi;
        const float key = (n < j) ? u2f((f2u(gt[r]) & ~31u) | (unsigned)n) : -INFINITY; INS3(key); }
    { const float p0 = xhalf(t0), p1 = xhalf(t1), p2 = xhalf(t2); INS3(p0); INS3(p1); INS3(p2); }
#undef INS3
    const int sel0 = (t0 > -INFINITY) ? (int)(f2u(t0) & 31u) : -1;
    const int sel1 = (t1 > -INFINITY) ? (int)(f2u(t1) & 31u) : -1;
    const int sel2 = (t2 > -INFINITY) ? (int)(f2u(t2) & 31u) : -1;
    { const unsigned mm = (sel0 >= 0 ? 1u << sel0 : 0u) | (sel1 >= 0 ? 1u << sel1 : 0u) | (sel2 >= 0 ? 1u << sel2 : 0u);
      if (mm) { __hip_atomic_fetch_or(msk + w, mm, __ATOMIC_RELAXED, __HIP_MEMORY_SCOPE_WORKGROUP); __hip_atomic_fetch_or(msk + 8, mm, __ATOMIC_RELAXED, __HIP_MEMORY_SCOPE_WORKGROUP); } }
    __syncthreads();
    const float slope = ldexpf(1.f, -(h + 1)), dcut = tcut / slope;
    const float sl2 = slope * LOG2E, sc2 = 0.125f * LOG2E;
    int nlo = (int)ceilf(((float)(j * 256) - dcut - 255.f) * (1.f / 256.f)); if (nlo < 0) nlo = 0;
    const unsigned keep = nlo >= 32 ? 0u : (0xffffffffu << nlo);
    const unsigned bmask = msk[8] & keep; const unsigned wmask = (unsigned)__builtin_amdgcn_readfirstlane((int)msk[w]) & keep;
    AttnSt<64> st; attn_init<64>(st);
    unsigned rem = bmask;
    int blk = j, kt = 3, buf = 0;
    TileRegs<1, 64> R;
    tile_load<1, 64>(R, Z, ldz, rowb + blk * 256 + kt * 64, kcol, vcol, tid);
    tile_store<1, 64>(R, lds, lds + 64 * KSTRB, tid);
    __syncthreads();
    for (;;) {
        int nblk = blk, nkt = kt - 1; bool has_next = true;
        if (nkt < 0) { nkt = 3; if (rem) { nblk = 31 - __builtin_clz(rem); rem &= ~(1u << nblk); } else has_next = false; }
        if (has_next) tile_load<1, 64>(R, Z, ldz, rowb + nblk * 256 + nkt * 64, kcol, vcol, tid);
        const bool own = (blk == j);
        const bool active = (own ? (kt * 64 <= w * 32 + 31) : (((wmask >> blk) & 1u) != 0u)) && ((float)(j * 256 + w * 32 - (blk * 256 + kt * 64 + 63)) <= dcut);
        if (active) {
            const bool rowok = own || blk == sel0 || blk == sel1 || blk == sel2;
            const bool diag = own && (kt * 64 + 63 > w * 32);
            attn_tile<64>(st, lds + buf * BUFB, lds + buf * BUFB + 64 * KSTRB, qf, sc2, sl2, qpos, blk * 256 + kt * 64, diag, rowok, lane);
        }
        if (!has_next) break;
        tile_store<1, 64>(R, lds + (buf ^ 1) * BUFB, lds + (buf ^ 1) * BUFB + 64 * KSTRB, tid);
        __syncthreads();
        buf ^= 1; blk = nblk; kt = nkt;
    }
    const float inv = 1.f / st.l;
    bf16* Y = WSP(bf16, WS_XNY) + (rowb + qpos) * 1024 + 512 + h * 64;
#pragma unroll
    for (int t = 0; t < 2; ++t)
#pragma unroll
        for (int rg = 0; rg < 4; ++rg) { v2u o; o.x = pk2(st.o[t][4 * rg] * inv, st.o[t][4 * rg + 1] * inv); o.y = pk2(st.o[t][4 * rg + 2] * inv, st.o[t][4 * rg + 3] * inv);
            *(GAS v2u*)(Y + t * 32 + 8 * rg + 4 * hi) = o; }
    __syncthreads();
}

__device__ __forceinline__ void diff_unit(Frame& F, const Args& A, int b, int h, int qt, float lam, float tcut) {
    const bf16* Z = WSP(bf16, WS_Z); constexpr int ldz = NZ1;
    const int lane = ((int)(threadIdx.x & 63u)), w = F.wave, r32 = lane & 31, hi = lane >> 5, tid = ((int)threadIdx.x);
    const int comp = w >> 2, wq = w & 3;
    const size_t rowb = (size_t)b * SEQ;
    const int q0 = qt * 128, qpos = q0 + wq * 32 + r32;
    const int qcol = h * 128 + comp * 64, kcol = 1024 + h * 128, vcol = 2048 + h * 128;
    LAS unsigned char* lds = F.lds;
    constexpr int BUFB = 2 * 64 * KSTRB + 64 * VStr<128>::B;
    bf16x8 qf[4];
    const bf16* qrow = Z + (rowb + qpos) * ldz + qcol;
#pragma unroll
    for (int ks = 0; ks < 4; ++ks) qf[ks] = *(const GAS bf16x8*)(qrow + 16 * ks + 8 * hi);
    const float slope = ldexpf(1.f, -(h + 1)), dcut = tcut / slope;
    const float sl2 = slope * LOG2E, sc2 = 0.125f * LOG2E;
    AttnSt<128> st; attn_init<128>(st);
    const int nt = (q0 + 128) / 64;
    int kt_lo = (int)ceilf(((float)q0 - dcut - 63.f) * (1.f / 64.f)); if (kt_lo < 0) kt_lo = 0;
    TileRegs<2, 128> R;
    tile_load<2, 128>(R, Z, ldz, rowb + (size_t)(nt - 1) * 64, kcol, vcol, tid);
    tile_store<2, 128>(R, lds, lds + 2 * 64 * KSTRB, tid);
    __syncthreads();
    int buf = 0;
    for (int kt = nt - 1; kt >= kt_lo; --kt) {
        const bool has_next = kt > kt_lo;
        if (has_next) tile_load<2, 128>(R, Z, ldz, rowb + (size_t)(kt - 1) * 64, kcol, vcol, tid);
        if (kt * 64 <= q0 + wq * 32 + 31) {
            const bool diag = kt * 64 + 63 > q0 + wq * 32;
            attn_tile<128>(st, lds + buf * BUFB + comp * (64 * KSTRB), lds + buf * BUFB + 2 * 64 * KSTRB, qf, sc2, sl2, qpos, kt * 64, diag, true, lane);
        }
        if (has_next) { tile_store<2, 128>(R, lds + (buf ^ 1) * BUFB, lds + (buf ^ 1) * BUFB + 2 * 64 * KSTRB, tid); }
        __syncthreads();
        buf ^= 1;
    }
    const float inv = 1.f / st.l;
    LAS float* o2 = (LAS float*)lds;
    if (comp == 1) {
#pragma unroll
        for (int t = 0; t < 4; ++t)
#pragma unroll
            for (int r = 0; r < 16; ++r) o2[((wq * 4 + t) * 16 + r) * 64 + lane] = st.o[t][r] * inv;
    }
    __syncthreads();
    if (comp == 0) {
        float ss = 0.f;
#pragma unroll
        for (int t = 0; t < 4; ++t)
#pragma unroll
            for (int r = 0; r < 16; ++r) { const float v = st.o[t][r] * inv - lam * o2[((wq * 4 + t) * 16 + r) * 64 + lane]; st.o[t][r] = v; ss += v * v; }
        ss += xhalf(ss);
        const float rs = rsqrtf(ss * (1.f / 128.f) + EPS) * 0.6444909324090307f;
        const float* og = A.in[18];
        bf16* Y = WSP(bf16, WS_XNY) + (rowb + qpos) * 1024 + h * 128;
#pragma unroll
        for (int t = 0; t < 4; ++t)
#pragma unroll
            for (int rg = 0; rg < 4; ++rg) { const int dv = t * 32 + 8 * rg + 4 * hi; const f32x4 gg = *(const f32x4*)(og + dv);
                v2u o; o.x = pk2(st.o[t][4 * rg] * rs * gg.x, st.o[t][4 * rg + 1] * rs * gg.y); o.y = pk2(st.o[t][4 * rg + 2] * rs * gg.z, st.o[t][4 * rg + 3] * rs * gg.w);
                *(GAS v2u*)(Y + dv) = o; }
    }
    __syncthreads();
}

template <int MT, int NT>
__device__ __forceinline__ void mma_nt(const LAS unsigned char* A, int lda, const LAS unsigned char* B, int ldb, int K, f32x4 (&acc)[MT][NT], int lane) {
    const int r = lane & 15, kq = (lane >> 4) * 16;
    for (int k0 = 0; k0 < K; k0 += 32) {
        bf16x8 a[MT], bb[NT];
#pragma unroll
        for (int m = 0; m < MT; ++m) a[m] = *(const LAS bf16x8*)(A + (m * 16 + r) * lda + k0 * 2 + kq);
#pragma unroll
        for (int n = 0; n < NT; ++n) bb[n] = *(const LAS bf16x8*)(B + (n * 16 + r) * ldb + k0 * 2 + kq);
#pragma unroll
        for (int m = 0; m < MT; ++m)
#pragma unroll
            for (int n = 0; n < NT; ++n) acc[m][n] = __builtin_amdgcn_mfma_f32_16x16x32_bf16(a[m], bb[n], acc[m][n], 0, 0, 0);
    }
}
constexpr int TS = 272;
constexpr int TILEB = 128 * TS;
constexpr int ML_Q = 0, ML_K = TILEB, ML_V = 2 * TILEB, ML_SM = 3 * TILEB;

__device__ __forceinline__ void ml_gates(const float* GT, size_t row0, int hm, LAS float* sm, int lane) {
    const float i0 = GT[(row0 + 2 * lane) * 8 + hm], i1 = GT[(row0 + 2 * lane + 1) * 8 + hm];
    const float f0 = logsigmoid_f(GT[(row0 + 2 * lane) * 8 + 4 + hm]), f1 = logsigmoid_f(GT[(row0 + 2 * lane + 1) * 8 + 4 + hm]);
    float s = f0 + f1;
#pragma unroll
    for (int o = 1; o < 64; o <<= 1) { const float t = __shfl_up(s, o); if (lane >= o) s += t; }
    const float excl = s - (f0 + f1);
    sm[2 * lane] = excl + f0; sm[2 * lane + 1] = excl + f0 + f1;
    sm[128 + 2 * lane] = i0; sm[128 + 2 * lane + 1] = i1;
}
template <bool TRANSPOSE>
__device__ __forceinline__ void ml_conv_tile(const bf16* Z, size_t rowb, int t0, int zc, const float* cw, int wc, float mul, LAS unsigned char* dst, const LAS float* rs, int tid) {
#pragma unroll
    for (int it = 0; it < 4; ++it) {
        const int item = tid + 512 * it, l = item >> 4, ch = (item & 15) * 8;
        float acc[8];
#pragma unroll
        for (int i = 0; i < 8; ++i) acc[i] = 0.f;
        v4u wv[4];
#pragma unroll
        for (int jj = 0; jj < 4; ++jj) { const int t = t0 + l - 3 + jj;
            wv[jj] = *(const GAS v4u*)(Z + (rowb + (t < 0 ? 0 : t)) * NZ0 + zc + ch); }
#pragma unroll
        for (int jj = 0; jj < 4; ++jj) {
            const int t = t0 + l - 3 + jj; const float tm = t >= 0 ? 1.f : 0.f;
            const v4u w = wv[jj];
            const float x[8] = {bflo(w.x), bfhi(w.x), bflo(w.y), bfhi(w.y), bflo(w.z), bfhi(w.z), bflo(w.w), bfhi(w.w)};
            const f32x4 c0 = *(const f32x4*)(cw + jj * 1024 + wc + ch) * tm, c1 = *(const f32x4*)(cw + jj * 1024 + wc + ch + 4) * tm;
            acc[0] += x[0] * c0.x; acc[1] += x[1] * c0.y; acc[2] += x[2] * c0.z; acc[3] += x[3] * c0.w;
            acc[4] += x[4] * c1.x; acc[5] += x[5] * c1.y; acc[6] += x[6] * c1.z; acc[7] += x[7] * c1.w;
        }
        const float sc = TRANSPOSE ? mul * rs[l] : mul;
#pragma unroll
        for (int i = 0; i < 8; ++i) acc[i] = silu_f(acc[i]) * sc;
        if (TRANSPOSE) {
#pragma unroll
            for (int i = 0; i < 8; ++i) *(LAS bf16*)(dst + (ch + i) * TS + l * 2) = (bf16)f2bf(acc[i]);
        } else {
            v4u o; o.x = pk2(acc[0], acc[1]); o.y = pk2(acc[2], acc[3]); o.z = pk2(acc[4], acc[5]); o.w = pk2(acc[6], acc[7]);
            *(LAS v4u*)(dst + l * TS + ch * 2) = o;
        }
    }
}
__device__ __forceinline__ void ml_vt_tile(const bf16* Z, size_t row0, int zc, LAS unsigned char* dst, int tid) {
#pragma unroll
    for (int it = 0; it < 4; ++it) {
        const int item = tid + 512 * it, l = item >> 4, ch = (item & 15) * 8;
        const v4u w = *(const GAS v4u*)(Z + (row0 + l) * NZ0 + zc + ch);
        const unsigned ww[4] = {w.x, w.y, w.z, w.w};
#pragma unroll
        for (int i = 0; i < 4; ++i) { *(LAS bf16*)(dst + (ch + 2 * i) * TS + l * 2) = (bf16)(ww[i] & 0xffffu); *(LAS bf16*)(dst + (ch + 2 * i + 1) * TS + l * 2) = (bf16)(ww[i] >> 16); }
    }
}
__device__ __forceinline__ void mlstm_a_unit(Frame& F, const Args& A, int unit) {
    const int c = unit & 63, bh = unit >> 6, hm = bh & 3, b = bh >> 2;
    const bf16* Z = WSP(bf16, WS_Z); const float* GT = WSP(float, WS_GATES);
    const size_t rowb = (size_t)b * SEQ; const int t0 = c * 128;
    LAS unsigned char* lds = F.lds; LAS float* sm = (LAS float*)(lds + ML_SM);
    if (F.wave == 0) {
        ml_gates(GT, rowb + t0, hm, sm, ((int)(threadIdx.x & 63u)));
        LDS_WAIT();
        const float bend = sm[127];
        const float w0 = bend - sm[2 * ((int)(threadIdx.x & 63u))] + sm[128 + 2 * ((int)(threadIdx.x & 63u))], w1 = bend - sm[2 * ((int)(threadIdx.x & 63u)) + 1] + sm[128 + 2 * ((int)(threadIdx.x & 63u)) + 1];
        const float ml = wave_max(fmaxf(w0, w1));
        sm[256 + 2 * ((int)(threadIdx.x & 63u))] = __expf(w0 - ml); sm[256 + 2 * ((int)(threadIdx.x & 63u)) + 1] = __expf(w1 - ml);
        if (((int)(threadIdx.x & 63u)) == 0) { WSP(float, WS_BEND)[unit] = bend; WSP(float, WS_MLOC)[unit] = ml; }
    }
    __syncthreads();
    ml_conv_tile<true>(Z, rowb, t0, 512 + hm * 128, A.in[7], 512 + hm * 128, 0.08838834764831845f, lds + ML_K, sm + 256, ((int)threadIdx.x));
    ml_vt_tile(Z, rowb + t0, 1024 + hm * 128, lds + ML_V, ((int)threadIdx.x));
    __syncthreads();
    f32x4 acc[2][4];
#pragma unroll
    for (int m = 0; m < 2; ++m)
#pragma unroll
        for (int n = 0; n < 4; ++n) acc[m][n] = (f32x4){0.f, 0.f, 0.f, 0.f};
    const int dv0 = 32 * (F.wave >> 1), dk0 = 64 * (F.wave & 1);
    mma_nt<2, 4>(lds + ML_V + dv0 * TS, TS, lds + ML_K + dk0 * TS, TS, 128, acc, ((int)(threadIdx.x & 63u)));
    {
        const int lane_ = (int)(threadIdx.x & 63u);
#pragma unroll
        for (int m = 0; m < 2; ++m)
#pragma unroll
            for (int n = 0; n < 4; ++n)
#pragma unroll
                for (int i = 0; i < 4; ++i) *(LAS bf16*)(lds + ML_Q + (dv0 + 16 * m + 4 * (lane_ >> 4) + i) * TS + (dk0 + 16 * n + (lane_ & 15)) * 2) = (bf16)f2bf(acc[m][n][i]);
        __syncthreads();
        bf16* CL = WSP(bf16, WS_CLOC) + (size_t)unit * 16384;
#pragma unroll
        for (int it = 0; it < 4; ++it) { const int item = (int)threadIdx.x + 512 * it, rr = item >> 4, ch = (item & 15) * 8;
            *(GAS v4u*)(CL + rr * 128 + ch) = *(const LAS v4u*)(lds + ML_Q + rr * TS + ch * 2); }
    }
    if (((int)threadIdx.x) < 128) { float s = 0.f; const LAS bf16* kr = (const LAS bf16*)(lds + ML_K + ((int)threadIdx.x) * TS);
        for (int l = 0; l < 128; ++l) s += bf2f(kr[l]);
        WSP(float, WS_NLOC)[(size_t)unit * 128 + ((int)threadIdx.x)] = s; }
    __syncthreads();
}
__device__ __forceinline__ void mlstm_scan_unit(Frame& F, int unit) {
    const int bh = unit >> 3, sl = unit & 7;
    LAS float* tab = (LAS float*)F.lds;
    if (((int)threadIdx.x) == 0) {
        const float* BE = WSP(float, WS_BEND) + bh * 64; const float* ML = WSP(float, WS_MLOC) + bh * 64; float* MP = WSP(float, WS_MPREV) + bh * 64;
        float m = 0.f;
        for (int c = 0; c < 64; ++c) { const float be = BE[c], ml = ML[c]; const float mn = fmaxf(be + m, ml);
            tab[c] = __expf(be + m - mn); tab[64 + c] = __expf(ml - mn); if (sl == 0) MP[c] = m; m = mn; }
    }
    __syncthreads();
    bf16* CL = WSP(bf16, WS_CLOC) + (size_t)bh * 64 * 16384 + sl * 2048 + 4 * ((int)threadIdx.x);
    float s0 = 0.f, s1 = 0.f, s2 = 0.f, s3 = 0.f;
#pragma unroll 8
    for (int c = 0; c < 64; ++c) { GAS v2u* p = (GAS v2u*)(CL + (size_t)c * 16384); const v2u v = *p; v2u o; o.x = pk2(s0, s1); o.y = pk2(s2, s3); *p = o;
        const float a = tab[c], sc = tab[64 + c]; const unsigned v0 = v.x, v1 = v.y;
        s0 = a * s0 + sc * bflo(v0); s1 = a * s1 + sc * bfhi(v0); s2 = a * s2 + sc * bflo(v1); s3 = a * s3 + sc * bfhi(v1); }
    if (sl == 0 && ((int)threadIdx.x) < 128) { float* NL = WSP(float, WS_NLOC) + (size_t)bh * 64 * 128 + ((int)threadIdx.x); float s = 0.f;
        for (int c = 0; c < 64; ++c) { const float v = NL[c * 128]; NL[c * 128] = s; s = tab[c] * s + tab[64 + c] * v; } }
    __syncthreads();
}
__device__ __forceinline__ void mlstm_c_unit(Frame& F, const Args& A, int unit) {
    const int c = unit & 63, bh = unit >> 6, hm = bh & 3, b = bh >> 2;
    const bf16* Z = WSP(bf16, WS_Z); const float* GT = WSP(float, WS_GATES);
    const size_t rowb = (size_t)b * SEQ; const int t0 = c * 128;
    LAS unsigned char* lds = F.lds; LAS float* sm = (LAS float*)(lds + ML_SM);
    const int lane = ((int)(threadIdx.x & 63u)), w = F.wave, tid = ((int)threadIdx.x);
    const float mprev = WSP(float, WS_MPREV)[unit];
    const int l0 = 32 * (w >> 1), c0 = 64 * (w & 1);
    if (w == 0) {
        ml_gates(GT, rowb + t0, hm, sm, lane);
        LDS_WAIT();
        const float b0 = sm[2 * lane], b1 = sm[2 * lane + 1];
        const float g0 = sm[128 + 2 * lane] - b0, g1 = sm[128 + 2 * lane + 1] - b1;
        float pm = fmaxf(g0, g1);
#pragma unroll
        for (int o = 1; o < 64; o <<= 1) { const float t = __shfl_up(pm, o); if (lane >= o) pm = fmaxf(pm, t); }
        float pe = __shfl_up(pm, 1); if (lane == 0) pe = -INFINITY;
        const float M0 = fmaxf(mprev, fmaxf(pe, g0)), M1 = fmaxf(mprev, pm);
        sm[256 + 2 * lane] = g0; sm[256 + 2 * lane + 1] = g1;
        sm[384 + 2 * lane] = M0; sm[384 + 2 * lane + 1] = M1;
        sm[512 + 2 * lane] = __expf(mprev - M0); sm[512 + 2 * lane + 1] = __expf(mprev - M1);
        sm[640 + 2 * lane] = __expf(-b0 - M0); sm[640 + 2 * lane + 1] = __expf(-b1 - M1);
        sm[768 + 2 * lane] = 0.f; sm[768 + 2 * lane + 1] = 0.f; sm[896 + 2 * lane] = 0.f; sm[896 + 2 * lane + 1] = 0.f;
    }
    if (w == 1) { sm[1152 + lane] = WSP(float, WS_NLOC)[(size_t)unit * 128 + lane]; sm[1152 + 64 + lane] = WSP(float, WS_NLOC)[(size_t)unit * 128 + 64 + lane]; }
    ml_conv_tile<false>(Z, rowb, t0, hm * 128, A.in[7], hm * 128, 1.f, lds + ML_Q, nullptr, tid);
    ml_conv_tile<false>(Z, rowb, t0, 512 + hm * 128, A.in[7], 512 + hm * 128, 0.08838834764831845f, lds + ML_K, nullptr, tid);
    ml_vt_tile(Z, rowb + t0, 1024 + hm * 128, lds + ML_V, tid);
    __syncthreads();
    bf16x8 cpf[4][4];
    { const bf16* CP = WSP(bf16, WS_CLOC) + (size_t)unit * 16384;
      const int r = lane & 15, kq = (lane >> 4) * 8;
#pragma unroll
      for (int kk = 0; kk < 4; ++kk)
#pragma unroll
          for (int n = 0; n < 4; ++n) cpf[kk][n] = *(const GAS bf16x8*)(CP + (size_t)(c0 + n * 16 + r) * 128 + 32 * kk + kq); }
    const int lr = 4 * (lane >> 4), lc = lane & 15;
    { const int l = tid >> 2, part = tid & 3; float s = 0.f;
#pragma unroll
        for (int j = 0; j < 4; ++j) { const v4u qv = *(const LAS v4u*)(lds + ML_Q + l * TS + part * 64 + j * 16);
            const f32x4 n0 = *(const LAS f32x4*)(sm + 1152 + part * 32 + j * 8), n1 = *(const LAS f32x4*)(sm + 1152 + part * 32 + j * 8 + 4);
            const unsigned q0 = qv.x, q1 = qv.y, q2 = qv.z, q3 = qv.w;
            s += (bflo(q0) * n0.x + bfhi(q0) * n0.y) + (bflo(q1) * n0.z + bfhi(q1) * n0.w) + (bflo(q2) * n1.x + bfhi(q2) * n1.y) + (bflo(q3) * n1.z + bfhi(q3) * n1.w); }
        s += __shfl_xor(s, 1); s += __shfl_xor(s, 2);
        if (part == 0) sm[1024 + l] = s; }
    f32x4 acc[2][4];
#pragma unroll
    for (int m = 0; m < 2; ++m)
#pragma unroll
        for (int n = 0; n < 4; ++n) acc[m][n] = (f32x4){0.f, 0.f, 0.f, 0.f};
    mma_nt<2, 4>(lds + ML_Q + l0 * TS, TS, lds + ML_K + c0 * TS, TS, 128, acc, lane);
#pragma unroll
    for (int m = 0; m < 2; ++m)
#pragma unroll
        for (int i = 0; i < 4; ++i) { const int l = l0 + 16 * m + lr + i; const float Ml = sm[384 + l]; float rsum = 0.f;
#pragma unroll
            for (int n = 0; n < 4; ++n) { const int s = c0 + 16 * n + lc; const float v = (s <= l) ? acc[m][n][i] * __expf(sm[256 + s] - Ml) : 0.f; acc[m][n][i] = v; rsum += v; }
            rsum += __shfl_xor(rsum, 1); rsum += __shfl_xor(rsum, 2); rsum += __shfl_xor(rsum, 4); rsum += __shfl_xor(rsum, 8);
            if (lc == 0) __hip_atomic_fetch_add(sm + 768 + l, rsum, __ATOMIC_RELAXED, __HIP_MEMORY_SCOPE_WORKGROUP); }
    __syncthreads();
#pragma unroll
    for (int m = 0; m < 2; ++m)
#pragma unroll
        for (int n = 0; n < 4; ++n)
#pragma unroll
            for (int i = 0; i < 4; ++i) *(LAS bf16*)(lds + ML_K + (l0 + 16 * m + lr + i) * TS + (c0 + 16 * n + lc) * 2) = (bf16)f2bf(acc[m][n][i]);
    __syncthreads();
    f32x4 ai[2][4], ae[2][4];
#pragma unroll
    for (int m = 0; m < 2; ++m)
#pragma unroll
        for (int n = 0; n < 4; ++n) { ai[m][n] = (f32x4){0.f, 0.f, 0.f, 0.f}; ae[m][n] = (f32x4){0.f, 0.f, 0.f, 0.f}; }
    mma_nt<2, 4>(lds + ML_K + l0 * TS, TS, lds + ML_V + c0 * TS, TS, 128, ai, lane);
    {
        const int r = lane & 15, kq = (lane >> 4) * 8;
#pragma unroll
        for (int kk = 0; kk < 4; ++kk) {
            bf16x8 a[2];
#pragma unroll
            for (int m = 0; m < 2; ++m) a[m] = *(const LAS bf16x8*)(lds + ML_Q + (l0 + m * 16 + r) * TS + (32 * kk + kq) * 2);
#pragma unroll
            for (int m = 0; m < 2; ++m)
#pragma unroll
                for (int n = 0; n < 4; ++n) ae[m][n] = __builtin_amdgcn_mfma_f32_16x16x32_bf16(a[m], cpf[kk][n], ae[m][n], 0, 0, 0);
        }
    }
#pragma unroll
    for (int m = 0; m < 2; ++m)
#pragma unroll
        for (int i = 0; i < 4; ++i) { const int l = l0 + 16 * m + lr + i; const float wi = sm[512 + l];
            const float den = wi * sm[1024 + l] + sm[768 + l]; const float dinv = 1.f / fmaxf(fabsf(den), sm[640 + l]); float ssq = 0.f;
#pragma unroll
            for (int n = 0; n < 4; ++n) { const float hv = (wi * ae[m][n][i] + ai[m][n][i]) * dinv; ai[m][n][i] = hv; ssq += hv * hv; }
            ssq += __shfl_xor(ssq, 1); ssq += __shfl_xor(ssq, 2); ssq += __shfl_xor(ssq, 4); ssq += __shfl_xor(ssq, 8);
            if (lc == 0) __hip_atomic_fetch_add(sm + 896 + l, ssq, __ATOMIC_RELAXED, __HIP_MEMORY_SCOPE_WORKGROUP); }
    __syncthreads();
    v4u owf[4];
#pragma unroll
    for (int it = 0; it < 4; ++it) { const int item = tid + 512 * it, l = item >> 4, ch = (item & 15) * 8; owf[it] = *(const GAS v4u*)(Z + (rowb + t0 + l) * NZ0 + 1536 + hm * 128 + ch); }
    LAS float* HT = (LAS float*)(lds + ML_Q);
#pragma unroll
    for (int m = 0; m < 2; ++m)
#pragma unroll
        for (int i = 0; i < 4; ++i) { const int l = l0 + 16 * m + lr + i; const float rstd = rsqrtf(sm[896 + l] * (1.f / 128.f) + EPS);
#pragma unroll
            for (int n = 0; n < 4; ++n) HT[l * 132 + c0 + 16 * n + lc] = ai[m][n][i] * rstd; }
    __syncthreads();
    { const float* mg = A.in[10] + hm * 128; bf16* Y = WSP(bf16, WS_XNY);
#pragma unroll
      for (int it = 0; it < 4; ++it) { const int item = tid + 512 * it, l = item >> 4, ch = (item & 15) * 8; const size_t row = rowb + t0 + l;
          const v4u ow = owf[it];
          const f32x4 h0 = *(const LAS f32x4*)(HT + l * 132 + ch), h1 = *(const LAS f32x4*)(HT + l * 132 + ch + 4), g0 = *(const f32x4*)(mg + ch), g1 = *(const f32x4*)(mg + ch + 4);
          v4u o; o.x = pk2(h0.x * g0.x * sigmoid_f(bflo(ow.x)), h0.y * g0.y * sigmoid_f(bfhi(ow.x))); o.y = pk2(h0.z * g0.z * sigmoid_f(bflo(ow.y)), h0.w * g0.w * sigmoid_f(bfhi(ow.y)));
          o.z = pk2(h1.x * g1.x * sigmoid_f(bflo(ow.z)), h1.y * g1.y * sigmoid_f(bfhi(ow.z))); o.w = pk2(h1.z * g1.z * sigmoid_f(bflo(ow.w)), h1.w * g1.w * sigmoid_f(bfhi(ow.w)));
          *(GAS v4u*)(Y + row * 1024 + hm * 128 + ch) = o; } }
    __syncthreads();
}
template <int N> __device__ __forceinline__ void bitonic_sort_desc(float (&v)[N]) {
#pragma unroll
    for (int k = 2; k <= N; k <<= 1)
#pragma unroll
        for (int j = k >> 1; j > 0; j >>= 1)
#pragma unroll
            for (int i = 0; i < N; ++i) { const int l = i ^ j; if (l > i) { const bool desc = ((i & k) == 0); const float a = v[i], b = v[l]; const float mx = fmaxf(a, b), mn = fminf(a, b); v[i] = desc ? mx : mn; v[l] = desc ? mn : mx; } }
}
__device__ __forceinline__ void merge_top16(float (&run)[16], const float (&nw)[16]) {
#pragma unroll
    for (int i = 0; i < 16; ++i) run[i] = fmaxf(run[i], nw[15 - i]);
#pragma unroll
    for (int j = 8; j > 0; j >>= 1)
#pragma unroll
        for (int i = 0; i < 16; ++i) { const int l = i ^ j; if (l > i) { const float a = run[i], b = run[l]; run[i] = fmaxf(a, b); run[l] = fminf(a, b); } }
}
constexpr int SCS = 132;
__device__ __forceinline__ void peer_route_unit(Frame& F, int tok0, int hd, const bf16x8 (&kf)[4][2]) {
    const bf16* QRY = WSP(bf16, WS_QRY); unsigned short* IDX = WSP(unsigned short, WS_IDX); float* GATE = WSP(float, WS_GATE);
    LAS float* SC = (LAS float*)F.lds;
    const int lane = ((int)(threadIdx.x & 63u)), w = F.wave, tid = ((int)threadIdx.x);
    {
        constexpr int AST = 528;
        LAS unsigned char* As = F.lds;
#pragma unroll
        for (int i = 0; i < 8; ++i) { const int ch = tid + 512 * i, row = ch >> 5, cc = ch & 31;
            *(LAS v4u*)(As + row * AST + cc * 16) = *(const GAS v4u*)(QRY + (size_t)(tok0 + row) * NQ + hd * 256 + cc * 8); }
        __syncthreads();
        const int p = w & 1, nq = w >> 1, r = lane & 15, kq = (lane >> 4) * 16;
        f32x4 acc[8][2];
#pragma unroll
        for (int m = 0; m < 8; ++m) { acc[m][0] = (f32x4){0.f, 0.f, 0.f, 0.f}; acc[m][1] = (f32x4){0.f, 0.f, 0.f, 0.f}; }
#pragma unroll
        for (int ks = 0; ks < 4; ++ks)
#pragma unroll
            for (int m = 0; m < 8; ++m) { const bf16x8 a = *(const LAS bf16x8*)(As + (16 * m + r) * AST + p * 256 + ks * 64 + kq);
                acc[m][0] = __builtin_amdgcn_mfma_f32_16x16x32_bf16(a, kf[ks][0], acc[m][0], 0, 0, 0);
                acc[m][1] = __builtin_amdgcn_mfma_f32_16x16x32_bf16(a, kf[ks][1], acc[m][1], 0, 0, 0); }
        __syncthreads();
#pragma unroll
        for (int m = 0; m < 8; ++m)
#pragma unroll
            for (int n = 0; n < 2; ++n)
#pragma unroll
                for (int i = 0; i < 4; ++i) SC[(p * 128 + 16 * m + 4 * (lane >> 4) + i) * SCS + 32 * nq + 16 * n + r] = acc[m][n][i];
    }
    __syncthreads();
    {
        const int t = tid & 127, p = (tid >> 7) & 1, half = tid >> 8;
        LAS float* seg = SC + (p * 128 + t) * SCS + 64 * half;
        float run[16], nw[16];
#pragma unroll
        for (int ch = 0; ch < 4; ++ch) {
#pragma unroll
            for (int q = 0; q < 4; ++q) { const f32x4 v = *(const LAS f32x4*)(seg + 16 * ch + 4 * q);
#pragma unroll
                for (int e = 0; e < 4; ++e) { const unsigned n = (unsigned)(64 * half + 16 * ch + 4 * q + e); const float key = u2f((f2u(v[e]) & ~127u) | n);
                    if (ch == 0) run[4 * q + e] = key; else nw[4 * q + e] = key; } }
            if (ch == 0) bitonic_sort_desc<16>(run); else { bitonic_sort_desc<16>(nw); merge_top16(run, nw); }
        }
#pragma unroll
        for (int q = 0; q < 4; ++q) *(LAS f32x4*)(seg + 4 * q) = (f32x4){run[4 * q], run[4 * q + 1], run[4 * q + 2], run[4 * q + 3]};
    }
    __syncthreads();
    if (tid < 128) {
        const int t = tid;
        float s0[16], s1[16];
        {
            LAS float* a = SC + (0 * 128 + t) * SCS; float nw[16];
#pragma unroll
            for (int q = 0; q < 4; ++q) { const f32x4 v = *(const LAS f32x4*)(a + 4 * q), u = *(const LAS f32x4*)(a + 64 + 4 * q);
#pragma unroll
                for (int e = 0; e < 4; ++e) { s0[4 * q + e] = v[e]; nw[4 * q + e] = u[e]; } }
            merge_top16(s0, nw);
#pragma unroll
            for (int q = 0; q < 4; ++q) *(LAS f32x4*)(a + 16 + 4 * q) = (f32x4){s0[4 * q], s0[4 * q + 1], s0[4 * q + 2], s0[4 * q + 3]};
        }
        {
            LAS float* a = SC + (1 * 128 + t) * SCS; float nw[16];
#pragma unroll
            for (int q = 0; q < 4; ++q) { const f32x4 v = *(const LAS f32x4*)(a + 4 * q), u = *(const LAS f32x4*)(a + 64 + 4 * q);
#pragma unroll
                for (int e = 0; e < 4; ++e) { s1[4 * q + e] = v[e]; nw[4 * q + e] = u[e]; } }
            merge_top16(s1, nw);
#pragma unroll
            for (int q = 0; q < 4; ++q) *(LAS f32x4*)(a + 16 + 4 * q) = (f32x4){s1[4 * q], s1[4 * q + 1], s1[4 * q + 2], s1[4 * q + 3]};
        }
#pragma unroll
        for (int i = 0; i < 16; ++i) { s0[i] = u2f(f2u(s0[i]) & ~127u); s1[i] = u2f(f2u(s1[i]) & ~127u); }
        constexpr int CNT[16] = {16, 8, 5, 4, 3, 2, 2, 2, 1, 1, 1, 1, 1, 1, 1, 1};
        constexpr int OFF[16] = {0, 16, 24, 29, 33, 36, 38, 40, 42, 43, 44, 45, 46, 47, 48, 49};
        float top[16], nw[16];
#pragma unroll
        for (int grp = 0; grp < 4; ++grp) {
#pragma unroll
            for (int e = 0; e < 16; ++e) nw[e] = -INFINITY;
#pragma unroll
            for (int i = 0; i < 16; ++i)
#pragma unroll
                for (int j = 0; j < 16; ++j) if (j < CNT[i] && (OFF[i] + j) / 16 == grp) {
                    const float sum = s0[i] + s1[j];
                    nw[(OFF[i] + j) % 16] = u2f((f2u(sum) & ~255u) | (unsigned)(i * 16 + j)); }
            bitonic_sort_desc<16>(nw);
            if (grp == 0) {
#pragma unroll
                for (int e = 0; e < 16; ++e) top[e] = nw[e];
            } else merge_top16(top, nw);
        }
        float sc[16], den = 0.f;
        const float mx = u2f(f2u(top[0]) & ~255u);
#pragma unroll
        for (int k = 0; k < 16; ++k) { sc[k] = __expf(u2f(f2u(top[k]) & ~255u) - mx); den += sc[k]; }
        const float inv = 1.f / den;
        LDS_WAIT();
        const LAS unsigned* l0 = (const LAS unsigned*)(SC + (0 * 128 + t) * SCS + 16); const LAS unsigned* l1 = (const LAS unsigned*)(SC + (1 * 128 + t) * SCS + 16);
        const size_t ob = (size_t)(tok0 + t) * 128 + hd * 16;
        unsigned eid[16];
#pragma unroll
        for (int k = 0; k < 16; ++k) { const unsigned id = f2u(top[k]) & 255u; const unsigned e0 = l0[id >> 4] & 127u, e1 = l1[id & 15u] & 127u; eid[k] = e0 * 128u + e1; }
        { v4u i0, i1; i0.x = eid[0] | (eid[1] << 16); i0.y = eid[2] | (eid[3] << 16); i0.z = eid[4] | (eid[5] << 16); i0.w = eid[6] | (eid[7] << 16);
          i1.x = eid[8] | (eid[9] << 16); i1.y = eid[10] | (eid[11] << 16); i1.z = eid[12] | (eid[13] << 16); i1.w = eid[14] | (eid[15] << 16);
          *(GAS v4u*)(IDX + ob) = i0; *(GAS v4u*)(IDX + ob + 8) = i1; }
#pragma unroll
        for (int q4 = 0; q4 < 4; ++q4) *(GAS f32x4*)(GATE + ob + 4 * q4) = (f32x4){sc[4 * q4] * inv, sc[4 * q4 + 1] * inv, sc[4 * q4 + 2] * inv, sc[4 * q4 + 3] * inv};
    }
    __syncthreads();
}
__device__ __forceinline__ void peer_u_phase(Frame& F, const unsigned char* U8  ) {
    const bf16* XN = WSP(bf16, WS_XNY); const unsigned short* IDX = WSP(unsigned short, WS_IDX); unsigned short* PART = WSP(unsigned short, WS_PART);
    const int lane = (int)(threadIdx.x & 63u), t8 = lane >> 3, l8 = lane & 7;
    const int g = F.bid & 7, nsw = (F.G >> 3) * NWAVES, ws = (F.bid >> 3) * NWAVES + F.wave;
    const unsigned char* Ug = U8 + (size_t)g * 16384 * 128; const unsigned lo8 = 16u * (unsigned)l8;
    for (int wi = ws; wi < M / 8; wi += nsw) {
        const int tok = wi * 8 + t8;
        int hq[4]; float hsc;
        { const bf16* hp = XN + (size_t)tok * D + 128 * g + 16 * l8; const v4u x = *(const GAS v4u*)hp, y = *(const GAS v4u*)(hp + 8);
          const float hf[16] = {bflo(x.x), bfhi(x.x), bflo(x.y), bfhi(x.y), bflo(x.z), bfhi(x.z), bflo(x.w), bfhi(x.w), bflo(y.x), bfhi(y.x), bflo(y.y), bfhi(y.y), bflo(y.z), bfhi(y.z), bflo(y.w), bfhi(y.w)};
          float am = 0.f;
#pragma unroll
          for (int i = 0; i < 16; ++i) am = fmaxf(am, fabsf(hf[i]));
          am = fmaxf(am, __shfl_xor(am, 1)); am = fmaxf(am, __shfl_xor(am, 2)); am = fmaxf(am, __shfl_xor(am, 4));
          const float hinv = am > 1e-30f ? 127.f / am : 0.f; hsc = am * (1.f / (127.f * 64.f));
#pragma unroll
          for (int q4 = 0; q4 < 4; ++q4) { unsigned wv = 0;
#pragma unroll
              for (int e = 0; e < 4; ++e) { const int qv = (int)rintf(hf[4 * q4 + e] * hinv); wv |= ((unsigned)qv & 0xffu) << (8 * e); }
              hq[q4] = (int)wv; } }
        const unsigned short* ip = IDX + (size_t)tok * 128; unsigned short* pp = PART + ((size_t)g * M + tok) * 128;
#pragma unroll 4
        for (int gi = 0; gi < 16; ++gi) {
            const v4u idp = *(const GAS v4u*)(ip + 8 * gi);
            const unsigned e0 = idp.x & 0xffffu, e1 = idp.x >> 16, e2 = idp.y & 0xffffu, e3 = idp.y >> 16, e4 = idp.z & 0xffffu, e5 = idp.z >> 16, e6 = idp.w & 0xffffu, e7 = idp.w >> 16;
            const v4u r0 = *(const GAS v4u*)(Ug + ((e0 << 7) | lo8)), r1 = *(const GAS v4u*)(Ug + ((e1 << 7) | lo8)), r2 = *(const GAS v4u*)(Ug + ((e2 << 7) | lo8)), r3 = *(const GAS v4u*)(Ug + ((e3 << 7) | lo8));
            const v4u r4 = *(const GAS v4u*)(Ug + ((e4 << 7) | lo8)), r5 = *(const GAS v4u*)(Ug + ((e5 << 7) | lo8)), r6 = *(const GAS v4u*)(Ug + ((e6 << 7) | lo8)), r7 = *(const GAS v4u*)(Ug + ((e7 << 7) | lo8));
#define U_DOT(R) ({ const unsigned a_ = R.x, b_ = R.y, c_ = R.z, d_ = R.w; int acc_ = __builtin_amdgcn_sdot4((int)a_, hq[0], 0, false); acc_ = __builtin_amdgcn_sdot4((int)b_, hq[1], acc_, false); \
                    acc_ = __builtin_amdgcn_sdot4((int)c_, hq[2], acc_, false); acc_ = __builtin_amdgcn_sdot4((int)d_, hq[3], acc_, false); \
                    acc_ += __shfl_xor(acc_, 1); acc_ += __shfl_xor(acc_, 2); acc_ += __shfl_xor(acc_, 4); (float)acc_ * hsc; })
            const float d0 = U_DOT(r0), d1 = U_DOT(r1), d2 = U_DOT(r2), d3 = U_DOT(r3), d4 = U_DOT(r4), d5 = U_DOT(r5), d6 = U_DOT(r6), d7 = U_DOT(r7);
#undef U_DOT
            if (l8 == 0) { v4u o; o.x = f2h2(d0, d1); o.y = f2h2(d2, d3); o.z = f2h2(d4, d5); o.w = f2h2(d6, d7); *(GAS v4u*)(pp + 8 * gi) = o; }
        }
    }
}
__device__ __forceinline__ void peer_act_phase(Frame& F, const float* ISU, const float* ISV) {
    const unsigned short* IDX = WSP(unsigned short, WS_IDX); const float* GATE = WSP(float, WS_GATE); const unsigned* PART = WSP(unsigned, WS_PART);
    unsigned short* ACT8 = WSP(unsigned short, WS_ACT); float* ACTS = WSP(float, WS_ACTS);
    const int gw = F.bid * NWAVES + F.wave, NGW = F.G * NWAVES, lane = ((int)(threadIdx.x & 63u));
    for (int tok = gw; tok < M; tok += NGW) {
        const size_t i = (size_t)tok * 128 + 2 * lane;
        float s0 = 0.f, s1 = 0.f;
#pragma unroll
        for (int g = 0; g < 8; ++g) { const unsigned p = PART[((size_t)g * M * 128 + i) >> 1]; s0 += h2f_lo(p); s1 += h2f_hi(p); }
        const unsigned idw = *(const unsigned*)(IDX + i); int2 id; id.x = (int)(idw & 0xffffu); id.y = (int)(idw >> 16); const float2 gt = *(const float2*)(GATE + i);
        const float d0 = s0 * (64.f * ISU[id.x]), d1 = s1 * (64.f * ISU[id.y]);
        const float a0 = 0.5f * d0 * (1.f + erff(d0 * 0.70710678118654752f)) * gt.x * ISV[id.x], a1 = 0.5f * d1 * (1.f + erff(d1 * 0.70710678118654752f)) * gt.y * ISV[id.y];
        const float am = wave_max(fmaxf(fabsf(a0), fabsf(a1)));
        const float inv = am > 1e-30f ? 127.f / am : 0.f;
        const int q0 = (int)rintf(a0 * inv), q1 = (int)rintf(a1 * inv);
        ACT8[(size_t)tok * 64 + lane] = (unsigned short)(((unsigned)q0 & 0xffu) | (((unsigned)q1 & 0xffu) << 8));
        if (lane == 0) ACTS[tok] = am * (1.f / 127.f);
    }
}
template <bool FINAL>
__device__ __forceinline__ void peer_v_phase(Frame& F, const unsigned char* V8, const float* g2  ) {
    const unsigned short* IDX = WSP(unsigned short, WS_IDX); const unsigned* ACT8 = WSP(unsigned, WS_ACT); const float* ACTS = WSP(float, WS_ACTS);
    const int lane = ((int)(threadIdx.x & 63u)), t8 = lane >> 3, l8 = lane & 7;
    const int g = F.bid & 7, nsw = (F.G >> 3) * NWAVES, ws = (F.bid >> 3) * NWAVES + F.wave;
    const unsigned char* Vg = V8 + (size_t)g * 16384 * 128; const unsigned lo8 = 16u * (unsigned)l8;
    for (int wi = ws; wi < M / 8; wi += nsw) {
        const int tok = wi * 8 + t8;
        const unsigned short* ip = IDX + (size_t)tok * 128; const unsigned* ap = ACT8 + (size_t)tok * 32;
        int acc[16];
#pragma unroll
        for (int i = 0; i < 16; ++i) acc[i] = 0;
#pragma unroll 8
        for (int gi = 0; gi < 32; ++gi) {
            const v2u idp = *(const GAS v2u*)(ip + 4 * gi); v4u id4; id4.x = idp.x & 0xffffu; id4.y = idp.x >> 16; id4.z = idp.y & 0xffffu; id4.w = idp.y >> 16; const int qa = (int)ap[gi];
            const v4u ra = *(const GAS v4u*)(Vg + ((id4.x << 7) | lo8)), rb = *(const GAS v4u*)(Vg + ((id4.y << 7) | lo8)), rc = *(const GAS v4u*)(Vg + ((id4.z << 7) | lo8)), rd = *(const GAS v4u*)(Vg + ((id4.w << 7) | lo8));
            const unsigned A[4] = {ra.x, ra.y, ra.z, ra.w}, B[4] = {rb.x, rb.y, rb.z, rb.w}, C[4] = {rc.x, rc.y, rc.z, rc.w}, Dd[4] = {rd.x, rd.y, rd.z, rd.w};
#pragma unroll
            for (int j = 0; j < 4; ++j) {
                const unsigned ablo = __builtin_amdgcn_perm(B[j], A[j], 0x05010400u), abhi = __builtin_amdgcn_perm(B[j], A[j], 0x07030602u);
                const unsigned cdlo = __builtin_amdgcn_perm(Dd[j], C[j], 0x05010400u), cdhi = __builtin_amdgcn_perm(Dd[j], C[j], 0x07030602u);
                const unsigned t0 = __builtin_amdgcn_perm(cdlo, ablo, 0x05040100u), t1 = __builtin_amdgcn_perm(cdlo, ablo, 0x07060302u);
                const unsigned t2 = __builtin_amdgcn_perm(cdhi, abhi, 0x05040100u), t3 = __builtin_amdgcn_perm(cdhi, abhi, 0x07060302u);
                acc[4 * j] = __builtin_amdgcn_sdot4((int)t0, qa, acc[4 * j], false); acc[4 * j + 1] = __builtin_amdgcn_sdot4((int)t1, qa, acc[4 * j + 1], false);
                acc[4 * j + 2] = __builtin_amdgcn_sdot4((int)t2, qa, acc[4 * j + 2], false); acc[4 * j + 3] = __builtin_amdgcn_sdot4((int)t3, qa, acc[4 * j + 3], false);
            }
        }
        const float sc = ACTS[tok];
        const int b = tok >> 13, c0 = 128 * g + 16 * l8; bf16* xs = WSP(bf16, WS_XS) + (size_t)tok * D + c0; const float* gr = g2 + (size_t)b * 6144 + c0;
        const v4u xa = *(const GAS v4u*)xs, xb = *(const GAS v4u*)(xs + 8);
        const unsigned xw[8] = {xa.x, xa.y, xa.z, xa.w, xb.x, xb.y, xb.z, xb.w};
        float o[16];
#pragma unroll
        for (int q4 = 0; q4 < 4; ++q4) { const f32x4 gv = *(const f32x4*)(gr + 4 * q4);
            o[4 * q4] = bflo(xw[2 * q4]) + gv.x * sc * (float)acc[4 * q4]; o[4 * q4 + 1] = bfhi(xw[2 * q4]) + gv.y * sc * (float)acc[4 * q4 + 1];
            o[4 * q4 + 2] = bflo(xw[2 * q4 + 1]) + gv.z * sc * (float)acc[4 * q4 + 2]; o[4 * q4 + 3] = bfhi(xw[2 * q4 + 1]) + gv.w * sc * (float)acc[4 * q4 + 3]; }
        if (FINAL) { float* xr = F.out + (size_t)tok * D + c0;
#pragma unroll
            for (int q4 = 0; q4 < 4; ++q4) *(GAS f32x4*)(xr + 4 * q4) = (f32x4){o[4 * q4], o[4 * q4 + 1], o[4 * q4 + 2], o[4 * q4 + 3]};
        } else { v4u ya, yb; ya.x = pk2(o[0], o[1]); ya.y = pk2(o[2], o[3]); ya.z = pk2(o[4], o[5]); ya.w = pk2(o[6], o[7]); yb.x = pk2(o[8], o[9]); yb.y = pk2(o[10], o[11]); yb.z = pk2(o[12], o[13]); yb.w = pk2(o[14], o[15]);
            *(GAS v4u*)xs = ya; *(GAS v4u*)(xs + 8) = yb; }
    }
}
#ifndef MK_PER_PHASE
#define MK_PER_PHASE 0
#endif
constexpr int NPHASE = 24;
#ifndef PHASE_MASK
#define PHASE_MASK 0x1ffffffu
#endif
#define IN(k) (lo <= (k) && (k) < hi && ((PHASE_MASK >> (k)) & 1u))
#define SEAM(k) do { if (IN(k) && IN((k) + 1)) xcd_barrier(bar); } while (0)
__device__ __forceinline__ float alibi_tcut(const float* gq, const float* gk, int lane) { return 16.f * wave_max(fabsf(gq[lane])) * wave_max(fabsf(gk[lane])) + ALIBI_MARGIN; }
template <int layer>
__device__ __forceinline__ void layer_phases(Frame& F, const Args& args, const XcdBarrier& bar, const int lo, const int hi) {
    volatile LAS unsigned* MISCW = (volatile LAS unsigned*)(F.lds + MISC_OFF);
    float* MOD = WSP(float, WS_MOD);
    bf16* XNY = WSP(bf16, WS_XNY); bf16* Zb = WSP(bf16, WS_Z);

        constexpr int pb = layer * 12;
        const float* mod = MOD + (size_t)layer * 4 * 6144;
        if (IN(pb + 1)) { if (layer == 0) norm_pass<true, false>(F, args, args.in[0], args.in[4], mod, 0, XNY); else norm_pass<false, true>(F, args, WSP(bf16, WS_XS), args.in[4] + 1024, mod, 0, XNY); } SEAM(pb + 1);
        if (IN(pb + 2)) {
            const int N = layer == 0 ? NZ0 : NZ1;
            pg8::Gemm g{XNY, layer == 0 ? WSP(bf16, WS_WIN0) : WSP(bf16, WS_WIN1), M, N, D}; pg8::StaticOrder S; S.init(M, N, F.G, F.bid);
            pg8::EpiBf16QK E{Zb, N, layer == 0 ? 8 : 0, layer == 0 ? 10 : 4, layer == 0 ? 10 : 4, layer == 0 ? 12 : 8, layer == 0 ? args.in[11] : args.in[15], layer == 0 ? args.in[12] : args.in[16], 0.125f * LOG2E, (LAS float*)(F.lds + 131072)};
            pg8::gemm_phase<pg8::EpiBf16QK, pg8::StaticOrder, true, true>(F.lds, g, S, E);
        } SEAM(pb + 2);
        if (layer == 0) {
            if (IN(3)) {
                for (int u = F.bid; u < 1024 + 128; u += F.G) {
                    if (u < 1024) mlstm_a_unit(F, args, u);
                    else { const int v = u - 1024, b = v >> 5, j = v & 31;
                        kmean_unit(F, Zb, NZ0, b * SEQ + j * 256, 2560, WSP(float, WS_KMEAN) + (size_t)((b * 8) * 32 + j) * 64); }
                }
            } SEAM(3);
            if (IN(4)) {
                for (int u = F.bid; u < 128; u += F.G) mlstm_scan_unit(F, u);
                { const float tcut = alibi_tcut(args.in[11], args.in[12], ((int)(threadIdx.x & 63u)));
                  const unsigned short* ORD = WSP(unsigned short, WS_ORD) + 2048; unsigned* qw = (unsigned*)(F.ws + WS_CTL) + CW_QMOBA;
                  for (int xi = 0; xi < 8; ++xi) { const int x = (F.bid + xi) & 7;
                      for (;;) { if (((int)threadIdx.x) == 0) MISCW[0] = atomicAdd(qw + 16 * x, 1u); __syncthreads(); const unsigned qi = MISCW[0]; __syncthreads(); if (qi >= 128u) break;
                          const int u = ORD[x * 128 + qi]; moba_unit(F, u >> 8, (u >> 5) & 7, u & 31, tcut); } }
                  { unsigned* cw = (unsigned*)(F.ws + WS_CTL) + CW_QCVT0;
                      for (;;) { if (((int)threadIdx.x) == 0) MISCW[0] = atomicAdd(cw, 1u); __syncthreads(); const unsigned ci = MISCW[0]; __syncthreads(); if (ci >= 512u) break; i8_chunk(F, args, 0, (int)ci); } } }
            } SEAM(4);
            if (IN(5)) { for (int u = F.bid; u < 1024; u += F.G) mlstm_c_unit(F, args, u); } SEAM(5);
        } else {
            if (IN(pb + 4)) {
                const float* lp = args.in[17];
                const float lam = __expf(wave_sum(lp[((int)(threadIdx.x & 63u))] * lp[64 + ((int)(threadIdx.x & 63u))])) - __expf(wave_sum(lp[128 + ((int)(threadIdx.x & 63u))] * lp[192 + ((int)(threadIdx.x & 63u))])) + 0.35550906759096926f;
                { const float tcut = alibi_tcut(args.in[15], args.in[16], ((int)(threadIdx.x & 63u)));
                  const unsigned short* ORD = WSP(unsigned short, WS_ORD); unsigned* qw = (unsigned*)(F.ws + WS_CTL) + CW_QDIFF;
                  for (int xi = 0; xi < 8; ++xi) { const int x = (F.bid + xi) & 7;
                      for (;;) { if (((int)threadIdx.x) == 0) MISCW[0] = atomicAdd(qw + 16 * x, 1u); __syncthreads(); const unsigned qi = MISCW[0]; __syncthreads(); if (qi >= 256u) break;
                          const int u = ORD[x * 256 + qi]; diff_unit(F, args, u >> 9, (u >> 6) & 7, u & 63, lam, tcut); } }
                  { unsigned* cw = (unsigned*)(F.ws + WS_CTL) + CW_QCVT1;
                      for (;;) { if (((int)threadIdx.x) == 0) MISCW[0] = atomicAdd(cw, 1u); __syncthreads(); const unsigned ci = MISCW[0]; __syncthreads(); if (ci >= 512u) break; i8_chunk(F, args, 1, (int)ci); } } }
            } SEAM(pb + 4);
        }
        if (IN(pb + 6)) {
            pg8::Gemm g{XNY, layer == 0 ? WSP(bf16, WS_WOUT0) : WSP(bf16, WS_WOUT1), M, D, D}; pg8::StaticOrder S; S.init(M, D, F.G, F.bid);
            if (layer == 0) { pg8::EpiResid<false> E{args.in[0], WSP(bf16, WS_XS), mod + 2 * 1024}; pg8::gemm_phase<pg8::EpiResid<false>, pg8::StaticOrder, true, true>(F.lds, g, S, E); }
            else { pg8::EpiResid<true> E{WSP(bf16, WS_XS), WSP(bf16, WS_XS), mod + 2 * 1024}; pg8::gemm_phase<pg8::EpiResid<true>, pg8::StaticOrder, true, true>(F.lds, g, S, E); }
        } SEAM(pb + 6);
        if (IN(pb + 7)) { norm_pass<false, true>(F, args, WSP(bf16, WS_XS), args.in[5] + layer * 1024, mod, 3, XNY); } SEAM(pb + 7);
        if (IN(pb + 8)) {
            pg8::Gemm g{XNY, WSP(bf16, WS_WQ) + (size_t)layer * NQ * D, M, NQ, D}; pg8::StaticOrder S; S.init(M, NQ, F.G, F.bid);
            pg8::EpiBf16 E{WSP(bf16, WS_QRY), NQ};
            pg8::gemm_phase<pg8::EpiBf16, pg8::StaticOrder, true, true>(F.lds, g, S, E);
        } SEAM(pb + 8);
        if (IN(pb + 9)) { const bf16* KEYS = WSP(bf16, WS_KEYS) + (size_t)layer * 2 * 128 * 128;
            bf16x8 kf[4][2];
#pragma unroll
            for (int ks = 0; ks < 4; ++ks)
#pragma unroll
                for (int n = 0; n < 2; ++n) kf[ks][n] = *(const GAS bf16x8*)(KEYS + (size_t)((F.wave & 1) * 128 + 32 * (F.wave >> 1) + 16 * n + (((int)(threadIdx.x & 63u)) & 15)) * 128 + 32 * ks + 8 * (((int)(threadIdx.x & 63u)) >> 4));
            for (int u = F.bid; u < 2048; u += F.G) peer_route_unit(F, (u >> 3) * 128, u & 7, kf); } SEAM(pb + 9);
        if (IN(pb + 10)) { peer_u_phase(F, F.ws + WS_UB + (size_t)layer * 8 * 16384 * 128); } SEAM(pb + 10);
        if (IN(pb + 11)) { peer_act_phase(F, WSP(float, WS_ISU) + layer * 16384, WSP(float, WS_ISV) + layer * 16384); } SEAM(pb + 11);
        if (IN(pb + 12)) { peer_v_phase<layer == 1>(F, F.ws + WS_VB + (size_t)layer * 8 * 16384 * 128, mod + 5 * 1024); }
        if (layer == 0) SEAM(12);
    }
__global__ void __launch_bounds__(NTHR, 2) mega_fwd(Args args) {
    extern __shared__ __attribute__((aligned(16))) unsigned char lds_raw[];
    Frame F;
    F.lds = (LAS unsigned char*)lds_raw;
    F.wave = __builtin_amdgcn_readfirstlane((int)threadIdx.x >> 6);
    F.G = gridDim.x; F.bid = blockIdx.x;
    F.out = args.out; F.ws = args.ws;
    volatile LAS unsigned* MISC = (volatile LAS unsigned*)(F.lds + MISC_OFF);
    for (int u = ((int)threadIdx.x); u < (LDS_BYTES - LDSCTL_OFF) / 4; u += NTHR) ((LAS unsigned*)(F.lds + LDSCTL_OFF))[u] = 0u;
    __syncthreads();
    XcdBarrier bar; bar.bar = (unsigned*)(F.ws + WS_CTL) + CW_BAR; bar.x = 0; bar.st = nullptr;
    if (!MK_PER_PHASE) bar = xcd_barrier_post((unsigned*)(F.ws + WS_CTL) + CW_BAR, MISC + 8);
    const int lo = args.ph_lo, hi = args.ph_hi;

#ifdef EXTRA_BAR
    for (int i = 0; i < EXTRA_BAR; ++i) xcd_barrier(bar);
#endif
    if (IN(0)) { p0_prologue(F, args); } SEAM(0);
    layer_phases<0>(F, args, bar, lo, hi);
    layer_phases<1>(F, args, bar, lo, hi);
}
#undef IN
#undef SEAM

extern "C" void kernel_launch(void* const* d_in, const int* in_sizes, int n_in, void* d_out, int out_size, void* d_ws, size_t ws_size, hipStream_t stream) {
    static int grid = 0;
    if (grid == 0) {
        if (n_in != 24 || in_sizes[0] != M * D || out_size != M * D || ws_size < WS_END) { fprintf(stderr, "kernel_launch: unexpected problem (n_in %d, in0 %d, out %d, ws %zu < %zu); nothing launched\n", n_in, n_in > 0 ? in_sizes[0] : -1, out_size, ws_size, (size_t)WS_END); grid = -1; return; }
        int dev = 0, cus = 0, per_cu = 0;
        if (hipGetDevice(&dev) != hipSuccess || hipDeviceGetAttribute(&cus, hipDeviceAttributeMultiprocessorCount, dev) != hipSuccess) { grid = -1; return; }
        if (hipFuncSetAttribute((const void*)mega_fwd, hipFuncAttributeMaxDynamicSharedMemorySize, LDS_BYTES) != hipSuccess) { fprintf(stderr, "kernel_launch: hipFuncSetAttribute failed\n"); grid = -1; return; }
        if (hipOccupancyMaxActiveBlocksPerMultiprocessor(&per_cu, (const void*)mega_fwd, NTHR, LDS_BYTES) != hipSuccess || per_cu < 1)
            fprintf(stderr, "kernel_launch: note: occupancy query reports %d workgroups per CU\n", per_cu);
        (void)hipGetLastError();
        grid = cus;
    }
    if (grid < 0) return;
    if (hipMemsetAsync((char*)d_ws + WS_CTL, 0, CTL_ZERO_BYTES, stream) != hipSuccess) { fprintf(stderr, "kernel_launch: memset failed\n"); return; }
    Args a{};
    for (int i = 0; i < 24; ++i) a.in[i] = (const float*)d_in[i];
    a.out = (float*)d_out; a.ws = (unsigned char*)d_ws;
#if MK_PER_PHASE
    for (int p = 0; p < NPHASE + 1; ++p) { a.ph_lo = p; a.ph_hi = p + 1; hipLaunchKernelGGL(mega_fwd, dim3(grid), dim3(NTHR), LDS_BYTES, stream, a); }
#else
#ifdef MK_PROBE_HI
    a.ph_lo = 0; a.ph_hi = MK_PROBE_HI;
    hipLaunchKernelGGL(mega_fwd, dim3(grid), dim3(NTHR), LDS_BYTES, stream, a);
    if (hipMemsetAsync((char*)d_ws + WS_CTL, 0, CTL_ZERO_BYTES, stream) != hipSuccess) return;
#endif
    a.ph_lo = 0; a.ph_hi = NPHASE + 1;
    hipLaunchKernelGGL(mega_fwd, dim3(grid), dim3(NTHR), LDS_BYTES, stream, a);
#endif
    const hipError_t le = hipPeekAtLastError();
    if (le != hipSuccess) fprintf(stderr, "kernel_launch: launch failed: %s\n", hipGetErrorName(le));
}
```

```cpp
#include <hip/hip_runtime.h>
#include <cstdio>
#include <cstdint>
namespace pg8 {
#define PG8_LAS __attribute__((address_space(3)))
typedef unsigned short bf16_t;
typedef short bf16x8 __attribute__((ext_vector_type(8)));
typedef float f32x4 __attribute__((ext_vector_type(4)));
typedef unsigned u32x4 __attribute__((ext_vector_type(4)));
constexpr int BM = 256, BK = 64, HALF = 128, HTB = HALF * BK * 2  , STAGE_BYTES = 8 * HTB, NXCD = 8, WGM = 8;

__host__ __device__ __forceinline__ int lds_byte(int r, int c) { const int st = (r >> 4) * 2 + (c >> 5), rr = r & 15, cc = c & 31, ob = rr * 64 + cc * 2; return st * 1024 + (ob ^ (((ob >> 9) & 1) << 5)); }
__host__ __device__ __forceinline__ void stage_rc(int b, int& R, int& C) { const int st = b / 1024, sb = b % 1024, swz = sb ^ (((sb >> 9) & 1) << 5); R = (st >> 1) * 16 + swz / 64; C = (st & 1) * 32 + (swz % 64) / 2; }
__host__ __device__ __forceinline__ int perm32(int rho) { const int n = rho >> 4, i = rho & 15; return 8 * (i >> 2) + 4 * n + (i & 3); }

struct Unit { int pm, pn; };
struct Gemm { const bf16_t* A; const bf16_t* Bt; int M, N, K; size_t bstride; };

struct StaticOrder {
    int nM, nN, nwg, G, c;
    __host__ __device__ void init(int M, int N, int G_, int c_) { nM = M / BM; nN = N / BM; nwg = nM * nN; G = G_; c = c_; }
    __host__ __device__ bool next(int i, Unit& u) const {
        const long L = (long)i * G + c; if (L >= nwg) return false;
        int wgid = (int)L; { const int q = nwg / NXCD, r = nwg % NXCD, xcd = wgid % NXCD, off = wgid / NXCD; wgid = (xcd < r ? xcd * (q + 1) : r * (q + 1) + (xcd - r) * q) + off; }
        const int nig = WGM * nN, gid = wgid / nig, fm = gid * WGM, gsz = (nM - fm) < WGM ? (nM - fm) : WGM;
        u.pm = fm + ((wgid % nig) % gsz); u.pn = (wgid % nig) / gsz; return true;
    }
    __device__ __forceinline__ void a_ready(const Unit&) const {}
    __device__ __forceinline__ void done(const Unit&) const {}
};

__device__ __forceinline__ unsigned cvt_pk_bf16(float lo, float hi) { unsigned r; asm volatile("v_cvt_pk_bf16_f32 %0, %1, %2" : "=v"(r) : "v"(lo), "v"(hi)); return r; }
typedef unsigned u32x4 __attribute__((ext_vector_type(4)));
struct EpiBf16 {
    static constexpr bool PERM = true, AFTER_DRAIN = false;
    bf16_t* O; int ldc;
    __device__ __forceinline__ void operator()(const f32x4 (&acc)[2][2][4][2], const Unit& u, int wr, int wc, int fr, int fq) const {
        const int row0 = u.pm * BM + wr * 64 + fr; const int col0 = u.pn * BM + wc * 64 + 8 * fq;
#pragma unroll
        for (int ai = 0; ai < 2; ++ai)
#pragma unroll
            for (int m = 0; m < 4; ++m) { bf16_t* rowp = O + (size_t)(row0 + ai * HALF + m * 16) * ldc + col0;
#pragma unroll
                for (int bj = 0; bj < 2; ++bj) { const f32x4 v0 = acc[ai][bj][m][0], v1 = acc[ai][bj][m][1];
                    u32x4 w; w.x = cvt_pk_bf16(v0[0], v0[1]); w.y = cvt_pk_bf16(v0[2], v0[3]); w.z = cvt_pk_bf16(v1[0], v1[1]); w.w = cvt_pk_bf16(v1[2], v1[3]);
                    *(u32x4*)(rowp + bj * 32) = w; } }
    }
};
struct EpiBf16QK {
    static constexpr bool PERM = true, AFTER_DRAIN = false;
    bf16_t* O; int ldc; int q_lo, q_hi, k_lo, k_hi; const float* gq; const float* gk; float qmul; PG8_LAS float* xs;
    __device__ __forceinline__ void operator()(const f32x4 (&acc)[2][2][4][2], const Unit& u, int wr, int wc, int fr, int fq) const {
        const int row0 = u.pm * BM + wr * 64 + fr; const int col0 = u.pn * BM + wc * 64 + 8 * fq;
        const bool isq = u.pn >= q_lo && u.pn < q_hi, isk = u.pn >= k_lo && u.pn < k_hi;
        if (!(isq || isk)) {
#pragma unroll
            for (int ai = 0; ai < 2; ++ai)
#pragma unroll
                for (int m = 0; m < 4; ++m) { bf16_t* rowp = O + (size_t)(row0 + ai * HALF + m * 16) * ldc + col0;
#pragma unroll
                    for (int bj = 0; bj < 2; ++bj) { const f32x4 v0 = acc[ai][bj][m][0], v1 = acc[ai][bj][m][1];
                        u32x4 w; w.x = cvt_pk_bf16(v0[0], v0[1]); w.y = cvt_pk_bf16(v0[2], v0[3]); w.z = cvt_pk_bf16(v1[0], v1[1]); w.w = cvt_pk_bf16(v1[2], v1[3]);
                        *(u32x4*)(rowp + bj * 32) = w; } }
            return;
        }
        const float* g = isq ? gq : gk; const float gm = isq ? qmul : 1.f;
        f32x4 gg[2][2];
#pragma unroll
        for (int bj = 0; bj < 2; ++bj) { gg[bj][0] = *(const f32x4*)(g + bj * 32 + 8 * fq) * gm; gg[bj][1] = *(const f32x4*)(g + bj * 32 + 8 * fq + 4) * gm; }
#pragma unroll
        for (int ai = 0; ai < 2; ++ai)
#pragma unroll
            for (int m = 0; m < 4; ++m) { bf16_t* rowp = O + (size_t)(row0 + ai * HALF + m * 16) * ldc + col0;
                float s = 0.f;
#pragma unroll
                for (int bj = 0; bj < 2; ++bj) { const f32x4 v0 = acc[ai][bj][m][0], v1 = acc[ai][bj][m][1];
                    s += (v0[0] * v0[0] + v0[1] * v0[1]) + (v0[2] * v0[2] + v0[3] * v0[3]) + (v1[0] * v1[0] + v1[1] * v1[1]) + (v1[2] * v1[2] + v1[3] * v1[3]); }
                s += __shfl_xor(s, 16); s += __shfl_xor(s, 32);
                const float rs = __builtin_amdgcn_rsqf(s * (1.f / 64.f) + 1e-6f);
#pragma unroll
                for (int bj = 0; bj < 2; ++bj) {
                    const f32x4 v0 = acc[ai][bj][m][0] * rs * gg[bj][0], v1 = acc[ai][bj][m][1] * rs * gg[bj][1];
                    u32x4 w; w.x = cvt_pk_bf16(v0[0], v0[1]); w.y = cvt_pk_bf16(v0[2], v0[3]); w.z = cvt_pk_bf16(v1[0], v1[1]); w.w = cvt_pk_bf16(v1[2], v1[3]);
                    *(u32x4*)(rowp + bj * 32) = w; } }
    }
};
struct EpiBf16RS {
    static constexpr bool PERM = true, AFTER_DRAIN = false;
    bf16_t* O; int ldc; const float* rss; const float* bias; int bias_stride;
    __device__ __forceinline__ void operator()(const f32x4 (&acc)[2][2][4][2], const Unit& u, int wr, int wc, int fr, int fq) const {
        const int row0 = u.pm * BM + wr * 64 + fr; const int col0 = u.pn * BM + wc * 64 + 8 * fq; const int b = (u.pm * BM) >> 13;
        f32x4 bv[2][2];
#pragma unroll
        for (int bj = 0; bj < 2; ++bj)
#pragma unroll
            for (int n = 0; n < 2; ++n) bv[bj][n] = *(const f32x4*)(bias + (size_t)b * bias_stride + col0 + bj * 32 + 4 * n);
#pragma unroll
        for (int ai = 0; ai < 2; ++ai)
#pragma unroll
            for (int m = 0; m < 4; ++m) { const int row = row0 + ai * HALF + m * 16; bf16_t* rowp = O + (size_t)row * ldc + col0;
                const f32x4 p0 = *(const f32x4*)(rss + (size_t)row * 16), p1 = *(const f32x4*)(rss + (size_t)row * 16 + 4), p2 = *(const f32x4*)(rss + (size_t)row * 16 + 8), p3 = *(const f32x4*)(rss + (size_t)row * 16 + 12);
                const f32x4 pt = (p0 + p1) + (p2 + p3);
                const float rs = __builtin_amdgcn_rsqf(((pt[0] + pt[1]) + (pt[2] + pt[3])) * (1.f / 1024.f) + 1e-6f);
#pragma unroll
                for (int bj = 0; bj < 2; ++bj) { const f32x4 v0 = acc[ai][bj][m][0] * rs + bv[bj][0], v1 = acc[ai][bj][m][1] * rs + bv[bj][1];
                    u32x4 w; w.x = cvt_pk_bf16(v0[0], v0[1]); w.y = cvt_pk_bf16(v0[2], v0[3]); w.z = cvt_pk_bf16(v1[0], v1[1]); w.w = cvt_pk_bf16(v1[2], v1[3]);
                    *(u32x4*)(rowp + bj * 32) = w; } }
    }
};
template <bool BASE_BF16> struct EpiResid {
    static constexpr bool PERM = true, AFTER_DRAIN = false;
    const void* base; bf16_t* out; const float* gate;
    __device__ __forceinline__ void operator()(const f32x4 (&acc)[2][2][4][2], const Unit& u, int wr, int wc, int fr, int fq) const {
        const int row0 = u.pm * BM + wr * 64 + fr; const int col0 = u.pn * BM + wc * 64 + 8 * fq; const int b = (u.pm * BM) >> 13;
        f32x4 gv[2][2];
#pragma unroll
        for (int bj = 0; bj < 2; ++bj)
#pragma unroll
            for (int n = 0; n < 2; ++n) gv[bj][n] = *(const f32x4*)(gate + (size_t)b * 6144 + col0 + bj * 32 + 4 * n);
#pragma unroll
        for (int ai = 0; ai < 2; ++ai)
#pragma unroll
            for (int m = 0; m < 4; ++m)
#pragma unroll
                for (int bj = 0; bj < 2; ++bj) { const size_t off = (size_t)(row0 + ai * HALF + m * 16) * 1024 + col0 + bj * 32;
                    f32x4 b0, b1;
                    if (BASE_BF16) { const u32x4 w = *(const u32x4*)((const bf16_t*)base + off); const unsigned w0 = w.x, w1 = w.y, w2 = w.z, w3 = w.w;
                        b0 = (f32x4){__builtin_bit_cast(float, w0 << 16), __builtin_bit_cast(float, w0 & 0xffff0000u), __builtin_bit_cast(float, w1 << 16), __builtin_bit_cast(float, w1 & 0xffff0000u)};
                        b1 = (f32x4){__builtin_bit_cast(float, w2 << 16), __builtin_bit_cast(float, w2 & 0xffff0000u), __builtin_bit_cast(float, w3 << 16), __builtin_bit_cast(float, w3 & 0xffff0000u)}; }
                    else { b0 = *(const f32x4*)((const float*)base + off); b1 = *(const f32x4*)((const float*)base + off + 4); }
                    const f32x4 o0 = b0 + gv[bj][0] * acc[ai][bj][m][0], o1 = b1 + gv[bj][1] * acc[ai][bj][m][1];
                    u32x4 ow; ow.x = cvt_pk_bf16(o0[0], o0[1]); ow.y = cvt_pk_bf16(o0[2], o0[3]); ow.z = cvt_pk_bf16(o1[0], o1[1]); ow.w = cvt_pk_bf16(o1[2], o1[3]);
                    *(u32x4*)(out + off) = ow; }
    }
};

template <class Epi, class Sched, bool ALIGN_EPI = false, bool SP2 = false>
__device__ __forceinline__ void gemm_phase(PG8_LAS unsigned char* lds, const Gemm g, const Sched& S, const Epi& E) {
    const int tid = threadIdx.x, wid = __builtin_amdgcn_readfirstlane(tid >> 6), lane = tid & 63, wr = wid >> 2, wc = wid & 3, fr = lane & 15, fq = lane >> 4;
    const int K = g.K, nt = K / BK;
    unsigned voffA[2], voffB[2];
#pragma unroll
    for (int i = 0; i < 2; ++i) { int R, C; stage_rc(tid * 16 + i * 8192, R, C); const int Rb = (R >> 5) * 64 + (Epi::PERM ? perm32(R & 31) : (R & 31));
        voffA[i] = (unsigned)(R * K + C) * 2u; voffB[i] = (unsigned)(Rb * K + C) * 2u; }
    const size_t kstep = (size_t)(BK * 2);
    const size_t hstep = (size_t)HALF * K * 2;
    const size_t hstepB = (size_t)32 * K * 2;
    const size_t tstep = 2 * hstep;
    const unsigned ldsw = (unsigned)wid * 1024u;
    const int aoff = lds_byte(wr * 64 + fr, fq * 8), boff = lds_byte(wc * 32 + fr, fq * 8);
#define PG8_SA(b, h) (((b) * 2 + (h)) * HTB)
#define PG8_SB(b, h) ((4 + (b) * 2 + (h)) * HTB)
#define PG8_STAGE(bufoff, gbase, voff) do { _Pragma("unroll") for (int _i = 0; _i < 2; ++_i) \
        __builtin_amdgcn_global_load_lds((const unsigned*)((const char*)(gbase) + (voff)[_i]), (PG8_LAS unsigned*)(lds + (bufoff) + ldsw + _i * 8192), 16, 0, 0); } while (0)
#define PG8_LDA(dst, b, h) do { _Pragma("unroll") for (int m = 0; m < 4; ++m) _Pragma("unroll") for (int k = 0; k < 2; ++k) dst[m][k] = *(const PG8_LAS bf16x8*)(lds + PG8_SA(b, h) + aoff + m * 2048 + k * 1024); } while (0)
#define PG8_LDB(dst, b, h) do { _Pragma("unroll") for (int n = 0; n < 2; ++n) _Pragma("unroll") for (int k = 0; k < 2; ++k) dst[n][k] = *(const PG8_LAS bf16x8*)(lds + PG8_SB(b, h) + boff + n * 2048 + k * 1024); } while (0)
#define PG8_MMA(ai, bj, At, Bt) do { __builtin_amdgcn_s_setprio(1); _Pragma("unroll") for (int m = 0; m < 4; ++m) _Pragma("unroll") for (int n = 0; n < 2; ++n) _Pragma("unroll") for (int k = 0; k < 2; ++k) \
        acc[ai][bj][m][n] = __builtin_amdgcn_mfma_f32_16x16x32_bf16(Bt[n][k], At[m][k], acc[ai][bj][m][n], 0, 0, 0); __builtin_amdgcn_s_setprio(0); } while (0)
#define PG8_WAIT_V(n) asm volatile("s_waitcnt vmcnt(" #n ")" ::: "memory")
#define PG8_WAIT_L(n) asm volatile("s_waitcnt lgkmcnt(" #n ")" ::: "memory")
#define PG8_BAR __builtin_amdgcn_s_barrier()
#define PG8_SCHED __builtin_amdgcn_sched_barrier(0)
    Unit cur, nxt; int ui = 0;
    if (!S.next(0, cur)) return;
    f32x4 acc[2][2][4][2];
#pragma unroll
    for (int a = 0; a < 2; ++a)
#pragma unroll
        for (int b = 0; b < 2; ++b)
#pragma unroll
            for (int m = 0; m < 4; ++m)
#pragma unroll
                for (int n = 0; n < 2; ++n) acc[a][b][m][n] = (f32x4){0.f, 0.f, 0.f, 0.f};
    bf16x8 At[4][2], B0[2][2], B1[2][2];
    const char* cA = (const char*)g.A + (size_t)cur.pm * tstep; const char* cB = (const char*)g.Bt + (size_t)(cur.pm >> 5) * g.bstride + (size_t)cur.pn * tstep;
    S.a_ready(cur);
    if constexpr (SP2) {
        PG8_STAGE(PG8_SB(0, 0), cB, voffB); PG8_STAGE(PG8_SB(0, 1), cB + hstepB, voffB); PG8_STAGE(PG8_SA(0, 0), cA, voffA); PG8_STAGE(PG8_SA(0, 1), cA + hstep, voffA);
        if (wr == 1) PG8_BAR;
        PG8_WAIT_V(2); PG8_BAR;
        PG8_STAGE(PG8_SB(1, 0), cB + kstep, voffB); PG8_STAGE(PG8_SA(1, 0), cA + kstep, voffA); PG8_STAGE(PG8_SB(1, 1), cB + hstepB + kstep, voffB);
        PG8_WAIT_V(6); PG8_BAR;
    } else {
        PG8_STAGE(PG8_SB(0, 0), cB, voffB); PG8_STAGE(PG8_SA(0, 0), cA, voffA); PG8_STAGE(PG8_SB(0, 1), cB + hstepB, voffB); PG8_STAGE(PG8_SA(0, 1), cA + hstep, voffA);
        if (wr == 1) PG8_BAR;
        PG8_WAIT_V(4); PG8_BAR;
        PG8_STAGE(PG8_SB(1, 0), cB + kstep, voffB); PG8_STAGE(PG8_SA(1, 0), cA + kstep, voffA); PG8_STAGE(PG8_SB(1, 1), cB + hstepB + kstep, voffB);
        PG8_WAIT_V(6); PG8_BAR;
    }
    for (;;) {
        const bool has_next = S.next(ui + 1, nxt);
        const char* nA = has_next ? (const char*)g.A + (size_t)nxt.pm * tstep : cA; const char* nB = has_next ? (const char*)g.Bt + (size_t)(nxt.pm >> 5) * g.bstride + (size_t)nxt.pn * tstep : cB;
        for (int t = 0; t < nt; t += 2) {
            const bool last = (t == nt - 2);
            const char* a1 = cA + (size_t)(t + 1) * kstep;
            const char* a2 = last ? nA : cA + (size_t)(t + 2) * kstep; const char* b2 = last ? nB : cB + (size_t)(t + 2) * kstep;
            const char* a3 = a2 + kstep; const char* b3 = b2 + kstep;
            if (last && has_next) S.a_ready(nxt);
            if constexpr (SP2) {
            PG8_LDB(B0, 0, 0); PG8_LDB(B1, 0, 1); PG8_SCHED; PG8_LDA(At, 0, 0); PG8_STAGE(PG8_SA(1, 1), a1 + hstep, voffA);
            PG8_WAIT_V(8); PG8_WAIT_L(0); PG8_BAR; PG8_MMA(0, 0, At, B0); PG8_MMA(0, 1, At, B1); PG8_BAR; PG8_SCHED;
            PG8_LDA(At, 0, 1); PG8_STAGE(PG8_SB(0, 0), b2, voffB); PG8_STAGE(PG8_SB(0, 1), b2 + hstepB, voffB); PG8_STAGE(PG8_SA(0, 0), a2, voffA);
            PG8_WAIT_V(8); PG8_WAIT_L(0); PG8_BAR; PG8_MMA(1, 0, At, B0); PG8_MMA(1, 1, At, B1); PG8_BAR; PG8_SCHED;
            PG8_LDB(B0, 1, 0); PG8_LDB(B1, 1, 1); PG8_SCHED; PG8_LDA(At, 1, 0); PG8_STAGE(PG8_SA(0, 1), a2 + hstep, voffA);
            PG8_WAIT_V(8); PG8_WAIT_L(0); PG8_BAR; PG8_MMA(0, 0, At, B0); PG8_MMA(0, 1, At, B1); PG8_BAR; PG8_SCHED;
            PG8_LDA(At, 1, 1); PG8_STAGE(PG8_SB(1, 0), b3, voffB); PG8_STAGE(PG8_SB(1, 1), b3 + hstepB, voffB); PG8_STAGE(PG8_SA(1, 0), a3, voffA);
            PG8_WAIT_V(8); PG8_WAIT_L(0); PG8_BAR; PG8_MMA(1, 0, At, B0); PG8_MMA(1, 1, At, B1); PG8_BAR; PG8_SCHED;
            } else {
            PG8_LDB(B0, 0, 0); PG8_SCHED; PG8_LDA(At, 0, 0); PG8_STAGE(PG8_SA(1, 1), a1 + hstep, voffA);
            PG8_WAIT_L(8); PG8_BAR; PG8_WAIT_L(0); PG8_MMA(0, 0, At, B0); PG8_BAR; PG8_SCHED;
            PG8_LDB(B1, 0, 1); PG8_STAGE(PG8_SB(0, 0), b2, voffB);
            PG8_BAR; PG8_WAIT_L(0); PG8_MMA(0, 1, At, B1); PG8_BAR;
            PG8_LDA(At, 0, 1); PG8_STAGE(PG8_SA(0, 0), a2, voffA);
            PG8_BAR; PG8_WAIT_L(0); PG8_MMA(1, 0, At, B0); PG8_BAR; PG8_SCHED;
            PG8_STAGE(PG8_SB(0, 1), b2 + hstepB, voffB);
            PG8_WAIT_V(6); PG8_BAR; PG8_MMA(1, 1, At, B1); PG8_BAR;
            PG8_LDB(B0, 1, 0); PG8_SCHED; PG8_LDA(At, 1, 0); PG8_STAGE(PG8_SA(0, 1), a2 + hstep, voffA);
            PG8_WAIT_L(8); PG8_BAR; PG8_WAIT_L(0); PG8_MMA(0, 0, At, B0); PG8_BAR; PG8_SCHED;
            PG8_LDB(B1, 1, 1); PG8_STAGE(PG8_SB(1, 0), b3, voffB);
            PG8_BAR; PG8_WAIT_L(0); PG8_MMA(0, 1, At, B1); PG8_BAR;
            PG8_LDA(At, 1, 1); PG8_STAGE(PG8_SA(1, 0), a3, voffA);
            PG8_BAR; PG8_WAIT_L(0); PG8_MMA(1, 0, At, B0); PG8_BAR; PG8_SCHED;
            PG8_STAGE(PG8_SB(1, 1), b3 + hstepB, voffB);
            PG8_WAIT_V(6); PG8_BAR; PG8_MMA(1, 1, At, B1); PG8_BAR;
            }
        }
        if constexpr (ALIGN_EPI) { if (wr == 0) PG8_BAR; }
        if constexpr (!Epi::AFTER_DRAIN) { E(acc, cur, wr, wc, fr, fq); S.done(cur); }
        if (!has_next) break;
#pragma unroll
        for (int a = 0; a < 2; ++a)
#pragma unroll
            for (int b = 0; b < 2; ++b)
#pragma unroll
                for (int m = 0; m < 4; ++m)
#pragma unroll
                    for (int n = 0; n < 2; ++n) acc[a][b][m][n] = (f32x4){0.f, 0.f, 0.f, 0.f};
        cur = nxt; cA = nA; cB = nB; ++ui;
        if constexpr (ALIGN_EPI) { if (wr == 1) PG8_BAR; }
    }
    PG8_WAIT_V(0);
    if constexpr (!ALIGN_EPI) { if (wr == 0) PG8_BAR; }
    PG8_BAR;
    if constexpr (Epi::AFTER_DRAIN) { E.fused(acc, cur, wr, wc, fr, fq, lds, wid, lane); S.done(cur); }
#undef PG8_SA
#undef PG8_SB
#undef PG8_STAGE
#undef PG8_LDA
#undef PG8_LDB
#undef PG8_MMA
#undef PG8_WAIT_V
#undef PG8_WAIT_L
#undef PG8_BAR
#undef PG8_SCHED
}
}
constexpr int NB = 4, SEQ = 8192, D = 1024, M = NB * SEQ;
constexpr int NZ0 = 3584, NZ1 = 3072, NQ = 2048, SRC_IN0 = 3592;
constexpr float EPS = 1e-6f;
constexpr int NWAVES = 8, NTHR = 512;
constexpr float LOG2E = 1.4426950408889634f;
constexpr size_t MiB = 1u << 20;
constexpr size_t WS_CTL = 0, CTL_ZERO_BYTES = 1 * MiB;
constexpr size_t WS_WIN0 = 1 * MiB, WS_WOUT0 = 8 * MiB, WS_WIN1 = 10 * MiB, WS_WOUT1 = 16 * MiB, WS_WQ = 18 * MiB;
constexpr size_t WS_KEYS = 26 * MiB, WS_MOD = WS_KEYS + 128 * 1024, WS_KMEAN = WS_MOD + 192 * 1024, WS_NLOC = WS_KMEAN + 256 * 1024,
                 WS_BEND = WS_NLOC + 512 * 1024, WS_MLOC = WS_BEND + 4096, WS_MPREV = WS_MLOC + 4096,
                 WS_ISU = 27 * MiB + 512 * 1024, WS_ISV = WS_ISU + 128 * 1024, WS_ORD = WS_ISV + 128 * 1024  ;
constexpr size_t WS_GATES = 28 * MiB;
constexpr size_t WS_UB = 32 * MiB  , WS_VB = 64 * MiB, WS_ACT = 96 * MiB  , WS_ACTS = 100 * MiB  , WS_XNY = 160 * MiB, WS_Z = 224 * MiB, WS_CLOC = 448 * MiB, WS_END = 512 * MiB;
constexpr size_t WS_LIST = WS_Z + 160 * MiB  , WS_DTOK = WS_Z + 176 * MiB  ;
constexpr size_t WS_QRY = WS_Z, WS_IDX = WS_Z + 128 * MiB, WS_GATE = WS_Z + 144 * MiB, WS_PART = WS_Z  , WS_XS = 448 * MiB  ;
constexpr int CW_BAR = 4096, CW_QMOBA = 8192  , CW_QDIFF = 8448, CW_QCVT0 = 8704, CW_QCVT1 = 8768;
constexpr float ALIBI_MARGIN = 27.03f;
constexpr int RING_BYTES = 139264;
constexpr int LDSCTL_OFF = RING_BYTES, MISC_OFF = LDSCTL_OFF + 320;
constexpr int LDS_BYTES = 147456;
static_assert(MISC_OFF + 128 <= LDS_BYTES, "LDS map");

#define GAS __attribute__((address_space(1)))
#define LAS __attribute__((address_space(3)))
typedef unsigned short bf16;
typedef unsigned v4u __attribute__((ext_vector_type(4)));
typedef unsigned v2u __attribute__((ext_vector_type(2)));
typedef float f32x4 __attribute__((ext_vector_type(4)));
typedef float f32x16 __attribute__((ext_vector_type(16)));
typedef short bf16x8 __attribute__((ext_vector_type(8)));
typedef short s16x4 __attribute__((ext_vector_type(4)));
typedef GAS unsigned gu32;
#define RLX_AGENT __ATOMIC_RELAXED, __HIP_MEMORY_SCOPE_AGENT
#define LDS_WAIT() asm volatile("s_waitcnt lgkmcnt(0)" ::: "memory")
#define VM_WAIT() asm volatile("s_waitcnt vmcnt(0)" ::: "memory")
__device__ __forceinline__ unsigned f2bf(float f) { unsigned u = __builtin_bit_cast(unsigned, f); return (u + 0x7fffu + ((u >> 16) & 1u)) >> 16; }
__device__ __forceinline__ unsigned pk2(float lo, float hi) { return f2bf(lo) | (f2bf(hi) << 16); }
__device__ __forceinline__ float bflo(unsigned w) { return __builtin_bit_cast(float, w << 16); }
__device__ __forceinline__ float bfhi(unsigned w) { return __builtin_bit_cast(float, w & 0xffff0000u); }
__device__ __forceinline__ float bf2f(bf16 h) { return __builtin_bit_cast(float, (unsigned)h << 16); }
__device__ __forceinline__ unsigned f2u(float x) { return __builtin_bit_cast(unsigned, x); }
__device__ __forceinline__ float u2f(unsigned x) { return __builtin_bit_cast(float, x); }
__device__ __forceinline__ float dot2bf(unsigned a, unsigned b, float acc) { typedef __bf16 bf2_ __attribute__((ext_vector_type(2))); return __builtin_amdgcn_fdot2_f32_bf16(__builtin_bit_cast(bf2_, a), __builtin_bit_cast(bf2_, b), acc, false); }
__device__ __forceinline__ unsigned f2h2(float lo, float hi) { typedef _Float16 h2_ __attribute__((ext_vector_type(2))); typedef float f2_ __attribute__((ext_vector_type(2))); f2_ v = {lo, hi}; h2_ h = __builtin_convertvector(v, h2_); return __builtin_bit_cast(unsigned, h); }
__device__ __forceinline__ float h2f_lo(unsigned w) { return (float)__builtin_bit_cast(_Float16, (unsigned short)(w & 0xffffu)); }
__device__ __forceinline__ float h2f_hi(unsigned w) { return (float)__builtin_bit_cast(_Float16, (unsigned short)(w >> 16)); }
__device__ __forceinline__ float wave_sum(float v) {
#pragma unroll
    for (int o = 1; o < 64; o <<= 1) v += __shfl_xor(v, o);
    return v;
}
__device__ __forceinline__ float wave_max(float v) {
#pragma unroll
    for (int o = 1; o < 64; o <<= 1) v = fmaxf(v, __shfl_xor(v, o));
    return v;
}
__device__ __forceinline__ float silu_f(float x) { return x / (1.f + __expf(-x)); }
__device__ __forceinline__ float sigmoid_f(float x) { return 1.f / (1.f + __expf(-x)); }
__device__ __forceinline__ float logsigmoid_f(float x) { return fminf(x, 0.f) - log1pf(__expf(-fabsf(x))); }
struct Args { const float* in[24]; float* out; unsigned char* ws; int ph_lo, ph_hi; };
#define XB_TMO      128
#define XB_XCNT(j)  (256  + 64 * (j))
#define XB_XSUB(j)  (1280 + 64 * (j))
#define XB_XGEN(j)  (2304 + 64 * (j))
#define XB_TOP      3328
#define XB_TOPGEN   3392
#define XCD_BAR_WORDS 3456
#define XB_SPIN_CAP (1u << 18)

__device__ __forceinline__ unsigned xb_ld(unsigned* p)              { return __hip_atomic_load(p, __ATOMIC_RELAXED, __HIP_MEMORY_SCOPE_AGENT); }
__device__ __forceinline__ unsigned xb_add(unsigned* p, unsigned v) { return __hip_atomic_fetch_add(p, v, __ATOMIC_RELAXED, __HIP_MEMORY_SCOPE_AGENT); }
__device__ __forceinline__ unsigned xb_xcc_id() { return (unsigned)__builtin_amdgcn_s_getreg((3 << 11) | 20) & 0xFu; }
#define XB_SPIN(cond, bar) do { unsigned _sp = 0; while (cond) { __builtin_amdgcn_s_sleep(1); \
    if ((++_sp & 255u) == 0u) { if (xb_ld(&(bar)[XB_TMO])) break; if (_sp > XB_SPIN_CAP) { atomicAdd(&(bar)[XB_TMO], 1u); break; } } } } while (0)

struct XcdBarrier {
    unsigned* bar; unsigned x;
    volatile LAS unsigned* st;
};

__device__ __forceinline__ XcdBarrier xcd_barrier_post(unsigned* bar, volatile LAS unsigned* st) {
    XcdBarrier b; b.bar = bar; b.x = xb_xcc_id(); b.st = st;
    if (threadIdx.x == 0) (void)xb_add(&bar[XB_XCNT(b.x)], 1u);
    return b;
}
__device__ __forceinline__ void xcd_barrier_complete(unsigned* bar, unsigned x, unsigned& nloc, unsigned& nx) {
    const unsigned G = gridDim.x * gridDim.y * gridDim.z;
    unsigned sum, cnt, mine, sp = 0u;
    for (;;) {
        sum = 0u; cnt = 0u; mine = 0u;
#pragma unroll
        for (unsigned j = 0; j < 16; ++j) { const unsigned c = xb_ld(&bar[XB_XCNT(j)]); sum += c; cnt += (c > 0u) ? 1u : 0u; mine = (j == x) ? c : mine; }
        if (sum == G) break;
        __builtin_amdgcn_s_sleep(1);
        if ((++sp & 255u) == 0u) { if (xb_ld(&bar[XB_TMO])) break; if (sp > XB_SPIN_CAP) { atomicAdd(&bar[XB_TMO], 1u); break; } }
    }
    nloc = mine > 0u ? mine : 1u; nx = cnt > 0u ? cnt : 1u;
}

__device__ __forceinline__ void xcd_barrier(const XcdBarrier& b) {
    asm volatile("s_waitcnt vmcnt(0)" ::: "memory");
    __syncthreads();
    if (threadIdx.x == 0) {
        unsigned* bar = b.bar;
        __builtin_amdgcn_s_waitcnt(0);
        unsigned nloc = b.st[0], nx = b.st[1];
        if (nloc == 0u) { xcd_barrier_complete(bar, b.x, nloc, nx); b.st[0] = nloc; b.st[1] = nx; }
        const unsigned old = xb_add(&bar[XB_XSUB(b.x)], 1u);
        const unsigned gen = old / nloc;
        if (old + 1u == (gen + 1u) * nloc) {
            __builtin_amdgcn_fence(__ATOMIC_RELEASE, "agent");
            asm volatile("s_waitcnt vmcnt(0)" ::: "memory");
            const unsigned og = xb_add(&bar[XB_TOP], 1u);
            const unsigned tg = og / nx;
            if (og + 1u == (tg + 1u) * nx) xb_add(&bar[XB_TOPGEN], 1u);
            else XB_SPIN(xb_ld(&bar[XB_TOPGEN]) == tg, bar);
            __builtin_amdgcn_fence(__ATOMIC_ACQUIRE, "agent");
            xb_add(&bar[XB_XGEN(b.x)], 1u);
            asm volatile("s_waitcnt vmcnt(0)" ::: "memory");
        } else {
            XB_SPIN(xb_ld(&bar[XB_XGEN(b.x)]) == gen, bar);
            __builtin_amdgcn_fence(__ATOMIC_ACQUIRE, "agent");
            asm volatile("s_waitcnt vmcnt(0)" ::: "memory");
        }
    }
    __syncthreads();
}
struct Frame {
    LAS unsigned char* lds;
    int wave, G, bid;
    float* out; unsigned char* ws;
};
#define WSP(T, off) ((T*)(F.ws + (off)))

__device__ __forceinline__ void p0_transpose_item(const float* W, int K, int ldw, int nblk, int thr, int shift, bf16* WT, LAS float* scr, int item, int lane) {
    const int kb = item / nblk, nb = item % nblk, k0 = 64 * kb, n0 = 32 * nb, ns = n0 + (n0 >= thr ? shift : 0);
#pragma unroll 8
    for (int i = 0; i < 32; ++i) { const int kk = 2 * i + (lane >> 5); scr[kk * 33 + (lane & 31)] = W[(size_t)(k0 + kk) * ldw + ns + (lane & 31)]; }
    LDS_WAIT(); asm volatile("" ::: "memory");
    const int c = lane & 7;
#pragma unroll
    for (int j = 0; j < 4; ++j) { const int n = (lane >> 3) + 8 * j; const LAS float* s = scr + (8 * c) * 33 + n;
        v4u o; o.x = pk2(s[0 * 33], s[1 * 33]); o.y = pk2(s[2 * 33], s[3 * 33]); o.z = pk2(s[4 * 33], s[5 * 33]); o.w = pk2(s[6 * 33], s[7 * 33]);
        *(GAS v4u*)(WT + (size_t)(n0 + n) * K + k0 + 8 * c) = o; }
    LDS_WAIT(); asm volatile("" ::: "memory");
}
__device__ __forceinline__ void cvt_f32_bf16_stream(const float* src, bf16* dst, size_t n8, size_t gtid, size_t gthreads) {
    for (size_t i = gtid; i < n8; i += gthreads) {
        const f32x4 a = *(const GAS f32x4*)(src + i * 8), b = *(const GAS f32x4*)(src + i * 8 + 4);
        v4u o; o.x = pk2(a.x, a.y); o.y = pk2(a.z, a.w); o.z = pk2(b.x, b.y); o.w = pk2(b.z, b.w);
        *(GAS v4u*)(dst + i * 8) = o; }
}
__device__ __forceinline__ void i8_row(const float* src_row, unsigned char* dst  , float* scale  , int er, int lane) {
    const float* r = src_row + 16 * lane;
    float x[16];
#pragma unroll
    for (int q4 = 0; q4 < 4; ++q4) { const f32x4 a = *(const GAS f32x4*)(r + 4 * q4); x[4 * q4] = a.x; x[4 * q4 + 1] = a.y; x[4 * q4 + 2] = a.z; x[4 * q4 + 3] = a.w; }
    float am = 0.f;
#pragma unroll
    for (int i = 0; i < 16; ++i) am = fmaxf(am, fabsf(x[i]));
    am = wave_max(am);
    const float inv = am > 1e-30f ? 127.f / am : 0.f;
    unsigned wd[4];
#pragma unroll
    for (int q4 = 0; q4 < 4; ++q4) { unsigned w = 0;
#pragma unroll
        for (int e = 0; e < 4; ++e) { const int qv = (int)rintf(x[4 * q4 + e] * inv); w |= ((unsigned)qv & 0xffu) << (8 * e); }
        wd[q4] = w; }
    v4u o; o.x = wd[0]; o.y = wd[1]; o.z = wd[2]; o.w = wd[3];
    *(GAS v4u*)(dst + ((size_t)((lane >> 3) * 16384 + er)) * 128 + 16 * (lane & 7)) = o;
    if (lane == 0) scale[er] = am * (1.f / 127.f);
}
__device__ __forceinline__ void i8_chunk(Frame& F, const Args& A, int layer, int c) {
    const int tbl = c >> 8, row0 = (c & 255) * 64 + F.wave * 8;
    const float* src = A.in[22 + tbl] + (size_t)layer * 16384 * 1024;
    unsigned char* dst = F.ws + (tbl ? WS_VB : WS_UB) + (size_t)layer * 8 * 16384 * 128;
    float* sc = WSP(float, tbl ? WS_ISV : WS_ISU) + layer * 16384;
    for (int i = 0; i < 8; ++i) i8_row(src + (size_t)(row0 + i) * 1024, dst, sc, row0 + i, ((int)(threadIdx.x & 63u)));
}
__device__ __forceinline__ void p0_prologue(Frame& F, const Args& A) {
    {
        const float* c = A.in[1]; const float* aw = A.in[2]; const float* ab = A.in[3]; float* MOD = WSP(float, WS_MOD);
        LAS float* red = (LAS float*)F.lds;
        LAS float* cact = (LAS float*)(F.lds + 8192);
        if (F.bid < 192) { for (int i = (int)threadIdx.x; i < 4096; i += NTHR) cact[i] = silu_f(c[i]); __syncthreads(); }
        for (int item = F.bid; item < 192; item += F.G) {
            const int l = item / 96, n0 = (item % 96) * 64;
            float acc[4] = {0.f, 0.f, 0.f, 0.f};
            const int kbeg = F.wave * 128;
#pragma unroll 8
            for (int k = kbeg; k < kbeg + 128; ++k) {
                const float wv = aw[((size_t)l * 1024 + k) * 6144 + n0 + ((int)(threadIdx.x & 63u))];
#pragma unroll
                for (int b = 0; b < 4; ++b) acc[b] += cact[b * 1024 + k] * wv;
            }
#pragma unroll
            for (int b = 0; b < 4; ++b) red[(F.wave * 4 + b) * 64 + ((int)(threadIdx.x & 63u))] = acc[b];
            __syncthreads();
            if (((int)threadIdx.x) < 256) { const int b = ((int)threadIdx.x) >> 6, ln = ((int)threadIdx.x) & 63; float s = ab[l * 6144 + n0 + ln];
#pragma unroll
                for (int w = 0; w < 8; ++w) s += red[(w * 4 + b) * 64 + ln];
                MOD[(size_t)(l * 4 + b) * 6144 + n0 + ln] = s; }
            __syncthreads();
        }
    }
    if (F.bid >= F.G - 16) {
        LAS unsigned* hist = (LAS unsigned*)F.lds;
        unsigned short* ORD = WSP(unsigned short, WS_ORD);
        const int tid = (int)threadIdx.x, tbl = F.bid - (F.G - 16);
        { const int pass = tbl >> 3;
            const int nq = pass == 0 ? 64 : 32, nper = 4 * nq;
            { const int x = tbl & 7;
                if (tid < 160) hist[tid] = 0u;
                __syncthreads();
                int cost = 0, u = 0;
                if (tid < nper) {
                    const int hs = tid / nq, q = tid % nq, h = (x >> 2) ? (hs == 0 ? 6 : hs == 1 ? 5 : hs == 2 ? 1 : 0) : (hs == 0 ? 7 : hs == 1 ? 4 : hs == 2 ? 3 : 2), b = x & 3;
                    const float dcut = 46.f * (float)(2 << h);
                    if (pass == 0) { const int nt = 2 * q + 2; int lo = (int)ceilf(((float)(q * 128) - dcut - 63.f) * (1.f / 64.f)); if (lo < 0) lo = 0; cost = nt - lo; u = (b << 9) | (h << 6) | q; }
                    else { int lo = (int)ceilf(((float)(q * 256) - dcut - 255.f) * (1.f / 256.f)); if (lo < 0) lo = 0; int nb = q - lo; if (nb > 24) nb = 24; cost = 4 * (nb + 1); u = (b << 8) | (h << 5) | q; }
                    if (cost > 159) cost = 159;
                    atomicAdd((unsigned*)(hist + (159 - cost)), 1u);
                }
                __syncthreads();
                if (tid == 0) { unsigned acc = 0; for (int i = 0; i < 160; ++i) { const unsigned c = hist[i]; hist[i] = acc; acc += c; } }
                __syncthreads();
                if (tid < nper) { const unsigned pos = atomicAdd((unsigned*)(hist + (159 - cost)), 1u); ORD[(pass == 0 ? 0 : 2048) + x * nper + pos] = (unsigned short)u; }
                __syncthreads();
            }
        }
    }
    {
        LAS float* scr = (LAS float*)(F.lds + F.wave * 8704);
        const int gw = F.bid * NWAVES + F.wave, NGW = F.G * NWAVES;
        constexpr int I_IN0 = 16 * (NZ0 / 32), I_OUT = 16 * 32, I_IN1 = 16 * (NZ1 / 32), I_Q = 16 * (NQ / 32);
        constexpr int NITEMS = I_IN0 + 2 * I_OUT + I_IN1 + 2 * I_Q;
        for (int it = gw; it < NITEMS; it += NGW) {
            int r = it;
            if (r < I_IN0) { p0_transpose_item(A.in[6], D, SRC_IN0, NZ0 / 32, 2048, 8, WSP(bf16, WS_WIN0), scr, r, ((int)(threadIdx.x & 63u))); continue; } r -= I_IN0;
            if (r < I_OUT) { p0_transpose_item(A.in[13], D, D, 32, 1 << 30, 0, WSP(bf16, WS_WOUT0), scr, r, ((int)(threadIdx.x & 63u))); continue; } r -= I_OUT;
            if (r < I_IN1) { p0_transpose_item(A.in[14], D, NZ1, NZ1 / 32, 1 << 30, 0, WSP(bf16, WS_WIN1), scr, r, ((int)(threadIdx.x & 63u))); continue; } r -= I_IN1;
            if (r < I_OUT) { p0_transpose_item(A.in[19], D, D, 32, 1 << 30, 0, WSP(bf16, WS_WOUT1), scr, r, ((int)(threadIdx.x & 63u))); continue; } r -= I_OUT;
            if (r < I_Q) { p0_transpose_item(A.in[20], D, NQ, NQ / 32, 1 << 30, 0, WSP(bf16, WS_WQ), scr, r, ((int)(threadIdx.x & 63u))); continue; } r -= I_Q;
            p0_transpose_item(A.in[20] + (size_t)D * NQ, D, NQ, NQ / 32, 1 << 30, 0, WSP(bf16, WS_WQ) + (size_t)NQ * D, scr, r, ((int)(threadIdx.x & 63u)));
        }
    }
    {
        const size_t gtid = (size_t)F.bid * NTHR + ((int)threadIdx.x), gth = (size_t)F.G * NTHR;
        cvt_f32_bf16_stream(A.in[21], WSP(bf16, WS_KEYS), (size_t)2 * 2 * 128 * 128 / 8, gtid, gth);
    }
}

template <bool GATES, bool IN_BF16>
__device__ __forceinline__ void norm_pass(Frame& F, const Args& A, const void* X, const float* g, const float* mod, int shc, bf16* XN) {
    LAS float* wgT = (LAS float*)F.lds;
    if (GATES) {
        const float* win = A.in[6];
        for (int i = ((int)threadIdx.x); i < 8 * 1024; i += NTHR) { const int cg = i >> 10, k = i & 1023; wgT[i] = win[(size_t)k * SRC_IN0 + 2048 + cg]; }
        __syncthreads();
    }
    const int gw = F.bid * NWAVES + F.wave, NGW = F.G * NWAVES, lane = (int)(threadIdx.x & 63u);
    unsigned wpk[GATES ? 8 : 1][4][2]; float gbias = 0.f;
    if (GATES) {
#pragma unroll
        for (int cg = 0; cg < 8; ++cg)
#pragma unroll
            for (int j = 0; j < 4; ++j) { const f32x4 w = *(const LAS f32x4*)(wgT + cg * 1024 + 4 * lane + 256 * j); wpk[cg][j][0] = pk2(w.x, w.y); wpk[cg][j][1] = pk2(w.z, w.w); }
        const int cgl = ((lane >> 5) & 1) * 4 + ((lane >> 4) & 1) * 2 + ((lane >> 3) & 1);
        gbias = cgl < 4 ? A.in[8][cgl] : A.in[9][cgl - 4];
    }
    constexpr int NR = 2;
    for (int row0 = gw; row0 < M; row0 += NR * NGW) {
        f32x4 v[NR][4]; float ss[NR];
#pragma unroll
        for (int rr = 0; rr < NR; ++rr) { const int row = row0 + rr * NGW;
            if (IN_BF16) { const GAS v2u* xr = (const GAS v2u*)((const bf16*)X + (size_t)row * D) + lane;
#pragma unroll
                for (int j = 0; j < 4; ++j) { const v2u w = xr[64 * j]; const unsigned w0 = w.x, w1 = w.y; v[rr][j] = (f32x4){bflo(w0), bfhi(w0), bflo(w1), bfhi(w1)}; }
            } else { const GAS f32x4* xr = (const GAS f32x4*)((const float*)X + (size_t)row * D) + lane;
#pragma unroll
                for (int j = 0; j < 4; ++j) v[rr][j] = xr[64 * j]; } }
#pragma unroll
        for (int rr = 0; rr < NR; ++rr) { float s = 0.f;
#pragma unroll
            for (int j = 0; j < 4; ++j) s += (v[rr][j].x * v[rr][j].x + v[rr][j].y * v[rr][j].y) + (v[rr][j].z * v[rr][j].z + v[rr][j].w * v[rr][j].w);
            ss[rr] = s; }
#pragma unroll
        for (int o = 1; o < 64; o <<= 1) {
#pragma unroll
            for (int rr = 0; rr < NR; ++rr) ss[rr] += __shfl_xor(ss[rr], o); }
#pragma unroll
        for (int rr = 0; rr < NR; ++rr) { const int row = row0 + rr * NGW, b = row >> 13;
            const float rstd = rsqrtf(ss[rr] * (1.f / D) + EPS);
            const float* shp = mod + (size_t)b * 6144 + shc * 1024; const float* scp = shp + 1024;
            unsigned opk[4][2];
#pragma unroll
            for (int j = 0; j < 4; ++j) { const int c = 4 * lane + 256 * j;
                const f32x4 gg = *(const f32x4*)(g + c), sc = *(const f32x4*)(scp + c), sh = *(const f32x4*)(shp + c);
                v[rr][j] = v[rr][j] * rstd * gg * (sc + 1.f) + sh;
                v2u o; o.x = pk2(v[rr][j].x, v[rr][j].y); o.y = pk2(v[rr][j].z, v[rr][j].w);
                if (GATES) { opk[j][0] = o.x; opk[j][1] = o.y; }
                *(GAS v2u*)(XN + (size_t)row * D + c) = o; }
            if (GATES) {
                float* GT = WSP(float, WS_GATES);
                float p[8];
#pragma unroll
                for (int cg = 0; cg < 8; ++cg) { float a = 0.f;
#pragma unroll
                    for (int j = 0; j < 4; ++j) { a = dot2bf(opk[j][0], wpk[cg][j][0], a); a = dot2bf(opk[j][1], wpk[cg][j][1], a); }
                    p[cg] = a; }
                const bool u5 = (lane & 32) != 0, u4 = (lane & 16) != 0, u3 = (lane & 8) != 0;
                float q[4], r2[2];
#pragma unroll
                for (int i = 0; i < 4; ++i) { const float send = u5 ? p[i] : p[i + 4], keep = u5 ? p[i + 4] : p[i]; q[i] = keep + __shfl_xor(send, 32); }
#pragma unroll
                for (int i = 0; i < 2; ++i) { const float send = u4 ? q[i] : q[i + 2], keep = u4 ? q[i + 2] : q[i]; r2[i] = keep + __shfl_xor(send, 16); }
                float sg; { const float send = u3 ? r2[0] : r2[1], keep = u3 ? r2[1] : r2[0]; sg = keep + __shfl_xor(send, 8); }
                sg += __shfl_xor(sg, 4); sg += __shfl_xor(sg, 2); sg += __shfl_xor(sg, 1);
                if ((lane & 7) == 0) GT[(size_t)row * 8 + (lane >> 3)] = sg + gbias;
            }
        }
    }
}

__device__ __forceinline__ void qknorm_unit(Frame& F, bf16* Z, int ldz, int row0, int col0, const float* g, float gmul, float* kmean  ) {
    const int c = col0 + 8 * ((int)(threadIdx.x & 63u)), d0 = (8 * ((int)(threadIdx.x & 63u))) & 63;
    float gv[8];
#pragma unroll
    for (int i = 0; i < 8; ++i) gv[i] = g[d0 + i] * gmul;
    float ks[8] = {0.f, 0.f, 0.f, 0.f, 0.f, 0.f, 0.f, 0.f};
    for (int r = 0; r < 32; ++r) {
        bf16* p = Z + (size_t)(row0 + F.wave * 32 + r) * ldz + c;
        const v4u w = *(const GAS v4u*)p;
        float x[8] = {bflo(w.x), bfhi(w.x), bflo(w.y), bfhi(w.y), bflo(w.z), bfhi(w.z), bflo(w.w), bfhi(w.w)};
        float ss = 0.f;
#pragma unroll
        for (int i = 0; i < 8; ++i) ss += x[i] * x[i];
        ss += __shfl_xor(ss, 1); ss += __shfl_xor(ss, 2); ss += __shfl_xor(ss, 4);
        const float rstd = rsqrtf(ss * (1.f / 64.f) + EPS);
#pragma unroll
        for (int i = 0; i < 8; ++i) { x[i] = x[i] * rstd * gv[i]; ks[i] += x[i]; }
        v4u o; o.x = pk2(x[0], x[1]); o.y = pk2(x[2], x[3]); o.z = pk2(x[4], x[5]); o.w = pk2(x[6], x[7]);
        *(GAS v4u*)p = o;
    }
    if (kmean) {
        LAS float* red = (LAS float*)F.lds;
#pragma unroll
        for (int i = 0; i < 8; ++i) red[F.wave * 512 + 8 * ((int)(threadIdx.x & 63u)) + i] = ks[i];
        __syncthreads();
        { float s = 0.f;
#pragma unroll
          for (int w = 0; w < 8; ++w) s += red[w * 512 + ((int)threadIdx.x)];
          kmean[(size_t)(((int)threadIdx.x) >> 6) * (32 * 64) + (((int)threadIdx.x) & 63)] = s * (1.f / 256.f); }
        __syncthreads();
    }
}

__device__ __forceinline__ void kmean_unit(Frame& F, const bf16* Z, int ldz, int row0, int col0, float* kmean) {
    const int c = col0 + 8 * ((int)(threadIdx.x & 63u));
    float ks[8] = {0.f, 0.f, 0.f, 0.f, 0.f, 0.f, 0.f, 0.f};
#pragma unroll 4
    for (int r = 0; r < 32; ++r) {
        const v4u w = *(const GAS v4u*)(Z + (size_t)(row0 + F.wave * 32 + r) * ldz + c);
        ks[0] += bflo(w.x); ks[1] += bfhi(w.x); ks[2] += bflo(w.y); ks[3] += bfhi(w.y); ks[4] += bflo(w.z); ks[5] += bfhi(w.z); ks[6] += bflo(w.w); ks[7] += bfhi(w.w);
    }
    LAS float* red = (LAS float*)F.lds;
#pragma unroll
    for (int i = 0; i < 8; ++i) red[F.wave * 512 + 8 * ((int)(threadIdx.x & 63u)) + i] = ks[i];
    __syncthreads();
    { float s = 0.f;
#pragma unroll
      for (int w = 0; w < 8; ++w) s += red[w * 512 + ((int)threadIdx.x)];
      kmean[(size_t)(((int)threadIdx.x) >> 6) * (32 * 64) + (((int)threadIdx.x) & 63)] = s * (1.f / 256.f); }
    __syncthreads();
}

constexpr int KSTRB = 144;
template <int DV> struct VStr { static constexpr int B = (DV == 64) ? 192 : 320; };
typedef short v4i16_t __attribute__((ext_vector_type(4)));
__device__ __forceinline__ s16x4 vtr(const LAS unsigned char* p) { return __builtin_bit_cast(s16x4, __builtin_amdgcn_ds_read_tr16_b64_v4i16((LAS v4i16_t*)p)); }
__device__ __forceinline__ unsigned cvtpk(float lo, float hi) { typedef float f2 __attribute__((ext_vector_type(2))); typedef __bf16 b2 __attribute__((ext_vector_type(2)));
    f2 v = {lo, hi}; b2 b = __builtin_convertvector(v, b2); return __builtin_bit_cast(unsigned, b); }
__device__ __forceinline__ float xhalf(float v) {
    auto rr = __builtin_amdgcn_permlane32_swap(__builtin_bit_cast(unsigned, v), __builtin_bit_cast(unsigned, v), false, false);
    const unsigned r0 = rr[0], r1 = rr[1]; return u2f((threadIdx.x & 32) ? r0 : r1);
}
template <int DV> struct AttnSt { f32x16 o[DV / 32]; float m, l; };
template <int DV> __device__ __forceinline__ void attn_init(AttnSt<DV>& st) {
#pragma unroll
    for (int t = 0; t < DV / 32; ++t)
#pragma unroll
        for (int r = 0; r < 16; ++r) st.o[t][r] = 0.f;
    st.m = -1e30f; st.l = 0.f;
}
template <int DV>
__device__ __forceinline__ void attn_qk(AttnSt<DV>& st, const LAS unsigned char* Kt, const bf16x8 (&qf)[4], float sl2, int tq, int kt0, bool diag, bool rowok, int lane, bf16x8 (&pf)[2][2]) {
    const int r32 = lane & 31, hi = lane >> 5;
    const int kb = kt0 + 4 * hi;
    const float ref = st.m > -1e29f ? st.m : 0.f;
    const float c0 = -sl2 * (float)(tq - kb) - ref;
    f32x16 s0, s1;
#pragma unroll
    for (int r = 0; r < 16; ++r) { const int ko = (r & 3) + 8 * (r >> 2); s0[r] = c0 + sl2 * (float)ko; s1[r] = c0 + sl2 * (float)(ko + 32); }
    const LAS unsigned char* kp = Kt + r32 * KSTRB + hi * 16;
#pragma unroll
    for (int ks = 0; ks < 4; ++ks) {
        const bf16x8 k0 = *(const LAS bf16x8*)(kp + ks * 32), k1 = *(const LAS bf16x8*)(kp + 32 * KSTRB + ks * 32);
        s0 = __builtin_amdgcn_mfma_f32_32x32x16_bf16(k0, qf[ks], s0, 0, 0, 0);
        s1 = __builtin_amdgcn_mfma_f32_32x32x16_bf16(k1, qf[ks], s1, 0, 0, 0);
    }
    if (diag || !rowok) {
#pragma unroll
        for (int r = 0; r < 16; ++r) { const int ko = (r & 3) + 8 * (r >> 2);
            if (!rowok || kb + ko > tq) s0[r] = -INFINITY;
            if (!rowok || kb + ko + 32 > tq) s1[r] = -INFINITY; }
    }
    float mx = fmaxf(s0[0], s1[0]);
#pragma unroll
    for (int r = 1; r < 16; ++r) mx = fmaxf(mx, fmaxf(s0[r], s1[r]));
    mx = fmaxf(mx, xhalf(mx));
    const float mnew = fmaxf(st.m, ref + mx);
    if (__any(mnew > st.m)) {
        const float alpha = __builtin_amdgcn_exp2f(st.m - mnew), dd = mnew - ref;
        st.m = mnew; st.l *= alpha;
#pragma unroll
        for (int t = 0; t < DV / 32; ++t)
#pragma unroll
            for (int r = 0; r < 16; ++r) st.o[t][r] *= alpha;
#pragma unroll
        for (int r = 0; r < 16; ++r) { s0[r] -= dd; s1[r] -= dd; }
    }
#pragma unroll
    for (int r = 0; r < 16; ++r) { s0[r] = __builtin_amdgcn_exp2f(s0[r]); s1[r] = __builtin_amdgcn_exp2f(s1[r]); }
#pragma unroll
    for (int s = 0; s < 2; ++s) {
        v4u a, b;
        a.x = cvtpk(s0[8 * s + 0], s0[8 * s + 1]); a.y = cvtpk(s0[8 * s + 2], s0[8 * s + 3]); a.z = cvtpk(s0[8 * s + 4], s0[8 * s + 5]); a.w = cvtpk(s0[8 * s + 6], s0[8 * s + 7]);
        b.x = cvtpk(s1[8 * s + 0], s1[8 * s + 1]); b.y = cvtpk(s1[8 * s + 2], s1[8 * s + 3]); b.z = cvtpk(s1[8 * s + 4], s1[8 * s + 5]); b.w = cvtpk(s1[8 * s + 6], s1[8 * s + 7]);
        pf[0][s] = __builtin_bit_cast(bf16x8, a); pf[1][s] = __builtin_bit_cast(bf16x8, b);
    }
}
template <int DV>
__device__ __forceinline__ void attn_pv(AttnSt<DV>& st, const LAS unsigned char* Vt, const bf16x8 (&pf)[2][2], int lane) {
    { const bf16x8 ones = {0x3F80, 0x3F80, 0x3F80, 0x3F80, 0x3F80, 0x3F80, 0x3F80, 0x3F80};
      f32x16 rs = __builtin_amdgcn_mfma_f32_32x32x16_bf16(ones, pf[0][0], (f32x16){0.f, 0.f, 0.f, 0.f, 0.f, 0.f, 0.f, 0.f, 0.f, 0.f, 0.f, 0.f, 0.f, 0.f, 0.f, 0.f}, 0, 0, 0);
      rs = __builtin_amdgcn_mfma_f32_32x32x16_bf16(ones, pf[0][1], rs, 0, 0, 0); rs = __builtin_amdgcn_mfma_f32_32x32x16_bf16(ones, pf[1][0], rs, 0, 0, 0); rs = __builtin_amdgcn_mfma_f32_32x32x16_bf16(ones, pf[1][1], rs, 0, 0, 0);
      st.l += rs[0]; }
    constexpr int VS = VStr<DV>::B;
    const int g = lane >> 4, i16 = lane & 15;
    const LAS unsigned char* vp = Vt + (4 * (g >> 1) + (i16 >> 2)) * VS + (16 * (g & 1) + 4 * (i16 & 3)) * 2;
#pragma unroll
    for (int kbk = 0; kbk < 2; ++kbk)
#pragma unroll
        for (int s = 0; s < 2; ++s)
#pragma unroll
            for (int t = 0; t < DV / 32; ++t) {
                const s16x4 lo = vtr(vp + (kbk * 32 + 16 * s) * VS + t * 64), h8 = vtr(vp + (kbk * 32 + 16 * s + 8) * VS + t * 64);
                const bf16x8 va = {lo[0], lo[1], lo[2], lo[3], h8[0], h8[1], h8[2], h8[3]};
                st.o[t] = __builtin_amdgcn_mfma_f32_32x32x16_bf16(va, pf[kbk][s], st.o[t], 0, 0, 0);
            }
}
template <int DV>
__device__ __forceinline__ void attn_tile(AttnSt<DV>& st, const LAS unsigned char* Kt, const LAS unsigned char* Vt, const bf16x8 (&qf)[4], float sc2, float sl2, int tq, int kt0, bool diag, bool rowok, int lane) {
    bf16x8 pf[2][2];
    attn_qk<DV>(st, Kt, qf, sl2, tq, kt0, diag, rowok, lane, pf);
    attn_pv<DV>(st, Vt, pf, lane);
}
template <int NK, int DV> struct TileRegs { v4u k[NK]; v4u v[DV / 64]; };
template <int NK, int DV>
__device__ __forceinline__ void tile_load(TileRegs<NK, DV>& R, const bf16* Z, int ldz, size_t zrow0, int kcol, int vcol, int tid) {
#pragma unroll
    for (int i = 0; i < NK; ++i) { const int ch = tid + 512 * i; const int row = ch / (8 * NK), cc = ch % (8 * NK);
        R.k[i] = *(const GAS v4u*)(Z + (zrow0 + row) * ldz + kcol + cc * 8); }
#pragma unroll
    for (int i = 0; i < DV / 64; ++i) { const int ch = tid + 512 * i; const int row = ch / (DV / 8), cc = ch % (DV / 8);
        R.v[i] = *(const GAS v4u*)(Z + (zrow0 + row) * ldz + vcol + cc * 8); }
}
template <int NK, int DV>
__device__ __forceinline__ void tile_store(const TileRegs<NK, DV>& R, LAS unsigned char* Kt  , LAS unsigned char* Vt, int tid) {
#pragma unroll
    for (int i = 0; i < NK; ++i) { const int ch = tid + 512 * i; const int row = ch / (8 * NK), cc = ch % (8 * NK);
        *(LAS v4u*)(Kt + (cc >> 3) * (64 * KSTRB) + row * KSTRB + (cc & 7) * 16) = R.k[i]; }
#pragma unroll
    for (int i = 0; i < DV / 64; ++i) { const int ch = tid + 512 * i; const int row = ch / (DV / 8), cc = ch % (DV / 8);
        *(LAS v4u*)(Vt + row * VStr<DV>::B + cc * 16) = R.v[i]; }
}
__device__ __forceinline__ void moba_unit(Frame& F, int b, int h, int j, float tcut  ) {
    const bf16* Z = WSP(bf16, WS_Z); constexpr int ldz = NZ0;
    const int lane = ((int)(threadIdx.x & 63u)), w = F.wave, r32 = lane & 31, hi = lane >> 5, tid = ((int)threadIdx.x);
    const size_t rowb = (size_t)b * SEQ;
    const int qpos = j * 256 + w * 32 + r32;
    const int qcol = 2048 + h * 64, kcol = 2560 + h * 64, vcol = 3072 + h * 64;
    LAS unsigned char* lds = F.lds;
    constexpr int BUFB = 64 * KSTRB + 64 * VStr<64>::B;
    LAS unsigned char* kmh = lds + 2 * BUFB;
    LAS unsigned char* kml = lds + 2 * BUFB + 32 * KSTRB;
    LAS unsigned* msk = (LAS unsigned*)(lds + 2 * BUFB + 64 * KSTRB);
    { const float* KM = WSP(float, WS_KMEAN) + (size_t)((b * 8 + h) * 32) * 64; const f32x4 x = *(const f32x4*)(KM + 4 * tid);
      const int n = tid >> 4, d0 = (tid & 15) * 4;
      const unsigned h0 = f2bf(x.x), h1 = f2bf(x.y), h2 = f2bf(x.z), h3 = f2bf(x.w);
      v2u hv; hv.x = h0 | (h1 << 16); hv.y = h2 | (h3 << 16);
      v2u lv; lv.x = pk2(x.x - u2f(h0 << 16), x.y - u2f(h1 << 16)); lv.y = pk2(x.z - u2f(h2 << 16), x.w - u2f(h3 << 16));
      *(LAS v2u*)(kmh + n * KSTRB + d0 * 2) = hv; *(LAS v2u*)(kml + n * KSTRB + d0 * 2) = lv; }
    if (tid < 16) msk[tid] = 0u;
    bf16x8 qf[4];
    const bf16* qrow = Z + (rowb + qpos) * ldz + qcol;
#pragma unroll
    for (int ks = 0; ks < 4; ++ks) qf[ks] = *(const GAS bf16x8*)(qrow + 16 * ks + 8 * hi);
    __syncthreads();
    f32x16 gt;
#pragma unroll
    for (int r = 0; r < 16; ++r) gt[r] = 0.f;
#pragma unroll
    for (int ks = 0; ks < 4; ++ks) {
        const bf16x8 a = *(const LAS bf16x8*)(kmh + r32 * KSTRB + hi * 16 + ks * 32), c = *(const LAS bf16x8*)(kml + r32 * KSTRB + hi * 16 + ks * 32);
        gt = __builtin_amdgcn_mfma_f32_32x32x16_bf16(a, qf[ks], gt, 0, 0, 0);
        gt = __builtin_amdgcn_mfma_f32_32x32x16_bf16(c, qf[ks], gt, 0, 0, 0);
    }
    float t0 = -INFINITY, t1 = -INFINITY, t2 = -INFINITY;
#define INS3(key) do { float k_ = (key); float a_ = fmaxf(t0, k_), l_ = fminf(t0, k_); t0 = a_; a_ = fmaxf(t1, l_); l_ = fminf(t1, l_); t1 = a_; t2 = fmaxf(t2, l_); } while (0)
#pragma unroll
    for (int r = 0; r < 16; ++r) { const int n = (r & 3) + 8 * (r >> 2) + 4 * hi;
        const float key = (n < j) ? u2f((f2u(gt[r]) & ~31u) | (unsigned)n) : -INFINITY; INS3(key); }
    { const float p0 = xhalf(t0), p1 = xhalf(t1), p2 = xhalf(t2); INS3(p0); INS3(p1); INS3(p2); }
#undef INS3
    const int sel0 = (t0 > -INFINITY) ? (int)(f2u(t0) & 31u) : -1;
    const int sel1 = (t1 > -INFINITY) ? (int)(f2u(t1) & 31u) : -1;
    const int sel2 = (t2 > -INFINITY) ? (int)(f2u(t2) & 31u) : -1;
    { const unsigned mm = (sel0 >= 0 ? 1u << sel0 : 0u) | (sel1 >= 0 ? 1u << sel1 : 0u) | (sel2 >= 0 ? 1u << sel2 : 0u);
      if (mm) { __hip_atomic_fetch_or(msk + w, mm, __ATOMIC_RELAXED, __HIP_MEMORY_SCOPE_WORKGROUP); __hip_atomic_fetch_or(msk + 8, mm, __ATOMIC_RELAXED, __HIP_MEMORY_SCOPE_WORKGROUP); } }
    __syncthreads();
    const float slope = ldexpf(1.f, -(h + 1)), dcut = tcut / slope;
    const float sl2 = slope * LOG2E, sc2 = 0.125f * LOG2E;
    int nlo = (int)ceilf(((float)(j * 256) - dcut - 255.f) * (1.f / 256.f)); if (nlo < 0) nlo = 0;
    const unsigned keep = nlo >= 32 ? 0u : (0xffffffffu << nlo);
    const unsigned bmask = msk[8] & keep; const unsigned wmask = (unsigned)__builtin_amdgcn_readfirstlane((int)msk[w]) & keep;
    AttnSt<64> st; attn_init<64>(st);
    unsigned rem = bmask;
    int blk = j, kt = 3, buf = 0;
    TileRegs<1, 64> R;
    tile_load<1, 64>(R, Z, ldz, rowb + blk * 256 + kt * 64, kcol, vcol, tid);
    tile_store<1, 64>(R, lds, lds + 64 * KSTRB, tid);
    __syncthreads();
    for (;;) {
        int nblk = blk, nkt = kt - 1; bool has_next = true;
        if (nkt < 0) { nkt = 3; if (rem) { nblk = 31 - __builtin_clz(rem); rem &= ~(1u << nblk); } else has_next = false; }
        if (has_next) tile_load<1, 64>(R, Z, ldz, rowb + nblk * 256 + nkt * 64, kcol, vcol, tid);
        const bool own = (blk == j);
        const bool active = (own ? (kt * 64 <= w * 32 + 31) : (((wmask >> blk) & 1u) != 0u)) && ((float)(j * 256 + w * 32 - (blk * 256 + kt * 64 + 63)) <= dcut);
        if (active) {
            const bool rowok = own || blk == sel0 || blk == sel1 || blk == sel2;
            const bool diag = own && (kt * 64 + 63 > w * 32);
            attn_tile<64>(st, lds + buf * BUFB, lds + buf * BUFB + 64 * KSTRB, qf, sc2, sl2, qpos, blk * 256 + kt * 64, diag, rowok, lane);
        }
        if (!has_next) break;
        tile_store<1, 64>(R, lds + (buf ^ 1) * BUFB, lds + (buf ^ 1) * BUFB + 64 * KSTRB, tid);
        __syncthreads();
        buf ^= 1; blk = nblk; kt = nkt;
    }
    const float inv = 1.f / st.l;
    bf16* Y = WSP(bf16, WS_XNY) + (rowb + qpos) * 1024 + 512 + h * 64;
#pragma unroll
    for (int t = 0; t < 2; ++t)
#pragma unroll
        for (int rg = 0; rg < 4; ++rg) { v2u o; o.x = pk2(st.o[t][4 * rg] * inv, st.o[t][4 * rg + 1] * inv); o.y = pk2(st.o[t][4 * rg + 2] * inv, st.o[t][4 * rg + 3] * inv);
            *(GAS v2u*)(Y + t * 32 + 8 * rg + 4 * hi) = o; }
    __syncthreads();
}

__device__ __forceinline__ void diff_unit(Frame& F, const Args& A, int b, int h, int qt, float lam, float tcut) {
    const bf16* Z = WSP(bf16, WS_Z); constexpr int ldz = NZ1;
    const int lane = ((int)(threadIdx.x & 63u)), w = F.wave, r32 = lane & 31, hi = lane >> 5, tid = ((int)threadIdx.x);
    const int comp = w >> 2, wq = w & 3;
    const size_t rowb = (size_t)b * SEQ;
    const int q0 = qt * 128, qpos = q0 + wq * 32 + r32;
    const int qcol = h * 128 + comp * 64, kcol = 1024 + h * 128, vcol = 2048 + h * 128;
    LAS unsigned char* lds = F.lds;
    constexpr int BUFB = 2 * 64 * KSTRB + 64 * VStr<128>::B;
    bf16x8 qf[4];
    const bf16* qrow = Z + (rowb + qpos) * ldz + qcol;
#pragma unroll
    for (int ks = 0; ks < 4; ++ks) qf[ks] = *(const GAS bf16x8*)(qrow + 16 * ks + 8 * hi);
    const float slope = ldexpf(1.f, -(h + 1)), dcut = tcut / slope;
    const float sl2 = slope * LOG2E, sc2 = 0.125f * LOG2E;
    AttnSt<128> st; attn_init<128>(st);
    const int nt = (q0 + 128) / 64;
    int kt_lo = (int)ceilf(((float)q0 - dcut - 63.f) * (1.f / 64.f)); if (kt_lo < 0) kt_lo = 0;
    TileRegs<2, 128> R;
    tile_load<2, 128>(R, Z, ldz, rowb + (size_t)(nt - 1) * 64, kcol, vcol, tid);
    tile_store<2, 128>(R, lds, lds + 2 * 64 * KSTRB, tid);
    __syncthreads();
    int buf = 0;
    for (int kt = nt - 1; kt >= kt_lo; --kt) {
        const bool has_next = kt > kt_lo;
        if (has_next) tile_load<2, 128>(R, Z, ldz, rowb + (size_t)(kt - 1) * 64, kcol, vcol, tid);
        if (kt * 64 <= q0 + wq * 32 + 31) {
            const bool diag = kt * 64 + 63 > q0 + wq * 32;
            attn_tile<128>(st, lds + buf * BUFB + comp * (64 * KSTRB), lds + buf * BUFB + 2 * 64 * KSTRB, qf, sc2, sl2, qpos, kt * 64, diag, true, lane);
        }
        if (has_next) { tile_store<2, 128>(R, lds + (buf ^ 1) * BUFB, lds + (buf ^ 1) * BUFB + 2 * 64 * KSTRB, tid); }
        __syncthreads();
        buf ^= 1;
    }
    const float inv = 1.f / st.l;
    LAS float* o2 = (LAS float*)lds;
    if (comp == 1) {
#pragma unroll
        for (int t = 0; t < 4; ++t)
#pragma unroll
            for (int r = 0; r < 16; ++r) o2[((wq * 4 + t) * 16 + r) * 64 + lane] = st.o[t][r] * inv;
    }
    __syncthreads();
    if (comp == 0) {
        float ss = 0.f;
#pragma unroll
        for (int t = 0; t < 4; ++t)
#pragma unroll
            for (int r = 0; r < 16; ++r) { const float v = st.o[t][r] * inv - lam * o2[((wq * 4 + t) * 16 + r) * 64 + lane]; st.o[t][r] = v; ss += v * v; }
        ss += xhalf(ss);
        const float rs = rsqrtf(ss * (1.f / 128.f) + EPS) * 0.6444909324090307f;
        const float* og = A.in[18];
        bf16* Y = WSP(bf16, WS_XNY) + (rowb + qpos) * 1024 + h * 128;
#pragma unroll
        for (int t = 0; t < 4; ++t)
#pragma unroll
            for (int rg = 0; rg < 4; ++rg) { const int dv = t * 32 + 8 * rg + 4 * hi; const f32x4 gg = *(const f32x4*)(og + dv);
                v2u o; o.x = pk2(st.o[t][4 * rg] * rs * gg.x, st.o[t][4 * rg + 1] * rs * gg.y); o.y = pk2(st.o[t][4 * rg + 2] * rs * gg.z, st.o[t][4 * rg + 3] * rs * gg.w);
                *(GAS v2u*)(Y + dv) = o; }
    }
    __syncthreads();
}

template <int MT, int NT>
__device__ __forceinline__ void mma_nt(const LAS unsigned char* A, int lda, const LAS unsigned char* B, int ldb, int K, f32x4 (&acc)[MT][NT], int lane) {
    const int r = lane & 15, kq = (lane >> 4) * 16;
    for (int k0 = 0; k0 < K; k0 += 32) {
        bf16x8 a[MT], bb[NT];
#pragma unroll
        for (int m = 0; m < MT; ++m) a[m] = *(const LAS bf16x8*)(A + (m * 16 + r) * lda + k0 * 2 + kq);
#pragma unroll
        for (int n = 0; n < NT; ++n) bb[n] = *(const LAS bf16x8*)(B + (n * 16 + r) * ldb + k0 * 2 + kq);
#pragma unroll
        for (int m = 0; m < MT; ++m)
#pragma unroll
            for (int n = 0; n < NT; ++n) acc[m][n] = __builtin_amdgcn_mfma_f32_16x16x32_bf16(a[m], bb[n], acc[m][n], 0, 0, 0);
    }
}
constexpr int TS = 272;
constexpr int TILEB = 128 * TS;
constexpr int ML_Q = 0, ML_K = TILEB, ML_V = 2 * TILEB, ML_SM = 3 * TILEB;

__device__ __forceinline__ void ml_gates(const float* GT, size_t row0, int hm, LAS float* sm, int lane) {
    const float i0 = GT[(row0 + 2 * lane) * 8 + hm], i1 = GT[(row0 + 2 * lane + 1) * 8 + hm];
    const float f0 = logsigmoid_f(GT[(row0 + 2 * lane) * 8 + 4 + hm]), f1 = logsigmoid_f(GT[(row0 + 2 * lane + 1) * 8 + 4 + hm]);
    float s = f0 + f1;
#pragma unroll
    for (int o = 1; o < 64; o <<= 1) { const float t = __shfl_up(s, o); if (lane >= o) s += t; }
    const float excl = s - (f0 + f1);
    sm[2 * lane] = excl + f0; sm[2 * lane + 1] = excl + f0 + f1;
    sm[128 + 2 * lane] = i0; sm[128 + 2 * lane + 1] = i1;
}
template <bool TRANSPOSE>
__device__ __forceinline__ void ml_conv_tile(const bf16* Z, size_t rowb, int t0, int zc, const float* cw, int wc, float mul, LAS unsigned char* dst, const LAS float* rs, int tid) {
#pragma unroll
    for (int it = 0; it < 4; ++it) {
        const int item = tid + 512 * it, l = item >> 4, ch = (item & 15) * 8;
        float acc[8];
#pragma unroll
        for (int i = 0; i < 8; ++i) acc[i] = 0.f;
        v4u wv[4];
#pragma unroll
        for (int jj = 0; jj < 4; ++jj) { const int t = t0 + l - 3 + jj;
            wv[jj] = *(const GAS v4u*)(Z + (rowb + (t < 0 ? 0 : t)) * NZ0 + zc + ch); }
#pragma unroll
        for (int jj = 0; jj < 4; ++jj) {
            const int t = t0 + l - 3 + jj; const float tm = t >= 0 ? 1.f : 0.f;
            const v4u w = wv[jj];
            const float x[8] = {bflo(w.x), bfhi(w.x), bflo(w.y), bfhi(w.y), bflo(w.z), bfhi(w.z), bflo(w.w), bfhi(w.w)};
            const f32x4 c0 = *(const f32x4*)(cw + jj * 1024 + wc + ch) * tm, c1 = *(const f32x4*)(cw + jj * 1024 + wc + ch + 4) * tm;
            acc[0] += x[0] * c0.x; acc[1] += x[1] * c0.y; acc[2] += x[2] * c0.z; acc[3] += x[3] * c0.w;
            acc[4] += x[4] * c1.x; acc[5] += x[5] * c1.y; acc[6] += x[6] * c1.z; acc[7] += x[7] * c1.w;
        }
        const float sc = TRANSPOSE ? mul * rs[l] : mul;
#pragma unroll
        for (int i = 0; i < 8; ++i) acc[i] = silu_f(acc[i]) * sc;
        if (TRANSPOSE) {
#pragma unroll
            for (int i = 0; i < 8; ++i) *(LAS bf16*)(dst + (ch + i) * TS + l * 2) = (bf16)f2bf(acc[i]);
        } else {
            v4u o; o.x = pk2(acc[0], acc[1]); o.y = pk2(acc[2], acc[3]); o.z = pk2(acc[4], acc[5]); o.w = pk2(acc[6], acc[7]);
            *(LAS v4u*)(dst + l * TS + ch * 2) = o;
        }
    }
}
__device__ __forceinline__ void ml_vt_tile(const bf16* Z, size_t row0, int zc, LAS unsigned char* dst, int tid) {
#pragma unroll
    for (int it = 0; it < 4; ++it) {
        const int item = tid + 512 * it, l = item >> 4, ch = (item & 15) * 8;
        const v4u w = *(const GAS v4u*)(Z + (row0 + l) * NZ0 + zc + ch);
        const unsigned ww[4] = {w.x, w.y, w.z, w.w};
#pragma unroll
        for (int i = 0; i < 4; ++i) { *(LAS bf16*)(dst + (ch + 2 * i) * TS + l * 2) = (bf16)(ww[i] & 0xffffu); *(LAS bf16*)(dst + (ch + 2 * i + 1) * TS + l * 2) = (bf16)(ww[i] >> 16); }
    }
}
__device__ __forceinline__ void mlstm_a_unit(Frame& F, const Args& A, int unit) {
    const int c = unit & 63, bh = unit >> 6, hm = bh & 3, b = bh >> 2;
    const bf16* Z = WSP(bf16, WS_Z); const float* GT = WSP(float, WS_GATES);
    const size_t rowb = (size_t)b * SEQ; const int t0 = c * 128;
    LAS unsigned char* lds = F.lds; LAS float* sm = (LAS float*)(lds + ML_SM);
    if (F.wave == 0) {
        ml_gates(GT, rowb + t0, hm, sm, ((int)(threadIdx.x & 63u)));
        LDS_WAIT();
        const float bend = sm[127];
        const float w0 = bend - sm[2 * ((int)(threadIdx.x & 63u))] + sm[128 + 2 * ((int)(threadIdx.x & 63u))], w1 = bend - sm[2 * ((int)(threadIdx.x & 63u)) + 1] + sm[128 + 2 * ((int)(threadIdx.x & 63u)) + 1];
        const float ml = wave_max(fmaxf(w0, w1));
        sm[256 + 2 * ((int)(threadIdx.x & 63u))] = __expf(w0 - ml); sm[256 + 2 * ((int)(threadIdx.x & 63u)) + 1] = __expf(w1 - ml);
        if (((int)(threadIdx.x & 63u)) == 0) { WSP(float, WS_BEND)[unit] = bend; WSP(float, WS_MLOC)[unit] = ml; }
    }
    __syncthreads();
    ml_conv_tile<true>(Z, rowb, t0, 512 + hm * 128, A.in[7], 512 + hm * 128, 0.08838834764831845f, lds + ML_K, sm + 256, ((int)threadIdx.x));
    ml_vt_tile(Z, rowb + t0, 1024 + hm * 128, lds + ML_V, ((int)threadIdx.x));
    __syncthreads();
    f32x4 acc[2][4];
#pragma unroll
    for (int m = 0; m < 2; ++m)
#pragma unroll
        for (int n = 0; n < 4; ++n) acc[m][n] = (f32x4){0.f, 0.f, 0.f, 0.f};
    const int dv0 = 32 * (F.wave >> 1), dk0 = 64 * (F.wave & 1);
    mma_nt<2, 4>(lds + ML_V + dv0 * TS, TS, lds + ML_K + dk0 * TS, TS, 128, acc, ((int)(threadIdx.x & 63u)));
    {
        const int lane_ = (int)(threadIdx.x & 63u);
#pragma unroll
        for (int m = 0; m < 2; ++m)
#pragma unroll
            for (int n = 0; n < 4; ++n)
#pragma unroll
                for (int i = 0; i < 4; ++i) *(LAS bf16*)(lds + ML_Q + (dv0 + 16 * m + 4 * (lane_ >> 4) + i) * TS + (dk0 + 16 * n + (lane_ & 15)) * 2) = (bf16)f2bf(acc[m][n][i]);
        __syncthreads();
        bf16* CL = WSP(bf16, WS_CLOC) + (size_t)unit * 16384;
#pragma unroll
        for (int it = 0; it < 4; ++it) { const int item = (int)threadIdx.x + 512 * it, rr = item >> 4, ch = (item & 15) * 8;
            *(GAS v4u*)(CL + rr * 128 + ch) = *(const LAS v4u*)(lds + ML_Q + rr * TS + ch * 2); }
    }
    if (((int)threadIdx.x) < 128) { float s = 0.f; const LAS bf16* kr = (const LAS bf16*)(lds + ML_K + ((int)threadIdx.x) * TS);
        for (int l = 0; l < 128; ++l) s += bf2f(kr[l]);
        WSP(float, WS_NLOC)[(size_t)unit * 128 + ((int)threadIdx.x)] = s; }
    __syncthreads();
}
__device__ __forceinline__ void mlstm_scan_unit(Frame& F, int unit) {
    const int bh = unit >> 3, sl = unit & 7;
    LAS float* tab = (LAS float*)F.lds;
    if (((int)threadIdx.x) == 0) {
        const float* BE = WSP(float, WS_BEND) + bh * 64; const float* ML = WSP(float, WS_MLOC) + bh * 64; float* MP = WSP(float, WS_MPREV) + bh * 64;
        float m = 0.f;
        for (int c = 0; c < 64; ++c) { const float be = BE[c], ml = ML[c]; const float mn = fmaxf(be + m, ml);
            tab[c] = __expf(be + m - mn); tab[64 + c] = __expf(ml - mn); if (sl == 0) MP[c] = m; m = mn; }
    }
    __syncthreads();
    bf16* CL = WSP(bf16, WS_CLOC) + (size_t)bh * 64 * 16384 + sl * 2048 + 4 * ((int)threadIdx.x);
    float s0 = 0.f, s1 = 0.f, s2 = 0.f, s3 = 0.f;
#pragma unroll 8
    for (int c = 0; c < 64; ++c) { GAS v2u* p = (GAS v2u*)(CL + (size_t)c * 16384); const v2u v = *p; v2u o; o.x = pk2(s0, s1); o.y = pk2(s2, s3); *p = o;
        const float a = tab[c], sc = tab[64 + c]; const unsigned v0 = v.x, v1 = v.y;
        s0 = a * s0 + sc * bflo(v0); s1 = a * s1 + sc * bfhi(v0); s2 = a * s2 + sc * bflo(v1); s3 = a * s3 + sc * bfhi(v1); }
    if (sl == 0 && ((int)threadIdx.x) < 128) { float* NL = WSP(float, WS_NLOC) + (size_t)bh * 64 * 128 + ((int)threadIdx.x); float s = 0.f;
        for (int c = 0; c < 64; ++c) { const float v = NL[c * 128]; NL[c * 128] = s; s = tab[c] * s + tab[64 + c] * v; } }
    __syncthreads();
}
__device__ __forceinline__ void mlstm_c_unit(Frame& F, const Args& A, int unit) {
    const int c = unit & 63, bh = unit >> 6, hm = bh & 3, b = bh >> 2;
    const bf16* Z = WSP(bf16, WS_Z); const float* GT = WSP(float, WS_GATES);
    const size_t rowb = (size_t)b * SEQ; const int t0 = c * 128;
    LAS unsigned char* lds = F.lds; LAS float* sm = (LAS float*)(lds + ML_SM);
    const int lane = ((int)(threadIdx.x & 63u)), w = F.wave, tid = ((int)threadIdx.x);
    const float mprev = WSP(float, WS_MPREV)[unit];
    const int l0 = 32 * (w >> 1), c0 = 64 * (w & 1);
    if (w == 0) {
        ml_gates(GT, rowb + t0, hm, sm, lane);
        LDS_WAIT();
        const float b0 = sm[2 * lane], b1 = sm[2 * lane + 1];
        const float g0 = sm[128 + 2 * lane] - b0, g1 = sm[128 + 2 * lane + 1] - b1;
        float pm = fmaxf(g0, g1);
#pragma unroll
        for (int o = 1; o < 64; o <<= 1) { const float t = __shfl_up(pm, o); if (lane >= o) pm = fmaxf(pm, t); }
        float pe = __shfl_up(pm, 1); if (lane == 0) pe = -INFINITY;
        const float M0 = fmaxf(mprev, fmaxf(pe, g0)), M1 = fmaxf(mprev, pm);
        sm[256 + 2 * lane] = g0; sm[256 + 2 * lane + 1] = g1;
        sm[384 + 2 * lane] = M0; sm[384 + 2 * lane + 1] = M1;
        sm[512 + 2 * lane] = __expf(mprev - M0); sm[512 + 2 * lane + 1] = __expf(mprev - M1);
        sm[640 + 2 * lane] = __expf(-b0 - M0); sm[640 + 2 * lane + 1] = __expf(-b1 - M1);
        sm[768 + 2 * lane] = 0.f; sm[768 + 2 * lane + 1] = 0.f; sm[896 + 2 * lane] = 0.f; sm[896 + 2 * lane + 1] = 0.f;
    }
    if (w == 1) { sm[1152 + lane] = WSP(float, WS_NLOC)[(size_t)unit * 128 + lane]; sm[1152 + 64 + lane] = WSP(float, WS_NLOC)[(size_t)unit * 128 + 64 + lane]; }
    ml_conv_tile<false>(Z, rowb, t0, hm * 128, A.in[7], hm * 128, 1.f, lds + ML_Q, nullptr, tid);
    ml_conv_tile<false>(Z, rowb, t0, 512 + hm * 128, A.in[7], 512 + hm * 128, 0.08838834764831845f, lds + ML_K, nullptr, tid);
    ml_vt_tile(Z, rowb + t0, 1024 + hm * 128, lds + ML_V, tid);
    __syncthreads();
    bf16x8 cpf[4][4];
    { const bf16* CP = WSP(bf16, WS_CLOC) + (size_t)unit * 16384;
      const int r = lane & 15, kq = (lane >> 4) * 8;
#pragma unroll
      for (int kk = 0; kk < 4; ++kk)
#pragma unroll
          for (int n = 0; n < 4; ++n) cpf[kk][n] = *(const GAS bf16x8*)(CP + (size_t)(c0 + n * 16 + r) * 128 + 32 * kk + kq); }
    const int lr = 4 * (lane >> 4), lc = lane & 15;
    { const int l = tid >> 2, part = tid & 3; float s = 0.f;
#pragma unroll
        for (int j = 0; j < 4; ++j) { const v4u qv = *(const LAS v4u*)(lds + ML_Q + l * TS + part * 64 + j * 16);
            const f32x4 n0 = *(const LAS f32x4*)(sm + 1152 + part * 32 + j * 8), n1 = *(const LAS f32x4*)(sm + 1152 + part * 32 + j * 8 + 4);
            const unsigned q0 = qv.x, q1 = qv.y, q2 = qv.z, q3 = qv.w;
            s += (bflo(q0) * n0.x + bfhi(q0) * n0.y) + (bflo(q1) * n0.z + bfhi(q1) * n0.w) + (bflo(q2) * n1.x + bfhi(q2) * n1.y) + (bflo(q3) * n1.z + bfhi(q3) * n1.w); }
        s += __shfl_xor(s, 1); s += __shfl_xor(s, 2);
        if (part == 0) sm[1024 + l] = s; }
    f32x4 acc[2][4];
#pragma unroll
    for (int m = 0; m < 2; ++m)
#pragma unroll
        for (int n = 0; n < 4; ++n) acc[m][n] = (f32x4){0.f, 0.f, 0.f, 0.f};
    mma_nt<2, 4>(lds + ML_Q + l0 * TS, TS, lds + ML_K + c0 * TS, TS, 128, acc, lane);
#pragma unroll
    for (int m = 0; m < 2; ++m)
#pragma unroll
        for (int i = 0; i < 4; ++i) { const int l = l0 + 16 * m + lr + i; const float Ml = sm[384 + l]; float rsum = 0.f;
#pragma unroll
            for (int n = 0; n < 4; ++n) { const int s = c0 + 16 * n + lc; const float v = (s <= l) ? acc[m][n][i] * __expf(sm[256 + s] - Ml) : 0.f; acc[m][n][i] = v; rsum += v; }
            rsum += __shfl_xor(rsum, 1); rsum += __shfl_xor(rsum, 2); rsum += __shfl_xor(rsum, 4); rsum += __shfl_xor(rsum, 8);
            if (lc == 0) __hip_atomic_fetch_add(sm + 768 + l, rsum, __ATOMIC_RELAXED, __HIP_MEMORY_SCOPE_WORKGROUP); }
    __syncthreads();
#pragma unroll
    for (int m = 0; m < 2; ++m)
#pragma unroll
        for (int n = 0; n < 4; ++n)
#pragma unroll
            for (int i = 0; i < 4; ++i) *(LAS bf16*)(lds + ML_K + (l0 + 16 * m + lr + i) * TS + (c0 + 16 * n + lc) * 2) = (bf16)f2bf(acc[m][n][i]);
    __syncthreads();
    f32x4 ai[2][4], ae[2][4];
#pragma unroll
    for (int m = 0; m < 2; ++m)
#pragma unroll
        for (int n = 0; n < 4; ++n) { ai[m][n] = (f32x4){0.f, 0.f, 0.f, 0.f}; ae[m][n] = (f32x4){0.f, 0.f, 0.f, 0.f}; }
    mma_nt<2, 4>(lds + ML_K + l0 * TS, TS, lds + ML_V + c0 * TS, TS, 128, ai, lane);
    {
        const int r = lane & 15, kq = (lane >> 4) * 8;
#pragma unroll
        for (int kk = 0; kk < 4; ++kk) {
            bf16x8 a[2];
#pragma unroll
            for (int m = 0; m < 2; ++m) a[m] = *(const LAS bf16x8*)(lds + ML_Q + (l0 + m * 16 + r) * TS + (32 * kk + kq) * 2);
#pragma unroll
            for (int m = 0; m < 2; ++m)
#pragma unroll
                for (int n = 0; n < 4; ++n) ae[m][n] = __builtin_amdgcn_mfma_f32_16x16x32_bf16(a[m], cpf[kk][n], ae[m][n], 0, 0, 0);
        }
    }
#pragma unroll
    for (int m = 0; m < 2; ++m)
#pragma unroll
        for (int i = 0; i < 4; ++i) { const int l = l0 + 16 * m + lr + i; const float wi = sm[512 + l];
            const float den = wi * sm[1024 + l] + sm[768 + l]; const float dinv = 1.f / fmaxf(fabsf(den), sm[640 + l]); float ssq = 0.f;
#pragma unroll
            for (int n = 0; n < 4; ++n) { const float hv = (wi * ae[m][n][i] + ai[m][n][i]) * dinv; ai[m][n][i] = hv; ssq += hv * hv; }
            ssq += __shfl_xor(ssq, 1); ssq += __shfl_xor(ssq, 2); ssq += __shfl_xor(ssq, 4); ssq += __shfl_xor(ssq, 8);
            if (lc == 0) __hip_atomic_fetch_add(sm + 896 + l, ssq, __ATOMIC_RELAXED, __HIP_MEMORY_SCOPE_WORKGROUP); }
    __syncthreads();
    v4u owf[4];
#pragma unroll
    for (int it = 0; it < 4; ++it) { const int item = tid + 512 * it, l = item >> 4, ch = (item & 15) * 8; owf[it] = *(const GAS v4u*)(Z + (rowb + t0 + l) * NZ0 + 1536 + hm * 128 + ch); }
    LAS float* HT = (LAS float*)(lds + ML_Q);
#pragma unroll
    for (int m = 0; m < 2; ++m)
#pragma unroll
        for (int i = 0; i < 4; ++i) { const int l = l0 + 16 * m + lr + i; const float rstd = rsqrtf(sm[896 + l] * (1.f / 128.f) + EPS);
#pragma unroll
            for (int n = 0; n < 4; ++n) HT[l * 132 + c0 + 16 * n + lc] = ai[m][n][i] * rstd; }
    __syncthreads();
    { const float* mg = A.in[10] + hm * 128; bf16* Y = WSP(bf16, WS_XNY);
#pragma unroll
      for (int it = 0; it < 4; ++it) { const int item = tid + 512 * it, l = item >> 4, ch = (item & 15) * 8; const size_t row = rowb + t0 + l;
          const v4u ow = owf[it];
          const f32x4 h0 = *(const LAS f32x4*)(HT + l * 132 + ch), h1 = *(const LAS f32x4*)(HT + l * 132 + ch + 4), g0 = *(const f32x4*)(mg + ch), g1 = *(const f32x4*)(mg + ch + 4);
          v4u o; o.x = pk2(h0.x * g0.x * sigmoid_f(bflo(ow.x)), h0.y * g0.y * sigmoid_f(bfhi(ow.x))); o.y = pk2(h0.z * g0.z * sigmoid_f(bflo(ow.y)), h0.w * g0.w * sigmoid_f(bfhi(ow.y)));
          o.z = pk2(h1.x * g1.x * sigmoid_f(bflo(ow.z)), h1.y * g1.y * sigmoid_f(bfhi(ow.z))); o.w = pk2(h1.z * g1.z * sigmoid_f(bflo(ow.w)), h1.w * g1.w * sigmoid_f(bfhi(ow.w)));
          *(GAS v4u*)(Y + row * 1024 + hm * 128 + ch) = o; } }
    __syncthreads();
}
template <int N> __device__ __forceinline__ void bitonic_sort_desc(float (&v)[N]) {
#pragma unroll
    for (int k = 2; k <= N; k <<= 1)
#pragma unroll
        for (int j = k >> 1; j > 0; j >>= 1)
#pragma unroll
            for (int i = 0; i < N; ++i) { const int l = i ^ j; if (l > i) { const bool desc = ((i & k) == 0); const float a = v[i], b = v[l]; const float mx = fmaxf(a, b), mn = fminf(a, b); v[i] = desc ? mx : mn; v[l] = desc ? mn : mx; } }
}
__device__ __forceinline__ void merge_top16(float (&run)[16], const float (&nw)[16]) {
#pragma unroll
    for (int i = 0; i < 16; ++i) run[i] = fmaxf(run[i], nw[15 - i]);
#pragma unroll
    for (int j = 8; j > 0; j >>= 1)
#pragma unroll
        for (int i = 0; i < 16; ++i) { const int l = i ^ j; if (l > i) { const float a = run[i], b = run[l]; run[i] = fmaxf(a, b); run[l] = fminf(a, b); } }
}
constexpr int SCS = 132;
__device__ __forceinline__ void peer_route_unit(Frame& F, int tok0, int hd, const bf16x8 (&kf)[4][2]) {
    const bf16* QRY = WSP(bf16, WS_QRY); unsigned short* IDX = WSP(unsigned short, WS_IDX); float* GATE = WSP(float, WS_GATE);
    LAS float* SC = (LAS float*)F.lds;
    const int lane = ((int)(threadIdx.x & 63u)), w = F.wave, tid = ((int)threadIdx.x);
    {
        constexpr int AST = 528;
        LAS unsigned char* As = F.lds;
#pragma unroll
        for (int i = 0; i < 8; ++i) { const int ch = tid + 512 * i, row = ch >> 5, cc = ch & 31;
            *(LAS v4u*)(As + row * AST + cc * 16) = *(const GAS v4u*)(QRY + (size_t)(tok0 + row) * NQ + hd * 256 + cc * 8); }
        __syncthreads();
        const int p = w & 1, nq = w >> 1, r = lane & 15, kq = (lane >> 4) * 16;
        f32x4 acc[8][2];
#pragma unroll
        for (int m = 0; m < 8; ++m) { acc[m][0] = (f32x4){0.f, 0.f, 0.f, 0.f}; acc[m][1] = (f32x4){0.f, 0.f, 0.f, 0.f}; }
#pragma unroll
        for (int ks = 0; ks < 4; ++ks)
#pragma unroll
            for (int m = 0; m < 8; ++m) { const bf16x8 a = *(const LAS bf16x8*)(As + (16 * m + r) * AST + p * 256 + ks * 64 + kq);
                acc[m][0] = __builtin_amdgcn_mfma_f32_16x16x32_bf16(a, kf[ks][0], acc[m][0], 0, 0, 0);
                acc[m][1] = __builtin_amdgcn_mfma_f32_16x16x32_bf16(a, kf[ks][1], acc[m][1], 0, 0, 0); }
        __syncthreads();
#pragma unroll
        for (int m = 0; m < 8; ++m)
#pragma unroll
            for (int n = 0; n < 2; ++n)
#pragma unroll
                for (int i = 0; i < 4; ++i) SC[(p * 128 + 16 * m + 4 * (lane >> 4) + i) * SCS + 32 * nq + 16 * n + r] = acc[m][n][i];
    }
    __syncthreads();
    {
        const int t = tid & 127, p = (tid >> 7) & 1, half = tid >> 8;
        LAS float* seg = SC + (p * 128 + t) * SCS + 64 * half;
        float run[16], nw[16];
#pragma unroll
        for (int ch = 0; ch < 4; ++ch) {
#pragma unroll
            for (int q = 0; q < 4; ++q) { const f32x4 v = *(const LAS f32x4*)(seg + 16 * ch + 4 * q);
#pragma unroll
                for (int e = 0; e < 4; ++e) { const unsigned n = (unsigned)(64 * half + 16 * ch + 4 * q + e); const float key = u2f((f2u(v[e]) & ~127u) | n);
                    if (ch == 0) run[4 * q + e] = key; else nw[4 * q + e] = key; } }
            if (ch == 0) bitonic_sort_desc<16>(run); else { bitonic_sort_desc<16>(nw); merge_top16(run, nw); }
        }
#pragma unroll
        for (int q = 0; q < 4; ++q) *(LAS f32x4*)(seg + 4 * q) = (f32x4){run[4 * q], run[4 * q + 1], run[4 * q + 2], run[4 * q + 3]};
    }
    __syncthreads();
    if (tid < 128) {
        const int t = tid;
        float s0[16], s1[16];
        {
            LAS float* a = SC + (0 * 128 + t) * SCS; float nw[16];
#pragma unroll
            for (int q = 0; q < 4; ++q) { const f32x4 v = *(const LAS f32x4*)(a + 4 * q), u = *(const LAS f32x4*)(a + 64 + 4 * q);
#pragma unroll
                for (int e = 0; e < 4; ++e) { s0[4 * q + e] = v[e]; nw[4 * q + e] = u[e]; } }
            merge_top16(s0, nw);
#pragma unroll
            for (int q = 0; q < 4; ++q) *(LAS f32x4*)(a + 16 + 4 * q) = (f32x4){s0[4 * q], s0[4 * q + 1], s0[4 * q + 2], s0[4 * q + 3]};
        }
        {
            LAS float* a = SC + (1 * 128 + t) * SCS; float nw[16];
#pragma unroll
            for (int q = 0; q < 4; ++q) { const f32x4 v = *(const LAS f32x4*)(a + 4 * q), u = *(const LAS f32x4*)(a + 64 + 4 * q);
#pragma unroll
                for (int e = 0; e < 4; ++e) { s1[4 * q + e] = v[e]; nw[4 * q + e] = u[e]; } }
            merge_top16(s1, nw);
#pragma unroll
            for (int q = 0; q < 4; ++q) *(LAS f32x4*)(a + 16 + 4 * q) = (f32x4){s1[4 * q], s1[4 * q + 1], s1[4 * q + 2], s1[4 * q + 3]};
        }
#pragma unroll
        for (int i = 0; i < 16; ++i) { s0[i] = u2f(f2u(s0[i]) & ~127u); s1[i] = u2f(f2u(s1[i]) & ~127u); }
        constexpr int CNT[16] = {16, 8, 5, 4, 3, 2, 2, 2, 1, 1, 1, 1, 1, 1, 1, 1};
        constexpr int OFF[16] = {0, 16, 24, 29, 33, 36, 38, 40, 42, 43, 44, 45, 46, 47, 48, 49};
        float top[16], nw[16];
#pragma unroll
        for (int grp = 0; grp < 4; ++grp) {
#pragma unroll
            for (int e = 0; e < 16; ++e) nw[e] = -INFINITY;
#pragma unroll
            for (int i = 0; i < 16; ++i)
#pragma unroll
                for (int j = 0; j < 16; ++j) if (j < CNT[i] && (OFF[i] + j) / 16 == grp) {
                    const float sum = s0[i] + s1[j];
                    nw[(OFF[i] + j) % 16] = u2f((f2u(sum) & ~255u) | (unsigned)(i * 16 + j)); }
            bitonic_sort_desc<16>(nw);
            if (grp == 0) {
#pragma unroll
                for (int e = 0; e < 16; ++e) top[e] = nw[e];
            } else merge_top16(top, nw);
        }
        float sc[16], den = 0.f;
        const float mx = u2f(f2u(top[0]) & ~255u);
#pragma unroll
        for (int k = 0; k < 16; ++k) { sc[k] = __expf(u2f(f2u(top[k]) & ~255u) - mx); den += sc[k]; }
        const float inv = 1.f / den;
        LDS_WAIT();
        const LAS unsigned* l0 = (const LAS unsigned*)(SC + (0 * 128 + t) * SCS + 16); const LAS unsigned* l1 = (const LAS unsigned*)(SC + (1 * 128 + t) * SCS + 16);
        const size_t ob = (size_t)(tok0 + t) * 128 + hd * 16;
        unsigned eid[16];
#pragma unroll
        for (int k = 0; k < 16; ++k) { const unsigned id = f2u(top[k]) & 255u; const unsigned e0 = l0[id >> 4] & 127u, e1 = l1[id & 15u] & 127u; eid[k] = e0 * 128u + e1; }
        { v4u i0, i1; i0.x = eid[0] | (eid[1] << 16); i0.y = eid[2] | (eid[3] << 16); i0.z = eid[4] | (eid[5] << 16); i0.w = eid[6] | (eid[7] << 16);
          i1.x = eid[8] | (eid[9] << 16); i1.y = eid[10] | (eid[11] << 16); i1.z = eid[12] | (eid[13] << 16); i1.w = eid[14] | (eid[15] << 16);
          *(GAS v4u*)(IDX + ob) = i0; *(GAS v4u*)(IDX + ob + 8) = i1; }
#pragma unroll
        for (int q4 = 0; q4 < 4; ++q4) *(GAS f32x4*)(GATE + ob + 4 * q4) = (f32x4){sc[4 * q4] * inv, sc[4 * q4 + 1] * inv, sc[4 * q4 + 2] * inv, sc[4 * q4 + 3] * inv};
    }
    __syncthreads();
}
__device__ __forceinline__ void peer_u_phase(Frame& F, const unsigned char* U8  ) {
    const bf16* XN = WSP(bf16, WS_XNY); const unsigned short* IDX = WSP(unsigned short, WS_IDX); unsigned short* PART = WSP(unsigned short, WS_PART);
    const int lane = (int)(threadIdx.x & 63u), t8 = lane >> 3, l8 = lane & 7;
    const int g = F.bid & 7, nsw = (F.G >> 3) * NWAVES, ws = (F.bid >> 3) * NWAVES + F.wave;
    const unsigned char* Ug = U8 + (size_t)g * 16384 * 128; const unsigned lo8 = 16u * (unsigned)l8;
    for (int wi = ws; wi < M / 8; wi += nsw) {
        const int tok = wi * 8 + t8;
        int hq[4]; float hsc;
        { const bf16* hp = XN + (size_t)tok * D + 128 * g + 16 * l8; const v4u x = *(const GAS v4u*)hp, y = *(const GAS v4u*)(hp + 8);
          const float hf[16] = {bflo(x.x), bfhi(x.x), bflo(x.y), bfhi(x.y), bflo(x.z), bfhi(x.z), bflo(x.w), bfhi(x.w), bflo(y.x), bfhi(y.x), bflo(y.y), bfhi(y.y), bflo(y.z), bfhi(y.z), bflo(y.w), bfhi(y.w)};
          float am = 0.f;
#pragma unroll
          for (int i = 0; i < 16; ++i) am = fmaxf(am, fabsf(hf[i]));
          am = fmaxf(am, __shfl_xor(am, 1)); am = fmaxf(am, __shfl_xor(am, 2)); am = fmaxf(am, __shfl_xor(am, 4));
          const float hinv = am > 1e-30f ? 127.f / am : 0.f; hsc = am * (1.f / (127.f * 64.f));
#pragma unroll
          for (int q4 = 0; q4 < 4; ++q4) { unsigned wv = 0;
#pragma unroll
              for (int e = 0; e < 4; ++e) { const int qv = (int)rintf(hf[4 * q4 + e] * hinv); wv |= ((unsigned)qv & 0xffu) << (8 * e); }
              hq[q4] = (int)wv; } }
        const unsigned short* ip = IDX + (size_t)tok * 128; unsigned short* pp = PART + ((size_t)g * M + tok) * 128;
#pragma unroll 4
        for (int gi = 0; gi < 16; ++gi) {
            const v4u idp = *(const GAS v4u*)(ip + 8 * gi);
            const unsigned e0 = idp.x & 0xffffu, e1 = idp.x >> 16, e2 = idp.y & 0xffffu, e3 = idp.y >> 16, e4 = idp.z & 0xffffu, e5 = idp.z >> 16, e6 = idp.w & 0xffffu, e7 = idp.w >> 16;
            const v4u r0 = *(const GAS v4u*)(Ug + ((e0 << 7) | lo8)), r1 = *(const GAS v4u*)(Ug + ((e1 << 7) | lo8)), r2 = *(const GAS v4u*)(Ug + ((e2 << 7) | lo8)), r3 = *(const GAS v4u*)(Ug + ((e3 << 7) | lo8));
            const v4u r4 = *(const GAS v4u*)(Ug + ((e4 << 7) | lo8)), r5 = *(const GAS v4u*)(Ug + ((e5 << 7) | lo8)), r6 = *(const GAS v4u*)(Ug + ((e6 << 7) | lo8)), r7 = *(const GAS v4u*)(Ug + ((e7 << 7) | lo8));
#define U_DOT(R) ({ const unsigned a_ = R.x, b_ = R.y, c_ = R.z, d_ = R.w; int acc_ = __builtin_amdgcn_sdot4((int)a_, hq[0], 0, false); acc_ = __builtin_amdgcn_sdot4((int)b_, hq[1], acc_, false); \
                    acc_ = __builtin_amdgcn_sdot4((int)c_, hq[2], acc_, false); acc_ = __builtin_amdgcn_sdot4((int)d_, hq[3], acc_, false); \
                    acc_ += __shfl_xor(acc_, 1); acc_ += __shfl_xor(acc_, 2); acc_ += __shfl_xor(acc_, 4); (float)acc_ * hsc; })
            const float d0 = U_DOT(r0), d1 = U_DOT(r1), d2 = U_DOT(r2), d3 = U_DOT(r3), d4 = U_DOT(r4), d5 = U_DOT(r5), d6 = U_DOT(r6), d7 = U_DOT(r7);
#undef U_DOT
            if (l8 == 0) { v4u o; o.x = f2h2(d0, d1); o.y = f2h2(d2, d3); o.z = f2h2(d4, d5); o.w = f2h2(d6, d7); *(GAS v4u*)(pp + 8 * gi) = o; }
        }
    }
}
template <int CTRL> __device__ __forceinline__ int dppx(int v) { return __builtin_amdgcn_update_dpp(0, v, CTRL, 0xf, 0xf, false); }

__device__ __forceinline__ void peer_sort_phase(Frame& F) {
    const unsigned short* IDX = WSP(unsigned short, WS_IDX); unsigned* LIST = WSP(unsigned, WS_LIST);
    LAS unsigned* hist = (LAS unsigned*)F.lds;
    LAS unsigned* aux = hist + 2048;
    const int tid = (int)threadIdx.x, lane = tid & 63;
    for (int unit = F.bid; unit < 256; unit += F.G) {
        const unsigned t = ((unsigned)unit & 7u) * 4u + ((unsigned)unit >> 6), r = ((unsigned)unit >> 3) & 7u;
        for (int i = tid; i < 2048; i += NTHR) hist[i] = 0u;
        if (tid < 16) aux[tid] = 0u;
        __syncthreads();
        const GAS v4u* src = (const GAS v4u*)(IDX + (size_t)t * 131072);
        unsigned low = 0u;
#pragma unroll 4
        for (int st = 0; st < 32; ++st) { const v4u w = src[st * 512 + tid]; const unsigned ww[4] = {w.x, w.y, w.z, w.w};
#pragma unroll
            for (int k = 0; k < 8; ++k) { const unsigned e = (k & 1) ? (ww[k >> 1] >> 16) : (ww[k >> 1] & 0xffffu); const unsigned rg = e >> 11;
                low += rg < r ? 1u : 0u;
                if (rg == r) __hip_atomic_fetch_add(hist + (e & 2047u), 1u, __ATOMIC_RELAXED, __HIP_MEMORY_SCOPE_WORKGROUP); } }
#pragma unroll
        for (int o = 1; o < 64; o <<= 1) low += __shfl_xor(low, o);
        if (lane == 0) __hip_atomic_fetch_add(aux, low, __ATOMIC_RELAXED, __HIP_MEMORY_SCOPE_WORKGROUP);
        __syncthreads();
        {
            const unsigned h0 = hist[4 * tid], h1 = hist[4 * tid + 1], h2 = hist[4 * tid + 2], h3 = hist[4 * tid + 3]; const unsigned s = h0 + h1 + h2 + h3; unsigned inc = s;
#pragma unroll
            for (int o = 1; o < 64; o <<= 1) { const unsigned v = __shfl_up(inc, o); if (lane >= o) inc += v; }
            if (lane == 63) aux[8 + F.wave] = inc;
            __syncthreads();
            unsigned off = aux[0];
            for (int w = 0; w < F.wave; ++w) off += aux[8 + w];
            const unsigned ex = off + inc - s;
            hist[4 * tid] = ex; hist[4 * tid + 1] = ex + h0; hist[4 * tid + 2] = ex + h0 + h1; hist[4 * tid + 3] = ex + h0 + h1 + h2;
        }
        __syncthreads();
        unsigned* L = LIST + (size_t)t * 131072;
#pragma unroll 2
        for (int st = 0; st < 32; ++st) { const v4u w = src[st * 512 + tid]; const unsigned ww[4] = {w.x, w.y, w.z, w.w}; const unsigned i0 = (unsigned)(st * 512 + tid) * 8u;
#pragma unroll
            for (int k = 0; k < 8; ++k) { const unsigned e = (k & 1) ? (ww[k >> 1] >> 16) : (ww[k >> 1] & 0xffffu);
                if ((e >> 11) == r) { const unsigned pos = __hip_atomic_fetch_add(hist + (e & 2047u), 1u, __ATOMIC_RELAXED, __HIP_MEMORY_SCOPE_WORKGROUP); L[pos] = (e << 17) | (i0 + (unsigned)k); } } }
        __syncthreads();
    }
}

__device__ __forceinline__ void peer_u_sorted(Frame& F, const unsigned char* U8  ) {
    const bf16* XN = WSP(bf16, WS_XNY); const unsigned* LIST = WSP(unsigned, WS_LIST); unsigned short* PART = WSP(unsigned short, WS_PART);
    const int lane = (int)(threadIdx.x & 63u), p8 = lane >> 3, l8 = lane & 7;
    LAS unsigned char* hl = F.lds;
    LAS float* hs = (LAS float*)(F.lds + 131072);
    const unsigned lo8 = 16u * (unsigned)l8;
    for (int unit = F.bid; unit < 256; unit += F.G) {
        const int t = unit >> 3, g = unit & 7;
        const unsigned char* Ug = U8 + (size_t)g * 16384 * 128;
#pragma unroll 4
        for (int s = 0; s < 16; ++s) { const int tl = (s * NWAVES + F.wave) * 8 + p8;
            const bf16* hp = XN + (size_t)(t * 1024 + tl) * D + 128 * g + 16 * l8; const v4u x = *(const GAS v4u*)hp, y = *(const GAS v4u*)(hp + 8);
            const float hf[16] = {bflo(x.x), bfhi(x.x), bflo(x.y), bfhi(x.y), bflo(x.z), bfhi(x.z), bflo(x.w), bfhi(x.w), bflo(y.x), bfhi(y.x), bflo(y.y), bfhi(y.y), bflo(y.z), bfhi(y.z), bflo(y.w), bfhi(y.w)};
            float am = 0.f;
#pragma unroll
            for (int i = 0; i < 16; ++i) am = fmaxf(am, fabsf(hf[i]));
            am = fmaxf(am, __shfl_xor(am, 1)); am = fmaxf(am, __shfl_xor(am, 2)); am = fmaxf(am, __shfl_xor(am, 4));
            const float hinv = am > 1e-30f ? 127.f / am : 0.f;
            v4u hq; unsigned hw[4];
#pragma unroll
            for (int q4 = 0; q4 < 4; ++q4) { unsigned wv = 0;
#pragma unroll
                for (int e = 0; e < 4; ++e) { const int qv = (int)rintf(hf[4 * q4 + e] * hinv); wv |= ((unsigned)qv & 0xffu) << (8 * e); }
                hw[q4] = wv; }
            hq.x = hw[0]; hq.y = hw[1]; hq.z = hw[2]; hq.w = hw[3];
            *(LAS v4u*)(hl + tl * 128 + lo8) = hq;
            if (l8 == 0) hs[tl] = am * (1.f / (127.f * 64.f)); }
        __syncthreads();
        const unsigned* L = LIST + (size_t)t * 131072 + F.wave * 16384; unsigned short* P = PART + ((size_t)g * 32 + t) * 131072 + F.wave * 16384;
        const bool u2 = (l8 & 4) != 0, u1 = (l8 & 2) != 0, u0 = (l8 & 1) != 0;
        LAS unsigned* es = (LAS unsigned*)(F.lds + 135168) + F.wave * 128;
        unsigned mine0 = L[lane], mine1 = L[64 + lane];
        es[lane] = mine0;
        v4u eaA = *(const LAS v4u*)(es + p8 * 8), ebA = *(const LAS v4u*)(es + p8 * 8 + 4), eaB, ebB;
        v4u rwA[8], rwB[8];
        { const unsigned en[8] = {eaA.x, eaA.y, eaA.z, eaA.w, ebA.x, ebA.y, ebA.z, ebA.w};
#pragma unroll
          for (int j = 0; j < 8; ++j) rwA[j] = *(const GAS v4u*)(Ug + (((en[j] >> 17) << 7) | lo8)); }
#define U_TRIP(IT, RWC, EAC, EBC, RWN, EAN, EBN, SLOT) do { const int base = (IT) * 64; const int nb = ((IT) + 2 < 256 ? (IT) + 2 : 255) * 64; \
            const unsigned mine2 = L[nb + lane]; \
            LAS unsigned* sl = es + (SLOT) * 64; sl[lane] = mine1; \
            EAN = *(const LAS v4u*)(sl + p8 * 8); EBN = *(const LAS v4u*)(sl + p8 * 8 + 4); \
            { const unsigned en1[8] = {EAN.x, EAN.y, EAN.z, EAN.w, EBN.x, EBN.y, EBN.z, EBN.w}; \
              _Pragma("unroll") for (int j = 0; j < 8; ++j) RWN[j] = *(const GAS v4u*)(Ug + (((en1[j] >> 17) << 7) | lo8)); } \
            __builtin_amdgcn_sched_barrier(0);        \
            const unsigned en[8] = {EAC.x, EAC.y, EAC.z, EAC.w, EBC.x, EBC.y, EBC.z, EBC.w}; \
            int acc[8]; \
            _Pragma("unroll") for (int j = 0; j < 8; ++j) { const v4u hv = *(const LAS v4u*)(hl + ((((en[j] >> 7) & 1023u) << 7) | lo8)); \
                const unsigned ra = RWC[j].x, rb = RWC[j].y, rc = RWC[j].z, rd = RWC[j].w, ha = hv.x, hb = hv.y, hc = hv.z, hd = hv.w; \
                int a = __builtin_amdgcn_sdot4((int)ra, (int)ha, 0, false); a = __builtin_amdgcn_sdot4((int)rb, (int)hb, a, false); \
                a = __builtin_amdgcn_sdot4((int)rc, (int)hc, a, false); a = __builtin_amdgcn_sdot4((int)rd, (int)hd, a, false); acc[j] = a; } \
            int q[4], r2[2]; \
            _Pragma("unroll") for (int i = 0; i < 4; ++i) { const int send = u2 ? acc[i] : acc[i + 4], keep = u2 ? acc[i + 4] : acc[i]; q[i] = keep + dppx<0x141>(send); } \
            _Pragma("unroll") for (int i = 0; i < 2; ++i) { const int send = u1 ? q[i] : q[i + 2], keep = u1 ? q[i + 2] : q[i]; r2[i] = keep + dppx<0x4E>(send); } \
            const int send = u0 ? r2[0] : r2[1], keep = u0 ? r2[1] : r2[0]; const int tot = keep + dppx<0xB1>(send); \
            const float dv = (float)tot * hs[(mine0 >> 7) & 1023u]; \
            P[base + lane] = (unsigned short)(f2h2(dv, 0.f) & 0xffffu); \
            mine0 = mine1; mine1 = mine2; } while (0)
        for (int it = 0; it < 256; it += 2) {
            U_TRIP(it, rwA, eaA, ebA, rwB, eaB, ebB, 1);
            U_TRIP(it + 1, rwB, eaB, ebB, rwA, eaA, ebA, 0);
        }
#undef U_TRIP
        __syncthreads();
    }
}

__device__ __forceinline__ void peer_reduce_phase(Frame& F) {
    const unsigned* LIST = WSP(unsigned, WS_LIST); const unsigned short* PART = WSP(unsigned short, WS_PART); float* DT = WSP(float, WS_DTOK);
    for (int unit = F.bid; unit < 256; unit += F.G) {
        const size_t t = (size_t)(unit & 7) * 4 + (unit >> 6), k8 = (unit >> 3) & 7; const size_t tb = t * 131072;
#pragma unroll 2
        for (int st = 0; st < 4; ++st) { const size_t p0 = tb + k8 * 16384 + ((size_t)st * NTHR + (int)threadIdx.x) * 8;
            float s[8];
#pragma unroll
            for (int k = 0; k < 8; ++k) s[k] = 0.f;
#pragma unroll
            for (int g = 0; g < 8; ++g) { const v4u w = *(const GAS v4u*)(PART + (size_t)g * 32 * 131072 + p0); const unsigned w0 = w.x, w1 = w.y, w2 = w.z, w3 = w.w;
                s[0] += h2f_lo(w0); s[1] += h2f_hi(w0); s[2] += h2f_lo(w1); s[3] += h2f_hi(w1); s[4] += h2f_lo(w2); s[5] += h2f_hi(w2); s[6] += h2f_lo(w3); s[7] += h2f_hi(w3); }
            const v4u la = *(const GAS v4u*)(LIST + p0), lb = *(const GAS v4u*)(LIST + p0 + 4);
            const unsigned en[8] = {la.x, la.y, la.z, la.w, lb.x, lb.y, lb.z, lb.w};
#pragma unroll
            for (int k = 0; k < 8; ++k) DT[tb + (en[k] & 0x1ffffu)] = s[k]; }
    }
}
__device__ __forceinline__ void peer_act_phase(Frame& F, const float* ISU, const float* ISV) {
    const unsigned short* IDX = WSP(unsigned short, WS_IDX); const float* GATE = WSP(float, WS_GATE); const unsigned* PART = WSP(unsigned, WS_PART);
    unsigned short* ACT8 = WSP(unsigned short, WS_ACT); float* ACTS = WSP(float, WS_ACTS);
    const int gw = F.bid * NWAVES + F.wave, NGW = F.G * NWAVES, lane = ((int)(threadIdx.x & 63u));
    for (int tok = gw; tok < M; tok += NGW) {
        const size_t i = (size_t)tok * 128 + 2 * lane;
        const float2 dd = *(const float2*)(WSP(float, WS_DTOK) + i); const float s0 = dd.x, s1 = dd.y;
        const unsigned idw = *(const unsigned*)(IDX + i); int2 id; id.x = (int)(idw & 0xffffu); id.y = (int)(idw >> 16); const float2 gt = *(const float2*)(GATE + i);
        const float d0 = s0 * (64.f * ISU[id.x]), d1 = s1 * (64.f * ISU[id.y]);
        const float a0 = 0.5f * d0 * (1.f + erff(d0 * 0.70710678118654752f)) * gt.x * ISV[id.x], a1 = 0.5f * d1 * (1.f + erff(d1 * 0.70710678118654752f)) * gt.y * ISV[id.y];
        const float am = wave_max(fmaxf(fabsf(a0), fabsf(a1)));
        const float inv = am > 1e-30f ? 127.f / am : 0.f;
        const int q0 = (int)rintf(a0 * inv), q1 = (int)rintf(a1 * inv);
        ACT8[(size_t)tok * 64 + lane] = (unsigned short)(((unsigned)q0 & 0xffu) | (((unsigned)q1 & 0xffu) << 8));
        if (lane == 0) ACTS[tok] = am * (1.f / 127.f);
    }
}
template <bool FINAL>
__device__ __forceinline__ void peer_v_phase(Frame& F, const unsigned char* V8, const float* g2  ) {
    const unsigned short* IDX = WSP(unsigned short, WS_IDX); const unsigned* ACT8 = WSP(unsigned, WS_ACT); const float* ACTS = WSP(float, WS_ACTS);
    const int lane = ((int)(threadIdx.x & 63u)), t8 = lane >> 3, l8 = lane & 7;
    const int g = F.bid & 7, nsw = (F.G >> 3) * NWAVES, ws = (F.bid >> 3) * NWAVES + F.wave;
    const unsigned char* Vg = V8 + (size_t)g * 16384 * 128; const unsigned lo8 = 16u * (unsigned)l8;
    for (int wi = ws; wi < M / 8; wi += nsw) {
        const int tok = wi * 8 + t8;
        const unsigned short* ip = IDX + (size_t)tok * 128; const unsigned* ap = ACT8 + (size_t)tok * 32;
        int acc[16];
#pragma unroll
        for (int i = 0; i < 16; ++i) acc[i] = 0;
#pragma unroll 8
        for (int gi = 0; gi < 32; ++gi) {
            const v2u idp = *(const GAS v2u*)(ip + 4 * gi); v4u id4; id4.x = idp.x & 0xffffu; id4.y = idp.x >> 16; id4.z = idp.y & 0xffffu; id4.w = idp.y >> 16; const int qa = (int)ap[gi];
            const v4u ra = *(const GAS v4u*)(Vg + ((id4.x << 7) | lo8)), rb = *(const GAS v4u*)(Vg + ((id4.y << 7) | lo8)), rc = *(const GAS v4u*)(Vg + ((id4.z << 7) | lo8)), rd = *(const GAS v4u*)(Vg + ((id4.w << 7) | lo8));
            const unsigned A[4] = {ra.x, ra.y, ra.z, ra.w}, B[4] = {rb.x, rb.y, rb.z, rb.w}, C[4] = {rc.x, rc.y, rc.z, rc.w}, Dd[4] = {rd.x, rd.y, rd.z, rd.w};
#pragma unroll
            for (int j = 0; j < 4; ++j) {
                const unsigned ablo = __builtin_amdgcn_perm(B[j], A[j], 0x05010400u), abhi = __builtin_amdgcn_perm(B[j], A[j], 0x07030602u);
                const unsigned cdlo = __builtin_amdgcn_perm(Dd[j], C[j], 0x05010400u), cdhi = __builtin_amdgcn_perm(Dd[j], C[j], 0x07030602u);
                const unsigned t0 = __builtin_amdgcn_perm(cdlo, ablo, 0x05040100u), t1 = __builtin_amdgcn_perm(cdlo, ablo, 0x07060302u);
                const unsigned t2 = __builtin_amdgcn_perm(cdhi, abhi, 0x05040100u), t3 = __builtin_amdgcn_perm(cdhi, abhi, 0x07060302u);
                acc[4 * j] = __builtin_amdgcn_sdot4((int)t0, qa, acc[4 * j], false); acc[4 * j + 1] = __builtin_amdgcn_sdot4((int)t1, qa, acc[4 * j + 1], false);
                acc[4 * j + 2] = __builtin_amdgcn_sdot4((int)t2, qa, acc[4 * j + 2], false); acc[4 * j + 3] = __builtin_amdgcn_sdot4((int)t3, qa, acc[4 * j + 3], false);
            }
        }
        const float sc = ACTS[tok];
        const int b = tok >> 13, c0 = 128 * g + 16 * l8; bf16* xs = WSP(bf16, WS_XS) + (size_t)tok * D + c0; const float* gr = g2 + (size_t)b * 6144 + c0;
        const v4u xa = *(const GAS v4u*)xs, xb = *(const GAS v4u*)(xs + 8);
        const unsigned xw[8] = {xa.x, xa.y, xa.z, xa.w, xb.x, xb.y, xb.z, xb.w};
        float o[16];
#pragma unroll
        for (int q4 = 0; q4 < 4; ++q4) { const f32x4 gv = *(const f32x4*)(gr + 4 * q4);
            o[4 * q4] = bflo(xw[2 * q4]) + gv.x * sc * (float)acc[4 * q4]; o[4 * q4 + 1] = bfhi(xw[2 * q4]) + gv.y * sc * (float)acc[4 * q4 + 1];
            o[4 * q4 + 2] = bflo(xw[2 * q4 + 1]) + gv.z * sc * (float)acc[4 * q4 + 2]; o[4 * q4 + 3] = bfhi(xw[2 * q4 + 1]) + gv.w * sc * (float)acc[4 * q4 + 3]; }
        if (FINAL) { float* xr = F.out + (size_t)tok * D + c0;
#pragma unroll
            for (int q4 = 0; q4 < 4; ++q4) *(GAS f32x4*)(xr + 4 * q4) = (f32x4){o[4 * q4], o[4 * q4 + 1], o[4 * q4 + 2], o[4 * q4 + 3]};
        } else { v4u ya, yb; ya.x = pk2(o[0], o[1]); ya.y = pk2(o[2], o[3]); ya.z = pk2(o[4], o[5]); ya.w = pk2(o[6], o[7]); yb.x = pk2(o[8], o[9]); yb.y = pk2(o[10], o[11]); yb.z = pk2(o[12], o[13]); yb.w = pk2(o[14], o[15]);
            *(GAS v4u*)xs = ya; *(GAS v4u*)(xs + 8) = yb; }
    }
}
#ifndef MK_PER_PHASE
#define MK_PER_PHASE 0
#endif
constexpr int NPHASE = 24;
#ifndef PHASE_MASK
#define PHASE_MASK 0x1ffffffu
#endif
#define IN(k) (lo <= (k) && (k) < hi && ((PHASE_MASK >> (k)) & 1u))
#define SEAM(k) do { if (IN(k) && IN((k) + 1)) xcd_barrier(bar); } while (0)
__device__ __forceinline__ float alibi_tcut(const float* gq, const float* gk, int lane) { return 16.f * wave_max(fabsf(gq[lane])) * wave_max(fabsf(gk[lane])) + ALIBI_MARGIN; }
template <int layer>
__device__ __forceinline__ void layer_phases(Frame& F, const Args& args, const XcdBarrier& bar, const int lo, const int hi) {
    volatile LAS unsigned* MISCW = (volatile LAS unsigned*)(F.lds + MISC_OFF);
    float* MOD = WSP(float, WS_MOD);
    bf16* XNY = WSP(bf16, WS_XNY); bf16* Zb = WSP(bf16, WS_Z);

        constexpr int pb = layer * 12;
        const float* mod = MOD + (size_t)layer * 4 * 6144;
        if (IN(pb + 1)) { if (layer == 0) norm_pass<true, false>(F, args, args.in[0], args.in[4], mod, 0, XNY); else norm_pass<false, true>(F, args, WSP(bf16, WS_XS), args.in[4] + 1024, mod, 0, XNY); } SEAM(pb + 1);
        if (IN(pb + 2)) {
            const int N = layer == 0 ? NZ0 : NZ1;
            pg8::Gemm g{XNY, layer == 0 ? WSP(bf16, WS_WIN0) : WSP(bf16, WS_WIN1), M, N, D}; pg8::StaticOrder S; S.init(M, N, F.G, F.bid);
            pg8::EpiBf16QK E{Zb, N, layer == 0 ? 8 : 0, layer == 0 ? 10 : 4, layer == 0 ? 10 : 4, layer == 0 ? 12 : 8, layer == 0 ? args.in[11] : args.in[15], layer == 0 ? args.in[12] : args.in[16], 0.125f * LOG2E, (LAS float*)(F.lds + 131072)};
            pg8::gemm_phase<pg8::EpiBf16QK, pg8::StaticOrder, true, true>(F.lds, g, S, E);
        } SEAM(pb + 2);
        if (layer == 0) {
            if (IN(3)) {
                for (int u = F.bid; u < 1024 + 128; u += F.G) {
                    if (u < 1024) mlstm_a_unit(F, args, u);
                    else { const int v = u - 1024, b = v >> 5, j = v & 31;
                        kmean_unit(F, Zb, NZ0, b * SEQ + j * 256, 2560, WSP(float, WS_KMEAN) + (size_t)((b * 8) * 32 + j) * 64); }
                }
            } SEAM(3);
            if (IN(4)) {
                for (int u = F.bid; u < 128; u += F.G) mlstm_scan_unit(F, u);
                { const float tcut = alibi_tcut(args.in[11], args.in[12], ((int)(threadIdx.x & 63u)));
                  const unsigned short* ORD = WSP(unsigned short, WS_ORD) + 2048; unsigned* qw = (unsigned*)(F.ws + WS_CTL) + CW_QMOBA;
                  for (int xi = 0; xi < 8; ++xi) { const int x = (F.bid + xi) & 7;
                      for (;;) { if (((int)threadIdx.x) == 0) MISCW[0] = atomicAdd(qw + 16 * x, 1u); __syncthreads(); const unsigned qi = MISCW[0]; __syncthreads(); if (qi >= 128u) break;
                          const int u = ORD[x * 128 + qi]; moba_unit(F, u >> 8, (u >> 5) & 7, u & 31, tcut); } }
                  { unsigned* cw = (unsigned*)(F.ws + WS_CTL) + CW_QCVT0;
                      for (;;) { if (((int)threadIdx.x) == 0) MISCW[0] = atomicAdd(cw, 1u); __syncthreads(); const unsigned ci = MISCW[0]; __syncthreads(); if (ci >= 512u) break; i8_chunk(F, args, 0, (int)ci); } } }
            } SEAM(4);
            if (IN(5)) { for (int u = F.bid; u < 1024; u += F.G) mlstm_c_unit(F, args, u); } SEAM(5);
        } else {
            if (IN(pb + 4)) {
                const float* lp = args.in[17];
                const float lam = __expf(wave_sum(lp[((int)(threadIdx.x & 63u))] * lp[64 + ((int)(threadIdx.x & 63u))])) - __expf(wave_sum(lp[128 + ((int)(threadIdx.x & 63u))] * lp[192 + ((int)(threadIdx.x & 63u))])) + 0.35550906759096926f;
                { const float tcut = alibi_tcut(args.in[15], args.in[16], ((int)(threadIdx.x & 63u)));
                  const unsigned short* ORD = WSP(unsigned short, WS_ORD); unsigned* qw = (unsigned*)(F.ws + WS_CTL) + CW_QDIFF;
                  for (int xi = 0; xi < 8; ++xi) { const int x = (F.bid + xi) & 7;
                      for (;;) { if (((int)threadIdx.x) == 0) MISCW[0] = atomicAdd(qw + 16 * x, 1u); __syncthreads(); const unsigned qi = MISCW[0]; __syncthreads(); if (qi >= 256u) break;
                          const int u = ORD[x * 256 + qi]; diff_unit(F, args, u >> 9, (u >> 6) & 7, u & 63, lam, tcut); } }
                  { unsigned* cw = (unsigned*)(F.ws + WS_CTL) + CW_QCVT1;
                      for (;;) { if (((int)threadIdx.x) == 0) MISCW[0] = atomicAdd(cw, 1u); __syncthreads(); const unsigned ci = MISCW[0]; __syncthreads(); if (ci >= 512u) break; i8_chunk(F, args, 1, (int)ci); } } }
            } SEAM(pb + 4);
        }
        if (IN(pb + 6)) {
            pg8::Gemm g{XNY, layer == 0 ? WSP(bf16, WS_WOUT0) : WSP(bf16, WS_WOUT1), M, D, D}; pg8::StaticOrder S; S.init(M, D, F.G, F.bid);
            if (layer == 0) { pg8::EpiResid<false> E{args.in[0], WSP(bf16, WS_XS), mod + 2 * 1024}; pg8::gemm_phase<pg8::EpiResid<false>, pg8::StaticOrder, true, true>(F.lds, g, S, E); }
            else { pg8::EpiResid<true> E{WSP(bf16, WS_XS), WSP(bf16, WS_XS), mod + 2 * 1024}; pg8::gemm_phase<pg8::EpiResid<true>, pg8::StaticOrder, true, true>(F.lds, g, S, E); }
        } SEAM(pb + 6);
        if (IN(pb + 7)) { norm_pass<false, true>(F, args, WSP(bf16, WS_XS), args.in[5] + layer * 1024, mod, 3, XNY); } SEAM(pb + 7);
        if (IN(pb + 8)) {
            pg8::Gemm g{XNY, WSP(bf16, WS_WQ) + (size_t)layer * NQ * D, M, NQ, D}; pg8::StaticOrder S; S.init(M, NQ, F.G, F.bid);
            pg8::EpiBf16 E{WSP(bf16, WS_QRY), NQ};
            pg8::gemm_phase<pg8::EpiBf16, pg8::StaticOrder, true, true>(F.lds, g, S, E);
        } SEAM(pb + 8);
        if (IN(pb + 9)) { const bf16* KEYS = WSP(bf16, WS_KEYS) + (size_t)layer * 2 * 128 * 128;
            bf16x8 kf[4][2];
#pragma unroll
            for (int ks = 0; ks < 4; ++ks)
#pragma unroll
                for (int n = 0; n < 2; ++n) kf[ks][n] = *(const GAS bf16x8*)(KEYS + (size_t)((F.wave & 1) * 128 + 32 * (F.wave >> 1) + 16 * n + (((int)(threadIdx.x & 63u)) & 15)) * 128 + 32 * ks + 8 * (((int)(threadIdx.x & 63u)) >> 4));
            for (int u = F.bid; u < 2048; u += F.G) peer_route_unit(F, (u >> 3) * 128, u & 7, kf); xcd_barrier(bar); peer_sort_phase(F); } SEAM(pb + 9);
        if (IN(pb + 10)) { peer_u_sorted(F, F.ws + WS_UB + (size_t)layer * 8 * 16384 * 128); } SEAM(pb + 10);
        if (IN(pb + 11)) { peer_reduce_phase(F); xcd_barrier(bar); peer_act_phase(F, WSP(float, WS_ISU) + layer * 16384, WSP(float, WS_ISV) + layer * 16384); } SEAM(pb + 11);
        if (IN(pb + 12)) { peer_v_phase<layer == 1>(F, F.ws + WS_VB + (size_t)layer * 8 * 16384 * 128, mod + 5 * 1024); }
        if (layer == 0) SEAM(12);
    }
__global__ void __launch_bounds__(NTHR, 2) mega_fwd(Args args) {
    extern __shared__ __attribute__((aligned(16))) unsigned char lds_raw[];
    Frame F;
    F.lds = (LAS unsigned char*)lds_raw;
    F.wave = __builtin_amdgcn_readfirstlane((int)threadIdx.x >> 6);
    F.G = gridDim.x; F.bid = blockIdx.x;
    F.out = args.out; F.ws = args.ws;
    volatile LAS unsigned* MISC = (volatile LAS unsigned*)(F.lds + MISC_OFF);
    for (int u = ((int)threadIdx.x); u < (LDS_BYTES - LDSCTL_OFF) / 4; u += NTHR) ((LAS unsigned*)(F.lds + LDSCTL_OFF))[u] = 0u;
    __syncthreads();
    XcdBarrier bar; bar.bar = (unsigned*)(F.ws + WS_CTL) + CW_BAR; bar.x = 0; bar.st = nullptr;
    if (!MK_PER_PHASE) bar = xcd_barrier_post((unsigned*)(F.ws + WS_CTL) + CW_BAR, MISC + 8);
    const int lo = args.ph_lo, hi = args.ph_hi;

#ifdef EXTRA_BAR
    for (int i = 0; i < EXTRA_BAR; ++i) xcd_barrier(bar);
#endif
    if (IN(0)) { p0_prologue(F, args); } SEAM(0);
    layer_phases<0>(F, args, bar, lo, hi);
    layer_phases<1>(F, args, bar, lo, hi);
}
#undef IN
#undef SEAM

extern "C" void kernel_launch(void* const* d_in, const int* in_sizes, int n_in, void* d_out, int out_size, void* d_ws, size_t ws_size, hipStream_t stream) {
    static int grid = 0;
    if (grid == 0) {
        if (n_in != 24 || in_sizes[0] != M * D || out_size != M * D || ws_size < WS_END) { fprintf(stderr, "kernel_launch: unexpected problem (n_in %d, in0 %d, out %d, ws %zu < %zu); nothing launched\n", n_in, n_in > 0 ? in_sizes[0] : -1, out_size, ws_size, (size_t)WS_END); grid = -1; return; }
        int dev = 0, cus = 0, per_cu = 0;
        if (hipGetDevice(&dev) != hipSuccess || hipDeviceGetAttribute(&cus, hipDeviceAttributeMultiprocessorCount, dev) != hipSuccess) { grid = -1; return; }
        if (hipFuncSetAttribute((const void*)mega_fwd, hipFuncAttributeMaxDynamicSharedMemorySize, LDS_BYTES) != hipSuccess) { fprintf(stderr, "kernel_launch: hipFuncSetAttribute failed\n"); grid = -1; return; }
        if (hipOccupancyMaxActiveBlocksPerMultiprocessor(&per_cu, (const void*)mega_fwd, NTHR, LDS_BYTES) != hipSuccess || per_cu < 1)
            fprintf(stderr, "kernel_launch: note: occupancy query reports %d workgroups per CU\n", per_cu);
        (void)hipGetLastError();
        grid = cus;
    }
    if (grid < 0) return;
    if (hipMemsetAsync((char*)d_ws + WS_CTL, 0, CTL_ZERO_BYTES, stream) != hipSuccess) { fprintf(stderr, "kernel_launch: memset failed\n"); return; }
    Args a{};
    for (int i = 0; i < 24; ++i) a.in[i] = (const float*)d_in[i];
    a.out = (float*)d_out; a.ws = (unsigned char*)d_ws;
#if MK_PER_PHASE
    for (int p = 0; p < NPHASE + 1; ++p) { a.ph_lo = p; a.ph_hi = p + 1; hipLaunchKernelGGL(mega_fwd, dim3(grid), dim3(NTHR), LDS_BYTES, stream, a); }
#else
#ifdef MK_PROBE_HI
    a.ph_lo = 0; a.ph_hi = MK_PROBE_HI;
    hipLaunchKernelGGL(mega_fwd, dim3(grid), dim3(NTHR), LDS_BYTES, stream, a);
    if (hipMemsetAsync((char*)d_ws + WS_CTL, 0, CTL_ZERO_BYTES, stream) != hipSuccess) return;
#endif
    a.ph_lo = 0; a.ph_hi = NPHASE + 1;
    hipLaunchKernelGGL(mega_fwd, dim3(grid), dim3(NTHR), LDS_BYTES, stream, a);
#endif
    const hipError_t le = hipPeekAtLastError();
    if (le != hipSuccess) fprintf(stderr, "kernel_launch: launch failed: %s\n", hipGetErrorName(le));
}
```

```cpp
#include <hip/hip_runtime.h>
#include <cstdio>
#include <cstdint>
namespace pg8 {
#define PG8_LAS __attribute__((address_space(3)))
typedef unsigned short bf16_t;
typedef short bf16x8 __attribute__((ext_vector_type(8)));
typedef float f32x4 __attribute__((ext_vector_type(4)));
typedef unsigned u32x4 __attribute__((ext_vector_type(4)));
constexpr int BM = 256, BK = 64, HALF = 128, HTB = HALF * BK * 2  , STAGE_BYTES = 8 * HTB, NXCD = 8, WGM = 8;

__host__ __device__ __forceinline__ int lds_byte(int r, int c) { const int st = (r >> 4) * 2 + (c >> 5), rr = r & 15, cc = c & 31, ob = rr * 64 + cc * 2; return st * 1024 + (ob ^ (((ob >> 9) & 1) << 5)); }
__host__ __device__ __forceinline__ void stage_rc(int b, int& R, int& C) { const int st = b / 1024, sb = b % 1024, swz = sb ^ (((sb >> 9) & 1) << 5); R = (st >> 1) * 16 + swz / 64; C = (st & 1) * 32 + (swz % 64) / 2; }
__host__ __device__ __forceinline__ int perm32(int rho) { const int n = rho >> 4, i = rho & 15; return 8 * (i >> 2) + 4 * n + (i & 3); }

struct Unit { int pm, pn; };
struct Gemm { const bf16_t* A; const bf16_t* Bt; int M, N, K; size_t bstride; };

struct StaticOrder {
    int nM, nN, nwg, G, c;
    __host__ __device__ void init(int M, int N, int G_, int c_) { nM = M / BM; nN = N / BM; nwg = nM * nN; G = G_; c = c_; }
    __host__ __device__ bool next(int i, Unit& u) const {
        const long L = (long)i * G + c; if (L >= nwg) return false;
        int wgid = (int)L; { const int q = nwg / NXCD, r = nwg % NXCD, xcd = wgid % NXCD, off = wgid / NXCD; wgid = (xcd < r ? xcd * (q + 1) : r * (q + 1) + (xcd - r) * q) + off; }
        const int nig = WGM * nN, gid = wgid / nig, fm = gid * WGM, gsz = (nM - fm) < WGM ? (nM - fm) : WGM;
        u.pm = fm + ((wgid % nig) % gsz); u.pn = (wgid % nig) / gsz; return true;
    }
    __device__ __forceinline__ void a_ready(const Unit&) const {}
    __device__ __forceinline__ void done(const Unit&) const {}
};

__device__ __forceinline__ unsigned cvt_pk_bf16(float lo, float hi) { unsigned r; asm volatile("v_cvt_pk_bf16_f32 %0, %1, %2" : "=v"(r) : "v"(lo), "v"(hi)); return r; }
typedef unsigned u32x4 __attribute__((ext_vector_type(4)));
struct EpiBf16 {
    static constexpr bool PERM = true, AFTER_DRAIN = false;
    bf16_t* O; int ldc;
    __device__ __forceinline__ void operator()(const f32x4 (&acc)[2][2][4][2], const Unit& u, int wr, int wc, int fr, int fq) const {
        const int row0 = u.pm * BM + wr * 64 + fr; const int col0 = u.pn * BM + wc * 64 + 8 * fq;
#pragma unroll
        for (int ai = 0; ai < 2; ++ai)
#pragma unroll
            for (int m = 0; m < 4; ++m) { bf16_t* rowp = O + (size_t)(row0 + ai * HALF + m * 16) * ldc + col0;
#pragma unroll
                for (int bj = 0; bj < 2; ++bj) { const f32x4 v0 = acc[ai][bj][m][0], v1 = acc[ai][bj][m][1];
                    u32x4 w; w.x = cvt_pk_bf16(v0[0], v0[1]); w.y = cvt_pk_bf16(v0[2], v0[3]); w.z = cvt_pk_bf16(v1[0], v1[1]); w.w = cvt_pk_bf16(v1[2], v1[3]);
                    *(u32x4*)(rowp + bj * 32) = w; } }
    }
};
struct EpiBf16QK {
    static constexpr bool PERM = true, AFTER_DRAIN = false;
    bf16_t* O; int ldc; int q_lo, q_hi, k_lo, k_hi; const float* gq; const float* gk; float qmul; PG8_LAS float* xs;
    __device__ __forceinline__ void operator()(const f32x4 (&acc)[2][2][4][2], const Unit& u, int wr, int wc, int fr, int fq) const {
        const int row0 = u.pm * BM + wr * 64 + fr; const int col0 = u.pn * BM + wc * 64 + 8 * fq;
        const bool isq = u.pn >= q_lo && u.pn < q_hi, isk = u.pn >= k_lo && u.pn < k_hi;
        if (!(isq || isk)) {
#pragma unroll
            for (int ai = 0; ai < 2; ++ai)
#pragma unroll
                for (int m = 0; m < 4; ++m) { bf16_t* rowp = O + (size_t)(row0 + ai * HALF + m * 16) * ldc + col0;
#pragma unroll
                    for (int bj = 0; bj < 2; ++bj) { const f32x4 v0 = acc[ai][bj][m][0], v1 = acc[ai][bj][m][1];
                        u32x4 w; w.x = cvt_pk_bf16(v0[0], v0[1]); w.y = cvt_pk_bf16(v0[2], v0[3]); w.z = cvt_pk_bf16(v1[0], v1[1]); w.w = cvt_pk_bf16(v1[2], v1[3]);
                        *(u32x4*)(rowp + bj * 32) = w; } }
            return;
        }
        const float* g = isq ? gq : gk; const float gm = isq ? qmul : 1.f;
        f32x4 gg[2][2];
#pragma unroll
        for (int bj = 0; bj < 2; ++bj) { gg[bj][0] = *(const f32x4*)(g + bj * 32 + 8 * fq) * gm; gg[bj][1] = *(const f32x4*)(g + bj * 32 + 8 * fq + 4) * gm; }
#pragma unroll
        for (int ai = 0; ai < 2; ++ai)
#pragma unroll
            for (int m = 0; m < 4; ++m) { bf16_t* rowp = O + (size_t)(row0 + ai * HALF + m * 16) * ldc + col0;
                float s = 0.f;
#pragma unroll
                for (int bj = 0; bj < 2; ++bj) { const f32x4 v0 = acc[ai][bj][m][0], v1 = acc[ai][bj][m][1];
                    s += (v0[0] * v0[0] + v0[1] * v0[1]) + (v0[2] * v0[2] + v0[3] * v0[3]) + (v1[0] * v1[0] + v1[1] * v1[1]) + (v1[2] * v1[2] + v1[3] * v1[3]); }
                s += __shfl_xor(s, 16); s += __shfl_xor(s, 32);
                const float rs = __builtin_amdgcn_rsqf(s * (1.f / 64.f) + 1e-6f);
#pragma unroll
                for (int bj = 0; bj < 2; ++bj) {
                    const f32x4 v0 = acc[ai][bj][m][0] * rs * gg[bj][0], v1 = acc[ai][bj][m][1] * rs * gg[bj][1];
                    u32x4 w; w.x = cvt_pk_bf16(v0[0], v0[1]); w.y = cvt_pk_bf16(v0[2], v0[3]); w.z = cvt_pk_bf16(v1[0], v1[1]); w.w = cvt_pk_bf16(v1[2], v1[3]);
                    *(u32x4*)(rowp + bj * 32) = w; } }
    }
};
struct EpiBf16RS {
    static constexpr bool PERM = true, AFTER_DRAIN = false;
    bf16_t* O; int ldc; const float* rss; const float* bias; int bias_stride;
    __device__ __forceinline__ void operator()(const f32x4 (&acc)[2][2][4][2], const Unit& u, int wr, int wc, int fr, int fq) const {
        const int row0 = u.pm * BM + wr * 64 + fr; const int col0 = u.pn * BM + wc * 64 + 8 * fq; const int b = (u.pm * BM) >> 13;
        f32x4 bv[2][2];
#pragma unroll
        for (int bj = 0; bj < 2; ++bj)
#pragma unroll
            for (int n = 0; n < 2; ++n) bv[bj][n] = *(const f32x4*)(bias + (size_t)b * bias_stride + col0 + bj * 32 + 4 * n);
#pragma unroll
        for (int ai = 0; ai < 2; ++ai)
#pragma unroll
            for (int m = 0; m < 4; ++m) { const int row = row0 + ai * HALF + m * 16; bf16_t* rowp = O + (size_t)row * ldc + col0;
                const f32x4 p0 = *(const f32x4*)(rss + (size_t)row * 16), p1 = *(const f32x4*)(rss + (size_t)row * 16 + 4), p2 = *(const f32x4*)(rss + (size_t)row * 16 + 8), p3 = *(const f32x4*)(rss + (size_t)row * 16 + 12);
                const f32x4 pt = (p0 + p1) + (p2 + p3);
                const float rs = __builtin_amdgcn_rsqf(((pt[0] + pt[1]) + (pt[2] + pt[3])) * (1.f / 1024.f) + 1e-6f);
#pragma unroll
                for (int bj = 0; bj < 2; ++bj) { const f32x4 v0 = acc[ai][bj][m][0] * rs + bv[bj][0], v1 = acc[ai][bj][m][1] * rs + bv[bj][1];
                    u32x4 w; w.x = cvt_pk_bf16(v0[0], v0[1]); w.y = cvt_pk_bf16(v0[2], v0[3]); w.z = cvt_pk_bf16(v1[0], v1[1]); w.w = cvt_pk_bf16(v1[2], v1[3]);
                    *(u32x4*)(rowp + bj * 32) = w; } }
    }
};
template <bool BASE_BF16> struct EpiResid {
    static constexpr bool PERM = true, AFTER_DRAIN = false;
    const void* base; bf16_t* out; const float* gate;
    __device__ __forceinline__ void operator()(const f32x4 (&acc)[2][2][4][2], const Unit& u, int wr, int wc, int fr, int fq) const {
        const int row0 = u.pm * BM + wr * 64 + fr; const int col0 = u.pn * BM + wc * 64 + 8 * fq; const int b = (u.pm * BM) >> 13;
        f32x4 gv[2][2];
#pragma unroll
        for (int bj = 0; bj < 2; ++bj)
#pragma unroll
            for (int n = 0; n < 2; ++n) gv[bj][n] = *(const f32x4*)(gate + (size_t)b * 6144 + col0 + bj * 32 + 4 * n);
#pragma unroll
        for (int ai = 0; ai < 2; ++ai)
#pragma unroll
            for (int m = 0; m < 4; ++m)
#pragma unroll
                for (int bj = 0; bj < 2; ++bj) { const size_t off = (size_t)(row0 + ai * HALF + m * 16) * 1024 + col0 + bj * 32;
                    f32x4 b0, b1;
                    if (BASE_BF16) { const u32x4 w = *(const u32x4*)((const bf16_t*)base + off); const unsigned w0 = w.x, w1 = w.y, w2 = w.z, w3 = w.w;
                        b0 = (f32x4){__builtin_bit_cast(float, w0 << 16), __builtin_bit_cast(float, w0 & 0xffff0000u), __builtin_bit_cast(float, w1 << 16), __builtin_bit_cast(float, w1 & 0xffff0000u)};
                        b1 = (f32x4){__builtin_bit_cast(float, w2 << 16), __builtin_bit_cast(float, w2 & 0xffff0000u), __builtin_bit_cast(float, w3 << 16), __builtin_bit_cast(float, w3 & 0xffff0000u)}; }
                    else { b0 = *(const f32x4*)((const float*)base + off); b1 = *(const f32x4*)((const float*)base + off + 4); }
                    const f32x4 o0 = b0 + gv[bj][0] * acc[ai][bj][m][0], o1 = b1 + gv[bj][1] * acc[ai][bj][m][1];
                    u32x4 ow; ow.x = cvt_pk_bf16(o0[0], o0[1]); ow.y = cvt_pk_bf16(o0[2], o0[3]); ow.z = cvt_pk_bf16(o1[0], o1[1]); ow.w = cvt_pk_bf16(o1[2], o1[3]);
                    *(u32x4*)(out + off) = ow; }
    }
};

template <class Epi, class Sched, bool ALIGN_EPI = false, bool SP2 = false>
__device__ __forceinline__ void gemm_phase(PG8_LAS unsigned char* lds, const Gemm g, const Sched& S, const Epi& E) {
    const int tid = threadIdx.x, wid = __builtin_amdgcn_readfirstlane(tid >> 6), lane = tid & 63, wr = wid >> 2, wc = wid & 3, fr = lane & 15, fq = lane >> 4;
    const int K = g.K, nt = K / BK;
    unsigned voffA[2], voffB[2];
#pragma unroll
    for (int i = 0; i < 2; ++i) { int R, C; stage_rc(tid * 16 + i * 8192, R, C); const int Rb = (R >> 5) * 64 + (Epi::PERM ? perm32(R & 31) : (R & 31));
        voffA[i] = (unsigned)(R * K + C) * 2u; voffB[i] = (unsigned)(Rb * K + C) * 2u; }
    const size_t kstep = (size_t)(BK * 2);
    const size_t hstep = (size_t)HALF * K * 2;
    const size_t hstepB = (size_t)32 * K * 2;
    const size_t tstep = 2 * hstep;
    const unsigned ldsw = (unsigned)wid * 1024u;
    const int aoff = lds_byte(wr * 64 + fr, fq * 8), boff = lds_byte(wc * 32 + fr, fq * 8);
#define PG8_SA(b, h) (((b) * 2 + (h)) * HTB)
#define PG8_SB(b, h) ((4 + (b) * 2 + (h)) * HTB)
#define PG8_STAGE(bufoff, gbase, voff) do { _Pragma("unroll") for (int _i = 0; _i < 2; ++_i) \
        __builtin_amdgcn_global_load_lds((const unsigned*)((const char*)(gbase) + (voff)[_i]), (PG8_LAS unsigned*)(lds + (bufoff) + ldsw + _i * 8192), 16, 0, 0); } while (0)
#define PG8_LDA(dst, b, h) do { _Pragma("unroll") for (int m = 0; m < 4; ++m) _Pragma("unroll") for (int k = 0; k < 2; ++k) dst[m][k] = *(const PG8_LAS bf16x8*)(lds + PG8_SA(b, h) + aoff + m * 2048 + k * 1024); } while (0)
#define PG8_LDB(dst, b, h) do { _Pragma("unroll") for (int n = 0; n < 2; ++n) _Pragma("unroll") for (int k = 0; k < 2; ++k) dst[n][k] = *(const PG8_LAS bf16x8*)(lds + PG8_SB(b, h) + boff + n * 2048 + k * 1024); } while (0)
#define PG8_MMA(ai, bj, At, Bt) do { __builtin_amdgcn_s_setprio(1); _Pragma("unroll") for (int m = 0; m < 4; ++m) _Pragma("unroll") for (int n = 0; n < 2; ++n) _Pragma("unroll") for (int k = 0; k < 2; ++k) \
        acc[ai][bj][m][n] = __builtin_amdgcn_mfma_f32_16x16x32_bf16(Bt[n][k], At[m][k], acc[ai][bj][m][n], 0, 0, 0); __builtin_amdgcn_s_setprio(0); } while (0)
#define PG8_WAIT_V(n) asm volatile("s_waitcnt vmcnt(" #n ")" ::: "memory")
#define PG8_WAIT_L(n) asm volatile("s_waitcnt lgkmcnt(" #n ")" ::: "memory")
#define PG8_BAR __builtin_amdgcn_s_barrier()
#define PG8_SCHED __builtin_amdgcn_sched_barrier(0)
    Unit cur, nxt; int ui = 0;
    if (!S.next(0, cur)) return;
    f32x4 acc[2][2][4][2];
#pragma unroll
    for (int a = 0; a < 2; ++a)
#pragma unroll
        for (int b = 0; b < 2; ++b)
#pragma unroll
            for (int m = 0; m < 4; ++m)
#pragma unroll
                for (int n = 0; n < 2; ++n) acc[a][b][m][n] = (f32x4){0.f, 0.f, 0.f, 0.f};
    bf16x8 At[4][2], B0[2][2], B1[2][2];
    const char* cA = (const char*)g.A + (size_t)cur.pm * tstep; const char* cB = (const char*)g.Bt + (size_t)(cur.pm >> 5) * g.bstride + (size_t)cur.pn * tstep;
    S.a_ready(cur);
    if constexpr (SP2) {
        PG8_STAGE(PG8_SB(0, 0), cB, voffB); PG8_STAGE(PG8_SB(0, 1), cB + hstepB, voffB); PG8_STAGE(PG8_SA(0, 0), cA, voffA); PG8_STAGE(PG8_SA(0, 1), cA + hstep, voffA);
        if (wr == 1) PG8_BAR;
        PG8_WAIT_V(2); PG8_BAR;
        PG8_STAGE(PG8_SB(1, 0), cB + kstep, voffB); PG8_STAGE(PG8_SA(1, 0), cA + kstep, voffA); PG8_STAGE(PG8_SB(1, 1), cB + hstepB + kstep, voffB);
        PG8_WAIT_V(6); PG8_BAR;
    } else {
        PG8_STAGE(PG8_SB(0, 0), cB, voffB); PG8_STAGE(PG8_SA(0, 0), cA, voffA); PG8_STAGE(PG8_SB(0, 1), cB + hstepB, voffB); PG8_STAGE(PG8_SA(0, 1), cA + hstep, voffA);
        if (wr == 1) PG8_BAR;
        PG8_WAIT_V(4); PG8_BAR;
        PG8_STAGE(PG8_SB(1, 0), cB + kstep, voffB); PG8_STAGE(PG8_SA(1, 0), cA + kstep, voffA); PG8_STAGE(PG8_SB(1, 1), cB + hstepB + kstep, voffB);
        PG8_WAIT_V(6); PG8_BAR;
    }
    for (;;) {
        const bool has_next = S.next(ui + 1, nxt);
        const char* nA = has_next ? (const char*)g.A + (size_t)nxt.pm * tstep : cA; const char* nB = has_next ? (const char*)g.Bt + (size_t)(nxt.pm >> 5) * g.bstride + (size_t)nxt.pn * tstep : cB;
        for (int t = 0; t < nt; t += 2) {
            const bool last = (t == nt - 2);
            const char* a1 = cA + (size_t)(t + 1) * kstep;
            const char* a2 = last ? nA : cA + (size_t)(t + 2) * kstep; const char* b2 = last ? nB : cB + (size_t)(t + 2) * kstep;
            const char* a3 = a2 + kstep; const char* b3 = b2 + kstep;
            if (last && has_next) S.a_ready(nxt);
            if constexpr (SP2) {
            PG8_LDB(B0, 0, 0); PG8_LDB(B1, 0, 1); PG8_SCHED; PG8_LDA(At, 0, 0); PG8_STAGE(PG8_SA(1, 1), a1 + hstep, voffA);
            PG8_WAIT_V(8); PG8_WAIT_L(0); PG8_BAR; PG8_MMA(0, 0, At, B0); PG8_MMA(0, 1, At, B1); PG8_BAR; PG8_SCHED;
            PG8_LDA(At, 0, 1); PG8_STAGE(PG8_SB(0, 0), b2, voffB); PG8_STAGE(PG8_SB(0, 1), b2 + hstepB, voffB); PG8_STAGE(PG8_SA(0, 0), a2, voffA);
            PG8_WAIT_V(8); PG8_WAIT_L(0); PG8_BAR; PG8_MMA(1, 0, At, B0); PG8_MMA(1, 1, At, B1); PG8_BAR; PG8_SCHED;
            PG8_LDB(B0, 1, 0); PG8_LDB(B1, 1, 1); PG8_SCHED; PG8_LDA(At, 1, 0); PG8_STAGE(PG8_SA(0, 1), a2 + hstep, voffA);
            PG8_WAIT_V(8); PG8_WAIT_L(0); PG8_BAR; PG8_MMA(0, 0, At, B0); PG8_MMA(0, 1, At, B1); PG8_BAR; PG8_SCHED;
            PG8_LDA(At, 1, 1); PG8_STAGE(PG8_SB(1, 0), b3, voffB); PG8_STAGE(PG8_SB(1, 1), b3 + hstepB, voffB); PG8_STAGE(PG8_SA(1, 0), a3, voffA);
            PG8_WAIT_V(8); PG8_WAIT_L(0); PG8_BAR; PG8_MMA(1, 0, At, B0); PG8_MMA(1, 1, At, B1); PG8_BAR; PG8_SCHED;
            } else {
            PG8_LDB(B0, 0, 0); PG8_SCHED; PG8_LDA(At, 0, 0); PG8_STAGE(PG8_SA(1, 1), a1 + hstep, voffA);
            PG8_WAIT_L(8); PG8_BAR; PG8_WAIT_L(0); PG8_MMA(0, 0, At, B0); PG8_BAR; PG8_SCHED;
            PG8_LDB(B1, 0, 1); PG8_STAGE(PG8_SB(0, 0), b2, voffB);
            PG8_BAR; PG8_WAIT_L(0); PG8_MMA(0, 1, At, B1); PG8_BAR;
            PG8_LDA(At, 0, 1); PG8_STAGE(PG8_SA(0, 0), a2, voffA);
            PG8_BAR; PG8_WAIT_L(0); PG8_MMA(1, 0, At, B0); PG8_BAR; PG8_SCHED;
            PG8_STAGE(PG8_SB(0, 1), b2 + hstepB, voffB);
            PG8_WAIT_V(6); PG8_BAR; PG8_MMA(1, 1, At, B1); PG8_BAR;
            PG8_LDB(B0, 1, 0); PG8_SCHED; PG8_LDA(At, 1, 0); PG8_STAGE(PG8_SA(0, 1), a2 + hstep, voffA);
            PG8_WAIT_L(8); PG8_BAR; PG8_WAIT_L(0); PG8_MMA(0, 0, At, B0); PG8_BAR; PG8_SCHED;
            PG8_LDB(B1, 1, 1); PG8_STAGE(PG8_SB(1, 0), b3, voffB);
            PG8_BAR; PG8_WAIT_L(0); PG8_MMA(0, 1, At, B1); PG8_BAR;
            PG8_LDA(At, 1, 1); PG8_STAGE(PG8_SA(1, 0), a3, voffA);
            PG8_BAR; PG8_WAIT_L(0); PG8_MMA(1, 0, At, B0); PG8_BAR; PG8_SCHED;
            PG8_STAGE(PG8_SB(1, 1), b3 + hstepB, voffB);
            PG8_WAIT_V(6); PG8_BAR; PG8_MMA(1, 1, At, B1); PG8_BAR;
            }
        }
        if constexpr (ALIGN_EPI) { if (wr == 0) PG8_BAR; }
        if constexpr (!Epi::AFTER_DRAIN) { E(acc, cur, wr, wc, fr, fq); S.done(cur); }
        if (!has_next) break;
#pragma unroll
        for (int a = 0; a < 2; ++a)
#pragma unroll
            for (int b = 0; b < 2; ++b)
#pragma unroll
                for (int m = 0; m < 4; ++m)
#pragma unroll
                    for (int n = 0; n < 2; ++n) acc[a][b][m][n] = (f32x4){0.f, 0.f, 0.f, 0.f};
        cur = nxt; cA = nA; cB = nB; ++ui;
        if constexpr (ALIGN_EPI) { if (wr == 1) PG8_BAR; }
    }
    PG8_WAIT_V(0);
    if constexpr (!ALIGN_EPI) { if (wr == 0) PG8_BAR; }
    PG8_BAR;
    if constexpr (Epi::AFTER_DRAIN) { E.fused(acc, cur, wr, wc, fr, fq, lds, wid, lane); S.done(cur); }
#undef PG8_SA
#undef PG8_SB
#undef PG8_STAGE
#undef PG8_LDA
#undef PG8_LDB
#undef PG8_MMA
#undef PG8_WAIT_V
#undef PG8_WAIT_L
#undef PG8_BAR
#undef PG8_SCHED
}
}
constexpr int NB = 4, SEQ = 8192, D = 1024, M = NB * SEQ;
constexpr int NZ0 = 3584, NZ1 = 3072, NQ = 2048, SRC_IN0 = 3592;
constexpr int QLD = NQ + 64;
constexpr float EPS = 1e-6f;
constexpr int NWAVES = 8, NTHR = 512;
constexpr float LOG2E = 1.4426950408889634f;
constexpr size_t MiB = 1u << 20;
constexpr size_t WS_CTL = 0, CTL_ZERO_BYTES = 1 * MiB;
constexpr size_t WS_WIN0 = 1 * MiB, WS_WOUT0 = 8 * MiB, WS_WIN1 = 10 * MiB, WS_WOUT1 = 16 * MiB, WS_WQ = 18 * MiB;
constexpr size_t WS_KEYS = 26 * MiB, WS_MOD = WS_KEYS + 128 * 1024, WS_KMEAN = WS_MOD + 192 * 1024, WS_NLOC = WS_KMEAN + 256 * 1024,
                 WS_BEND = WS_NLOC + 512 * 1024, WS_MLOC = WS_BEND + 4096, WS_MPREV = WS_MLOC + 4096,
                 WS_ISU = 27 * MiB + 512 * 1024, WS_ISV = WS_ISU + 128 * 1024, WS_ORD = WS_ISV + 128 * 1024  ;
constexpr size_t WS_GATES = 28 * MiB;
constexpr size_t WS_UB = 32 * MiB  , WS_VB = 64 * MiB, WS_ACT = 96 * MiB  , WS_ACTS = 100 * MiB  , WS_XNY = 160 * MiB, WS_Z = 224 * MiB, WS_CLOC = 448 * MiB, WS_END = 512 * MiB;
constexpr size_t WS_LIST = WS_Z + 160 * MiB  , WS_DTOK = WS_Z + 176 * MiB  ;
constexpr size_t WS_QRY = WS_Z, WS_IDX = WS_Z + 136 * MiB  , WS_GATE = WS_Z + 144 * MiB, WS_PART = WS_Z  , WS_XS = 448 * MiB  ;
constexpr int CW_BAR = 4096, CW_QMOBA = 8192  , CW_QDIFF = 8448, CW_QCVT0 = 8704, CW_QCVT1 = 8768;
constexpr float ALIBI_MARGIN = 27.03f;
constexpr int RING_BYTES = 139264;
constexpr int LDSCTL_OFF = RING_BYTES, MISC_OFF = LDSCTL_OFF + 320;
constexpr int LDS_BYTES = 147456;
static_assert(MISC_OFF + 128 <= LDS_BYTES, "LDS map");

#define GAS __attribute__((address_space(1)))
#define LAS __attribute__((address_space(3)))
typedef unsigned short bf16;
typedef unsigned v4u __attribute__((ext_vector_type(4)));
typedef unsigned v2u __attribute__((ext_vector_type(2)));
typedef float f32x4 __attribute__((ext_vector_type(4)));
typedef float f32x16 __attribute__((ext_vector_type(16)));
typedef short bf16x8 __attribute__((ext_vector_type(8)));
typedef short s16x4 __attribute__((ext_vector_type(4)));
typedef GAS unsigned gu32;
#define RLX_AGENT __ATOMIC_RELAXED, __HIP_MEMORY_SCOPE_AGENT
#define LDS_WAIT() asm volatile("s_waitcnt lgkmcnt(0)" ::: "memory")
#define VM_WAIT() asm volatile("s_waitcnt vmcnt(0)" ::: "memory")
__device__ __forceinline__ unsigned f2bf(float f) { unsigned u = __builtin_bit_cast(unsigned, f); return (u + 0x7fffu + ((u >> 16) & 1u)) >> 16; }
__device__ __forceinline__ unsigned pk2(float lo, float hi) { return f2bf(lo) | (f2bf(hi) << 16); }
__device__ __forceinline__ float bflo(unsigned w) { return __builtin_bit_cast(float, w << 16); }
__device__ __forceinline__ float bfhi(unsigned w) { return __builtin_bit_cast(float, w & 0xffff0000u); }
__device__ __forceinline__ float bf2f(bf16 h) { return __builtin_bit_cast(float, (unsigned)h << 16); }
__device__ __forceinline__ unsigned f2u(float x) { return __builtin_bit_cast(unsigned, x); }
__device__ __forceinline__ float u2f(unsigned x) { return __builtin_bit_cast(float, x); }
__device__ __forceinline__ float dot2bf(unsigned a, unsigned b, float acc) { typedef __bf16 bf2_ __attribute__((ext_vector_type(2))); return __builtin_amdgcn_fdot2_f32_bf16(__builtin_bit_cast(bf2_, a), __builtin_bit_cast(bf2_, b), acc, false); }
__device__ __forceinline__ unsigned f2h2(float lo, float hi) { typedef _Float16 h2_ __attribute__((ext_vector_type(2))); typedef float f2_ __attribute__((ext_vector_type(2))); f2_ v = {lo, hi}; h2_ h = __builtin_convertvector(v, h2_); return __builtin_bit_cast(unsigned, h); }
__device__ __forceinline__ float h2f_lo(unsigned w) { return (float)__builtin_bit_cast(_Float16, (unsigned short)(w & 0xffffu)); }
__device__ __forceinline__ float h2f_hi(unsigned w) { return (float)__builtin_bit_cast(_Float16, (unsigned short)(w >> 16)); }
__device__ __forceinline__ float wave_sum(float v) {
#pragma unroll
    for (int o = 1; o < 64; o <<= 1) v += __shfl_xor(v, o);
    return v;
}
__device__ __forceinline__ float wave_max(float v) {
#pragma unroll
    for (int o = 1; o < 64; o <<= 1) v = fmaxf(v, __shfl_xor(v, o));
    return v;
}
__device__ __forceinline__ float silu_f(float x) { return x / (1.f + __expf(-x)); }
__device__ __forceinline__ float sigmoid_f(float x) { return 1.f / (1.f + __expf(-x)); }
__device__ __forceinline__ float logsigmoid_f(float x) { return fminf(x, 0.f) - log1pf(__expf(-fabsf(x))); }
struct Args { const float* in[24]; float* out; unsigned char* ws; int ph_lo, ph_hi; };
#define XB_TMO      128
#define XB_XCNT(j)  (256  + 64 * (j))
#define XB_XSUB(j)  (1280 + 64 * (j))
#define XB_XGEN(j)  (2304 + 64 * (j))
#define XB_TOP      3328
#define XB_TOPGEN   3392
#define XCD_BAR_WORDS 3456
#define XB_SPIN_CAP (1u << 18)

__device__ __forceinline__ unsigned xb_ld(unsigned* p)              { return __hip_atomic_load(p, __ATOMIC_RELAXED, __HIP_MEMORY_SCOPE_AGENT); }
__device__ __forceinline__ unsigned xb_add(unsigned* p, unsigned v) { return __hip_atomic_fetch_add(p, v, __ATOMIC_RELAXED, __HIP_MEMORY_SCOPE_AGENT); }
__device__ __forceinline__ unsigned xb_xcc_id() { return (unsigned)__builtin_amdgcn_s_getreg((3 << 11) | 20) & 0xFu; }
#define XB_SPIN(cond, bar) do { unsigned _sp = 0; while (cond) { __builtin_amdgcn_s_sleep(1); \
    if ((++_sp & 255u) == 0u) { if (xb_ld(&(bar)[XB_TMO])) break; if (_sp > XB_SPIN_CAP) { atomicAdd(&(bar)[XB_TMO], 1u); break; } } } } while (0)

struct XcdBarrier {
    unsigned* bar; unsigned x;
    volatile LAS unsigned* st;
};

__device__ __forceinline__ XcdBarrier xcd_barrier_post(unsigned* bar, volatile LAS unsigned* st) {
    XcdBarrier b; b.bar = bar; b.x = xb_xcc_id(); b.st = st;
    if (threadIdx.x == 0) (void)xb_add(&bar[XB_XCNT(b.x)], 1u);
    return b;
}
__device__ __forceinline__ void xcd_barrier_complete(unsigned* bar, unsigned x, unsigned& nloc, unsigned& nx) {
    const unsigned G = gridDim.x * gridDim.y * gridDim.z;
    unsigned sum, cnt, mine, sp = 0u;
    for (;;) {
        sum = 0u; cnt = 0u; mine = 0u;
#pragma unroll
        for (unsigned j = 0; j < 16; ++j) { const unsigned c = xb_ld(&bar[XB_XCNT(j)]); sum += c; cnt += (c > 0u) ? 1u : 0u; mine = (j == x) ? c : mine; }
        if (sum == G) break;
        __builtin_amdgcn_s_sleep(1);
        if ((++sp & 255u) == 0u) { if (xb_ld(&bar[XB_TMO])) break; if (sp > XB_SPIN_CAP) { atomicAdd(&bar[XB_TMO], 1u); break; } }
    }
    nloc = mine > 0u ? mine : 1u; nx = cnt > 0u ? cnt : 1u;
}

__device__ __forceinline__ void xcd_barrier(const XcdBarrier& b) {
    asm volatile("s_waitcnt vmcnt(0)" ::: "memory");
    __syncthreads();
    if (threadIdx.x == 0) {
        unsigned* bar = b.bar;
        __builtin_amdgcn_s_waitcnt(0);
        unsigned nloc = b.st[0], nx = b.st[1];
        if (nloc == 0u) { xcd_barrier_complete(bar, b.x, nloc, nx); b.st[0] = nloc; b.st[1] = nx; }
        const unsigned old = xb_add(&bar[XB_XSUB(b.x)], 1u);
        const unsigned gen = old / nloc;
        if (old + 1u == (gen + 1u) * nloc) {
            __builtin_amdgcn_fence(__ATOMIC_RELEASE, "agent");
            asm volatile("s_waitcnt vmcnt(0)" ::: "memory");
            const unsigned og = xb_add(&bar[XB_TOP], 1u);
            const unsigned tg = og / nx;
            if (og + 1u == (tg + 1u) * nx) xb_add(&bar[XB_TOPGEN], 1u);
            else XB_SPIN(xb_ld(&bar[XB_TOPGEN]) == tg, bar);
            __builtin_amdgcn_fence(__ATOMIC_ACQUIRE, "agent");
            xb_add(&bar[XB_XGEN(b.x)], 1u);
            asm volatile("s_waitcnt vmcnt(0)" ::: "memory");
        } else {
            XB_SPIN(xb_ld(&bar[XB_XGEN(b.x)]) == gen, bar);
            __builtin_amdgcn_fence(__ATOMIC_ACQUIRE, "agent");
            asm volatile("s_waitcnt vmcnt(0)" ::: "memory");
        }
    }
    __syncthreads();
}
struct Frame {
    LAS unsigned char* lds;
    int wave, G, bid;
    float* out; unsigned char* ws;
};
#define WSP(T, off) ((T*)(F.ws + (off)))

__device__ __forceinline__ void p0_transpose_item(const float* W, int K, int ldw, int nblk, int thr, int shift, bf16* WT, LAS float* scr, int item, int lane) {
    const int kb = item / nblk, nb = item % nblk, k0 = 64 * kb, n0 = 32 * nb, ns = n0 + (n0 >= thr ? shift : 0);
#pragma unroll 8
    for (int i = 0; i < 32; ++i) { const int kk = 2 * i + (lane >> 5); scr[kk * 33 + (lane & 31)] = W[(size_t)(k0 + kk) * ldw + ns + (lane & 31)]; }
    LDS_WAIT(); asm volatile("" ::: "memory");
    const int c = lane & 7;
#pragma unroll
    for (int j = 0; j < 4; ++j) { const int n = (lane >> 3) + 8 * j; const LAS float* s = scr + (8 * c) * 33 + n;
        v4u o; o.x = pk2(s[0 * 33], s[1 * 33]); o.y = pk2(s[2 * 33], s[3 * 33]); o.z = pk2(s[4 * 33], s[5 * 33]); o.w = pk2(s[6 * 33], s[7 * 33]);
        *(GAS v4u*)(WT + (size_t)(n0 + n) * K + k0 + 8 * c) = o; }
    LDS_WAIT(); asm volatile("" ::: "memory");
}
__device__ __forceinline__ void cvt_f32_bf16_stream(const float* src, bf16* dst, size_t n8, size_t gtid, size_t gthreads) {
    for (size_t i = gtid; i < n8; i += gthreads) {
        const f32x4 a = *(const GAS f32x4*)(src + i * 8), b = *(const GAS f32x4*)(src + i * 8 + 4);
        v4u o; o.x = pk2(a.x, a.y); o.y = pk2(a.z, a.w); o.z = pk2(b.x, b.y); o.w = pk2(b.z, b.w);
        *(GAS v4u*)(dst + i * 8) = o; }
}
__device__ __forceinline__ void i8_row(const float* src_row, unsigned char* dst  , float* scale  , int er, int lane) {
    const float* r = src_row + 16 * lane;
    float x[16];
#pragma unroll
    for (int q4 = 0; q4 < 4; ++q4) { const f32x4 a = *(const GAS f32x4*)(r + 4 * q4); x[4 * q4] = a.x; x[4 * q4 + 1] = a.y; x[4 * q4 + 2] = a.z; x[4 * q4 + 3] = a.w; }
    float am = 0.f;
#pragma unroll
    for (int i = 0; i < 16; ++i) am = fmaxf(am, fabsf(x[i]));
    am = wave_max(am);
    const float inv = am > 1e-30f ? 127.f / am : 0.f;
    unsigned wd[4];
#pragma unroll
    for (int q4 = 0; q4 < 4; ++q4) { unsigned w = 0;
#pragma unroll
        for (int e = 0; e < 4; ++e) { const int qv = (int)rintf(x[4 * q4 + e] * inv); w |= ((unsigned)qv & 0xffu) << (8 * e); }
        wd[q4] = w; }
    v4u o; o.x = wd[0]; o.y = wd[1]; o.z = wd[2]; o.w = wd[3];
    *(GAS v4u*)(dst + ((size_t)((lane >> 3) * 16384 + er)) * 128 + 16 * (lane & 7)) = o;
    if (lane == 0) scale[er] = am * (1.f / 127.f);
}
__device__ __forceinline__ void i8_chunk(Frame& F, const Args& A, int layer, int c) {
    const int tbl = c >> 8, row0 = (c & 255) * 64 + F.wave * 8;
    const float* src = A.in[22 + tbl] + (size_t)layer * 16384 * 1024;
    unsigned char* dst = F.ws + (tbl ? WS_VB : WS_UB) + (size_t)layer * 8 * 16384 * 128;
    float* sc = WSP(float, tbl ? WS_ISV : WS_ISU) + layer * 16384;
    for (int i = 0; i < 8; ++i) i8_row(src + (size_t)(row0 + i) * 1024, dst, sc, row0 + i, ((int)(threadIdx.x & 63u)));
}
__device__ __forceinline__ void p0_prologue(Frame& F, const Args& A) {
    {
        const float* c = A.in[1]; const float* aw = A.in[2]; const float* ab = A.in[3]; float* MOD = WSP(float, WS_MOD);
        LAS float* red = (LAS float*)F.lds;
        LAS float* cact = (LAS float*)(F.lds + 8192);
        if (F.bid < 192) { for (int i = (int)threadIdx.x; i < 4096; i += NTHR) cact[i] = silu_f(c[i]); __syncthreads(); }
        for (int item = F.bid; item < 192; item += F.G) {
            const int l = item / 96, n0 = (item % 96) * 64;
            float acc[4] = {0.f, 0.f, 0.f, 0.f};
            const int kbeg = F.wave * 128;
#pragma unroll 8
            for (int k = kbeg; k < kbeg + 128; ++k) {
                const float wv = aw[((size_t)l * 1024 + k) * 6144 + n0 + ((int)(threadIdx.x & 63u))];
#pragma unroll
                for (int b = 0; b < 4; ++b) acc[b] += cact[b * 1024 + k] * wv;
            }
#pragma unroll
            for (int b = 0; b < 4; ++b) red[(F.wave * 4 + b) * 64 + ((int)(threadIdx.x & 63u))] = acc[b];
            __syncthreads();
            if (((int)threadIdx.x) < 256) { const int b = ((int)threadIdx.x) >> 6, ln = ((int)threadIdx.x) & 63; float s = ab[l * 6144 + n0 + ln];
#pragma unroll
                for (int w = 0; w < 8; ++w) s += red[(w * 4 + b) * 64 + ln];
                MOD[(size_t)(l * 4 + b) * 6144 + n0 + ln] = s; }
            __syncthreads();
        }
    }
    if (F.bid >= F.G - 16) {
        LAS unsigned* hist = (LAS unsigned*)F.lds;
        unsigned short* ORD = WSP(unsigned short, WS_ORD);
        const int tid = (int)threadIdx.x, tbl = F.bid - (F.G - 16);
        { const int pass = tbl >> 3;
            const int nq = pass == 0 ? 64 : 32, nper = 4 * nq;
            { const int x = tbl & 7;
                if (tid < 160) hist[tid] = 0u;
                __syncthreads();
                int cost = 0, u = 0;
                if (tid < nper) {
                    const int hs = tid / nq, q = tid % nq, h = (x >> 2) ? (hs == 0 ? 6 : hs == 1 ? 5 : hs == 2 ? 1 : 0) : (hs == 0 ? 7 : hs == 1 ? 4 : hs == 2 ? 3 : 2), b = x & 3;
                    const float dcut = 46.f * (float)(2 << h);
                    if (pass == 0) { const int nt = 2 * q + 2; int lo = (int)ceilf(((float)(q * 128) - dcut - 63.f) * (1.f / 64.f)); if (lo < 0) lo = 0; cost = nt - lo; u = (b << 9) | (h << 6) | q; }
                    else { int lo = (int)ceilf(((float)(q * 256) - dcut - 255.f) * (1.f / 256.f)); if (lo < 0) lo = 0; int nb = q - lo; if (nb > 24) nb = 24; cost = 4 * (nb + 1); u = (b << 8) | (h << 5) | q; }
                    if (cost > 159) cost = 159;
                    atomicAdd((unsigned*)(hist + (159 - cost)), 1u);
                }
                __syncthreads();
                if (tid == 0) { unsigned acc = 0; for (int i = 0; i < 160; ++i) { const unsigned c = hist[i]; hist[i] = acc; acc += c; } }
                __syncthreads();
                if (tid < nper) { const unsigned pos = atomicAdd((unsigned*)(hist + (159 - cost)), 1u); ORD[(pass == 0 ? 0 : 2048) + x * nper + pos] = (unsigned short)u; }
                __syncthreads();
            }
        }
    }
    {
        LAS float* scr = (LAS float*)(F.lds + F.wave * 8704);
        const int gw = F.bid * NWAVES + F.wave, NGW = F.G * NWAVES;
        constexpr int I_IN0 = 16 * (NZ0 / 32), I_OUT = 16 * 32, I_IN1 = 16 * (NZ1 / 32), I_Q = 16 * (NQ / 32);
        constexpr int NITEMS = I_IN0 + 2 * I_OUT + I_IN1 + 2 * I_Q;
        for (int it = gw; it < NITEMS; it += NGW) {
            int r = it;
            if (r < I_IN0) { p0_transpose_item(A.in[6], D, SRC_IN0, NZ0 / 32, 2048, 8, WSP(bf16, WS_WIN0), scr, r, ((int)(threadIdx.x & 63u))); continue; } r -= I_IN0;
            if (r < I_OUT) { p0_transpose_item(A.in[13], D, D, 32, 1 << 30, 0, WSP(bf16, WS_WOUT0), scr, r, ((int)(threadIdx.x & 63u))); continue; } r -= I_OUT;
            if (r < I_IN1) { p0_transpose_item(A.in[14], D, NZ1, NZ1 / 32, 1 << 30, 0, WSP(bf16, WS_WIN1), scr, r, ((int)(threadIdx.x & 63u))); continue; } r -= I_IN1;
            if (r < I_OUT) { p0_transpose_item(A.in[19], D, D, 32, 1 << 30, 0, WSP(bf16, WS_WOUT1), scr, r, ((int)(threadIdx.x & 63u))); continue; } r -= I_OUT;
            if (r < I_Q) { p0_transpose_item(A.in[20], D, NQ, NQ / 32, 1 << 30, 0, WSP(bf16, WS_WQ), scr, r, ((int)(threadIdx.x & 63u))); continue; } r -= I_Q;
            p0_transpose_item(A.in[20] + (size_t)D * NQ, D, NQ, NQ / 32, 1 << 30, 0, WSP(bf16, WS_WQ) + (size_t)NQ * D, scr, r, ((int)(threadIdx.x & 63u)));
        }
    }
    {
        const size_t gtid = (size_t)F.bid * NTHR + ((int)threadIdx.x), gth = (size_t)F.G * NTHR;
        cvt_f32_bf16_stream(A.in[21], WSP(bf16, WS_KEYS), (size_t)2 * 2 * 128 * 128 / 8, gtid, gth);
    }
}

template <bool GATES, bool IN_BF16>
__device__ __forceinline__ void norm_pass(Frame& F, const Args& A, const void* X, const float* g, const float* mod, int shc, bf16* XN) {
    LAS float* wgT = (LAS float*)F.lds;
    if (GATES) {
        const float* win = A.in[6];
        for (int i = ((int)threadIdx.x); i < 8 * 1024; i += NTHR) { const int cg = i >> 10, k = i & 1023; wgT[i] = win[(size_t)k * SRC_IN0 + 2048 + cg]; }
        __syncthreads();
    }
    const int gw = F.bid * NWAVES + F.wave, NGW = F.G * NWAVES, lane = (int)(threadIdx.x & 63u);
    unsigned wpk[GATES ? 8 : 1][4][2]; float gbias = 0.f;
    if (GATES) {
#pragma unroll
        for (int cg = 0; cg < 8; ++cg)
#pragma unroll
            for (int j = 0; j < 4; ++j) { const f32x4 w = *(const LAS f32x4*)(wgT + cg * 1024 + 4 * lane + 256 * j); wpk[cg][j][0] = pk2(w.x, w.y); wpk[cg][j][1] = pk2(w.z, w.w); }
        const int cgl = ((lane >> 5) & 1) * 4 + ((lane >> 4) & 1) * 2 + ((lane >> 3) & 1);
        gbias = cgl < 4 ? A.in[8][cgl] : A.in[9][cgl - 4];
    }
    constexpr int NR = 2;
    for (int row0 = gw; row0 < M; row0 += NR * NGW) {
        f32x4 v[NR][4]; float ss[NR];
#pragma unroll
        for (int rr = 0; rr < NR; ++rr) { const int row = row0 + rr * NGW;
            if (IN_BF16) { const GAS v2u* xr = (const GAS v2u*)((const bf16*)X + (size_t)row * D) + lane;
#pragma unroll
                for (int j = 0; j < 4; ++j) { const v2u w = xr[64 * j]; const unsigned w0 = w.x, w1 = w.y; v[rr][j] = (f32x4){bflo(w0), bfhi(w0), bflo(w1), bfhi(w1)}; }
            } else { const GAS f32x4* xr = (const GAS f32x4*)((const float*)X + (size_t)row * D) + lane;
#pragma unroll
                for (int j = 0; j < 4; ++j) v[rr][j] = xr[64 * j]; } }
#pragma unroll
        for (int rr = 0; rr < NR; ++rr) { float s = 0.f;
#pragma unroll
            for (int j = 0; j < 4; ++j) s += (v[rr][j].x * v[rr][j].x + v[rr][j].y * v[rr][j].y) + (v[rr][j].z * v[rr][j].z + v[rr][j].w * v[rr][j].w);
            ss[rr] = s; }
#pragma unroll
        for (int o = 1; o < 64; o <<= 1) {
#pragma unroll
            for (int rr = 0; rr < NR; ++rr) ss[rr] += __shfl_xor(ss[rr], o); }
#pragma unroll
        for (int rr = 0; rr < NR; ++rr) { const int row = row0 + rr * NGW, b = row >> 13;
            const float rstd = rsqrtf(ss[rr] * (1.f / D) + EPS);
            const float* shp = mod + (size_t)b * 6144 + shc * 1024; const float* scp = shp + 1024;
            unsigned opk[4][2];
#pragma unroll
            for (int j = 0; j < 4; ++j) { const int c = 4 * lane + 256 * j;
                const f32x4 gg = *(const f32x4*)(g + c), sc = *(const f32x4*)(scp + c), sh = *(const f32x4*)(shp + c);
                v[rr][j] = v[rr][j] * rstd * gg * (sc + 1.f) + sh;
                v2u o; o.x = pk2(v[rr][j].x, v[rr][j].y); o.y = pk2(v[rr][j].z, v[rr][j].w);
                if (GATES) { opk[j][0] = o.x; opk[j][1] = o.y; }
                *(GAS v2u*)(XN + (size_t)row * D + c) = o; }
            if (GATES) {
                float* GT = WSP(float, WS_GATES);
                float p[8];
#pragma unroll
                for (int cg = 0; cg < 8; ++cg) { float a = 0.f;
#pragma unroll
                    for (int j = 0; j < 4; ++j) { a = dot2bf(opk[j][0], wpk[cg][j][0], a); a = dot2bf(opk[j][1], wpk[cg][j][1], a); }
                    p[cg] = a; }
                const bool u5 = (lane & 32) != 0, u4 = (lane & 16) != 0, u3 = (lane & 8) != 0;
                float q[4], r2[2];
#pragma unroll
                for (int i = 0; i < 4; ++i) { const float send = u5 ? p[i] : p[i + 4], keep = u5 ? p[i + 4] : p[i]; q[i] = keep + __shfl_xor(send, 32); }
#pragma unroll
                for (int i = 0; i < 2; ++i) { const float send = u4 ? q[i] : q[i + 2], keep = u4 ? q[i + 2] : q[i]; r2[i] = keep + __shfl_xor(send, 16); }
                float sg; { const float send = u3 ? r2[0] : r2[1], keep = u3 ? r2[1] : r2[0]; sg = keep + __shfl_xor(send, 8); }
                sg += __shfl_xor(sg, 4); sg += __shfl_xor(sg, 2); sg += __shfl_xor(sg, 1);
                if ((lane & 7) == 0) GT[(size_t)row * 8 + (lane >> 3)] = sg + gbias;
            }
        }
    }
}

__device__ __forceinline__ void qknorm_unit(Frame& F, bf16* Z, int ldz, int row0, int col0, const float* g, float gmul, float* kmean  ) {
    const int c = col0 + 8 * ((int)(threadIdx.x & 63u)), d0 = (8 * ((int)(threadIdx.x & 63u))) & 63;
    float gv[8];
#pragma unroll
    for (int i = 0; i < 8; ++i) gv[i] = g[d0 + i] * gmul;
    float ks[8] = {0.f, 0.f, 0.f, 0.f, 0.f, 0.f, 0.f, 0.f};
    for (int r = 0; r < 32; ++r) {
        bf16* p = Z + (size_t)(row0 + F.wave * 32 + r) * ldz + c;
        const v4u w = *(const GAS v4u*)p;
        float x[8] = {bflo(w.x), bfhi(w.x), bflo(w.y), bfhi(w.y), bflo(w.z), bfhi(w.z), bflo(w.w), bfhi(w.w)};
        float ss = 0.f;
#pragma unroll
        for (int i = 0; i < 8; ++i) ss += x[i] * x[i];
        ss += __shfl_xor(ss, 1); ss += __shfl_xor(ss, 2); ss += __shfl_xor(ss, 4);
        const float rstd = rsqrtf(ss * (1.f / 64.f) + EPS);
#pragma unroll
        for (int i = 0; i < 8; ++i) { x[i] = x[i] * rstd * gv[i]; ks[i] += x[i]; }
        v4u o; o.x = pk2(x[0], x[1]); o.y = pk2(x[2], x[3]); o.z = pk2(x[4], x[5]); o.w = pk2(x[6], x[7]);
        *(GAS v4u*)p = o;
    }
    if (kmean) {
        LAS float* red = (LAS float*)F.lds;
#pragma unroll
        for (int i = 0; i < 8; ++i) red[F.wave * 512 + 8 * ((int)(threadIdx.x & 63u)) + i] = ks[i];
        __syncthreads();
        { float s = 0.f;
#pragma unroll
          for (int w = 0; w < 8; ++w) s += red[w * 512 + ((int)threadIdx.x)];
          kmean[(size_t)(((int)threadIdx.x) >> 6) * (32 * 64) + (((int)threadIdx.x) & 63)] = s * (1.f / 256.f); }
        __syncthreads();
    }
}

__device__ __forceinline__ void kmean_unit(Frame& F, const bf16* Z, int ldz, int row0, int col0, float* kmean) {
    const int c = col0 + 8 * ((int)(threadIdx.x & 63u));
    float ks[8] = {0.f, 0.f, 0.f, 0.f, 0.f, 0.f, 0.f, 0.f};
#pragma unroll 4
    for (int r = 0; r < 32; ++r) {
        const v4u w = *(const GAS v4u*)(Z + (size_t)(row0 + F.wave * 32 + r) * ldz + c);
        ks[0] += bflo(w.x); ks[1] += bfhi(w.x); ks[2] += bflo(w.y); ks[3] += bfhi(w.y); ks[4] += bflo(w.z); ks[5] += bfhi(w.z); ks[6] += bflo(w.w); ks[7] += bfhi(w.w);
    }
    LAS float* red = (LAS float*)F.lds;
#pragma unroll
    for (int i = 0; i < 8; ++i) red[F.wave * 512 + 8 * ((int)(threadIdx.x & 63u)) + i] = ks[i];
    __syncthreads();
    { float s = 0.f;
#pragma unroll
      for (int w = 0; w < 8; ++w) s += red[w * 512 + ((int)threadIdx.x)];
      kmean[(size_t)(((int)threadIdx.x) >> 6) * (32 * 64) + (((int)threadIdx.x) & 63)] = s * (1.f / 256.f); }
    __syncthreads();
}

constexpr int KSTRB = 144;
template <int DV> struct VStr { static constexpr int B = (DV == 64) ? 192 : 320; };
typedef short v4i16_t __attribute__((ext_vector_type(4)));
__device__ __forceinline__ s16x4 vtr(const LAS unsigned char* p) { return __builtin_bit_cast(s16x4, __builtin_amdgcn_ds_read_tr16_b64_v4i16((LAS v4i16_t*)p)); }
__device__ __forceinline__ unsigned cvtpk(float lo, float hi) { typedef float f2 __attribute__((ext_vector_type(2))); typedef __bf16 b2 __attribute__((ext_vector_type(2)));
    f2 v = {lo, hi}; b2 b = __builtin_convertvector(v, b2); return __builtin_bit_cast(unsigned, b); }
__device__ __forceinline__ float xhalf(float v) {
    auto rr = __builtin_amdgcn_permlane32_swap(__builtin_bit_cast(unsigned, v), __builtin_bit_cast(unsigned, v), false, false);
    const unsigned r0 = rr[0], r1 = rr[1]; return u2f((threadIdx.x & 32) ? r0 : r1);
}
template <int DV> struct AttnSt { f32x16 o[DV / 32]; float m, l; };
template <int DV> __device__ __forceinline__ void attn_init(AttnSt<DV>& st) {
#pragma unroll
    for (int t = 0; t < DV / 32; ++t)
#pragma unroll
        for (int r = 0; r < 16; ++r) st.o[t][r] = 0.f;
    st.m = -1e30f; st.l = 0.f;
}
template <int DV>
__device__ __forceinline__ void attn_qk(AttnSt<DV>& st, const LAS unsigned char* Kt, const bf16x8 (&qf)[4], float sl2, int tq, int kt0, bool diag, bool rowok, int lane, bf16x8 (&pf)[2][2]) {
    const int r32 = lane & 31, hi = lane >> 5;
    const int kb = kt0 + 4 * hi;
    const float ref = st.m > -1e29f ? st.m : 0.f;
    const float c0 = -sl2 * (float)(tq - kb) - ref;
    f32x16 s0, s1;
#pragma unroll
    for (int r = 0; r < 16; ++r) { const int ko = (r & 3) + 8 * (r >> 2); s0[r] = c0 + sl2 * (float)ko; s1[r] = c0 + sl2 * (float)(ko + 32); }
    const LAS unsigned char* kp = Kt + r32 * KSTRB + hi * 16;
#pragma unroll
    for (int ks = 0; ks < 4; ++ks) {
        const bf16x8 k0 = *(const LAS bf16x8*)(kp + ks * 32), k1 = *(const LAS bf16x8*)(kp + 32 * KSTRB + ks * 32);
        s0 = __builtin_amdgcn_mfma_f32_32x32x16_bf16(k0, qf[ks], s0, 0, 0, 0);
        s1 = __builtin_amdgcn_mfma_f32_32x32x16_bf16(k1, qf[ks], s1, 0, 0, 0);
    }
    if (diag || !rowok) {
#pragma unroll
        for (int r = 0; r < 16; ++r) { const int ko = (r & 3) + 8 * (r >> 2);
            if (!rowok || kb + ko > tq) s0[r] = -INFINITY;
            if (!rowok || kb + ko + 32 > tq) s1[r] = -INFINITY; }
    }
    float mx = fmaxf(s0[0], s1[0]);
#pragma unroll
    for (int r = 1; r < 16; ++r) mx = fmaxf(mx, fmaxf(s0[r], s1[r]));
    mx = fmaxf(mx, xhalf(mx));
    const float mnew = fmaxf(st.m, ref + mx);
    if (__any(mnew > st.m)) {
        const float alpha = __builtin_amdgcn_exp2f(st.m - mnew), dd = mnew - ref;
        st.m = mnew; st.l *= alpha;
#pragma unroll
        for (int t = 0; t < DV / 32; ++t)
#pragma unroll
            for (int r = 0; r < 16; ++r) st.o[t][r] *= alpha;
#pragma unroll
        for (int r = 0; r < 16; ++r) { s0[r] -= dd; s1[r] -= dd; }
    }
#pragma unroll
    for (int r = 0; r < 16; ++r) { s0[r] = __builtin_amdgcn_exp2f(s0[r]); s1[r] = __builtin_amdgcn_exp2f(s1[r]); }
#pragma unroll
    for (int s = 0; s < 2; ++s) {
        v4u a, b;
        a.x = cvtpk(s0[8 * s + 0], s0[8 * s + 1]); a.y = cvtpk(s0[8 * s + 2], s0[8 * s + 3]); a.z = cvtpk(s0[8 * s + 4], s0[8 * s + 5]); a.w = cvtpk(s0[8 * s + 6], s0[8 * s + 7]);
        b.x = cvtpk(s1[8 * s + 0], s1[8 * s + 1]); b.y = cvtpk(s1[8 * s + 2], s1[8 * s + 3]); b.z = cvtpk(s1[8 * s + 4], s1[8 * s + 5]); b.w = cvtpk(s1[8 * s + 6], s1[8 * s + 7]);
        pf[0][s] = __builtin_bit_cast(bf16x8, a); pf[1][s] = __builtin_bit_cast(bf16x8, b);
    }
}
template <int DV>
__device__ __forceinline__ void attn_pv(AttnSt<DV>& st, const LAS unsigned char* Vt, const bf16x8 (&pf)[2][2], int lane) {
    { const bf16x8 ones = {0x3F80, 0x3F80, 0x3F80, 0x3F80, 0x3F80, 0x3F80, 0x3F80, 0x3F80};
      f32x16 rs = __builtin_amdgcn_mfma_f32_32x32x16_bf16(ones, pf[0][0], (f32x16){0.f, 0.f, 0.f, 0.f, 0.f, 0.f, 0.f, 0.f, 0.f, 0.f, 0.f, 0.f, 0.f, 0.f, 0.f, 0.f}, 0, 0, 0);
      rs = __builtin_amdgcn_mfma_f32_32x32x16_bf16(ones, pf[0][1], rs, 0, 0, 0); rs = __builtin_amdgcn_mfma_f32_32x32x16_bf16(ones, pf[1][0], rs, 0, 0, 0); rs = __builtin_amdgcn_mfma_f32_32x32x16_bf16(ones, pf[1][1], rs, 0, 0, 0);
      st.l += rs[0]; }
    constexpr int VS = VStr<DV>::B;
    const int g = lane >> 4, i16 = lane & 15;
    const LAS unsigned char* vp = Vt + (4 * (g >> 1) + (i16 >> 2)) * VS + (16 * (g & 1) + 4 * (i16 & 3)) * 2;
#pragma unroll
    for (int kbk = 0; kbk < 2; ++kbk)
#pragma unroll
        for (int s = 0; s < 2; ++s)
#pragma unroll
            for (int t = 0; t < DV / 32; ++t) {
                const s16x4 lo = vtr(vp + (kbk * 32 + 16 * s) * VS + t * 64), h8 = vtr(vp + (kbk * 32 + 16 * s + 8) * VS + t * 64);
                const bf16x8 va = {lo[0], lo[1], lo[2], lo[3], h8[0], h8[1], h8[2], h8[3]};
                st.o[t] = __builtin_amdgcn_mfma_f32_32x32x16_bf16(va, pf[kbk][s], st.o[t], 0, 0, 0);
            }
}
template <int DV>
__device__ __forceinline__ void attn_tile(AttnSt<DV>& st, const LAS unsigned char* Kt, const LAS unsigned char* Vt, const bf16x8 (&qf)[4], float sc2, float sl2, int tq, int kt0, bool diag, bool rowok, int lane) {
    bf16x8 pf[2][2];
    attn_qk<DV>(st, Kt, qf, sl2, tq, kt0, diag, rowok, lane, pf);
    attn_pv<DV>(st, Vt, pf, lane);
}
template <int NK, int DV> struct TileRegs { v4u k[NK]; v4u v[DV / 64]; };
template <int NK, int DV>
__device__ __forceinline__ void tile_load(TileRegs<NK, DV>& R, const bf16* Z, int ldz, size_t zrow0, int kcol, int vcol, int tid) {
#pragma unroll
    for (int i = 0; i < NK; ++i) { const int ch = tid + 512 * i; const int row = ch / (8 * NK), cc = ch % (8 * NK);
        R.k[i] = *(const GAS v4u*)(Z + (zrow0 + row) * ldz + kcol + cc * 8); }
#pragma unroll
    for (int i = 0; i < DV / 64; ++i) { const int ch = tid + 512 * i; const int row = ch / (DV / 8), cc = ch % (DV / 8);
        R.v[i] = *(const GAS v4u*)(Z + (zrow0 + row) * ldz + vcol + cc * 8); }
}
template <int NK, int DV>
__device__ __forceinline__ void tile_store(const TileRegs<NK, DV>& R, LAS unsigned char* Kt  , LAS unsigned char* Vt, int tid) {
#pragma unroll
    for (int i = 0; i < NK; ++i) { const int ch = tid + 512 * i; const int row = ch / (8 * NK), cc = ch % (8 * NK);
        *(LAS v4u*)(Kt + (cc >> 3) * (64 * KSTRB) + row * KSTRB + (cc & 7) * 16) = R.k[i]; }
#pragma unroll
    for (int i = 0; i < DV / 64; ++i) { const int ch = tid + 512 * i; const int row = ch / (DV / 8), cc = ch % (DV / 8);
        *(LAS v4u*)(Vt + row * VStr<DV>::B + cc * 16) = R.v[i]; }
}
__device__ __forceinline__ void moba_unit(Frame& F, int b, int h, int j, float tcut  ) {
    const bf16* Z = WSP(bf16, WS_Z); constexpr int ldz = NZ0;
    const int lane = ((int)(threadIdx.x & 63u)), w = F.wave, r32 = lane & 31, hi = lane >> 5, tid = ((int)threadIdx.x);
    const size_t rowb = (size_t)b * SEQ;
    const int qpos = j * 256 + w * 32 + r32;
    const int qcol = 2048 + h * 64, kcol = 2560 + h * 64, vcol = 3072 + h * 64;
    LAS unsigned char* lds = F.lds;
    constexpr int BUFB = 64 * KSTRB + 64 * VStr<64>::B;
    LAS unsigned char* kmh = lds + 2 * BUFB;
    LAS unsigned char* kml = lds + 2 * BUFB + 32 * KSTRB;
    LAS unsigned* msk = (LAS unsigned*)(lds + 2 * BUFB + 64 * KSTRB);
    { const float* KM = WSP(float, WS_KMEAN) + (size_t)((b * 8 + h) * 32) * 64; const f32x4 x = *(const f32x4*)(KM + 4 * tid);
      const int n = tid >> 4, d0 = (tid & 15) * 4;
      const unsigned h0 = f2bf(x.x), h1 = f2bf(x.y), h2 = f2bf(x.z), h3 = f2bf(x.w);
      v2u hv; hv.x = h0 | (h1 << 16); hv.y = h2 | (h3 << 16);
      v2u lv; lv.x = pk2(x.x - u2f(h0 << 16), x.y - u2f(h1 << 16)); lv.y = pk2(x.z - u2f(h2 << 16), x.w - u2f(h3 << 16));
      *(LAS v2u*)(kmh + n * KSTRB + d0 * 2) = hv; *(LAS v2u*)(kml + n * KSTRB + d0 * 2) = lv; }
    if (tid < 16) msk[tid] = 0u;
    bf16x8 qf[4];
    const bf16* qrow = Z + (rowb + qpos) * ldz + qcol;
#pragma unroll
    for (int ks = 0; ks < 4; ++ks) qf[ks] = *(const GAS bf16x8*)(qrow + 16 * ks + 8 * hi);
    __syncthreads();
    f32x16 gt;
#pragma unroll
    for (int r = 0; r < 16; ++r) gt[r] = 0.f;
#pragma unroll
    for (int ks = 0; ks < 4; ++ks) {
        const bf16x8 a = *(const LAS bf16x8*)(kmh + r32 * KSTRB + hi * 16 + ks * 32), c = *(const LAS bf16x8*)(kml + r32 * KSTRB + hi * 16 + ks * 32);
        gt = __builtin_amdgcn_mfma_f32_32x32x16_bf16(a, qf[ks], gt, 0, 0, 0);
        gt = __builtin_amdgcn_mfma_f32_32x32x16_bf16(c, qf[ks], gt, 0, 0, 0);
    }
    float t0 = -INFINITY, t1 = -INFINITY, t2 = -INFINITY;
#define INS3(key) do { float k_ = (key); float a_ = fmaxf(t0, k_), l_ = fminf(t0, k_); t0 = a_; a_ = fmaxf(t1, l_); l_ = fminf(t1, l_); t1 = a_; t2 = fmaxf(t2, l_); } while (0)
#pragma unroll
    for (int r = 0; r < 16; ++r) { const int n = (r & 3) + 8 * (r >> 2) + 4 * hi;
        const float key = (n < j) ? u2f((f2u(gt[r]) & ~31u) | (unsigned)n) : -INFINITY; INS3(key); }
    { const float p0 = xhalf(t0), p1 = xhalf(t1), p2 = xhalf(t2); INS3(p0); INS3(p1); INS3(p2); }
#undef INS3
    const int sel0 = (t0 > -INFINITY) ? (int)(f2u(t0) & 31u) : -1;
    const int sel1 = (t1 > -INFINITY) ? (int)(f2u(t1) & 31u) : -1;
    const int sel2 = (t2 > -INFINITY) ? (int)(f2u(t2) & 31u) : -1;
    { const unsigned mm = (sel0 >= 0 ? 1u << sel0 : 0u) | (sel1 >= 0 ? 1u << sel1 : 0u) | (sel2 >= 0 ? 1u << sel2 : 0u);
      if (mm) { __hip_atomic_fetch_or(msk + w, mm, __ATOMIC_RELAXED, __HIP_MEMORY_SCOPE_WORKGROUP); __hip_atomic_fetch_or(msk + 8, mm, __ATOMIC_RELAXED, __HIP_MEMORY_SCOPE_WORKGROUP); } }
    __syncthreads();
    const float slope = ldexpf(1.f, -(h + 1)), dcut = tcut / slope;
    const float sl2 = slope * LOG2E, sc2 = 0.125f * LOG2E;
    int nlo = (int)ceilf(((float)(j * 256) - dcut - 255.f) * (1.f / 256.f)); if (nlo < 0) nlo = 0;
    const unsigned keep = nlo >= 32 ? 0u : (0xffffffffu << nlo);
    const unsigned bmask = msk[8] & keep; const unsigned wmask = (unsigned)__builtin_amdgcn_readfirstlane((int)msk[w]) & keep;
    AttnSt<64> st; attn_init<64>(st);
    unsigned rem = bmask;
    int blk = j, kt = 3, buf = 0;
    TileRegs<1, 64> R;
    tile_load<1, 64>(R, Z, ldz, rowb + blk * 256 + kt * 64, kcol, vcol, tid);
    tile_store<1, 64>(R, lds, lds + 64 * KSTRB, tid);
    __syncthreads();
    for (;;) {
        int nblk = blk, nkt = kt - 1; bool has_next = true;
        if (nkt < 0) { nkt = 3; if (rem) { nblk = 31 - __builtin_clz(rem); rem &= ~(1u << nblk); } else has_next = false; }
        if (has_next) tile_load<1, 64>(R, Z, ldz, rowb + nblk * 256 + nkt * 64, kcol, vcol, tid);
        const bool own = (blk == j);
        const bool active = (own ? (kt * 64 <= w * 32 + 31) : (((wmask >> blk) & 1u) != 0u)) && ((float)(j * 256 + w * 32 - (blk * 256 + kt * 64 + 63)) <= dcut);
        if (active) {
            const bool rowok = own || blk == sel0 || blk == sel1 || blk == sel2;
            const bool diag = own && (kt * 64 + 63 > w * 32);
            attn_tile<64>(st, lds + buf * BUFB, lds + buf * BUFB + 64 * KSTRB, qf, sc2, sl2, qpos, blk * 256 + kt * 64, diag, rowok, lane);
        }
        if (!has_next) break;
        tile_store<1, 64>(R, lds + (buf ^ 1) * BUFB, lds + (buf ^ 1) * BUFB + 64 * KSTRB, tid);
        __syncthreads();
        buf ^= 1; blk = nblk; kt = nkt;
    }
    const float inv = 1.f / st.l;
    bf16* Y = WSP(bf16, WS_XNY) + (rowb + qpos) * 1024 + 512 + h * 64;
#pragma unroll
    for (int t = 0; t < 2; ++t)
#pragma unroll
        for (int rg = 0; rg < 4; ++rg) { v2u o; o.x = pk2(st.o[t][4 * rg] * inv, st.o[t][4 * rg + 1] * inv); o.y = pk2(st.o[t][4 * rg + 2] * inv, st.o[t][4 * rg + 3] * inv);
            *(GAS v2u*)(Y + t * 32 + 8 * rg + 4 * hi) = o; }
    __syncthreads();
}

__device__ __forceinline__ void diff_unit(Frame& F, const Args& A, int b, int h, int qt, float lam, float tcut) {
    const bf16* Z = WSP(bf16, WS_Z); constexpr int ldz = NZ1;
    const int lane = ((int)(threadIdx.x & 63u)), w = F.wave, r32 = lane & 31, hi = lane >> 5, tid = ((int)threadIdx.x);
    const int comp = w >> 2, wq = w & 3;
    const size_t rowb = (size_t)b * SEQ;
    const int q0 = qt * 128, qpos = q0 + wq * 32 + r32;
    const int qcol = h * 128 + comp * 64, kcol = 1024 + h * 128, vcol = 2048 + h * 128;
    LAS unsigned char* lds = F.lds;
    constexpr int BUFB = 2 * 64 * KSTRB + 64 * VStr<128>::B;
    bf16x8 qf[4];
    const bf16* qrow = Z + (rowb + qpos) * ldz + qcol;
#pragma unroll
    for (int ks = 0; ks < 4; ++ks) qf[ks] = *(const GAS bf16x8*)(qrow + 16 * ks + 8 * hi);
    const float slope = ldexpf(1.f, -(h + 1)), dcut = tcut / slope;
    const float sl2 = slope * LOG2E, sc2 = 0.125f * LOG2E;
    AttnSt<128> st; attn_init<128>(st);
    const int nt = (q0 + 128) / 64;
    int kt_lo = (int)ceilf(((float)q0 - dcut - 63.f) * (1.f / 64.f)); if (kt_lo < 0) kt_lo = 0;
    TileRegs<2, 128> R;
    tile_load<2, 128>(R, Z, ldz, rowb + (size_t)(nt - 1) * 64, kcol, vcol, tid);
    tile_store<2, 128>(R, lds, lds + 2 * 64 * KSTRB, tid);
    __syncthreads();
    int buf = 0;
    for (int kt = nt - 1; kt >= kt_lo; --kt) {
        const bool has_next = kt > kt_lo;
        if (has_next) tile_load<2, 128>(R, Z, ldz, rowb + (size_t)(kt - 1) * 64, kcol, vcol, tid);
        if (kt * 64 <= q0 + wq * 32 + 31) {
            const bool diag = kt * 64 + 63 > q0 + wq * 32;
            attn_tile<128>(st, lds + buf * BUFB + comp * (64 * KSTRB), lds + buf * BUFB + 2 * 64 * KSTRB, qf, sc2, sl2, qpos, kt * 64, diag, true, lane);
        }
        if (has_next) { tile_store<2, 128>(R, lds + (buf ^ 1) * BUFB, lds + (buf ^ 1) * BUFB + 2 * 64 * KSTRB, tid); }
        __syncthreads();
        buf ^= 1;
    }
    const float inv = 1.f / st.l;
    LAS float* o2 = (LAS float*)lds;
    if (comp == 1) {
#pragma unroll
        for (int t = 0; t < 4; ++t)
#pragma unroll
            for (int r = 0; r < 16; ++r) o2[((wq * 4 + t) * 16 + r) * 64 + lane] = st.o[t][r] * inv;
    }
    __syncthreads();
    if (comp == 0) {
        float ss = 0.f;
#pragma unroll
        for (int t = 0; t < 4; ++t)
#pragma unroll
            for (int r = 0; r < 16; ++r) { const float v = st.o[t][r] * inv - lam * o2[((wq * 4 + t) * 16 + r) * 64 + lane]; st.o[t][r] = v; ss += v * v; }
        ss += xhalf(ss);
        const float rs = rsqrtf(ss * (1.f / 128.f) + EPS) * 0.6444909324090307f;
        const float* og = A.in[18];
        bf16* Y = WSP(bf16, WS_XNY) + (rowb + qpos) * 1024 + h * 128;
#pragma unroll
        for (int t = 0; t < 4; ++t)
#pragma unroll
            for (int rg = 0; rg < 4; ++rg) { const int dv = t * 32 + 8 * rg + 4 * hi; const f32x4 gg = *(const f32x4*)(og + dv);
                v2u o; o.x = pk2(st.o[t][4 * rg] * rs * gg.x, st.o[t][4 * rg + 1] * rs * gg.y); o.y = pk2(st.o[t][4 * rg + 2] * rs * gg.z, st.o[t][4 * rg + 3] * rs * gg.w);
                *(GAS v2u*)(Y + dv) = o; }
    }
    __syncthreads();
}

template <int MT, int NT>
__device__ __forceinline__ void mma_nt(const LAS unsigned char* A, int lda, const LAS unsigned char* B, int ldb, int K, f32x4 (&acc)[MT][NT], int lane) {
    const int r = lane & 15, kq = (lane >> 4) * 16;
    for (int k0 = 0; k0 < K; k0 += 32) {
        bf16x8 a[MT], bb[NT];
#pragma unroll
        for (int m = 0; m < MT; ++m) a[m] = *(const LAS bf16x8*)(A + (m * 16 + r) * lda + k0 * 2 + kq);
#pragma unroll
        for (int n = 0; n < NT; ++n) bb[n] = *(const LAS bf16x8*)(B + (n * 16 + r) * ldb + k0 * 2 + kq);
#pragma unroll
        for (int m = 0; m < MT; ++m)
#pragma unroll
            for (int n = 0; n < NT; ++n) acc[m][n] = __builtin_amdgcn_mfma_f32_16x16x32_bf16(a[m], bb[n], acc[m][n], 0, 0, 0);
    }
}
constexpr int TS = 272;
constexpr int TILEB = 128 * TS;
constexpr int ML_Q = 0, ML_K = TILEB, ML_V = 2 * TILEB, ML_SM = 3 * TILEB;

__device__ __forceinline__ void ml_gates(const float* GT, size_t row0, int hm, LAS float* sm, int lane) {
    const float i0 = GT[(row0 + 2 * lane) * 8 + hm], i1 = GT[(row0 + 2 * lane + 1) * 8 + hm];
    const float f0 = logsigmoid_f(GT[(row0 + 2 * lane) * 8 + 4 + hm]), f1 = logsigmoid_f(GT[(row0 + 2 * lane + 1) * 8 + 4 + hm]);
    float s = f0 + f1;
#pragma unroll
    for (int o = 1; o < 64; o <<= 1) { const float t = __shfl_up(s, o); if (lane >= o) s += t; }
    const float excl = s - (f0 + f1);
    sm[2 * lane] = excl + f0; sm[2 * lane + 1] = excl + f0 + f1;
    sm[128 + 2 * lane] = i0; sm[128 + 2 * lane + 1] = i1;
}
template <bool TRANSPOSE>
__device__ __forceinline__ void ml_conv_tile(const bf16* Z, size_t rowb, int t0, int zc, const float* cw, int wc, float mul, LAS unsigned char* dst, const LAS float* rs, int tid) {
#pragma unroll
    for (int it = 0; it < 4; ++it) {
        const int item = tid + 512 * it, l = item >> 4, ch = (item & 15) * 8;
        float acc[8];
#pragma unroll
        for (int i = 0; i < 8; ++i) acc[i] = 0.f;
        v4u wv[4];
#pragma unroll
        for (int jj = 0; jj < 4; ++jj) { const int t = t0 + l - 3 + jj;
            wv[jj] = *(const GAS v4u*)(Z + (rowb + (t < 0 ? 0 : t)) * NZ0 + zc + ch); }
#pragma unroll
        for (int jj = 0; jj < 4; ++jj) {
            const int t = t0 + l - 3 + jj; const float tm = t >= 0 ? 1.f : 0.f;
            const v4u w = wv[jj];
            const float x[8] = {bflo(w.x), bfhi(w.x), bflo(w.y), bfhi(w.y), bflo(w.z), bfhi(w.z), bflo(w.w), bfhi(w.w)};
            const f32x4 c0 = *(const f32x4*)(cw + jj * 1024 + wc + ch) * tm, c1 = *(const f32x4*)(cw + jj * 1024 + wc + ch + 4) * tm;
            acc[0] += x[0] * c0.x; acc[1] += x[1] * c0.y; acc[2] += x[2] * c0.z; acc[3] += x[3] * c0.w;
            acc[4] += x[4] * c1.x; acc[5] += x[5] * c1.y; acc[6] += x[6] * c1.z; acc[7] += x[7] * c1.w;
        }
        const float sc = TRANSPOSE ? mul * rs[l] : mul;
#pragma unroll
        for (int i = 0; i < 8; ++i) acc[i] = silu_f(acc[i]) * sc;
        if (TRANSPOSE) {
#pragma unroll
            for (int i = 0; i < 8; ++i) *(LAS bf16*)(dst + (ch + i) * TS + l * 2) = (bf16)f2bf(acc[i]);
        } else {
            v4u o; o.x = pk2(acc[0], acc[1]); o.y = pk2(acc[2], acc[3]); o.z = pk2(acc[4], acc[5]); o.w = pk2(acc[6], acc[7]);
            *(LAS v4u*)(dst + l * TS + ch * 2) = o;
        }
    }
}
__device__ __forceinline__ void ml_vt_tile(const bf16* Z, size_t row0, int zc, LAS unsigned char* dst, int tid) {
#pragma unroll
    for (int it = 0; it < 4; ++it) {
        const int item = tid + 512 * it, l = item >> 4, ch = (item & 15) * 8;
        const v4u w = *(const GAS v4u*)(Z + (row0 + l) * NZ0 + zc + ch);
        const unsigned ww[4] = {w.x, w.y, w.z, w.w};
#pragma unroll
        for (int i = 0; i < 4; ++i) { *(LAS bf16*)(dst + (ch + 2 * i) * TS + l * 2) = (bf16)(ww[i] & 0xffffu); *(LAS bf16*)(dst + (ch + 2 * i + 1) * TS + l * 2) = (bf16)(ww[i] >> 16); }
    }
}
__device__ __forceinline__ void mlstm_a_unit(Frame& F, const Args& A, int unit) {
    const int c = unit & 63, bh = unit >> 6, hm = bh & 3, b = bh >> 2;
    const bf16* Z = WSP(bf16, WS_Z); const float* GT = WSP(float, WS_GATES);
    const size_t rowb = (size_t)b * SEQ; const int t0 = c * 128;
    LAS unsigned char* lds = F.lds; LAS float* sm = (LAS float*)(lds + ML_SM);
    if (F.wave == 0) {
        ml_gates(GT, rowb + t0, hm, sm, ((int)(threadIdx.x & 63u)));
        LDS_WAIT();
        const float bend = sm[127];
        const float w0 = bend - sm[2 * ((int)(threadIdx.x & 63u))] + sm[128 + 2 * ((int)(threadIdx.x & 63u))], w1 = bend - sm[2 * ((int)(threadIdx.x & 63u)) + 1] + sm[128 + 2 * ((int)(threadIdx.x & 63u)) + 1];
        const float ml = wave_max(fmaxf(w0, w1));
        sm[256 + 2 * ((int)(threadIdx.x & 63u))] = __expf(w0 - ml); sm[256 + 2 * ((int)(threadIdx.x & 63u)) + 1] = __expf(w1 - ml);
        if (((int)(threadIdx.x & 63u)) == 0) { WSP(float, WS_BEND)[unit] = bend; WSP(float, WS_MLOC)[unit] = ml; }
    }
    __syncthreads();
    ml_conv_tile<true>(Z, rowb, t0, 512 + hm * 128, A.in[7], 512 + hm * 128, 0.08838834764831845f, lds + ML_K, sm + 256, ((int)threadIdx.x));
    ml_vt_tile(Z, rowb + t0, 1024 + hm * 128, lds + ML_V, ((int)threadIdx.x));
    __syncthreads();
    f32x4 acc[2][4];
#pragma unroll
    for (int m = 0; m < 2; ++m)
#pragma unroll
        for (int n = 0; n < 4; ++n) acc[m][n] = (f32x4){0.f, 0.f, 0.f, 0.f};
    const int dv0 = 32 * (F.wave >> 1), dk0 = 64 * (F.wave & 1);
    mma_nt<2, 4>(lds + ML_V + dv0 * TS, TS, lds + ML_K + dk0 * TS, TS, 128, acc, ((int)(threadIdx.x & 63u)));
    {
        const int lane_ = (int)(threadIdx.x & 63u);
#pragma unroll
        for (int m = 0; m < 2; ++m)
#pragma unroll
            for (int n = 0; n < 4; ++n)
#pragma unroll
                for (int i = 0; i < 4; ++i) *(LAS bf16*)(lds + ML_Q + (dv0 + 16 * m + 4 * (lane_ >> 4) + i) * TS + (dk0 + 16 * n + (lane_ & 15)) * 2) = (bf16)f2bf(acc[m][n][i]);
        __syncthreads();
        bf16* CL = WSP(bf16, WS_CLOC) + (size_t)unit * 16384;
#pragma unroll
        for (int it = 0; it < 4; ++it) { const int item = (int)threadIdx.x + 512 * it, rr = item >> 4, ch = (item & 15) * 8;
            *(GAS v4u*)(CL + rr * 128 + ch) = *(const LAS v4u*)(lds + ML_Q + rr * TS + ch * 2); }
    }
    if (((int)threadIdx.x) < 128) { float s = 0.f; const LAS bf16* kr = (const LAS bf16*)(lds + ML_K + ((int)threadIdx.x) * TS);
        for (int l = 0; l < 128; ++l) s += bf2f(kr[l]);
        WSP(float, WS_NLOC)[(size_t)unit * 128 + ((int)threadIdx.x)] = s; }
    __syncthreads();
}
__device__ __forceinline__ void mlstm_scan_unit(Frame& F, int unit) {
    const int bh = unit >> 3, sl = unit & 7;
    LAS float* tab = (LAS float*)F.lds;
    if (((int)threadIdx.x) == 0) {
        const float* BE = WSP(float, WS_BEND) + bh * 64; const float* ML = WSP(float, WS_MLOC) + bh * 64; float* MP = WSP(float, WS_MPREV) + bh * 64;
        float m = 0.f;
        for (int c = 0; c < 64; ++c) { const float be = BE[c], ml = ML[c]; const float mn = fmaxf(be + m, ml);
            tab[c] = __expf(be + m - mn); tab[64 + c] = __expf(ml - mn); if (sl == 0) MP[c] = m; m = mn; }
    }
    __syncthreads();
    bf16* CL = WSP(bf16, WS_CLOC) + (size_t)bh * 64 * 16384 + sl * 2048 + 4 * ((int)threadIdx.x);
    float s0 = 0.f, s1 = 0.f, s2 = 0.f, s3 = 0.f;
#pragma unroll 8
    for (int c = 0; c < 64; ++c) { GAS v2u* p = (GAS v2u*)(CL + (size_t)c * 16384); const v2u v = *p; v2u o; o.x = pk2(s0, s1); o.y = pk2(s2, s3); *p = o;
        const float a = tab[c], sc = tab[64 + c]; const unsigned v0 = v.x, v1 = v.y;
        s0 = a * s0 + sc * bflo(v0); s1 = a * s1 + sc * bfhi(v0); s2 = a * s2 + sc * bflo(v1); s3 = a * s3 + sc * bfhi(v1); }
    if (sl == 0 && ((int)threadIdx.x) < 128) { float* NL = WSP(float, WS_NLOC) + (size_t)bh * 64 * 128 + ((int)threadIdx.x); float s = 0.f;
        for (int c = 0; c < 64; ++c) { const float v = NL[c * 128]; NL[c * 128] = s; s = tab[c] * s + tab[64 + c] * v; } }
    __syncthreads();
}
__device__ __forceinline__ void mlstm_c_unit(Frame& F, const Args& A, int unit) {
    const int c = unit & 63, bh = unit >> 6, hm = bh & 3, b = bh >> 2;
    const bf16* Z = WSP(bf16, WS_Z); const float* GT = WSP(float, WS_GATES);
    const size_t rowb = (size_t)b * SEQ; const int t0 = c * 128;
    LAS unsigned char* lds = F.lds; LAS float* sm = (LAS float*)(lds + ML_SM);
    const int lane = ((int)(threadIdx.x & 63u)), w = F.wave, tid = ((int)threadIdx.x);
    const float mprev = WSP(float, WS_MPREV)[unit];
    const int l0 = 32 * (w >> 1), c0 = 64 * (w & 1);
    if (w == 0) {
        ml_gates(GT, rowb + t0, hm, sm, lane);
        LDS_WAIT();
        const float b0 = sm[2 * lane], b1 = sm[2 * lane + 1];
        const float g0 = sm[128 + 2 * lane] - b0, g1 = sm[128 + 2 * lane + 1] - b1;
        float pm = fmaxf(g0, g1);
#pragma unroll
        for (int o = 1; o < 64; o <<= 1) { const float t = __shfl_up(pm, o); if (lane >= o) pm = fmaxf(pm, t); }
        float pe = __shfl_up(pm, 1); if (lane == 0) pe = -INFINITY;
        const float M0 = fmaxf(mprev, fmaxf(pe, g0)), M1 = fmaxf(mprev, pm);
        sm[256 + 2 * lane] = g0; sm[256 + 2 * lane + 1] = g1;
        sm[384 + 2 * lane] = M0; sm[384 + 2 * lane + 1] = M1;
        sm[512 + 2 * lane] = __expf(mprev - M0); sm[512 + 2 * lane + 1] = __expf(mprev - M1);
        sm[640 + 2 * lane] = __expf(-b0 - M0); sm[640 + 2 * lane + 1] = __expf(-b1 - M1);
        sm[768 + 2 * lane] = 0.f; sm[768 + 2 * lane + 1] = 0.f; sm[896 + 2 * lane] = 0.f; sm[896 + 2 * lane + 1] = 0.f;
    }
    if (w == 1) { sm[1152 + lane] = WSP(float, WS_NLOC)[(size_t)unit * 128 + lane]; sm[1152 + 64 + lane] = WSP(float, WS_NLOC)[(size_t)unit * 128 + 64 + lane]; }
    ml_conv_tile<false>(Z, rowb, t0, hm * 128, A.in[7], hm * 128, 1.f, lds + ML_Q, nullptr, tid);
    ml_conv_tile<false>(Z, rowb, t0, 512 + hm * 128, A.in[7], 512 + hm * 128, 0.08838834764831845f, lds + ML_K, nullptr, tid);
    ml_vt_tile(Z, rowb + t0, 1024 + hm * 128, lds + ML_V, tid);
    __syncthreads();
    bf16x8 cpf[4][4];
    { const bf16* CP = WSP(bf16, WS_CLOC) + (size_t)unit * 16384;
      const int r = lane & 15, kq = (lane >> 4) * 8;
#pragma unroll
      for (int kk = 0; kk < 4; ++kk)
#pragma unroll
          for (int n = 0; n < 4; ++n) cpf[kk][n] = *(const GAS bf16x8*)(CP + (size_t)(c0 + n * 16 + r) * 128 + 32 * kk + kq); }
    const int lr = 4 * (lane >> 4), lc = lane & 15;
    { const int l = tid >> 2, part = tid & 3; float s = 0.f;
#pragma unroll
        for (int j = 0; j < 4; ++j) { const v4u qv = *(const LAS v4u*)(lds + ML_Q + l * TS + part * 64 + j * 16);
            const f32x4 n0 = *(const LAS f32x4*)(sm + 1152 + part * 32 + j * 8), n1 = *(const LAS f32x4*)(sm + 1152 + part * 32 + j * 8 + 4);
            const unsigned q0 = qv.x, q1 = qv.y, q2 = qv.z, q3 = qv.w;
            s += (bflo(q0) * n0.x + bfhi(q0) * n0.y) + (bflo(q1) * n0.z + bfhi(q1) * n0.w) + (bflo(q2) * n1.x + bfhi(q2) * n1.y) + (bflo(q3) * n1.z + bfhi(q3) * n1.w); }
        s += __shfl_xor(s, 1); s += __shfl_xor(s, 2);
        if (part == 0) sm[1024 + l] = s; }
    f32x4 acc[2][4];
#pragma unroll
    for (int m = 0; m < 2; ++m)
#pragma unroll
        for (int n = 0; n < 4; ++n) acc[m][n] = (f32x4){0.f, 0.f, 0.f, 0.f};
    mma_nt<2, 4>(lds + ML_Q + l0 * TS, TS, lds + ML_K + c0 * TS, TS, 128, acc, lane);
#pragma unroll
    for (int m = 0; m < 2; ++m)
#pragma unroll
        for (int i = 0; i < 4; ++i) { const int l = l0 + 16 * m + lr + i; const float Ml = sm[384 + l]; float rsum = 0.f;
#pragma unroll
            for (int n = 0; n < 4; ++n) { const int s = c0 + 16 * n + lc; const float v = (s <= l) ? acc[m][n][i] * __expf(sm[256 + s] - Ml) : 0.f; acc[m][n][i] = v; rsum += v; }
            rsum += __shfl_xor(rsum, 1); rsum += __shfl_xor(rsum, 2); rsum += __shfl_xor(rsum, 4); rsum += __shfl_xor(rsum, 8);
            if (lc == 0) __hip_atomic_fetch_add(sm + 768 + l, rsum, __ATOMIC_RELAXED, __HIP_MEMORY_SCOPE_WORKGROUP); }
    __syncthreads();
#pragma unroll
    for (int m = 0; m < 2; ++m)
#pragma unroll
        for (int n = 0; n < 4; ++n)
#pragma unroll
            for (int i = 0; i < 4; ++i) *(LAS bf16*)(lds + ML_K + (l0 + 16 * m + lr + i) * TS + (c0 + 16 * n + lc) * 2) = (bf16)f2bf(acc[m][n][i]);
    __syncthreads();
    f32x4 ai[2][4], ae[2][4];
#pragma unroll
    for (int m = 0; m < 2; ++m)
#pragma unroll
        for (int n = 0; n < 4; ++n) { ai[m][n] = (f32x4){0.f, 0.f, 0.f, 0.f}; ae[m][n] = (f32x4){0.f, 0.f, 0.f, 0.f}; }
    mma_nt<2, 4>(lds + ML_K + l0 * TS, TS, lds + ML_V + c0 * TS, TS, 128, ai, lane);
    {
        const int r = lane & 15, kq = (lane >> 4) * 8;
#pragma unroll
        for (int kk = 0; kk < 4; ++kk) {
            bf16x8 a[2];
#pragma unroll
            for (int m = 0; m < 2; ++m) a[m] = *(const LAS bf16x8*)(lds + ML_Q + (l0 + m * 16 + r) * TS + (32 * kk + kq) * 2);
#pragma unroll
            for (int m = 0; m < 2; ++m)
#pragma unroll
                for (int n = 0; n < 4; ++n) ae[m][n] = __builtin_amdgcn_mfma_f32_16x16x32_bf16(a[m], cpf[kk][n], ae[m][n], 0, 0, 0);
        }
    }
#pragma unroll
    for (int m = 0; m < 2; ++m)
#pragma unroll
        for (int i = 0; i < 4; ++i) { const int l = l0 + 16 * m + lr + i; const float wi = sm[512 + l];
            const float den = wi * sm[1024 + l] + sm[768 + l]; const float dinv = 1.f / fmaxf(fabsf(den), sm[640 + l]); float ssq = 0.f;
#pragma unroll
            for (int n = 0; n < 4; ++n) { const float hv = (wi * ae[m][n][i] + ai[m][n][i]) * dinv; ai[m][n][i] = hv; ssq += hv * hv; }
            ssq += __shfl_xor(ssq, 1); ssq += __shfl_xor(ssq, 2); ssq += __shfl_xor(ssq, 4); ssq += __shfl_xor(ssq, 8);
            if (lc == 0) __hip_atomic_fetch_add(sm + 896 + l, ssq, __ATOMIC_RELAXED, __HIP_MEMORY_SCOPE_WORKGROUP); }
    __syncthreads();
    v4u owf[4];
#pragma unroll
    for (int it = 0; it < 4; ++it) { const int item = tid + 512 * it, l = item >> 4, ch = (item & 15) * 8; owf[it] = *(const GAS v4u*)(Z + (rowb + t0 + l) * NZ0 + 1536 + hm * 128 + ch); }
    LAS float* HT = (LAS float*)(lds + ML_Q);
#pragma unroll
    for (int m = 0; m < 2; ++m)
#pragma unroll
        for (int i = 0; i < 4; ++i) { const int l = l0 + 16 * m + lr + i; const float rstd = rsqrtf(sm[896 + l] * (1.f / 128.f) + EPS);
#pragma unroll
            for (int n = 0; n < 4; ++n) HT[l * 132 + c0 + 16 * n + lc] = ai[m][n][i] * rstd; }
    __syncthreads();
    { const float* mg = A.in[10] + hm * 128; bf16* Y = WSP(bf16, WS_XNY);
#pragma unroll
      for (int it = 0; it < 4; ++it) { const int item = tid + 512 * it, l = item >> 4, ch = (item & 15) * 8; const size_t row = rowb + t0 + l;
          const v4u ow = owf[it];
          const f32x4 h0 = *(const LAS f32x4*)(HT + l * 132 + ch), h1 = *(const LAS f32x4*)(HT + l * 132 + ch + 4), g0 = *(const f32x4*)(mg + ch), g1 = *(const f32x4*)(mg + ch + 4);
          v4u o; o.x = pk2(h0.x * g0.x * sigmoid_f(bflo(ow.x)), h0.y * g0.y * sigmoid_f(bfhi(ow.x))); o.y = pk2(h0.z * g0.z * sigmoid_f(bflo(ow.y)), h0.w * g0.w * sigmoid_f(bfhi(ow.y)));
          o.z = pk2(h1.x * g1.x * sigmoid_f(bflo(ow.z)), h1.y * g1.y * sigmoid_f(bfhi(ow.z))); o.w = pk2(h1.z * g1.z * sigmoid_f(bflo(ow.w)), h1.w * g1.w * sigmoid_f(bfhi(ow.w)));
          *(GAS v4u*)(Y + row * 1024 + hm * 128 + ch) = o; } }
    __syncthreads();
}
template <int N> __device__ __forceinline__ void bitonic_sort_desc(float (&v)[N]) {
#pragma unroll
    for (int k = 2; k <= N; k <<= 1)
#pragma unroll
        for (int j = k >> 1; j > 0; j >>= 1)
#pragma unroll
            for (int i = 0; i < N; ++i) { const int l = i ^ j; if (l > i) { const bool desc = ((i & k) == 0); const float a = v[i], b = v[l]; const float mx = fmaxf(a, b), mn = fminf(a, b); v[i] = desc ? mx : mn; v[l] = desc ? mn : mx; } }
}
__device__ __forceinline__ void merge_top16(float (&run)[16], const float (&nw)[16]) {
#pragma unroll
    for (int i = 0; i < 16; ++i) run[i] = fmaxf(run[i], nw[15 - i]);
#pragma unroll
    for (int j = 8; j > 0; j >>= 1)
#pragma unroll
        for (int i = 0; i < 16; ++i) { const int l = i ^ j; if (l > i) { const float a = run[i], b = run[l]; run[i] = fmaxf(a, b); run[l] = fminf(a, b); } }
}
constexpr int SCS = 132;
__device__ __forceinline__ void peer_route_unit(Frame& F, int tok0, int hd, const bf16x8 (&kf)[4][2]) {
    const bf16* QRY = WSP(bf16, WS_QRY); unsigned short* IDX = WSP(unsigned short, WS_IDX); float* GATE = WSP(float, WS_GATE);
    LAS float* SC = (LAS float*)F.lds;
    const int lane = ((int)(threadIdx.x & 63u)), w = F.wave, tid = ((int)threadIdx.x);
    {
        constexpr int AST = 528;
        LAS unsigned char* As = F.lds;
#pragma unroll
        for (int i = 0; i < 8; ++i) { const int ch = tid + 512 * i, row = ch >> 5, cc = ch & 31;
            *(LAS v4u*)(As + row * AST + cc * 16) = *(const GAS v4u*)(QRY + (size_t)(tok0 + row) * QLD + hd * 256 + cc * 8); }
        __syncthreads();
        const int p = w & 1, nq = w >> 1, r = lane & 15, kq = (lane >> 4) * 16;
        f32x4 acc[8][2];
#pragma unroll
        for (int m = 0; m < 8; ++m) { acc[m][0] = (f32x4){0.f, 0.f, 0.f, 0.f}; acc[m][1] = (f32x4){0.f, 0.f, 0.f, 0.f}; }
#pragma unroll
        for (int ks = 0; ks < 4; ++ks)
#pragma unroll
            for (int m = 0; m < 8; ++m) { const bf16x8 a = *(const LAS bf16x8*)(As + (16 * m + r) * AST + p * 256 + ks * 64 + kq);
                acc[m][0] = __builtin_amdgcn_mfma_f32_16x16x32_bf16(a, kf[ks][0], acc[m][0], 0, 0, 0);
                acc[m][1] = __builtin_amdgcn_mfma_f32_16x16x32_bf16(a, kf[ks][1], acc[m][1], 0, 0, 0); }
        __syncthreads();
#pragma unroll
        for (int m = 0; m < 8; ++m)
#pragma unroll
            for (int n = 0; n < 2; ++n)
#pragma unroll
                for (int i = 0; i < 4; ++i) SC[(p * 128 + 16 * m + 4 * (lane >> 4) + i) * SCS + 32 * nq + 16 * n + r] = acc[m][n][i];
    }
    __syncthreads();
    {
        const int t = tid & 127, p = (tid >> 7) & 1, half = tid >> 8;
        LAS float* seg = SC + (p * 128 + t) * SCS + 64 * half;
        float run[16], nw[16];
#pragma unroll
        for (int ch = 0; ch < 4; ++ch) {
#pragma unroll
            for (int q = 0; q < 4; ++q) { const f32x4 v = *(const LAS f32x4*)(seg + 16 * ch + 4 * q);
#pragma unroll
                for (int e = 0; e < 4; ++e) { const unsigned n = (unsigned)(64 * half + 16 * ch + 4 * q + e); const float key = u2f((f2u(v[e]) & ~127u) | n);
                    if (ch == 0) run[4 * q + e] = key; else nw[4 * q + e] = key; } }
            if (ch == 0) bitonic_sort_desc<16>(run); else { bitonic_sort_desc<16>(nw); merge_top16(run, nw); }
        }
#pragma unroll
        for (int q = 0; q < 4; ++q) *(LAS f32x4*)(seg + 4 * q) = (f32x4){run[4 * q], run[4 * q + 1], run[4 * q + 2], run[4 * q + 3]};
    }
    __syncthreads();
    if (tid < 128) {
        const int t = tid;
        float s0[16], s1[16];
        {
            LAS float* a = SC + (0 * 128 + t) * SCS; float nw[16];
#pragma unroll
            for (int q = 0; q < 4; ++q) { const f32x4 v = *(const LAS f32x4*)(a + 4 * q), u = *(const LAS f32x4*)(a + 64 + 4 * q);
#pragma unroll
                for (int e = 0; e < 4; ++e) { s0[4 * q + e] = v[e]; nw[4 * q + e] = u[e]; } }
            merge_top16(s0, nw);
#pragma unroll
            for (int q = 0; q < 4; ++q) *(LAS f32x4*)(a + 16 + 4 * q) = (f32x4){s0[4 * q], s0[4 * q + 1], s0[4 * q + 2], s0[4 * q + 3]};
        }
        {
            LAS float* a = SC + (1 * 128 + t) * SCS; float nw[16];
#pragma unroll
            for (int q = 0; q < 4; ++q) { const f32x4 v = *(const LAS f32x4*)(a + 4 * q), u = *(const LAS f32x4*)(a + 64 + 4 * q);
#pragma unroll
                for (int e = 0; e < 4; ++e) { s1[4 * q + e] = v[e]; nw[4 * q + e] = u[e]; } }
            merge_top16(s1, nw);
#pragma unroll
            for (int q = 0; q < 4; ++q) *(LAS f32x4*)(a + 16 + 4 * q) = (f32x4){s1[4 * q], s1[4 * q + 1], s1[4 * q + 2], s1[4 * q + 3]};
        }
#pragma unroll
        for (int i = 0; i < 16; ++i) { s0[i] = u2f(f2u(s0[i]) & ~127u); s1[i] = u2f(f2u(s1[i]) & ~127u); }
        constexpr int CNT[16] = {16, 8, 5, 4, 3, 2, 2, 2, 1, 1, 1, 1, 1, 1, 1, 1};
        constexpr int OFF[16] = {0, 16, 24, 29, 33, 36, 38, 40, 42, 43, 44, 45, 46, 47, 48, 49};
        float top[16], nw[16];
#pragma unroll
        for (int grp = 0; grp < 4; ++grp) {
#pragma unroll
            for (int e = 0; e < 16; ++e) nw[e] = -INFINITY;
#pragma unroll
            for (int i = 0; i < 16; ++i)
#pragma unroll
                for (int j = 0; j < 16; ++j) if (j < CNT[i] && (OFF[i] + j) / 16 == grp) {
                    const float sum = s0[i] + s1[j];
                    nw[(OFF[i] + j) % 16] = u2f((f2u(sum) & ~255u) | (unsigned)(i * 16 + j)); }
            bitonic_sort_desc<16>(nw);
            if (grp == 0) {
#pragma unroll
                for (int e = 0; e < 16; ++e) top[e] = nw[e];
            } else merge_top16(top, nw);
        }
        float sc[16], den = 0.f;
        const float mx = u2f(f2u(top[0]) & ~255u);
#pragma unroll
        for (int k = 0; k < 16; ++k) { sc[k] = __expf(u2f(f2u(top[k]) & ~255u) - mx); den += sc[k]; }
        const float inv = 1.f / den;
        LDS_WAIT();
        const LAS unsigned* l0 = (const LAS unsigned*)(SC + (0 * 128 + t) * SCS + 16); const LAS unsigned* l1 = (const LAS unsigned*)(SC + (1 * 128 + t) * SCS + 16);
        const size_t ob = (size_t)(tok0 + t) * 128 + hd * 16;
        unsigned eid[16];
#pragma unroll
        for (int k = 0; k < 16; ++k) { const unsigned id = f2u(top[k]) & 255u; const unsigned e0 = l0[id >> 4] & 127u, e1 = l1[id & 15u] & 127u; eid[k] = e0 * 128u + e1; }
        { v4u i0, i1; i0.x = eid[0] | (eid[1] << 16); i0.y = eid[2] | (eid[3] << 16); i0.z = eid[4] | (eid[5] << 16); i0.w = eid[6] | (eid[7] << 16);
          i1.x = eid[8] | (eid[9] << 16); i1.y = eid[10] | (eid[11] << 16); i1.z = eid[12] | (eid[13] << 16); i1.w = eid[14] | (eid[15] << 16);
          *(GAS v4u*)(IDX + ob) = i0; *(GAS v4u*)(IDX + ob + 8) = i1; }
#pragma unroll
        for (int q4 = 0; q4 < 4; ++q4) *(GAS f32x4*)(GATE + ob + 4 * q4) = (f32x4){sc[4 * q4] * inv, sc[4 * q4 + 1] * inv, sc[4 * q4 + 2] * inv, sc[4 * q4 + 3] * inv};
    }
    __syncthreads();
}
__device__ __forceinline__ void peer_u_phase(Frame& F, const unsigned char* U8  ) {
    const bf16* XN = WSP(bf16, WS_XNY); const unsigned short* IDX = WSP(unsigned short, WS_IDX); unsigned short* PART = WSP(unsigned short, WS_PART);
    const int lane = (int)(threadIdx.x & 63u), t8 = lane >> 3, l8 = lane & 7;
    const int g = F.bid & 7, nsw = (F.G >> 3) * NWAVES, ws = (F.bid >> 3) * NWAVES + F.wave;
    const unsigned char* Ug = U8 + (size_t)g * 16384 * 128; const unsigned lo8 = 16u * (unsigned)l8;
    for (int wi = ws; wi < M / 8; wi += nsw) {
        const int tok = wi * 8 + t8;
        int hq[4]; float hsc;
        { const bf16* hp = XN + (size_t)tok * D + 128 * g + 16 * l8; const v4u x = *(const GAS v4u*)hp, y = *(const GAS v4u*)(hp + 8);
          const float hf[16] = {bflo(x.x), bfhi(x.x), bflo(x.y), bfhi(x.y), bflo(x.z), bfhi(x.z), bflo(x.w), bfhi(x.w), bflo(y.x), bfhi(y.x), bflo(y.y), bfhi(y.y), bflo(y.z), bfhi(y.z), bflo(y.w), bfhi(y.w)};
          float am = 0.f;
#pragma unroll
          for (int i = 0; i < 16; ++i) am = fmaxf(am, fabsf(hf[i]));
          am = fmaxf(am, __shfl_xor(am, 1)); am = fmaxf(am, __shfl_xor(am, 2)); am = fmaxf(am, __shfl_xor(am, 4));
          const float hinv = am > 1e-30f ? 127.f / am : 0.f; hsc = am * (1.f / (127.f * 64.f));
#pragma unroll
          for (int q4 = 0; q4 < 4; ++q4) { unsigned wv = 0;
#pragma unroll
              for (int e = 0; e < 4; ++e) { const int qv = (int)rintf(hf[4 * q4 + e] * hinv); wv |= ((unsigned)qv & 0xffu) << (8 * e); }
              hq[q4] = (int)wv; } }
        const unsigned short* ip = IDX + (size_t)tok * 128; unsigned short* pp = PART + ((size_t)g * M + tok) * 128;
#pragma unroll 4
        for (int gi = 0; gi < 16; ++gi) {
            const v4u idp = *(const GAS v4u*)(ip + 8 * gi);
            const unsigned e0 = idp.x & 0xffffu, e1 = idp.x >> 16, e2 = idp.y & 0xffffu, e3 = idp.y >> 16, e4 = idp.z & 0xffffu, e5 = idp.z >> 16, e6 = idp.w & 0xffffu, e7 = idp.w >> 16;
            const v4u r0 = *(const GAS v4u*)(Ug + ((e0 << 7) | lo8)), r1 = *(const GAS v4u*)(Ug + ((e1 << 7) | lo8)), r2 = *(const GAS v4u*)(Ug + ((e2 << 7) | lo8)), r3 = *(const GAS v4u*)(Ug + ((e3 << 7) | lo8));
            const v4u r4 = *(const GAS v4u*)(Ug + ((e4 << 7) | lo8)), r5 = *(const GAS v4u*)(Ug + ((e5 << 7) | lo8)), r6 = *(const GAS v4u*)(Ug + ((e6 << 7) | lo8)), r7 = *(const GAS v4u*)(Ug + ((e7 << 7) | lo8));
#define U_DOT(R) ({ const unsigned a_ = R.x, b_ = R.y, c_ = R.z, d_ = R.w; int acc_ = __builtin_amdgcn_sdot4((int)a_, hq[0], 0, false); acc_ = __builtin_amdgcn_sdot4((int)b_, hq[1], acc_, false); \
                    acc_ = __builtin_amdgcn_sdot4((int)c_, hq[2], acc_, false); acc_ = __builtin_amdgcn_sdot4((int)d_, hq[3], acc_, false); \
                    acc_ += __shfl_xor(acc_, 1); acc_ += __shfl_xor(acc_, 2); acc_ += __shfl_xor(acc_, 4); (float)acc_ * hsc; })
            const float d0 = U_DOT(r0), d1 = U_DOT(r1), d2 = U_DOT(r2), d3 = U_DOT(r3), d4 = U_DOT(r4), d5 = U_DOT(r5), d6 = U_DOT(r6), d7 = U_DOT(r7);
#undef U_DOT
            if (l8 == 0) { v4u o; o.x = f2h2(d0, d1); o.y = f2h2(d2, d3); o.z = f2h2(d4, d5); o.w = f2h2(d6, d7); *(GAS v4u*)(pp + 8 * gi) = o; }
        }
    }
}
template <int CTRL> __device__ __forceinline__ int dppx(int v) { return __builtin_amdgcn_update_dpp(0, v, CTRL, 0xf, 0xf, false); }

__device__ __forceinline__ void peer_sort_phase(Frame& F) {
    const unsigned short* IDX = WSP(unsigned short, WS_IDX); unsigned* LIST = WSP(unsigned, WS_LIST);
    LAS unsigned* hist = (LAS unsigned*)F.lds;
    LAS unsigned* aux = hist + 2112;
    const int tid = (int)threadIdx.x, lane = tid & 63;
    for (int unit = F.bid; unit < 256; unit += F.G) {
        const unsigned t = ((unsigned)unit & 7u) * 4u + ((unsigned)unit >> 6), r = ((unsigned)unit >> 3) & 7u;
        const GAS v4u* src = (const GAS v4u*)(IDX + (size_t)t * 131072);
        for (int i = tid; i < 2112; i += NTHR) hist[i] = 0u;
        if (tid < 16) aux[tid] = 0u;
        __syncthreads();
        unsigned low = 0u;
        for (int hf = 0; hf < 2; ++hf) {
        v4u w[16];
#pragma unroll
        for (int st = 0; st < 16; ++st) w[st] = src[(hf * 16 + st) * 512 + tid];
#pragma unroll
        for (int st = 0; st < 16; ++st) { const unsigned ww[4] = {w[st].x, w[st].y, w[st].z, w[st].w};
#pragma unroll
            for (int k = 0; k < 8; ++k) { const unsigned e = (k & 1) ? (ww[k >> 1] >> 16) : (ww[k >> 1] & 0xffffu); const unsigned rg = e >> 11;
                low += rg < r ? 1u : 0u;
                __hip_atomic_fetch_add(hist + (rg == r ? (e & 2047u) : 2048u + (unsigned)lane), 1u, __ATOMIC_RELAXED, __HIP_MEMORY_SCOPE_WORKGROUP); } }
        }
#pragma unroll
        for (int o = 1; o < 64; o <<= 1) low += __shfl_xor(low, o);
        if (lane == 0) __hip_atomic_fetch_add(aux, low, __ATOMIC_RELAXED, __HIP_MEMORY_SCOPE_WORKGROUP);
        __syncthreads();
        {
            const unsigned h0 = hist[4 * tid], h1 = hist[4 * tid + 1], h2 = hist[4 * tid + 2], h3 = hist[4 * tid + 3]; const unsigned s = h0 + h1 + h2 + h3; unsigned inc = s;
#pragma unroll
            for (int o = 1; o < 64; o <<= 1) { const unsigned v = __shfl_up(inc, o); if (lane >= o) inc += v; }
            if (lane == 63) aux[8 + F.wave] = inc;
            __syncthreads();
            unsigned off = aux[0];
            for (int wv = 0; wv < F.wave; ++wv) off += aux[8 + wv];
            const unsigned ex = off + inc - s;
            hist[4 * tid] = ex; hist[4 * tid + 1] = ex + h0; hist[4 * tid + 2] = ex + h0 + h1; hist[4 * tid + 3] = ex + h0 + h1 + h2;
        }
        __syncthreads();
        unsigned* L = LIST + (size_t)t * 131072;
        for (int hf = 0; hf < 2; ++hf) {
        v4u w[16];
#pragma unroll
        for (int st = 0; st < 16; ++st) w[st] = src[(hf * 16 + st) * 512 + tid];
#pragma unroll
        for (int st = 0; st < 16; ++st) { const unsigned ww[4] = {w[st].x, w[st].y, w[st].z, w[st].w}; const unsigned i0 = (unsigned)((hf * 16 + st) * 512 + tid) * 8u;
            unsigned pos[8];
#pragma unroll
            for (int k = 0; k < 8; ++k) { const unsigned e = (k & 1) ? (ww[k >> 1] >> 16) : (ww[k >> 1] & 0xffffu);
                pos[k] = __hip_atomic_fetch_add(hist + ((e >> 11) == r ? (e & 2047u) : 2048u + (unsigned)lane), 1u, __ATOMIC_RELAXED, __HIP_MEMORY_SCOPE_WORKGROUP); }
#pragma unroll
            for (int k = 0; k < 8; ++k) { const unsigned e = (k & 1) ? (ww[k >> 1] >> 16) : (ww[k >> 1] & 0xffffu);
                if ((e >> 11) == r) L[pos[k]] = (e << 17) | (i0 + (unsigned)k); } }
        }
        __syncthreads();
    }
}

__device__ __forceinline__ void peer_u_sorted(Frame& F, const unsigned char* U8  ) {
    const bf16* XN = WSP(bf16, WS_XNY); const unsigned* LIST = WSP(unsigned, WS_LIST); unsigned short* PART = WSP(unsigned short, WS_PART);
    const int lane = (int)(threadIdx.x & 63u), p8 = lane >> 3, l8 = lane & 7;
    LAS unsigned char* hl = F.lds;
    LAS float* hs = (LAS float*)(F.lds + 131072);
    const unsigned lo8 = 16u * (unsigned)l8;
    for (int unit = F.bid; unit < 256; unit += F.G) {
        const int t = unit >> 3, g = unit & 7;
        const unsigned char* Ug = U8 + (size_t)g * 16384 * 128;
#pragma unroll 4
        for (int s = 0; s < 16; ++s) { const int tl = (s * NWAVES + F.wave) * 8 + p8;
            const bf16* hp = XN + (size_t)(t * 1024 + tl) * D + 128 * g + 16 * l8; const v4u x = *(const GAS v4u*)hp, y = *(const GAS v4u*)(hp + 8);
            const float hf[16] = {bflo(x.x), bfhi(x.x), bflo(x.y), bfhi(x.y), bflo(x.z), bfhi(x.z), bflo(x.w), bfhi(x.w), bflo(y.x), bfhi(y.x), bflo(y.y), bfhi(y.y), bflo(y.z), bfhi(y.z), bflo(y.w), bfhi(y.w)};
            float am = 0.f;
#pragma unroll
            for (int i = 0; i < 16; ++i) am = fmaxf(am, fabsf(hf[i]));
            am = fmaxf(am, __shfl_xor(am, 1)); am = fmaxf(am, __shfl_xor(am, 2)); am = fmaxf(am, __shfl_xor(am, 4));
            const float hinv = am > 1e-30f ? 127.f / am : 0.f;
            v4u hq; unsigned hw[4];
#pragma unroll
            for (int q4 = 0; q4 < 4; ++q4) { unsigned wv = 0;
#pragma unroll
                for (int e = 0; e < 4; ++e) { const int qv = (int)rintf(hf[4 * q4 + e] * hinv); wv |= ((unsigned)qv & 0xffu) << (8 * e); }
                hw[q4] = wv; }
            hq.x = hw[0]; hq.y = hw[1]; hq.z = hw[2]; hq.w = hw[3];
            *(LAS v4u*)(hl + tl * 128 + lo8) = hq;
            if (l8 == 0) hs[tl] = am * (1.f / (127.f * 64.f)); }
        __syncthreads();
        const unsigned* L = LIST + (size_t)t * 131072 + F.wave * 16384; unsigned short* P = PART + ((size_t)g * 32 + t) * 131072 + F.wave * 16384;
        const bool u2 = (l8 & 4) != 0, u1 = (l8 & 2) != 0, u0 = (l8 & 1) != 0;
        LAS unsigned* es = (LAS unsigned*)(F.lds + 135168) + F.wave * 128;
        unsigned mine0 = L[lane], mine1 = L[64 + lane];
        es[lane] = mine0;
        v4u eaA = *(const LAS v4u*)(es + p8 * 8), ebA = *(const LAS v4u*)(es + p8 * 8 + 4), eaB, ebB;
        v4u rwA[8], rwB[8];
        { const unsigned en[8] = {eaA.x, eaA.y, eaA.z, eaA.w, ebA.x, ebA.y, ebA.z, ebA.w};
#pragma unroll
          for (int j = 0; j < 8; ++j) rwA[j] = *(const GAS v4u*)(Ug + (((en[j] >> 17) << 7) | lo8)); }
#define U_TRIP(IT, RWC, EAC, EBC, RWN, EAN, EBN, SLOT) do { const int base = (IT) * 64; const int nb = ((IT) + 2 < 256 ? (IT) + 2 : 255) * 64; \
            const unsigned mine2 = L[nb + lane]; \
            LAS unsigned* sl = es + (SLOT) * 64; sl[lane] = mine1; \
            EAN = *(const LAS v4u*)(sl + p8 * 8); EBN = *(const LAS v4u*)(sl + p8 * 8 + 4); \
            { const unsigned en1[8] = {EAN.x, EAN.y, EAN.z, EAN.w, EBN.x, EBN.y, EBN.z, EBN.w}; \
              _Pragma("unroll") for (int j = 0; j < 8; ++j) RWN[j] = *(const GAS v4u*)(Ug + (((en1[j] >> 17) << 7) | lo8)); } \
            __builtin_amdgcn_sched_barrier(0);        \
            const unsigned en[8] = {EAC.x, EAC.y, EAC.z, EAC.w, EBC.x, EBC.y, EBC.z, EBC.w}; \
            int acc[8]; \
            _Pragma("unroll") for (int j = 0; j < 8; ++j) { const v4u hv = *(const LAS v4u*)(hl + ((((en[j] >> 7) & 1023u) << 7) | lo8)); \
                const unsigned ra = RWC[j].x, rb = RWC[j].y, rc = RWC[j].z, rd = RWC[j].w, ha = hv.x, hb = hv.y, hc = hv.z, hd = hv.w; \
                int a = __builtin_amdgcn_sdot4((int)ra, (int)ha, 0, false); a = __builtin_amdgcn_sdot4((int)rb, (int)hb, a, false); \
                a = __builtin_amdgcn_sdot4((int)rc, (int)hc, a, false); a = __builtin_amdgcn_sdot4((int)rd, (int)hd, a, false); acc[j] = a; } \
            int q[4], r2[2]; \
            _Pragma("unroll") for (int i = 0; i < 4; ++i) { const int send = u2 ? acc[i] : acc[i + 4], keep = u2 ? acc[i + 4] : acc[i]; q[i] = keep + dppx<0x141>(send); } \
            _Pragma("unroll") for (int i = 0; i < 2; ++i) { const int send = u1 ? q[i] : q[i + 2], keep = u1 ? q[i + 2] : q[i]; r2[i] = keep + dppx<0x4E>(send); } \
            const int send = u0 ? r2[0] : r2[1], keep = u0 ? r2[1] : r2[0]; const int tot = keep + dppx<0xB1>(send); \
            const float dv = (float)tot * hs[(mine0 >> 7) & 1023u]; \
            P[base + lane] = (unsigned short)(f2h2(dv, 0.f) & 0xffffu); \
            mine0 = mine1; mine1 = mine2; } while (0)
        for (int it = 0; it < 256; it += 2) {
            U_TRIP(it, rwA, eaA, ebA, rwB, eaB, ebB, 1);
            U_TRIP(it + 1, rwB, eaB, ebB, rwA, eaA, ebA, 0);
        }
#undef U_TRIP
        __syncthreads();
    }
}

__device__ __forceinline__ void peer_reduce_phase(Frame& F) {
    const unsigned* LIST = WSP(unsigned, WS_LIST); const unsigned short* PART = WSP(unsigned short, WS_PART); float* DT = WSP(float, WS_DTOK);
    for (int unit = F.bid; unit < 256; unit += F.G) {
        const size_t t = (size_t)(unit & 7) * 4 + (unit >> 6), k8 = (unit >> 3) & 7; const size_t tb = t * 131072;
#pragma unroll 2
        for (int st = 0; st < 4; ++st) { const size_t p0 = tb + k8 * 16384 + ((size_t)st * NTHR + (int)threadIdx.x) * 8;
            float s[8];
#pragma unroll
            for (int k = 0; k < 8; ++k) s[k] = 0.f;
#pragma unroll
            for (int g = 0; g < 8; ++g) { const v4u w = *(const GAS v4u*)(PART + (size_t)g * 32 * 131072 + p0); const unsigned w0 = w.x, w1 = w.y, w2 = w.z, w3 = w.w;
                s[0] += h2f_lo(w0); s[1] += h2f_hi(w0); s[2] += h2f_lo(w1); s[3] += h2f_hi(w1); s[4] += h2f_lo(w2); s[5] += h2f_hi(w2); s[6] += h2f_lo(w3); s[7] += h2f_hi(w3); }
            const v4u la = *(const GAS v4u*)(LIST + p0), lb = *(const GAS v4u*)(LIST + p0 + 4);
            const unsigned en[8] = {la.x, la.y, la.z, la.w, lb.x, lb.y, lb.z, lb.w};
#pragma unroll
            for (int k = 0; k < 8; ++k) DT[tb + (en[k] & 0x1ffffu)] = s[k]; }
    }
}
__device__ __forceinline__ void peer_act_phase(Frame& F, const float* ISU, const float* ISV) {
    const unsigned short* IDX = WSP(unsigned short, WS_IDX); const float* GATE = WSP(float, WS_GATE); const unsigned* PART = WSP(unsigned, WS_PART);
    unsigned short* ACT8 = WSP(unsigned short, WS_ACT); float* ACTS = WSP(float, WS_ACTS);
    const int gw = F.bid * NWAVES + F.wave, NGW = F.G * NWAVES, lane = ((int)(threadIdx.x & 63u));
    for (int tok = gw; tok < M; tok += NGW) {
        const size_t i = (size_t)tok * 128 + 2 * lane;
        const float2 dd = *(const float2*)(WSP(float, WS_DTOK) + i); const float s0 = dd.x, s1 = dd.y;
        const unsigned idw = *(const unsigned*)(IDX + i); int2 id; id.x = (int)(idw & 0xffffu); id.y = (int)(idw >> 16); const float2 gt = *(const float2*)(GATE + i);
        const float d0 = s0 * (64.f * ISU[id.x]), d1 = s1 * (64.f * ISU[id.y]);
        const float a0 = 0.5f * d0 * (1.f + erff(d0 * 0.70710678118654752f)) * gt.x * ISV[id.x], a1 = 0.5f * d1 * (1.f + erff(d1 * 0.70710678118654752f)) * gt.y * ISV[id.y];
        const float am = wave_max(fmaxf(fabsf(a0), fabsf(a1)));
        const float inv = am > 1e-30f ? 127.f / am : 0.f;
        const int q0 = (int)rintf(a0 * inv), q1 = (int)rintf(a1 * inv);
        ACT8[(size_t)tok * 64 + lane] = (unsigned short)(((unsigned)q0 & 0xffu) | (((unsigned)q1 & 0xffu) << 8));
        if (lane == 0) ACTS[tok] = am * (1.f / 127.f);
    }
}
template <bool FINAL>
__device__ __forceinline__ void peer_v_phase(Frame& F, const unsigned char* V8, const float* g2  ) {
    const unsigned short* IDX = WSP(unsigned short, WS_IDX); const unsigned* ACT8 = WSP(unsigned, WS_ACT); const float* ACTS = WSP(float, WS_ACTS);
    const int lane = ((int)(threadIdx.x & 63u)), t8 = lane >> 3, l8 = lane & 7;
    const int g = F.bid & 7, nsw = (F.G >> 3) * NWAVES, ws = (F.bid >> 3) * NWAVES + F.wave;
    const unsigned char* Vg = V8 + (size_t)g * 16384 * 128; const unsigned lo8 = 16u * (unsigned)l8;
    for (int wi = ws; wi < M / 8; wi += nsw) {
        const int tok = wi * 8 + t8;
        const unsigned short* ip = IDX + (size_t)tok * 128; const unsigned* ap = ACT8 + (size_t)tok * 32;
        int acc[16];
#pragma unroll
        for (int i = 0; i < 16; ++i) acc[i] = 0;
#pragma unroll 8
        for (int gi = 0; gi < 32; ++gi) {
            const v2u idp = *(const GAS v2u*)(ip + 4 * gi); v4u id4; id4.x = idp.x & 0xffffu; id4.y = idp.x >> 16; id4.z = idp.y & 0xffffu; id4.w = idp.y >> 16; const int qa = (int)ap[gi];
            const v4u ra = *(const GAS v4u*)(Vg + ((id4.x << 7) | lo8)), rb = *(const GAS v4u*)(Vg + ((id4.y << 7) | lo8)), rc = *(const GAS v4u*)(Vg + ((id4.z << 7) | lo8)), rd = *(const GAS v4u*)(Vg + ((id4.w << 7) | lo8));
            const unsigned A[4] = {ra.x, ra.y, ra.z, ra.w}, B[4] = {rb.x, rb.y, rb.z, rb.w}, C[4] = {rc.x, rc.y, rc.z, rc.w}, Dd[4] = {rd.x, rd.y, rd.z, rd.w};
#pragma unroll
            for (int j = 0; j < 4; ++j) {
                const unsigned ablo = __builtin_amdgcn_perm(B[j], A[j], 0x05010400u), abhi = __builtin_amdgcn_perm(B[j], A[j], 0x07030602u);
                const unsigned cdlo = __builtin_amdgcn_perm(Dd[j], C[j], 0x05010400u), cdhi = __builtin_amdgcn_perm(Dd[j], C[j], 0x07030602u);
                const unsigned t0 = __builtin_amdgcn_perm(cdlo, ablo, 0x05040100u), t1 = __builtin_amdgcn_perm(cdlo, ablo, 0x07060302u);
                const unsigned t2 = __builtin_amdgcn_perm(cdhi, abhi, 0x05040100u), t3 = __builtin_amdgcn_perm(cdhi, abhi, 0x07060302u);
                acc[4 * j] = __builtin_amdgcn_sdot4((int)t0, qa, acc[4 * j], false); acc[4 * j + 1] = __builtin_amdgcn_sdot4((int)t1, qa, acc[4 * j + 1], false);
                acc[4 * j + 2] = __builtin_amdgcn_sdot4((int)t2, qa, acc[4 * j + 2], false); acc[4 * j + 3] = __builtin_amdgcn_sdot4((int)t3, qa, acc[4 * j + 3], false);
            }
        }
        const float sc = ACTS[tok];
        const int b = tok >> 13, c0 = 128 * g + 16 * l8; bf16* xs = WSP(bf16, WS_XS) + (size_t)tok * D + c0; const float* gr = g2 + (size_t)b * 6144 + c0;
        const v4u xa = *(const GAS v4u*)xs, xb = *(const GAS v4u*)(xs + 8);
        const unsigned xw[8] = {xa.x, xa.y, xa.z, xa.w, xb.x, xb.y, xb.z, xb.w};
        float o[16];
#pragma unroll
        for (int q4 = 0; q4 < 4; ++q4) { const f32x4 gv = *(const f32x4*)(gr + 4 * q4);
            o[4 * q4] = bflo(xw[2 * q4]) + gv.x * sc * (float)acc[4 * q4]; o[4 * q4 + 1] = bfhi(xw[2 * q4]) + gv.y * sc * (float)acc[4 * q4 + 1];
            o[4 * q4 + 2] = bflo(xw[2 * q4 + 1]) + gv.z * sc * (float)acc[4 * q4 + 2]; o[4 * q4 + 3] = bfhi(xw[2 * q4 + 1]) + gv.w * sc * (float)acc[4 * q4 + 3]; }
        if (FINAL) { float* xr = F.out + (size_t)tok * D + c0;
#pragma unroll
            for (int q4 = 0; q4 < 4; ++q4) *(GAS f32x4*)(xr + 4 * q4) = (f32x4){o[4 * q4], o[4 * q4 + 1], o[4 * q4 + 2], o[4 * q4 + 3]};
        } else { v4u ya, yb; ya.x = pk2(o[0], o[1]); ya.y = pk2(o[2], o[3]); ya.z = pk2(o[4], o[5]); ya.w = pk2(o[6], o[7]); yb.x = pk2(o[8], o[9]); yb.y = pk2(o[10], o[11]); yb.z = pk2(o[12], o[13]); yb.w = pk2(o[14], o[15]);
            *(GAS v4u*)xs = ya; *(GAS v4u*)(xs + 8) = yb; }
    }
}
#ifndef MK_PER_PHASE
#define MK_PER_PHASE 0
#endif
constexpr int NPHASE = 24;
#ifndef PHASE_MASK
#define PHASE_MASK 0x1ffffffu
#endif
#define IN(k) (lo <= (k) && (k) < hi && ((PHASE_MASK >> (k)) & 1u))
#define SEAM(k) do { if (IN(k) && IN((k) + 1)) xcd_barrier(bar); } while (0)
__device__ __forceinline__ float alibi_tcut(const float* gq, const float* gk, int lane) { return 16.f * wave_max(fabsf(gq[lane])) * wave_max(fabsf(gk[lane])) + ALIBI_MARGIN; }
template <int layer>
__device__ __forceinline__ void layer_phases(Frame& F, const Args& args, const XcdBarrier& bar, const int lo, const int hi) {
    volatile LAS unsigned* MISCW = (volatile LAS unsigned*)(F.lds + MISC_OFF);
    float* MOD = WSP(float, WS_MOD);
    bf16* XNY = WSP(bf16, WS_XNY); bf16* Zb = WSP(bf16, WS_Z);

        constexpr int pb = layer * 12;
        const float* mod = MOD + (size_t)layer * 4 * 6144;
        if (IN(pb + 1)) { if (layer == 0) norm_pass<true, false>(F, args, args.in[0], args.in[4], mod, 0, XNY); else norm_pass<false, true>(F, args, WSP(bf16, WS_XS), args.in[4] + 1024, mod, 0, XNY); } SEAM(pb + 1);
        if (IN(pb + 2)) {
            const int N = layer == 0 ? NZ0 : NZ1;
            pg8::Gemm g{XNY, layer == 0 ? WSP(bf16, WS_WIN0) : WSP(bf16, WS_WIN1), M, N, D}; pg8::StaticOrder S; S.init(M, N, F.G, F.bid);
            pg8::EpiBf16QK E{Zb, N, layer == 0 ? 8 : 0, layer == 0 ? 10 : 4, layer == 0 ? 10 : 4, layer == 0 ? 12 : 8, layer == 0 ? args.in[11] : args.in[15], layer == 0 ? args.in[12] : args.in[16], 0.125f * LOG2E, (LAS float*)(F.lds + 131072)};
            pg8::gemm_phase<pg8::EpiBf16QK, pg8::StaticOrder, true, true>(F.lds, g, S, E);
        } SEAM(pb + 2);
        if (layer == 0) {
            if (IN(3)) {
                for (int u = F.bid; u < 1024 + 128; u += F.G) {
                    if (u < 1024) mlstm_a_unit(F, args, u);
                    else { const int v = u - 1024, b = v >> 5, j = v & 31;
                        kmean_unit(F, Zb, NZ0, b * SEQ + j * 256, 2560, WSP(float, WS_KMEAN) + (size_t)((b * 8) * 32 + j) * 64); }
                }
            } SEAM(3);
            if (IN(4)) {
                for (int u = F.bid; u < 128; u += F.G) mlstm_scan_unit(F, u);
                { const float tcut = alibi_tcut(args.in[11], args.in[12], ((int)(threadIdx.x & 63u)));
                  const unsigned short* ORD = WSP(unsigned short, WS_ORD) + 2048; unsigned* qw = (unsigned*)(F.ws + WS_CTL) + CW_QMOBA;
                  for (int xi = 0; xi < 8; ++xi) { const int x = (F.bid + xi) & 7;
                      for (;;) { if (((int)threadIdx.x) == 0) MISCW[0] = atomicAdd(qw + 16 * x, 1u); __syncthreads(); const unsigned qi = MISCW[0]; __syncthreads(); if (qi >= 128u) break;
                          const int u = ORD[x * 128 + qi]; moba_unit(F, u >> 8, (u >> 5) & 7, u & 31, tcut); } }
                  { unsigned* cw = (unsigned*)(F.ws + WS_CTL) + CW_QCVT0;
                      for (;;) { if (((int)threadIdx.x) == 0) MISCW[0] = atomicAdd(cw, 1u); __syncthreads(); const unsigned ci = MISCW[0]; __syncthreads(); if (ci >= 512u) break; i8_chunk(F, args, 0, (int)ci); } } }
            } SEAM(4);
            if (IN(5)) { for (int u = F.bid; u < 1024; u += F.G) mlstm_c_unit(F, args, u); } SEAM(5);
        } else {
            if (IN(pb + 4)) {
                const float* lp = args.in[17];
                const float lam = __expf(wave_sum(lp[((int)(threadIdx.x & 63u))] * lp[64 + ((int)(threadIdx.x & 63u))])) - __expf(wave_sum(lp[128 + ((int)(threadIdx.x & 63u))] * lp[192 + ((int)(threadIdx.x & 63u))])) + 0.35550906759096926f;
                { const float tcut = alibi_tcut(args.in[15], args.in[16], ((int)(threadIdx.x & 63u)));
                  const unsigned short* ORD = WSP(unsigned short, WS_ORD); unsigned* qw = (unsigned*)(F.ws + WS_CTL) + CW_QDIFF;
                  for (int xi = 0; xi < 8; ++xi) { const int x = (F.bid + xi) & 7;
                      for (;;) { if (((int)threadIdx.x) == 0) MISCW[0] = atomicAdd(qw + 16 * x, 1u); __syncthreads(); const unsigned qi = MISCW[0]; __syncthreads(); if (qi >= 256u) break;
                          const int u = ORD[x * 256 + qi]; diff_unit(F, args, u >> 9, (u >> 6) & 7, u & 63, lam, tcut); } }
                  { unsigned* cw = (unsigned*)(F.ws + WS_CTL) + CW_QCVT1;
                      for (;;) { if (((int)threadIdx.x) == 0) MISCW[0] = atomicAdd(cw, 1u); __syncthreads(); const unsigned ci = MISCW[0]; __syncthreads(); if (ci >= 512u) break; i8_chunk(F, args, 1, (int)ci); } } }
            } SEAM(pb + 4);
        }
        if (IN(pb + 6)) {
            pg8::Gemm g{XNY, layer == 0 ? WSP(bf16, WS_WOUT0) : WSP(bf16, WS_WOUT1), M, D, D}; pg8::StaticOrder S; S.init(M, D, F.G, F.bid);
            if (layer == 0) { pg8::EpiResid<false> E{args.in[0], WSP(bf16, WS_XS), mod + 2 * 1024}; pg8::gemm_phase<pg8::EpiResid<false>, pg8::StaticOrder, true, true>(F.lds, g, S, E); }
            else { pg8::EpiResid<true> E{WSP(bf16, WS_XS), WSP(bf16, WS_XS), mod + 2 * 1024}; pg8::gemm_phase<pg8::EpiResid<true>, pg8::StaticOrder, true, true>(F.lds, g, S, E); }
        } SEAM(pb + 6);
        if (IN(pb + 7)) { norm_pass<false, true>(F, args, WSP(bf16, WS_XS), args.in[5] + layer * 1024, mod, 3, XNY); } SEAM(pb + 7);
        if (IN(pb + 8)) {
            pg8::Gemm g{XNY, WSP(bf16, WS_WQ) + (size_t)layer * NQ * D, M, NQ, D}; pg8::StaticOrder S; S.init(M, NQ, F.G, F.bid);
            pg8::EpiBf16 E{WSP(bf16, WS_QRY), QLD};
            pg8::gemm_phase<pg8::EpiBf16, pg8::StaticOrder, true, true>(F.lds, g, S, E);
        } SEAM(pb + 8);
        if (IN(pb + 9)) { const bf16* KEYS = WSP(bf16, WS_KEYS) + (size_t)layer * 2 * 128 * 128;
            bf16x8 kf[4][2];
#pragma unroll
            for (int ks = 0; ks < 4; ++ks)
#pragma unroll
                for (int n = 0; n < 2; ++n) kf[ks][n] = *(const GAS bf16x8*)(KEYS + (size_t)((F.wave & 1) * 128 + 32 * (F.wave >> 1) + 16 * n + (((int)(threadIdx.x & 63u)) & 15)) * 128 + 32 * ks + 8 * (((int)(threadIdx.x & 63u)) >> 4));
            for (int u = F.bid; u < 2048; u += F.G) peer_route_unit(F, (u >> 3) * 128, u & 7, kf); } SEAM(pb + 9);
        if (IN(pb + 10)) { peer_sort_phase(F); xcd_barrier(bar); peer_u_sorted(F, F.ws + WS_UB + (size_t)layer * 8 * 16384 * 128); } SEAM(pb + 10);
        if (IN(pb + 11)) { peer_reduce_phase(F); xcd_barrier(bar); peer_act_phase(F, WSP(float, WS_ISU) + layer * 16384, WSP(float, WS_ISV) + layer * 16384); } SEAM(pb + 11);
        if (IN(pb + 12)) { peer_v_phase<layer == 1>(F, F.ws + WS_VB + (size_t)layer * 8 * 16384 * 128, mod + 5 * 1024); }
        if (layer == 0) SEAM(12);
    }
__global__ void __launch_bounds__(NTHR, 2) mega_fwd(Args args) {
    extern __shared__ __attribute__((aligned(16))) unsigned char lds_raw[];
    Frame F;
    F.lds = (LAS unsigned char*)lds_raw;
    F.wave = __builtin_amdgcn_readfirstlane((int)threadIdx.x >> 6);
    F.G = gridDim.x; F.bid = blockIdx.x;
    F.out = args.out; F.ws = args.ws;
    volatile LAS unsigned* MISC = (volatile LAS unsigned*)(F.lds + MISC_OFF);
    for (int u = ((int)threadIdx.x); u < (LDS_BYTES - LDSCTL_OFF) / 4; u += NTHR) ((LAS unsigned*)(F.lds + LDSCTL_OFF))[u] = 0u;
    __syncthreads();
    XcdBarrier bar; bar.bar = (unsigned*)(F.ws + WS_CTL) + CW_BAR; bar.x = 0; bar.st = nullptr;
    if (!MK_PER_PHASE) bar = xcd_barrier_post((unsigned*)(F.ws + WS_CTL) + CW_BAR, MISC + 8);
    const int lo = args.ph_lo, hi = args.ph_hi;

#ifdef EXTRA_BAR
    for (int i = 0; i < EXTRA_BAR; ++i) xcd_barrier(bar);
#endif
    if (IN(0)) { p0_prologue(F, args); } SEAM(0);
    layer_phases<0>(F, args, bar, lo, hi);
    layer_phases<1>(F, args, bar, lo, hi);
}
#undef IN
#undef SEAM

extern "C" void kernel_launch(void* const* d_in, const int* in_sizes, int n_in, void* d_out, int out_size, void* d_ws, size_t ws_size, hipStream_t stream) {
    static int grid = 0;
    if (grid == 0) {
        if (n_in != 24 || in_sizes[0] != M * D || out_size != M * D || ws_size < WS_END) { fprintf(stderr, "kernel_launch: unexpected problem (n_in %d, in0 %d, out %d, ws %zu < %zu); nothing launched\n", n_in, n_in > 0 ? in_sizes[0] : -1, out_size, ws_size, (size_t)WS_END); grid = -1; return; }
        int dev = 0, cus = 0, per_cu = 0;
        if (hipGetDevice(&dev) != hipSuccess || hipDeviceGetAttribute(&cus, hipDeviceAttributeMultiprocessorCount, dev) != hipSuccess) { grid = -1; return; }
        if (hipFuncSetAttribute((const void*)mega_fwd, hipFuncAttributeMaxDynamicSharedMemorySize, LDS_BYTES) != hipSuccess) { fprintf(stderr, "kernel_launch: hipFuncSetAttribute failed\n"); grid = -1; return; }
        if (hipOccupancyMaxActiveBlocksPerMultiprocessor(&per_cu, (const void*)mega_fwd, NTHR, LDS_BYTES) != hipSuccess || per_cu < 1)
            fprintf(stderr, "kernel_launch: note: occupancy query reports %d workgroups per CU\n", per_cu);
        (void)hipGetLastError();
        grid = cus;
    }
    if (grid < 0) return;
    if (hipMemsetAsync((char*)d_ws + WS_CTL, 0, CTL_ZERO_BYTES, stream) != hipSuccess) { fprintf(stderr, "kernel_launch: memset failed\n"); return; }
    Args a{};
    for (int i = 0; i < 24; ++i) a.in[i] = (const float*)d_in[i];
    a.out = (float*)d_out; a.ws = (unsigned char*)d_ws;
#if MK_PER_PHASE
    for (int p = 0; p < NPHASE + 1; ++p) { a.ph_lo = p; a.ph_hi = p + 1; hipLaunchKernelGGL(mega_fwd, dim3(grid), dim3(NTHR), LDS_BYTES, stream, a); }
#else
#ifdef MK_PROBE_HI
    a.ph_lo = 0; a.ph_hi = MK_PROBE_HI;
    hipLaunchKernelGGL(mega_fwd, dim3(grid), dim3(NTHR), LDS_BYTES, stream, a);
    if (hipMemsetAsync((char*)d_ws + WS_CTL, 0, CTL_ZERO_BYTES, stream) != hipSuccess) return;
#endif
    a.ph_lo = 0; a.ph_hi = NPHASE + 1;
    hipLaunchKernelGGL(mega_fwd, dim3(grid), dim3(NTHR), LDS_BYTES, stream, a);
#endif
    const hipError_t le = hipPeekAtLastError();
    if (le != hipSuccess) fprintf(stderr, "kernel_launch: launch failed: %s\n", hipGetErrorName(le));
}
```

```cpp
#include <hip/hip_runtime.h>
#include <cstdio>
#include <cstdint>
namespace pg8 {
#define PG8_LAS __attribute__((address_space(3)))
typedef unsigned short bf16_t;
typedef short bf16x8 __attribute__((ext_vector_type(8)));
typedef float f32x4 __attribute__((ext_vector_type(4)));
typedef unsigned u32x4 __attribute__((ext_vector_type(4)));
constexpr int BM = 256, BK = 64, HALF = 128, HTB = HALF * BK * 2  , STAGE_BYTES = 8 * HTB, NXCD = 8, WGM = 8;

__host__ __device__ __forceinline__ int lds_byte(int r, int c) { const int st = (r >> 4) * 2 + (c >> 5), rr = r & 15, cc = c & 31, ob = rr * 64 + cc * 2; return st * 1024 + (ob ^ (((ob >> 9) & 1) << 5)); }
__host__ __device__ __forceinline__ void stage_rc(int b, int& R, int& C) { const int st = b / 1024, sb = b % 1024, swz = sb ^ (((sb >> 9) & 1) << 5); R = (st >> 1) * 16 + swz / 64; C = (st & 1) * 32 + (swz % 64) / 2; }
__host__ __device__ __forceinline__ int perm32(int rho) { const int n = rho >> 4, i = rho & 15; return 8 * (i >> 2) + 4 * n + (i & 3); }

struct Unit { int pm, pn; };
struct Gemm { const bf16_t* A; const bf16_t* Bt; int M, N, K; size_t bstride; };

struct StaticOrder {
    int nM, nN, nwg, G, c;
    __host__ __device__ void init(int M, int N, int G_, int c_) { nM = M / BM; nN = N / BM; nwg = nM * nN; G = G_; c = c_; }
    __host__ __device__ bool next(int i, Unit& u) const {
        const long L = (long)i * G + c; if (L >= nwg) return false;
        int wgid = (int)L; { const int q = nwg / NXCD, r = nwg % NXCD, xcd = wgid % NXCD, off = wgid / NXCD; wgid = (xcd < r ? xcd * (q + 1) : r * (q + 1) + (xcd - r) * q) + off; }
        const int nig = WGM * nN, gid = wgid / nig, fm = gid * WGM, gsz = (nM - fm) < WGM ? (nM - fm) : WGM;
        u.pm = fm + ((wgid % nig) % gsz); u.pn = (wgid % nig) / gsz; return true;
    }
    __device__ __forceinline__ void a_ready(const Unit&) const {}
    __device__ __forceinline__ void done(const Unit&) const {}
};

__device__ __forceinline__ unsigned cvt_pk_bf16(float lo, float hi) { unsigned r; asm volatile("v_cvt_pk_bf16_f32 %0, %1, %2" : "=v"(r) : "v"(lo), "v"(hi)); return r; }
typedef unsigned u32x4 __attribute__((ext_vector_type(4)));
struct EpiBf16 {
    static constexpr bool PERM = true, AFTER_DRAIN = false, SPLIT = false;
    bf16_t* O; int ldc;
    __device__ __forceinline__ void operator()(const f32x4 (&acc)[2][2][4][2], const Unit& u, int wr, int wc, int fr, int fq, const int ai0 = 0, const int ai1 = 2) const {
        const int row0 = u.pm * BM + wr * 64 + fr; const int col0 = u.pn * BM + wc * 64 + 8 * fq;
#pragma unroll
        for (int ai = 0; ai < 2; ++ai) if (ai >= ai0 && ai < ai1)
#pragma unroll
            for (int m = 0; m < 4; ++m) { bf16_t* rowp = O + (size_t)(row0 + ai * HALF + m * 16) * ldc + col0;
#pragma unroll
                for (int bj = 0; bj < 2; ++bj) { const f32x4 v0 = acc[ai][bj][m][0], v1 = acc[ai][bj][m][1];
                    u32x4 w; w.x = cvt_pk_bf16(v0[0], v0[1]); w.y = cvt_pk_bf16(v0[2], v0[3]); w.z = cvt_pk_bf16(v1[0], v1[1]); w.w = cvt_pk_bf16(v1[2], v1[3]);
                    *(u32x4*)(rowp + bj * 32) = w; } }
    }
};
struct EpiBf16QK {
    static constexpr bool PERM = true, AFTER_DRAIN = false, SPLIT = false;
    bf16_t* O; int ldc; int q_lo, q_hi, k_lo, k_hi; const float* gq; const float* gk; float qmul; PG8_LAS float* xs; int nostore = 0;
    __device__ __forceinline__ void operator()(const f32x4 (&acc)[2][2][4][2], const Unit& u, int wr, int wc, int fr, int fq, const int ai0 = 0, const int ai1 = 2) const {
        if (nostore) return;
        const int row0 = u.pm * BM + wr * 64 + fr; const int col0 = u.pn * BM + wc * 64 + 8 * fq;
        const bool isq = u.pn >= q_lo && u.pn < q_hi, isk = u.pn >= k_lo && u.pn < k_hi;
        if (!(isq || isk)) {
#pragma unroll
            for (int ai = 0; ai < 2; ++ai) if (ai >= ai0 && ai < ai1)
#pragma unroll
                for (int m = 0; m < 4; ++m) { bf16_t* rowp = O + (size_t)(row0 + ai * HALF + m * 16) * ldc + col0;
#pragma unroll
                    for (int bj = 0; bj < 2; ++bj) { const f32x4 v0 = acc[ai][bj][m][0], v1 = acc[ai][bj][m][1];
                        u32x4 w; w.x = cvt_pk_bf16(v0[0], v0[1]); w.y = cvt_pk_bf16(v0[2], v0[3]); w.z = cvt_pk_bf16(v1[0], v1[1]); w.w = cvt_pk_bf16(v1[2], v1[3]);
                        *(u32x4*)(rowp + bj * 32) = w; } }
            return;
        }
        const float* g = isq ? gq : gk; const float gm = isq ? qmul : 1.f;
        f32x4 gg[2][2];
#pragma unroll
        for (int bj = 0; bj < 2; ++bj) { gg[bj][0] = *(const f32x4*)(g + bj * 32 + 8 * fq) * gm; gg[bj][1] = *(const f32x4*)(g + bj * 32 + 8 * fq + 4) * gm; }
#pragma unroll
        for (int ai = 0; ai < 2; ++ai) if (ai >= ai0 && ai < ai1)
#pragma unroll
            for (int m = 0; m < 4; ++m) { bf16_t* rowp = O + (size_t)(row0 + ai * HALF + m * 16) * ldc + col0;
                float s = 0.f;
#pragma unroll
                for (int bj = 0; bj < 2; ++bj) { const f32x4 v0 = acc[ai][bj][m][0], v1 = acc[ai][bj][m][1];
                    s += (v0[0] * v0[0] + v0[1] * v0[1]) + (v0[2] * v0[2] + v0[3] * v0[3]) + (v1[0] * v1[0] + v1[1] * v1[1]) + (v1[2] * v1[2] + v1[3] * v1[3]); }
                s += __shfl_xor(s, 16); s += __shfl_xor(s, 32);
                const float rs = __builtin_amdgcn_rsqf(s * (1.f / 64.f) + 1e-6f);
#pragma unroll
                for (int bj = 0; bj < 2; ++bj) {
                    const f32x4 v0 = acc[ai][bj][m][0] * rs * gg[bj][0], v1 = acc[ai][bj][m][1] * rs * gg[bj][1];
                    u32x4 w; w.x = cvt_pk_bf16(v0[0], v0[1]); w.y = cvt_pk_bf16(v0[2], v0[3]); w.z = cvt_pk_bf16(v1[0], v1[1]); w.w = cvt_pk_bf16(v1[2], v1[3]);
                    *(u32x4*)(rowp + bj * 32) = w; } }
    }
};
struct EpiBf16RS {
    static constexpr bool PERM = true, AFTER_DRAIN = false, SPLIT = false;
    bf16_t* O; int ldc; const float* rss; const float* bias; int bias_stride;
    __device__ __forceinline__ void operator()(const f32x4 (&acc)[2][2][4][2], const Unit& u, int wr, int wc, int fr, int fq, const int ai0 = 0, const int ai1 = 2) const {
        const int row0 = u.pm * BM + wr * 64 + fr; const int col0 = u.pn * BM + wc * 64 + 8 * fq; const int b = (u.pm * BM) >> 13;
        f32x4 bv[2][2];
#pragma unroll
        for (int bj = 0; bj < 2; ++bj)
#pragma unroll
            for (int n = 0; n < 2; ++n) bv[bj][n] = *(const f32x4*)(bias + (size_t)b * bias_stride + col0 + bj * 32 + 4 * n);
#pragma unroll
        for (int ai = 0; ai < 2; ++ai) if (ai >= ai0 && ai < ai1)
#pragma unroll
            for (int m = 0; m < 4; ++m) { const int row = row0 + ai * HALF + m * 16; bf16_t* rowp = O + (size_t)row * ldc + col0;
                const f32x4 p0 = *(const f32x4*)(rss + (size_t)row * 16), p1 = *(const f32x4*)(rss + (size_t)row * 16 + 4), p2 = *(const f32x4*)(rss + (size_t)row * 16 + 8), p3 = *(const f32x4*)(rss + (size_t)row * 16 + 12);
                const f32x4 pt = (p0 + p1) + (p2 + p3);
                const float rs = __builtin_amdgcn_rsqf(((pt[0] + pt[1]) + (pt[2] + pt[3])) * (1.f / 1024.f) + 1e-6f);
#pragma unroll
                for (int bj = 0; bj < 2; ++bj) { const f32x4 v0 = acc[ai][bj][m][0] * rs + bv[bj][0], v1 = acc[ai][bj][m][1] * rs + bv[bj][1];
                    u32x4 w; w.x = cvt_pk_bf16(v0[0], v0[1]); w.y = cvt_pk_bf16(v0[2], v0[3]); w.z = cvt_pk_bf16(v1[0], v1[1]); w.w = cvt_pk_bf16(v1[2], v1[3]);
                    *(u32x4*)(rowp + bj * 32) = w; } }
    }
};
template <bool BASE_BF16> struct EpiResid {
    static constexpr bool PERM = true, AFTER_DRAIN = false, SPLIT = false;
    const void* base; bf16_t* out; const float* gate;
    __device__ __forceinline__ void operator()(const f32x4 (&acc)[2][2][4][2], const Unit& u, int wr, int wc, int fr, int fq, const int ai0 = 0, const int ai1 = 2) const {
        const int row0 = u.pm * BM + wr * 64 + fr; const int col0 = u.pn * BM + wc * 64 + 8 * fq; const int b = (u.pm * BM) >> 13;
        f32x4 gv[2][2];
#pragma unroll
        for (int bj = 0; bj < 2; ++bj)
#pragma unroll
            for (int n = 0; n < 2; ++n) gv[bj][n] = *(const f32x4*)(gate + (size_t)b * 6144 + col0 + bj * 32 + 4 * n);
#pragma unroll
        for (int ai = 0; ai < 2; ++ai) if (ai >= ai0 && ai < ai1)
#pragma unroll
            for (int m = 0; m < 4; ++m)
#pragma unroll
                for (int bj = 0; bj < 2; ++bj) { const size_t off = (size_t)(row0 + ai * HALF + m * 16) * 1024 + col0 + bj * 32;
                    f32x4 b0, b1;
                    if (BASE_BF16) { const u32x4 w = *(const u32x4*)((const bf16_t*)base + off); const unsigned w0 = w.x, w1 = w.y, w2 = w.z, w3 = w.w;
                        b0 = (f32x4){__builtin_bit_cast(float, w0 << 16), __builtin_bit_cast(float, w0 & 0xffff0000u), __builtin_bit_cast(float, w1 << 16), __builtin_bit_cast(float, w1 & 0xffff0000u)};
                        b1 = (f32x4){__builtin_bit_cast(float, w2 << 16), __builtin_bit_cast(float, w2 & 0xffff0000u), __builtin_bit_cast(float, w3 << 16), __builtin_bit_cast(float, w3 & 0xffff0000u)}; }
                    else { b0 = *(const f32x4*)((const float*)base + off); b1 = *(const f32x4*)((const float*)base + off + 4); }
                    const f32x4 o0 = b0 + gv[bj][0] * acc[ai][bj][m][0], o1 = b1 + gv[bj][1] * acc[ai][bj][m][1];
                    u32x4 ow; ow.x = cvt_pk_bf16(o0[0], o0[1]); ow.y = cvt_pk_bf16(o0[2], o0[3]); ow.z = cvt_pk_bf16(o1[0], o1[1]); ow.w = cvt_pk_bf16(o1[2], o1[3]);
                    *(u32x4*)(out + off) = ow; }
    }
};

template <class Epi, class Sched, bool ALIGN_EPI = false, bool SP2 = false>
__device__ __forceinline__ void gemm_phase(PG8_LAS unsigned char* lds, const Gemm g, const Sched& S, const Epi& E) {
    const int tid = threadIdx.x, wid = __builtin_amdgcn_readfirstlane(tid >> 6), lane = tid & 63, wr = wid >> 2, wc = wid & 3, fr = lane & 15, fq = lane >> 4;
    const int K = g.K, nt = K / BK;
    unsigned voffA[2], voffB[2];
#pragma unroll
    for (int i = 0; i < 2; ++i) { int R, C; stage_rc(tid * 16 + i * 8192, R, C); const int Rb = (R >> 5) * 64 + (Epi::PERM ? perm32(R & 31) : (R & 31));
        voffA[i] = (unsigned)(R * K + C) * 2u; voffB[i] = (unsigned)(Rb * K + C) * 2u; }
    const size_t kstep = (size_t)(BK * 2);
    const size_t hstep = (size_t)HALF * K * 2;
    const size_t hstepB = (size_t)32 * K * 2;
    const size_t tstep = 2 * hstep;
    const unsigned ldsw = (unsigned)wid * 1024u;
    const int aoff = lds_byte(wr * 64 + fr, fq * 8), boff = lds_byte(wc * 32 + fr, fq * 8);
#define PG8_SA(b, h) (((b) * 2 + (h)) * HTB)
#define PG8_SB(b, h) ((4 + (b) * 2 + (h)) * HTB)
#define PG8_STAGE(bufoff, gbase, voff) do { _Pragma("unroll") for (int _i = 0; _i < 2; ++_i) \
        __builtin_amdgcn_global_load_lds((const unsigned*)((const char*)(gbase) + (voff)[_i]), (PG8_LAS unsigned*)(lds + (bufoff) + ldsw + _i * 8192), 16, 0, 0); } while (0)
#define PG8_LDA(dst, b, h) do { _Pragma("unroll") for (int m = 0; m < 4; ++m) _Pragma("unroll") for (int k = 0; k < 2; ++k) dst[m][k] = *(const PG8_LAS bf16x8*)(lds + PG8_SA(b, h) + aoff + m * 2048 + k * 1024); } while (0)
#define PG8_LDB(dst, b, h) do { _Pragma("unroll") for (int n = 0; n < 2; ++n) _Pragma("unroll") for (int k = 0; k < 2; ++k) dst[n][k] = *(const PG8_LAS bf16x8*)(lds + PG8_SB(b, h) + boff + n * 2048 + k * 1024); } while (0)
#define PG8_MMA(ai, bj, At, Bt) do { __builtin_amdgcn_s_setprio(1); _Pragma("unroll") for (int m = 0; m < 4; ++m) _Pragma("unroll") for (int n = 0; n < 2; ++n) _Pragma("unroll") for (int k = 0; k < 2; ++k) \
        acc[ai][bj][m][n] = __builtin_amdgcn_mfma_f32_16x16x32_bf16(Bt[n][k], At[m][k], acc[ai][bj][m][n], 0, 0, 0); __builtin_amdgcn_s_setprio(0); } while (0)
#define PG8_WAIT_V(n) asm volatile("s_waitcnt vmcnt(" #n ")" ::: "memory")
#define PG8_WAIT_L(n) asm volatile("s_waitcnt lgkmcnt(" #n ")" ::: "memory")
#define PG8_BAR __builtin_amdgcn_s_barrier()
#define PG8_SCHED __builtin_amdgcn_sched_barrier(0)
    Unit cur, nxt; int ui = 0;
    if (!S.next(0, cur)) return;
    f32x4 acc[2][2][4][2];
#pragma unroll
    for (int a = 0; a < 2; ++a)
#pragma unroll
        for (int b = 0; b < 2; ++b)
#pragma unroll
            for (int m = 0; m < 4; ++m)
#pragma unroll
                for (int n = 0; n < 2; ++n) acc[a][b][m][n] = (f32x4){0.f, 0.f, 0.f, 0.f};
    bf16x8 At[4][2], B0[2][2], B1[2][2];
    const char* cA = (const char*)g.A + (size_t)cur.pm * tstep; const char* cB = (const char*)g.Bt + (size_t)(cur.pm >> 5) * g.bstride + (size_t)cur.pn * tstep;
    S.a_ready(cur);
    if constexpr (SP2) {
        PG8_STAGE(PG8_SB(0, 0), cB, voffB); PG8_STAGE(PG8_SB(0, 1), cB + hstepB, voffB); PG8_STAGE(PG8_SA(0, 0), cA, voffA); PG8_STAGE(PG8_SA(0, 1), cA + hstep, voffA);
        if (wr == 1) PG8_BAR;
        PG8_WAIT_V(2); PG8_BAR;
        PG8_STAGE(PG8_SB(1, 0), cB + kstep, voffB); PG8_STAGE(PG8_SA(1, 0), cA + kstep, voffA); PG8_STAGE(PG8_SB(1, 1), cB + hstepB + kstep, voffB);
        PG8_WAIT_V(6); PG8_BAR;
    } else {
        PG8_STAGE(PG8_SB(0, 0), cB, voffB); PG8_STAGE(PG8_SA(0, 0), cA, voffA); PG8_STAGE(PG8_SB(0, 1), cB + hstepB, voffB); PG8_STAGE(PG8_SA(0, 1), cA + hstep, voffA);
        if (wr == 1) PG8_BAR;
        PG8_WAIT_V(4); PG8_BAR;
        PG8_STAGE(PG8_SB(1, 0), cB + kstep, voffB); PG8_STAGE(PG8_SA(1, 0), cA + kstep, voffA); PG8_STAGE(PG8_SB(1, 1), cB + hstepB + kstep, voffB);
        PG8_WAIT_V(6); PG8_BAR;
    }
    for (;;) {
        const bool has_next = S.next(ui + 1, nxt);
        const char* nA = has_next ? (const char*)g.A + (size_t)nxt.pm * tstep : cA; const char* nB = has_next ? (const char*)g.Bt + (size_t)(nxt.pm >> 5) * g.bstride + (size_t)nxt.pn * tstep : cB;
        for (int t = 0; t < nt; t += 2) {
            const bool last = (t == nt - 2);
            const char* a1 = cA + (size_t)(t + 1) * kstep;
            const char* a2 = last ? nA : cA + (size_t)(t + 2) * kstep; const char* b2 = last ? nB : cB + (size_t)(t + 2) * kstep;
            const char* a3 = a2 + kstep; const char* b3 = b2 + kstep;
            if (last && has_next) S.a_ready(nxt);
            if constexpr (SP2) {
            PG8_LDB(B0, 0, 0); PG8_LDB(B1, 0, 1); PG8_SCHED; PG8_LDA(At, 0, 0); PG8_STAGE(PG8_SA(1, 1), a1 + hstep, voffA);
            PG8_WAIT_V(8); PG8_WAIT_L(0); PG8_BAR; PG8_MMA(0, 0, At, B0); PG8_MMA(0, 1, At, B1); PG8_BAR; PG8_SCHED;
            PG8_LDA(At, 0, 1); PG8_STAGE(PG8_SB(0, 0), b2, voffB); PG8_STAGE(PG8_SB(0, 1), b2 + hstepB, voffB); PG8_STAGE(PG8_SA(0, 0), a2, voffA);
            PG8_WAIT_V(8); PG8_WAIT_L(0); PG8_BAR; PG8_MMA(1, 0, At, B0); PG8_MMA(1, 1, At, B1); PG8_BAR; PG8_SCHED;
            PG8_LDB(B0, 1, 0); PG8_LDB(B1, 1, 1); PG8_SCHED; PG8_LDA(At, 1, 0); PG8_STAGE(PG8_SA(0, 1), a2 + hstep, voffA);
            PG8_WAIT_V(8); PG8_WAIT_L(0); PG8_BAR; PG8_MMA(0, 0, At, B0); PG8_MMA(0, 1, At, B1); PG8_BAR; PG8_SCHED;
            if constexpr (Epi::SPLIT) { if (last) E(acc, cur, wr, wc, fr, fq, 0, 1); }
            PG8_LDA(At, 1, 1); PG8_STAGE(PG8_SB(1, 0), b3, voffB); PG8_STAGE(PG8_SB(1, 1), b3 + hstepB, voffB); PG8_STAGE(PG8_SA(1, 0), a3, voffA);
            PG8_WAIT_V(8); PG8_WAIT_L(0); PG8_BAR; PG8_MMA(1, 0, At, B0); PG8_MMA(1, 1, At, B1); PG8_BAR; PG8_SCHED;
            } else {
            PG8_LDB(B0, 0, 0); PG8_SCHED; PG8_LDA(At, 0, 0); PG8_STAGE(PG8_SA(1, 1), a1 + hstep, voffA);
            PG8_WAIT_L(8); PG8_BAR; PG8_WAIT_L(0); PG8_MMA(0, 0, At, B0); PG8_BAR; PG8_SCHED;
            PG8_LDB(B1, 0, 1); PG8_STAGE(PG8_SB(0, 0), b2, voffB);
            PG8_BAR; PG8_WAIT_L(0); PG8_MMA(0, 1, At, B1); PG8_BAR;
            PG8_LDA(At, 0, 1); PG8_STAGE(PG8_SA(0, 0), a2, voffA);
            PG8_BAR; PG8_WAIT_L(0); PG8_MMA(1, 0, At, B0); PG8_BAR; PG8_SCHED;
            PG8_STAGE(PG8_SB(0, 1), b2 + hstepB, voffB);
            PG8_WAIT_V(6); PG8_BAR; PG8_MMA(1, 1, At, B1); PG8_BAR;
            PG8_LDB(B0, 1, 0); PG8_SCHED; PG8_LDA(At, 1, 0); PG8_STAGE(PG8_SA(0, 1), a2 + hstep, voffA);
            PG8_WAIT_L(8); PG8_BAR; PG8_WAIT_L(0); PG8_MMA(0, 0, At, B0); PG8_BAR; PG8_SCHED;
            PG8_LDB(B1, 1, 1); PG8_STAGE(PG8_SB(1, 0), b3, voffB);
            PG8_BAR; PG8_WAIT_L(0); PG8_MMA(0, 1, At, B1); PG8_BAR;
            PG8_LDA(At, 1, 1); PG8_STAGE(PG8_SA(1, 0), a3, voffA);
            PG8_BAR; PG8_WAIT_L(0); PG8_MMA(1, 0, At, B0); PG8_BAR; PG8_SCHED;
            PG8_STAGE(PG8_SB(1, 1), b3 + hstepB, voffB);
            PG8_WAIT_V(6); PG8_BAR; PG8_MMA(1, 1, At, B1); PG8_BAR;
            }
        }
        if constexpr (ALIGN_EPI) { if (wr == 0) PG8_BAR; }
        if constexpr (!Epi::AFTER_DRAIN) { if constexpr (Epi::SPLIT) E(acc, cur, wr, wc, fr, fq, 1, 2); else E(acc, cur, wr, wc, fr, fq); S.done(cur); }
        if (!has_next) break;
#pragma unroll
        for (int a = 0; a < 2; ++a)
#pragma unroll
            for (int b = 0; b < 2; ++b)
#pragma unroll
                for (int m = 0; m < 4; ++m)
#pragma unroll
                    for (int n = 0; n < 2; ++n) acc[a][b][m][n] = (f32x4){0.f, 0.f, 0.f, 0.f};
        cur = nxt; cA = nA; cB = nB; ++ui;
        if constexpr (ALIGN_EPI) { if (wr == 1) PG8_BAR; }
    }
    PG8_WAIT_V(0);
    if constexpr (!ALIGN_EPI) { if (wr == 0) PG8_BAR; }
    PG8_BAR;
    if constexpr (Epi::AFTER_DRAIN) { E.fused(acc, cur, wr, wc, fr, fq, lds, wid, lane); S.done(cur); }
#undef PG8_SA
#undef PG8_SB
#undef PG8_STAGE
#undef PG8_LDA
#undef PG8_LDB
#undef PG8_MMA
#undef PG8_WAIT_V
#undef PG8_WAIT_L
#undef PG8_BAR
#undef PG8_SCHED
}
}
constexpr int NB = 4, SEQ = 8192, D = 1024, M = NB * SEQ;
constexpr int NZ0 = 3584, NZ1 = 3072, NQ = 2048, SRC_IN0 = 3592;
constexpr int QLD = NQ + 64;
constexpr float EPS = 1e-6f;
constexpr int NWAVES = 8, NTHR = 512;
constexpr float LOG2E = 1.4426950408889634f;
constexpr size_t MiB = 1u << 20;
constexpr size_t WS_CTL = 0, CTL_ZERO_BYTES = 1 * MiB;
constexpr size_t WS_WIN0 = 1 * MiB, WS_WOUT0 = 8 * MiB, WS_WIN1 = 10 * MiB, WS_WOUT1 = 16 * MiB, WS_WQ = 18 * MiB;
constexpr size_t WS_KEYS = 26 * MiB, WS_MOD = WS_KEYS + 128 * 1024, WS_KMEAN = WS_MOD + 192 * 1024, WS_NLOC = WS_KMEAN + 256 * 1024,
                 WS_BEND = WS_NLOC + 512 * 1024, WS_MLOC = WS_BEND + 4096, WS_MPREV = WS_MLOC + 4096,
                 WS_ISU = 27 * MiB + 512 * 1024, WS_ISV = WS_ISU + 128 * 1024, WS_ORD = WS_ISV + 128 * 1024  ;
constexpr size_t WS_GATES = 28 * MiB, WS_GB = 29 * MiB  ;
constexpr size_t WS_UB = 32 * MiB  , WS_VB = 64 * MiB, WS_ACT = 96 * MiB  , WS_ACTS = 100 * MiB  , WS_XNY = 160 * MiB, WS_Z = 224 * MiB, WS_CLOC = 448 * MiB, WS_END = 512 * MiB;
constexpr size_t WS_LIST = WS_Z + 160 * MiB  , WS_DTOK = WS_Z + 176 * MiB  ;
constexpr size_t WS_QRY = WS_Z, WS_IDX = WS_Z + 136 * MiB  , WS_GATE = WS_Z + 144 * MiB, WS_PART = WS_Z  , WS_XS = 448 * MiB  ;
constexpr int CW_BAR = 4096, CW_QMOBA = 8192  , CW_QDIFF = 8448, CW_QCVT0 = 8704, CW_QCVT1 = 8768;
constexpr float ALIBI_MARGIN = 27.03f;
constexpr int RING_BYTES = 139264;
constexpr int LDSCTL_OFF = RING_BYTES, MISC_OFF = LDSCTL_OFF + 320;
constexpr int LDS_BYTES = 147456;
static_assert(MISC_OFF + 128 <= LDS_BYTES, "LDS map");

#define GAS __attribute__((address_space(1)))
#define LAS __attribute__((address_space(3)))
typedef unsigned short bf16;
typedef unsigned v4u __attribute__((ext_vector_type(4)));
typedef unsigned v2u __attribute__((ext_vector_type(2)));
typedef float f32x4 __attribute__((ext_vector_type(4)));
typedef float f32x16 __attribute__((ext_vector_type(16)));
typedef short bf16x8 __attribute__((ext_vector_type(8)));
typedef short s16x4 __attribute__((ext_vector_type(4)));
typedef GAS unsigned gu32;
#define RLX_AGENT __ATOMIC_RELAXED, __HIP_MEMORY_SCOPE_AGENT
#define LDS_WAIT() asm volatile("s_waitcnt lgkmcnt(0)" ::: "memory")
#define VM_WAIT() asm volatile("s_waitcnt vmcnt(0)" ::: "memory")
__device__ __forceinline__ unsigned f2bf(float f) { unsigned u = __builtin_bit_cast(unsigned, f); return (u + 0x7fffu + ((u >> 16) & 1u)) >> 16; }
__device__ __forceinline__ unsigned pk2(float lo, float hi) { return f2bf(lo) | (f2bf(hi) << 16); }
__device__ __forceinline__ float bflo(unsigned w) { return __builtin_bit_cast(float, w << 16); }
__device__ __forceinline__ float bfhi(unsigned w) { return __builtin_bit_cast(float, w & 0xffff0000u); }
__device__ __forceinline__ float bf2f(bf16 h) { return __builtin_bit_cast(float, (unsigned)h << 16); }
__device__ __forceinline__ unsigned f2u(float x) { return __builtin_bit_cast(unsigned, x); }
__device__ __forceinline__ float u2f(unsigned x) { return __builtin_bit_cast(float, x); }
__device__ __forceinline__ float dot2bf(unsigned a, unsigned b, float acc) { typedef __bf16 bf2_ __attribute__((ext_vector_type(2))); return __builtin_amdgcn_fdot2_f32_bf16(__builtin_bit_cast(bf2_, a), __builtin_bit_cast(bf2_, b), acc, false); }
__device__ __forceinline__ unsigned f2h2(float lo, float hi) { typedef _Float16 h2_ __attribute__((ext_vector_type(2))); typedef float f2_ __attribute__((ext_vector_type(2))); f2_ v = {lo, hi}; h2_ h = __builtin_convertvector(v, h2_); return __builtin_bit_cast(unsigned, h); }
__device__ __forceinline__ float h2f_lo(unsigned w) { return (float)__builtin_bit_cast(_Float16, (unsigned short)(w & 0xffffu)); }
__device__ __forceinline__ float h2f_hi(unsigned w) { return (float)__builtin_bit_cast(_Float16, (unsigned short)(w >> 16)); }
__device__ __forceinline__ float wave_sum(float v) {
#pragma unroll
    for (int o = 1; o < 64; o <<= 1) v += __shfl_xor(v, o);
    return v;
}
template <int CTRL> __device__ __forceinline__ float dppf(float v) { return __builtin_bit_cast(float, __builtin_amdgcn_update_dpp(0, __builtin_bit_cast(int, v), CTRL, 0xf, 0xf, false)); }
__device__ __forceinline__ float x32f(float v) { auto rr = __builtin_amdgcn_permlane32_swap(__builtin_bit_cast(unsigned, v), __builtin_bit_cast(unsigned, v), false, false); const unsigned r0 = rr[0], r1 = rr[1]; return u2f((threadIdx.x & 32) ? r0 : r1); }
__device__ __forceinline__ float x16f(float v) { auto rr = __builtin_amdgcn_permlane16_swap(__builtin_bit_cast(unsigned, v), __builtin_bit_cast(unsigned, v), false, false); const unsigned r0 = rr[0], r1 = rr[1]; return u2f((threadIdx.x & 16) ? r0 : r1); }
__device__ __forceinline__ float wave_sum_fast(float v) {
    v += dppf<0xB1>(v); v += dppf<0x4E>(v); v += dppf<0x141>(v); v += dppf<0x140>(v); v += x16f(v); v += x32f(v); return v; }
__device__ __forceinline__ float wave_max(float v) {
#pragma unroll
    for (int o = 1; o < 64; o <<= 1) v = fmaxf(v, __shfl_xor(v, o));
    return v;
}
__device__ __forceinline__ float wave_max_fast(float v) {
    v = fmaxf(v, dppf<0xB1>(v)); v = fmaxf(v, dppf<0x4E>(v)); v = fmaxf(v, dppf<0x141>(v)); v = fmaxf(v, dppf<0x140>(v)); v = fmaxf(v, x16f(v)); v = fmaxf(v, x32f(v)); return v; }
__device__ __forceinline__ float silu_f(float x) { return x * __builtin_amdgcn_rcpf(1.f + __expf(-x)); }
__device__ __forceinline__ float sigmoid_f(float x) { return __builtin_amdgcn_rcpf(1.f + __expf(-x)); }
__device__ __forceinline__ float logsigmoid_f(float x) { return fminf(x, 0.f) - log1pf(__expf(-fabsf(x))); }
#ifdef MK_PROBE_HI
struct Args { const float* in[24]; float* out; unsigned char* ws; int ph_lo, ph_hi, mode; };
#define PMODE(args) ((args).mode)
#define PROF_K 64
#define PROF_T0(mode, id) unsigned long long prof_t0_##id = 0; if ((MK_PROBE_MODE & 0xff) == (id)) { __syncthreads(); prof_t0_##id = __builtin_amdgcn_s_memrealtime(); }
#define PROF_T1(mode, id) if ((MK_PROBE_MODE & 0xff) == (id)) { __syncthreads(); const unsigned dt_ = (unsigned)(__builtin_amdgcn_s_memrealtime() - prof_t0_##id); if (threadIdx.x == 0) atomicMax((unsigned*)(F.ws + WS_CTL) + 12288, dt_); }
#else
#define PROF_T0(mode, id)
#define PROF_T1(mode, id)
struct Args { const float* in[24]; float* out; unsigned char* ws; int ph_lo, ph_hi; };
#define PMODE(args) 0
#endif
#define XB_TMO      128
#define XB_XCNT(j)  (256  + 64 * (j))
#define XB_XSUB(j)  (1280 + 64 * (j))
#define XB_XGEN(j)  (2304 + 64 * (j))
#define XB_TOP      3328
#define XB_TOPGEN   3392
#define XCD_BAR_WORDS 3456
#define XB_SPIN_CAP (1u << 18)

__device__ __forceinline__ unsigned xb_ld(unsigned* p)              { return __hip_atomic_load(p, __ATOMIC_RELAXED, __HIP_MEMORY_SCOPE_AGENT); }
__device__ __forceinline__ unsigned xb_add(unsigned* p, unsigned v) { return __hip_atomic_fetch_add(p, v, __ATOMIC_RELAXED, __HIP_MEMORY_SCOPE_AGENT); }
__device__ __forceinline__ unsigned xb_xcc_id() { return (unsigned)__builtin_amdgcn_s_getreg((3 << 11) | 20) & 0xFu; }
#define XB_SPIN(cond, bar) do { unsigned _sp = 0; while (cond) { __builtin_amdgcn_s_sleep(1); \
    if ((++_sp & 255u) == 0u) { if (xb_ld(&(bar)[XB_TMO])) break; if (_sp > XB_SPIN_CAP) { atomicAdd(&(bar)[XB_TMO], 1u); break; } } } } while (0)

struct XcdBarrier {
    unsigned* bar; unsigned x;
    volatile LAS unsigned* st;
};

__device__ __forceinline__ XcdBarrier xcd_barrier_post(unsigned* bar, volatile LAS unsigned* st) {
    XcdBarrier b; b.bar = bar; b.x = xb_xcc_id(); b.st = st;
    if (threadIdx.x == 0) (void)xb_add(&bar[XB_XCNT(b.x)], 1u);
    return b;
}
__device__ __forceinline__ void xcd_barrier_complete(unsigned* bar, unsigned x, unsigned& nloc, unsigned& nx) {
    const unsigned G = gridDim.x * gridDim.y * gridDim.z;
    unsigned sum, cnt, mine, sp = 0u;
    for (;;) {
        sum = 0u; cnt = 0u; mine = 0u;
#pragma unroll
        for (unsigned j = 0; j < 16; ++j) { const unsigned c = xb_ld(&bar[XB_XCNT(j)]); sum += c; cnt += (c > 0u) ? 1u : 0u; mine = (j == x) ? c : mine; }
        if (sum == G) break;
        __builtin_amdgcn_s_sleep(1);
        if ((++sp & 255u) == 0u) { if (xb_ld(&bar[XB_TMO])) break; if (sp > XB_SPIN_CAP) { atomicAdd(&bar[XB_TMO], 1u); break; } }
    }
    nloc = mine > 0u ? mine : 1u; nx = cnt > 0u ? cnt : 1u;
}

__device__ __forceinline__ void xcd_barrier(const XcdBarrier& b) {
    asm volatile("s_waitcnt vmcnt(0)" ::: "memory");
    __syncthreads();
    if (threadIdx.x == 0) {
        unsigned* bar = b.bar;
        __builtin_amdgcn_s_waitcnt(0);
        unsigned nloc = b.st[0], nx = b.st[1];
        if (nloc == 0u) { xcd_barrier_complete(bar, b.x, nloc, nx); b.st[0] = nloc; b.st[1] = nx; }
        const unsigned old = xb_add(&bar[XB_XSUB(b.x)], 1u);
        const unsigned gen = old / nloc;
        if (old + 1u == (gen + 1u) * nloc) {
            __builtin_amdgcn_fence(__ATOMIC_RELEASE, "agent");
            asm volatile("s_waitcnt vmcnt(0)" ::: "memory");
            const unsigned og = xb_add(&bar[XB_TOP], 1u);
            const unsigned tg = og / nx;
            if (og + 1u == (tg + 1u) * nx) xb_add(&bar[XB_TOPGEN], 1u);
            else XB_SPIN(xb_ld(&bar[XB_TOPGEN]) == tg, bar);
            __builtin_amdgcn_fence(__ATOMIC_ACQUIRE, "agent");
            xb_add(&bar[XB_XGEN(b.x)], 1u);
            asm volatile("s_waitcnt vmcnt(0)" ::: "memory");
        } else {
            XB_SPIN(xb_ld(&bar[XB_XGEN(b.x)]) == gen, bar);
            __builtin_amdgcn_fence(__ATOMIC_ACQUIRE, "agent");
            asm volatile("s_waitcnt vmcnt(0)" ::: "memory");
        }
    }
    __syncthreads();
}
struct Frame {
    LAS unsigned char* lds;
    int wave, G, bid;
    float* out; unsigned char* ws;
};
#define WSP(T, off) ((T*)(F.ws + (off)))

__device__ __forceinline__ void p0_transpose_item(const float* W, int K, int ldw, int nblk, int thr, int shift, bf16* WT, LAS float* scr, int item, int lane) {
    const int kb = item / nblk, nb = item % nblk, k0 = 64 * kb, n0 = 32 * nb, ns = n0 + (n0 >= thr ? shift : 0);
#pragma unroll 8
    for (int i = 0; i < 32; ++i) { const int kk = 2 * i + (lane >> 5); scr[kk * 33 + (lane & 31)] = W[(size_t)(k0 + kk) * ldw + ns + (lane & 31)]; }
    LDS_WAIT(); asm volatile("" ::: "memory");
    const int c = lane & 7;
#pragma unroll
    for (int j = 0; j < 4; ++j) { const int n = (lane >> 3) + 8 * j; const LAS float* s = scr + (8 * c) * 33 + n;
        v4u o; o.x = pk2(s[0 * 33], s[1 * 33]); o.y = pk2(s[2 * 33], s[3 * 33]); o.z = pk2(s[4 * 33], s[5 * 33]); o.w = pk2(s[6 * 33], s[7 * 33]);
        *(GAS v4u*)(WT + (size_t)(n0 + n) * K + k0 + 8 * c) = o; }
    LDS_WAIT(); asm volatile("" ::: "memory");
}
__device__ __forceinline__ void cvt_f32_bf16_stream(const float* src, bf16* dst, size_t n8, size_t gtid, size_t gthreads) {
    for (size_t i = gtid; i < n8; i += gthreads) {
        const f32x4 a = *(const GAS f32x4*)(src + i * 8), b = *(const GAS f32x4*)(src + i * 8 + 4);
        v4u o; o.x = pk2(a.x, a.y); o.y = pk2(a.z, a.w); o.z = pk2(b.x, b.y); o.w = pk2(b.z, b.w);
        *(GAS v4u*)(dst + i * 8) = o; }
}
__device__ __forceinline__ void i8_row(const float* src_row, unsigned char* dst  , float* scale  , int er, int lane) {
    const float* r = src_row + 16 * lane;
    float x[16];
#pragma unroll
    for (int q4 = 0; q4 < 4; ++q4) { const f32x4 a = *(const GAS f32x4*)(r + 4 * q4); x[4 * q4] = a.x; x[4 * q4 + 1] = a.y; x[4 * q4 + 2] = a.z; x[4 * q4 + 3] = a.w; }
    float am = 0.f;
#pragma unroll
    for (int i = 0; i < 16; ++i) am = fmaxf(am, fabsf(x[i]));
    am = wave_max(am);
    const float inv = am > 1e-30f ? 127.f / am : 0.f;
    unsigned wd[4];
#pragma unroll
    for (int q4 = 0; q4 < 4; ++q4) { unsigned w = 0;
#pragma unroll
        for (int e = 0; e < 4; ++e) { const int qv = (int)rintf(x[4 * q4 + e] * inv); w |= ((unsigned)qv & 0xffu) << (8 * e); }
        wd[q4] = w; }
    v4u o; o.x = wd[0]; o.y = wd[1]; o.z = wd[2]; o.w = wd[3];
    *(GAS v4u*)(dst + ((size_t)((lane >> 3) * 16384 + er)) * 128 + 16 * (lane & 7)) = o;
    if (lane == 0) scale[er] = am * (1.f / 127.f);
}
__device__ __forceinline__ void i8_chunk(Frame& F, const Args& A, int layer, int c) {
    const int tbl = c >> 8, row0 = (c & 255) * 64 + F.wave * 8;
    const float* src = A.in[22 + tbl] + (size_t)layer * 16384 * 1024;
    unsigned char* dst = F.ws + (tbl ? WS_VB : WS_UB) + (size_t)layer * 8 * 16384 * 128;
    float* sc = WSP(float, tbl ? WS_ISV : WS_ISU) + layer * 16384;
    for (int i = 0; i < 8; ++i) i8_row(src + (size_t)(row0 + i) * 1024, dst, sc, row0 + i, ((int)(threadIdx.x & 63u)));
}
__device__ __forceinline__ void p0_prologue(Frame& F, const Args& A) {
    {
        const float* c = A.in[1]; const float* aw = A.in[2]; const float* ab = A.in[3]; float* MOD = WSP(float, WS_MOD);
        LAS float* red = (LAS float*)F.lds;
        LAS float* cact = (LAS float*)(F.lds + 8192);
        if (F.bid < 192) { for (int i = (int)threadIdx.x; i < 4096; i += NTHR) cact[i] = silu_f(c[i]); __syncthreads(); }
        for (int item = F.bid; item < 192; item += F.G) {
            const int l = item / 96, n0 = (item % 96) * 64;
            const int ch = ((int)threadIdx.x) & 15, kg = ((int)threadIdx.x) >> 4;
            f32x4 acc[4];
#pragma unroll
            for (int b = 0; b < 4; ++b) acc[b] = (f32x4){0.f, 0.f, 0.f, 0.f};
            const float* wp = aw + ((size_t)l * 1024 + kg) * 6144 + n0 + 4 * ch;
#pragma unroll 16
            for (int i = 0; i < 32; ++i) {
                const f32x4 wv = *(const GAS f32x4*)(wp + (size_t)i * 32 * 6144); const int k = kg + 32 * i;
#pragma unroll
                for (int b = 0; b < 4; ++b) acc[b] += cact[b * 1024 + k] * wv;
            }
#pragma unroll
            for (int b = 0; b < 4; ++b) {
#pragma unroll
                for (int e = 0; e < 4; ++e) { float v = acc[b][e]; v += __shfl_xor(v, 16); v += __shfl_xor(v, 32); acc[b][e] = v; }
                if ((((int)threadIdx.x) & 63) < 16) *(LAS f32x4*)(red + (F.wave * 4 + b) * 64 + 4 * ch) = acc[b]; }
            __syncthreads();
            if (((int)threadIdx.x) < 256) { const int b = ((int)threadIdx.x) >> 6, ln = ((int)threadIdx.x) & 63; float s = ab[l * 6144 + n0 + ln];
#pragma unroll
                for (int w = 0; w < 8; ++w) s += red[(w * 4 + b) * 64 + ln];
                MOD[(size_t)(l * 4 + b) * 6144 + n0 + ln] = s; }
            __syncthreads();
        }
    }
    if (F.bid >= F.G - 16) {
        LAS unsigned* hist = (LAS unsigned*)F.lds;
        unsigned short* ORD = WSP(unsigned short, WS_ORD);
        const int tid = (int)threadIdx.x, tbl = F.bid - (F.G - 16);
        { const int pass = tbl >> 3;
            const int nq = pass == 0 ? 64 : 32, nper = 4 * nq;
            { const int x = tbl & 7;
                if (tid < 160) hist[tid] = 0u;
                __syncthreads();
                int cost = 0, u = 0;
                if (tid < nper) {
                    const int hs = tid / nq, q = tid % nq, h = (x >> 2) ? (hs == 0 ? 6 : hs == 1 ? 5 : hs == 2 ? 1 : 0) : (hs == 0 ? 7 : hs == 1 ? 4 : hs == 2 ? 3 : 2), b = x & 3;
                    const float dcut = 46.f * (float)(2 << h);
                    if (pass == 0) { const int nt = 2 * q + 2; int lo = (int)ceilf(((float)(q * 128) - dcut - 63.f) * (1.f / 64.f)); if (lo < 0) lo = 0; cost = nt - lo; u = (b << 9) | (h << 6) | q; }
                    else { int lo = (int)ceilf(((float)(q * 256) - dcut - 255.f) * (1.f / 256.f)); if (lo < 0) lo = 0; int nb = q - lo; if (nb > 24) nb = 24; cost = 4 * (nb + 1); u = (b << 8) | (h << 5) | q; }
                    if (cost > 159) cost = 159;
                    atomicAdd((unsigned*)(hist + (159 - cost)), 1u);
                }
                __syncthreads();
                if (tid == 0) { unsigned acc = 0; for (int i = 0; i < 160; ++i) { const unsigned c = hist[i]; hist[i] = acc; acc += c; } }
                __syncthreads();
                if (tid < nper) { const unsigned pos = atomicAdd((unsigned*)(hist + (159 - cost)), 1u); ORD[(pass == 0 ? 0 : 2048) + x * nper + pos] = (unsigned short)u; }
                __syncthreads();
            }
        }
    }
    {
        LAS float* scr = (LAS float*)(F.lds + F.wave * 8704);
        const int gw = F.bid * NWAVES + F.wave, NGW = F.G * NWAVES;
        constexpr int I_IN0 = 16 * (NZ0 / 32), I_OUT = 16 * 32, I_IN1 = 16 * (NZ1 / 32), I_Q = 16 * (NQ / 32);
        constexpr int NITEMS = I_IN0 + 2 * I_OUT + I_IN1 + 2 * I_Q;
        for (int it = gw; it < NITEMS; it += NGW) {
            int r = it;
            if (r < I_IN0) { p0_transpose_item(A.in[6], D, SRC_IN0, NZ0 / 32, 2048, 8, WSP(bf16, WS_WIN0), scr, r, ((int)(threadIdx.x & 63u))); continue; } r -= I_IN0;
            if (r < I_OUT) { p0_transpose_item(A.in[13], D, D, 32, 1 << 30, 0, WSP(bf16, WS_WOUT0), scr, r, ((int)(threadIdx.x & 63u))); continue; } r -= I_OUT;
            if (r < I_IN1) { p0_transpose_item(A.in[14], D, NZ1, NZ1 / 32, 1 << 30, 0, WSP(bf16, WS_WIN1), scr, r, ((int)(threadIdx.x & 63u))); continue; } r -= I_IN1;
            if (r < I_OUT) { p0_transpose_item(A.in[19], D, D, 32, 1 << 30, 0, WSP(bf16, WS_WOUT1), scr, r, ((int)(threadIdx.x & 63u))); continue; } r -= I_OUT;
            if (r < I_Q) { p0_transpose_item(A.in[20], D, NQ, NQ / 32, 1 << 30, 0, WSP(bf16, WS_WQ), scr, r, ((int)(threadIdx.x & 63u))); continue; } r -= I_Q;
            p0_transpose_item(A.in[20] + (size_t)D * NQ, D, NQ, NQ / 32, 1 << 30, 0, WSP(bf16, WS_WQ) + (size_t)NQ * D, scr, r, ((int)(threadIdx.x & 63u)));
        }
    }
    {
        const size_t gtid = (size_t)F.bid * NTHR + ((int)threadIdx.x), gth = (size_t)F.G * NTHR;
        cvt_f32_bf16_stream(A.in[21], WSP(bf16, WS_KEYS), (size_t)2 * 2 * 128 * 128 / 8, gtid, gth);
    }
}

template <bool GATES, bool IN_BF16>
__device__ __forceinline__ void norm_pass(Frame& F, const Args& A, const void* X, const float* g, const float* mod, int shc, bf16* XN) {
    LAS float* wgT = (LAS float*)F.lds;
    if (GATES) {
        const float* win = A.in[6];
        for (int i = ((int)threadIdx.x); i < 8 * 1024; i += NTHR) { const int cg = i >> 10, k = i & 1023; wgT[i] = win[(size_t)k * SRC_IN0 + 2048 + cg]; }
        __syncthreads();
    }
    const int gw = F.bid * NWAVES + F.wave, NGW = F.G * NWAVES, lane = (int)(threadIdx.x & 63u);
    unsigned wpk[GATES ? 8 : 1][4][2]; float gbias = 0.f;
    if (GATES) {
#pragma unroll
        for (int cg = 0; cg < 8; ++cg)
#pragma unroll
            for (int j = 0; j < 4; ++j) { const f32x4 w = *(const LAS f32x4*)(wgT + cg * 1024 + 4 * lane + 256 * j); wpk[cg][j][0] = pk2(w.x, w.y); wpk[cg][j][1] = pk2(w.z, w.w); }
        const int cgl = ((lane >> 5) & 1) * 4 + ((lane >> 4) & 1) * 2 + ((lane >> 3) & 1);
        gbias = cgl < 4 ? A.in[8][cgl] : A.in[9][cgl - 4];
    }
    constexpr int NR = 2;
    f32x4 gsc[4], shf[4]; int bcur = -1;
    for (int row0 = gw; row0 < M; row0 += NR * NGW) {
        f32x4 v[NR][4]; float ss[NR];
#pragma unroll
        for (int rr = 0; rr < NR; ++rr) { const int row = row0 + rr * NGW;
            if (IN_BF16) { const GAS v2u* xr = (const GAS v2u*)((const bf16*)X + (size_t)row * D) + lane;
#pragma unroll
                for (int j = 0; j < 4; ++j) { const v2u w = xr[64 * j]; const unsigned w0 = w.x, w1 = w.y; v[rr][j] = (f32x4){bflo(w0), bfhi(w0), bflo(w1), bfhi(w1)}; }
            } else { const GAS f32x4* xr = (const GAS f32x4*)((const float*)X + (size_t)row * D) + lane;
#pragma unroll
                for (int j = 0; j < 4; ++j) v[rr][j] = xr[64 * j]; } }
#pragma unroll
        for (int rr = 0; rr < NR; ++rr) { float s = 0.f;
#pragma unroll
            for (int j = 0; j < 4; ++j) s += (v[rr][j].x * v[rr][j].x + v[rr][j].y * v[rr][j].y) + (v[rr][j].z * v[rr][j].z + v[rr][j].w * v[rr][j].w);
            ss[rr] = s; }
#pragma unroll
        for (int rr = 0; rr < NR; ++rr) ss[rr] = wave_sum_fast(ss[rr]);
#pragma unroll
        for (int rr = 0; rr < NR; ++rr) { const int row = row0 + rr * NGW, b = row >> 13;
            const float rstd = rsqrtf(ss[rr] * (1.f / D) + EPS);
            if (b != bcur) { bcur = b;
                const float* shp = mod + (size_t)b * 6144 + shc * 1024; const float* scp = shp + 1024;
#pragma unroll
                for (int j = 0; j < 4; ++j) { const int c = 4 * lane + 256 * j;
                    const f32x4 gg = *(const f32x4*)(g + c), sc = *(const f32x4*)(scp + c); gsc[j] = gg * (sc + 1.f); shf[j] = *(const f32x4*)(shp + c); } }
            unsigned opk[4][2];
#pragma unroll
            for (int j = 0; j < 4; ++j) { const int c = 4 * lane + 256 * j;
                v[rr][j] = v[rr][j] * rstd * gsc[j] + shf[j];
                v2u o; o.x = pk2(v[rr][j].x, v[rr][j].y); o.y = pk2(v[rr][j].z, v[rr][j].w);
                if (GATES) { opk[j][0] = o.x; opk[j][1] = o.y; }
                *(GAS v2u*)(XN + (size_t)row * D + c) = o; }
            if (GATES && !(PMODE(A) & 32)) {
                float* GT = WSP(float, WS_GATES);
                float p[8];
#pragma unroll
                for (int cg = 0; cg < 8; ++cg) { float a = 0.f;
#pragma unroll
                    for (int j = 0; j < 4; ++j) { a = dot2bf(opk[j][0], wpk[cg][j][0], a); a = dot2bf(opk[j][1], wpk[cg][j][1], a); }
                    p[cg] = a; }
                const bool u5 = (lane & 32) != 0, u4 = (lane & 16) != 0, u3 = (lane & 8) != 0;
                float q[4], r2[2];
#pragma unroll
                for (int i = 0; i < 4; ++i) { const float send = u5 ? p[i] : p[i + 4], keep = u5 ? p[i + 4] : p[i]; q[i] = keep + x32f(send); }
#pragma unroll
                for (int i = 0; i < 2; ++i) { const float send = u4 ? q[i] : q[i + 2], keep = u4 ? q[i + 2] : q[i]; r2[i] = keep + x16f(send); }
                float sg; { const float send = u3 ? r2[0] : r2[1], keep = u3 ? r2[1] : r2[0]; sg = keep + dppf<0x128>(send); }
                sg += dppf<0x141>(sg); sg += dppf<0x4E>(sg); sg += dppf<0xB1>(sg);
                if ((lane & 7) == 0) GT[(size_t)row * 8 + (lane >> 3)] = sg + gbias;
            }
        }
    }
}

__device__ __forceinline__ void qknorm_unit(Frame& F, bf16* Z, int ldz, int row0, int col0, const float* g, float gmul, float* kmean  ) {
    const int c = col0 + 8 * ((int)(threadIdx.x & 63u)), d0 = (8 * ((int)(threadIdx.x & 63u))) & 63;
    float gv[8];
#pragma unroll
    for (int i = 0; i < 8; ++i) gv[i] = g[d0 + i] * gmul;
    float ks[8] = {0.f, 0.f, 0.f, 0.f, 0.f, 0.f, 0.f, 0.f};
    for (int r = 0; r < 32; ++r) {
        bf16* p = Z + (size_t)(row0 + F.wave * 32 + r) * ldz + c;
        const v4u w = *(const GAS v4u*)p;
        float x[8] = {bflo(w.x), bfhi(w.x), bflo(w.y), bfhi(w.y), bflo(w.z), bfhi(w.z), bflo(w.w), bfhi(w.w)};
        float ss = 0.f;
#pragma unroll
        for (int i = 0; i < 8; ++i) ss += x[i] * x[i];
        ss += __shfl_xor(ss, 1); ss += __shfl_xor(ss, 2); ss += __shfl_xor(ss, 4);
        const float rstd = rsqrtf(ss * (1.f / 64.f) + EPS);
#pragma unroll
        for (int i = 0; i < 8; ++i) { x[i] = x[i] * rstd * gv[i]; ks[i] += x[i]; }
        v4u o; o.x = pk2(x[0], x[1]); o.y = pk2(x[2], x[3]); o.z = pk2(x[4], x[5]); o.w = pk2(x[6], x[7]);
        *(GAS v4u*)p = o;
    }
    if (kmean) {
        LAS float* red = (LAS float*)F.lds;
#pragma unroll
        for (int i = 0; i < 8; ++i) red[F.wave * 512 + 8 * ((int)(threadIdx.x & 63u)) + i] = ks[i];
        __syncthreads();
        { float s = 0.f;
#pragma unroll
          for (int w = 0; w < 8; ++w) s += red[w * 512 + ((int)threadIdx.x)];
          kmean[(size_t)(((int)threadIdx.x) >> 6) * (32 * 64) + (((int)threadIdx.x) & 63)] = s * (1.f / 256.f); }
        __syncthreads();
    }
}

__device__ __forceinline__ void kmean_unit(Frame& F, const bf16* Z, int ldz, int row0, int col0, float* kmean) {
    const int c = col0 + 8 * ((int)(threadIdx.x & 63u));
    float ks[8] = {0.f, 0.f, 0.f, 0.f, 0.f, 0.f, 0.f, 0.f};
#pragma unroll 4
    for (int r = 0; r < 32; ++r) {
        const v4u w = *(const GAS v4u*)(Z + (size_t)(row0 + F.wave * 32 + r) * ldz + c);
        ks[0] += bflo(w.x); ks[1] += bfhi(w.x); ks[2] += bflo(w.y); ks[3] += bfhi(w.y); ks[4] += bflo(w.z); ks[5] += bfhi(w.z); ks[6] += bflo(w.w); ks[7] += bfhi(w.w);
    }
    LAS float* red = (LAS float*)F.lds;
#pragma unroll
    for (int i = 0; i < 8; ++i) red[F.wave * 512 + 8 * ((int)(threadIdx.x & 63u)) + i] = ks[i];
    __syncthreads();
    { float s = 0.f;
#pragma unroll
      for (int w = 0; w < 8; ++w) s += red[w * 512 + ((int)threadIdx.x)];
      kmean[(size_t)(((int)threadIdx.x) >> 6) * (32 * 64) + (((int)threadIdx.x) & 63)] = s * (1.f / 256.f); }
    __syncthreads();
}

constexpr int KSTRB = 144;
template <int DV> struct VStr { static constexpr int B = (DV == 64) ? 192 : 320; };
typedef short v4i16_t __attribute__((ext_vector_type(4)));
__device__ __forceinline__ s16x4 vtr(const LAS unsigned char* p) { return __builtin_bit_cast(s16x4, __builtin_amdgcn_ds_read_tr16_b64_v4i16((LAS v4i16_t*)p)); }
__device__ __forceinline__ unsigned cvtpk(float lo, float hi) { typedef float f2 __attribute__((ext_vector_type(2))); typedef __bf16 b2 __attribute__((ext_vector_type(2)));
    f2 v = {lo, hi}; b2 b = __builtin_convertvector(v, b2); return __builtin_bit_cast(unsigned, b); }
__device__ __forceinline__ float xhalf(float v) {
    auto rr = __builtin_amdgcn_permlane32_swap(__builtin_bit_cast(unsigned, v), __builtin_bit_cast(unsigned, v), false, false);
    const unsigned r0 = rr[0], r1 = rr[1]; return u2f((threadIdx.x & 32) ? r0 : r1);
}
template <int DV> struct AttnSt { f32x16 o[DV / 32]; float m, l; };
template <int DV> __device__ __forceinline__ void attn_init(AttnSt<DV>& st) {
#pragma unroll
    for (int t = 0; t < DV / 32; ++t)
#pragma unroll
        for (int r = 0; r < 16; ++r) st.o[t][r] = 0.f;
    st.m = -1e30f; st.l = 0.f;
}
template <int DV>
__device__ __forceinline__ void attn_qk(AttnSt<DV>& st, const LAS unsigned char* Kt, const bf16x8 (&qf)[4], float sl2, int tq, int kt0, bool diag, bool rowok, int lane, bf16x8 (&pf)[2][2]) {
    const int r32 = lane & 31, hi = lane >> 5;
    const int kb = kt0 + 4 * hi;
    const float ref = st.m > -1e29f ? st.m : 0.f;
    const float c0 = -sl2 * (float)(tq - kb) - ref;
    f32x16 s0, s1;
#pragma unroll
    for (int r = 0; r < 16; ++r) { const int ko = (r & 3) + 8 * (r >> 2); s0[r] = c0 + sl2 * (float)ko; s1[r] = c0 + sl2 * (float)(ko + 32); }
    const LAS unsigned char* kp = Kt + r32 * KSTRB + hi * 16;
#pragma unroll
    for (int ks = 0; ks < 4; ++ks) {
        const bf16x8 k0 = *(const LAS bf16x8*)(kp + ks * 32), k1 = *(const LAS bf16x8*)(kp + 32 * KSTRB + ks * 32);
        s0 = __builtin_amdgcn_mfma_f32_32x32x16_bf16(k0, qf[ks], s0, 0, 0, 0);
        s1 = __builtin_amdgcn_mfma_f32_32x32x16_bf16(k1, qf[ks], s1, 0, 0, 0);
    }
    if (diag || !rowok) {
#pragma unroll
        for (int r = 0; r < 16; ++r) { const int ko = (r & 3) + 8 * (r >> 2);
            if (!rowok || kb + ko > tq) s0[r] = -INFINITY;
            if (!rowok || kb + ko + 32 > tq) s1[r] = -INFINITY; }
    }
    float mx = fmaxf(s0[0], s1[0]);
#pragma unroll
    for (int r = 1; r < 16; ++r) mx = fmaxf(mx, fmaxf(s0[r], s1[r]));
    mx = fmaxf(mx, xhalf(mx));
    const float mnew = fmaxf(st.m, ref + mx);
    if (__any(mnew > st.m)) {
        const float alpha = __builtin_amdgcn_exp2f(st.m - mnew), dd = mnew - ref;
        st.m = mnew; st.l *= alpha;
#pragma unroll
        for (int t = 0; t < DV / 32; ++t)
#pragma unroll
            for (int r = 0; r < 16; ++r) st.o[t][r] *= alpha;
#pragma unroll
        for (int r = 0; r < 16; ++r) { s0[r] -= dd; s1[r] -= dd; }
    }
#pragma unroll
    for (int r = 0; r < 16; ++r) { s0[r] = __builtin_amdgcn_exp2f(s0[r]); s1[r] = __builtin_amdgcn_exp2f(s1[r]); }
#pragma unroll
    for (int s = 0; s < 2; ++s) {
        v4u a, b;
        a.x = cvtpk(s0[8 * s + 0], s0[8 * s + 1]); a.y = cvtpk(s0[8 * s + 2], s0[8 * s + 3]); a.z = cvtpk(s0[8 * s + 4], s0[8 * s + 5]); a.w = cvtpk(s0[8 * s + 6], s0[8 * s + 7]);
        b.x = cvtpk(s1[8 * s + 0], s1[8 * s + 1]); b.y = cvtpk(s1[8 * s + 2], s1[8 * s + 3]); b.z = cvtpk(s1[8 * s + 4], s1[8 * s + 5]); b.w = cvtpk(s1[8 * s + 6], s1[8 * s + 7]);
        pf[0][s] = __builtin_bit_cast(bf16x8, a); pf[1][s] = __builtin_bit_cast(bf16x8, b);
    }
}
template <int DV>
__device__ __forceinline__ void attn_pv(AttnSt<DV>& st, const LAS unsigned char* Vt, const bf16x8 (&pf)[2][2], int lane) {
    { const bf16x8 ones = {0x3F80, 0x3F80, 0x3F80, 0x3F80, 0x3F80, 0x3F80, 0x3F80, 0x3F80};
      f32x16 rs = __builtin_amdgcn_mfma_f32_32x32x16_bf16(ones, pf[0][0], (f32x16){0.f, 0.f, 0.f, 0.f, 0.f, 0.f, 0.f, 0.f, 0.f, 0.f, 0.f, 0.f, 0.f, 0.f, 0.f, 0.f}, 0, 0, 0);
      rs = __builtin_amdgcn_mfma_f32_32x32x16_bf16(ones, pf[0][1], rs, 0, 0, 0); rs = __builtin_amdgcn_mfma_f32_32x32x16_bf16(ones, pf[1][0], rs, 0, 0, 0); rs = __builtin_amdgcn_mfma_f32_32x32x16_bf16(ones, pf[1][1], rs, 0, 0, 0);
      st.l += rs[0]; }
    constexpr int VS = VStr<DV>::B;
    const int g = lane >> 4, i16 = lane & 15;
    const LAS unsigned char* vp = Vt + (4 * (g >> 1) + (i16 >> 2)) * VS + (16 * (g & 1) + 4 * (i16 & 3)) * 2;
#pragma unroll
    for (int kbk = 0; kbk < 2; ++kbk)
#pragma unroll
        for (int s = 0; s < 2; ++s)
#pragma unroll
            for (int t = 0; t < DV / 32; ++t) {
                const s16x4 lo = vtr(vp + (kbk * 32 + 16 * s) * VS + t * 64), h8 = vtr(vp + (kbk * 32 + 16 * s + 8) * VS + t * 64);
                const bf16x8 va = {lo[0], lo[1], lo[2], lo[3], h8[0], h8[1], h8[2], h8[3]};
                st.o[t] = __builtin_amdgcn_mfma_f32_32x32x16_bf16(va, pf[kbk][s], st.o[t], 0, 0, 0);
            }
}
template <int DV>
__device__ __forceinline__ void attn_tile(AttnSt<DV>& st, const LAS unsigned char* Kt, const LAS unsigned char* Vt, const bf16x8 (&qf)[4], float sc2, float sl2, int tq, int kt0, bool diag, bool rowok, int lane) {
    bf16x8 pf[2][2];
    attn_qk<DV>(st, Kt, qf, sl2, tq, kt0, diag, rowok, lane, pf);
    attn_pv<DV>(st, Vt, pf, lane);
}
template <int NK, int DV> struct TileRegs { v4u k[NK]; v4u v[DV / 64]; };
template <int NK, int DV>
__device__ __forceinline__ void tile_load(TileRegs<NK, DV>& R, const bf16* Z, int ldz, size_t zrow0, int kcol, int vcol, int tid) {
#pragma unroll
    for (int i = 0; i < NK; ++i) { const int ch = tid + 512 * i; const int row = ch / (8 * NK), cc = ch % (8 * NK);
        R.k[i] = *(const GAS v4u*)(Z + (zrow0 + row) * ldz + kcol + cc * 8); }
#pragma unroll
    for (int i = 0; i < DV / 64; ++i) { const int ch = tid + 512 * i; const int row = ch / (DV / 8), cc = ch % (DV / 8);
        R.v[i] = *(const GAS v4u*)(Z + (zrow0 + row) * ldz + vcol + cc * 8); }
}
template <int NK, int DV>
__device__ __forceinline__ void tile_store(const TileRegs<NK, DV>& R, LAS unsigned char* Kt  , LAS unsigned char* Vt, int tid) {
#pragma unroll
    for (int i = 0; i < NK; ++i) { const int ch = tid + 512 * i; const int row = ch / (8 * NK), cc = ch % (8 * NK);
        *(LAS v4u*)(Kt + (cc >> 3) * (64 * KSTRB) + row * KSTRB + (cc & 7) * 16) = R.k[i]; }
#pragma unroll
    for (int i = 0; i < DV / 64; ++i) { const int ch = tid + 512 * i; const int row = ch / (DV / 8), cc = ch % (DV / 8);
        *(LAS v4u*)(Vt + row * VStr<DV>::B + cc * 16) = R.v[i]; }
}
__device__ __forceinline__ void moba_unit(Frame& F, int b, int h, int j, float tcut  ) {
    const bf16* Z = WSP(bf16, WS_Z); constexpr int ldz = NZ0;
    const int lane = ((int)(threadIdx.x & 63u)), w = F.wave, r32 = lane & 31, hi = lane >> 5, tid = ((int)threadIdx.x);
    const size_t rowb = (size_t)b * SEQ;
    const int qpos = j * 256 + w * 32 + r32;
    const int qcol = 2048 + h * 64, kcol = 2560 + h * 64, vcol = 3072 + h * 64;
    LAS unsigned char* lds = F.lds;
    constexpr int BUFB = 64 * KSTRB + 64 * VStr<64>::B;
    LAS unsigned char* kmh = lds + 2 * BUFB;
    LAS unsigned char* kml = lds + 2 * BUFB + 32 * KSTRB;
    LAS unsigned* msk = (LAS unsigned*)(lds + 2 * BUFB + 64 * KSTRB);
    { const float* KM = WSP(float, WS_KMEAN) + (size_t)((b * 8 + h) * 32) * 64; const f32x4 x = *(const f32x4*)(KM + 4 * tid);
      const int n = tid >> 4, d0 = (tid & 15) * 4;
      const unsigned h0 = f2bf(x.x), h1 = f2bf(x.y), h2 = f2bf(x.z), h3 = f2bf(x.w);
      v2u hv; hv.x = h0 | (h1 << 16); hv.y = h2 | (h3 << 16);
      v2u lv; lv.x = pk2(x.x - u2f(h0 << 16), x.y - u2f(h1 << 16)); lv.y = pk2(x.z - u2f(h2 << 16), x.w - u2f(h3 << 16));
      *(LAS v2u*)(kmh + n * KSTRB + d0 * 2) = hv; *(LAS v2u*)(kml + n * KSTRB + d0 * 2) = lv; }
    if (tid < 16) msk[tid] = 0u;
    bf16x8 qf[4];
    const bf16* qrow = Z + (rowb + qpos) * ldz + qcol;
#pragma unroll
    for (int ks = 0; ks < 4; ++ks) qf[ks] = *(const GAS bf16x8*)(qrow + 16 * ks + 8 * hi);
    __syncthreads();
    f32x16 gt;
#pragma unroll
    for (int r = 0; r < 16; ++r) gt[r] = 0.f;
#pragma unroll
    for (int ks = 0; ks < 4; ++ks) {
        const bf16x8 a = *(const LAS bf16x8*)(kmh + r32 * KSTRB + hi * 16 + ks * 32), c = *(const LAS bf16x8*)(kml + r32 * KSTRB + hi * 16 + ks * 32);
        gt = __builtin_amdgcn_mfma_f32_32x32x16_bf16(a, qf[ks], gt, 0, 0, 0);
        gt = __builtin_amdgcn_mfma_f32_32x32x16_bf16(c, qf[ks], gt, 0, 0, 0);
    }
    float t0 = -INFINITY, t1 = -INFINITY, t2 = -INFINITY;
#define INS3(key) do { float k_ = (key); float a_ = fmaxf(t0, k_), l_ = fminf(t0, k_); t0 = a_; a_ = fmaxf(t1, l_); l_ = fminf(t1, l_); t1 = a_; t2 = fmaxf(t2, l_); } while (0)
#pragma unroll
    for (int r = 0; r < 16; ++r) { const int n = (r & 3) + 8 * (r >> 2) + 4 * hi;
        const float key = (n < j) ? u2f((f2u(gt[r]) & ~31u) | (unsigned)n) : -INFINITY; INS3(key); }
    { const float p0 = xhalf(t0), p1 = xhalf(t1), p2 = xhalf(t2); INS3(p0); INS3(p1); INS3(p2); }
#undef INS3
    const int sel0 = (t0 > -INFINITY) ? (int)(f2u(t0) & 31u) : -1;
    const int sel1 = (t1 > -INFINITY) ? (int)(f2u(t1) & 31u) : -1;
    const int sel2 = (t2 > -INFINITY) ? (int)(f2u(t2) & 31u) : -1;
    { const unsigned mm = (sel0 >= 0 ? 1u << sel0 : 0u) | (sel1 >= 0 ? 1u << sel1 : 0u) | (sel2 >= 0 ? 1u << sel2 : 0u);
      if (mm) { __hip_atomic_fetch_or(msk + w, mm, __ATOMIC_RELAXED, __HIP_MEMORY_SCOPE_WORKGROUP); __hip_atomic_fetch_or(msk + 8, mm, __ATOMIC_RELAXED, __HIP_MEMORY_SCOPE_WORKGROUP); } }
    __syncthreads();
    const float slope = ldexpf(1.f, -(h + 1)), dcut = tcut / slope;
    const float sl2 = slope * LOG2E, sc2 = 0.125f * LOG2E;
    int nlo = (int)ceilf(((float)(j * 256) - dcut - 255.f) * (1.f / 256.f)); if (nlo < 0) nlo = 0;
    const unsigned keep = nlo >= 32 ? 0u : (0xffffffffu << nlo);
    const unsigned bmask = msk[8] & keep; const unsigned wmask = (unsigned)__builtin_amdgcn_readfirstlane((int)msk[w]) & keep;
    AttnSt<64> st; attn_init<64>(st);
    unsigned rem = bmask;
    int blk = j, kt = 3, buf = 0;
    TileRegs<1, 64> R;
    tile_load<1, 64>(R, Z, ldz, rowb + blk * 256 + kt * 64, kcol, vcol, tid);
    tile_store<1, 64>(R, lds, lds + 64 * KSTRB, tid);
    __syncthreads();
    for (;;) {
        int nblk = blk, nkt = kt - 1; bool has_next = true;
        if (nkt < 0) { nkt = 3; if (rem) { nblk = 31 - __builtin_clz(rem); rem &= ~(1u << nblk); } else has_next = false; }
        if (has_next) tile_load<1, 64>(R, Z, ldz, rowb + nblk * 256 + nkt * 64, kcol, vcol, tid);
        const bool own = (blk == j);
        const bool active = (own ? (kt * 64 <= w * 32 + 31) : (((wmask >> blk) & 1u) != 0u)) && ((float)(j * 256 + w * 32 - (blk * 256 + kt * 64 + 63)) <= dcut);
        if (active) {
            const bool rowok = own || blk == sel0 || blk == sel1 || blk == sel2;
            const bool diag = own && (kt * 64 + 63 > w * 32);
            attn_tile<64>(st, lds + buf * BUFB, lds + buf * BUFB + 64 * KSTRB, qf, sc2, sl2, qpos, blk * 256 + kt * 64, diag, rowok, lane);
        }
        if (!has_next) break;
        tile_store<1, 64>(R, lds + (buf ^ 1) * BUFB, lds + (buf ^ 1) * BUFB + 64 * KSTRB, tid);
        __syncthreads();
        buf ^= 1; blk = nblk; kt = nkt;
    }
    const float inv = 1.f / st.l;
    bf16* Y = WSP(bf16, WS_XNY) + (rowb + qpos) * 1024 + 512 + h * 64;
#pragma unroll
    for (int t = 0; t < 2; ++t)
#pragma unroll
        for (int rg = 0; rg < 4; ++rg) { v2u o; o.x = pk2(st.o[t][4 * rg] * inv, st.o[t][4 * rg + 1] * inv); o.y = pk2(st.o[t][4 * rg + 2] * inv, st.o[t][4 * rg + 3] * inv);
            *(GAS v2u*)(Y + t * 32 + 8 * rg + 4 * hi) = o; }
    __syncthreads();
}

__device__ __forceinline__ void diff_unit(Frame& F, const Args& A, int b, int h, int qt, float lam, float tcut) {
    const bf16* Z = WSP(bf16, WS_Z); constexpr int ldz = NZ1;
    const int lane = ((int)(threadIdx.x & 63u)), w = F.wave, r32 = lane & 31, hi = lane >> 5, tid = ((int)threadIdx.x);
    const int comp = w >> 2, wq = w & 3;
    const size_t rowb = (size_t)b * SEQ;
    const int q0 = qt * 128, qpos = q0 + wq * 32 + r32;
    const int qcol = h * 128 + comp * 64, kcol = 1024 + h * 128, vcol = 2048 + h * 128;
    LAS unsigned char* lds = F.lds;
    constexpr int BUFB = 2 * 64 * KSTRB + 64 * VStr<128>::B;
    bf16x8 qf[4];
    const bf16* qrow = Z + (rowb + qpos) * ldz + qcol;
#pragma unroll
    for (int ks = 0; ks < 4; ++ks) qf[ks] = *(const GAS bf16x8*)(qrow + 16 * ks + 8 * hi);
    const float slope = ldexpf(1.f, -(h + 1)), dcut = tcut / slope;
    const float sl2 = slope * LOG2E, sc2 = 0.125f * LOG2E;
    AttnSt<128> st; attn_init<128>(st);
    const int nt = (q0 + 128) / 64;
    int kt_lo = (int)ceilf(((float)q0 - dcut - 63.f) * (1.f / 64.f)); if (kt_lo < 0) kt_lo = 0;
    TileRegs<2, 128> R;
    tile_load<2, 128>(R, Z, ldz, rowb + (size_t)(nt - 1) * 64, kcol, vcol, tid);
    tile_store<2, 128>(R, lds, lds + 2 * 64 * KSTRB, tid);
    __syncthreads();
    int buf = 0;
    for (int kt = nt - 1; kt >= kt_lo; --kt) {
        const bool has_next = kt > kt_lo;
        if (has_next) tile_load<2, 128>(R, Z, ldz, rowb + (size_t)(kt - 1) * 64, kcol, vcol, tid);
        if (kt * 64 <= q0 + wq * 32 + 31) {
            const bool diag = kt * 64 + 63 > q0 + wq * 32;
            attn_tile<128>(st, lds + buf * BUFB + comp * (64 * KSTRB), lds + buf * BUFB + 2 * 64 * KSTRB, qf, sc2, sl2, qpos, kt * 64, diag, true, lane);
        }
        if (has_next) { tile_store<2, 128>(R, lds + (buf ^ 1) * BUFB, lds + (buf ^ 1) * BUFB + 2 * 64 * KSTRB, tid); }
        __syncthreads();
        buf ^= 1;
    }
    const float inv = 1.f / st.l;
    LAS float* o2 = (LAS float*)lds;
    if (comp == 1) {
#pragma unroll
        for (int t = 0; t < 4; ++t)
#pragma unroll
            for (int r = 0; r < 16; ++r) o2[((wq * 4 + t) * 16 + r) * 64 + lane] = st.o[t][r] * inv;
    }
    __syncthreads();
    if (comp == 0) {
        float ss = 0.f;
#pragma unroll
        for (int t = 0; t < 4; ++t)
#pragma unroll
            for (int r = 0; r < 16; ++r) { const float v = st.o[t][r] * inv - lam * o2[((wq * 4 + t) * 16 + r) * 64 + lane]; st.o[t][r] = v; ss += v * v; }
        ss += xhalf(ss);
        const float rs = rsqrtf(ss * (1.f / 128.f) + EPS) * 0.6444909324090307f;
        const float* og = A.in[18];
        bf16* Y = WSP(bf16, WS_XNY) + (rowb + qpos) * 1024 + h * 128;
#pragma unroll
        for (int t = 0; t < 4; ++t)
#pragma unroll
            for (int rg = 0; rg < 4; ++rg) { const int dv = t * 32 + 8 * rg + 4 * hi; const f32x4 gg = *(const f32x4*)(og + dv);
                v2u o; o.x = pk2(st.o[t][4 * rg] * rs * gg.x, st.o[t][4 * rg + 1] * rs * gg.y); o.y = pk2(st.o[t][4 * rg + 2] * rs * gg.z, st.o[t][4 * rg + 3] * rs * gg.w);
                *(GAS v2u*)(Y + dv) = o; }
    }
    __syncthreads();
}

template <int MT, int NT, bool SWA = false, bool SWB = false>
__device__ __forceinline__ void mma_nt(const LAS unsigned char* A, int lda, const LAS unsigned char* B, int ldb, int K, f32x4 (&acc)[MT][NT], int lane, int arow0 = 0, int brow0 = 0) {
    const int r = lane & 15, cq = lane >> 4;
    for (int k0 = 0; k0 < K; k0 += 32) {
        bf16x8 a[MT], bb[NT];
#pragma unroll
        for (int m = 0; m < MT; ++m) { const int ch = (k0 >> 3) + cq; a[m] = *(const LAS bf16x8*)(A + (m * 16 + r) * lda + ((SWA ? (ch ^ (((arow0 + m * 16 + r) >> 3) & 15)) : ch) << 4)); }
#pragma unroll
        for (int n = 0; n < NT; ++n) { const int ch = (k0 >> 3) + cq; bb[n] = *(const LAS bf16x8*)(B + (n * 16 + r) * ldb + ((SWB ? (ch ^ (((brow0 + n * 16 + r) >> 3) & 15)) : ch) << 4)); }
#pragma unroll
        for (int m = 0; m < MT; ++m)
#pragma unroll
            for (int n = 0; n < NT; ++n) acc[m][n] = __builtin_amdgcn_mfma_f32_16x16x32_bf16(a[m], bb[n], acc[m][n], 0, 0, 0);
    }
}
constexpr int TS = 272;
constexpr int TILEB = 128 * TS;
constexpr int ML_Q = 0, ML_K = TILEB, ML_V = 2 * TILEB, ML_SM = 3 * TILEB;

__device__ __forceinline__ void ml_gates(const float* GT, size_t row0, int hm, LAS float* sm, int lane) {
    const float i0 = GT[(row0 + 2 * lane) * 8 + hm], i1 = GT[(row0 + 2 * lane + 1) * 8 + hm];
    const float f0 = logsigmoid_f(GT[(row0 + 2 * lane) * 8 + 4 + hm]), f1 = logsigmoid_f(GT[(row0 + 2 * lane + 1) * 8 + 4 + hm]);
    float s = f0 + f1;
#pragma unroll
    for (int o = 1; o < 64; o <<= 1) { const float t = __shfl_up(s, o); if (lane >= o) s += t; }
    const float excl = s - (f0 + f1);
    sm[2 * lane] = excl + f0; sm[2 * lane + 1] = excl + f0 + f1;
    sm[128 + 2 * lane] = i0; sm[128 + 2 * lane + 1] = i1;
}
template <bool TRANSPOSE>
__device__ __forceinline__ void ml_conv_tile(const bf16* Z, size_t rowb, int t0, int zc, const float* cw, int wc, float mul, LAS unsigned char* dst, const LAS float* rs, int tid) {
#pragma unroll
    for (int it = 0; it < 4; ++it) {
        const int item = tid + 512 * it, l = item >> 4, ch = (item & 15) * 8;
        float acc[8];
#pragma unroll
        for (int i = 0; i < 8; ++i) acc[i] = 0.f;
        v4u wv[4];
#pragma unroll
        for (int jj = 0; jj < 4; ++jj) { const int t = t0 + l - 3 + jj;
            wv[jj] = *(const GAS v4u*)(Z + (rowb + (t < 0 ? 0 : t)) * NZ0 + zc + ch); }
#pragma unroll
        for (int jj = 0; jj < 4; ++jj) {
            const int t = t0 + l - 3 + jj; const float tm = t >= 0 ? 1.f : 0.f;
            const v4u w = wv[jj];
            const float x[8] = {bflo(w.x), bfhi(w.x), bflo(w.y), bfhi(w.y), bflo(w.z), bfhi(w.z), bflo(w.w), bfhi(w.w)};
            const f32x4 c0 = *(const f32x4*)(cw + jj * 1024 + wc + ch) * tm, c1 = *(const f32x4*)(cw + jj * 1024 + wc + ch + 4) * tm;
            acc[0] += x[0] * c0.x; acc[1] += x[1] * c0.y; acc[2] += x[2] * c0.z; acc[3] += x[3] * c0.w;
            acc[4] += x[4] * c1.x; acc[5] += x[5] * c1.y; acc[6] += x[6] * c1.z; acc[7] += x[7] * c1.w;
        }
        const float sc = TRANSPOSE ? mul * rs[l] : mul;
#pragma unroll
        for (int i = 0; i < 8; ++i) acc[i] = silu_f(acc[i]) * sc;
        if (TRANSPOSE) {
#pragma unroll
            for (int i = 0; i < 8; ++i) *(LAS bf16*)(dst + (ch + i) * TS + ((l ^ ch) * 2)) = (bf16)f2bf(acc[i]);
        } else {
            v4u o; o.x = pk2(acc[0], acc[1]); o.y = pk2(acc[2], acc[3]); o.z = pk2(acc[4], acc[5]); o.w = pk2(acc[6], acc[7]);
            *(LAS v4u*)(dst + l * TS + ch * 2) = o;
        }
    }
}
__device__ __forceinline__ void ml_vt_tile(const bf16* Z, size_t row0, int zc, LAS unsigned char* dst, int tid) {
#pragma unroll
    for (int it = 0; it < 4; ++it) {
        const int item = tid + 512 * it, l = item >> 4, ch = (item & 15) * 8;
        const v4u w = *(const GAS v4u*)(Z + (row0 + l) * NZ0 + zc + ch);
        const unsigned ww[4] = {w.x, w.y, w.z, w.w};
#pragma unroll
        for (int i = 0; i < 4; ++i) { *(LAS bf16*)(dst + (ch + 2 * i) * TS + ((l ^ ch) * 2)) = (bf16)(ww[i] & 0xffffu); *(LAS bf16*)(dst + (ch + 2 * i + 1) * TS + ((l ^ ch) * 2)) = (bf16)(ww[i] >> 16); }
    }
}
__device__ __forceinline__ void ml_conv_load(const bf16* Z, size_t rowb, int t0, int zc, v4u (&wv)[4][4], int tid) {
#pragma unroll
    for (int it = 0; it < 4; ++it) { const int item = tid + 512 * it, l = item >> 4, ch = (item & 15) * 8;
#pragma unroll
        for (int jj = 0; jj < 4; ++jj) { const int t = t0 + l - 3 + jj; wv[it][jj] = *(const GAS v4u*)(Z + (rowb + (t < 0 ? 0 : t)) * NZ0 + zc + ch); } }
}
__device__ __forceinline__ void ml_conv_finish_t(const v4u (&wv)[4][4], int t0, const float* cw, int wc, float mul, LAS unsigned char* dst, const LAS float* rs, int tid) {
#pragma unroll
    for (int it = 0; it < 4; ++it) {
        const int item = tid + 512 * it, l = item >> 4, ch = (item & 15) * 8;
        float acc[8];
#pragma unroll
        for (int i = 0; i < 8; ++i) acc[i] = 0.f;
#pragma unroll
        for (int jj = 0; jj < 4; ++jj) {
            const int t = t0 + l - 3 + jj; const float tm = t >= 0 ? 1.f : 0.f;
            const v4u w = wv[it][jj];
            const float x[8] = {bflo(w.x), bfhi(w.x), bflo(w.y), bfhi(w.y), bflo(w.z), bfhi(w.z), bflo(w.w), bfhi(w.w)};
            const f32x4 c0 = *(const f32x4*)(cw + jj * 1024 + wc + ch) * tm, c1 = *(const f32x4*)(cw + jj * 1024 + wc + ch + 4) * tm;
            acc[0] += x[0] * c0.x; acc[1] += x[1] * c0.y; acc[2] += x[2] * c0.z; acc[3] += x[3] * c0.w;
            acc[4] += x[4] * c1.x; acc[5] += x[5] * c1.y; acc[6] += x[6] * c1.z; acc[7] += x[7] * c1.w;
        }
        const float sc = mul * rs[l];
#pragma unroll
        for (int i = 0; i < 8; ++i) acc[i] = silu_f(acc[i]) * sc;
#pragma unroll
        for (int i = 0; i < 8; ++i) *(LAS bf16*)(dst + (ch + i) * TS + ((l ^ ch) * 2)) = (bf16)f2bf(acc[i]);
    }
}
__device__ __forceinline__ void mlstm_a_unit(Frame& F, const Args& A, int unit) {
    const int c = unit & 63, bh = unit >> 6, hm = bh & 3, b = bh >> 2;
    const bf16* Z = WSP(bf16, WS_Z); const float* GT = WSP(float, WS_GATES);
    const size_t rowb = (size_t)b * SEQ; const int t0 = c * 128;
    LAS unsigned char* lds = F.lds; LAS float* sm = (LAS float*)(lds + ML_SM);
    PROF_T0(PMODE(A), 32)
    if (F.wave == 0) {
        ml_gates(GT, rowb + t0, hm, sm, ((int)(threadIdx.x & 63u)));
        LDS_WAIT();
        { const int ln = (int)(threadIdx.x & 63u); float* GB = WSP(float, WS_GB) + (size_t)unit * 256;
          GB[2 * ln] = sm[2 * ln]; GB[2 * ln + 1] = sm[2 * ln + 1]; GB[128 + 2 * ln] = sm[128 + 2 * ln]; GB[128 + 2 * ln + 1] = sm[128 + 2 * ln + 1]; }
        const float bend = sm[127];
        const float w0 = bend - sm[2 * ((int)(threadIdx.x & 63u))] + sm[128 + 2 * ((int)(threadIdx.x & 63u))], w1 = bend - sm[2 * ((int)(threadIdx.x & 63u)) + 1] + sm[128 + 2 * ((int)(threadIdx.x & 63u)) + 1];
        const float ml = wave_max(fmaxf(w0, w1));
        sm[256 + 2 * ((int)(threadIdx.x & 63u))] = __expf(w0 - ml); sm[256 + 2 * ((int)(threadIdx.x & 63u)) + 1] = __expf(w1 - ml);
        if (((int)(threadIdx.x & 63u)) == 0) { WSP(float, WS_BEND)[unit] = bend; WSP(float, WS_MLOC)[unit] = ml; }
    }
    v4u wk[4][4];
    ml_conv_load(Z, rowb, t0, 512 + hm * 128, wk, ((int)threadIdx.x));
    ml_vt_tile(Z, rowb + t0, 1024 + hm * 128, lds + ML_V, ((int)threadIdx.x));
    __syncthreads();
    PROF_T1(PMODE(A), 32)
    PROF_T0(PMODE(A), 33)
    ml_conv_finish_t(wk, t0, A.in[7], 512 + hm * 128, 0.08838834764831845f, lds + ML_K, sm + 256, ((int)threadIdx.x));
    __syncthreads();
    PROF_T1(PMODE(A), 33)
    PROF_T0(PMODE(A), 34)
    f32x4 acc[2][4];
#pragma unroll
    for (int m = 0; m < 2; ++m)
#pragma unroll
        for (int n = 0; n < 4; ++n) acc[m][n] = (f32x4){0.f, 0.f, 0.f, 0.f};
    const int dv0 = 32 * (F.wave >> 1), dk0 = 64 * (F.wave & 1);
    mma_nt<2, 4, true, true>(lds + ML_V + dv0 * TS, TS, lds + ML_K + dk0 * TS, TS, 128, acc, ((int)(threadIdx.x & 63u)), dv0, dk0);
    {
        const int lane_ = (int)(threadIdx.x & 63u);
#pragma unroll
        for (int m = 0; m < 2; ++m)
#pragma unroll
            for (int n = 0; n < 4; ++n)
#pragma unroll
                for (int i = 0; i < 4; ++i) *(LAS bf16*)(lds + ML_Q + (dv0 + 16 * m + 4 * (lane_ >> 4) + i) * TS + (dk0 + 16 * n + (lane_ & 15)) * 2) = (bf16)f2bf(acc[m][n][i]);
        __syncthreads();
        bf16* CL = WSP(bf16, WS_CLOC) + (size_t)unit * 16384;
#pragma unroll
        for (int it = 0; it < 4; ++it) { const int item = (int)threadIdx.x + 512 * it, rr = item >> 4, ch = (item & 15) * 8;
            *(GAS v4u*)(CL + rr * 128 + ch) = *(const LAS v4u*)(lds + ML_Q + rr * TS + ch * 2); }
    }
    { const int dk = ((int)threadIdx.x) >> 2, part = ((int)threadIdx.x) & 3; float s = 0.f;
#pragma unroll
        for (int j = 0; j < 4; ++j) { const v4u kv = *(const LAS v4u*)(lds + ML_K + dk * TS + part * 64 + j * 16); const unsigned k0 = kv.x, k1 = kv.y, k2 = kv.z, k3 = kv.w;
            s += (bflo(k0) + bfhi(k0)) + (bflo(k1) + bfhi(k1)) + (bflo(k2) + bfhi(k2)) + (bflo(k3) + bfhi(k3)); }
        s += __shfl_xor(s, 1); s += __shfl_xor(s, 2);
        if (part == 0) WSP(float, WS_NLOC)[(size_t)unit * 128 + dk] = s; }
    __syncthreads();
    PROF_T1(PMODE(A), 34)
}
__device__ __forceinline__ void mlstm_scan_unit(Frame& F, int unit) {
    const int bh = unit >> 3, sl = unit & 7;
    LAS float* tab = (LAS float*)F.lds;
    if (((int)threadIdx.x) == 0) {
        const float* BE = WSP(float, WS_BEND) + bh * 64; const float* ML = WSP(float, WS_MLOC) + bh * 64; float* MP = WSP(float, WS_MPREV) + bh * 64;
        float m = 0.f;
        for (int c = 0; c < 64; ++c) { const float be = BE[c], ml = ML[c]; const float mn = fmaxf(be + m, ml);
            tab[c] = __expf(be + m - mn); tab[64 + c] = __expf(ml - mn); if (sl == 0) MP[c] = m; m = mn; }
    }
    __syncthreads();
    bf16* CL = WSP(bf16, WS_CLOC) + (size_t)bh * 64 * 16384 + sl * 2048 + 4 * ((int)threadIdx.x);
    float s0 = 0.f, s1 = 0.f, s2 = 0.f, s3 = 0.f;
#pragma unroll 8
    for (int c = 0; c < 64; ++c) { GAS v2u* p = (GAS v2u*)(CL + (size_t)c * 16384); const v2u v = *p; v2u o; o.x = pk2(s0, s1); o.y = pk2(s2, s3); *p = o;
        const float a = tab[c], sc = tab[64 + c]; const unsigned v0 = v.x, v1 = v.y;
        s0 = a * s0 + sc * bflo(v0); s1 = a * s1 + sc * bfhi(v0); s2 = a * s2 + sc * bflo(v1); s3 = a * s3 + sc * bfhi(v1); }
    if (sl == 0 && ((int)threadIdx.x) < 128) { float* NL = WSP(float, WS_NLOC) + (size_t)bh * 64 * 128 + ((int)threadIdx.x); float s = 0.f;
        for (int c = 0; c < 64; ++c) { const float v = NL[c * 128]; NL[c * 128] = s; s = tab[c] * s + tab[64 + c] * v; } }
    __syncthreads();
}
__device__ __forceinline__ void mlstm_c_unit(Frame& F, const Args& A, int unit) {
    const int c = unit & 63, bh = unit >> 6, hm = bh & 3, b = bh >> 2;
    const bf16* Z = WSP(bf16, WS_Z); const float* GT = WSP(float, WS_GATES);
    const size_t rowb = (size_t)b * SEQ; const int t0 = c * 128;
    LAS unsigned char* lds = F.lds; LAS float* sm = (LAS float*)(lds + ML_SM);
    const int lane = ((int)(threadIdx.x & 63u)), w = F.wave, tid = ((int)threadIdx.x);
    const float mprev = WSP(float, WS_MPREV)[unit];
    PROF_T0(0, 35)
    const int l0 = 32 * (w >> 1), c0 = 64 * (w & 1);
    if (w == 0) {
        const float* GB = WSP(float, WS_GB) + (size_t)unit * 256;
        const float b0 = GB[2 * lane], b1 = GB[2 * lane + 1];
        const float g0 = GB[128 + 2 * lane] - b0, g1 = GB[128 + 2 * lane + 1] - b1;
        float pm = fmaxf(g0, g1);
#pragma unroll
        for (int o = 1; o < 64; o <<= 1) { const float t = __shfl_up(pm, o); if (lane >= o) pm = fmaxf(pm, t); }
        float pe = __shfl_up(pm, 1); if (lane == 0) pe = -INFINITY;
        const float M0 = fmaxf(mprev, fmaxf(pe, g0)), M1 = fmaxf(mprev, pm);
        sm[256 + 2 * lane] = g0; sm[256 + 2 * lane + 1] = g1;
        sm[384 + 2 * lane] = M0; sm[384 + 2 * lane + 1] = M1;
        sm[512 + 2 * lane] = __expf(mprev - M0); sm[512 + 2 * lane + 1] = __expf(mprev - M1);
        sm[640 + 2 * lane] = __expf(-b0 - M0); sm[640 + 2 * lane + 1] = __expf(-b1 - M1);
        sm[768 + 2 * lane] = 0.f; sm[768 + 2 * lane + 1] = 0.f; sm[896 + 2 * lane] = 0.f; sm[896 + 2 * lane + 1] = 0.f;
    }
    if (w == 1) { sm[1152 + lane] = WSP(float, WS_NLOC)[(size_t)unit * 128 + lane]; sm[1152 + 64 + lane] = WSP(float, WS_NLOC)[(size_t)unit * 128 + 64 + lane]; }
    ml_conv_tile<false>(Z, rowb, t0, hm * 128, A.in[7], hm * 128, 1.f, lds + ML_Q, nullptr, tid);
    ml_conv_tile<false>(Z, rowb, t0, 512 + hm * 128, A.in[7], 512 + hm * 128, 0.08838834764831845f, lds + ML_K, nullptr, tid);
    ml_vt_tile(Z, rowb + t0, 1024 + hm * 128, lds + ML_V, tid);
    __syncthreads();
    PROF_T1(0, 35)
    PROF_T0(0, 36)
    bf16x8 cpf[4][4];
    { const bf16* CP = WSP(bf16, WS_CLOC) + (size_t)unit * 16384;
      const int r = lane & 15, kq = (lane >> 4) * 8;
#pragma unroll
      for (int kk = 0; kk < 4; ++kk)
#pragma unroll
          for (int n = 0; n < 4; ++n) cpf[kk][n] = *(const GAS bf16x8*)(CP + (size_t)(c0 + n * 16 + r) * 128 + 32 * kk + kq); }
    const int lr = 4 * (lane >> 4), lc = lane & 15;
    { const int l = tid >> 2, part = tid & 3; float s = 0.f;
#pragma unroll
        for (int j = 0; j < 4; ++j) { const v4u qv = *(const LAS v4u*)(lds + ML_Q + l * TS + part * 64 + j * 16);
            const f32x4 n0 = *(const LAS f32x4*)(sm + 1152 + part * 32 + j * 8), n1 = *(const LAS f32x4*)(sm + 1152 + part * 32 + j * 8 + 4);
            const unsigned q0 = qv.x, q1 = qv.y, q2 = qv.z, q3 = qv.w;
            s += (bflo(q0) * n0.x + bfhi(q0) * n0.y) + (bflo(q1) * n0.z + bfhi(q1) * n0.w) + (bflo(q2) * n1.x + bfhi(q2) * n1.y) + (bflo(q3) * n1.z + bfhi(q3) * n1.w); }
        s += __shfl_xor(s, 1); s += __shfl_xor(s, 2);
        if (part == 0) sm[1024 + l] = s; }
    f32x4 acc[2][4];
#pragma unroll
    for (int m = 0; m < 2; ++m)
#pragma unroll
        for (int n = 0; n < 4; ++n) acc[m][n] = (f32x4){0.f, 0.f, 0.f, 0.f};
    mma_nt<2, 4>(lds + ML_Q + l0 * TS, TS, lds + ML_K + c0 * TS, TS, 128, acc, lane);
#pragma unroll
    for (int m = 0; m < 2; ++m)
#pragma unroll
        for (int i = 0; i < 4; ++i) { const int l = l0 + 16 * m + lr + i; const float Ml = sm[384 + l]; float rsum = 0.f;
#pragma unroll
            for (int n = 0; n < 4; ++n) { const int s = c0 + 16 * n + lc; const float v = (s <= l) ? acc[m][n][i] * __expf(sm[256 + s] - Ml) : 0.f; acc[m][n][i] = v; rsum += v; }
            rsum += __shfl_xor(rsum, 1); rsum += __shfl_xor(rsum, 2); rsum += __shfl_xor(rsum, 4); rsum += __shfl_xor(rsum, 8);
            if (lc == 0) __hip_atomic_fetch_add(sm + 768 + l, rsum, __ATOMIC_RELAXED, __HIP_MEMORY_SCOPE_WORKGROUP); }
    __syncthreads();
#pragma unroll
    for (int m = 0; m < 2; ++m)
#pragma unroll
        for (int n = 0; n < 4; ++n)
#pragma unroll
            for (int i = 0; i < 4; ++i) *(LAS bf16*)(lds + ML_K + (l0 + 16 * m + lr + i) * TS + (c0 + 16 * n + lc) * 2) = (bf16)f2bf(acc[m][n][i]);
    __syncthreads();
    PROF_T1(0, 36)
    PROF_T0(0, 37)
    f32x4 ai[2][4], ae[2][4];
#pragma unroll
    for (int m = 0; m < 2; ++m)
#pragma unroll
        for (int n = 0; n < 4; ++n) { ai[m][n] = (f32x4){0.f, 0.f, 0.f, 0.f}; ae[m][n] = (f32x4){0.f, 0.f, 0.f, 0.f}; }
    mma_nt<2, 4, false, true>(lds + ML_K + l0 * TS, TS, lds + ML_V + c0 * TS, TS, 128, ai, lane, 0, c0);
    {
        const int r = lane & 15, kq = (lane >> 4) * 8;
#pragma unroll
        for (int kk = 0; kk < 4; ++kk) {
            bf16x8 a[2];
#pragma unroll
            for (int m = 0; m < 2; ++m) a[m] = *(const LAS bf16x8*)(lds + ML_Q + (l0 + m * 16 + r) * TS + (32 * kk + kq) * 2);
#pragma unroll
            for (int m = 0; m < 2; ++m)
#pragma unroll
                for (int n = 0; n < 4; ++n) ae[m][n] = __builtin_amdgcn_mfma_f32_16x16x32_bf16(a[m], cpf[kk][n], ae[m][n], 0, 0, 0);
        }
    }
#pragma unroll
    for (int m = 0; m < 2; ++m)
#pragma unroll
        for (int i = 0; i < 4; ++i) { const int l = l0 + 16 * m + lr + i; const float wi = sm[512 + l];
            const float den = wi * sm[1024 + l] + sm[768 + l]; const float dinv = 1.f / fmaxf(fabsf(den), sm[640 + l]); float ssq = 0.f;
#pragma unroll
            for (int n = 0; n < 4; ++n) { const float hv = (wi * ae[m][n][i] + ai[m][n][i]) * dinv; ai[m][n][i] = hv; ssq += hv * hv; }
            ssq += __shfl_xor(ssq, 1); ssq += __shfl_xor(ssq, 2); ssq += __shfl_xor(ssq, 4); ssq += __shfl_xor(ssq, 8);
            if (lc == 0) __hip_atomic_fetch_add(sm + 896 + l, ssq, __ATOMIC_RELAXED, __HIP_MEMORY_SCOPE_WORKGROUP); }
    __syncthreads();
    v4u owf[4];
#pragma unroll
    for (int it = 0; it < 4; ++it) { const int item = tid + 512 * it, l = item >> 4, ch = (item & 15) * 8; owf[it] = *(const GAS v4u*)(Z + (rowb + t0 + l) * NZ0 + 1536 + hm * 128 + ch); }
    LAS float* HT = (LAS float*)(lds + ML_Q);
#pragma unroll
    for (int m = 0; m < 2; ++m)
#pragma unroll
        for (int i = 0; i < 4; ++i) { const int l = l0 + 16 * m + lr + i; const float rstd = rsqrtf(sm[896 + l] * (1.f / 128.f) + EPS);
#pragma unroll
            for (int n = 0; n < 4; ++n) HT[l * 132 + c0 + 16 * n + lc] = ai[m][n][i] * rstd; }
    __syncthreads();
    { const float* mg = A.in[10] + hm * 128; bf16* Y = WSP(bf16, WS_XNY);
#pragma unroll
      for (int it = 0; it < 4; ++it) { const int item = tid + 512 * it, l = item >> 4, ch = (item & 15) * 8; const size_t row = rowb + t0 + l;
          const v4u ow = owf[it];
          const f32x4 h0 = *(const LAS f32x4*)(HT + l * 132 + ch), h1 = *(const LAS f32x4*)(HT + l * 132 + ch + 4), g0 = *(const f32x4*)(mg + ch), g1 = *(const f32x4*)(mg + ch + 4);
          v4u o; o.x = pk2(h0.x * g0.x * sigmoid_f(bflo(ow.x)), h0.y * g0.y * sigmoid_f(bfhi(ow.x))); o.y = pk2(h0.z * g0.z * sigmoid_f(bflo(ow.y)), h0.w * g0.w * sigmoid_f(bfhi(ow.y)));
          o.z = pk2(h1.x * g1.x * sigmoid_f(bflo(ow.z)), h1.y * g1.y * sigmoid_f(bfhi(ow.z))); o.w = pk2(h1.z * g1.z * sigmoid_f(bflo(ow.w)), h1.w * g1.w * sigmoid_f(bfhi(ow.w)));
          *(GAS v4u*)(Y + row * 1024 + hm * 128 + ch) = o; } }
    __syncthreads();
    PROF_T1(0, 37)
}
template <int N> __device__ __forceinline__ void bitonic_sort_desc(float (&v)[N]) {
#pragma unroll
    for (int k = 2; k <= N; k <<= 1)
#pragma unroll
        for (int j = k >> 1; j > 0; j >>= 1)
#pragma unroll
            for (int i = 0; i < N; ++i) { const int l = i ^ j; if (l > i) { const bool desc = ((i & k) == 0); const float a = v[i], b = v[l]; const float mx = fmaxf(a, b), mn = fminf(a, b); v[i] = desc ? mx : mn; v[l] = desc ? mn : mx; } }
}
__device__ __forceinline__ void merge_top16(float (&run)[16], const float (&nw)[16]) {
#pragma unroll
    for (int i = 0; i < 16; ++i) run[i] = fmaxf(run[i], nw[15 - i]);
#pragma unroll
    for (int j = 8; j > 0; j >>= 1)
#pragma unroll
        for (int i = 0; i < 16; ++i) { const int l = i ^ j; if (l > i) { const float a = run[i], b = run[l]; run[i] = fmaxf(a, b); run[l] = fminf(a, b); } }
}
constexpr int SCS = 132;
template <int GRP> __device__ __forceinline__ void route_cand(float (&nw)[16], const float (&s0)[16], const float (&s1)[16]) {
    constexpr int CNT[16] = {16, 8, 5, 4, 3, 2, 2, 2, 1, 1, 1, 1, 1, 1, 1, 1};
    constexpr int OFF[16] = {0, 16, 24, 29, 33, 36, 38, 40, 42, 43, 44, 45, 46, 47, 48, 49};
#pragma unroll
    for (int i = 0; i < 16; ++i)
#pragma unroll
        for (int j = 0; j < 16; ++j) if (j < CNT[i] && (OFF[i] + j) / 16 == GRP) {
            const float sum = s0[i] + s1[j];
            nw[(OFF[i] + j) % 16] = u2f((f2u(sum) & ~255u) | (unsigned)(i * 16 + j)); }
}
__device__ __forceinline__ void peer_route_unit(Frame& F, int tok0, int hd, const bf16x8 (&kf)[4][2], const int mode = 0) {
    const bf16* QRY = WSP(bf16, WS_QRY); unsigned short* IDX = WSP(unsigned short, WS_IDX); float* GATE = WSP(float, WS_GATE);
    LAS float* SC = (LAS float*)F.lds;
    const int lane = ((int)(threadIdx.x & 63u)), w = F.wave, tid = ((int)threadIdx.x);
    PROF_T0(0, 50)
    {
        constexpr int AST = 528;
        LAS unsigned char* As = F.lds;
#pragma unroll
        for (int i = 0; i < 8; ++i) { const int ch = tid + 512 * i, row = ch >> 5, cc = ch & 31;
            *(LAS v4u*)(As + row * AST + cc * 16) = *(const GAS v4u*)(QRY + (size_t)(tok0 + row) * QLD + hd * 256 + cc * 8); }
        __syncthreads();
        const int p = w & 1, nq = w >> 1, r = lane & 15, kq = (lane >> 4) * 16;
        f32x4 acc[8][2];
#pragma unroll
        for (int m = 0; m < 8; ++m) { acc[m][0] = (f32x4){0.f, 0.f, 0.f, 0.f}; acc[m][1] = (f32x4){0.f, 0.f, 0.f, 0.f}; }
#pragma unroll
        for (int ks = 0; ks < 4; ++ks)
#pragma unroll
            for (int m = 0; m < 8; ++m) { const bf16x8 a = *(const LAS bf16x8*)(As + (16 * m + r) * AST + p * 256 + ks * 64 + kq);
                acc[m][0] = __builtin_amdgcn_mfma_f32_16x16x32_bf16(a, kf[ks][0], acc[m][0], 0, 0, 0);
                acc[m][1] = __builtin_amdgcn_mfma_f32_16x16x32_bf16(a, kf[ks][1], acc[m][1], 0, 0, 0); }
        __syncthreads();
#pragma unroll
        for (int m = 0; m < 8; ++m)
#pragma unroll
            for (int n = 0; n < 2; ++n)
#pragma unroll
                for (int i = 0; i < 4; ++i) SC[(p * 128 + 16 * m + 4 * (lane >> 4) + i) * SCS + 32 * nq + 16 * n + r] = acc[m][n][i];
    }
    __syncthreads();
    PROF_T1(0, 50)
    PROF_T0(0, 51)
    if (!(mode & 256))
    {
        const int t = tid & 127, p = (tid >> 7) & 1, half = tid >> 8;
        LAS float* seg = SC + (p * 128 + t) * SCS + 64 * half;
        float run[16], nw[16];
#pragma unroll
        for (int ch = 0; ch < 4; ++ch) {
#pragma unroll
            for (int q = 0; q < 4; ++q) { const f32x4 v = *(const LAS f32x4*)(seg + 16 * ch + 4 * q);
#pragma unroll
                for (int e = 0; e < 4; ++e) { const unsigned n = (unsigned)(64 * half + 16 * ch + 4 * q + e); const float key = u2f((f2u(v[e]) & ~127u) | n);
                    if (ch == 0) run[4 * q + e] = key; else nw[4 * q + e] = key; } }
            if (ch == 0) bitonic_sort_desc<16>(run); else { bitonic_sort_desc<16>(nw); merge_top16(run, nw); }
        }
#pragma unroll
        for (int q = 0; q < 4; ++q) *(LAS f32x4*)(seg + 4 * q) = (f32x4){run[4 * q], run[4 * q + 1], run[4 * q + 2], run[4 * q + 3]};
    }
    __syncthreads();
    PROF_T1(0, 51)
    PROF_T0(0, 52)
    float top[16];
    if (!(mode & 384)) {
        const int t = tid & 127, g = tid >> 7;
        float s0[16], s1[16];
        {
            LAS float* a = SC + (0 * 128 + t) * SCS; float nw[16];
#pragma unroll
            for (int q = 0; q < 4; ++q) { const f32x4 v = *(const LAS f32x4*)(a + 4 * q), u = *(const LAS f32x4*)(a + 64 + 4 * q);
#pragma unroll
                for (int e = 0; e < 4; ++e) { s0[4 * q + e] = v[e]; nw[4 * q + e] = u[e]; } }
            merge_top16(s0, nw);
            if (g == 0) {
#pragma unroll
                for (int q = 0; q < 4; ++q) *(LAS f32x4*)(a + 16 + 4 * q) = (f32x4){s0[4 * q], s0[4 * q + 1], s0[4 * q + 2], s0[4 * q + 3]}; }
        }
        {
            LAS float* a = SC + (1 * 128 + t) * SCS; float nw[16];
#pragma unroll
            for (int q = 0; q < 4; ++q) { const f32x4 v = *(const LAS f32x4*)(a + 4 * q), u = *(const LAS f32x4*)(a + 64 + 4 * q);
#pragma unroll
                for (int e = 0; e < 4; ++e) { s1[4 * q + e] = v[e]; nw[4 * q + e] = u[e]; } }
            merge_top16(s1, nw);
            if (g == 1) {
#pragma unroll
                for (int q = 0; q < 4; ++q) *(LAS f32x4*)(a + 16 + 4 * q) = (f32x4){s1[4 * q], s1[4 * q + 1], s1[4 * q + 2], s1[4 * q + 3]}; }
        }
#pragma unroll
        for (int i = 0; i < 16; ++i) { s0[i] = u2f(f2u(s0[i]) & ~127u); s1[i] = u2f(f2u(s1[i]) & ~127u); }
        float nw[16];
#pragma unroll
        for (int e = 0; e < 16; ++e) nw[e] = -INFINITY;
        if (g == 0) route_cand<0>(nw, s0, s1); else if (g == 1) route_cand<1>(nw, s0, s1); else if (g == 2) route_cand<2>(nw, s0, s1); else route_cand<3>(nw, s0, s1);
        bitonic_sort_desc<16>(nw);
        LAS float* o = SC + ((g >> 1) * 128 + t) * SCS + 32 + 16 * (g & 1);
#pragma unroll
        for (int q = 0; q < 4; ++q) *(LAS f32x4*)(o + 4 * q) = (f32x4){nw[4 * q], nw[4 * q + 1], nw[4 * q + 2], nw[4 * q + 3]};
    }
    __syncthreads();
    if (tid < 256 && !(mode & 384)) {
        const int t = tid & 127, h2 = tid >> 7;
        LAS float* a = SC + (h2 * 128 + t) * SCS + 32; float nw[16];
#pragma unroll
        for (int q = 0; q < 4; ++q) { const f32x4 v = *(const LAS f32x4*)(a + 4 * q), u = *(const LAS f32x4*)(a + 16 + 4 * q);
#pragma unroll
            for (int e = 0; e < 4; ++e) { top[4 * q + e] = v[e]; nw[4 * q + e] = u[e]; } }
        merge_top16(top, nw);
        if (h2 == 1) {
#pragma unroll
            for (int q = 0; q < 4; ++q) *(LAS f32x4*)(a + 48 + 4 * q) = (f32x4){top[4 * q], top[4 * q + 1], top[4 * q + 2], top[4 * q + 3]}; }
    }
    __syncthreads();
    if (tid < 128 && !(mode & 384)) {
        const int t = tid;
        { LAS float* a = SC + (1 * 128 + t) * SCS + 80; float nw[16];
#pragma unroll
          for (int q = 0; q < 4; ++q) { const f32x4 v = *(const LAS f32x4*)(a + 4 * q);
#pragma unroll
              for (int e = 0; e < 4; ++e) nw[4 * q + e] = v[e]; }
          merge_top16(top, nw); }
        float sc[16], den = 0.f;
        const float mx = u2f(f2u(top[0]) & ~255u);
#pragma unroll
        for (int k = 0; k < 16; ++k) { sc[k] = __expf(u2f(f2u(top[k]) & ~255u) - mx); den += sc[k]; }
        const float inv = 1.f / den;
        LDS_WAIT();
        const LAS unsigned* l0 = (const LAS unsigned*)(SC + (0 * 128 + t) * SCS + 16); const LAS unsigned* l1 = (const LAS unsigned*)(SC + (1 * 128 + t) * SCS + 16);
        const size_t ob = ((size_t)hd * M + tok0 + t) * 16;
        unsigned eid[16];
#pragma unroll
        for (int k = 0; k < 16; ++k) { const unsigned id = f2u(top[k]) & 255u; const unsigned e0 = l0[id >> 4] & 127u, e1 = l1[id & 15u] & 127u; eid[k] = e0 * 128u + e1; }
        { v4u i0, i1; i0.x = eid[0] | (eid[1] << 16); i0.y = eid[2] | (eid[3] << 16); i0.z = eid[4] | (eid[5] << 16); i0.w = eid[6] | (eid[7] << 16);
          i1.x = eid[8] | (eid[9] << 16); i1.y = eid[10] | (eid[11] << 16); i1.z = eid[12] | (eid[13] << 16); i1.w = eid[14] | (eid[15] << 16);
          if (!(mode & 512)) { *(GAS v4u*)(IDX + ob) = i0; *(GAS v4u*)(IDX + ob + 8) = i1; } }
#pragma unroll
        for (int q4 = 0; q4 < 4; ++q4) if (!(mode & 512)) *(GAS f32x4*)(GATE + ob + 4 * q4) = (f32x4){sc[4 * q4] * inv, sc[4 * q4 + 1] * inv, sc[4 * q4 + 2] * inv, sc[4 * q4 + 3] * inv};
        }
    __syncthreads();
    PROF_T1(0, 52)
}
__device__ __forceinline__ void peer_u_phase(Frame& F, const unsigned char* U8  ) {
    const bf16* XN = WSP(bf16, WS_XNY); const unsigned short* IDX = WSP(unsigned short, WS_IDX); unsigned short* PART = WSP(unsigned short, WS_PART);
    const int lane = (int)(threadIdx.x & 63u), t8 = lane >> 3, l8 = lane & 7;
    const int g = F.bid & 7, nsw = (F.G >> 3) * NWAVES, ws = (F.bid >> 3) * NWAVES + F.wave;
    const unsigned char* Ug = U8 + (size_t)g * 16384 * 128; const unsigned lo8 = 16u * (unsigned)l8;
    for (int wi = ws; wi < M / 8; wi += nsw) {
        const int tok = wi * 8 + t8;
        int hq[4]; float hsc;
        { const bf16* hp = XN + (size_t)tok * D + 128 * g + 16 * l8; const v4u x = *(const GAS v4u*)hp, y = *(const GAS v4u*)(hp + 8);
          const float hf[16] = {bflo(x.x), bfhi(x.x), bflo(x.y), bfhi(x.y), bflo(x.z), bfhi(x.z), bflo(x.w), bfhi(x.w), bflo(y.x), bfhi(y.x), bflo(y.y), bfhi(y.y), bflo(y.z), bfhi(y.z), bflo(y.w), bfhi(y.w)};
          float am = 0.f;
#pragma unroll
          for (int i = 0; i < 16; ++i) am = fmaxf(am, fabsf(hf[i]));
          am = fmaxf(am, __shfl_xor(am, 1)); am = fmaxf(am, __shfl_xor(am, 2)); am = fmaxf(am, __shfl_xor(am, 4));
          const float hinv = am > 1e-30f ? 127.f / am : 0.f; hsc = am * (1.f / (127.f * 64.f));
#pragma unroll
          for (int q4 = 0; q4 < 4; ++q4) { unsigned wv = 0;
#pragma unroll
              for (int e = 0; e < 4; ++e) { const int qv = (int)rintf(hf[4 * q4 + e] * hinv); wv |= ((unsigned)qv & 0xffu) << (8 * e); }
              hq[q4] = (int)wv; } }
        const unsigned short* ip = IDX + (size_t)tok * 128; unsigned short* pp = PART + ((size_t)g * M + tok) * 128;
#pragma unroll 4
        for (int gi = 0; gi < 16; ++gi) {
            const v4u idp = *(const GAS v4u*)(ip + 8 * gi);
            const unsigned e0 = idp.x & 0xffffu, e1 = idp.x >> 16, e2 = idp.y & 0xffffu, e3 = idp.y >> 16, e4 = idp.z & 0xffffu, e5 = idp.z >> 16, e6 = idp.w & 0xffffu, e7 = idp.w >> 16;
            const v4u r0 = *(const GAS v4u*)(Ug + ((e0 << 7) | lo8)), r1 = *(const GAS v4u*)(Ug + ((e1 << 7) | lo8)), r2 = *(const GAS v4u*)(Ug + ((e2 << 7) | lo8)), r3 = *(const GAS v4u*)(Ug + ((e3 << 7) | lo8));
            const v4u r4 = *(const GAS v4u*)(Ug + ((e4 << 7) | lo8)), r5 = *(const GAS v4u*)(Ug + ((e5 << 7) | lo8)), r6 = *(const GAS v4u*)(Ug + ((e6 << 7) | lo8)), r7 = *(const GAS v4u*)(Ug + ((e7 << 7) | lo8));
#define U_DOT(R) ({ const unsigned a_ = R.x, b_ = R.y, c_ = R.z, d_ = R.w; int acc_ = __builtin_amdgcn_sdot4((int)a_, hq[0], 0, false); acc_ = __builtin_amdgcn_sdot4((int)b_, hq[1], acc_, false); \
                    acc_ = __builtin_amdgcn_sdot4((int)c_, hq[2], acc_, false); acc_ = __builtin_amdgcn_sdot4((int)d_, hq[3], acc_, false); \
                    acc_ += __shfl_xor(acc_, 1); acc_ += __shfl_xor(acc_, 2); acc_ += __shfl_xor(acc_, 4); (float)acc_ * hsc; })
            const float d0 = U_DOT(r0), d1 = U_DOT(r1), d2 = U_DOT(r2), d3 = U_DOT(r3), d4 = U_DOT(r4), d5 = U_DOT(r5), d6 = U_DOT(r6), d7 = U_DOT(r7);
#undef U_DOT
            if (l8 == 0) { v4u o; o.x = f2h2(d0, d1); o.y = f2h2(d2, d3); o.z = f2h2(d4, d5); o.w = f2h2(d6, d7); *(GAS v4u*)(pp + 8 * gi) = o; }
        }
    }
}
template <int CTRL> __device__ __forceinline__ int dppx(int v) { return __builtin_amdgcn_update_dpp(0, v, CTRL, 0xf, 0xf, false); }

__device__ __forceinline__ void peer_sort_phase(Frame& F, const int mode = 0) {
    const unsigned short* IDX = WSP(unsigned short, WS_IDX); unsigned* LIST = WSP(unsigned, WS_LIST);
    LAS unsigned* hist = (LAS unsigned*)F.lds;
    LAS unsigned* aux = hist + 2112;
    const int tid = (int)threadIdx.x, lane = tid & 63;
    for (int unit = F.bid; unit < 256; unit += F.G) {
        const unsigned t = ((unsigned)unit & 7u) * 4u + ((unsigned)unit >> 6), r = ((unsigned)unit >> 3) & 7u;
        PROF_T0(mode, 1)
        for (int i = tid; i < 2112; i += NTHR) hist[i] = 0u;
        if (tid < 16) aux[tid] = 0u;
        __syncthreads();
        PROF_T0(mode, 2)
        unsigned low = 0u;
        for (int hf = 0; hf < 2; ++hf) {
        v4u w[16];
#pragma unroll
        for (int st = 0; st < 16; ++st) { const int jv = (hf * 16 + st) * 512 + tid; w[st] = *(const GAS v4u*)(IDX + ((size_t)(jv >> 11) * M + (size_t)t * 1024) * 16 + (size_t)(jv & 2047) * 8); }
#pragma unroll
        for (int st = 0; st < 16; ++st) { const unsigned ww[4] = {w[st].x, w[st].y, w[st].z, w[st].w};
#pragma unroll
            for (int k = 0; k < 8; ++k) { const unsigned e = (k & 1) ? (ww[k >> 1] >> 16) : (ww[k >> 1] & 0xffffu); const unsigned rg = e >> 11;
                low += rg < r ? 1u : 0u;
                if (!(mode & 0x400)) __hip_atomic_fetch_add(hist + (rg == r ? (e & 2047u) : 2048u + (unsigned)lane), 1u, __ATOMIC_RELAXED, __HIP_MEMORY_SCOPE_WORKGROUP); } }
        }
#pragma unroll
        for (int o = 1; o < 64; o <<= 1) low += __shfl_xor(low, o);
        if (lane == 0) __hip_atomic_fetch_add(aux, low, __ATOMIC_RELAXED, __HIP_MEMORY_SCOPE_WORKGROUP);
        __syncthreads();
        PROF_T1(mode, 2)
        PROF_T0(mode, 3)
        {
            const unsigned h0 = hist[4 * tid], h1 = hist[4 * tid + 1], h2 = hist[4 * tid + 2], h3 = hist[4 * tid + 3]; const unsigned s = h0 + h1 + h2 + h3; unsigned inc = s;
#pragma unroll
            for (int o = 1; o < 64; o <<= 1) { const unsigned v = __shfl_up(inc, o); if (lane >= o) inc += v; }
            if (lane == 63) aux[8 + F.wave] = inc;
            __syncthreads();
            unsigned off = aux[0];
            for (int wv = 0; wv < F.wave; ++wv) off += aux[8 + wv];
            const unsigned ex = off + inc - s;
            hist[4 * tid] = ex; hist[4 * tid + 1] = ex + h0; hist[4 * tid + 2] = ex + h0 + h1; hist[4 * tid + 3] = ex + h0 + h1 + h2;
        }
        __syncthreads();
        PROF_T1(mode, 3)
        PROF_T0(mode, 4)
        unsigned* L = LIST + (size_t)t * 131072;
        if (!(mode & 0x200))
        for (int hf = 0; hf < 2; ++hf) {
        v4u w[16];
#pragma unroll
        for (int st = 0; st < 16; ++st) { const int jv = (hf * 16 + st) * 512 + tid; w[st] = *(const GAS v4u*)(IDX + ((size_t)(jv >> 11) * M + (size_t)t * 1024) * 16 + (size_t)(jv & 2047) * 8); }
#pragma unroll
        for (int st = 0; st < 16; ++st) { const unsigned ww[4] = {w[st].x, w[st].y, w[st].z, w[st].w}; const unsigned i0 = (unsigned)((hf * 16 + st) * 512 + tid) * 8u;
            unsigned pos[8];
#pragma unroll
            for (int k = 0; k < 8; ++k) { const unsigned e = (k & 1) ? (ww[k >> 1] >> 16) : (ww[k >> 1] & 0xffffu);
                pos[k] = __hip_atomic_fetch_add(hist + ((e >> 11) == r ? (e & 2047u) : 2048u + (unsigned)lane), 1u, __ATOMIC_RELAXED, __HIP_MEMORY_SCOPE_WORKGROUP); }
#pragma unroll
            for (int k = 0; k < 8; ++k) { const unsigned e = (k & 1) ? (ww[k >> 1] >> 16) : (ww[k >> 1] & 0xffffu);
                if ((e >> 11) == r && !(mode & 0x100)) L[pos[k]] = (e << 17) | (i0 + (unsigned)k); } }
        }
        __syncthreads();
        PROF_T1(mode, 4)
        PROF_T1(mode, 1)
    }
}

__device__ __forceinline__ void peer_u_sorted(Frame& F, const unsigned char* U8  , const int mode = 0) {
    const bf16* XN = WSP(bf16, WS_XNY); const unsigned* LIST = WSP(unsigned, WS_LIST); unsigned short* PART = WSP(unsigned short, WS_PART);
    const int lane = (int)(threadIdx.x & 63u), p8 = lane >> 3, l8 = lane & 7;
    LAS unsigned char* hl = F.lds;
    LAS float* hs = (LAS float*)(F.lds + 131072);
    const unsigned lo8 = 16u * (unsigned)l8;
    for (int unit = F.bid; unit < 256; unit += F.G) {
        const int t = unit >> 3, g = unit & 7;
        const unsigned char* Ug = U8 + (size_t)g * 16384 * 128;
        PROF_T0(mode, 5)
#pragma unroll 8
        for (int s = 0; s < 16; ++s) { const int tl = (s * NWAVES + F.wave) * 8 + p8;
            const bf16* hp = XN + (size_t)(t * 1024 + tl) * D + 128 * g + 16 * l8; const v4u x = *(const GAS v4u*)hp, y = *(const GAS v4u*)(hp + 8);
            const float hf[16] = {bflo(x.x), bfhi(x.x), bflo(x.y), bfhi(x.y), bflo(x.z), bfhi(x.z), bflo(x.w), bfhi(x.w), bflo(y.x), bfhi(y.x), bflo(y.y), bfhi(y.y), bflo(y.z), bfhi(y.z), bflo(y.w), bfhi(y.w)};
            float am = 0.f;
#pragma unroll
            for (int i = 0; i < 16; ++i) am = fmaxf(am, fabsf(hf[i]));
            am = fmaxf(am, __shfl_xor(am, 1)); am = fmaxf(am, __shfl_xor(am, 2)); am = fmaxf(am, __shfl_xor(am, 4));
            const float hinv = am > 1e-30f ? 127.f / am : 0.f;
            v4u hq; unsigned hw[4];
#pragma unroll
            for (int q4 = 0; q4 < 4; ++q4) { unsigned wv = 0;
#pragma unroll
                for (int e = 0; e < 4; ++e) { const int qv = (int)rintf(hf[4 * q4 + e] * hinv); wv |= ((unsigned)qv & 0xffu) << (8 * e); }
                hw[q4] = wv; }
            hq.x = hw[0]; hq.y = hw[1]; hq.z = hw[2]; hq.w = hw[3];
            *(LAS v4u*)(hl + tl * 128 + lo8) = hq;
            if (l8 == 0) hs[tl] = am * (1.f / (127.f * 64.f)); }
        __syncthreads();
        PROF_T1(mode, 5)
        PROF_T0(mode, 6)
        const unsigned* L = LIST + (size_t)t * 131072 + F.wave * 16384; unsigned short* P = PART + ((size_t)g * 32 + t) * 131072 + F.wave * 16384;
        const bool u2 = (l8 & 4) != 0, u1 = (l8 & 2) != 0, u0 = (l8 & 1) != 0;
        LAS unsigned* es = (LAS unsigned*)(F.lds + 135168) + F.wave * 128;
        unsigned mine0 = L[lane], mine1 = L[64 + lane];
        es[lane] = mine0;
        v4u eaA = *(const LAS v4u*)(es + p8 * 8), ebA = *(const LAS v4u*)(es + p8 * 8 + 4), eaB, ebB;
        v4u rwA[8], rwB[8];
        { const unsigned en[8] = {eaA.x, eaA.y, eaA.z, eaA.w, ebA.x, ebA.y, ebA.z, ebA.w};
#pragma unroll
          for (int j = 0; j < 8; ++j) rwA[j] = *(const GAS v4u*)(Ug + (((en[j] >> 17) << 7) | lo8)); }
#define U_TRIP(IT, RWC, EAC, EBC, RWN, EAN, EBN, SLOT) do { const int base = (IT) * 64; const int nb = ((IT) + 2 < 256 ? (IT) + 2 : 255) * 64; \
            const unsigned mine2 = L[nb + lane]; \
            LAS unsigned* sl = es + (SLOT) * 64; sl[lane] = mine1; \
            EAN = *(const LAS v4u*)(sl + p8 * 8); EBN = *(const LAS v4u*)(sl + p8 * 8 + 4); \
            { const unsigned en1[8] = {EAN.x, EAN.y, EAN.z, EAN.w, EBN.x, EBN.y, EBN.z, EBN.w}; \
              _Pragma("unroll") for (int j = 0; j < 8; ++j) RWN[j] = *(const GAS v4u*)(Ug + (((en1[j] >> 17) << 7) | lo8)); } \
            __builtin_amdgcn_sched_barrier(0);        \
            const unsigned en[8] = {EAC.x, EAC.y, EAC.z, EAC.w, EBC.x, EBC.y, EBC.z, EBC.w}; \
            int acc[8]; \
            _Pragma("unroll") for (int j = 0; j < 8; ++j) { const v4u hv = *(const LAS v4u*)(hl + ((((en[j] >> 4) & 1023u) << 7) | lo8)); \
                const unsigned ra = RWC[j].x, rb = RWC[j].y, rc = RWC[j].z, rd = RWC[j].w, ha = hv.x, hb = hv.y, hc = hv.z, hd = hv.w; \
                int a = __builtin_amdgcn_sdot4((int)ra, (int)ha, 0, false); a = __builtin_amdgcn_sdot4((int)rb, (int)hb, a, false); \
                a = __builtin_amdgcn_sdot4((int)rc, (int)hc, a, false); a = __builtin_amdgcn_sdot4((int)rd, (int)hd, a, false); acc[j] = a; } \
            int q[4], r2[2]; \
            _Pragma("unroll") for (int i = 0; i < 4; ++i) { const int send = u2 ? acc[i] : acc[i + 4], keep = u2 ? acc[i + 4] : acc[i]; q[i] = keep + dppx<0x141>(send); } \
            _Pragma("unroll") for (int i = 0; i < 2; ++i) { const int send = u1 ? q[i] : q[i + 2], keep = u1 ? q[i + 2] : q[i]; r2[i] = keep + dppx<0x4E>(send); } \
            const int send = u0 ? r2[0] : r2[1], keep = u0 ? r2[1] : r2[0]; const int tot = keep + dppx<0xB1>(send); \
            const float dv = (float)tot * hs[(mine0 >> 4) & 1023u]; \
            P[base + lane] = (unsigned short)(f2h2(dv, 0.f) & 0xffffu); \
            mine0 = mine1; mine1 = mine2; } while (0)
        for (int it = 0; it < 256; it += 2) {
            U_TRIP(it, rwA, eaA, ebA, rwB, eaB, ebB, 1);
            U_TRIP(it + 1, rwB, eaB, ebB, rwA, eaA, ebA, 0);
        }
#undef U_TRIP
        __syncthreads();
        PROF_T1(mode, 6)
    }
}

__device__ __forceinline__ void peer_reduce_phase(Frame& F) {
    const unsigned* LIST = WSP(unsigned, WS_LIST); const unsigned short* PART = WSP(unsigned short, WS_PART); float* DT = WSP(float, WS_DTOK);
    for (int unit = F.bid; unit < 256; unit += F.G) {
        const size_t t = (size_t)(unit & 7) * 4 + (unit >> 6), k8 = (unit >> 3) & 7; const size_t tb = t * 131072;
#pragma unroll 2
        for (int st = 0; st < 4; ++st) { const size_t p0 = tb + k8 * 16384 + ((size_t)st * NTHR + (int)threadIdx.x) * 8;
            float s[8];
#pragma unroll
            for (int k = 0; k < 8; ++k) s[k] = 0.f;
#pragma unroll
            for (int g = 0; g < 8; ++g) { const v4u w = *(const GAS v4u*)(PART + (size_t)g * 32 * 131072 + p0); const unsigned w0 = w.x, w1 = w.y, w2 = w.z, w3 = w.w;
                s[0] += h2f_lo(w0); s[1] += h2f_hi(w0); s[2] += h2f_lo(w1); s[3] += h2f_hi(w1); s[4] += h2f_lo(w2); s[5] += h2f_hi(w2); s[6] += h2f_lo(w3); s[7] += h2f_hi(w3); }
            const v4u la = *(const GAS v4u*)(LIST + p0), lb = *(const GAS v4u*)(LIST + p0 + 4);
            const unsigned en[8] = {la.x, la.y, la.z, la.w, lb.x, lb.y, lb.z, lb.w};
#pragma unroll
            for (int k = 0; k < 8; ++k) DT[tb + (en[k] & 0x1ffffu)] = s[k]; }
    }
}
__device__ __forceinline__ void peer_act_phase(Frame& F, const float* ISU, const float* ISV) {
    const unsigned short* IDX = WSP(unsigned short, WS_IDX); const float* GATE = WSP(float, WS_GATE); const unsigned* PART = WSP(unsigned, WS_PART);
    unsigned short* ACT8 = WSP(unsigned short, WS_ACT); float* ACTS = WSP(float, WS_ACTS);
    const int gw = F.bid * NWAVES + F.wave, NGW = F.G * NWAVES, lane = ((int)(threadIdx.x & 63u));
    constexpr int NT = 4;
    for (int tok0 = gw; tok0 < M; tok0 += NT * NGW) {
        float2 dd[NT], gt[NT]; unsigned idw[NT];
#pragma unroll
        for (int j = 0; j < NT; ++j) { const int tok = tok0 + j * NGW;
            const size_t ih = ((size_t)(lane >> 3) * M + tok) * 16 + 2 * (lane & 7);
            const size_t idt = ((size_t)(tok >> 10) << 17) + (size_t)(lane >> 3) * 16384 + (size_t)(tok & 1023) * 16 + 2 * (lane & 7);
            dd[j] = *(const float2*)(WSP(float, WS_DTOK) + idt); idw[j] = *(const unsigned*)(IDX + ih); gt[j] = *(const float2*)(GATE + ih); }
        float su0[NT], su1[NT], sv0[NT], sv1[NT];
#pragma unroll
        for (int j = 0; j < NT; ++j) { const unsigned w_ = idw[j]; const int ix = (int)(w_ & 0xffffu), iy = (int)(w_ >> 16); su0[j] = ISU[ix]; su1[j] = ISU[iy]; sv0[j] = ISV[ix]; sv1[j] = ISV[iy]; }
#pragma unroll
        for (int j = 0; j < NT; ++j) { const int tok = tok0 + j * NGW;
            const float d0 = dd[j].x * (64.f * su0[j]), d1 = dd[j].y * (64.f * su1[j]);
            const float a0 = 0.5f * d0 * (1.f + erff(d0 * 0.70710678118654752f)) * gt[j].x * sv0[j], a1 = 0.5f * d1 * (1.f + erff(d1 * 0.70710678118654752f)) * gt[j].y * sv1[j];
            const float am = wave_max_fast(fmaxf(fabsf(a0), fabsf(a1)));
            const float inv = am > 1e-30f ? 127.f / am : 0.f;
            const int q0 = (int)rintf(a0 * inv), q1 = (int)rintf(a1 * inv);
            ACT8[(size_t)tok * 64 + lane] = (unsigned short)(((unsigned)q0 & 0xffu) | (((unsigned)q1 & 0xffu) << 8));
            if (lane == 0) ACTS[tok] = am * (1.f / 127.f); }
    }
}
template <bool FINAL>
__device__ __forceinline__ void peer_v_phase(Frame& F, const unsigned char* V8, const float* g2  ) {
    const unsigned short* IDX = WSP(unsigned short, WS_IDX); const unsigned* ACT8 = WSP(unsigned, WS_ACT); const float* ACTS = WSP(float, WS_ACTS);
    const int lane = ((int)(threadIdx.x & 63u)), t8 = lane >> 3, l8 = lane & 7;
    const int g = F.bid & 7, nsw = (F.G >> 3) * NWAVES, ws = (F.bid >> 3) * NWAVES + F.wave;
    const unsigned char* Vg = V8 + (size_t)g * 16384 * 128; const unsigned lo8 = 16u * (unsigned)l8;
    LAS unsigned char* vsl = F.lds + F.wave * 3072;
    v4u ni0, ni1, na0;
    { const int tok = ws * 8 + t8; const GAS v4u* ipg = (const GAS v4u*)(IDX + ((size_t)l8 * M + tok) * 16); ni0 = ipg[0]; ni1 = ipg[1]; na0 = *(const GAS v4u*)(ACT8 + (size_t)tok * 32 + 4 * l8); }
    for (int wi = ws; wi < M / 8; wi += nsw) {
        const int tok = wi * 8 + t8;
        { *(LAS v4u*)(vsl + t8 * 256 + l8 * 32) = ni0; *(LAS v4u*)(vsl + t8 * 256 + l8 * 32 + 16) = ni1; *(LAS v4u*)(vsl + 2048 + t8 * 128 + l8 * 16) = na0;
          const int nwi = wi + nsw < M / 8 ? wi + nsw : wi; const int ntok = nwi * 8 + t8;
          const GAS v4u* ipg = (const GAS v4u*)(IDX + ((size_t)l8 * M + ntok) * 16); ni0 = ipg[0]; ni1 = ipg[1]; na0 = *(const GAS v4u*)(ACT8 + (size_t)ntok * 32 + 4 * l8); }
        const LAS unsigned char* ipl = vsl + t8 * 256; const LAS unsigned* apl = (const LAS unsigned*)(vsl + 2048 + t8 * 128);
        const float sc = ACTS[tok];
        const int b = tok >> 13, c0 = 128 * g + 16 * l8; bf16* xs = WSP(bf16, WS_XS) + (size_t)tok * D + c0; const float* gr = g2 + (size_t)b * 6144 + c0;
        const v4u xa = *(const GAS v4u*)xs, xb = *(const GAS v4u*)(xs + 8);
        f32x4 gvq[4];
#pragma unroll
        for (int q4 = 0; q4 < 4; ++q4) gvq[q4] = *(const f32x4*)(gr + 4 * q4);
        int acc[16];
#pragma unroll
        for (int i = 0; i < 16; ++i) acc[i] = 0;
#pragma unroll 8
        for (int gi = 0; gi < 32; ++gi) {
            const v2u idp = *(const LAS v2u*)(ipl + gi * 8); v4u id4; id4.x = idp.x & 0xffffu; id4.y = idp.x >> 16; id4.z = idp.y & 0xffffu; id4.w = idp.y >> 16; const int qa = (int)apl[gi];
            const v4u ra = *(const GAS v4u*)(Vg + ((id4.x << 7) | lo8)), rb = *(const GAS v4u*)(Vg + ((id4.y << 7) | lo8)), rc = *(const GAS v4u*)(Vg + ((id4.z << 7) | lo8)), rd = *(const GAS v4u*)(Vg + ((id4.w << 7) | lo8));
            const unsigned A[4] = {ra.x, ra.y, ra.z, ra.w}, B[4] = {rb.x, rb.y, rb.z, rb.w}, C[4] = {rc.x, rc.y, rc.z, rc.w}, Dd[4] = {rd.x, rd.y, rd.z, rd.w};
#pragma unroll
            for (int j = 0; j < 4; ++j) {
                const unsigned ablo = __builtin_amdgcn_perm(B[j], A[j], 0x05010400u), abhi = __builtin_amdgcn_perm(B[j], A[j], 0x07030602u);
                const unsigned cdlo = __builtin_amdgcn_perm(Dd[j], C[j], 0x05010400u), cdhi = __builtin_amdgcn_perm(Dd[j], C[j], 0x07030602u);
                const unsigned t0 = __builtin_amdgcn_perm(cdlo, ablo, 0x05040100u), t1 = __builtin_amdgcn_perm(cdlo, ablo, 0x07060302u);
                const unsigned t2 = __builtin_amdgcn_perm(cdhi, abhi, 0x05040100u), t3 = __builtin_amdgcn_perm(cdhi, abhi, 0x07060302u);
                acc[4 * j] = __builtin_amdgcn_sdot4((int)t0, qa, acc[4 * j], false); acc[4 * j + 1] = __builtin_amdgcn_sdot4((int)t1, qa, acc[4 * j + 1], false);
                acc[4 * j + 2] = __builtin_amdgcn_sdot4((int)t2, qa, acc[4 * j + 2], false); acc[4 * j + 3] = __builtin_amdgcn_sdot4((int)t3, qa, acc[4 * j + 3], false);
            }
        }
        const unsigned xw[8] = {xa.x, xa.y, xa.z, xa.w, xb.x, xb.y, xb.z, xb.w};
        float o[16];
#pragma unroll
        for (int q4 = 0; q4 < 4; ++q4) { const f32x4 gv = gvq[q4];
            o[4 * q4] = bflo(xw[2 * q4]) + gv.x * sc * (float)acc[4 * q4]; o[4 * q4 + 1] = bfhi(xw[2 * q4]) + gv.y * sc * (float)acc[4 * q4 + 1];
            o[4 * q4 + 2] = bflo(xw[2 * q4 + 1]) + gv.z * sc * (float)acc[4 * q4 + 2]; o[4 * q4 + 3] = bfhi(xw[2 * q4 + 1]) + gv.w * sc * (float)acc[4 * q4 + 3]; }
        if (FINAL) { float* xr = F.out + (size_t)tok * D + c0;
#pragma unroll
            for (int q4 = 0; q4 < 4; ++q4) *(GAS f32x4*)(xr + 4 * q4) = (f32x4){o[4 * q4], o[4 * q4 + 1], o[4 * q4 + 2], o[4 * q4 + 3]};
        } else { v4u ya, yb; ya.x = pk2(o[0], o[1]); ya.y = pk2(o[2], o[3]); ya.z = pk2(o[4], o[5]); ya.w = pk2(o[6], o[7]); yb.x = pk2(o[8], o[9]); yb.y = pk2(o[10], o[11]); yb.z = pk2(o[12], o[13]); yb.w = pk2(o[14], o[15]);
            *(GAS v4u*)xs = ya; *(GAS v4u*)(xs + 8) = yb; }
    }
}
#ifndef MK_PER_PHASE
#define MK_PER_PHASE 0
#endif
constexpr int NPHASE = 24;
#ifndef PHASE_MASK
#define PHASE_MASK 0x1ffffffu
#endif
#define IN(k) (lo <= (k) && (k) < hi && ((PHASE_MASK >> (k)) & 1u))
#define SEAM(k) do { if (IN(k) && IN((k) + 1)) xcd_barrier(bar); } while (0)
__device__ __forceinline__ float alibi_tcut(const float* gq, const float* gk, int lane) { return 16.f * wave_max(fabsf(gq[lane])) * wave_max(fabsf(gk[lane])) + ALIBI_MARGIN; }
template <int layer>
__device__ __forceinline__ void layer_phases(Frame& F, const Args& args, const XcdBarrier& bar, const int lo, const int hi) {
    volatile LAS unsigned* MISCW = (volatile LAS unsigned*)(F.lds + MISC_OFF);
    float* MOD = WSP(float, WS_MOD);
    bf16* XNY = WSP(bf16, WS_XNY); bf16* Zb = WSP(bf16, WS_Z);

        constexpr int pb = layer * 12;
        const float* mod = MOD + (size_t)layer * 4 * 6144;
        if (IN(pb + 1)) { if (layer == 0) { norm_pass<true, false>(F, args, args.in[0], args.in[4], mod, 0, XNY); if (PMODE(args) & 64) { xcd_barrier(bar); norm_pass<true, false>(F, args, args.in[0], args.in[4], mod, 0, XNY); } } else norm_pass<false, true>(F, args, WSP(bf16, WS_XS), args.in[4] + 1024, mod, 0, XNY); } SEAM(pb + 1);
        if (IN(pb + 2)) {
            const int N = layer == 0 ? NZ0 : NZ1;
            pg8::Gemm g{XNY, layer == 0 ? WSP(bf16, WS_WIN0) : WSP(bf16, WS_WIN1), M, N, D}; pg8::StaticOrder S; S.init(M, N, F.G, F.bid);
            pg8::EpiBf16QK E{Zb, N, layer == 0 ? 8 : 0, layer == 0 ? 10 : 4, layer == 0 ? 10 : 4, layer == 0 ? 12 : 8, layer == 0 ? args.in[11] : args.in[15], layer == 0 ? args.in[12] : args.in[16], 0.125f * LOG2E, (LAS float*)(F.lds + 131072), (PMODE(args) & 0x1000) ? 1 : 0};
            PROF_T0(PMODE(args), 10)
            pg8::gemm_phase<pg8::EpiBf16QK, pg8::StaticOrder, true, true>(F.lds, g, S, E);
            PROF_T1(PMODE(args), 10)
        } SEAM(pb + 2);
        if (layer == 0) {
            if (IN(3)) {
                PROF_T0(PMODE(args), 30)
                for (int u = F.bid; u < 1024 + 128; u += F.G) {
                    if (u < 1024) mlstm_a_unit(F, args, u);
                    else { const int v = u - 1024, b = v >> 5, j = v & 31;
                        kmean_unit(F, Zb, NZ0, b * SEQ + j * 256, 2560, WSP(float, WS_KMEAN) + (size_t)((b * 8) * 32 + j) * 64); }
                }
                PROF_T1(PMODE(args), 30)
            } SEAM(3);
            if (IN(4)) {
                PROF_T0(PMODE(args), 20)
                for (int u = F.bid; u < 128; u += F.G) mlstm_scan_unit(F, u);
                PROF_T1(PMODE(args), 20)
                PROF_T0(PMODE(args), 21)
                PROF_T0(PMODE(args), 23)
                { const float tcut = alibi_tcut(args.in[11], args.in[12], ((int)(threadIdx.x & 63u)));
                  const unsigned short* ORD = WSP(unsigned short, WS_ORD) + 2048; unsigned* qw = (unsigned*)(F.ws + WS_CTL) + CW_QMOBA;
                  for (int xi = 0; xi < 8; ++xi) { const int x = (F.bid + xi) & 7;
                      for (;;) { if (((int)threadIdx.x) == 0) MISCW[0] = atomicAdd(qw + 16 * x, 1u); __syncthreads(); const unsigned qi = MISCW[0]; __syncthreads(); if (qi >= 128u) break;
                          const int u = ORD[x * 128 + qi]; moba_unit(F, u >> 8, (u >> 5) & 7, u & 31, tcut); } }
                  PROF_T1(PMODE(args), 21)
                  PROF_T0(PMODE(args), 22)
                  { unsigned* cw = (unsigned*)(F.ws + WS_CTL) + CW_QCVT0;
                      for (;;) { if (((int)threadIdx.x) == 0) MISCW[0] = atomicAdd(cw, 1u); __syncthreads(); const unsigned ci = MISCW[0]; __syncthreads(); if (ci >= 512u) break; i8_chunk(F, args, 0, (int)ci); } }
                  PROF_T1(PMODE(args), 22)
                  PROF_T1(PMODE(args), 23) }
            } SEAM(4);
            if (IN(5)) { PROF_T0(PMODE(args), 31) for (int u = F.bid; u < 1024; u += F.G) mlstm_c_unit(F, args, u); PROF_T1(PMODE(args), 31) } SEAM(5);
        } else {
            if (IN(pb + 4)) {
                const float* lp = args.in[17];
                const float lam = __expf(wave_sum(lp[((int)(threadIdx.x & 63u))] * lp[64 + ((int)(threadIdx.x & 63u))])) - __expf(wave_sum(lp[128 + ((int)(threadIdx.x & 63u))] * lp[192 + ((int)(threadIdx.x & 63u))])) + 0.35550906759096926f;
                { const float tcut = alibi_tcut(args.in[15], args.in[16], ((int)(threadIdx.x & 63u)));
                  const unsigned short* ORD = WSP(unsigned short, WS_ORD); unsigned* qw = (unsigned*)(F.ws + WS_CTL) + CW_QDIFF;
                  for (int xi = 0; xi < 8; ++xi) { const int x = (F.bid + xi) & 7;
                      for (;;) { if (((int)threadIdx.x) == 0) MISCW[0] = atomicAdd(qw + 16 * x, 1u); __syncthreads(); const unsigned qi = MISCW[0]; __syncthreads(); if (qi >= 256u) break;
                          const int u = ORD[x * 256 + qi]; diff_unit(F, args, u >> 9, (u >> 6) & 7, u & 63, lam, tcut); } }
                  { unsigned* cw = (unsigned*)(F.ws + WS_CTL) + CW_QCVT1;
                      for (;;) { if (((int)threadIdx.x) == 0) MISCW[0] = atomicAdd(cw, 1u); __syncthreads(); const unsigned ci = MISCW[0]; __syncthreads(); if (ci >= 512u) break; i8_chunk(F, args, 1, (int)ci); } } }
            } SEAM(pb + 4);
        }
        if (IN(pb + 6)) {
            pg8::Gemm g{XNY, layer == 0 ? WSP(bf16, WS_WOUT0) : WSP(bf16, WS_WOUT1), M, D, D}; pg8::StaticOrder S; S.init(M, D, F.G, F.bid);
            if (layer == 0) { pg8::EpiResid<false> E{args.in[0], WSP(bf16, WS_XS), mod + 2 * 1024}; pg8::gemm_phase<pg8::EpiResid<false>, pg8::StaticOrder, true, true>(F.lds, g, S, E); }
            else { pg8::EpiResid<true> E{WSP(bf16, WS_XS), WSP(bf16, WS_XS), mod + 2 * 1024}; pg8::gemm_phase<pg8::EpiResid<true>, pg8::StaticOrder, true, true>(F.lds, g, S, E); }
        } SEAM(pb + 6);
        if (IN(pb + 7)) { PROF_T0(0, 60) norm_pass<false, true>(F, args, WSP(bf16, WS_XS), args.in[5] + layer * 1024, mod, 3, XNY); PROF_T1(0, 60) } SEAM(pb + 7);
        if (IN(pb + 8)) {
            pg8::Gemm g{XNY, WSP(bf16, WS_WQ) + (size_t)layer * NQ * D, M, NQ, D}; pg8::StaticOrder S; S.init(M, NQ, F.G, F.bid);
            pg8::EpiBf16 E{WSP(bf16, WS_QRY), QLD};
            pg8::gemm_phase<pg8::EpiBf16, pg8::StaticOrder, true, true>(F.lds, g, S, E);
        } SEAM(pb + 8);
        if (IN(pb + 9)) { const bf16* KEYS = WSP(bf16, WS_KEYS) + (size_t)layer * 2 * 128 * 128;
            bf16x8 kf[4][2];
#pragma unroll
            for (int ks = 0; ks < 4; ++ks)
#pragma unroll
                for (int n = 0; n < 2; ++n) kf[ks][n] = *(const GAS bf16x8*)(KEYS + (size_t)((F.wave & 1) * 128 + 32 * (F.wave >> 1) + 16 * n + (((int)(threadIdx.x & 63u)) & 15)) * 128 + 32 * ks + 8 * (((int)(threadIdx.x & 63u)) >> 4));
            for (int u = F.bid; u < 2048; u += F.G) peer_route_unit(F, (u >> 3) * 128, u & 7, kf, PMODE(args)); } SEAM(pb + 9);
        if (IN(pb + 10)) { peer_sort_phase(F, PMODE(args)); xcd_barrier(bar); if (!(PMODE(args) & 0x800)) peer_u_sorted(F, F.ws + WS_UB + (size_t)layer * 8 * 16384 * 128, PMODE(args)); } SEAM(pb + 10);
        if (IN(pb + 11)) { PROF_T0(0, 41) peer_reduce_phase(F); PROF_T1(0, 41) xcd_barrier(bar); PROF_T0(0, 40) peer_act_phase(F, WSP(float, WS_ISU) + layer * 16384, WSP(float, WS_ISV) + layer * 16384); PROF_T1(0, 40) } SEAM(pb + 11);
        if (IN(pb + 12)) { peer_v_phase<layer == 1>(F, F.ws + WS_VB + (size_t)layer * 8 * 16384 * 128, mod + 5 * 1024); }
        if (layer == 0) SEAM(12);
    }
__global__ void __launch_bounds__(NTHR, 2) mega_fwd(Args args) {
    extern __shared__ __attribute__((aligned(16))) unsigned char lds_raw[];
    Frame F;
    F.lds = (LAS unsigned char*)lds_raw;
    F.wave = __builtin_amdgcn_readfirstlane((int)threadIdx.x >> 6);
    F.G = gridDim.x; F.bid = blockIdx.x;
    F.out = args.out; F.ws = args.ws;
    volatile LAS unsigned* MISC = (volatile LAS unsigned*)(F.lds + MISC_OFF);
    for (int u = ((int)threadIdx.x); u < (LDS_BYTES - LDSCTL_OFF) / 4; u += NTHR) ((LAS unsigned*)(F.lds + LDSCTL_OFF))[u] = 0u;
    __syncthreads();
    XcdBarrier bar; bar.bar = (unsigned*)(F.ws + WS_CTL) + CW_BAR; bar.x = 0; bar.st = nullptr;
    if (!MK_PER_PHASE) bar = xcd_barrier_post((unsigned*)(F.ws + WS_CTL) + CW_BAR, MISC + 8);
    const int lo = args.ph_lo, hi = args.ph_hi;

#ifdef EXTRA_BAR
    for (int i = 0; i < EXTRA_BAR; ++i) xcd_barrier(bar);
#endif
    if (IN(0)) { p0_prologue(F, args); } SEAM(0);
    layer_phases<0>(F, args, bar, lo, hi);
    layer_phases<1>(F, args, bar, lo, hi);
#ifdef MK_PROBE_HI
    if (args.mode & 0xff) { xcd_barrier(bar);
        if (F.bid == 0 && threadIdx.x == 0) { const unsigned mx = __hip_atomic_load((unsigned*)(F.ws + WS_CTL) + 12288, __ATOMIC_RELAXED, __HIP_MEMORY_SCOPE_AGENT);
            const unsigned long long t0 = __builtin_amdgcn_s_memrealtime(), span = (unsigned long long)mx * PROF_K;
            while (__builtin_amdgcn_s_memrealtime() - t0 < span) __builtin_amdgcn_s_sleep(32); } }
#endif
}
#undef IN
#undef SEAM

extern "C" void kernel_launch(void* const* d_in, const int* in_sizes, int n_in, void* d_out, int out_size, void* d_ws, size_t ws_size, hipStream_t stream) {
    static int grid = 0;
    if (grid == 0) {
        if (n_in != 24 || in_sizes[0] != M * D || out_size != M * D || ws_size < WS_END) { fprintf(stderr, "kernel_launch: unexpected problem (n_in %d, in0 %d, out %d, ws %zu < %zu); nothing launched\n", n_in, n_in > 0 ? in_sizes[0] : -1, out_size, ws_size, (size_t)WS_END); grid = -1; return; }
        int dev = 0, cus = 0, per_cu = 0;
        if (hipGetDevice(&dev) != hipSuccess || hipDeviceGetAttribute(&cus, hipDeviceAttributeMultiprocessorCount, dev) != hipSuccess) { grid = -1; return; }
        if (hipFuncSetAttribute((const void*)mega_fwd, hipFuncAttributeMaxDynamicSharedMemorySize, LDS_BYTES) != hipSuccess) { fprintf(stderr, "kernel_launch: hipFuncSetAttribute failed\n"); grid = -1; return; }
        if (hipOccupancyMaxActiveBlocksPerMultiprocessor(&per_cu, (const void*)mega_fwd, NTHR, LDS_BYTES) != hipSuccess || per_cu < 1)
            fprintf(stderr, "kernel_launch: note: occupancy query reports %d workgroups per CU\n", per_cu);
        (void)hipGetLastError();
        grid = cus;
    }
    if (grid < 0) return;
    if (hipMemsetAsync((char*)d_ws + WS_CTL, 0, CTL_ZERO_BYTES, stream) != hipSuccess) { fprintf(stderr, "kernel_launch: memset failed\n"); return; }
    Args a{};
    for (int i = 0; i < 24; ++i) a.in[i] = (const float*)d_in[i];
    a.out = (float*)d_out; a.ws = (unsigned char*)d_ws;
#if MK_PER_PHASE
    for (int p = 0; p < NPHASE + 1; ++p) { a.ph_lo = p; a.ph_hi = p + 1; hipLaunchKernelGGL(mega_fwd, dim3(grid), dim3(NTHR), LDS_BYTES, stream, a); }
#else
#ifdef MK_PROBE_HI
    a.ph_lo = 0; a.ph_hi = MK_PROBE_HI; a.mode = MK_PROBE_MODE;
    hipLaunchKernelGGL(mega_fwd, dim3(grid), dim3(NTHR), LDS_BYTES, stream, a);
    if (hipMemsetAsync((char*)d_ws + WS_CTL, 0, CTL_ZERO_BYTES, stream) != hipSuccess) return;
#endif
    a.ph_lo = 0; a.ph_hi = NPHASE + 1;
#ifdef MK_PROBE_HI
    a.mode = 0;
#endif
    hipLaunchKernelGGL(mega_fwd, dim3(grid), dim3(NTHR), LDS_BYTES, stream, a);
#endif
    const hipError_t le = hipPeekAtLastError();
    if (le != hipSuccess) fprintf(stderr, "kernel_launch: launch failed: %s\n", hipGetErrorName(le));
}
```
